# Optimizing an MI355X kernel written in HIP

```python
import jax
import jax.numpy as jnp
from jax import lax
import numpy as np

D_MODEL = 2048
BATCH = 8
SEQ = 4096
DEPTH = 4

ROPE_THETA = 500000.0
Q_BLOCK = 128
NORM_EPS = 1e-6
MIXER_ORDER = ('dsa', 'fox', 'nsa')
N_MIXERS = len(MIXER_ORDER)

DSA_HEADS = 32
DSA_Q_RANK = 512
DSA_KV_RANK = 256
DSA_QK_DIM = 192
DSA_ROPE = DSA_QK_DIM // 4
DSA_NOPE = DSA_QK_DIM - DSA_ROPE
DSA_V_DIM = 128
IDX_HEADS = 16
IDX_DIM = 128
IDX_ROPE = IDX_DIM // 4
DSA_TOPK_MAX = 256
DSA_IN_SIZES = (DSA_Q_RANK, DSA_KV_RANK, DSA_ROPE, IDX_DIM, IDX_HEADS)
DSA_IN = sum(DSA_IN_SIZES)
DSA_QUP = DSA_HEADS * DSA_QK_DIM + IDX_HEADS * IDX_DIM

FOX_HEADS = 16
FOX_DIM = 128
FOX_IN = 3 * FOX_HEADS * FOX_DIM + FOX_HEADS

NSA_HEADS = 48
NSA_GROUPS = 4
NSA_HPG = NSA_HEADS // NSA_GROUPS
NSA_QK_DIM = 192
NSA_ROPE = NSA_QK_DIM // 4
NSA_V_DIM = 128
CMP_BLOCK = 32
CMP_STRIDE = 16
CMP_HIDDEN = 256
SLC_BLOCK = 64
SLC_TOPK = 16
WINDOW = 512
NSA_N_BRANCH = 3
NSA_KD = NSA_GROUPS * NSA_QK_DIM
NSA_VD = NSA_GROUPS * NSA_V_DIM
NSA_IN_SIZES = (NSA_HEADS * NSA_QK_DIM, NSA_KD, NSA_VD, NSA_KD, NSA_VD, NSA_KD, NSA_VD, NSA_N_BRANCH * NSA_HEADS)
NSA_IN = sum(NSA_IN_SIZES)

D_FF = 5632
CONV_WIDTH = 3

kernel_name = 'hybrid_dsa_fox_nsa_convffn_trunk'


def split_last(x, sizes):
    cuts = [int(c) for c in np.cumsum(sizes)[:-1]]
    return jnp.split(x, cuts, axis=-1)


def rms_norm(x, g):
    xf = x.astype(jnp.float32)
    y = xf * lax.rsqrt(jnp.mean(xf * xf, axis=-1, keepdims=True) + NORM_EPS)
    return (y * g.astype(jnp.float32)).astype(x.dtype)


def layer_norm(x, g, b):
    xf = x.astype(jnp.float32)
    mu = jnp.mean(xf, axis=-1, keepdims=True)
    var = jnp.mean(jnp.square(xf - mu), axis=-1, keepdims=True)
    y = (xf - mu) * lax.rsqrt(var + NORM_EPS)
    return (y * g.astype(jnp.float32) + b.astype(jnp.float32)).astype(x.dtype)


def rope_tables(positions, rot):
    inv = ROPE_THETA ** (-jnp.arange(0, rot, 2, dtype=jnp.float32) / rot)
    ang = positions.astype(jnp.float32)[..., None] * inv
    return jnp.cos(ang), jnp.sin(ang)


def apply_partial_rope(x, cos, sin):
    half = cos.shape[-1]
    rot = 2 * half
    xf = x[..., :rot].astype(jnp.float32)
    x1, x2 = xf[..., :half], xf[..., half:]
    c, s = cos[:, :, None, :], sin[:, :, None, :]
    r = jnp.concatenate([x1 * c - x2 * s, x1 * s + x2 * c], axis=-1).astype(x.dtype)
    return jnp.concatenate([r, x[..., rot:]], axis=-1)


def masked_softmax(logits, mask):
    z = jnp.where(mask, logits.astype(jnp.float32), -jnp.inf)
    m = jnp.max(z, axis=-1, keepdims=True)
    m = jnp.where(jnp.isfinite(m), m, 0.0)
    e = jnp.where(mask, jnp.exp(z - m), 0.0)
    den = jnp.sum(e, axis=-1, keepdims=True)
    return e / jnp.where(den > 0, den, 1.0)


def sweep_query_blocks(block_fn, seq):
    out = lax.map(block_fn, jnp.arange(seq // Q_BLOCK))
    out = jnp.moveaxis(out, 0, 1)
    return out.reshape((out.shape[0], seq) + out.shape[3:])


def dsa_mixer(h, positions, w_in, q_norm, kv_norm, idx_ln_g, idx_ln_b, w_qup, w_uk, w_uv, w_out):
    B, S, _ = h.shape
    n_keep = min(DSA_TOPK_MAX, S // 4)
    scale = DSA_QK_DIM ** -0.5
    cq, ckv, k_pe, k_idx, w_idx = split_last(h @ w_in, DSA_IN_SIZES)
    q, q_idx = split_last(rms_norm(cq, q_norm) @ w_qup, (DSA_HEADS * DSA_QK_DIM, IDX_HEADS * IDX_DIM))
    cos, sin = rope_tables(positions, DSA_ROPE)
    q = apply_partial_rope(q.reshape(B, S, DSA_HEADS, DSA_QK_DIM), cos, sin)
    q_pe, q_nope = q[..., :DSA_ROPE], q[..., DSA_ROPE:]
    k_pe = apply_partial_rope(k_pe[:, :, None, :], cos, sin)[:, :, 0]
    latent = jnp.concatenate([rms_norm(ckv, kv_norm), k_pe], axis=-1)
    icos, isin = rope_tables(positions, IDX_ROPE)
    q_idx = apply_partial_rope(q_idx.reshape(B, S, IDX_HEADS, IDX_DIM), icos, isin)
    k_idx = apply_partial_rope(layer_norm(k_idx, idx_ln_g, idx_ln_b)[:, :, None, :], icos, isin)[:, :, 0]
    w_idx = w_idx * (IDX_HEADS ** -0.5 * IDX_DIM ** -0.5)
    key_pos = jnp.arange(S)

    def block(i):
        q0 = i * Q_BLOCK
        t = q0 + jnp.arange(Q_BLOCK)
        causal = key_pos[None, :] <= t[:, None]
        qi = lax.dynamic_slice_in_dim(q_idx, q0, Q_BLOCK, 1)
        wi = lax.dynamic_slice_in_dim(w_idx, q0, Q_BLOCK, 1)
        dots = jnp.einsum('bqhd,bsd->bqhs', qi, k_idx)
        score = jnp.einsum('bqhs,bqh->bqs', jax.nn.relu(dots).astype(jnp.float32), wi.astype(jnp.float32))
        score = jnp.where(causal[None], score, -jnp.inf)
        _, sel = lax.top_k(score, n_keep)
        valid = sel <= t[None, :, None]
        kv = jax.vmap(lambda a, ix: a[ix])(latent, sel)
        c_sel, kpe_sel = kv[..., :DSA_KV_RANK], kv[..., DSA_KV_RANK:]
        qn = lax.dynamic_slice_in_dim(q_nope, q0, Q_BLOCK, 1)
        qp = lax.dynamic_slice_in_dim(q_pe, q0, Q_BLOCK, 1)
        q_lat = jnp.einsum('bqhn,hrn->bqhr', qn, w_uk)
        logits = (jnp.einsum('bqhr,bqkr->bqhk', q_lat, c_sel)
                  + jnp.einsum('bqhe,bqke->bqhk', qp, kpe_sel)) * scale
        p = masked_softmax(logits, valid[:, :, None, :]).astype(c_sel.dtype)
        o_lat = jnp.einsum('bqhk,bqkr->bqhr', p, c_sel)
        return jnp.einsum('bqhr,hrv->bqhv', o_lat, w_uv)

    o = sweep_query_blocks(block, S)
    return o.reshape(B, S, DSA_HEADS * DSA_V_DIM) @ w_out


def fox_mixer(h, w_in, b_f, w_out):
    B, S, _ = h.shape
    hd = FOX_HEADS * FOX_DIM
    q, k, v, f_logit = split_last(h @ w_in, (hd, hd, hd, FOX_HEADS))
    q = q.reshape(B, S, FOX_HEADS, FOX_DIM)
    k = k.reshape(B, S, FOX_HEADS, FOX_DIM)
    v = v.reshape(B, S, FOX_HEADS, FOX_DIM)
    log_f = jax.nn.log_sigmoid(f_logit.astype(jnp.float32) + b_f.astype(jnp.float32))
    cum = jnp.cumsum(log_f, axis=1).transpose(0, 2, 1)
    scale = FOX_DIM ** -0.5
    key_pos = jnp.arange(S)

    def block(i):
        q0 = i * Q_BLOCK
        t = q0 + jnp.arange(Q_BLOCK)
        qb = lax.dynamic_slice_in_dim(q, q0, Q_BLOCK, 1)
        cb = lax.dynamic_slice_in_dim(cum, q0, Q_BLOCK, 2)
        logits = (jnp.einsum('bqhd,bshd->bhqs', qb, k).astype(jnp.float32) * scale
                  + (cb[..., None] - cum[:, :, None, :]))
        p = masked_softmax(logits, key_pos[None, :] <= t[:, None]).astype(v.dtype)
        return jnp.einsum('bhqs,bshd->bqhd', p, v)

    o = sweep_query_blocks(block, S)
    return o.reshape(B, S, hd) @ w_out


def compress_blocks(x, pe, w1, b1, w2):
    B, S, G, D = x.shape
    n_cmp = (S - CMP_BLOCK) // CMP_STRIDE + 1
    idx = np.arange(n_cmp)[:, None] * CMP_STRIDE + np.arange(CMP_BLOCK)[None, :]
    blocks = x[:, idx] + pe[None, None, :, None, :]
    blocks = blocks.transpose(0, 1, 3, 2, 4).reshape(B, n_cmp, G, CMP_BLOCK * D)
    return jax.nn.gelu(blocks @ w1 + b1) @ w2


def nsa_mixer(h, positions, w_in, k_pe, k_w1, k_b1, k_w2, v_pe, v_w1, v_b1, v_w2, w_out):
    B, S, _ = h.shape
    G, J, DK, DV = NSA_GROUPS, NSA_HPG, NSA_QK_DIM, NSA_V_DIM
    q, k_c, v_c, k_s, v_s, k_w, v_w, g_logit = split_last(h @ w_in, NSA_IN_SIZES)
    cos, sin = rope_tables(positions, NSA_ROPE)
    q = apply_partial_rope(q.reshape(B, S, NSA_HEADS, DK), cos, sin).reshape(B, S, G, J, DK)
    k_c = apply_partial_rope(k_c.reshape(B, S, G, DK), cos, sin)
    k_s = apply_partial_rope(k_s.reshape(B, S, G, DK), cos, sin)
    k_w = apply_partial_rope(k_w.reshape(B, S, G, DK), cos, sin)
    v_c = v_c.reshape(B, S, G, DV)
    v_s = v_s.reshape(B, S, G, DV)
    v_w = v_w.reshape(B, S, G, DV)
    gates = jax.nn.sigmoid(g_logit.astype(jnp.float32)).astype(h.dtype).reshape(B, S, NSA_N_BRANCH, G, J)
    kc = compress_blocks(k_c, k_pe, k_w1, k_b1, k_w2)
    vc = compress_blocks(v_c, v_pe, v_w1, v_b1, v_w2)
    n_cmp = kc.shape[1]
    cmp_start = np.arange(n_cmp) * CMP_STRIDE
    cmp_last = jnp.asarray(cmp_start + CMP_BLOCK - 1)
    n_slc = S // SLC_BLOCK
    n_sel = min(SLC_TOPK, n_slc)
    slc_start = np.arange(n_slc) * SLC_BLOCK
    overlap = jnp.asarray(((cmp_start[:, None] < slc_start[None, :] + SLC_BLOCK)
                           & (cmp_start[:, None] + CMP_BLOCK > slc_start[None, :])).astype(np.float32))
    ks_blocks = k_s.reshape(B, n_slc, SLC_BLOCK, G, DK).transpose(0, 3, 1, 2, 4)
    vs_blocks = v_s.reshape(B, n_slc, SLC_BLOCK, G, DV).transpose(0, 3, 1, 2, 4)
    blk_ids = jnp.arange(n_slc)
    in_blk = jnp.arange(SLC_BLOCK)
    gather = jax.vmap(jax.vmap(lambda a, ix: a[ix]))
    pad = ((0, 0), (WINDOW, 0), (0, 0), (0, 0))
    k_wp = jnp.pad(k_w, pad)
    v_wp = jnp.pad(v_w, pad)
    win_len = WINDOW + Q_BLOCK
    scale = DK ** -0.5

    def block(i):
        q0 = i * Q_BLOCK
        t = q0 + jnp.arange(Q_BLOCK)
        qb = lax.dynamic_slice_in_dim(q, q0, Q_BLOCK, 1)
        lc = jnp.einsum('bqgjd,bngd->bgjqn', qb, kc) * scale
        pc = masked_softmax(lc, cmp_last[None, :] <= t[:, None])
        o_c = jnp.einsum('bgjqn,bngv->bqgjv', pc.astype(vc.dtype), vc)
        imp = jnp.einsum('bgjqn,nm->bgqm', pc, overlap)
        cur = t // SLC_BLOCK
        forced = ((blk_ids[None, :] == 0) | (blk_ids[None, :] == cur[:, None])
                  | (blk_ids[None, :] == cur[:, None] - 1))
        causal_blk = blk_ids[None, :] * SLC_BLOCK <= t[:, None]
        imp = jnp.where(causal_blk, jnp.where(forced, jnp.inf, imp), -jnp.inf)
        _, sel = lax.top_k(imp, n_sel)
        ks = gather(ks_blocks, sel).reshape(B, G, Q_BLOCK, n_sel * SLC_BLOCK, DK)
        vs = gather(vs_blocks, sel).reshape(B, G, Q_BLOCK, n_sel * SLC_BLOCK, DV)
        pos = (sel[..., None] * SLC_BLOCK + in_blk).reshape(B, G, Q_BLOCK, n_sel * SLC_BLOCK)
        ls = jnp.einsum('bqgjd,bgqkd->bgjqk', qb, ks) * scale
        ps = masked_softmax(ls, (pos <= t[None, None, :, None])[:, :, None]).astype(vs.dtype)
        o_s = jnp.einsum('bgjqk,bgqkv->bqgjv', ps, vs)
        kw = lax.dynamic_slice_in_dim(k_wp, q0, win_len, 1)
        vw = lax.dynamic_slice_in_dim(v_wp, q0, win_len, 1)
        s_pos = q0 - WINDOW + jnp.arange(win_len)
        wmask = ((s_pos[None, :] >= 0) & (s_pos[None, :] <= t[:, None])
                 & (s_pos[None, :] > t[:, None] - WINDOW))
        lw = jnp.einsum('bqgjd,bsgd->bgjqs', qb, kw) * scale
        pw = masked_softmax(lw, wmask).astype(vw.dtype)
        o_w = jnp.einsum('bgjqs,bsgv->bqgjv', pw, vw)
        gb = lax.dynamic_slice_in_dim(gates, q0, Q_BLOCK, 1)
        return gb[:, :, 0, ..., None] * o_c + gb[:, :, 1, ..., None] * o_s + gb[:, :, 2, ..., None] * o_w

    o = sweep_query_blocks(block, S)
    return o.reshape(B, S, NSA_HEADS * DV) @ w_out


def conv_glu_ffn(h, w_up, conv_w, conv_b, w_down):
    S = h.shape[1]
    u = h @ w_up
    up = jnp.pad(u, ((0, 0), (CONV_WIDTH - 1, 0), (0, 0)))
    y = conv_b
    for j in range(CONV_WIDTH):
        y = y + conv_w[j] * up[:, j:j + S]
    gate, val = jnp.split(y, 2, axis=-1)
    return (jax.nn.silu(gate) * val) @ w_down


def _normal(key, shape, scale):
    return jax.random.normal(key, shape, jnp.float32) * scale


def _gain(key, n):
    return 1.0 + 0.05 * jax.random.normal(key, (n,), jnp.float32)


def _dsa_params(key, p):
    ks = jax.random.split(key, 9)
    return {
        p + 'dsa_w_in': _normal(ks[0], (D_MODEL, DSA_IN), D_MODEL ** -0.5),
        p + 'dsa_q_norm': _gain(ks[1], DSA_Q_RANK),
        p + 'dsa_kv_norm': _gain(ks[2], DSA_KV_RANK),
        p + 'dsa_idx_ln_g': _gain(ks[3], IDX_DIM),
        p + 'dsa_idx_ln_b': _normal(ks[4], (IDX_DIM,), 0.02),
        p + 'dsa_w_qup': _normal(ks[5], (DSA_Q_RANK, DSA_QUP), DSA_Q_RANK ** -0.5),
        p + 'dsa_w_uk': _normal(ks[6], (DSA_HEADS, DSA_KV_RANK, DSA_NOPE), DSA_KV_RANK ** -0.5),
        p + 'dsa_w_uv': _normal(ks[7], (DSA_HEADS, DSA_KV_RANK, DSA_V_DIM), DSA_KV_RANK ** -0.5),
        p + 'dsa_w_out': _normal(ks[8], (DSA_HEADS * DSA_V_DIM, D_MODEL), (DSA_HEADS * DSA_V_DIM) ** -0.5),
    }


def _fox_params(key, p):
    ks = jax.random.split(key, 3)
    return {
        p + 'fox_w_in': _normal(ks[0], (D_MODEL, FOX_IN), D_MODEL ** -0.5),
        p + 'fox_b_f': jax.random.uniform(ks[1], (FOX_HEADS,), jnp.float32, 1.0, 5.0),
        p + 'fox_w_out': _normal(ks[2], (FOX_HEADS * FOX_DIM, D_MODEL), (FOX_HEADS * FOX_DIM) ** -0.5),
    }


def _nsa_params(key, p):
    ks = jax.random.split(key, 10)
    return {
        p + 'nsa_w_in': _normal(ks[0], (D_MODEL, NSA_IN), D_MODEL ** -0.5),
        p + 'nsa_k_pe': _normal(ks[1], (CMP_BLOCK, NSA_QK_DIM), 0.1),
        p + 'nsa_k_w1': _normal(ks[2], (CMP_BLOCK * NSA_QK_DIM, CMP_HIDDEN), (CMP_BLOCK * NSA_QK_DIM) ** -0.5),
        p + 'nsa_k_b1': _normal(ks[3], (CMP_HIDDEN,), 0.01),
        p + 'nsa_k_w2': _normal(ks[4], (CMP_HIDDEN, NSA_QK_DIM), CMP_HIDDEN ** -0.5),
        p + 'nsa_v_pe': _normal(ks[5], (CMP_BLOCK, NSA_V_DIM), 0.1),
        p + 'nsa_v_w1': _normal(ks[6], (CMP_BLOCK * NSA_V_DIM, CMP_HIDDEN), (CMP_BLOCK * NSA_V_DIM) ** -0.5),
        p + 'nsa_v_b1': _normal(ks[7], (CMP_HIDDEN,), 0.01),
        p + 'nsa_v_w2': _normal(ks[8], (CMP_HIDDEN, NSA_V_DIM), CMP_HIDDEN ** -0.5),
        p + 'nsa_w_out': _normal(ks[9], (NSA_HEADS * NSA_V_DIM, D_MODEL), (NSA_HEADS * NSA_V_DIM) ** -0.5),
    }


def _ffn_params(key, p):
    ks = jax.random.split(key, 5)
    return {
        p + 'ffn_norm': _gain(ks[0], D_MODEL),
        p + 'ffn_up': _normal(ks[1], (D_MODEL, 2 * D_FF), D_MODEL ** -0.5),
        p + 'ffn_conv_w': _normal(ks[2], (CONV_WIDTH, 2 * D_FF), CONV_WIDTH ** -0.5),
        p + 'ffn_conv_b': _normal(ks[3], (2 * D_FF,), 0.01),
        p + 'ffn_down': _normal(ks[4], (D_FF, D_MODEL), D_FF ** -0.5),
    }


def setup_inputs(seed: int = 0) -> dict:
    key = jax.random.key(seed)
    keys = jax.random.split(key, DEPTH + 3)
    mixer_init = {'dsa': _dsa_params, 'fox': _fox_params, 'nsa': _nsa_params}
    params = {}
    params['x'] = jax.random.normal(keys[0], (BATCH, SEQ, D_MODEL), jnp.float32)
    offset = jax.random.randint(keys[1], (BATCH, 1), 0, 1024, dtype=jnp.int32)
    params['positions'] = jnp.arange(SEQ, dtype=jnp.int32)[None, :] + offset
    for i in range(DEPTH):
        k_norm, k_mix, k_ffn = jax.random.split(keys[2 + i], 3)
        p = 'l%d_' % i
        params[p + 'attn_norm'] = _gain(k_norm, D_MODEL)
        params.update(mixer_init[MIXER_ORDER[i % N_MIXERS]](k_mix, p))
        params.update(_ffn_params(k_ffn, p))
    params['final_norm'] = _gain(keys[DEPTH + 2], D_MODEL)
    return params


def reference(x, positions,
              l0_attn_norm, l0_dsa_w_in, l0_dsa_q_norm, l0_dsa_kv_norm, l0_dsa_idx_ln_g, l0_dsa_idx_ln_b,
              l0_dsa_w_qup, l0_dsa_w_uk, l0_dsa_w_uv, l0_dsa_w_out,
              l0_ffn_norm, l0_ffn_up, l0_ffn_conv_w, l0_ffn_conv_b, l0_ffn_down,
              l1_attn_norm, l1_fox_w_in, l1_fox_b_f, l1_fox_w_out,
              l1_ffn_norm, l1_ffn_up, l1_ffn_conv_w, l1_ffn_conv_b, l1_ffn_down,
              l2_attn_norm, l2_nsa_w_in, l2_nsa_k_pe, l2_nsa_k_w1, l2_nsa_k_b1, l2_nsa_k_w2,
              l2_nsa_v_pe, l2_nsa_v_w1, l2_nsa_v_b1, l2_nsa_v_w2, l2_nsa_w_out,
              l2_ffn_norm, l2_ffn_up, l2_ffn_conv_w, l2_ffn_conv_b, l2_ffn_down,
              l3_attn_norm, l3_dsa_w_in, l3_dsa_q_norm, l3_dsa_kv_norm, l3_dsa_idx_ln_g, l3_dsa_idx_ln_b,
              l3_dsa_w_qup, l3_dsa_w_uk, l3_dsa_w_uv, l3_dsa_w_out,
              l3_ffn_norm, l3_ffn_up, l3_ffn_conv_w, l3_ffn_conv_b, l3_ffn_down,
              final_norm):
    mixer_fns = {'dsa': dsa_mixer, 'fox': fox_mixer, 'nsa': nsa_mixer}
    layer_args = (
        (l0_attn_norm,
         (positions, l0_dsa_w_in, l0_dsa_q_norm, l0_dsa_kv_norm, l0_dsa_idx_ln_g, l0_dsa_idx_ln_b,
          l0_dsa_w_qup, l0_dsa_w_uk, l0_dsa_w_uv, l0_dsa_w_out),
         l0_ffn_norm, (l0_ffn_up, l0_ffn_conv_w, l0_ffn_conv_b, l0_ffn_down)),
        (l1_attn_norm,
         (l1_fox_w_in, l1_fox_b_f, l1_fox_w_out),
         l1_ffn_norm, (l1_ffn_up, l1_ffn_conv_w, l1_ffn_conv_b, l1_ffn_down)),
        (l2_attn_norm,
         (positions, l2_nsa_w_in, l2_nsa_k_pe, l2_nsa_k_w1, l2_nsa_k_b1, l2_nsa_k_w2,
          l2_nsa_v_pe, l2_nsa_v_w1, l2_nsa_v_b1, l2_nsa_v_w2, l2_nsa_w_out),
         l2_ffn_norm, (l2_ffn_up, l2_ffn_conv_w, l2_ffn_conv_b, l2_ffn_down)),
        (l3_attn_norm,
         (positions, l3_dsa_w_in, l3_dsa_q_norm, l3_dsa_kv_norm, l3_dsa_idx_ln_g, l3_dsa_idx_ln_b,
          l3_dsa_w_qup, l3_dsa_w_uk, l3_dsa_w_uv, l3_dsa_w_out),
         l3_ffn_norm, (l3_ffn_up, l3_ffn_conv_w, l3_ffn_conv_b, l3_ffn_down)),
    )
    h = x
    for i in range(DEPTH):
        attn_norm, mix_args, ffn_norm, ffn_args = layer_args[i]
        mixer = mixer_fns[MIXER_ORDER[i % N_MIXERS]]
        h = h + mixer(rms_norm(h, attn_norm), *mix_args)
        h = h + conv_glu_ffn(rms_norm(h, ffn_norm), *ffn_args)
    return rms_norm(h, final_norm)
```

```cpp
#include <hip/hip_runtime.h>
#include <cstdio>
#include <cstdint>
#define DI __device__ __forceinline__
namespace pg8 {
#define PG8_LAS __attribute__((address_space(3)))
typedef unsigned short bf16_t;
typedef short bf16x8 __attribute__((ext_vector_type(8)));
typedef float f32x4 __attribute__((ext_vector_type(4)));
typedef unsigned u32x4 __attribute__((ext_vector_type(4)));
constexpr int BM = 256, BK = 64, HALF = 128, HTB = HALF * BK * 2  , STAGE_BYTES = 8 * HTB, NXCD = 8, WGM = 8;

__host__ __device__ __forceinline__ int lds_byte(int r, int c) { const int st = (r >> 4) * 2 + (c >> 5), rr = r & 15, cc = c & 31, ob = rr * 64 + cc * 2; return st * 1024 + (ob ^ (((ob >> 9) & 1) << 5)); }
__host__ __device__ __forceinline__ void stage_rc(int b, int& R, int& C) { const int st = b / 1024, sb = b % 1024, swz = sb ^ (((sb >> 9) & 1) << 5); R = (st >> 1) * 16 + swz / 64; C = (st & 1) * 32 + (swz % 64) / 2; }
__host__ __device__ __forceinline__ int perm32(int rho) { const int n = rho >> 4, i = rho & 15; return 8 * (i >> 2) + 4 * n + (i & 3); }

struct Unit { int pm, pn; };
struct Gemm { const bf16_t* A; const bf16_t* Bt; int M, N, K, lda, ldb; };

struct StaticOrder {
    int nM, nN, nwg, G, c;
    __host__ __device__ void init(int M, int N, int G_, int c_) { nM = M / BM; nN = N / BM; nwg = nM * nN; G = G_; c = c_; }
    __host__ __device__ bool next(int i, Unit& u) const {
        const long L = (long)i * G + c; if (L >= nwg) return false;
        int wgid = (int)L; { const int q = nwg / NXCD, r = nwg % NXCD, xcd = wgid % NXCD, off = wgid / NXCD; wgid = (xcd < r ? xcd * (q + 1) : r * (q + 1) + (xcd - r) * q) + off; }
        const int nig = WGM * nN, gid = wgid / nig, fm = gid * WGM, gsz = (nM - fm) < WGM ? (nM - fm) : WGM;
        u.pm = fm + ((wgid % nig) % gsz); u.pn = (wgid % nig) / gsz; return true;
    }
    __device__ __forceinline__ void a_ready(const Unit&) const {}
    __device__ __forceinline__ void done(const Unit&) const {}
};
__device__ __forceinline__ unsigned cvt_pk_bf16(float lo, float hi) { unsigned r; asm volatile("v_cvt_pk_bf16_f32 %0, %1, %2" : "=v"(r) : "v"(lo), "v"(hi)); return r; }
template <class Epi, class Sched, bool ALIGN_EPI = false, bool SP2 = false>
__device__ __forceinline__ void gemm_phase(PG8_LAS unsigned char* lds, const Gemm g, const Sched& S, const Epi& E) {
    const int tid = threadIdx.x, wid = __builtin_amdgcn_readfirstlane(tid >> 6), lane = tid & 63, wr = wid >> 2, wc = wid & 3, fr = lane & 15, fq = lane >> 4;
    const int K = g.K, nt = K / BK;
    unsigned voffA[2], voffB[2];
#pragma unroll
    for (int i = 0; i < 2; ++i) { int R, C; stage_rc(tid * 16 + i * 8192, R, C); const int Rb = Epi::PERM ? ((R & ~31) + perm32(R & 31)) : R;
        voffA[i] = (unsigned)(R * g.lda + C) * 2u; voffB[i] = (unsigned)(Rb * g.ldb + C) * 2u; }
    const size_t kstep = (size_t)(BK * 2);
    const size_t hstepA = (size_t)HALF * g.lda * 2, hstepB = (size_t)HALF * g.ldb * 2;
    const size_t tstepA = 2 * hstepA, tstepB = 2 * hstepB;
    const unsigned ldsw = (unsigned)wid * 1024u;
    const int aoff = lds_byte(wr * 64 + fr, fq * 8), boff = lds_byte(wc * 32 + fr, fq * 8);
#define PG8_SA(b, h) (((b) * 2 + (h)) * HTB)
#define PG8_SB(b, h) ((4 + (b) * 2 + (h)) * HTB)
#define PG8_STAGE(bufoff, gbase, voff) do { _Pragma("unroll") for (int _i = 0; _i < 2; ++_i) \
        __builtin_amdgcn_global_load_lds((const unsigned*)((const char*)(gbase) + (voff)[_i]), (PG8_LAS unsigned*)(lds + (bufoff) + ldsw + _i * 8192), 16, 0, 0); } while (0)
#define PG8_LDA(dst, b, h) do { _Pragma("unroll") for (int m = 0; m < 4; ++m) _Pragma("unroll") for (int k = 0; k < 2; ++k) dst[m][k] = *(const PG8_LAS bf16x8*)(lds + PG8_SA(b, h) + aoff + m * 2048 + k * 1024); } while (0)
#define PG8_LDB(dst, b, h) do { _Pragma("unroll") for (int n = 0; n < 2; ++n) _Pragma("unroll") for (int k = 0; k < 2; ++k) dst[n][k] = *(const PG8_LAS bf16x8*)(lds + PG8_SB(b, h) + boff + n * 2048 + k * 1024); } while (0)
#define PG8_MMA(ai, bj, At, Bt) do { __builtin_amdgcn_s_setprio(1); _Pragma("unroll") for (int m = 0; m < 4; ++m) _Pragma("unroll") for (int n = 0; n < 2; ++n) _Pragma("unroll") for (int k = 0; k < 2; ++k) \
        acc[ai][bj][m][n] = __builtin_amdgcn_mfma_f32_16x16x32_bf16(Bt[n][k], At[m][k], acc[ai][bj][m][n], 0, 0, 0); __builtin_amdgcn_s_setprio(0); } while (0)
#define PG8_WAIT_V(n) asm volatile("s_waitcnt vmcnt(" #n ")" ::: "memory")
#define PG8_WAIT_L(n) asm volatile("s_waitcnt lgkmcnt(" #n ")" ::: "memory")
#define PG8_BAR __builtin_amdgcn_s_barrier()
#define PG8_SCHED __builtin_amdgcn_sched_barrier(0)
    Unit cur, nxt; int ui = 0;
    if (!S.next(0, cur)) return;
    f32x4 acc[2][2][4][2];
#pragma unroll
    for (int a = 0; a < 2; ++a)
#pragma unroll
        for (int b = 0; b < 2; ++b)
#pragma unroll
            for (int m = 0; m < 4; ++m)
#pragma unroll
                for (int n = 0; n < 2; ++n) acc[a][b][m][n] = (f32x4){0.f, 0.f, 0.f, 0.f};
    bf16x8 At[4][2], B0[2][2], B1[2][2];
    const char* cA = (const char*)g.A + (size_t)cur.pm * tstepA; const char* cB = (const char*)g.Bt + (size_t)cur.pn * tstepB;
    S.a_ready(cur);
    if constexpr (SP2) {
        PG8_STAGE(PG8_SB(0, 0), cB, voffB); PG8_STAGE(PG8_SB(0, 1), cB + hstepB, voffB); PG8_STAGE(PG8_SA(0, 0), cA, voffA); PG8_STAGE(PG8_SA(0, 1), cA + hstepA, voffA);
        if (wr == 1) PG8_BAR;
        PG8_WAIT_V(2); PG8_BAR;
        PG8_STAGE(PG8_SB(1, 0), cB + kstep, voffB); PG8_STAGE(PG8_SA(1, 0), cA + kstep, voffA); PG8_STAGE(PG8_SB(1, 1), cB + hstepB + kstep, voffB);
        PG8_WAIT_V(6); PG8_BAR;
    } else {
        PG8_STAGE(PG8_SB(0, 0), cB, voffB); PG8_STAGE(PG8_SA(0, 0), cA, voffA); PG8_STAGE(PG8_SB(0, 1), cB + hstepB, voffB); PG8_STAGE(PG8_SA(0, 1), cA + hstepA, voffA);
        if (wr == 1) PG8_BAR;
        PG8_WAIT_V(4); PG8_BAR;
        PG8_STAGE(PG8_SB(1, 0), cB + kstep, voffB); PG8_STAGE(PG8_SA(1, 0), cA + kstep, voffA); PG8_STAGE(PG8_SB(1, 1), cB + hstepB + kstep, voffB);
        PG8_WAIT_V(6); PG8_BAR;
    }
    for (;;) {
        const bool has_next = S.next(ui + 1, nxt);
        const char* nA = has_next ? (const char*)g.A + (size_t)nxt.pm * tstepA : cA; const char* nB = has_next ? (const char*)g.Bt + (size_t)nxt.pn * tstepB : cB;
        for (int t = 0; t < nt; t += 2) {
            const bool last = (t == nt - 2);
            const char* a1 = cA + (size_t)(t + 1) * kstep;
            const char* a2 = last ? nA : cA + (size_t)(t + 2) * kstep; const char* b2 = last ? nB : cB + (size_t)(t + 2) * kstep;
            const char* a3 = a2 + kstep; const char* b3 = b2 + kstep;
            if (last && has_next) S.a_ready(nxt);
            if constexpr (SP2) {
            PG8_LDB(B0, 0, 0); PG8_LDB(B1, 0, 1); PG8_SCHED; PG8_LDA(At, 0, 0); PG8_STAGE(PG8_SA(1, 1), a1 + hstepA, voffA);
            PG8_WAIT_V(8); PG8_WAIT_L(0); PG8_BAR; PG8_MMA(0, 0, At, B0); PG8_MMA(0, 1, At, B1); PG8_BAR; PG8_SCHED;
            PG8_LDA(At, 0, 1); PG8_STAGE(PG8_SB(0, 0), b2, voffB); PG8_STAGE(PG8_SB(0, 1), b2 + hstepB, voffB); PG8_STAGE(PG8_SA(0, 0), a2, voffA);
            PG8_WAIT_V(8); PG8_WAIT_L(0); PG8_BAR; PG8_MMA(1, 0, At, B0); PG8_MMA(1, 1, At, B1); PG8_BAR; PG8_SCHED;
            PG8_LDB(B0, 1, 0); PG8_LDB(B1, 1, 1); PG8_SCHED; PG8_LDA(At, 1, 0); PG8_STAGE(PG8_SA(0, 1), a2 + hstepA, voffA);
            PG8_WAIT_V(8); PG8_WAIT_L(0); PG8_BAR; PG8_MMA(0, 0, At, B0); PG8_MMA(0, 1, At, B1); PG8_BAR; PG8_SCHED;
            PG8_LDA(At, 1, 1); PG8_STAGE(PG8_SB(1, 0), b3, voffB); PG8_STAGE(PG8_SB(1, 1), b3 + hstepB, voffB); PG8_STAGE(PG8_SA(1, 0), a3, voffA);
            PG8_WAIT_V(8); PG8_WAIT_L(0); PG8_BAR; PG8_MMA(1, 0, At, B0); PG8_MMA(1, 1, At, B1); PG8_BAR; PG8_SCHED;
            } else {
            PG8_LDB(B0, 0, 0); PG8_SCHED; PG8_LDA(At, 0, 0); PG8_STAGE(PG8_SA(1, 1), a1 + hstepA, voffA);
            PG8_WAIT_L(8); PG8_BAR; PG8_WAIT_L(0); PG8_MMA(0, 0, At, B0); PG8_BAR; PG8_SCHED;
            PG8_LDB(B1, 0, 1); PG8_STAGE(PG8_SB(0, 0), b2, voffB);
            PG8_BAR; PG8_WAIT_L(0); PG8_MMA(0, 1, At, B1); PG8_BAR;
            PG8_LDA(At, 0, 1); PG8_STAGE(PG8_SA(0, 0), a2, voffA);
            PG8_BAR; PG8_WAIT_L(0); PG8_MMA(1, 0, At, B0); PG8_BAR; PG8_SCHED;
            PG8_STAGE(PG8_SB(0, 1), b2 + hstepB, voffB);
            PG8_WAIT_V(6); PG8_BAR; PG8_MMA(1, 1, At, B1); PG8_BAR;
            PG8_LDB(B0, 1, 0); PG8_SCHED; PG8_LDA(At, 1, 0); PG8_STAGE(PG8_SA(0, 1), a2 + hstepA, voffA);
            PG8_WAIT_L(8); PG8_BAR; PG8_WAIT_L(0); PG8_MMA(0, 0, At, B0); PG8_BAR; PG8_SCHED;
            PG8_LDB(B1, 1, 1); PG8_STAGE(PG8_SB(1, 0), b3, voffB);
            PG8_BAR; PG8_WAIT_L(0); PG8_MMA(0, 1, At, B1); PG8_BAR;
            PG8_LDA(At, 1, 1); PG8_STAGE(PG8_SA(1, 0), a3, voffA);
            PG8_BAR; PG8_WAIT_L(0); PG8_MMA(1, 0, At, B0); PG8_BAR; PG8_SCHED;
            PG8_STAGE(PG8_SB(1, 1), b3 + hstepB, voffB);
            PG8_WAIT_V(6); PG8_BAR; PG8_MMA(1, 1, At, B1); PG8_BAR;
            }
        }
        if constexpr (ALIGN_EPI) { if (wr == 0) PG8_BAR; }
        if constexpr (!Epi::AFTER_DRAIN) { E(acc, cur, wr, wc, fr, fq); S.done(cur); }
        if (!has_next) break;
#pragma unroll
        for (int a = 0; a < 2; ++a)
#pragma unroll
            for (int b = 0; b < 2; ++b)
#pragma unroll
                for (int m = 0; m < 4; ++m)
#pragma unroll
                    for (int n = 0; n < 2; ++n) acc[a][b][m][n] = (f32x4){0.f, 0.f, 0.f, 0.f};
        cur = nxt; cA = nA; cB = nB; ++ui;
        if constexpr (ALIGN_EPI) { if (wr == 1) PG8_BAR; }
    }
    PG8_WAIT_V(0);
    if constexpr (!ALIGN_EPI) { if (wr == 0) PG8_BAR; }
    PG8_BAR;
    if constexpr (Epi::AFTER_DRAIN) { E.fused(acc, cur, wr, wc, fr, fq, lds, wid, lane); S.done(cur); }
#undef PG8_SA
#undef PG8_SB
#undef PG8_STAGE
#undef PG8_LDA
#undef PG8_LDB
#undef PG8_MMA
#undef PG8_WAIT_V
#undef PG8_WAIT_L
#undef PG8_BAR
#undef PG8_SCHED
}
}
namespace pg8 {
typedef float f32x2 __attribute__((ext_vector_type(2)));
struct SegTab { bf16_t* base[6]; int ldc[6]; int t0[6]; int gw[6]; int nseg; int pad_; };
struct EpiBf16R {
    static constexpr bool PERM = true, AFTER_DRAIN = false;
    SegTab T;
    __device__ __forceinline__ void operator()(const f32x4 (&acc)[2][2][4][2], const Unit& u, int wr, int wc, int fr, int fq) const {
        bf16_t* base = T.base[0]; int ldc = T.ldc[0], gw = T.gw[0], t0 = T.t0[0];
#pragma unroll
        for (int s = 1; s < 6; ++s) if (s < T.nseg && u.pn >= T.t0[s]) { base = T.base[s]; ldc = T.ldc[s]; gw = T.gw[s]; t0 = T.t0[s]; }
        const int colt = (u.pn - t0) * BM, row0 = u.pm * BM + wr * 64 + fr;
#pragma unroll
        for (int ai = 0; ai < 2; ++ai)
#pragma unroll
            for (int m = 0; m < 4; ++m) { const int row = row0 + ai * HALF + m * 16;
#pragma unroll
                for (int bj = 0; bj < 2; ++bj) { const int col = colt + bj * HALF + wc * 32 + 8 * fq;
                    bf16_t* dst;
                    if (gw == 0) dst = base + (size_t)row * ldc + col;
                    else { const int g = col / gw, d = col - g * gw; dst = base + ((size_t)((row >> 12) * 4 + g) * 4096 + (row & 4095)) * gw + d; }
                    const f32x4 v0 = acc[ai][bj][m][0], v1 = acc[ai][bj][m][1];
                    u32x4 w; w.x = cvt_pk_bf16(v0[0], v0[1]); w.y = cvt_pk_bf16(v0[2], v0[3]); w.z = cvt_pk_bf16(v1[0], v1[1]); w.w = cvt_pk_bf16(v1[2], v1[3]);
                    *(u32x4*)dst = w; } }
    }
};
struct EpiGelu {
    static constexpr bool PERM = true, AFTER_DRAIN = false;
    bf16_t* O; int ldc; const float* bias;
    static __device__ __forceinline__ float gelu(float x) { const float u2 = 1.5957691216f * (x + 0.044715f * x * x * x); const float e = __builtin_amdgcn_exp2f(-u2 * 1.4426950409f); return x * __builtin_amdgcn_rcpf(1.0f + e); }
    __device__ __forceinline__ void operator()(const f32x4 (&acc)[2][2][4][2], const Unit& u, int wr, int wc, int fr, int fq) const {
        const int row0 = u.pm * BM + wr * 64 + fr, col0 = u.pn * BM + wc * 32 + 8 * fq;
#pragma unroll
        for (int bj = 0; bj < 2; ++bj) { const f32x4 b0 = *(const f32x4*)(bias + col0 + bj * HALF), b1 = *(const f32x4*)(bias + col0 + bj * HALF + 4);
#pragma unroll
            for (int ai = 0; ai < 2; ++ai)
#pragma unroll
                for (int m = 0; m < 4; ++m) { const f32x4 v0 = acc[ai][bj][m][0] + b0, v1 = acc[ai][bj][m][1] + b1;
                    u32x4 w; w.x = cvt_pk_bf16(gelu(v0[0]), gelu(v0[1])); w.y = cvt_pk_bf16(gelu(v0[2]), gelu(v0[3])); w.z = cvt_pk_bf16(gelu(v1[0]), gelu(v1[1])); w.w = cvt_pk_bf16(gelu(v1[2]), gelu(v1[3]));
                    *(u32x4*)(O + (size_t)(row0 + ai * HALF + m * 16) * ldc + col0 + bj * HALF) = w; } }
    }
};
struct EpiF32 {
    static constexpr bool PERM = false, AFTER_DRAIN = false;
    float* C; int ldc;
    __device__ __forceinline__ void operator()(const f32x4 (&acc)[2][2][4][2], const Unit& u, int wr, int wc, int fr, int fq) const {
        const int row0 = u.pm * BM + wr * 64 + fr, col0 = u.pn * BM + wc * 32 + 4 * fq;
#pragma unroll
        for (int ai = 0; ai < 2; ++ai)
#pragma unroll
            for (int m = 0; m < 4; ++m) { float* rowp = C + (size_t)(row0 + ai * HALF + m * 16) * ldc + col0;
#pragma unroll
                for (int bj = 0; bj < 2; ++bj)
#pragma unroll
                    for (int n = 0; n < 2; ++n) *(f32x4*)(rowp + bj * HALF + n * 16) = acc[ai][bj][m][n]; }
    }
};
struct EpiRes {
    static constexpr bool PERM = false, AFTER_DRAIN = false;
    const float* res; float* out; int ldc; int row_off;
    __device__ __forceinline__ void operator()(const f32x4 (&acc)[2][2][4][2], const Unit& u, int wr, int wc, int fr, int fq) const {
        const int row0 = row_off + u.pm * BM + wr * 64 + fr, col0 = u.pn * BM + wc * 32 + 4 * fq;
#pragma unroll
        for (int ai = 0; ai < 2; ++ai)
#pragma unroll
            for (int m = 0; m < 4; ++m) { const size_t off = (size_t)(row0 + ai * HALF + m * 16) * ldc + col0;
                f32x4 r[2][2];
#pragma unroll
                for (int bj = 0; bj < 2; ++bj)
#pragma unroll
                    for (int n = 0; n < 2; ++n) r[bj][n] = *(const f32x4*)(res + off + bj * HALF + n * 16);
#pragma unroll
                for (int bj = 0; bj < 2; ++bj)
#pragma unroll
                    for (int n = 0; n < 2; ++n) *(f32x4*)(out + off + bj * HALF + n * 16) = r[bj][n] + acc[ai][bj][m][n];
                asm volatile("" ::: "memory"); }
    }
};
}
constexpr int BATCH = 8, SEQ = 4096, DM = 2048, MTOT = BATCH * SEQ, MC = MTOT / 2  , BPH = BATCH / 2;
constexpr int DFF = 5632;
constexpr float NORM_EPS = 1e-6f, LOG2E = 1.4426950408889634f;
constexpr int NWAVES = 8;
constexpr size_t MiB = 1u << 20;
constexpr size_t WS_CTL = 0, CTL_ZERO_BYTES = 1 * MiB;
constexpr size_t WS_TAB = 1 * MiB;
constexpr size_t TAB_COS48 = WS_TAB, TAB_SIN48 = WS_TAB + 3 * MiB, TAB_COS32 = WS_TAB + 6 * MiB, TAB_SIN32 = WS_TAB + 8 * MiB;
constexpr size_t WS_WMIX = 12 * MiB;
constexpr size_t WS_WFFN = 100 * MiB;
constexpr size_t WS_MISC = 168 * MiB;
constexpr size_t WS_XN = 170 * MiB;
constexpr size_t WS_AR = 234 * MiB;
constexpr size_t WS_END = 934 * MiB;
constexpr int CW_TMO = 0;
constexpr int CW_BAR = 4096;
constexpr int RING_BYTES = 131072;
constexpr int LDSCTL_OFF = 135168;
constexpr int LDS_BYTES = 147456;

#define GAS __attribute__((address_space(1)))
#define LAS __attribute__((address_space(3)))
typedef unsigned short bf16;
typedef unsigned u32x4 __attribute__((ext_vector_type(4)));
typedef unsigned u32x2 __attribute__((ext_vector_type(2)));
typedef float f32x4 __attribute__((ext_vector_type(4)));
typedef float f32x16 __attribute__((ext_vector_type(16)));
typedef short bf16x8 __attribute__((ext_vector_type(8)));
typedef short s16x4 __attribute__((ext_vector_type(4)));
typedef short v4i16_t __attribute__((ext_vector_type(4)));
typedef __bf16 bf16x2_t __attribute__((ext_vector_type(2)));
typedef float f32x2_t __attribute__((ext_vector_type(2)));
#define LDS_WAIT() asm volatile("s_waitcnt lgkmcnt(0)" ::: "memory")
#define VM_WAIT() asm volatile("s_waitcnt vmcnt(0)" ::: "memory")
#define MFMA32(a, b, c) __builtin_amdgcn_mfma_f32_32x32x16_bf16((a), (b), (c), 0, 0, 0)
DI unsigned pk2(float lo, float hi) { f32x2_t v = {lo, hi}; bf16x2_t b = __builtin_convertvector(v, bf16x2_t); return __builtin_bit_cast(unsigned, b); }
DI float bf2f(unsigned short b) { return __builtin_bit_cast(float, (unsigned)b << 16); }
DI float bflo(unsigned w) { return __builtin_bit_cast(float, w << 16); }
DI float bfhi(unsigned w) { return __builtin_bit_cast(float, w & 0xffff0000u); }
DI unsigned short f2bf(float f) { return (unsigned short)(pk2(f, 0.f) & 0xffffu); }
DI float wave_sum(float v) {
#pragma unroll
    for (int o = 1; o < 64; o <<= 1) v += __shfl_xor(v, o);
    return v;
}
DI int crow(int i, int h) { return (i & 3) + 8 * (i >> 2) + 4 * h; }
#define XB_TMO      128
#define XB_XCNT(j)  (256  + 64 * (j))
#define XB_XSUB(j)  (1280 + 64 * (j))
#define XB_XGEN(j)  (2304 + 64 * (j))
#define XB_TOP      3328
#define XB_TOPGEN   3392
#define XCD_BAR_WORDS 3456
#define XB_SPIN_CAP (1u << 18)

__device__ __forceinline__ unsigned xb_ld(unsigned* p)              { return __hip_atomic_load(p, __ATOMIC_RELAXED, __HIP_MEMORY_SCOPE_AGENT); }
__device__ __forceinline__ unsigned xb_add(unsigned* p, unsigned v) { return __hip_atomic_fetch_add(p, v, __ATOMIC_RELAXED, __HIP_MEMORY_SCOPE_AGENT); }
__device__ __forceinline__ unsigned xb_xcc_id() { return (unsigned)__builtin_amdgcn_s_getreg((3 << 11) | 20) & 0xFu; }
#define XB_SPIN(cond, bar) do { unsigned _sp = 0; while (cond) { __builtin_amdgcn_s_sleep(1); \
    if ((++_sp & 255u) == 0u) { if (xb_ld(&(bar)[XB_TMO])) break; if (_sp > XB_SPIN_CAP) { atomicAdd(&(bar)[XB_TMO], 1u); break; } } } } while (0)

struct XcdBarrier {
    unsigned* bar; unsigned x;
    volatile LAS unsigned* st;
};

__device__ __forceinline__ XcdBarrier xcd_barrier_post(unsigned* bar, volatile LAS unsigned* st) {
    XcdBarrier b; b.bar = bar; b.x = xb_xcc_id(); b.st = st;
    if (threadIdx.x == 0) (void)xb_add(&bar[XB_XCNT(b.x)], 1u);
    return b;
}
__device__ __forceinline__ void xcd_barrier_complete(unsigned* bar, unsigned x, unsigned& nloc, unsigned& nx) {
    const unsigned G = gridDim.x * gridDim.y * gridDim.z;
    unsigned sum, cnt, mine, sp = 0u;
    for (;;) {
        sum = 0u; cnt = 0u; mine = 0u;
#pragma unroll
        for (unsigned j = 0; j < 16; ++j) { const unsigned c = xb_ld(&bar[XB_XCNT(j)]); sum += c; cnt += (c > 0u) ? 1u : 0u; mine = (j == x) ? c : mine; }
        if (sum == G) break;
        __builtin_amdgcn_s_sleep(1);
        if ((++sp & 255u) == 0u) { if (xb_ld(&bar[XB_TMO])) break; if (sp > XB_SPIN_CAP) { atomicAdd(&bar[XB_TMO], 1u); break; } }
    }
    nloc = mine > 0u ? mine : 1u; nx = cnt > 0u ? cnt : 1u;
}

__device__ __forceinline__ void xcd_barrier(const XcdBarrier& b) {
    asm volatile("s_waitcnt vmcnt(0)" ::: "memory");
    __syncthreads();
    if (threadIdx.x == 0) {
        unsigned* bar = b.bar;
        __builtin_amdgcn_s_waitcnt(0);
        unsigned nloc = b.st[0], nx = b.st[1];
        if (nloc == 0u) { xcd_barrier_complete(bar, b.x, nloc, nx); b.st[0] = nloc; b.st[1] = nx; }
        const unsigned old = xb_add(&bar[XB_XSUB(b.x)], 1u);
        const unsigned gen = old / nloc;
        if (old + 1u == (gen + 1u) * nloc) {
            __builtin_amdgcn_fence(__ATOMIC_RELEASE, "agent");
            asm volatile("s_waitcnt vmcnt(0)" ::: "memory");
            const unsigned og = xb_add(&bar[XB_TOP], 1u);
            const unsigned tg = og / nx;
            if (og + 1u == (tg + 1u) * nx) xb_add(&bar[XB_TOPGEN], 1u);
            else XB_SPIN(xb_ld(&bar[XB_TOPGEN]) == tg, bar);
            __builtin_amdgcn_fence(__ATOMIC_ACQUIRE, "agent");
            xb_add(&bar[XB_XGEN(b.x)], 1u);
            asm volatile("s_waitcnt vmcnt(0)" ::: "memory");
        } else {
            XB_SPIN(xb_ld(&bar[XB_XGEN(b.x)]) == gen, bar);
            __builtin_amdgcn_fence(__ATOMIC_ACQUIRE, "agent");
            asm volatile("s_waitcnt vmcnt(0)" ::: "memory");
        }
    }
    __syncthreads();
}
struct Frame {
    LAS unsigned char* lds; unsigned* ctl; unsigned char* ws;
    int tid, lane, wave, G, gw, NGW;
};
DI void ph_tables(const Frame& F, const int* pos) {
    float* c48 = (float*)(F.ws + TAB_COS48); float* s48 = (float*)(F.ws + TAB_SIN48); float* c32 = (float*)(F.ws + TAB_COS32); float* s32 = (float*)(F.ws + TAB_SIN32);
    const int gt = blockIdx.x * (NWAVES * 64) + F.tid, NT = F.G * NWAVES * 64;
    for (int i = gt; i < MTOT * 40; i += NT) {
        const int m = i / 40, j = i - m * 40; const float p = (float)pos[m];
        const bool a = j < 24; const int jj = a ? j : j - 24;
        const float inv = (float)exp(-(2.0 * jj / (a ? 48.0 : 32.0)) * 13.122363377404328);
        const float ang = p * inv; float sn, cs; sincosf(ang, &sn, &cs);
        if (a) { c48[m * 24 + jj] = cs; s48[m * 24 + jj] = sn; } else { c32[m * 16 + jj] = cs; s32[m * 16 + jj] = sn; }
    }
}
DI void cvt_item(const float* W, int ldw, int col0, int ncols, bf16* WT, int ldt, int row_off, float scale, LAS float* scr, int item, int nblk, int lane) {
    const int kb = item / nblk, nb = item - kb * nblk, k0 = 64 * kb, n0 = 32 * nb;
    const int nn = n0 + (lane & 31); const bool ok = nn < ncols;
#pragma unroll 8
    for (int i = 0; i < 32; ++i) { const int kk = 2 * i + (lane >> 5); scr[kk * 33 + (lane & 31)] = ok ? W[(size_t)(k0 + kk) * ldw + col0 + nn] * scale : 0.f; }
    LDS_WAIT();
    const int c = lane & 7;
#pragma unroll
    for (int j = 0; j < 4; ++j) { const int n = (lane >> 3) + 8 * j; const LAS float* s = scr + (8 * c) * 33 + n;
        u32x4 o; o.x = pk2(s[0 * 33], s[1 * 33]); o.y = pk2(s[2 * 33], s[3 * 33]); o.z = pk2(s[4 * 33], s[5 * 33]); o.w = pk2(s[6 * 33], s[7 * 33]);
        if (n0 + n < ncols) *(u32x4*)(WT + (size_t)(row_off + n0 + n) * ldt + k0 + 8 * c) = o; }
    LDS_WAIT();
}
DI void cvt_job(const Frame& F, const float* W, int ldw, int K, int col0, int ncols, bf16* WT, int ldt, int row_off, float scale) {
    LAS float* scr = (LAS float*)(F.lds + F.wave * 16384);
    const int nblk = (ncols + 31) / 32, nitems = (K / 64) * nblk;
    for (int it = F.gw; it < nitems; it += F.NGW) cvt_item(W, ldw, col0, ncols, WT, ldt, row_off, scale, scr, it, nblk, F.lane);
}
DI void zero_bf16(const Frame& F, bf16* p, size_t nelem) {
    const size_t gt = (size_t)blockIdx.x * (NWAVES * 64) + F.tid, NT = (size_t)F.G * NWAVES * 64;
    for (size_t i = gt; i < nelem / 8; i += NT) ((u32x4*)p)[i] = (u32x4){0u, 0u, 0u, 0u};
}
DI void ph_cvt_ffn(const Frame& F, const float* up, const float* down) {
    bf16* WUP = (bf16*)(F.ws + WS_WFFN); bf16* WDN = WUP + (size_t)2 * DFF * DM;
    cvt_job(F, up, 2 * DFF, DM, 0, 2 * DFF, WUP, DM, 0, 1.f);
    cvt_job(F, down, DM, DFF, 0, DM, WDN, DFF, 0, 1.f);
}
DI void ph_rmsnorm(const Frame& F, const float* src, int row_off, const float* gain, bf16* XN) {
    f32x4 g[8];
#pragma unroll
    for (int j = 0; j < 8; ++j) g[j] = *(const f32x4*)(gain + 4 * (F.lane + 64 * j));
    for (int ml = F.gw; ml < MC; ml += F.NGW) {
        const f32x4* xr = (const f32x4*)(src + (size_t)(row_off + ml) * DM) + F.lane;
        f32x4 v[8]; float ss = 0.f;
#pragma unroll
        for (int j = 0; j < 8; ++j) { v[j] = xr[64 * j]; ss += (v[j].x * v[j].x + v[j].y * v[j].y) + (v[j].z * v[j].z + v[j].w * v[j].w); }
        const float rstd = 1.0f / sqrtf(wave_sum(ss) * (1.f / DM) + NORM_EPS);
        u32x2* o = (u32x2*)(XN + (size_t)ml * DM) + F.lane;
#pragma unroll
        for (int j = 0; j < 8; ++j) { const f32x4 y = v[j] * rstd * g[j]; u32x2 w; w.x = pk2(y.x, y.y); w.y = pk2(y.z, y.w); o[64 * j] = w; }
    }
}
DI void ph_final_norm(const Frame& F, float* h, const float* gain) {
    f32x4 g[8];
#pragma unroll
    for (int j = 0; j < 8; ++j) g[j] = *(const f32x4*)(gain + 4 * (F.lane + 64 * j));
    for (int m = F.gw; m < MTOT; m += F.NGW) {
        f32x4* xr = (f32x4*)(h + (size_t)m * DM) + F.lane;
        f32x4 v[8]; float ss = 0.f;
#pragma unroll
        for (int j = 0; j < 8; ++j) { v[j] = xr[64 * j]; ss += (v[j].x * v[j].x + v[j].y * v[j].y) + (v[j].z * v[j].z + v[j].w * v[j].w); }
        const float rstd = 1.0f / sqrtf(wave_sum(ss) * (1.f / DM) + NORM_EPS);
#pragma unroll
        for (int j = 0; j < 8; ++j) xr[64 * j] = v[j] * rstd * g[j];
    }
}
DI void ph_conv_glu(const Frame& F, const bf16* U, bf16* Gb, const float* cw, const float* cb) {
    constexpr int RC = 32, NCG = DFF / 8, NRC = MC / RC;
    const int gt = blockIdx.x * (NWAVES * 64) + F.tid, NT = F.G * NWAVES * 64;
    for (int it = gt; it < NCG * NRC; it += NT) {
        const int cg = it % NCG, rc = it / NCG, c0 = cg * 8, r0 = rc * RC;
        float w0g[8], w1g[8], w2g[8], bg[8], w0v[8], w1v[8], w2v[8], bv[8];
#pragma unroll
        for (int e = 0; e < 8; ++e) { w0g[e] = cw[c0 + e]; w1g[e] = cw[2 * DFF + c0 + e]; w2g[e] = cw[4 * DFF + c0 + e]; bg[e] = cb[c0 + e];
            w0v[e] = cw[DFF + c0 + e]; w1v[e] = cw[3 * DFF + c0 + e]; w2v[e] = cw[5 * DFF + c0 + e]; bv[e] = cb[DFF + c0 + e]; }
        float pg2[8], pg1[8], pv2[8], pv1[8];
        const bool has = (r0 & (SEQ - 1)) != 0;
        {
            u32x4 a = {0u, 0u, 0u, 0u}, b = a, c = a, d = a;
            if (has) { a = *(const u32x4*)(U + (size_t)(r0 - 2) * (2 * DFF) + c0); b = *(const u32x4*)(U + (size_t)(r0 - 1) * (2 * DFF) + c0);
                       c = *(const u32x4*)(U + (size_t)(r0 - 2) * (2 * DFF) + DFF + c0); d = *(const u32x4*)(U + (size_t)(r0 - 1) * (2 * DFF) + DFF + c0); }
#pragma unroll
            for (int e = 0; e < 4; ++e) { pg2[2 * e] = bflo(a[e]); pg2[2 * e + 1] = bfhi(a[e]); pg1[2 * e] = bflo(b[e]); pg1[2 * e + 1] = bfhi(b[e]);
                pv2[2 * e] = bflo(c[e]); pv2[2 * e + 1] = bfhi(c[e]); pv1[2 * e] = bflo(d[e]); pv1[2 * e + 1] = bfhi(d[e]); }
        }
        for (int r = 0; r < RC; ++r) {
            const u32x4 ug = *(const u32x4*)(U + (size_t)(r0 + r) * (2 * DFF) + c0), uv = *(const u32x4*)(U + (size_t)(r0 + r) * (2 * DFF) + DFF + c0);
            float cg_[8], cv_[8], o[8];
#pragma unroll
            for (int e = 0; e < 4; ++e) { cg_[2 * e] = bflo(ug[e]); cg_[2 * e + 1] = bfhi(ug[e]); cv_[2 * e] = bflo(uv[e]); cv_[2 * e + 1] = bfhi(uv[e]); }
#pragma unroll
            for (int e = 0; e < 8; ++e) {
                const float yg = bg[e] + w0g[e] * pg2[e] + w1g[e] * pg1[e] + w2g[e] * cg_[e];
                const float yv = bv[e] + w0v[e] * pv2[e] + w1v[e] * pv1[e] + w2v[e] * cv_[e];
                const float sg = yg * __builtin_amdgcn_rcpf(1.0f + __builtin_amdgcn_exp2f(-yg * LOG2E));
                o[e] = sg * yv; pg2[e] = pg1[e]; pg1[e] = cg_[e]; pv2[e] = pv1[e]; pv1[e] = cv_[e];
            }
            u32x4 w; w.x = pk2(o[0], o[1]); w.y = pk2(o[2], o[3]); w.z = pk2(o[4], o[5]); w.w = pk2(o[6], o[7]);
            *(u32x4*)(Gb + (size_t)(r0 + r) * DFF + c0) = w;
        }
    }
}
constexpr size_t DA_DIN = 0, DA_CQN = 64 * MiB, DA_LATC = 80 * MiB, DA_KPE = 88 * MiB, DA_KIDX = 90 * MiB, DA_WIDX = 94 * MiB, DA_QL = 96 * MiB, DA_QPE = 352 * MiB, DA_QIDX = 400 * MiB,
                 DA_SEL = 464 * MiB, DA_CNT = 472 * MiB, DA_SC = 474 * MiB;
constexpr size_t DW_W1 = 0, DW_W2 = (size_t)1024 * 2048, DW_WO = DW_W2 + (size_t)11776 * 512;
constexpr float DSA_QSCALE = 0.07216878364870322f * LOG2E;
constexpr float DSA_WIDX_SCALE = 0.25f * 0.08838834764831845f;

DI void ph_dsa_cvt(const Frame& F, const float* w_in, const float* w_qup, const float* w_uk, const float* w_uv, const float* w_out) {
    bf16* WB = (bf16*)(F.ws + WS_WMIX);
    cvt_job(F, w_in, 960, DM, 0, 960, WB + DW_W1, DM, 0, 1.f);
    zero_bf16(F, WB + DW_W1 + (size_t)960 * DM, (size_t)64 * DM);
    { LAS float* scr = (LAS float*)(F.lds + F.wave * 16384);
      for (int it = F.gw; it < 32 * 16; it += F.NGW) { const int h = it >> 4; cvt_item(w_qup, 8192, h * 192, 48, WB + DW_W2, 512, 8192 + h * 48, DSA_QSCALE, scr, it & 15, 2, F.lane); } }
    cvt_job(F, w_qup, 8192, 512, 6144, 2048, WB + DW_W2, 512, 9728, 1.f);
    __syncthreads();
    {
        LAS float* As = (LAS float*)F.lds; LAS float* Bs = As + 64 * 145;
        for (int u = blockIdx.x; u < 32 * 4 * 8; u += F.G) {
            const int h = u >> 5, r0 = ((u >> 3) & 3) * 64, k0 = (u & 7) * 64;
            for (int i = F.tid; i < 64 * 144; i += NWAVES * 64) { const int row = i / 144, col = i - row * 144;
                As[row * 145 + col] = w_uk[(size_t)(h * 256 + r0) * 144 + i]; Bs[row * 145 + col] = w_qup[(size_t)(k0 + row) * 8192 + h * 192 + 48 + col]; }
            __syncthreads();
            const int r = F.tid & 63, kg = F.tid >> 6; float acc[8];
#pragma unroll
            for (int j = 0; j < 8; ++j) acc[j] = 0.f;
            for (int n = 0; n < 144; ++n) { const float a = As[r * 145 + n];
#pragma unroll
                for (int j = 0; j < 8; ++j) acc[j] += a * Bs[(kg * 8 + j) * 145 + n]; }
            u32x4 o; o.x = pk2(acc[0] * DSA_QSCALE, acc[1] * DSA_QSCALE); o.y = pk2(acc[2] * DSA_QSCALE, acc[3] * DSA_QSCALE); o.z = pk2(acc[4] * DSA_QSCALE, acc[5] * DSA_QSCALE); o.w = pk2(acc[6] * DSA_QSCALE, acc[7] * DSA_QSCALE);
            *(u32x4*)(WB + DW_W2 + (size_t)(h * 256 + r0 + r) * 512 + k0 + kg * 8) = o;
            __syncthreads();
        }
        LAS float* Av = (LAS float*)F.lds; LAS float* Bv = Av + 64 * 129;
        for (int u = blockIdx.x; u < 32 * 4 * 32; u += F.G) {
            const int h = u >> 7, r0 = ((u >> 5) & 3) * 64, c0 = (u & 31) * 64;
            for (int i = F.tid; i < 64 * 128; i += NWAVES * 64) { const int row = i >> 7, col = i & 127; Av[row * 129 + col] = w_uv[(size_t)(h * 256 + r0) * 128 + i]; }
            for (int i = F.tid; i < 128 * 64; i += NWAVES * 64) { const int v = i >> 6, c = i & 63; Bv[v * 64 + c] = w_out[(size_t)(h * 128 + v) * DM + c0 + c]; }
            __syncthreads();
            const int c = F.tid & 63, rg = F.tid >> 6; float acc[8];
#pragma unroll
            for (int j = 0; j < 8; ++j) acc[j] = 0.f;
            for (int v = 0; v < 128; ++v) { const float b = Bv[v * 64 + c];
#pragma unroll
                for (int j = 0; j < 8; ++j) acc[j] += Av[(rg * 8 + j) * 129 + v] * b; }
            u32x4 o; o.x = pk2(acc[0], acc[1]); o.y = pk2(acc[2], acc[3]); o.z = pk2(acc[4], acc[5]); o.w = pk2(acc[6], acc[7]);
            *(u32x4*)(WB + DW_WO + (size_t)(c0 + c) * 8192 + h * 256 + r0 + rg * 8) = o;
            __syncthreads();
        }
    }
}
DI void ph_dsa_post1(const Frame& F, int half, const float* qn, const float* kvn, const float* lng, const float* lnb) {
    unsigned char* ar = F.ws + WS_AR;
    const float* DIN = (const float*)(ar + DA_DIN); bf16* CQN = (bf16*)(ar + DA_CQN); bf16* LATC = (bf16*)(ar + DA_LATC); bf16* KPE = (bf16*)(ar + DA_KPE); bf16* KIDX = (bf16*)(ar + DA_KIDX); float* WIDX = (float*)(ar + DA_WIDX);
    const float* c48 = (const float*)(F.ws + TAB_COS48); const float* s48 = (const float*)(F.ws + TAB_SIN48); const float* c32 = (const float*)(F.ws + TAB_COS32); const float* s32 = (const float*)(F.ws + TAB_SIN32);
    LAS float* buf = (LAS float*)(F.lds + F.wave * 1024);
    const int lane = F.lane;
    for (int ml = F.gw; ml < MC; ml += F.NGW) {
        const int mg = half * MC + ml;
        const float* row = DIN + (size_t)ml * 1024 + 16 * lane;
        f32x4 v[4]; float ss = 0.f, s1 = 0.f;
#pragma unroll
        for (int j = 0; j < 4; ++j) { v[j] = *(const f32x4*)(row + 4 * j); ss += (v[j].x * v[j].x + v[j].y * v[j].y) + (v[j].z * v[j].z + v[j].w * v[j].w); s1 += (v[j].x + v[j].y) + (v[j].z + v[j].w); }
        const bool isq = lane < 32, iskv = lane >= 32 && lane < 48, ispe = lane >= 48 && lane < 51, isix = lane >= 51 && lane < 59;
        const float ssq = wave_sum(isq ? ss : 0.f), sskv = wave_sum(iskv ? ss : 0.f), mean = wave_sum(isix ? s1 : 0.f) * (1.f / 128.f);
        float d2 = 0.f;
#pragma unroll
        for (int j = 0; j < 4; ++j) { const f32x4 d = v[j] - mean; d2 += (d.x * d.x + d.y * d.y) + (d.z * d.z + d.w * d.w); }
        const float var = wave_sum(isix ? d2 : 0.f) * (1.f / 128.f);
        const float rq = 1.0f / sqrtf(ssq * (1.f / 512.f) + NORM_EPS), rkv = 1.0f / sqrtf(sskv * (1.f / 256.f) + NORM_EPS), rstd = 1.0f / sqrtf(var + NORM_EPS);
        if (isq || iskv) {
            const float* gp = isq ? qn + 16 * lane : kvn + 16 * (lane - 32); const float rs = isq ? rq : rkv;
            bf16* dst = isq ? CQN + (size_t)ml * 512 + 16 * lane : LATC + (size_t)ml * 256 + 16 * (lane - 32);
            u32x4 o[2];
#pragma unroll
            for (int j = 0; j < 4; ++j) { const f32x4 g = *(const f32x4*)(gp + 4 * j); const f32x4 y = v[j] * rs * g; o[j >> 1][(j & 1) * 2] = pk2(y.x, y.y); o[j >> 1][(j & 1) * 2 + 1] = pk2(y.z, y.w); }
            *(u32x4*)dst = o[0]; *(u32x4*)(dst + 8) = o[1];
        } else if (ispe) {
#pragma unroll
            for (int j = 0; j < 4; ++j) *(LAS f32x4*)(buf + (lane - 48) * 16 + 4 * j) = v[j];
        } else if (isix) {
#pragma unroll
            for (int j = 0; j < 4; ++j) { const f32x4 g = *(const f32x4*)(lng + (lane - 51) * 16 + 4 * j), b = *(const f32x4*)(lnb + (lane - 51) * 16 + 4 * j); *(LAS f32x4*)(buf + 48 + (lane - 51) * 16 + 4 * j) = (v[j] - mean) * rstd * g + b; }
        } else if (lane == 59) {
#pragma unroll
            for (int j = 0; j < 4; ++j) *(f32x4*)(WIDX + (size_t)ml * 16 + 4 * j) = v[j] * DSA_WIDX_SCALE;
        }
        LDS_WAIT();
        if (lane < 24) { const float x1 = buf[lane], x2 = buf[24 + lane], c = c48[(size_t)mg * 24 + lane], s = s48[(size_t)mg * 24 + lane];
            KPE[(size_t)ml * 48 + lane] = f2bf(x1 * c - x2 * s); KPE[(size_t)ml * 48 + 24 + lane] = f2bf(x1 * s + x2 * c);
        } else if (lane < 40) { const int i = lane - 24; const float x1 = buf[48 + i], x2 = buf[48 + 16 + i], c = c32[(size_t)mg * 16 + i], s = s32[(size_t)mg * 16 + i];
            KIDX[(size_t)ml * 128 + i] = f2bf(x1 * c - x2 * s); KIDX[(size_t)ml * 128 + 16 + i] = f2bf(x1 * s + x2 * c);
        } else { const int d = 32 + 4 * (lane - 40); const f32x4 y = *(const LAS f32x4*)(buf + 48 + d); u32x2 w; w.x = pk2(y.x, y.y); w.y = pk2(y.z, y.w); *(u32x2*)(KIDX + (size_t)ml * 128 + d) = w; }
        LDS_WAIT();
    }
}
DI void ph_dsa_rope(const Frame& F, int half) {
    unsigned char* ar = F.ws + WS_AR; bf16* QPE = (bf16*)(ar + DA_QPE); bf16* QIDX = (bf16*)(ar + DA_QIDX);
    const float* c48 = (const float*)(F.ws + TAB_COS48); const float* s48 = (const float*)(F.ws + TAB_SIN48); const float* c32 = (const float*)(F.ws + TAB_COS32); const float* s32 = (const float*)(F.ws + TAB_SIN32);
    for (int ml = F.gw; ml < MC; ml += F.NGW) {
        const size_t mg = (size_t)half * MC + ml;
        for (int p = F.lane; p < 768; p += 64) { const int hd = p / 24, i = p - hd * 24; bf16* q = QPE + (size_t)ml * 1536 + hd * 48 + i;
            const float x1 = bf2f(q[0]), x2 = bf2f(q[24]), c = c48[mg * 24 + i], s = s48[mg * 24 + i]; q[0] = f2bf(x1 * c - x2 * s); q[24] = f2bf(x1 * s + x2 * c); }
        for (int p = F.lane; p < 256; p += 64) { const int hd = p >> 4, i = p & 15; bf16* q = QIDX + (size_t)ml * 2048 + hd * 128 + i;
            const float x1 = bf2f(q[0]), x2 = bf2f(q[16]), c = c32[mg * 16 + i], s = s32[mg * 16 + i]; q[0] = f2bf(x1 * c - x2 * s); q[16] = f2bf(x1 * s + x2 * c); }
    }
}
DI unsigned f2sortable(float s) { const unsigned b = __builtin_bit_cast(unsigned, s); return (b & 0x80000000u) ? ~b : (b | 0x80000000u); }
DI void ph_dsa_index(const Frame& F) {
    unsigned char* ar = F.ws + WS_AR;
    const bf16* QIDX = (const bf16*)(ar + DA_QIDX); const bf16* KIDX = (const bf16*)(ar + DA_KIDX); const float* WIDX = (const float*)(ar + DA_WIDX);
    unsigned short* SEL = (unsigned short*)(ar + DA_SEL); int* CNT = (int*)(ar + DA_CNT); float* SC = (float*)(ar + DA_SC) + (size_t)F.gw * 16384;
    const int lane = F.lane, r = lane & 31, hf = lane >> 5;
#pragma unroll 1
    for (int tile = blockIdx.x; tile < BPH * 128; tile += F.G) {
        const int j = tile >> 8, c8 = tile & 255, c7 = c8 & 127, bl = (c8 >> 7) * 2 + j, qt = j ? 127 - c7 : c7;
        const int q0 = qt * 32 + 4 * F.wave;
        const int ntile = (q0 + 3) / 32 + 1;
        bf16x8 qa[2][8]; float wv[2][16];
#pragma unroll
        for (int pr = 0; pr < 2; ++pr) {
            const int mrow = bl * SEQ + q0 + 2 * pr + (r >> 4);
#pragma unroll
            for (int s = 0; s < 8; ++s) qa[pr][s] = *(const bf16x8*)(QIDX + (size_t)mrow * 2048 + (r & 15) * 128 + 16 * s + 8 * hf);
#pragma unroll
            for (int i = 0; i < 16; ++i) wv[pr][i] = WIDX[(size_t)(bl * SEQ + q0 + 2 * pr + (i >> 3)) * 16 + (i & 3) + 8 * ((i >> 2) & 1) + 4 * hf];
        }
#pragma unroll 1
        for (int t = 0; t < ntile; ++t) {
            bf16x8 kf[8];
            const bf16* kp = KIDX + (size_t)(bl * SEQ + 32 * t + r) * 128 + 8 * hf;
#pragma unroll
            for (int s = 0; s < 8; ++s) kf[s] = *(const bf16x8*)(kp + 16 * s);
#pragma unroll
            for (int pr = 0; pr < 2; ++pr) {
                f32x16 acc;
#pragma unroll
                for (int i = 0; i < 16; ++i) acc[i] = 0.f;
#pragma unroll
                for (int s = 0; s < 8; ++s) acc = MFMA32(qa[pr][s], kf[s], acc);
                float p0 = 0.f, p1 = 0.f;
#pragma unroll
                for (int i = 0; i < 8; ++i) { p0 += wv[pr][i] * fmaxf(acc[i], 0.f); p1 += wv[pr][8 + i] * fmaxf(acc[8 + i], 0.f); }
                const float t0 = p0 + __shfl_xor(p0, 32), t1 = p1 + __shfl_xor(p1, 32);
                SC[(pr * 128 + t) * 64 + lane] = hf ? t1 : t0;
            }
        }
        VM_WAIT();
#pragma unroll 1
        for (int qi = 0; qi < 4; ++qi) {
            const int tq = q0 + qi, pr = qi >> 1, qs = qi & 1;
            unsigned u[64];
            const unsigned* scp = (const unsigned*)(SC + pr * 8192 + hf * 64 + qs * 32 + r);
#pragma unroll
            for (int g8 = 0; g8 < 8; ++g8) {
#pragma unroll
                for (int e = 0; e < 8; ++e) { const int i = 8 * g8 + e; const float s = __builtin_bit_cast(float, __hip_atomic_load(scp + e * 128, __ATOMIC_RELAXED, __HIP_MEMORY_SCOPE_AGENT));
                    u[i] = (2 * i + hf < ntile && 64 * i + lane <= tq) ? f2sortable(s) : 0u; }
                scp += 1024; asm volatile("" : "+v"(scp));
            }
            unsigned prefix = 0u;
#pragma unroll 1
            for (int bit = 31; bit >= 0; --bit) {
                const unsigned cand = prefix | (1u << bit); int c = 0;
#pragma unroll
                for (int i = 0; i < 64; ++i) c += (u[i] >= cand) ? 1 : 0;
#pragma unroll
                for (int o = 1; o < 64; o <<= 1) c += __shfl_xor(c, o);
                if (c >= 256) prefix = cand;
            }
            const unsigned T = prefix > 1u ? prefix : 1u;
            int nl = 0;
#pragma unroll
            for (int i = 0; i < 64; ++i) nl += (u[i] >= T) ? 1 : 0;
            int inc = nl;
#pragma unroll
            for (int o = 1; o < 64; o <<= 1) { const int y = __shfl_up(inc, o); if (lane >= o) inc += y; }
            const int base = __shfl(inc, 63);
            int pos = inc - nl;
            unsigned short* sel = SEL + (size_t)(bl * SEQ + tq) * 256;
#pragma unroll
            for (int i = 0; i < 64; ++i) { if (u[i] >= T) { if (pos < 256) sel[pos] = (unsigned short)(64 * i + lane); ++pos; } }
            if (lane == 0) CNT[bl * SEQ + tq] = base < 256 ? base : 256;
        }
    }
}
DI void ph_dsa_attn(const Frame& F) {
    unsigned char* ar = F.ws + WS_AR;
    bf16* QL = (bf16*)(ar + DA_QL); const bf16* QPE = (const bf16*)(ar + DA_QPE); const bf16* LATC = (const bf16*)(ar + DA_LATC); const bf16* KPE = (const bf16*)(ar + DA_KPE);
    const unsigned short* SEL = (const unsigned short*)(ar + DA_SEL); const int* CNT = (const int*)(ar + DA_CNT);
    const int lane = F.lane, r = lane & 31, h = lane >> 5;
    u32x4* PS = (u32x4*)(ar + DA_SC + (size_t)F.gw * 65536) + lane;
    float* AS = (float*)(ar + DA_SC + (size_t)F.gw * 65536 + 16384) + lane;
    LAS unsigned char* img = F.lds + F.wave * 8704;
    const int i16 = lane & 15, tq_ = i16 >> 2, tp_ = i16 & 3, blk = (lane >> 4) & 1;
#pragma unroll 1
    for (int ml = F.gw; ml < MC; ml += F.NGW) {
        const int bl = ml >> 12, cnt = CNT[ml], nch = (cnt + 31) >> 5;
        const unsigned short* sel = SEL + (size_t)ml * 256;
        float linv;
        {
            bf16x8 qf[16], qp[3];
#pragma unroll
            for (int s = 0; s < 16; ++s) qf[s] = *(const bf16x8*)(QL + (size_t)ml * 8192 + r * 256 + 16 * s + 8 * h);
#pragma unroll
            for (int s = 0; s < 3; ++s) qp[s] = *(const bf16x8*)(QPE + (size_t)ml * 1536 + r * 48 + 16 * s + 8 * h);
            float m = -INFINITY, l = 0.f;
#pragma unroll 1
            for (int c = 0; c < nch; ++c) {
                const int slot = 32 * c + r; const int kidx = slot < cnt ? (int)sel[slot] : 0;
                const bf16* kc = LATC + (size_t)(bl * SEQ + kidx) * 256 + 8 * h; const bf16* kp = KPE + (size_t)(bl * SEQ + kidx) * 48 + 8 * h;
                f32x16 acc;
#pragma unroll
                for (int i = 0; i < 16; ++i) acc[i] = 0.f;
#pragma unroll
                for (int s = 0; s < 16; ++s) acc = MFMA32(*(const bf16x8*)(kc + 16 * s), qf[s], acc);
#pragma unroll
                for (int s = 0; s < 3; ++s) acc = MFMA32(*(const bf16x8*)(kp + 16 * s), qp[s], acc);
                float mx = -INFINITY;
#pragma unroll
                for (int i = 0; i < 16; ++i) { acc[i] = (32 * c + crow(i, h) < cnt) ? acc[i] : -INFINITY; mx = fmaxf(mx, acc[i]); }
                mx = fmaxf(mx, __shfl_xor(mx, 32));
                const float mn = fmaxf(m, mx), a = __builtin_amdgcn_exp2f(m - mn);
                float sum = 0.f;
#pragma unroll
                for (int i = 0; i < 16; ++i) { acc[i] = __builtin_amdgcn_exp2f(acc[i] - mn); sum += acc[i]; }
                l = l * a + sum; m = mn;
                AS[c * 64] = a;
#pragma unroll
                for (int s = 0; s < 2; ++s) { u32x4 w; w.x = pk2(acc[8 * s], acc[8 * s + 1]); w.y = pk2(acc[8 * s + 2], acc[8 * s + 3]); w.z = pk2(acc[8 * s + 4], acc[8 * s + 5]); w.w = pk2(acc[8 * s + 6], acc[8 * s + 7]); PS[(c * 2 + s) * 64] = w; }
            }
            l += __shfl_xor(l, 32);
            linv = 1.0f / l;
        }
#pragma unroll 1
        for (int dh = 0; dh < 2; ++dh) {
            f32x16 O[4];
#pragma unroll
            for (int db = 0; db < 4; ++db)
#pragma unroll
                for (int i = 0; i < 16; ++i) O[db][i] = 0.f;
#pragma unroll 1
            for (int c = 0; c < nch; ++c) {
                const int slot = 32 * c + r; const int myk = slot < cnt ? (int)sel[slot] : 0;
                const float a = AS[c * 64];
                const bf16x8 p0 = __builtin_bit_cast(bf16x8, PS[(c * 2) * 64]), p1 = __builtin_bit_cast(bf16x8, PS[(c * 2 + 1) * 64]);
#pragma unroll
                for (int it = 0; it < 8; ++it) { const int rr = (lane >> 4) + 4 * it; const int ki = __shfl(myk, rr);
                    const u32x4 d = *(const u32x4*)(LATC + (size_t)(bl * SEQ + ki) * 256 + dh * 128 + i16 * 8);
                    *(LAS u32x4*)(img + rr * 272 + i16 * 16) = d; }
#pragma unroll
                for (int db = 0; db < 4; ++db)
#pragma unroll
                    for (int i = 0; i < 16; ++i) O[db][i] *= a;
                LDS_WAIT();
#pragma unroll
                for (int db = 0; db < 4; ++db)
#pragma unroll
                    for (int s = 0; s < 2; ++s) {
                        const s16x4 lo = __builtin_bit_cast(s16x4, __builtin_amdgcn_ds_read_tr16_b64_v4i16((LAS v4i16_t*)(img + (16 * s + 4 * h + tq_) * 272 + db * 64 + 32 * blk + 8 * tp_)));
                        const s16x4 hi = __builtin_bit_cast(s16x4, __builtin_amdgcn_ds_read_tr16_b64_v4i16((LAS v4i16_t*)(img + (16 * s + 8 + 4 * h + tq_) * 272 + db * 64 + 32 * blk + 8 * tp_)));
                        O[db] = MFMA32(__builtin_shufflevector(lo, hi, 0, 1, 2, 3, 4, 5, 6, 7), s ? p1 : p0, O[db]);
                    }
                LDS_WAIT();
            }
            bf16* o = QL + (size_t)ml * 8192 + r * 256 + dh * 128 + 4 * h;
#pragma unroll
            for (int db = 0; db < 4; ++db)
#pragma unroll
                for (int g = 0; g < 4; ++g) { u32x2 w; w.x = pk2(O[db][4 * g] * linv, O[db][4 * g + 1] * linv); w.y = pk2(O[db][4 * g + 2] * linv, O[db][4 * g + 3] * linv); *(u32x2*)(o + db * 32 + 8 * g) = w; }
        }
    }
}
template <int NDB> DI void softmax_step(f32x16& S, float& m, float& l, f32x16 (&O)[NDB], bf16x8 (&pf)[2]) {
    float mx = S[0];
#pragma unroll
    for (int i = 1; i < 16; ++i) mx = fmaxf(mx, S[i]);
    mx = fmaxf(mx, __shfl_xor(mx, 32));
    const float mn = fmaxf(m, mx), ms = (mn == -INFINITY) ? 0.f : mn;
    const float alpha = __builtin_amdgcn_exp2f(m - ms);
    float sum = 0.f;
#pragma unroll
    for (int i = 0; i < 16; ++i) { S[i] = __builtin_amdgcn_exp2f(S[i] - ms); sum += S[i]; }
    l = l * alpha + sum; m = mn;
#pragma unroll
    for (int db = 0; db < NDB; ++db)
#pragma unroll
        for (int i = 0; i < 16; ++i) O[db][i] *= alpha;
#pragma unroll
    for (int s = 0; s < 2; ++s) { u32x4 w; w.x = pk2(S[8 * s], S[8 * s + 1]); w.y = pk2(S[8 * s + 2], S[8 * s + 3]); w.z = pk2(S[8 * s + 4], S[8 * s + 5]); w.w = pk2(S[8 * s + 6], S[8 * s + 7]); pf[s] = __builtin_bit_cast(bf16x8, w); }
}
template <int NQ, int NDB, bool PV, bool QL, class KA, class VA, class MK>
DI void attn_run(const bf16x8 (&qf)[NQ], const LAS unsigned char* qlds, f32x16 (&O)[NDB], float& m, float& l, int tb, int te, const KA& ka, const VA& va, const MK& mk) {
    if (tb >= te) return;
    bf16x8 kf[NQ];
    { const bf16* kp = ka(tb);
#pragma unroll
      for (int s = 0; s < NQ; ++s) kf[s] = *(const bf16x8*)(kp + 16 * s); }
    for (int t = tb; t < te; ++t) {
        s16x4 vl[NDB][2], vh[NDB][2];
        if (PV) {
#pragma unroll
            for (int db = 0; db < NDB; ++db) { const bf16* vp = va(t, db);
#pragma unroll
                for (int s = 0; s < 2; ++s) { vl[db][s] = *(const s16x4*)(vp + 16 * s); vh[db][s] = *(const s16x4*)(vp + 16 * s + 8); } }
        }
        f32x16 S;
#pragma unroll
        for (int i = 0; i < 16; ++i) S[i] = 0.f;
#pragma unroll
        for (int s = 0; s < NQ; ++s) { if (QL) { unsigned qa_ = (unsigned)(size_t)qlds; asm volatile("" : "+v"(qa_)); S = MFMA32(kf[s], *(const LAS bf16x8*)((LAS unsigned char*)(size_t)qa_ + s * 1024), S); } else S = MFMA32(kf[s], qf[s], S); }
        if (t + 1 < te) { const bf16* kp = ka(t + 1);
#pragma unroll
            for (int s = 0; s < NQ; ++s) kf[s] = *(const bf16x8*)(kp + 16 * s); }
        mk(t, S);
        bf16x8 pf[2]; softmax_step<NDB>(S, m, l, O, pf);
        if (PV) {
#pragma unroll
            for (int db = 0; db < NDB; ++db)
#pragma unroll
                for (int s = 0; s < 2; ++s) O[db] = MFMA32(__builtin_shufflevector(vl[db][s], vh[db][s], 0, 1, 2, 3, 4, 5, 6, 7), pf[s], O[db]);
        }
    }
}
template <bool ACC> DI void store_col(bf16* out, const f32x16 (&O)[4], float scale, int h) {
#pragma unroll
    for (int db = 0; db < 4; ++db)
#pragma unroll
        for (int g = 0; g < 4; ++g) { u32x2* p = (u32x2*)(out + db * 32 + 8 * g + 4 * h);
            float a = O[db][4 * g] * scale, b = O[db][4 * g + 1] * scale, c = O[db][4 * g + 2] * scale, d = O[db][4 * g + 3] * scale;
            if (ACC) { const u32x2 o = *p; a += bflo(o.x); b += bfhi(o.x); c += bflo(o.y); d += bfhi(o.y); }
            u32x2 w; w.x = pk2(a, b); w.y = pk2(c, d); *p = w; }
}
constexpr size_t FA_Q = 0, FA_K = 64 * MiB, FA_F = 128 * MiB, FA_VT = 136 * MiB, FA_CUM = 200 * MiB, FA_O = 202 * MiB;
constexpr size_t FW_IN = 0, FW_V = (size_t)4352 * 2048, FW_OUT = FW_V + (size_t)2048 * 2048;
constexpr float FOX_QSCALE = 0.08838834764831845f * LOG2E;
DI void ph_fox_cvt(const Frame& F, const float* w_in, const float* w_out) {
    bf16* WB = (bf16*)(F.ws + WS_WMIX);
    cvt_job(F, w_in, 6160, DM, 0, 2048, WB + FW_IN, DM, 0, FOX_QSCALE);
    cvt_job(F, w_in, 6160, DM, 2048, 2048, WB + FW_IN, DM, 2048, 1.f);
    cvt_job(F, w_in, 6160, DM, 6144, 16, WB + FW_IN, DM, 4096, 1.f);
    zero_bf16(F, WB + FW_IN + (size_t)4112 * DM, (size_t)240 * DM);
    cvt_job(F, w_in, 6160, DM, 4096, 2048, WB + FW_V, DM, 0, 1.f);
    cvt_job(F, w_out, DM, DM, 0, DM, WB + FW_OUT, DM, 0, 1.f);
}
DI void ph_fox_scan(const Frame& F, const float* b_f) {
    unsigned char* ar = F.ws + WS_AR; const bf16* FB = (const bf16*)(ar + FA_F); float* CUM = (float*)(ar + FA_CUM);
    for (int w = F.gw; w < BPH * 16; w += F.NGW) {
        const int bl = w >> 4, hd = w & 15; const float bf_ = b_f[hd];
        float v[64]; float run = 0.f;
#pragma unroll
        for (int i = 0; i < 64; ++i) { const float x = bf2f(FB[(size_t)(bl * SEQ + F.lane * 64 + i) * 256 + hd]) + bf_;
            const float ls = fminf(x, 0.f) - log1pf(expf(-fabsf(x))); run += ls; v[i] = run; }
        float inc = run;
#pragma unroll
        for (int o = 1; o < 64; o <<= 1) { const float y = __shfl_up(inc, o); if (F.lane >= o) inc += y; }
        const float base = inc - run;
        float* dst = CUM + (size_t)w * SEQ + F.lane * 64;
#pragma unroll
        for (int i = 0; i < 64; i += 4) *(f32x4*)(dst + i) = (f32x4){(v[i] + base) * LOG2E, (v[i + 1] + base) * LOG2E, (v[i + 2] + base) * LOG2E, (v[i + 3] + base) * LOG2E};
    }
}
struct FoxKA { const bf16* base; DI const bf16* operator()(int t) const { return base + (size_t)t * 32 * DM; } };
struct FoxVA { const bf16* base; DI const bf16* operator()(int t, int db) const { return base + (size_t)db * 32 * MC + t * 32; } };
struct FoxMK { const float* cum; float ct; int tq, h;
    DI void operator()(int t, f32x16& S) const {
        const int k0 = 32 * t + 4 * h;
#pragma unroll
        for (int g = 0; g < 4; ++g) { const f32x4 cs = *(const f32x4*)(cum + k0 + 8 * g);
#pragma unroll
            for (int e = 0; e < 4; ++e) S[4 * g + e] = (k0 + 8 * g + e <= tq) ? S[4 * g + e] + (ct - cs[e]) : -INFINITY; }
    } };
DI void ph_fox_attn(const Frame& F) {
    unsigned char* ar = F.ws + WS_AR; const bf16* Q = (const bf16*)(ar + FA_Q); const bf16* K = (const bf16*)(ar + FA_K); const bf16* VT = (const bf16*)(ar + FA_VT); const float* CUM = (const float*)(ar + FA_CUM); bf16* Ob = (bf16*)(ar + FA_O);
    const int r = F.lane & 31, h = F.lane >> 5;
    for (int wt = F.gw; wt < BPH * 16 * 32; wt += F.NGW) {
        const int bh = wt >> 5, x = wt & 31, bl = bh >> 4, hd = bh & 15;
#pragma unroll 1
        for (int k = 0; k < 4; ++k) {
            const int qt = (k == 0) ? x : (k == 1) ? 63 - x : (k == 2) ? 64 + x : 127 - x;
            const int tq = qt * 32 + r; const size_t mrow = (size_t)bl * SEQ + tq;
            bf16x8 qf[8];
#pragma unroll
            for (int s = 0; s < 8; ++s) qf[s] = *(const bf16x8*)(Q + mrow * DM + hd * 128 + 16 * s + 8 * h);
            f32x16 O[4];
#pragma unroll
            for (int db = 0; db < 4; ++db)
#pragma unroll
                for (int i = 0; i < 16; ++i) O[db][i] = 0.f;
            float m = -INFINITY, l = 0.f;
            const float* cum = CUM + (size_t)bh * SEQ;
            const FoxKA ka{K + ((size_t)bl * SEQ + r) * DM + hd * 128 + 8 * h}; const FoxVA va{VT + ((size_t)hd * 128 + r) * MC + bl * SEQ + 4 * h}; const FoxMK mk{cum, cum[tq], tq, h};
            attn_run<8, 4, true, false>(qf, nullptr, O, m, l, 0, qt + 1, ka, va, mk);
            l += __shfl_xor(l, 32);
            store_col<false>(Ob + mrow * DM + hd * 128, O, l > 0.f ? 1.0f / l : 0.f, h);
        }
    }
}
constexpr size_t NA_Q = 0, NA_KC = 288 * MiB, NA_VC = 313 * MiB, NA_KS = 330 * MiB, NA_KW = 354 * MiB, NA_GT = 378 * MiB, NA_VT2 = 386 * MiB, NA_GK = 418 * MiB, NA_GV = 420 * MiB,
                 NA_KCMP = 422 * MiB, NA_VCT = 424 * MiB, NA_SELB = 426 * MiB, NA_O = 428 * MiB;
constexpr size_t NW_IN = 0, NW_V2 = (size_t)12288 * 2048, NW_W1K = NW_V2 + (size_t)1024 * 2048, NW_W1V = NW_W1K + (size_t)256 * 6144, NW_W2K = NW_W1V + (size_t)256 * 4096, NW_W2V = NW_W2K + 65536, NW_OUT = NW_W2V + 65536;
constexpr float NSA_QSCALE = 0.07216878364870322f * LOG2E;
DI void ph_nsa_cvt(const Frame& F, const float* w_in, const float* k_pe, const float* k_w1, const float* k_b1, const float* k_w2, const float* v_pe, const float* v_w1, const float* v_b1, const float* v_w2, const float* w_out) {
    bf16* WB = (bf16*)(F.ws + WS_WMIX); float* BIAS = (float*)(F.ws + WS_MISC);
    cvt_job(F, w_in, 13200, DM, 0, 9216, WB + NW_IN, DM, 0, NSA_QSCALE);
    cvt_job(F, w_in, 13200, DM, 9216, 768, WB + NW_IN, DM, 9216, 1.f);
    cvt_job(F, w_in, 13200, DM, 9984, 512, WB + NW_IN, DM, 9984, 1.f);
    cvt_job(F, w_in, 13200, DM, 10496, 768, WB + NW_IN, DM, 10496, 1.f);
    cvt_job(F, w_in, 13200, DM, 11776, 768, WB + NW_IN, DM, 11264, 1.f);
    cvt_job(F, w_in, 13200, DM, 13056, 144, WB + NW_IN, DM, 12032, 1.f);
    zero_bf16(F, WB + NW_IN + (size_t)12176 * DM, (size_t)112 * DM);
    cvt_job(F, w_in, 13200, DM, 11264, 512, WB + NW_V2, DM, 0, 1.f);
    cvt_job(F, w_in, 13200, DM, 12544, 512, WB + NW_V2, DM, 512, 1.f);
    cvt_job(F, k_w1, 256, 6144, 0, 256, WB + NW_W1K, 6144, 0, 1.f);
    cvt_job(F, v_w1, 256, 4096, 0, 256, WB + NW_W1V, 4096, 0, 1.f);
    cvt_job(F, k_w2, 192, 256, 0, 192, WB + NW_W2K, 256, 0, 1.f); zero_bf16(F, WB + NW_W2K + 192 * 256, 64 * 256);
    cvt_job(F, v_w2, 128, 256, 0, 128, WB + NW_W2V, 256, 0, 1.f); zero_bf16(F, WB + NW_W2V + 128 * 256, 128 * 256);
    cvt_job(F, w_out, DM, 6144, 0, DM, WB + NW_OUT, 6144, 0, 1.f);
    for (int w = F.gw; w < 512; w += F.NGW) { const bool isk = w < 256; const int c = w & 255, n = isk ? 6144 : 4096; const float* pe = isk ? k_pe : v_pe; const float* w1 = isk ? k_w1 : v_w1;
        float s = 0.f; for (int i = F.lane; i < n; i += 64) s += pe[i] * w1[(size_t)i * 256 + c];
        s = wave_sum(s); if (F.lane == 0) BIAS[w] = s + (isk ? k_b1[c] : v_b1[c]); }
}
DI void ph_nsa_rope(const Frame& F, int half) {
    unsigned char* ar = F.ws + WS_AR; bf16* Q = (bf16*)(ar + NA_Q); bf16* KC = (bf16*)(ar + NA_KC); bf16* KS = (bf16*)(ar + NA_KS); bf16* KW = (bf16*)(ar + NA_KW);
    const float* c48 = (const float*)(F.ws + TAB_COS48); const float* s48 = (const float*)(F.ws + TAB_SIN48);
    for (int ml = F.gw; ml < MC; ml += F.NGW) {
        const size_t mg = (size_t)half * MC + ml; const int bl = ml >> 12, sq = ml & 4095;
        for (int p = F.lane; p < 1440; p += 64) {
            const int hd = p / 24, i = p - hd * 24; bf16* q;
            if (hd < 48) q = Q + (size_t)ml * 9216 + hd * 192 + i;
            else if (hd < 52) q = KC + ((size_t)(bl * 4 + hd - 48) * 4096 + sq) * 192 + i;
            else if (hd < 56) q = KS + (size_t)ml * 768 + (hd - 52) * 192 + i;
            else q = KW + (size_t)ml * 768 + (hd - 56) * 192 + i;
            const float x1 = bf2f(q[0]), x2 = bf2f(q[24]), c = c48[mg * 24 + i], s = s48[mg * 24 + i]; q[0] = f2bf(x1 * c - x2 * s); q[24] = f2bf(x1 * s + x2 * c);
        }
    }
}
DI float sigmoidf_(float x) { return __builtin_amdgcn_rcpf(1.0f + __builtin_amdgcn_exp2f(-x * LOG2E)); }
struct LinKA { const bf16* base; size_t tstride; DI const bf16* operator()(int t) const { return base + (size_t)t * tstride; } };
struct LinVA { const bf16* base; size_t dbstride; DI const bf16* operator()(int t, int db) const { return base + (size_t)db * dbstride + t * 32; } };
struct CmpMK { int tq, h; DI void operator()(int t, f32x16& S) const {
#pragma unroll
    for (int i = 0; i < 16; ++i) { const int n = 32 * t + crow(i, h); S[i] = (16 * n + 31 <= tq) ? S[i] : -INFINITY; } } };
struct WinMK { int tq, h; DI void operator()(int t, f32x16& S) const {
#pragma unroll
    for (int i = 0; i < 16; ++i) { const int k = 32 * t + crow(i, h); S[i] = (k <= tq && k > tq - 512) ? S[i] : -INFINITY; } } };
DI void ph_nsa_cmp(const Frame& F) {
    unsigned char* ar = F.ws + WS_AR; const bf16* Q = (const bf16*)(ar + NA_Q); const bf16* KCMP = (const bf16*)(ar + NA_KCMP); const bf16* VCT = (const bf16*)(ar + NA_VCT); const bf16* GT = (const bf16*)(ar + NA_GT);
    unsigned char* SELB = ar + NA_SELB; bf16* Ob = (bf16*)(ar + NA_O);
    LAS float* imp = (LAS float*)F.lds;
    LAS unsigned char* qlds = F.lds + 20480 + F.wave * 12288 + F.lane * 16;
    const int lane = F.lane, r = lane & 31, h = lane >> 5;
    for (int u = blockIdx.x; u < BPH * 4 * 64; u += F.G) {
        const int bg = u >> 6, qt64 = u & 63, bl = bg >> 2, g = bg & 3;
        for (int i = F.tid; i < 64 * 65; i += NWAVES * 64) imp[i] = 0.f;
        __syncthreads();
#pragma unroll 1
        for (int k = 0; k < 3; ++k) {
            const int idx = F.wave * 3 + k, j = idx >> 1, sub = idx & 1, ql = sub * 32 + r, tq = qt64 * 64 + ql, hd = g * 12 + j;
            const size_t mrow = (size_t)bl * SEQ + tq;
            bf16x8 qf[12];
#pragma unroll
            for (int s = 0; s < 12; ++s) { qf[s] = *(const bf16x8*)(Q + mrow * 9216 + hd * 192 + 16 * s + 8 * h); *(LAS bf16x8*)(qlds + s * 1024) = qf[s]; }
            LDS_WAIT();
            const int tqmax = qt64 * 64 + sub * 32 + 31, te = (tqmax >= 31) ? ((tqmax - 31) / 16) / 32 + 1 : 0;
            const LinKA ka{KCMP + ((size_t)bg * 256 + r) * 256 + 8 * h, (size_t)32 * 256}; const LinVA va{VCT + (size_t)r * 4096 + bg * 256 + 4 * h, (size_t)32 * 4096}; const CmpMK mk{tq, h};
            f32x16 O[4];
#pragma unroll
            for (int db = 0; db < 4; ++db)
#pragma unroll
                for (int i = 0; i < 16; ++i) O[db][i] = 0.f;
            float m = -INFINITY, l = 0.f;
            attn_run<12, 4, false, true>(qf, qlds, O, m, l, 0, te, ka, va, mk);
            l += __shfl_xor(l, 32);
            const float linv = l > 0.f ? 1.0f / l : 0.f, ms = (m == -INFINITY) ? 0.f : m;
            for (int t = 0; t < te; ++t) {
                const bf16* kp = ka(t); f32x16 S;
#pragma unroll
                for (int i = 0; i < 16; ++i) S[i] = 0.f;
#pragma unroll
                for (int s = 0; s < 12; ++s) { unsigned qa_ = (unsigned)(size_t)qlds; asm volatile("" : "+v"(qa_)); S = MFMA32(*(const bf16x8*)(kp + 16 * s), *(const LAS bf16x8*)((LAS unsigned char*)(size_t)qa_ + s * 1024), S); }
                mk(t, S);
#pragma unroll
                for (int i = 0; i < 16; ++i) S[i] = __builtin_amdgcn_exp2f(S[i] - ms) * linv;
#pragma unroll
                for (int g4 = 0; g4 < 4; ++g4) { const float gs = (S[4 * g4] + S[4 * g4 + 1]) + (S[4 * g4 + 2] + S[4 * g4 + 3]); const int mb = 8 * t + 2 * g4 + h;
                    __hip_atomic_fetch_add(imp + ql * 65 + mb, gs, __ATOMIC_RELAXED, __HIP_MEMORY_SCOPE_WORKGROUP);
                    if (mb + 1 < 64) __hip_atomic_fetch_add(imp + ql * 65 + mb + 1, S[4 * g4 + 3], __ATOMIC_RELAXED, __HIP_MEMORY_SCOPE_WORKGROUP); }
                bf16x8 pf[2];
#pragma unroll
                for (int s = 0; s < 2; ++s) { u32x4 w; w.x = pk2(S[8 * s], S[8 * s + 1]); w.y = pk2(S[8 * s + 2], S[8 * s + 3]); w.z = pk2(S[8 * s + 4], S[8 * s + 5]); w.w = pk2(S[8 * s + 6], S[8 * s + 7]); pf[s] = __builtin_bit_cast(bf16x8, w); }
#pragma unroll
                for (int db = 0; db < 4; ++db) { const bf16* vp = va(t, db);
#pragma unroll
                    for (int s = 0; s < 2; ++s) O[db] = MFMA32(__builtin_shufflevector(*(const s16x4*)(vp + 16 * s), *(const s16x4*)(vp + 16 * s + 8), 0, 1, 2, 3, 4, 5, 6, 7), pf[s], O[db]); }
            }
            const float gate = sigmoidf_(bf2f(GT[mrow * 256 + hd]));
            store_col<false>(Ob + mrow * 6144 + hd * 128, O, gate, h);
        }
        __syncthreads();
#pragma unroll 1
        for (int k = 0; k < 8; ++k) {
            const int ql = F.wave * 8 + k, tq = qt64 * 64 + ql, cur = tq >> 6, mb = lane;
            const bool causal = mb <= cur, forced = (mb == 0) || (mb == cur) || (mb == cur - 1);
            const float v = causal ? (forced ? INFINITY : imp[ql * 65 + mb]) : -INFINITY;
            int rank = 0;
            for (int o = 0; o < 64; ++o) { const float vo = __shfl(v, o); rank += (vo > v || (vo == v && o < mb)) ? 1 : 0; }
            if (rank < 16) SELB[((size_t)bg * 4096 + tq) * 16 + rank] = causal ? (unsigned char)mb : (unsigned char)0xFF;
        }
        __syncthreads();
    }
}
struct SelKA { const bf16* base; u32x4 sel; DI int tok0(int t) const { const int b = t >> 1; const unsigned w = (b < 4) ? sel.x : (b < 8) ? sel.y : (b < 12) ? sel.z : sel.w; return (int)((w >> ((b & 3) * 8)) & 0xFFu) * 64 + 32 * (t & 1); }
    DI const bf16* operator()(int t) const { return base + (size_t)tok0(t) * 768; } };
struct SelVA { const bf16* base; u32x4 sel; DI int tok0(int t) const { const int b = t >> 1; const unsigned w = (b < 4) ? sel.x : (b < 8) ? sel.y : (b < 12) ? sel.z : sel.w; return (int)((w >> ((b & 3) * 8)) & 0xFFu) * 64 + 32 * (t & 1); }
    DI const bf16* operator()(int t, int db) const { return base + (size_t)db * 32 * MC + tok0(t); } };
struct SelMK { u32x4 sel; int tq, h; DI void operator()(int t, f32x16& S) const { const int b = t >> 1; const unsigned w = (b < 4) ? sel.x : (b < 8) ? sel.y : (b < 12) ? sel.z : sel.w; const int k0 = (int)((w >> ((b & 3) * 8)) & 0xFFu) * 64 + 32 * (t & 1);
#pragma unroll
    for (int i = 0; i < 16; ++i) S[i] = (k0 + crow(i, h) <= tq) ? S[i] : -INFINITY; } };
DI void ph_nsa_sel(const Frame& F) {
    unsigned char* ar = F.ws + WS_AR; const bf16* Q = (const bf16*)(ar + NA_Q); const bf16* KS = (const bf16*)(ar + NA_KS); const bf16* VT2 = (const bf16*)(ar + NA_VT2); const bf16* GT = (const bf16*)(ar + NA_GT);
    const unsigned char* SELB = ar + NA_SELB; bf16* Ob = (bf16*)(ar + NA_O);
    const int r = F.lane & 31, h = F.lane >> 5; const bool act = r < 12;
    LAS unsigned char* qlds = F.lds + F.wave * 12288 + F.lane * 16;
    for (int it = F.gw; it < BPH * 4 * SEQ; it += F.NGW) {
        const int bg = it >> 12, tq = it & 4095, bl = bg >> 2, g = bg & 3; const size_t mrow = (size_t)bl * SEQ + tq; const int hd = g * 12 + (act ? r : 0);
        bf16x8 qf[12];
#pragma unroll
        for (int s = 0; s < 12; ++s) { qf[s] = *(const bf16x8*)(Q + mrow * 9216 + hd * 192 + 16 * s + 8 * h); if (!act) qf[s] = (bf16x8){0, 0, 0, 0, 0, 0, 0, 0}; *(LAS bf16x8*)(qlds + s * 1024) = qf[s]; }
        LDS_WAIT();
        const u32x4 sel = *(const u32x4*)(SELB + (size_t)it * 16);
        const int nv = ((tq >> 6) + 1 < 16) ? (tq >> 6) + 1 : 16;
        const SelKA ka{KS + ((size_t)bl * SEQ + r) * 768 + g * 192 + 8 * h, sel}; const SelVA va{VT2 + ((size_t)g * 128 + r) * MC + bl * SEQ + 4 * h, sel}; const SelMK mk{sel, tq, h};
        f32x16 O[4];
#pragma unroll
        for (int db = 0; db < 4; ++db)
#pragma unroll
            for (int i = 0; i < 16; ++i) O[db][i] = 0.f;
        float m = -INFINITY, l = 0.f;
        attn_run<12, 4, true, true>(qf, qlds, O, m, l, 0, 2 * nv, ka, va, mk);
        l += __shfl_xor(l, 32);
        if (act) { const float gate = sigmoidf_(bf2f(GT[mrow * 256 + 48 + hd])); store_col<true>(Ob + mrow * 6144 + hd * 128, O, l > 0.f ? gate / l : 0.f, h); }
    }
}
DI void ph_nsa_win(const Frame& F) {
    unsigned char* ar = F.ws + WS_AR; const bf16* Q = (const bf16*)(ar + NA_Q); const bf16* KW = (const bf16*)(ar + NA_KW); const bf16* VT2 = (const bf16*)(ar + NA_VT2); const bf16* GT = (const bf16*)(ar + NA_GT); bf16* Ob = (bf16*)(ar + NA_O);
    const int r = F.lane & 31, h = F.lane >> 5;
    LAS unsigned char* qlds = F.lds + F.wave * 12288 + F.lane * 16;
    for (int id = F.gw; id < BPH * 48 * 128; id += F.NGW) {
        const int qt = id & 127, bh = id >> 7, hd = bh % 48, bl = bh / 48, g = hd / 12, tq = qt * 32 + r; const size_t mrow = (size_t)bl * SEQ + tq;
        bf16x8 qf[12];
#pragma unroll
        for (int s = 0; s < 12; ++s) { qf[s] = *(const bf16x8*)(Q + mrow * 9216 + hd * 192 + 16 * s + 8 * h); *(LAS bf16x8*)(qlds + s * 1024) = qf[s]; }
        LDS_WAIT();
        const LinKA ka{KW + ((size_t)bl * SEQ + r) * 768 + g * 192 + 8 * h, (size_t)32 * 768}; const LinVA va{VT2 + ((size_t)512 + g * 128 + r) * MC + bl * SEQ + 4 * h, (size_t)32 * MC}; const WinMK mk{tq, h};
        f32x16 O[4];
#pragma unroll
        for (int db = 0; db < 4; ++db)
#pragma unroll
            for (int i = 0; i < 16; ++i) O[db][i] = 0.f;
        float m = -INFINITY, l = 0.f;
        attn_run<12, 4, true, true>(qf, qlds, O, m, l, qt >= 16 ? qt - 16 : 0, qt + 1, ka, va, mk);
        l += __shfl_xor(l, 32);
        const float gate = sigmoidf_(bf2f(GT[mrow * 256 + 96 + hd]));
        store_col<true>(Ob + mrow * 6144 + hd * 128, O, l > 0.f ? gate / l : 0.f, h);
    }
}
#ifndef MK_ONE_LAUNCH
#define MK_ONE_LAUNCH 0
#endif
constexpr int NPH = 102;
struct Args { const float* in[58]; float* out; unsigned char* ws; int ph_lo, ph_hi; };
#define GEMM_CALL(EpiT, Evar, Aptr, Bptr, Mv, Nv, Kv, ldav, ldbv, cidx) do { const pg8::Gemm g_{(const pg8::bf16_t*)(Aptr), (const pg8::bf16_t*)(Bptr), (Mv), (Nv), (Kv), (ldav), (ldbv)}; \
    pg8::StaticOrder S_; S_.init((Mv), (Nv), F.G, (cidx)); pg8::gemm_phase<EpiT, pg8::StaticOrder, true, true>((PG8_LAS unsigned char*)F.lds, g_, S_, Evar); } while (0)
DI pg8::EpiBf16R epi1(bf16* base, int ldc) { pg8::EpiBf16R e; for (int s = 0; s < 6; ++s) { e.T.base[s] = base; e.T.ldc[s] = ldc; e.T.t0[s] = 0; e.T.gw[s] = 0; } e.T.nseg = 1; e.T.pad_ = 0; return e; }
#define PH_BEGIN if (ph >= lo && ph < hi) { Frame F; { unsigned long long w_ = (unsigned long long)args.ws; asm volatile("" : "+s"(w_)); F.ws = (unsigned char*)w_; F.ctl = (unsigned*)(F.ws + WS_CTL); } \
    F.lds = lds; F.tid = threadIdx.x; F.lane = F.tid & 63; F.wave = __builtin_amdgcn_readfirstlane(F.tid >> 6); F.G = gridDim.x; F.gw = blockIdx.x * NWAVES + F.wave; F.NGW = F.G * NWAVES; \
    float* out; { unsigned long long o_ = (unsigned long long)args.out; asm volatile("" : "+s"(o_)); out = (float*)o_; } \
    unsigned char* const ar = F.ws + WS_AR; bf16* const XN = (bf16*)(F.ws + WS_XN); bf16* const WB = (bf16*)(F.ws + WS_WMIX); bf16* const WUP = (bf16*)(F.ws + WS_WFFN); bf16* const WDN = WUP + (size_t)2 * DFF * DM; \
    const float* const res_mix = (ib == 2) ? args.in[0] : (const float*)out; (void)ar; (void)XN; (void)WB; (void)WUP; (void)WDN; (void)res_mix; (void)iff;
#define PH_END   if (ph + 1 < hi) { XcdBarrier b_; b_.bar = (unsigned*)F.ctl + CW_BAR; b_.x = xb_xcc_id(); b_.st = MISC + 8; xcd_barrier(b_); } } ++ph;
template <int LAYER> DI void run_cvt(const Args& args, LAS unsigned char* lds, volatile LAS unsigned* MISC, int& ph, const int lo, const int hi) {
    constexpr int ib = (LAYER == 0) ? 2 : (LAYER == 1) ? 17 : (LAYER == 2) ? 26 : 42;
    constexpr int iff = (LAYER == 0) ? 12 : (LAYER == 1) ? 21 : (LAYER == 2) ? 37 : 52;
    constexpr int kind = (LAYER == 1) ? 1 : (LAYER == 2) ? 2 : 0;
        PH_BEGIN
            if constexpr (kind == 0) ph_dsa_cvt(F, args.in[ib + 1], args.in[ib + 6], args.in[ib + 7], args.in[ib + 8], args.in[ib + 9]);
            else if constexpr (kind == 1) ph_fox_cvt(F, args.in[ib + 1], args.in[ib + 3]);
            else ph_nsa_cvt(F, args.in[ib + 1], args.in[ib + 2], args.in[ib + 3], args.in[ib + 4], args.in[ib + 5], args.in[ib + 6], args.in[ib + 7], args.in[ib + 8], args.in[ib + 9], args.in[ib + 10]);
            ph_cvt_ffn(F, args.in[iff + 1], args.in[iff + 4]);
        PH_END
}
template <int LAYER, int HALF> DI void run_half(const Args& args, LAS unsigned char* lds, volatile LAS unsigned* MISC, int& ph, const int lo, const int hi) {
    constexpr int ib = (LAYER == 0) ? 2 : (LAYER == 1) ? 17 : (LAYER == 2) ? 26 : 42;
    constexpr int iff = (LAYER == 0) ? 12 : (LAYER == 1) ? 21 : (LAYER == 2) ? 37 : 52;
    constexpr int kind = (LAYER == 1) ? 1 : (LAYER == 2) ? 2 : 0;
    constexpr int half = HALF;
            const int roff = half * MC;
            PH_BEGIN ph_rmsnorm(F, res_mix, roff, args.in[ib], XN); PH_END
            if constexpr (kind == 0) {
                PH_BEGIN { pg8::EpiF32 E{(float*)(ar + DA_DIN), 1024}; GEMM_CALL(pg8::EpiF32, E, XN, WB + DW_W1, MC, 1024, DM, DM, DM, (int)blockIdx.x); } PH_END
                PH_BEGIN ph_dsa_post1(F, half, args.in[ib + 2], args.in[ib + 3], args.in[ib + 4], args.in[ib + 5]); PH_END
                PH_BEGIN { pg8::EpiBf16R E = epi1((bf16*)(ar + DA_QL), 8192); E.T.base[1] = (bf16*)(ar + DA_QPE); E.T.ldc[1] = 1536; E.T.t0[1] = 32; E.T.base[2] = (bf16*)(ar + DA_QIDX); E.T.ldc[2] = 2048; E.T.t0[2] = 38; E.T.nseg = 3;
                    GEMM_CALL(pg8::EpiBf16R, E, ar + DA_CQN, WB + DW_W2, MC, 11776, 512, 512, 512, (int)blockIdx.x); } PH_END
                PH_BEGIN ph_dsa_rope(F, half); PH_END
                PH_BEGIN ph_dsa_index(F); PH_END
                PH_BEGIN ph_dsa_attn(F); PH_END
                PH_BEGIN { pg8::EpiRes E{res_mix, out, DM, roff}; GEMM_CALL(pg8::EpiRes, E, ar + DA_QL, WB + DW_WO, MC, DM, 8192, 8192, 8192, (int)blockIdx.x); } PH_END
            } else if constexpr (kind == 1) {
                PH_BEGIN { pg8::EpiBf16R E = epi1((bf16*)(ar + FA_Q), DM); E.T.base[1] = (bf16*)(ar + FA_K); E.T.ldc[1] = DM; E.T.t0[1] = 8; E.T.base[2] = (bf16*)(ar + FA_F); E.T.ldc[2] = 256; E.T.t0[2] = 16; E.T.nseg = 3;
                    GEMM_CALL(pg8::EpiBf16R, E, XN, WB + FW_IN, MC, 4352, DM, DM, DM, (int)blockIdx.x); } PH_END
                PH_BEGIN { pg8::EpiBf16R E = epi1((bf16*)(ar + FA_VT), MC); GEMM_CALL(pg8::EpiBf16R, E, WB + FW_V, XN, 2048, MC, DM, DM, DM, (int)blockIdx.x); } PH_END
                PH_BEGIN ph_fox_scan(F, args.in[ib + 2]); PH_END
                PH_BEGIN ph_fox_attn(F); PH_END
                PH_BEGIN { pg8::EpiRes E{res_mix, out, DM, roff}; GEMM_CALL(pg8::EpiRes, E, ar + FA_O, WB + FW_OUT, MC, DM, DM, DM, DM, (int)blockIdx.x); } PH_END
            } else {
                PH_BEGIN { pg8::EpiBf16R E = epi1((bf16*)(ar + NA_Q), 9216);
                    E.T.base[1] = (bf16*)(ar + NA_KC); E.T.ldc[1] = 192; E.T.t0[1] = 36; E.T.gw[1] = 192;
                    E.T.base[2] = (bf16*)(ar + NA_VC); E.T.ldc[2] = 128; E.T.t0[2] = 39; E.T.gw[2] = 128;
                    E.T.base[3] = (bf16*)(ar + NA_KS); E.T.ldc[3] = 768; E.T.t0[3] = 41;
                    E.T.base[4] = (bf16*)(ar + NA_KW); E.T.ldc[4] = 768; E.T.t0[4] = 44;
                    E.T.base[5] = (bf16*)(ar + NA_GT); E.T.ldc[5] = 256; E.T.t0[5] = 47; E.T.nseg = 6;
                    GEMM_CALL(pg8::EpiBf16R, E, XN, WB + NW_IN, MC, 12288, DM, DM, DM, (int)blockIdx.x); } PH_END
                PH_BEGIN { pg8::EpiBf16R E = epi1((bf16*)(ar + NA_VT2), MC); GEMM_CALL(pg8::EpiBf16R, E, WB + NW_V2, XN, 1024, MC, DM, DM, DM, (int)blockIdx.x); } PH_END
                PH_BEGIN ph_nsa_rope(F, half); PH_END
                PH_BEGIN {
                    const float* BIAS = (const float*)(args.ws + WS_MISC);
                    { pg8::EpiGelu E{(bf16*)(ar + NA_GK), 256, BIAS}; GEMM_CALL(pg8::EpiGelu, E, ar + NA_KC, WB + NW_W1K, 4096, 256, 6144, 3072, 6144, (int)blockIdx.x); }
                    { pg8::EpiGelu E{(bf16*)(ar + NA_GV), 256, BIAS + 256}; GEMM_CALL(pg8::EpiGelu, E, ar + NA_VC, WB + NW_W1V, 4096, 256, 4096, 2048, 4096, (int)((blockIdx.x + F.G - 16) % F.G)); }
                } PH_END
                PH_BEGIN {
                    { pg8::EpiBf16R E = epi1((bf16*)(ar + NA_KCMP), 256); GEMM_CALL(pg8::EpiBf16R, E, ar + NA_GK, WB + NW_W2K, 4096, 256, 256, 256, 256, (int)blockIdx.x); }
                    { pg8::EpiBf16R E = epi1((bf16*)(ar + NA_VCT), 4096); GEMM_CALL(pg8::EpiBf16R, E, WB + NW_W2V, ar + NA_GV, 256, 4096, 256, 256, 256, (int)((blockIdx.x + F.G - 16) % F.G)); }
                } PH_END
                PH_BEGIN ph_nsa_cmp(F); PH_END
                PH_BEGIN ph_nsa_sel(F); PH_END
                PH_BEGIN ph_nsa_win(F); PH_END
                PH_BEGIN { pg8::EpiRes E{res_mix, out, DM, roff}; GEMM_CALL(pg8::EpiRes, E, ar + NA_O, WB + NW_OUT, MC, DM, 6144, 6144, 6144, (int)blockIdx.x); } PH_END
            }
            PH_BEGIN ph_rmsnorm(F, out, roff, args.in[iff], XN); PH_END
            PH_BEGIN { pg8::EpiBf16R E = epi1((bf16*)ar, 2 * DFF); GEMM_CALL(pg8::EpiBf16R, E, XN, WUP, MC, 2 * DFF, DM, DM, DM, (int)blockIdx.x); } PH_END
            PH_BEGIN ph_conv_glu(F, (const bf16*)ar, (bf16*)(ar + 352 * MiB), args.in[iff + 2], args.in[iff + 3]); PH_END
            PH_BEGIN { pg8::EpiRes E{out, out, DM, roff}; GEMM_CALL(pg8::EpiRes, E, ar + 352 * MiB, WDN, MC, DM, DFF, DFF, DFF, (int)blockIdx.x); } PH_END
}
__global__ void __launch_bounds__(NWAVES * 64, 2) mk_fwd(Args args) {
    extern __shared__ __attribute__((aligned(16))) unsigned char lds_[];
    LAS unsigned char* const lds = (LAS unsigned char*)lds_;
    volatile LAS unsigned* MISC = (volatile LAS unsigned*)(lds + LDSCTL_OFF);
    for (int u = threadIdx.x; u < 64; u += NWAVES * 64) ((LAS unsigned*)(lds + LDSCTL_OFF))[u] = 0u;
    __syncthreads();
    const int lo = args.ph_lo, hi = args.ph_hi;
    (void)xcd_barrier_post((unsigned*)(args.ws + WS_CTL) + CW_BAR, MISC + 8);
    int ph = 0;
    { constexpr int ib = 2, iff = 12; PH_BEGIN ph_tables(F, (const int*)args.in[1]); PH_END }
    run_cvt<0>(args, lds, MISC, ph, lo, hi); run_half<0, 0>(args, lds, MISC, ph, lo, hi); run_half<0, 1>(args, lds, MISC, ph, lo, hi);
    run_cvt<1>(args, lds, MISC, ph, lo, hi); run_half<1, 0>(args, lds, MISC, ph, lo, hi); run_half<1, 1>(args, lds, MISC, ph, lo, hi);
    run_cvt<2>(args, lds, MISC, ph, lo, hi); run_half<2, 0>(args, lds, MISC, ph, lo, hi); run_half<2, 1>(args, lds, MISC, ph, lo, hi);
    run_cvt<3>(args, lds, MISC, ph, lo, hi); run_half<3, 0>(args, lds, MISC, ph, lo, hi); run_half<3, 1>(args, lds, MISC, ph, lo, hi);
    { constexpr int ib = 42, iff = 52; PH_BEGIN ph_final_norm(F, out, args.in[57]); PH_END }
}
extern "C" void kernel_launch(void* const* d_in, const int* in_sizes, int n_in, void* d_out, int out_size, void* d_ws, size_t ws_size, hipStream_t stream) {
    static int grid = 0;
    if (grid == 0) {
        if (n_in != 58 || out_size != MTOT * DM || ws_size < WS_END) { fprintf(stderr, "kernel_launch: unexpected shapes (n_in %d, out %d, ws %zu)\n", n_in, out_size, ws_size); grid = -1; return; }
        int dev = 0, cus = 0;
        if (hipGetDevice(&dev) != hipSuccess || hipDeviceGetAttribute(&cus, hipDeviceAttributeMultiprocessorCount, dev) != hipSuccess) { grid = -1; return; }
        if (hipFuncSetAttribute((const void*)mk_fwd, hipFuncAttributeMaxDynamicSharedMemorySize, LDS_BYTES) != hipSuccess) { fprintf(stderr, "kernel_launch: hipFuncSetAttribute failed\n"); grid = -1; return; }
        int per_cu = 0;
        (void)hipOccupancyMaxActiveBlocksPerMultiprocessor(&per_cu, (const void*)mk_fwd, NWAVES * 64, LDS_BYTES);
        (void)hipGetLastError();
        grid = cus;
    }
    if (grid < 0) return;
    if (hipMemsetAsync((char*)d_ws + WS_CTL, 0, CTL_ZERO_BYTES, stream) != hipSuccess) return;
    Args a{};
    for (int i = 0; i < 58; ++i) a.in[i] = (const float*)d_in[i];
    a.out = (float*)d_out; a.ws = (unsigned char*)d_ws;
#if MK_ONE_LAUNCH
    a.ph_lo = 0; a.ph_hi = NPH;
    hipLaunchKernelGGL(mk_fwd, dim3(grid), dim3(NWAVES * 64), LDS_BYTES, stream, a);
#else
    for (int p = 0; p < NPH; ++p) { a.ph_lo = p; a.ph_hi = p + 1; hipLaunchKernelGGL(mk_fwd, dim3(grid), dim3(NWAVES * 64), LDS_BYTES, stream, a); }
#endif
}
```

```cpp
#include <hip/hip_runtime.h>
#include <cstdio>
#include <cstdint>
#define DI __device__ __forceinline__
namespace pg8 {
#define PG8_LAS __attribute__((address_space(3)))
typedef unsigned short bf16_t;
typedef short bf16x8 __attribute__((ext_vector_type(8)));
typedef float f32x4 __attribute__((ext_vector_type(4)));
typedef unsigned u32x4 __attribute__((ext_vector_type(4)));
constexpr int BM = 256, BK = 64, HALF = 128, HTB = HALF * BK * 2  , STAGE_BYTES = 8 * HTB, NXCD = 8, WGM = 8;

__host__ __device__ __forceinline__ int lds_byte(int r, int c) { const int st = (r >> 4) * 2 + (c >> 5), rr = r & 15, cc = c & 31, ob = rr * 64 + cc * 2; return st * 1024 + (ob ^ (((ob >> 9) & 1) << 5)); }
__host__ __device__ __forceinline__ void stage_rc(int b, int& R, int& C) { const int st = b / 1024, sb = b % 1024, swz = sb ^ (((sb >> 9) & 1) << 5); R = (st >> 1) * 16 + swz / 64; C = (st & 1) * 32 + (swz % 64) / 2; }
__host__ __device__ __forceinline__ int perm32(int rho) { const int n = rho >> 4, i = rho & 15; return 8 * (i >> 2) + 4 * n + (i & 3); }

struct Unit { int pm, pn; };
struct Gemm { const bf16_t* A; const bf16_t* Bt; int M, N, K, lda, ldb; };

struct StaticOrder {
    int nM, nN, nwg, G, c;
    __host__ __device__ void init(int M, int N, int G_, int c_) { nM = M / BM; nN = N / BM; nwg = nM * nN; G = G_; c = c_; }
    __host__ __device__ bool next(int i, Unit& u) const {
        const long L = (long)i * G + c; if (L >= nwg) return false;
        int wgid = (int)L; { const int q = nwg / NXCD, r = nwg % NXCD, xcd = wgid % NXCD, off = wgid / NXCD; wgid = (xcd < r ? xcd * (q + 1) : r * (q + 1) + (xcd - r) * q) + off; }
        const int nig = WGM * nN, gid = wgid / nig, fm = gid * WGM, gsz = (nM - fm) < WGM ? (nM - fm) : WGM;
        u.pm = fm + ((wgid % nig) % gsz); u.pn = (wgid % nig) / gsz; return true;
    }
    __device__ __forceinline__ void a_ready(const Unit&) const {}
    __device__ __forceinline__ void done(const Unit&) const {}
};
__device__ __forceinline__ unsigned cvt_pk_bf16(float lo, float hi) { unsigned r; asm volatile("v_cvt_pk_bf16_f32 %0, %1, %2" : "=v"(r) : "v"(lo), "v"(hi)); return r; }
template <class Epi, class Sched, bool ALIGN_EPI = false, bool SP2 = false>
__device__ __forceinline__ void gemm_phase(PG8_LAS unsigned char* lds, const Gemm g, const Sched& S, const Epi& E) {
    const int tid = threadIdx.x, wid = __builtin_amdgcn_readfirstlane(tid >> 6), lane = tid & 63, wr = wid >> 2, wc = wid & 3, fr = lane & 15, fq = lane >> 4;
    const int K = g.K, nt = K / BK;
    unsigned voffA[2], voffB[2];
#pragma unroll
    for (int i = 0; i < 2; ++i) { int R, C; stage_rc(tid * 16 + i * 8192, R, C); const int Rb = Epi::PERM ? ((R & ~31) + perm32(R & 31)) : R;
        voffA[i] = (unsigned)(R * g.lda + C) * 2u; voffB[i] = (unsigned)(Rb * g.ldb + C) * 2u; }
    const size_t kstep = (size_t)(BK * 2);
    const size_t hstepA = (size_t)HALF * g.lda * 2, hstepB = (size_t)HALF * g.ldb * 2;
    const size_t tstepA = 2 * hstepA, tstepB = 2 * hstepB;
    const unsigned ldsw = (unsigned)wid * 1024u;
    const int aoff = lds_byte(wr * 64 + fr, fq * 8), boff = lds_byte(wc * 32 + fr, fq * 8);
#define PG8_SA(b, h) (((b) * 2 + (h)) * HTB)
#define PG8_SB(b, h) ((4 + (b) * 2 + (h)) * HTB)
#define PG8_STAGE(bufoff, gbase, voff) do { _Pragma("unroll") for (int _i = 0; _i < 2; ++_i) \
        __builtin_amdgcn_global_load_lds((const unsigned*)((const char*)(gbase) + (voff)[_i]), (PG8_LAS unsigned*)(lds + (bufoff) + ldsw + _i * 8192), 16, 0, 0); } while (0)
#define PG8_LDA(dst, b, h) do { _Pragma("unroll") for (int m = 0; m < 4; ++m) _Pragma("unroll") for (int k = 0; k < 2; ++k) dst[m][k] = *(const PG8_LAS bf16x8*)(lds + PG8_SA(b, h) + aoff + m * 2048 + k * 1024); } while (0)
#define PG8_LDB(dst, b, h) do { _Pragma("unroll") for (int n = 0; n < 2; ++n) _Pragma("unroll") for (int k = 0; k < 2; ++k) dst[n][k] = *(const PG8_LAS bf16x8*)(lds + PG8_SB(b, h) + boff + n * 2048 + k * 1024); } while (0)
#define PG8_MMA(ai, bj, At, Bt) do { __builtin_amdgcn_s_setprio(1); _Pragma("unroll") for (int m = 0; m < 4; ++m) _Pragma("unroll") for (int n = 0; n < 2; ++n) _Pragma("unroll") for (int k = 0; k < 2; ++k) \
        acc[ai][bj][m][n] = __builtin_amdgcn_mfma_f32_16x16x32_bf16(Bt[n][k], At[m][k], acc[ai][bj][m][n], 0, 0, 0); __builtin_amdgcn_s_setprio(0); } while (0)
#define PG8_WAIT_V(n) asm volatile("s_waitcnt vmcnt(" #n ")" ::: "memory")
#define PG8_WAIT_L(n) asm volatile("s_waitcnt lgkmcnt(" #n ")" ::: "memory")
#define PG8_BAR __builtin_amdgcn_s_barrier()
#define PG8_SCHED __builtin_amdgcn_sched_barrier(0)
    Unit cur, nxt; int ui = 0;
    if (!S.next(0, cur)) return;
    f32x4 acc[2][2][4][2];
#pragma unroll
    for (int a = 0; a < 2; ++a)
#pragma unroll
        for (int b = 0; b < 2; ++b)
#pragma unroll
            for (int m = 0; m < 4; ++m)
#pragma unroll
                for (int n = 0; n < 2; ++n) acc[a][b][m][n] = (f32x4){0.f, 0.f, 0.f, 0.f};
    bf16x8 At[4][2], B0[2][2], B1[2][2];
    const char* cA = (const char*)g.A + (size_t)cur.pm * tstepA; const char* cB = (const char*)g.Bt + (size_t)cur.pn * tstepB;
    S.a_ready(cur);
    if constexpr (SP2) {
        PG8_STAGE(PG8_SB(0, 0), cB, voffB); PG8_STAGE(PG8_SB(0, 1), cB + hstepB, voffB); PG8_STAGE(PG8_SA(0, 0), cA, voffA); PG8_STAGE(PG8_SA(0, 1), cA + hstepA, voffA);
        if (wr == 1) PG8_BAR;
        PG8_WAIT_V(2); PG8_BAR;
        PG8_STAGE(PG8_SB(1, 0), cB + kstep, voffB); PG8_STAGE(PG8_SA(1, 0), cA + kstep, voffA); PG8_STAGE(PG8_SB(1, 1), cB + hstepB + kstep, voffB);
        PG8_WAIT_V(6); PG8_BAR;
    } else {
        PG8_STAGE(PG8_SB(0, 0), cB, voffB); PG8_STAGE(PG8_SA(0, 0), cA, voffA); PG8_STAGE(PG8_SB(0, 1), cB + hstepB, voffB); PG8_STAGE(PG8_SA(0, 1), cA + hstepA, voffA);
        if (wr == 1) PG8_BAR;
        PG8_WAIT_V(4); PG8_BAR;
        PG8_STAGE(PG8_SB(1, 0), cB + kstep, voffB); PG8_STAGE(PG8_SA(1, 0), cA + kstep, voffA); PG8_STAGE(PG8_SB(1, 1), cB + hstepB + kstep, voffB);
        PG8_WAIT_V(6); PG8_BAR;
    }
    for (;;) {
        const bool has_next = S.next(ui + 1, nxt);
        const char* nA = has_next ? (const char*)g.A + (size_t)nxt.pm * tstepA : cA; const char* nB = has_next ? (const char*)g.Bt + (size_t)nxt.pn * tstepB : cB;
        for (int t = 0; t < nt; t += 2) {
            const bool last = (t == nt - 2);
            const char* a1 = cA + (size_t)(t + 1) * kstep;
            const char* a2 = last ? nA : cA + (size_t)(t + 2) * kstep; const char* b2 = last ? nB : cB + (size_t)(t + 2) * kstep;
            const char* a3 = a2 + kstep; const char* b3 = b2 + kstep;
            if (last && has_next) S.a_ready(nxt);
            if constexpr (SP2) {
            PG8_LDB(B0, 0, 0); PG8_LDB(B1, 0, 1); PG8_SCHED; PG8_LDA(At, 0, 0); PG8_STAGE(PG8_SA(1, 1), a1 + hstepA, voffA);
            PG8_WAIT_V(8); PG8_WAIT_L(0); PG8_BAR; PG8_MMA(0, 0, At, B0); PG8_MMA(0, 1, At, B1); PG8_BAR; PG8_SCHED;
            PG8_LDA(At, 0, 1); PG8_STAGE(PG8_SB(0, 0), b2, voffB); PG8_STAGE(PG8_SB(0, 1), b2 + hstepB, voffB); PG8_STAGE(PG8_SA(0, 0), a2, voffA);
            PG8_WAIT_V(8); PG8_WAIT_L(0); PG8_BAR; PG8_MMA(1, 0, At, B0); PG8_MMA(1, 1, At, B1); PG8_BAR; PG8_SCHED;
            PG8_LDB(B0, 1, 0); PG8_LDB(B1, 1, 1); PG8_SCHED; PG8_LDA(At, 1, 0); PG8_STAGE(PG8_SA(0, 1), a2 + hstepA, voffA);
            PG8_WAIT_V(8); PG8_WAIT_L(0); PG8_BAR; PG8_MMA(0, 0, At, B0); PG8_MMA(0, 1, At, B1); PG8_BAR; PG8_SCHED;
            PG8_LDA(At, 1, 1); PG8_STAGE(PG8_SB(1, 0), b3, voffB); PG8_STAGE(PG8_SB(1, 1), b3 + hstepB, voffB); PG8_STAGE(PG8_SA(1, 0), a3, voffA);
            PG8_WAIT_V(8); PG8_WAIT_L(0); PG8_BAR; PG8_MMA(1, 0, At, B0); PG8_MMA(1, 1, At, B1); PG8_BAR; PG8_SCHED;
            } else {
            PG8_LDB(B0, 0, 0); PG8_SCHED; PG8_LDA(At, 0, 0); PG8_STAGE(PG8_SA(1, 1), a1 + hstepA, voffA);
            PG8_WAIT_L(8); PG8_BAR; PG8_WAIT_L(0); PG8_MMA(0, 0, At, B0); PG8_BAR; PG8_SCHED;
            PG8_LDB(B1, 0, 1); PG8_STAGE(PG8_SB(0, 0), b2, voffB);
            PG8_BAR; PG8_WAIT_L(0); PG8_MMA(0, 1, At, B1); PG8_BAR;
            PG8_LDA(At, 0, 1); PG8_STAGE(PG8_SA(0, 0), a2, voffA);
            PG8_BAR; PG8_WAIT_L(0); PG8_MMA(1, 0, At, B0); PG8_BAR; PG8_SCHED;
            PG8_STAGE(PG8_SB(0, 1), b2 + hstepB, voffB);
            PG8_WAIT_V(6); PG8_BAR; PG8_MMA(1, 1, At, B1); PG8_BAR;
            PG8_LDB(B0, 1, 0); PG8_SCHED; PG8_LDA(At, 1, 0); PG8_STAGE(PG8_SA(0, 1), a2 + hstepA, voffA);
            PG8_WAIT_L(8); PG8_BAR; PG8_WAIT_L(0); PG8_MMA(0, 0, At, B0); PG8_BAR; PG8_SCHED;
            PG8_LDB(B1, 1, 1); PG8_STAGE(PG8_SB(1, 0), b3, voffB);
            PG8_BAR; PG8_WAIT_L(0); PG8_MMA(0, 1, At, B1); PG8_BAR;
            PG8_LDA(At, 1, 1); PG8_STAGE(PG8_SA(1, 0), a3, voffA);
            PG8_BAR; PG8_WAIT_L(0); PG8_MMA(1, 0, At, B0); PG8_BAR; PG8_SCHED;
            PG8_STAGE(PG8_SB(1, 1), b3 + hstepB, voffB);
            PG8_WAIT_V(6); PG8_BAR; PG8_MMA(1, 1, At, B1); PG8_BAR;
            }
        }
        if constexpr (ALIGN_EPI) { if (wr == 0) PG8_BAR; }
        if constexpr (!Epi::AFTER_DRAIN) { E(acc, cur, wr, wc, fr, fq); S.done(cur); }
        if (!has_next) break;
#pragma unroll
        for (int a = 0; a < 2; ++a)
#pragma unroll
            for (int b = 0; b < 2; ++b)
#pragma unroll
                for (int m = 0; m < 4; ++m)
#pragma unroll
                    for (int n = 0; n < 2; ++n) acc[a][b][m][n] = (f32x4){0.f, 0.f, 0.f, 0.f};
        cur = nxt; cA = nA; cB = nB; ++ui;
        if constexpr (ALIGN_EPI) { if (wr == 1) PG8_BAR; }
    }
    PG8_WAIT_V(0);
    if constexpr (!ALIGN_EPI) { if (wr == 0) PG8_BAR; }
    PG8_BAR;
    if constexpr (Epi::AFTER_DRAIN) { E.fused(acc, cur, wr, wc, fr, fq, lds, wid, lane); S.done(cur); }
#undef PG8_SA
#undef PG8_SB
#undef PG8_STAGE
#undef PG8_LDA
#undef PG8_LDB
#undef PG8_MMA
#undef PG8_WAIT_V
#undef PG8_WAIT_L
#undef PG8_BAR
#undef PG8_SCHED
}
}
namespace pg8 {
typedef float f32x2 __attribute__((ext_vector_type(2)));
struct SegTab { bf16_t* base[6]; int ldc[6]; int t0[6]; int gw[6]; int nseg; int pad_; };
struct EpiBf16R {
    static constexpr bool PERM = true, AFTER_DRAIN = false;
    SegTab T;
    __device__ __forceinline__ void operator()(const f32x4 (&acc)[2][2][4][2], const Unit& u, int wr, int wc, int fr, int fq) const {
        bf16_t* base = T.base[0]; int ldc = T.ldc[0], gw = T.gw[0], t0 = T.t0[0];
#pragma unroll
        for (int s = 1; s < 6; ++s) if (s < T.nseg && u.pn >= T.t0[s]) { base = T.base[s]; ldc = T.ldc[s]; gw = T.gw[s]; t0 = T.t0[s]; }
        const int colt = (u.pn - t0) * BM, row0 = u.pm * BM + wr * 64 + fr;
#pragma unroll
        for (int ai = 0; ai < 2; ++ai)
#pragma unroll
            for (int m = 0; m < 4; ++m) { const int row = row0 + ai * HALF + m * 16;
#pragma unroll
                for (int bj = 0; bj < 2; ++bj) { const int col = colt + bj * HALF + wc * 32 + 8 * fq;
                    bf16_t* dst;
                    if (gw == 0) dst = base + (size_t)row * ldc + col;
                    else { const int g = col / gw, d = col - g * gw; dst = base + ((size_t)((row >> 12) * 4 + g) * 4096 + (row & 4095)) * gw + d; }
                    const f32x4 v0 = acc[ai][bj][m][0], v1 = acc[ai][bj][m][1];
                    u32x4 w; w.x = cvt_pk_bf16(v0[0], v0[1]); w.y = cvt_pk_bf16(v0[2], v0[3]); w.z = cvt_pk_bf16(v1[0], v1[1]); w.w = cvt_pk_bf16(v1[2], v1[3]);
                    *(u32x4*)dst = w; } }
    }
};
struct EpiGelu {
    static constexpr bool PERM = true, AFTER_DRAIN = false;
    bf16_t* O; int ldc; const float* bias;
    static __device__ __forceinline__ float gelu(float x) { const float u2 = 1.5957691216f * (x + 0.044715f * x * x * x); const float e = __builtin_amdgcn_exp2f(-u2 * 1.4426950409f); return x * __builtin_amdgcn_rcpf(1.0f + e); }
    __device__ __forceinline__ void operator()(const f32x4 (&acc)[2][2][4][2], const Unit& u, int wr, int wc, int fr, int fq) const {
        const int row0 = u.pm * BM + wr * 64 + fr, col0 = u.pn * BM + wc * 32 + 8 * fq;
#pragma unroll
        for (int bj = 0; bj < 2; ++bj) { const f32x4 b0 = *(const f32x4*)(bias + col0 + bj * HALF), b1 = *(const f32x4*)(bias + col0 + bj * HALF + 4);
#pragma unroll
            for (int ai = 0; ai < 2; ++ai)
#pragma unroll
                for (int m = 0; m < 4; ++m) { const f32x4 v0 = acc[ai][bj][m][0] + b0, v1 = acc[ai][bj][m][1] + b1;
                    u32x4 w; w.x = cvt_pk_bf16(gelu(v0[0]), gelu(v0[1])); w.y = cvt_pk_bf16(gelu(v0[2]), gelu(v0[3])); w.z = cvt_pk_bf16(gelu(v1[0]), gelu(v1[1])); w.w = cvt_pk_bf16(gelu(v1[2]), gelu(v1[3]));
                    *(u32x4*)(O + (size_t)(row0 + ai * HALF + m * 16) * ldc + col0 + bj * HALF) = w; } }
    }
};
struct EpiF32 {
    static constexpr bool PERM = false, AFTER_DRAIN = false;
    float* C; int ldc;
    __device__ __forceinline__ void operator()(const f32x4 (&acc)[2][2][4][2], const Unit& u, int wr, int wc, int fr, int fq) const {
        const int row0 = u.pm * BM + wr * 64 + fr, col0 = u.pn * BM + wc * 32 + 4 * fq;
#pragma unroll
        for (int ai = 0; ai < 2; ++ai)
#pragma unroll
            for (int m = 0; m < 4; ++m) { float* rowp = C + (size_t)(row0 + ai * HALF + m * 16) * ldc + col0;
#pragma unroll
                for (int bj = 0; bj < 2; ++bj)
#pragma unroll
                    for (int n = 0; n < 2; ++n) *(f32x4*)(rowp + bj * HALF + n * 16) = acc[ai][bj][m][n]; }
    }
};
struct EpiRes {
    static constexpr bool PERM = false, AFTER_DRAIN = false;
    const float* res; float* out; int ldc; int row_off;
    __device__ __forceinline__ void operator()(const f32x4 (&acc)[2][2][4][2], const Unit& u, int wr, int wc, int fr, int fq) const {
        const int row0 = row_off + u.pm * BM + wr * 64 + fr, col0 = u.pn * BM + wc * 32 + 4 * fq;
#pragma unroll
        for (int ai = 0; ai < 2; ++ai)
#pragma unroll
            for (int m = 0; m < 4; ++m) { const size_t off = (size_t)(row0 + ai * HALF + m * 16) * ldc + col0;
                f32x4 r[2][2];
#pragma unroll
                for (int bj = 0; bj < 2; ++bj)
#pragma unroll
                    for (int n = 0; n < 2; ++n) r[bj][n] = *(const f32x4*)(res + off + bj * HALF + n * 16);
#pragma unroll
                for (int bj = 0; bj < 2; ++bj)
#pragma unroll
                    for (int n = 0; n < 2; ++n) *(f32x4*)(out + off + bj * HALF + n * 16) = r[bj][n] + acc[ai][bj][m][n];
                asm volatile("" ::: "memory"); }
    }
};
}
constexpr int BATCH = 8, SEQ = 4096, DM = 2048, MTOT = BATCH * SEQ, MC = MTOT / 2  , BPH = BATCH / 2;
constexpr int DFF = 5632;
constexpr float NORM_EPS = 1e-6f, LOG2E = 1.4426950408889634f;
constexpr int NWAVES = 8;
constexpr size_t MiB = 1u << 20;
constexpr size_t WS_CTL = 0, CTL_ZERO_BYTES = 1 * MiB;
constexpr size_t WS_TAB = 1 * MiB;
constexpr size_t TAB_COS48 = WS_TAB, TAB_SIN48 = WS_TAB + 3 * MiB, TAB_COS32 = WS_TAB + 6 * MiB, TAB_SIN32 = WS_TAB + 8 * MiB;
constexpr size_t WS_WMIX = 12 * MiB;
constexpr size_t WS_WFFN = 100 * MiB;
constexpr size_t WS_MISC = 168 * MiB;
constexpr size_t WS_XN = 170 * MiB;
constexpr size_t WS_AR = 234 * MiB;
constexpr size_t WS_END = 934 * MiB;
constexpr int CW_TMO = 0;
constexpr int CW_BAR = 4096;
constexpr int RING_BYTES = 131072;
constexpr int LDSCTL_OFF = 135168;
constexpr int LDS_BYTES = 147456;

#define GAS __attribute__((address_space(1)))
#define LAS __attribute__((address_space(3)))
typedef unsigned short bf16;
typedef unsigned u32x4 __attribute__((ext_vector_type(4)));
typedef unsigned u32x2 __attribute__((ext_vector_type(2)));
typedef float f32x4 __attribute__((ext_vector_type(4)));
typedef float f32x16 __attribute__((ext_vector_type(16)));
typedef short bf16x8 __attribute__((ext_vector_type(8)));
typedef short s16x4 __attribute__((ext_vector_type(4)));
typedef short v4i16_t __attribute__((ext_vector_type(4)));
typedef __bf16 bf16x2_t __attribute__((ext_vector_type(2)));
typedef float f32x2_t __attribute__((ext_vector_type(2)));
#define LDS_WAIT() asm volatile("s_waitcnt lgkmcnt(0)" ::: "memory")
#define VM_WAIT() asm volatile("s_waitcnt vmcnt(0)" ::: "memory")
#define MFMA32(a, b, c) __builtin_amdgcn_mfma_f32_32x32x16_bf16((a), (b), (c), 0, 0, 0)
DI unsigned pk2(float lo, float hi) { f32x2_t v = {lo, hi}; bf16x2_t b = __builtin_convertvector(v, bf16x2_t); return __builtin_bit_cast(unsigned, b); }
DI float bf2f(unsigned short b) { return __builtin_bit_cast(float, (unsigned)b << 16); }
DI float bflo(unsigned w) { return __builtin_bit_cast(float, w << 16); }
DI float bfhi(unsigned w) { return __builtin_bit_cast(float, w & 0xffff0000u); }
DI unsigned short f2bf(float f) { return (unsigned short)(pk2(f, 0.f) & 0xffffu); }
DI float wave_sum(float v) {
#pragma unroll
    for (int o = 1; o < 64; o <<= 1) v += __shfl_xor(v, o);
    return v;
}
DI int crow(int i, int h) { return (i & 3) + 8 * (i >> 2) + 4 * h; }
#define XB_TMO      128
#define XB_XCNT(j)  (256  + 64 * (j))
#define XB_XSUB(j)  (1280 + 64 * (j))
#define XB_XGEN(j)  (2304 + 64 * (j))
#define XB_TOP      3328
#define XB_TOPGEN   3392
#define XCD_BAR_WORDS 3456
#define XB_SPIN_CAP (1u << 18)

__device__ __forceinline__ unsigned xb_ld(unsigned* p)              { return __hip_atomic_load(p, __ATOMIC_RELAXED, __HIP_MEMORY_SCOPE_AGENT); }
__device__ __forceinline__ unsigned xb_add(unsigned* p, unsigned v) { return __hip_atomic_fetch_add(p, v, __ATOMIC_RELAXED, __HIP_MEMORY_SCOPE_AGENT); }
__device__ __forceinline__ unsigned xb_xcc_id() { return (unsigned)__builtin_amdgcn_s_getreg((3 << 11) | 20) & 0xFu; }
#define XB_SPIN(cond, bar) do { unsigned _sp = 0; while (cond) { __builtin_amdgcn_s_sleep(1); \
    if ((++_sp & 255u) == 0u) { if (xb_ld(&(bar)[XB_TMO])) break; if (_sp > XB_SPIN_CAP) { atomicAdd(&(bar)[XB_TMO], 1u); break; } } } } while (0)

struct XcdBarrier {
    unsigned* bar; unsigned x;
    volatile LAS unsigned* st;
};

__device__ __forceinline__ XcdBarrier xcd_barrier_post(unsigned* bar, volatile LAS unsigned* st) {
    XcdBarrier b; b.bar = bar; b.x = xb_xcc_id(); b.st = st;
    if (threadIdx.x == 0) (void)xb_add(&bar[XB_XCNT(b.x)], 1u);
    return b;
}
__device__ __forceinline__ void xcd_barrier_complete(unsigned* bar, unsigned x, unsigned& nloc, unsigned& nx) {
    const unsigned G = gridDim.x * gridDim.y * gridDim.z;
    unsigned sum, cnt, mine, sp = 0u;
    for (;;) {
        sum = 0u; cnt = 0u; mine = 0u;
#pragma unroll
        for (unsigned j = 0; j < 16; ++j) { const unsigned c = xb_ld(&bar[XB_XCNT(j)]); sum += c; cnt += (c > 0u) ? 1u : 0u; mine = (j == x) ? c : mine; }
        if (sum == G) break;
        __builtin_amdgcn_s_sleep(1);
        if ((++sp & 255u) == 0u) { if (xb_ld(&bar[XB_TMO])) break; if (sp > XB_SPIN_CAP) { atomicAdd(&bar[XB_TMO], 1u); break; } }
    }
    nloc = mine > 0u ? mine : 1u; nx = cnt > 0u ? cnt : 1u;
}

__device__ __forceinline__ void xcd_barrier(const XcdBarrier& b) {
    asm volatile("s_waitcnt vmcnt(0)" ::: "memory");
    __syncthreads();
    if (threadIdx.x == 0) {
        unsigned* bar = b.bar;
        __builtin_amdgcn_s_waitcnt(0);
        unsigned nloc = b.st[0], nx = b.st[1];
        if (nloc == 0u) { xcd_barrier_complete(bar, b.x, nloc, nx); b.st[0] = nloc; b.st[1] = nx; }
        const unsigned old = xb_add(&bar[XB_XSUB(b.x)], 1u);
        const unsigned gen = old / nloc;
        if (old + 1u == (gen + 1u) * nloc) {
            __builtin_amdgcn_fence(__ATOMIC_RELEASE, "agent");
            asm volatile("s_waitcnt vmcnt(0)" ::: "memory");
            const unsigned og = xb_add(&bar[XB_TOP], 1u);
            const unsigned tg = og / nx;
            if (og + 1u == (tg + 1u) * nx) xb_add(&bar[XB_TOPGEN], 1u);
            else XB_SPIN(xb_ld(&bar[XB_TOPGEN]) == tg, bar);
            __builtin_amdgcn_fence(__ATOMIC_ACQUIRE, "agent");
            xb_add(&bar[XB_XGEN(b.x)], 1u);
            asm volatile("s_waitcnt vmcnt(0)" ::: "memory");
        } else {
            XB_SPIN(xb_ld(&bar[XB_XGEN(b.x)]) == gen, bar);
            __builtin_amdgcn_fence(__ATOMIC_ACQUIRE, "agent");
            asm volatile("s_waitcnt vmcnt(0)" ::: "memory");
        }
    }
    __syncthreads();
}
struct Frame {
    LAS unsigned char* lds; unsigned* ctl; unsigned char* ws;
    int tid, lane, wave, G, gw, NGW;
};
DI void ph_tables(const Frame& F, const int* pos) {
    float* c48 = (float*)(F.ws + TAB_COS48); float* s48 = (float*)(F.ws + TAB_SIN48); float* c32 = (float*)(F.ws + TAB_COS32); float* s32 = (float*)(F.ws + TAB_SIN32);
    const int gt = blockIdx.x * (NWAVES * 64) + F.tid, NT = F.G * NWAVES * 64;
    for (int i = gt; i < MTOT * 40; i += NT) {
        const int m = i / 40, j = i - m * 40; const float p = (float)pos[m];
        const bool a = j < 24; const int jj = a ? j : j - 24;
        const float inv = (float)exp(-(2.0 * jj / (a ? 48.0 : 32.0)) * 13.122363377404328);
        const float ang = p * inv; float sn, cs; sincosf(ang, &sn, &cs);
        if (a) { c48[m * 24 + jj] = cs; s48[m * 24 + jj] = sn; } else { c32[m * 16 + jj] = cs; s32[m * 16 + jj] = sn; }
    }
}
DI void cvt_item(const float* W, int ldw, int col0, int ncols, bf16* WT, int ldt, int row_off, float scale, LAS float* scr, int item, int nblk, int lane) {
    const int kb = item / nblk, nb = item - kb * nblk, k0 = 64 * kb, n0 = 32 * nb;
    const int nn = n0 + (lane & 31); const bool ok = nn < ncols;
#pragma unroll 8
    for (int i = 0; i < 32; ++i) { const int kk = 2 * i + (lane >> 5); scr[kk * 33 + (lane & 31)] = ok ? W[(size_t)(k0 + kk) * ldw + col0 + nn] * scale : 0.f; }
    LDS_WAIT();
    const int c = lane & 7;
#pragma unroll
    for (int j = 0; j < 4; ++j) { const int n = (lane >> 3) + 8 * j; const LAS float* s = scr + (8 * c) * 33 + n;
        u32x4 o; o.x = pk2(s[0 * 33], s[1 * 33]); o.y = pk2(s[2 * 33], s[3 * 33]); o.z = pk2(s[4 * 33], s[5 * 33]); o.w = pk2(s[6 * 33], s[7 * 33]);
        if (n0 + n < ncols) *(u32x4*)(WT + (size_t)(row_off + n0 + n) * ldt + k0 + 8 * c) = o; }
    LDS_WAIT();
}
DI void cvt_job(const Frame& F, const float* W, int ldw, int K, int col0, int ncols, bf16* WT, int ldt, int row_off, float scale) {
    LAS float* scr = (LAS float*)(F.lds + F.wave * 16384);
    const int nblk = (ncols + 31) / 32, nitems = (K / 64) * nblk;
    for (int it = F.gw; it < nitems; it += F.NGW) cvt_item(W, ldw, col0, ncols, WT, ldt, row_off, scale, scr, it, nblk, F.lane);
}
DI void zero_bf16(const Frame& F, bf16* p, size_t nelem) {
    const size_t gt = (size_t)blockIdx.x * (NWAVES * 64) + F.tid, NT = (size_t)F.G * NWAVES * 64;
    for (size_t i = gt; i < nelem / 8; i += NT) ((u32x4*)p)[i] = (u32x4){0u, 0u, 0u, 0u};
}
DI void ph_cvt_ffn(const Frame& F, const float* up, const float* down) {
    bf16* WUP = (bf16*)(F.ws + WS_WFFN); bf16* WDN = WUP + (size_t)2 * DFF * DM;
    cvt_job(F, up, 2 * DFF, DM, 0, 2 * DFF, WUP, DM, 0, 1.f);
    cvt_job(F, down, DM, DFF, 0, DM, WDN, DFF, 0, 1.f);
}
DI void ph_rmsnorm(const Frame& F, const float* src, int row_off, const float* gain, bf16* XN) {
    f32x4 g[8];
#pragma unroll
    for (int j = 0; j < 8; ++j) g[j] = *(const f32x4*)(gain + 4 * (F.lane + 64 * j));
    for (int ml = F.gw; ml < MC; ml += F.NGW) {
        const f32x4* xr = (const f32x4*)(src + (size_t)(row_off + ml) * DM) + F.lane;
        f32x4 v[8]; float ss = 0.f;
#pragma unroll
        for (int j = 0; j < 8; ++j) { v[j] = xr[64 * j]; ss += (v[j].x * v[j].x + v[j].y * v[j].y) + (v[j].z * v[j].z + v[j].w * v[j].w); }
        const float rstd = 1.0f / sqrtf(wave_sum(ss) * (1.f / DM) + NORM_EPS);
        u32x2* o = (u32x2*)(XN + (size_t)ml * DM) + F.lane;
#pragma unroll
        for (int j = 0; j < 8; ++j) { const f32x4 y = v[j] * rstd * g[j]; u32x2 w; w.x = pk2(y.x, y.y); w.y = pk2(y.z, y.w); o[64 * j] = w; }
    }
}
DI void ph_final_norm(const Frame& F, float* h, const float* gain) {
    f32x4 g[8];
#pragma unroll
    for (int j = 0; j < 8; ++j) g[j] = *(const f32x4*)(gain + 4 * (F.lane + 64 * j));
    for (int m = F.gw; m < MTOT; m += F.NGW) {
        f32x4* xr = (f32x4*)(h + (size_t)m * DM) + F.lane;
        f32x4 v[8]; float ss = 0.f;
#pragma unroll
        for (int j = 0; j < 8; ++j) { v[j] = xr[64 * j]; ss += (v[j].x * v[j].x + v[j].y * v[j].y) + (v[j].z * v[j].z + v[j].w * v[j].w); }
        const float rstd = 1.0f / sqrtf(wave_sum(ss) * (1.f / DM) + NORM_EPS);
#pragma unroll
        for (int j = 0; j < 8; ++j) xr[64 * j] = v[j] * rstd * g[j];
    }
}
DI void ph_conv_glu(const Frame& F, const bf16* U, bf16* Gb, const float* cw, const float* cb) {
    constexpr int RC = 32, NCG = DFF / 8, NRC = MC / RC;
    const int gt = blockIdx.x * (NWAVES * 64) + F.tid, NT = F.G * NWAVES * 64;
    for (int it = gt; it < NCG * NRC; it += NT) {
        const int cg = it % NCG, rc = it / NCG, c0 = cg * 8, r0 = rc * RC;
        float w0g[8], w1g[8], w2g[8], bg[8], w0v[8], w1v[8], w2v[8], bv[8];
#pragma unroll
        for (int e = 0; e < 8; ++e) { w0g[e] = cw[c0 + e]; w1g[e] = cw[2 * DFF + c0 + e]; w2g[e] = cw[4 * DFF + c0 + e]; bg[e] = cb[c0 + e];
            w0v[e] = cw[DFF + c0 + e]; w1v[e] = cw[3 * DFF + c0 + e]; w2v[e] = cw[5 * DFF + c0 + e]; bv[e] = cb[DFF + c0 + e]; }
        float pg2[8], pg1[8], pv2[8], pv1[8];
        const bool has = (r0 & (SEQ - 1)) != 0;
        {
            u32x4 a = {0u, 0u, 0u, 0u}, b = a, c = a, d = a;
            if (has) { a = *(const u32x4*)(U + (size_t)(r0 - 2) * (2 * DFF) + c0); b = *(const u32x4*)(U + (size_t)(r0 - 1) * (2 * DFF) + c0);
                       c = *(const u32x4*)(U + (size_t)(r0 - 2) * (2 * DFF) + DFF + c0); d = *(const u32x4*)(U + (size_t)(r0 - 1) * (2 * DFF) + DFF + c0); }
#pragma unroll
            for (int e = 0; e < 4; ++e) { pg2[2 * e] = bflo(a[e]); pg2[2 * e + 1] = bfhi(a[e]); pg1[2 * e] = bflo(b[e]); pg1[2 * e + 1] = bfhi(b[e]);
                pv2[2 * e] = bflo(c[e]); pv2[2 * e + 1] = bfhi(c[e]); pv1[2 * e] = bflo(d[e]); pv1[2 * e + 1] = bfhi(d[e]); }
        }
        for (int r = 0; r < RC; ++r) {
            const u32x4 ug = *(const u32x4*)(U + (size_t)(r0 + r) * (2 * DFF) + c0), uv = *(const u32x4*)(U + (size_t)(r0 + r) * (2 * DFF) + DFF + c0);
            float cg_[8], cv_[8], o[8];
#pragma unroll
            for (int e = 0; e < 4; ++e) { cg_[2 * e] = bflo(ug[e]); cg_[2 * e + 1] = bfhi(ug[e]); cv_[2 * e] = bflo(uv[e]); cv_[2 * e + 1] = bfhi(uv[e]); }
#pragma unroll
            for (int e = 0; e < 8; ++e) {
                const float yg = bg[e] + w0g[e] * pg2[e] + w1g[e] * pg1[e] + w2g[e] * cg_[e];
                const float yv = bv[e] + w0v[e] * pv2[e] + w1v[e] * pv1[e] + w2v[e] * cv_[e];
                const float sg = yg * __builtin_amdgcn_rcpf(1.0f + __builtin_amdgcn_exp2f(-yg * LOG2E));
                o[e] = sg * yv; pg2[e] = pg1[e]; pg1[e] = cg_[e]; pv2[e] = pv1[e]; pv1[e] = cv_[e];
            }
            u32x4 w; w.x = pk2(o[0], o[1]); w.y = pk2(o[2], o[3]); w.z = pk2(o[4], o[5]); w.w = pk2(o[6], o[7]);
            *(u32x4*)(Gb + (size_t)(r0 + r) * DFF + c0) = w;
        }
    }
}
constexpr size_t DA_DIN = 0, DA_CQN = 64 * MiB, DA_LATC = 80 * MiB, DA_KPE = 88 * MiB, DA_KIDX = 90 * MiB, DA_WIDX = 94 * MiB, DA_QL = 96 * MiB, DA_QPE = 352 * MiB, DA_QIDX = 400 * MiB,
                 DA_SEL = 464 * MiB, DA_CNT = 472 * MiB, DA_SC = 474 * MiB;
constexpr size_t DW_W1 = 0, DW_W2 = (size_t)1024 * 2048, DW_WO = DW_W2 + (size_t)11776 * 512;
constexpr float DSA_QSCALE = 0.07216878364870322f * LOG2E;
constexpr float DSA_WIDX_SCALE = 0.25f * 0.08838834764831845f;

DI void ph_dsa_cvt(const Frame& F, const float* w_in, const float* w_qup, const float* w_uk, const float* w_uv, const float* w_out) {
    bf16* WB = (bf16*)(F.ws + WS_WMIX);
    cvt_job(F, w_in, 960, DM, 0, 960, WB + DW_W1, DM, 0, 1.f);
    zero_bf16(F, WB + DW_W1 + (size_t)960 * DM, (size_t)64 * DM);
    { LAS float* scr = (LAS float*)(F.lds + F.wave * 16384);
      for (int it = F.gw; it < 32 * 16; it += F.NGW) { const int h = it >> 4; cvt_item(w_qup, 8192, h * 192, 48, WB + DW_W2, 512, 8192 + h * 48, DSA_QSCALE, scr, it & 15, 2, F.lane); } }
    cvt_job(F, w_qup, 8192, 512, 6144, 2048, WB + DW_W2, 512, 9728, 1.f);
    __syncthreads();
    {
        LAS float* As = (LAS float*)F.lds; LAS float* Bs = As + 64 * 145;
        for (int u = blockIdx.x; u < 32 * 4 * 8; u += F.G) {
            const int h = u >> 5, r0 = ((u >> 3) & 3) * 64, k0 = (u & 7) * 64;
            for (int i = F.tid; i < 64 * 144; i += NWAVES * 64) { const int row = i / 144, col = i - row * 144;
                As[row * 145 + col] = w_uk[(size_t)(h * 256 + r0) * 144 + i]; Bs[row * 145 + col] = w_qup[(size_t)(k0 + row) * 8192 + h * 192 + 48 + col]; }
            __syncthreads();
            const int r = F.tid & 63, kg = F.tid >> 6; float acc[8];
#pragma unroll
            for (int j = 0; j < 8; ++j) acc[j] = 0.f;
            for (int n = 0; n < 144; ++n) { const float a = As[r * 145 + n];
#pragma unroll
                for (int j = 0; j < 8; ++j) acc[j] += a * Bs[(kg * 8 + j) * 145 + n]; }
            u32x4 o; o.x = pk2(acc[0] * DSA_QSCALE, acc[1] * DSA_QSCALE); o.y = pk2(acc[2] * DSA_QSCALE, acc[3] * DSA_QSCALE); o.z = pk2(acc[4] * DSA_QSCALE, acc[5] * DSA_QSCALE); o.w = pk2(acc[6] * DSA_QSCALE, acc[7] * DSA_QSCALE);
            *(u32x4*)(WB + DW_W2 + (size_t)(h * 256 + r0 + r) * 512 + k0 + kg * 8) = o;
            __syncthreads();
        }
        LAS float* Av = (LAS float*)F.lds; LAS float* Bv = Av + 64 * 129;
        for (int u = blockIdx.x; u < 32 * 4 * 32; u += F.G) {
            const int h = u >> 7, r0 = ((u >> 5) & 3) * 64, c0 = (u & 31) * 64;
            for (int i = F.tid; i < 64 * 128; i += NWAVES * 64) { const int row = i >> 7, col = i & 127; Av[row * 129 + col] = w_uv[(size_t)(h * 256 + r0) * 128 + i]; }
            for (int i = F.tid; i < 128 * 64; i += NWAVES * 64) { const int v = i >> 6, c = i & 63; Bv[v * 64 + c] = w_out[(size_t)(h * 128 + v) * DM + c0 + c]; }
            __syncthreads();
            const int c = F.tid & 63, rg = F.tid >> 6; float acc[8];
#pragma unroll
            for (int j = 0; j < 8; ++j) acc[j] = 0.f;
            for (int v = 0; v < 128; ++v) { const float b = Bv[v * 64 + c];
#pragma unroll
                for (int j = 0; j < 8; ++j) acc[j] += Av[(rg * 8 + j) * 129 + v] * b; }
            u32x4 o; o.x = pk2(acc[0], acc[1]); o.y = pk2(acc[2], acc[3]); o.z = pk2(acc[4], acc[5]); o.w = pk2(acc[6], acc[7]);
            *(u32x4*)(WB + DW_WO + (size_t)(c0 + c) * 8192 + h * 256 + r0 + rg * 8) = o;
            __syncthreads();
        }
    }
}
DI void ph_dsa_post1(const Frame& F, int half, const float* qn, const float* kvn, const float* lng, const float* lnb) {
    unsigned char* ar = F.ws + WS_AR;
    const float* DIN = (const float*)(ar + DA_DIN); bf16* CQN = (bf16*)(ar + DA_CQN); bf16* LATC = (bf16*)(ar + DA_LATC); bf16* KPE = (bf16*)(ar + DA_KPE); bf16* KIDX = (bf16*)(ar + DA_KIDX); float* WIDX = (float*)(ar + DA_WIDX);
    const float* c48 = (const float*)(F.ws + TAB_COS48); const float* s48 = (const float*)(F.ws + TAB_SIN48); const float* c32 = (const float*)(F.ws + TAB_COS32); const float* s32 = (const float*)(F.ws + TAB_SIN32);
    LAS float* buf = (LAS float*)(F.lds + F.wave * 1024);
    const int lane = F.lane;
    for (int ml = F.gw; ml < MC; ml += F.NGW) {
        const int mg = half * MC + ml;
        const float* row = DIN + (size_t)ml * 1024 + 16 * lane;
        f32x4 v[4]; float ss = 0.f, s1 = 0.f;
#pragma unroll
        for (int j = 0; j < 4; ++j) { v[j] = *(const f32x4*)(row + 4 * j); ss += (v[j].x * v[j].x + v[j].y * v[j].y) + (v[j].z * v[j].z + v[j].w * v[j].w); s1 += (v[j].x + v[j].y) + (v[j].z + v[j].w); }
        const bool isq = lane < 32, iskv = lane >= 32 && lane < 48, ispe = lane >= 48 && lane < 51, isix = lane >= 51 && lane < 59;
        const float ssq = wave_sum(isq ? ss : 0.f), sskv = wave_sum(iskv ? ss : 0.f), mean = wave_sum(isix ? s1 : 0.f) * (1.f / 128.f);
        float d2 = 0.f;
#pragma unroll
        for (int j = 0; j < 4; ++j) { const f32x4 d = v[j] - mean; d2 += (d.x * d.x + d.y * d.y) + (d.z * d.z + d.w * d.w); }
        const float var = wave_sum(isix ? d2 : 0.f) * (1.f / 128.f);
        const float rq = 1.0f / sqrtf(ssq * (1.f / 512.f) + NORM_EPS), rkv = 1.0f / sqrtf(sskv * (1.f / 256.f) + NORM_EPS), rstd = 1.0f / sqrtf(var + NORM_EPS);
        if (isq || iskv) {
            const float* gp = isq ? qn + 16 * lane : kvn + 16 * (lane - 32); const float rs = isq ? rq : rkv;
            bf16* dst = isq ? CQN + (size_t)ml * 512 + 16 * lane : LATC + (size_t)ml * 256 + 16 * (lane - 32);
            u32x4 o[2];
#pragma unroll
            for (int j = 0; j < 4; ++j) { const f32x4 g = *(const f32x4*)(gp + 4 * j); const f32x4 y = v[j] * rs * g; o[j >> 1][(j & 1) * 2] = pk2(y.x, y.y); o[j >> 1][(j & 1) * 2 + 1] = pk2(y.z, y.w); }
            *(u32x4*)dst = o[0]; *(u32x4*)(dst + 8) = o[1];
        } else if (ispe) {
#pragma unroll
            for (int j = 0; j < 4; ++j) *(LAS f32x4*)(buf + (lane - 48) * 16 + 4 * j) = v[j];
        } else if (isix) {
#pragma unroll
            for (int j = 0; j < 4; ++j) { const f32x4 g = *(const f32x4*)(lng + (lane - 51) * 16 + 4 * j), b = *(const f32x4*)(lnb + (lane - 51) * 16 + 4 * j); *(LAS f32x4*)(buf + 48 + (lane - 51) * 16 + 4 * j) = (v[j] - mean) * rstd * g + b; }
        } else if (lane == 59) {
#pragma unroll
            for (int j = 0; j < 4; ++j) *(f32x4*)(WIDX + (size_t)ml * 16 + 4 * j) = v[j] * DSA_WIDX_SCALE;
        }
        LDS_WAIT();
        if (lane < 24) { const float x1 = buf[lane], x2 = buf[24 + lane], c = c48[(size_t)mg * 24 + lane], s = s48[(size_t)mg * 24 + lane];
            KPE[(size_t)ml * 48 + lane] = f2bf(x1 * c - x2 * s); KPE[(size_t)ml * 48 + 24 + lane] = f2bf(x1 * s + x2 * c);
        } else if (lane < 40) { const int i = lane - 24; const float x1 = buf[48 + i], x2 = buf[48 + 16 + i], c = c32[(size_t)mg * 16 + i], s = s32[(size_t)mg * 16 + i];
            KIDX[(size_t)ml * 128 + i] = f2bf(x1 * c - x2 * s); KIDX[(size_t)ml * 128 + 16 + i] = f2bf(x1 * s + x2 * c);
        } else { const int d = 32 + 4 * (lane - 40); const f32x4 y = *(const LAS f32x4*)(buf + 48 + d); u32x2 w; w.x = pk2(y.x, y.y); w.y = pk2(y.z, y.w); *(u32x2*)(KIDX + (size_t)ml * 128 + d) = w; }
        LDS_WAIT();
    }
}
DI void ph_dsa_rope(const Frame& F, int half) {
    unsigned char* ar = F.ws + WS_AR; bf16* QPE = (bf16*)(ar + DA_QPE); bf16* QIDX = (bf16*)(ar + DA_QIDX);
    const float* c48 = (const float*)(F.ws + TAB_COS48); const float* s48 = (const float*)(F.ws + TAB_SIN48); const float* c32 = (const float*)(F.ws + TAB_COS32); const float* s32 = (const float*)(F.ws + TAB_SIN32);
    for (int ml = F.gw; ml < MC; ml += F.NGW) {
        const size_t mg = (size_t)half * MC + ml;
        for (int p = F.lane; p < 768; p += 64) { const int hd = p / 24, i = p - hd * 24; bf16* q = QPE + (size_t)ml * 1536 + hd * 48 + i;
            const float x1 = bf2f(q[0]), x2 = bf2f(q[24]), c = c48[mg * 24 + i], s = s48[mg * 24 + i]; q[0] = f2bf(x1 * c - x2 * s); q[24] = f2bf(x1 * s + x2 * c); }
        for (int p = F.lane; p < 256; p += 64) { const int hd = p >> 4, i = p & 15; bf16* q = QIDX + (size_t)ml * 2048 + hd * 128 + i;
            const float x1 = bf2f(q[0]), x2 = bf2f(q[16]), c = c32[mg * 16 + i], s = s32[mg * 16 + i]; q[0] = f2bf(x1 * c - x2 * s); q[16] = f2bf(x1 * s + x2 * c); }
    }
}
DI unsigned f2sortable(float s) { const unsigned b = __builtin_bit_cast(unsigned, s); return (b & 0x80000000u) ? ~b : (b | 0x80000000u); }
DI void ph_dsa_index(const Frame& F) {
    unsigned char* ar = F.ws + WS_AR;
    const bf16* QIDX = (const bf16*)(ar + DA_QIDX); const bf16* KIDX = (const bf16*)(ar + DA_KIDX); const float* WIDX = (const float*)(ar + DA_WIDX);
    unsigned short* SEL = (unsigned short*)(ar + DA_SEL); int* CNT = (int*)(ar + DA_CNT); float* SC = (float*)(ar + DA_SC) + (size_t)F.gw * 16384;
    const int lane = F.lane, r = lane & 31, hf = lane >> 5;
#pragma unroll 1
    for (int tile = blockIdx.x; tile < BPH * 128; tile += F.G) {
        const int j = tile >> 8, c8 = tile & 255, c7 = c8 & 127, bl = (c8 >> 7) * 2 + j, qt = j ? 127 - c7 : c7;
        const int q0 = qt * 32 + 4 * F.wave;
        const int ntile = (q0 + 3) / 32 + 1;
        bf16x8 qa[2][8]; float wv[2][16];
#pragma unroll
        for (int pr = 0; pr < 2; ++pr) {
            const int mrow = bl * SEQ + q0 + 2 * pr + (r >> 4);
#pragma unroll
            for (int s = 0; s < 8; ++s) qa[pr][s] = *(const bf16x8*)(QIDX + (size_t)mrow * 2048 + (r & 15) * 128 + 16 * s + 8 * hf);
#pragma unroll
            for (int i = 0; i < 16; ++i) wv[pr][i] = WIDX[(size_t)(bl * SEQ + q0 + 2 * pr + (i >> 3)) * 16 + (i & 3) + 8 * ((i >> 2) & 1) + 4 * hf];
        }
#pragma unroll 1
        for (int t = 0; t < ntile; ++t) {
            bf16x8 kf[8];
            const bf16* kp = KIDX + (size_t)(bl * SEQ + 32 * t + r) * 128 + 8 * hf;
#pragma unroll
            for (int s = 0; s < 8; ++s) kf[s] = *(const bf16x8*)(kp + 16 * s);
#pragma unroll
            for (int pr = 0; pr < 2; ++pr) {
                f32x16 acc;
#pragma unroll
                for (int i = 0; i < 16; ++i) acc[i] = 0.f;
#pragma unroll
                for (int s = 0; s < 8; ++s) acc = MFMA32(qa[pr][s], kf[s], acc);
                float p0 = 0.f, p1 = 0.f;
#pragma unroll
                for (int i = 0; i < 8; ++i) { p0 += wv[pr][i] * fmaxf(acc[i], 0.f); p1 += wv[pr][8 + i] * fmaxf(acc[8 + i], 0.f); }
                const float t0 = p0 + __shfl_xor(p0, 32), t1 = p1 + __shfl_xor(p1, 32);
                SC[(pr * 128 + t) * 64 + lane] = hf ? t1 : t0;
            }
        }
        VM_WAIT();
#pragma unroll 1
        for (int qi = 0; qi < 4; ++qi) {
            const int tq = q0 + qi, pr = qi >> 1, qs = qi & 1;
            unsigned u[64];
            const unsigned* scp = (const unsigned*)(SC + pr * 8192 + hf * 64 + qs * 32 + r);
#pragma unroll
            for (int g8 = 0; g8 < 8; ++g8) {
#pragma unroll
                for (int e = 0; e < 8; ++e) { const int i = 8 * g8 + e; const float s = __builtin_bit_cast(float, __hip_atomic_load(scp + e * 128, __ATOMIC_RELAXED, __HIP_MEMORY_SCOPE_AGENT));
                    u[i] = (2 * i + hf < ntile && 64 * i + lane <= tq) ? f2sortable(s) : 0u; }
                scp += 1024; asm volatile("" : "+v"(scp));
            }
            unsigned prefix = 0u;
#pragma unroll 1
            for (int bit = 31; bit >= 0; --bit) {
                const unsigned cand = prefix | (1u << bit); int c = 0;
#pragma unroll
                for (int i = 0; i < 64; ++i) c += (u[i] >= cand) ? 1 : 0;
#pragma unroll
                for (int o = 1; o < 64; o <<= 1) c += __shfl_xor(c, o);
                if (c >= 256) prefix = cand;
            }
            const unsigned T = prefix > 1u ? prefix : 1u;
            int nl = 0;
#pragma unroll
            for (int i = 0; i < 64; ++i) nl += (u[i] >= T) ? 1 : 0;
            int inc = nl;
#pragma unroll
            for (int o = 1; o < 64; o <<= 1) { const int y = __shfl_up(inc, o); if (lane >= o) inc += y; }
            const int base = __shfl(inc, 63);
            int pos = inc - nl;
            unsigned short* sel = SEL + (size_t)(bl * SEQ + tq) * 256;
#pragma unroll
            for (int i = 0; i < 64; ++i) { if (u[i] >= T) { if (pos < 256) sel[pos] = (unsigned short)(64 * i + lane); ++pos; } }
            if (lane == 0) CNT[bl * SEQ + tq] = base < 256 ? base : 256;
        }
    }
}
DI void ph_dsa_attn(const Frame& F) {
    unsigned char* ar = F.ws + WS_AR;
    bf16* QL = (bf16*)(ar + DA_QL); const bf16* QPE = (const bf16*)(ar + DA_QPE); const bf16* LATC = (const bf16*)(ar + DA_LATC); const bf16* KPE = (const bf16*)(ar + DA_KPE);
    const unsigned short* SEL = (const unsigned short*)(ar + DA_SEL); const int* CNT = (const int*)(ar + DA_CNT);
    const int lane = F.lane, r = lane & 31, h = lane >> 5;
    u32x4* PS = (u32x4*)(ar + DA_SC + (size_t)F.gw * 65536) + lane;
    float* AS = (float*)(ar + DA_SC + (size_t)F.gw * 65536 + 16384) + lane;
    LAS unsigned char* img = F.lds + F.wave * 8704;
    const int i16 = lane & 15, tq_ = i16 >> 2, tp_ = i16 & 3, blk = (lane >> 4) & 1;
#pragma unroll 1
    for (int ml = F.gw; ml < MC; ml += F.NGW) {
        const int bl = ml >> 12, cnt = CNT[ml], nch = (cnt + 31) >> 5;
        const unsigned short* sel = SEL + (size_t)ml * 256;
        float linv;
        {
            bf16x8 qf[16], qp[3];
#pragma unroll
            for (int s = 0; s < 16; ++s) qf[s] = *(const bf16x8*)(QL + (size_t)ml * 8192 + r * 256 + 16 * s + 8 * h);
#pragma unroll
            for (int s = 0; s < 3; ++s) qp[s] = *(const bf16x8*)(QPE + (size_t)ml * 1536 + r * 48 + 16 * s + 8 * h);
            float m = -INFINITY, l = 0.f;
#pragma unroll 1
            for (int c = 0; c < nch; ++c) {
                const int slot = 32 * c + r; const int kidx = slot < cnt ? (int)sel[slot] : 0;
                const bf16* kc = LATC + (size_t)(bl * SEQ + kidx) * 256 + 8 * h; const bf16* kp = KPE + (size_t)(bl * SEQ + kidx) * 48 + 8 * h;
                f32x16 acc;
#pragma unroll
                for (int i = 0; i < 16; ++i) acc[i] = 0.f;
#pragma unroll
                for (int s = 0; s < 16; ++s) acc = MFMA32(*(const bf16x8*)(kc + 16 * s), qf[s], acc);
#pragma unroll
                for (int s = 0; s < 3; ++s) acc = MFMA32(*(const bf16x8*)(kp + 16 * s), qp[s], acc);
                float mx = -INFINITY;
#pragma unroll
                for (int i = 0; i < 16; ++i) { acc[i] = (32 * c + crow(i, h) < cnt) ? acc[i] : -INFINITY; mx = fmaxf(mx, acc[i]); }
                mx = fmaxf(mx, __shfl_xor(mx, 32));
                const float mn = fmaxf(m, mx), a = __builtin_amdgcn_exp2f(m - mn);
                float sum = 0.f;
#pragma unroll
                for (int i = 0; i < 16; ++i) { acc[i] = __builtin_amdgcn_exp2f(acc[i] - mn); sum += acc[i]; }
                l = l * a + sum; m = mn;
                AS[c * 64] = a;
#pragma unroll
                for (int s = 0; s < 2; ++s) { u32x4 w; w.x = pk2(acc[8 * s], acc[8 * s + 1]); w.y = pk2(acc[8 * s + 2], acc[8 * s + 3]); w.z = pk2(acc[8 * s + 4], acc[8 * s + 5]); w.w = pk2(acc[8 * s + 6], acc[8 * s + 7]); PS[(c * 2 + s) * 64] = w; }
            }
            l += __shfl_xor(l, 32);
            linv = 1.0f / l;
        }
#pragma unroll 1
        for (int dh = 0; dh < 2; ++dh) {
            f32x16 O[4];
#pragma unroll
            for (int db = 0; db < 4; ++db)
#pragma unroll
                for (int i = 0; i < 16; ++i) O[db][i] = 0.f;
#pragma unroll 1
            for (int c = 0; c < nch; ++c) {
                const int slot = 32 * c + r; const int myk = slot < cnt ? (int)sel[slot] : 0;
                const float a = AS[c * 64];
                const bf16x8 p0 = __builtin_bit_cast(bf16x8, PS[(c * 2) * 64]), p1 = __builtin_bit_cast(bf16x8, PS[(c * 2 + 1) * 64]);
#pragma unroll
                for (int it = 0; it < 8; ++it) { const int rr = (lane >> 4) + 4 * it; const int ki = __shfl(myk, rr);
                    const u32x4 d = *(const u32x4*)(LATC + (size_t)(bl * SEQ + ki) * 256 + dh * 128 + i16 * 8);
                    *(LAS u32x4*)(img + rr * 272 + i16 * 16) = d; }
#pragma unroll
                for (int db = 0; db < 4; ++db)
#pragma unroll
                    for (int i = 0; i < 16; ++i) O[db][i] *= a;
                LDS_WAIT();
#pragma unroll
                for (int db = 0; db < 4; ++db)
#pragma unroll
                    for (int s = 0; s < 2; ++s) {
                        const s16x4 lo = __builtin_bit_cast(s16x4, __builtin_amdgcn_ds_read_tr16_b64_v4i16((LAS v4i16_t*)(img + (16 * s + 4 * h + tq_) * 272 + db * 64 + 32 * blk + 8 * tp_)));
                        const s16x4 hi = __builtin_bit_cast(s16x4, __builtin_amdgcn_ds_read_tr16_b64_v4i16((LAS v4i16_t*)(img + (16 * s + 8 + 4 * h + tq_) * 272 + db * 64 + 32 * blk + 8 * tp_)));
                        O[db] = MFMA32(__builtin_shufflevector(lo, hi, 0, 1, 2, 3, 4, 5, 6, 7), s ? p1 : p0, O[db]);
                    }
                LDS_WAIT();
            }
            bf16* o = QL + (size_t)ml * 8192 + r * 256 + dh * 128 + 4 * h;
#pragma unroll
            for (int db = 0; db < 4; ++db)
#pragma unroll
                for (int g = 0; g < 4; ++g) { u32x2 w; w.x = pk2(O[db][4 * g] * linv, O[db][4 * g + 1] * linv); w.y = pk2(O[db][4 * g + 2] * linv, O[db][4 * g + 3] * linv); *(u32x2*)(o + db * 32 + 8 * g) = w; }
        }
    }
}
template <int NDB> DI void softmax_step(f32x16& S, float& m, float& l, f32x16 (&O)[NDB], bf16x8 (&pf)[2]) {
    float mx = S[0];
#pragma unroll
    for (int i = 1; i < 16; ++i) mx = fmaxf(mx, S[i]);
    mx = fmaxf(mx, __shfl_xor(mx, 32));
    const float mn = fmaxf(m, mx), ms = (mn == -INFINITY) ? 0.f : mn;
    const float alpha = __builtin_amdgcn_exp2f(m - ms);
    float sum = 0.f;
#pragma unroll
    for (int i = 0; i < 16; ++i) { S[i] = __builtin_amdgcn_exp2f(S[i] - ms); sum += S[i]; }
    l = l * alpha + sum; m = mn;
#pragma unroll
    for (int db = 0; db < NDB; ++db)
#pragma unroll
        for (int i = 0; i < 16; ++i) O[db][i] *= alpha;
#pragma unroll
    for (int s = 0; s < 2; ++s) { u32x4 w; w.x = pk2(S[8 * s], S[8 * s + 1]); w.y = pk2(S[8 * s + 2], S[8 * s + 3]); w.z = pk2(S[8 * s + 4], S[8 * s + 5]); w.w = pk2(S[8 * s + 6], S[8 * s + 7]); pf[s] = __builtin_bit_cast(bf16x8, w); }
}
template <int NQ, int NDB, bool PV, bool QL, class KA, class VA, class MK>
DI void attn_run(const bf16x8 (&qf)[NQ], const LAS unsigned char* qlds, f32x16 (&O)[NDB], float& m, float& l, int tb, int te, const KA& ka, const VA& va, const MK& mk) {
    if (tb >= te) return;
    bf16x8 kf[NQ];
    { const bf16* kp = ka(tb);
#pragma unroll
      for (int s = 0; s < NQ; ++s) kf[s] = *(const bf16x8*)(kp + 16 * s); }
    for (int t = tb; t < te; ++t) {
        s16x4 vl[NDB][2], vh[NDB][2];
        if (PV) {
#pragma unroll
            for (int db = 0; db < NDB; ++db) { const bf16* vp = va(t, db);
#pragma unroll
                for (int s = 0; s < 2; ++s) { vl[db][s] = *(const s16x4*)(vp + 16 * s); vh[db][s] = *(const s16x4*)(vp + 16 * s + 8); } }
        }
        f32x16 S;
#pragma unroll
        for (int i = 0; i < 16; ++i) S[i] = 0.f;
#pragma unroll
        for (int s = 0; s < NQ; ++s) { if (QL) { unsigned qa_ = (unsigned)(size_t)qlds; asm volatile("" : "+v"(qa_)); S = MFMA32(kf[s], *(const LAS bf16x8*)((LAS unsigned char*)(size_t)qa_ + s * 1024), S); } else S = MFMA32(kf[s], qf[s], S); }
        if (t + 1 < te) { const bf16* kp = ka(t + 1);
#pragma unroll
            for (int s = 0; s < NQ; ++s) kf[s] = *(const bf16x8*)(kp + 16 * s); }
        mk(t, S);
        bf16x8 pf[2]; softmax_step<NDB>(S, m, l, O, pf);
        if (PV) {
#pragma unroll
            for (int db = 0; db < NDB; ++db)
#pragma unroll
                for (int s = 0; s < 2; ++s) O[db] = MFMA32(__builtin_shufflevector(vl[db][s], vh[db][s], 0, 1, 2, 3, 4, 5, 6, 7), pf[s], O[db]);
        }
    }
}
template <bool ACC> DI void store_col(bf16* out, const f32x16 (&O)[4], float scale, int h) {
#pragma unroll
    for (int db = 0; db < 4; ++db)
#pragma unroll
        for (int g = 0; g < 4; ++g) { u32x2* p = (u32x2*)(out + db * 32 + 8 * g + 4 * h);
            float a = O[db][4 * g] * scale, b = O[db][4 * g + 1] * scale, c = O[db][4 * g + 2] * scale, d = O[db][4 * g + 3] * scale;
            if (ACC) { const u32x2 o = *p; a += bflo(o.x); b += bfhi(o.x); c += bflo(o.y); d += bfhi(o.y); }
            u32x2 w; w.x = pk2(a, b); w.y = pk2(c, d); *p = w; }
}
constexpr size_t FA_Q = 0, FA_K = 64 * MiB, FA_F = 128 * MiB, FA_VT = 136 * MiB, FA_CUM = 200 * MiB, FA_O = 202 * MiB;
constexpr size_t FW_IN = 0, FW_V = (size_t)4352 * 2048, FW_OUT = FW_V + (size_t)2048 * 2048;
constexpr float FOX_QSCALE = 0.08838834764831845f * LOG2E;
DI void ph_fox_cvt(const Frame& F, const float* w_in, const float* w_out) {
    bf16* WB = (bf16*)(F.ws + WS_WMIX);
    cvt_job(F, w_in, 6160, DM, 0, 2048, WB + FW_IN, DM, 0, FOX_QSCALE);
    cvt_job(F, w_in, 6160, DM, 2048, 2048, WB + FW_IN, DM, 2048, 1.f);
    cvt_job(F, w_in, 6160, DM, 6144, 16, WB + FW_IN, DM, 4096, 1.f);
    zero_bf16(F, WB + FW_IN + (size_t)4112 * DM, (size_t)240 * DM);
    cvt_job(F, w_in, 6160, DM, 4096, 2048, WB + FW_V, DM, 0, 1.f);
    cvt_job(F, w_out, DM, DM, 0, DM, WB + FW_OUT, DM, 0, 1.f);
}
DI void ph_fox_scan(const Frame& F, const float* b_f) {
    unsigned char* ar = F.ws + WS_AR; const bf16* FB = (const bf16*)(ar + FA_F); float* CUM = (float*)(ar + FA_CUM);
    for (int w = F.gw; w < BPH * 16; w += F.NGW) {
        const int bl = w >> 4, hd = w & 15; const float bf_ = b_f[hd];
        float v[64]; float run = 0.f;
#pragma unroll
        for (int i = 0; i < 64; ++i) { const float x = bf2f(FB[(size_t)(bl * SEQ + F.lane * 64 + i) * 256 + hd]) + bf_;
            const float ls = fminf(x, 0.f) - log1pf(expf(-fabsf(x))); run += ls; v[i] = run; }
        float inc = run;
#pragma unroll
        for (int o = 1; o < 64; o <<= 1) { const float y = __shfl_up(inc, o); if (F.lane >= o) inc += y; }
        const float base = inc - run;
        float* dst = CUM + (size_t)w * SEQ + F.lane * 64;
#pragma unroll
        for (int i = 0; i < 64; i += 4) *(f32x4*)(dst + i) = (f32x4){(v[i] + base) * LOG2E, (v[i + 1] + base) * LOG2E, (v[i + 2] + base) * LOG2E, (v[i + 3] + base) * LOG2E};
    }
}
struct FoxKA { const bf16* base; DI const bf16* operator()(int t) const { return base + (size_t)t * 32 * DM; } };
struct FoxVA { const bf16* base; DI const bf16* operator()(int t, int db) const { return base + (size_t)db * 32 * MC + t * 32; } };
struct FoxMK { const float* cum; float ct; int tq, h;
    DI void operator()(int t, f32x16& S) const {
        const int k0 = 32 * t + 4 * h;
#pragma unroll
        for (int g = 0; g < 4; ++g) { const f32x4 cs = *(const f32x4*)(cum + k0 + 8 * g);
#pragma unroll
            for (int e = 0; e < 4; ++e) S[4 * g + e] = (k0 + 8 * g + e <= tq) ? S[4 * g + e] + (ct - cs[e]) : -INFINITY; }
    } };
DI void ph_fox_attn(const Frame& F) {
    unsigned char* ar = F.ws + WS_AR; const bf16* Q = (const bf16*)(ar + FA_Q); const bf16* K = (const bf16*)(ar + FA_K); const bf16* VT = (const bf16*)(ar + FA_VT); const float* CUM = (const float*)(ar + FA_CUM); bf16* Ob = (bf16*)(ar + FA_O);
    const int r = F.lane & 31, h = F.lane >> 5;
    for (int wt = F.gw; wt < BPH * 16 * 32; wt += F.NGW) {
        const int bh = wt >> 5, x = wt & 31, bl = bh >> 4, hd = bh & 15;
#pragma unroll 1
        for (int k = 0; k < 4; ++k) {
            const int qt = (k == 0) ? x : (k == 1) ? 63 - x : (k == 2) ? 64 + x : 127 - x;
            const int tq = qt * 32 + r; const size_t mrow = (size_t)bl * SEQ + tq;
            bf16x8 qf[8];
#pragma unroll
            for (int s = 0; s < 8; ++s) qf[s] = *(const bf16x8*)(Q + mrow * DM + hd * 128 + 16 * s + 8 * h);
            f32x16 O[4];
#pragma unroll
            for (int db = 0; db < 4; ++db)
#pragma unroll
                for (int i = 0; i < 16; ++i) O[db][i] = 0.f;
            float m = -INFINITY, l = 0.f;
            const float* cum = CUM + (size_t)bh * SEQ;
            const FoxKA ka{K + ((size_t)bl * SEQ + r) * DM + hd * 128 + 8 * h}; const FoxVA va{VT + ((size_t)hd * 128 + r) * MC + bl * SEQ + 4 * h}; const FoxMK mk{cum, cum[tq], tq, h};
            attn_run<8, 4, true, false>(qf, nullptr, O, m, l, 0, qt + 1, ka, va, mk);
            l += __shfl_xor(l, 32);
            store_col<false>(Ob + mrow * DM + hd * 128, O, l > 0.f ? 1.0f / l : 0.f, h);
        }
    }
}
constexpr size_t NA_Q = 0, NA_KC = 288 * MiB, NA_VC = 313 * MiB, NA_KS = 330 * MiB, NA_KW = 354 * MiB, NA_GT = 378 * MiB, NA_VT2 = 386 * MiB, NA_GK = 418 * MiB, NA_GV = 420 * MiB,
                 NA_KCMP = 422 * MiB, NA_VCT = 424 * MiB, NA_SELB = 426 * MiB, NA_O = 428 * MiB;
constexpr size_t NW_IN = 0, NW_V2 = (size_t)12288 * 2048, NW_W1K = NW_V2 + (size_t)1024 * 2048, NW_W1V = NW_W1K + (size_t)256 * 6144, NW_W2K = NW_W1V + (size_t)256 * 4096, NW_W2V = NW_W2K + 65536, NW_OUT = NW_W2V + 65536;
constexpr float NSA_QSCALE = 0.07216878364870322f * LOG2E;
DI void ph_nsa_cvt(const Frame& F, const float* w_in, const float* k_pe, const float* k_w1, const float* k_b1, const float* k_w2, const float* v_pe, const float* v_w1, const float* v_b1, const float* v_w2, const float* w_out) {
    bf16* WB = (bf16*)(F.ws + WS_WMIX); float* BIAS = (float*)(F.ws + WS_MISC);
    cvt_job(F, w_in, 13200, DM, 0, 9216, WB + NW_IN, DM, 0, NSA_QSCALE);
    cvt_job(F, w_in, 13200, DM, 9216, 768, WB + NW_IN, DM, 9216, 1.f);
    cvt_job(F, w_in, 13200, DM, 9984, 512, WB + NW_IN, DM, 9984, 1.f);
    cvt_job(F, w_in, 13200, DM, 10496, 768, WB + NW_IN, DM, 10496, 1.f);
    cvt_job(F, w_in, 13200, DM, 11776, 768, WB + NW_IN, DM, 11264, 1.f);
    cvt_job(F, w_in, 13200, DM, 13056, 144, WB + NW_IN, DM, 12032, 1.f);
    zero_bf16(F, WB + NW_IN + (size_t)12176 * DM, (size_t)112 * DM);
    cvt_job(F, w_in, 13200, DM, 11264, 512, WB + NW_V2, DM, 0, 1.f);
    cvt_job(F, w_in, 13200, DM, 12544, 512, WB + NW_V2, DM, 512, 1.f);
    cvt_job(F, k_w1, 256, 6144, 0, 256, WB + NW_W1K, 6144, 0, 1.f);
    cvt_job(F, v_w1, 256, 4096, 0, 256, WB + NW_W1V, 4096, 0, 1.f);
    cvt_job(F, k_w2, 192, 256, 0, 192, WB + NW_W2K, 256, 0, 1.f); zero_bf16(F, WB + NW_W2K + 192 * 256, 64 * 256);
    cvt_job(F, v_w2, 128, 256, 0, 128, WB + NW_W2V, 256, 0, 1.f); zero_bf16(F, WB + NW_W2V + 128 * 256, 128 * 256);
    cvt_job(F, w_out, DM, 6144, 0, DM, WB + NW_OUT, 6144, 0, 1.f);
    for (int w = F.gw; w < 512; w += F.NGW) { const bool isk = w < 256; const int c = w & 255, n = isk ? 6144 : 4096; const float* pe = isk ? k_pe : v_pe; const float* w1 = isk ? k_w1 : v_w1;
        float s = 0.f; for (int i = F.lane; i < n; i += 64) s += pe[i] * w1[(size_t)i * 256 + c];
        s = wave_sum(s); if (F.lane == 0) BIAS[w] = s + (isk ? k_b1[c] : v_b1[c]); }
}
DI void ph_nsa_rope(const Frame& F, int half) {
    unsigned char* ar = F.ws + WS_AR; bf16* Q = (bf16*)(ar + NA_Q); bf16* KC = (bf16*)(ar + NA_KC); bf16* KS = (bf16*)(ar + NA_KS); bf16* KW = (bf16*)(ar + NA_KW);
    const float* c48 = (const float*)(F.ws + TAB_COS48); const float* s48 = (const float*)(F.ws + TAB_SIN48);
    for (int ml = F.gw; ml < MC; ml += F.NGW) {
        const size_t mg = (size_t)half * MC + ml; const int bl = ml >> 12, sq = ml & 4095;
        for (int p = F.lane; p < 1440; p += 64) {
            const int hd = p / 24, i = p - hd * 24; bf16* q;
            if (hd < 48) q = Q + (size_t)ml * 9216 + hd * 192 + i;
            else if (hd < 52) q = KC + ((size_t)(bl * 4 + hd - 48) * 4096 + sq) * 192 + i;
            else if (hd < 56) q = KS + (size_t)ml * 768 + (hd - 52) * 192 + i;
            else q = KW + (size_t)ml * 768 + (hd - 56) * 192 + i;
            const float x1 = bf2f(q[0]), x2 = bf2f(q[24]), c = c48[mg * 24 + i], s = s48[mg * 24 + i]; q[0] = f2bf(x1 * c - x2 * s); q[24] = f2bf(x1 * s + x2 * c);
        }
    }
}
DI float sigmoidf_(float x) { return __builtin_amdgcn_rcpf(1.0f + __builtin_amdgcn_exp2f(-x * LOG2E)); }
struct LinKA { const bf16* base; size_t tstride; DI const bf16* operator()(int t) const { return base + (size_t)t * tstride; } };
struct LinVA { const bf16* base; size_t dbstride; DI const bf16* operator()(int t, int db) const { return base + (size_t)db * dbstride + t * 32; } };
struct CmpMK { int tq, h; DI void operator()(int t, f32x16& S) const {
#pragma unroll
    for (int i = 0; i < 16; ++i) { const int n = 32 * t + crow(i, h); S[i] = (16 * n + 31 <= tq) ? S[i] : -INFINITY; } } };
struct WinMK { int tq, h; DI void operator()(int t, f32x16& S) const {
#pragma unroll
    for (int i = 0; i < 16; ++i) { const int k = 32 * t + crow(i, h); S[i] = (k <= tq && k > tq - 512) ? S[i] : -INFINITY; } } };
DI void ph_nsa_cmp(const Frame& F) {
    unsigned char* ar = F.ws + WS_AR; const bf16* Q = (const bf16*)(ar + NA_Q); const bf16* KCMP = (const bf16*)(ar + NA_KCMP); const bf16* VCT = (const bf16*)(ar + NA_VCT); const bf16* GT = (const bf16*)(ar + NA_GT);
    unsigned char* SELB = ar + NA_SELB; bf16* Ob = (bf16*)(ar + NA_O);
    LAS float* imp = (LAS float*)F.lds;
    LAS unsigned char* qlds = F.lds + 20480 + F.wave * 12288 + F.lane * 16;
    const int lane = F.lane, r = lane & 31, h = lane >> 5;
    for (int u = blockIdx.x; u < BPH * 4 * 64; u += F.G) {
        const int bg = u >> 6, qt64 = u & 63, bl = bg >> 2, g = bg & 3;
        for (int i = F.tid; i < 64 * 65; i += NWAVES * 64) imp[i] = 0.f;
        __syncthreads();
#pragma unroll 1
        for (int k = 0; k < 3; ++k) {
            const int idx = F.wave * 3 + k, j = idx >> 1, sub = idx & 1, ql = sub * 32 + r, tq = qt64 * 64 + ql, hd = g * 12 + j;
            const size_t mrow = (size_t)bl * SEQ + tq;
            bf16x8 qf[12];
#pragma unroll
            for (int s = 0; s < 12; ++s) { qf[s] = *(const bf16x8*)(Q + mrow * 9216 + hd * 192 + 16 * s + 8 * h); *(LAS bf16x8*)(qlds + s * 1024) = qf[s]; }
            LDS_WAIT();
            const int tqmax = qt64 * 64 + sub * 32 + 31, te = (tqmax >= 31) ? ((tqmax - 31) / 16) / 32 + 1 : 0;
            const LinKA ka{KCMP + ((size_t)bg * 256 + r) * 256 + 8 * h, (size_t)32 * 256}; const LinVA va{VCT + (size_t)r * 4096 + bg * 256 + 4 * h, (size_t)32 * 4096}; const CmpMK mk{tq, h};
            f32x16 O[4];
#pragma unroll
            for (int db = 0; db < 4; ++db)
#pragma unroll
                for (int i = 0; i < 16; ++i) O[db][i] = 0.f;
            float m = -INFINITY, l = 0.f;
            attn_run<12, 4, false, true>(qf, qlds, O, m, l, 0, te, ka, va, mk);
            l += __shfl_xor(l, 32);
            const float linv = l > 0.f ? 1.0f / l : 0.f, ms = (m == -INFINITY) ? 0.f : m;
            for (int t = 0; t < te; ++t) {
                const bf16* kp = ka(t); f32x16 S;
#pragma unroll
                for (int i = 0; i < 16; ++i) S[i] = 0.f;
#pragma unroll
                for (int s = 0; s < 12; ++s) { unsigned qa_ = (unsigned)(size_t)qlds; asm volatile("" : "+v"(qa_)); S = MFMA32(*(const bf16x8*)(kp + 16 * s), *(const LAS bf16x8*)((LAS unsigned char*)(size_t)qa_ + s * 1024), S); }
                mk(t, S);
#pragma unroll
                for (int i = 0; i < 16; ++i) S[i] = __builtin_amdgcn_exp2f(S[i] - ms) * linv;
#pragma unroll
                for (int g4 = 0; g4 < 4; ++g4) { const float gs = (S[4 * g4] + S[4 * g4 + 1]) + (S[4 * g4 + 2] + S[4 * g4 + 3]); const int mb = 8 * t + 2 * g4 + h;
                    __hip_atomic_fetch_add(imp + ql * 65 + mb, gs, __ATOMIC_RELAXED, __HIP_MEMORY_SCOPE_WORKGROUP);
                    if (mb + 1 < 64) __hip_atomic_fetch_add(imp + ql * 65 + mb + 1, S[4 * g4 + 3], __ATOMIC_RELAXED, __HIP_MEMORY_SCOPE_WORKGROUP); }
                bf16x8 pf[2];
#pragma unroll
                for (int s = 0; s < 2; ++s) { u32x4 w; w.x = pk2(S[8 * s], S[8 * s + 1]); w.y = pk2(S[8 * s + 2], S[8 * s + 3]); w.z = pk2(S[8 * s + 4], S[8 * s + 5]); w.w = pk2(S[8 * s + 6], S[8 * s + 7]); pf[s] = __builtin_bit_cast(bf16x8, w); }
#pragma unroll
                for (int db = 0; db < 4; ++db) { const bf16* vp = va(t, db);
#pragma unroll
                    for (int s = 0; s < 2; ++s) O[db] = MFMA32(__builtin_shufflevector(*(const s16x4*)(vp + 16 * s), *(const s16x4*)(vp + 16 * s + 8), 0, 1, 2, 3, 4, 5, 6, 7), pf[s], O[db]); }
            }
            const float gate = sigmoidf_(bf2f(GT[mrow * 256 + hd]));
            store_col<false>(Ob + mrow * 6144 + hd * 128, O, gate, h);
        }
        __syncthreads();
#pragma unroll 1
        for (int k = 0; k < 8; ++k) {
            const int ql = F.wave * 8 + k, tq = qt64 * 64 + ql, cur = tq >> 6, mb = lane;
            const bool causal = mb <= cur, forced = (mb == 0) || (mb == cur) || (mb == cur - 1);
            const float v = causal ? (forced ? INFINITY : imp[ql * 65 + mb]) : -INFINITY;
            int rank = 0;
            for (int o = 0; o < 64; ++o) { const float vo = __shfl(v, o); rank += (vo > v || (vo == v && o < mb)) ? 1 : 0; }
            if (rank < 16) SELB[((size_t)bg * 4096 + tq) * 16 + rank] = causal ? (unsigned char)mb : (unsigned char)0xFF;
        }
        __syncthreads();
    }
}
struct SelKA { const bf16* base; u32x4 sel; DI int tok0(int t) const { const int b = t >> 1; const unsigned w = (b < 4) ? sel.x : (b < 8) ? sel.y : (b < 12) ? sel.z : sel.w; return (int)((w >> ((b & 3) * 8)) & 0xFFu) * 64 + 32 * (t & 1); }
    DI const bf16* operator()(int t) const { return base + (size_t)tok0(t) * 768; } };
struct SelVA { const bf16* base; u32x4 sel; DI int tok0(int t) const { const int b = t >> 1; const unsigned w = (b < 4) ? sel.x : (b < 8) ? sel.y : (b < 12) ? sel.z : sel.w; return (int)((w >> ((b & 3) * 8)) & 0xFFu) * 64 + 32 * (t & 1); }
    DI const bf16* operator()(int t, int db) const { return base + (size_t)db * 32 * MC + tok0(t); } };
struct SelMK { u32x4 sel; int tq, h; DI void operator()(int t, f32x16& S) const { const int b = t >> 1; const unsigned w = (b < 4) ? sel.x : (b < 8) ? sel.y : (b < 12) ? sel.z : sel.w; const int k0 = (int)((w >> ((b & 3) * 8)) & 0xFFu) * 64 + 32 * (t & 1);
#pragma unroll
    for (int i = 0; i < 16; ++i) S[i] = (k0 + crow(i, h) <= tq) ? S[i] : -INFINITY; } };
DI void ph_nsa_sel(const Frame& F) {
    unsigned char* ar = F.ws + WS_AR; const bf16* Q = (const bf16*)(ar + NA_Q); const bf16* KS = (const bf16*)(ar + NA_KS); const bf16* VT2 = (const bf16*)(ar + NA_VT2); const bf16* GT = (const bf16*)(ar + NA_GT);
    const unsigned char* SELB = ar + NA_SELB; bf16* Ob = (bf16*)(ar + NA_O);
    const int r = F.lane & 31, h = F.lane >> 5; const bool act = r < 12;
    LAS unsigned char* qlds = F.lds + F.wave * 12288 + F.lane * 16;
    for (int it = F.gw; it < BPH * 4 * SEQ; it += F.NGW) {
        const int bg = it >> 12, tq = it & 4095, bl = bg >> 2, g = bg & 3; const size_t mrow = (size_t)bl * SEQ + tq; const int hd = g * 12 + (act ? r : 0);
        bf16x8 qf[12];
#pragma unroll
        for (int s = 0; s < 12; ++s) { qf[s] = *(const bf16x8*)(Q + mrow * 9216 + hd * 192 + 16 * s + 8 * h); if (!act) qf[s] = (bf16x8){0, 0, 0, 0, 0, 0, 0, 0}; *(LAS bf16x8*)(qlds + s * 1024) = qf[s]; }
        LDS_WAIT();
        const u32x4 sel = *(const u32x4*)(SELB + (size_t)it * 16);
        const int nv = ((tq >> 6) + 1 < 16) ? (tq >> 6) + 1 : 16;
        const SelKA ka{KS + ((size_t)bl * SEQ + r) * 768 + g * 192 + 8 * h, sel}; const SelVA va{VT2 + ((size_t)g * 128 + r) * MC + bl * SEQ + 4 * h, sel}; const SelMK mk{sel, tq, h};
        f32x16 O[4];
#pragma unroll
        for (int db = 0; db < 4; ++db)
#pragma unroll
            for (int i = 0; i < 16; ++i) O[db][i] = 0.f;
        float m = -INFINITY, l = 0.f;
        attn_run<12, 4, true, true>(qf, qlds, O, m, l, 0, 2 * nv, ka, va, mk);
        l += __shfl_xor(l, 32);
        if (act) { const float gate = sigmoidf_(bf2f(GT[mrow * 256 + 48 + hd])); store_col<true>(Ob + mrow * 6144 + hd * 128, O, l > 0.f ? gate / l : 0.f, h); }
    }
}
DI void ph_nsa_win(const Frame& F) {
    unsigned char* ar = F.ws + WS_AR; const bf16* Q = (const bf16*)(ar + NA_Q); const bf16* KW = (const bf16*)(ar + NA_KW); const bf16* VT2 = (const bf16*)(ar + NA_VT2); const bf16* GT = (const bf16*)(ar + NA_GT); bf16* Ob = (bf16*)(ar + NA_O);
    const int r = F.lane & 31, h = F.lane >> 5;
    LAS unsigned char* qlds = F.lds + F.wave * 12288 + F.lane * 16;
    for (int id = F.gw; id < BPH * 48 * 128; id += F.NGW) {
        const int qt = id & 127, bh = id >> 7, hd = bh % 48, bl = bh / 48, g = hd / 12, tq = qt * 32 + r; const size_t mrow = (size_t)bl * SEQ + tq;
        bf16x8 qf[12];
#pragma unroll
        for (int s = 0; s < 12; ++s) { qf[s] = *(const bf16x8*)(Q + mrow * 9216 + hd * 192 + 16 * s + 8 * h); *(LAS bf16x8*)(qlds + s * 1024) = qf[s]; }
        LDS_WAIT();
        const LinKA ka{KW + ((size_t)bl * SEQ + r) * 768 + g * 192 + 8 * h, (size_t)32 * 768}; const LinVA va{VT2 + ((size_t)512 + g * 128 + r) * MC + bl * SEQ + 4 * h, (size_t)32 * MC}; const WinMK mk{tq, h};
        f32x16 O[4];
#pragma unroll
        for (int db = 0; db < 4; ++db)
#pragma unroll
            for (int i = 0; i < 16; ++i) O[db][i] = 0.f;
        float m = -INFINITY, l = 0.f;
        attn_run<12, 4, true, true>(qf, qlds, O, m, l, qt >= 16 ? qt - 16 : 0, qt + 1, ka, va, mk);
        l += __shfl_xor(l, 32);
        const float gate = sigmoidf_(bf2f(GT[mrow * 256 + 96 + hd]));
        store_col<true>(Ob + mrow * 6144 + hd * 128, O, l > 0.f ? gate / l : 0.f, h);
    }
}
#ifndef MK_ONE_LAUNCH
#define MK_ONE_LAUNCH 1
#endif
constexpr int NPH = 102;
struct Args { const float* in[58]; float* out; unsigned char* ws; int ph_lo, ph_hi; };
#define GEMM_CALL(EpiT, Evar, Aptr, Bptr, Mv, Nv, Kv, ldav, ldbv, cidx) do { const pg8::Gemm g_{(const pg8::bf16_t*)(Aptr), (const pg8::bf16_t*)(Bptr), (Mv), (Nv), (Kv), (ldav), (ldbv)}; \
    pg8::StaticOrder S_; S_.init((Mv), (Nv), F.G, (cidx)); pg8::gemm_phase<EpiT, pg8::StaticOrder, true, true>((PG8_LAS unsigned char*)F.lds, g_, S_, Evar); } while (0)
DI pg8::EpiBf16R epi1(bf16* base, int ldc) { pg8::EpiBf16R e; for (int s = 0; s < 6; ++s) { e.T.base[s] = base; e.T.ldc[s] = ldc; e.T.t0[s] = 0; e.T.gw[s] = 0; } e.T.nseg = 1; e.T.pad_ = 0; return e; }
#define PH_BEGIN if (ph >= lo && ph < hi) { Frame F; { unsigned long long w_ = (unsigned long long)args.ws; asm volatile("" : "+s"(w_)); F.ws = (unsigned char*)w_; F.ctl = (unsigned*)(F.ws + WS_CTL); } \
    F.lds = lds; F.tid = threadIdx.x; F.lane = F.tid & 63; F.wave = __builtin_amdgcn_readfirstlane(F.tid >> 6); F.G = gridDim.x; F.gw = blockIdx.x * NWAVES + F.wave; F.NGW = F.G * NWAVES; \
    float* out; { unsigned long long o_ = (unsigned long long)args.out; asm volatile("" : "+s"(o_)); out = (float*)o_; } \
    unsigned char* const ar = F.ws + WS_AR; bf16* const XN = (bf16*)(F.ws + WS_XN); bf16* const WB = (bf16*)(F.ws + WS_WMIX); bf16* const WUP = (bf16*)(F.ws + WS_WFFN); bf16* const WDN = WUP + (size_t)2 * DFF * DM; \
    const float* const res_mix = (ib == 2) ? args.in[0] : (const float*)out; (void)ar; (void)XN; (void)WB; (void)WUP; (void)WDN; (void)res_mix; (void)iff;
#define PH_END   if (ph + 1 < hi) { XcdBarrier b_; b_.bar = (unsigned*)F.ctl + CW_BAR; b_.x = xb_xcc_id(); b_.st = MISC + 8; xcd_barrier(b_); } } ++ph;
template <int LAYER> DI void run_cvt(const Args& args, LAS unsigned char* lds, volatile LAS unsigned* MISC, int& ph, const int lo, const int hi) {
    constexpr int ib = (LAYER == 0) ? 2 : (LAYER == 1) ? 17 : (LAYER == 2) ? 26 : 42;
    constexpr int iff = (LAYER == 0) ? 12 : (LAYER == 1) ? 21 : (LAYER == 2) ? 37 : 52;
    constexpr int kind = (LAYER == 1) ? 1 : (LAYER == 2) ? 2 : 0;
        PH_BEGIN
            if constexpr (kind == 0) ph_dsa_cvt(F, args.in[ib + 1], args.in[ib + 6], args.in[ib + 7], args.in[ib + 8], args.in[ib + 9]);
            else if constexpr (kind == 1) ph_fox_cvt(F, args.in[ib + 1], args.in[ib + 3]);
            else ph_nsa_cvt(F, args.in[ib + 1], args.in[ib + 2], args.in[ib + 3], args.in[ib + 4], args.in[ib + 5], args.in[ib + 6], args.in[ib + 7], args.in[ib + 8], args.in[ib + 9], args.in[ib + 10]);
            ph_cvt_ffn(F, args.in[iff + 1], args.in[iff + 4]);
        PH_END
}
template <int LAYER, int HALF> DI void run_half(const Args& args, LAS unsigned char* lds, volatile LAS unsigned* MISC, int& ph, const int lo, const int hi) {
    constexpr int ib = (LAYER == 0) ? 2 : (LAYER == 1) ? 17 : (LAYER == 2) ? 26 : 42;
    constexpr int iff = (LAYER == 0) ? 12 : (LAYER == 1) ? 21 : (LAYER == 2) ? 37 : 52;
    constexpr int kind = (LAYER == 1) ? 1 : (LAYER == 2) ? 2 : 0;
    constexpr int half = HALF;
            const int roff = half * MC;
            PH_BEGIN ph_rmsnorm(F, res_mix, roff, args.in[ib], XN); PH_END
            if constexpr (kind == 0) {
                PH_BEGIN { pg8::EpiF32 E{(float*)(ar + DA_DIN), 1024}; GEMM_CALL(pg8::EpiF32, E, XN, WB + DW_W1, MC, 1024, DM, DM, DM, (int)blockIdx.x); } PH_END
                PH_BEGIN ph_dsa_post1(F, half, args.in[ib + 2], args.in[ib + 3], args.in[ib + 4], args.in[ib + 5]); PH_END
                PH_BEGIN { pg8::EpiBf16R E = epi1((bf16*)(ar + DA_QL), 8192); E.T.base[1] = (bf16*)(ar + DA_QPE); E.T.ldc[1] = 1536; E.T.t0[1] = 32; E.T.base[2] = (bf16*)(ar + DA_QIDX); E.T.ldc[2] = 2048; E.T.t0[2] = 38; E.T.nseg = 3;
                    GEMM_CALL(pg8::EpiBf16R, E, ar + DA_CQN, WB + DW_W2, MC, 11776, 512, 512, 512, (int)blockIdx.x); } PH_END
                PH_BEGIN ph_dsa_rope(F, half); PH_END
                PH_BEGIN ph_dsa_index(F); PH_END
                PH_BEGIN ph_dsa_attn(F); PH_END
                PH_BEGIN { pg8::EpiRes E{res_mix, out, DM, roff}; GEMM_CALL(pg8::EpiRes, E, ar + DA_QL, WB + DW_WO, MC, DM, 8192, 8192, 8192, (int)blockIdx.x); } PH_END
            } else if constexpr (kind == 1) {
                PH_BEGIN { pg8::EpiBf16R E = epi1((bf16*)(ar + FA_Q), DM); E.T.base[1] = (bf16*)(ar + FA_K); E.T.ldc[1] = DM; E.T.t0[1] = 8; E.T.base[2] = (bf16*)(ar + FA_F); E.T.ldc[2] = 256; E.T.t0[2] = 16; E.T.nseg = 3;
                    GEMM_CALL(pg8::EpiBf16R, E, XN, WB + FW_IN, MC, 4352, DM, DM, DM, (int)blockIdx.x); } PH_END
                PH_BEGIN { pg8::EpiBf16R E = epi1((bf16*)(ar + FA_VT), MC); GEMM_CALL(pg8::EpiBf16R, E, WB + FW_V, XN, 2048, MC, DM, DM, DM, (int)blockIdx.x); } PH_END
                PH_BEGIN ph_fox_scan(F, args.in[ib + 2]); PH_END
                PH_BEGIN ph_fox_attn(F); PH_END
                PH_BEGIN { pg8::EpiRes E{res_mix, out, DM, roff}; GEMM_CALL(pg8::EpiRes, E, ar + FA_O, WB + FW_OUT, MC, DM, DM, DM, DM, (int)blockIdx.x); } PH_END
            } else {
                PH_BEGIN { pg8::EpiBf16R E = epi1((bf16*)(ar + NA_Q), 9216);
                    E.T.base[1] = (bf16*)(ar + NA_KC); E.T.ldc[1] = 192; E.T.t0[1] = 36; E.T.gw[1] = 192;
                    E.T.base[2] = (bf16*)(ar + NA_VC); E.T.ldc[2] = 128; E.T.t0[2] = 39; E.T.gw[2] = 128;
                    E.T.base[3] = (bf16*)(ar + NA_KS); E.T.ldc[3] = 768; E.T.t0[3] = 41;
                    E.T.base[4] = (bf16*)(ar + NA_KW); E.T.ldc[4] = 768; E.T.t0[4] = 44;
                    E.T.base[5] = (bf16*)(ar + NA_GT); E.T.ldc[5] = 256; E.T.t0[5] = 47; E.T.nseg = 6;
                    GEMM_CALL(pg8::EpiBf16R, E, XN, WB + NW_IN, MC, 12288, DM, DM, DM, (int)blockIdx.x); } PH_END
                PH_BEGIN { pg8::EpiBf16R E = epi1((bf16*)(ar + NA_VT2), MC); GEMM_CALL(pg8::EpiBf16R, E, WB + NW_V2, XN, 1024, MC, DM, DM, DM, (int)blockIdx.x); } PH_END
                PH_BEGIN ph_nsa_rope(F, half); PH_END
                PH_BEGIN {
                    const float* BIAS = (const float*)(args.ws + WS_MISC);
                    { pg8::EpiGelu E{(bf16*)(ar + NA_GK), 256, BIAS}; GEMM_CALL(pg8::EpiGelu, E, ar + NA_KC, WB + NW_W1K, 4096, 256, 6144, 3072, 6144, (int)blockIdx.x); }
                    { pg8::EpiGelu E{(bf16*)(ar + NA_GV), 256, BIAS + 256}; GEMM_CALL(pg8::EpiGelu, E, ar + NA_VC, WB + NW_W1V, 4096, 256, 4096, 2048, 4096, (int)((blockIdx.x + F.G - 16) % F.G)); }
                } PH_END
                PH_BEGIN {
                    { pg8::EpiBf16R E = epi1((bf16*)(ar + NA_KCMP), 256); GEMM_CALL(pg8::EpiBf16R, E, ar + NA_GK, WB + NW_W2K, 4096, 256, 256, 256, 256, (int)blockIdx.x); }
                    { pg8::EpiBf16R E = epi1((bf16*)(ar + NA_VCT), 4096); GEMM_CALL(pg8::EpiBf16R, E, WB + NW_W2V, ar + NA_GV, 256, 4096, 256, 256, 256, (int)((blockIdx.x + F.G - 16) % F.G)); }
                } PH_END
                PH_BEGIN ph_nsa_cmp(F); PH_END
                PH_BEGIN ph_nsa_sel(F); PH_END
                PH_BEGIN ph_nsa_win(F); PH_END
                PH_BEGIN { pg8::EpiRes E{res_mix, out, DM, roff}; GEMM_CALL(pg8::EpiRes, E, ar + NA_O, WB + NW_OUT, MC, DM, 6144, 6144, 6144, (int)blockIdx.x); } PH_END
            }
            PH_BEGIN ph_rmsnorm(F, out, roff, args.in[iff], XN); PH_END
            PH_BEGIN { pg8::EpiBf16R E = epi1((bf16*)ar, 2 * DFF); GEMM_CALL(pg8::EpiBf16R, E, XN, WUP, MC, 2 * DFF, DM, DM, DM, (int)blockIdx.x); } PH_END
            PH_BEGIN ph_conv_glu(F, (const bf16*)ar, (bf16*)(ar + 352 * MiB), args.in[iff + 2], args.in[iff + 3]); PH_END
            PH_BEGIN { pg8::EpiRes E{out, out, DM, roff}; GEMM_CALL(pg8::EpiRes, E, ar + 352 * MiB, WDN, MC, DM, DFF, DFF, DFF, (int)blockIdx.x); } PH_END
}
__global__ void __launch_bounds__(NWAVES * 64, 2) mk_fwd(Args args) {
    extern __shared__ __attribute__((aligned(16))) unsigned char lds_[];
    LAS unsigned char* const lds = (LAS unsigned char*)lds_;
    volatile LAS unsigned* MISC = (volatile LAS unsigned*)(lds + LDSCTL_OFF);
    for (int u = threadIdx.x; u < 64; u += NWAVES * 64) ((LAS unsigned*)(lds + LDSCTL_OFF))[u] = 0u;
    __syncthreads();
    const int lo = args.ph_lo, hi = args.ph_hi;
    (void)xcd_barrier_post((unsigned*)(args.ws + WS_CTL) + CW_BAR, MISC + 8);
    int ph = 0;
    { constexpr int ib = 2, iff = 12; PH_BEGIN ph_tables(F, (const int*)args.in[1]); PH_END }
    run_cvt<0>(args, lds, MISC, ph, lo, hi); run_half<0, 0>(args, lds, MISC, ph, lo, hi); run_half<0, 1>(args, lds, MISC, ph, lo, hi);
    run_cvt<1>(args, lds, MISC, ph, lo, hi); run_half<1, 0>(args, lds, MISC, ph, lo, hi); run_half<1, 1>(args, lds, MISC, ph, lo, hi);
    run_cvt<2>(args, lds, MISC, ph, lo, hi); run_half<2, 0>(args, lds, MISC, ph, lo, hi); run_half<2, 1>(args, lds, MISC, ph, lo, hi);
    run_cvt<3>(args, lds, MISC, ph, lo, hi); run_half<3, 0>(args, lds, MISC, ph, lo, hi); run_half<3, 1>(args, lds, MISC, ph, lo, hi);
    { constexpr int ib = 42, iff = 52; PH_BEGIN ph_final_norm(F, out, args.in[57]); PH_END }
}
extern "C" void kernel_launch(void* const* d_in, const int* in_sizes, int n_in, void* d_out, int out_size, void* d_ws, size_t ws_size, hipStream_t stream) {
    static int grid = 0;
    if (grid == 0) {
        if (n_in != 58 || out_size != MTOT * DM || ws_size < WS_END) { fprintf(stderr, "kernel_launch: unexpected shapes (n_in %d, out %d, ws %zu)\n", n_in, out_size, ws_size); grid = -1; return; }
        int dev = 0, cus = 0;
        if (hipGetDevice(&dev) != hipSuccess || hipDeviceGetAttribute(&cus, hipDeviceAttributeMultiprocessorCount, dev) != hipSuccess) { grid = -1; return; }
        if (hipFuncSetAttribute((const void*)mk_fwd, hipFuncAttributeMaxDynamicSharedMemorySize, LDS_BYTES) != hipSuccess) { fprintf(stderr, "kernel_launch: hipFuncSetAttribute failed\n"); grid = -1; return; }
        int per_cu = 0;
        (void)hipOccupancyMaxActiveBlocksPerMultiprocessor(&per_cu, (const void*)mk_fwd, NWAVES * 64, LDS_BYTES);
        (void)hipGetLastError();
        grid = cus;
    }
    if (grid < 0) return;
    if (hipMemsetAsync((char*)d_ws + WS_CTL, 0, CTL_ZERO_BYTES, stream) != hipSuccess) return;
    Args a{};
    for (int i = 0; i < 58; ++i) a.in[i] = (const float*)d_in[i];
    a.out = (float*)d_out; a.ws = (unsigned char*)d_ws;
#if MK_ONE_LAUNCH
    a.ph_lo = 0; a.ph_hi = NPH;
    hipLaunchKernelGGL(mk_fwd, dim3(grid), dim3(NWAVES * 64), LDS_BYTES, stream, a);
#else
    for (int p = 0; p < NPH; ++p) { a.ph_lo = p; a.ph_hi = p + 1; hipLaunchKernelGGL(mk_fwd, dim3(grid), dim3(NWAVES * 64), LDS_BYTES, stream, a); }
#endif
}
```

```cpp
#include <hip/hip_runtime.h>
#include <cstdio>
#include <cstdint>
#define DI __device__ __forceinline__
namespace pg8 {
#define PG8_LAS __attribute__((address_space(3)))
typedef unsigned short bf16_t;
typedef short bf16x8 __attribute__((ext_vector_type(8)));
typedef float f32x4 __attribute__((ext_vector_type(4)));
typedef unsigned u32x4 __attribute__((ext_vector_type(4)));
constexpr int BM = 256, BK = 64, HALF = 128, HTB = HALF * BK * 2  , STAGE_BYTES = 8 * HTB, NXCD = 8, WGM = 8;

__host__ __device__ __forceinline__ int lds_byte(int r, int c) { const int st = (r >> 4) * 2 + (c >> 5), rr = r & 15, cc = c & 31, ob = rr * 64 + cc * 2; return st * 1024 + (ob ^ (((ob >> 9) & 1) << 5)); }
__host__ __device__ __forceinline__ void stage_rc(int b, int& R, int& C) { const int st = b / 1024, sb = b % 1024, swz = sb ^ (((sb >> 9) & 1) << 5); R = (st >> 1) * 16 + swz / 64; C = (st & 1) * 32 + (swz % 64) / 2; }
__host__ __device__ __forceinline__ int perm32(int rho) { const int n = rho >> 4, i = rho & 15; return 8 * (i >> 2) + 4 * n + (i & 3); }

struct Unit { int pm, pn; };
struct Gemm { const bf16_t* A; const bf16_t* Bt; int M, N, K, lda, ldb; };

struct StaticOrder {
    int nM, nN, nwg, G, c;
    __host__ __device__ void init(int M, int N, int G_, int c_) { nM = M / BM; nN = N / BM; nwg = nM * nN; G = G_; c = c_; }
    __host__ __device__ bool next(int i, Unit& u) const {
        const long L = (long)i * G + c; if (L >= nwg) return false;
        int wgid = (int)L; { const int q = nwg / NXCD, r = nwg % NXCD, xcd = wgid % NXCD, off = wgid / NXCD; wgid = (xcd < r ? xcd * (q + 1) : r * (q + 1) + (xcd - r) * q) + off; }
        const int nig = WGM * nN, gid = wgid / nig, fm = gid * WGM, gsz = (nM - fm) < WGM ? (nM - fm) : WGM;
        u.pm = fm + ((wgid % nig) % gsz); u.pn = (wgid % nig) / gsz; return true;
    }
    __device__ __forceinline__ void a_ready(const Unit&) const {}
    __device__ __forceinline__ void done(const Unit&) const {}
};
__device__ __forceinline__ unsigned cvt_pk_bf16(float lo, float hi) { unsigned r; asm volatile("v_cvt_pk_bf16_f32 %0, %1, %2" : "=v"(r) : "v"(lo), "v"(hi)); return r; }
template <class Epi, class Sched, bool ALIGN_EPI = false, bool SP2 = false>
__device__ __forceinline__ void gemm_phase(PG8_LAS unsigned char* lds, const Gemm g, const Sched& S, const Epi& E) {
    const int tid = threadIdx.x, wid = __builtin_amdgcn_readfirstlane(tid >> 6), lane = tid & 63, wr = wid >> 2, wc = wid & 3, fr = lane & 15, fq = lane >> 4;
    const int K = g.K, nt = K / BK;
    unsigned voffA[2], voffB[2];
#pragma unroll
    for (int i = 0; i < 2; ++i) { int R, C; stage_rc(tid * 16 + i * 8192, R, C); const int Rb = Epi::PERM ? ((R & ~31) + perm32(R & 31)) : R;
        voffA[i] = (unsigned)(R * g.lda + C) * 2u; voffB[i] = (unsigned)(Rb * g.ldb + C) * 2u; }
    const size_t kstep = (size_t)(BK * 2);
    const size_t hstepA = (size_t)HALF * g.lda * 2, hstepB = (size_t)HALF * g.ldb * 2;
    const size_t tstepA = 2 * hstepA, tstepB = 2 * hstepB;
    const unsigned ldsw = (unsigned)wid * 1024u;
    const int aoff = lds_byte(wr * 64 + fr, fq * 8), boff = lds_byte(wc * 32 + fr, fq * 8);
#define PG8_SA(b, h) (((b) * 2 + (h)) * HTB)
#define PG8_SB(b, h) ((4 + (b) * 2 + (h)) * HTB)
#define PG8_STAGE(bufoff, gbase, voff) do { _Pragma("unroll") for (int _i = 0; _i < 2; ++_i) \
        __builtin_amdgcn_global_load_lds((const unsigned*)((const char*)(gbase) + (voff)[_i]), (PG8_LAS unsigned*)(lds + (bufoff) + ldsw + _i * 8192), 16, 0, 0); } while (0)
#define PG8_LDA(dst, b, h) do { _Pragma("unroll") for (int m = 0; m < 4; ++m) _Pragma("unroll") for (int k = 0; k < 2; ++k) dst[m][k] = *(const PG8_LAS bf16x8*)(lds + PG8_SA(b, h) + aoff + m * 2048 + k * 1024); } while (0)
#define PG8_LDB(dst, b, h) do { _Pragma("unroll") for (int n = 0; n < 2; ++n) _Pragma("unroll") for (int k = 0; k < 2; ++k) dst[n][k] = *(const PG8_LAS bf16x8*)(lds + PG8_SB(b, h) + boff + n * 2048 + k * 1024); } while (0)
#define PG8_MMA(ai, bj, At, Bt) do { __builtin_amdgcn_s_setprio(1); _Pragma("unroll") for (int m = 0; m < 4; ++m) _Pragma("unroll") for (int n = 0; n < 2; ++n) _Pragma("unroll") for (int k = 0; k < 2; ++k) \
        acc[ai][bj][m][n] = __builtin_amdgcn_mfma_f32_16x16x32_bf16(Bt[n][k], At[m][k], acc[ai][bj][m][n], 0, 0, 0); __builtin_amdgcn_s_setprio(0); } while (0)
#define PG8_WAIT_V(n) asm volatile("s_waitcnt vmcnt(" #n ")" ::: "memory")
#define PG8_WAIT_L(n) asm volatile("s_waitcnt lgkmcnt(" #n ")" ::: "memory")
#define PG8_BAR __builtin_amdgcn_s_barrier()
#define PG8_SCHED __builtin_amdgcn_sched_barrier(0)
    Unit cur, nxt; int ui = 0;
    if (!S.next(0, cur)) return;
    f32x4 acc[2][2][4][2];
#pragma unroll
    for (int a = 0; a < 2; ++a)
#pragma unroll
        for (int b = 0; b < 2; ++b)
#pragma unroll
            for (int m = 0; m < 4; ++m)
#pragma unroll
                for (int n = 0; n < 2; ++n) acc[a][b][m][n] = (f32x4){0.f, 0.f, 0.f, 0.f};
    bf16x8 At[4][2], B0[2][2], B1[2][2];
    const char* cA = (const char*)g.A + (size_t)cur.pm * tstepA; const char* cB = (const char*)g.Bt + (size_t)cur.pn * tstepB;
    S.a_ready(cur);
    if constexpr (SP2) {
        PG8_STAGE(PG8_SB(0, 0), cB, voffB); PG8_STAGE(PG8_SB(0, 1), cB + hstepB, voffB); PG8_STAGE(PG8_SA(0, 0), cA, voffA); PG8_STAGE(PG8_SA(0, 1), cA + hstepA, voffA);
        if (wr == 1) PG8_BAR;
        PG8_WAIT_V(2); PG8_BAR;
        PG8_STAGE(PG8_SB(1, 0), cB + kstep, voffB); PG8_STAGE(PG8_SA(1, 0), cA + kstep, voffA); PG8_STAGE(PG8_SB(1, 1), cB + hstepB + kstep, voffB);
        PG8_WAIT_V(6); PG8_BAR;
    } else {
        PG8_STAGE(PG8_SB(0, 0), cB, voffB); PG8_STAGE(PG8_SA(0, 0), cA, voffA); PG8_STAGE(PG8_SB(0, 1), cB + hstepB, voffB); PG8_STAGE(PG8_SA(0, 1), cA + hstepA, voffA);
        if (wr == 1) PG8_BAR;
        PG8_WAIT_V(4); PG8_BAR;
        PG8_STAGE(PG8_SB(1, 0), cB + kstep, voffB); PG8_STAGE(PG8_SA(1, 0), cA + kstep, voffA); PG8_STAGE(PG8_SB(1, 1), cB + hstepB + kstep, voffB);
        PG8_WAIT_V(6); PG8_BAR;
    }
    for (;;) {
        const bool has_next = S.next(ui + 1, nxt);
        const char* nA = has_next ? (const char*)g.A + (size_t)nxt.pm * tstepA : cA; const char* nB = has_next ? (const char*)g.Bt + (size_t)nxt.pn * tstepB : cB;
        for (int t = 0; t < nt; t += 2) {
            const bool last = (t == nt - 2);
            const char* a1 = cA + (size_t)(t + 1) * kstep;
            const char* a2 = last ? nA : cA + (size_t)(t + 2) * kstep; const char* b2 = last ? nB : cB + (size_t)(t + 2) * kstep;
            const char* a3 = a2 + kstep; const char* b3 = b2 + kstep;
            if (last && has_next) S.a_ready(nxt);
            if constexpr (SP2) {
            PG8_LDB(B0, 0, 0); PG8_LDB(B1, 0, 1); PG8_SCHED; PG8_LDA(At, 0, 0); PG8_STAGE(PG8_SA(1, 1), a1 + hstepA, voffA);
            PG8_WAIT_V(8); PG8_WAIT_L(0); PG8_BAR; PG8_MMA(0, 0, At, B0); PG8_MMA(0, 1, At, B1); PG8_BAR; PG8_SCHED;
            PG8_LDA(At, 0, 1); PG8_STAGE(PG8_SB(0, 0), b2, voffB); PG8_STAGE(PG8_SB(0, 1), b2 + hstepB, voffB); PG8_STAGE(PG8_SA(0, 0), a2, voffA);
            PG8_WAIT_V(8); PG8_WAIT_L(0); PG8_BAR; PG8_MMA(1, 0, At, B0); PG8_MMA(1, 1, At, B1); PG8_BAR; PG8_SCHED;
            PG8_LDB(B0, 1, 0); PG8_LDB(B1, 1, 1); PG8_SCHED; PG8_LDA(At, 1, 0); PG8_STAGE(PG8_SA(0, 1), a2 + hstepA, voffA);
            PG8_WAIT_V(8); PG8_WAIT_L(0); PG8_BAR; PG8_MMA(0, 0, At, B0); PG8_MMA(0, 1, At, B1); PG8_BAR; PG8_SCHED;
            PG8_LDA(At, 1, 1); PG8_STAGE(PG8_SB(1, 0), b3, voffB); PG8_STAGE(PG8_SB(1, 1), b3 + hstepB, voffB); PG8_STAGE(PG8_SA(1, 0), a3, voffA);
            PG8_WAIT_V(8); PG8_WAIT_L(0); PG8_BAR; PG8_MMA(1, 0, At, B0); PG8_MMA(1, 1, At, B1); PG8_BAR; PG8_SCHED;
            } else {
            PG8_LDB(B0, 0, 0); PG8_SCHED; PG8_LDA(At, 0, 0); PG8_STAGE(PG8_SA(1, 1), a1 + hstepA, voffA);
            PG8_WAIT_L(8); PG8_BAR; PG8_WAIT_L(0); PG8_MMA(0, 0, At, B0); PG8_BAR; PG8_SCHED;
            PG8_LDB(B1, 0, 1); PG8_STAGE(PG8_SB(0, 0), b2, voffB);
            PG8_BAR; PG8_WAIT_L(0); PG8_MMA(0, 1, At, B1); PG8_BAR;
            PG8_LDA(At, 0, 1); PG8_STAGE(PG8_SA(0, 0), a2, voffA);
            PG8_BAR; PG8_WAIT_L(0); PG8_MMA(1, 0, At, B0); PG8_BAR; PG8_SCHED;
            PG8_STAGE(PG8_SB(0, 1), b2 + hstepB, voffB);
            PG8_WAIT_V(6); PG8_BAR; PG8_MMA(1, 1, At, B1); PG8_BAR;
            PG8_LDB(B0, 1, 0); PG8_SCHED; PG8_LDA(At, 1, 0); PG8_STAGE(PG8_SA(0, 1), a2 + hstepA, voffA);
            PG8_WAIT_L(8); PG8_BAR; PG8_WAIT_L(0); PG8_MMA(0, 0, At, B0); PG8_BAR; PG8_SCHED;
            PG8_LDB(B1, 1, 1); PG8_STAGE(PG8_SB(1, 0), b3, voffB);
            PG8_BAR; PG8_WAIT_L(0); PG8_MMA(0, 1, At, B1); PG8_BAR;
            PG8_LDA(At, 1, 1); PG8_STAGE(PG8_SA(1, 0), a3, voffA);
            PG8_BAR; PG8_WAIT_L(0); PG8_MMA(1, 0, At, B0); PG8_BAR; PG8_SCHED;
            PG8_STAGE(PG8_SB(1, 1), b3 + hstepB, voffB);
            PG8_WAIT_V(6); PG8_BAR; PG8_MMA(1, 1, At, B1); PG8_BAR;
            }
        }
        if constexpr (ALIGN_EPI) { if (wr == 0) PG8_BAR; }
        if constexpr (!Epi::AFTER_DRAIN) { E(acc, cur, wr, wc, fr, fq); S.done(cur); }
        if (!has_next) break;
#pragma unroll
        for (int a = 0; a < 2; ++a)
#pragma unroll
            for (int b = 0; b < 2; ++b)
#pragma unroll
                for (int m = 0; m < 4; ++m)
#pragma unroll
                    for (int n = 0; n < 2; ++n) acc[a][b][m][n] = (f32x4){0.f, 0.f, 0.f, 0.f};
        cur = nxt; cA = nA; cB = nB; ++ui;
        if constexpr (ALIGN_EPI) { if (wr == 1) PG8_BAR; }
    }
    PG8_WAIT_V(0);
    if constexpr (!ALIGN_EPI) { if (wr == 0) PG8_BAR; }
    PG8_BAR;
    if constexpr (Epi::AFTER_DRAIN) { E.fused(acc, cur, wr, wc, fr, fq, lds, wid, lane); S.done(cur); }
#undef PG8_SA
#undef PG8_SB
#undef PG8_STAGE
#undef PG8_LDA
#undef PG8_LDB
#undef PG8_MMA
#undef PG8_WAIT_V
#undef PG8_WAIT_L
#undef PG8_BAR
#undef PG8_SCHED
}
}
namespace pg8 {
typedef float f32x2 __attribute__((ext_vector_type(2)));
struct SegTab { bf16_t* base[8]; int ldc[8]; int t0[8]; int gw[8]; int nseg; int pad_; };
struct EpiBf16R {
    static constexpr bool PERM = true, AFTER_DRAIN = false;
    SegTab T;
    __device__ __forceinline__ void operator()(const f32x4 (&acc)[2][2][4][2], const Unit& u, int wr, int wc, int fr, int fq) const {
        bf16_t* base = T.base[0]; int ldc = T.ldc[0], gw = T.gw[0], t0 = T.t0[0];
#pragma unroll
        for (int s = 1; s < 8; ++s) if (s < T.nseg && u.pn >= T.t0[s]) { base = T.base[s]; ldc = T.ldc[s]; gw = T.gw[s]; t0 = T.t0[s]; }
        const int colt = (u.pn - t0) * BM, row0 = u.pm * BM + wr * 64 + fr;
#pragma unroll
        for (int ai = 0; ai < 2; ++ai)
#pragma unroll
            for (int m = 0; m < 4; ++m) { const int row = row0 + ai * HALF + m * 16;
#pragma unroll
                for (int bj = 0; bj < 2; ++bj) { const int col = colt + bj * HALF + wc * 32 + 8 * fq;
                    bf16_t* dst;
                    if (gw == 0) dst = base + (size_t)row * ldc + col;
                    else { const int g = col / gw, d = col - g * gw; dst = base + ((size_t)((row >> 12) * 4 + g) * 4096 + (row & 4095)) * gw + d; }
                    const f32x4 v0 = acc[ai][bj][m][0], v1 = acc[ai][bj][m][1];
                    u32x4 w; w.x = cvt_pk_bf16(v0[0], v0[1]); w.y = cvt_pk_bf16(v0[2], v0[3]); w.z = cvt_pk_bf16(v1[0], v1[1]); w.w = cvt_pk_bf16(v1[2], v1[3]);
                    *(u32x4*)dst = w; } }
    }
};
struct EpiGelu {
    static constexpr bool PERM = true, AFTER_DRAIN = false;
    bf16_t* O; int ldc; const float* bias;
    static __device__ __forceinline__ float gelu(float x) { const float u2 = 1.5957691216f * (x + 0.044715f * x * x * x); const float e = __builtin_amdgcn_exp2f(-u2 * 1.4426950409f); return x * __builtin_amdgcn_rcpf(1.0f + e); }
    __device__ __forceinline__ void operator()(const f32x4 (&acc)[2][2][4][2], const Unit& u, int wr, int wc, int fr, int fq) const {
        const int row0 = u.pm * BM + wr * 64 + fr, col0 = u.pn * BM + wc * 32 + 8 * fq;
#pragma unroll
        for (int bj = 0; bj < 2; ++bj) { const f32x4 b0 = *(const f32x4*)(bias + col0 + bj * HALF), b1 = *(const f32x4*)(bias + col0 + bj * HALF + 4);
#pragma unroll
            for (int ai = 0; ai < 2; ++ai)
#pragma unroll
                for (int m = 0; m < 4; ++m) { const f32x4 v0 = acc[ai][bj][m][0] + b0, v1 = acc[ai][bj][m][1] + b1;
                    u32x4 w; w.x = cvt_pk_bf16(gelu(v0[0]), gelu(v0[1])); w.y = cvt_pk_bf16(gelu(v0[2]), gelu(v0[3])); w.z = cvt_pk_bf16(gelu(v1[0]), gelu(v1[1])); w.w = cvt_pk_bf16(gelu(v1[2]), gelu(v1[3]));
                    *(u32x4*)(O + (size_t)(row0 + ai * HALF + m * 16) * ldc + col0 + bj * HALF) = w; } }
    }
};
struct EpiF32 {
    static constexpr bool PERM = false, AFTER_DRAIN = false;
    float* C; int ldc;
    __device__ __forceinline__ void operator()(const f32x4 (&acc)[2][2][4][2], const Unit& u, int wr, int wc, int fr, int fq) const {
        const int row0 = u.pm * BM + wr * 64 + fr, col0 = u.pn * BM + wc * 32 + 4 * fq;
#pragma unroll
        for (int ai = 0; ai < 2; ++ai)
#pragma unroll
            for (int m = 0; m < 4; ++m) { float* rowp = C + (size_t)(row0 + ai * HALF + m * 16) * ldc + col0;
#pragma unroll
                for (int bj = 0; bj < 2; ++bj)
#pragma unroll
                    for (int n = 0; n < 2; ++n) *(f32x4*)(rowp + bj * HALF + n * 16) = acc[ai][bj][m][n]; }
    }
};
struct EpiRes {
    static constexpr bool PERM = false, AFTER_DRAIN = false;
    const float* res; float* out; int ldc; int row_off;
    __device__ __forceinline__ void operator()(const f32x4 (&acc)[2][2][4][2], const Unit& u, int wr, int wc, int fr, int fq) const {
        const int row0 = row_off + u.pm * BM + wr * 64 + fr, col0 = u.pn * BM + wc * 32 + 4 * fq;
#pragma unroll
        for (int ai = 0; ai < 2; ++ai)
#pragma unroll
            for (int m = 0; m < 4; ++m) { const size_t off = (size_t)(row0 + ai * HALF + m * 16) * ldc + col0;
                f32x4 r[2][2];
#pragma unroll
                for (int bj = 0; bj < 2; ++bj)
#pragma unroll
                    for (int n = 0; n < 2; ++n) r[bj][n] = *(const f32x4*)(res + off + bj * HALF + n * 16);
#pragma unroll
                for (int bj = 0; bj < 2; ++bj)
#pragma unroll
                    for (int n = 0; n < 2; ++n) *(f32x4*)(out + off + bj * HALF + n * 16) = r[bj][n] + acc[ai][bj][m][n];
                asm volatile("" ::: "memory"); }
    }
};
struct EpiDry {
    static constexpr bool PERM = false, AFTER_DRAIN = false;
    float* D;
    __device__ __forceinline__ void operator()(const f32x4 (&acc)[2][2][4][2], const Unit& u, int wr, int wc, int fr, int fq) const {
        float* p = D + ((size_t)blockIdx.x * 512 + threadIdx.x) * 64;
#pragma unroll
        for (int ai = 0; ai < 2; ++ai)
#pragma unroll
            for (int m = 0; m < 4; ++m)
#pragma unroll
                for (int bj = 0; bj < 2; ++bj) *(f32x4*)(p + ((ai * 4 + m) * 2 + bj) * 4) = acc[ai][bj][m][0] + acc[ai][bj][m][1];
    }
};
}
constexpr int BATCH = 8, SEQ = 4096, DM = 2048, MTOT = BATCH * SEQ, MC = MTOT / 2  , BPH = BATCH / 2;
constexpr int DFF = 5632;
constexpr float NORM_EPS = 1e-6f, LOG2E = 1.4426950408889634f;
constexpr int NWAVES = 8;
constexpr size_t MiB = 1u << 20;
constexpr size_t WS_CTL = 0, CTL_ZERO_BYTES = 1 * MiB;
constexpr size_t WS_TAB = 1 * MiB;
constexpr size_t TAB_COS48 = WS_TAB, TAB_SIN48 = WS_TAB + 3 * MiB, TAB_COS32 = WS_TAB + 6 * MiB, TAB_SIN32 = WS_TAB + 8 * MiB;
constexpr size_t WS_WMIX = 12 * MiB;
constexpr size_t WS_WFFN = 100 * MiB;
constexpr size_t WS_MISC = 168 * MiB;
constexpr size_t WS_XN = 170 * MiB;
constexpr size_t WS_AR = 234 * MiB;
constexpr size_t WS_END = 1010 * MiB;
constexpr size_t DUMMY_OFF = 700 * MiB;
constexpr int CW_TMO = 0;
constexpr int CW_BAR = 4096;
constexpr int RING_BYTES = 131072;
constexpr int LDSCTL_OFF = 135168;
constexpr int LDS_BYTES = 147456;

#define GAS __attribute__((address_space(1)))
#define LAS __attribute__((address_space(3)))
typedef unsigned short bf16;
typedef unsigned u32x4 __attribute__((ext_vector_type(4)));
typedef unsigned u32x2 __attribute__((ext_vector_type(2)));
typedef float f32x4 __attribute__((ext_vector_type(4)));
typedef float f32x16 __attribute__((ext_vector_type(16)));
typedef short bf16x8 __attribute__((ext_vector_type(8)));
typedef short s16x4 __attribute__((ext_vector_type(4)));
typedef short v4i16_t __attribute__((ext_vector_type(4)));
typedef __bf16 bf16x2_t __attribute__((ext_vector_type(2)));
typedef float f32x2_t __attribute__((ext_vector_type(2)));
#define LDS_WAIT() asm volatile("s_waitcnt lgkmcnt(0)" ::: "memory")
#define VM_WAIT() asm volatile("s_waitcnt vmcnt(0)" ::: "memory")
#define MFMA32(a, b, c) __builtin_amdgcn_mfma_f32_32x32x16_bf16((a), (b), (c), 0, 0, 0)
DI unsigned pk2(float lo, float hi) { f32x2_t v = {lo, hi}; bf16x2_t b = __builtin_convertvector(v, bf16x2_t); return __builtin_bit_cast(unsigned, b); }
DI float bf2f(unsigned short b) { return __builtin_bit_cast(float, (unsigned)b << 16); }
DI float bflo(unsigned w) { return __builtin_bit_cast(float, w << 16); }
DI float bfhi(unsigned w) { return __builtin_bit_cast(float, w & 0xffff0000u); }
DI unsigned short f2bf(float f) { return (unsigned short)(pk2(f, 0.f) & 0xffffu); }
DI float wave_sum(float v) {
#pragma unroll
    for (int o = 1; o < 64; o <<= 1) v += __shfl_xor(v, o);
    return v;
}
DI int crow(int i, int h) { return (i & 3) + 8 * (i >> 2) + 4 * h; }
#define XB_TMO      128
#define XB_XCNT(j)  (256  + 64 * (j))
#define XB_XSUB(j)  (1280 + 64 * (j))
#define XB_XGEN(j)  (2304 + 64 * (j))
#define XB_TOP      3328
#define XB_TOPGEN   3392
#define XCD_BAR_WORDS 3456
#define XB_SPIN_CAP (1u << 18)

__device__ __forceinline__ unsigned xb_ld(unsigned* p)              { return __hip_atomic_load(p, __ATOMIC_RELAXED, __HIP_MEMORY_SCOPE_AGENT); }
__device__ __forceinline__ unsigned xb_add(unsigned* p, unsigned v) { return __hip_atomic_fetch_add(p, v, __ATOMIC_RELAXED, __HIP_MEMORY_SCOPE_AGENT); }
__device__ __forceinline__ unsigned xb_xcc_id() { return (unsigned)__builtin_amdgcn_s_getreg((3 << 11) | 20) & 0xFu; }
#define XB_SPIN(cond, bar) do { unsigned _sp = 0; while (cond) { __builtin_amdgcn_s_sleep(1); \
    if ((++_sp & 255u) == 0u) { if (xb_ld(&(bar)[XB_TMO])) break; if (_sp > XB_SPIN_CAP) { atomicAdd(&(bar)[XB_TMO], 1u); break; } } } } while (0)

struct XcdBarrier {
    unsigned* bar; unsigned x;
    volatile LAS unsigned* st;
};

__device__ __forceinline__ XcdBarrier xcd_barrier_post(unsigned* bar, volatile LAS unsigned* st) {
    XcdBarrier b; b.bar = bar; b.x = xb_xcc_id(); b.st = st;
    if (threadIdx.x == 0) (void)xb_add(&bar[XB_XCNT(b.x)], 1u);
    return b;
}
__device__ __forceinline__ void xcd_barrier_complete(unsigned* bar, unsigned x, unsigned& nloc, unsigned& nx) {
    const unsigned G = gridDim.x * gridDim.y * gridDim.z;
    unsigned sum, cnt, mine, sp = 0u;
    for (;;) {
        sum = 0u; cnt = 0u; mine = 0u;
#pragma unroll
        for (unsigned j = 0; j < 16; ++j) { const unsigned c = xb_ld(&bar[XB_XCNT(j)]); sum += c; cnt += (c > 0u) ? 1u : 0u; mine = (j == x) ? c : mine; }
        if (sum == G) break;
        __builtin_amdgcn_s_sleep(1);
        if ((++sp & 255u) == 0u) { if (xb_ld(&bar[XB_TMO])) break; if (sp > XB_SPIN_CAP) { atomicAdd(&bar[XB_TMO], 1u); break; } }
    }
    nloc = mine > 0u ? mine : 1u; nx = cnt > 0u ? cnt : 1u;
}

__device__ __forceinline__ void xcd_barrier(const XcdBarrier& b) {
    asm volatile("s_waitcnt vmcnt(0)" ::: "memory");
    __syncthreads();
    if (threadIdx.x == 0) {
        unsigned* bar = b.bar;
        __builtin_amdgcn_s_waitcnt(0);
        unsigned nloc = b.st[0], nx = b.st[1];
        if (nloc == 0u) { xcd_barrier_complete(bar, b.x, nloc, nx); b.st[0] = nloc; b.st[1] = nx; }
        const unsigned old = xb_add(&bar[XB_XSUB(b.x)], 1u);
        const unsigned gen = old / nloc;
        if (old + 1u == (gen + 1u) * nloc) {
            __builtin_amdgcn_fence(__ATOMIC_RELEASE, "agent");
            asm volatile("s_waitcnt vmcnt(0)" ::: "memory");
            const unsigned og = xb_add(&bar[XB_TOP], 1u);
            const unsigned tg = og / nx;
            if (og + 1u == (tg + 1u) * nx) xb_add(&bar[XB_TOPGEN], 1u);
            else XB_SPIN(xb_ld(&bar[XB_TOPGEN]) == tg, bar);
            __builtin_amdgcn_fence(__ATOMIC_ACQUIRE, "agent");
            xb_add(&bar[XB_XGEN(b.x)], 1u);
            asm volatile("s_waitcnt vmcnt(0)" ::: "memory");
        } else {
            XB_SPIN(xb_ld(&bar[XB_XGEN(b.x)]) == gen, bar);
            __builtin_amdgcn_fence(__ATOMIC_ACQUIRE, "agent");
            asm volatile("s_waitcnt vmcnt(0)" ::: "memory");
        }
    }
    __syncthreads();
}
struct Frame {
    LAS unsigned char* lds; unsigned* ctl; unsigned char* ws;
    int tid, lane, wave, G, gw, NGW;
};
DI void ph_tables(const Frame& F, const int* pos) {
    float* c48 = (float*)(F.ws + TAB_COS48); float* s48 = (float*)(F.ws + TAB_SIN48); float* c32 = (float*)(F.ws + TAB_COS32); float* s32 = (float*)(F.ws + TAB_SIN32);
    const int gt = blockIdx.x * (NWAVES * 64) + F.tid, NT = F.G * NWAVES * 64;
    for (int i = gt; i < MTOT * 40; i += NT) {
        const int m = i / 40, j = i - m * 40; const float p = (float)pos[m];
        const bool a = j < 24; const int jj = a ? j : j - 24;
        const float inv = (float)exp(-(2.0 * jj / (a ? 48.0 : 32.0)) * 13.122363377404328);
        const float ang = p * inv; float sn, cs; sincosf(ang, &sn, &cs);
        if (a) { c48[m * 24 + jj] = cs; s48[m * 24 + jj] = sn; } else { c32[m * 16 + jj] = cs; s32[m * 16 + jj] = sn; }
    }
}
DI void cvt_item(const float* W, int ldw, int col0, int ncols, bf16* WT, int ldt, int row_off, float scale, LAS float* scr, int item, int nblk, int lane) {
    const int kb = item / nblk, nb = item - kb * nblk, k0 = 64 * kb, n0 = 32 * nb;
    const int nn = n0 + (lane & 31); const bool ok = nn < ncols;
#pragma unroll 8
    for (int i = 0; i < 32; ++i) { const int kk = 2 * i + (lane >> 5); scr[kk * 33 + (lane & 31)] = ok ? W[(size_t)(k0 + kk) * ldw + col0 + nn] * scale : 0.f; }
    LDS_WAIT();
    const int c = lane & 7;
#pragma unroll
    for (int j = 0; j < 4; ++j) { const int n = (lane >> 3) + 8 * j; const LAS float* s = scr + (8 * c) * 33 + n;
        u32x4 o; o.x = pk2(s[0 * 33], s[1 * 33]); o.y = pk2(s[2 * 33], s[3 * 33]); o.z = pk2(s[4 * 33], s[5 * 33]); o.w = pk2(s[6 * 33], s[7 * 33]);
        if (n0 + n < ncols) *(u32x4*)(WT + (size_t)(row_off + n0 + n) * ldt + k0 + 8 * c) = o; }
    LDS_WAIT();
}
DI void cvt_job(const Frame& F, const float* W, int ldw, int K, int col0, int ncols, bf16* WT, int ldt, int row_off, float scale) {
    LAS float* scr = (LAS float*)(F.lds + F.wave * 16384);
    const int nblk = (ncols + 31) / 32, nitems = (K / 64) * nblk;
    for (int it = F.gw; it < nitems; it += F.NGW) cvt_item(W, ldw, col0, ncols, WT, ldt, row_off, scale, scr, it, nblk, F.lane);
}
DI void zero_bf16(const Frame& F, bf16* p, size_t nelem) {
    const size_t gt = (size_t)blockIdx.x * (NWAVES * 64) + F.tid, NT = (size_t)F.G * NWAVES * 64;
    for (size_t i = gt; i < nelem / 8; i += NT) ((u32x4*)p)[i] = (u32x4){0u, 0u, 0u, 0u};
}
DI void ph_cvt_ffn(const Frame& F, const float* up, const float* down) {
    bf16* WUP = (bf16*)(F.ws + WS_WFFN); bf16* WDN = WUP + (size_t)2 * DFF * DM;
    cvt_job(F, up, 2 * DFF, DM, 0, 2 * DFF, WUP, DM, 0, 1.f);
    cvt_job(F, down, DM, DFF, 0, DM, WDN, DFF, 0, 1.f);
}
DI void ph_rmsnorm(const Frame& F, const float* src, int row_off, const float* gain, bf16* XN) {
    f32x4 g[8];
#pragma unroll
    for (int j = 0; j < 8; ++j) g[j] = *(const f32x4*)(gain + 4 * (F.lane + 64 * j));
    for (int ml = F.gw; ml < MC; ml += F.NGW) {
        const f32x4* xr = (const f32x4*)(src + (size_t)(row_off + ml) * DM) + F.lane;
        f32x4 v[8]; float ss = 0.f;
#pragma unroll
        for (int j = 0; j < 8; ++j) { v[j] = xr[64 * j]; ss += (v[j].x * v[j].x + v[j].y * v[j].y) + (v[j].z * v[j].z + v[j].w * v[j].w); }
        const float rstd = 1.0f / sqrtf(wave_sum(ss) * (1.f / DM) + NORM_EPS);
        u32x2* o = (u32x2*)(XN + (size_t)ml * DM) + F.lane;
#pragma unroll
        for (int j = 0; j < 8; ++j) { const f32x4 y = v[j] * rstd * g[j]; u32x2 w; w.x = pk2(y.x, y.y); w.y = pk2(y.z, y.w); o[64 * j] = w; }
    }
}
DI void ph_final_norm(const Frame& F, float* h, const float* gain) {
    f32x4 g[8];
#pragma unroll
    for (int j = 0; j < 8; ++j) g[j] = *(const f32x4*)(gain + 4 * (F.lane + 64 * j));
    for (int m = F.gw; m < MTOT; m += F.NGW) {
        f32x4* xr = (f32x4*)(h + (size_t)m * DM) + F.lane;
        f32x4 v[8]; float ss = 0.f;
#pragma unroll
        for (int j = 0; j < 8; ++j) { v[j] = xr[64 * j]; ss += (v[j].x * v[j].x + v[j].y * v[j].y) + (v[j].z * v[j].z + v[j].w * v[j].w); }
        const float rstd = 1.0f / sqrtf(wave_sum(ss) * (1.f / DM) + NORM_EPS);
#pragma unroll
        for (int j = 0; j < 8; ++j) xr[64 * j] = v[j] * rstd * g[j];
    }
}
DI void ph_conv_glu(const Frame& F, const bf16* U, bf16* Gb, const float* cw, const float* cb) {
    constexpr int RC = 32, NCG = DFF / 8, NRC = MC / RC;
    const int gt = blockIdx.x * (NWAVES * 64) + F.tid, NT = F.G * NWAVES * 64;
    for (int it = gt; it < NCG * NRC; it += NT) {
        const int cg = it % NCG, rc = it / NCG, c0 = cg * 8, r0 = rc * RC;
        float w0g[8], w1g[8], w2g[8], bg[8], w0v[8], w1v[8], w2v[8], bv[8];
#pragma unroll
        for (int e = 0; e < 8; ++e) { w0g[e] = cw[c0 + e]; w1g[e] = cw[2 * DFF + c0 + e]; w2g[e] = cw[4 * DFF + c0 + e]; bg[e] = cb[c0 + e];
            w0v[e] = cw[DFF + c0 + e]; w1v[e] = cw[3 * DFF + c0 + e]; w2v[e] = cw[5 * DFF + c0 + e]; bv[e] = cb[DFF + c0 + e]; }
        float pg2[8], pg1[8], pv2[8], pv1[8];
        const bool has = (r0 & (SEQ - 1)) != 0;
        {
            u32x4 a = {0u, 0u, 0u, 0u}, b = a, c = a, d = a;
            if (has) { a = *(const u32x4*)(U + (size_t)(r0 - 2) * (2 * DFF) + c0); b = *(const u32x4*)(U + (size_t)(r0 - 1) * (2 * DFF) + c0);
                       c = *(const u32x4*)(U + (size_t)(r0 - 2) * (2 * DFF) + DFF + c0); d = *(const u32x4*)(U + (size_t)(r0 - 1) * (2 * DFF) + DFF + c0); }
#pragma unroll
            for (int e = 0; e < 4; ++e) { pg2[2 * e] = bflo(a[e]); pg2[2 * e + 1] = bfhi(a[e]); pg1[2 * e] = bflo(b[e]); pg1[2 * e + 1] = bfhi(b[e]);
                pv2[2 * e] = bflo(c[e]); pv2[2 * e + 1] = bfhi(c[e]); pv1[2 * e] = bflo(d[e]); pv1[2 * e + 1] = bfhi(d[e]); }
        }
        for (int r = 0; r < RC; ++r) {
            const u32x4 ug = *(const u32x4*)(U + (size_t)(r0 + r) * (2 * DFF) + c0), uv = *(const u32x4*)(U + (size_t)(r0 + r) * (2 * DFF) + DFF + c0);
            float cg_[8], cv_[8], o[8];
#pragma unroll
            for (int e = 0; e < 4; ++e) { cg_[2 * e] = bflo(ug[e]); cg_[2 * e + 1] = bfhi(ug[e]); cv_[2 * e] = bflo(uv[e]); cv_[2 * e + 1] = bfhi(uv[e]); }
#pragma unroll
            for (int e = 0; e < 8; ++e) {
                const float yg = bg[e] + w0g[e] * pg2[e] + w1g[e] * pg1[e] + w2g[e] * cg_[e];
                const float yv = bv[e] + w0v[e] * pv2[e] + w1v[e] * pv1[e] + w2v[e] * cv_[e];
                const float sg = yg * __builtin_amdgcn_rcpf(1.0f + __builtin_amdgcn_exp2f(-yg * LOG2E));
                o[e] = sg * yv; pg2[e] = pg1[e]; pg1[e] = cg_[e]; pv2[e] = pv1[e]; pv1[e] = cv_[e];
            }
            u32x4 w; w.x = pk2(o[0], o[1]); w.y = pk2(o[2], o[3]); w.z = pk2(o[4], o[5]); w.w = pk2(o[6], o[7]);
            *(u32x4*)(Gb + (size_t)(r0 + r) * DFF + c0) = w;
        }
    }
}
constexpr size_t DA_DIN = 0, DA_CQN = 64 * MiB, DA_LATC = 80 * MiB, DA_KPE = 88 * MiB, DA_KIDX = 90 * MiB, DA_WIDX = 94 * MiB, DA_QL = 96 * MiB, DA_QPE = 352 * MiB, DA_QIDX = 400 * MiB,
                 DA_SEL = 464 * MiB, DA_CNT = 472 * MiB, DA_SC = 474 * MiB;
constexpr size_t DW_W1 = 0, DW_W2 = (size_t)1024 * 2048, DW_WO = DW_W2 + (size_t)11776 * 512;
constexpr float DSA_QSCALE = 0.07216878364870322f * LOG2E;
constexpr float DSA_WIDX_SCALE = 0.25f * 0.08838834764831845f;

DI void ph_dsa_cvt(const Frame& F, const float* w_in, const float* w_qup, const float* w_uk, const float* w_uv, const float* w_out) {
    bf16* WB = (bf16*)(F.ws + WS_WMIX);
    cvt_job(F, w_in, 960, DM, 0, 960, WB + DW_W1, DM, 0, 1.f);
    zero_bf16(F, WB + DW_W1 + (size_t)960 * DM, (size_t)64 * DM);
    { LAS float* scr = (LAS float*)(F.lds + F.wave * 16384);
      for (int it = F.gw; it < 32 * 16; it += F.NGW) { const int h = it >> 4; cvt_item(w_qup, 8192, h * 192, 48, WB + DW_W2, 512, 8192 + h * 48, DSA_QSCALE, scr, it & 15, 2, F.lane); } }
    cvt_job(F, w_qup, 8192, 512, 6144, 2048, WB + DW_W2, 512, 9728, 1.f);
    __syncthreads();
    {
        LAS float* As = (LAS float*)F.lds; LAS float* Bs = As + 64 * 145;
        for (int u = blockIdx.x; u < 32 * 4 * 8; u += F.G) {
            const int h = u >> 5, r0 = ((u >> 3) & 3) * 64, k0 = (u & 7) * 64;
            for (int i = F.tid; i < 64 * 144; i += NWAVES * 64) { const int row = i / 144, col = i - row * 144;
                As[row * 145 + col] = w_uk[(size_t)(h * 256 + r0) * 144 + i]; Bs[row * 145 + col] = w_qup[(size_t)(k0 + row) * 8192 + h * 192 + 48 + col]; }
            __syncthreads();
            const int r = F.tid & 63, kg = F.tid >> 6; float acc[8];
#pragma unroll
            for (int j = 0; j < 8; ++j) acc[j] = 0.f;
            for (int n = 0; n < 144; ++n) { const float a = As[r * 145 + n];
#pragma unroll
                for (int j = 0; j < 8; ++j) acc[j] += a * Bs[(kg * 8 + j) * 145 + n]; }
            u32x4 o; o.x = pk2(acc[0] * DSA_QSCALE, acc[1] * DSA_QSCALE); o.y = pk2(acc[2] * DSA_QSCALE, acc[3] * DSA_QSCALE); o.z = pk2(acc[4] * DSA_QSCALE, acc[5] * DSA_QSCALE); o.w = pk2(acc[6] * DSA_QSCALE, acc[7] * DSA_QSCALE);
            *(u32x4*)(WB + DW_W2 + (size_t)(h * 256 + r0 + r) * 512 + k0 + kg * 8) = o;
            __syncthreads();
        }
        LAS float* Av = (LAS float*)F.lds; LAS float* Bv = Av + 64 * 129;
        for (int u = blockIdx.x; u < 32 * 4 * 32; u += F.G) {
            const int h = u >> 7, r0 = ((u >> 5) & 3) * 64, c0 = (u & 31) * 64;
            for (int i = F.tid; i < 64 * 128; i += NWAVES * 64) { const int row = i >> 7, col = i & 127; Av[row * 129 + col] = w_uv[(size_t)(h * 256 + r0) * 128 + i]; }
            for (int i = F.tid; i < 128 * 64; i += NWAVES * 64) { const int v = i >> 6, c = i & 63; Bv[v * 64 + c] = w_out[(size_t)(h * 128 + v) * DM + c0 + c]; }
            __syncthreads();
            const int c = F.tid & 63, rg = F.tid >> 6; float acc[8];
#pragma unroll
            for (int j = 0; j < 8; ++j) acc[j] = 0.f;
            for (int v = 0; v < 128; ++v) { const float b = Bv[v * 64 + c];
#pragma unroll
                for (int j = 0; j < 8; ++j) acc[j] += Av[(rg * 8 + j) * 129 + v] * b; }
            u32x4 o; o.x = pk2(acc[0], acc[1]); o.y = pk2(acc[2], acc[3]); o.z = pk2(acc[4], acc[5]); o.w = pk2(acc[6], acc[7]);
            *(u32x4*)(WB + DW_WO + (size_t)(c0 + c) * 8192 + h * 256 + r0 + rg * 8) = o;
            __syncthreads();
        }
    }
}
DI void ph_dsa_post1(const Frame& F, int half, const float* qn, const float* kvn, const float* lng, const float* lnb) {
    unsigned char* ar = F.ws + WS_AR;
    const float* DIN = (const float*)(ar + DA_DIN); bf16* CQN = (bf16*)(ar + DA_CQN); bf16* LATC = (bf16*)(ar + DA_LATC); bf16* KPE = (bf16*)(ar + DA_KPE); bf16* KIDX = (bf16*)(ar + DA_KIDX); float* WIDX = (float*)(ar + DA_WIDX);
    const float* c48 = (const float*)(F.ws + TAB_COS48); const float* s48 = (const float*)(F.ws + TAB_SIN48); const float* c32 = (const float*)(F.ws + TAB_COS32); const float* s32 = (const float*)(F.ws + TAB_SIN32);
    LAS float* buf = (LAS float*)(F.lds + F.wave * 1024);
    const int lane = F.lane;
    for (int ml = F.gw; ml < MC; ml += F.NGW) {
        const int mg = half * MC + ml;
        const float* row = DIN + (size_t)ml * 1024 + 16 * lane;
        f32x4 v[4]; float ss = 0.f, s1 = 0.f;
#pragma unroll
        for (int j = 0; j < 4; ++j) { v[j] = *(const f32x4*)(row + 4 * j); ss += (v[j].x * v[j].x + v[j].y * v[j].y) + (v[j].z * v[j].z + v[j].w * v[j].w); s1 += (v[j].x + v[j].y) + (v[j].z + v[j].w); }
        const bool isq = lane < 32, iskv = lane >= 32 && lane < 48, ispe = lane >= 48 && lane < 51, isix = lane >= 51 && lane < 59;
        const float ssq = wave_sum(isq ? ss : 0.f), sskv = wave_sum(iskv ? ss : 0.f), mean = wave_sum(isix ? s1 : 0.f) * (1.f / 128.f);
        float d2 = 0.f;
#pragma unroll
        for (int j = 0; j < 4; ++j) { const f32x4 d = v[j] - mean; d2 += (d.x * d.x + d.y * d.y) + (d.z * d.z + d.w * d.w); }
        const float var = wave_sum(isix ? d2 : 0.f) * (1.f / 128.f);
        const float rq = 1.0f / sqrtf(ssq * (1.f / 512.f) + NORM_EPS), rkv = 1.0f / sqrtf(sskv * (1.f / 256.f) + NORM_EPS), rstd = 1.0f / sqrtf(var + NORM_EPS);
        if (isq || iskv) {
            const float* gp = isq ? qn + 16 * lane : kvn + 16 * (lane - 32); const float rs = isq ? rq : rkv;
            bf16* dst = isq ? CQN + (size_t)ml * 512 + 16 * lane : LATC + (size_t)ml * 256 + 16 * (lane - 32);
            u32x4 o[2];
#pragma unroll
            for (int j = 0; j < 4; ++j) { const f32x4 g = *(const f32x4*)(gp + 4 * j); const f32x4 y = v[j] * rs * g; o[j >> 1][(j & 1) * 2] = pk2(y.x, y.y); o[j >> 1][(j & 1) * 2 + 1] = pk2(y.z, y.w); }
            *(u32x4*)dst = o[0]; *(u32x4*)(dst + 8) = o[1];
        } else if (ispe) {
#pragma unroll
            for (int j = 0; j < 4; ++j) *(LAS f32x4*)(buf + (lane - 48) * 16 + 4 * j) = v[j];
        } else if (isix) {
#pragma unroll
            for (int j = 0; j < 4; ++j) { const f32x4 g = *(const f32x4*)(lng + (lane - 51) * 16 + 4 * j), b = *(const f32x4*)(lnb + (lane - 51) * 16 + 4 * j); *(LAS f32x4*)(buf + 48 + (lane - 51) * 16 + 4 * j) = (v[j] - mean) * rstd * g + b; }
        } else if (lane == 59) {
#pragma unroll
            for (int j = 0; j < 4; ++j) *(f32x4*)(WIDX + (size_t)ml * 16 + 4 * j) = v[j] * DSA_WIDX_SCALE;
        }
        LDS_WAIT();
        if (lane < 24) { const float x1 = buf[lane], x2 = buf[24 + lane], c = c48[(size_t)mg * 24 + lane], s = s48[(size_t)mg * 24 + lane];
            KPE[(size_t)ml * 48 + lane] = f2bf(x1 * c - x2 * s); KPE[(size_t)ml * 48 + 24 + lane] = f2bf(x1 * s + x2 * c);
        } else if (lane < 40) { const int i = lane - 24; const float x1 = buf[48 + i], x2 = buf[48 + 16 + i], c = c32[(size_t)mg * 16 + i], s = s32[(size_t)mg * 16 + i];
            KIDX[(size_t)ml * 128 + i] = f2bf(x1 * c - x2 * s); KIDX[(size_t)ml * 128 + 16 + i] = f2bf(x1 * s + x2 * c);
        } else { const int d = 32 + 4 * (lane - 40); const f32x4 y = *(const LAS f32x4*)(buf + 48 + d); u32x2 w; w.x = pk2(y.x, y.y); w.y = pk2(y.z, y.w); *(u32x2*)(KIDX + (size_t)ml * 128 + d) = w; }
        LDS_WAIT();
    }
}
DI void ph_dsa_rope(const Frame& F, int half) {
    unsigned char* ar = F.ws + WS_AR; bf16* QPE = (bf16*)(ar + DA_QPE); bf16* QIDX = (bf16*)(ar + DA_QIDX);
    const float* c48 = (const float*)(F.ws + TAB_COS48); const float* s48 = (const float*)(F.ws + TAB_SIN48); const float* c32 = (const float*)(F.ws + TAB_COS32); const float* s32 = (const float*)(F.ws + TAB_SIN32);
    for (int ml = F.gw; ml < MC; ml += F.NGW) {
        const size_t mg = (size_t)half * MC + ml;
        for (int p = F.lane; p < 768; p += 64) { const int hd = p / 24, i = p - hd * 24; bf16* q = QPE + (size_t)ml * 1536 + hd * 48 + i;
            const float x1 = bf2f(q[0]), x2 = bf2f(q[24]), c = c48[mg * 24 + i], s = s48[mg * 24 + i]; q[0] = f2bf(x1 * c - x2 * s); q[24] = f2bf(x1 * s + x2 * c); }
        for (int p = F.lane; p < 256; p += 64) { const int hd = p >> 4, i = p & 15; bf16* q = QIDX + (size_t)ml * 2048 + hd * 128 + i;
            const float x1 = bf2f(q[0]), x2 = bf2f(q[16]), c = c32[mg * 16 + i], s = s32[mg * 16 + i]; q[0] = f2bf(x1 * c - x2 * s); q[16] = f2bf(x1 * s + x2 * c); }
    }
}
DI unsigned f2sortable(float s) { const unsigned b = __builtin_bit_cast(unsigned, s); return (b & 0x80000000u) ? ~b : (b | 0x80000000u); }
DI void ph_dsa_index(const Frame& F, const int dry = 0) {
    unsigned char* ar = F.ws + WS_AR;
    const bf16* QIDX = (const bf16*)(ar + DA_QIDX); const bf16* KIDX = (const bf16*)(ar + DA_KIDX); const float* WIDX = (const float*)(ar + DA_WIDX);
    unsigned short* SEL = (unsigned short*)(ar + DA_SEL); int* CNT = (int*)(ar + DA_CNT); float* SC = (float*)(ar + DA_SC) + (size_t)F.gw * 16384;
    const int lane = F.lane, r = lane & 31, hf = lane >> 5;
#pragma unroll 1
    for (int tile = blockIdx.x; tile < BPH * 128; tile += F.G) {
        const int j = tile >> 8, c8 = tile & 255, c7 = c8 & 127, bl = (c8 >> 7) * 2 + j, qt = j ? 127 - c7 : c7;
        const int q0 = qt * 32 + 4 * F.wave;
        const int ntile = (q0 + 3) / 32 + 1;
        bf16x8 qa[2][8]; float wv[2][16];
#pragma unroll
        for (int pr = 0; pr < 2; ++pr) {
            const int mrow = bl * SEQ + q0 + 2 * pr + (r >> 4);
#pragma unroll
            for (int s = 0; s < 8; ++s) qa[pr][s] = *(const bf16x8*)(QIDX + (size_t)mrow * 2048 + (r & 15) * 128 + 16 * s + 8 * hf);
#pragma unroll
            for (int i = 0; i < 16; ++i) wv[pr][i] = WIDX[(size_t)(bl * SEQ + q0 + 2 * pr + (i >> 3)) * 16 + (i & 3) + 8 * ((i >> 2) & 1) + 4 * hf];
        }
#pragma unroll 1
        for (int t = 0; t < ntile; ++t) {
            bf16x8 kf[8];
            const bf16* kp = KIDX + (size_t)(bl * SEQ + 32 * t + r) * 128 + 8 * hf;
#pragma unroll
            for (int s = 0; s < 8; ++s) kf[s] = *(const bf16x8*)(kp + 16 * s);
#pragma unroll
            for (int pr = 0; pr < 2; ++pr) {
                f32x16 acc;
#pragma unroll
                for (int i = 0; i < 16; ++i) acc[i] = 0.f;
#pragma unroll
                for (int s = 0; s < 8; ++s) acc = MFMA32(qa[pr][s], kf[s], acc);
                float p0 = 0.f, p1 = 0.f;
#pragma unroll
                for (int i = 0; i < 8; ++i) { p0 += wv[pr][i] * fmaxf(acc[i], 0.f); p1 += wv[pr][8 + i] * fmaxf(acc[8 + i], 0.f); }
                const float t0 = p0 + __shfl_xor(p0, 32), t1 = p1 + __shfl_xor(p1, 32);
                SC[(pr * 128 + t) * 64 + lane] = hf ? t1 : t0;
            }
        }
        VM_WAIT();
#pragma unroll 1
        for (int qi = 0; qi < 4; ++qi) {
            const int tq = q0 + qi, pr = qi >> 1, qs = qi & 1;
            unsigned u[64];
            const unsigned* scp = (const unsigned*)(SC + pr * 8192 + hf * 64 + qs * 32 + r);
#pragma unroll
            for (int g8 = 0; g8 < 8; ++g8) {
#pragma unroll
                for (int e = 0; e < 8; ++e) { const int i = 8 * g8 + e; const float s = __builtin_bit_cast(float, __hip_atomic_load(scp + e * 128, __ATOMIC_RELAXED, __HIP_MEMORY_SCOPE_AGENT));
                    u[i] = (2 * i + hf < ntile && 64 * i + lane <= tq) ? f2sortable(s) : 0u; }
                scp += 1024; asm volatile("" : "+v"(scp));
            }
            unsigned prefix = 0u;
#pragma unroll 1
            for (int bit = 31; bit >= 0; --bit) {
                const unsigned cand = prefix | (1u << bit); int c = 0;
#pragma unroll
                for (int i = 0; i < 64; ++i) c += (u[i] >= cand) ? 1 : 0;
#pragma unroll
                for (int o = 1; o < 64; o <<= 1) c += __shfl_xor(c, o);
                if (c >= 256) prefix = cand;
            }
            const unsigned T = prefix > 1u ? prefix : 1u;
            int nl = 0;
#pragma unroll
            for (int i = 0; i < 64; ++i) nl += (u[i] >= T) ? 1 : 0;
            int inc = nl;
#pragma unroll
            for (int o = 1; o < 64; o <<= 1) { const int y = __shfl_up(inc, o); if (lane >= o) inc += y; }
            const int base = __shfl(inc, 63);
            int pos = inc - nl;
            unsigned short* sel = dry ? (unsigned short*)(ar + DUMMY_OFF) + (size_t)F.gw * 256 : SEL + (size_t)(bl * SEQ + tq) * 256;
#pragma unroll
            for (int i = 0; i < 64; ++i) { if (u[i] >= T) { if (pos < 256) sel[pos] = (unsigned short)(64 * i + lane); ++pos; } }
            if (lane == 0) (dry ? (int*)(ar + DUMMY_OFF + 32 * MiB) + F.gw : CNT + bl * SEQ + tq)[0] = base < 256 ? base : 256;
        }
    }
}
DI void ph_dsa_attn(const Frame& F, const int dry = 0) {
    unsigned char* ar = F.ws + WS_AR;
    bf16* QL = (bf16*)(ar + DA_QL); const bf16* QPE = (const bf16*)(ar + DA_QPE); const bf16* LATC = (const bf16*)(ar + DA_LATC); const bf16* KPE = (const bf16*)(ar + DA_KPE);
    const unsigned short* SEL = (const unsigned short*)(ar + DA_SEL); const int* CNT = (const int*)(ar + DA_CNT);
    const int lane = F.lane, r = lane & 31, h = lane >> 5;
    u32x4* PS = (u32x4*)(ar + DA_SC + (size_t)F.gw * 65536) + lane;
    float* AS = (float*)(ar + DA_SC + (size_t)F.gw * 65536 + 16384) + lane;
    LAS unsigned char* img = F.lds + F.wave * 8704;
    const int i16 = lane & 15, tq_ = i16 >> 2, tp_ = i16 & 3, blk = (lane >> 4) & 1;
#pragma unroll 1
    for (int ml = F.gw; ml < MC; ml += F.NGW) {
        const int bl = ml >> 12, cnt = CNT[ml], nch = (cnt + 31) >> 5;
        const unsigned short* sel = SEL + (size_t)ml * 256;
        float linv;
        {
            bf16x8 qf[16], qp[3];
#pragma unroll
            for (int s = 0; s < 16; ++s) qf[s] = *(const bf16x8*)(QL + (size_t)ml * 8192 + r * 256 + 16 * s + 8 * h);
#pragma unroll
            for (int s = 0; s < 3; ++s) qp[s] = *(const bf16x8*)(QPE + (size_t)ml * 1536 + r * 48 + 16 * s + 8 * h);
            float m = -INFINITY, l = 0.f;
#pragma unroll 1
            for (int c = 0; c < nch; ++c) {
                const int slot = 32 * c + r; const int kidx = slot < cnt ? (int)sel[slot] : 0;
                const bf16* kc = LATC + (size_t)(bl * SEQ + kidx) * 256 + 8 * h; const bf16* kp = KPE + (size_t)(bl * SEQ + kidx) * 48 + 8 * h;
                f32x16 acc;
#pragma unroll
                for (int i = 0; i < 16; ++i) acc[i] = 0.f;
#pragma unroll
                for (int s = 0; s < 16; ++s) acc = MFMA32(*(const bf16x8*)(kc + 16 * s), qf[s], acc);
#pragma unroll
                for (int s = 0; s < 3; ++s) acc = MFMA32(*(const bf16x8*)(kp + 16 * s), qp[s], acc);
                float mx = -INFINITY;
#pragma unroll
                for (int i = 0; i < 16; ++i) { acc[i] = (32 * c + crow(i, h) < cnt) ? acc[i] : -INFINITY; mx = fmaxf(mx, acc[i]); }
                mx = fmaxf(mx, __shfl_xor(mx, 32));
                const float mn = fmaxf(m, mx), a = __builtin_amdgcn_exp2f(m - mn);
                float sum = 0.f;
#pragma unroll
                for (int i = 0; i < 16; ++i) { acc[i] = __builtin_amdgcn_exp2f(acc[i] - mn); sum += acc[i]; }
                l = l * a + sum; m = mn;
                AS[c * 64] = a;
#pragma unroll
                for (int s = 0; s < 2; ++s) { u32x4 w; w.x = pk2(acc[8 * s], acc[8 * s + 1]); w.y = pk2(acc[8 * s + 2], acc[8 * s + 3]); w.z = pk2(acc[8 * s + 4], acc[8 * s + 5]); w.w = pk2(acc[8 * s + 6], acc[8 * s + 7]); PS[(c * 2 + s) * 64] = w; }
            }
            l += __shfl_xor(l, 32);
            linv = 1.0f / l;
        }
#pragma unroll 1
        for (int dh = 0; dh < 2; ++dh) {
            f32x16 O[4];
#pragma unroll
            for (int db = 0; db < 4; ++db)
#pragma unroll
                for (int i = 0; i < 16; ++i) O[db][i] = 0.f;
#pragma unroll 1
            for (int c = 0; c < nch; ++c) {
                const int slot = 32 * c + r; const int myk = slot < cnt ? (int)sel[slot] : 0;
                const float a = AS[c * 64];
                const bf16x8 p0 = __builtin_bit_cast(bf16x8, PS[(c * 2) * 64]), p1 = __builtin_bit_cast(bf16x8, PS[(c * 2 + 1) * 64]);
#pragma unroll
                for (int it = 0; it < 8; ++it) { const int rr = (lane >> 4) + 4 * it; const int ki = __shfl(myk, rr);
                    const u32x4 d = *(const u32x4*)(LATC + (size_t)(bl * SEQ + ki) * 256 + dh * 128 + i16 * 8);
                    *(LAS u32x4*)(img + rr * 272 + i16 * 16) = d; }
#pragma unroll
                for (int db = 0; db < 4; ++db)
#pragma unroll
                    for (int i = 0; i < 16; ++i) O[db][i] *= a;
                LDS_WAIT();
#pragma unroll
                for (int db = 0; db < 4; ++db)
#pragma unroll
                    for (int s = 0; s < 2; ++s) {
                        const s16x4 lo = __builtin_bit_cast(s16x4, __builtin_amdgcn_ds_read_tr16_b64_v4i16((LAS v4i16_t*)(img + (16 * s + 4 * h + tq_) * 272 + db * 64 + 32 * blk + 8 * tp_)));
                        const s16x4 hi = __builtin_bit_cast(s16x4, __builtin_amdgcn_ds_read_tr16_b64_v4i16((LAS v4i16_t*)(img + (16 * s + 8 + 4 * h + tq_) * 272 + db * 64 + 32 * blk + 8 * tp_)));
                        O[db] = MFMA32(__builtin_shufflevector(lo, hi, 0, 1, 2, 3, 4, 5, 6, 7), s ? p1 : p0, O[db]);
                    }
                LDS_WAIT();
            }
            bf16* o = (dry ? (bf16*)(ar + DUMMY_OFF) + (size_t)F.gw * 8192 : QL + (size_t)ml * 8192) + r * 256 + dh * 128 + 4 * h;
#pragma unroll
            for (int db = 0; db < 4; ++db)
#pragma unroll
                for (int g = 0; g < 4; ++g) { u32x2 w; w.x = pk2(O[db][4 * g] * linv, O[db][4 * g + 1] * linv); w.y = pk2(O[db][4 * g + 2] * linv, O[db][4 * g + 3] * linv); *(u32x2*)(o + db * 32 + 8 * g) = w; }
        }
    }
}
template <int NDB> DI void softmax_step(f32x16& S, float& m, float& l, f32x16 (&O)[NDB], bf16x8 (&pf)[2]) {
    float mx = S[0];
#pragma unroll
    for (int i = 1; i < 16; ++i) mx = fmaxf(mx, S[i]);
    mx = fmaxf(mx, __shfl_xor(mx, 32));
    const float mn = fmaxf(m, mx), ms = (mn == -INFINITY) ? 0.f : mn;
    const float alpha = __builtin_amdgcn_exp2f(m - ms);
    float sum = 0.f;
#pragma unroll
    for (int i = 0; i < 16; ++i) { S[i] = __builtin_amdgcn_exp2f(S[i] - ms); sum += S[i]; }
    l = l * alpha + sum; m = mn;
#pragma unroll
    for (int db = 0; db < NDB; ++db)
#pragma unroll
        for (int i = 0; i < 16; ++i) O[db][i] *= alpha;
#pragma unroll
    for (int s = 0; s < 2; ++s) { u32x4 w; w.x = pk2(S[8 * s], S[8 * s + 1]); w.y = pk2(S[8 * s + 2], S[8 * s + 3]); w.z = pk2(S[8 * s + 4], S[8 * s + 5]); w.w = pk2(S[8 * s + 6], S[8 * s + 7]); pf[s] = __builtin_bit_cast(bf16x8, w); }
}
template <int NQ, int NDB, bool PV, bool QL, bool FRAG, class KA, class VA, class MK>
DI void attn_run(const bf16x8 (&qf)[NQ], const LAS unsigned char* qlds, f32x16 (&O)[NDB], float& m, float& l, int tb, int te, const KA& ka, const VA& va, const MK& mk) {
    if (tb >= te) return;
    bf16x8 kf[NQ];
    { const bf16* kp = ka(tb);
#pragma unroll
      for (int s = 0; s < NQ; ++s) kf[s] = *(const bf16x8*)(kp + (FRAG ? 512 : 16) * s); }
    for (int t = tb; t < te; ++t) {
        bf16x8 vf[NDB][2];
        if (PV) {
#pragma unroll
            for (int db = 0; db < NDB; ++db) { const bf16* vp = va(t, db);
#pragma unroll
                for (int s = 0; s < 2; ++s) { if (FRAG) vf[db][s] = *(const bf16x8*)(vp + 512 * s); else vf[db][s] = __builtin_shufflevector(*(const s16x4*)(vp + 16 * s), *(const s16x4*)(vp + 16 * s + 8), 0, 1, 2, 3, 4, 5, 6, 7); } }
        }
        f32x16 S;
#pragma unroll
        for (int i = 0; i < 16; ++i) S[i] = 0.f;
#pragma unroll
        for (int s = 0; s < NQ; ++s) { if (QL) { unsigned qa_ = (unsigned)(size_t)qlds; asm volatile("" : "+v"(qa_)); S = MFMA32(kf[s], *(const LAS bf16x8*)((LAS unsigned char*)(size_t)qa_ + s * 1024), S); } else S = MFMA32(kf[s], qf[s], S); }
        if (t + 1 < te) { const bf16* kp = ka(t + 1);
#pragma unroll
            for (int s = 0; s < NQ; ++s) kf[s] = *(const bf16x8*)(kp + (FRAG ? 512 : 16) * s); }
        mk(t, S);
        bf16x8 pf[2]; softmax_step<NDB>(S, m, l, O, pf);
        if (PV) {
#pragma unroll
            for (int db = 0; db < NDB; ++db)
#pragma unroll
                for (int s = 0; s < 2; ++s) O[db] = MFMA32(vf[db][s], pf[s], O[db]);
        }
    }
}
template <bool ACC> DI void store_col(bf16* out, const f32x16 (&O)[4], float scale, int h) {
#pragma unroll
    for (int db = 0; db < 4; ++db)
#pragma unroll
        for (int g = 0; g < 4; ++g) { u32x2* p = (u32x2*)(out + db * 32 + 8 * g + 4 * h);
            float a = O[db][4 * g] * scale, b = O[db][4 * g + 1] * scale, c = O[db][4 * g + 2] * scale, d = O[db][4 * g + 3] * scale;
            if (ACC) { const u32x2 o = *p; a += bflo(o.x); b += bfhi(o.x); c += bflo(o.y); d += bfhi(o.y); }
            u32x2 w; w.x = pk2(a, b); w.y = pk2(c, d); *p = w; }
}
constexpr size_t FA_Q = 0, FA_K = 64 * MiB, FA_F = 128 * MiB, FA_V = 136 * MiB, FA_CUM = 200 * MiB, FA_O = 202 * MiB, FA_KF = 266 * MiB, FA_VF = 330 * MiB;
constexpr size_t FW_IN = 0, FW_OUT = (size_t)6400 * 2048;
constexpr float FOX_QSCALE = 0.08838834764831845f * LOG2E;
DI void ph_fox_cvt(const Frame& F, const float* w_in, const float* w_out) {
    bf16* WB = (bf16*)(F.ws + WS_WMIX);
    cvt_job(F, w_in, 6160, DM, 0, 2048, WB + FW_IN, DM, 0, FOX_QSCALE);
    cvt_job(F, w_in, 6160, DM, 2048, 2048, WB + FW_IN, DM, 2048, 1.f);
    cvt_job(F, w_in, 6160, DM, 4096, 2048, WB + FW_IN, DM, 4096, 1.f);
    cvt_job(F, w_in, 6160, DM, 6144, 16, WB + FW_IN, DM, 6144, 1.f);
    zero_bf16(F, WB + FW_IN + (size_t)6160 * DM, (size_t)240 * DM);
    cvt_job(F, w_out, DM, DM, 0, DM, WB + FW_OUT, DM, 0, 1.f);
}
DI void ph_fox_scan(const Frame& F, const float* b_f) {
    unsigned char* ar = F.ws + WS_AR; const bf16* FB = (const bf16*)(ar + FA_F); float* CUM = (float*)(ar + FA_CUM);
    for (int w = F.gw; w < BPH * 16; w += F.NGW) {
        const int bl = w >> 4, hd = w & 15; const float bf_ = b_f[hd];
        float v[64]; float run = 0.f;
#pragma unroll
        for (int i = 0; i < 64; ++i) { const float x = bf2f(FB[(size_t)(bl * SEQ + F.lane * 64 + i) * 256 + hd]) + bf_;
            const float ls = fminf(x, 0.f) - log1pf(expf(-fabsf(x))); run += ls; v[i] = run; }
        float inc = run;
#pragma unroll
        for (int o = 1; o < 64; o <<= 1) { const float y = __shfl_up(inc, o); if (F.lane >= o) inc += y; }
        const float base = inc - run;
        float* dst = CUM + (size_t)w * SEQ + F.lane * 64;
#pragma unroll
        for (int i = 0; i < 64; i += 4) *(f32x4*)(dst + i) = (f32x4){(v[i] + base) * LOG2E, (v[i + 1] + base) * LOG2E, (v[i + 2] + base) * LOG2E, (v[i + 3] + base) * LOG2E};
    }
    const bf16* Kr = (const bf16*)(ar + FA_K); const bf16* Vr = (const bf16*)(ar + FA_V); bf16* KF = (bf16*)(ar + FA_KF); bf16* VF = (bf16*)(ar + FA_VF);
    const int r = F.lane & 31, h = F.lane >> 5;
    for (int u = F.gw; u < BPH * 16 * 128; u += F.NGW) {
        const int bh = u >> 7, tile = u & 127, bl = bh >> 4, hd = bh & 15;
        const bf16* krow_ = Kr + ((size_t)bl * SEQ + tile * 32 + r) * DM + hd * 128 + 8 * h;
        bf16* kd = KF + (((size_t)bh * 128 + tile) * 8 * 64 + F.lane) * 8;
#pragma unroll
        for (int s = 0; s < 8; ++s) *(u32x4*)(kd + s * 512) = *(const u32x4*)(krow_ + 16 * s);
        bf16* vd = VF + (((size_t)bh * 128 + tile) * 8 * 64 + F.lane) * 8;
#pragma unroll
        for (int db = 0; db < 4; ++db)
#pragma unroll
            for (int s = 0; s < 2; ++s) { unsigned short e[8];
#pragma unroll
                for (int j = 0; j < 8; ++j) e[j] = Vr[((size_t)bl * SEQ + tile * 32 + 16 * s + 8 * (j >> 2) + 4 * h + (j & 3)) * DM + hd * 128 + db * 32 + r];
                u32x4 w; w.x = e[0] | ((unsigned)e[1] << 16); w.y = e[2] | ((unsigned)e[3] << 16); w.z = e[4] | ((unsigned)e[5] << 16); w.w = e[6] | ((unsigned)e[7] << 16);
                *(u32x4*)(vd + (db * 2 + s) * 512) = w; }
    }
}
struct FragKA { const bf16* base; int nq; DI const bf16* operator()(int t) const { return base + (size_t)t * nq * 512; } };
struct FragVA { const bf16* base; DI const bf16* operator()(int t, int db) const { return base + ((size_t)t * 8 + db * 2) * 512; } };
struct FoxMK { const float* cum; float ct; int tq, h;
    DI void operator()(int t, f32x16& S) const {
        const int k0 = 32 * t + 4 * h;
#pragma unroll
        for (int g = 0; g < 4; ++g) { const f32x4 cs = *(const f32x4*)(cum + k0 + 8 * g);
#pragma unroll
            for (int e = 0; e < 4; ++e) S[4 * g + e] = (k0 + 8 * g + e <= tq) ? S[4 * g + e] + (ct - cs[e]) : -INFINITY; }
    } };
DI void ph_fox_attn(const Frame& F, const int dry = 0) {
    unsigned char* ar = F.ws + WS_AR; const bf16* Q = (const bf16*)(ar + FA_Q); const bf16* KF = (const bf16*)(ar + FA_KF); const bf16* VF = (const bf16*)(ar + FA_VF); const float* CUM = (const float*)(ar + FA_CUM); bf16* Ob = (bf16*)(ar + FA_O);
    const int r = F.lane & 31, h = F.lane >> 5;
    for (int wt = F.gw; wt < BPH * 16 * 32; wt += F.NGW) {
        const int bh = wt >> 5, x = wt & 31, bl = bh >> 4, hd = bh & 15;
#pragma unroll 1
        for (int k = 0; k < 4; ++k) {
            const int qt = (k == 0) ? x : (k == 1) ? 63 - x : (k == 2) ? 64 + x : 127 - x;
            const int tq = qt * 32 + r; const size_t mrow = (size_t)bl * SEQ + tq;
            bf16x8 qf[8];
#pragma unroll
            for (int s = 0; s < 8; ++s) qf[s] = *(const bf16x8*)(Q + mrow * DM + hd * 128 + 16 * s + 8 * h);
            f32x16 O[4];
#pragma unroll
            for (int db = 0; db < 4; ++db)
#pragma unroll
                for (int i = 0; i < 16; ++i) O[db][i] = 0.f;
            float m = -INFINITY, l = 0.f;
            const float* cum = CUM + (size_t)bh * SEQ;
            const FragKA ka{KF + ((size_t)bh * 128 * 8 * 64 + F.lane) * 8, 8}; const FragVA va{VF + ((size_t)bh * 128 * 8 * 64 + F.lane) * 8}; const FoxMK mk{cum, cum[tq], tq, h};
            attn_run<8, 4, true, false, true>(qf, nullptr, O, m, l, 0, qt + 1, ka, va, mk);
            l += __shfl_xor(l, 32);
            store_col<false>(dry ? (bf16*)(ar + DUMMY_OFF) + ((size_t)F.gw * 32 + r) * 128 : Ob + mrow * DM + hd * 128, O, l > 0.f ? 1.0f / l : 0.f, h);
        }
    }
}
constexpr size_t NA_Q = 0, NA_KC = 288 * MiB, NA_VC = 313 * MiB, NA_KSR = 330 * MiB, NA_KWR = 354 * MiB, NA_GT = 378 * MiB, NA_VSR = 386 * MiB, NA_VWR = 402 * MiB, NA_GK = 418 * MiB, NA_GV = 420 * MiB,
                 NA_KCMP = 422 * MiB, NA_VCT = 424 * MiB, NA_SELB = 426 * MiB, NA_O = 428 * MiB,
                 NA_KSF = 620 * MiB, NA_KWF = 644 * MiB, NA_VSF = 668 * MiB, NA_VWF = 684 * MiB;
constexpr size_t NW_IN = 0, NW_W1K = (size_t)13312 * 2048, NW_W1V = NW_W1K + (size_t)256 * 6144, NW_W2K = NW_W1V + (size_t)256 * 4096, NW_W2V = NW_W2K + 65536, NW_OUT = NW_W2V + 65536;
constexpr float NSA_QSCALE = 0.07216878364870322f * LOG2E;
DI void ph_nsa_cvt(const Frame& F, const float* w_in, const float* k_pe, const float* k_w1, const float* k_b1, const float* k_w2, const float* v_pe, const float* v_w1, const float* v_b1, const float* v_w2, const float* w_out) {
    bf16* WB = (bf16*)(F.ws + WS_WMIX); float* BIAS = (float*)(F.ws + WS_MISC);
    cvt_job(F, w_in, 13200, DM, 0, 9216, WB + NW_IN, DM, 0, NSA_QSCALE);
    cvt_job(F, w_in, 13200, DM, 9216, 768, WB + NW_IN, DM, 9216, 1.f);
    cvt_job(F, w_in, 13200, DM, 9984, 512, WB + NW_IN, DM, 9984, 1.f);
    cvt_job(F, w_in, 13200, DM, 10496, 768, WB + NW_IN, DM, 10496, 1.f);
    cvt_job(F, w_in, 13200, DM, 11776, 768, WB + NW_IN, DM, 11264, 1.f);
    cvt_job(F, w_in, 13200, DM, 13056, 144, WB + NW_IN, DM, 12032, 1.f);
    zero_bf16(F, WB + NW_IN + (size_t)12176 * DM, (size_t)112 * DM);
    cvt_job(F, w_in, 13200, DM, 11264, 512, WB + NW_IN, DM, 12288, 1.f);
    cvt_job(F, w_in, 13200, DM, 12544, 512, WB + NW_IN, DM, 12800, 1.f);
    cvt_job(F, k_w1, 256, 6144, 0, 256, WB + NW_W1K, 6144, 0, 1.f);
    cvt_job(F, v_w1, 256, 4096, 0, 256, WB + NW_W1V, 4096, 0, 1.f);
    cvt_job(F, k_w2, 192, 256, 0, 192, WB + NW_W2K, 256, 0, 1.f); zero_bf16(F, WB + NW_W2K + 192 * 256, 64 * 256);
    cvt_job(F, v_w2, 128, 256, 0, 128, WB + NW_W2V, 256, 0, 1.f); zero_bf16(F, WB + NW_W2V + 128 * 256, 128 * 256);
    cvt_job(F, w_out, DM, 6144, 0, DM, WB + NW_OUT, 6144, 0, 1.f);
    for (int w = F.gw; w < 512; w += F.NGW) { const bool isk = w < 256; const int c = w & 255, n = isk ? 6144 : 4096; const float* pe = isk ? k_pe : v_pe; const float* w1 = isk ? k_w1 : v_w1;
        float s = 0.f; for (int i = F.lane; i < n; i += 64) s += pe[i] * w1[(size_t)i * 256 + c];
        s = wave_sum(s); if (F.lane == 0) BIAS[w] = s + (isk ? k_b1[c] : v_b1[c]); }
}
DI void ph_nsa_rope(const Frame& F, int half) {
    unsigned char* ar = F.ws + WS_AR; bf16* Q = (bf16*)(ar + NA_Q); bf16* KC = (bf16*)(ar + NA_KC);
    const bf16* KSR = (const bf16*)(ar + NA_KSR); const bf16* KWR = (const bf16*)(ar + NA_KWR); bf16* KSF = (bf16*)(ar + NA_KSF); bf16* KWF = (bf16*)(ar + NA_KWF);
    const float* c48 = (const float*)(F.ws + TAB_COS48); const float* s48 = (const float*)(F.ws + TAB_SIN48);
    for (int ml = F.gw; ml < MC; ml += F.NGW) {
        const size_t mg = (size_t)half * MC + ml; const int bl = ml >> 12, sq = ml & 4095;
        for (int p = F.lane; p < 1248; p += 64) {
            const int hd = p / 24, i = p - hd * 24; bf16* q;
            if (hd < 48) q = Q + (size_t)ml * 9216 + hd * 192 + i;
            else q = KC + ((size_t)(bl * 4 + hd - 48) * 4096 + sq) * 192 + i;
            const float x1 = bf2f(q[0]), x2 = bf2f(q[24]), c = c48[mg * 24 + i], s = s48[mg * 24 + i]; q[0] = f2bf(x1 * c - x2 * s); q[24] = f2bf(x1 * s + x2 * c);
        }
        const int tile = sq >> 5, rr = sq & 31;
        for (int u = F.lane; u < 168; u += 64) {
            const int tens = u / 84, uu = u - tens * 84, g = uu / 21, v = uu - g * 21;
            const bf16* src = (tens ? KWR : KSR) + (size_t)ml * 768 + g * 192;
            bf16* dst = (tens ? KWF : KSF) + ((size_t)((bl * 4 + g) * 128 + tile) * 12 * 64 + rr) * 8;
            if (v < 3) {
                const u32x4 a = *(const u32x4*)(src + 8 * v), b = *(const u32x4*)(src + 8 * v + 24); u32x4 o1, o2;
#pragma unroll
                for (int e = 0; e < 4; ++e) { const float c0 = c48[mg * 24 + 8 * v + 2 * e], s0 = s48[mg * 24 + 8 * v + 2 * e], c1 = c48[mg * 24 + 8 * v + 2 * e + 1], s1 = s48[mg * 24 + 8 * v + 2 * e + 1];
                    const float x1l = bflo(a[e]), x1h = bfhi(a[e]), x2l = bflo(b[e]), x2h = bfhi(b[e]);
                    o1[e] = pk2(x1l * c0 - x2l * s0, x1h * c1 - x2h * s1); o2[e] = pk2(x1l * s0 + x2l * c0, x1h * s1 + x2h * c1); }
                const int p1 = v, p2 = v + 3;
                *(u32x4*)(dst + ((p1 >> 1) * 64 + (p1 & 1) * 32) * 8) = o1; *(u32x4*)(dst + ((p2 >> 1) * 64 + (p2 & 1) * 32) * 8) = o2;
            } else { const int pc = v + 3; *(u32x4*)(dst + ((pc >> 1) * 64 + (pc & 1) * 32) * 8) = *(const u32x4*)(src + 8 * pc); }
        }
    }
    const bf16* VSR = (const bf16*)(ar + NA_VSR); const bf16* VWR = (const bf16*)(ar + NA_VWR); bf16* VSF = (bf16*)(ar + NA_VSF); bf16* VWF = (bf16*)(ar + NA_VWF);
    const int r = F.lane & 31, h = F.lane >> 5;
    for (int u = F.gw; u < 2 * BPH * 4 * 128; u += F.NGW) {
        const int tens = u >> 11, bg = (u >> 7) & 15, tile = u & 127, bl = bg >> 2, g = bg & 3;
        const bf16* src = (tens ? VWR : VSR) + ((size_t)bl * SEQ + tile * 32) * 512 + g * 128 + r;
        bf16* vd = (tens ? VWF : VSF) + (((size_t)bg * 128 + tile) * 8 * 64 + F.lane) * 8;
#pragma unroll
        for (int db = 0; db < 4; ++db)
#pragma unroll
            for (int s = 0; s < 2; ++s) { unsigned short e[8];
#pragma unroll
                for (int j = 0; j < 8; ++j) e[j] = src[(size_t)(16 * s + 8 * (j >> 2) + 4 * h + (j & 3)) * 512 + db * 32];
                u32x4 w; w.x = e[0] | ((unsigned)e[1] << 16); w.y = e[2] | ((unsigned)e[3] << 16); w.z = e[4] | ((unsigned)e[5] << 16); w.w = e[6] | ((unsigned)e[7] << 16);
                *(u32x4*)(vd + (db * 2 + s) * 512) = w; }
    }
}
DI float sigmoidf_(float x) { return __builtin_amdgcn_rcpf(1.0f + __builtin_amdgcn_exp2f(-x * LOG2E)); }
struct LinKA { const bf16* base; size_t tstride; DI const bf16* operator()(int t) const { return base + (size_t)t * tstride; } };
struct LinVA { const bf16* base; size_t dbstride; DI const bf16* operator()(int t, int db) const { return base + (size_t)db * dbstride + t * 32; } };
struct CmpMK { int tq, h; DI void operator()(int t, f32x16& S) const {
#pragma unroll
    for (int i = 0; i < 16; ++i) { const int n = 32 * t + crow(i, h); S[i] = (16 * n + 31 <= tq) ? S[i] : -INFINITY; } } };
struct WinMK { int tq, h; DI void operator()(int t, f32x16& S) const {
#pragma unroll
    for (int i = 0; i < 16; ++i) { const int k = 32 * t + crow(i, h); S[i] = (k <= tq && k > tq - 512) ? S[i] : -INFINITY; } } };
DI void ph_nsa_cmp(const Frame& F, const int dry = 0) {
    unsigned char* ar = F.ws + WS_AR; const bf16* Q = (const bf16*)(ar + NA_Q); const bf16* KCMP = (const bf16*)(ar + NA_KCMP); const bf16* VCT = (const bf16*)(ar + NA_VCT); const bf16* GT = (const bf16*)(ar + NA_GT);
    unsigned char* SELB = ar + NA_SELB; bf16* Ob = (bf16*)(ar + NA_O);
    LAS float* imp = (LAS float*)F.lds;
    LAS unsigned char* qlds = F.lds + 20480 + F.wave * 12288 + F.lane * 16;
    const int lane = F.lane, r = lane & 31, h = lane >> 5;
    for (int u = blockIdx.x; u < BPH * 4 * 64; u += F.G) {
        const int bg = u >> 6, qt64 = u & 63, bl = bg >> 2, g = bg & 3;
        for (int i = F.tid; i < 64 * 65; i += NWAVES * 64) imp[i] = 0.f;
        __syncthreads();
#pragma unroll 1
        for (int k = 0; k < 3; ++k) {
            const int idx = F.wave * 3 + k, j = idx >> 1, sub = idx & 1, ql = sub * 32 + r, tq = qt64 * 64 + ql, hd = g * 12 + j;
            const size_t mrow = (size_t)bl * SEQ + tq;
            bf16x8 qf[12];
#pragma unroll
            for (int s = 0; s < 12; ++s) { qf[s] = *(const bf16x8*)(Q + mrow * 9216 + hd * 192 + 16 * s + 8 * h); *(LAS bf16x8*)(qlds + s * 1024) = qf[s]; }
            LDS_WAIT();
            const int tqmax = qt64 * 64 + sub * 32 + 31, te = (tqmax >= 31) ? ((tqmax - 31) / 16) / 32 + 1 : 0;
            const LinKA ka{KCMP + ((size_t)bg * 256 + r) * 256 + 8 * h, (size_t)32 * 256}; const LinVA va{VCT + (size_t)r * 4096 + bg * 256 + 4 * h, (size_t)32 * 4096}; const CmpMK mk{tq, h};
            f32x16 O[4];
#pragma unroll
            for (int db = 0; db < 4; ++db)
#pragma unroll
                for (int i = 0; i < 16; ++i) O[db][i] = 0.f;
            float m = -INFINITY, l = 0.f;
            attn_run<12, 4, false, true, false>(qf, qlds, O, m, l, 0, te, ka, va, mk);
            l += __shfl_xor(l, 32);
            const float linv = l > 0.f ? 1.0f / l : 0.f, ms = (m == -INFINITY) ? 0.f : m;
            for (int t = 0; t < te; ++t) {
                const bf16* kp = ka(t); f32x16 S;
#pragma unroll
                for (int i = 0; i < 16; ++i) S[i] = 0.f;
#pragma unroll
                for (int s = 0; s < 12; ++s) { unsigned qa_ = (unsigned)(size_t)qlds; asm volatile("" : "+v"(qa_)); S = MFMA32(*(const bf16x8*)(kp + 16 * s), *(const LAS bf16x8*)((LAS unsigned char*)(size_t)qa_ + s * 1024), S); }
                mk(t, S);
#pragma unroll
                for (int i = 0; i < 16; ++i) S[i] = __builtin_amdgcn_exp2f(S[i] - ms) * linv;
#pragma unroll
                for (int g4 = 0; g4 < 4; ++g4) { const float gs = (S[4 * g4] + S[4 * g4 + 1]) + (S[4 * g4 + 2] + S[4 * g4 + 3]); const int mb = 8 * t + 2 * g4 + h;
                    __hip_atomic_fetch_add(imp + ql * 65 + mb, gs, __ATOMIC_RELAXED, __HIP_MEMORY_SCOPE_WORKGROUP);
                    if (mb + 1 < 64) __hip_atomic_fetch_add(imp + ql * 65 + mb + 1, S[4 * g4 + 3], __ATOMIC_RELAXED, __HIP_MEMORY_SCOPE_WORKGROUP); }
                bf16x8 pf[2];
#pragma unroll
                for (int s = 0; s < 2; ++s) { u32x4 w; w.x = pk2(S[8 * s], S[8 * s + 1]); w.y = pk2(S[8 * s + 2], S[8 * s + 3]); w.z = pk2(S[8 * s + 4], S[8 * s + 5]); w.w = pk2(S[8 * s + 6], S[8 * s + 7]); pf[s] = __builtin_bit_cast(bf16x8, w); }
#pragma unroll
                for (int db = 0; db < 4; ++db) { const bf16* vp = va(t, db);
#pragma unroll
                    for (int s = 0; s < 2; ++s) O[db] = MFMA32(__builtin_shufflevector(*(const s16x4*)(vp + 16 * s), *(const s16x4*)(vp + 16 * s + 8), 0, 1, 2, 3, 4, 5, 6, 7), pf[s], O[db]); }
            }
            const float gate = sigmoidf_(bf2f(GT[mrow * 256 + hd]));
            store_col<false>(dry ? (bf16*)(ar + DUMMY_OFF) + ((size_t)F.gw * 32 + r) * 128 : Ob + mrow * 6144 + hd * 128, O, gate, h);
        }
        __syncthreads();
#pragma unroll 1
        for (int k = 0; k < 8; ++k) {
            const int ql = F.wave * 8 + k, tq = qt64 * 64 + ql, cur = tq >> 6, mb = lane;
            const bool causal = mb <= cur, forced = (mb == 0) || (mb == cur) || (mb == cur - 1);
            const float v = causal ? (forced ? INFINITY : imp[ql * 65 + mb]) : -INFINITY;
            int rank = 0;
            for (int o = 0; o < 64; ++o) { const float vo = __shfl(v, o); rank += (vo > v || (vo == v && o < mb)) ? 1 : 0; }
            if (rank < 16) (dry ? ar + DUMMY_OFF + 32 * MiB + (size_t)F.gw * 16 : SELB + ((size_t)bg * 4096 + tq) * 16)[rank] = causal ? (unsigned char)mb : (unsigned char)0xFF;
        }
        __syncthreads();
    }
}
DI int sel_tile(const u32x4& sel, int t) { const int b = t >> 1; const unsigned w = (b < 4) ? sel.x : (b < 8) ? sel.y : (b < 12) ? sel.z : sel.w; return (int)((w >> ((b & 3) * 8)) & 0xFFu) * 2 + (t & 1); }
struct SelKA { const bf16* base; u32x4 sel; DI const bf16* operator()(int t) const { return base + (size_t)sel_tile(sel, t) * 12 * 512; } };
struct SelVA { const bf16* base; u32x4 sel; DI const bf16* operator()(int t, int db) const { return base + ((size_t)sel_tile(sel, t) * 8 + db * 2) * 512; } };
struct SelMK { u32x4 sel; int tq, h; DI void operator()(int t, f32x16& S) const { const int k0 = sel_tile(sel, t) * 32;
#pragma unroll
    for (int i = 0; i < 16; ++i) S[i] = (k0 + crow(i, h) <= tq) ? S[i] : -INFINITY; } };
DI void ph_nsa_sel(const Frame& F, const int dry = 0) {
    unsigned char* ar = F.ws + WS_AR; const bf16* Q = (const bf16*)(ar + NA_Q); const bf16* KSF = (const bf16*)(ar + NA_KSF); const bf16* VSF = (const bf16*)(ar + NA_VSF); const bf16* GT = (const bf16*)(ar + NA_GT);
    const unsigned char* SELB = ar + NA_SELB; bf16* Ob = (bf16*)(ar + NA_O);
    const int r = F.lane & 31, h = F.lane >> 5; const bool act = r < 12;
    LAS unsigned char* qlds = F.lds + F.wave * 12288 + F.lane * 16;
    for (int it = F.gw; it < BPH * 4 * SEQ; it += F.NGW) {
        const int bg = it >> 12, tq = it & 4095, bl = bg >> 2, g = bg & 3; const size_t mrow = (size_t)bl * SEQ + tq; const int hd = g * 12 + (act ? r : 0);
        bf16x8 qf[12];
#pragma unroll
        for (int s = 0; s < 12; ++s) { qf[s] = *(const bf16x8*)(Q + mrow * 9216 + hd * 192 + 16 * s + 8 * h); if (!act) qf[s] = (bf16x8){0, 0, 0, 0, 0, 0, 0, 0}; *(LAS bf16x8*)(qlds + s * 1024) = qf[s]; }
        LDS_WAIT();
        const u32x4 sel = *(const u32x4*)(SELB + (size_t)it * 16);
        const int nv = ((tq >> 6) + 1 < 16) ? (tq >> 6) + 1 : 16;
        const SelKA ka{KSF + ((size_t)bg * 128 * 12 * 64 + F.lane) * 8, sel}; const SelVA va{VSF + ((size_t)bg * 128 * 8 * 64 + F.lane) * 8, sel}; const SelMK mk{sel, tq, h};
        f32x16 O[4];
#pragma unroll
        for (int db = 0; db < 4; ++db)
#pragma unroll
            for (int i = 0; i < 16; ++i) O[db][i] = 0.f;
        float m = -INFINITY, l = 0.f;
        attn_run<12, 4, true, true, true>(qf, qlds, O, m, l, 0, 2 * nv, ka, va, mk);
        l += __shfl_xor(l, 32);
        if (act) { const float gate = sigmoidf_(bf2f(GT[mrow * 256 + 48 + hd])); store_col<true>(dry ? (bf16*)(ar + DUMMY_OFF) + ((size_t)F.gw * 32 + r) * 128 : Ob + mrow * 6144 + hd * 128, O, l > 0.f ? gate / l : 0.f, h); }
    }
}
DI void ph_nsa_win(const Frame& F, const int dry = 0) {
    unsigned char* ar = F.ws + WS_AR; const bf16* Q = (const bf16*)(ar + NA_Q); const bf16* KWF = (const bf16*)(ar + NA_KWF); const bf16* VWF = (const bf16*)(ar + NA_VWF); const bf16* GT = (const bf16*)(ar + NA_GT); bf16* Ob = (bf16*)(ar + NA_O);
    const int r = F.lane & 31, h = F.lane >> 5;
    LAS unsigned char* qlds = F.lds + F.wave * 12288 + F.lane * 16;
    for (int id = F.gw; id < BPH * 48 * 128; id += F.NGW) {
        const int qt = id & 127, bh = id >> 7, hd = bh % 48, bl = bh / 48, g = hd / 12, tq = qt * 32 + r; const size_t mrow = (size_t)bl * SEQ + tq;
        bf16x8 qf[12];
#pragma unroll
        for (int s = 0; s < 12; ++s) { qf[s] = *(const bf16x8*)(Q + mrow * 9216 + hd * 192 + 16 * s + 8 * h); *(LAS bf16x8*)(qlds + s * 1024) = qf[s]; }
        LDS_WAIT();
        const int bg = bl * 4 + g; const FragKA ka{KWF + ((size_t)bg * 128 * 12 * 64 + F.lane) * 8, 12}; const FragVA va{VWF + ((size_t)bg * 128 * 8 * 64 + F.lane) * 8}; const WinMK mk{tq, h};
        f32x16 O[4];
#pragma unroll
        for (int db = 0; db < 4; ++db)
#pragma unroll
            for (int i = 0; i < 16; ++i) O[db][i] = 0.f;
        float m = -INFINITY, l = 0.f;
        attn_run<12, 4, true, true, true>(qf, qlds, O, m, l, qt >= 16 ? qt - 16 : 0, qt + 1, ka, va, mk);
        l += __shfl_xor(l, 32);
        const float gate = sigmoidf_(bf2f(GT[mrow * 256 + 96 + hd]));
        store_col<true>(dry ? (bf16*)(ar + DUMMY_OFF) + ((size_t)F.gw * 32 + r) * 128 : Ob + mrow * 6144 + hd * 128, O, l > 0.f ? gate / l : 0.f, h);
    }
}
#ifndef MK_ONE_LAUNCH
#define MK_ONE_LAUNCH 1
#endif
constexpr int NPH = 98;
struct Args { const float* in[58]; float* out; unsigned char* ws; int ph_lo, ph_hi; };
#ifndef PROBE_GEMM
#define PROBE_GEMM 0
#endif
#ifndef PROBE_PH
#define PROBE_PH 0
#endif
#define GEMM_CALL(EpiT, Evar, Aptr, Bptr, Mv, Nv, Kv, ldav, ldbv, cidx) do { if (PROBE_GEMM) { const pg8::Gemm g0_{(const pg8::bf16_t*)(Aptr), (const pg8::bf16_t*)(Bptr), (Mv), (Nv), (Kv), (ldav), (ldbv)}; \
    pg8::StaticOrder S0_; S0_.init((Mv), (Nv), F.G, (cidx)); pg8::EpiDry E0_{(float*)(ar + DUMMY_OFF)}; pg8::gemm_phase<pg8::EpiDry, pg8::StaticOrder, true, true>((PG8_LAS unsigned char*)F.lds, g0_, S0_, E0_); __syncthreads(); } \
    const pg8::Gemm g_{(const pg8::bf16_t*)(Aptr), (const pg8::bf16_t*)(Bptr), (Mv), (Nv), (Kv), (ldav), (ldbv)}; \
    pg8::StaticOrder S_; S_.init((Mv), (Nv), F.G, (cidx)); pg8::gemm_phase<EpiT, pg8::StaticOrder, true, true>((PG8_LAS unsigned char*)F.lds, g_, S_, Evar); } while (0)
DI pg8::EpiBf16R epi1(bf16* base, int ldc) { pg8::EpiBf16R e; for (int s = 0; s < 8; ++s) { e.T.base[s] = base; e.T.ldc[s] = ldc; e.T.t0[s] = 0; e.T.gw[s] = 0; } e.T.nseg = 1; e.T.pad_ = 0; return e; }
#define PH_BEGIN if (ph >= lo && ph < hi) { Frame F; { unsigned long long w_ = (unsigned long long)args.ws; asm volatile("" : "+s"(w_)); F.ws = (unsigned char*)w_; F.ctl = (unsigned*)(F.ws + WS_CTL); } \
    F.lds = lds; F.tid = threadIdx.x; F.lane = F.tid & 63; F.wave = __builtin_amdgcn_readfirstlane(F.tid >> 6); F.G = gridDim.x; F.gw = blockIdx.x * NWAVES + F.wave; F.NGW = F.G * NWAVES; \
    float* out; { unsigned long long o_ = (unsigned long long)args.out; asm volatile("" : "+s"(o_)); out = (float*)o_; } \
    unsigned char* const ar = F.ws + WS_AR; bf16* const XN = (bf16*)(F.ws + WS_XN); bf16* const WB = (bf16*)(F.ws + WS_WMIX); bf16* const WUP = (bf16*)(F.ws + WS_WFFN); bf16* const WDN = WUP + (size_t)2 * DFF * DM; \
    const float* const res_mix = (ib == 2) ? args.in[0] : (const float*)out; (void)ar; (void)XN; (void)WB; (void)WUP; (void)WDN; (void)res_mix; (void)iff;
#define PH_END   if (ph + 1 < hi) { XcdBarrier b_; b_.bar = (unsigned*)F.ctl + CW_BAR; b_.x = xb_xcc_id(); b_.st = MISC + 8; xcd_barrier(b_); } } ++ph;
template <int LAYER> DI void run_cvt(const Args& args, LAS unsigned char* lds, volatile LAS unsigned* MISC, int& ph, const int lo, const int hi) {
    constexpr int ib = (LAYER == 0) ? 2 : (LAYER == 1) ? 17 : (LAYER == 2) ? 26 : 42;
    constexpr int iff = (LAYER == 0) ? 12 : (LAYER == 1) ? 21 : (LAYER == 2) ? 37 : 52;
    constexpr int kind = (LAYER == 1) ? 1 : (LAYER == 2) ? 2 : 0;
        PH_BEGIN
            if constexpr (kind == 0) ph_dsa_cvt(F, args.in[ib + 1], args.in[ib + 6], args.in[ib + 7], args.in[ib + 8], args.in[ib + 9]);
            else if constexpr (kind == 1) ph_fox_cvt(F, args.in[ib + 1], args.in[ib + 3]);
            else ph_nsa_cvt(F, args.in[ib + 1], args.in[ib + 2], args.in[ib + 3], args.in[ib + 4], args.in[ib + 5], args.in[ib + 6], args.in[ib + 7], args.in[ib + 8], args.in[ib + 9], args.in[ib + 10]);
            ph_cvt_ffn(F, args.in[iff + 1], args.in[iff + 4]);
        PH_END
}
template <int LAYER, int HALF> DI void run_half(const Args& args, LAS unsigned char* lds, volatile LAS unsigned* MISC, int& ph, const int lo, const int hi) {
    constexpr int ib = (LAYER == 0) ? 2 : (LAYER == 1) ? 17 : (LAYER == 2) ? 26 : 42;
    constexpr int iff = (LAYER == 0) ? 12 : (LAYER == 1) ? 21 : (LAYER == 2) ? 37 : 52;
    constexpr int kind = (LAYER == 1) ? 1 : (LAYER == 2) ? 2 : 0;
    constexpr int half = HALF;
            const int roff = half * MC;
            PH_BEGIN ph_rmsnorm(F, res_mix, roff, args.in[ib], XN); PH_END
            if constexpr (kind == 0) {
                PH_BEGIN { pg8::EpiF32 E{(float*)(ar + DA_DIN), 1024}; GEMM_CALL(pg8::EpiF32, E, XN, WB + DW_W1, MC, 1024, DM, DM, DM, (int)blockIdx.x); } PH_END
                PH_BEGIN ph_dsa_post1(F, half, args.in[ib + 2], args.in[ib + 3], args.in[ib + 4], args.in[ib + 5]); PH_END
                PH_BEGIN { pg8::EpiBf16R E = epi1((bf16*)(ar + DA_QL), 8192); E.T.base[1] = (bf16*)(ar + DA_QPE); E.T.ldc[1] = 1536; E.T.t0[1] = 32; E.T.base[2] = (bf16*)(ar + DA_QIDX); E.T.ldc[2] = 2048; E.T.t0[2] = 38; E.T.nseg = 3;
                    GEMM_CALL(pg8::EpiBf16R, E, ar + DA_CQN, WB + DW_W2, MC, 11776, 512, 512, 512, (int)blockIdx.x); } PH_END
                PH_BEGIN ph_dsa_rope(F, half); PH_END
                PH_BEGIN if (PROBE_PH == 1) { ph_dsa_index(F, 1); __syncthreads(); } ph_dsa_index(F); PH_END
                PH_BEGIN if (PROBE_PH == 2) { ph_dsa_attn(F, 1); __syncthreads(); } ph_dsa_attn(F); PH_END
                PH_BEGIN { pg8::EpiRes E{res_mix, out, DM, roff}; GEMM_CALL(pg8::EpiRes, E, ar + DA_QL, WB + DW_WO, MC, DM, 8192, 8192, 8192, (int)blockIdx.x); } PH_END
            } else if constexpr (kind == 1) {
                PH_BEGIN { pg8::EpiBf16R E = epi1((bf16*)(ar + FA_Q), DM); E.T.base[1] = (bf16*)(ar + FA_K); E.T.ldc[1] = DM; E.T.t0[1] = 8; E.T.base[2] = (bf16*)(ar + FA_V); E.T.ldc[2] = DM; E.T.t0[2] = 16;
                    E.T.base[3] = (bf16*)(ar + FA_F); E.T.ldc[3] = 256; E.T.t0[3] = 24; E.T.nseg = 4;
                    GEMM_CALL(pg8::EpiBf16R, E, XN, WB + FW_IN, MC, 6400, DM, DM, DM, (int)blockIdx.x); } PH_END
                PH_BEGIN ph_fox_scan(F, args.in[ib + 2]); PH_END
                PH_BEGIN if (PROBE_PH == 3) { ph_fox_attn(F, 1); __syncthreads(); } ph_fox_attn(F); PH_END
                PH_BEGIN { pg8::EpiRes E{res_mix, out, DM, roff}; GEMM_CALL(pg8::EpiRes, E, ar + FA_O, WB + FW_OUT, MC, DM, DM, DM, DM, (int)blockIdx.x); } PH_END
            } else {
                PH_BEGIN { pg8::EpiBf16R E = epi1((bf16*)(ar + NA_Q), 9216);
                    E.T.base[1] = (bf16*)(ar + NA_KC); E.T.ldc[1] = 192; E.T.t0[1] = 36; E.T.gw[1] = 192;
                    E.T.base[2] = (bf16*)(ar + NA_VC); E.T.ldc[2] = 128; E.T.t0[2] = 39; E.T.gw[2] = 128;
                    E.T.base[3] = (bf16*)(ar + NA_KSR); E.T.ldc[3] = 768; E.T.t0[3] = 41;
                    E.T.base[4] = (bf16*)(ar + NA_KWR); E.T.ldc[4] = 768; E.T.t0[4] = 44;
                    E.T.base[5] = (bf16*)(ar + NA_GT); E.T.ldc[5] = 256; E.T.t0[5] = 47;
                    E.T.base[6] = (bf16*)(ar + NA_VSR); E.T.ldc[6] = 512; E.T.t0[6] = 48;
                    E.T.base[7] = (bf16*)(ar + NA_VWR); E.T.ldc[7] = 512; E.T.t0[7] = 50; E.T.nseg = 8;
                    GEMM_CALL(pg8::EpiBf16R, E, XN, WB + NW_IN, MC, 13312, DM, DM, DM, (int)blockIdx.x); } PH_END
                PH_BEGIN ph_nsa_rope(F, half); PH_END
                PH_BEGIN {
                    const float* BIAS = (const float*)(args.ws + WS_MISC);
                    { pg8::EpiGelu E{(bf16*)(ar + NA_GK), 256, BIAS}; GEMM_CALL(pg8::EpiGelu, E, ar + NA_KC, WB + NW_W1K, 4096, 256, 6144, 3072, 6144, (int)blockIdx.x); }
                    { pg8::EpiGelu E{(bf16*)(ar + NA_GV), 256, BIAS + 256}; GEMM_CALL(pg8::EpiGelu, E, ar + NA_VC, WB + NW_W1V, 4096, 256, 4096, 2048, 4096, (int)((blockIdx.x + F.G - 16) % F.G)); }
                } PH_END
                PH_BEGIN {
                    { pg8::EpiBf16R E = epi1((bf16*)(ar + NA_KCMP), 256); GEMM_CALL(pg8::EpiBf16R, E, ar + NA_GK, WB + NW_W2K, 4096, 256, 256, 256, 256, (int)blockIdx.x); }
                    { pg8::EpiBf16R E = epi1((bf16*)(ar + NA_VCT), 4096); GEMM_CALL(pg8::EpiBf16R, E, WB + NW_W2V, ar + NA_GV, 256, 4096, 256, 256, 256, (int)((blockIdx.x + F.G - 16) % F.G)); }
                } PH_END
                PH_BEGIN if (PROBE_PH == 4) { ph_nsa_cmp(F, 1); __syncthreads(); } ph_nsa_cmp(F); PH_END
                PH_BEGIN if (PROBE_PH == 5) { ph_nsa_sel(F, 1); __syncthreads(); } ph_nsa_sel(F); PH_END
                PH_BEGIN if (PROBE_PH == 6) { ph_nsa_win(F, 1); __syncthreads(); } ph_nsa_win(F); PH_END
                PH_BEGIN { pg8::EpiRes E{res_mix, out, DM, roff}; GEMM_CALL(pg8::EpiRes, E, ar + NA_O, WB + NW_OUT, MC, DM, 6144, 6144, 6144, (int)blockIdx.x); } PH_END
            }
            PH_BEGIN ph_rmsnorm(F, out, roff, args.in[iff], XN); PH_END
            PH_BEGIN { pg8::EpiBf16R E = epi1((bf16*)ar, 2 * DFF); GEMM_CALL(pg8::EpiBf16R, E, XN, WUP, MC, 2 * DFF, DM, DM, DM, (int)blockIdx.x); } PH_END
            PH_BEGIN ph_conv_glu(F, (const bf16*)ar, (bf16*)(ar + 352 * MiB), args.in[iff + 2], args.in[iff + 3]); PH_END
            PH_BEGIN { pg8::EpiRes E{out, out, DM, roff}; GEMM_CALL(pg8::EpiRes, E, ar + 352 * MiB, WDN, MC, DM, DFF, DFF, DFF, (int)blockIdx.x); } PH_END
}
__global__ void __launch_bounds__(NWAVES * 64, 2) mk_fwd(Args args) {
    extern __shared__ __attribute__((aligned(16))) unsigned char lds_[];
    LAS unsigned char* const lds = (LAS unsigned char*)lds_;
    volatile LAS unsigned* MISC = (volatile LAS unsigned*)(lds + LDSCTL_OFF);
    for (int u = threadIdx.x; u < 64; u += NWAVES * 64) ((LAS unsigned*)(lds + LDSCTL_OFF))[u] = 0u;
    __syncthreads();
    const int lo = args.ph_lo, hi = args.ph_hi;
    (void)xcd_barrier_post((unsigned*)(args.ws + WS_CTL) + CW_BAR, MISC + 8);
    int ph = 0;
    { constexpr int ib = 2, iff = 12; PH_BEGIN ph_tables(F, (const int*)args.in[1]); PH_END }
    run_cvt<0>(args, lds, MISC, ph, lo, hi); run_half<0, 0>(args, lds, MISC, ph, lo, hi); run_half<0, 1>(args, lds, MISC, ph, lo, hi);
    run_cvt<1>(args, lds, MISC, ph, lo, hi); run_half<1, 0>(args, lds, MISC, ph, lo, hi); run_half<1, 1>(args, lds, MISC, ph, lo, hi);
    run_cvt<2>(args, lds, MISC, ph, lo, hi); run_half<2, 0>(args, lds, MISC, ph, lo, hi); run_half<2, 1>(args, lds, MISC, ph, lo, hi);
    run_cvt<3>(args, lds, MISC, ph, lo, hi); run_half<3, 0>(args, lds, MISC, ph, lo, hi); run_half<3, 1>(args, lds, MISC, ph, lo, hi);
    { constexpr int ib = 42, iff = 52; PH_BEGIN ph_final_norm(F, out, args.in[57]); PH_END }
}
extern "C" void kernel_launch(void* const* d_in, const int* in_sizes, int n_in, void* d_out, int out_size, void* d_ws, size_t ws_size, hipStream_t stream) {
    static int grid = 0;
    if (grid == 0) {
        if (n_in != 58 || out_size != MTOT * DM || ws_size < WS_END) { fprintf(stderr, "kernel_launch: unexpected shapes (n_in %d, out %d, ws %zu)\n", n_in, out_size, ws_size); grid = -1; return; }
        int dev = 0, cus = 0;
        if (hipGetDevice(&dev) != hipSuccess || hipDeviceGetAttribute(&cus, hipDeviceAttributeMultiprocessorCount, dev) != hipSuccess) { grid = -1; return; }
        if (hipFuncSetAttribute((const void*)mk_fwd, hipFuncAttributeMaxDynamicSharedMemorySize, LDS_BYTES) != hipSuccess) { fprintf(stderr, "kernel_launch: hipFuncSetAttribute failed\n"); grid = -1; return; }
        int per_cu = 0;
        (void)hipOccupancyMaxActiveBlocksPerMultiprocessor(&per_cu, (const void*)mk_fwd, NWAVES * 64, LDS_BYTES);
        (void)hipGetLastError();
        grid = cus;
    }
    if (grid < 0) return;
    if (hipMemsetAsync((char*)d_ws + WS_CTL, 0, CTL_ZERO_BYTES, stream) != hipSuccess) return;
    Args a{};
    for (int i = 0; i < 58; ++i) a.in[i] = (const float*)d_in[i];
    a.out = (float*)d_out; a.ws = (unsigned char*)d_ws;
#if MK_ONE_LAUNCH
    a.ph_lo = 0; a.ph_hi = NPH;
    hipLaunchKernelGGL(mk_fwd, dim3(grid), dim3(NWAVES * 64), LDS_BYTES, stream, a);
#else
    for (int p = 0; p < NPH; ++p) { a.ph_lo = p; a.ph_hi = p + 1; hipLaunchKernelGGL(mk_fwd, dim3(grid), dim3(NWAVES * 64), LDS_BYTES, stream, a); }
#endif
}
```

```cpp
#include <hip/hip_runtime.h>
#include <cstdio>
#include <cstdint>
#define DI __device__ __forceinline__
namespace pg8 {
#define PG8_LAS __attribute__((address_space(3)))
typedef unsigned short bf16_t;
typedef short bf16x8 __attribute__((ext_vector_type(8)));
typedef float f32x4 __attribute__((ext_vector_type(4)));
typedef unsigned u32x4 __attribute__((ext_vector_type(4)));
constexpr int BM = 256, BK = 64, HALF = 128, HTB = HALF * BK * 2  , STAGE_BYTES = 8 * HTB, NXCD = 8, WGM = 8;

__host__ __device__ __forceinline__ int lds_byte(int r, int c) { const int st = (r >> 4) * 2 + (c >> 5), rr = r & 15, cc = c & 31, ob = rr * 64 + cc * 2; return st * 1024 + (ob ^ (((ob >> 9) & 1) << 5)); }
__host__ __device__ __forceinline__ void stage_rc(int b, int& R, int& C) { const int st = b / 1024, sb = b % 1024, swz = sb ^ (((sb >> 9) & 1) << 5); R = (st >> 1) * 16 + swz / 64; C = (st & 1) * 32 + (swz % 64) / 2; }
__host__ __device__ __forceinline__ int perm32(int rho) { const int n = rho >> 4, i = rho & 15; return 8 * (i >> 2) + 4 * n + (i & 3); }

struct Unit { int pm, pn; };
struct Gemm { const bf16_t* A; const bf16_t* Bt; int M, N, K, lda, ldb; };

struct StaticOrder {
    int nM, nN, nwg, G, c;
    __host__ __device__ void init(int M, int N, int G_, int c_) { nM = M / BM; nN = N / BM; nwg = nM * nN; G = G_; c = c_; }
    __host__ __device__ bool next(int i, Unit& u) const {
        const long L = (long)i * G + c; if (L >= nwg) return false;
        int wgid = (int)L; { const int q = nwg / NXCD, r = nwg % NXCD, xcd = wgid % NXCD, off = wgid / NXCD; wgid = (xcd < r ? xcd * (q + 1) : r * (q + 1) + (xcd - r) * q) + off; }
        const int nig = WGM * nN, gid = wgid / nig, fm = gid * WGM, gsz = (nM - fm) < WGM ? (nM - fm) : WGM;
        u.pm = fm + ((wgid % nig) % gsz); u.pn = (wgid % nig) / gsz; return true;
    }
    __device__ __forceinline__ void a_ready(const Unit&) const {}
    __device__ __forceinline__ void done(const Unit&) const {}
};
__device__ __forceinline__ unsigned cvt_pk_bf16(float lo, float hi) { unsigned r; asm volatile("v_cvt_pk_bf16_f32 %0, %1, %2" : "=v"(r) : "v"(lo), "v"(hi)); return r; }
template <class Epi, class Sched, bool ALIGN_EPI = false, bool SP2 = false>
__device__ __forceinline__ void gemm_phase(PG8_LAS unsigned char* lds, const Gemm g, const Sched& S, const Epi& E) {
    const int tid = threadIdx.x, wid = __builtin_amdgcn_readfirstlane(tid >> 6), lane = tid & 63, wr = wid >> 2, wc = wid & 3, fr = lane & 15, fq = lane >> 4;
    const int K = g.K, nt = K / BK;
    unsigned voffA[2], voffB[2];
#pragma unroll
    for (int i = 0; i < 2; ++i) { int R, C; stage_rc(tid * 16 + i * 8192, R, C); const int Rb = Epi::PERM ? ((R & ~31) + perm32(R & 31)) : R;
        voffA[i] = (unsigned)(R * g.lda + C) * 2u; voffB[i] = (unsigned)(Rb * g.ldb + C) * 2u; }
    const size_t kstep = (size_t)(BK * 2);
    const size_t hstepA = (size_t)HALF * g.lda * 2, hstepB = (size_t)HALF * g.ldb * 2;
    const size_t tstepA = 2 * hstepA, tstepB = 2 * hstepB;
    const unsigned ldsw = (unsigned)wid * 1024u;
    const int aoff = lds_byte(wr * 64 + fr, fq * 8), boff = lds_byte(wc * 32 + fr, fq * 8);
#define PG8_SA(b, h) (((b) * 2 + (h)) * HTB)
#define PG8_SB(b, h) ((4 + (b) * 2 + (h)) * HTB)
#define PG8_STAGE(bufoff, gbase, voff) do { _Pragma("unroll") for (int _i = 0; _i < 2; ++_i) \
        __builtin_amdgcn_global_load_lds((const unsigned*)((const char*)(gbase) + (voff)[_i]), (PG8_LAS unsigned*)(lds + (bufoff) + ldsw + _i * 8192), 16, 0, 0); } while (0)
#define PG8_LDA(dst, b, h) do { _Pragma("unroll") for (int m = 0; m < 4; ++m) _Pragma("unroll") for (int k = 0; k < 2; ++k) dst[m][k] = *(const PG8_LAS bf16x8*)(lds + PG8_SA(b, h) + aoff + m * 2048 + k * 1024); } while (0)
#define PG8_LDB(dst, b, h) do { _Pragma("unroll") for (int n = 0; n < 2; ++n) _Pragma("unroll") for (int k = 0; k < 2; ++k) dst[n][k] = *(const PG8_LAS bf16x8*)(lds + PG8_SB(b, h) + boff + n * 2048 + k * 1024); } while (0)
#define PG8_MMA(ai, bj, At, Bt) do { __builtin_amdgcn_s_setprio(1); _Pragma("unroll") for (int m = 0; m < 4; ++m) _Pragma("unroll") for (int n = 0; n < 2; ++n) _Pragma("unroll") for (int k = 0; k < 2; ++k) \
        acc[ai][bj][m][n] = __builtin_amdgcn_mfma_f32_16x16x32_bf16(Bt[n][k], At[m][k], acc[ai][bj][m][n], 0, 0, 0); __builtin_amdgcn_s_setprio(0); } while (0)
#define PG8_WAIT_V(n) asm volatile("s_waitcnt vmcnt(" #n ")" ::: "memory")
#define PG8_WAIT_L(n) asm volatile("s_waitcnt lgkmcnt(" #n ")" ::: "memory")
#define PG8_BAR __builtin_amdgcn_s_barrier()
#define PG8_SCHED __builtin_amdgcn_sched_barrier(0)
    Unit cur, nxt; int ui = 0;
    if (!S.next(0, cur)) return;
    f32x4 acc[2][2][4][2];
#pragma unroll
    for (int a = 0; a < 2; ++a)
#pragma unroll
        for (int b = 0; b < 2; ++b)
#pragma unroll
            for (int m = 0; m < 4; ++m)
#pragma unroll
                for (int n = 0; n < 2; ++n) acc[a][b][m][n] = (f32x4){0.f, 0.f, 0.f, 0.f};
    bf16x8 At[4][2], B0[2][2], B1[2][2];
    const char* cA = (const char*)g.A + (size_t)cur.pm * tstepA; const char* cB = (const char*)g.Bt + (size_t)cur.pn * tstepB;
    S.a_ready(cur);
    if constexpr (SP2) {
        PG8_STAGE(PG8_SB(0, 0), cB, voffB); PG8_STAGE(PG8_SB(0, 1), cB + hstepB, voffB); PG8_STAGE(PG8_SA(0, 0), cA, voffA); PG8_STAGE(PG8_SA(0, 1), cA + hstepA, voffA);
        if (wr == 1) PG8_BAR;
        PG8_WAIT_V(2); PG8_BAR;
        PG8_STAGE(PG8_SB(1, 0), cB + kstep, voffB); PG8_STAGE(PG8_SA(1, 0), cA + kstep, voffA); PG8_STAGE(PG8_SB(1, 1), cB + hstepB + kstep, voffB);
        PG8_WAIT_V(6); PG8_BAR;
    } else {
        PG8_STAGE(PG8_SB(0, 0), cB, voffB); PG8_STAGE(PG8_SA(0, 0), cA, voffA); PG8_STAGE(PG8_SB(0, 1), cB + hstepB, voffB); PG8_STAGE(PG8_SA(0, 1), cA + hstepA, voffA);
        if (wr == 1) PG8_BAR;
        PG8_WAIT_V(4); PG8_BAR;
        PG8_STAGE(PG8_SB(1, 0), cB + kstep, voffB); PG8_STAGE(PG8_SA(1, 0), cA + kstep, voffA); PG8_STAGE(PG8_SB(1, 1), cB + hstepB + kstep, voffB);
        PG8_WAIT_V(6); PG8_BAR;
    }
    for (;;) {
        const bool has_next = S.next(ui + 1, nxt);
        const char* nA = has_next ? (const char*)g.A + (size_t)nxt.pm * tstepA : cA; const char* nB = has_next ? (const char*)g.Bt + (size_t)nxt.pn * tstepB : cB;
        for (int t = 0; t < nt; t += 2) {
            const bool last = (t == nt - 2);
            const char* a1 = cA + (size_t)(t + 1) * kstep;
            const char* a2 = last ? nA : cA + (size_t)(t + 2) * kstep; const char* b2 = last ? nB : cB + (size_t)(t + 2) * kstep;
            const char* a3 = a2 + kstep; const char* b3 = b2 + kstep;
            if (last && has_next) S.a_ready(nxt);
            if constexpr (SP2) {
            PG8_LDB(B0, 0, 0); PG8_LDB(B1, 0, 1); PG8_SCHED; PG8_LDA(At, 0, 0); PG8_STAGE(PG8_SA(1, 1), a1 + hstepA, voffA);
            PG8_WAIT_V(8); PG8_WAIT_L(0); PG8_BAR; PG8_MMA(0, 0, At, B0); PG8_MMA(0, 1, At, B1); PG8_BAR; PG8_SCHED;
            PG8_LDA(At, 0, 1); PG8_STAGE(PG8_SB(0, 0), b2, voffB); PG8_STAGE(PG8_SB(0, 1), b2 + hstepB, voffB); PG8_STAGE(PG8_SA(0, 0), a2, voffA);
            PG8_WAIT_V(8); PG8_WAIT_L(0); PG8_BAR; PG8_MMA(1, 0, At, B0); PG8_MMA(1, 1, At, B1); PG8_BAR; PG8_SCHED;
            PG8_LDB(B0, 1, 0); PG8_LDB(B1, 1, 1); PG8_SCHED; PG8_LDA(At, 1, 0); PG8_STAGE(PG8_SA(0, 1), a2 + hstepA, voffA);
            PG8_WAIT_V(8); PG8_WAIT_L(0); PG8_BAR; PG8_MMA(0, 0, At, B0); PG8_MMA(0, 1, At, B1); PG8_BAR; PG8_SCHED;
            PG8_LDA(At, 1, 1); PG8_STAGE(PG8_SB(1, 0), b3, voffB); PG8_STAGE(PG8_SB(1, 1), b3 + hstepB, voffB); PG8_STAGE(PG8_SA(1, 0), a3, voffA);
            PG8_WAIT_V(8); PG8_WAIT_L(0); PG8_BAR; PG8_MMA(1, 0, At, B0); PG8_MMA(1, 1, At, B1); PG8_BAR; PG8_SCHED;
            } else {
            PG8_LDB(B0, 0, 0); PG8_SCHED; PG8_LDA(At, 0, 0); PG8_STAGE(PG8_SA(1, 1), a1 + hstepA, voffA);
            PG8_WAIT_L(8); PG8_BAR; PG8_WAIT_L(0); PG8_MMA(0, 0, At, B0); PG8_BAR; PG8_SCHED;
            PG8_LDB(B1, 0, 1); PG8_STAGE(PG8_SB(0, 0), b2, voffB);
            PG8_BAR; PG8_WAIT_L(0); PG8_MMA(0, 1, At, B1); PG8_BAR;
            PG8_LDA(At, 0, 1); PG8_STAGE(PG8_SA(0, 0), a2, voffA);
            PG8_BAR; PG8_WAIT_L(0); PG8_MMA(1, 0, At, B0); PG8_BAR; PG8_SCHED;
            PG8_STAGE(PG8_SB(0, 1), b2 + hstepB, voffB);
            PG8_WAIT_V(6); PG8_BAR; PG8_MMA(1, 1, At, B1); PG8_BAR;
            PG8_LDB(B0, 1, 0); PG8_SCHED; PG8_LDA(At, 1, 0); PG8_STAGE(PG8_SA(0, 1), a2 + hstepA, voffA);
            PG8_WAIT_L(8); PG8_BAR; PG8_WAIT_L(0); PG8_MMA(0, 0, At, B0); PG8_BAR; PG8_SCHED;
            PG8_LDB(B1, 1, 1); PG8_STAGE(PG8_SB(1, 0), b3, voffB);
            PG8_BAR; PG8_WAIT_L(0); PG8_MMA(0, 1, At, B1); PG8_BAR;
            PG8_LDA(At, 1, 1); PG8_STAGE(PG8_SA(1, 0), a3, voffA);
            PG8_BAR; PG8_WAIT_L(0); PG8_MMA(1, 0, At, B0); PG8_BAR; PG8_SCHED;
            PG8_STAGE(PG8_SB(1, 1), b3 + hstepB, voffB);
            PG8_WAIT_V(6); PG8_BAR; PG8_MMA(1, 1, At, B1); PG8_BAR;
            }
        }
        if constexpr (ALIGN_EPI) { if (wr == 0) PG8_BAR; }
        if constexpr (!Epi::AFTER_DRAIN) { E(acc, cur, wr, wc, fr, fq); S.done(cur); }
        if (!has_next) break;
#pragma unroll
        for (int a = 0; a < 2; ++a)
#pragma unroll
            for (int b = 0; b < 2; ++b)
#pragma unroll
                for (int m = 0; m < 4; ++m)
#pragma unroll
                    for (int n = 0; n < 2; ++n) acc[a][b][m][n] = (f32x4){0.f, 0.f, 0.f, 0.f};
        cur = nxt; cA = nA; cB = nB; ++ui;
        if constexpr (ALIGN_EPI) { if (wr == 1) PG8_BAR; }
    }
    PG8_WAIT_V(0);
    if constexpr (!ALIGN_EPI) { if (wr == 0) PG8_BAR; }
    PG8_BAR;
    if constexpr (Epi::AFTER_DRAIN) { E.fused(acc, cur, wr, wc, fr, fq, lds, wid, lane); S.done(cur); }
#undef PG8_SA
#undef PG8_SB
#undef PG8_STAGE
#undef PG8_LDA
#undef PG8_LDB
#undef PG8_MMA
#undef PG8_WAIT_V
#undef PG8_WAIT_L
#undef PG8_BAR
#undef PG8_SCHED
}
}
namespace pg8 {
typedef float f32x2 __attribute__((ext_vector_type(2)));
struct SegTab { bf16_t* base[8]; int ldc[8]; int t0[8]; int gw[8]; int nseg; int pad_; };
struct EpiBf16R {
    static constexpr bool PERM = true, AFTER_DRAIN = false;
    SegTab T;
    __device__ __forceinline__ void operator()(const f32x4 (&acc)[2][2][4][2], const Unit& u, int wr, int wc, int fr, int fq) const {
        bf16_t* base = T.base[0]; int ldc = T.ldc[0], gw = T.gw[0], t0 = T.t0[0];
#pragma unroll
        for (int s = 1; s < 8; ++s) if (s < T.nseg && u.pn >= T.t0[s]) { base = T.base[s]; ldc = T.ldc[s]; gw = T.gw[s]; t0 = T.t0[s]; }
        const int colt = (u.pn - t0) * BM, row0 = u.pm * BM + wr * 64 + fr;
#pragma unroll
        for (int ai = 0; ai < 2; ++ai)
#pragma unroll
            for (int m = 0; m < 4; ++m) { const int row = row0 + ai * HALF + m * 16;
#pragma unroll
                for (int bj = 0; bj < 2; ++bj) { const int col = colt + bj * HALF + wc * 32 + 8 * fq;
                    const f32x4 v0 = acc[ai][bj][m][0], v1 = acc[ai][bj][m][1];
                    u32x4 w; w.x = cvt_pk_bf16(v0[0], v0[1]); w.y = cvt_pk_bf16(v0[2], v0[3]); w.z = cvt_pk_bf16(v1[0], v1[1]); w.w = cvt_pk_bf16(v1[2], v1[3]);
                    if (gw == -2) {
                        if ((row >> 5) < ldc) { bf16_t* d0 = base + ((size_t)(((col >> 5) * ldc + (row >> 5)) * 2 + ((col >> 4) & 1)) * 64 + (row & 31)) * 8 + 4 * ((col >> 3) & 1);
                            typedef unsigned u32x2_ __attribute__((ext_vector_type(2)));
                            *(u32x2_*)d0 = (u32x2_){w.x, w.y}; *(u32x2_*)(d0 + 32 * 8) = (u32x2_){w.z, w.w}; }
                        continue; }
                    bf16_t* dst;
                    if (gw == 0) dst = base + (size_t)row * ldc + col;
                    else if (gw == -1) { if ((col >> 4) >= ldc) continue; dst = base + ((size_t)((row >> 5) * ldc + (col >> 4)) * 64 + ((col >> 3) & 1) * 32 + (row & 31)) * 8; }
                    else { const int g = col / gw, d = col - g * gw; dst = base + ((size_t)((row >> 12) * 4 + g) * 4096 + (row & 4095)) * gw + d; }
                    *(u32x4*)dst = w; } }
    }
};
struct EpiGelu {
    static constexpr bool PERM = true, AFTER_DRAIN = false;
    bf16_t* O; int ldc; const float* bias;
    static __device__ __forceinline__ float gelu(float x) { const float u2 = 1.5957691216f * (x + 0.044715f * x * x * x); const float e = __builtin_amdgcn_exp2f(-u2 * 1.4426950409f); return x * __builtin_amdgcn_rcpf(1.0f + e); }
    __device__ __forceinline__ void operator()(const f32x4 (&acc)[2][2][4][2], const Unit& u, int wr, int wc, int fr, int fq) const {
        const int row0 = u.pm * BM + wr * 64 + fr, col0 = u.pn * BM + wc * 32 + 8 * fq;
#pragma unroll
        for (int bj = 0; bj < 2; ++bj) { const f32x4 b0 = *(const f32x4*)(bias + col0 + bj * HALF), b1 = *(const f32x4*)(bias + col0 + bj * HALF + 4);
#pragma unroll
            for (int ai = 0; ai < 2; ++ai)
#pragma unroll
                for (int m = 0; m < 4; ++m) { const f32x4 v0 = acc[ai][bj][m][0] + b0, v1 = acc[ai][bj][m][1] + b1;
                    u32x4 w; w.x = cvt_pk_bf16(gelu(v0[0]), gelu(v0[1])); w.y = cvt_pk_bf16(gelu(v0[2]), gelu(v0[3])); w.z = cvt_pk_bf16(gelu(v1[0]), gelu(v1[1])); w.w = cvt_pk_bf16(gelu(v1[2]), gelu(v1[3]));
                    *(u32x4*)(O + (size_t)(row0 + ai * HALF + m * 16) * ldc + col0 + bj * HALF) = w; } }
    }
};
struct EpiF32 {
    static constexpr bool PERM = false, AFTER_DRAIN = false;
    float* C; int ldc;
    __device__ __forceinline__ void operator()(const f32x4 (&acc)[2][2][4][2], const Unit& u, int wr, int wc, int fr, int fq) const {
        const int row0 = u.pm * BM + wr * 64 + fr, col0 = u.pn * BM + wc * 32 + 4 * fq;
#pragma unroll
        for (int ai = 0; ai < 2; ++ai)
#pragma unroll
            for (int m = 0; m < 4; ++m) { float* rowp = C + (size_t)(row0 + ai * HALF + m * 16) * ldc + col0;
#pragma unroll
                for (int bj = 0; bj < 2; ++bj)
#pragma unroll
                    for (int n = 0; n < 2; ++n) *(f32x4*)(rowp + bj * HALF + n * 16) = acc[ai][bj][m][n]; }
    }
};
struct EpiRes {
    static constexpr bool PERM = false, AFTER_DRAIN = false;
    const float* res; float* out; int ldc; int row_off;
    __device__ __forceinline__ void operator()(const f32x4 (&acc)[2][2][4][2], const Unit& u, int wr, int wc, int fr, int fq) const {
        const int row0 = row_off + u.pm * BM + wr * 64 + fr, col0 = u.pn * BM + wc * 32 + 4 * fq;
#pragma unroll
        for (int ai = 0; ai < 2; ++ai)
#pragma unroll
            for (int m = 0; m < 4; ++m) { const size_t off = (size_t)(row0 + ai * HALF + m * 16) * ldc + col0;
                f32x4 r[2][2];
#pragma unroll
                for (int bj = 0; bj < 2; ++bj)
#pragma unroll
                    for (int n = 0; n < 2; ++n) r[bj][n] = *(const f32x4*)(res + off + bj * HALF + n * 16);
#pragma unroll
                for (int bj = 0; bj < 2; ++bj)
#pragma unroll
                    for (int n = 0; n < 2; ++n) *(f32x4*)(out + off + bj * HALF + n * 16) = r[bj][n] + acc[ai][bj][m][n];
                asm volatile("" ::: "memory"); }
    }
};
struct EpiDry {
    static constexpr bool PERM = false, AFTER_DRAIN = false;
    float* D;
    __device__ __forceinline__ void operator()(const f32x4 (&acc)[2][2][4][2], const Unit& u, int wr, int wc, int fr, int fq) const {
        float* p = D + ((size_t)blockIdx.x * 512 + threadIdx.x) * 64;
#pragma unroll
        for (int ai = 0; ai < 2; ++ai)
#pragma unroll
            for (int m = 0; m < 4; ++m)
#pragma unroll
                for (int bj = 0; bj < 2; ++bj) *(f32x4*)(p + ((ai * 4 + m) * 2 + bj) * 4) = acc[ai][bj][m][0] + acc[ai][bj][m][1];
    }
};
}
constexpr int BATCH = 8, SEQ = 4096, DM = 2048, MTOT = BATCH * SEQ, MC = MTOT / 2  , BPH = BATCH / 2;
constexpr int DFF = 5632;
constexpr float NORM_EPS = 1e-6f, LOG2E = 1.4426950408889634f;
constexpr int NWAVES = 8;
constexpr size_t MiB = 1u << 20;
constexpr size_t WS_CTL = 0, CTL_ZERO_BYTES = 1 * MiB;
constexpr size_t WS_TAB = 1 * MiB;
constexpr size_t TAB_COS48 = WS_TAB, TAB_SIN48 = WS_TAB + 3 * MiB, TAB_COS32 = WS_TAB + 6 * MiB, TAB_SIN32 = WS_TAB + 8 * MiB;
constexpr size_t WS_WMIX = 12 * MiB;
constexpr size_t WS_WFFN = 100 * MiB;
constexpr size_t WS_MISC = 168 * MiB;
constexpr size_t WS_XN = 170 * MiB;
constexpr size_t WS_AR = 234 * MiB;
constexpr size_t WS_END = 1010 * MiB;
constexpr size_t DUMMY_OFF = 700 * MiB;
constexpr int CW_TMO = 0;
constexpr int CW_BAR = 4096;
constexpr int RING_BYTES = 131072;
constexpr int LDSCTL_OFF = 135168;
constexpr int LDS_BYTES = 147456;

#define GAS __attribute__((address_space(1)))
#define LAS __attribute__((address_space(3)))
typedef unsigned short bf16;
typedef unsigned u32x4 __attribute__((ext_vector_type(4)));
typedef unsigned u32x2 __attribute__((ext_vector_type(2)));
typedef float f32x4 __attribute__((ext_vector_type(4)));
typedef float f32x16 __attribute__((ext_vector_type(16)));
typedef short bf16x8 __attribute__((ext_vector_type(8)));
typedef short s16x4 __attribute__((ext_vector_type(4)));
typedef short v4i16_t __attribute__((ext_vector_type(4)));
typedef __bf16 bf16x2_t __attribute__((ext_vector_type(2)));
typedef float f32x2_t __attribute__((ext_vector_type(2)));
#define LDS_WAIT() asm volatile("s_waitcnt lgkmcnt(0)" ::: "memory")
#define VM_WAIT() asm volatile("s_waitcnt vmcnt(0)" ::: "memory")
#define MFMA32(a, b, c) __builtin_amdgcn_mfma_f32_32x32x16_bf16((a), (b), (c), 0, 0, 0)
DI unsigned pk2(float lo, float hi) { f32x2_t v = {lo, hi}; bf16x2_t b = __builtin_convertvector(v, bf16x2_t); return __builtin_bit_cast(unsigned, b); }
DI float bf2f(unsigned short b) { return __builtin_bit_cast(float, (unsigned)b << 16); }
DI float bflo(unsigned w) { return __builtin_bit_cast(float, w << 16); }
DI float bfhi(unsigned w) { return __builtin_bit_cast(float, w & 0xffff0000u); }
DI unsigned short f2bf(float f) { return (unsigned short)(pk2(f, 0.f) & 0xffffu); }
DI float wave_sum(float v) {
#pragma unroll
    for (int o = 1; o < 64; o <<= 1) v += __shfl_xor(v, o);
    return v;
}
DI int crow(int i, int h) { return (i & 3) + 8 * (i >> 2) + 4 * h; }
#define XB_TMO      128
#define XB_XCNT(j)  (256  + 64 * (j))
#define XB_XSUB(j)  (1280 + 64 * (j))
#define XB_XGEN(j)  (2304 + 64 * (j))
#define XB_TOP      3328
#define XB_TOPGEN   3392
#define XCD_BAR_WORDS 3456
#define XB_SPIN_CAP (1u << 18)

__device__ __forceinline__ unsigned xb_ld(unsigned* p)              { return __hip_atomic_load(p, __ATOMIC_RELAXED, __HIP_MEMORY_SCOPE_AGENT); }
__device__ __forceinline__ unsigned xb_add(unsigned* p, unsigned v) { return __hip_atomic_fetch_add(p, v, __ATOMIC_RELAXED, __HIP_MEMORY_SCOPE_AGENT); }
__device__ __forceinline__ unsigned xb_xcc_id() { return (unsigned)__builtin_amdgcn_s_getreg((3 << 11) | 20) & 0xFu; }
#define XB_SPIN(cond, bar) do { unsigned _sp = 0; while (cond) { __builtin_amdgcn_s_sleep(1); \
    if ((++_sp & 255u) == 0u) { if (xb_ld(&(bar)[XB_TMO])) break; if (_sp > XB_SPIN_CAP) { atomicAdd(&(bar)[XB_TMO], 1u); break; } } } } while (0)

struct XcdBarrier {
    unsigned* bar; unsigned x;
    volatile LAS unsigned* st;
};

__device__ __forceinline__ XcdBarrier xcd_barrier_post(unsigned* bar, volatile LAS unsigned* st) {
    XcdBarrier b; b.bar = bar; b.x = xb_xcc_id(); b.st = st;
    if (threadIdx.x == 0) (void)xb_add(&bar[XB_XCNT(b.x)], 1u);
    return b;
}
__device__ __forceinline__ void xcd_barrier_complete(unsigned* bar, unsigned x, unsigned& nloc, unsigned& nx) {
    const unsigned G = gridDim.x * gridDim.y * gridDim.z;
    unsigned sum, cnt, mine, sp = 0u;
    for (;;) {
        sum = 0u; cnt = 0u; mine = 0u;
#pragma unroll
        for (unsigned j = 0; j < 16; ++j) { const unsigned c = xb_ld(&bar[XB_XCNT(j)]); sum += c; cnt += (c > 0u) ? 1u : 0u; mine = (j == x) ? c : mine; }
        if (sum == G) break;
        __builtin_amdgcn_s_sleep(1);
        if ((++sp & 255u) == 0u) { if (xb_ld(&bar[XB_TMO])) break; if (sp > XB_SPIN_CAP) { atomicAdd(&bar[XB_TMO], 1u); break; } }
    }
    nloc = mine > 0u ? mine : 1u; nx = cnt > 0u ? cnt : 1u;
}

__device__ __forceinline__ void xcd_barrier(const XcdBarrier& b) {
    asm volatile("s_waitcnt vmcnt(0)" ::: "memory");
    __syncthreads();
    if (threadIdx.x == 0) {
        unsigned* bar = b.bar;
        __builtin_amdgcn_s_waitcnt(0);
        unsigned nloc = b.st[0], nx = b.st[1];
        if (nloc == 0u) { xcd_barrier_complete(bar, b.x, nloc, nx); b.st[0] = nloc; b.st[1] = nx; }
        const unsigned old = xb_add(&bar[XB_XSUB(b.x)], 1u);
        const unsigned gen = old / nloc;
        if (old + 1u == (gen + 1u) * nloc) {
            __builtin_amdgcn_fence(__ATOMIC_RELEASE, "agent");
            asm volatile("s_waitcnt vmcnt(0)" ::: "memory");
            const unsigned og = xb_add(&bar[XB_TOP], 1u);
            const unsigned tg = og / nx;
            if (og + 1u == (tg + 1u) * nx) xb_add(&bar[XB_TOPGEN], 1u);
            else XB_SPIN(xb_ld(&bar[XB_TOPGEN]) == tg, bar);
            __builtin_amdgcn_fence(__ATOMIC_ACQUIRE, "agent");
            xb_add(&bar[XB_XGEN(b.x)], 1u);
            asm volatile("s_waitcnt vmcnt(0)" ::: "memory");
        } else {
            XB_SPIN(xb_ld(&bar[XB_XGEN(b.x)]) == gen, bar);
            __builtin_amdgcn_fence(__ATOMIC_ACQUIRE, "agent");
            asm volatile("s_waitcnt vmcnt(0)" ::: "memory");
        }
    }
    __syncthreads();
}
struct Frame {
    LAS unsigned char* lds; unsigned* ctl; unsigned char* ws;
    int tid, lane, wave, G, gw, NGW;
};
DI void ph_tables(const Frame& F, const int* pos) {
    float* c48 = (float*)(F.ws + TAB_COS48); float* s48 = (float*)(F.ws + TAB_SIN48); float* c32 = (float*)(F.ws + TAB_COS32); float* s32 = (float*)(F.ws + TAB_SIN32);
    const int gt = blockIdx.x * (NWAVES * 64) + F.tid, NT = F.G * NWAVES * 64;
    for (int i = gt; i < MTOT * 40; i += NT) {
        const int m = i / 40, j = i - m * 40; const float p = (float)pos[m];
        const bool a = j < 24; const int jj = a ? j : j - 24;
        const float inv = (float)exp(-(2.0 * jj / (a ? 48.0 : 32.0)) * 13.122363377404328);
        const float ang = p * inv; float sn, cs; sincosf(ang, &sn, &cs);
        if (a) { c48[m * 24 + jj] = cs; s48[m * 24 + jj] = sn; } else { c32[m * 16 + jj] = cs; s32[m * 16 + jj] = sn; }
    }
}
DI void cvt_item(const float* W, int ldw, int col0, int ncols, bf16* WT, int ldt, int row_off, float scale, LAS float* scr, int item, int nblk, int lane) {
    const int kb = item / nblk, nb = item - kb * nblk, k0 = 64 * kb, n0 = 32 * nb;
    const int nn = n0 + (lane & 31); const bool ok = nn < ncols;
#pragma unroll 8
    for (int i = 0; i < 32; ++i) { const int kk = 2 * i + (lane >> 5); scr[kk * 33 + (lane & 31)] = ok ? W[(size_t)(k0 + kk) * ldw + col0 + nn] * scale : 0.f; }
    LDS_WAIT();
    const int c = lane & 7;
#pragma unroll
    for (int j = 0; j < 4; ++j) { const int n = (lane >> 3) + 8 * j; const LAS float* s = scr + (8 * c) * 33 + n;
        u32x4 o; o.x = pk2(s[0 * 33], s[1 * 33]); o.y = pk2(s[2 * 33], s[3 * 33]); o.z = pk2(s[4 * 33], s[5 * 33]); o.w = pk2(s[6 * 33], s[7 * 33]);
        if (n0 + n < ncols) *(u32x4*)(WT + (size_t)(row_off + n0 + n) * ldt + k0 + 8 * c) = o; }
    LDS_WAIT();
}
DI void cvt_job(const Frame& F, const float* W, int ldw, int K, int col0, int ncols, bf16* WT, int ldt, int row_off, float scale) {
    LAS float* scr = (LAS float*)(F.lds + F.wave * 16384);
    const int nblk = (ncols + 31) / 32, nitems = (K / 64) * nblk;
    for (int it = F.gw; it < nitems; it += F.NGW) cvt_item(W, ldw, col0, ncols, WT, ldt, row_off, scale, scr, it, nblk, F.lane);
}
DI void zero_bf16(const Frame& F, bf16* p, size_t nelem) {
    const size_t gt = (size_t)blockIdx.x * (NWAVES * 64) + F.tid, NT = (size_t)F.G * NWAVES * 64;
    for (size_t i = gt; i < nelem / 8; i += NT) ((u32x4*)p)[i] = (u32x4){0u, 0u, 0u, 0u};
}
DI void ph_cvt_ffn(const Frame& F, const float* up, const float* down) {
    bf16* WUP = (bf16*)(F.ws + WS_WFFN); bf16* WDN = WUP + (size_t)2 * DFF * DM;
    cvt_job(F, up, 2 * DFF, DM, 0, 2 * DFF, WUP, DM, 0, 1.f);
    cvt_job(F, down, DM, DFF, 0, DM, WDN, DFF, 0, 1.f);
}
DI void ph_rmsnorm(const Frame& F, const float* src, int row_off, const float* gain, bf16* XN) {
    f32x4 g[8];
#pragma unroll
    for (int j = 0; j < 8; ++j) g[j] = *(const f32x4*)(gain + 4 * (F.lane + 64 * j));
    for (int ml = F.gw; ml < MC; ml += F.NGW) {
        const f32x4* xr = (const f32x4*)(src + (size_t)(row_off + ml) * DM) + F.lane;
        f32x4 v[8]; float ss = 0.f;
#pragma unroll
        for (int j = 0; j < 8; ++j) { v[j] = xr[64 * j]; ss += (v[j].x * v[j].x + v[j].y * v[j].y) + (v[j].z * v[j].z + v[j].w * v[j].w); }
        const float rstd = 1.0f / sqrtf(wave_sum(ss) * (1.f / DM) + NORM_EPS);
        u32x2* o = (u32x2*)(XN + (size_t)ml * DM) + F.lane;
#pragma unroll
        for (int j = 0; j < 8; ++j) { const f32x4 y = v[j] * rstd * g[j]; u32x2 w; w.x = pk2(y.x, y.y); w.y = pk2(y.z, y.w); o[64 * j] = w; }
    }
}
DI void ph_final_norm(const Frame& F, float* h, const float* gain) {
    f32x4 g[8];
#pragma unroll
    for (int j = 0; j < 8; ++j) g[j] = *(const f32x4*)(gain + 4 * (F.lane + 64 * j));
    for (int m = F.gw; m < MTOT; m += F.NGW) {
        f32x4* xr = (f32x4*)(h + (size_t)m * DM) + F.lane;
        f32x4 v[8]; float ss = 0.f;
#pragma unroll
        for (int j = 0; j < 8; ++j) { v[j] = xr[64 * j]; ss += (v[j].x * v[j].x + v[j].y * v[j].y) + (v[j].z * v[j].z + v[j].w * v[j].w); }
        const float rstd = 1.0f / sqrtf(wave_sum(ss) * (1.f / DM) + NORM_EPS);
#pragma unroll
        for (int j = 0; j < 8; ++j) xr[64 * j] = v[j] * rstd * g[j];
    }
}
DI void ph_conv_glu(const Frame& F, const bf16* U, bf16* Gb, const float* cw, const float* cb) {
    constexpr int RC = 32, NCG = DFF / 8, NRC = MC / RC;
    const int gt = blockIdx.x * (NWAVES * 64) + F.tid, NT = F.G * NWAVES * 64;
    for (int it = gt; it < NCG * NRC; it += NT) {
        const int cg = it % NCG, rc = it / NCG, c0 = cg * 8, r0 = rc * RC;
        float w0g[8], w1g[8], w2g[8], bg[8], w0v[8], w1v[8], w2v[8], bv[8];
#pragma unroll
        for (int e = 0; e < 8; ++e) { w0g[e] = cw[c0 + e]; w1g[e] = cw[2 * DFF + c0 + e]; w2g[e] = cw[4 * DFF + c0 + e]; bg[e] = cb[c0 + e];
            w0v[e] = cw[DFF + c0 + e]; w1v[e] = cw[3 * DFF + c0 + e]; w2v[e] = cw[5 * DFF + c0 + e]; bv[e] = cb[DFF + c0 + e]; }
        float pg2[8], pg1[8], pv2[8], pv1[8];
        const bool has = (r0 & (SEQ - 1)) != 0;
        {
            u32x4 a = {0u, 0u, 0u, 0u}, b = a, c = a, d = a;
            if (has) { a = *(const u32x4*)(U + (size_t)(r0 - 2) * (2 * DFF) + c0); b = *(const u32x4*)(U + (size_t)(r0 - 1) * (2 * DFF) + c0);
                       c = *(const u32x4*)(U + (size_t)(r0 - 2) * (2 * DFF) + DFF + c0); d = *(const u32x4*)(U + (size_t)(r0 - 1) * (2 * DFF) + DFF + c0); }
#pragma unroll
            for (int e = 0; e < 4; ++e) { pg2[2 * e] = bflo(a[e]); pg2[2 * e + 1] = bfhi(a[e]); pg1[2 * e] = bflo(b[e]); pg1[2 * e + 1] = bfhi(b[e]);
                pv2[2 * e] = bflo(c[e]); pv2[2 * e + 1] = bfhi(c[e]); pv1[2 * e] = bflo(d[e]); pv1[2 * e + 1] = bfhi(d[e]); }
        }
        for (int r = 0; r < RC; ++r) {
            const u32x4 ug = *(const u32x4*)(U + (size_t)(r0 + r) * (2 * DFF) + c0), uv = *(const u32x4*)(U + (size_t)(r0 + r) * (2 * DFF) + DFF + c0);
            float cg_[8], cv_[8], o[8];
#pragma unroll
            for (int e = 0; e < 4; ++e) { cg_[2 * e] = bflo(ug[e]); cg_[2 * e + 1] = bfhi(ug[e]); cv_[2 * e] = bflo(uv[e]); cv_[2 * e + 1] = bfhi(uv[e]); }
#pragma unroll
            for (int e = 0; e < 8; ++e) {
                const float yg = bg[e] + w0g[e] * pg2[e] + w1g[e] * pg1[e] + w2g[e] * cg_[e];
                const float yv = bv[e] + w0v[e] * pv2[e] + w1v[e] * pv1[e] + w2v[e] * cv_[e];
                const float sg = yg * __builtin_amdgcn_rcpf(1.0f + __builtin_amdgcn_exp2f(-yg * LOG2E));
                o[e] = sg * yv; pg2[e] = pg1[e]; pg1[e] = cg_[e]; pv2[e] = pv1[e]; pv1[e] = cv_[e];
            }
            u32x4 w; w.x = pk2(o[0], o[1]); w.y = pk2(o[2], o[3]); w.z = pk2(o[4], o[5]); w.w = pk2(o[6], o[7]);
            *(u32x4*)(Gb + (size_t)(r0 + r) * DFF + c0) = w;
        }
    }
}
constexpr size_t DA_DIN = 0, DA_CQN = 64 * MiB, DA_LATC = 80 * MiB, DA_KPE = 88 * MiB, DA_KIDX = 90 * MiB, DA_WIDX = 94 * MiB, DA_QL = 96 * MiB, DA_QPE = 352 * MiB, DA_QIDX = 400 * MiB,
                 DA_SEL = 464 * MiB, DA_CNT = 472 * MiB, DA_SC = 474 * MiB;
constexpr size_t DW_W1 = 0, DW_W2 = (size_t)1024 * 2048, DW_WO = DW_W2 + (size_t)11776 * 512;
constexpr float DSA_QSCALE = 0.07216878364870322f * LOG2E;
constexpr float DSA_WIDX_SCALE = 0.25f * 0.08838834764831845f;

DI void ph_dsa_cvt(const Frame& F, const float* w_in, const float* w_qup, const float* w_uk, const float* w_uv, const float* w_out) {
    bf16* WB = (bf16*)(F.ws + WS_WMIX);
    cvt_job(F, w_in, 960, DM, 0, 960, WB + DW_W1, DM, 0, 1.f);
    zero_bf16(F, WB + DW_W1 + (size_t)960 * DM, (size_t)64 * DM);
    { LAS float* scr = (LAS float*)(F.lds + F.wave * 16384);
      for (int it = F.gw; it < 32 * 16; it += F.NGW) { const int h = it >> 4; cvt_item(w_qup, 8192, h * 192, 48, WB + DW_W2, 512, 8192 + h * 48, DSA_QSCALE, scr, it & 15, 2, F.lane); } }
    cvt_job(F, w_qup, 8192, 512, 6144, 2048, WB + DW_W2, 512, 9728, 1.f);
    __syncthreads();
    {
        LAS float* As = (LAS float*)F.lds; LAS float* Bs = As + 64 * 145;
        for (int u = blockIdx.x; u < 32 * 4 * 8; u += F.G) {
            const int h = u >> 5, r0 = ((u >> 3) & 3) * 64, k0 = (u & 7) * 64;
            for (int i = F.tid; i < 64 * 144; i += NWAVES * 64) { const int row = i / 144, col = i - row * 144;
                As[row * 145 + col] = w_uk[(size_t)(h * 256 + r0) * 144 + i]; Bs[row * 145 + col] = w_qup[(size_t)(k0 + row) * 8192 + h * 192 + 48 + col]; }
            __syncthreads();
            const int r = F.tid & 63, kg = F.tid >> 6; float acc[8];
#pragma unroll
            for (int j = 0; j < 8; ++j) acc[j] = 0.f;
            for (int n = 0; n < 144; ++n) { const float a = As[r * 145 + n];
#pragma unroll
                for (int j = 0; j < 8; ++j) acc[j] += a * Bs[(kg * 8 + j) * 145 + n]; }
            u32x4 o; o.x = pk2(acc[0] * DSA_QSCALE, acc[1] * DSA_QSCALE); o.y = pk2(acc[2] * DSA_QSCALE, acc[3] * DSA_QSCALE); o.z = pk2(acc[4] * DSA_QSCALE, acc[5] * DSA_QSCALE); o.w = pk2(acc[6] * DSA_QSCALE, acc[7] * DSA_QSCALE);
            *(u32x4*)(WB + DW_W2 + (size_t)(h * 256 + r0 + r) * 512 + k0 + kg * 8) = o;
            __syncthreads();
        }
        LAS float* Av = (LAS float*)F.lds; LAS float* Bv = Av + 64 * 129;
        for (int u = blockIdx.x; u < 32 * 4 * 32; u += F.G) {
            const int h = u >> 7, r0 = ((u >> 5) & 3) * 64, c0 = (u & 31) * 64;
            for (int i = F.tid; i < 64 * 128; i += NWAVES * 64) { const int row = i >> 7, col = i & 127; Av[row * 129 + col] = w_uv[(size_t)(h * 256 + r0) * 128 + i]; }
            for (int i = F.tid; i < 128 * 64; i += NWAVES * 64) { const int v = i >> 6, c = i & 63; Bv[v * 64 + c] = w_out[(size_t)(h * 128 + v) * DM + c0 + c]; }
            __syncthreads();
            const int c = F.tid & 63, rg = F.tid >> 6; float acc[8];
#pragma unroll
            for (int j = 0; j < 8; ++j) acc[j] = 0.f;
            for (int v = 0; v < 128; ++v) { const float b = Bv[v * 64 + c];
#pragma unroll
                for (int j = 0; j < 8; ++j) acc[j] += Av[(rg * 8 + j) * 129 + v] * b; }
            u32x4 o; o.x = pk2(acc[0], acc[1]); o.y = pk2(acc[2], acc[3]); o.z = pk2(acc[4], acc[5]); o.w = pk2(acc[6], acc[7]);
            *(u32x4*)(WB + DW_WO + (size_t)(c0 + c) * 8192 + h * 256 + r0 + rg * 8) = o;
            __syncthreads();
        }
    }
}
DI void ph_dsa_post1(const Frame& F, int half, const float* qn, const float* kvn, const float* lng, const float* lnb) {
    unsigned char* ar = F.ws + WS_AR;
    const float* DIN = (const float*)(ar + DA_DIN); bf16* CQN = (bf16*)(ar + DA_CQN); bf16* LATC = (bf16*)(ar + DA_LATC); bf16* KPE = (bf16*)(ar + DA_KPE); bf16* KIDX = (bf16*)(ar + DA_KIDX); float* WIDX = (float*)(ar + DA_WIDX);
    const float* c48 = (const float*)(F.ws + TAB_COS48); const float* s48 = (const float*)(F.ws + TAB_SIN48); const float* c32 = (const float*)(F.ws + TAB_COS32); const float* s32 = (const float*)(F.ws + TAB_SIN32);
    LAS float* buf = (LAS float*)(F.lds + F.wave * 1024);
    const int lane = F.lane;
    for (int ml = F.gw; ml < MC; ml += F.NGW) {
        const int mg = half * MC + ml;
        const size_t kfb = ((size_t)(ml >> 5) * 8 * 64 + (ml & 31)) * 8;
        const float* row = DIN + (size_t)ml * 1024 + 16 * lane;
        f32x4 v[4]; float ss = 0.f, s1 = 0.f;
#pragma unroll
        for (int j = 0; j < 4; ++j) { v[j] = *(const f32x4*)(row + 4 * j); ss += (v[j].x * v[j].x + v[j].y * v[j].y) + (v[j].z * v[j].z + v[j].w * v[j].w); s1 += (v[j].x + v[j].y) + (v[j].z + v[j].w); }
        const bool isq = lane < 32, iskv = lane >= 32 && lane < 48, ispe = lane >= 48 && lane < 51, isix = lane >= 51 && lane < 59;
        const float ssq = wave_sum(isq ? ss : 0.f), sskv = wave_sum(iskv ? ss : 0.f), mean = wave_sum(isix ? s1 : 0.f) * (1.f / 128.f);
        float d2 = 0.f;
#pragma unroll
        for (int j = 0; j < 4; ++j) { const f32x4 d = v[j] - mean; d2 += (d.x * d.x + d.y * d.y) + (d.z * d.z + d.w * d.w); }
        const float var = wave_sum(isix ? d2 : 0.f) * (1.f / 128.f);
        const float rq = 1.0f / sqrtf(ssq * (1.f / 512.f) + NORM_EPS), rkv = 1.0f / sqrtf(sskv * (1.f / 256.f) + NORM_EPS), rstd = 1.0f / sqrtf(var + NORM_EPS);
        if (isq || iskv) {
            const float* gp = isq ? qn + 16 * lane : kvn + 16 * (lane - 32); const float rs = isq ? rq : rkv;
            bf16* dst = isq ? CQN + (size_t)ml * 512 + 16 * lane : LATC + (size_t)ml * 256 + 16 * (lane - 32);
            u32x4 o[2];
#pragma unroll
            for (int j = 0; j < 4; ++j) { const f32x4 g = *(const f32x4*)(gp + 4 * j); const f32x4 y = v[j] * rs * g; o[j >> 1][(j & 1) * 2] = pk2(y.x, y.y); o[j >> 1][(j & 1) * 2 + 1] = pk2(y.z, y.w); }
            *(u32x4*)dst = o[0]; *(u32x4*)(dst + 8) = o[1];
        } else if (ispe) {
#pragma unroll
            for (int j = 0; j < 4; ++j) *(LAS f32x4*)(buf + (lane - 48) * 16 + 4 * j) = v[j];
        } else if (isix) {
#pragma unroll
            for (int j = 0; j < 4; ++j) { const f32x4 g = *(const f32x4*)(lng + (lane - 51) * 16 + 4 * j), b = *(const f32x4*)(lnb + (lane - 51) * 16 + 4 * j); *(LAS f32x4*)(buf + 48 + (lane - 51) * 16 + 4 * j) = (v[j] - mean) * rstd * g + b; }
        } else if (lane == 59) {
#pragma unroll
            for (int j = 0; j < 4; ++j) *(f32x4*)(WIDX + (size_t)ml * 16 + 4 * j) = v[j] * DSA_WIDX_SCALE;
        }
        LDS_WAIT();
        if (lane < 24) { const float x1 = buf[lane], x2 = buf[24 + lane], c = c48[(size_t)mg * 24 + lane], s = s48[(size_t)mg * 24 + lane];
            KPE[(size_t)ml * 48 + lane] = f2bf(x1 * c - x2 * s); KPE[(size_t)ml * 48 + 24 + lane] = f2bf(x1 * s + x2 * c);
        } else if (lane < 40) { const int i = lane - 24; const float x1 = buf[48 + i], x2 = buf[48 + 16 + i], c = c32[(size_t)mg * 16 + i], s = s32[(size_t)mg * 16 + i];
            KIDX[kfb + (size_t)((i >> 3) * 32) * 8 + (i & 7)] = f2bf(x1 * c - x2 * s); KIDX[kfb + (size_t)(64 + (i >> 3) * 32) * 8 + (i & 7)] = f2bf(x1 * s + x2 * c);
        } else { const int d = 32 + 4 * (lane - 40); const f32x4 y = *(const LAS f32x4*)(buf + 48 + d); u32x2 w; w.x = pk2(y.x, y.y); w.y = pk2(y.z, y.w); *(u32x2*)(KIDX + kfb + (size_t)((d >> 4) * 64 + ((d >> 3) & 1) * 32) * 8 + (d & 7)) = w; }
        LDS_WAIT();
    }
}
DI void ph_dsa_rope(const Frame& F, int half) {
    unsigned char* ar = F.ws + WS_AR; bf16* QPE = (bf16*)(ar + DA_QPE); bf16* QIDX = (bf16*)(ar + DA_QIDX);
    const float* c48 = (const float*)(F.ws + TAB_COS48); const float* s48 = (const float*)(F.ws + TAB_SIN48); const float* c32 = (const float*)(F.ws + TAB_COS32); const float* s32 = (const float*)(F.ws + TAB_SIN32);
    for (int ml = F.gw; ml < MC; ml += F.NGW) {
        const size_t mg = (size_t)half * MC + ml;
        for (int p = F.lane; p < 768; p += 64) { const int hd = p / 24, i = p - hd * 24; bf16* q = QPE + (size_t)ml * 1536 + hd * 48 + i;
            const float x1 = bf2f(q[0]), x2 = bf2f(q[24]), c = c48[mg * 24 + i], s = s48[mg * 24 + i]; q[0] = f2bf(x1 * c - x2 * s); q[24] = f2bf(x1 * s + x2 * c); }
        for (int p = F.lane; p < 256; p += 64) { const int hd = p >> 4, i = p & 15; bf16* q = QIDX + (size_t)ml * 2048 + hd * 128 + i;
            const float x1 = bf2f(q[0]), x2 = bf2f(q[16]), c = c32[mg * 16 + i], s = s32[mg * 16 + i]; q[0] = f2bf(x1 * c - x2 * s); q[16] = f2bf(x1 * s + x2 * c); }
    }
}
DI unsigned f2sortable(float s) { const unsigned b = __builtin_bit_cast(unsigned, s); return (b & 0x80000000u) ? ~b : (b | 0x80000000u); }
DI void ph_dsa_index(const Frame& F, const int dry = 0) {
    unsigned char* ar = F.ws + WS_AR;
    const bf16* QIDX = (const bf16*)(ar + DA_QIDX); const bf16* KIDX = (const bf16*)(ar + DA_KIDX); const float* WIDX = (const float*)(ar + DA_WIDX);
    unsigned short* SEL = (unsigned short*)(ar + DA_SEL); int* CNT = (int*)(ar + DA_CNT); float* SC = (float*)(ar + DA_SC) + (size_t)F.gw * 16384;
    const int lane = F.lane, r = lane & 31, hf = lane >> 5;
    LAS unsigned char* wl = F.lds + F.wave * 8192 + lane * 16;
#pragma unroll 1
    for (int tile = blockIdx.x; tile < BPH * 128; tile += F.G) {
        const int j = tile >> 8, c8 = tile & 255, c7 = c8 & 127, bl = (c8 >> 7) * 2 + j, qt = j ? 127 - c7 : c7;
        const int q0 = qt * 32 + 4 * F.wave;
        const int ntile = (q0 + 3) / 32 + 1;
        bf16x8 qa[2][8];
#pragma unroll
        for (int pr = 0; pr < 2; ++pr) {
            const int mrow = bl * SEQ + q0 + 2 * pr + (r >> 4);
#pragma unroll
            for (int s = 0; s < 8; ++s) qa[pr][s] = *(const bf16x8*)(QIDX + (size_t)mrow * 2048 + (r & 15) * 128 + 16 * s + 8 * hf);
            float wv[2][16];
#pragma unroll
            for (int i = 0; i < 16; ++i) wv[pr][i] = WIDX[(size_t)(bl * SEQ + q0 + 2 * pr + (i >> 3)) * 16 + (i & 3) + 8 * ((i >> 2) & 1) + 4 * hf];
#pragma unroll
            for (int i = 0; i < 16; i += 4) *(LAS f32x4*)(wl + (pr * 4 + (i >> 2)) * 1024) = (f32x4){wv[pr][i], wv[pr][i + 1], wv[pr][i + 2], wv[pr][i + 3]};
        }
        LDS_WAIT();
        bf16x8 kf[8];
        { const bf16* kp = KIDX + ((size_t)(bl * 128) * 8 * 64 + lane) * 8;
#pragma unroll
          for (int s = 0; s < 8; ++s) kf[s] = *(const bf16x8*)(kp + 512 * s); }
#pragma unroll 1
        for (int t = 0; t < ntile; ++t) {
            f32x16 accs[2];
#pragma unroll
            for (int pr = 0; pr < 2; ++pr) {
#pragma unroll
                for (int i = 0; i < 16; ++i) accs[pr][i] = 0.f;
#pragma unroll
                for (int s = 0; s < 8; ++s) accs[pr] = MFMA32(qa[pr][s], kf[s], accs[pr]);
            }
            if (t + 1 < ntile) { const bf16* kp = KIDX + ((size_t)(bl * 128 + t + 1) * 8 * 64 + lane) * 8;
#pragma unroll
                for (int s = 0; s < 8; ++s) kf[s] = *(const bf16x8*)(kp + 512 * s); }
#pragma unroll
            for (int pr = 0; pr < 2; ++pr) {
                const f32x16 acc = accs[pr];
                float wv[2][16];
                { unsigned wa_ = (unsigned)(size_t)wl; asm volatile("" : "+v"(wa_));
#pragma unroll
                  for (int i = 0; i < 16; i += 4) { const f32x4 w4 = *(const LAS f32x4*)((LAS unsigned char*)(size_t)wa_ + (pr * 4 + (i >> 2)) * 1024); wv[pr][i] = w4.x; wv[pr][i + 1] = w4.y; wv[pr][i + 2] = w4.z; wv[pr][i + 3] = w4.w; } }
                float p0 = 0.f, p1 = 0.f;
#pragma unroll
                for (int i = 0; i < 8; ++i) { p0 += wv[pr][i] * fmaxf(acc[i], 0.f); p1 += wv[pr][8 + i] * fmaxf(acc[8 + i], 0.f); }
                const float t0 = p0 + __shfl_xor(p0, 32), t1 = p1 + __shfl_xor(p1, 32);
                SC[(pr * 128 + t) * 64 + lane] = hf ? t1 : t0;
            }
        }
        VM_WAIT();
#pragma unroll 1
        for (int qi = 0; qi < 4; ++qi) {
            const int tq = q0 + qi, pr = qi >> 1, qs = qi & 1;
            unsigned u[64];
            const unsigned* scp = (const unsigned*)(SC + pr * 8192 + hf * 64 + qs * 32 + r);
#pragma unroll
            for (int g8 = 0; g8 < 8; ++g8) {
#pragma unroll
                for (int e = 0; e < 8; ++e) { const int i = 8 * g8 + e; const float s = __builtin_bit_cast(float, __hip_atomic_load(scp + e * 128, __ATOMIC_RELAXED, __HIP_MEMORY_SCOPE_AGENT));
                    u[i] = (2 * i + hf < ntile && 64 * i + lane <= tq) ? f2sortable(s) : 0u; }
                scp += 1024; asm volatile("" : "+v"(scp));
            }
            unsigned prefix = 0u;
#pragma unroll 1
            for (int bit = 31; bit >= 0; --bit) {
                const unsigned cand = prefix | (1u << bit); int c = 0;
#pragma unroll
                for (int i = 0; i < 64; ++i) c += (u[i] >= cand) ? 1 : 0;
#pragma unroll
                for (int o = 1; o < 64; o <<= 1) c += __shfl_xor(c, o);
                if (c >= 256) prefix = cand;
            }
            const unsigned T = prefix > 1u ? prefix : 1u;
            int nl = 0;
#pragma unroll
            for (int i = 0; i < 64; ++i) nl += (u[i] >= T) ? 1 : 0;
            int inc = nl;
#pragma unroll
            for (int o = 1; o < 64; o <<= 1) { const int y = __shfl_up(inc, o); if (lane >= o) inc += y; }
            const int base = __shfl(inc, 63);
            int pos = inc - nl;
            unsigned short* sel = dry ? (unsigned short*)(ar + DUMMY_OFF) + (size_t)F.gw * 256 : SEL + (size_t)(bl * SEQ + tq) * 256;
#pragma unroll
            for (int i = 0; i < 64; ++i) { if (u[i] >= T) { if (pos < 256) sel[pos] = (unsigned short)(64 * i + lane); ++pos; } }
            if (lane == 0) (dry ? (int*)(ar + DUMMY_OFF + 32 * MiB) + F.gw : CNT + bl * SEQ + tq)[0] = base < 256 ? base : 256;
        }
    }
}
DI void ph_dsa_attn(const Frame& F, const int dry = 0) {
    unsigned char* ar = F.ws + WS_AR;
    bf16* QL = (bf16*)(ar + DA_QL); const bf16* QPE = (const bf16*)(ar + DA_QPE); const bf16* LATC = (const bf16*)(ar + DA_LATC); const bf16* KPE = (const bf16*)(ar + DA_KPE);
    const unsigned short* SEL = (const unsigned short*)(ar + DA_SEL); const int* CNT = (const int*)(ar + DA_CNT);
    const int lane = F.lane, r = lane & 31, h = lane >> 5;
    u32x4* PS = (u32x4*)(ar + DA_SC + (size_t)F.gw * 65536) + lane;
    float* AS = (float*)(ar + DA_SC + (size_t)F.gw * 65536 + 16384) + lane;
    LAS unsigned char* img = F.lds + F.wave * 8704;
    const int i16 = lane & 15, tq_ = i16 >> 2, tp_ = i16 & 3, blk = (lane >> 4) & 1;
#pragma unroll 1
    for (int ml = F.gw; ml < MC; ml += F.NGW) {
        const int bl = ml >> 12, cnt = CNT[ml], nch = (cnt + 31) >> 5;
        const unsigned short* sel = SEL + (size_t)ml * 256;
        float linv;
        {
            bf16x8 qf[16], qp[3];
#pragma unroll
            for (int s = 0; s < 16; ++s) qf[s] = *(const bf16x8*)(QL + (size_t)ml * 8192 + r * 256 + 16 * s + 8 * h);
#pragma unroll
            for (int s = 0; s < 3; ++s) qp[s] = *(const bf16x8*)(QPE + (size_t)ml * 1536 + r * 48 + 16 * s + 8 * h);
            float m = -INFINITY, l = 0.f;
            bf16x8 kfc[16], kfp[3];
            { const int kidx = r < cnt ? (int)sel[r] : 0;
              const bf16* kc = LATC + (size_t)(bl * SEQ + kidx) * 256 + 8 * h; const bf16* kp = KPE + (size_t)(bl * SEQ + kidx) * 48 + 8 * h;
#pragma unroll
              for (int s = 0; s < 16; ++s) kfc[s] = *(const bf16x8*)(kc + 16 * s);
#pragma unroll
              for (int s = 0; s < 3; ++s) kfp[s] = *(const bf16x8*)(kp + 16 * s); }
#pragma unroll 1
            for (int c = 0; c < nch; ++c) {
                f32x16 acc;
#pragma unroll
                for (int i = 0; i < 16; ++i) acc[i] = 0.f;
#pragma unroll
                for (int s = 0; s < 16; ++s) acc = MFMA32(kfc[s], qf[s], acc);
#pragma unroll
                for (int s = 0; s < 3; ++s) acc = MFMA32(kfp[s], qp[s], acc);
                if (c + 1 < nch) {
                    const int slot = 32 * (c + 1) + r; const int kidx = slot < cnt ? (int)sel[slot] : 0;
                    const bf16* kc = LATC + (size_t)(bl * SEQ + kidx) * 256 + 8 * h; const bf16* kp = KPE + (size_t)(bl * SEQ + kidx) * 48 + 8 * h;
#pragma unroll
                    for (int s = 0; s < 16; ++s) kfc[s] = *(const bf16x8*)(kc + 16 * s);
#pragma unroll
                    for (int s = 0; s < 3; ++s) kfp[s] = *(const bf16x8*)(kp + 16 * s);
                }
                float mx = -INFINITY;
#pragma unroll
                for (int i = 0; i < 16; ++i) { acc[i] = (32 * c + crow(i, h) < cnt) ? acc[i] : -INFINITY; mx = fmaxf(mx, acc[i]); }
                mx = fmaxf(mx, __shfl_xor(mx, 32));
                const float mn = fmaxf(m, mx), a = __builtin_amdgcn_exp2f(m - mn);
                float sum = 0.f;
#pragma unroll
                for (int i = 0; i < 16; ++i) { acc[i] = __builtin_amdgcn_exp2f(acc[i] - mn); sum += acc[i]; }
                l = l * a + sum; m = mn;
                AS[c * 64] = a;
#pragma unroll
                for (int s = 0; s < 2; ++s) { u32x4 w; w.x = pk2(acc[8 * s], acc[8 * s + 1]); w.y = pk2(acc[8 * s + 2], acc[8 * s + 3]); w.z = pk2(acc[8 * s + 4], acc[8 * s + 5]); w.w = pk2(acc[8 * s + 6], acc[8 * s + 7]); PS[(c * 2 + s) * 64] = w; }
            }
            l += __shfl_xor(l, 32);
            linv = 1.0f / l;
        }
#pragma unroll 1
        for (int dh = 0; dh < 2; ++dh) {
            f32x16 O[4];
#pragma unroll
            for (int db = 0; db < 4; ++db)
#pragma unroll
                for (int i = 0; i < 16; ++i) O[db][i] = 0.f;
            u32x4 rows[8];
            { const int myk = r < cnt ? (int)sel[r] : 0;
#pragma unroll
              for (int it = 0; it < 8; ++it) { const int ki = __shfl(myk, (lane >> 4) + 4 * it); rows[it] = *(const u32x4*)(LATC + (size_t)(bl * SEQ + ki) * 256 + dh * 128 + i16 * 8); } }
#pragma unroll 1
            for (int c = 0; c < nch; ++c) {
                const float a = AS[c * 64];
                const bf16x8 p0 = __builtin_bit_cast(bf16x8, PS[(c * 2) * 64]), p1 = __builtin_bit_cast(bf16x8, PS[(c * 2 + 1) * 64]);
#pragma unroll
                for (int it = 0; it < 8; ++it) *(LAS u32x4*)(img + ((lane >> 4) + 4 * it) * 272 + i16 * 16) = rows[it];
                if (c + 1 < nch) { const int slot = 32 * (c + 1) + r; const int myk = slot < cnt ? (int)sel[slot] : 0;
#pragma unroll
                    for (int it = 0; it < 8; ++it) { const int ki = __shfl(myk, (lane >> 4) + 4 * it); rows[it] = *(const u32x4*)(LATC + (size_t)(bl * SEQ + ki) * 256 + dh * 128 + i16 * 8); } }
#pragma unroll
                for (int db = 0; db < 4; ++db)
#pragma unroll
                    for (int i = 0; i < 16; ++i) O[db][i] *= a;
                LDS_WAIT();
#pragma unroll
                for (int db = 0; db < 4; ++db)
#pragma unroll
                    for (int s = 0; s < 2; ++s) {
                        const s16x4 lo = __builtin_bit_cast(s16x4, __builtin_amdgcn_ds_read_tr16_b64_v4i16((LAS v4i16_t*)(img + (16 * s + 4 * h + tq_) * 272 + db * 64 + 32 * blk + 8 * tp_)));
                        const s16x4 hi = __builtin_bit_cast(s16x4, __builtin_amdgcn_ds_read_tr16_b64_v4i16((LAS v4i16_t*)(img + (16 * s + 8 + 4 * h + tq_) * 272 + db * 64 + 32 * blk + 8 * tp_)));
                        O[db] = MFMA32(__builtin_shufflevector(lo, hi, 0, 1, 2, 3, 4, 5, 6, 7), s ? p1 : p0, O[db]);
                    }
                LDS_WAIT();
            }
            bf16* o = (dry ? (bf16*)(ar + DUMMY_OFF) + (size_t)F.gw * 8192 : QL + (size_t)ml * 8192) + r * 256 + dh * 128 + 4 * h;
#pragma unroll
            for (int db = 0; db < 4; ++db)
#pragma unroll
                for (int g = 0; g < 4; ++g) { u32x2 w; w.x = pk2(O[db][4 * g] * linv, O[db][4 * g + 1] * linv); w.y = pk2(O[db][4 * g + 2] * linv, O[db][4 * g + 3] * linv); *(u32x2*)(o + db * 32 + 8 * g) = w; }
        }
    }
}
template <int NDB> DI void softmax_step(f32x16& S, float& m, float& l, f32x16 (&O)[NDB], bf16x8 (&pf)[2]) {
    float mx = S[0];
#pragma unroll
    for (int i = 1; i < 16; ++i) mx = fmaxf(mx, S[i]);
    mx = fmaxf(mx, __shfl_xor(mx, 32));
    const float mn = fmaxf(m, mx), ms = (mn == -INFINITY) ? 0.f : mn;
    const float alpha = __builtin_amdgcn_exp2f(m - ms);
    float sum = 0.f;
#pragma unroll
    for (int i = 0; i < 16; ++i) { S[i] = __builtin_amdgcn_exp2f(S[i] - ms); sum += S[i]; }
    l = l * alpha + sum; m = mn;
#pragma unroll
    for (int db = 0; db < NDB; ++db)
#pragma unroll
        for (int i = 0; i < 16; ++i) O[db][i] *= alpha;
#pragma unroll
    for (int s = 0; s < 2; ++s) { u32x4 w; w.x = pk2(S[8 * s], S[8 * s + 1]); w.y = pk2(S[8 * s + 2], S[8 * s + 3]); w.z = pk2(S[8 * s + 4], S[8 * s + 5]); w.w = pk2(S[8 * s + 6], S[8 * s + 7]); pf[s] = __builtin_bit_cast(bf16x8, w); }
}
template <int NQ, int NDB, bool PV, bool QL, bool FRAG, class KA, class VA, class MK>
DI void attn_run(const bf16x8 (&qf)[NQ], const LAS unsigned char* qlds, f32x16 (&O)[NDB], float& m, float& l, int tb, int te, const KA& ka, const VA& va, const MK& mk) {
    if (tb >= te) return;
    bf16x8 kf[NQ];
    { const bf16* kp = ka(tb);
#pragma unroll
      for (int s = 0; s < NQ; ++s) kf[s] = *(const bf16x8*)(kp + (FRAG ? 512 : 16) * s); }
    for (int t = tb; t < te; ++t) {
        bf16x8 vf[NDB][2];
        if (PV) {
#pragma unroll
            for (int db = 0; db < NDB; ++db) { const bf16* vp = va(t, db);
#pragma unroll
                for (int s = 0; s < 2; ++s) { if (FRAG) vf[db][s] = *(const bf16x8*)(vp + 512 * s); else vf[db][s] = __builtin_shufflevector(*(const s16x4*)(vp + 16 * s), *(const s16x4*)(vp + 16 * s + 8), 0, 1, 2, 3, 4, 5, 6, 7); } }
        }
        f32x16 S;
#pragma unroll
        for (int i = 0; i < 16; ++i) S[i] = 0.f;
#pragma unroll
        for (int s = 0; s < NQ; ++s) { if (QL) { unsigned qa_ = (unsigned)(size_t)qlds; asm volatile("" : "+v"(qa_)); S = MFMA32(kf[s], *(const LAS bf16x8*)((LAS unsigned char*)(size_t)qa_ + s * 1024), S); } else S = MFMA32(kf[s], qf[s], S); }
        if (t + 1 < te) { const bf16* kp = ka(t + 1);
#pragma unroll
            for (int s = 0; s < NQ; ++s) kf[s] = *(const bf16x8*)(kp + (FRAG ? 512 : 16) * s); }
        mk(t, S);
        bf16x8 pf[2]; softmax_step<NDB>(S, m, l, O, pf);
        if (PV) {
#pragma unroll
            for (int db = 0; db < NDB; ++db)
#pragma unroll
                for (int s = 0; s < 2; ++s) O[db] = MFMA32(vf[db][s], pf[s], O[db]);
        }
    }
}
template <bool ACC> DI void store_col(bf16* out, const f32x16 (&O)[4], float scale, int h) {
#pragma unroll
    for (int db = 0; db < 4; ++db)
#pragma unroll
        for (int g = 0; g < 4; ++g) { u32x2* p = (u32x2*)(out + db * 32 + 8 * g + 4 * h);
            float a = O[db][4 * g] * scale, b = O[db][4 * g + 1] * scale, c = O[db][4 * g + 2] * scale, d = O[db][4 * g + 3] * scale;
            if (ACC) { const u32x2 o = *p; a += bflo(o.x); b += bfhi(o.x); c += bflo(o.y); d += bfhi(o.y); }
            u32x2 w; w.x = pk2(a, b); w.y = pk2(c, d); *p = w; }
}
constexpr size_t FA_Q = 0, FA_K = 64 * MiB, FA_F = 128 * MiB, FA_V = 136 * MiB, FA_CUM = 200 * MiB, FA_O = 202 * MiB, FA_KF = 266 * MiB, FA_VF = 330 * MiB;
constexpr size_t FW_IN = 0, FW_OUT = (size_t)6400 * 2048;
constexpr float FOX_QSCALE = 0.08838834764831845f * LOG2E;
DI void ph_fox_cvt(const Frame& F, const float* w_in, const float* w_out) {
    bf16* WB = (bf16*)(F.ws + WS_WMIX);
    cvt_job(F, w_in, 6160, DM, 0, 2048, WB + FW_IN, DM, 0, FOX_QSCALE);
    cvt_job(F, w_in, 6160, DM, 2048, 2048, WB + FW_IN, DM, 2048, 1.f);
    cvt_job(F, w_in, 6160, DM, 4096, 2048, WB + FW_IN, DM, 4096, 1.f);
    cvt_job(F, w_in, 6160, DM, 6144, 16, WB + FW_IN, DM, 6144, 1.f);
    zero_bf16(F, WB + FW_IN + (size_t)6160 * DM, (size_t)240 * DM);
    cvt_job(F, w_out, DM, DM, 0, DM, WB + FW_OUT, DM, 0, 1.f);
}
DI void ph_fox_scan(const Frame& F, const float* b_f) {
    unsigned char* ar = F.ws + WS_AR; const bf16* FB = (const bf16*)(ar + FA_F); float* CUM = (float*)(ar + FA_CUM);
    for (int w = F.gw; w < BPH * 16; w += F.NGW) {
        const int bl = w >> 4, hd = w & 15; const float bf_ = b_f[hd];
        float v[64]; float run = 0.f;
#pragma unroll
        for (int i = 0; i < 64; ++i) { const float x = bf2f(FB[(size_t)(bl * SEQ + F.lane * 64 + i) * 256 + hd]) + bf_;
            const float ls = fminf(x, 0.f) - log1pf(expf(-fabsf(x))); run += ls; v[i] = run; }
        float inc = run;
#pragma unroll
        for (int o = 1; o < 64; o <<= 1) { const float y = __shfl_up(inc, o); if (F.lane >= o) inc += y; }
        const float base = inc - run;
        float* dst = CUM + (size_t)w * SEQ + F.lane * 64;
#pragma unroll
        for (int i = 0; i < 64; i += 4) *(f32x4*)(dst + i) = (f32x4){(v[i] + base) * LOG2E, (v[i + 1] + base) * LOG2E, (v[i + 2] + base) * LOG2E, (v[i + 3] + base) * LOG2E};
    }
    const bf16* Kr = (const bf16*)(ar + FA_K); const bf16* Vr = (const bf16*)(ar + FA_V); bf16* KF = (bf16*)(ar + FA_KF); bf16* VF = (bf16*)(ar + FA_VF);
    const int r = F.lane & 31, h = F.lane >> 5;
    for (int u = F.gw; u < BPH * 16 * 128; u += F.NGW) {
        const int bh = u >> 7, tile = u & 127, bl = bh >> 4, hd = bh & 15;
        const bf16* krow_ = Kr + ((size_t)bl * SEQ + tile * 32 + r) * DM + hd * 128 + 8 * h;
        bf16* kd = KF + (((size_t)bh * 128 + tile) * 8 * 64 + F.lane) * 8;
#pragma unroll
        for (int s = 0; s < 8; ++s) *(u32x4*)(kd + s * 512) = *(const u32x4*)(krow_ + 16 * s);
        bf16* vd = VF + (((size_t)bh * 128 + tile) * 8 * 64 + F.lane) * 8;
#pragma unroll
        for (int db = 0; db < 4; ++db)
#pragma unroll
            for (int s = 0; s < 2; ++s) { unsigned short e[8];
#pragma unroll
                for (int j = 0; j < 8; ++j) e[j] = Vr[((size_t)bl * SEQ + tile * 32 + 16 * s + 8 * (j >> 2) + 4 * h + (j & 3)) * DM + hd * 128 + db * 32 + r];
                u32x4 w; w.x = e[0] | ((unsigned)e[1] << 16); w.y = e[2] | ((unsigned)e[3] << 16); w.z = e[4] | ((unsigned)e[5] << 16); w.w = e[6] | ((unsigned)e[7] << 16);
                *(u32x4*)(vd + (db * 2 + s) * 512) = w; }
    }
}
struct FragKA { const bf16* base; int nq; DI const bf16* operator()(int t) const { return base + (size_t)t * nq * 512; } };
struct FragVA { const bf16* base; DI const bf16* operator()(int t, int db) const { return base + ((size_t)t * 8 + db * 2) * 512; } };
struct FoxMK { const float* cum; float ct; int tq, h;
    DI void operator()(int t, f32x16& S) const {
        const int k0 = 32 * t + 4 * h;
#pragma unroll
        for (int g = 0; g < 4; ++g) { const f32x4 cs = *(const f32x4*)(cum + k0 + 8 * g);
#pragma unroll
            for (int e = 0; e < 4; ++e) S[4 * g + e] = (k0 + 8 * g + e <= tq) ? S[4 * g + e] + (ct - cs[e]) : -INFINITY; }
    } };
DI void ph_fox_attn(const Frame& F, const int dry = 0) {
    unsigned char* ar = F.ws + WS_AR; const bf16* Q = (const bf16*)(ar + FA_Q); const bf16* KF = (const bf16*)(ar + FA_KF); const bf16* VF = (const bf16*)(ar + FA_VF); const float* CUM = (const float*)(ar + FA_CUM); bf16* Ob = (bf16*)(ar + FA_O);
    const int r = F.lane & 31, h = F.lane >> 5;
    for (int wt = F.gw; wt < BPH * 16 * 32; wt += F.NGW) {
        const int bh = wt >> 5, x = wt & 31, bl = bh >> 4, hd = bh & 15;
#pragma unroll 1
        for (int k = 0; k < 4; ++k) {
            const int qt = (k == 0) ? x : (k == 1) ? 63 - x : (k == 2) ? 64 + x : 127 - x;
            const int tq = qt * 32 + r; const size_t mrow = (size_t)bl * SEQ + tq;
            bf16x8 qf[8];
#pragma unroll
            for (int s = 0; s < 8; ++s) qf[s] = *(const bf16x8*)(Q + mrow * DM + hd * 128 + 16 * s + 8 * h);
            f32x16 O[4];
#pragma unroll
            for (int db = 0; db < 4; ++db)
#pragma unroll
                for (int i = 0; i < 16; ++i) O[db][i] = 0.f;
            float m = -INFINITY, l = 0.f;
            const float* cum = CUM + (size_t)bh * SEQ;
            const FragKA ka{KF + ((size_t)bh * 128 * 8 * 64 + F.lane) * 8, 8}; const FragVA va{VF + ((size_t)bh * 128 * 8 * 64 + F.lane) * 8}; const FoxMK mk{cum, cum[tq], tq, h};
            attn_run<8, 4, true, false, true>(qf, nullptr, O, m, l, 0, qt + 1, ka, va, mk);
            l += __shfl_xor(l, 32);
            store_col<false>(dry ? (bf16*)(ar + DUMMY_OFF) + ((size_t)F.gw * 32 + r) * 128 : Ob + mrow * DM + hd * 128, O, l > 0.f ? 1.0f / l : 0.f, h);
        }
    }
}
constexpr size_t NA_Q = 0, NA_KC = 288 * MiB, NA_VC = 313 * MiB, NA_KSR = 330 * MiB, NA_KWR = 354 * MiB, NA_GT = 378 * MiB, NA_VSR = 386 * MiB, NA_VWR = 402 * MiB, NA_GK = 418 * MiB, NA_GV = 420 * MiB,
                 NA_KCMP = 422 * MiB, NA_VCT = 424 * MiB, NA_SELB = 426 * MiB, NA_O = 428 * MiB,
                 NA_KSF = 620 * MiB, NA_KWF = 644 * MiB, NA_VSF = 668 * MiB, NA_VWF = 684 * MiB;
constexpr size_t NW_IN = 0, NW_W1K = (size_t)13312 * 2048, NW_W1V = NW_W1K + (size_t)256 * 6144, NW_W2K = NW_W1V + (size_t)256 * 4096, NW_W2V = NW_W2K + 65536, NW_OUT = NW_W2V + 65536;
constexpr float NSA_QSCALE = 0.07216878364870322f * LOG2E;
DI void ph_nsa_cvt(const Frame& F, const float* w_in, const float* k_pe, const float* k_w1, const float* k_b1, const float* k_w2, const float* v_pe, const float* v_w1, const float* v_b1, const float* v_w2, const float* w_out) {
    bf16* WB = (bf16*)(F.ws + WS_WMIX); float* BIAS = (float*)(F.ws + WS_MISC);
    cvt_job(F, w_in, 13200, DM, 0, 9216, WB + NW_IN, DM, 0, NSA_QSCALE);
    cvt_job(F, w_in, 13200, DM, 9216, 768, WB + NW_IN, DM, 9216, 1.f);
    cvt_job(F, w_in, 13200, DM, 9984, 512, WB + NW_IN, DM, 9984, 1.f);
    cvt_job(F, w_in, 13200, DM, 10496, 768, WB + NW_IN, DM, 10496, 1.f);
    cvt_job(F, w_in, 13200, DM, 11776, 768, WB + NW_IN, DM, 11264, 1.f);
    cvt_job(F, w_in, 13200, DM, 13056, 144, WB + NW_IN, DM, 12032, 1.f);
    zero_bf16(F, WB + NW_IN + (size_t)12176 * DM, (size_t)112 * DM);
    cvt_job(F, w_in, 13200, DM, 11264, 512, WB + NW_IN, DM, 12288, 1.f);
    cvt_job(F, w_in, 13200, DM, 12544, 512, WB + NW_IN, DM, 12800, 1.f);
    cvt_job(F, k_w1, 256, 6144, 0, 256, WB + NW_W1K, 6144, 0, 1.f);
    cvt_job(F, v_w1, 256, 4096, 0, 256, WB + NW_W1V, 4096, 0, 1.f);
    cvt_job(F, k_w2, 192, 256, 0, 192, WB + NW_W2K, 256, 0, 1.f); zero_bf16(F, WB + NW_W2K + 192 * 256, 64 * 256);
    cvt_job(F, v_w2, 128, 256, 0, 128, WB + NW_W2V, 256, 0, 1.f); zero_bf16(F, WB + NW_W2V + 128 * 256, 128 * 256);
    cvt_job(F, w_out, DM, 6144, 0, DM, WB + NW_OUT, 6144, 0, 1.f);
    for (int w = F.gw; w < 512; w += F.NGW) { const bool isk = w < 256; const int c = w & 255, n = isk ? 6144 : 4096; const float* pe = isk ? k_pe : v_pe; const float* w1 = isk ? k_w1 : v_w1;
        float s = 0.f; for (int i = F.lane; i < n; i += 64) s += pe[i] * w1[(size_t)i * 256 + c];
        s = wave_sum(s); if (F.lane == 0) BIAS[w] = s + (isk ? k_b1[c] : v_b1[c]); }
}
DI void ph_nsa_rope(const Frame& F, int half) {
    unsigned char* ar = F.ws + WS_AR; bf16* Q = (bf16*)(ar + NA_Q); bf16* KC = (bf16*)(ar + NA_KC);
    const bf16* KSR = (const bf16*)(ar + NA_KSR); const bf16* KWR = (const bf16*)(ar + NA_KWR); bf16* KSF = (bf16*)(ar + NA_KSF); bf16* KWF = (bf16*)(ar + NA_KWF);
    const float* c48 = (const float*)(F.ws + TAB_COS48); const float* s48 = (const float*)(F.ws + TAB_SIN48);
    for (int ml = F.gw; ml < MC; ml += F.NGW) {
        const size_t mg = (size_t)half * MC + ml; const int bl = ml >> 12, sq = ml & 4095;
        for (int p = F.lane; p < 1248; p += 64) {
            const int hd = p / 24, i = p - hd * 24; bf16* q;
            if (hd < 48) q = Q + (size_t)ml * 9216 + hd * 192 + i;
            else q = KC + ((size_t)(bl * 4 + hd - 48) * 4096 + sq) * 192 + i;
            const float x1 = bf2f(q[0]), x2 = bf2f(q[24]), c = c48[mg * 24 + i], s = s48[mg * 24 + i]; q[0] = f2bf(x1 * c - x2 * s); q[24] = f2bf(x1 * s + x2 * c);
        }
        const int tile = sq >> 5, rr = sq & 31;
        for (int u = F.lane; u < 168; u += 64) {
            const int tens = u / 84, uu = u - tens * 84, g = uu / 21, v = uu - g * 21;
            const bf16* src = (tens ? KWR : KSR) + (size_t)ml * 768 + g * 192;
            bf16* dst = (tens ? KWF : KSF) + ((size_t)((bl * 4 + g) * 128 + tile) * 12 * 64 + rr) * 8;
            if (v < 3) {
                const u32x4 a = *(const u32x4*)(src + 8 * v), b = *(const u32x4*)(src + 8 * v + 24); u32x4 o1, o2;
#pragma unroll
                for (int e = 0; e < 4; ++e) { const float c0 = c48[mg * 24 + 8 * v + 2 * e], s0 = s48[mg * 24 + 8 * v + 2 * e], c1 = c48[mg * 24 + 8 * v + 2 * e + 1], s1 = s48[mg * 24 + 8 * v + 2 * e + 1];
                    const float x1l = bflo(a[e]), x1h = bfhi(a[e]), x2l = bflo(b[e]), x2h = bfhi(b[e]);
                    o1[e] = pk2(x1l * c0 - x2l * s0, x1h * c1 - x2h * s1); o2[e] = pk2(x1l * s0 + x2l * c0, x1h * s1 + x2h * c1); }
                const int p1 = v, p2 = v + 3;
                *(u32x4*)(dst + ((p1 >> 1) * 64 + (p1 & 1) * 32) * 8) = o1; *(u32x4*)(dst + ((p2 >> 1) * 64 + (p2 & 1) * 32) * 8) = o2;
            } else { const int pc = v + 3; *(u32x4*)(dst + ((pc >> 1) * 64 + (pc & 1) * 32) * 8) = *(const u32x4*)(src + 8 * pc); }
        }
    }
    const bf16* VSR = (const bf16*)(ar + NA_VSR); const bf16* VWR = (const bf16*)(ar + NA_VWR); bf16* VSF = (bf16*)(ar + NA_VSF); bf16* VWF = (bf16*)(ar + NA_VWF);
    const int r = F.lane & 31, h = F.lane >> 5;
    for (int u = F.gw; u < 2 * BPH * 4 * 128; u += F.NGW) {
        const int tens = u >> 11, bg = (u >> 7) & 15, tile = u & 127, bl = bg >> 2, g = bg & 3;
        const bf16* src = (tens ? VWR : VSR) + ((size_t)bl * SEQ + tile * 32) * 512 + g * 128 + r;
        bf16* vd = (tens ? VWF : VSF) + (((size_t)bg * 128 + tile) * 8 * 64 + F.lane) * 8;
#pragma unroll
        for (int db = 0; db < 4; ++db)
#pragma unroll
            for (int s = 0; s < 2; ++s) { unsigned short e[8];
#pragma unroll
                for (int j = 0; j < 8; ++j) e[j] = src[(size_t)(16 * s + 8 * (j >> 2) + 4 * h + (j & 3)) * 512 + db * 32];
                u32x4 w; w.x = e[0] | ((unsigned)e[1] << 16); w.y = e[2] | ((unsigned)e[3] << 16); w.z = e[4] | ((unsigned)e[5] << 16); w.w = e[6] | ((unsigned)e[7] << 16);
                *(u32x4*)(vd + (db * 2 + s) * 512) = w; }
    }
}
DI float sigmoidf_(float x) { return __builtin_amdgcn_rcpf(1.0f + __builtin_amdgcn_exp2f(-x * LOG2E)); }
struct LinKA { const bf16* base; size_t tstride; DI const bf16* operator()(int t) const { return base + (size_t)t * tstride; } };
struct LinVA { const bf16* base; size_t dbstride; DI const bf16* operator()(int t, int db) const { return base + (size_t)db * dbstride + t * 32; } };
struct CmpMK { int tq, h; DI void operator()(int t, f32x16& S) const {
#pragma unroll
    for (int i = 0; i < 16; ++i) { const int n = 32 * t + crow(i, h); S[i] = (16 * n + 31 <= tq) ? S[i] : -INFINITY; } } };
struct WinMK { int tq, h; DI void operator()(int t, f32x16& S) const {
#pragma unroll
    for (int i = 0; i < 16; ++i) { const int k = 32 * t + crow(i, h); S[i] = (k <= tq && k > tq - 512) ? S[i] : -INFINITY; } } };
DI void ph_nsa_cmp(const Frame& F, const int dry = 0) {
    unsigned char* ar = F.ws + WS_AR; const bf16* Q = (const bf16*)(ar + NA_Q); const bf16* KCMP = (const bf16*)(ar + NA_KCMP); const bf16* VCT = (const bf16*)(ar + NA_VCT); const bf16* GT = (const bf16*)(ar + NA_GT);
    unsigned char* SELB = ar + NA_SELB; bf16* Ob = (bf16*)(ar + NA_O);
    LAS float* imp = (LAS float*)F.lds;
    LAS unsigned char* qlds = F.lds + 20480 + F.wave * 12288 + F.lane * 16;
    const int lane = F.lane, r = lane & 31, h = lane >> 5;
    for (int u = blockIdx.x; u < BPH * 4 * 64; u += F.G) {
        const int bg = u >> 6, qt64 = u & 63, bl = bg >> 2, g = bg & 3;
        for (int i = F.tid; i < 64 * 65; i += NWAVES * 64) imp[i] = 0.f;
        __syncthreads();
#pragma unroll 1
        for (int k = 0; k < 3; ++k) {
            const int idx = F.wave * 3 + k, j = idx >> 1, sub = idx & 1, ql = sub * 32 + r, tq = qt64 * 64 + ql, hd = g * 12 + j;
            const size_t mrow = (size_t)bl * SEQ + tq;
            bf16x8 qf[12];
#pragma unroll
            for (int s = 0; s < 12; ++s) { qf[s] = *(const bf16x8*)(Q + mrow * 9216 + hd * 192 + 16 * s + 8 * h); *(LAS bf16x8*)(qlds + s * 1024) = qf[s]; }
            LDS_WAIT();
            const int tqmax = qt64 * 64 + sub * 32 + 31, te = (tqmax >= 31) ? ((tqmax - 31) / 16) / 32 + 1 : 0;
            const FragKA ka{KCMP + ((size_t)bg * 8 * 12 * 64 + lane) * 8, 12}; const FragVA va{VCT + ((size_t)bg * 8 * 8 * 64 + lane) * 8}; const CmpMK mk{tq, h};
            f32x16 O[4];
#pragma unroll
            for (int db = 0; db < 4; ++db)
#pragma unroll
                for (int i = 0; i < 16; ++i) O[db][i] = 0.f;
            float m = -INFINITY, l = 0.f;
            attn_run<12, 4, false, true, true>(qf, qlds, O, m, l, 0, te, ka, va, mk);
            l += __shfl_xor(l, 32);
            const float linv = l > 0.f ? 1.0f / l : 0.f, ms = (m == -INFINITY) ? 0.f : m;
            for (int t = 0; t < te; ++t) {
                const bf16* kp = ka(t); f32x16 S;
#pragma unroll
                for (int i = 0; i < 16; ++i) S[i] = 0.f;
#pragma unroll
                for (int s = 0; s < 12; ++s) { unsigned qa_ = (unsigned)(size_t)qlds; asm volatile("" : "+v"(qa_)); S = MFMA32(*(const bf16x8*)(kp + 512 * s), *(const LAS bf16x8*)((LAS unsigned char*)(size_t)qa_ + s * 1024), S); }
                mk(t, S);
#pragma unroll
                for (int i = 0; i < 16; ++i) S[i] = __builtin_amdgcn_exp2f(S[i] - ms) * linv;
#pragma unroll
                for (int g4 = 0; g4 < 4; ++g4) { const float gs = (S[4 * g4] + S[4 * g4 + 1]) + (S[4 * g4 + 2] + S[4 * g4 + 3]); const int mb = 8 * t + 2 * g4 + h;
                    __hip_atomic_fetch_add(imp + ql * 65 + mb, gs, __ATOMIC_RELAXED, __HIP_MEMORY_SCOPE_WORKGROUP);
                    if (mb + 1 < 64) __hip_atomic_fetch_add(imp + ql * 65 + mb + 1, S[4 * g4 + 3], __ATOMIC_RELAXED, __HIP_MEMORY_SCOPE_WORKGROUP); }
                bf16x8 pf[2];
#pragma unroll
                for (int s = 0; s < 2; ++s) { u32x4 w; w.x = pk2(S[8 * s], S[8 * s + 1]); w.y = pk2(S[8 * s + 2], S[8 * s + 3]); w.z = pk2(S[8 * s + 4], S[8 * s + 5]); w.w = pk2(S[8 * s + 6], S[8 * s + 7]); pf[s] = __builtin_bit_cast(bf16x8, w); }
#pragma unroll
                for (int db = 0; db < 4; ++db) { const bf16* vp = va(t, db);
#pragma unroll
                    for (int s = 0; s < 2; ++s) O[db] = MFMA32(*(const bf16x8*)(vp + 512 * s), pf[s], O[db]); }
            }
            const float gate = sigmoidf_(bf2f(GT[mrow * 256 + hd]));
            store_col<false>(dry ? (bf16*)(ar + DUMMY_OFF) + ((size_t)F.gw * 32 + r) * 128 : Ob + mrow * 6144 + hd * 128, O, gate, h);
        }
        __syncthreads();
#pragma unroll 1
        for (int k = 0; k < 8; ++k) {
            const int ql = F.wave * 8 + k, tq = qt64 * 64 + ql, cur = tq >> 6, mb = lane;
            const bool causal = mb <= cur, forced = (mb == 0) || (mb == cur) || (mb == cur - 1);
            const float v = causal ? (forced ? INFINITY : imp[ql * 65 + mb]) : -INFINITY;
            int rank = 0;
            for (int o = 0; o < 64; ++o) { const float vo = __shfl(v, o); rank += (vo > v || (vo == v && o < mb)) ? 1 : 0; }
            if (rank < 16) (dry ? ar + DUMMY_OFF + 32 * MiB + (size_t)F.gw * 16 : SELB + ((size_t)bg * 4096 + tq) * 16)[rank] = causal ? (unsigned char)mb : (unsigned char)0xFF;
        }
        __syncthreads();
    }
}
DI int sel_tile(const u32x4& sel, int t) { const int b = t >> 1; const unsigned w = (b < 4) ? sel.x : (b < 8) ? sel.y : (b < 12) ? sel.z : sel.w; return (int)((w >> ((b & 3) * 8)) & 0xFFu) * 2 + (t & 1); }
struct SelKA { const bf16* base; u32x4 sel; DI const bf16* operator()(int t) const { return base + (size_t)sel_tile(sel, t) * 12 * 512; } };
struct SelVA { const bf16* base; u32x4 sel; DI const bf16* operator()(int t, int db) const { return base + ((size_t)sel_tile(sel, t) * 8 + db * 2) * 512; } };
struct SelMK { u32x4 sel; int tq, h; DI void operator()(int t, f32x16& S) const { const int k0 = sel_tile(sel, t) * 32;
#pragma unroll
    for (int i = 0; i < 16; ++i) S[i] = (k0 + crow(i, h) <= tq) ? S[i] : -INFINITY; } };
DI void ph_nsa_sel(const Frame& F, const int dry = 0) {
    unsigned char* ar = F.ws + WS_AR; const bf16* Q = (const bf16*)(ar + NA_Q); const bf16* KSF = (const bf16*)(ar + NA_KSF); const bf16* VSF = (const bf16*)(ar + NA_VSF); const bf16* GT = (const bf16*)(ar + NA_GT);
    const unsigned char* SELB = ar + NA_SELB; bf16* Ob = (bf16*)(ar + NA_O);
    const int r = F.lane & 31, h = F.lane >> 5; const bool act = r < 12;
    LAS unsigned char* qlds = F.lds + F.wave * 12288 + F.lane * 16;
    for (int it = F.gw; it < BPH * 4 * SEQ; it += F.NGW) {
        const int bg = it >> 12, tq = it & 4095, bl = bg >> 2, g = bg & 3; const size_t mrow = (size_t)bl * SEQ + tq; const int hd = g * 12 + (act ? r : 0);
        bf16x8 qf[12];
#pragma unroll
        for (int s = 0; s < 12; ++s) { qf[s] = *(const bf16x8*)(Q + mrow * 9216 + hd * 192 + 16 * s + 8 * h); if (!act) qf[s] = (bf16x8){0, 0, 0, 0, 0, 0, 0, 0}; *(LAS bf16x8*)(qlds + s * 1024) = qf[s]; }
        LDS_WAIT();
        const u32x4 sel = *(const u32x4*)(SELB + (size_t)it * 16);
        const int nv = ((tq >> 6) + 1 < 16) ? (tq >> 6) + 1 : 16;
        const SelKA ka{KSF + ((size_t)bg * 128 * 12 * 64 + F.lane) * 8, sel}; const SelVA va{VSF + ((size_t)bg * 128 * 8 * 64 + F.lane) * 8, sel}; const SelMK mk{sel, tq, h};
        f32x16 O[4];
#pragma unroll
        for (int db = 0; db < 4; ++db)
#pragma unroll
            for (int i = 0; i < 16; ++i) O[db][i] = 0.f;
        float m = -INFINITY, l = 0.f;
        attn_run<12, 4, true, true, true>(qf, qlds, O, m, l, 0, 2 * nv, ka, va, mk);
        l += __shfl_xor(l, 32);
        if (act) { const float gate = sigmoidf_(bf2f(GT[mrow * 256 + 48 + hd])); store_col<true>(dry ? (bf16*)(ar + DUMMY_OFF) + ((size_t)F.gw * 32 + r) * 128 : Ob + mrow * 6144 + hd * 128, O, l > 0.f ? gate / l : 0.f, h); }
    }
}
DI void ph_nsa_win(const Frame& F, const int dry = 0) {
    unsigned char* ar = F.ws + WS_AR; const bf16* Q = (const bf16*)(ar + NA_Q); const bf16* KWF = (const bf16*)(ar + NA_KWF); const bf16* VWF = (const bf16*)(ar + NA_VWF); const bf16* GT = (const bf16*)(ar + NA_GT); bf16* Ob = (bf16*)(ar + NA_O);
    const int r = F.lane & 31, h = F.lane >> 5;
    LAS unsigned char* qlds = F.lds + F.wave * 12288 + F.lane * 16;
    for (int id = F.gw; id < BPH * 48 * 128; id += F.NGW) {
        const int qt = id & 127, bh = id >> 7, hd = bh % 48, bl = bh / 48, g = hd / 12, tq = qt * 32 + r; const size_t mrow = (size_t)bl * SEQ + tq;
        bf16x8 qf[12];
#pragma unroll
        for (int s = 0; s < 12; ++s) { qf[s] = *(const bf16x8*)(Q + mrow * 9216 + hd * 192 + 16 * s + 8 * h); *(LAS bf16x8*)(qlds + s * 1024) = qf[s]; }
        LDS_WAIT();
        const int bg = bl * 4 + g; const FragKA ka{KWF + ((size_t)bg * 128 * 12 * 64 + F.lane) * 8, 12}; const FragVA va{VWF + ((size_t)bg * 128 * 8 * 64 + F.lane) * 8}; const WinMK mk{tq, h};
        f32x16 O[4];
#pragma unroll
        for (int db = 0; db < 4; ++db)
#pragma unroll
            for (int i = 0; i < 16; ++i) O[db][i] = 0.f;
        float m = -INFINITY, l = 0.f;
        attn_run<12, 4, true, true, true>(qf, qlds, O, m, l, qt >= 16 ? qt - 16 : 0, qt + 1, ka, va, mk);
        l += __shfl_xor(l, 32);
        const float gate = sigmoidf_(bf2f(GT[mrow * 256 + 96 + hd]));
        store_col<true>(dry ? (bf16*)(ar + DUMMY_OFF) + ((size_t)F.gw * 32 + r) * 128 : Ob + mrow * 6144 + hd * 128, O, l > 0.f ? gate / l : 0.f, h);
    }
}
#ifndef MK_ONE_LAUNCH
#define MK_ONE_LAUNCH 1
#endif
constexpr int NPH = 98;
struct Args { const float* in[58]; float* out; unsigned char* ws; int ph_lo, ph_hi; };
#ifndef PROBE_GEMM
#define PROBE_GEMM 0
#endif
#ifndef PROBE_PH
#define PROBE_PH 0
#endif
#define GEMM_CALL(EpiT, Evar, Aptr, Bptr, Mv, Nv, Kv, ldav, ldbv, cidx) do { if (PROBE_GEMM) { const pg8::Gemm g0_{(const pg8::bf16_t*)(Aptr), (const pg8::bf16_t*)(Bptr), (Mv), (Nv), (Kv), (ldav), (ldbv)}; \
    pg8::StaticOrder S0_; S0_.init((Mv), (Nv), F.G, (cidx)); pg8::EpiDry E0_{(float*)(ar + DUMMY_OFF)}; pg8::gemm_phase<pg8::EpiDry, pg8::StaticOrder, true, true>((PG8_LAS unsigned char*)F.lds, g0_, S0_, E0_); __syncthreads(); } \
    const pg8::Gemm g_{(const pg8::bf16_t*)(Aptr), (const pg8::bf16_t*)(Bptr), (Mv), (Nv), (Kv), (ldav), (ldbv)}; \
    pg8::StaticOrder S_; S_.init((Mv), (Nv), F.G, (cidx)); pg8::gemm_phase<EpiT, pg8::StaticOrder, true, true>((PG8_LAS unsigned char*)F.lds, g_, S_, Evar); } while (0)
DI pg8::EpiBf16R epi1(bf16* base, int ldc) { pg8::EpiBf16R e; for (int s = 0; s < 8; ++s) { e.T.base[s] = base; e.T.ldc[s] = ldc; e.T.t0[s] = 0; e.T.gw[s] = 0; } e.T.nseg = 1; e.T.pad_ = 0; return e; }
#define PH_BEGIN if (ph >= lo && ph < hi) { Frame F; { unsigned long long w_ = (unsigned long long)args.ws; asm volatile("" : "+s"(w_)); F.ws = (unsigned char*)w_; F.ctl = (unsigned*)(F.ws + WS_CTL); } \
    F.lds = lds; F.tid = threadIdx.x; F.lane = F.tid & 63; F.wave = __builtin_amdgcn_readfirstlane(F.tid >> 6); F.G = gridDim.x; F.gw = blockIdx.x * NWAVES + F.wave; F.NGW = F.G * NWAVES; \
    float* out; { unsigned long long o_ = (unsigned long long)args.out; asm volatile("" : "+s"(o_)); out = (float*)o_; } \
    unsigned char* const ar = F.ws + WS_AR; bf16* const XN = (bf16*)(F.ws + WS_XN); bf16* const WB = (bf16*)(F.ws + WS_WMIX); bf16* const WUP = (bf16*)(F.ws + WS_WFFN); bf16* const WDN = WUP + (size_t)2 * DFF * DM; \
    const float* const res_mix = (ib == 2) ? args.in[0] : (const float*)out; (void)ar; (void)XN; (void)WB; (void)WUP; (void)WDN; (void)res_mix; (void)iff;
#define PH_END   if (ph + 1 < hi) { XcdBarrier b_; b_.bar = (unsigned*)F.ctl + CW_BAR; b_.x = xb_xcc_id(); b_.st = MISC + 8; xcd_barrier(b_); } } ++ph;
template <int LAYER> DI void run_cvt(const Args& args, LAS unsigned char* lds, volatile LAS unsigned* MISC, int& ph, const int lo, const int hi) {
    constexpr int ib = (LAYER == 0) ? 2 : (LAYER == 1) ? 17 : (LAYER == 2) ? 26 : 42;
    constexpr int iff = (LAYER == 0) ? 12 : (LAYER == 1) ? 21 : (LAYER == 2) ? 37 : 52;
    constexpr int kind = (LAYER == 1) ? 1 : (LAYER == 2) ? 2 : 0;
        PH_BEGIN
            if constexpr (kind == 0) ph_dsa_cvt(F, args.in[ib + 1], args.in[ib + 6], args.in[ib + 7], args.in[ib + 8], args.in[ib + 9]);
            else if constexpr (kind == 1) ph_fox_cvt(F, args.in[ib + 1], args.in[ib + 3]);
            else ph_nsa_cvt(F, args.in[ib + 1], args.in[ib + 2], args.in[ib + 3], args.in[ib + 4], args.in[ib + 5], args.in[ib + 6], args.in[ib + 7], args.in[ib + 8], args.in[ib + 9], args.in[ib + 10]);
            ph_cvt_ffn(F, args.in[iff + 1], args.in[iff + 4]);
        PH_END
}
template <int LAYER, int HALF> DI void run_half(const Args& args, LAS unsigned char* lds, volatile LAS unsigned* MISC, int& ph, const int lo, const int hi) {
    constexpr int ib = (LAYER == 0) ? 2 : (LAYER == 1) ? 17 : (LAYER == 2) ? 26 : 42;
    constexpr int iff = (LAYER == 0) ? 12 : (LAYER == 1) ? 21 : (LAYER == 2) ? 37 : 52;
    constexpr int kind = (LAYER == 1) ? 1 : (LAYER == 2) ? 2 : 0;
    constexpr int half = HALF;
            const int roff = half * MC;
            PH_BEGIN ph_rmsnorm(F, res_mix, roff, args.in[ib], XN); PH_END
            if constexpr (kind == 0) {
                PH_BEGIN { pg8::EpiF32 E{(float*)(ar + DA_DIN), 1024}; GEMM_CALL(pg8::EpiF32, E, XN, WB + DW_W1, MC, 1024, DM, DM, DM, (int)blockIdx.x); } PH_END
                PH_BEGIN ph_dsa_post1(F, half, args.in[ib + 2], args.in[ib + 3], args.in[ib + 4], args.in[ib + 5]); PH_END
                PH_BEGIN { pg8::EpiBf16R E = epi1((bf16*)(ar + DA_QL), 8192); E.T.base[1] = (bf16*)(ar + DA_QPE); E.T.ldc[1] = 1536; E.T.t0[1] = 32; E.T.base[2] = (bf16*)(ar + DA_QIDX); E.T.ldc[2] = 2048; E.T.t0[2] = 38; E.T.nseg = 3;
                    GEMM_CALL(pg8::EpiBf16R, E, ar + DA_CQN, WB + DW_W2, MC, 11776, 512, 512, 512, (int)blockIdx.x); } PH_END
                PH_BEGIN ph_dsa_rope(F, half); PH_END
                PH_BEGIN if (PROBE_PH == 1) { ph_dsa_index(F, 1); __syncthreads(); } ph_dsa_index(F); PH_END
                PH_BEGIN if (PROBE_PH == 2) { ph_dsa_attn(F, 1); __syncthreads(); } ph_dsa_attn(F); PH_END
                PH_BEGIN { pg8::EpiRes E{res_mix, out, DM, roff}; GEMM_CALL(pg8::EpiRes, E, ar + DA_QL, WB + DW_WO, MC, DM, 8192, 8192, 8192, (int)blockIdx.x); } PH_END
            } else if constexpr (kind == 1) {
                PH_BEGIN { pg8::EpiBf16R E = epi1((bf16*)(ar + FA_Q), DM); E.T.base[1] = (bf16*)(ar + FA_K); E.T.ldc[1] = DM; E.T.t0[1] = 8; E.T.base[2] = (bf16*)(ar + FA_V); E.T.ldc[2] = DM; E.T.t0[2] = 16;
                    E.T.base[3] = (bf16*)(ar + FA_F); E.T.ldc[3] = 256; E.T.t0[3] = 24; E.T.nseg = 4;
                    GEMM_CALL(pg8::EpiBf16R, E, XN, WB + FW_IN, MC, 6400, DM, DM, DM, (int)blockIdx.x); } PH_END
                PH_BEGIN ph_fox_scan(F, args.in[ib + 2]); PH_END
                PH_BEGIN if (PROBE_PH == 3) { ph_fox_attn(F, 1); __syncthreads(); } ph_fox_attn(F); PH_END
                PH_BEGIN { pg8::EpiRes E{res_mix, out, DM, roff}; GEMM_CALL(pg8::EpiRes, E, ar + FA_O, WB + FW_OUT, MC, DM, DM, DM, DM, (int)blockIdx.x); } PH_END
            } else {
                PH_BEGIN { pg8::EpiBf16R E = epi1((bf16*)(ar + NA_Q), 9216);
                    E.T.base[1] = (bf16*)(ar + NA_KC); E.T.ldc[1] = 192; E.T.t0[1] = 36; E.T.gw[1] = 192;
                    E.T.base[2] = (bf16*)(ar + NA_VC); E.T.ldc[2] = 128; E.T.t0[2] = 39; E.T.gw[2] = 128;
                    E.T.base[3] = (bf16*)(ar + NA_KSR); E.T.ldc[3] = 768; E.T.t0[3] = 41;
                    E.T.base[4] = (bf16*)(ar + NA_KWR); E.T.ldc[4] = 768; E.T.t0[4] = 44;
                    E.T.base[5] = (bf16*)(ar + NA_GT); E.T.ldc[5] = 256; E.T.t0[5] = 47;
                    E.T.base[6] = (bf16*)(ar + NA_VSR); E.T.ldc[6] = 512; E.T.t0[6] = 48;
                    E.T.base[7] = (bf16*)(ar + NA_VWR); E.T.ldc[7] = 512; E.T.t0[7] = 50; E.T.nseg = 8;
                    GEMM_CALL(pg8::EpiBf16R, E, XN, WB + NW_IN, MC, 13312, DM, DM, DM, (int)blockIdx.x); } PH_END
                PH_BEGIN ph_nsa_rope(F, half); PH_END
                PH_BEGIN {
                    const float* BIAS = (const float*)(args.ws + WS_MISC);
                    { pg8::EpiGelu E{(bf16*)(ar + NA_GK), 256, BIAS}; GEMM_CALL(pg8::EpiGelu, E, ar + NA_KC, WB + NW_W1K, 4096, 256, 6144, 3072, 6144, (int)blockIdx.x); }
                    { pg8::EpiGelu E{(bf16*)(ar + NA_GV), 256, BIAS + 256}; GEMM_CALL(pg8::EpiGelu, E, ar + NA_VC, WB + NW_W1V, 4096, 256, 4096, 2048, 4096, (int)((blockIdx.x + F.G - 16) % F.G)); }
                } PH_END
                PH_BEGIN {
                    { pg8::EpiBf16R E = epi1((bf16*)(ar + NA_KCMP), 12); E.T.gw[0] = -1; GEMM_CALL(pg8::EpiBf16R, E, ar + NA_GK, WB + NW_W2K, 4096, 256, 256, 256, 256, (int)blockIdx.x); }
                    { pg8::EpiBf16R E = epi1((bf16*)(ar + NA_VCT), 4); E.T.gw[0] = -2; GEMM_CALL(pg8::EpiBf16R, E, WB + NW_W2V, ar + NA_GV, 256, 4096, 256, 256, 256, (int)((blockIdx.x + F.G - 16) % F.G)); }
                } PH_END
                PH_BEGIN if (PROBE_PH == 4) { ph_nsa_cmp(F, 1); __syncthreads(); } ph_nsa_cmp(F); PH_END
                PH_BEGIN if (PROBE_PH == 5) { ph_nsa_sel(F, 1); __syncthreads(); } ph_nsa_sel(F); PH_END
                PH_BEGIN if (PROBE_PH == 6) { ph_nsa_win(F, 1); __syncthreads(); } ph_nsa_win(F); PH_END
                PH_BEGIN { pg8::EpiRes E{res_mix, out, DM, roff}; GEMM_CALL(pg8::EpiRes, E, ar + NA_O, WB + NW_OUT, MC, DM, 6144, 6144, 6144, (int)blockIdx.x); } PH_END
            }
            PH_BEGIN ph_rmsnorm(F, out, roff, args.in[iff], XN); PH_END
            PH_BEGIN { pg8::EpiBf16R E = epi1((bf16*)ar, 2 * DFF); GEMM_CALL(pg8::EpiBf16R, E, XN, WUP, MC, 2 * DFF, DM, DM, DM, (int)blockIdx.x); } PH_END
            PH_BEGIN ph_conv_glu(F, (const bf16*)ar, (bf16*)(ar + 352 * MiB), args.in[iff + 2], args.in[iff + 3]); PH_END
            PH_BEGIN { pg8::EpiRes E{out, out, DM, roff}; GEMM_CALL(pg8::EpiRes, E, ar + 352 * MiB, WDN, MC, DM, DFF, DFF, DFF, (int)blockIdx.x); } PH_END
}
__global__ void __launch_bounds__(NWAVES * 64, 2) mk_fwd(Args args) {
    extern __shared__ __attribute__((aligned(16))) unsigned char lds_[];
    LAS unsigned char* const lds = (LAS unsigned char*)lds_;
    volatile LAS unsigned* MISC = (volatile LAS unsigned*)(lds + LDSCTL_OFF);
    for (int u = threadIdx.x; u < 64; u += NWAVES * 64) ((LAS unsigned*)(lds + LDSCTL_OFF))[u] = 0u;
    __syncthreads();
    const int lo = args.ph_lo, hi = args.ph_hi;
    (void)xcd_barrier_post((unsigned*)(args.ws + WS_CTL) + CW_BAR, MISC + 8);
    int ph = 0;
    { constexpr int ib = 2, iff = 12; PH_BEGIN ph_tables(F, (const int*)args.in[1]); PH_END }
    run_cvt<0>(args, lds, MISC, ph, lo, hi); run_half<0, 0>(args, lds, MISC, ph, lo, hi); run_half<0, 1>(args, lds, MISC, ph, lo, hi);
    run_cvt<1>(args, lds, MISC, ph, lo, hi); run_half<1, 0>(args, lds, MISC, ph, lo, hi); run_half<1, 1>(args, lds, MISC, ph, lo, hi);
    run_cvt<2>(args, lds, MISC, ph, lo, hi); run_half<2, 0>(args, lds, MISC, ph, lo, hi); run_half<2, 1>(args, lds, MISC, ph, lo, hi);
    run_cvt<3>(args, lds, MISC, ph, lo, hi); run_half<3, 0>(args, lds, MISC, ph, lo, hi); run_half<3, 1>(args, lds, MISC, ph, lo, hi);
    { constexpr int ib = 42, iff = 52; PH_BEGIN ph_final_norm(F, out, args.in[57]); PH_END }
}
extern "C" void kernel_launch(void* const* d_in, const int* in_sizes, int n_in, void* d_out, int out_size, void* d_ws, size_t ws_size, hipStream_t stream) {
    static int grid = 0;
    if (grid == 0) {
        if (n_in != 58 || out_size != MTOT * DM || ws_size < WS_END) { fprintf(stderr, "kernel_launch: unexpected shapes (n_in %d, out %d, ws %zu)\n", n_in, out_size, ws_size); grid = -1; return; }
        int dev = 0, cus = 0;
        if (hipGetDevice(&dev) != hipSuccess || hipDeviceGetAttribute(&cus, hipDeviceAttributeMultiprocessorCount, dev) != hipSuccess) { grid = -1; return; }
        if (hipFuncSetAttribute((const void*)mk_fwd, hipFuncAttributeMaxDynamicSharedMemorySize, LDS_BYTES) != hipSuccess) { fprintf(stderr, "kernel_launch: hipFuncSetAttribute failed\n"); grid = -1; return; }
        int per_cu = 0;
        (void)hipOccupancyMaxActiveBlocksPerMultiprocessor(&per_cu, (const void*)mk_fwd, NWAVES * 64, LDS_BYTES);
        (void)hipGetLastError();
        grid = cus;
    }
    if (grid < 0) return;
    if (hipMemsetAsync((char*)d_ws + WS_CTL, 0, CTL_ZERO_BYTES, stream) != hipSuccess) return;
    Args a{};
    for (int i = 0; i < 58; ++i) a.in[i] = (const float*)d_in[i];
    a.out = (float*)d_out; a.ws = (unsigned char*)d_ws;
#if MK_ONE_LAUNCH
    a.ph_lo = 0; a.ph_hi = NPH;
    hipLaunchKernelGGL(mk_fwd, dim3(grid), dim3(NWAVES * 64), LDS_BYTES, stream, a);
#else
    for (int p = 0; p < NPH; ++p) { a.ph_lo = p; a.ph_hi = p + 1; hipLaunchKernelGGL(mk_fwd, dim3(grid), dim3(NWAVES * 64), LDS_BYTES, stream, a); }
#endif
}
```

```cpp
#include <hip/hip_runtime.h>
#include <cstdio>
#include <cstdint>
#define DI __device__ __forceinline__
namespace pg8 {
#define PG8_LAS __attribute__((address_space(3)))
typedef unsigned short bf16_t;
typedef short bf16x8 __attribute__((ext_vector_type(8)));
typedef float f32x4 __attribute__((ext_vector_type(4)));
typedef unsigned u32x4 __attribute__((ext_vector_type(4)));
constexpr int BM = 256, BK = 64, HALF = 128, HTB = HALF * BK * 2  , STAGE_BYTES = 8 * HTB, NXCD = 8, WGM = 8;

__host__ __device__ __forceinline__ int lds_byte(int r, int c) { const int st = (r >> 4) * 2 + (c >> 5), rr = r & 15, cc = c & 31, ob = rr * 64 + cc * 2; return st * 1024 + (ob ^ (((ob >> 9) & 1) << 5)); }
__host__ __device__ __forceinline__ void stage_rc(int b, int& R, int& C) { const int st = b / 1024, sb = b % 1024, swz = sb ^ (((sb >> 9) & 1) << 5); R = (st >> 1) * 16 + swz / 64; C = (st & 1) * 32 + (swz % 64) / 2; }
__host__ __device__ __forceinline__ int perm32(int rho) { const int n = rho >> 4, i = rho & 15; return 8 * (i >> 2) + 4 * n + (i & 3); }

struct Unit { int pm, pn; };
struct Gemm { const bf16_t* A; const bf16_t* Bt; int M, N, K, lda, ldb; };

struct StaticOrder {
    int nM, nN, nwg, G, c;
    __host__ __device__ void init(int M, int N, int G_, int c_) { nM = M / BM; nN = N / BM; nwg = nM * nN; G = G_; c = c_; }
    __host__ __device__ bool next(int i, Unit& u) const {
        const long L = (long)i * G + c; if (L >= nwg) return false;
        int wgid = (int)L; { const int q = nwg / NXCD, r = nwg % NXCD, xcd = wgid % NXCD, off = wgid / NXCD; wgid = (xcd < r ? xcd * (q + 1) : r * (q + 1) + (xcd - r) * q) + off; }
        const int nig = WGM * nN, gid = wgid / nig, fm = gid * WGM, gsz = (nM - fm) < WGM ? (nM - fm) : WGM;
        u.pm = fm + ((wgid % nig) % gsz); u.pn = (wgid % nig) / gsz; return true;
    }
    __device__ __forceinline__ void a_ready(const Unit&) const {}
    __device__ __forceinline__ void done(const Unit&) const {}
};
__device__ __forceinline__ unsigned cvt_pk_bf16(float lo, float hi) { unsigned r; asm volatile("v_cvt_pk_bf16_f32 %0, %1, %2" : "=v"(r) : "v"(lo), "v"(hi)); return r; }
template <class Epi, class Sched, bool ALIGN_EPI = false, bool SP2 = false>
__device__ __forceinline__ void gemm_phase(PG8_LAS unsigned char* lds, const Gemm g, const Sched& S, const Epi& E) {
    const int tid = threadIdx.x, wid = __builtin_amdgcn_readfirstlane(tid >> 6), lane = tid & 63, wr = wid >> 2, wc = wid & 3, fr = lane & 15, fq = lane >> 4;
    const int K = g.K, nt = K / BK;
    unsigned voffA[2], voffB[2];
#pragma unroll
    for (int i = 0; i < 2; ++i) { int R, C; stage_rc(tid * 16 + i * 8192, R, C); const int Rb = Epi::PERM ? ((R & ~31) + perm32(R & 31)) : R;
        voffA[i] = (unsigned)(R * g.lda + C) * 2u; voffB[i] = (unsigned)(Rb * g.ldb + C) * 2u; }
    const size_t kstep = (size_t)(BK * 2);
    const size_t hstepA = (size_t)HALF * g.lda * 2, hstepB = (size_t)HALF * g.ldb * 2;
    const size_t tstepA = 2 * hstepA, tstepB = 2 * hstepB;
    const unsigned ldsw = (unsigned)wid * 1024u;
    const int aoff = lds_byte(wr * 64 + fr, fq * 8), boff = lds_byte(wc * 32 + fr, fq * 8);
#define PG8_SA(b, h) (((b) * 2 + (h)) * HTB)
#define PG8_SB(b, h) ((4 + (b) * 2 + (h)) * HTB)
#define PG8_STAGE(bufoff, gbase, voff) do { _Pragma("unroll") for (int _i = 0; _i < 2; ++_i) \
        __builtin_amdgcn_global_load_lds((const unsigned*)((const char*)(gbase) + (voff)[_i]), (PG8_LAS unsigned*)(lds + (bufoff) + ldsw + _i * 8192), 16, 0, 0); } while (0)
#define PG8_LDA(dst, b, h) do { _Pragma("unroll") for (int m = 0; m < 4; ++m) _Pragma("unroll") for (int k = 0; k < 2; ++k) dst[m][k] = *(const PG8_LAS bf16x8*)(lds + PG8_SA(b, h) + aoff + m * 2048 + k * 1024); } while (0)
#define PG8_LDB(dst, b, h) do { _Pragma("unroll") for (int n = 0; n < 2; ++n) _Pragma("unroll") for (int k = 0; k < 2; ++k) dst[n][k] = *(const PG8_LAS bf16x8*)(lds + PG8_SB(b, h) + boff + n * 2048 + k * 1024); } while (0)
#define PG8_MMA(ai, bj, At, Bt) do { __builtin_amdgcn_s_setprio(1); _Pragma("unroll") for (int m = 0; m < 4; ++m) _Pragma("unroll") for (int n = 0; n < 2; ++n) _Pragma("unroll") for (int k = 0; k < 2; ++k) \
        acc[ai][bj][m][n] = __builtin_amdgcn_mfma_f32_16x16x32_bf16(Bt[n][k], At[m][k], acc[ai][bj][m][n], 0, 0, 0); __builtin_amdgcn_s_setprio(0); } while (0)
#define PG8_WAIT_V(n) asm volatile("s_waitcnt vmcnt(" #n ")" ::: "memory")
#define PG8_WAIT_L(n) asm volatile("s_waitcnt lgkmcnt(" #n ")" ::: "memory")
#define PG8_BAR __builtin_amdgcn_s_barrier()
#define PG8_SCHED __builtin_amdgcn_sched_barrier(0)
    Unit cur, nxt; int ui = 0;
    if (!S.next(0, cur)) return;
    f32x4 acc[2][2][4][2];
#pragma unroll
    for (int a = 0; a < 2; ++a)
#pragma unroll
        for (int b = 0; b < 2; ++b)
#pragma unroll
            for (int m = 0; m < 4; ++m)
#pragma unroll
                for (int n = 0; n < 2; ++n) acc[a][b][m][n] = (f32x4){0.f, 0.f, 0.f, 0.f};
    bf16x8 At[4][2], B0[2][2], B1[2][2];
    const char* cA = (const char*)g.A + (size_t)cur.pm * tstepA; const char* cB = (const char*)g.Bt + (size_t)cur.pn * tstepB;
    S.a_ready(cur);
    if constexpr (SP2) {
        PG8_STAGE(PG8_SB(0, 0), cB, voffB); PG8_STAGE(PG8_SB(0, 1), cB + hstepB, voffB); PG8_STAGE(PG8_SA(0, 0), cA, voffA); PG8_STAGE(PG8_SA(0, 1), cA + hstepA, voffA);
        if (wr == 1) PG8_BAR;
        PG8_WAIT_V(2); PG8_BAR;
        PG8_STAGE(PG8_SB(1, 0), cB + kstep, voffB); PG8_STAGE(PG8_SA(1, 0), cA + kstep, voffA); PG8_STAGE(PG8_SB(1, 1), cB + hstepB + kstep, voffB);
        PG8_WAIT_V(6); PG8_BAR;
    } else {
        PG8_STAGE(PG8_SB(0, 0), cB, voffB); PG8_STAGE(PG8_SA(0, 0), cA, voffA); PG8_STAGE(PG8_SB(0, 1), cB + hstepB, voffB); PG8_STAGE(PG8_SA(0, 1), cA + hstepA, voffA);
        if (wr == 1) PG8_BAR;
        PG8_WAIT_V(4); PG8_BAR;
        PG8_STAGE(PG8_SB(1, 0), cB + kstep, voffB); PG8_STAGE(PG8_SA(1, 0), cA + kstep, voffA); PG8_STAGE(PG8_SB(1, 1), cB + hstepB + kstep, voffB);
        PG8_WAIT_V(6); PG8_BAR;
    }
    for (;;) {
        const bool has_next = S.next(ui + 1, nxt);
        const char* nA = has_next ? (const char*)g.A + (size_t)nxt.pm * tstepA : cA; const char* nB = has_next ? (const char*)g.Bt + (size_t)nxt.pn * tstepB : cB;
        for (int t = 0; t < nt; t += 2) {
            const bool last = (t == nt - 2);
            const char* a1 = cA + (size_t)(t + 1) * kstep;
            const char* a2 = last ? nA : cA + (size_t)(t + 2) * kstep; const char* b2 = last ? nB : cB + (size_t)(t + 2) * kstep;
            const char* a3 = a2 + kstep; const char* b3 = b2 + kstep;
            if (last && has_next) S.a_ready(nxt);
            if constexpr (SP2) {
            PG8_LDB(B0, 0, 0); PG8_LDB(B1, 0, 1); PG8_SCHED; PG8_LDA(At, 0, 0); PG8_STAGE(PG8_SA(1, 1), a1 + hstepA, voffA);
            PG8_WAIT_V(8); PG8_WAIT_L(0); PG8_BAR; PG8_MMA(0, 0, At, B0); PG8_MMA(0, 1, At, B1); PG8_BAR; PG8_SCHED;
            PG8_LDA(At, 0, 1); PG8_STAGE(PG8_SB(0, 0), b2, voffB); PG8_STAGE(PG8_SB(0, 1), b2 + hstepB, voffB); PG8_STAGE(PG8_SA(0, 0), a2, voffA);
            PG8_WAIT_V(8); PG8_WAIT_L(0); PG8_BAR; PG8_MMA(1, 0, At, B0); PG8_MMA(1, 1, At, B1); PG8_BAR; PG8_SCHED;
            PG8_LDB(B0, 1, 0); PG8_LDB(B1, 1, 1); PG8_SCHED; PG8_LDA(At, 1, 0); PG8_STAGE(PG8_SA(0, 1), a2 + hstepA, voffA);
            PG8_WAIT_V(8); PG8_WAIT_L(0); PG8_BAR; PG8_MMA(0, 0, At, B0); PG8_MMA(0, 1, At, B1); PG8_BAR; PG8_SCHED;
            PG8_LDA(At, 1, 1); PG8_STAGE(PG8_SB(1, 0), b3, voffB); PG8_STAGE(PG8_SB(1, 1), b3 + hstepB, voffB); PG8_STAGE(PG8_SA(1, 0), a3, voffA);
            PG8_WAIT_V(8); PG8_WAIT_L(0); PG8_BAR; PG8_MMA(1, 0, At, B0); PG8_MMA(1, 1, At, B1); PG8_BAR; PG8_SCHED;
            } else {
            PG8_LDB(B0, 0, 0); PG8_SCHED; PG8_LDA(At, 0, 0); PG8_STAGE(PG8_SA(1, 1), a1 + hstepA, voffA);
            PG8_WAIT_L(8); PG8_BAR; PG8_WAIT_L(0); PG8_MMA(0, 0, At, B0); PG8_BAR; PG8_SCHED;
            PG8_LDB(B1, 0, 1); PG8_STAGE(PG8_SB(0, 0), b2, voffB);
            PG8_BAR; PG8_WAIT_L(0); PG8_MMA(0, 1, At, B1); PG8_BAR;
            PG8_LDA(At, 0, 1); PG8_STAGE(PG8_SA(0, 0), a2, voffA);
            PG8_BAR; PG8_WAIT_L(0); PG8_MMA(1, 0, At, B0); PG8_BAR; PG8_SCHED;
            PG8_STAGE(PG8_SB(0, 1), b2 + hstepB, voffB);
            PG8_WAIT_V(6); PG8_BAR; PG8_MMA(1, 1, At, B1); PG8_BAR;
            PG8_LDB(B0, 1, 0); PG8_SCHED; PG8_LDA(At, 1, 0); PG8_STAGE(PG8_SA(0, 1), a2 + hstepA, voffA);
            PG8_WAIT_L(8); PG8_BAR; PG8_WAIT_L(0); PG8_MMA(0, 0, At, B0); PG8_BAR; PG8_SCHED;
            PG8_LDB(B1, 1, 1); PG8_STAGE(PG8_SB(1, 0), b3, voffB);
            PG8_BAR; PG8_WAIT_L(0); PG8_MMA(0, 1, At, B1); PG8_BAR;
            PG8_LDA(At, 1, 1); PG8_STAGE(PG8_SA(1, 0), a3, voffA);
            PG8_BAR; PG8_WAIT_L(0); PG8_MMA(1, 0, At, B0); PG8_BAR; PG8_SCHED;
            PG8_STAGE(PG8_SB(1, 1), b3 + hstepB, voffB);
            PG8_WAIT_V(6); PG8_BAR; PG8_MMA(1, 1, At, B1); PG8_BAR;
            }
        }
        if constexpr (ALIGN_EPI) { if (wr == 0) PG8_BAR; }
        if constexpr (!Epi::AFTER_DRAIN) { E(acc, cur, wr, wc, fr, fq); S.done(cur); }
        if (!has_next) break;
#pragma unroll
        for (int a = 0; a < 2; ++a)
#pragma unroll
            for (int b = 0; b < 2; ++b)
#pragma unroll
                for (int m = 0; m < 4; ++m)
#pragma unroll
                    for (int n = 0; n < 2; ++n) acc[a][b][m][n] = (f32x4){0.f, 0.f, 0.f, 0.f};
        cur = nxt; cA = nA; cB = nB; ++ui;
        if constexpr (ALIGN_EPI) { if (wr == 1) PG8_BAR; }
    }
    PG8_WAIT_V(0);
    if constexpr (!ALIGN_EPI) { if (wr == 0) PG8_BAR; }
    PG8_BAR;
    if constexpr (Epi::AFTER_DRAIN) { E.fused(acc, cur, wr, wc, fr, fq, lds, wid, lane); S.done(cur); }
#undef PG8_SA
#undef PG8_SB
#undef PG8_STAGE
#undef PG8_LDA
#undef PG8_LDB
#undef PG8_MMA
#undef PG8_WAIT_V
#undef PG8_WAIT_L
#undef PG8_BAR
#undef PG8_SCHED
}
}
namespace pg8 {
typedef float f32x2 __attribute__((ext_vector_type(2)));
struct SegTab { bf16_t* base[8]; int ldc[8]; int t0[8]; int gw[8]; int nseg; int pad_; };
struct EpiBf16R {
    static constexpr bool PERM = true, AFTER_DRAIN = false;
    SegTab T;
    __device__ __forceinline__ void operator()(const f32x4 (&acc)[2][2][4][2], const Unit& u, int wr, int wc, int fr, int fq) const {
        bf16_t* base = T.base[0]; int ldc = T.ldc[0], gw = T.gw[0], t0 = T.t0[0];
#pragma unroll
        for (int s = 1; s < 8; ++s) if (s < T.nseg && u.pn >= T.t0[s]) { base = T.base[s]; ldc = T.ldc[s]; gw = T.gw[s]; t0 = T.t0[s]; }
        const int colt = (u.pn - t0) * BM, row0 = u.pm * BM + wr * 64 + fr;
#pragma unroll
        for (int ai = 0; ai < 2; ++ai)
#pragma unroll
            for (int m = 0; m < 4; ++m) { const int row = row0 + ai * HALF + m * 16;
#pragma unroll
                for (int bj = 0; bj < 2; ++bj) { const int col = colt + bj * HALF + wc * 32 + 8 * fq;
                    const f32x4 v0 = acc[ai][bj][m][0], v1 = acc[ai][bj][m][1];
                    u32x4 w; w.x = cvt_pk_bf16(v0[0], v0[1]); w.y = cvt_pk_bf16(v0[2], v0[3]); w.z = cvt_pk_bf16(v1[0], v1[1]); w.w = cvt_pk_bf16(v1[2], v1[3]);
                    if (gw == -2) {
                        if ((row >> 5) < ldc) { bf16_t* d0 = base + ((size_t)(((col >> 5) * ldc + (row >> 5)) * 2 + ((col >> 4) & 1)) * 64 + (row & 31)) * 8 + 4 * ((col >> 3) & 1);
                            typedef unsigned u32x2_ __attribute__((ext_vector_type(2)));
                            *(u32x2_*)d0 = (u32x2_){w.x, w.y}; *(u32x2_*)(d0 + 32 * 8) = (u32x2_){w.z, w.w}; }
                        continue; }
                    bf16_t* dst;
                    if (gw == 0) dst = base + (size_t)row * ldc + col;
                    else if (gw == -1) { if ((col >> 4) >= ldc) continue; dst = base + ((size_t)((row >> 5) * ldc + (col >> 4)) * 64 + ((col >> 3) & 1) * 32 + (row & 31)) * 8; }
                    else { const int g = col / gw, d = col - g * gw; dst = base + ((size_t)((row >> 12) * 4 + g) * 4096 + (row & 4095)) * gw + d; }
                    *(u32x4*)dst = w; } }
    }
};
struct EpiGelu {
    static constexpr bool PERM = true, AFTER_DRAIN = false;
    bf16_t* O; int ldc; const float* bias;
    static __device__ __forceinline__ float gelu(float x) { const float u2 = 1.5957691216f * (x + 0.044715f * x * x * x); const float e = __builtin_amdgcn_exp2f(-u2 * 1.4426950409f); return x * __builtin_amdgcn_rcpf(1.0f + e); }
    __device__ __forceinline__ void operator()(const f32x4 (&acc)[2][2][4][2], const Unit& u, int wr, int wc, int fr, int fq) const {
        const int row0 = u.pm * BM + wr * 64 + fr, col0 = u.pn * BM + wc * 32 + 8 * fq;
#pragma unroll
        for (int bj = 0; bj < 2; ++bj) { const f32x4 b0 = *(const f32x4*)(bias + col0 + bj * HALF), b1 = *(const f32x4*)(bias + col0 + bj * HALF + 4);
#pragma unroll
            for (int ai = 0; ai < 2; ++ai)
#pragma unroll
                for (int m = 0; m < 4; ++m) { const f32x4 v0 = acc[ai][bj][m][0] + b0, v1 = acc[ai][bj][m][1] + b1;
                    u32x4 w; w.x = cvt_pk_bf16(gelu(v0[0]), gelu(v0[1])); w.y = cvt_pk_bf16(gelu(v0[2]), gelu(v0[3])); w.z = cvt_pk_bf16(gelu(v1[0]), gelu(v1[1])); w.w = cvt_pk_bf16(gelu(v1[2]), gelu(v1[3]));
                    *(u32x4*)(O + (size_t)(row0 + ai * HALF + m * 16) * ldc + col0 + bj * HALF) = w; } }
    }
};
struct EpiF32 {
    static constexpr bool PERM = false, AFTER_DRAIN = false;
    float* C; int ldc;
    __device__ __forceinline__ void operator()(const f32x4 (&acc)[2][2][4][2], const Unit& u, int wr, int wc, int fr, int fq) const {
        const int row0 = u.pm * BM + wr * 64 + fr, col0 = u.pn * BM + wc * 32 + 4 * fq;
#pragma unroll
        for (int ai = 0; ai < 2; ++ai)
#pragma unroll
            for (int m = 0; m < 4; ++m) { float* rowp = C + (size_t)(row0 + ai * HALF + m * 16) * ldc + col0;
#pragma unroll
                for (int bj = 0; bj < 2; ++bj)
#pragma unroll
                    for (int n = 0; n < 2; ++n) *(f32x4*)(rowp + bj * HALF + n * 16) = acc[ai][bj][m][n]; }
    }
};
struct EpiRes {
    static constexpr bool PERM = false, AFTER_DRAIN = false;
    const float* res; float* out; int ldc; int row_off;
    __device__ __forceinline__ void operator()(const f32x4 (&acc)[2][2][4][2], const Unit& u, int wr, int wc, int fr, int fq) const {
        const int row0 = row_off + u.pm * BM + wr * 64 + fr, col0 = u.pn * BM + wc * 32 + 4 * fq;
#pragma unroll
        for (int ai = 0; ai < 2; ++ai)
#pragma unroll
            for (int m = 0; m < 4; ++m) { const size_t off = (size_t)(row0 + ai * HALF + m * 16) * ldc + col0;
                f32x4 r[2][2];
#pragma unroll
                for (int bj = 0; bj < 2; ++bj)
#pragma unroll
                    for (int n = 0; n < 2; ++n) r[bj][n] = *(const f32x4*)(res + off + bj * HALF + n * 16);
#pragma unroll
                for (int bj = 0; bj < 2; ++bj)
#pragma unroll
                    for (int n = 0; n < 2; ++n) *(f32x4*)(out + off + bj * HALF + n * 16) = r[bj][n] + acc[ai][bj][m][n];
                asm volatile("" ::: "memory"); }
    }
};
struct EpiDry {
    static constexpr bool PERM = false, AFTER_DRAIN = false;
    float* D;
    __device__ __forceinline__ void operator()(const f32x4 (&acc)[2][2][4][2], const Unit& u, int wr, int wc, int fr, int fq) const {
        float* p = D + ((size_t)blockIdx.x * 512 + threadIdx.x) * 64;
#pragma unroll
        for (int ai = 0; ai < 2; ++ai)
#pragma unroll
            for (int m = 0; m < 4; ++m)
#pragma unroll
                for (int bj = 0; bj < 2; ++bj) *(f32x4*)(p + ((ai * 4 + m) * 2 + bj) * 4) = acc[ai][bj][m][0] + acc[ai][bj][m][1];
    }
};
struct EpiConvGlu {
    static constexpr bool PERM = true, AFTER_DRAIN = false;
    bf16_t* G; float* UB; const float* cw; const float* cb; PG8_LAS float* xb; int dff;
    static __device__ __forceinline__ float shr(float old, float src, int n) { const int o = __builtin_bit_cast(int, old), s = __builtin_bit_cast(int, src);
        return __builtin_bit_cast(float, n == 1 ? __builtin_amdgcn_update_dpp(o, s, 0x111, 0xf, 0xf, false) : __builtin_amdgcn_update_dpp(o, s, 0x112, 0xf, 0xf, false)); }
    static __device__ __forceinline__ float ror(float src, int n) { const int s = __builtin_bit_cast(int, src);
        return __builtin_bit_cast(float, n == 1 ? __builtin_amdgcn_update_dpp(0, s, 0x121, 0xf, 0xf, false) : __builtin_amdgcn_update_dpp(0, s, 0x122, 0xf, 0xf, false)); }
    __device__ __forceinline__ void operator()(const f32x4 (&acc)[2][2][4][2], const Unit& u, int wr, int wc, int fr, int fq) const {
        typedef unsigned u32x2_ __attribute__((ext_vector_type(2)));
        if (fr >= 14) {
#pragma unroll
            for (int ai = 0; ai < 2; ++ai)
#pragma unroll
                for (int bj = 0; bj < 2; ++bj)
#pragma unroll
                    for (int n = 0; n < 2; ++n) *(PG8_LAS f32x4*)(xb + (((((ai * 2 + wr) * 4 + wc) * 2 + (fr - 14)) * 4 + fq) * 16) + (bj * 2 + n) * 4) = acc[ai][bj][3][n];
        }
        { const int ncol = 4 * dff / 2;
          const bool top = (wr == 0 && fr < 2), bot = (wr == 1 && fr >= 14);
          if (top || bot) { float* ub = UB + ((size_t)(u.pm * 4 + (top ? fr : 2 + fr - 14)) * ncol) + u.pn * BM + wc * 32 + 8 * fq;
#pragma unroll
            for (int bj = 0; bj < 2; ++bj)
#pragma unroll
                for (int n = 0; n < 2; ++n) *(f32x4*)(ub + bj * HALF + 4 * n) = top ? acc[0][bj][0][n] : acc[1][bj][3][n]; } }
        asm volatile("s_waitcnt lgkmcnt(0)" ::: "memory"); __builtin_amdgcn_s_barrier(); asm volatile("" ::: "memory");
        u32x2_ res[2][4][2];
        const int ch0 = u.pn * HALF + wc * 32 + 8 * fq;
#pragma unroll
        for (int n = 0; n < 2; ++n) {
            const float* wp = cw + ch0 + 4 * n; const float* bp = cb + ch0 + 4 * n;
            const f32x4 w0g = *(const f32x4*)(wp), w1g = *(const f32x4*)(wp + 2 * dff), w2g = *(const f32x4*)(wp + 4 * dff), bg = *(const f32x4*)(bp);
            const f32x4 w0v = *(const f32x4*)(wp + dff), w1v = *(const f32x4*)(wp + 3 * dff), w2v = *(const f32x4*)(wp + 5 * dff), bv = *(const f32x4*)(bp + dff);
#pragma unroll
            for (int ai = 0; ai < 2; ++ai)
#pragma unroll
                for (int m = 0; m < 4; ++m) {
                    const f32x4 cg = acc[ai][0][m][n], cv = acc[ai][1][m][n];
                    f32x4 b1g, b2g, b1v, b2v;
                    if (m > 0) {
#pragma unroll
                        for (int e = 0; e < 4; ++e) { b1g[e] = ror(acc[ai][0][m - 1][n][e], 1); b2g[e] = ror(acc[ai][0][m - 1][n][e], 2); b1v[e] = ror(acc[ai][1][m - 1][n][e], 1); b2v[e] = ror(acc[ai][1][m - 1][n][e], 2); }
                    } else {
                        const int sai = wr ? ai : ai - 1, swr = wr ? 0 : 1;
                        f32x4 x14g = {0.f, 0.f, 0.f, 0.f}, x15g = x14g, x14v = x14g, x15v = x14g;
                        if (sai >= 0) { const PG8_LAS float* xp = xb + (((((sai * 2 + swr) * 4 + wc) * 2) * 4 + fq) * 16);
                            x14g = *(const PG8_LAS f32x4*)(xp + n * 4); x14v = *(const PG8_LAS f32x4*)(xp + (2 + n) * 4); x15g = *(const PG8_LAS f32x4*)(xp + 64 + n * 4); x15v = *(const PG8_LAS f32x4*)(xp + 64 + (2 + n) * 4); }
                        b1g = x15g; b1v = x15v; b2g = fr == 0 ? x14g : x15g; b2v = fr == 0 ? x14v : x15v;
                    }
                    float o[4];
#pragma unroll
                    for (int e = 0; e < 4; ++e) {
                        const float p1g = shr(b1g[e], cg[e], 1), p2g = shr(b2g[e], cg[e], 2), p1v = shr(b1v[e], cv[e], 1), p2v = shr(b2v[e], cv[e], 2);
                        const float yg = bg[e] + w0g[e] * p2g + w1g[e] * p1g + w2g[e] * cg[e], yv = bv[e] + w0v[e] * p2v + w1v[e] * p1v + w2v[e] * cv[e];
                        o[e] = yg * __builtin_amdgcn_rcpf(1.0f + __builtin_amdgcn_exp2f(-yg * 1.4426950409f)) * yv;
                    }
                    res[ai][m][n] = (u32x2_){cvt_pk_bf16(o[0], o[1]), cvt_pk_bf16(o[2], o[3])};
                }
        }
        const int row0 = u.pm * BM + wr * 64 + fr;
#pragma unroll
        for (int ai = 0; ai < 2; ++ai)
#pragma unroll
            for (int m = 0; m < 4; ++m) *(u32x4*)(G + (size_t)(row0 + ai * HALF + m * 16) * dff + ch0) = (u32x4){res[ai][m][0].x, res[ai][m][0].y, res[ai][m][1].x, res[ai][m][1].y};
    }
};
}
constexpr int BATCH = 8, SEQ = 4096, DM = 2048, MTOT = BATCH * SEQ, MC = MTOT / 2  , BPH = BATCH / 2;
constexpr int DFF = 5632;
constexpr float NORM_EPS = 1e-6f, LOG2E = 1.4426950408889634f;
constexpr int NWAVES = 8;
constexpr size_t MiB = 1u << 20;
constexpr size_t WS_CTL = 0, CTL_ZERO_BYTES = 1 * MiB;
constexpr size_t WS_TAB = 1 * MiB;
constexpr size_t TAB_COS48 = WS_TAB, TAB_SIN48 = WS_TAB + 3 * MiB, TAB_COS32 = WS_TAB + 6 * MiB, TAB_SIN32 = WS_TAB + 8 * MiB;
constexpr size_t WS_WMIX = 12 * MiB;
constexpr size_t WS_WFFN = 100 * MiB;
constexpr size_t WS_MISC = 168 * MiB;
constexpr size_t WS_XN = 170 * MiB;
constexpr size_t WS_AR = 234 * MiB;
constexpr size_t WS_END = 1010 * MiB;
constexpr size_t DUMMY_OFF = 700 * MiB;
constexpr int CW_TMO = 0;
constexpr int CW_BAR = 4096;
constexpr int RING_BYTES = 131072;
constexpr int LDSCTL_OFF = 135168;
constexpr int LDS_BYTES = 163840;

#define GAS __attribute__((address_space(1)))
#define LAS __attribute__((address_space(3)))
typedef unsigned short bf16;
typedef unsigned u32x4 __attribute__((ext_vector_type(4)));
typedef unsigned u32x2 __attribute__((ext_vector_type(2)));
typedef float f32x4 __attribute__((ext_vector_type(4)));
typedef float f32x16 __attribute__((ext_vector_type(16)));
typedef short bf16x8 __attribute__((ext_vector_type(8)));
typedef short s16x4 __attribute__((ext_vector_type(4)));
typedef short v4i16_t __attribute__((ext_vector_type(4)));
typedef __bf16 bf16x2_t __attribute__((ext_vector_type(2)));
typedef float f32x2_t __attribute__((ext_vector_type(2)));
#define LDS_WAIT() asm volatile("s_waitcnt lgkmcnt(0)" ::: "memory")
#define VM_WAIT() asm volatile("s_waitcnt vmcnt(0)" ::: "memory")
#define MFMA32(a, b, c) __builtin_amdgcn_mfma_f32_32x32x16_bf16((a), (b), (c), 0, 0, 0)
DI unsigned pk2(float lo, float hi) { f32x2_t v = {lo, hi}; bf16x2_t b = __builtin_convertvector(v, bf16x2_t); return __builtin_bit_cast(unsigned, b); }
DI float bf2f(unsigned short b) { return __builtin_bit_cast(float, (unsigned)b << 16); }
DI float bflo(unsigned w) { return __builtin_bit_cast(float, w << 16); }
DI float bfhi(unsigned w) { return __builtin_bit_cast(float, w & 0xffff0000u); }
DI unsigned short f2bf(float f) { return (unsigned short)(pk2(f, 0.f) & 0xffffu); }
DI float wave_sum(float v) {
#pragma unroll
    for (int o = 1; o < 64; o <<= 1) v += __shfl_xor(v, o);
    return v;
}
DI int crow(int i, int h) { return (i & 3) + 8 * (i >> 2) + 4 * h; }
#define XB_TMO      128
#define XB_XCNT(j)  (256  + 64 * (j))
#define XB_XSUB(j)  (1280 + 64 * (j))
#define XB_XGEN(j)  (2304 + 64 * (j))
#define XB_TOP      3328
#define XB_TOPGEN   3392
#define XCD_BAR_WORDS 3456
#define XB_SPIN_CAP (1u << 18)

__device__ __forceinline__ unsigned xb_ld(unsigned* p)              { return __hip_atomic_load(p, __ATOMIC_RELAXED, __HIP_MEMORY_SCOPE_AGENT); }
__device__ __forceinline__ unsigned xb_add(unsigned* p, unsigned v) { return __hip_atomic_fetch_add(p, v, __ATOMIC_RELAXED, __HIP_MEMORY_SCOPE_AGENT); }
__device__ __forceinline__ unsigned xb_xcc_id() { return (unsigned)__builtin_amdgcn_s_getreg((3 << 11) | 20) & 0xFu; }
#define XB_SPIN(cond, bar) do { unsigned _sp = 0; while (cond) { __builtin_amdgcn_s_sleep(1); \
    if ((++_sp & 255u) == 0u) { if (xb_ld(&(bar)[XB_TMO])) break; if (_sp > XB_SPIN_CAP) { atomicAdd(&(bar)[XB_TMO], 1u); break; } } } } while (0)

struct XcdBarrier {
    unsigned* bar; unsigned x;
    volatile LAS unsigned* st;
};

__device__ __forceinline__ XcdBarrier xcd_barrier_post(unsigned* bar, volatile LAS unsigned* st) {
    XcdBarrier b; b.bar = bar; b.x = xb_xcc_id(); b.st = st;
    if (threadIdx.x == 0) (void)xb_add(&bar[XB_XCNT(b.x)], 1u);
    return b;
}
__device__ __forceinline__ void xcd_barrier_complete(unsigned* bar, unsigned x, unsigned& nloc, unsigned& nx) {
    const unsigned G = gridDim.x * gridDim.y * gridDim.z;
    unsigned sum, cnt, mine, sp = 0u;
    for (;;) {
        sum = 0u; cnt = 0u; mine = 0u;
#pragma unroll
        for (unsigned j = 0; j < 16; ++j) { const unsigned c = xb_ld(&bar[XB_XCNT(j)]); sum += c; cnt += (c > 0u) ? 1u : 0u; mine = (j == x) ? c : mine; }
        if (sum == G) break;
        __builtin_amdgcn_s_sleep(1);
        if ((++sp & 255u) == 0u) { if (xb_ld(&bar[XB_TMO])) break; if (sp > XB_SPIN_CAP) { atomicAdd(&bar[XB_TMO], 1u); break; } }
    }
    nloc = mine > 0u ? mine : 1u; nx = cnt > 0u ? cnt : 1u;
}

__device__ __forceinline__ void xcd_barrier(const XcdBarrier& b) {
    asm volatile("s_waitcnt vmcnt(0)" ::: "memory");
    __syncthreads();
    if (threadIdx.x == 0) {
        unsigned* bar = b.bar;
        __builtin_amdgcn_s_waitcnt(0);
        unsigned nloc = b.st[0], nx = b.st[1];
        if (nloc == 0u) { xcd_barrier_complete(bar, b.x, nloc, nx); b.st[0] = nloc; b.st[1] = nx; }
        const unsigned old = xb_add(&bar[XB_XSUB(b.x)], 1u);
        const unsigned gen = old / nloc;
        if (old + 1u == (gen + 1u) * nloc) {
            __builtin_amdgcn_fence(__ATOMIC_RELEASE, "agent");
            asm volatile("s_waitcnt vmcnt(0)" ::: "memory");
            const unsigned og = xb_add(&bar[XB_TOP], 1u);
            const unsigned tg = og / nx;
            if (og + 1u == (tg + 1u) * nx) xb_add(&bar[XB_TOPGEN], 1u);
            else XB_SPIN(xb_ld(&bar[XB_TOPGEN]) == tg, bar);
            __builtin_amdgcn_fence(__ATOMIC_ACQUIRE, "agent");
            xb_add(&bar[XB_XGEN(b.x)], 1u);
            asm volatile("s_waitcnt vmcnt(0)" ::: "memory");
        } else {
            XB_SPIN(xb_ld(&bar[XB_XGEN(b.x)]) == gen, bar);
            __builtin_amdgcn_fence(__ATOMIC_ACQUIRE, "agent");
            asm volatile("s_waitcnt vmcnt(0)" ::: "memory");
        }
    }
    __syncthreads();
}
struct Frame {
    LAS unsigned char* lds; unsigned* ctl; unsigned char* ws;
    int tid, lane, wave, G, gw, NGW;
};
DI void ph_tables(const Frame& F, const int* pos) {
    float* c48 = (float*)(F.ws + TAB_COS48); float* s48 = (float*)(F.ws + TAB_SIN48); float* c32 = (float*)(F.ws + TAB_COS32); float* s32 = (float*)(F.ws + TAB_SIN32);
    const int gt = blockIdx.x * (NWAVES * 64) + F.tid, NT = F.G * NWAVES * 64;
    for (int i = gt; i < MTOT * 40; i += NT) {
        const int m = i / 40, j = i - m * 40; const float p = (float)pos[m];
        const bool a = j < 24; const int jj = a ? j : j - 24;
        const float inv = (float)exp(-(2.0 * jj / (a ? 48.0 : 32.0)) * 13.122363377404328);
        const float ang = p * inv; float sn, cs; sincosf(ang, &sn, &cs);
        if (a) { c48[m * 24 + jj] = cs; s48[m * 24 + jj] = sn; } else { c32[m * 16 + jj] = cs; s32[m * 16 + jj] = sn; }
    }
}
DI void cvt_item(const float* W, int ldw, int col0, int ncols, bf16* WT, int ldt, int row_off, float scale, LAS float* scr, int item, int nblk, int lane) {
    const int kb = item / nblk, nb = item - kb * nblk, k0 = 64 * kb, n0 = 32 * nb;
    const int nn = n0 + (lane & 31); const bool ok = nn < ncols;
#pragma unroll 8
    for (int i = 0; i < 32; ++i) { const int kk = 2 * i + (lane >> 5); scr[kk * 33 + (lane & 31)] = ok ? W[(size_t)(k0 + kk) * ldw + col0 + nn] * scale : 0.f; }
    LDS_WAIT();
    const int c = lane & 7;
#pragma unroll
    for (int j = 0; j < 4; ++j) { const int n = (lane >> 3) + 8 * j; const LAS float* s = scr + (8 * c) * 33 + n;
        u32x4 o; o.x = pk2(s[0 * 33], s[1 * 33]); o.y = pk2(s[2 * 33], s[3 * 33]); o.z = pk2(s[4 * 33], s[5 * 33]); o.w = pk2(s[6 * 33], s[7 * 33]);
        if (n0 + n < ncols) *(u32x4*)(WT + (size_t)(row_off + n0 + n) * ldt + k0 + 8 * c) = o; }
    LDS_WAIT();
}
DI void cvt_job(const Frame& F, const float* W, int ldw, int K, int col0, int ncols, bf16* WT, int ldt, int row_off, float scale) {
    LAS float* scr = (LAS float*)(F.lds + F.wave * 16384);
    const int nblk = (ncols + 31) / 32, nitems = (K / 64) * nblk;
    for (int it = F.gw; it < nitems; it += F.NGW) cvt_item(W, ldw, col0, ncols, WT, ldt, row_off, scale, scr, it, nblk, F.lane);
}
DI void zero_bf16(const Frame& F, bf16* p, size_t nelem) {
    const size_t gt = (size_t)blockIdx.x * (NWAVES * 64) + F.tid, NT = (size_t)F.G * NWAVES * 64;
    for (size_t i = gt; i < nelem / 8; i += NT) ((u32x4*)p)[i] = (u32x4){0u, 0u, 0u, 0u};
}
DI void ph_cvt_ffn(const Frame& F, const float* up, const float* down) {
    bf16* WUP = (bf16*)(F.ws + WS_WFFN); bf16* WDN = WUP + (size_t)2 * DFF * DM;
    { LAS float* scr = (LAS float*)(F.lds + F.wave * 16384);
      for (int it = F.gw; it < 88 * 128; it += F.NGW) { const int seg = it >> 7, pn = seg >> 1, isv = seg & 1;
          cvt_item(up, 2 * DFF, isv * DFF + pn * 128, 128, WUP, DM, pn * 256 + isv * 128, 1.f, scr, it & 127, 4, F.lane); } }
    cvt_job(F, down, DM, DFF, 0, DM, WDN, DFF, 0, 1.f);
}
DI void ph_conv_fix(const Frame& F, const float* UB, bf16* Gb, const float* cw, const float* cb) {
    const int gt = blockIdx.x * (NWAVES * 64) + F.tid, NT = F.G * NWAVES * 64;
    for (int it = gt; it < (MC / 256) * (DFF / 4); it += NT) {
        const int pm = it / (DFF / 4), c4 = it - pm * (DFF / 4), ch = c4 * 4, col = (ch >> 7) * 256 + (ch & 127);
        const float* ub = UB + (size_t)pm * 4 * (2 * DFF) + col; const bool has = (pm & 15) != 0;
        const f32x4 z = {0.f, 0.f, 0.f, 0.f};
        const f32x4 g0 = *(const f32x4*)(ub), g1 = *(const f32x4*)(ub + 2 * DFF), v0 = *(const f32x4*)(ub + 128), v1 = *(const f32x4*)(ub + 2 * DFF + 128);
        const f32x4 gm2 = has ? *(const f32x4*)(ub - 2 * (2 * DFF)) : z, gm1 = has ? *(const f32x4*)(ub - (2 * DFF)) : z, vm2 = has ? *(const f32x4*)(ub - 2 * (2 * DFF) + 128) : z, vm1 = has ? *(const f32x4*)(ub - (2 * DFF) + 128) : z;
        const f32x4 w0g = *(const f32x4*)(cw + ch), w1g = *(const f32x4*)(cw + 2 * DFF + ch), w2g = *(const f32x4*)(cw + 4 * DFF + ch), bg = *(const f32x4*)(cb + ch);
        const f32x4 w0v = *(const f32x4*)(cw + DFF + ch), w1v = *(const f32x4*)(cw + 3 * DFF + ch), w2v = *(const f32x4*)(cw + 5 * DFF + ch), bv = *(const f32x4*)(cb + DFF + ch);
        float o0[4], o1[4];
#pragma unroll
        for (int e = 0; e < 4; ++e) {
            const float yg0 = bg[e] + w0g[e] * gm2[e] + w1g[e] * gm1[e] + w2g[e] * g0[e], yv0 = bv[e] + w0v[e] * vm2[e] + w1v[e] * vm1[e] + w2v[e] * v0[e];
            const float yg1 = bg[e] + w0g[e] * gm1[e] + w1g[e] * g0[e] + w2g[e] * g1[e], yv1 = bv[e] + w0v[e] * vm1[e] + w1v[e] * v0[e] + w2v[e] * v1[e];
            o0[e] = yg0 * __builtin_amdgcn_rcpf(1.0f + __builtin_amdgcn_exp2f(-yg0 * LOG2E)) * yv0; o1[e] = yg1 * __builtin_amdgcn_rcpf(1.0f + __builtin_amdgcn_exp2f(-yg1 * LOG2E)) * yv1;
        }
        u32x2 a, b; a.x = pk2(o0[0], o0[1]); a.y = pk2(o0[2], o0[3]); b.x = pk2(o1[0], o1[1]); b.y = pk2(o1[2], o1[3]);
        *(u32x2*)(Gb + (size_t)(pm * 256) * DFF + ch) = a; *(u32x2*)(Gb + (size_t)(pm * 256 + 1) * DFF + ch) = b;
    }
}
DI void ph_rmsnorm(const Frame& F, const float* src, int row_off, const float* gain, bf16* XN) {
    f32x4 g[8];
#pragma unroll
    for (int j = 0; j < 8; ++j) g[j] = *(const f32x4*)(gain + 4 * (F.lane + 64 * j));
    for (int ml = F.gw; ml < MC; ml += F.NGW) {
        const f32x4* xr = (const f32x4*)(src + (size_t)(row_off + ml) * DM) + F.lane;
        f32x4 v[8]; float ss = 0.f;
#pragma unroll
        for (int j = 0; j < 8; ++j) { v[j] = xr[64 * j]; ss += (v[j].x * v[j].x + v[j].y * v[j].y) + (v[j].z * v[j].z + v[j].w * v[j].w); }
        const float rstd = 1.0f / sqrtf(wave_sum(ss) * (1.f / DM) + NORM_EPS);
        u32x2* o = (u32x2*)(XN + (size_t)ml * DM) + F.lane;
#pragma unroll
        for (int j = 0; j < 8; ++j) { const f32x4 y = v[j] * rstd * g[j]; u32x2 w; w.x = pk2(y.x, y.y); w.y = pk2(y.z, y.w); o[64 * j] = w; }
    }
}
DI void ph_final_norm(const Frame& F, float* h, const float* gain) {
    f32x4 g[8];
#pragma unroll
    for (int j = 0; j < 8; ++j) g[j] = *(const f32x4*)(gain + 4 * (F.lane + 64 * j));
    for (int m = F.gw; m < MTOT; m += F.NGW) {
        f32x4* xr = (f32x4*)(h + (size_t)m * DM) + F.lane;
        f32x4 v[8]; float ss = 0.f;
#pragma unroll
        for (int j = 0; j < 8; ++j) { v[j] = xr[64 * j]; ss += (v[j].x * v[j].x + v[j].y * v[j].y) + (v[j].z * v[j].z + v[j].w * v[j].w); }
        const float rstd = 1.0f / sqrtf(wave_sum(ss) * (1.f / DM) + NORM_EPS);
#pragma unroll
        for (int j = 0; j < 8; ++j) xr[64 * j] = v[j] * rstd * g[j];
    }
}
DI void ph_conv_glu(const Frame& F, const bf16* U, bf16* Gb, const float* cw, const float* cb) {
    constexpr int RC = 32, NCG = DFF / 8, NRC = MC / RC;
    const int gt = blockIdx.x * (NWAVES * 64) + F.tid, NT = F.G * NWAVES * 64;
    for (int it = gt; it < NCG * NRC; it += NT) {
        const int cg = it % NCG, rc = it / NCG, c0 = cg * 8, r0 = rc * RC;
        float w0g[8], w1g[8], w2g[8], bg[8], w0v[8], w1v[8], w2v[8], bv[8];
#pragma unroll
        for (int e = 0; e < 8; ++e) { w0g[e] = cw[c0 + e]; w1g[e] = cw[2 * DFF + c0 + e]; w2g[e] = cw[4 * DFF + c0 + e]; bg[e] = cb[c0 + e];
            w0v[e] = cw[DFF + c0 + e]; w1v[e] = cw[3 * DFF + c0 + e]; w2v[e] = cw[5 * DFF + c0 + e]; bv[e] = cb[DFF + c0 + e]; }
        float pg2[8], pg1[8], pv2[8], pv1[8];
        const bool has = (r0 & (SEQ - 1)) != 0;
        {
            u32x4 a = {0u, 0u, 0u, 0u}, b = a, c = a, d = a;
            if (has) { a = *(const u32x4*)(U + (size_t)(r0 - 2) * (2 * DFF) + c0); b = *(const u32x4*)(U + (size_t)(r0 - 1) * (2 * DFF) + c0);
                       c = *(const u32x4*)(U + (size_t)(r0 - 2) * (2 * DFF) + DFF + c0); d = *(const u32x4*)(U + (size_t)(r0 - 1) * (2 * DFF) + DFF + c0); }
#pragma unroll
            for (int e = 0; e < 4; ++e) { pg2[2 * e] = bflo(a[e]); pg2[2 * e + 1] = bfhi(a[e]); pg1[2 * e] = bflo(b[e]); pg1[2 * e + 1] = bfhi(b[e]);
                pv2[2 * e] = bflo(c[e]); pv2[2 * e + 1] = bfhi(c[e]); pv1[2 * e] = bflo(d[e]); pv1[2 * e + 1] = bfhi(d[e]); }
        }
        for (int r = 0; r < RC; ++r) {
            const u32x4 ug = *(const u32x4*)(U + (size_t)(r0 + r) * (2 * DFF) + c0), uv = *(const u32x4*)(U + (size_t)(r0 + r) * (2 * DFF) + DFF + c0);
            float cg_[8], cv_[8], o[8];
#pragma unroll
            for (int e = 0; e < 4; ++e) { cg_[2 * e] = bflo(ug[e]); cg_[2 * e + 1] = bfhi(ug[e]); cv_[2 * e] = bflo(uv[e]); cv_[2 * e + 1] = bfhi(uv[e]); }
#pragma unroll
            for (int e = 0; e < 8; ++e) {
                const float yg = bg[e] + w0g[e] * pg2[e] + w1g[e] * pg1[e] + w2g[e] * cg_[e];
                const float yv = bv[e] + w0v[e] * pv2[e] + w1v[e] * pv1[e] + w2v[e] * cv_[e];
                const float sg = yg * __builtin_amdgcn_rcpf(1.0f + __builtin_amdgcn_exp2f(-yg * LOG2E));
                o[e] = sg * yv; pg2[e] = pg1[e]; pg1[e] = cg_[e]; pv2[e] = pv1[e]; pv1[e] = cv_[e];
            }
            u32x4 w; w.x = pk2(o[0], o[1]); w.y = pk2(o[2], o[3]); w.z = pk2(o[4], o[5]); w.w = pk2(o[6], o[7]);
            *(u32x4*)(Gb + (size_t)(r0 + r) * DFF + c0) = w;
        }
    }
}
constexpr size_t DA_DIN = 0, DA_CQN = 64 * MiB, DA_LATC = 80 * MiB, DA_KPE = 88 * MiB, DA_KIDX = 90 * MiB, DA_WIDX = 94 * MiB, DA_QL = 96 * MiB, DA_QPE = 352 * MiB, DA_QIDX = 400 * MiB,
                 DA_SEL = 464 * MiB, DA_CNT = 472 * MiB, DA_SC = 474 * MiB;
constexpr size_t DW_W1 = 0, DW_W2 = (size_t)1024 * 2048, DW_WO = DW_W2 + (size_t)11776 * 512;
constexpr float DSA_QSCALE = 0.07216878364870322f * LOG2E;
constexpr float DSA_WIDX_SCALE = 0.25f * 0.08838834764831845f;

DI void ph_dsa_cvt(const Frame& F, const float* w_in, const float* w_qup, const float* w_uk, const float* w_uv, const float* w_out) {
    bf16* WB = (bf16*)(F.ws + WS_WMIX);
    cvt_job(F, w_in, 960, DM, 0, 960, WB + DW_W1, DM, 0, 1.f);
    zero_bf16(F, WB + DW_W1 + (size_t)960 * DM, (size_t)64 * DM);
    { LAS float* scr = (LAS float*)(F.lds + F.wave * 16384);
      for (int it = F.gw; it < 32 * 16; it += F.NGW) { const int h = it >> 4; cvt_item(w_qup, 8192, h * 192, 48, WB + DW_W2, 512, 8192 + h * 48, DSA_QSCALE, scr, it & 15, 2, F.lane); } }
    cvt_job(F, w_qup, 8192, 512, 6144, 2048, WB + DW_W2, 512, 9728, 1.f);
    __syncthreads();
    {
        LAS float* As = (LAS float*)F.lds; LAS float* Bs = As + 64 * 145;
        for (int u = blockIdx.x; u < 32 * 4 * 8; u += F.G) {
            const int h = u >> 5, r0 = ((u >> 3) & 3) * 64, k0 = (u & 7) * 64;
            for (int i = F.tid; i < 64 * 144; i += NWAVES * 64) { const int row = i / 144, col = i - row * 144;
                As[row * 145 + col] = w_uk[(size_t)(h * 256 + r0) * 144 + i]; Bs[row * 145 + col] = w_qup[(size_t)(k0 + row) * 8192 + h * 192 + 48 + col]; }
            __syncthreads();
            const int r = F.tid & 63, kg = F.tid >> 6; float acc[8];
#pragma unroll
            for (int j = 0; j < 8; ++j) acc[j] = 0.f;
            for (int n = 0; n < 144; ++n) { const float a = As[r * 145 + n];
#pragma unroll
                for (int j = 0; j < 8; ++j) acc[j] += a * Bs[(kg * 8 + j) * 145 + n]; }
            u32x4 o; o.x = pk2(acc[0] * DSA_QSCALE, acc[1] * DSA_QSCALE); o.y = pk2(acc[2] * DSA_QSCALE, acc[3] * DSA_QSCALE); o.z = pk2(acc[4] * DSA_QSCALE, acc[5] * DSA_QSCALE); o.w = pk2(acc[6] * DSA_QSCALE, acc[7] * DSA_QSCALE);
            *(u32x4*)(WB + DW_W2 + (size_t)(h * 256 + r0 + r) * 512 + k0 + kg * 8) = o;
            __syncthreads();
        }
        LAS float* Av = (LAS float*)F.lds; LAS float* Bv = Av + 64 * 129;
        for (int u = blockIdx.x; u < 32 * 4 * 32; u += F.G) {
            const int h = u >> 7, r0 = ((u >> 5) & 3) * 64, c0 = (u & 31) * 64;
            for (int i = F.tid; i < 64 * 128; i += NWAVES * 64) { const int row = i >> 7, col = i & 127; Av[row * 129 + col] = w_uv[(size_t)(h * 256 + r0) * 128 + i]; }
            for (int i = F.tid; i < 128 * 64; i += NWAVES * 64) { const int v = i >> 6, c = i & 63; Bv[v * 64 + c] = w_out[(size_t)(h * 128 + v) * DM + c0 + c]; }
            __syncthreads();
            const int c = F.tid & 63, rg = F.tid >> 6; float acc[8];
#pragma unroll
            for (int j = 0; j < 8; ++j) acc[j] = 0.f;
            for (int v = 0; v < 128; ++v) { const float b = Bv[v * 64 + c];
#pragma unroll
                for (int j = 0; j < 8; ++j) acc[j] += Av[(rg * 8 + j) * 129 + v] * b; }
            u32x4 o; o.x = pk2(acc[0], acc[1]); o.y = pk2(acc[2], acc[3]); o.z = pk2(acc[4], acc[5]); o.w = pk2(acc[6], acc[7]);
            *(u32x4*)(WB + DW_WO + (size_t)(c0 + c) * 8192 + h * 256 + r0 + rg * 8) = o;
            __syncthreads();
        }
    }
}
DI void ph_dsa_post1(const Frame& F, int half, const float* qn, const float* kvn, const float* lng, const float* lnb) {
    unsigned char* ar = F.ws + WS_AR;
    const float* DIN = (const float*)(ar + DA_DIN); bf16* CQN = (bf16*)(ar + DA_CQN); bf16* LATC = (bf16*)(ar + DA_LATC); bf16* KPE = (bf16*)(ar + DA_KPE); bf16* KIDX = (bf16*)(ar + DA_KIDX); float* WIDX = (float*)(ar + DA_WIDX);
    const float* c48 = (const float*)(F.ws + TAB_COS48); const float* s48 = (const float*)(F.ws + TAB_SIN48); const float* c32 = (const float*)(F.ws + TAB_COS32); const float* s32 = (const float*)(F.ws + TAB_SIN32);
    LAS float* buf = (LAS float*)(F.lds + F.wave * 1024);
    const int lane = F.lane;
    for (int ml = F.gw; ml < MC; ml += F.NGW) {
        const int mg = half * MC + ml;
        const size_t kfb = ((size_t)(ml >> 5) * 8 * 64 + (ml & 31)) * 8;
        const float* row = DIN + (size_t)ml * 1024 + 16 * lane;
        f32x4 v[4]; float ss = 0.f, s1 = 0.f;
#pragma unroll
        for (int j = 0; j < 4; ++j) { v[j] = *(const f32x4*)(row + 4 * j); ss += (v[j].x * v[j].x + v[j].y * v[j].y) + (v[j].z * v[j].z + v[j].w * v[j].w); s1 += (v[j].x + v[j].y) + (v[j].z + v[j].w); }
        const bool isq = lane < 32, iskv = lane >= 32 && lane < 48, ispe = lane >= 48 && lane < 51, isix = lane >= 51 && lane < 59;
        const float ssq = wave_sum(isq ? ss : 0.f), sskv = wave_sum(iskv ? ss : 0.f), mean = wave_sum(isix ? s1 : 0.f) * (1.f / 128.f);
        float d2 = 0.f;
#pragma unroll
        for (int j = 0; j < 4; ++j) { const f32x4 d = v[j] - mean; d2 += (d.x * d.x + d.y * d.y) + (d.z * d.z + d.w * d.w); }
        const float var = wave_sum(isix ? d2 : 0.f) * (1.f / 128.f);
        const float rq = 1.0f / sqrtf(ssq * (1.f / 512.f) + NORM_EPS), rkv = 1.0f / sqrtf(sskv * (1.f / 256.f) + NORM_EPS), rstd = 1.0f / sqrtf(var + NORM_EPS);
        if (isq || iskv) {
            const float* gp = isq ? qn + 16 * lane : kvn + 16 * (lane - 32); const float rs = isq ? rq : rkv;
            bf16* dst = isq ? CQN + (size_t)ml * 512 + 16 * lane : LATC + (size_t)ml * 256 + 16 * (lane - 32);
            u32x4 o[2];
#pragma unroll
            for (int j = 0; j < 4; ++j) { const f32x4 g = *(const f32x4*)(gp + 4 * j); const f32x4 y = v[j] * rs * g; o[j >> 1][(j & 1) * 2] = pk2(y.x, y.y); o[j >> 1][(j & 1) * 2 + 1] = pk2(y.z, y.w); }
            *(u32x4*)dst = o[0]; *(u32x4*)(dst + 8) = o[1];
        } else if (ispe) {
#pragma unroll
            for (int j = 0; j < 4; ++j) *(LAS f32x4*)(buf + (lane - 48) * 16 + 4 * j) = v[j];
        } else if (isix) {
#pragma unroll
            for (int j = 0; j < 4; ++j) { const f32x4 g = *(const f32x4*)(lng + (lane - 51) * 16 + 4 * j), b = *(const f32x4*)(lnb + (lane - 51) * 16 + 4 * j); *(LAS f32x4*)(buf + 48 + (lane - 51) * 16 + 4 * j) = (v[j] - mean) * rstd * g + b; }
        } else if (lane == 59) {
#pragma unroll
            for (int j = 0; j < 4; ++j) *(f32x4*)(WIDX + (size_t)ml * 16 + 4 * j) = v[j] * DSA_WIDX_SCALE;
        }
        LDS_WAIT();
        if (lane < 24) { const float x1 = buf[lane], x2 = buf[24 + lane], c = c48[(size_t)mg * 24 + lane], s = s48[(size_t)mg * 24 + lane];
            KPE[(size_t)ml * 48 + lane] = f2bf(x1 * c - x2 * s); KPE[(size_t)ml * 48 + 24 + lane] = f2bf(x1 * s + x2 * c);
        } else if (lane < 40) { const int i = lane - 24; const float x1 = buf[48 + i], x2 = buf[48 + 16 + i], c = c32[(size_t)mg * 16 + i], s = s32[(size_t)mg * 16 + i];
            KIDX[kfb + (size_t)((i >> 3) * 32) * 8 + (i & 7)] = f2bf(x1 * c - x2 * s); KIDX[kfb + (size_t)(64 + (i >> 3) * 32) * 8 + (i & 7)] = f2bf(x1 * s + x2 * c);
        } else { const int d = 32 + 4 * (lane - 40); const f32x4 y = *(const LAS f32x4*)(buf + 48 + d); u32x2 w; w.x = pk2(y.x, y.y); w.y = pk2(y.z, y.w); *(u32x2*)(KIDX + kfb + (size_t)((d >> 4) * 64 + ((d >> 3) & 1) * 32) * 8 + (d & 7)) = w; }
        LDS_WAIT();
    }
}
DI void ph_dsa_rope(const Frame& F, int half) {
    unsigned char* ar = F.ws + WS_AR; bf16* QPE = (bf16*)(ar + DA_QPE); bf16* QIDX = (bf16*)(ar + DA_QIDX);
    const float* c48 = (const float*)(F.ws + TAB_COS48); const float* s48 = (const float*)(F.ws + TAB_SIN48); const float* c32 = (const float*)(F.ws + TAB_COS32); const float* s32 = (const float*)(F.ws + TAB_SIN32);
    for (int ml = F.gw; ml < MC; ml += F.NGW) {
        const size_t mg = (size_t)half * MC + ml;
        for (int p = F.lane; p < 768; p += 64) { const int hd = p / 24, i = p - hd * 24; bf16* q = QPE + (size_t)ml * 1536 + hd * 48 + i;
            const float x1 = bf2f(q[0]), x2 = bf2f(q[24]), c = c48[mg * 24 + i], s = s48[mg * 24 + i]; q[0] = f2bf(x1 * c - x2 * s); q[24] = f2bf(x1 * s + x2 * c); }
        for (int p = F.lane; p < 256; p += 64) { const int hd = p >> 4, i = p & 15; bf16* q = QIDX + (size_t)ml * 2048 + hd * 128 + i;
            const float x1 = bf2f(q[0]), x2 = bf2f(q[16]), c = c32[mg * 16 + i], s = s32[mg * 16 + i]; q[0] = f2bf(x1 * c - x2 * s); q[16] = f2bf(x1 * s + x2 * c); }
    }
}
DI unsigned f2sortable(float s) { const unsigned b = __builtin_bit_cast(unsigned, s); return (b & 0x80000000u) ? ~b : (b | 0x80000000u); }
DI void ph_dsa_index(const Frame& F, const int dry = 0) {
    unsigned char* ar = F.ws + WS_AR;
    const bf16* QIDX = (const bf16*)(ar + DA_QIDX); const bf16* KIDX = (const bf16*)(ar + DA_KIDX); const float* WIDX = (const float*)(ar + DA_WIDX);
    unsigned short* SEL = (unsigned short*)(ar + DA_SEL); int* CNT = (int*)(ar + DA_CNT); float* SC = (float*)(ar + DA_SC) + (size_t)F.gw * 16384;
    const int lane = F.lane, r = lane & 31, hf = lane >> 5;
    LAS unsigned char* wl = F.lds + F.wave * 8192 + lane * 16;
#pragma unroll 1
    for (int tile = blockIdx.x; tile < BPH * 128; tile += F.G) {
        const int j = tile >> 8, c8 = tile & 255, c7 = c8 & 127, bl = (c8 >> 7) * 2 + j, qt = j ? 127 - c7 : c7;
        const int q0 = qt * 32 + 4 * F.wave;
        const int ntile = (q0 + 3) / 32 + 1;
        bf16x8 qa[2][8];
#pragma unroll
        for (int pr = 0; pr < 2; ++pr) {
            const int mrow = bl * SEQ + q0 + 2 * pr + (r >> 4);
#pragma unroll
            for (int s = 0; s < 8; ++s) qa[pr][s] = *(const bf16x8*)(QIDX + (size_t)mrow * 2048 + (r & 15) * 128 + 16 * s + 8 * hf);
            float wv[2][16];
#pragma unroll
            for (int i = 0; i < 16; ++i) wv[pr][i] = WIDX[(size_t)(bl * SEQ + q0 + 2 * pr + (i >> 3)) * 16 + (i & 3) + 8 * ((i >> 2) & 1) + 4 * hf];
#pragma unroll
            for (int i = 0; i < 16; i += 4) *(LAS f32x4*)(wl + (pr * 4 + (i >> 2)) * 1024) = (f32x4){wv[pr][i], wv[pr][i + 1], wv[pr][i + 2], wv[pr][i + 3]};
        }
        LDS_WAIT();
        bf16x8 kf[8];
        { const bf16* kp = KIDX + ((size_t)(bl * 128) * 8 * 64 + lane) * 8;
#pragma unroll
          for (int s = 0; s < 8; ++s) kf[s] = *(const bf16x8*)(kp + 512 * s); }
#pragma unroll 1
        for (int t = 0; t < ntile; ++t) {
            f32x16 accs[2];
#pragma unroll
            for (int pr = 0; pr < 2; ++pr) {
#pragma unroll
                for (int i = 0; i < 16; ++i) accs[pr][i] = 0.f;
#pragma unroll
                for (int s = 0; s < 8; ++s) accs[pr] = MFMA32(qa[pr][s], kf[s], accs[pr]);
            }
            if (t + 1 < ntile) { const bf16* kp = KIDX + ((size_t)(bl * 128 + t + 1) * 8 * 64 + lane) * 8;
#pragma unroll
                for (int s = 0; s < 8; ++s) kf[s] = *(const bf16x8*)(kp + 512 * s); }
#pragma unroll
            for (int pr = 0; pr < 2; ++pr) {
                const f32x16 acc = accs[pr];
                float wv[2][16];
                { unsigned wa_ = (unsigned)(size_t)wl; asm volatile("" : "+v"(wa_));
#pragma unroll
                  for (int i = 0; i < 16; i += 4) { const f32x4 w4 = *(const LAS f32x4*)((LAS unsigned char*)(size_t)wa_ + (pr * 4 + (i >> 2)) * 1024); wv[pr][i] = w4.x; wv[pr][i + 1] = w4.y; wv[pr][i + 2] = w4.z; wv[pr][i + 3] = w4.w; } }
                float p0 = 0.f, p1 = 0.f;
#pragma unroll
                for (int i = 0; i < 8; ++i) { p0 += wv[pr][i] * fmaxf(acc[i], 0.f); p1 += wv[pr][8 + i] * fmaxf(acc[8 + i], 0.f); }
                const float t0 = p0 + __shfl_xor(p0, 32), t1 = p1 + __shfl_xor(p1, 32);
                SC[(pr * 128 + t) * 64 + lane] = hf ? t1 : t0;
            }
        }
        VM_WAIT();
#pragma unroll 1
        for (int qi = 0; qi < 4; ++qi) {
            const int tq = q0 + qi, pr = qi >> 1, qs = qi & 1;
            unsigned u[64];
            const unsigned* scp = (const unsigned*)(SC + pr * 8192 + hf * 64 + qs * 32 + r);
#pragma unroll
            for (int g8 = 0; g8 < 8; ++g8) {
#pragma unroll
                for (int e = 0; e < 8; ++e) { const int i = 8 * g8 + e; const float s = __builtin_bit_cast(float, __hip_atomic_load(scp + e * 128, __ATOMIC_RELAXED, __HIP_MEMORY_SCOPE_AGENT));
                    u[i] = (2 * i + hf < ntile && 64 * i + lane <= tq) ? f2sortable(s) : 0u; }
                scp += 1024; asm volatile("" : "+v"(scp));
            }
            unsigned prefix = 0u;
#pragma unroll 1
            for (int bit = 31; bit >= 0; --bit) {
                const unsigned cand = prefix | (1u << bit); int c = 0;
#pragma unroll
                for (int i = 0; i < 64; ++i) c += (u[i] >= cand) ? 1 : 0;
#pragma unroll
                for (int o = 1; o < 64; o <<= 1) c += __shfl_xor(c, o);
                if (c >= 256) prefix = cand;
            }
            const unsigned T = prefix > 1u ? prefix : 1u;
            int nl = 0;
#pragma unroll
            for (int i = 0; i < 64; ++i) nl += (u[i] >= T) ? 1 : 0;
            int inc = nl;
#pragma unroll
            for (int o = 1; o < 64; o <<= 1) { const int y = __shfl_up(inc, o); if (lane >= o) inc += y; }
            const int base = __shfl(inc, 63);
            int pos = inc - nl;
            unsigned short* sel = dry ? (unsigned short*)(ar + DUMMY_OFF) + (size_t)F.gw * 256 : SEL + (size_t)(bl * SEQ + tq) * 256;
#pragma unroll
            for (int i = 0; i < 64; ++i) { if (u[i] >= T) { if (pos < 256) sel[pos] = (unsigned short)(64 * i + lane); ++pos; } }
            if (lane == 0) (dry ? (int*)(ar + DUMMY_OFF + 32 * MiB) + F.gw : CNT + bl * SEQ + tq)[0] = base < 256 ? base : 256;
        }
    }
}
DI int dsa_fsw(int row) { return ((row & 3) << 2) | ((row >> 2) & 3); }
struct DsaPre { u32x4 row[16]; bf16x8 kpe[3]; bf16x8 q[3]; };
DI void dsa_prefetch(DsaPre& P, const bf16* LATC, const bf16* KPE, const bf16* QL, const bf16* QPE, int ml, int selv, int lane, int w) {
    const int bl = ml >> 12, r = lane & 31, h = lane >> 5;
#pragma unroll
    for (int it = 0; it < 16; ++it) { const int ki = __shfl(selv, (lane >> 5) + 2 * it); P.row[it] = *(const u32x4*)(LATC + (size_t)(bl * SEQ + ki) * 256 + (lane & 31) * 8); }
#pragma unroll
    for (int s = 0; s < 3; ++s) P.kpe[s] = *(const bf16x8*)(KPE + (size_t)(bl * SEQ + selv) * 48 + 16 * s + 8 * h);
#pragma unroll
    for (int j = 0; j < 3; ++j) { const int fi = w + 8 * j;
        if (fi < 16) P.q[j] = *(const bf16x8*)(QL + (size_t)ml * 8192 + r * 256 + 16 * fi + 8 * h);
        else if (fi < 19) P.q[j] = *(const bf16x8*)(QPE + (size_t)ml * 1536 + r * 48 + 16 * (fi - 16) + 8 * h); }
}
DI void ph_dsa_attn(const Frame& F, const int dry = 0) {
    unsigned char* ar = F.ws + WS_AR;
    bf16* QL = (bf16*)(ar + DA_QL); const bf16* QPE = (const bf16*)(ar + DA_QPE); const bf16* LATC = (const bf16*)(ar + DA_LATC); const bf16* KPE = (const bf16*)(ar + DA_KPE);
    const unsigned short* SEL = (const unsigned short*)(ar + DA_SEL); const int* CNT = (const int*)(ar + DA_CNT);
    const int lane = F.lane, r = lane & 31, h = lane >> 5, w = F.wave;
    LAS unsigned char* IMG = F.lds; LAS unsigned char* QB = F.lds + LDSCTL_OFF + 256; LAS float* MX = (LAS float*)(F.lds + LDSCTL_OFF + 256 + 19456); LAS float* SX = MX + 256;
    const int i16 = lane & 15, tq_ = i16 >> 2, tp_ = i16 & 3, blk = (lane >> 4) & 1;
    int ml = blockIdx.x;
    if (ml >= MC) return;
    DsaPre P;
    int cnt_c = CNT[ml];
    { const int slot = 32 * w + r; const int selv = slot < cnt_c ? (int)SEL[(size_t)ml * 256 + slot] : 0; dsa_prefetch(P, LATC, KPE, QL, QPE, ml, selv, lane, w); }
    int cnt_n = 0, selv_n = 0;
    if (ml + F.G < MC) { cnt_n = CNT[ml + F.G]; const int slot = 32 * w + r; selv_n = slot < cnt_n ? (int)SEL[(size_t)(ml + F.G) * 256 + slot] : 0; }
#pragma unroll 1
    for (; ml < MC; ml += F.G) {
        const int cnt = cnt_c, nch = (cnt + 31) >> 5; const bool act = w < nch;
#pragma unroll
        for (int it = 0; it < 16; ++it) { const int rr = (lane >> 5) + 2 * it; *(LAS u32x4*)(IMG + (32 * w + rr) * 512 + (((lane & 31) ^ dsa_fsw(rr)) * 16)) = P.row[it]; }
#pragma unroll
        for (int j = 0; j < 3; ++j) { const int fi = w + 8 * j; if (fi < 19) *(LAS bf16x8*)(QB + fi * 1024 + lane * 16) = P.q[j]; }
        bf16x8 kpe[3];
#pragma unroll
        for (int s = 0; s < 3; ++s) kpe[s] = P.kpe[s];
        LDS_WAIT(); __builtin_amdgcn_s_barrier(); asm volatile("" ::: "memory");
        if (ml + F.G < MC) {
            dsa_prefetch(P, LATC, KPE, QL, QPE, ml + F.G, selv_n, lane, w); cnt_c = cnt_n;
            if (ml + 2 * F.G < MC) { cnt_n = CNT[ml + 2 * F.G]; const int slot = 32 * w + r; selv_n = slot < cnt_n ? (int)SEL[(size_t)(ml + 2 * F.G) * 256 + slot] : 0; }
        }
        f32x16 S; float mx = -INFINITY;
#pragma unroll
        for (int i = 0; i < 16; ++i) S[i] = 0.f;
        if (act) {
#pragma unroll
            for (int s = 0; s < 16; ++s) S = MFMA32(*(const LAS bf16x8*)(IMG + (32 * w + r) * 512 + (((2 * s + h) ^ dsa_fsw(r)) * 16)), *(const LAS bf16x8*)(QB + s * 1024 + lane * 16), S);
#pragma unroll
            for (int s = 0; s < 3; ++s) S = MFMA32(kpe[s], *(const LAS bf16x8*)(QB + (16 + s) * 1024 + lane * 16), S);
#pragma unroll
            for (int i = 0; i < 16; ++i) { S[i] = (32 * w + crow(i, h) < cnt) ? S[i] : -INFINITY; mx = fmaxf(mx, S[i]); }
            mx = fmaxf(mx, __shfl_xor(mx, 32));
        }
        if (h == 0) MX[w * 32 + r] = mx;
        LDS_WAIT(); __builtin_amdgcn_s_barrier(); asm volatile("" ::: "memory");
        float M = MX[r];
#pragma unroll
        for (int k = 1; k < 8; ++k) M = fmaxf(M, MX[k * 32 + r]);
        float lsum = 0.f; bf16x8 pf[2] = {(bf16x8){0, 0, 0, 0, 0, 0, 0, 0}, (bf16x8){0, 0, 0, 0, 0, 0, 0, 0}};
        if (act) {
#pragma unroll
            for (int i = 0; i < 16; ++i) { S[i] = __builtin_amdgcn_exp2f(S[i] - M); lsum += S[i]; }
#pragma unroll
            for (int s = 0; s < 2; ++s) { u32x4 t; t.x = pk2(S[8 * s], S[8 * s + 1]); t.y = pk2(S[8 * s + 2], S[8 * s + 3]); t.z = pk2(S[8 * s + 4], S[8 * s + 5]); t.w = pk2(S[8 * s + 6], S[8 * s + 7]); pf[s] = __builtin_bit_cast(bf16x8, t); }
        }
        lsum += __shfl_xor(lsum, 32);
        if (h == 0) SX[w * 32 + r] = lsum;
        *(LAS bf16x8*)(QB + (2 * w) * 1024 + lane * 16) = pf[0]; *(LAS bf16x8*)(QB + (2 * w + 1) * 1024 + lane * 16) = pf[1];
        LDS_WAIT(); __builtin_amdgcn_s_barrier(); asm volatile("" ::: "memory");
        f32x16 O;
#pragma unroll
        for (int i = 0; i < 16; ++i) O[i] = 0.f;
#pragma unroll 2
        for (int ks = 0; ks < 2 * nch; ++ks) {
            const int r0 = 16 * ks + 4 * h + tq_, r1 = r0 + 8, pc = 4 * w + 2 * blk + (tp_ >> 1);
            const s16x4 lo = __builtin_bit_cast(s16x4, __builtin_amdgcn_ds_read_tr16_b64_v4i16((LAS v4i16_t*)(IMG + r0 * 512 + ((pc ^ dsa_fsw(r0)) * 16) + 8 * (tp_ & 1))));
            const s16x4 hi = __builtin_bit_cast(s16x4, __builtin_amdgcn_ds_read_tr16_b64_v4i16((LAS v4i16_t*)(IMG + r1 * 512 + ((pc ^ dsa_fsw(r1)) * 16) + 8 * (tp_ & 1))));
            O = MFMA32(__builtin_shufflevector(lo, hi, 0, 1, 2, 3, 4, 5, 6, 7), *(const LAS bf16x8*)(QB + ks * 1024 + lane * 16), O);
        }
        float l = SX[r];
#pragma unroll
        for (int k = 1; k < 8; ++k) l += SX[k * 32 + r];
        const float linv = 1.0f / l;
        bf16* o = (dry ? (bf16*)(ar + DUMMY_OFF) + (size_t)blockIdx.x * 8192 : QL + (size_t)ml * 8192) + r * 256 + 32 * w + 4 * h;
#pragma unroll
        for (int g = 0; g < 4; ++g) { u32x2 t; t.x = pk2(O[4 * g] * linv, O[4 * g + 1] * linv); t.y = pk2(O[4 * g + 2] * linv, O[4 * g + 3] * linv); *(u32x2*)(o + 8 * g) = t; }
        LDS_WAIT(); __builtin_amdgcn_s_barrier(); asm volatile("" ::: "memory");
    }
}
template <int NDB> DI void softmax_step(f32x16& S, float& m, float& l, f32x16 (&O)[NDB], bf16x8 (&pf)[2]) {
    float mx = S[0];
#pragma unroll
    for (int i = 1; i < 16; ++i) mx = fmaxf(mx, S[i]);
    mx = fmaxf(mx, __shfl_xor(mx, 32));
    const float mn = fmaxf(m, mx), ms = (mn == -INFINITY) ? 0.f : mn;
    const float alpha = __builtin_amdgcn_exp2f(m - ms);
    float sum = 0.f;
#pragma unroll
    for (int i = 0; i < 16; ++i) { S[i] = __builtin_amdgcn_exp2f(S[i] - ms); sum += S[i]; }
    l = l * alpha + sum; m = mn;
#pragma unroll
    for (int db = 0; db < NDB; ++db)
#pragma unroll
        for (int i = 0; i < 16; ++i) O[db][i] *= alpha;
#pragma unroll
    for (int s = 0; s < 2; ++s) { u32x4 w; w.x = pk2(S[8 * s], S[8 * s + 1]); w.y = pk2(S[8 * s + 2], S[8 * s + 3]); w.z = pk2(S[8 * s + 4], S[8 * s + 5]); w.w = pk2(S[8 * s + 6], S[8 * s + 7]); pf[s] = __builtin_bit_cast(bf16x8, w); }
}
template <int NQ, int NDB, bool PV, bool QL, bool FRAG, class KA, class VA, class MK>
DI void attn_run(const bf16x8 (&qf)[NQ], const LAS unsigned char* qlds, f32x16 (&O)[NDB], float& m, float& l, int tb, int te, const KA& ka, const VA& va, const MK& mk) {
    if (tb >= te) return;
    bf16x8 kf[NQ];
    { const bf16* kp = ka(tb);
#pragma unroll
      for (int s = 0; s < NQ; ++s) kf[s] = *(const bf16x8*)(kp + (FRAG ? 512 : 16) * s); }
    for (int t = tb; t < te; ++t) {
        bf16x8 vf[NDB][2];
        if (PV) {
#pragma unroll
            for (int db = 0; db < NDB; ++db) { const bf16* vp = va(t, db);
#pragma unroll
                for (int s = 0; s < 2; ++s) { if (FRAG) vf[db][s] = *(const bf16x8*)(vp + 512 * s); else vf[db][s] = __builtin_shufflevector(*(const s16x4*)(vp + 16 * s), *(const s16x4*)(vp + 16 * s + 8), 0, 1, 2, 3, 4, 5, 6, 7); } }
        }
        f32x16 S;
#pragma unroll
        for (int i = 0; i < 16; ++i) S[i] = 0.f;
#pragma unroll
        for (int s = 0; s < NQ; ++s) { if (QL) { unsigned qa_ = (unsigned)(size_t)qlds; asm volatile("" : "+v"(qa_)); S = MFMA32(kf[s], *(const LAS bf16x8*)((LAS unsigned char*)(size_t)qa_ + s * 1024), S); } else S = MFMA32(kf[s], qf[s], S); }
        if (t + 1 < te) { const bf16* kp = ka(t + 1);
#pragma unroll
            for (int s = 0; s < NQ; ++s) kf[s] = *(const bf16x8*)(kp + (FRAG ? 512 : 16) * s); }
        mk(t, S);
        bf16x8 pf[2]; softmax_step<NDB>(S, m, l, O, pf);
        if (PV) {
#pragma unroll
            for (int db = 0; db < NDB; ++db)
#pragma unroll
                for (int s = 0; s < 2; ++s) O[db] = MFMA32(vf[db][s], pf[s], O[db]);
        }
    }
}
template <bool ACC> DI void store_col(bf16* out, const f32x16 (&O)[4], float scale, int h) {
#pragma unroll
    for (int db = 0; db < 4; ++db)
#pragma unroll
        for (int g = 0; g < 4; ++g) { u32x2* p = (u32x2*)(out + db * 32 + 8 * g + 4 * h);
            float a = O[db][4 * g] * scale, b = O[db][4 * g + 1] * scale, c = O[db][4 * g + 2] * scale, d = O[db][4 * g + 3] * scale;
            if (ACC) { const u32x2 o = *p; a += bflo(o.x); b += bfhi(o.x); c += bflo(o.y); d += bfhi(o.y); }
            u32x2 w; w.x = pk2(a, b); w.y = pk2(c, d); *p = w; }
}
template <int NQ> struct TilePre { u32x4 a, b, c; };
template <int NQ, class SRC> DI void tile_fetch(TilePre<NQ>& p, const SRC& src, int T, int tid) {
    const bf16* k = src.k(T); const bf16* v = src.v(T);
    constexpr int NK = NQ * 64;
    p.a = *(const u32x4*)(k + (size_t)tid * 8);
    const int p1 = tid + 512; p.b = (p1 < NK) ? *(const u32x4*)(k + (size_t)p1 * 8) : *(const u32x4*)(v + (size_t)(p1 - NK) * 8);
    if (NQ * 64 + 512 > 1024) { const int p2 = tid + 1024; if (p2 < NK + 512) p.c = *(const u32x4*)(v + (size_t)(p2 - NK) * 8); }
}
template <int NQ> DI void tile_put(const TilePre<NQ>& p, LAS unsigned char* buf, int tid) {
    *(LAS u32x4*)(buf + tid * 16) = p.a; *(LAS u32x4*)(buf + (tid + 512) * 16) = p.b;
    if (NQ * 64 + 512 > 1024) { if (tid + 1024 < NQ * 64 + 512) *(LAS u32x4*)(buf + (tid + 1024) * 16) = p.c; }
}
template <int NQ, bool PV, class SRC, class MK>
DI void attn_run_sh(LAS unsigned char* tl, int tid, int lane, const bf16x8 (&qf)[NQ], f32x16 (&O)[4], float& m, float& l, int TB, int TE, int tb, int te, const SRC& src, const MK& mk) {
    constexpr int TBYTES = (NQ + 8) * 1024;
    if (TB >= TE) return;
    TilePre<NQ> pre;
    tile_fetch<NQ>(pre, src, TB, tid); tile_put<NQ>(pre, tl, tid);
    LDS_WAIT(); __builtin_amdgcn_s_barrier(); asm volatile("" ::: "memory");
#pragma unroll 1
    for (int T = TB; T < TE; ++T) {
        LAS unsigned char* cur = tl + ((T - TB) & 1) * TBYTES;
        if (T + 1 < TE) tile_fetch<NQ>(pre, src, T + 1, tid);
        if (T >= tb && T < te) {
            f32x16 S;
#pragma unroll
            for (int i = 0; i < 16; ++i) S[i] = 0.f;
#pragma unroll
            for (int s = 0; s < NQ; ++s) S = MFMA32(*(const LAS bf16x8*)(cur + s * 1024 + lane * 16), qf[s], S);
            mk(T, S);
            bf16x8 pf[2]; softmax_step<4>(S, m, l, O, pf);
            if (PV) {
#pragma unroll
                for (int db = 0; db < 4; ++db)
#pragma unroll
                    for (int s = 0; s < 2; ++s) O[db] = MFMA32(*(const LAS bf16x8*)(cur + (NQ + db * 2 + s) * 1024 + lane * 16), pf[s], O[db]);
            }
        }
        if (T + 1 < TE) tile_put<NQ>(pre, tl + ((T + 1 - TB) & 1) * TBYTES, tid);
        LDS_WAIT(); __builtin_amdgcn_s_barrier(); asm volatile("" ::: "memory");
    }
}
struct FragSrc { const bf16* kb; const bf16* vb; int nq; DI const bf16* k(int T) const { return kb + (size_t)T * nq * 512; } DI const bf16* v(int T) const { return vb + (size_t)T * 8 * 512; } };
constexpr size_t FA_Q = 0, FA_K = 64 * MiB, FA_F = 128 * MiB, FA_V = 136 * MiB, FA_CUM = 200 * MiB, FA_O = 202 * MiB, FA_KF = 266 * MiB, FA_VF = 330 * MiB;
constexpr size_t FW_IN = 0, FW_OUT = (size_t)6400 * 2048;
constexpr float FOX_QSCALE = 0.08838834764831845f * LOG2E;
DI void ph_fox_cvt(const Frame& F, const float* w_in, const float* w_out) {
    bf16* WB = (bf16*)(F.ws + WS_WMIX);
    cvt_job(F, w_in, 6160, DM, 0, 2048, WB + FW_IN, DM, 0, FOX_QSCALE);
    cvt_job(F, w_in, 6160, DM, 2048, 2048, WB + FW_IN, DM, 2048, 1.f);
    cvt_job(F, w_in, 6160, DM, 4096, 2048, WB + FW_IN, DM, 4096, 1.f);
    cvt_job(F, w_in, 6160, DM, 6144, 16, WB + FW_IN, DM, 6144, 1.f);
    zero_bf16(F, WB + FW_IN + (size_t)6160 * DM, (size_t)240 * DM);
    cvt_job(F, w_out, DM, DM, 0, DM, WB + FW_OUT, DM, 0, 1.f);
}
DI void ph_fox_scan(const Frame& F, const float* b_f) {
    unsigned char* ar = F.ws + WS_AR; const bf16* FB = (const bf16*)(ar + FA_F); float* CUM = (float*)(ar + FA_CUM);
    for (int w = F.gw; w < BPH * 16; w += F.NGW) {
        const int bl = w >> 4, hd = w & 15; const float bf_ = b_f[hd];
        float v[64]; float run = 0.f;
#pragma unroll
        for (int i = 0; i < 64; ++i) { const float x = bf2f(FB[(size_t)(bl * SEQ + F.lane * 64 + i) * 256 + hd]) + bf_;
            const float ls = fminf(x, 0.f) - log1pf(expf(-fabsf(x))); run += ls; v[i] = run; }
        float inc = run;
#pragma unroll
        for (int o = 1; o < 64; o <<= 1) { const float y = __shfl_up(inc, o); if (F.lane >= o) inc += y; }
        const float base = inc - run;
        float* dst = CUM + (size_t)w * SEQ + F.lane * 64;
#pragma unroll
        for (int i = 0; i < 64; i += 4) *(f32x4*)(dst + i) = (f32x4){(v[i] + base) * LOG2E, (v[i + 1] + base) * LOG2E, (v[i + 2] + base) * LOG2E, (v[i + 3] + base) * LOG2E};
    }
    const bf16* Kr = (const bf16*)(ar + FA_K); const bf16* Vr = (const bf16*)(ar + FA_V); bf16* KF = (bf16*)(ar + FA_KF); bf16* VF = (bf16*)(ar + FA_VF);
    const int r = F.lane & 31, h = F.lane >> 5;
    for (int u = F.gw; u < BPH * 16 * 128; u += F.NGW) {
        const int bh = u >> 7, tile = u & 127, bl = bh >> 4, hd = bh & 15;
        const bf16* krow_ = Kr + ((size_t)bl * SEQ + tile * 32 + r) * DM + hd * 128 + 8 * h;
        bf16* kd = KF + (((size_t)bh * 128 + tile) * 8 * 64 + F.lane) * 8;
#pragma unroll
        for (int s = 0; s < 8; ++s) *(u32x4*)(kd + s * 512) = *(const u32x4*)(krow_ + 16 * s);
        bf16* vd = VF + (((size_t)bh * 128 + tile) * 8 * 64 + F.lane) * 8;
#pragma unroll
        for (int db = 0; db < 4; ++db)
#pragma unroll
            for (int s = 0; s < 2; ++s) { unsigned short e[8];
#pragma unroll
                for (int j = 0; j < 8; ++j) e[j] = Vr[((size_t)bl * SEQ + tile * 32 + 16 * s + 8 * (j >> 2) + 4 * h + (j & 3)) * DM + hd * 128 + db * 32 + r];
                u32x4 w; w.x = e[0] | ((unsigned)e[1] << 16); w.y = e[2] | ((unsigned)e[3] << 16); w.z = e[4] | ((unsigned)e[5] << 16); w.w = e[6] | ((unsigned)e[7] << 16);
                *(u32x4*)(vd + (db * 2 + s) * 512) = w; }
    }
}
struct FragKA { const bf16* base; int nq; DI const bf16* operator()(int t) const { return base + (size_t)t * nq * 512; } };
struct FragVA { const bf16* base; DI const bf16* operator()(int t, int db) const { return base + ((size_t)t * 8 + db * 2) * 512; } };
struct FoxMK { const float* cum; float ct; int tq, h;
    DI void operator()(int t, f32x16& S) const {
        const int k0 = 32 * t + 4 * h;
#pragma unroll
        for (int g = 0; g < 4; ++g) { const f32x4 cs = *(const f32x4*)(cum + k0 + 8 * g);
#pragma unroll
            for (int e = 0; e < 4; ++e) S[4 * g + e] = (k0 + 8 * g + e <= tq) ? S[4 * g + e] + (ct - cs[e]) : -INFINITY; }
    } };
DI void ph_fox_attn(const Frame& F, const int dry = 0) {
    unsigned char* ar = F.ws + WS_AR; const bf16* Q = (const bf16*)(ar + FA_Q); const bf16* KF = (const bf16*)(ar + FA_KF); const bf16* VF = (const bf16*)(ar + FA_VF); const float* CUM = (const float*)(ar + FA_CUM); bf16* Ob = (bf16*)(ar + FA_O);
    const int r = F.lane & 31, h = F.lane >> 5;
    for (int wb = blockIdx.x; wb < BPH * 16 * 4; wb += F.G) {
        const int bh = wb >> 2, x = (wb & 3) * 8 + F.wave, bl = bh >> 4, hd = bh & 15;
#pragma unroll 1
        for (int k = 0; k < 4; ++k) {
            const int qt = (k == 0) ? x : (k == 1) ? 63 - x : (k == 2) ? 64 + x : 127 - x;
            const int qhi = (k == 0) ? (wb & 3) * 8 + 7 : (k == 1) ? 63 - (wb & 3) * 8 : (k == 2) ? 64 + (wb & 3) * 8 + 7 : 127 - (wb & 3) * 8;
            const int tq = qt * 32 + r; const size_t mrow = (size_t)bl * SEQ + tq;
            bf16x8 qf[8];
#pragma unroll
            for (int s = 0; s < 8; ++s) qf[s] = *(const bf16x8*)(Q + mrow * DM + hd * 128 + 16 * s + 8 * h);
            f32x16 O[4];
#pragma unroll
            for (int db = 0; db < 4; ++db)
#pragma unroll
                for (int i = 0; i < 16; ++i) O[db][i] = 0.f;
            float m = -INFINITY, l = 0.f;
            const float* cum = CUM + (size_t)bh * SEQ;
            const FragSrc src{KF + (size_t)bh * 128 * 8 * 512, VF + (size_t)bh * 128 * 8 * 512, 8}; const FoxMK mk{cum, cum[tq], tq, h};
            attn_run_sh<8, true>(F.lds, F.tid, F.lane, qf, O, m, l, 0, qhi + 1, 0, qt + 1, src, mk);
            l += __shfl_xor(l, 32);
            store_col<false>(dry ? (bf16*)(ar + DUMMY_OFF) + ((size_t)F.gw * 32 + r) * 128 : Ob + mrow * DM + hd * 128, O, l > 0.f ? 1.0f / l : 0.f, h);
        }
    }
}
constexpr size_t NA_Q = 0, NA_KC = 288 * MiB, NA_VC = 313 * MiB, NA_KSR = 330 * MiB, NA_KWR = 354 * MiB, NA_GT = 378 * MiB, NA_VSR = 386 * MiB, NA_VWR = 402 * MiB, NA_GK = 418 * MiB, NA_GV = 420 * MiB,
                 NA_KCMP = 422 * MiB, NA_VCT = 424 * MiB, NA_SELB = 426 * MiB, NA_O = 428 * MiB,
                 NA_KSF = 620 * MiB, NA_KWF = 644 * MiB, NA_VSF = 668 * MiB, NA_VWF = 684 * MiB;
constexpr size_t NW_IN = 0, NW_W1K = (size_t)13312 * 2048, NW_W1V = NW_W1K + (size_t)256 * 6144, NW_W2K = NW_W1V + (size_t)256 * 4096, NW_W2V = NW_W2K + 65536, NW_OUT = NW_W2V + 65536;
constexpr float NSA_QSCALE = 0.07216878364870322f * LOG2E;
DI void ph_nsa_cvt(const Frame& F, const float* w_in, const float* k_pe, const float* k_w1, const float* k_b1, const float* k_w2, const float* v_pe, const float* v_w1, const float* v_b1, const float* v_w2, const float* w_out) {
    bf16* WB = (bf16*)(F.ws + WS_WMIX); float* BIAS = (float*)(F.ws + WS_MISC);
    cvt_job(F, w_in, 13200, DM, 0, 9216, WB + NW_IN, DM, 0, NSA_QSCALE);
    cvt_job(F, w_in, 13200, DM, 9216, 768, WB + NW_IN, DM, 9216, 1.f);
    cvt_job(F, w_in, 13200, DM, 9984, 512, WB + NW_IN, DM, 9984, 1.f);
    cvt_job(F, w_in, 13200, DM, 10496, 768, WB + NW_IN, DM, 10496, 1.f);
    cvt_job(F, w_in, 13200, DM, 11776, 768, WB + NW_IN, DM, 11264, 1.f);
    cvt_job(F, w_in, 13200, DM, 13056, 144, WB + NW_IN, DM, 12032, 1.f);
    zero_bf16(F, WB + NW_IN + (size_t)12176 * DM, (size_t)112 * DM);
    cvt_job(F, w_in, 13200, DM, 11264, 512, WB + NW_IN, DM, 12288, 1.f);
    cvt_job(F, w_in, 13200, DM, 12544, 512, WB + NW_IN, DM, 12800, 1.f);
    cvt_job(F, k_w1, 256, 6144, 0, 256, WB + NW_W1K, 6144, 0, 1.f);
    cvt_job(F, v_w1, 256, 4096, 0, 256, WB + NW_W1V, 4096, 0, 1.f);
    cvt_job(F, k_w2, 192, 256, 0, 192, WB + NW_W2K, 256, 0, 1.f); zero_bf16(F, WB + NW_W2K + 192 * 256, 64 * 256);
    cvt_job(F, v_w2, 128, 256, 0, 128, WB + NW_W2V, 256, 0, 1.f); zero_bf16(F, WB + NW_W2V + 128 * 256, 128 * 256);
    cvt_job(F, w_out, DM, 6144, 0, DM, WB + NW_OUT, 6144, 0, 1.f);
    for (int w = F.gw; w < 512; w += F.NGW) { const bool isk = w < 256; const int c = w & 255, n = isk ? 6144 : 4096; const float* pe = isk ? k_pe : v_pe; const float* w1 = isk ? k_w1 : v_w1;
        float s = 0.f; for (int i = F.lane; i < n; i += 64) s += pe[i] * w1[(size_t)i * 256 + c];
        s = wave_sum(s); if (F.lane == 0) BIAS[w] = s + (isk ? k_b1[c] : v_b1[c]); }
}
DI void ph_nsa_rope(const Frame& F, int half) {
    unsigned char* ar = F.ws + WS_AR; bf16* Q = (bf16*)(ar + NA_Q); bf16* KC = (bf16*)(ar + NA_KC);
    const bf16* KSR = (const bf16*)(ar + NA_KSR); const bf16* KWR = (const bf16*)(ar + NA_KWR); bf16* KSF = (bf16*)(ar + NA_KSF); bf16* KWF = (bf16*)(ar + NA_KWF);
    const float* c48 = (const float*)(F.ws + TAB_COS48); const float* s48 = (const float*)(F.ws + TAB_SIN48);
    for (int ml = F.gw; ml < MC; ml += F.NGW) {
        const size_t mg = (size_t)half * MC + ml; const int bl = ml >> 12, sq = ml & 4095;
        for (int p = F.lane; p < 1248; p += 64) {
            const int hd = p / 24, i = p - hd * 24; bf16* q;
            if (hd < 48) q = Q + (size_t)ml * 9216 + hd * 192 + i;
            else q = KC + ((size_t)(bl * 4 + hd - 48) * 4096 + sq) * 192 + i;
            const float x1 = bf2f(q[0]), x2 = bf2f(q[24]), c = c48[mg * 24 + i], s = s48[mg * 24 + i]; q[0] = f2bf(x1 * c - x2 * s); q[24] = f2bf(x1 * s + x2 * c);
        }
        const int tile = sq >> 5, rr = sq & 31;
        for (int u = F.lane; u < 168; u += 64) {
            const int tens = u / 84, uu = u - tens * 84, g = uu / 21, v = uu - g * 21;
            const bf16* src = (tens ? KWR : KSR) + (size_t)ml * 768 + g * 192;
            bf16* dst = (tens ? KWF : KSF) + ((size_t)((bl * 4 + g) * 128 + tile) * 12 * 64 + rr) * 8;
            if (v < 3) {
                const u32x4 a = *(const u32x4*)(src + 8 * v), b = *(const u32x4*)(src + 8 * v + 24); u32x4 o1, o2;
#pragma unroll
                for (int e = 0; e < 4; ++e) { const float c0 = c48[mg * 24 + 8 * v + 2 * e], s0 = s48[mg * 24 + 8 * v + 2 * e], c1 = c48[mg * 24 + 8 * v + 2 * e + 1], s1 = s48[mg * 24 + 8 * v + 2 * e + 1];
                    const float x1l = bflo(a[e]), x1h = bfhi(a[e]), x2l = bflo(b[e]), x2h = bfhi(b[e]);
                    o1[e] = pk2(x1l * c0 - x2l * s0, x1h * c1 - x2h * s1); o2[e] = pk2(x1l * s0 + x2l * c0, x1h * s1 + x2h * c1); }
                const int p1 = v, p2 = v + 3;
                *(u32x4*)(dst + ((p1 >> 1) * 64 + (p1 & 1) * 32) * 8) = o1; *(u32x4*)(dst + ((p2 >> 1) * 64 + (p2 & 1) * 32) * 8) = o2;
            } else { const int pc = v + 3; *(u32x4*)(dst + ((pc >> 1) * 64 + (pc & 1) * 32) * 8) = *(const u32x4*)(src + 8 * pc); }
        }
    }
    const bf16* VSR = (const bf16*)(ar + NA_VSR); const bf16* VWR = (const bf16*)(ar + NA_VWR); bf16* VSF = (bf16*)(ar + NA_VSF); bf16* VWF = (bf16*)(ar + NA_VWF);
    const int r = F.lane & 31, h = F.lane >> 5;
    for (int u = F.gw; u < 2 * BPH * 4 * 128; u += F.NGW) {
        const int tens = u >> 11, bg = (u >> 7) & 15, tile = u & 127, bl = bg >> 2, g = bg & 3;
        const bf16* src = (tens ? VWR : VSR) + ((size_t)bl * SEQ + tile * 32) * 512 + g * 128 + r;
        bf16* vd = (tens ? VWF : VSF) + (((size_t)bg * 128 + tile) * 8 * 64 + F.lane) * 8;
#pragma unroll
        for (int db = 0; db < 4; ++db)
#pragma unroll
            for (int s = 0; s < 2; ++s) { unsigned short e[8];
#pragma unroll
                for (int j = 0; j < 8; ++j) e[j] = src[(size_t)(16 * s + 8 * (j >> 2) + 4 * h + (j & 3)) * 512 + db * 32];
                u32x4 w; w.x = e[0] | ((unsigned)e[1] << 16); w.y = e[2] | ((unsigned)e[3] << 16); w.z = e[4] | ((unsigned)e[5] << 16); w.w = e[6] | ((unsigned)e[7] << 16);
                *(u32x4*)(vd + (db * 2 + s) * 512) = w; }
    }
}
DI float sigmoidf_(float x) { return __builtin_amdgcn_rcpf(1.0f + __builtin_amdgcn_exp2f(-x * LOG2E)); }
struct LinKA { const bf16* base; size_t tstride; DI const bf16* operator()(int t) const { return base + (size_t)t * tstride; } };
struct LinVA { const bf16* base; size_t dbstride; DI const bf16* operator()(int t, int db) const { return base + (size_t)db * dbstride + t * 32; } };
struct CmpMK { int tq, h; DI void operator()(int t, f32x16& S) const {
#pragma unroll
    for (int i = 0; i < 16; ++i) { const int n = 32 * t + crow(i, h); S[i] = (16 * n + 31 <= tq) ? S[i] : -INFINITY; } } };
struct WinMK { int tq, h; DI void operator()(int t, f32x16& S) const {
#pragma unroll
    for (int i = 0; i < 16; ++i) { const int k = 32 * t + crow(i, h); S[i] = (k <= tq && k > tq - 512) ? S[i] : -INFINITY; } } };
DI void ph_nsa_cmp(const Frame& F, const int dry = 0) {
    unsigned char* ar = F.ws + WS_AR; const bf16* Q = (const bf16*)(ar + NA_Q); const bf16* KCMP = (const bf16*)(ar + NA_KCMP); const bf16* VCT = (const bf16*)(ar + NA_VCT); const bf16* GT = (const bf16*)(ar + NA_GT);
    unsigned char* SELB = ar + NA_SELB; bf16* Ob = (bf16*)(ar + NA_O);
    LAS float* imp = (LAS float*)F.lds;
    LAS unsigned char* tl = F.lds + 20480;
    const int lane = F.lane, r = lane & 31, h = lane >> 5, tid = F.tid;
    for (int u = blockIdx.x; u < BPH * 4 * 64; u += F.G) {
        const int bg = u >> 6, qt64 = u & 63, bl = bg >> 2, g = bg & 3;
        for (int i = F.tid; i < 64 * 65; i += NWAVES * 64) imp[i] = 0.f;
        __syncthreads();
        const FragSrc src{KCMP + (size_t)bg * 8 * 12 * 512, VCT + (size_t)bg * 8 * 8 * 512, 12};
        const int tqmaxb = qt64 * 64 + 63, TE = (tqmaxb >= 31) ? ((tqmaxb - 31) / 16) / 32 + 1 : 0;
#pragma unroll 1
        for (int k = 0; k < 3; ++k) {
            const int idx = F.wave * 3 + k, j = idx >> 1, sub = idx & 1, ql = sub * 32 + r, tq = qt64 * 64 + ql, hd = g * 12 + j;
            const size_t mrow = (size_t)bl * SEQ + tq;
            bf16x8 qf[12];
#pragma unroll
            for (int s = 0; s < 12; ++s) qf[s] = *(const bf16x8*)(Q + mrow * 9216 + hd * 192 + 16 * s + 8 * h);
            const int tqmax = qt64 * 64 + sub * 32 + 31, te = (tqmax >= 31) ? ((tqmax - 31) / 16) / 32 + 1 : 0;
            const CmpMK mk{tq, h};
            f32x16 O[4];
#pragma unroll
            for (int db = 0; db < 4; ++db)
#pragma unroll
                for (int i = 0; i < 16; ++i) O[db][i] = 0.f;
            float m = -INFINITY, l = 0.f;
            attn_run_sh<12, false>(tl, tid, lane, qf, O, m, l, 0, TE, 0, te, src, mk);
            l += __shfl_xor(l, 32);
            const float linv = l > 0.f ? 1.0f / l : 0.f, ms = (m == -INFINITY) ? 0.f : m;
            if (TE > 0) {
                TilePre<12> pre;
                tile_fetch<12>(pre, src, 0, tid); tile_put<12>(pre, tl, tid);
                LDS_WAIT(); __builtin_amdgcn_s_barrier(); asm volatile("" ::: "memory");
#pragma unroll 1
                for (int t = 0; t < TE; ++t) {
                    LAS unsigned char* cur = tl + (t & 1) * 20480;
                    if (t + 1 < TE) tile_fetch<12>(pre, src, t + 1, tid);
                    if (t < te) {
                        f32x16 S;
#pragma unroll
                        for (int i = 0; i < 16; ++i) S[i] = 0.f;
#pragma unroll
                        for (int s = 0; s < 12; ++s) S = MFMA32(*(const LAS bf16x8*)(cur + s * 1024 + lane * 16), qf[s], S);
                        mk(t, S);
#pragma unroll
                        for (int i = 0; i < 16; ++i) S[i] = __builtin_amdgcn_exp2f(S[i] - ms) * linv;
#pragma unroll
                        for (int g4 = 0; g4 < 4; ++g4) { const float gs = (S[4 * g4] + S[4 * g4 + 1]) + (S[4 * g4 + 2] + S[4 * g4 + 3]); const int mb = 8 * t + 2 * g4 + h;
                            __hip_atomic_fetch_add(imp + ql * 65 + mb, gs, __ATOMIC_RELAXED, __HIP_MEMORY_SCOPE_WORKGROUP);
                            if (mb + 1 < 64) __hip_atomic_fetch_add(imp + ql * 65 + mb + 1, S[4 * g4 + 3], __ATOMIC_RELAXED, __HIP_MEMORY_SCOPE_WORKGROUP); }
                        bf16x8 pf[2];
#pragma unroll
                        for (int s = 0; s < 2; ++s) { u32x4 w; w.x = pk2(S[8 * s], S[8 * s + 1]); w.y = pk2(S[8 * s + 2], S[8 * s + 3]); w.z = pk2(S[8 * s + 4], S[8 * s + 5]); w.w = pk2(S[8 * s + 6], S[8 * s + 7]); pf[s] = __builtin_bit_cast(bf16x8, w); }
#pragma unroll
                        for (int db = 0; db < 4; ++db)
#pragma unroll
                            for (int s = 0; s < 2; ++s) O[db] = MFMA32(*(const LAS bf16x8*)(cur + (12 + db * 2 + s) * 1024 + lane * 16), pf[s], O[db]);
                    }
                    if (t + 1 < TE) tile_put<12>(pre, tl + ((t + 1) & 1) * 20480, tid);
                    LDS_WAIT(); __builtin_amdgcn_s_barrier(); asm volatile("" ::: "memory");
                }
            }
            const float gate = sigmoidf_(bf2f(GT[mrow * 256 + hd]));
            store_col<false>(dry ? (bf16*)(ar + DUMMY_OFF) + ((size_t)F.gw * 32 + r) * 128 : Ob + mrow * 6144 + hd * 128, O, gate, h);
        }
        __syncthreads();
#pragma unroll 1
        for (int k = 0; k < 8; ++k) {
            const int ql = F.wave * 8 + k, tq = qt64 * 64 + ql, cur = tq >> 6, mb = lane;
            const bool causal = mb <= cur, forced = (mb == 0) || (mb == cur) || (mb == cur - 1);
            const float v = causal ? (forced ? INFINITY : imp[ql * 65 + mb]) : -INFINITY;
            int rank = 0;
            for (int o = 0; o < 64; ++o) { const float vo = __shfl(v, o); rank += (vo > v || (vo == v && o < mb)) ? 1 : 0; }
            if (rank < 16) (dry ? ar + DUMMY_OFF + 32 * MiB + (size_t)F.gw * 16 : SELB + ((size_t)bg * 4096 + tq) * 16)[rank] = causal ? (unsigned char)mb : (unsigned char)0xFF;
        }
        __syncthreads();
    }
}
DI int sel_tile(const u32x4& sel, int t) { const int b = t >> 1; const unsigned w = (b < 4) ? sel.x : (b < 8) ? sel.y : (b < 12) ? sel.z : sel.w; return (int)((w >> ((b & 3) * 8)) & 0xFFu) * 2 + (t & 1); }
struct SelKA { const bf16* base; u32x4 sel; DI const bf16* operator()(int t) const { return base + (size_t)sel_tile(sel, t) * 12 * 512; } };
struct SelVA { const bf16* base; u32x4 sel; DI const bf16* operator()(int t, int db) const { return base + ((size_t)sel_tile(sel, t) * 8 + db * 2) * 512; } };
struct SelMK { u32x4 sel; int tq, h; DI void operator()(int t, f32x16& S) const { const int k0 = sel_tile(sel, t) * 32;
#pragma unroll
    for (int i = 0; i < 16; ++i) S[i] = (k0 + crow(i, h) <= tq) ? S[i] : -INFINITY; } };
DI void ph_nsa_sel(const Frame& F, const int dry = 0) {
    unsigned char* ar = F.ws + WS_AR; const bf16* Q = (const bf16*)(ar + NA_Q); const bf16* KSF = (const bf16*)(ar + NA_KSF); const bf16* VSF = (const bf16*)(ar + NA_VSF); const bf16* GT = (const bf16*)(ar + NA_GT);
    const unsigned char* SELB = ar + NA_SELB; bf16* Ob = (bf16*)(ar + NA_O);
    const int r = F.lane & 31, h = F.lane >> 5; const bool act = r < 12;
    LAS unsigned char* qlds = F.lds + F.wave * 12288 + F.lane * 16;
    for (int it = F.gw; it < BPH * 4 * SEQ; it += F.NGW) {
        const int bg = it >> 12, tq = it & 4095, bl = bg >> 2, g = bg & 3; const size_t mrow = (size_t)bl * SEQ + tq; const int hd = g * 12 + (act ? r : 0);
        bf16x8 qf[12];
#pragma unroll
        for (int s = 0; s < 12; ++s) { qf[s] = *(const bf16x8*)(Q + mrow * 9216 + hd * 192 + 16 * s + 8 * h); if (!act) qf[s] = (bf16x8){0, 0, 0, 0, 0, 0, 0, 0}; *(LAS bf16x8*)(qlds + s * 1024) = qf[s]; }
        LDS_WAIT();
        const u32x4 sel = *(const u32x4*)(SELB + (size_t)it * 16);
        const int nv = ((tq >> 6) + 1 < 16) ? (tq >> 6) + 1 : 16;
        const SelKA ka{KSF + ((size_t)bg * 128 * 12 * 64 + F.lane) * 8, sel}; const SelVA va{VSF + ((size_t)bg * 128 * 8 * 64 + F.lane) * 8, sel}; const SelMK mk{sel, tq, h};
        f32x16 O[4];
#pragma unroll
        for (int db = 0; db < 4; ++db)
#pragma unroll
            for (int i = 0; i < 16; ++i) O[db][i] = 0.f;
        float m = -INFINITY, l = 0.f;
        attn_run<12, 4, true, true, true>(qf, qlds, O, m, l, 0, 2 * nv, ka, va, mk);
        l += __shfl_xor(l, 32);
        if (act) { const float gate = sigmoidf_(bf2f(GT[mrow * 256 + 48 + hd])); store_col<true>(dry ? (bf16*)(ar + DUMMY_OFF) + ((size_t)F.gw * 32 + r) * 128 : Ob + mrow * 6144 + hd * 128, O, l > 0.f ? gate / l : 0.f, h); }
    }
}
DI void ph_nsa_win(const Frame& F, const int dry = 0) {
    unsigned char* ar = F.ws + WS_AR; const bf16* Q = (const bf16*)(ar + NA_Q); const bf16* KWF = (const bf16*)(ar + NA_KWF); const bf16* VWF = (const bf16*)(ar + NA_VWF); const bf16* GT = (const bf16*)(ar + NA_GT); bf16* Ob = (bf16*)(ar + NA_O);
    const int r = F.lane & 31, h = F.lane >> 5;
    for (int idb = blockIdx.x; idb < BPH * 48 * 16; idb += F.G) {
        const int qt0 = (idb & 15) * 8, qt = qt0 + F.wave, bh = idb >> 4, hd = bh % 48, bl = bh / 48, g = hd / 12, bg = bl * 4 + g, tq = qt * 32 + r; const size_t mrow = (size_t)bl * SEQ + tq;
        bf16x8 qf[12];
#pragma unroll
        for (int s = 0; s < 12; ++s) qf[s] = *(const bf16x8*)(Q + mrow * 9216 + hd * 192 + 16 * s + 8 * h);
        const FragSrc src{KWF + (size_t)bg * 128 * 12 * 512, VWF + (size_t)bg * 128 * 8 * 512, 12}; const WinMK mk{tq, h};
        f32x16 O[4];
#pragma unroll
        for (int db = 0; db < 4; ++db)
#pragma unroll
            for (int i = 0; i < 16; ++i) O[db][i] = 0.f;
        float m = -INFINITY, l = 0.f;
        attn_run_sh<12, true>(F.lds, F.tid, F.lane, qf, O, m, l, qt0 >= 16 ? qt0 - 16 : 0, qt0 + 8, qt >= 16 ? qt - 16 : 0, qt + 1, src, mk);
        l += __shfl_xor(l, 32);
        const float gate = sigmoidf_(bf2f(GT[mrow * 256 + 96 + hd]));
        store_col<true>(dry ? (bf16*)(ar + DUMMY_OFF) + ((size_t)F.gw * 32 + r) * 128 : Ob + mrow * 6144 + hd * 128, O, l > 0.f ? gate / l : 0.f, h);
    }
}
#ifndef MK_ONE_LAUNCH
#define MK_ONE_LAUNCH 1
#endif
constexpr int NPH = 98;
struct Args { const float* in[58]; float* out; unsigned char* ws; int ph_lo, ph_hi; };
#ifndef PROBE_GEMM
#define PROBE_GEMM 0
#endif
#ifndef PROBE_PH
#define PROBE_PH 0
#endif
#define GEMM_CALL(EpiT, Evar, Aptr, Bptr, Mv, Nv, Kv, ldav, ldbv, cidx) do { if (PROBE_GEMM) { const pg8::Gemm g0_{(const pg8::bf16_t*)(Aptr), (const pg8::bf16_t*)(Bptr), (Mv), (Nv), (Kv), (ldav), (ldbv)}; \
    pg8::StaticOrder S0_; S0_.init((Mv), (Nv), F.G, (cidx)); pg8::EpiDry E0_{(float*)(ar + DUMMY_OFF)}; pg8::gemm_phase<pg8::EpiDry, pg8::StaticOrder, true, true>((PG8_LAS unsigned char*)F.lds, g0_, S0_, E0_); __syncthreads(); } \
    const pg8::Gemm g_{(const pg8::bf16_t*)(Aptr), (const pg8::bf16_t*)(Bptr), (Mv), (Nv), (Kv), (ldav), (ldbv)}; \
    pg8::StaticOrder S_; S_.init((Mv), (Nv), F.G, (cidx)); pg8::gemm_phase<EpiT, pg8::StaticOrder, true, true>((PG8_LAS unsigned char*)F.lds, g_, S_, Evar); } while (0)
DI pg8::EpiBf16R epi1(bf16* base, int ldc) { pg8::EpiBf16R e; for (int s = 0; s < 8; ++s) { e.T.base[s] = base; e.T.ldc[s] = ldc; e.T.t0[s] = 0; e.T.gw[s] = 0; } e.T.nseg = 1; e.T.pad_ = 0; return e; }
#define PH_BEGIN if (ph >= lo && ph < hi) { Frame F; { unsigned long long w_ = (unsigned long long)args.ws; asm volatile("" : "+s"(w_)); F.ws = (unsigned char*)w_; F.ctl = (unsigned*)(F.ws + WS_CTL); } \
    F.lds = lds; F.tid = threadIdx.x; F.lane = F.tid & 63; F.wave = __builtin_amdgcn_readfirstlane(F.tid >> 6); F.G = gridDim.x; F.gw = blockIdx.x * NWAVES + F.wave; F.NGW = F.G * NWAVES; \
    float* out; { unsigned long long o_ = (unsigned long long)args.out; asm volatile("" : "+s"(o_)); out = (float*)o_; } \
    unsigned char* const ar = F.ws + WS_AR; bf16* const XN = (bf16*)(F.ws + WS_XN); bf16* const WB = (bf16*)(F.ws + WS_WMIX); bf16* const WUP = (bf16*)(F.ws + WS_WFFN); bf16* const WDN = WUP + (size_t)2 * DFF * DM; \
    const float* const res_mix = (ib == 2) ? args.in[0] : (const float*)out; (void)ar; (void)XN; (void)WB; (void)WUP; (void)WDN; (void)res_mix; (void)iff;
#define PH_END   if (ph + 1 < hi) { XcdBarrier b_; b_.bar = (unsigned*)F.ctl + CW_BAR; b_.x = xb_xcc_id(); b_.st = MISC + 8; xcd_barrier(b_); } } ++ph;
template <int LAYER> DI void run_cvt(const Args& args, LAS unsigned char* lds, volatile LAS unsigned* MISC, int& ph, const int lo, const int hi) {
    constexpr int ib = (LAYER == 0) ? 2 : (LAYER == 1) ? 17 : (LAYER == 2) ? 26 : 42;
    constexpr int iff = (LAYER == 0) ? 12 : (LAYER == 1) ? 21 : (LAYER == 2) ? 37 : 52;
    constexpr int kind = (LAYER == 1) ? 1 : (LAYER == 2) ? 2 : 0;
        PH_BEGIN
            if constexpr (kind == 0) ph_dsa_cvt(F, args.in[ib + 1], args.in[ib + 6], args.in[ib + 7], args.in[ib + 8], args.in[ib + 9]);
            else if constexpr (kind == 1) ph_fox_cvt(F, args.in[ib + 1], args.in[ib + 3]);
            else ph_nsa_cvt(F, args.in[ib + 1], args.in[ib + 2], args.in[ib + 3], args.in[ib + 4], args.in[ib + 5], args.in[ib + 6], args.in[ib + 7], args.in[ib + 8], args.in[ib + 9], args.in[ib + 10]);
            ph_cvt_ffn(F, args.in[iff + 1], args.in[iff + 4]);
        PH_END
}
template <int LAYER, int HALF> DI void run_half(const Args& args, LAS unsigned char* lds, volatile LAS unsigned* MISC, int& ph, const int lo, const int hi) {
    constexpr int ib = (LAYER == 0) ? 2 : (LAYER == 1) ? 17 : (LAYER == 2) ? 26 : 42;
    constexpr int iff = (LAYER == 0) ? 12 : (LAYER == 1) ? 21 : (LAYER == 2) ? 37 : 52;
    constexpr int kind = (LAYER == 1) ? 1 : (LAYER == 2) ? 2 : 0;
    constexpr int half = HALF;
            const int roff = half * MC;
            PH_BEGIN ph_rmsnorm(F, res_mix, roff, args.in[ib], XN); PH_END
            if constexpr (kind == 0) {
                PH_BEGIN { pg8::EpiF32 E{(float*)(ar + DA_DIN), 1024}; GEMM_CALL(pg8::EpiF32, E, XN, WB + DW_W1, MC, 1024, DM, DM, DM, (int)blockIdx.x); } PH_END
                PH_BEGIN ph_dsa_post1(F, half, args.in[ib + 2], args.in[ib + 3], args.in[ib + 4], args.in[ib + 5]); PH_END
                PH_BEGIN { pg8::EpiBf16R E = epi1((bf16*)(ar + DA_QL), 8192); E.T.base[1] = (bf16*)(ar + DA_QPE); E.T.ldc[1] = 1536; E.T.t0[1] = 32; E.T.base[2] = (bf16*)(ar + DA_QIDX); E.T.ldc[2] = 2048; E.T.t0[2] = 38; E.T.nseg = 3;
                    GEMM_CALL(pg8::EpiBf16R, E, ar + DA_CQN, WB + DW_W2, MC, 11776, 512, 512, 512, (int)blockIdx.x); } PH_END
                PH_BEGIN ph_dsa_rope(F, half); PH_END
                PH_BEGIN if (PROBE_PH == 1) { ph_dsa_index(F, 1); __syncthreads(); } ph_dsa_index(F); PH_END
                PH_BEGIN if (PROBE_PH == 2) { ph_dsa_attn(F, 1); __syncthreads(); } ph_dsa_attn(F); PH_END
                PH_BEGIN { pg8::EpiRes E{res_mix, out, DM, roff}; GEMM_CALL(pg8::EpiRes, E, ar + DA_QL, WB + DW_WO, MC, DM, 8192, 8192, 8192, (int)blockIdx.x); } PH_END
            } else if constexpr (kind == 1) {
                PH_BEGIN { pg8::EpiBf16R E = epi1((bf16*)(ar + FA_Q), DM); E.T.base[1] = (bf16*)(ar + FA_K); E.T.ldc[1] = DM; E.T.t0[1] = 8; E.T.base[2] = (bf16*)(ar + FA_V); E.T.ldc[2] = DM; E.T.t0[2] = 16;
                    E.T.base[3] = (bf16*)(ar + FA_F); E.T.ldc[3] = 256; E.T.t0[3] = 24; E.T.nseg = 4;
                    GEMM_CALL(pg8::EpiBf16R, E, XN, WB + FW_IN, MC, 6400, DM, DM, DM, (int)blockIdx.x); } PH_END
                PH_BEGIN ph_fox_scan(F, args.in[ib + 2]); PH_END
                PH_BEGIN if (PROBE_PH == 3) { ph_fox_attn(F, 1); __syncthreads(); } ph_fox_attn(F); PH_END
                PH_BEGIN { pg8::EpiRes E{res_mix, out, DM, roff}; GEMM_CALL(pg8::EpiRes, E, ar + FA_O, WB + FW_OUT, MC, DM, DM, DM, DM, (int)blockIdx.x); } PH_END
            } else {
                PH_BEGIN { pg8::EpiBf16R E = epi1((bf16*)(ar + NA_Q), 9216);
                    E.T.base[1] = (bf16*)(ar + NA_KC); E.T.ldc[1] = 192; E.T.t0[1] = 36; E.T.gw[1] = 192;
                    E.T.base[2] = (bf16*)(ar + NA_VC); E.T.ldc[2] = 128; E.T.t0[2] = 39; E.T.gw[2] = 128;
                    E.T.base[3] = (bf16*)(ar + NA_KSR); E.T.ldc[3] = 768; E.T.t0[3] = 41;
                    E.T.base[4] = (bf16*)(ar + NA_KWR); E.T.ldc[4] = 768; E.T.t0[4] = 44;
                    E.T.base[5] = (bf16*)(ar + NA_GT); E.T.ldc[5] = 256; E.T.t0[5] = 47;
                    E.T.base[6] = (bf16*)(ar + NA_VSR); E.T.ldc[6] = 512; E.T.t0[6] = 48;
                    E.T.base[7] = (bf16*)(ar + NA_VWR); E.T.ldc[7] = 512; E.T.t0[7] = 50; E.T.nseg = 8;
                    GEMM_CALL(pg8::EpiBf16R, E, XN, WB + NW_IN, MC, 13312, DM, DM, DM, (int)blockIdx.x); } PH_END
                PH_BEGIN ph_nsa_rope(F, half); PH_END
                PH_BEGIN {
                    const float* BIAS = (const float*)(args.ws + WS_MISC);
                    { pg8::EpiGelu E{(bf16*)(ar + NA_GK), 256, BIAS}; GEMM_CALL(pg8::EpiGelu, E, ar + NA_KC, WB + NW_W1K, 4096, 256, 6144, 3072, 6144, (int)blockIdx.x); }
                    { pg8::EpiGelu E{(bf16*)(ar + NA_GV), 256, BIAS + 256}; GEMM_CALL(pg8::EpiGelu, E, ar + NA_VC, WB + NW_W1V, 4096, 256, 4096, 2048, 4096, (int)((blockIdx.x + F.G - 16) % F.G)); }
                } PH_END
                PH_BEGIN {
                    { pg8::EpiBf16R E = epi1((bf16*)(ar + NA_KCMP), 12); E.T.gw[0] = -1; GEMM_CALL(pg8::EpiBf16R, E, ar + NA_GK, WB + NW_W2K, 4096, 256, 256, 256, 256, (int)blockIdx.x); }
                    { pg8::EpiBf16R E = epi1((bf16*)(ar + NA_VCT), 4); E.T.gw[0] = -2; GEMM_CALL(pg8::EpiBf16R, E, WB + NW_W2V, ar + NA_GV, 256, 4096, 256, 256, 256, (int)((blockIdx.x + F.G - 16) % F.G)); }
                } PH_END
                PH_BEGIN if (PROBE_PH == 4) { ph_nsa_cmp(F, 1); __syncthreads(); } ph_nsa_cmp(F); PH_END
                PH_BEGIN if (PROBE_PH == 5) { ph_nsa_sel(F, 1); __syncthreads(); } ph_nsa_sel(F); PH_END
                PH_BEGIN if (PROBE_PH == 6) { ph_nsa_win(F, 1); __syncthreads(); } ph_nsa_win(F); PH_END
                PH_BEGIN { pg8::EpiRes E{res_mix, out, DM, roff}; GEMM_CALL(pg8::EpiRes, E, ar + NA_O, WB + NW_OUT, MC, DM, 6144, 6144, 6144, (int)blockIdx.x); } PH_END
            }
            PH_BEGIN ph_rmsnorm(F, out, roff, args.in[iff], XN); PH_END
            PH_BEGIN { pg8::EpiConvGlu E{(pg8::bf16_t*)ar, (float*)(ar + 352 * MiB), args.in[iff + 2], args.in[iff + 3], (PG8_LAS float*)(F.lds + LDSCTL_OFF + 256), DFF};
                GEMM_CALL(pg8::EpiConvGlu, E, XN, WUP, MC, 2 * DFF, DM, DM, DM, (int)blockIdx.x); } PH_END
            PH_BEGIN ph_conv_fix(F, (const float*)(ar + 352 * MiB), (bf16*)ar, args.in[iff + 2], args.in[iff + 3]); PH_END
            PH_BEGIN { pg8::EpiRes E{out, out, DM, roff}; GEMM_CALL(pg8::EpiRes, E, ar, WDN, MC, DM, DFF, DFF, DFF, (int)blockIdx.x); } PH_END
}
__global__ void __launch_bounds__(NWAVES * 64, 2) mk_fwd(Args args) {
    extern __shared__ __attribute__((aligned(16))) unsigned char lds_[];
    LAS unsigned char* const lds = (LAS unsigned char*)lds_;
    volatile LAS unsigned* MISC = (volatile LAS unsigned*)(lds + LDSCTL_OFF);
    for (int u = threadIdx.x; u < 64; u += NWAVES * 64) ((LAS unsigned*)(lds + LDSCTL_OFF))[u] = 0u;
    __syncthreads();
    const int lo = args.ph_lo, hi = args.ph_hi;
    (void)xcd_barrier_post((unsigned*)(args.ws + WS_CTL) + CW_BAR, MISC + 8);
    int ph = 0;
    { constexpr int ib = 2, iff = 12; PH_BEGIN ph_tables(F, (const int*)args.in[1]); PH_END }
    run_cvt<0>(args, lds, MISC, ph, lo, hi); run_half<0, 0>(args, lds, MISC, ph, lo, hi); run_half<0, 1>(args, lds, MISC, ph, lo, hi);
    run_cvt<1>(args, lds, MISC, ph, lo, hi); run_half<1, 0>(args, lds, MISC, ph, lo, hi); run_half<1, 1>(args, lds, MISC, ph, lo, hi);
    run_cvt<2>(args, lds, MISC, ph, lo, hi); run_half<2, 0>(args, lds, MISC, ph, lo, hi); run_half<2, 1>(args, lds, MISC, ph, lo, hi);
    run_cvt<3>(args, lds, MISC, ph, lo, hi); run_half<3, 0>(args, lds, MISC, ph, lo, hi); run_half<3, 1>(args, lds, MISC, ph, lo, hi);
    { constexpr int ib = 42, iff = 52; PH_BEGIN ph_final_norm(F, out, args.in[57]); PH_END }
}
extern "C" void kernel_launch(void* const* d_in, const int* in_sizes, int n_in, void* d_out, int out_size, void* d_ws, size_t ws_size, hipStream_t stream) {
    static int grid = 0;
    if (grid == 0) {
        if (n_in != 58 || out_size != MTOT * DM || ws_size < WS_END) { fprintf(stderr, "kernel_launch: unexpected shapes (n_in %d, out %d, ws %zu)\n", n_in, out_size, ws_size); grid = -1; return; }
        int dev = 0, cus = 0;
        if (hipGetDevice(&dev) != hipSuccess || hipDeviceGetAttribute(&cus, hipDeviceAttributeMultiprocessorCount, dev) != hipSuccess) { grid = -1; return; }
        if (hipFuncSetAttribute((const void*)mk_fwd, hipFuncAttributeMaxDynamicSharedMemorySize, LDS_BYTES) != hipSuccess) { fprintf(stderr, "kernel_launch: hipFuncSetAttribute failed\n"); grid = -1; return; }
        int per_cu = 0;
        (void)hipOccupancyMaxActiveBlocksPerMultiprocessor(&per_cu, (const void*)mk_fwd, NWAVES * 64, LDS_BYTES);
        (void)hipGetLastError();
        grid = cus;
    }
    if (grid < 0) return;
    if (hipMemsetAsync((char*)d_ws + WS_CTL, 0, CTL_ZERO_BYTES, stream) != hipSuccess) return;
    Args a{};
    for (int i = 0; i < 58; ++i) a.in[i] = (const float*)d_in[i];
    a.out = (float*)d_out; a.ws = (unsigned char*)d_ws;
#if MK_ONE_LAUNCH
    a.ph_lo = 0; a.ph_hi = NPH;
    hipLaunchKernelGGL(mk_fwd, dim3(grid), dim3(NWAVES * 64), LDS_BYTES, stream, a);
#else
    for (int p = 0; p < NPH; ++p) { a.ph_lo = p; a.ph_hi = p + 1; hipLaunchKernelGGL(mk_fwd, dim3(grid), dim3(NWAVES * 64), LDS_BYTES, stream, a); }
#endif
}
```

```cpp
#include <hip/hip_runtime.h>
#include <cstdio>
#include <cstdint>
#define DI __device__ __forceinline__
namespace pg8 {
#define PG8_LAS __attribute__((address_space(3)))
typedef unsigned short bf16_t;
typedef short bf16x8 __attribute__((ext_vector_type(8)));
typedef float f32x4 __attribute__((ext_vector_type(4)));
typedef unsigned u32x4 __attribute__((ext_vector_type(4)));
constexpr int BM = 256, BK = 64, HALF = 128, HTB = HALF * BK * 2  , STAGE_BYTES = 8 * HTB, NXCD = 8, WGM = 8;

__host__ __device__ __forceinline__ int lds_byte(int r, int c) { const int st = (r >> 4) * 2 + (c >> 5), rr = r & 15, cc = c & 31, ob = rr * 64 + cc * 2; return st * 1024 + (ob ^ (((ob >> 9) & 1) << 5)); }
__host__ __device__ __forceinline__ void stage_rc(int b, int& R, int& C) { const int st = b / 1024, sb = b % 1024, swz = sb ^ (((sb >> 9) & 1) << 5); R = (st >> 1) * 16 + swz / 64; C = (st & 1) * 32 + (swz % 64) / 2; }
__host__ __device__ __forceinline__ int perm32(int rho) { const int n = rho >> 4, i = rho & 15; return 8 * (i >> 2) + 4 * n + (i & 3); }

struct Unit { int pm, pn; };
struct Gemm { const bf16_t* A; const bf16_t* Bt; int M, N, K, lda, ldb, akoff; };

struct StaticOrder {
    int nM, nN, nwg, G, c;
    __host__ __device__ void init(int M, int N, int G_, int c_) { nM = M / BM; nN = N / BM; nwg = nM * nN; G = G_; c = c_; }
    __host__ __device__ bool next(int i, Unit& u) const {
        const long L = (long)i * G + c; if (L >= nwg) return false;
        int wgid = (int)L; { const int q = nwg / NXCD, r = nwg % NXCD, xcd = wgid % NXCD, off = wgid / NXCD; wgid = (xcd < r ? xcd * (q + 1) : r * (q + 1) + (xcd - r) * q) + off; }
        const int nig = WGM * nN, gid = wgid / nig, fm = gid * WGM, gsz = (nM - fm) < WGM ? (nM - fm) : WGM;
        u.pm = fm + ((wgid % nig) % gsz); u.pn = (wgid % nig) / gsz; return true;
    }
    __device__ __forceinline__ void a_ready(const Unit&) const {}
    __device__ __forceinline__ void done(const Unit&) const {}
};
__device__ __forceinline__ unsigned cvt_pk_bf16(float lo, float hi) { unsigned r; asm volatile("v_cvt_pk_bf16_f32 %0, %1, %2" : "=v"(r) : "v"(lo), "v"(hi)); return r; }
template <class Epi, class Sched, bool ALIGN_EPI = false, bool SP2 = false>
__device__ __forceinline__ void gemm_phase(PG8_LAS unsigned char* lds, const Gemm g, const Sched& S, const Epi& E) {
    const int tid = threadIdx.x, wid = __builtin_amdgcn_readfirstlane(tid >> 6), lane = tid & 63, wr = wid >> 2, wc = wid & 3, fr = lane & 15, fq = lane >> 4;
    const int K = g.K, nt = K / BK;
    unsigned voffA[2], voffB[2];
#pragma unroll
    for (int i = 0; i < 2; ++i) { int R, C; stage_rc(tid * 16 + i * 8192, R, C); const int Rb = Epi::PERM ? ((R & ~31) + perm32(R & 31)) : R;
        voffA[i] = (unsigned)(R * g.lda + C) * 2u; voffB[i] = (unsigned)(Rb * g.ldb + C) * 2u; }
    const size_t kstep = (size_t)(BK * 2);
    const size_t hstepA = (size_t)HALF * g.lda * 2, hstepB = (size_t)HALF * g.ldb * 2;
    const size_t tstepA = 2 * hstepA, tstepB = 2 * hstepB;
    const unsigned ldsw = (unsigned)wid * 1024u;
    const int aoff = lds_byte(wr * 64 + fr, fq * 8), boff = lds_byte(wc * 32 + fr, fq * 8);
#define PG8_SA(b, h) (((b) * 2 + (h)) * HTB)
#define PG8_SB(b, h) ((4 + (b) * 2 + (h)) * HTB)
#define PG8_STAGE(bufoff, gbase, voff) do { _Pragma("unroll") for (int _i = 0; _i < 2; ++_i) \
        __builtin_amdgcn_global_load_lds((const unsigned*)((const char*)(gbase) + (voff)[_i]), (PG8_LAS unsigned*)(lds + (bufoff) + ldsw + _i * 8192), 16, 0, 0); } while (0)
#define PG8_LDA(dst, b, h) do { _Pragma("unroll") for (int m = 0; m < 4; ++m) _Pragma("unroll") for (int k = 0; k < 2; ++k) dst[m][k] = *(const PG8_LAS bf16x8*)(lds + PG8_SA(b, h) + aoff + m * 2048 + k * 1024); } while (0)
#define PG8_LDB(dst, b, h) do { _Pragma("unroll") for (int n = 0; n < 2; ++n) _Pragma("unroll") for (int k = 0; k < 2; ++k) dst[n][k] = *(const PG8_LAS bf16x8*)(lds + PG8_SB(b, h) + boff + n * 2048 + k * 1024); } while (0)
#define PG8_MMA(ai, bj, At, Bt) do { __builtin_amdgcn_s_setprio(1); _Pragma("unroll") for (int m = 0; m < 4; ++m) _Pragma("unroll") for (int n = 0; n < 2; ++n) _Pragma("unroll") for (int k = 0; k < 2; ++k) \
        acc[ai][bj][m][n] = __builtin_amdgcn_mfma_f32_16x16x32_bf16(Bt[n][k], At[m][k], acc[ai][bj][m][n], 0, 0, 0); __builtin_amdgcn_s_setprio(0); } while (0)
#define PG8_WAIT_V(n) asm volatile("s_waitcnt vmcnt(" #n ")" ::: "memory")
#define PG8_WAIT_L(n) asm volatile("s_waitcnt lgkmcnt(" #n ")" ::: "memory")
#define PG8_BAR __builtin_amdgcn_s_barrier()
#define PG8_SCHED __builtin_amdgcn_sched_barrier(0)
    Unit cur, nxt; int ui = 0;
    if (!S.next(0, cur)) return;
    f32x4 acc[2][2][4][2];
#pragma unroll
    for (int a = 0; a < 2; ++a)
#pragma unroll
        for (int b = 0; b < 2; ++b)
#pragma unroll
            for (int m = 0; m < 4; ++m)
#pragma unroll
                for (int n = 0; n < 2; ++n) acc[a][b][m][n] = (f32x4){0.f, 0.f, 0.f, 0.f};
    bf16x8 At[4][2], B0[2][2], B1[2][2];
    const char* cA = (const char*)g.A + (size_t)cur.pm * tstepA + (size_t)cur.pn * g.akoff * 2; const char* cB = (const char*)g.Bt + (size_t)cur.pn * tstepB;
    S.a_ready(cur);
    if constexpr (SP2) {
        PG8_STAGE(PG8_SB(0, 0), cB, voffB); PG8_STAGE(PG8_SB(0, 1), cB + hstepB, voffB); PG8_STAGE(PG8_SA(0, 0), cA, voffA); PG8_STAGE(PG8_SA(0, 1), cA + hstepA, voffA);
        if (wr == 1) PG8_BAR;
        PG8_WAIT_V(2); PG8_BAR;
        PG8_STAGE(PG8_SB(1, 0), cB + kstep, voffB); PG8_STAGE(PG8_SA(1, 0), cA + kstep, voffA); PG8_STAGE(PG8_SB(1, 1), cB + hstepB + kstep, voffB);
        PG8_WAIT_V(6); PG8_BAR;
    } else {
        PG8_STAGE(PG8_SB(0, 0), cB, voffB); PG8_STAGE(PG8_SA(0, 0), cA, voffA); PG8_STAGE(PG8_SB(0, 1), cB + hstepB, voffB); PG8_STAGE(PG8_SA(0, 1), cA + hstepA, voffA);
        if (wr == 1) PG8_BAR;
        PG8_WAIT_V(4); PG8_BAR;
        PG8_STAGE(PG8_SB(1, 0), cB + kstep, voffB); PG8_STAGE(PG8_SA(1, 0), cA + kstep, voffA); PG8_STAGE(PG8_SB(1, 1), cB + hstepB + kstep, voffB);
        PG8_WAIT_V(6); PG8_BAR;
    }
    for (;;) {
        const bool has_next = S.next(ui + 1, nxt);
        const char* nA = has_next ? (const char*)g.A + (size_t)nxt.pm * tstepA + (size_t)nxt.pn * g.akoff * 2 : cA; const char* nB = has_next ? (const char*)g.Bt + (size_t)nxt.pn * tstepB : cB;
        for (int t = 0; t < nt; t += 2) {
            const bool last = (t == nt - 2);
            const char* a1 = cA + (size_t)(t + 1) * kstep;
            const char* a2 = last ? nA : cA + (size_t)(t + 2) * kstep; const char* b2 = last ? nB : cB + (size_t)(t + 2) * kstep;
            const char* a3 = a2 + kstep; const char* b3 = b2 + kstep;
            if (last && has_next) S.a_ready(nxt);
            if constexpr (SP2) {
            PG8_LDB(B0, 0, 0); PG8_LDB(B1, 0, 1); PG8_SCHED; PG8_LDA(At, 0, 0); PG8_STAGE(PG8_SA(1, 1), a1 + hstepA, voffA);
            PG8_WAIT_V(8); PG8_WAIT_L(0); PG8_BAR; PG8_MMA(0, 0, At, B0); PG8_MMA(0, 1, At, B1); PG8_BAR; PG8_SCHED;
            PG8_LDA(At, 0, 1); PG8_STAGE(PG8_SB(0, 0), b2, voffB); PG8_STAGE(PG8_SB(0, 1), b2 + hstepB, voffB); PG8_STAGE(PG8_SA(0, 0), a2, voffA);
            PG8_WAIT_V(8); PG8_WAIT_L(0); PG8_BAR; PG8_MMA(1, 0, At, B0); PG8_MMA(1, 1, At, B1); PG8_BAR; PG8_SCHED;
            PG8_LDB(B0, 1, 0); PG8_LDB(B1, 1, 1); PG8_SCHED; PG8_LDA(At, 1, 0); PG8_STAGE(PG8_SA(0, 1), a2 + hstepA, voffA);
            PG8_WAIT_V(8); PG8_WAIT_L(0); PG8_BAR; PG8_MMA(0, 0, At, B0); PG8_MMA(0, 1, At, B1); PG8_BAR; PG8_SCHED;
            PG8_LDA(At, 1, 1); PG8_STAGE(PG8_SB(1, 0), b3, voffB); PG8_STAGE(PG8_SB(1, 1), b3 + hstepB, voffB); PG8_STAGE(PG8_SA(1, 0), a3, voffA);
            PG8_WAIT_V(8); PG8_WAIT_L(0); PG8_BAR; PG8_MMA(1, 0, At, B0); PG8_MMA(1, 1, At, B1); PG8_BAR; PG8_SCHED;
            } else {
            PG8_LDB(B0, 0, 0); PG8_SCHED; PG8_LDA(At, 0, 0); PG8_STAGE(PG8_SA(1, 1), a1 + hstepA, voffA);
            PG8_WAIT_L(8); PG8_BAR; PG8_WAIT_L(0); PG8_MMA(0, 0, At, B0); PG8_BAR; PG8_SCHED;
            PG8_LDB(B1, 0, 1); PG8_STAGE(PG8_SB(0, 0), b2, voffB);
            PG8_BAR; PG8_WAIT_L(0); PG8_MMA(0, 1, At, B1); PG8_BAR;
            PG8_LDA(At, 0, 1); PG8_STAGE(PG8_SA(0, 0), a2, voffA);
            PG8_BAR; PG8_WAIT_L(0); PG8_MMA(1, 0, At, B0); PG8_BAR; PG8_SCHED;
            PG8_STAGE(PG8_SB(0, 1), b2 + hstepB, voffB);
            PG8_WAIT_V(6); PG8_BAR; PG8_MMA(1, 1, At, B1); PG8_BAR;
            PG8_LDB(B0, 1, 0); PG8_SCHED; PG8_LDA(At, 1, 0); PG8_STAGE(PG8_SA(0, 1), a2 + hstepA, voffA);
            PG8_WAIT_L(8); PG8_BAR; PG8_WAIT_L(0); PG8_MMA(0, 0, At, B0); PG8_BAR; PG8_SCHED;
            PG8_LDB(B1, 1, 1); PG8_STAGE(PG8_SB(1, 0), b3, voffB);
            PG8_BAR; PG8_WAIT_L(0); PG8_MMA(0, 1, At, B1); PG8_BAR;
            PG8_LDA(At, 1, 1); PG8_STAGE(PG8_SA(1, 0), a3, voffA);
            PG8_BAR; PG8_WAIT_L(0); PG8_MMA(1, 0, At, B0); PG8_BAR; PG8_SCHED;
            PG8_STAGE(PG8_SB(1, 1), b3 + hstepB, voffB);
            PG8_WAIT_V(6); PG8_BAR; PG8_MMA(1, 1, At, B1); PG8_BAR;
            }
        }
        if constexpr (ALIGN_EPI) { if (wr == 0) PG8_BAR; }
        if constexpr (!Epi::AFTER_DRAIN) { E(acc, cur, wr, wc, fr, fq); S.done(cur); }
        if (!has_next) break;
#pragma unroll
        for (int a = 0; a < 2; ++a)
#pragma unroll
            for (int b = 0; b < 2; ++b)
#pragma unroll
                for (int m = 0; m < 4; ++m)
#pragma unroll
                    for (int n = 0; n < 2; ++n) acc[a][b][m][n] = (f32x4){0.f, 0.f, 0.f, 0.f};
        cur = nxt; cA = nA; cB = nB; ++ui;
        if constexpr (ALIGN_EPI) { if (wr == 1) PG8_BAR; }
    }
    PG8_WAIT_V(0);
    if constexpr (!ALIGN_EPI) { if (wr == 0) PG8_BAR; }
    PG8_BAR;
    if constexpr (Epi::AFTER_DRAIN) { E.fused(acc, cur, wr, wc, fr, fq, lds, wid, lane); S.done(cur); }
#undef PG8_SA
#undef PG8_SB
#undef PG8_STAGE
#undef PG8_LDA
#undef PG8_LDB
#undef PG8_MMA
#undef PG8_WAIT_V
#undef PG8_WAIT_L
#undef PG8_BAR
#undef PG8_SCHED
}
}
namespace pg8 {
typedef float f32x2 __attribute__((ext_vector_type(2)));
struct SegTab { bf16_t* base[8]; int ldc[8]; int t0[8]; int gw[8]; int nseg; int pad_; };
struct EpiBf16R {
    static constexpr bool PERM = true, AFTER_DRAIN = false;
    SegTab T;
    __device__ __forceinline__ void operator()(const f32x4 (&acc)[2][2][4][2], const Unit& u, int wr, int wc, int fr, int fq) const {
        bf16_t* base = T.base[0]; int ldc = T.ldc[0], gw = T.gw[0], t0 = T.t0[0];
#pragma unroll
        for (int s = 1; s < 8; ++s) if (s < T.nseg && u.pn >= T.t0[s]) { base = T.base[s]; ldc = T.ldc[s]; gw = T.gw[s]; t0 = T.t0[s]; }
        const int colt = (u.pn - t0) * BM, row0 = u.pm * BM + wr * 64 + fr;
#pragma unroll
        for (int ai = 0; ai < 2; ++ai)
#pragma unroll
            for (int m = 0; m < 4; ++m) { const int row = row0 + ai * HALF + m * 16;
#pragma unroll
                for (int bj = 0; bj < 2; ++bj) { const int col = colt + bj * HALF + wc * 32 + 8 * fq;
                    const f32x4 v0 = acc[ai][bj][m][0], v1 = acc[ai][bj][m][1];
                    u32x4 w; w.x = cvt_pk_bf16(v0[0], v0[1]); w.y = cvt_pk_bf16(v0[2], v0[3]); w.z = cvt_pk_bf16(v1[0], v1[1]); w.w = cvt_pk_bf16(v1[2], v1[3]);
                    if (gw == -2) {
                        if ((row >> 5) < ldc) { bf16_t* d0 = base + ((size_t)(((col >> 5) * ldc + (row >> 5)) * 2 + ((col >> 4) & 1)) * 64 + (row & 31)) * 8 + 4 * ((col >> 3) & 1);
                            typedef unsigned u32x2_ __attribute__((ext_vector_type(2)));
                            *(u32x2_*)d0 = (u32x2_){w.x, w.y}; *(u32x2_*)(d0 + 32 * 8) = (u32x2_){w.z, w.w}; }
                        continue; }
                    bf16_t* dst;
                    if (gw == 0) dst = base + (size_t)row * ldc + col;
                    else if (gw == -1) { if ((col >> 4) >= ldc) continue; dst = base + ((size_t)((row >> 5) * ldc + (col >> 4)) * 64 + ((col >> 3) & 1) * 32 + (row & 31)) * 8; }
                    else { const int g = col / gw, d = col - g * gw; dst = base + ((size_t)((row >> 12) * 4 + g) * 4096 + (row & 4095)) * gw + d; }
                    *(u32x4*)dst = w; } }
    }
};
struct EpiGelu {
    static constexpr bool PERM = true, AFTER_DRAIN = false;
    bf16_t* O; int ldc; const float* bias;
    static __device__ __forceinline__ float gelu(float x) { const float u2 = 1.5957691216f * (x + 0.044715f * x * x * x); const float e = __builtin_amdgcn_exp2f(-u2 * 1.4426950409f); return x * __builtin_amdgcn_rcpf(1.0f + e); }
    __device__ __forceinline__ void operator()(const f32x4 (&acc)[2][2][4][2], const Unit& u, int wr, int wc, int fr, int fq) const {
        const int row0 = u.pm * BM + wr * 64 + fr, col0 = u.pn * BM + wc * 32 + 8 * fq;
#pragma unroll
        for (int bj = 0; bj < 2; ++bj) { const f32x4 b0 = *(const f32x4*)(bias + col0 + bj * HALF), b1 = *(const f32x4*)(bias + col0 + bj * HALF + 4);
#pragma unroll
            for (int ai = 0; ai < 2; ++ai)
#pragma unroll
                for (int m = 0; m < 4; ++m) { const f32x4 v0 = acc[ai][bj][m][0] + b0, v1 = acc[ai][bj][m][1] + b1;
                    u32x4 w; w.x = cvt_pk_bf16(gelu(v0[0]), gelu(v0[1])); w.y = cvt_pk_bf16(gelu(v0[2]), gelu(v0[3])); w.z = cvt_pk_bf16(gelu(v1[0]), gelu(v1[1])); w.w = cvt_pk_bf16(gelu(v1[2]), gelu(v1[3]));
                    *(u32x4*)(O + (size_t)(row0 + ai * HALF + m * 16) * ldc + col0 + bj * HALF) = w; } }
    }
};
struct EpiF32 {
    static constexpr bool PERM = false, AFTER_DRAIN = false;
    float* C; int ldc;
    __device__ __forceinline__ void operator()(const f32x4 (&acc)[2][2][4][2], const Unit& u, int wr, int wc, int fr, int fq) const {
        const int row0 = u.pm * BM + wr * 64 + fr, col0 = u.pn * BM + wc * 32 + 4 * fq;
#pragma unroll
        for (int ai = 0; ai < 2; ++ai)
#pragma unroll
            for (int m = 0; m < 4; ++m) { float* rowp = C + (size_t)(row0 + ai * HALF + m * 16) * ldc + col0;
#pragma unroll
                for (int bj = 0; bj < 2; ++bj)
#pragma unroll
                    for (int n = 0; n < 2; ++n) *(f32x4*)(rowp + bj * HALF + n * 16) = acc[ai][bj][m][n]; }
    }
};
struct EpiRes {
    static constexpr bool PERM = false, AFTER_DRAIN = false;
    const float* res; float* out; int ldc; int row_off;
    __device__ __forceinline__ void operator()(const f32x4 (&acc)[2][2][4][2], const Unit& u, int wr, int wc, int fr, int fq) const {
        const int row0 = row_off + u.pm * BM + wr * 64 + fr, col0 = u.pn * BM + wc * 32 + 4 * fq;
#pragma unroll
        for (int ai = 0; ai < 2; ++ai)
#pragma unroll
            for (int m = 0; m < 4; ++m) { const size_t off = (size_t)(row0 + ai * HALF + m * 16) * ldc + col0;
                f32x4 r[2][2];
#pragma unroll
                for (int bj = 0; bj < 2; ++bj)
#pragma unroll
                    for (int n = 0; n < 2; ++n) r[bj][n] = *(const f32x4*)(res + off + bj * HALF + n * 16);
#pragma unroll
                for (int bj = 0; bj < 2; ++bj)
#pragma unroll
                    for (int n = 0; n < 2; ++n) *(f32x4*)(out + off + bj * HALF + n * 16) = r[bj][n] + acc[ai][bj][m][n];
                asm volatile("" ::: "memory"); }
    }
};
struct EpiDry {
    static constexpr bool PERM = false, AFTER_DRAIN = false;
    float* D;
    __device__ __forceinline__ void operator()(const f32x4 (&acc)[2][2][4][2], const Unit& u, int wr, int wc, int fr, int fq) const {
        float* p = D + ((size_t)blockIdx.x * 512 + threadIdx.x) * 64;
#pragma unroll
        for (int ai = 0; ai < 2; ++ai)
#pragma unroll
            for (int m = 0; m < 4; ++m)
#pragma unroll
                for (int bj = 0; bj < 2; ++bj) *(f32x4*)(p + ((ai * 4 + m) * 2 + bj) * 4) = acc[ai][bj][m][0] + acc[ai][bj][m][1];
    }
};
struct EpiConvGlu {
    static constexpr bool PERM = true, AFTER_DRAIN = false;
    bf16_t* G; float* UB; const float* cw; const float* cb; PG8_LAS float* xb; int dff;
    static __device__ __forceinline__ float shr(float old, float src, int n) { const int o = __builtin_bit_cast(int, old), s = __builtin_bit_cast(int, src);
        return __builtin_bit_cast(float, n == 1 ? __builtin_amdgcn_update_dpp(o, s, 0x111, 0xf, 0xf, false) : __builtin_amdgcn_update_dpp(o, s, 0x112, 0xf, 0xf, false)); }
    static __device__ __forceinline__ float ror(float src, int n) { const int s = __builtin_bit_cast(int, src);
        return __builtin_bit_cast(float, n == 1 ? __builtin_amdgcn_update_dpp(0, s, 0x121, 0xf, 0xf, false) : __builtin_amdgcn_update_dpp(0, s, 0x122, 0xf, 0xf, false)); }
    __device__ __forceinline__ void operator()(const f32x4 (&acc)[2][2][4][2], const Unit& u, int wr, int wc, int fr, int fq) const {
        typedef unsigned u32x2_ __attribute__((ext_vector_type(2)));
        if (fr >= 14) {
#pragma unroll
            for (int ai = 0; ai < 2; ++ai)
#pragma unroll
                for (int bj = 0; bj < 2; ++bj)
#pragma unroll
                    for (int n = 0; n < 2; ++n) *(PG8_LAS f32x4*)(xb + (((((ai * 2 + wr) * 4 + wc) * 2 + (fr - 14)) * 4 + fq) * 16) + (bj * 2 + n) * 4) = acc[ai][bj][3][n];
        }
        { const int ncol = 4 * dff / 2;
          const bool top = (wr == 0 && fr < 2), bot = (wr == 1 && fr >= 14);
          if (top || bot) { float* ub = UB + ((size_t)(u.pm * 4 + (top ? fr : 2 + fr - 14)) * ncol) + u.pn * BM + wc * 32 + 8 * fq;
#pragma unroll
            for (int bj = 0; bj < 2; ++bj)
#pragma unroll
                for (int n = 0; n < 2; ++n) *(f32x4*)(ub + bj * HALF + 4 * n) = top ? acc[0][bj][0][n] : acc[1][bj][3][n]; } }
        asm volatile("s_waitcnt lgkmcnt(0)" ::: "memory"); __builtin_amdgcn_s_barrier(); asm volatile("" ::: "memory");
        u32x2_ res[2][4][2];
        const int ch0 = u.pn * HALF + wc * 32 + 8 * fq;
#pragma unroll
        for (int n = 0; n < 2; ++n) {
            const float* wp = cw + ch0 + 4 * n; const float* bp = cb + ch0 + 4 * n;
            const f32x4 w0g = *(const f32x4*)(wp), w1g = *(const f32x4*)(wp + 2 * dff), w2g = *(const f32x4*)(wp + 4 * dff), bg = *(const f32x4*)(bp);
            const f32x4 w0v = *(const f32x4*)(wp + dff), w1v = *(const f32x4*)(wp + 3 * dff), w2v = *(const f32x4*)(wp + 5 * dff), bv = *(const f32x4*)(bp + dff);
#pragma unroll
            for (int ai = 0; ai < 2; ++ai)
#pragma unroll
                for (int m = 0; m < 4; ++m) {
                    const f32x4 cg = acc[ai][0][m][n], cv = acc[ai][1][m][n];
                    f32x4 b1g, b2g, b1v, b2v;
                    if (m > 0) {
#pragma unroll
                        for (int e = 0; e < 4; ++e) { b1g[e] = ror(acc[ai][0][m - 1][n][e], 1); b2g[e] = ror(acc[ai][0][m - 1][n][e], 2); b1v[e] = ror(acc[ai][1][m - 1][n][e], 1); b2v[e] = ror(acc[ai][1][m - 1][n][e], 2); }
                    } else {
                        const int sai = wr ? ai : ai - 1, swr = wr ? 0 : 1;
                        f32x4 x14g = {0.f, 0.f, 0.f, 0.f}, x15g = x14g, x14v = x14g, x15v = x14g;
                        if (sai >= 0) { const PG8_LAS float* xp = xb + (((((sai * 2 + swr) * 4 + wc) * 2) * 4 + fq) * 16);
                            x14g = *(const PG8_LAS f32x4*)(xp + n * 4); x14v = *(const PG8_LAS f32x4*)(xp + (2 + n) * 4); x15g = *(const PG8_LAS f32x4*)(xp + 64 + n * 4); x15v = *(const PG8_LAS f32x4*)(xp + 64 + (2 + n) * 4); }
                        b1g = x15g; b1v = x15v; b2g = fr == 0 ? x14g : x15g; b2v = fr == 0 ? x14v : x15v;
                    }
                    float o[4];
#pragma unroll
                    for (int e = 0; e < 4; ++e) {
                        const float p1g = shr(b1g[e], cg[e], 1), p2g = shr(b2g[e], cg[e], 2), p1v = shr(b1v[e], cv[e], 1), p2v = shr(b2v[e], cv[e], 2);
                        const float yg = bg[e] + w0g[e] * p2g + w1g[e] * p1g + w2g[e] * cg[e], yv = bv[e] + w0v[e] * p2v + w1v[e] * p1v + w2v[e] * cv[e];
                        o[e] = yg * __builtin_amdgcn_rcpf(1.0f + __builtin_amdgcn_exp2f(-yg * 1.4426950409f)) * yv;
                    }
                    res[ai][m][n] = (u32x2_){cvt_pk_bf16(o[0], o[1]), cvt_pk_bf16(o[2], o[3])};
                }
        }
        const int row0 = u.pm * BM + wr * 64 + fr;
#pragma unroll
        for (int ai = 0; ai < 2; ++ai)
#pragma unroll
            for (int m = 0; m < 4; ++m) *(u32x4*)(G + (size_t)(row0 + ai * HALF + m * 16) * dff + ch0) = (u32x4){res[ai][m][0].x, res[ai][m][0].y, res[ai][m][1].x, res[ai][m][1].y};
    }
};
}
constexpr int BATCH = 8, SEQ = 4096, DM = 2048, MTOT = BATCH * SEQ, MC = MTOT / 2  , BPH = BATCH / 2;
constexpr int DFF = 5632;
constexpr float NORM_EPS = 1e-6f, LOG2E = 1.4426950408889634f;
constexpr int NWAVES = 8;
constexpr size_t MiB = 1u << 20;
constexpr size_t WS_CTL = 0, CTL_ZERO_BYTES = 1 * MiB;
constexpr size_t WS_TAB = 1 * MiB;
constexpr size_t TAB_COS48 = WS_TAB, TAB_SIN48 = WS_TAB + 3 * MiB, TAB_COS32 = WS_TAB + 6 * MiB, TAB_SIN32 = WS_TAB + 8 * MiB;
constexpr size_t WS_WMIX = 12 * MiB;
constexpr size_t WS_WFFN = 100 * MiB;
constexpr size_t WS_MISC = 168 * MiB;
constexpr size_t WS_XN = 170 * MiB;
constexpr size_t WS_AR = 234 * MiB;
constexpr size_t WS_END = 1010 * MiB;
constexpr size_t DUMMY_OFF = 700 * MiB;
constexpr int CW_TMO = 0;
constexpr int CW_BAR = 4096;
constexpr int RING_BYTES = 131072;
constexpr int LDSCTL_OFF = 135168;
constexpr int LDS_BYTES = 163840;

#define GAS __attribute__((address_space(1)))
#define LAS __attribute__((address_space(3)))
typedef unsigned short bf16;
typedef unsigned u32x4 __attribute__((ext_vector_type(4)));
typedef unsigned u32x2 __attribute__((ext_vector_type(2)));
typedef float f32x4 __attribute__((ext_vector_type(4)));
typedef float f32x16 __attribute__((ext_vector_type(16)));
typedef short bf16x8 __attribute__((ext_vector_type(8)));
typedef short s16x4 __attribute__((ext_vector_type(4)));
typedef short v4i16_t __attribute__((ext_vector_type(4)));
typedef __bf16 bf16x2_t __attribute__((ext_vector_type(2)));
typedef float f32x2_t __attribute__((ext_vector_type(2)));
#define LDS_WAIT() asm volatile("s_waitcnt lgkmcnt(0)" ::: "memory")
#define VM_WAIT() asm volatile("s_waitcnt vmcnt(0)" ::: "memory")
#define MFMA32(a, b, c) __builtin_amdgcn_mfma_f32_32x32x16_bf16((a), (b), (c), 0, 0, 0)
DI unsigned pk2(float lo, float hi) { f32x2_t v = {lo, hi}; bf16x2_t b = __builtin_convertvector(v, bf16x2_t); return __builtin_bit_cast(unsigned, b); }
DI float bf2f(unsigned short b) { return __builtin_bit_cast(float, (unsigned)b << 16); }
DI float bflo(unsigned w) { return __builtin_bit_cast(float, w << 16); }
DI float bfhi(unsigned w) { return __builtin_bit_cast(float, w & 0xffff0000u); }
DI unsigned short f2bf(float f) { return (unsigned short)(pk2(f, 0.f) & 0xffffu); }
DI float wave_sum(float v) {
#pragma unroll
    for (int o = 1; o < 64; o <<= 1) v += __shfl_xor(v, o);
    return v;
}
DI int crow(int i, int h) { return (i & 3) + 8 * (i >> 2) + 4 * h; }
#define XB_TMO      128
#define XB_XCNT(j)  (256  + 64 * (j))
#define XB_XSUB(j)  (1280 + 64 * (j))
#define XB_XGEN(j)  (2304 + 64 * (j))
#define XB_TOP      3328
#define XB_TOPGEN   3392
#define XCD_BAR_WORDS 3456
#define XB_SPIN_CAP (1u << 18)

__device__ __forceinline__ unsigned xb_ld(unsigned* p)              { return __hip_atomic_load(p, __ATOMIC_RELAXED, __HIP_MEMORY_SCOPE_AGENT); }
__device__ __forceinline__ unsigned xb_add(unsigned* p, unsigned v) { return __hip_atomic_fetch_add(p, v, __ATOMIC_RELAXED, __HIP_MEMORY_SCOPE_AGENT); }
__device__ __forceinline__ unsigned xb_xcc_id() { return (unsigned)__builtin_amdgcn_s_getreg((3 << 11) | 20) & 0xFu; }
#define XB_SPIN(cond, bar) do { unsigned _sp = 0; while (cond) { __builtin_amdgcn_s_sleep(1); \
    if ((++_sp & 255u) == 0u) { if (xb_ld(&(bar)[XB_TMO])) break; if (_sp > XB_SPIN_CAP) { atomicAdd(&(bar)[XB_TMO], 1u); break; } } } } while (0)

struct XcdBarrier {
    unsigned* bar; unsigned x;
    volatile LAS unsigned* st;
};

__device__ __forceinline__ XcdBarrier xcd_barrier_post(unsigned* bar, volatile LAS unsigned* st) {
    XcdBarrier b; b.bar = bar; b.x = xb_xcc_id(); b.st = st;
    if (threadIdx.x == 0) (void)xb_add(&bar[XB_XCNT(b.x)], 1u);
    return b;
}
__device__ __forceinline__ void xcd_barrier_complete(unsigned* bar, unsigned x, unsigned& nloc, unsigned& nx) {
    const unsigned G = gridDim.x * gridDim.y * gridDim.z;
    unsigned sum, cnt, mine, sp = 0u;
    for (;;) {
        sum = 0u; cnt = 0u; mine = 0u;
#pragma unroll
        for (unsigned j = 0; j < 16; ++j) { const unsigned c = xb_ld(&bar[XB_XCNT(j)]); sum += c; cnt += (c > 0u) ? 1u : 0u; mine = (j == x) ? c : mine; }
        if (sum == G) break;
        __builtin_amdgcn_s_sleep(1);
        if ((++sp & 255u) == 0u) { if (xb_ld(&bar[XB_TMO])) break; if (sp > XB_SPIN_CAP) { atomicAdd(&bar[XB_TMO], 1u); break; } }
    }
    nloc = mine > 0u ? mine : 1u; nx = cnt > 0u ? cnt : 1u;
}

__device__ __forceinline__ void xcd_barrier(const XcdBarrier& b) {
    asm volatile("s_waitcnt vmcnt(0)" ::: "memory");
    __syncthreads();
    if (threadIdx.x == 0) {
        unsigned* bar = b.bar;
        __builtin_amdgcn_s_waitcnt(0);
        unsigned nloc = b.st[0], nx = b.st[1];
        if (nloc == 0u) { xcd_barrier_complete(bar, b.x, nloc, nx); b.st[0] = nloc; b.st[1] = nx; }
        const unsigned old = xb_add(&bar[XB_XSUB(b.x)], 1u);
        const unsigned gen = old / nloc;
        if (old + 1u == (gen + 1u) * nloc) {
            __builtin_amdgcn_fence(__ATOMIC_RELEASE, "agent");
            asm volatile("s_waitcnt vmcnt(0)" ::: "memory");
            const unsigned og = xb_add(&bar[XB_TOP], 1u);
            const unsigned tg = og / nx;
            if (og + 1u == (tg + 1u) * nx) xb_add(&bar[XB_TOPGEN], 1u);
            else XB_SPIN(xb_ld(&bar[XB_TOPGEN]) == tg, bar);
            __builtin_amdgcn_fence(__ATOMIC_ACQUIRE, "agent");
            xb_add(&bar[XB_XGEN(b.x)], 1u);
            asm volatile("s_waitcnt vmcnt(0)" ::: "memory");
        } else {
            XB_SPIN(xb_ld(&bar[XB_XGEN(b.x)]) == gen, bar);
            __builtin_amdgcn_fence(__ATOMIC_ACQUIRE, "agent");
            asm volatile("s_waitcnt vmcnt(0)" ::: "memory");
        }
    }
    __syncthreads();
}
struct Frame {
    LAS unsigned char* lds; unsigned* ctl; unsigned char* ws;
    int tid, lane, wave, G, gw, NGW;
};
DI void ph_tables(const Frame& F, const int* pos) {
    float* c48 = (float*)(F.ws + TAB_COS48); float* s48 = (float*)(F.ws + TAB_SIN48); float* c32 = (float*)(F.ws + TAB_COS32); float* s32 = (float*)(F.ws + TAB_SIN32);
    const int gt = blockIdx.x * (NWAVES * 64) + F.tid, NT = F.G * NWAVES * 64;
    for (int i = gt; i < MTOT * 40; i += NT) {
        const int m = i / 40, j = i - m * 40; const float p = (float)pos[m];
        const bool a = j < 24; const int jj = a ? j : j - 24;
        const float inv = (float)exp(-(2.0 * jj / (a ? 48.0 : 32.0)) * 13.122363377404328);
        const float ang = p * inv; float sn, cs; sincosf(ang, &sn, &cs);
        if (a) { c48[m * 24 + jj] = cs; s48[m * 24 + jj] = sn; } else { c32[m * 16 + jj] = cs; s32[m * 16 + jj] = sn; }
    }
}
DI void cvt_item(const float* W, int ldw, int col0, int ncols, bf16* WT, int ldt, int row_off, float scale, LAS float* scr, int item, int nblk, int lane) {
    const int kb = item / nblk, nb = item - kb * nblk, k0 = 64 * kb, n0 = 32 * nb;
    const int nn = n0 + (lane & 31); const bool ok = nn < ncols;
#pragma unroll 8
    for (int i = 0; i < 32; ++i) { const int kk = 2 * i + (lane >> 5); scr[kk * 33 + (lane & 31)] = ok ? W[(size_t)(k0 + kk) * ldw + col0 + nn] * scale : 0.f; }
    LDS_WAIT();
    const int c = lane & 7;
#pragma unroll
    for (int j = 0; j < 4; ++j) { const int n = (lane >> 3) + 8 * j; const LAS float* s = scr + (8 * c) * 33 + n;
        u32x4 o; o.x = pk2(s[0 * 33], s[1 * 33]); o.y = pk2(s[2 * 33], s[3 * 33]); o.z = pk2(s[4 * 33], s[5 * 33]); o.w = pk2(s[6 * 33], s[7 * 33]);
        if (n0 + n < ncols) *(u32x4*)(WT + (size_t)(row_off + n0 + n) * ldt + k0 + 8 * c) = o; }
    LDS_WAIT();
}
DI void cvt_job(const Frame& F, const float* W, int ldw, int K, int col0, int ncols, bf16* WT, int ldt, int row_off, float scale) {
    LAS float* scr = (LAS float*)(F.lds + F.wave * 16384);
    const int nblk = (ncols + 31) / 32, nitems = (K / 64) * nblk;
    for (int it = F.gw; it < nitems; it += F.NGW) cvt_item(W, ldw, col0, ncols, WT, ldt, row_off, scale, scr, it, nblk, F.lane);
}
DI void zero_bf16(const Frame& F, bf16* p, size_t nelem) {
    const size_t gt = (size_t)blockIdx.x * (NWAVES * 64) + F.tid, NT = (size_t)F.G * NWAVES * 64;
    for (size_t i = gt; i < nelem / 8; i += NT) ((u32x4*)p)[i] = (u32x4){0u, 0u, 0u, 0u};
}
DI void ph_cvt_ffn(const Frame& F, const float* up, const float* down) {
    bf16* WUP = (bf16*)(F.ws + WS_WFFN); bf16* WDN = WUP + (size_t)2 * DFF * DM;
    { LAS float* scr = (LAS float*)(F.lds + F.wave * 16384);
      for (int it = F.gw; it < 88 * 128; it += F.NGW) { const int seg = it >> 7, pn = seg >> 1, isv = seg & 1;
          cvt_item(up, 2 * DFF, isv * DFF + pn * 128, 128, WUP, DM, pn * 256 + isv * 128, 1.f, scr, it & 127, 4, F.lane); } }
    cvt_job(F, down, DM, DFF, 0, DM, WDN, DFF, 0, 1.f);
}
DI void ph_conv_fix(const Frame& F, const float* UB, bf16* Gb, const float* cw, const float* cb) {
    const int gt = blockIdx.x * (NWAVES * 64) + F.tid, NT = F.G * NWAVES * 64;
    for (int it = gt; it < (MC / 256) * (DFF / 4); it += NT) {
        const int pm = it / (DFF / 4), c4 = it - pm * (DFF / 4), ch = c4 * 4, col = (ch >> 7) * 256 + (ch & 127);
        const float* ub = UB + (size_t)pm * 4 * (2 * DFF) + col; const bool has = (pm & 15) != 0;
        const f32x4 z = {0.f, 0.f, 0.f, 0.f};
        const f32x4 g0 = *(const f32x4*)(ub), g1 = *(const f32x4*)(ub + 2 * DFF), v0 = *(const f32x4*)(ub + 128), v1 = *(const f32x4*)(ub + 2 * DFF + 128);
        const f32x4 gm2 = has ? *(const f32x4*)(ub - 2 * (2 * DFF)) : z, gm1 = has ? *(const f32x4*)(ub - (2 * DFF)) : z, vm2 = has ? *(const f32x4*)(ub - 2 * (2 * DFF) + 128) : z, vm1 = has ? *(const f32x4*)(ub - (2 * DFF) + 128) : z;
        const f32x4 w0g = *(const f32x4*)(cw + ch), w1g = *(const f32x4*)(cw + 2 * DFF + ch), w2g = *(const f32x4*)(cw + 4 * DFF + ch), bg = *(const f32x4*)(cb + ch);
        const f32x4 w0v = *(const f32x4*)(cw + DFF + ch), w1v = *(const f32x4*)(cw + 3 * DFF + ch), w2v = *(const f32x4*)(cw + 5 * DFF + ch), bv = *(const f32x4*)(cb + DFF + ch);
        float o0[4], o1[4];
#pragma unroll
        for (int e = 0; e < 4; ++e) {
            const float yg0 = bg[e] + w0g[e] * gm2[e] + w1g[e] * gm1[e] + w2g[e] * g0[e], yv0 = bv[e] + w0v[e] * vm2[e] + w1v[e] * vm1[e] + w2v[e] * v0[e];
            const float yg1 = bg[e] + w0g[e] * gm1[e] + w1g[e] * g0[e] + w2g[e] * g1[e], yv1 = bv[e] + w0v[e] * vm1[e] + w1v[e] * v0[e] + w2v[e] * v1[e];
            o0[e] = yg0 * __builtin_amdgcn_rcpf(1.0f + __builtin_amdgcn_exp2f(-yg0 * LOG2E)) * yv0; o1[e] = yg1 * __builtin_amdgcn_rcpf(1.0f + __builtin_amdgcn_exp2f(-yg1 * LOG2E)) * yv1;
        }
        u32x2 a, b; a.x = pk2(o0[0], o0[1]); a.y = pk2(o0[2], o0[3]); b.x = pk2(o1[0], o1[1]); b.y = pk2(o1[2], o1[3]);
        *(u32x2*)(Gb + (size_t)(pm * 256) * DFF + ch) = a; *(u32x2*)(Gb + (size_t)(pm * 256 + 1) * DFF + ch) = b;
    }
}
DI void ph_rmsnorm(const Frame& F, const float* src, int row_off, const float* gain, bf16* XN) {
    f32x4 g[8];
#pragma unroll
    for (int j = 0; j < 8; ++j) g[j] = *(const f32x4*)(gain + 4 * (F.lane + 64 * j));
    for (int ml = F.gw; ml < MC; ml += F.NGW) {
        const f32x4* xr = (const f32x4*)(src + (size_t)(row_off + ml) * DM) + F.lane;
        f32x4 v[8]; float ss = 0.f;
#pragma unroll
        for (int j = 0; j < 8; ++j) { v[j] = xr[64 * j]; ss += (v[j].x * v[j].x + v[j].y * v[j].y) + (v[j].z * v[j].z + v[j].w * v[j].w); }
        const float rstd = 1.0f / sqrtf(wave_sum(ss) * (1.f / DM) + NORM_EPS);
        u32x2* o = (u32x2*)(XN + (size_t)ml * DM) + F.lane;
#pragma unroll
        for (int j = 0; j < 8; ++j) { const f32x4 y = v[j] * rstd * g[j]; u32x2 w; w.x = pk2(y.x, y.y); w.y = pk2(y.z, y.w); o[64 * j] = w; }
    }
}
DI void ph_final_norm(const Frame& F, float* h, const float* gain) {
    f32x4 g[8];
#pragma unroll
    for (int j = 0; j < 8; ++j) g[j] = *(const f32x4*)(gain + 4 * (F.lane + 64 * j));
    for (int m = F.gw; m < MTOT; m += F.NGW) {
        f32x4* xr = (f32x4*)(h + (size_t)m * DM) + F.lane;
        f32x4 v[8]; float ss = 0.f;
#pragma unroll
        for (int j = 0; j < 8; ++j) { v[j] = xr[64 * j]; ss += (v[j].x * v[j].x + v[j].y * v[j].y) + (v[j].z * v[j].z + v[j].w * v[j].w); }
        const float rstd = 1.0f / sqrtf(wave_sum(ss) * (1.f / DM) + NORM_EPS);
#pragma unroll
        for (int j = 0; j < 8; ++j) xr[64 * j] = v[j] * rstd * g[j];
    }
}
DI void ph_conv_glu(const Frame& F, const bf16* U, bf16* Gb, const float* cw, const float* cb) {
    constexpr int RC = 32, NCG = DFF / 8, NRC = MC / RC;
    const int gt = blockIdx.x * (NWAVES * 64) + F.tid, NT = F.G * NWAVES * 64;
    for (int it = gt; it < NCG * NRC; it += NT) {
        const int cg = it % NCG, rc = it / NCG, c0 = cg * 8, r0 = rc * RC;
        float w0g[8], w1g[8], w2g[8], bg[8], w0v[8], w1v[8], w2v[8], bv[8];
#pragma unroll
        for (int e = 0; e < 8; ++e) { w0g[e] = cw[c0 + e]; w1g[e] = cw[2 * DFF + c0 + e]; w2g[e] = cw[4 * DFF + c0 + e]; bg[e] = cb[c0 + e];
            w0v[e] = cw[DFF + c0 + e]; w1v[e] = cw[3 * DFF + c0 + e]; w2v[e] = cw[5 * DFF + c0 + e]; bv[e] = cb[DFF + c0 + e]; }
        float pg2[8], pg1[8], pv2[8], pv1[8];
        const bool has = (r0 & (SEQ - 1)) != 0;
        {
            u32x4 a = {0u, 0u, 0u, 0u}, b = a, c = a, d = a;
            if (has) { a = *(const u32x4*)(U + (size_t)(r0 - 2) * (2 * DFF) + c0); b = *(const u32x4*)(U + (size_t)(r0 - 1) * (2 * DFF) + c0);
                       c = *(const u32x4*)(U + (size_t)(r0 - 2) * (2 * DFF) + DFF + c0); d = *(const u32x4*)(U + (size_t)(r0 - 1) * (2 * DFF) + DFF + c0); }
#pragma unroll
            for (int e = 0; e < 4; ++e) { pg2[2 * e] = bflo(a[e]); pg2[2 * e + 1] = bfhi(a[e]); pg1[2 * e] = bflo(b[e]); pg1[2 * e + 1] = bfhi(b[e]);
                pv2[2 * e] = bflo(c[e]); pv2[2 * e + 1] = bfhi(c[e]); pv1[2 * e] = bflo(d[e]); pv1[2 * e + 1] = bfhi(d[e]); }
        }
        for (int r = 0; r < RC; ++r) {
            const u32x4 ug = *(const u32x4*)(U + (size_t)(r0 + r) * (2 * DFF) + c0), uv = *(const u32x4*)(U + (size_t)(r0 + r) * (2 * DFF) + DFF + c0);
            float cg_[8], cv_[8], o[8];
#pragma unroll
            for (int e = 0; e < 4; ++e) { cg_[2 * e] = bflo(ug[e]); cg_[2 * e + 1] = bfhi(ug[e]); cv_[2 * e] = bflo(uv[e]); cv_[2 * e + 1] = bfhi(uv[e]); }
#pragma unroll
            for (int e = 0; e < 8; ++e) {
                const float yg = bg[e] + w0g[e] * pg2[e] + w1g[e] * pg1[e] + w2g[e] * cg_[e];
                const float yv = bv[e] + w0v[e] * pv2[e] + w1v[e] * pv1[e] + w2v[e] * cv_[e];
                const float sg = yg * __builtin_amdgcn_rcpf(1.0f + __builtin_amdgcn_exp2f(-yg * LOG2E));
                o[e] = sg * yv; pg2[e] = pg1[e]; pg1[e] = cg_[e]; pv2[e] = pv1[e]; pv1[e] = cv_[e];
            }
            u32x4 w; w.x = pk2(o[0], o[1]); w.y = pk2(o[2], o[3]); w.z = pk2(o[4], o[5]); w.w = pk2(o[6], o[7]);
            *(u32x4*)(Gb + (size_t)(r0 + r) * DFF + c0) = w;
        }
    }
}
constexpr size_t DA_DIN = 0, DA_CQN = 64 * MiB, DA_LATC = 80 * MiB, DA_KPE = 88 * MiB, DA_KIDX = 90 * MiB, DA_WIDX = 94 * MiB, DA_QL = 96 * MiB, DA_QPE = 352 * MiB, DA_QIDX = 400 * MiB,
                 DA_SEL = 464 * MiB, DA_CNT = 472 * MiB, DA_SC = 474 * MiB, DA_O2 = 474 * MiB;
constexpr size_t DW_W1 = 0, DW_W2 = (size_t)1024 * 2048, DW_WO = DW_W2 + (size_t)11776 * 512, DW_BD = DW_WO + (size_t)2048 * 4096;
constexpr float DSA_QSCALE = 0.07216878364870322f * LOG2E;
constexpr float DSA_WIDX_SCALE = 0.25f * 0.08838834764831845f;

DI void ph_dsa_cvt(const Frame& F, const float* w_in, const float* w_qup, const float* w_uk, const float* w_uv, const float* w_out) {
    bf16* WB = (bf16*)(F.ws + WS_WMIX);
    cvt_job(F, w_in, 960, DM, 0, 960, WB + DW_W1, DM, 0, 1.f);
    zero_bf16(F, WB + DW_W1 + (size_t)960 * DM, (size_t)64 * DM);
    { LAS float* scr = (LAS float*)(F.lds + F.wave * 16384);
      for (int it = F.gw; it < 32 * 16; it += F.NGW) { const int h = it >> 4; cvt_item(w_qup, 8192, h * 192, 48, WB + DW_W2, 512, 8192 + h * 48, DSA_QSCALE, scr, it & 15, 2, F.lane); } }
    cvt_job(F, w_qup, 8192, 512, 6144, 2048, WB + DW_W2, 512, 9728, 1.f);
    __syncthreads();
    {
        LAS float* As = (LAS float*)F.lds; LAS float* Bs = As + 64 * 145;
        for (int u = blockIdx.x; u < 32 * 4 * 8; u += F.G) {
            const int h = u >> 5, r0 = ((u >> 3) & 3) * 64, k0 = (u & 7) * 64;
            for (int i = F.tid; i < 64 * 144; i += NWAVES * 64) { const int row = i / 144, col = i - row * 144;
                As[row * 145 + col] = w_uk[(size_t)(h * 256 + r0) * 144 + i]; Bs[row * 145 + col] = w_qup[(size_t)(k0 + row) * 8192 + h * 192 + 48 + col]; }
            __syncthreads();
            const int r = F.tid & 63, kg = F.tid >> 6; float acc[8];
#pragma unroll
            for (int j = 0; j < 8; ++j) acc[j] = 0.f;
            for (int n = 0; n < 144; ++n) { const float a = As[r * 145 + n];
#pragma unroll
                for (int j = 0; j < 8; ++j) acc[j] += a * Bs[(kg * 8 + j) * 145 + n]; }
            u32x4 o; o.x = pk2(acc[0] * DSA_QSCALE, acc[1] * DSA_QSCALE); o.y = pk2(acc[2] * DSA_QSCALE, acc[3] * DSA_QSCALE); o.z = pk2(acc[4] * DSA_QSCALE, acc[5] * DSA_QSCALE); o.w = pk2(acc[6] * DSA_QSCALE, acc[7] * DSA_QSCALE);
            *(u32x4*)(WB + DW_W2 + (size_t)(h * 256 + r0 + r) * 512 + k0 + kg * 8) = o;
            __syncthreads();
        }
    }
    { LAS float* scr = (LAS float*)(F.lds + F.wave * 16384);
      for (int it = F.gw; it < 32 * 16; it += F.NGW) { const int h = it >> 4; cvt_item(w_uv + (size_t)h * 256 * 128, 128, 0, 128, WB + DW_BD + (h & 1) * 256, 512, h * 128, 1.f, scr, it & 15, 4, F.lane); } }
    { const size_t gt = (size_t)blockIdx.x * (NWAVES * 64) + F.tid, NT = (size_t)F.G * NWAVES * 64;
      for (size_t i = gt; i < (size_t)4096 * 32; i += NT) { const int row = (int)(i >> 5), pc = (int)(i & 31); *(u32x4*)(WB + DW_BD + (size_t)row * 512 + (1 - ((row >> 7) & 1)) * 256 + pc * 8) = (u32x4){0u, 0u, 0u, 0u}; } }
    cvt_job(F, w_out, DM, 4096, 0, DM, WB + DW_WO, 4096, 0, 1.f);
}
DI void ph_dsa_post1(const Frame& F, int half, const float* qn, const float* kvn, const float* lng, const float* lnb) {
    unsigned char* ar = F.ws + WS_AR;
    const float* DIN = (const float*)(ar + DA_DIN); bf16* CQN = (bf16*)(ar + DA_CQN); bf16* LATC = (bf16*)(ar + DA_LATC); bf16* KPE = (bf16*)(ar + DA_KPE); bf16* KIDX = (bf16*)(ar + DA_KIDX); float* WIDX = (float*)(ar + DA_WIDX);
    const float* c48 = (const float*)(F.ws + TAB_COS48); const float* s48 = (const float*)(F.ws + TAB_SIN48); const float* c32 = (const float*)(F.ws + TAB_COS32); const float* s32 = (const float*)(F.ws + TAB_SIN32);
    LAS float* buf = (LAS float*)(F.lds + F.wave * 1024);
    const int lane = F.lane;
    for (int ml = F.gw; ml < MC; ml += F.NGW) {
        const int mg = half * MC + ml;
        const size_t kfb = ((size_t)(ml >> 5) * 8 * 64 + (ml & 31)) * 8;
        const float* row = DIN + (size_t)ml * 1024 + 16 * lane;
        f32x4 v[4]; float ss = 0.f, s1 = 0.f;
#pragma unroll
        for (int j = 0; j < 4; ++j) { v[j] = *(const f32x4*)(row + 4 * j); ss += (v[j].x * v[j].x + v[j].y * v[j].y) + (v[j].z * v[j].z + v[j].w * v[j].w); s1 += (v[j].x + v[j].y) + (v[j].z + v[j].w); }
        const bool isq = lane < 32, iskv = lane >= 32 && lane < 48, ispe = lane >= 48 && lane < 51, isix = lane >= 51 && lane < 59;
        const float ssq = wave_sum(isq ? ss : 0.f), sskv = wave_sum(iskv ? ss : 0.f), mean = wave_sum(isix ? s1 : 0.f) * (1.f / 128.f);
        float d2 = 0.f;
#pragma unroll
        for (int j = 0; j < 4; ++j) { const f32x4 d = v[j] - mean; d2 += (d.x * d.x + d.y * d.y) + (d.z * d.z + d.w * d.w); }
        const float var = wave_sum(isix ? d2 : 0.f) * (1.f / 128.f);
        const float rq = 1.0f / sqrtf(ssq * (1.f / 512.f) + NORM_EPS), rkv = 1.0f / sqrtf(sskv * (1.f / 256.f) + NORM_EPS), rstd = 1.0f / sqrtf(var + NORM_EPS);
        if (isq || iskv) {
            const float* gp = isq ? qn + 16 * lane : kvn + 16 * (lane - 32); const float rs = isq ? rq : rkv;
            bf16* dst = isq ? CQN + (size_t)ml * 512 + 16 * lane : LATC + (size_t)ml * 256 + 16 * (lane - 32);
            u32x4 o[2];
#pragma unroll
            for (int j = 0; j < 4; ++j) { const f32x4 g = *(const f32x4*)(gp + 4 * j); const f32x4 y = v[j] * rs * g; o[j >> 1][(j & 1) * 2] = pk2(y.x, y.y); o[j >> 1][(j & 1) * 2 + 1] = pk2(y.z, y.w); }
            *(u32x4*)dst = o[0]; *(u32x4*)(dst + 8) = o[1];
        } else if (ispe) {
#pragma unroll
            for (int j = 0; j < 4; ++j) *(LAS f32x4*)(buf + (lane - 48) * 16 + 4 * j) = v[j];
        } else if (isix) {
#pragma unroll
            for (int j = 0; j < 4; ++j) { const f32x4 g = *(const f32x4*)(lng + (lane - 51) * 16 + 4 * j), b = *(const f32x4*)(lnb + (lane - 51) * 16 + 4 * j); *(LAS f32x4*)(buf + 48 + (lane - 51) * 16 + 4 * j) = (v[j] - mean) * rstd * g + b; }
        } else if (lane == 59) {
#pragma unroll
            for (int j = 0; j < 4; ++j) *(f32x4*)(WIDX + (size_t)ml * 16 + 4 * j) = v[j] * DSA_WIDX_SCALE;
        }
        LDS_WAIT();
        if (lane < 24) { const float x1 = buf[lane], x2 = buf[24 + lane], c = c48[(size_t)mg * 24 + lane], s = s48[(size_t)mg * 24 + lane];
            KPE[(size_t)ml * 48 + lane] = f2bf(x1 * c - x2 * s); KPE[(size_t)ml * 48 + 24 + lane] = f2bf(x1 * s + x2 * c);
        } else if (lane < 40) { const int i = lane - 24; const float x1 = buf[48 + i], x2 = buf[48 + 16 + i], c = c32[(size_t)mg * 16 + i], s = s32[(size_t)mg * 16 + i];
            KIDX[kfb + (size_t)((i >> 3) * 32) * 8 + (i & 7)] = f2bf(x1 * c - x2 * s); KIDX[kfb + (size_t)(64 + (i >> 3) * 32) * 8 + (i & 7)] = f2bf(x1 * s + x2 * c);
        } else { const int d = 32 + 4 * (lane - 40); const f32x4 y = *(const LAS f32x4*)(buf + 48 + d); u32x2 w; w.x = pk2(y.x, y.y); w.y = pk2(y.z, y.w); *(u32x2*)(KIDX + kfb + (size_t)((d >> 4) * 64 + ((d >> 3) & 1) * 32) * 8 + (d & 7)) = w; }
        LDS_WAIT();
    }
}
DI void ph_dsa_rope(const Frame& F, int half) {
    unsigned char* ar = F.ws + WS_AR; bf16* QPE = (bf16*)(ar + DA_QPE); bf16* QIDX = (bf16*)(ar + DA_QIDX);
    const float* c48 = (const float*)(F.ws + TAB_COS48); const float* s48 = (const float*)(F.ws + TAB_SIN48); const float* c32 = (const float*)(F.ws + TAB_COS32); const float* s32 = (const float*)(F.ws + TAB_SIN32);
    for (int ml = F.gw; ml < MC; ml += F.NGW) {
        const size_t mg = (size_t)half * MC + ml;
        for (int p = F.lane; p < 768; p += 64) { const int hd = p / 24, i = p - hd * 24; bf16* q = QPE + (size_t)ml * 1536 + hd * 48 + i;
            const float x1 = bf2f(q[0]), x2 = bf2f(q[24]), c = c48[mg * 24 + i], s = s48[mg * 24 + i]; q[0] = f2bf(x1 * c - x2 * s); q[24] = f2bf(x1 * s + x2 * c); }
        for (int p = F.lane; p < 256; p += 64) { const int hd = p >> 4, i = p & 15; bf16* q = QIDX + (size_t)ml * 2048 + hd * 128 + i;
            const float x1 = bf2f(q[0]), x2 = bf2f(q[16]), c = c32[mg * 16 + i], s = s32[mg * 16 + i]; q[0] = f2bf(x1 * c - x2 * s); q[16] = f2bf(x1 * s + x2 * c); }
    }
}
DI int wave_isum_dpp(int v) {
    v += __builtin_amdgcn_update_dpp(0, v, 0x111, 0xf, 0xf, true); v += __builtin_amdgcn_update_dpp(0, v, 0x112, 0xf, 0xf, true);
    v += __builtin_amdgcn_update_dpp(0, v, 0x114, 0xf, 0xf, true); v += __builtin_amdgcn_update_dpp(0, v, 0x118, 0xf, 0xf, true);
    v += __builtin_amdgcn_update_dpp(0, v, 0x142, 0xa, 0xf, false);
    v += __builtin_amdgcn_update_dpp(0, v, 0x143, 0xc, 0xf, false);
    return __builtin_amdgcn_readlane(v, 63);
}
DI unsigned f2sortable(float s) { const unsigned b = __builtin_bit_cast(unsigned, s); return (b & 0x80000000u) ? ~b : (b | 0x80000000u); }
DI void ph_dsa_index(const Frame& F, const int dry = 0, const int parts = 3) {
    unsigned char* ar = F.ws + WS_AR;
    const bf16* QIDX = (const bf16*)(ar + DA_QIDX); const bf16* KIDX = (const bf16*)(ar + DA_KIDX); const float* WIDX = (const float*)(ar + DA_WIDX);
    unsigned short* SEL = (unsigned short*)(ar + DA_SEL); int* CNT = (int*)(ar + DA_CNT); float* SC = (float*)(ar + DA_SC) + (size_t)F.gw * 16384;
    const int lane = F.lane, r = lane & 31, hf = lane >> 5;
    LAS unsigned char* wl = F.lds + F.wave * 8192 + lane * 16;
#pragma unroll 1
    for (int tile = blockIdx.x; tile < BPH * 128; tile += F.G) {
        const int j = tile >> 8, c8 = tile & 255, c7 = c8 & 127, bl = (c8 >> 7) * 2 + j, qt = j ? 127 - c7 : c7;
        const int q0 = qt * 32 + 4 * F.wave;
        const int ntile = (q0 + 3) / 32 + 1;
        bf16x8 qa[2][8];
#pragma unroll
        for (int pr = 0; pr < 2; ++pr) {
            const int mrow = bl * SEQ + q0 + 2 * pr + (r >> 4);
#pragma unroll
            for (int s = 0; s < 8; ++s) qa[pr][s] = *(const bf16x8*)(QIDX + (size_t)mrow * 2048 + (r & 15) * 128 + 16 * s + 8 * hf);
            float wv[2][16];
#pragma unroll
            for (int i = 0; i < 16; ++i) wv[pr][i] = WIDX[(size_t)(bl * SEQ + q0 + 2 * pr + (i >> 3)) * 16 + (i & 3) + 8 * ((i >> 2) & 1) + 4 * hf];
#pragma unroll
            for (int i = 0; i < 16; i += 4) *(LAS f32x4*)(wl + (pr * 4 + (i >> 2)) * 1024) = (f32x4){wv[pr][i], wv[pr][i + 1], wv[pr][i + 2], wv[pr][i + 3]};
        }
        LDS_WAIT();
        if (parts & 1) {
        bf16x8 kf[8];
        { const bf16* kp = KIDX + ((size_t)(bl * 128) * 8 * 64 + lane) * 8;
#pragma unroll
          for (int s = 0; s < 8; ++s) kf[s] = *(const bf16x8*)(kp + 512 * s); }
#pragma unroll 1
        for (int t = 0; t < ntile; ++t) {
            f32x16 accs[2];
#pragma unroll
            for (int pr = 0; pr < 2; ++pr) {
#pragma unroll
                for (int i = 0; i < 16; ++i) accs[pr][i] = 0.f;
#pragma unroll
                for (int s = 0; s < 8; ++s) accs[pr] = MFMA32(qa[pr][s], kf[s], accs[pr]);
            }
            if (t + 1 < ntile) { const bf16* kp = KIDX + ((size_t)(bl * 128 + t + 1) * 8 * 64 + lane) * 8;
#pragma unroll
                for (int s = 0; s < 8; ++s) kf[s] = *(const bf16x8*)(kp + 512 * s); }
#pragma unroll
            for (int pr = 0; pr < 2; ++pr) {
                const f32x16 acc = accs[pr];
                float wv[2][16];
                { unsigned wa_ = (unsigned)(size_t)wl; asm volatile("" : "+v"(wa_));
#pragma unroll
                  for (int i = 0; i < 16; i += 4) { const f32x4 w4 = *(const LAS f32x4*)((LAS unsigned char*)(size_t)wa_ + (pr * 4 + (i >> 2)) * 1024); wv[pr][i] = w4.x; wv[pr][i + 1] = w4.y; wv[pr][i + 2] = w4.z; wv[pr][i + 3] = w4.w; } }
                float p0 = 0.f, p1 = 0.f;
#pragma unroll
                for (int i = 0; i < 8; ++i) { p0 += wv[pr][i] * fmaxf(acc[i], 0.f); p1 += wv[pr][8 + i] * fmaxf(acc[8 + i], 0.f); }
                const float t0 = p0 + __shfl_xor(p0, 32), t1 = p1 + __shfl_xor(p1, 32);
                SC[(pr * 128 + t) * 64 + lane] = hf ? t1 : t0;
            }
        }
        }
        VM_WAIT();
        if (parts & 2)
#pragma unroll 1
        for (int qi = 0; qi < 4; ++qi) {
            const int tq = q0 + qi, pr = qi >> 1, qs = qi & 1;
            unsigned u[64];
            const unsigned* scp = (const unsigned*)(SC + pr * 8192 + hf * 64 + qs * 32 + r);
#pragma unroll
            for (int g8 = 0; g8 < 8; ++g8) {
#pragma unroll
                for (int e = 0; e < 8; ++e) { const int i = 8 * g8 + e; const float s = __builtin_bit_cast(float, __hip_atomic_load(scp + e * 128, __ATOMIC_RELAXED, __HIP_MEMORY_SCOPE_AGENT));
                    u[i] = (2 * i + hf < ntile && 64 * i + lane <= tq) ? f2sortable(s) : 0u; }
                scp += 1024; asm volatile("" : "+v"(scp));
            }
            unsigned prefix = 0u;
#pragma unroll 1
            for (int bit = 31; bit >= 0; --bit) {
                const unsigned cand = prefix | (1u << bit); int c = 0;
#pragma unroll
                for (int i = 0; i < 64; ++i) c += (u[i] >= cand) ? 1 : 0;
                c = wave_isum_dpp(c);
                if (c >= 256) prefix = cand;
                if (c == 256) break;
            }
            const unsigned T = prefix > 1u ? prefix : 1u;
            int nl = 0;
#pragma unroll
            for (int i = 0; i < 64; ++i) nl += (u[i] >= T) ? 1 : 0;
            int inc = nl;
#pragma unroll
            for (int o = 1; o < 64; o <<= 1) { const int y = __shfl_up(inc, o); if (lane >= o) inc += y; }
            const int base = __shfl(inc, 63);
            int pos = inc - nl;
            unsigned short* sel = dry ? (unsigned short*)(ar + DUMMY_OFF) + (size_t)F.gw * 256 : SEL + (size_t)(bl * SEQ + tq) * 256;
#pragma unroll
            for (int i = 0; i < 64; ++i) { if (u[i] >= T) { if (pos < 256) sel[pos] = (unsigned short)(64 * i + lane); ++pos; } }
            if (lane == 0) (dry ? (int*)(ar + DUMMY_OFF + 32 * MiB) + F.gw : CNT + bl * SEQ + tq)[0] = base < 256 ? base : 256;
        }
    }
}
DI int dsa_fsw(int row) { return ((row & 3) << 2) | ((row >> 2) & 3); }
struct DsaPre { u32x4 row[16]; bf16x8 kpe[3]; bf16x8 q[3]; };
DI void dsa_prefetch(DsaPre& P, const bf16* LATC, const bf16* KPE, const bf16* QL, const bf16* QPE, int ml, int selv, int lane, int w) {
    const int bl = ml >> 12, r = lane & 31, h = lane >> 5;
#pragma unroll
    for (int it = 0; it < 16; ++it) { const int ki = __shfl(selv, (lane >> 5) + 2 * it); P.row[it] = *(const u32x4*)(LATC + (size_t)(bl * SEQ + ki) * 256 + (lane & 31) * 8); }
#pragma unroll
    for (int s = 0; s < 3; ++s) P.kpe[s] = *(const bf16x8*)(KPE + (size_t)(bl * SEQ + selv) * 48 + 16 * s + 8 * h);
#pragma unroll
    for (int j = 0; j < 3; ++j) { const int fi = w + 8 * j;
        if (fi < 16) P.q[j] = *(const bf16x8*)(QL + (size_t)ml * 8192 + r * 256 + 16 * fi + 8 * h);
        else if (fi < 19) P.q[j] = *(const bf16x8*)(QPE + (size_t)ml * 1536 + r * 48 + 16 * (fi - 16) + 8 * h); }
}
DI void ph_dsa_attn(const Frame& F, const int dry = 0) {
    unsigned char* ar = F.ws + WS_AR;
    bf16* QL = (bf16*)(ar + DA_QL); const bf16* QPE = (const bf16*)(ar + DA_QPE); const bf16* LATC = (const bf16*)(ar + DA_LATC); const bf16* KPE = (const bf16*)(ar + DA_KPE);
    const unsigned short* SEL = (const unsigned short*)(ar + DA_SEL); const int* CNT = (const int*)(ar + DA_CNT);
    const int lane = F.lane, r = lane & 31, h = lane >> 5, w = F.wave;
    LAS unsigned char* IMG = F.lds; LAS unsigned char* QB = F.lds + LDSCTL_OFF + 256; LAS float* MX = (LAS float*)(F.lds + LDSCTL_OFF + 256 + 19456); LAS float* SX = MX + 256;
    const int i16 = lane & 15, tq_ = i16 >> 2, tp_ = i16 & 3, blk = (lane >> 4) & 1;
    int ml = blockIdx.x;
    if (ml >= MC) return;
    DsaPre P;
    int cnt_c = CNT[ml];
    { const int slot = 32 * w + r; const int selv = slot < cnt_c ? (int)SEL[(size_t)ml * 256 + slot] : 0; dsa_prefetch(P, LATC, KPE, QL, QPE, ml, selv, lane, w); }
    int cnt_n = 0, selv_n = 0;
    if (ml + F.G < MC) { cnt_n = CNT[ml + F.G]; const int slot = 32 * w + r; selv_n = slot < cnt_n ? (int)SEL[(size_t)(ml + F.G) * 256 + slot] : 0; }
#pragma unroll 1
    for (; ml < MC; ml += F.G) {
        const int cnt = cnt_c, nch = (cnt + 31) >> 5; const bool act = w < nch;
#pragma unroll
        for (int it = 0; it < 16; ++it) { const int rr = (lane >> 5) + 2 * it; *(LAS u32x4*)(IMG + (32 * w + rr) * 512 + (((lane & 31) ^ dsa_fsw(rr)) * 16)) = P.row[it]; }
#pragma unroll
        for (int j = 0; j < 3; ++j) { const int fi = w + 8 * j; if (fi < 19) *(LAS bf16x8*)(QB + fi * 1024 + lane * 16) = P.q[j]; }
        bf16x8 kpe[3];
#pragma unroll
        for (int s = 0; s < 3; ++s) kpe[s] = P.kpe[s];
        LDS_WAIT(); __builtin_amdgcn_s_barrier(); asm volatile("" ::: "memory");
        if (ml + F.G < MC) {
            dsa_prefetch(P, LATC, KPE, QL, QPE, ml + F.G, selv_n, lane, w); cnt_c = cnt_n;
            if (ml + 2 * F.G < MC) { cnt_n = CNT[ml + 2 * F.G]; const int slot = 32 * w + r; selv_n = slot < cnt_n ? (int)SEL[(size_t)(ml + 2 * F.G) * 256 + slot] : 0; }
        }
        f32x16 S; float mx = -INFINITY;
#pragma unroll
        for (int i = 0; i < 16; ++i) S[i] = 0.f;
        if (act) {
#pragma unroll
            for (int s = 0; s < 16; ++s) S = MFMA32(*(const LAS bf16x8*)(IMG + (32 * w + r) * 512 + (((2 * s + h) ^ dsa_fsw(r)) * 16)), *(const LAS bf16x8*)(QB + s * 1024 + lane * 16), S);
#pragma unroll
            for (int s = 0; s < 3; ++s) S = MFMA32(kpe[s], *(const LAS bf16x8*)(QB + (16 + s) * 1024 + lane * 16), S);
#pragma unroll
            for (int i = 0; i < 16; ++i) { S[i] = (32 * w + crow(i, h) < cnt) ? S[i] : -INFINITY; mx = fmaxf(mx, S[i]); }
            mx = fmaxf(mx, __shfl_xor(mx, 32));
        }
        if (h == 0) MX[w * 32 + r] = mx;
        LDS_WAIT(); __builtin_amdgcn_s_barrier(); asm volatile("" ::: "memory");
        float M = MX[r];
#pragma unroll
        for (int k = 1; k < 8; ++k) M = fmaxf(M, MX[k * 32 + r]);
        float lsum = 0.f; bf16x8 pf[2] = {(bf16x8){0, 0, 0, 0, 0, 0, 0, 0}, (bf16x8){0, 0, 0, 0, 0, 0, 0, 0}};
        if (act) {
#pragma unroll
            for (int i = 0; i < 16; ++i) { S[i] = __builtin_amdgcn_exp2f(S[i] - M); lsum += S[i]; }
#pragma unroll
            for (int s = 0; s < 2; ++s) { u32x4 t; t.x = pk2(S[8 * s], S[8 * s + 1]); t.y = pk2(S[8 * s + 2], S[8 * s + 3]); t.z = pk2(S[8 * s + 4], S[8 * s + 5]); t.w = pk2(S[8 * s + 6], S[8 * s + 7]); pf[s] = __builtin_bit_cast(bf16x8, t); }
        }
        lsum += __shfl_xor(lsum, 32);
        if (h == 0) SX[w * 32 + r] = lsum;
        *(LAS bf16x8*)(QB + (2 * w) * 1024 + lane * 16) = pf[0]; *(LAS bf16x8*)(QB + (2 * w + 1) * 1024 + lane * 16) = pf[1];
        LDS_WAIT(); __builtin_amdgcn_s_barrier(); asm volatile("" ::: "memory");
        f32x16 O;
#pragma unroll
        for (int i = 0; i < 16; ++i) O[i] = 0.f;
#pragma unroll 2
        for (int ks = 0; ks < 2 * nch; ++ks) {
            const int r0 = 16 * ks + 4 * h + tq_, r1 = r0 + 8, pc = 4 * w + 2 * blk + (tp_ >> 1);
            const s16x4 lo = __builtin_bit_cast(s16x4, __builtin_amdgcn_ds_read_tr16_b64_v4i16((LAS v4i16_t*)(IMG + r0 * 512 + ((pc ^ dsa_fsw(r0)) * 16) + 8 * (tp_ & 1))));
            const s16x4 hi = __builtin_bit_cast(s16x4, __builtin_amdgcn_ds_read_tr16_b64_v4i16((LAS v4i16_t*)(IMG + r1 * 512 + ((pc ^ dsa_fsw(r1)) * 16) + 8 * (tp_ & 1))));
            O = MFMA32(__builtin_shufflevector(lo, hi, 0, 1, 2, 3, 4, 5, 6, 7), *(const LAS bf16x8*)(QB + ks * 1024 + lane * 16), O);
        }
        float l = SX[r];
#pragma unroll
        for (int k = 1; k < 8; ++k) l += SX[k * 32 + r];
        const float linv = 1.0f / l;
        bf16* o = (dry ? (bf16*)(ar + DUMMY_OFF) + (size_t)blockIdx.x * 8192 : QL + (size_t)ml * 8192) + r * 256 + 32 * w + 4 * h;
#pragma unroll
        for (int g = 0; g < 4; ++g) { u32x2 t; t.x = pk2(O[4 * g] * linv, O[4 * g + 1] * linv); t.y = pk2(O[4 * g + 2] * linv, O[4 * g + 3] * linv); *(u32x2*)(o + 8 * g) = t; }
        LDS_WAIT(); __builtin_amdgcn_s_barrier(); asm volatile("" ::: "memory");
    }
}
template <int NDB> DI void softmax_step(f32x16& S, float& m, float& l, f32x16 (&O)[NDB], bf16x8 (&pf)[2]) {
    float mx = S[0];
#pragma unroll
    for (int i = 1; i < 16; ++i) mx = fmaxf(mx, S[i]);
    mx = fmaxf(mx, __shfl_xor(mx, 32));
    const float mn = fmaxf(m, mx), ms = (mn == -INFINITY) ? 0.f : mn;
    const float alpha = __builtin_amdgcn_exp2f(m - ms);
    float sum = 0.f;
#pragma unroll
    for (int i = 0; i < 16; ++i) { S[i] = __builtin_amdgcn_exp2f(S[i] - ms); sum += S[i]; }
    l = l * alpha + sum; m = mn;
    if (__builtin_amdgcn_ballot_w64(alpha != 1.0f) != 0ull) {
#pragma unroll
        for (int db = 0; db < NDB; ++db)
#pragma unroll
            for (int i = 0; i < 16; ++i) O[db][i] *= alpha;
    }
#pragma unroll
    for (int s = 0; s < 2; ++s) { u32x4 w; w.x = pk2(S[8 * s], S[8 * s + 1]); w.y = pk2(S[8 * s + 2], S[8 * s + 3]); w.z = pk2(S[8 * s + 4], S[8 * s + 5]); w.w = pk2(S[8 * s + 6], S[8 * s + 7]); pf[s] = __builtin_bit_cast(bf16x8, w); }
}
template <int NQ, int NDB, bool PV, bool QL, bool FRAG, class KA, class VA, class MK>
DI void attn_run(const bf16x8 (&qf)[NQ], const LAS unsigned char* qlds, f32x16 (&O)[NDB], float& m, float& l, int tb, int te, const KA& ka, const VA& va, const MK& mk) {
    if (tb >= te) return;
    bf16x8 kf[NQ];
    { const bf16* kp = ka(tb);
#pragma unroll
      for (int s = 0; s < NQ; ++s) kf[s] = *(const bf16x8*)(kp + (FRAG ? 512 : 16) * s); }
    for (int t = tb; t < te; ++t) {
        bf16x8 vf[NDB][2];
        if (PV) {
#pragma unroll
            for (int db = 0; db < NDB; ++db) { const bf16* vp = va(t, db);
#pragma unroll
                for (int s = 0; s < 2; ++s) { if (FRAG) vf[db][s] = *(const bf16x8*)(vp + 512 * s); else vf[db][s] = __builtin_shufflevector(*(const s16x4*)(vp + 16 * s), *(const s16x4*)(vp + 16 * s + 8), 0, 1, 2, 3, 4, 5, 6, 7); } }
        }
        f32x16 S;
#pragma unroll
        for (int i = 0; i < 16; ++i) S[i] = 0.f;
#pragma unroll
        for (int s = 0; s < NQ; ++s) { if (QL) { unsigned qa_ = (unsigned)(size_t)qlds; asm volatile("" : "+v"(qa_)); S = MFMA32(kf[s], *(const LAS bf16x8*)((LAS unsigned char*)(size_t)qa_ + s * 1024), S); } else S = MFMA32(kf[s], qf[s], S); }
        if (t + 1 < te) { const bf16* kp = ka(t + 1);
#pragma unroll
            for (int s = 0; s < NQ; ++s) kf[s] = *(const bf16x8*)(kp + (FRAG ? 512 : 16) * s); }
        mk(t, S);
        bf16x8 pf[2]; softmax_step<NDB>(S, m, l, O, pf);
        if (PV) {
#pragma unroll
            for (int db = 0; db < NDB; ++db)
#pragma unroll
                for (int s = 0; s < 2; ++s) O[db] = MFMA32(vf[db][s], pf[s], O[db]);
        }
    }
}
template <bool ACC> DI void store_col(bf16* out, const f32x16 (&O)[4], float scale, int h) {
#pragma unroll
    for (int db = 0; db < 4; ++db)
#pragma unroll
        for (int g = 0; g < 4; ++g) { u32x2* p = (u32x2*)(out + db * 32 + 8 * g + 4 * h);
            float a = O[db][4 * g] * scale, b = O[db][4 * g + 1] * scale, c = O[db][4 * g + 2] * scale, d = O[db][4 * g + 3] * scale;
            if (ACC) { const u32x2 o = *p; a += bflo(o.x); b += bfhi(o.x); c += bflo(o.y); d += bfhi(o.y); }
            u32x2 w; w.x = pk2(a, b); w.y = pk2(c, d); *p = w; }
}
template <int NQ> struct TilePre { u32x4 a, b, c; };
template <int NQ, class SRC> DI void tile_fetch(TilePre<NQ>& p, const SRC& src, int T, int tid) {
    const bf16* k = src.k(T); const bf16* v = src.v(T);
    constexpr int NK = NQ * 64;
    p.a = *(const u32x4*)(k + (size_t)tid * 8);
    const int p1 = tid + 512; p.b = (p1 < NK) ? *(const u32x4*)(k + (size_t)p1 * 8) : *(const u32x4*)(v + (size_t)(p1 - NK) * 8);
    if (NQ * 64 + 512 > 1024) { const int p2 = tid + 1024; if (p2 < NK + 512) p.c = *(const u32x4*)(v + (size_t)(p2 - NK) * 8); }
}
template <int NQ> DI void tile_put(const TilePre<NQ>& p, LAS unsigned char* buf, int tid) {
    *(LAS u32x4*)(buf + tid * 16) = p.a; *(LAS u32x4*)(buf + (tid + 512) * 16) = p.b;
    if (NQ * 64 + 512 > 1024) { if (tid + 1024 < NQ * 64 + 512) *(LAS u32x4*)(buf + (tid + 1024) * 16) = p.c; }
}
template <int NQ, bool PV, class SRC, class MK>
DI void attn_run_sh(LAS unsigned char* tl, int tid, int lane, const bf16x8 (&qf)[NQ], f32x16 (&O)[4], float& m, float& l, int TB, int TE, int tb, int te, const SRC& src, const MK& mk) {
    constexpr int TBYTES = (NQ + 8) * 1024;
    if (TB >= TE) return;
    TilePre<NQ> pre;
    tile_fetch<NQ>(pre, src, TB, tid); tile_put<NQ>(pre, tl, tid);
    LDS_WAIT(); __builtin_amdgcn_s_barrier(); asm volatile("" ::: "memory");
#pragma unroll 1
    for (int T = TB; T < TE; ++T) {
        LAS unsigned char* cur = tl + ((T - TB) & 1) * TBYTES;
        if (T + 1 < TE) tile_fetch<NQ>(pre, src, T + 1, tid);
        if (T >= tb && T < te) {
            f32x16 S;
#pragma unroll
            for (int i = 0; i < 16; ++i) S[i] = 0.f;
#pragma unroll
            for (int s = 0; s < NQ; ++s) S = MFMA32(*(const LAS bf16x8*)(cur + s * 1024 + lane * 16), qf[s], S);
            mk(T, S);
            bf16x8 pf[2]; softmax_step<4>(S, m, l, O, pf);
            if (PV) {
#pragma unroll
                for (int db = 0; db < 4; ++db)
#pragma unroll
                    for (int s = 0; s < 2; ++s) O[db] = MFMA32(*(const LAS bf16x8*)(cur + (NQ + db * 2 + s) * 1024 + lane * 16), pf[s], O[db]);
            }
        }
        if (T + 1 < TE) tile_put<NQ>(pre, tl + ((T + 1 - TB) & 1) * TBYTES, tid);
        LDS_WAIT(); __builtin_amdgcn_s_barrier(); asm volatile("" ::: "memory");
    }
}
struct FragSrc { const bf16* kb; const bf16* vb; int nq; DI const bf16* k(int T) const { return kb + (size_t)T * nq * 512; } DI const bf16* v(int T) const { return vb + (size_t)T * 8 * 512; } };
constexpr size_t FA_Q = 0, FA_K = 64 * MiB, FA_F = 128 * MiB, FA_V = 136 * MiB, FA_CUM = 200 * MiB, FA_O = 202 * MiB, FA_KF = 266 * MiB, FA_VF = 330 * MiB;
constexpr size_t FW_IN = 0, FW_OUT = (size_t)6400 * 2048;
constexpr float FOX_QSCALE = 0.08838834764831845f * LOG2E;
DI void ph_fox_cvt(const Frame& F, const float* w_in, const float* w_out) {
    bf16* WB = (bf16*)(F.ws + WS_WMIX);
    cvt_job(F, w_in, 6160, DM, 0, 2048, WB + FW_IN, DM, 0, FOX_QSCALE);
    cvt_job(F, w_in, 6160, DM, 2048, 2048, WB + FW_IN, DM, 2048, 1.f);
    cvt_job(F, w_in, 6160, DM, 4096, 2048, WB + FW_IN, DM, 4096, 1.f);
    cvt_job(F, w_in, 6160, DM, 6144, 16, WB + FW_IN, DM, 6144, 1.f);
    zero_bf16(F, WB + FW_IN + (size_t)6160 * DM, (size_t)240 * DM);
    cvt_job(F, w_out, DM, DM, 0, DM, WB + FW_OUT, DM, 0, 1.f);
}
DI void ph_fox_scan(const Frame& F, const float* b_f) {
    unsigned char* ar = F.ws + WS_AR; const bf16* FB = (const bf16*)(ar + FA_F); float* CUM = (float*)(ar + FA_CUM);
    for (int w = F.gw; w < BPH * 16; w += F.NGW) {
        const int bl = w >> 4, hd = w & 15; const float bf_ = b_f[hd];
        float v[64]; float run = 0.f;
#pragma unroll
        for (int i = 0; i < 64; ++i) { const float x = bf2f(FB[(size_t)(bl * SEQ + F.lane * 64 + i) * 256 + hd]) + bf_;
            const float ls = fminf(x, 0.f) - log1pf(expf(-fabsf(x))); run += ls; v[i] = run; }
        float inc = run;
#pragma unroll
        for (int o = 1; o < 64; o <<= 1) { const float y = __shfl_up(inc, o); if (F.lane >= o) inc += y; }
        const float base = inc - run;
        float* dst = CUM + (size_t)w * SEQ + F.lane * 64;
#pragma unroll
        for (int i = 0; i < 64; i += 4) *(f32x4*)(dst + i) = (f32x4){(v[i] + base) * LOG2E, (v[i + 1] + base) * LOG2E, (v[i + 2] + base) * LOG2E, (v[i + 3] + base) * LOG2E};
    }
    const bf16* Kr = (const bf16*)(ar + FA_K); const bf16* Vr = (const bf16*)(ar + FA_V); bf16* KF = (bf16*)(ar + FA_KF); bf16* VF = (bf16*)(ar + FA_VF);
    const int r = F.lane & 31, h = F.lane >> 5;
    for (int u = F.gw; u < BPH * 16 * 128; u += F.NGW) {
        const int bh = u >> 7, tile = u & 127, bl = bh >> 4, hd = bh & 15;
        const bf16* krow_ = Kr + ((size_t)bl * SEQ + tile * 32 + r) * DM + hd * 128 + 8 * h;
        bf16* kd = KF + (((size_t)bh * 128 + tile) * 8 * 64 + F.lane) * 8;
#pragma unroll
        for (int s = 0; s < 8; ++s) *(u32x4*)(kd + s * 512) = *(const u32x4*)(krow_ + 16 * s);
        bf16* vd = VF + (((size_t)bh * 128 + tile) * 8 * 64 + F.lane) * 8;
#pragma unroll
        for (int db = 0; db < 4; ++db)
#pragma unroll
            for (int s = 0; s < 2; ++s) { unsigned short e[8];
#pragma unroll
                for (int j = 0; j < 8; ++j) e[j] = Vr[((size_t)bl * SEQ + tile * 32 + 16 * s + 8 * (j >> 2) + 4 * h + (j & 3)) * DM + hd * 128 + db * 32 + r];
                u32x4 w; w.x = e[0] | ((unsigned)e[1] << 16); w.y = e[2] | ((unsigned)e[3] << 16); w.z = e[4] | ((unsigned)e[5] << 16); w.w = e[6] | ((unsigned)e[7] << 16);
                *(u32x4*)(vd + (db * 2 + s) * 512) = w; }
    }
}
struct FragKA { const bf16* base; int nq; DI const bf16* operator()(int t) const { return base + (size_t)t * nq * 512; } };
struct FragVA { const bf16* base; DI const bf16* operator()(int t, int db) const { return base + ((size_t)t * 8 + db * 2) * 512; } };
struct FoxMK { const float* cum; float ct; int tq, h;
    DI void operator()(int t, f32x16& S) const {
        const int k0 = 32 * t + 4 * h;
#pragma unroll
        for (int g = 0; g < 4; ++g) { const f32x4 cs = *(const f32x4*)(cum + k0 + 8 * g);
#pragma unroll
            for (int e = 0; e < 4; ++e) S[4 * g + e] = (k0 + 8 * g + e <= tq) ? S[4 * g + e] + (ct - cs[e]) : -INFINITY; }
    } };
DI void ph_fox_attn(const Frame& F, const int dry = 0) {
    unsigned char* ar = F.ws + WS_AR; const bf16* Q = (const bf16*)(ar + FA_Q); const bf16* KF = (const bf16*)(ar + FA_KF); const bf16* VF = (const bf16*)(ar + FA_VF); const float* CUM = (const float*)(ar + FA_CUM); bf16* Ob = (bf16*)(ar + FA_O);
    const int r = F.lane & 31, h = F.lane >> 5;
    for (int wb = blockIdx.x; wb < BPH * 16 * 4; wb += F.G) {
        const int bh = wb >> 2, x = (wb & 3) * 8 + F.wave, bl = bh >> 4, hd = bh & 15;
#pragma unroll 1
        for (int k = 0; k < 4; ++k) {
            const int qt = (k == 0) ? x : (k == 1) ? 63 - x : (k == 2) ? 64 + x : 127 - x;
            const int qhi = (k == 0) ? (wb & 3) * 8 + 7 : (k == 1) ? 63 - (wb & 3) * 8 : (k == 2) ? 64 + (wb & 3) * 8 + 7 : 127 - (wb & 3) * 8;
            const int tq = qt * 32 + r; const size_t mrow = (size_t)bl * SEQ + tq;
            bf16x8 qf[8];
#pragma unroll
            for (int s = 0; s < 8; ++s) qf[s] = *(const bf16x8*)(Q + mrow * DM + hd * 128 + 16 * s + 8 * h);
            f32x16 O[4];
#pragma unroll
            for (int db = 0; db < 4; ++db)
#pragma unroll
                for (int i = 0; i < 16; ++i) O[db][i] = 0.f;
            float m = -INFINITY, l = 0.f;
            const float* cum = CUM + (size_t)bh * SEQ;
            const FragSrc src{KF + (size_t)bh * 128 * 8 * 512, VF + (size_t)bh * 128 * 8 * 512, 8}; const FoxMK mk{cum, cum[tq], tq, h};
            attn_run_sh<8, true>(F.lds, F.tid, F.lane, qf, O, m, l, 0, qhi + 1, 0, qt + 1, src, mk);
            l += __shfl_xor(l, 32);
            store_col<false>(dry ? (bf16*)(ar + DUMMY_OFF) + ((size_t)F.gw * 32 + r) * 128 : Ob + mrow * DM + hd * 128, O, l > 0.f ? 1.0f / l : 0.f, h);
        }
    }
}
typedef long fp8x8_t;
DI fp8x8_t pack_fp8x8(float a0, float a1, float a2, float a3, float a4, float a5, float a6, float a7) {
    int lo = 0, hi = 0;
    lo = __builtin_amdgcn_cvt_pk_fp8_f32(a0, a1, lo, false); lo = __builtin_amdgcn_cvt_pk_fp8_f32(a2, a3, lo, true);
    hi = __builtin_amdgcn_cvt_pk_fp8_f32(a4, a5, hi, false); hi = __builtin_amdgcn_cvt_pk_fp8_f32(a6, a7, hi, true);
    return (fp8x8_t)(((unsigned long long)(unsigned)hi << 32) | (unsigned long long)(unsigned)lo);
}
#define MFMA32F8(a, b, c) __builtin_amdgcn_mfma_f32_32x32x16_fp8_fp8((a), (b), (c), 0, 0, 0)
constexpr size_t NA_Q = 0, NA_KC = 288 * MiB, NA_VC = 313 * MiB, NA_KSR = 330 * MiB, NA_KWR = 354 * MiB, NA_GT = 378 * MiB, NA_VSR = 386 * MiB, NA_VWR = 402 * MiB, NA_GK = 418 * MiB, NA_GV = 420 * MiB,
                 NA_KCMP = 422 * MiB, NA_VCT = 424 * MiB, NA_SELB = 426 * MiB, NA_O = 428 * MiB,
                 NA_KSF = 620 * MiB, NA_KWF = 644 * MiB, NA_VSF = 668 * MiB, NA_VWF = 684 * MiB;
constexpr size_t NW_IN = 0, NW_W1K = (size_t)13312 * 2048, NW_W1V = NW_W1K + (size_t)256 * 6144, NW_W2K = NW_W1V + (size_t)256 * 4096, NW_W2V = NW_W2K + 65536, NW_OUT = NW_W2V + 65536;
constexpr float NSA_QSCALE = 0.07216878364870322f * LOG2E;
DI void ph_nsa_cvt(const Frame& F, const float* w_in, const float* k_pe, const float* k_w1, const float* k_b1, const float* k_w2, const float* v_pe, const float* v_w1, const float* v_b1, const float* v_w2, const float* w_out) {
    bf16* WB = (bf16*)(F.ws + WS_WMIX); float* BIAS = (float*)(F.ws + WS_MISC);
    cvt_job(F, w_in, 13200, DM, 0, 9216, WB + NW_IN, DM, 0, NSA_QSCALE);
    cvt_job(F, w_in, 13200, DM, 9216, 768, WB + NW_IN, DM, 9216, 1.f);
    cvt_job(F, w_in, 13200, DM, 9984, 512, WB + NW_IN, DM, 9984, 1.f);
    cvt_job(F, w_in, 13200, DM, 10496, 768, WB + NW_IN, DM, 10496, 1.f);
    cvt_job(F, w_in, 13200, DM, 11776, 768, WB + NW_IN, DM, 11264, 1.f);
    cvt_job(F, w_in, 13200, DM, 13056, 144, WB + NW_IN, DM, 12032, 1.f);
    zero_bf16(F, WB + NW_IN + (size_t)12176 * DM, (size_t)112 * DM);
    cvt_job(F, w_in, 13200, DM, 11264, 512, WB + NW_IN, DM, 12288, 1.f);
    cvt_job(F, w_in, 13200, DM, 12544, 512, WB + NW_IN, DM, 12800, 1.f);
    cvt_job(F, k_w1, 256, 6144, 0, 256, WB + NW_W1K, 6144, 0, 1.f);
    cvt_job(F, v_w1, 256, 4096, 0, 256, WB + NW_W1V, 4096, 0, 1.f);
    cvt_job(F, k_w2, 192, 256, 0, 192, WB + NW_W2K, 256, 0, 1.f); zero_bf16(F, WB + NW_W2K + 192 * 256, 64 * 256);
    cvt_job(F, v_w2, 128, 256, 0, 128, WB + NW_W2V, 256, 0, 1.f); zero_bf16(F, WB + NW_W2V + 128 * 256, 128 * 256);
    cvt_job(F, w_out, DM, 6144, 0, DM, WB + NW_OUT, 6144, 0, 1.f);
    for (int w = F.gw; w < 512; w += F.NGW) { const bool isk = w < 256; const int c = w & 255, n = isk ? 6144 : 4096; const float* pe = isk ? k_pe : v_pe; const float* w1 = isk ? k_w1 : v_w1;
        float s = 0.f; for (int i = F.lane; i < n; i += 64) s += pe[i] * w1[(size_t)i * 256 + c];
        s = wave_sum(s); if (F.lane == 0) BIAS[w] = s + (isk ? k_b1[c] : v_b1[c]); }
}
DI void ph_nsa_rope(const Frame& F, int half) {
    unsigned char* ar = F.ws + WS_AR; bf16* Q = (bf16*)(ar + NA_Q); bf16* KC = (bf16*)(ar + NA_KC);
    const bf16* KSR = (const bf16*)(ar + NA_KSR); const bf16* KWR = (const bf16*)(ar + NA_KWR); bf16* KSF = (bf16*)(ar + NA_KSF); bf16* KWF = (bf16*)(ar + NA_KWF);
    const float* c48 = (const float*)(F.ws + TAB_COS48); const float* s48 = (const float*)(F.ws + TAB_SIN48);
    for (int ml = F.gw; ml < MC; ml += F.NGW) {
        const size_t mg = (size_t)half * MC + ml; const int bl = ml >> 12, sq = ml & 4095;
        for (int p = F.lane; p < 1248; p += 64) {
            const int hd = p / 24, i = p - hd * 24; bf16* q;
            if (hd < 48) q = Q + (size_t)ml * 9216 + hd * 192 + i;
            else q = KC + ((size_t)(bl * 4 + hd - 48) * 4096 + sq) * 192 + i;
            const float x1 = bf2f(q[0]), x2 = bf2f(q[24]), c = c48[mg * 24 + i], s = s48[mg * 24 + i]; q[0] = f2bf(x1 * c - x2 * s); q[24] = f2bf(x1 * s + x2 * c);
        }
        const int tile = sq >> 5, rr = sq & 31;
        for (int u = F.lane; u < 168; u += 64) {
            const int tens = u / 84, uu = u - tens * 84, g = uu / 21, v = uu - g * 21;
            const bf16* src = (tens ? KWR : KSR) + (size_t)ml * 768 + g * 192;
            bf16* dst = (tens ? KWF : KSF) + ((size_t)((bl * 4 + g) * 128 + tile) * 12 * 64 + rr) * 8;
            if (v < 3) {
                const u32x4 a = *(const u32x4*)(src + 8 * v), b = *(const u32x4*)(src + 8 * v + 24); u32x4 o1, o2;
#pragma unroll
                for (int e = 0; e < 4; ++e) { const float c0 = c48[mg * 24 + 8 * v + 2 * e], s0 = s48[mg * 24 + 8 * v + 2 * e], c1 = c48[mg * 24 + 8 * v + 2 * e + 1], s1 = s48[mg * 24 + 8 * v + 2 * e + 1];
                    const float x1l = bflo(a[e]), x1h = bfhi(a[e]), x2l = bflo(b[e]), x2h = bfhi(b[e]);
                    o1[e] = pk2(x1l * c0 - x2l * s0, x1h * c1 - x2h * s1); o2[e] = pk2(x1l * s0 + x2l * c0, x1h * s1 + x2h * c1); }
                const int p1 = v, p2 = v + 3;
                if (tens) { *(u32x4*)(dst + ((p1 >> 1) * 64 + (p1 & 1) * 32) * 8) = o1; *(u32x4*)(dst + ((p2 >> 1) * 64 + (p2 & 1) * 32) * 8) = o2; }
                else { unsigned char* d8 = (unsigned char*)KSF + ((size_t)((bl * 4 + g) * 128 + tile) * 12 * 64 + rr) * 8;
                    *(fp8x8_t*)(d8 + ((p1 >> 1) * 64 + (p1 & 1) * 32) * 8) = pack_fp8x8(bflo(o1[0]), bfhi(o1[0]), bflo(o1[1]), bfhi(o1[1]), bflo(o1[2]), bfhi(o1[2]), bflo(o1[3]), bfhi(o1[3]));
                    *(fp8x8_t*)(d8 + ((p2 >> 1) * 64 + (p2 & 1) * 32) * 8) = pack_fp8x8(bflo(o2[0]), bfhi(o2[0]), bflo(o2[1]), bfhi(o2[1]), bflo(o2[2]), bfhi(o2[2]), bflo(o2[3]), bfhi(o2[3])); }
            } else { const int pc = v + 3; const u32x4 c = *(const u32x4*)(src + 8 * pc);
                if (tens) *(u32x4*)(dst + ((pc >> 1) * 64 + (pc & 1) * 32) * 8) = c;
                else { unsigned char* d8 = (unsigned char*)KSF + ((size_t)((bl * 4 + g) * 128 + tile) * 12 * 64 + rr) * 8;
                    *(fp8x8_t*)(d8 + ((pc >> 1) * 64 + (pc & 1) * 32) * 8) = pack_fp8x8(bflo(c[0]), bfhi(c[0]), bflo(c[1]), bfhi(c[1]), bflo(c[2]), bfhi(c[2]), bflo(c[3]), bfhi(c[3])); } }
        }
    }
    const bf16* VSR = (const bf16*)(ar + NA_VSR); const bf16* VWR = (const bf16*)(ar + NA_VWR); bf16* VSF = (bf16*)(ar + NA_VSF); bf16* VWF = (bf16*)(ar + NA_VWF);
    const int r = F.lane & 31, h = F.lane >> 5;
    for (int u = F.gw; u < 2 * BPH * 4 * 128; u += F.NGW) {
        const int tens = u >> 11, bg = (u >> 7) & 15, tile = u & 127, bl = bg >> 2, g = bg & 3;
        const bf16* src = (tens ? VWR : VSR) + ((size_t)bl * SEQ + tile * 32) * 512 + g * 128 + r;
        bf16* vd = (tens ? VWF : VSF) + (((size_t)bg * 128 + tile) * 8 * 64 + F.lane) * 8;
#pragma unroll
        for (int db = 0; db < 4; ++db)
#pragma unroll
            for (int s = 0; s < 2; ++s) { unsigned short e[8];
#pragma unroll
                for (int j = 0; j < 8; ++j) e[j] = src[(size_t)(16 * s + 8 * (j >> 2) + 4 * h + (j & 3)) * 512 + db * 32];
                if (tens) { u32x4 w; w.x = e[0] | ((unsigned)e[1] << 16); w.y = e[2] | ((unsigned)e[3] << 16); w.z = e[4] | ((unsigned)e[5] << 16); w.w = e[6] | ((unsigned)e[7] << 16);
                    *(u32x4*)(vd + (db * 2 + s) * 512) = w; }
                else *(fp8x8_t*)((unsigned char*)VSF + ((((size_t)bg * 128 + tile) * 8 + db * 2 + s) * 64 + F.lane) * 8) = pack_fp8x8(bf2f(e[0]), bf2f(e[1]), bf2f(e[2]), bf2f(e[3]), bf2f(e[4]), bf2f(e[5]), bf2f(e[6]), bf2f(e[7])); }
    }
}
DI float sigmoidf_(float x) { return __builtin_amdgcn_rcpf(1.0f + __builtin_amdgcn_exp2f(-x * LOG2E)); }
struct LinKA { const bf16* base; size_t tstride; DI const bf16* operator()(int t) const { return base + (size_t)t * tstride; } };
struct LinVA { const bf16* base; size_t dbstride; DI const bf16* operator()(int t, int db) const { return base + (size_t)db * dbstride + t * 32; } };
struct CmpMK { int tq, h; DI void operator()(int t, f32x16& S) const {
#pragma unroll
    for (int i = 0; i < 16; ++i) { const int n = 32 * t + crow(i, h); S[i] = (16 * n + 31 <= tq) ? S[i] : -INFINITY; } } };
struct WinMK { int tq, h; DI void operator()(int t, f32x16& S) const {
#pragma unroll
    for (int i = 0; i < 16; ++i) { const int k = 32 * t + crow(i, h); S[i] = (k <= tq && k > tq - 512) ? S[i] : -INFINITY; } } };
DI void ph_nsa_cmp(const Frame& F, const int dry = 0) {
    unsigned char* ar = F.ws + WS_AR; const bf16* Q = (const bf16*)(ar + NA_Q); const bf16* KCMP = (const bf16*)(ar + NA_KCMP); const bf16* VCT = (const bf16*)(ar + NA_VCT); const bf16* GT = (const bf16*)(ar + NA_GT);
    unsigned char* SELB = ar + NA_SELB; bf16* Ob = (bf16*)(ar + NA_O);
    LAS float* imp = (LAS float*)F.lds;
    LAS unsigned char* tl = F.lds + 20480;
    const int lane = F.lane, r = lane & 31, h = lane >> 5, tid = F.tid;
    for (int u = blockIdx.x; u < BPH * 4 * 64; u += F.G) {
        const int bg = u >> 6, qt64 = u & 63, bl = bg >> 2, g = bg & 3;
        for (int i = F.tid; i < 64 * 65; i += NWAVES * 64) imp[i] = 0.f;
        __syncthreads();
        const FragSrc src{KCMP + (size_t)bg * 8 * 12 * 512, VCT + (size_t)bg * 8 * 8 * 512, 12};
        const int tqmaxb = qt64 * 64 + 63, TE = (tqmaxb >= 31) ? ((tqmaxb - 31) / 16) / 32 + 1 : 0;
#pragma unroll 1
        for (int k = 0; k < 3; ++k) {
            const int idx = F.wave * 3 + k, j = idx >> 1, sub = idx & 1, ql = sub * 32 + r, tq = qt64 * 64 + ql, hd = g * 12 + j;
            const size_t mrow = (size_t)bl * SEQ + tq;
            bf16x8 qf[12];
#pragma unroll
            for (int s = 0; s < 12; ++s) qf[s] = *(const bf16x8*)(Q + mrow * 9216 + hd * 192 + 16 * s + 8 * h);
            const int tqmax = qt64 * 64 + sub * 32 + 31, te = (tqmax >= 31) ? ((tqmax - 31) / 16) / 32 + 1 : 0;
            const CmpMK mk{tq, h};
            f32x16 O[4];
#pragma unroll
            for (int db = 0; db < 4; ++db)
#pragma unroll
                for (int i = 0; i < 16; ++i) O[db][i] = 0.f;
            float m = -INFINITY, l = 0.f;
            attn_run_sh<12, false>(tl, tid, lane, qf, O, m, l, 0, TE, 0, te, src, mk);
            l += __shfl_xor(l, 32);
            const float linv = l > 0.f ? 1.0f / l : 0.f, ms = (m == -INFINITY) ? 0.f : m;
            if (TE > 0) {
                TilePre<12> pre;
                tile_fetch<12>(pre, src, 0, tid); tile_put<12>(pre, tl, tid);
                LDS_WAIT(); __builtin_amdgcn_s_barrier(); asm volatile("" ::: "memory");
#pragma unroll 1
                for (int t = 0; t < TE; ++t) {
                    LAS unsigned char* cur = tl + (t & 1) * 20480;
                    if (t + 1 < TE) tile_fetch<12>(pre, src, t + 1, tid);
                    if (t < te) {
                        f32x16 S;
#pragma unroll
                        for (int i = 0; i < 16; ++i) S[i] = 0.f;
#pragma unroll
                        for (int s = 0; s < 12; ++s) S = MFMA32(*(const LAS bf16x8*)(cur + s * 1024 + lane * 16), qf[s], S);
                        mk(t, S);
#pragma unroll
                        for (int i = 0; i < 16; ++i) S[i] = __builtin_amdgcn_exp2f(S[i] - ms) * linv;
#pragma unroll
                        for (int g4 = 0; g4 < 4; ++g4) { const float gs = (S[4 * g4] + S[4 * g4 + 1]) + (S[4 * g4 + 2] + S[4 * g4 + 3]); const int mb = 8 * t + 2 * g4 + h;
                            __hip_atomic_fetch_add(imp + ql * 65 + mb, gs, __ATOMIC_RELAXED, __HIP_MEMORY_SCOPE_WORKGROUP);
                            if (mb + 1 < 64) __hip_atomic_fetch_add(imp + ql * 65 + mb + 1, S[4 * g4 + 3], __ATOMIC_RELAXED, __HIP_MEMORY_SCOPE_WORKGROUP); }
                        bf16x8 pf[2];
#pragma unroll
                        for (int s = 0; s < 2; ++s) { u32x4 w; w.x = pk2(S[8 * s], S[8 * s + 1]); w.y = pk2(S[8 * s + 2], S[8 * s + 3]); w.z = pk2(S[8 * s + 4], S[8 * s + 5]); w.w = pk2(S[8 * s + 6], S[8 * s + 7]); pf[s] = __builtin_bit_cast(bf16x8, w); }
#pragma unroll
                        for (int db = 0; db < 4; ++db)
#pragma unroll
                            for (int s = 0; s < 2; ++s) O[db] = MFMA32(*(const LAS bf16x8*)(cur + (12 + db * 2 + s) * 1024 + lane * 16), pf[s], O[db]);
                    }
                    if (t + 1 < TE) tile_put<12>(pre, tl + ((t + 1) & 1) * 20480, tid);
                    LDS_WAIT(); __builtin_amdgcn_s_barrier(); asm volatile("" ::: "memory");
                }
            }
            const float gate = sigmoidf_(bf2f(GT[mrow * 256 + hd]));
            store_col<false>(dry ? (bf16*)(ar + DUMMY_OFF) + ((size_t)F.gw * 32 + r) * 128 : Ob + mrow * 6144 + hd * 128, O, gate, h);
        }
        __syncthreads();
#pragma unroll 1
        for (int k = 0; k < 8; ++k) {
            const int ql = F.wave * 8 + k, tq = qt64 * 64 + ql, cur = tq >> 6, mb = lane;
            const bool causal = mb <= cur, forced = (mb == 0) || (mb == cur) || (mb == cur - 1);
            const float v = causal ? (forced ? INFINITY : imp[ql * 65 + mb]) : -INFINITY;
            int rank = 0;
            for (int o = 0; o < 64; ++o) { const float vo = __shfl(v, o); rank += (vo > v || (vo == v && o < mb)) ? 1 : 0; }
            if (rank < 16) (dry ? ar + DUMMY_OFF + 32 * MiB + (size_t)F.gw * 16 : SELB + ((size_t)bg * 4096 + tq) * 16)[rank] = causal ? (unsigned char)mb : (unsigned char)0xFF;
        }
        __syncthreads();
    }
}
DI int sel_tile(const u32x4& sel, int t) { const int b = t >> 1; const unsigned w = (b < 4) ? sel.x : (b < 8) ? sel.y : (b < 12) ? sel.z : sel.w; return (int)((w >> ((b & 3) * 8)) & 0xFFu) * 2 + (t & 1); }
struct SelKA { const bf16* base; u32x4 sel; DI const bf16* operator()(int t) const { return base + (size_t)sel_tile(sel, t) * 12 * 512; } };
struct SelVA { const bf16* base; u32x4 sel; DI const bf16* operator()(int t, int db) const { return base + ((size_t)sel_tile(sel, t) * 8 + db * 2) * 512; } };
struct SelMK { u32x4 sel; int tq, h; DI void operator()(int t, f32x16& S) const { const int k0 = sel_tile(sel, t) * 32;
#pragma unroll
    for (int i = 0; i < 16; ++i) S[i] = (k0 + crow(i, h) <= tq) ? S[i] : -INFINITY; } };
DI void ph_nsa_sel(const Frame& F, const int dry = 0) {
    unsigned char* ar = F.ws + WS_AR; const bf16* Q = (const bf16*)(ar + NA_Q); const unsigned char* KS8 = ar + NA_KSF; const unsigned char* VS8 = ar + NA_VSF; const bf16* GT = (const bf16*)(ar + NA_GT);
    const unsigned char* SELB = ar + NA_SELB; bf16* Ob = (bf16*)(ar + NA_O);
    const int r = F.lane & 31, h = F.lane >> 5; const bool act = r < 12;
    for (int it = F.gw; it < BPH * 4 * SEQ; it += F.NGW) {
        const int bg = it >> 12, tq = it & 4095, bl = bg >> 2, g = bg & 3; const size_t mrow = (size_t)bl * SEQ + tq; const int hd = g * 12 + (act ? r : 0);
        fp8x8_t qf[12];
#pragma unroll
        for (int s = 0; s < 12; ++s) { const u32x4 q = *(const u32x4*)(Q + mrow * 9216 + hd * 192 + 16 * s + 8 * h); const float qs = act ? (1.0f / NSA_QSCALE) : 0.f;
            qf[s] = pack_fp8x8(bflo(q[0]) * qs, bfhi(q[0]) * qs, bflo(q[1]) * qs, bfhi(q[1]) * qs, bflo(q[2]) * qs, bfhi(q[2]) * qs, bflo(q[3]) * qs, bfhi(q[3]) * qs); }
        const u32x4 sel = *(const u32x4*)(SELB + (size_t)it * 16);
        const int nv = ((tq >> 6) + 1 < 16) ? (tq >> 6) + 1 : 16, te = 2 * nv;
        const unsigned char* kb = KS8 + ((size_t)bg * 128 * 12 * 64 + F.lane) * 8; const unsigned char* vb = VS8 + ((size_t)bg * 128 * 8 * 64 + F.lane) * 8;
        const SelMK mk{sel, tq, h};
        f32x16 O[4];
#pragma unroll
        for (int db = 0; db < 4; ++db)
#pragma unroll
            for (int i = 0; i < 16; ++i) O[db][i] = 0.f;
        float m = -INFINITY, l = 0.f;
        fp8x8_t kf[12];
        { const unsigned char* kp = kb + (size_t)sel_tile(sel, 0) * 12 * 512;
#pragma unroll
          for (int s = 0; s < 12; ++s) kf[s] = *(const fp8x8_t*)(kp + s * 512); }
#pragma unroll 1
        for (int t = 0; t < te; ++t) {
            fp8x8_t vf[8];
            { const unsigned char* vp = vb + (size_t)sel_tile(sel, t) * 8 * 512;
#pragma unroll
              for (int j = 0; j < 8; ++j) vf[j] = *(const fp8x8_t*)(vp + j * 512); }
            f32x16 S;
#pragma unroll
            for (int i = 0; i < 16; ++i) S[i] = 0.f;
#pragma unroll
            for (int s = 0; s < 12; ++s) S = MFMA32F8(kf[s], qf[s], S);
            if (t + 1 < te) { const unsigned char* kp = kb + (size_t)sel_tile(sel, t + 1) * 12 * 512;
#pragma unroll
                for (int s = 0; s < 12; ++s) kf[s] = *(const fp8x8_t*)(kp + s * 512); }
#pragma unroll
            for (int i = 0; i < 16; ++i) S[i] *= NSA_QSCALE;
            mk(t, S);
            bf16x8 pfb[2]; softmax_step<4>(S, m, l, O, pfb);
            const fp8x8_t p0 = pack_fp8x8(S[0], S[1], S[2], S[3], S[4], S[5], S[6], S[7]), p1 = pack_fp8x8(S[8], S[9], S[10], S[11], S[12], S[13], S[14], S[15]);
#pragma unroll
            for (int db = 0; db < 4; ++db) { O[db] = MFMA32F8(vf[db * 2], p0, O[db]); O[db] = MFMA32F8(vf[db * 2 + 1], p1, O[db]); }
        }
        l += __shfl_xor(l, 32);
        if (act) { const float gate = sigmoidf_(bf2f(GT[mrow * 256 + 48 + hd])); store_col<true>(dry ? (bf16*)(ar + DUMMY_OFF) + ((size_t)F.gw * 32 + r) * 128 : Ob + mrow * 6144 + hd * 128, O, l > 0.f ? gate / l : 0.f, h); }
    }
}
DI void ph_nsa_win(const Frame& F, const int dry = 0) {
    unsigned char* ar = F.ws + WS_AR; const bf16* Q = (const bf16*)(ar + NA_Q); const bf16* KWF = (const bf16*)(ar + NA_KWF); const bf16* VWF = (const bf16*)(ar + NA_VWF); const bf16* GT = (const bf16*)(ar + NA_GT); bf16* Ob = (bf16*)(ar + NA_O);
    const int r = F.lane & 31, h = F.lane >> 5;
    for (int idb = blockIdx.x; idb < BPH * 48 * 16; idb += F.G) {
        const int qt0 = (idb & 15) * 8, qt = qt0 + F.wave, bh = idb >> 4, hd = bh % 48, bl = bh / 48, g = hd / 12, bg = bl * 4 + g, tq = qt * 32 + r; const size_t mrow = (size_t)bl * SEQ + tq;
        bf16x8 qf[12];
#pragma unroll
        for (int s = 0; s < 12; ++s) qf[s] = *(const bf16x8*)(Q + mrow * 9216 + hd * 192 + 16 * s + 8 * h);
        const FragSrc src{KWF + (size_t)bg * 128 * 12 * 512, VWF + (size_t)bg * 128 * 8 * 512, 12}; const WinMK mk{tq, h};
        f32x16 O[4];
#pragma unroll
        for (int db = 0; db < 4; ++db)
#pragma unroll
            for (int i = 0; i < 16; ++i) O[db][i] = 0.f;
        float m = -INFINITY, l = 0.f;
        attn_run_sh<12, true>(F.lds, F.tid, F.lane, qf, O, m, l, qt0 >= 16 ? qt0 - 16 : 0, qt0 + 8, qt >= 16 ? qt - 16 : 0, qt + 1, src, mk);
        l += __shfl_xor(l, 32);
        const float gate = sigmoidf_(bf2f(GT[mrow * 256 + 96 + hd]));
        store_col<true>(dry ? (bf16*)(ar + DUMMY_OFF) + ((size_t)F.gw * 32 + r) * 128 : Ob + mrow * 6144 + hd * 128, O, l > 0.f ? gate / l : 0.f, h);
    }
}
#ifndef MK_ONE_LAUNCH
#define MK_ONE_LAUNCH 1
#endif
constexpr int NPH = 102;
struct Args { const float* in[58]; float* out; unsigned char* ws; int ph_lo, ph_hi; };
#ifndef PROBE_GEMM
#define PROBE_GEMM 0
#endif
#ifndef PROBE_PH
#define PROBE_PH 0
#endif
#define GEMM_AKOFF 0
#define GEMM_CALL(EpiT, Evar, Aptr, Bptr, Mv, Nv, Kv, ldav, ldbv, cidx) do { if (PROBE_GEMM) { const pg8::Gemm g0_{(const pg8::bf16_t*)(Aptr), (const pg8::bf16_t*)(Bptr), (Mv), (Nv), (Kv), (ldav), (ldbv), GEMM_AKOFF}; \
    pg8::StaticOrder S0_; S0_.init((Mv), (Nv), F.G, (cidx)); pg8::EpiDry E0_{(float*)(ar + DUMMY_OFF)}; pg8::gemm_phase<pg8::EpiDry, pg8::StaticOrder, true, true>((PG8_LAS unsigned char*)F.lds, g0_, S0_, E0_); __syncthreads(); } \
    const pg8::Gemm g_{(const pg8::bf16_t*)(Aptr), (const pg8::bf16_t*)(Bptr), (Mv), (Nv), (Kv), (ldav), (ldbv), GEMM_AKOFF}; \
    pg8::StaticOrder S_; S_.init((Mv), (Nv), F.G, (cidx)); pg8::gemm_phase<EpiT, pg8::StaticOrder, true, true>((PG8_LAS unsigned char*)F.lds, g_, S_, Evar); } while (0)
DI pg8::EpiBf16R epi1(bf16* base, int ldc) { pg8::EpiBf16R e; for (int s = 0; s < 8; ++s) { e.T.base[s] = base; e.T.ldc[s] = ldc; e.T.t0[s] = 0; e.T.gw[s] = 0; } e.T.nseg = 1; e.T.pad_ = 0; return e; }
#define PH_BEGIN if (ph >= lo && ph < hi) { Frame F; { unsigned long long w_ = (unsigned long long)args.ws; asm volatile("" : "+s"(w_)); F.ws = (unsigned char*)w_; F.ctl = (unsigned*)(F.ws + WS_CTL); } \
    F.lds = lds; F.tid = threadIdx.x; F.lane = F.tid & 63; F.wave = __builtin_amdgcn_readfirstlane(F.tid >> 6); F.G = gridDim.x; F.gw = blockIdx.x * NWAVES + F.wave; F.NGW = F.G * NWAVES; \
    float* out; { unsigned long long o_ = (unsigned long long)args.out; asm volatile("" : "+s"(o_)); out = (float*)o_; } \
    unsigned char* const ar = F.ws + WS_AR; bf16* const XN = (bf16*)(F.ws + WS_XN); bf16* const WB = (bf16*)(F.ws + WS_WMIX); bf16* const WUP = (bf16*)(F.ws + WS_WFFN); bf16* const WDN = WUP + (size_t)2 * DFF * DM; \
    const float* const res_mix = (ib == 2) ? args.in[0] : (const float*)out; (void)ar; (void)XN; (void)WB; (void)WUP; (void)WDN; (void)res_mix; (void)iff;
#define PH_END   if (ph + 1 < hi) { XcdBarrier b_; b_.bar = (unsigned*)F.ctl + CW_BAR; b_.x = xb_xcc_id(); b_.st = MISC + 8; xcd_barrier(b_); } } ++ph;
template <int LAYER> DI void run_cvt(const Args& args, LAS unsigned char* lds, volatile LAS unsigned* MISC, int& ph, const int lo, const int hi) {
    constexpr int ib = (LAYER == 0) ? 2 : (LAYER == 1) ? 17 : (LAYER == 2) ? 26 : 42;
    constexpr int iff = (LAYER == 0) ? 12 : (LAYER == 1) ? 21 : (LAYER == 2) ? 37 : 52;
    constexpr int kind = (LAYER == 1) ? 1 : (LAYER == 2) ? 2 : 0;
        PH_BEGIN
          for (int rep_ = 0; rep_ < (PROBE_PH == 11 ? 2 : 1); ++rep_) {
            if constexpr (kind == 0) ph_dsa_cvt(F, args.in[ib + 1], args.in[ib + 6], args.in[ib + 7], args.in[ib + 8], args.in[ib + 9]);
            else if constexpr (kind == 1) ph_fox_cvt(F, args.in[ib + 1], args.in[ib + 3]);
            else ph_nsa_cvt(F, args.in[ib + 1], args.in[ib + 2], args.in[ib + 3], args.in[ib + 4], args.in[ib + 5], args.in[ib + 6], args.in[ib + 7], args.in[ib + 8], args.in[ib + 9], args.in[ib + 10]);
            ph_cvt_ffn(F, args.in[iff + 1], args.in[iff + 4]); __syncthreads();
          }
        PH_END
}
template <int LAYER, int HALF> DI void run_half(const Args& args, LAS unsigned char* lds, volatile LAS unsigned* MISC, int& ph, const int lo, const int hi) {
    constexpr int ib = (LAYER == 0) ? 2 : (LAYER == 1) ? 17 : (LAYER == 2) ? 26 : 42;
    constexpr int iff = (LAYER == 0) ? 12 : (LAYER == 1) ? 21 : (LAYER == 2) ? 37 : 52;
    constexpr int kind = (LAYER == 1) ? 1 : (LAYER == 2) ? 2 : 0;
    constexpr int half = HALF;
            const int roff = half * MC;
            PH_BEGIN if (PROBE_PH == 9) { ph_rmsnorm(F, res_mix, roff, args.in[ib], XN); __syncthreads(); } ph_rmsnorm(F, res_mix, roff, args.in[ib], XN); PH_END
            if constexpr (kind == 0) {
                PH_BEGIN { pg8::EpiF32 E{(float*)(ar + DA_DIN), 1024}; GEMM_CALL(pg8::EpiF32, E, XN, WB + DW_W1, MC, 1024, DM, DM, DM, (int)blockIdx.x); } PH_END
                PH_BEGIN if (PROBE_PH == 10) { ph_dsa_post1(F, half, args.in[ib + 2], args.in[ib + 3], args.in[ib + 4], args.in[ib + 5]); __syncthreads(); } ph_dsa_post1(F, half, args.in[ib + 2], args.in[ib + 3], args.in[ib + 4], args.in[ib + 5]); PH_END
                PH_BEGIN { pg8::EpiBf16R E = epi1((bf16*)(ar + DA_QL), 8192); E.T.base[1] = (bf16*)(ar + DA_QPE); E.T.ldc[1] = 1536; E.T.t0[1] = 32; E.T.base[2] = (bf16*)(ar + DA_QIDX); E.T.ldc[2] = 2048; E.T.t0[2] = 38; E.T.nseg = 3;
                    GEMM_CALL(pg8::EpiBf16R, E, ar + DA_CQN, WB + DW_W2, MC, 11776, 512, 512, 512, (int)blockIdx.x); } PH_END
                PH_BEGIN ph_dsa_rope(F, half); PH_END
                PH_BEGIN if (PROBE_PH == 1) { ph_dsa_index(F, 1); __syncthreads(); } if (PROBE_PH == 7) { ph_dsa_index(F, 1, 1); __syncthreads(); } if (PROBE_PH == 8) { ph_dsa_index(F, 1, 2); __syncthreads(); } ph_dsa_index(F); PH_END
                PH_BEGIN if (PROBE_PH == 2) { ph_dsa_attn(F, 1); __syncthreads(); } ph_dsa_attn(F); PH_END
                PH_BEGIN {
                    pg8::EpiBf16R E = epi1((bf16*)(ar + DA_O2), 4096);
                    { const pg8::Gemm g_{(const pg8::bf16_t*)(ar + DA_QL), (const pg8::bf16_t*)(WB + DW_BD), MC, 4096, 512, 8192, 512, 512}; pg8::StaticOrder S_; S_.init(MC, 4096, F.G, (int)blockIdx.x);
                      pg8::gemm_phase<pg8::EpiBf16R, pg8::StaticOrder, true, true>((PG8_LAS unsigned char*)F.lds, g_, S_, E); } } PH_END
                PH_BEGIN { pg8::EpiRes E{res_mix, out, DM, roff}; GEMM_CALL(pg8::EpiRes, E, ar + DA_O2, WB + DW_WO, MC, DM, 4096, 4096, 4096, (int)blockIdx.x); } PH_END
            } else if constexpr (kind == 1) {
                PH_BEGIN { pg8::EpiBf16R E = epi1((bf16*)(ar + FA_Q), DM); E.T.base[1] = (bf16*)(ar + FA_K); E.T.ldc[1] = DM; E.T.t0[1] = 8; E.T.base[2] = (bf16*)(ar + FA_V); E.T.ldc[2] = DM; E.T.t0[2] = 16;
                    E.T.base[3] = (bf16*)(ar + FA_F); E.T.ldc[3] = 256; E.T.t0[3] = 24; E.T.nseg = 4;
                    GEMM_CALL(pg8::EpiBf16R, E, XN, WB + FW_IN, MC, 6400, DM, DM, DM, (int)blockIdx.x); } PH_END
                PH_BEGIN if (PROBE_PH == 10) { ph_fox_scan(F, args.in[ib + 2]); __syncthreads(); } ph_fox_scan(F, args.in[ib + 2]); PH_END
                PH_BEGIN if (PROBE_PH == 3) { ph_fox_attn(F, 1); __syncthreads(); } ph_fox_attn(F); PH_END
                PH_BEGIN { pg8::EpiRes E{res_mix, out, DM, roff}; GEMM_CALL(pg8::EpiRes, E, ar + FA_O, WB + FW_OUT, MC, DM, DM, DM, DM, (int)blockIdx.x); } PH_END
            } else {
                PH_BEGIN { pg8::EpiBf16R E = epi1((bf16*)(ar + NA_Q), 9216);
                    E.T.base[1] = (bf16*)(ar + NA_KC); E.T.ldc[1] = 192; E.T.t0[1] = 36; E.T.gw[1] = 192;
                    E.T.base[2] = (bf16*)(ar + NA_VC); E.T.ldc[2] = 128; E.T.t0[2] = 39; E.T.gw[2] = 128;
                    E.T.base[3] = (bf16*)(ar + NA_KSR); E.T.ldc[3] = 768; E.T.t0[3] = 41;
                    E.T.base[4] = (bf16*)(ar + NA_KWR); E.T.ldc[4] = 768; E.T.t0[4] = 44;
                    E.T.base[5] = (bf16*)(ar + NA_GT); E.T.ldc[5] = 256; E.T.t0[5] = 47;
                    E.T.base[6] = (bf16*)(ar + NA_VSR); E.T.ldc[6] = 512; E.T.t0[6] = 48;
                    E.T.base[7] = (bf16*)(ar + NA_VWR); E.T.ldc[7] = 512; E.T.t0[7] = 50; E.T.nseg = 8;
                    GEMM_CALL(pg8::EpiBf16R, E, XN, WB + NW_IN, MC, 13312, DM, DM, DM, (int)blockIdx.x); } PH_END
                PH_BEGIN ph_nsa_rope(F, half); PH_END
                PH_BEGIN {
                    const float* BIAS = (const float*)(args.ws + WS_MISC);
                    { pg8::EpiGelu E{(bf16*)(ar + NA_GK), 256, BIAS}; GEMM_CALL(pg8::EpiGelu, E, ar + NA_KC, WB + NW_W1K, 4096, 256, 6144, 3072, 6144, (int)blockIdx.x); }
                    { pg8::EpiGelu E{(bf16*)(ar + NA_GV), 256, BIAS + 256}; GEMM_CALL(pg8::EpiGelu, E, ar + NA_VC, WB + NW_W1V, 4096, 256, 4096, 2048, 4096, (int)((blockIdx.x + F.G - 16) % F.G)); }
                } PH_END
                PH_BEGIN {
                    { pg8::EpiBf16R E = epi1((bf16*)(ar + NA_KCMP), 12); E.T.gw[0] = -1; GEMM_CALL(pg8::EpiBf16R, E, ar + NA_GK, WB + NW_W2K, 4096, 256, 256, 256, 256, (int)blockIdx.x); }
                    { pg8::EpiBf16R E = epi1((bf16*)(ar + NA_VCT), 4); E.T.gw[0] = -2; GEMM_CALL(pg8::EpiBf16R, E, WB + NW_W2V, ar + NA_GV, 256, 4096, 256, 256, 256, (int)((blockIdx.x + F.G - 16) % F.G)); }
                } PH_END
                PH_BEGIN if (PROBE_PH == 4) { ph_nsa_cmp(F, 1); __syncthreads(); } ph_nsa_cmp(F); PH_END
                PH_BEGIN if (PROBE_PH == 5) { ph_nsa_sel(F, 1); __syncthreads(); } ph_nsa_sel(F); PH_END
                PH_BEGIN if (PROBE_PH == 6) { ph_nsa_win(F, 1); __syncthreads(); } ph_nsa_win(F); PH_END
                PH_BEGIN { pg8::EpiRes E{res_mix, out, DM, roff}; GEMM_CALL(pg8::EpiRes, E, ar + NA_O, WB + NW_OUT, MC, DM, 6144, 6144, 6144, (int)blockIdx.x); } PH_END
            }
            PH_BEGIN if (PROBE_PH == 9) { ph_rmsnorm(F, out, roff, args.in[iff], XN); __syncthreads(); } ph_rmsnorm(F, out, roff, args.in[iff], XN); PH_END
            PH_BEGIN { pg8::EpiConvGlu E{(pg8::bf16_t*)ar, (float*)(ar + 352 * MiB), args.in[iff + 2], args.in[iff + 3], (PG8_LAS float*)(F.lds + LDSCTL_OFF + 256), DFF};
                GEMM_CALL(pg8::EpiConvGlu, E, XN, WUP, MC, 2 * DFF, DM, DM, DM, (int)blockIdx.x); } PH_END
            PH_BEGIN ph_conv_fix(F, (const float*)(ar + 352 * MiB), (bf16*)ar, args.in[iff + 2], args.in[iff + 3]); PH_END
            PH_BEGIN { pg8::EpiRes E{out, out, DM, roff}; GEMM_CALL(pg8::EpiRes, E, ar, WDN, MC, DM, DFF, DFF, DFF, (int)blockIdx.x); } PH_END
}
__global__ void __launch_bounds__(NWAVES * 64, 2) mk_fwd(Args args) {
    extern __shared__ __attribute__((aligned(16))) unsigned char lds_[];
    LAS unsigned char* const lds = (LAS unsigned char*)lds_;
    volatile LAS unsigned* MISC = (volatile LAS unsigned*)(lds + LDSCTL_OFF);
    for (int u = threadIdx.x; u < 64; u += NWAVES * 64) ((LAS unsigned*)(lds + LDSCTL_OFF))[u] = 0u;
    __syncthreads();
    const int lo = args.ph_lo, hi = args.ph_hi;
    (void)xcd_barrier_post((unsigned*)(args.ws + WS_CTL) + CW_BAR, MISC + 8);
    int ph = 0;
    { constexpr int ib = 2, iff = 12; PH_BEGIN ph_tables(F, (const int*)args.in[1]); PH_END }
    run_cvt<0>(args, lds, MISC, ph, lo, hi); run_half<0, 0>(args, lds, MISC, ph, lo, hi); run_half<0, 1>(args, lds, MISC, ph, lo, hi);
    run_cvt<1>(args, lds, MISC, ph, lo, hi); run_half<1, 0>(args, lds, MISC, ph, lo, hi); run_half<1, 1>(args, lds, MISC, ph, lo, hi);
    run_cvt<2>(args, lds, MISC, ph, lo, hi); run_half<2, 0>(args, lds, MISC, ph, lo, hi); run_half<2, 1>(args, lds, MISC, ph, lo, hi);
    run_cvt<3>(args, lds, MISC, ph, lo, hi); run_half<3, 0>(args, lds, MISC, ph, lo, hi); run_half<3, 1>(args, lds, MISC, ph, lo, hi);
    { constexpr int ib = 42, iff = 52; PH_BEGIN ph_final_norm(F, out, args.in[57]); PH_END }
}
extern "C" void kernel_launch(void* const* d_in, const int* in_sizes, int n_in, void* d_out, int out_size, void* d_ws, size_t ws_size, hipStream_t stream) {
    static int grid = 0;
    if (grid == 0) {
        if (n_in != 58 || out_size != MTOT * DM || ws_size < WS_END) { fprintf(stderr, "kernel_launch: unexpected shapes (n_in %d, out %d, ws %zu)\n", n_in, out_size, ws_size); grid = -1; return; }
        int dev = 0, cus = 0;
        if (hipGetDevice(&dev) != hipSuccess || hipDeviceGetAttribute(&cus, hipDeviceAttributeMultiprocessorCount, dev) != hipSuccess) { grid = -1; return; }
        if (hipFuncSetAttribute((const void*)mk_fwd, hipFuncAttributeMaxDynamicSharedMemorySize, LDS_BYTES) != hipSuccess) { fprintf(stderr, "kernel_launch: hipFuncSetAttribute failed\n"); grid = -1; return; }
        int per_cu = 0;
        (void)hipOccupancyMaxActiveBlocksPerMultiprocessor(&per_cu, (const void*)mk_fwd, NWAVES * 64, LDS_BYTES);
        (void)hipGetLastError();
        grid = cus;
    }
    if (grid < 0) return;
    if (hipMemsetAsync((char*)d_ws + WS_CTL, 0, CTL_ZERO_BYTES, stream) != hipSuccess) return;
    Args a{};
    for (int i = 0; i < 58; ++i) a.in[i] = (const float*)d_in[i];
    a.out = (float*)d_out; a.ws = (unsigned char*)d_ws;
#if MK_ONE_LAUNCH
    a.ph_lo = 0; a.ph_hi = NPH;
    hipLaunchKernelGGL(mk_fwd, dim3(grid), dim3(NWAVES * 64), LDS_BYTES, stream, a);
#else
    for (int p = 0; p < NPH; ++p) { a.ph_lo = p; a.ph_hi = p + 1; hipLaunchKernelGGL(mk_fwd, dim3(grid), dim3(NWAVES * 64), LDS_BYTES, stream, a); }
#endif
}
```

```cpp
#include <hip/hip_runtime.h>
#include <cstdio>
#include <cstdint>
#define DI __device__ __forceinline__
namespace pg8 {
#define PG8_LAS __attribute__((address_space(3)))
typedef unsigned short bf16_t;
typedef short bf16x8 __attribute__((ext_vector_type(8)));
typedef float f32x4 __attribute__((ext_vector_type(4)));
typedef unsigned u32x4 __attribute__((ext_vector_type(4)));
constexpr int BM = 256, BK = 64, HALF = 128, HTB = HALF * BK * 2  , STAGE_BYTES = 8 * HTB, NXCD = 8, WGM = 8;

__host__ __device__ __forceinline__ int lds_byte(int r, int c) { const int st = (r >> 4) * 2 + (c >> 5), rr = r & 15, cc = c & 31, ob = rr * 64 + cc * 2; return st * 1024 + (ob ^ (((ob >> 9) & 1) << 5)); }
__host__ __device__ __forceinline__ void stage_rc(int b, int& R, int& C) { const int st = b / 1024, sb = b % 1024, swz = sb ^ (((sb >> 9) & 1) << 5); R = (st >> 1) * 16 + swz / 64; C = (st & 1) * 32 + (swz % 64) / 2; }
__host__ __device__ __forceinline__ int perm32(int rho) { const int n = rho >> 4, i = rho & 15; return 8 * (i >> 2) + 4 * n + (i & 3); }

struct Unit { int pm, pn; };
struct Gemm { const bf16_t* A; const bf16_t* Bt; int M, N, K, lda, ldb, akoff; };

struct StaticOrder {
    int nM, nN, nwg, G, c;
    __host__ __device__ void init(int M, int N, int G_, int c_) { nM = M / BM; nN = N / BM; nwg = nM * nN; G = G_; c = c_; }
    __host__ __device__ bool next(int i, Unit& u) const {
        const long L = (long)i * G + c; if (L >= nwg) return false;
        int wgid = (int)L; { const int q = nwg / NXCD, r = nwg % NXCD, xcd = wgid % NXCD, off = wgid / NXCD; wgid = (xcd < r ? xcd * (q + 1) : r * (q + 1) + (xcd - r) * q) + off; }
        const int nig = WGM * nN, gid = wgid / nig, fm = gid * WGM, gsz = (nM - fm) < WGM ? (nM - fm) : WGM;
        u.pm = fm + ((wgid % nig) % gsz); u.pn = (wgid % nig) / gsz; return true;
    }
    __device__ __forceinline__ void a_ready(const Unit&) const {}
    __device__ __forceinline__ void done(const Unit&) const {}
};
__device__ __forceinline__ unsigned cvt_pk_bf16(float lo, float hi) { unsigned r; asm volatile("v_cvt_pk_bf16_f32 %0, %1, %2" : "=v"(r) : "v"(lo), "v"(hi)); return r; }
template <class Epi, class Sched, bool ALIGN_EPI = false, bool SP2 = false>
__device__ __forceinline__ void gemm_phase(PG8_LAS unsigned char* lds, const Gemm g, const Sched& S, const Epi& E) {
    const int tid = threadIdx.x, wid = __builtin_amdgcn_readfirstlane(tid >> 6), lane = tid & 63, wr = wid >> 2, wc = wid & 3, fr = lane & 15, fq = lane >> 4;
    const int K = g.K, nt = K / BK;
    unsigned voffA[2], voffB[2];
#pragma unroll
    for (int i = 0; i < 2; ++i) { int R, C; stage_rc(tid * 16 + i * 8192, R, C); const int Rb = Epi::PERM ? ((R & ~31) + perm32(R & 31)) : R;
        voffA[i] = (unsigned)(R * g.lda + C) * 2u; voffB[i] = (unsigned)(Rb * g.ldb + C) * 2u; }
    const size_t kstep = (size_t)(BK * 2);
    const size_t hstepA = (size_t)HALF * g.lda * 2, hstepB = (size_t)HALF * g.ldb * 2;
    const size_t tstepA = 2 * hstepA, tstepB = 2 * hstepB;
    const unsigned ldsw = (unsigned)wid * 1024u;
    const int aoff = lds_byte(wr * 64 + fr, fq * 8), boff = lds_byte(wc * 32 + fr, fq * 8);
#define PG8_SA(b, h) (((b) * 2 + (h)) * HTB)
#define PG8_SB(b, h) ((4 + (b) * 2 + (h)) * HTB)
#define PG8_STAGE(bufoff, gbase, voff) do { _Pragma("unroll") for (int _i = 0; _i < 2; ++_i) \
        __builtin_amdgcn_global_load_lds((const unsigned*)((const char*)(gbase) + (voff)[_i]), (PG8_LAS unsigned*)(lds + (bufoff) + ldsw + _i * 8192), 16, 0, 0); } while (0)
#define PG8_LDA(dst, b, h) do { _Pragma("unroll") for (int m = 0; m < 4; ++m) _Pragma("unroll") for (int k = 0; k < 2; ++k) dst[m][k] = *(const PG8_LAS bf16x8*)(lds + PG8_SA(b, h) + aoff + m * 2048 + k * 1024); } while (0)
#define PG8_LDB(dst, b, h) do { _Pragma("unroll") for (int n = 0; n < 2; ++n) _Pragma("unroll") for (int k = 0; k < 2; ++k) dst[n][k] = *(const PG8_LAS bf16x8*)(lds + PG8_SB(b, h) + boff + n * 2048 + k * 1024); } while (0)
#define PG8_MMA(ai, bj, At, Bt) do { __builtin_amdgcn_s_setprio(1); _Pragma("unroll") for (int m = 0; m < 4; ++m) _Pragma("unroll") for (int n = 0; n < 2; ++n) _Pragma("unroll") for (int k = 0; k < 2; ++k) \
        acc[ai][bj][m][n] = __builtin_amdgcn_mfma_f32_16x16x32_bf16(Bt[n][k], At[m][k], acc[ai][bj][m][n], 0, 0, 0); __builtin_amdgcn_s_setprio(0); } while (0)
#define PG8_WAIT_V(n) asm volatile("s_waitcnt vmcnt(" #n ")" ::: "memory")
#define PG8_WAIT_L(n) asm volatile("s_waitcnt lgkmcnt(" #n ")" ::: "memory")
#define PG8_BAR __builtin_amdgcn_s_barrier()
#define PG8_SCHED __builtin_amdgcn_sched_barrier(0)
    Unit cur, nxt; int ui = 0;
    if (!S.next(0, cur)) return;
    f32x4 acc[2][2][4][2];
#pragma unroll
    for (int a = 0; a < 2; ++a)
#pragma unroll
        for (int b = 0; b < 2; ++b)
#pragma unroll
            for (int m = 0; m < 4; ++m)
#pragma unroll
                for (int n = 0; n < 2; ++n) acc[a][b][m][n] = (f32x4){0.f, 0.f, 0.f, 0.f};
    bf16x8 At[4][2], B0[2][2], B1[2][2];
    const char* cA = (const char*)g.A + (size_t)cur.pm * tstepA + (size_t)cur.pn * g.akoff * 2; const char* cB = (const char*)g.Bt + (size_t)cur.pn * tstepB;
    S.a_ready(cur);
    if constexpr (SP2) {
        PG8_STAGE(PG8_SB(0, 0), cB, voffB); PG8_STAGE(PG8_SB(0, 1), cB + hstepB, voffB); PG8_STAGE(PG8_SA(0, 0), cA, voffA); PG8_STAGE(PG8_SA(0, 1), cA + hstepA, voffA);
        if (wr == 1) PG8_BAR;
        PG8_WAIT_V(2); PG8_BAR;
        PG8_STAGE(PG8_SB(1, 0), cB + kstep, voffB); PG8_STAGE(PG8_SA(1, 0), cA + kstep, voffA); PG8_STAGE(PG8_SB(1, 1), cB + hstepB + kstep, voffB);
        PG8_WAIT_V(6); PG8_BAR;
    } else {
        PG8_STAGE(PG8_SB(0, 0), cB, voffB); PG8_STAGE(PG8_SA(0, 0), cA, voffA); PG8_STAGE(PG8_SB(0, 1), cB + hstepB, voffB); PG8_STAGE(PG8_SA(0, 1), cA + hstepA, voffA);
        if (wr == 1) PG8_BAR;
        PG8_WAIT_V(4); PG8_BAR;
        PG8_STAGE(PG8_SB(1, 0), cB + kstep, voffB); PG8_STAGE(PG8_SA(1, 0), cA + kstep, voffA); PG8_STAGE(PG8_SB(1, 1), cB + hstepB + kstep, voffB);
        PG8_WAIT_V(6); PG8_BAR;
    }
    for (;;) {
        const bool has_next = S.next(ui + 1, nxt);
        const char* nA = has_next ? (const char*)g.A + (size_t)nxt.pm * tstepA + (size_t)nxt.pn * g.akoff * 2 : cA; const char* nB = has_next ? (const char*)g.Bt + (size_t)nxt.pn * tstepB : cB;
        for (int t = 0; t < nt; t += 2) {
            const bool last = (t == nt - 2);
            const char* a1 = cA + (size_t)(t + 1) * kstep;
            const char* a2 = last ? nA : cA + (size_t)(t + 2) * kstep; const char* b2 = last ? nB : cB + (size_t)(t + 2) * kstep;
            const char* a3 = a2 + kstep; const char* b3 = b2 + kstep;
            if (last && has_next) S.a_ready(nxt);
            if constexpr (SP2) {
            PG8_LDB(B0, 0, 0); PG8_LDB(B1, 0, 1); PG8_SCHED; PG8_LDA(At, 0, 0); PG8_STAGE(PG8_SA(1, 1), a1 + hstepA, voffA);
            PG8_WAIT_V(8); PG8_WAIT_L(0); PG8_BAR; PG8_MMA(0, 0, At, B0); PG8_MMA(0, 1, At, B1); PG8_BAR; PG8_SCHED;
            PG8_LDA(At, 0, 1); PG8_STAGE(PG8_SB(0, 0), b2, voffB); PG8_STAGE(PG8_SB(0, 1), b2 + hstepB, voffB); PG8_STAGE(PG8_SA(0, 0), a2, voffA);
            PG8_WAIT_V(8); PG8_WAIT_L(0); PG8_BAR; PG8_MMA(1, 0, At, B0); PG8_MMA(1, 1, At, B1); PG8_BAR; PG8_SCHED;
            PG8_LDB(B0, 1, 0); PG8_LDB(B1, 1, 1); PG8_SCHED; PG8_LDA(At, 1, 0); PG8_STAGE(PG8_SA(0, 1), a2 + hstepA, voffA);
            PG8_WAIT_V(8); PG8_WAIT_L(0); PG8_BAR; PG8_MMA(0, 0, At, B0); PG8_MMA(0, 1, At, B1); PG8_BAR; PG8_SCHED;
            PG8_LDA(At, 1, 1); PG8_STAGE(PG8_SB(1, 0), b3, voffB); PG8_STAGE(PG8_SB(1, 1), b3 + hstepB, voffB); PG8_STAGE(PG8_SA(1, 0), a3, voffA);
            PG8_WAIT_V(8); PG8_WAIT_L(0); PG8_BAR; PG8_MMA(1, 0, At, B0); PG8_MMA(1, 1, At, B1); PG8_BAR; PG8_SCHED;
            } else {
            PG8_LDB(B0, 0, 0); PG8_SCHED; PG8_LDA(At, 0, 0); PG8_STAGE(PG8_SA(1, 1), a1 + hstepA, voffA);
            PG8_WAIT_L(8); PG8_BAR; PG8_WAIT_L(0); PG8_MMA(0, 0, At, B0); PG8_BAR; PG8_SCHED;
            PG8_LDB(B1, 0, 1); PG8_STAGE(PG8_SB(0, 0), b2, voffB);
            PG8_BAR; PG8_WAIT_L(0); PG8_MMA(0, 1, At, B1); PG8_BAR;
            PG8_LDA(At, 0, 1); PG8_STAGE(PG8_SA(0, 0), a2, voffA);
            PG8_BAR; PG8_WAIT_L(0); PG8_MMA(1, 0, At, B0); PG8_BAR; PG8_SCHED;
            PG8_STAGE(PG8_SB(0, 1), b2 + hstepB, voffB);
            PG8_WAIT_V(6); PG8_BAR; PG8_MMA(1, 1, At, B1); PG8_BAR;
            PG8_LDB(B0, 1, 0); PG8_SCHED; PG8_LDA(At, 1, 0); PG8_STAGE(PG8_SA(0, 1), a2 + hstepA, voffA);
            PG8_WAIT_L(8); PG8_BAR; PG8_WAIT_L(0); PG8_MMA(0, 0, At, B0); PG8_BAR; PG8_SCHED;
            PG8_LDB(B1, 1, 1); PG8_STAGE(PG8_SB(1, 0), b3, voffB);
            PG8_BAR; PG8_WAIT_L(0); PG8_MMA(0, 1, At, B1); PG8_BAR;
            PG8_LDA(At, 1, 1); PG8_STAGE(PG8_SA(1, 0), a3, voffA);
            PG8_BAR; PG8_WAIT_L(0); PG8_MMA(1, 0, At, B0); PG8_BAR; PG8_SCHED;
            PG8_STAGE(PG8_SB(1, 1), b3 + hstepB, voffB);
            PG8_WAIT_V(6); PG8_BAR; PG8_MMA(1, 1, At, B1); PG8_BAR;
            }
        }
        if constexpr (ALIGN_EPI) { if (wr == 0) PG8_BAR; }
        if constexpr (!Epi::AFTER_DRAIN) { E(acc, cur, wr, wc, fr, fq); S.done(cur); }
        if (!has_next) break;
#pragma unroll
        for (int a = 0; a < 2; ++a)
#pragma unroll
            for (int b = 0; b < 2; ++b)
#pragma unroll
                for (int m = 0; m < 4; ++m)
#pragma unroll
                    for (int n = 0; n < 2; ++n) acc[a][b][m][n] = (f32x4){0.f, 0.f, 0.f, 0.f};
        cur = nxt; cA = nA; cB = nB; ++ui;
        if constexpr (ALIGN_EPI) { if (wr == 1) PG8_BAR; }
    }
    PG8_WAIT_V(0);
    if constexpr (!ALIGN_EPI) { if (wr == 0) PG8_BAR; }
    PG8_BAR;
    if constexpr (Epi::AFTER_DRAIN) { E.fused(acc, cur, wr, wc, fr, fq, lds, wid, lane); S.done(cur); }
#undef PG8_SA
#undef PG8_SB
#undef PG8_STAGE
#undef PG8_LDA
#undef PG8_LDB
#undef PG8_MMA
#undef PG8_WAIT_V
#undef PG8_WAIT_L
#undef PG8_BAR
#undef PG8_SCHED
}
}
namespace pg8 {
typedef float f32x2 __attribute__((ext_vector_type(2)));
struct SegTab { bf16_t* base[8]; int ldc[8]; int t0[8]; int gw[8]; int nseg; int pad_; };
struct EpiBf16R {
    static constexpr bool PERM = true, AFTER_DRAIN = false;
    SegTab T;
    __device__ __forceinline__ void operator()(const f32x4 (&acc)[2][2][4][2], const Unit& u, int wr, int wc, int fr, int fq) const {
        bf16_t* base = T.base[0]; int ldc = T.ldc[0], gw = T.gw[0], t0 = T.t0[0];
#pragma unroll
        for (int s = 1; s < 8; ++s) if (s < T.nseg && u.pn >= T.t0[s]) { base = T.base[s]; ldc = T.ldc[s]; gw = T.gw[s]; t0 = T.t0[s]; }
        const int colt = (u.pn - t0) * BM, row0 = u.pm * BM + wr * 64 + fr;
#pragma unroll
        for (int ai = 0; ai < 2; ++ai)
#pragma unroll
            for (int m = 0; m < 4; ++m) { const int row = row0 + ai * HALF + m * 16;
#pragma unroll
                for (int bj = 0; bj < 2; ++bj) { const int col = colt + bj * HALF + wc * 32 + 8 * fq;
                    const f32x4 v0 = acc[ai][bj][m][0], v1 = acc[ai][bj][m][1];
                    u32x4 w; w.x = cvt_pk_bf16(v0[0], v0[1]); w.y = cvt_pk_bf16(v0[2], v0[3]); w.z = cvt_pk_bf16(v1[0], v1[1]); w.w = cvt_pk_bf16(v1[2], v1[3]);
                    if (gw == -2) {
                        if ((row >> 5) < ldc) { bf16_t* d0 = base + ((size_t)(((col >> 5) * ldc + (row >> 5)) * 2 + ((col >> 4) & 1)) * 64 + (row & 31)) * 8 + 4 * ((col >> 3) & 1);
                            typedef unsigned u32x2_ __attribute__((ext_vector_type(2)));
                            *(u32x2_*)d0 = (u32x2_){w.x, w.y}; *(u32x2_*)(d0 + 32 * 8) = (u32x2_){w.z, w.w}; }
                        continue; }
                    bf16_t* dst;
                    if (gw == 0) dst = base + (size_t)row * ldc + col;
                    else if (gw == -1) { if ((col >> 4) >= ldc) continue; dst = base + ((size_t)((row >> 5) * ldc + (col >> 4)) * 64 + ((col >> 3) & 1) * 32 + (row & 31)) * 8; }
                    else { const int g = col / gw, d = col - g * gw; dst = base + ((size_t)((row >> 12) * 4 + g) * 4096 + (row & 4095)) * gw + d; }
                    *(u32x4*)dst = w; } }
    }
};
struct EpiGelu {
    static constexpr bool PERM = true, AFTER_DRAIN = false;
    bf16_t* O; int ldc; const float* bias;
    static __device__ __forceinline__ float gelu(float x) { const float u2 = 1.5957691216f * (x + 0.044715f * x * x * x); const float e = __builtin_amdgcn_exp2f(-u2 * 1.4426950409f); return x * __builtin_amdgcn_rcpf(1.0f + e); }
    __device__ __forceinline__ void operator()(const f32x4 (&acc)[2][2][4][2], const Unit& u, int wr, int wc, int fr, int fq) const {
        const int row0 = u.pm * BM + wr * 64 + fr, col0 = u.pn * BM + wc * 32 + 8 * fq;
#pragma unroll
        for (int bj = 0; bj < 2; ++bj) { const f32x4 b0 = *(const f32x4*)(bias + col0 + bj * HALF), b1 = *(const f32x4*)(bias + col0 + bj * HALF + 4);
#pragma unroll
            for (int ai = 0; ai < 2; ++ai)
#pragma unroll
                for (int m = 0; m < 4; ++m) { const f32x4 v0 = acc[ai][bj][m][0] + b0, v1 = acc[ai][bj][m][1] + b1;
                    u32x4 w; w.x = cvt_pk_bf16(gelu(v0[0]), gelu(v0[1])); w.y = cvt_pk_bf16(gelu(v0[2]), gelu(v0[3])); w.z = cvt_pk_bf16(gelu(v1[0]), gelu(v1[1])); w.w = cvt_pk_bf16(gelu(v1[2]), gelu(v1[3]));
                    *(u32x4*)(O + (size_t)(row0 + ai * HALF + m * 16) * ldc + col0 + bj * HALF) = w; } }
    }
};
struct EpiF32 {
    static constexpr bool PERM = false, AFTER_DRAIN = false;
    float* C; int ldc;
    __device__ __forceinline__ void operator()(const f32x4 (&acc)[2][2][4][2], const Unit& u, int wr, int wc, int fr, int fq) const {
        const int row0 = u.pm * BM + wr * 64 + fr, col0 = u.pn * BM + wc * 32 + 4 * fq;
#pragma unroll
        for (int ai = 0; ai < 2; ++ai)
#pragma unroll
            for (int m = 0; m < 4; ++m) { float* rowp = C + (size_t)(row0 + ai * HALF + m * 16) * ldc + col0;
#pragma unroll
                for (int bj = 0; bj < 2; ++bj)
#pragma unroll
                    for (int n = 0; n < 2; ++n) *(f32x4*)(rowp + bj * HALF + n * 16) = acc[ai][bj][m][n]; }
    }
};
struct EpiRes {
    static constexpr bool PERM = false, AFTER_DRAIN = false;
    const float* res; float* out; int ldc; int row_off;
    __device__ __forceinline__ void operator()(const f32x4 (&acc)[2][2][4][2], const Unit& u, int wr, int wc, int fr, int fq) const {
        const int row0 = row_off + u.pm * BM + wr * 64 + fr, col0 = u.pn * BM + wc * 32 + 4 * fq;
#pragma unroll
        for (int ai = 0; ai < 2; ++ai)
#pragma unroll
            for (int m = 0; m < 4; ++m) { const size_t off = (size_t)(row0 + ai * HALF + m * 16) * ldc + col0;
                f32x4 r[2][2];
#pragma unroll
                for (int bj = 0; bj < 2; ++bj)
#pragma unroll
                    for (int n = 0; n < 2; ++n) r[bj][n] = *(const f32x4*)(res + off + bj * HALF + n * 16);
#pragma unroll
                for (int bj = 0; bj < 2; ++bj)
#pragma unroll
                    for (int n = 0; n < 2; ++n) *(f32x4*)(out + off + bj * HALF + n * 16) = r[bj][n] + acc[ai][bj][m][n];
                asm volatile("" ::: "memory"); }
    }
};
struct EpiDry {
    static constexpr bool PERM = false, AFTER_DRAIN = false;
    float* D;
    __device__ __forceinline__ void operator()(const f32x4 (&acc)[2][2][4][2], const Unit& u, int wr, int wc, int fr, int fq) const {
        float* p = D + ((size_t)blockIdx.x * 512 + threadIdx.x) * 64;
#pragma unroll
        for (int ai = 0; ai < 2; ++ai)
#pragma unroll
            for (int m = 0; m < 4; ++m)
#pragma unroll
                for (int bj = 0; bj < 2; ++bj) *(f32x4*)(p + ((ai * 4 + m) * 2 + bj) * 4) = acc[ai][bj][m][0] + acc[ai][bj][m][1];
    }
};
struct EpiConvGlu {
    static constexpr bool PERM = true, AFTER_DRAIN = false;
    bf16_t* G; float* UB; const float* cw; const float* cb; PG8_LAS float* xb; int dff;
    static __device__ __forceinline__ float shr(float old, float src, int n) { const int o = __builtin_bit_cast(int, old), s = __builtin_bit_cast(int, src);
        return __builtin_bit_cast(float, n == 1 ? __builtin_amdgcn_update_dpp(o, s, 0x111, 0xf, 0xf, false) : __builtin_amdgcn_update_dpp(o, s, 0x112, 0xf, 0xf, false)); }
    static __device__ __forceinline__ float ror(float src, int n) { const int s = __builtin_bit_cast(int, src);
        return __builtin_bit_cast(float, n == 1 ? __builtin_amdgcn_update_dpp(0, s, 0x121, 0xf, 0xf, false) : __builtin_amdgcn_update_dpp(0, s, 0x122, 0xf, 0xf, false)); }
    __device__ __forceinline__ void operator()(const f32x4 (&acc)[2][2][4][2], const Unit& u, int wr, int wc, int fr, int fq) const {
        typedef unsigned u32x2_ __attribute__((ext_vector_type(2)));
        if (fr >= 14) {
#pragma unroll
            for (int ai = 0; ai < 2; ++ai)
#pragma unroll
                for (int bj = 0; bj < 2; ++bj)
#pragma unroll
                    for (int n = 0; n < 2; ++n) *(PG8_LAS f32x4*)(xb + (((((ai * 2 + wr) * 4 + wc) * 2 + (fr - 14)) * 4 + fq) * 16) + (bj * 2 + n) * 4) = acc[ai][bj][3][n];
        }
        { const int ncol = 4 * dff / 2;
          const bool top = (wr == 0 && fr < 2), bot = (wr == 1 && fr >= 14);
          if (top || bot) { float* ub = UB + ((size_t)(u.pm * 4 + (top ? fr : 2 + fr - 14)) * ncol) + u.pn * BM + wc * 32 + 8 * fq;
#pragma unroll
            for (int bj = 0; bj < 2; ++bj)
#pragma unroll
                for (int n = 0; n < 2; ++n) *(f32x4*)(ub + bj * HALF + 4 * n) = top ? acc[0][bj][0][n] : acc[1][bj][3][n]; } }
        asm volatile("s_waitcnt lgkmcnt(0)" ::: "memory"); __builtin_amdgcn_s_barrier(); asm volatile("" ::: "memory");
        u32x2_ res[2][4][2];
        const int ch0 = u.pn * HALF + wc * 32 + 8 * fq;
#pragma unroll
        for (int n = 0; n < 2; ++n) {
            const float* wp = cw + ch0 + 4 * n; const float* bp = cb + ch0 + 4 * n;
            const f32x4 w0g = *(const f32x4*)(wp), w1g = *(const f32x4*)(wp + 2 * dff), w2g = *(const f32x4*)(wp + 4 * dff), bg = *(const f32x4*)(bp);
            const f32x4 w0v = *(const f32x4*)(wp + dff), w1v = *(const f32x4*)(wp + 3 * dff), w2v = *(const f32x4*)(wp + 5 * dff), bv = *(const f32x4*)(bp + dff);
#pragma unroll
            for (int ai = 0; ai < 2; ++ai)
#pragma unroll
                for (int m = 0; m < 4; ++m) {
                    const f32x4 cg = acc[ai][0][m][n], cv = acc[ai][1][m][n];
                    f32x4 b1g, b2g, b1v, b2v;
                    if (m > 0) {
#pragma unroll
                        for (int e = 0; e < 4; ++e) { b1g[e] = ror(acc[ai][0][m - 1][n][e], 1); b2g[e] = ror(acc[ai][0][m - 1][n][e], 2); b1v[e] = ror(acc[ai][1][m - 1][n][e], 1); b2v[e] = ror(acc[ai][1][m - 1][n][e], 2); }
                    } else {
                        const int sai = wr ? ai : ai - 1, swr = wr ? 0 : 1;
                        f32x4 x14g = {0.f, 0.f, 0.f, 0.f}, x15g = x14g, x14v = x14g, x15v = x14g;
                        if (sai >= 0) { const PG8_LAS float* xp = xb + (((((sai * 2 + swr) * 4 + wc) * 2) * 4 + fq) * 16);
                            x14g = *(const PG8_LAS f32x4*)(xp + n * 4); x14v = *(const PG8_LAS f32x4*)(xp + (2 + n) * 4); x15g = *(const PG8_LAS f32x4*)(xp + 64 + n * 4); x15v = *(const PG8_LAS f32x4*)(xp + 64 + (2 + n) * 4); }
                        b1g = x15g; b1v = x15v; b2g = fr == 0 ? x14g : x15g; b2v = fr == 0 ? x14v : x15v;
                    }
                    float o[4];
#pragma unroll
                    for (int e = 0; e < 4; ++e) {
                        const float p1g = shr(b1g[e], cg[e], 1), p2g = shr(b2g[e], cg[e], 2), p1v = shr(b1v[e], cv[e], 1), p2v = shr(b2v[e], cv[e], 2);
                        const float yg = bg[e] + w0g[e] * p2g + w1g[e] * p1g + w2g[e] * cg[e], yv = bv[e] + w0v[e] * p2v + w1v[e] * p1v + w2v[e] * cv[e];
                        o[e] = yg * __builtin_amdgcn_rcpf(1.0f + __builtin_amdgcn_exp2f(-yg * 1.4426950409f)) * yv;
                    }
                    res[ai][m][n] = (u32x2_){cvt_pk_bf16(o[0], o[1]), cvt_pk_bf16(o[2], o[3])};
                }
        }
        const int row0 = u.pm * BM + wr * 64 + fr;
#pragma unroll
        for (int ai = 0; ai < 2; ++ai)
#pragma unroll
            for (int m = 0; m < 4; ++m) *(u32x4*)(G + (size_t)(row0 + ai * HALF + m * 16) * dff + ch0) = (u32x4){res[ai][m][0].x, res[ai][m][0].y, res[ai][m][1].x, res[ai][m][1].y};
    }
};
}
constexpr int BATCH = 8, SEQ = 4096, DM = 2048, MTOT = BATCH * SEQ, MC = MTOT / 2  , BPH = BATCH / 2;
constexpr int DFF = 5632;
constexpr float NORM_EPS = 1e-6f, LOG2E = 1.4426950408889634f;
constexpr int NWAVES = 8;
constexpr size_t MiB = 1u << 20;
constexpr size_t WS_CTL = 0, CTL_ZERO_BYTES = 1 * MiB;
constexpr size_t WS_TAB = 1 * MiB;
constexpr size_t TAB_COS48 = WS_TAB, TAB_SIN48 = WS_TAB + 3 * MiB, TAB_COS32 = WS_TAB + 6 * MiB, TAB_SIN32 = WS_TAB + 8 * MiB;
constexpr size_t WS_WMIX = 12 * MiB;
constexpr size_t WS_WFFN = 100 * MiB;
constexpr size_t WS_MISC = 168 * MiB;
constexpr size_t WS_XN = 170 * MiB;
constexpr size_t WS_AR = 234 * MiB;
constexpr size_t WS_END = 1010 * MiB;
constexpr size_t DUMMY_OFF = 700 * MiB;
constexpr int CW_TMO = 0;
constexpr int CW_BAR = 4096;
constexpr int RING_BYTES = 131072;
constexpr int LDSCTL_OFF = 135168;
constexpr int LDS_BYTES = 163840;

#define GAS __attribute__((address_space(1)))
#define LAS __attribute__((address_space(3)))
typedef unsigned short bf16;
typedef unsigned u32x4 __attribute__((ext_vector_type(4)));
typedef unsigned u32x2 __attribute__((ext_vector_type(2)));
typedef float f32x4 __attribute__((ext_vector_type(4)));
typedef float f32x16 __attribute__((ext_vector_type(16)));
typedef short bf16x8 __attribute__((ext_vector_type(8)));
typedef short s16x4 __attribute__((ext_vector_type(4)));
typedef short v4i16_t __attribute__((ext_vector_type(4)));
typedef __bf16 bf16x2_t __attribute__((ext_vector_type(2)));
typedef float f32x2_t __attribute__((ext_vector_type(2)));
#define LDS_WAIT() asm volatile("s_waitcnt lgkmcnt(0)" ::: "memory")
#define VM_WAIT() asm volatile("s_waitcnt vmcnt(0)" ::: "memory")
#define MFMA32(a, b, c) __builtin_amdgcn_mfma_f32_32x32x16_bf16((a), (b), (c), 0, 0, 0)
DI unsigned pk2(float lo, float hi) { f32x2_t v = {lo, hi}; bf16x2_t b = __builtin_convertvector(v, bf16x2_t); return __builtin_bit_cast(unsigned, b); }
DI float bf2f(unsigned short b) { return __builtin_bit_cast(float, (unsigned)b << 16); }
DI float bflo(unsigned w) { return __builtin_bit_cast(float, w << 16); }
DI float bfhi(unsigned w) { return __builtin_bit_cast(float, w & 0xffff0000u); }
DI unsigned short f2bf(float f) { return (unsigned short)(pk2(f, 0.f) & 0xffffu); }
DI float wave_sum(float v) {
#pragma unroll
    for (int o = 1; o < 64; o <<= 1) v += __shfl_xor(v, o);
    return v;
}
DI int crow(int i, int h) { return (i & 3) + 8 * (i >> 2) + 4 * h; }
#define XB_TMO      128
#define XB_XCNT(j)  (256  + 64 * (j))
#define XB_XSUB(j)  (1280 + 64 * (j))
#define XB_XGEN(j)  (2304 + 64 * (j))
#define XB_TOP      3328
#define XB_TOPGEN   3392
#define XCD_BAR_WORDS 3456
#define XB_SPIN_CAP (1u << 18)

__device__ __forceinline__ unsigned xb_ld(unsigned* p)              { return __hip_atomic_load(p, __ATOMIC_RELAXED, __HIP_MEMORY_SCOPE_AGENT); }
__device__ __forceinline__ unsigned xb_add(unsigned* p, unsigned v) { return __hip_atomic_fetch_add(p, v, __ATOMIC_RELAXED, __HIP_MEMORY_SCOPE_AGENT); }
__device__ __forceinline__ unsigned xb_xcc_id() { return (unsigned)__builtin_amdgcn_s_getreg((3 << 11) | 20) & 0xFu; }
#define XB_SPIN(cond, bar) do { unsigned _sp = 0; while (cond) { __builtin_amdgcn_s_sleep(1); \
    if ((++_sp & 255u) == 0u) { if (xb_ld(&(bar)[XB_TMO])) break; if (_sp > XB_SPIN_CAP) { atomicAdd(&(bar)[XB_TMO], 1u); break; } } } } while (0)

struct XcdBarrier {
    unsigned* bar; unsigned x;
    volatile LAS unsigned* st;
};

__device__ __forceinline__ XcdBarrier xcd_barrier_post(unsigned* bar, volatile LAS unsigned* st) {
    XcdBarrier b; b.bar = bar; b.x = xb_xcc_id(); b.st = st;
    if (threadIdx.x == 0) (void)xb_add(&bar[XB_XCNT(b.x)], 1u);
    return b;
}
__device__ __forceinline__ void xcd_barrier_complete(unsigned* bar, unsigned x, unsigned& nloc, unsigned& nx) {
    const unsigned G = gridDim.x * gridDim.y * gridDim.z;
    unsigned sum, cnt, mine, sp = 0u;
    for (;;) {
        sum = 0u; cnt = 0u; mine = 0u;
#pragma unroll
        for (unsigned j = 0; j < 16; ++j) { const unsigned c = xb_ld(&bar[XB_XCNT(j)]); sum += c; cnt += (c > 0u) ? 1u : 0u; mine = (j == x) ? c : mine; }
        if (sum == G) break;
        __builtin_amdgcn_s_sleep(1);
        if ((++sp & 255u) == 0u) { if (xb_ld(&bar[XB_TMO])) break; if (sp > XB_SPIN_CAP) { atomicAdd(&bar[XB_TMO], 1u); break; } }
    }
    nloc = mine > 0u ? mine : 1u; nx = cnt > 0u ? cnt : 1u;
}

__device__ __forceinline__ void xcd_barrier(const XcdBarrier& b) {
    asm volatile("s_waitcnt vmcnt(0)" ::: "memory");
    __syncthreads();
    if (threadIdx.x == 0) {
        unsigned* bar = b.bar;
        __builtin_amdgcn_s_waitcnt(0);
        unsigned nloc = b.st[0], nx = b.st[1];
        if (nloc == 0u) { xcd_barrier_complete(bar, b.x, nloc, nx); b.st[0] = nloc; b.st[1] = nx; }
        const unsigned old = xb_add(&bar[XB_XSUB(b.x)], 1u);
        const unsigned gen = old / nloc;
        if (old + 1u == (gen + 1u) * nloc) {
            __builtin_amdgcn_fence(__ATOMIC_RELEASE, "agent");
            asm volatile("s_waitcnt vmcnt(0)" ::: "memory");
            const unsigned og = xb_add(&bar[XB_TOP], 1u);
            const unsigned tg = og / nx;
            if (og + 1u == (tg + 1u) * nx) xb_add(&bar[XB_TOPGEN], 1u);
            else XB_SPIN(xb_ld(&bar[XB_TOPGEN]) == tg, bar);
            __builtin_amdgcn_fence(__ATOMIC_ACQUIRE, "agent");
            xb_add(&bar[XB_XGEN(b.x)], 1u);
            asm volatile("s_waitcnt vmcnt(0)" ::: "memory");
        } else {
            XB_SPIN(xb_ld(&bar[XB_XGEN(b.x)]) == gen, bar);
            __builtin_amdgcn_fence(__ATOMIC_ACQUIRE, "agent");
            asm volatile("s_waitcnt vmcnt(0)" ::: "memory");
        }
    }
    __syncthreads();
}
struct Frame {
    LAS unsigned char* lds; unsigned* ctl; unsigned char* ws;
    int tid, lane, wave, G, gw, NGW;
};
DI void ph_tables(const Frame& F, const int* pos) {
    float* c48 = (float*)(F.ws + TAB_COS48); float* s48 = (float*)(F.ws + TAB_SIN48); float* c32 = (float*)(F.ws + TAB_COS32); float* s32 = (float*)(F.ws + TAB_SIN32);
    const int gt = blockIdx.x * (NWAVES * 64) + F.tid, NT = F.G * NWAVES * 64;
    for (int i = gt; i < MTOT * 40; i += NT) {
        const int m = i / 40, j = i - m * 40; const float p = (float)pos[m];
        const bool a = j < 24; const int jj = a ? j : j - 24;
        const float inv = (float)exp(-(2.0 * jj / (a ? 48.0 : 32.0)) * 13.122363377404328);
        const float ang = p * inv; float sn, cs; sincosf(ang, &sn, &cs);
        if (a) { c48[m * 24 + jj] = cs; s48[m * 24 + jj] = sn; } else { c32[m * 16 + jj] = cs; s32[m * 16 + jj] = sn; }
    }
}
DI void cvt_load(float (&v)[32], const float* W, int ldw, int col0, int ncols, int item, int nblk, int lane) {
    const int kb = item / nblk, nb = item - kb * nblk, k0 = 64 * kb, n0 = 32 * nb, nn = n0 + (lane & 31); const bool ok = nn < ncols;
    const float* p = W + (size_t)(k0 + (lane >> 5)) * ldw + col0 + (ok ? nn : 0);
#pragma unroll
    for (int i = 0; i < 32; ++i) { const float x = p[(size_t)(2 * i) * ldw]; v[i] = ok ? x : 0.f; }
}
DI void cvt_store(const float (&v)[32], int ncols, bf16* WT, int ldt, int row_off, float scale, LAS float* scr, int item, int nblk, int lane) {
    const int kb = item / nblk, nb = item - kb * nblk, k0 = 64 * kb, n0 = 32 * nb;
#pragma unroll
    for (int i = 0; i < 32; ++i) scr[(2 * i + (lane >> 5)) * 33 + (lane & 31)] = v[i] * scale;
    LDS_WAIT();
    const int c = lane & 7;
#pragma unroll
    for (int j = 0; j < 4; ++j) { const int n = (lane >> 3) + 8 * j; const LAS float* s = scr + (8 * c) * 33 + n;
        u32x4 o; o.x = pk2(s[0 * 33], s[1 * 33]); o.y = pk2(s[2 * 33], s[3 * 33]); o.z = pk2(s[4 * 33], s[5 * 33]); o.w = pk2(s[6 * 33], s[7 * 33]);
        if (n0 + n < ncols) *(u32x4*)(WT + (size_t)(row_off + n0 + n) * ldt + k0 + 8 * c) = o; }
    LDS_WAIT();
}
DI void cvt_item(const float* W, int ldw, int col0, int ncols, bf16* WT, int ldt, int row_off, float scale, LAS float* scr, int item, int nblk, int lane) {
    float v[32]; cvt_load(v, W, ldw, col0, ncols, item, nblk, lane); cvt_store(v, ncols, WT, ldt, row_off, scale, scr, item, nblk, lane);
}
template <class MAP> DI void cvt_loop(const Frame& F, const float* W, int ldw, int ncols, bf16* WT, int ldt, float scale, int nitems, int nblk, const MAP& map) {
    LAS float* scr = (LAS float*)(F.lds + F.wave * 16384);
    int it = F.gw; float cur[32]; int c0 = 0, ro = 0, li = 0;
    if (it < nitems) { map(it, c0, ro, li); cvt_load(cur, W, ldw, c0, ncols, li, nblk, F.lane); }
#pragma unroll 1
    for (; it < nitems; it += F.NGW) {
        float nxt[32]; int c1 = 0, r1 = 0, l1 = 0; const int ni = it + F.NGW;
        if (ni < nitems) { map(ni, c1, r1, l1); cvt_load(nxt, W, ldw, c1, ncols, l1, nblk, F.lane); }
        cvt_store(cur, ncols, WT, ldt, ro, scale, scr, li, nblk, F.lane);
#pragma unroll
        for (int i = 0; i < 32; ++i) cur[i] = nxt[i];
        c0 = c1; ro = r1; li = l1;
    }
}
struct CvtPlain { int col0, row_off; DI void operator()(int it, int& c, int& r, int& l) const { c = col0; r = row_off; l = it; } };
DI void cvt_job(const Frame& F, const float* W, int ldw, int K, int col0, int ncols, bf16* WT, int ldt, int row_off, float scale) {
    const int nblk = (ncols + 31) / 32;
    cvt_loop(F, W, ldw, ncols, WT, ldt, scale, (K / 64) * nblk, nblk, CvtPlain{col0, row_off});
}
DI void zero_bf16(const Frame& F, bf16* p, size_t nelem) {
    const size_t gt = (size_t)blockIdx.x * (NWAVES * 64) + F.tid, NT = (size_t)F.G * NWAVES * 64;
    for (size_t i = gt; i < nelem / 8; i += NT) ((u32x4*)p)[i] = (u32x4){0u, 0u, 0u, 0u};
}
DI void ph_cvt_ffn(const Frame& F, const float* up, const float* down) {
    bf16* WUP = (bf16*)(F.ws + WS_WFFN); bf16* WDN = WUP + (size_t)2 * DFF * DM;
    struct UpMap { DI void operator()(int it, int& c, int& r, int& l) const { const int seg = it >> 7, pn = seg >> 1, isv = seg & 1; c = isv * DFF + pn * 128; r = pn * 256 + isv * 128; l = it & 127; } };
    cvt_loop(F, up, 2 * DFF, 128, WUP, DM, 1.f, 88 * 128, 4, UpMap{});
    cvt_job(F, down, DM, DFF, 0, DM, WDN, DFF, 0, 1.f);
}
DI void ph_conv_fix(const Frame& F, const float* UB, bf16* Gb, const float* cw, const float* cb) {
    const int gt = blockIdx.x * (NWAVES * 64) + F.tid, NT = F.G * NWAVES * 64;
    for (int it = gt; it < (MC / 256) * (DFF / 4); it += NT) {
        const int pm = it / (DFF / 4), c4 = it - pm * (DFF / 4), ch = c4 * 4, col = (ch >> 7) * 256 + (ch & 127);
        const float* ub = UB + (size_t)pm * 4 * (2 * DFF) + col; const bool has = (pm & 15) != 0;
        const f32x4 z = {0.f, 0.f, 0.f, 0.f};
        const f32x4 g0 = *(const f32x4*)(ub), g1 = *(const f32x4*)(ub + 2 * DFF), v0 = *(const f32x4*)(ub + 128), v1 = *(const f32x4*)(ub + 2 * DFF + 128);
        const f32x4 gm2 = has ? *(const f32x4*)(ub - 2 * (2 * DFF)) : z, gm1 = has ? *(const f32x4*)(ub - (2 * DFF)) : z, vm2 = has ? *(const f32x4*)(ub - 2 * (2 * DFF) + 128) : z, vm1 = has ? *(const f32x4*)(ub - (2 * DFF) + 128) : z;
        const f32x4 w0g = *(const f32x4*)(cw + ch), w1g = *(const f32x4*)(cw + 2 * DFF + ch), w2g = *(const f32x4*)(cw + 4 * DFF + ch), bg = *(const f32x4*)(cb + ch);
        const f32x4 w0v = *(const f32x4*)(cw + DFF + ch), w1v = *(const f32x4*)(cw + 3 * DFF + ch), w2v = *(const f32x4*)(cw + 5 * DFF + ch), bv = *(const f32x4*)(cb + DFF + ch);
        float o0[4], o1[4];
#pragma unroll
        for (int e = 0; e < 4; ++e) {
            const float yg0 = bg[e] + w0g[e] * gm2[e] + w1g[e] * gm1[e] + w2g[e] * g0[e], yv0 = bv[e] + w0v[e] * vm2[e] + w1v[e] * vm1[e] + w2v[e] * v0[e];
            const float yg1 = bg[e] + w0g[e] * gm1[e] + w1g[e] * g0[e] + w2g[e] * g1[e], yv1 = bv[e] + w0v[e] * vm1[e] + w1v[e] * v0[e] + w2v[e] * v1[e];
            o0[e] = yg0 * __builtin_amdgcn_rcpf(1.0f + __builtin_amdgcn_exp2f(-yg0 * LOG2E)) * yv0; o1[e] = yg1 * __builtin_amdgcn_rcpf(1.0f + __builtin_amdgcn_exp2f(-yg1 * LOG2E)) * yv1;
        }
        u32x2 a, b; a.x = pk2(o0[0], o0[1]); a.y = pk2(o0[2], o0[3]); b.x = pk2(o1[0], o1[1]); b.y = pk2(o1[2], o1[3]);
        *(u32x2*)(Gb + (size_t)(pm * 256) * DFF + ch) = a; *(u32x2*)(Gb + (size_t)(pm * 256 + 1) * DFF + ch) = b;
    }
}
DI void ph_rmsnorm(const Frame& F, const float* src, int row_off, const float* gain, bf16* XN) {
    f32x4 g[8];
#pragma unroll
    for (int j = 0; j < 8; ++j) g[j] = *(const f32x4*)(gain + 4 * (F.lane + 64 * j));
    for (int ml = F.gw; ml < MC; ml += F.NGW) {
        const f32x4* xr = (const f32x4*)(src + (size_t)(row_off + ml) * DM) + F.lane;
        f32x4 v[8]; float ss = 0.f;
#pragma unroll
        for (int j = 0; j < 8; ++j) { v[j] = xr[64 * j]; ss += (v[j].x * v[j].x + v[j].y * v[j].y) + (v[j].z * v[j].z + v[j].w * v[j].w); }
        const float rstd = 1.0f / sqrtf(wave_sum(ss) * (1.f / DM) + NORM_EPS);
        u32x2* o = (u32x2*)(XN + (size_t)ml * DM) + F.lane;
#pragma unroll
        for (int j = 0; j < 8; ++j) { const f32x4 y = v[j] * rstd * g[j]; u32x2 w; w.x = pk2(y.x, y.y); w.y = pk2(y.z, y.w); o[64 * j] = w; }
    }
}
DI void ph_final_norm(const Frame& F, float* h, const float* gain) {
    f32x4 g[8];
#pragma unroll
    for (int j = 0; j < 8; ++j) g[j] = *(const f32x4*)(gain + 4 * (F.lane + 64 * j));
    for (int m = F.gw; m < MTOT; m += F.NGW) {
        f32x4* xr = (f32x4*)(h + (size_t)m * DM) + F.lane;
        f32x4 v[8]; float ss = 0.f;
#pragma unroll
        for (int j = 0; j < 8; ++j) { v[j] = xr[64 * j]; ss += (v[j].x * v[j].x + v[j].y * v[j].y) + (v[j].z * v[j].z + v[j].w * v[j].w); }
        const float rstd = 1.0f / sqrtf(wave_sum(ss) * (1.f / DM) + NORM_EPS);
#pragma unroll
        for (int j = 0; j < 8; ++j) xr[64 * j] = v[j] * rstd * g[j];
    }
}
DI void ph_conv_glu(const Frame& F, const bf16* U, bf16* Gb, const float* cw, const float* cb) {
    constexpr int RC = 32, NCG = DFF / 8, NRC = MC / RC;
    const int gt = blockIdx.x * (NWAVES * 64) + F.tid, NT = F.G * NWAVES * 64;
    for (int it = gt; it < NCG * NRC; it += NT) {
        const int cg = it % NCG, rc = it / NCG, c0 = cg * 8, r0 = rc * RC;
        float w0g[8], w1g[8], w2g[8], bg[8], w0v[8], w1v[8], w2v[8], bv[8];
#pragma unroll
        for (int e = 0; e < 8; ++e) { w0g[e] = cw[c0 + e]; w1g[e] = cw[2 * DFF + c0 + e]; w2g[e] = cw[4 * DFF + c0 + e]; bg[e] = cb[c0 + e];
            w0v[e] = cw[DFF + c0 + e]; w1v[e] = cw[3 * DFF + c0 + e]; w2v[e] = cw[5 * DFF + c0 + e]; bv[e] = cb[DFF + c0 + e]; }
        float pg2[8], pg1[8], pv2[8], pv1[8];
        const bool has = (r0 & (SEQ - 1)) != 0;
        {
            u32x4 a = {0u, 0u, 0u, 0u}, b = a, c = a, d = a;
            if (has) { a = *(const u32x4*)(U + (size_t)(r0 - 2) * (2 * DFF) + c0); b = *(const u32x4*)(U + (size_t)(r0 - 1) * (2 * DFF) + c0);
                       c = *(const u32x4*)(U + (size_t)(r0 - 2) * (2 * DFF) + DFF + c0); d = *(const u32x4*)(U + (size_t)(r0 - 1) * (2 * DFF) + DFF + c0); }
#pragma unroll
            for (int e = 0; e < 4; ++e) { pg2[2 * e] = bflo(a[e]); pg2[2 * e + 1] = bfhi(a[e]); pg1[2 * e] = bflo(b[e]); pg1[2 * e + 1] = bfhi(b[e]);
                pv2[2 * e] = bflo(c[e]); pv2[2 * e + 1] = bfhi(c[e]); pv1[2 * e] = bflo(d[e]); pv1[2 * e + 1] = bfhi(d[e]); }
        }
        for (int r = 0; r < RC; ++r) {
            const u32x4 ug = *(const u32x4*)(U + (size_t)(r0 + r) * (2 * DFF) + c0), uv = *(const u32x4*)(U + (size_t)(r0 + r) * (2 * DFF) + DFF + c0);
            float cg_[8], cv_[8], o[8];
#pragma unroll
            for (int e = 0; e < 4; ++e) { cg_[2 * e] = bflo(ug[e]); cg_[2 * e + 1] = bfhi(ug[e]); cv_[2 * e] = bflo(uv[e]); cv_[2 * e + 1] = bfhi(uv[e]); }
#pragma unroll
            for (int e = 0; e < 8; ++e) {
                const float yg = bg[e] + w0g[e] * pg2[e] + w1g[e] * pg1[e] + w2g[e] * cg_[e];
                const float yv = bv[e] + w0v[e] * pv2[e] + w1v[e] * pv1[e] + w2v[e] * cv_[e];
                const float sg = yg * __builtin_amdgcn_rcpf(1.0f + __builtin_amdgcn_exp2f(-yg * LOG2E));
                o[e] = sg * yv; pg2[e] = pg1[e]; pg1[e] = cg_[e]; pv2[e] = pv1[e]; pv1[e] = cv_[e];
            }
            u32x4 w; w.x = pk2(o[0], o[1]); w.y = pk2(o[2], o[3]); w.z = pk2(o[4], o[5]); w.w = pk2(o[6], o[7]);
            *(u32x4*)(Gb + (size_t)(r0 + r) * DFF + c0) = w;
        }
    }
}
constexpr size_t DA_DIN = 0, DA_CQN = 64 * MiB, DA_LATC = 80 * MiB, DA_KPE = 88 * MiB, DA_KIDX = 90 * MiB, DA_WIDX = 94 * MiB, DA_QL = 96 * MiB, DA_QPE = 352 * MiB, DA_QIDX = 400 * MiB,
                 DA_SEL = 464 * MiB, DA_CNT = 472 * MiB, DA_SC = 474 * MiB, DA_O2 = 474 * MiB;
constexpr size_t DW_W1 = 0, DW_W2 = (size_t)1024 * 2048, DW_WO = DW_W2 + (size_t)11776 * 512, DW_BD = DW_WO + (size_t)2048 * 4096;
constexpr float DSA_QSCALE = 0.07216878364870322f * LOG2E;
constexpr float DSA_WIDX_SCALE = 0.25f * 0.08838834764831845f;

DI void ph_dsa_cvt(const Frame& F, const float* w_in, const float* w_qup, const float* w_uk, const float* w_uv, const float* w_out) {
    bf16* WB = (bf16*)(F.ws + WS_WMIX);
    cvt_job(F, w_in, 960, DM, 0, 960, WB + DW_W1, DM, 0, 1.f);
    zero_bf16(F, WB + DW_W1 + (size_t)960 * DM, (size_t)64 * DM);
    { LAS float* scr = (LAS float*)(F.lds + F.wave * 16384);
      for (int it = F.gw; it < 32 * 16; it += F.NGW) { const int h = it >> 4; cvt_item(w_qup, 8192, h * 192, 48, WB + DW_W2, 512, 8192 + h * 48, DSA_QSCALE, scr, it & 15, 2, F.lane); } }
    cvt_job(F, w_qup, 8192, 512, 6144, 2048, WB + DW_W2, 512, 9728, 1.f);
    __syncthreads();
    {
        LAS float* As = (LAS float*)F.lds; LAS float* Bs = As + 64 * 145;
        for (int u = blockIdx.x; u < 32 * 4 * 8; u += F.G) {
            const int h = u >> 5, r0 = ((u >> 3) & 3) * 64, k0 = (u & 7) * 64;
            for (int i = F.tid; i < 64 * 144; i += NWAVES * 64) { const int row = i / 144, col = i - row * 144;
                As[row * 145 + col] = w_uk[(size_t)(h * 256 + r0) * 144 + i]; Bs[row * 145 + col] = w_qup[(size_t)(k0 + row) * 8192 + h * 192 + 48 + col]; }
            __syncthreads();
            const int r = F.tid & 63, kg = F.tid >> 6; float acc[8];
#pragma unroll
            for (int j = 0; j < 8; ++j) acc[j] = 0.f;
            for (int n = 0; n < 144; ++n) { const float a = As[r * 145 + n];
#pragma unroll
                for (int j = 0; j < 8; ++j) acc[j] += a * Bs[(kg * 8 + j) * 145 + n]; }
            u32x4 o; o.x = pk2(acc[0] * DSA_QSCALE, acc[1] * DSA_QSCALE); o.y = pk2(acc[2] * DSA_QSCALE, acc[3] * DSA_QSCALE); o.z = pk2(acc[4] * DSA_QSCALE, acc[5] * DSA_QSCALE); o.w = pk2(acc[6] * DSA_QSCALE, acc[7] * DSA_QSCALE);
            *(u32x4*)(WB + DW_W2 + (size_t)(h * 256 + r0 + r) * 512 + k0 + kg * 8) = o;
            __syncthreads();
        }
    }
    { LAS float* scr = (LAS float*)(F.lds + F.wave * 16384);
      for (int it = F.gw; it < 32 * 16; it += F.NGW) { const int h = it >> 4; cvt_item(w_uv + (size_t)h * 256 * 128, 128, 0, 128, WB + DW_BD + (h & 1) * 256, 512, h * 128, 1.f, scr, it & 15, 4, F.lane); } }
    { const size_t gt = (size_t)blockIdx.x * (NWAVES * 64) + F.tid, NT = (size_t)F.G * NWAVES * 64;
      for (size_t i = gt; i < (size_t)4096 * 32; i += NT) { const int row = (int)(i >> 5), pc = (int)(i & 31); *(u32x4*)(WB + DW_BD + (size_t)row * 512 + (1 - ((row >> 7) & 1)) * 256 + pc * 8) = (u32x4){0u, 0u, 0u, 0u}; } }
    cvt_job(F, w_out, DM, 4096, 0, DM, WB + DW_WO, 4096, 0, 1.f);
}
DI void ph_dsa_post1(const Frame& F, int half, const float* qn, const float* kvn, const float* lng, const float* lnb) {
    unsigned char* ar = F.ws + WS_AR;
    const float* DIN = (const float*)(ar + DA_DIN); bf16* CQN = (bf16*)(ar + DA_CQN); bf16* LATC = (bf16*)(ar + DA_LATC); bf16* KPE = (bf16*)(ar + DA_KPE); bf16* KIDX = (bf16*)(ar + DA_KIDX); float* WIDX = (float*)(ar + DA_WIDX);
    const float* c48 = (const float*)(F.ws + TAB_COS48); const float* s48 = (const float*)(F.ws + TAB_SIN48); const float* c32 = (const float*)(F.ws + TAB_COS32); const float* s32 = (const float*)(F.ws + TAB_SIN32);
    LAS float* buf = (LAS float*)(F.lds + F.wave * 1024);
    const int lane = F.lane;
    for (int ml = F.gw; ml < MC; ml += F.NGW) {
        const int mg = half * MC + ml;
        const size_t kfb = ((size_t)(ml >> 5) * 8 * 64 + (ml & 31)) * 8;
        const float* row = DIN + (size_t)ml * 1024 + 16 * lane;
        f32x4 v[4]; float ss = 0.f, s1 = 0.f;
#pragma unroll
        for (int j = 0; j < 4; ++j) { v[j] = *(const f32x4*)(row + 4 * j); ss += (v[j].x * v[j].x + v[j].y * v[j].y) + (v[j].z * v[j].z + v[j].w * v[j].w); s1 += (v[j].x + v[j].y) + (v[j].z + v[j].w); }
        const bool isq = lane < 32, iskv = lane >= 32 && lane < 48, ispe = lane >= 48 && lane < 51, isix = lane >= 51 && lane < 59;
        const float ssq = wave_sum(isq ? ss : 0.f), sskv = wave_sum(iskv ? ss : 0.f), mean = wave_sum(isix ? s1 : 0.f) * (1.f / 128.f);
        float d2 = 0.f;
#pragma unroll
        for (int j = 0; j < 4; ++j) { const f32x4 d = v[j] - mean; d2 += (d.x * d.x + d.y * d.y) + (d.z * d.z + d.w * d.w); }
        const float var = wave_sum(isix ? d2 : 0.f) * (1.f / 128.f);
        const float rq = 1.0f / sqrtf(ssq * (1.f / 512.f) + NORM_EPS), rkv = 1.0f / sqrtf(sskv * (1.f / 256.f) + NORM_EPS), rstd = 1.0f / sqrtf(var + NORM_EPS);
        if (isq || iskv) {
            const float* gp = isq ? qn + 16 * lane : kvn + 16 * (lane - 32); const float rs = isq ? rq : rkv;
            bf16* dst = isq ? CQN + (size_t)ml * 512 + 16 * lane : LATC + (size_t)ml * 256 + 16 * (lane - 32);
            u32x4 o[2];
#pragma unroll
            for (int j = 0; j < 4; ++j) { const f32x4 g = *(const f32x4*)(gp + 4 * j); const f32x4 y = v[j] * rs * g; o[j >> 1][(j & 1) * 2] = pk2(y.x, y.y); o[j >> 1][(j & 1) * 2 + 1] = pk2(y.z, y.w); }
            *(u32x4*)dst = o[0]; *(u32x4*)(dst + 8) = o[1];
        } else if (ispe) {
#pragma unroll
            for (int j = 0; j < 4; ++j) *(LAS f32x4*)(buf + (lane - 48) * 16 + 4 * j) = v[j];
        } else if (isix) {
#pragma unroll
            for (int j = 0; j < 4; ++j) { const f32x4 g = *(const f32x4*)(lng + (lane - 51) * 16 + 4 * j), b = *(const f32x4*)(lnb + (lane - 51) * 16 + 4 * j); *(LAS f32x4*)(buf + 48 + (lane - 51) * 16 + 4 * j) = (v[j] - mean) * rstd * g + b; }
        } else if (lane == 59) {
#pragma unroll
            for (int j = 0; j < 4; ++j) *(f32x4*)(WIDX + (size_t)ml * 16 + 4 * j) = v[j] * DSA_WIDX_SCALE;
        }
        LDS_WAIT();
        if (lane < 24) { const float x1 = buf[lane], x2 = buf[24 + lane], c = c48[(size_t)mg * 24 + lane], s = s48[(size_t)mg * 24 + lane];
            KPE[(size_t)ml * 48 + lane] = f2bf(x1 * c - x2 * s); KPE[(size_t)ml * 48 + 24 + lane] = f2bf(x1 * s + x2 * c);
        } else if (lane < 40) { const int i = lane - 24; const float x1 = buf[48 + i], x2 = buf[48 + 16 + i], c = c32[(size_t)mg * 16 + i], s = s32[(size_t)mg * 16 + i];
            KIDX[kfb + (size_t)((i >> 3) * 32) * 8 + (i & 7)] = f2bf(x1 * c - x2 * s); KIDX[kfb + (size_t)(64 + (i >> 3) * 32) * 8 + (i & 7)] = f2bf(x1 * s + x2 * c);
        } else { const int d = 32 + 4 * (lane - 40); const f32x4 y = *(const LAS f32x4*)(buf + 48 + d); u32x2 w; w.x = pk2(y.x, y.y); w.y = pk2(y.z, y.w); *(u32x2*)(KIDX + kfb + (size_t)((d >> 4) * 64 + ((d >> 3) & 1) * 32) * 8 + (d & 7)) = w; }
        LDS_WAIT();
    }
}
DI void ph_dsa_rope(const Frame& F, int half) {
    unsigned char* ar = F.ws + WS_AR; bf16* QPE = (bf16*)(ar + DA_QPE); bf16* QIDX = (bf16*)(ar + DA_QIDX);
    const float* c48 = (const float*)(F.ws + TAB_COS48); const float* s48 = (const float*)(F.ws + TAB_SIN48); const float* c32 = (const float*)(F.ws + TAB_COS32); const float* s32 = (const float*)(F.ws + TAB_SIN32);
    for (int ml = F.gw; ml < MC; ml += F.NGW) {
        const size_t mg = (size_t)half * MC + ml;
        for (int p = F.lane; p < 768; p += 64) { const int hd = p / 24, i = p - hd * 24; bf16* q = QPE + (size_t)ml * 1536 + hd * 48 + i;
            const float x1 = bf2f(q[0]), x2 = bf2f(q[24]), c = c48[mg * 24 + i], s = s48[mg * 24 + i]; q[0] = f2bf(x1 * c - x2 * s); q[24] = f2bf(x1 * s + x2 * c); }
        for (int p = F.lane; p < 256; p += 64) { const int hd = p >> 4, i = p & 15; bf16* q = QIDX + (size_t)ml * 2048 + hd * 128 + i;
            const float x1 = bf2f(q[0]), x2 = bf2f(q[16]), c = c32[mg * 16 + i], s = s32[mg * 16 + i]; q[0] = f2bf(x1 * c - x2 * s); q[16] = f2bf(x1 * s + x2 * c); }
    }
}
DI int wave_isum_dpp(int v) {
    v += __builtin_amdgcn_update_dpp(0, v, 0x111, 0xf, 0xf, true); v += __builtin_amdgcn_update_dpp(0, v, 0x112, 0xf, 0xf, true);
    v += __builtin_amdgcn_update_dpp(0, v, 0x114, 0xf, 0xf, true); v += __builtin_amdgcn_update_dpp(0, v, 0x118, 0xf, 0xf, true);
    v += __builtin_amdgcn_update_dpp(0, v, 0x142, 0xa, 0xf, false);
    v += __builtin_amdgcn_update_dpp(0, v, 0x143, 0xc, 0xf, false);
    return __builtin_amdgcn_readlane(v, 63);
}
DI unsigned f2sortable(float s) { const unsigned b = __builtin_bit_cast(unsigned, s); return (b & 0x80000000u) ? ~b : (b | 0x80000000u); }
DI void ph_dsa_index(const Frame& F, const int dry = 0, const int parts = 3) {
    unsigned char* ar = F.ws + WS_AR;
    const bf16* QIDX = (const bf16*)(ar + DA_QIDX); const bf16* KIDX = (const bf16*)(ar + DA_KIDX); const float* WIDX = (const float*)(ar + DA_WIDX);
    unsigned short* SEL = (unsigned short*)(ar + DA_SEL); int* CNT = (int*)(ar + DA_CNT); float* SC = (float*)(ar + DA_SC) + (size_t)F.gw * 16384;
    const int lane = F.lane, r = lane & 31, hf = lane >> 5;
    LAS unsigned char* wl = F.lds + F.wave * 8192 + lane * 16;
#pragma unroll 1
    for (int tile = blockIdx.x; tile < BPH * 128; tile += F.G) {
        const int j = tile >> 8, c8 = tile & 255, c7 = c8 & 127, bl = (c8 >> 7) * 2 + j, qt = j ? 127 - c7 : c7;
        const int q0 = qt * 32 + 4 * F.wave;
        const int ntile = (q0 + 3) / 32 + 1;
        bf16x8 qa[2][8];
#pragma unroll
        for (int pr = 0; pr < 2; ++pr) {
            const int mrow = bl * SEQ + q0 + 2 * pr + (r >> 4);
#pragma unroll
            for (int s = 0; s < 8; ++s) qa[pr][s] = *(const bf16x8*)(QIDX + (size_t)mrow * 2048 + (r & 15) * 128 + 16 * s + 8 * hf);
            float wv[2][16];
#pragma unroll
            for (int i = 0; i < 16; ++i) wv[pr][i] = WIDX[(size_t)(bl * SEQ + q0 + 2 * pr + (i >> 3)) * 16 + (i & 3) + 8 * ((i >> 2) & 1) + 4 * hf];
#pragma unroll
            for (int i = 0; i < 16; i += 4) *(LAS f32x4*)(wl + (pr * 4 + (i >> 2)) * 1024) = (f32x4){wv[pr][i], wv[pr][i + 1], wv[pr][i + 2], wv[pr][i + 3]};
        }
        LDS_WAIT();
        if (parts & 1) {
        bf16x8 kf[8];
        { const bf16* kp = KIDX + ((size_t)(bl * 128) * 8 * 64 + lane) * 8;
#pragma unroll
          for (int s = 0; s < 8; ++s) kf[s] = *(const bf16x8*)(kp + 512 * s); }
#pragma unroll 1
        for (int t = 0; t < ntile; ++t) {
            f32x16 accs[2];
#pragma unroll
            for (int pr = 0; pr < 2; ++pr) {
#pragma unroll
                for (int i = 0; i < 16; ++i) accs[pr][i] = 0.f;
#pragma unroll
                for (int s = 0; s < 8; ++s) accs[pr] = MFMA32(qa[pr][s], kf[s], accs[pr]);
            }
            if (t + 1 < ntile) { const bf16* kp = KIDX + ((size_t)(bl * 128 + t + 1) * 8 * 64 + lane) * 8;
#pragma unroll
                for (int s = 0; s < 8; ++s) kf[s] = *(const bf16x8*)(kp + 512 * s); }
#pragma unroll
            for (int pr = 0; pr < 2; ++pr) {
                const f32x16 acc = accs[pr];
                float wv[2][16];
                { unsigned wa_ = (unsigned)(size_t)wl; asm volatile("" : "+v"(wa_));
#pragma unroll
                  for (int i = 0; i < 16; i += 4) { const f32x4 w4 = *(const LAS f32x4*)((LAS unsigned char*)(size_t)wa_ + (pr * 4 + (i >> 2)) * 1024); wv[pr][i] = w4.x; wv[pr][i + 1] = w4.y; wv[pr][i + 2] = w4.z; wv[pr][i + 3] = w4.w; } }
                float p0 = 0.f, p1 = 0.f;
#pragma unroll
                for (int i = 0; i < 8; ++i) { p0 += wv[pr][i] * fmaxf(acc[i], 0.f); p1 += wv[pr][8 + i] * fmaxf(acc[8 + i], 0.f); }
                const float t0 = p0 + __shfl_xor(p0, 32), t1 = p1 + __shfl_xor(p1, 32);
                SC[(pr * 128 + t) * 64 + lane] = hf ? t1 : t0;
            }
        }
        }
        VM_WAIT();
        if (parts & 2)
#pragma unroll 1
        for (int qi = 0; qi < 4; ++qi) {
            const int tq = q0 + qi, pr = qi >> 1, qs = qi & 1;
            unsigned u[64];
            const unsigned* scp = (const unsigned*)(SC + pr * 8192 + hf * 64 + qs * 32 + r);
#pragma unroll
            for (int g8 = 0; g8 < 8; ++g8) {
#pragma unroll
                for (int e = 0; e < 8; ++e) { const int i = 8 * g8 + e; const float s = __builtin_bit_cast(float, __hip_atomic_load(scp + e * 128, __ATOMIC_RELAXED, __HIP_MEMORY_SCOPE_AGENT));
                    u[i] = (2 * i + hf < ntile && 64 * i + lane <= tq) ? f2sortable(s) : 0u; }
                scp += 1024; asm volatile("" : "+v"(scp));
            }
            unsigned prefix = 0u;
#pragma unroll 1
            for (int bit = 31; bit >= 0; --bit) {
                const unsigned cand = prefix | (1u << bit); int c = 0;
#pragma unroll
                for (int i = 0; i < 64; ++i) c += (u[i] >= cand) ? 1 : 0;
                c = wave_isum_dpp(c);
                if (c >= 256) prefix = cand;
                if (c == 256) break;
            }
            const unsigned T = prefix > 1u ? prefix : 1u;
            int nl = 0;
#pragma unroll
            for (int i = 0; i < 64; ++i) nl += (u[i] >= T) ? 1 : 0;
            int inc = nl;
#pragma unroll
            for (int o = 1; o < 64; o <<= 1) { const int y = __shfl_up(inc, o); if (lane >= o) inc += y; }
            const int base = __shfl(inc, 63);
            int pos = inc - nl;
            unsigned short* sel = dry ? (unsigned short*)(ar + DUMMY_OFF) + (size_t)F.gw * 256 : SEL + (size_t)(bl * SEQ + tq) * 256;
#pragma unroll
            for (int i = 0; i < 64; ++i) { if (u[i] >= T) { if (pos < 256) sel[pos] = (unsigned short)(64 * i + lane); ++pos; } }
            if (lane == 0) (dry ? (int*)(ar + DUMMY_OFF + 32 * MiB) + F.gw : CNT + bl * SEQ + tq)[0] = base < 256 ? base : 256;
        }
    }
}
DI int dsa_fsw(int row) { return ((row & 3) << 2) | ((row >> 2) & 3); }
struct DsaPre { u32x4 row[16]; bf16x8 kpe[3]; bf16x8 q[3]; };
DI void dsa_prefetch(DsaPre& P, const bf16* LATC, const bf16* KPE, const bf16* QL, const bf16* QPE, int ml, int selv, int lane, int w) {
    const int bl = ml >> 12, r = lane & 31, h = lane >> 5;
#pragma unroll
    for (int it = 0; it < 16; ++it) { const int ki = __shfl(selv, (lane >> 5) + 2 * it); P.row[it] = *(const u32x4*)(LATC + (size_t)(bl * SEQ + ki) * 256 + (lane & 31) * 8); }
#pragma unroll
    for (int s = 0; s < 3; ++s) P.kpe[s] = *(const bf16x8*)(KPE + (size_t)(bl * SEQ + selv) * 48 + 16 * s + 8 * h);
#pragma unroll
    for (int j = 0; j < 3; ++j) { const int fi = w + 8 * j;
        if (fi < 16) P.q[j] = *(const bf16x8*)(QL + (size_t)ml * 8192 + r * 256 + 16 * fi + 8 * h);
        else if (fi < 19) P.q[j] = *(const bf16x8*)(QPE + (size_t)ml * 1536 + r * 48 + 16 * (fi - 16) + 8 * h); }
}
DI void ph_dsa_attn(const Frame& F, const int dry = 0) {
    unsigned char* ar = F.ws + WS_AR;
    bf16* QL = (bf16*)(ar + DA_QL); const bf16* QPE = (const bf16*)(ar + DA_QPE); const bf16* LATC = (const bf16*)(ar + DA_LATC); const bf16* KPE = (const bf16*)(ar + DA_KPE);
    const unsigned short* SEL = (const unsigned short*)(ar + DA_SEL); const int* CNT = (const int*)(ar + DA_CNT);
    const int lane = F.lane, r = lane & 31, h = lane >> 5, w = F.wave;
    LAS unsigned char* IMG = F.lds; LAS unsigned char* QB = F.lds + LDSCTL_OFF + 256; LAS float* MX = (LAS float*)(F.lds + LDSCTL_OFF + 256 + 19456); LAS float* SX = MX + 256;
    const int i16 = lane & 15, tq_ = i16 >> 2, tp_ = i16 & 3, blk = (lane >> 4) & 1;
    int ml = blockIdx.x;
    if (ml >= MC) return;
    DsaPre P;
    int cnt_c = CNT[ml];
    { const int slot = 32 * w + r; const int selv = slot < cnt_c ? (int)SEL[(size_t)ml * 256 + slot] : 0; dsa_prefetch(P, LATC, KPE, QL, QPE, ml, selv, lane, w); }
    int cnt_n = 0, selv_n = 0;
    if (ml + F.G < MC) { cnt_n = CNT[ml + F.G]; const int slot = 32 * w + r; selv_n = slot < cnt_n ? (int)SEL[(size_t)(ml + F.G) * 256 + slot] : 0; }
#pragma unroll 1
    for (; ml < MC; ml += F.G) {
        const int cnt = cnt_c, nch = (cnt + 31) >> 5; const bool act = w < nch;
#pragma unroll
        for (int it = 0; it < 16; ++it) { const int rr = (lane >> 5) + 2 * it; *(LAS u32x4*)(IMG + (32 * w + rr) * 512 + (((lane & 31) ^ dsa_fsw(rr)) * 16)) = P.row[it]; }
#pragma unroll
        for (int j = 0; j < 3; ++j) { const int fi = w + 8 * j; if (fi < 19) *(LAS bf16x8*)(QB + fi * 1024 + lane * 16) = P.q[j]; }
        bf16x8 kpe[3];
#pragma unroll
        for (int s = 0; s < 3; ++s) kpe[s] = P.kpe[s];
        LDS_WAIT(); __builtin_amdgcn_s_barrier(); asm volatile("" ::: "memory");
        if (ml + F.G < MC) {
            dsa_prefetch(P, LATC, KPE, QL, QPE, ml + F.G, selv_n, lane, w); cnt_c = cnt_n;
            if (ml + 2 * F.G < MC) { cnt_n = CNT[ml + 2 * F.G]; const int slot = 32 * w + r; selv_n = slot < cnt_n ? (int)SEL[(size_t)(ml + 2 * F.G) * 256 + slot] : 0; }
        }
        f32x16 S; float mx = -INFINITY;
#pragma unroll
        for (int i = 0; i < 16; ++i) S[i] = 0.f;
        if (act) {
#pragma unroll
            for (int s = 0; s < 16; ++s) S = MFMA32(*(const LAS bf16x8*)(IMG + (32 * w + r) * 512 + (((2 * s + h) ^ dsa_fsw(r)) * 16)), *(const LAS bf16x8*)(QB + s * 1024 + lane * 16), S);
#pragma unroll
            for (int s = 0; s < 3; ++s) S = MFMA32(kpe[s], *(const LAS bf16x8*)(QB + (16 + s) * 1024 + lane * 16), S);
#pragma unroll
            for (int i = 0; i < 16; ++i) { S[i] = (32 * w + crow(i, h) < cnt) ? S[i] : -INFINITY; mx = fmaxf(mx, S[i]); }
            mx = fmaxf(mx, __shfl_xor(mx, 32));
        }
        if (h == 0) MX[w * 32 + r] = mx;
        LDS_WAIT(); __builtin_amdgcn_s_barrier(); asm volatile("" ::: "memory");
        float M = MX[r];
#pragma unroll
        for (int k = 1; k < 8; ++k) M = fmaxf(M, MX[k * 32 + r]);
        float lsum = 0.f; bf16x8 pf[2] = {(bf16x8){0, 0, 0, 0, 0, 0, 0, 0}, (bf16x8){0, 0, 0, 0, 0, 0, 0, 0}};
        if (act) {
#pragma unroll
            for (int i = 0; i < 16; ++i) { S[i] = __builtin_amdgcn_exp2f(S[i] - M); lsum += S[i]; }
#pragma unroll
            for (int s = 0; s < 2; ++s) { u32x4 t; t.x = pk2(S[8 * s], S[8 * s + 1]); t.y = pk2(S[8 * s + 2], S[8 * s + 3]); t.z = pk2(S[8 * s + 4], S[8 * s + 5]); t.w = pk2(S[8 * s + 6], S[8 * s + 7]); pf[s] = __builtin_bit_cast(bf16x8, t); }
        }
        lsum += __shfl_xor(lsum, 32);
        if (h == 0) SX[w * 32 + r] = lsum;
        *(LAS bf16x8*)(QB + (2 * w) * 1024 + lane * 16) = pf[0]; *(LAS bf16x8*)(QB + (2 * w + 1) * 1024 + lane * 16) = pf[1];
        LDS_WAIT(); __builtin_amdgcn_s_barrier(); asm volatile("" ::: "memory");
        f32x16 O;
#pragma unroll
        for (int i = 0; i < 16; ++i) O[i] = 0.f;
#pragma unroll 2
        for (int ks = 0; ks < 2 * nch; ++ks) {
            const int r0 = 16 * ks + 4 * h + tq_, r1 = r0 + 8, pc = 4 * w + 2 * blk + (tp_ >> 1);
            const s16x4 lo = __builtin_bit_cast(s16x4, __builtin_amdgcn_ds_read_tr16_b64_v4i16((LAS v4i16_t*)(IMG + r0 * 512 + ((pc ^ dsa_fsw(r0)) * 16) + 8 * (tp_ & 1))));
            const s16x4 hi = __builtin_bit_cast(s16x4, __builtin_amdgcn_ds_read_tr16_b64_v4i16((LAS v4i16_t*)(IMG + r1 * 512 + ((pc ^ dsa_fsw(r1)) * 16) + 8 * (tp_ & 1))));
            O = MFMA32(__builtin_shufflevector(lo, hi, 0, 1, 2, 3, 4, 5, 6, 7), *(const LAS bf16x8*)(QB + ks * 1024 + lane * 16), O);
        }
        float l = SX[r];
#pragma unroll
        for (int k = 1; k < 8; ++k) l += SX[k * 32 + r];
        const float linv = 1.0f / l;
        bf16* o = (dry ? (bf16*)(ar + DUMMY_OFF) + (size_t)blockIdx.x * 8192 : QL + (size_t)ml * 8192) + r * 256 + 32 * w + 4 * h;
#pragma unroll
        for (int g = 0; g < 4; ++g) { u32x2 t; t.x = pk2(O[4 * g] * linv, O[4 * g + 1] * linv); t.y = pk2(O[4 * g + 2] * linv, O[4 * g + 3] * linv); *(u32x2*)(o + 8 * g) = t; }
        LDS_WAIT(); __builtin_amdgcn_s_barrier(); asm volatile("" ::: "memory");
    }
}
template <int NDB> DI void softmax_step(f32x16& S, float& m, float& l, f32x16 (&O)[NDB], bf16x8 (&pf)[2]) {
    float mx = S[0];
#pragma unroll
    for (int i = 1; i < 16; ++i) mx = fmaxf(mx, S[i]);
    mx = fmaxf(mx, __shfl_xor(mx, 32));
    const float mn = fmaxf(m, mx), ms = (mn == -INFINITY) ? 0.f : mn;
    const float alpha = __builtin_amdgcn_exp2f(m - ms);
    float sum = 0.f;
#pragma unroll
    for (int i = 0; i < 16; ++i) { S[i] = __builtin_amdgcn_exp2f(S[i] - ms); sum += S[i]; }
    l = l * alpha + sum; m = mn;
    if (__builtin_amdgcn_ballot_w64(alpha != 1.0f) != 0ull) {
#pragma unroll
        for (int db = 0; db < NDB; ++db)
#pragma unroll
            for (int i = 0; i < 16; ++i) O[db][i] *= alpha;
    }
#pragma unroll
    for (int s = 0; s < 2; ++s) { u32x4 w; w.x = pk2(S[8 * s], S[8 * s + 1]); w.y = pk2(S[8 * s + 2], S[8 * s + 3]); w.z = pk2(S[8 * s + 4], S[8 * s + 5]); w.w = pk2(S[8 * s + 6], S[8 * s + 7]); pf[s] = __builtin_bit_cast(bf16x8, w); }
}
template <int NQ, int NDB, bool PV, bool QL, bool FRAG, class KA, class VA, class MK>
DI void attn_run(const bf16x8 (&qf)[NQ], const LAS unsigned char* qlds, f32x16 (&O)[NDB], float& m, float& l, int tb, int te, const KA& ka, const VA& va, const MK& mk) {
    if (tb >= te) return;
    bf16x8 kf[NQ];
    { const bf16* kp = ka(tb);
#pragma unroll
      for (int s = 0; s < NQ; ++s) kf[s] = *(const bf16x8*)(kp + (FRAG ? 512 : 16) * s); }
    for (int t = tb; t < te; ++t) {
        bf16x8 vf[NDB][2];
        if (PV) {
#pragma unroll
            for (int db = 0; db < NDB; ++db) { const bf16* vp = va(t, db);
#pragma unroll
                for (int s = 0; s < 2; ++s) { if (FRAG) vf[db][s] = *(const bf16x8*)(vp + 512 * s); else vf[db][s] = __builtin_shufflevector(*(const s16x4*)(vp + 16 * s), *(const s16x4*)(vp + 16 * s + 8), 0, 1, 2, 3, 4, 5, 6, 7); } }
        }
        f32x16 S;
#pragma unroll
        for (int i = 0; i < 16; ++i) S[i] = 0.f;
#pragma unroll
        for (int s = 0; s < NQ; ++s) { if (QL) { unsigned qa_ = (unsigned)(size_t)qlds; asm volatile("" : "+v"(qa_)); S = MFMA32(kf[s], *(const LAS bf16x8*)((LAS unsigned char*)(size_t)qa_ + s * 1024), S); } else S = MFMA32(kf[s], qf[s], S); }
        if (t + 1 < te) { const bf16* kp = ka(t + 1);
#pragma unroll
            for (int s = 0; s < NQ; ++s) kf[s] = *(const bf16x8*)(kp + (FRAG ? 512 : 16) * s); }
        mk(t, S);
        bf16x8 pf[2]; softmax_step<NDB>(S, m, l, O, pf);
        if (PV) {
#pragma unroll
            for (int db = 0; db < NDB; ++db)
#pragma unroll
                for (int s = 0; s < 2; ++s) O[db] = MFMA32(vf[db][s], pf[s], O[db]);
        }
    }
}
template <bool ACC> DI void store_col(bf16* out, const f32x16 (&O)[4], float scale, int h) {
#pragma unroll
    for (int db = 0; db < 4; ++db)
#pragma unroll
        for (int g = 0; g < 4; ++g) { u32x2* p = (u32x2*)(out + db * 32 + 8 * g + 4 * h);
            float a = O[db][4 * g] * scale, b = O[db][4 * g + 1] * scale, c = O[db][4 * g + 2] * scale, d = O[db][4 * g + 3] * scale;
            if (ACC) { const u32x2 o = *p; a += bflo(o.x); b += bfhi(o.x); c += bflo(o.y); d += bfhi(o.y); }
            u32x2 w; w.x = pk2(a, b); w.y = pk2(c, d); *p = w; }
}
template <int NQ> struct TilePre { u32x4 a, b, c; };
template <int NQ, class SRC> DI void tile_fetch(TilePre<NQ>& p, const SRC& src, int T, int tid) {
    const bf16* k = src.k(T); const bf16* v = src.v(T);
    constexpr int NK = NQ * 64;
    p.a = *(const u32x4*)(k + (size_t)tid * 8);
    const int p1 = tid + 512; p.b = (p1 < NK) ? *(const u32x4*)(k + (size_t)p1 * 8) : *(const u32x4*)(v + (size_t)(p1 - NK) * 8);
    if (NQ * 64 + 512 > 1024) { const int p2 = tid + 1024; if (p2 < NK + 512) p.c = *(const u32x4*)(v + (size_t)(p2 - NK) * 8); }
}
template <int NQ> DI void tile_put(const TilePre<NQ>& p, LAS unsigned char* buf, int tid) {
    *(LAS u32x4*)(buf + tid * 16) = p.a; *(LAS u32x4*)(buf + (tid + 512) * 16) = p.b;
    if (NQ * 64 + 512 > 1024) { if (tid + 1024 < NQ * 64 + 512) *(LAS u32x4*)(buf + (tid + 1024) * 16) = p.c; }
}
template <int NQ, bool PV, class SRC, class MK>
DI void attn_run_sh(LAS unsigned char* tl, int tid, int lane, const bf16x8 (&qf)[NQ], f32x16 (&O)[4], float& m, float& l, int TB, int TE, int tb, int te, const SRC& src, const MK& mk) {
    constexpr int TBYTES = (NQ + 8) * 1024;
    if (TB >= TE) return;
    TilePre<NQ> pre;
    tile_fetch<NQ>(pre, src, TB, tid); tile_put<NQ>(pre, tl, tid);
    LDS_WAIT(); __builtin_amdgcn_s_barrier(); asm volatile("" ::: "memory");
#pragma unroll 1
    for (int T = TB; T < TE; ++T) {
        LAS unsigned char* cur = tl + ((T - TB) & 1) * TBYTES;
        if (T + 1 < TE) tile_fetch<NQ>(pre, src, T + 1, tid);
        if (T >= tb && T < te) {
            f32x16 S;
#pragma unroll
            for (int i = 0; i < 16; ++i) S[i] = 0.f;
#pragma unroll
            for (int s = 0; s < NQ; ++s) S = MFMA32(*(const LAS bf16x8*)(cur + s * 1024 + lane * 16), qf[s], S);
            mk(T, S);
            bf16x8 pf[2]; softmax_step<4>(S, m, l, O, pf);
            if (PV) {
#pragma unroll
                for (int db = 0; db < 4; ++db)
#pragma unroll
                    for (int s = 0; s < 2; ++s) O[db] = MFMA32(*(const LAS bf16x8*)(cur + (NQ + db * 2 + s) * 1024 + lane * 16), pf[s], O[db]);
            }
        }
        if (T + 1 < TE) tile_put<NQ>(pre, tl + ((T + 1 - TB) & 1) * TBYTES, tid);
        LDS_WAIT(); __builtin_amdgcn_s_barrier(); asm volatile("" ::: "memory");
    }
}
struct FragSrc { const bf16* kb; const bf16* vb; int nq; DI const bf16* k(int T) const { return kb + (size_t)T * nq * 512; } DI const bf16* v(int T) const { return vb + (size_t)T * 8 * 512; } };
constexpr size_t FA_Q = 0, FA_K = 64 * MiB, FA_F = 128 * MiB, FA_V = 136 * MiB, FA_CUM = 200 * MiB, FA_O = 202 * MiB, FA_KF = 266 * MiB, FA_VF = 330 * MiB;
constexpr size_t FW_IN = 0, FW_OUT = (size_t)6400 * 2048;
constexpr float FOX_QSCALE = 0.08838834764831845f * LOG2E;
DI void ph_fox_cvt(const Frame& F, const float* w_in, const float* w_out) {
    bf16* WB = (bf16*)(F.ws + WS_WMIX);
    cvt_job(F, w_in, 6160, DM, 0, 2048, WB + FW_IN, DM, 0, FOX_QSCALE);
    cvt_job(F, w_in, 6160, DM, 2048, 2048, WB + FW_IN, DM, 2048, 1.f);
    cvt_job(F, w_in, 6160, DM, 4096, 2048, WB + FW_IN, DM, 4096, 1.f);
    cvt_job(F, w_in, 6160, DM, 6144, 16, WB + FW_IN, DM, 6144, 1.f);
    zero_bf16(F, WB + FW_IN + (size_t)6160 * DM, (size_t)240 * DM);
    cvt_job(F, w_out, DM, DM, 0, DM, WB + FW_OUT, DM, 0, 1.f);
}
DI void ph_fox_scan(const Frame& F, const float* b_f) {
    unsigned char* ar = F.ws + WS_AR; const bf16* FB = (const bf16*)(ar + FA_F); float* CUM = (float*)(ar + FA_CUM);
    for (int w = F.gw; w < BPH * 16; w += F.NGW) {
        const int bl = w >> 4, hd = w & 15; const float bf_ = b_f[hd];
        float v[64]; float run = 0.f;
#pragma unroll
        for (int i = 0; i < 64; ++i) { const float x = bf2f(FB[(size_t)(bl * SEQ + F.lane * 64 + i) * 256 + hd]) + bf_;
            const float ls = fminf(x, 0.f) - log1pf(expf(-fabsf(x))); run += ls; v[i] = run; }
        float inc = run;
#pragma unroll
        for (int o = 1; o < 64; o <<= 1) { const float y = __shfl_up(inc, o); if (F.lane >= o) inc += y; }
        const float base = inc - run;
        float* dst = CUM + (size_t)w * SEQ + F.lane * 64;
#pragma unroll
        for (int i = 0; i < 64; i += 4) *(f32x4*)(dst + i) = (f32x4){(v[i] + base) * LOG2E, (v[i + 1] + base) * LOG2E, (v[i + 2] + base) * LOG2E, (v[i + 3] + base) * LOG2E};
    }
    const bf16* Kr = (const bf16*)(ar + FA_K); const bf16* Vr = (const bf16*)(ar + FA_V); bf16* KF = (bf16*)(ar + FA_KF); bf16* VF = (bf16*)(ar + FA_VF);
    const int r = F.lane & 31, h = F.lane >> 5;
    for (int u = F.gw; u < BPH * 16 * 128; u += F.NGW) {
        const int bh = u >> 7, tile = u & 127, bl = bh >> 4, hd = bh & 15;
        const bf16* krow_ = Kr + ((size_t)bl * SEQ + tile * 32 + r) * DM + hd * 128 + 8 * h;
        bf16* kd = KF + (((size_t)bh * 128 + tile) * 8 * 64 + F.lane) * 8;
#pragma unroll
        for (int s = 0; s < 8; ++s) *(u32x4*)(kd + s * 512) = *(const u32x4*)(krow_ + 16 * s);
        bf16* vd = VF + (((size_t)bh * 128 + tile) * 8 * 64 + F.lane) * 8;
#pragma unroll
        for (int db = 0; db < 4; ++db)
#pragma unroll
            for (int s = 0; s < 2; ++s) { unsigned short e[8];
#pragma unroll
                for (int j = 0; j < 8; ++j) e[j] = Vr[((size_t)bl * SEQ + tile * 32 + 16 * s + 8 * (j >> 2) + 4 * h + (j & 3)) * DM + hd * 128 + db * 32 + r];
                u32x4 w; w.x = e[0] | ((unsigned)e[1] << 16); w.y = e[2] | ((unsigned)e[3] << 16); w.z = e[4] | ((unsigned)e[5] << 16); w.w = e[6] | ((unsigned)e[7] << 16);
                *(u32x4*)(vd + (db * 2 + s) * 512) = w; }
    }
}
struct FragKA { const bf16* base; int nq; DI const bf16* operator()(int t) const { return base + (size_t)t * nq * 512; } };
struct FragVA { const bf16* base; DI const bf16* operator()(int t, int db) const { return base + ((size_t)t * 8 + db * 2) * 512; } };
struct FoxMK { const float* cum; float ct; int tq, h;
    DI void operator()(int t, f32x16& S) const {
        const int k0 = 32 * t + 4 * h;
#pragma unroll
        for (int g = 0; g < 4; ++g) { const f32x4 cs = *(const f32x4*)(cum + k0 + 8 * g);
#pragma unroll
            for (int e = 0; e < 4; ++e) S[4 * g + e] = (k0 + 8 * g + e <= tq) ? S[4 * g + e] + (ct - cs[e]) : -INFINITY; }
    } };
DI void ph_fox_attn(const Frame& F, const int dry = 0) {
    unsigned char* ar = F.ws + WS_AR; const bf16* Q = (const bf16*)(ar + FA_Q); const bf16* KF = (const bf16*)(ar + FA_KF); const bf16* VF = (const bf16*)(ar + FA_VF); const float* CUM = (const float*)(ar + FA_CUM); bf16* Ob = (bf16*)(ar + FA_O);
    const int r = F.lane & 31, h = F.lane >> 5;
    for (int wb = blockIdx.x; wb < BPH * 16 * 4; wb += F.G) {
        const int bh = wb >> 2, x = (wb & 3) * 8 + F.wave, bl = bh >> 4, hd = bh & 15;
#pragma unroll 1
        for (int k = 0; k < 4; ++k) {
            const int qt = (k == 0) ? x : (k == 1) ? 63 - x : (k == 2) ? 64 + x : 127 - x;
            const int qhi = (k == 0) ? (wb & 3) * 8 + 7 : (k == 1) ? 63 - (wb & 3) * 8 : (k == 2) ? 64 + (wb & 3) * 8 + 7 : 127 - (wb & 3) * 8;
            const int tq = qt * 32 + r; const size_t mrow = (size_t)bl * SEQ + tq;
            bf16x8 qf[8];
#pragma unroll
            for (int s = 0; s < 8; ++s) qf[s] = *(const bf16x8*)(Q + mrow * DM + hd * 128 + 16 * s + 8 * h);
            f32x16 O[4];
#pragma unroll
            for (int db = 0; db < 4; ++db)
#pragma unroll
                for (int i = 0; i < 16; ++i) O[db][i] = 0.f;
            float m = -INFINITY, l = 0.f;
            const float* cum = CUM + (size_t)bh * SEQ;
            const FragSrc src{KF + (size_t)bh * 128 * 8 * 512, VF + (size_t)bh * 128 * 8 * 512, 8}; const FoxMK mk{cum, cum[tq], tq, h};
            attn_run_sh<8, true>(F.lds, F.tid, F.lane, qf, O, m, l, 0, qhi + 1, 0, qt + 1, src, mk);
            l += __shfl_xor(l, 32);
            store_col<false>(dry ? (bf16*)(ar + DUMMY_OFF) + ((size_t)F.gw * 32 + r) * 128 : Ob + mrow * DM + hd * 128, O, l > 0.f ? 1.0f / l : 0.f, h);
        }
    }
}
typedef long fp8x8_t;
DI fp8x8_t pack_fp8x8(float a0, float a1, float a2, float a3, float a4, float a5, float a6, float a7) {
    int lo = 0, hi = 0;
    lo = __builtin_amdgcn_cvt_pk_fp8_f32(a0, a1, lo, false); lo = __builtin_amdgcn_cvt_pk_fp8_f32(a2, a3, lo, true);
    hi = __builtin_amdgcn_cvt_pk_fp8_f32(a4, a5, hi, false); hi = __builtin_amdgcn_cvt_pk_fp8_f32(a6, a7, hi, true);
    return (fp8x8_t)(((unsigned long long)(unsigned)hi << 32) | (unsigned long long)(unsigned)lo);
}
#define MFMA32F8(a, b, c) __builtin_amdgcn_mfma_f32_32x32x16_fp8_fp8((a), (b), (c), 0, 0, 0)
constexpr size_t NA_Q = 0, NA_KC = 288 * MiB, NA_VC = 313 * MiB, NA_KSR = 330 * MiB, NA_KWR = 354 * MiB, NA_GT = 378 * MiB, NA_VSR = 386 * MiB, NA_VWR = 402 * MiB, NA_GK = 418 * MiB, NA_GV = 420 * MiB,
                 NA_KCMP = 422 * MiB, NA_VCT = 424 * MiB, NA_SELB = 426 * MiB, NA_O = 428 * MiB,
                 NA_KSF = 620 * MiB, NA_KWF = 644 * MiB, NA_VSF = 668 * MiB, NA_VWF = 684 * MiB;
constexpr size_t NW_IN = 0, NW_W1K = (size_t)13312 * 2048, NW_W1V = NW_W1K + (size_t)256 * 6144, NW_W2K = NW_W1V + (size_t)256 * 4096, NW_W2V = NW_W2K + 65536, NW_OUT = NW_W2V + 65536;
constexpr float NSA_QSCALE = 0.07216878364870322f * LOG2E;
DI void ph_nsa_cvt(const Frame& F, const float* w_in, const float* k_pe, const float* k_w1, const float* k_b1, const float* k_w2, const float* v_pe, const float* v_w1, const float* v_b1, const float* v_w2, const float* w_out) {
    bf16* WB = (bf16*)(F.ws + WS_WMIX); float* BIAS = (float*)(F.ws + WS_MISC);
    cvt_job(F, w_in, 13200, DM, 0, 9216, WB + NW_IN, DM, 0, NSA_QSCALE);
    cvt_job(F, w_in, 13200, DM, 9216, 768, WB + NW_IN, DM, 9216, 1.f);
    cvt_job(F, w_in, 13200, DM, 9984, 512, WB + NW_IN, DM, 9984, 1.f);
    cvt_job(F, w_in, 13200, DM, 10496, 768, WB + NW_IN, DM, 10496, 1.f);
    cvt_job(F, w_in, 13200, DM, 11776, 768, WB + NW_IN, DM, 11264, 1.f);
    cvt_job(F, w_in, 13200, DM, 13056, 144, WB + NW_IN, DM, 12032, 1.f);
    zero_bf16(F, WB + NW_IN + (size_t)12176 * DM, (size_t)112 * DM);
    cvt_job(F, w_in, 13200, DM, 11264, 512, WB + NW_IN, DM, 12288, 1.f);
    cvt_job(F, w_in, 13200, DM, 12544, 512, WB + NW_IN, DM, 12800, 1.f);
    cvt_job(F, k_w1, 256, 6144, 0, 256, WB + NW_W1K, 6144, 0, 1.f);
    cvt_job(F, v_w1, 256, 4096, 0, 256, WB + NW_W1V, 4096, 0, 1.f);
    cvt_job(F, k_w2, 192, 256, 0, 192, WB + NW_W2K, 256, 0, 1.f); zero_bf16(F, WB + NW_W2K + 192 * 256, 64 * 256);
    cvt_job(F, v_w2, 128, 256, 0, 128, WB + NW_W2V, 256, 0, 1.f); zero_bf16(F, WB + NW_W2V + 128 * 256, 128 * 256);
    cvt_job(F, w_out, DM, 6144, 0, DM, WB + NW_OUT, 6144, 0, 1.f);
    for (int w = F.gw; w < 512; w += F.NGW) { const bool isk = w < 256; const int c = w & 255, n = isk ? 6144 : 4096; const float* pe = isk ? k_pe : v_pe; const float* w1 = isk ? k_w1 : v_w1;
        float s = 0.f; for (int i = F.lane; i < n; i += 64) s += pe[i] * w1[(size_t)i * 256 + c];
        s = wave_sum(s); if (F.lane == 0) BIAS[w] = s + (isk ? k_b1[c] : v_b1[c]); }
}
DI void ph_nsa_rope(const Frame& F, int half) {
    unsigned char* ar = F.ws + WS_AR; bf16* Q = (bf16*)(ar + NA_Q); bf16* KC = (bf16*)(ar + NA_KC);
    const bf16* KSR = (const bf16*)(ar + NA_KSR); const bf16* KWR = (const bf16*)(ar + NA_KWR); bf16* KSF = (bf16*)(ar + NA_KSF); bf16* KWF = (bf16*)(ar + NA_KWF);
    const float* c48 = (const float*)(F.ws + TAB_COS48); const float* s48 = (const float*)(F.ws + TAB_SIN48);
    for (int ml = F.gw; ml < MC; ml += F.NGW) {
        const size_t mg = (size_t)half * MC + ml; const int bl = ml >> 12, sq = ml & 4095;
        for (int p = F.lane; p < 1248; p += 64) {
            const int hd = p / 24, i = p - hd * 24; bf16* q;
            if (hd < 48) q = Q + (size_t)ml * 9216 + hd * 192 + i;
            else q = KC + ((size_t)(bl * 4 + hd - 48) * 4096 + sq) * 192 + i;
            const float x1 = bf2f(q[0]), x2 = bf2f(q[24]), c = c48[mg * 24 + i], s = s48[mg * 24 + i]; q[0] = f2bf(x1 * c - x2 * s); q[24] = f2bf(x1 * s + x2 * c);
        }
        const int tile = sq >> 5, rr = sq & 31;
        for (int u = F.lane; u < 168; u += 64) {
            const int tens = u / 84, uu = u - tens * 84, g = uu / 21, v = uu - g * 21;
            const bf16* src = (tens ? KWR : KSR) + (size_t)ml * 768 + g * 192;
            bf16* dst = (tens ? KWF : KSF) + ((size_t)((bl * 4 + g) * 128 + tile) * 12 * 64 + rr) * 8;
            if (v < 3) {
                const u32x4 a = *(const u32x4*)(src + 8 * v), b = *(const u32x4*)(src + 8 * v + 24); u32x4 o1, o2;
#pragma unroll
                for (int e = 0; e < 4; ++e) { const float c0 = c48[mg * 24 + 8 * v + 2 * e], s0 = s48[mg * 24 + 8 * v + 2 * e], c1 = c48[mg * 24 + 8 * v + 2 * e + 1], s1 = s48[mg * 24 + 8 * v + 2 * e + 1];
                    const float x1l = bflo(a[e]), x1h = bfhi(a[e]), x2l = bflo(b[e]), x2h = bfhi(b[e]);
                    o1[e] = pk2(x1l * c0 - x2l * s0, x1h * c1 - x2h * s1); o2[e] = pk2(x1l * s0 + x2l * c0, x1h * s1 + x2h * c1); }
                const int p1 = v, p2 = v + 3;
                if (tens) { *(u32x4*)(dst + ((p1 >> 1) * 64 + (p1 & 1) * 32) * 8) = o1; *(u32x4*)(dst + ((p2 >> 1) * 64 + (p2 & 1) * 32) * 8) = o2; }
                else { unsigned char* d8 = (unsigned char*)KSF + ((size_t)(((bl * 4 + g) * 128 + tile) * 2 + (rr >> 4)) * 6 * 64 + (rr & 15)) * 8;
                    *(fp8x8_t*)(d8 + ((p1 >> 2) * 64 + (p1 & 3) * 16) * 8) = pack_fp8x8(bflo(o1[0]), bfhi(o1[0]), bflo(o1[1]), bfhi(o1[1]), bflo(o1[2]), bfhi(o1[2]), bflo(o1[3]), bfhi(o1[3]));
                    *(fp8x8_t*)(d8 + ((p2 >> 2) * 64 + (p2 & 3) * 16) * 8) = pack_fp8x8(bflo(o2[0]), bfhi(o2[0]), bflo(o2[1]), bfhi(o2[1]), bflo(o2[2]), bfhi(o2[2]), bflo(o2[3]), bfhi(o2[3])); }
            } else { const int pc = v + 3; const u32x4 c = *(const u32x4*)(src + 8 * pc);
                if (tens) *(u32x4*)(dst + ((pc >> 1) * 64 + (pc & 1) * 32) * 8) = c;
                else { unsigned char* d8 = (unsigned char*)KSF + ((size_t)(((bl * 4 + g) * 128 + tile) * 2 + (rr >> 4)) * 6 * 64 + (rr & 15)) * 8;
                    *(fp8x8_t*)(d8 + ((pc >> 2) * 64 + (pc & 3) * 16) * 8) = pack_fp8x8(bflo(c[0]), bfhi(c[0]), bflo(c[1]), bfhi(c[1]), bflo(c[2]), bfhi(c[2]), bflo(c[3]), bfhi(c[3])); } }
        }
    }
    const bf16* VSR = (const bf16*)(ar + NA_VSR); const bf16* VWR = (const bf16*)(ar + NA_VWR); bf16* VSF = (bf16*)(ar + NA_VSF); bf16* VWF = (bf16*)(ar + NA_VWF);
    const int r = F.lane & 31, h = F.lane >> 5;
    for (int u = F.gw; u < 2 * BPH * 4 * 128; u += F.NGW) {
        const int tens = u >> 11, bg = (u >> 7) & 15, tile = u & 127, bl = bg >> 2, g = bg & 3;
        if (tens) {
            const bf16* src = VWR + ((size_t)bl * SEQ + tile * 32) * 512 + g * 128 + r;
            bf16* vd = VWF + (((size_t)bg * 128 + tile) * 8 * 64 + F.lane) * 8;
#pragma unroll
            for (int db = 0; db < 4; ++db)
#pragma unroll
                for (int s = 0; s < 2; ++s) { unsigned short e[8];
#pragma unroll
                    for (int j = 0; j < 8; ++j) e[j] = src[(size_t)(16 * s + 8 * (j >> 2) + 4 * h + (j & 3)) * 512 + db * 32];
                    u32x4 w; w.x = e[0] | ((unsigned)e[1] << 16); w.y = e[2] | ((unsigned)e[3] << 16); w.z = e[4] | ((unsigned)e[5] << 16); w.w = e[6] | ((unsigned)e[7] << 16);
                    *(u32x4*)(vd + (db * 2 + s) * 512) = w; }
        } else {
            const int d16 = F.lane & 15, kq = F.lane >> 4;
            const bf16* src = VSR + ((size_t)bl * SEQ + tile * 32) * 512 + g * 128 + d16;
            unsigned char* vd = (unsigned char*)VSF + (((size_t)bg * 128 + tile) * 8 * 64 + F.lane) * 8;
#pragma unroll
            for (int db = 0; db < 8; ++db) { float e[8];
#pragma unroll
                for (int j = 0; j < 8; ++j) e[j] = bf2f(src[(size_t)((j < 4 ? 4 * kq + j : 16 + 4 * kq + j - 4)) * 512 + db * 16]);
                *(fp8x8_t*)(vd + db * 512) = pack_fp8x8(e[0], e[1], e[2], e[3], e[4], e[5], e[6], e[7]); }
        }
    }
}
DI float sigmoidf_(float x) { return __builtin_amdgcn_rcpf(1.0f + __builtin_amdgcn_exp2f(-x * LOG2E)); }
struct LinKA { const bf16* base; size_t tstride; DI const bf16* operator()(int t) const { return base + (size_t)t * tstride; } };
struct LinVA { const bf16* base; size_t dbstride; DI const bf16* operator()(int t, int db) const { return base + (size_t)db * dbstride + t * 32; } };
struct CmpMK { int tq, h; DI void operator()(int t, f32x16& S) const {
#pragma unroll
    for (int i = 0; i < 16; ++i) { const int n = 32 * t + crow(i, h); S[i] = (16 * n + 31 <= tq) ? S[i] : -INFINITY; } } };
struct WinMK { int tq, h; DI void operator()(int t, f32x16& S) const {
#pragma unroll
    for (int i = 0; i < 16; ++i) { const int k = 32 * t + crow(i, h); S[i] = (k <= tq && k > tq - 512) ? S[i] : -INFINITY; } } };
DI void ph_nsa_cmp(const Frame& F, const int dry = 0) {
    unsigned char* ar = F.ws + WS_AR; const bf16* Q = (const bf16*)(ar + NA_Q); const bf16* KCMP = (const bf16*)(ar + NA_KCMP); const bf16* VCT = (const bf16*)(ar + NA_VCT); const bf16* GT = (const bf16*)(ar + NA_GT);
    unsigned char* SELB = ar + NA_SELB; bf16* Ob = (bf16*)(ar + NA_O);
    LAS float* imp = (LAS float*)F.lds;
    LAS unsigned char* tl = F.lds + 20480;
    const int lane = F.lane, r = lane & 31, h = lane >> 5, tid = F.tid;
    for (int u = blockIdx.x; u < BPH * 4 * 64; u += F.G) {
        const int bg = u >> 6, qt64 = ((u >> 8) & 1) ? 63 - (u & 63) : (u & 63), bl = bg >> 2, g = bg & 3;
        for (int i = F.tid; i < 64 * 65; i += NWAVES * 64) imp[i] = 0.f;
        __syncthreads();
        const FragSrc src{KCMP + (size_t)bg * 8 * 12 * 512, VCT + (size_t)bg * 8 * 8 * 512, 12};
        const int tqmaxb = qt64 * 64 + 63, TE = (tqmaxb >= 31) ? ((tqmaxb - 31) / 16) / 32 + 1 : 0;
#pragma unroll 1
        for (int k = 0; k < 3; ++k) {
            const int idx = F.wave * 3 + k, j = idx >> 1, sub = idx & 1, ql = sub * 32 + r, tq = qt64 * 64 + ql, hd = g * 12 + j;
            const size_t mrow = (size_t)bl * SEQ + tq;
            bf16x8 qf[12];
#pragma unroll
            for (int s = 0; s < 12; ++s) qf[s] = *(const bf16x8*)(Q + mrow * 9216 + hd * 192 + 16 * s + 8 * h);
            const int tqmax = qt64 * 64 + sub * 32 + 31, te = (tqmax >= 31) ? ((tqmax - 31) / 16) / 32 + 1 : 0;
            const CmpMK mk{tq, h};
            f32x16 O[4];
#pragma unroll
            for (int db = 0; db < 4; ++db)
#pragma unroll
                for (int i = 0; i < 16; ++i) O[db][i] = 0.f;
            float m = -INFINITY, l = 0.f;
            attn_run_sh<12, false>(tl, tid, lane, qf, O, m, l, 0, TE, 0, te, src, mk);
            l += __shfl_xor(l, 32);
            const float linv = l > 0.f ? 1.0f / l : 0.f, ms = (m == -INFINITY) ? 0.f : m;
            if (TE > 0) {
                TilePre<12> pre;
                tile_fetch<12>(pre, src, 0, tid); tile_put<12>(pre, tl, tid);
                LDS_WAIT(); __builtin_amdgcn_s_barrier(); asm volatile("" ::: "memory");
#pragma unroll 1
                for (int t = 0; t < TE; ++t) {
                    LAS unsigned char* cur = tl + (t & 1) * 20480;
                    if (t + 1 < TE) tile_fetch<12>(pre, src, t + 1, tid);
                    if (t < te) {
                        f32x16 S;
#pragma unroll
                        for (int i = 0; i < 16; ++i) S[i] = 0.f;
#pragma unroll
                        for (int s = 0; s < 12; ++s) S = MFMA32(*(const LAS bf16x8*)(cur + s * 1024 + lane * 16), qf[s], S);
                        mk(t, S);
#pragma unroll
                        for (int i = 0; i < 16; ++i) S[i] = __builtin_amdgcn_exp2f(S[i] - ms) * linv;
#pragma unroll
                        for (int g4 = 0; g4 < 4; ++g4) { const float gs = (S[4 * g4] + S[4 * g4 + 1]) + (S[4 * g4 + 2] + S[4 * g4 + 3]); const int mb = 8 * t + 2 * g4 + h;
                            __hip_atomic_fetch_add(imp + ql * 65 + mb, gs, __ATOMIC_RELAXED, __HIP_MEMORY_SCOPE_WORKGROUP);
                            if (mb + 1 < 64) __hip_atomic_fetch_add(imp + ql * 65 + mb + 1, S[4 * g4 + 3], __ATOMIC_RELAXED, __HIP_MEMORY_SCOPE_WORKGROUP); }
                        bf16x8 pf[2];
#pragma unroll
                        for (int s = 0; s < 2; ++s) { u32x4 w; w.x = pk2(S[8 * s], S[8 * s + 1]); w.y = pk2(S[8 * s + 2], S[8 * s + 3]); w.z = pk2(S[8 * s + 4], S[8 * s + 5]); w.w = pk2(S[8 * s + 6], S[8 * s + 7]); pf[s] = __builtin_bit_cast(bf16x8, w); }
#pragma unroll
                        for (int db = 0; db < 4; ++db)
#pragma unroll
                            for (int s = 0; s < 2; ++s) O[db] = MFMA32(*(const LAS bf16x8*)(cur + (12 + db * 2 + s) * 1024 + lane * 16), pf[s], O[db]);
                    }
                    if (t + 1 < TE) tile_put<12>(pre, tl + ((t + 1) & 1) * 20480, tid);
                    LDS_WAIT(); __builtin_amdgcn_s_barrier(); asm volatile("" ::: "memory");
                }
            }
            const float gate = sigmoidf_(bf2f(GT[mrow * 256 + hd]));
            store_col<false>(dry ? (bf16*)(ar + DUMMY_OFF) + ((size_t)F.gw * 32 + r) * 128 : Ob + mrow * 6144 + hd * 128, O, gate, h);
        }
        __syncthreads();
#pragma unroll 1
        for (int k = 0; k < 8; ++k) {
            const int ql = F.wave * 8 + k, tq = qt64 * 64 + ql, cur = tq >> 6, mb = lane;
            const bool causal = mb <= cur, forced = (mb == 0) || (mb == cur) || (mb == cur - 1);
            const float v = causal ? (forced ? INFINITY : imp[ql * 65 + mb]) : -INFINITY;
            int rank = 0;
            for (int o = 0; o < 64; ++o) { const float vo = __shfl(v, o); rank += (vo > v || (vo == v && o < mb)) ? 1 : 0; }
            if (rank < 16) (dry ? ar + DUMMY_OFF + 32 * MiB + (size_t)F.gw * 16 : SELB + ((size_t)bg * 4096 + tq) * 16)[rank] = causal ? (unsigned char)mb : (unsigned char)0xFF;
        }
        __syncthreads();
    }
}
DI int sel_tile(const u32x4& sel, int t) { const int b = t >> 1; const unsigned w = (b < 4) ? sel.x : (b < 8) ? sel.y : (b < 12) ? sel.z : sel.w; return (int)((w >> ((b & 3) * 8)) & 0xFFu) * 2 + (t & 1); }
struct SelKA { const bf16* base; u32x4 sel; DI const bf16* operator()(int t) const { return base + (size_t)sel_tile(sel, t) * 12 * 512; } };
struct SelVA { const bf16* base; u32x4 sel; DI const bf16* operator()(int t, int db) const { return base + ((size_t)sel_tile(sel, t) * 8 + db * 2) * 512; } };
struct SelMK { u32x4 sel; int tq, h; DI void operator()(int t, f32x16& S) const { const int k0 = sel_tile(sel, t) * 32;
#pragma unroll
    for (int i = 0; i < 16; ++i) S[i] = (k0 + crow(i, h) <= tq) ? S[i] : -INFINITY; } };
typedef float f32x4_ __attribute__((ext_vector_type(4)));
#define MFMA16F8(a, b, c) __builtin_amdgcn_mfma_f32_16x16x32_fp8_fp8((a), (b), (c), 0, 0, 0)
DI void ph_nsa_sel(const Frame& F, const int dry = 0) {
    unsigned char* ar = F.ws + WS_AR; const bf16* Q = (const bf16*)(ar + NA_Q); const unsigned char* KS8 = ar + NA_KSF; const unsigned char* VS8 = ar + NA_VSF; const bf16* GT = (const bf16*)(ar + NA_GT);
    const unsigned char* SELB = ar + NA_SELB; bf16* Ob = (bf16*)(ar + NA_O);
    const int c16 = F.lane & 15, kq = F.lane >> 4; const bool act = c16 < 12;
    for (int it = F.gw; it < BPH * 4 * SEQ; it += F.NGW) {
        const int bg = it >> 12, tq = it & 4095, bl = bg >> 2, g = bg & 3; const size_t mrow = (size_t)bl * SEQ + tq; const int hd = g * 12 + (act ? c16 : 0);
        fp8x8_t qf[6];
#pragma unroll
        for (int s = 0; s < 6; ++s) { const u32x4 q = *(const u32x4*)(Q + mrow * 9216 + hd * 192 + 32 * s + 8 * kq); const float qs = act ? (1.0f / NSA_QSCALE) : 0.f;
            qf[s] = pack_fp8x8(bflo(q[0]) * qs, bfhi(q[0]) * qs, bflo(q[1]) * qs, bfhi(q[1]) * qs, bflo(q[2]) * qs, bfhi(q[2]) * qs, bflo(q[3]) * qs, bfhi(q[3]) * qs); }
        const u32x4 sel = *(const u32x4*)(SELB + (size_t)it * 16);
        const int nv = ((tq >> 6) + 1 < 16) ? (tq >> 6) + 1 : 16, te = 2 * nv;
        const unsigned char* kb = KS8 + ((size_t)bg * 128 * 12 * 64 + F.lane) * 8; const unsigned char* vb = VS8 + ((size_t)bg * 128 * 8 * 64 + F.lane) * 8;
        f32x4_ O[8];
#pragma unroll
        for (int db = 0; db < 8; ++db) O[db] = (f32x4_){0.f, 0.f, 0.f, 0.f};
        float m = -INFINITY, l = 0.f;
        fp8x8_t kfA[12], kfB[12], vfA[8], vfB[8];
        { const unsigned char* kp = kb + (size_t)sel_tile(sel, 0) * 12 * 512; const unsigned char* kp1 = kb + (size_t)sel_tile(sel, 1) * 12 * 512; const unsigned char* vp = vb + (size_t)sel_tile(sel, 0) * 8 * 512;
#pragma unroll
          for (int s = 0; s < 12; ++s) { kfA[s] = *(const fp8x8_t*)(kp + s * 512); kfB[s] = *(const fp8x8_t*)(kp1 + s * 512); }
#pragma unroll
          for (int j = 0; j < 8; ++j) vfA[j] = *(const fp8x8_t*)(vp + j * 512); }
#define SEL_STEP(T_, KF_, VF_, VFN_) do { const int t_ = (T_); const int tile = sel_tile(sel, t_); \
            if (t_ + 1 < te) { const unsigned char* vp = vb + (size_t)sel_tile(sel, t_ + 1) * 8 * 512; _Pragma("unroll") for (int j = 0; j < 8; ++j) VFN_[j] = *(const fp8x8_t*)(vp + j * 512); } \
            f32x4_ S0 = {0.f, 0.f, 0.f, 0.f}, S1 = S0; \
            _Pragma("unroll") for (int s = 0; s < 6; ++s) { S0 = MFMA16F8(KF_[s], qf[s], S0); S1 = MFMA16F8(KF_[6 + s], qf[s], S1); } \
            if (t_ + 2 < te) { const unsigned char* kp = kb + (size_t)sel_tile(sel, t_ + 2) * 12 * 512; _Pragma("unroll") for (int s = 0; s < 12; ++s) KF_[s] = *(const fp8x8_t*)(kp + s * 512); } \
            const int k0 = tile * 32 + 4 * kq; float mx = -INFINITY; \
            _Pragma("unroll") for (int i = 0; i < 4; ++i) { S0[i] = (k0 + i <= tq) ? S0[i] * NSA_QSCALE : -INFINITY; S1[i] = (k0 + 16 + i <= tq) ? S1[i] * NSA_QSCALE : -INFINITY; mx = fmaxf(mx, fmaxf(S0[i], S1[i])); } \
            mx = fmaxf(mx, __shfl_xor(mx, 16)); mx = fmaxf(mx, __shfl_xor(mx, 32)); \
            const float mn = fmaxf(m, mx), ms = (mn == -INFINITY) ? 0.f : mn, alpha = __builtin_amdgcn_exp2f(m - ms); \
            float sum = 0.f; \
            _Pragma("unroll") for (int i = 0; i < 4; ++i) { S0[i] = __builtin_amdgcn_exp2f(S0[i] - ms); S1[i] = __builtin_amdgcn_exp2f(S1[i] - ms); sum += S0[i] + S1[i]; } \
            l = l * alpha + sum; m = mn; \
            if (__builtin_amdgcn_ballot_w64(alpha != 1.0f) != 0ull) { _Pragma("unroll") for (int db = 0; db < 8; ++db) O[db] = O[db] * alpha; } \
            const fp8x8_t p8 = pack_fp8x8(S0[0], S0[1], S0[2], S0[3], S1[0], S1[1], S1[2], S1[3]);       \
            _Pragma("unroll") for (int db = 0; db < 8; ++db) O[db] = MFMA16F8(VF_[db], p8, O[db]); } while (0)
#pragma unroll 1
        for (int t = 0; t < te; t += 2) { SEL_STEP(t, kfA, vfA, vfB); SEL_STEP(t + 1, kfB, vfB, vfA); }
#undef SEL_STEP
        l += __shfl_xor(l, 16); l += __shfl_xor(l, 32);
        if (act) { const float gate = sigmoidf_(bf2f(GT[mrow * 256 + 48 + hd])); const float sc = l > 0.f ? gate / l : 0.f;
            bf16* o = (dry ? (bf16*)(ar + DUMMY_OFF) + ((size_t)F.gw * 16 + c16) * 128 : Ob + mrow * 6144 + hd * 128) + 4 * kq;
#pragma unroll
            for (int db = 0; db < 8; ++db) { u32x2* p = (u32x2*)(o + db * 16); const u32x2 prev = *p;
                u32x2 w; w.x = pk2(O[db][0] * sc + bflo(prev.x), O[db][1] * sc + bfhi(prev.x)); w.y = pk2(O[db][2] * sc + bflo(prev.y), O[db][3] * sc + bfhi(prev.y)); *p = w; } }
    }
}
DI void ph_nsa_win(const Frame& F, const int dry = 0) {
    unsigned char* ar = F.ws + WS_AR; const bf16* Q = (const bf16*)(ar + NA_Q); const bf16* KWF = (const bf16*)(ar + NA_KWF); const bf16* VWF = (const bf16*)(ar + NA_VWF); const bf16* GT = (const bf16*)(ar + NA_GT); bf16* Ob = (bf16*)(ar + NA_O);
    const int r = F.lane & 31, h = F.lane >> 5;
    for (int idb = blockIdx.x; idb < BPH * 48 * 16; idb += F.G) {
        const int qt0 = (idb & 15) * 8, qt = qt0 + F.wave, bh = idb >> 4, hd = bh % 48, bl = bh / 48, g = hd / 12, bg = bl * 4 + g, tq = qt * 32 + r; const size_t mrow = (size_t)bl * SEQ + tq;
        bf16x8 qf[12];
#pragma unroll
        for (int s = 0; s < 12; ++s) qf[s] = *(const bf16x8*)(Q + mrow * 9216 + hd * 192 + 16 * s + 8 * h);
        const FragSrc src{KWF + (size_t)bg * 128 * 12 * 512, VWF + (size_t)bg * 128 * 8 * 512, 12}; const WinMK mk{tq, h};
        f32x16 O[4];
#pragma unroll
        for (int db = 0; db < 4; ++db)
#pragma unroll
            for (int i = 0; i < 16; ++i) O[db][i] = 0.f;
        float m = -INFINITY, l = 0.f;
        attn_run_sh<12, true>(F.lds, F.tid, F.lane, qf, O, m, l, qt0 >= 16 ? qt0 - 16 : 0, qt0 + 8, qt >= 16 ? qt - 16 : 0, qt + 1, src, mk);
        l += __shfl_xor(l, 32);
        const float gate = sigmoidf_(bf2f(GT[mrow * 256 + 96 + hd]));
        store_col<true>(dry ? (bf16*)(ar + DUMMY_OFF) + ((size_t)F.gw * 32 + r) * 128 : Ob + mrow * 6144 + hd * 128, O, l > 0.f ? gate / l : 0.f, h);
    }
}
#ifndef MK_ONE_LAUNCH
#define MK_ONE_LAUNCH 1
#endif
constexpr int NPH = 102;
struct Args { const float* in[58]; float* out; unsigned char* ws; int ph_lo, ph_hi; };
#ifndef PROBE_GEMM
#define PROBE_GEMM 0
#endif
#ifndef PROBE_PH
#define PROBE_PH 0
#endif
#define GEMM_AKOFF 0
#define GEMM_CALL(EpiT, Evar, Aptr, Bptr, Mv, Nv, Kv, ldav, ldbv, cidx) do { if (PROBE_GEMM) { const pg8::Gemm g0_{(const pg8::bf16_t*)(Aptr), (const pg8::bf16_t*)(Bptr), (Mv), (Nv), (Kv), (ldav), (ldbv), GEMM_AKOFF}; \
    pg8::StaticOrder S0_; S0_.init((Mv), (Nv), F.G, (cidx)); pg8::EpiDry E0_{(float*)(ar + DUMMY_OFF)}; pg8::gemm_phase<pg8::EpiDry, pg8::StaticOrder, true, true>((PG8_LAS unsigned char*)F.lds, g0_, S0_, E0_); __syncthreads(); } \
    const pg8::Gemm g_{(const pg8::bf16_t*)(Aptr), (const pg8::bf16_t*)(Bptr), (Mv), (Nv), (Kv), (ldav), (ldbv), GEMM_AKOFF}; \
    pg8::StaticOrder S_; S_.init((Mv), (Nv), F.G, (cidx)); pg8::gemm_phase<EpiT, pg8::StaticOrder, true, true>((PG8_LAS unsigned char*)F.lds, g_, S_, Evar); } while (0)
DI pg8::EpiBf16R epi1(bf16* base, int ldc) { pg8::EpiBf16R e; for (int s = 0; s < 8; ++s) { e.T.base[s] = base; e.T.ldc[s] = ldc; e.T.t0[s] = 0; e.T.gw[s] = 0; } e.T.nseg = 1; e.T.pad_ = 0; return e; }
#define PH_BEGIN if (ph >= lo && ph < hi) { Frame F; { unsigned long long w_ = (unsigned long long)args.ws; asm volatile("" : "+s"(w_)); F.ws = (unsigned char*)w_; F.ctl = (unsigned*)(F.ws + WS_CTL); } \
    F.lds = lds; F.tid = threadIdx.x; F.lane = F.tid & 63; F.wave = __builtin_amdgcn_readfirstlane(F.tid >> 6); F.G = gridDim.x; F.gw = blockIdx.x * NWAVES + F.wave; F.NGW = F.G * NWAVES; \
    float* out; { unsigned long long o_ = (unsigned long long)args.out; asm volatile("" : "+s"(o_)); out = (float*)o_; } \
    unsigned char* const ar = F.ws + WS_AR; bf16* const XN = (bf16*)(F.ws + WS_XN); bf16* const WB = (bf16*)(F.ws + WS_WMIX); bf16* const WUP = (bf16*)(F.ws + WS_WFFN); bf16* const WDN = WUP + (size_t)2 * DFF * DM; \
    const float* const res_mix = (ib == 2) ? args.in[0] : (const float*)out; (void)ar; (void)XN; (void)WB; (void)WUP; (void)WDN; (void)res_mix; (void)iff;
#define PH_END   if (ph + 1 < hi) { XcdBarrier b_; b_.bar = (unsigned*)F.ctl + CW_BAR; b_.x = xb_xcc_id(); b_.st = MISC + 8; xcd_barrier(b_); } } ++ph;
template <int LAYER> DI void run_cvt(const Args& args, LAS unsigned char* lds, volatile LAS unsigned* MISC, int& ph, const int lo, const int hi) {
    constexpr int ib = (LAYER == 0) ? 2 : (LAYER == 1) ? 17 : (LAYER == 2) ? 26 : 42;
    constexpr int iff = (LAYER == 0) ? 12 : (LAYER == 1) ? 21 : (LAYER == 2) ? 37 : 52;
    constexpr int kind = (LAYER == 1) ? 1 : (LAYER == 2) ? 2 : 0;
        PH_BEGIN
          for (int rep_ = 0; rep_ < (PROBE_PH == 11 ? 2 : 1); ++rep_) {
            if constexpr (kind == 0) ph_dsa_cvt(F, args.in[ib + 1], args.in[ib + 6], args.in[ib + 7], args.in[ib + 8], args.in[ib + 9]);
            else if constexpr (kind == 1) ph_fox_cvt(F, args.in[ib + 1], args.in[ib + 3]);
            else ph_nsa_cvt(F, args.in[ib + 1], args.in[ib + 2], args.in[ib + 3], args.in[ib + 4], args.in[ib + 5], args.in[ib + 6], args.in[ib + 7], args.in[ib + 8], args.in[ib + 9], args.in[ib + 10]);
            ph_cvt_ffn(F, args.in[iff + 1], args.in[iff + 4]); __syncthreads();
          }
        PH_END
}
template <int LAYER, int HALF> DI void run_half(const Args& args, LAS unsigned char* lds, volatile LAS unsigned* MISC, int& ph, const int lo, const int hi) {
    constexpr int ib = (LAYER == 0) ? 2 : (LAYER == 1) ? 17 : (LAYER == 2) ? 26 : 42;
    constexpr int iff = (LAYER == 0) ? 12 : (LAYER == 1) ? 21 : (LAYER == 2) ? 37 : 52;
    constexpr int kind = (LAYER == 1) ? 1 : (LAYER == 2) ? 2 : 0;
    constexpr int half = HALF;
            const int roff = half * MC;
            PH_BEGIN if (PROBE_PH == 9) { ph_rmsnorm(F, res_mix, roff, args.in[ib], XN); __syncthreads(); } ph_rmsnorm(F, res_mix, roff, args.in[ib], XN); PH_END
            if constexpr (kind == 0) {
                PH_BEGIN { pg8::EpiF32 E{(float*)(ar + DA_DIN), 1024}; GEMM_CALL(pg8::EpiF32, E, XN, WB + DW_W1, MC, 1024, DM, DM, DM, (int)blockIdx.x); } PH_END
                PH_BEGIN if (PROBE_PH == 10) { ph_dsa_post1(F, half, args.in[ib + 2], args.in[ib + 3], args.in[ib + 4], args.in[ib + 5]); __syncthreads(); } ph_dsa_post1(F, half, args.in[ib + 2], args.in[ib + 3], args.in[ib + 4], args.in[ib + 5]); PH_END
                PH_BEGIN { pg8::EpiBf16R E = epi1((bf16*)(ar + DA_QL), 8192); E.T.base[1] = (bf16*)(ar + DA_QPE); E.T.ldc[1] = 1536; E.T.t0[1] = 32; E.T.base[2] = (bf16*)(ar + DA_QIDX); E.T.ldc[2] = 2048; E.T.t0[2] = 38; E.T.nseg = 3;
                    GEMM_CALL(pg8::EpiBf16R, E, ar + DA_CQN, WB + DW_W2, MC, 11776, 512, 512, 512, (int)blockIdx.x); } PH_END
                PH_BEGIN ph_dsa_rope(F, half); PH_END
                PH_BEGIN if (PROBE_PH == 1) { ph_dsa_index(F, 1); __syncthreads(); } if (PROBE_PH == 7) { ph_dsa_index(F, 1, 1); __syncthreads(); } if (PROBE_PH == 8) { ph_dsa_index(F, 1, 2); __syncthreads(); } ph_dsa_index(F); PH_END
                PH_BEGIN if (PROBE_PH == 2) { ph_dsa_attn(F, 1); __syncthreads(); } ph_dsa_attn(F); PH_END
                PH_BEGIN {
                    pg8::EpiBf16R E = epi1((bf16*)(ar + DA_O2), 4096);
                    { const pg8::Gemm g_{(const pg8::bf16_t*)(ar + DA_QL), (const pg8::bf16_t*)(WB + DW_BD), MC, 4096, 512, 8192, 512, 512}; pg8::StaticOrder S_; S_.init(MC, 4096, F.G, (int)blockIdx.x);
                      pg8::gemm_phase<pg8::EpiBf16R, pg8::StaticOrder, true, true>((PG8_LAS unsigned char*)F.lds, g_, S_, E); } } PH_END
                PH_BEGIN { pg8::EpiRes E{res_mix, out, DM, roff}; GEMM_CALL(pg8::EpiRes, E, ar + DA_O2, WB + DW_WO, MC, DM, 4096, 4096, 4096, (int)blockIdx.x); } PH_END
            } else if constexpr (kind == 1) {
                PH_BEGIN { pg8::EpiBf16R E = epi1((bf16*)(ar + FA_Q), DM); E.T.base[1] = (bf16*)(ar + FA_K); E.T.ldc[1] = DM; E.T.t0[1] = 8; E.T.base[2] = (bf16*)(ar + FA_V); E.T.ldc[2] = DM; E.T.t0[2] = 16;
                    E.T.base[3] = (bf16*)(ar + FA_F); E.T.ldc[3] = 256; E.T.t0[3] = 24; E.T.nseg = 4;
                    GEMM_CALL(pg8::EpiBf16R, E, XN, WB + FW_IN, MC, 6400, DM, DM, DM, (int)blockIdx.x); } PH_END
                PH_BEGIN if (PROBE_PH == 10) { ph_fox_scan(F, args.in[ib + 2]); __syncthreads(); } ph_fox_scan(F, args.in[ib + 2]); PH_END
                PH_BEGIN if (PROBE_PH == 3) { ph_fox_attn(F, 1); __syncthreads(); } ph_fox_attn(F); PH_END
                PH_BEGIN { pg8::EpiRes E{res_mix, out, DM, roff}; GEMM_CALL(pg8::EpiRes, E, ar + FA_O, WB + FW_OUT, MC, DM, DM, DM, DM, (int)blockIdx.x); } PH_END
            } else {
                PH_BEGIN { pg8::EpiBf16R E = epi1((bf16*)(ar + NA_Q), 9216);
                    E.T.base[1] = (bf16*)(ar + NA_KC); E.T.ldc[1] = 192; E.T.t0[1] = 36; E.T.gw[1] = 192;
                    E.T.base[2] = (bf16*)(ar + NA_VC); E.T.ldc[2] = 128; E.T.t0[2] = 39; E.T.gw[2] = 128;
                    E.T.base[3] = (bf16*)(ar + NA_KSR); E.T.ldc[3] = 768; E.T.t0[3] = 41;
                    E.T.base[4] = (bf16*)(ar + NA_KWR); E.T.ldc[4] = 768; E.T.t0[4] = 44;
                    E.T.base[5] = (bf16*)(ar + NA_GT); E.T.ldc[5] = 256; E.T.t0[5] = 47;
                    E.T.base[6] = (bf16*)(ar + NA_VSR); E.T.ldc[6] = 512; E.T.t0[6] = 48;
                    E.T.base[7] = (bf16*)(ar + NA_VWR); E.T.ldc[7] = 512; E.T.t0[7] = 50; E.T.nseg = 8;
                    GEMM_CALL(pg8::EpiBf16R, E, XN, WB + NW_IN, MC, 13312, DM, DM, DM, (int)blockIdx.x); } PH_END
                PH_BEGIN ph_nsa_rope(F, half); PH_END
                PH_BEGIN {
                    const float* BIAS = (const float*)(args.ws + WS_MISC);
                    { pg8::EpiGelu E{(bf16*)(ar + NA_GK), 256, BIAS}; GEMM_CALL(pg8::EpiGelu, E, ar + NA_KC, WB + NW_W1K, 4096, 256, 6144, 3072, 6144, (int)blockIdx.x); }
                    { pg8::EpiGelu E{(bf16*)(ar + NA_GV), 256, BIAS + 256}; GEMM_CALL(pg8::EpiGelu, E, ar + NA_VC, WB + NW_W1V, 4096, 256, 4096, 2048, 4096, (int)((blockIdx.x + F.G - 16) % F.G)); }
                } PH_END
                PH_BEGIN {
                    { pg8::EpiBf16R E = epi1((bf16*)(ar + NA_KCMP), 12); E.T.gw[0] = -1; GEMM_CALL(pg8::EpiBf16R, E, ar + NA_GK, WB + NW_W2K, 4096, 256, 256, 256, 256, (int)blockIdx.x); }
                    { pg8::EpiBf16R E = epi1((bf16*)(ar + NA_VCT), 4); E.T.gw[0] = -2; GEMM_CALL(pg8::EpiBf16R, E, WB + NW_W2V, ar + NA_GV, 256, 4096, 256, 256, 256, (int)((blockIdx.x + F.G - 16) % F.G)); }
                } PH_END
                PH_BEGIN if (PROBE_PH == 4) { ph_nsa_cmp(F, 1); __syncthreads(); } ph_nsa_cmp(F); PH_END
                PH_BEGIN if (PROBE_PH == 5) { ph_nsa_sel(F, 1); __syncthreads(); } ph_nsa_sel(F); PH_END
                PH_BEGIN if (PROBE_PH == 6) { ph_nsa_win(F, 1); __syncthreads(); } ph_nsa_win(F); PH_END
                PH_BEGIN { pg8::EpiRes E{res_mix, out, DM, roff}; GEMM_CALL(pg8::EpiRes, E, ar + NA_O, WB + NW_OUT, MC, DM, 6144, 6144, 6144, (int)blockIdx.x); } PH_END
            }
            PH_BEGIN if (PROBE_PH == 9) { ph_rmsnorm(F, out, roff, args.in[iff], XN); __syncthreads(); } ph_rmsnorm(F, out, roff, args.in[iff], XN); PH_END
            PH_BEGIN { pg8::EpiConvGlu E{(pg8::bf16_t*)ar, (float*)(ar + 352 * MiB), args.in[iff + 2], args.in[iff + 3], (PG8_LAS float*)(F.lds + LDSCTL_OFF + 256), DFF};
                GEMM_CALL(pg8::EpiConvGlu, E, XN, WUP, MC, 2 * DFF, DM, DM, DM, (int)blockIdx.x); } PH_END
            PH_BEGIN ph_conv_fix(F, (const float*)(ar + 352 * MiB), (bf16*)ar, args.in[iff + 2], args.in[iff + 3]); PH_END
            PH_BEGIN { pg8::EpiRes E{out, out, DM, roff}; GEMM_CALL(pg8::EpiRes, E, ar, WDN, MC, DM, DFF, DFF, DFF, (int)blockIdx.x); } PH_END
}
__global__ void __launch_bounds__(NWAVES * 64, 2) mk_fwd(Args args) {
    extern __shared__ __attribute__((aligned(16))) unsigned char lds_[];
    LAS unsigned char* const lds = (LAS unsigned char*)lds_;
    volatile LAS unsigned* MISC = (volatile LAS unsigned*)(lds + LDSCTL_OFF);
    for (int u = threadIdx.x; u < 64; u += NWAVES * 64) ((LAS unsigned*)(lds + LDSCTL_OFF))[u] = 0u;
    __syncthreads();
    const int lo = args.ph_lo, hi = args.ph_hi;
    (void)xcd_barrier_post((unsigned*)(args.ws + WS_CTL) + CW_BAR, MISC + 8);
    int ph = 0;
    { constexpr int ib = 2, iff = 12; PH_BEGIN ph_tables(F, (const int*)args.in[1]); PH_END }
    run_cvt<0>(args, lds, MISC, ph, lo, hi); run_half<0, 0>(args, lds, MISC, ph, lo, hi); run_half<0, 1>(args, lds, MISC, ph, lo, hi);
    run_cvt<1>(args, lds, MISC, ph, lo, hi); run_half<1, 0>(args, lds, MISC, ph, lo, hi); run_half<1, 1>(args, lds, MISC, ph, lo, hi);
    run_cvt<2>(args, lds, MISC, ph, lo, hi); run_half<2, 0>(args, lds, MISC, ph, lo, hi); run_half<2, 1>(args, lds, MISC, ph, lo, hi);
    run_cvt<3>(args, lds, MISC, ph, lo, hi); run_half<3, 0>(args, lds, MISC, ph, lo, hi); run_half<3, 1>(args, lds, MISC, ph, lo, hi);
    { constexpr int ib = 42, iff = 52; PH_BEGIN ph_final_norm(F, out, args.in[57]); PH_END }
}
extern "C" void kernel_launch(void* const* d_in, const int* in_sizes, int n_in, void* d_out, int out_size, void* d_ws, size_t ws_size, hipStream_t stream) {
    static int grid = 0;
    if (grid == 0) {
        if (n_in != 58 || out_size != MTOT * DM || ws_size < WS_END) { fprintf(stderr, "kernel_launch: unexpected shapes (n_in %d, out %d, ws %zu)\n", n_in, out_size, ws_size); grid = -1; return; }
        int dev = 0, cus = 0;
        if (hipGetDevice(&dev) != hipSuccess || hipDeviceGetAttribute(&cus, hipDeviceAttributeMultiprocessorCount, dev) != hipSuccess) { grid = -1; return; }
        if (hipFuncSetAttribute((const void*)mk_fwd, hipFuncAttributeMaxDynamicSharedMemorySize, LDS_BYTES) != hipSuccess) { fprintf(stderr, "kernel_launch: hipFuncSetAttribute failed\n"); grid = -1; return; }
        int per_cu = 0;
        (void)hipOccupancyMaxActiveBlocksPerMultiprocessor(&per_cu, (const void*)mk_fwd, NWAVES * 64, LDS_BYTES);
        (void)hipGetLastError();
        grid = cus;
    }
    if (grid < 0) return;
    if (hipMemsetAsync((char*)d_ws + WS_CTL, 0, CTL_ZERO_BYTES, stream) != hipSuccess) return;
    Args a{};
    for (int i = 0; i < 58; ++i) a.in[i] = (const float*)d_in[i];
    a.out = (float*)d_out; a.ws = (unsigned char*)d_ws;
#if MK_ONE_LAUNCH
    a.ph_lo = 0; a.ph_hi = NPH;
    hipLaunchKernelGGL(mk_fwd, dim3(grid), dim3(NWAVES * 64), LDS_BYTES, stream, a);
#else
    for (int p = 0; p < NPH; ++p) { a.ph_lo = p; a.ph_hi = p + 1; hipLaunchKernelGGL(mk_fwd, dim3(grid), dim3(NWAVES * 64), LDS_BYTES, stream, a); }
#endif
}
```

```cpp
#include <hip/hip_runtime.h>
#include <cstdio>
#include <cstdint>
#define DI __device__ __forceinline__
namespace pg8 {
#define PG8_LAS __attribute__((address_space(3)))
typedef unsigned short bf16_t;
typedef short bf16x8 __attribute__((ext_vector_type(8)));
typedef float f32x4 __attribute__((ext_vector_type(4)));
typedef unsigned u32x4 __attribute__((ext_vector_type(4)));
constexpr int BM = 256, BK = 64, HALF = 128, HTB = HALF * BK * 2  , STAGE_BYTES = 8 * HTB, NXCD = 8, WGM = 8;

__host__ __device__ __forceinline__ int lds_byte(int r, int c) { const int st = (r >> 4) * 2 + (c >> 5), rr = r & 15, cc = c & 31, ob = rr * 64 + cc * 2; return st * 1024 + (ob ^ (((ob >> 9) & 1) << 5)); }
__host__ __device__ __forceinline__ void stage_rc(int b, int& R, int& C) { const int st = b / 1024, sb = b % 1024, swz = sb ^ (((sb >> 9) & 1) << 5); R = (st >> 1) * 16 + swz / 64; C = (st & 1) * 32 + (swz % 64) / 2; }
__host__ __device__ __forceinline__ int perm32(int rho) { const int n = rho >> 4, i = rho & 15; return 8 * (i >> 2) + 4 * n + (i & 3); }

struct Unit { int pm, pn; };
struct Gemm { const bf16_t* A; const bf16_t* Bt; int M, N, K, lda, ldb, akoff; };

struct StaticOrder {
    int nM, nN, nwg, G, c;
    __host__ __device__ void init(int M, int N, int G_, int c_) { nM = M / BM; nN = N / BM; nwg = nM * nN; G = G_; c = c_; }
    __host__ __device__ bool next(int i, Unit& u) const {
        const long L = (long)i * G + c; if (L >= nwg) return false;
        int wgid = (int)L; { const int q = nwg / NXCD, r = nwg % NXCD, xcd = wgid % NXCD, off = wgid / NXCD; wgid = (xcd < r ? xcd * (q + 1) : r * (q + 1) + (xcd - r) * q) + off; }
        const int nig = WGM * nN, gid = wgid / nig, fm = gid * WGM, gsz = (nM - fm) < WGM ? (nM - fm) : WGM;
        u.pm = fm + ((wgid % nig) % gsz); u.pn = (wgid % nig) / gsz; return true;
    }
    __device__ __forceinline__ void a_ready(const Unit&) const {}
    __device__ __forceinline__ void done(const Unit&) const {}
};
__device__ __forceinline__ unsigned cvt_pk_bf16(float lo, float hi) { unsigned r; asm volatile("v_cvt_pk_bf16_f32 %0, %1, %2" : "=v"(r) : "v"(lo), "v"(hi)); return r; }
template <class Epi, class Sched, bool ALIGN_EPI = false, bool SP2 = false>
__device__ __forceinline__ void gemm_phase(PG8_LAS unsigned char* lds, const Gemm g, const Sched& S, const Epi& E) {
    const int tid = threadIdx.x, wid = __builtin_amdgcn_readfirstlane(tid >> 6), lane = tid & 63, wr = wid >> 2, wc = wid & 3, fr = lane & 15, fq = lane >> 4;
    const int K = g.K, nt = K / BK;
    unsigned voffA[2], voffB[2];
#pragma unroll
    for (int i = 0; i < 2; ++i) { int R, C; stage_rc(tid * 16 + i * 8192, R, C); const int Rb = Epi::PERM ? ((R & ~31) + perm32(R & 31)) : R;
        voffA[i] = (unsigned)(R * g.lda + C) * 2u; voffB[i] = (unsigned)(Rb * g.ldb + C) * 2u; }
    const size_t kstep = (size_t)(BK * 2);
    const size_t hstepA = (size_t)HALF * g.lda * 2, hstepB = (size_t)HALF * g.ldb * 2;
    const size_t tstepA = 2 * hstepA, tstepB = 2 * hstepB;
    const unsigned ldsw = (unsigned)wid * 1024u;
    const int aoff = lds_byte(wr * 64 + fr, fq * 8), boff = lds_byte(wc * 32 + fr, fq * 8);
#define PG8_SA(b, h) (((b) * 2 + (h)) * HTB)
#define PG8_SB(b, h) ((4 + (b) * 2 + (h)) * HTB)
#define PG8_STAGE(bufoff, gbase, voff) do { _Pragma("unroll") for (int _i = 0; _i < 2; ++_i) \
        __builtin_amdgcn_global_load_lds((const unsigned*)((const char*)(gbase) + (voff)[_i]), (PG8_LAS unsigned*)(lds + (bufoff) + ldsw + _i * 8192), 16, 0, 0); } while (0)
#define PG8_LDA(dst, b, h) do { _Pragma("unroll") for (int m = 0; m < 4; ++m) _Pragma("unroll") for (int k = 0; k < 2; ++k) dst[m][k] = *(const PG8_LAS bf16x8*)(lds + PG8_SA(b, h) + aoff + m * 2048 + k * 1024); } while (0)
#define PG8_LDB(dst, b, h) do { _Pragma("unroll") for (int n = 0; n < 2; ++n) _Pragma("unroll") for (int k = 0; k < 2; ++k) dst[n][k] = *(const PG8_LAS bf16x8*)(lds + PG8_SB(b, h) + boff + n * 2048 + k * 1024); } while (0)
#define PG8_MMA(ai, bj, At, Bt) do { __builtin_amdgcn_s_setprio(1); _Pragma("unroll") for (int m = 0; m < 4; ++m) _Pragma("unroll") for (int n = 0; n < 2; ++n) _Pragma("unroll") for (int k = 0; k < 2; ++k) \
        acc[ai][bj][m][n] = __builtin_amdgcn_mfma_f32_16x16x32_bf16(Bt[n][k], At[m][k], acc[ai][bj][m][n], 0, 0, 0); __builtin_amdgcn_s_setprio(0); } while (0)
#define PG8_WAIT_V(n) asm volatile("s_waitcnt vmcnt(" #n ")" ::: "memory")
#define PG8_WAIT_L(n) asm volatile("s_waitcnt lgkmcnt(" #n ")" ::: "memory")
#define PG8_BAR __builtin_amdgcn_s_barrier()
#define PG8_SCHED __builtin_amdgcn_sched_barrier(0)
    Unit cur, nxt; int ui = 0;
    if (!S.next(0, cur)) return;
    f32x4 acc[2][2][4][2];
#pragma unroll
    for (int a = 0; a < 2; ++a)
#pragma unroll
        for (int b = 0; b < 2; ++b)
#pragma unroll
            for (int m = 0; m < 4; ++m)
#pragma unroll
                for (int n = 0; n < 2; ++n) acc[a][b][m][n] = (f32x4){0.f, 0.f, 0.f, 0.f};
    bf16x8 At[4][2], B0[2][2], B1[2][2];
    const char* cA = (const char*)g.A + (size_t)cur.pm * tstepA + (size_t)cur.pn * g.akoff * 2; const char* cB = (const char*)g.Bt + (size_t)cur.pn * tstepB;
    S.a_ready(cur);
    if constexpr (SP2) {
        PG8_STAGE(PG8_SB(0, 0), cB, voffB); PG8_STAGE(PG8_SB(0, 1), cB + hstepB, voffB); PG8_STAGE(PG8_SA(0, 0), cA, voffA); PG8_STAGE(PG8_SA(0, 1), cA + hstepA, voffA);
        if (wr == 1) PG8_BAR;
        PG8_WAIT_V(2); PG8_BAR;
        PG8_STAGE(PG8_SB(1, 0), cB + kstep, voffB); PG8_STAGE(PG8_SA(1, 0), cA + kstep, voffA); PG8_STAGE(PG8_SB(1, 1), cB + hstepB + kstep, voffB);
        PG8_WAIT_V(6); PG8_BAR;
    } else {
        PG8_STAGE(PG8_SB(0, 0), cB, voffB); PG8_STAGE(PG8_SA(0, 0), cA, voffA); PG8_STAGE(PG8_SB(0, 1), cB + hstepB, voffB); PG8_STAGE(PG8_SA(0, 1), cA + hstepA, voffA);
        if (wr == 1) PG8_BAR;
        PG8_WAIT_V(4); PG8_BAR;
        PG8_STAGE(PG8_SB(1, 0), cB + kstep, voffB); PG8_STAGE(PG8_SA(1, 0), cA + kstep, voffA); PG8_STAGE(PG8_SB(1, 1), cB + hstepB + kstep, voffB);
        PG8_WAIT_V(6); PG8_BAR;
    }
    for (;;) {
        const bool has_next = S.next(ui + 1, nxt);
        const char* nA = has_next ? (const char*)g.A + (size_t)nxt.pm * tstepA + (size_t)nxt.pn * g.akoff * 2 : cA; const char* nB = has_next ? (const char*)g.Bt + (size_t)nxt.pn * tstepB : cB;
        for (int t = 0; t < nt; t += 2) {
            const bool last = (t == nt - 2);
            const char* a1 = cA + (size_t)(t + 1) * kstep;
            const char* a2 = last ? nA : cA + (size_t)(t + 2) * kstep; const char* b2 = last ? nB : cB + (size_t)(t + 2) * kstep;
            const char* a3 = a2 + kstep; const char* b3 = b2 + kstep;
            if (last && has_next) S.a_ready(nxt);
            if constexpr (SP2) {
            PG8_LDB(B0, 0, 0); PG8_LDB(B1, 0, 1); PG8_SCHED; PG8_LDA(At, 0, 0); PG8_STAGE(PG8_SA(1, 1), a1 + hstepA, voffA);
            PG8_WAIT_V(8); PG8_WAIT_L(0); PG8_BAR; PG8_MMA(0, 0, At, B0); PG8_MMA(0, 1, At, B1); PG8_BAR; PG8_SCHED;
            PG8_LDA(At, 0, 1); PG8_STAGE(PG8_SB(0, 0), b2, voffB); PG8_STAGE(PG8_SB(0, 1), b2 + hstepB, voffB); PG8_STAGE(PG8_SA(0, 0), a2, voffA);
            PG8_WAIT_V(8); PG8_WAIT_L(0); PG8_BAR; PG8_MMA(1, 0, At, B0); PG8_MMA(1, 1, At, B1); PG8_BAR; PG8_SCHED;
            PG8_LDB(B0, 1, 0); PG8_LDB(B1, 1, 1); PG8_SCHED; PG8_LDA(At, 1, 0); PG8_STAGE(PG8_SA(0, 1), a2 + hstepA, voffA);
            PG8_WAIT_V(8); PG8_WAIT_L(0); PG8_BAR; PG8_MMA(0, 0, At, B0); PG8_MMA(0, 1, At, B1); PG8_BAR; PG8_SCHED;
            PG8_LDA(At, 1, 1); PG8_STAGE(PG8_SB(1, 0), b3, voffB); PG8_STAGE(PG8_SB(1, 1), b3 + hstepB, voffB); PG8_STAGE(PG8_SA(1, 0), a3, voffA);
            PG8_WAIT_V(8); PG8_WAIT_L(0); PG8_BAR; PG8_MMA(1, 0, At, B0); PG8_MMA(1, 1, At, B1); PG8_BAR; PG8_SCHED;
            } else {
            PG8_LDB(B0, 0, 0); PG8_SCHED; PG8_LDA(At, 0, 0); PG8_STAGE(PG8_SA(1, 1), a1 + hstepA, voffA);
            PG8_WAIT_L(8); PG8_BAR; PG8_WAIT_L(0); PG8_MMA(0, 0, At, B0); PG8_BAR; PG8_SCHED;
            PG8_LDB(B1, 0, 1); PG8_STAGE(PG8_SB(0, 0), b2, voffB);
            PG8_BAR; PG8_WAIT_L(0); PG8_MMA(0, 1, At, B1); PG8_BAR;
            PG8_LDA(At, 0, 1); PG8_STAGE(PG8_SA(0, 0), a2, voffA);
            PG8_BAR; PG8_WAIT_L(0); PG8_MMA(1, 0, At, B0); PG8_BAR; PG8_SCHED;
            PG8_STAGE(PG8_SB(0, 1), b2 + hstepB, voffB);
            PG8_WAIT_V(6); PG8_BAR; PG8_MMA(1, 1, At, B1); PG8_BAR;
            PG8_LDB(B0, 1, 0); PG8_SCHED; PG8_LDA(At, 1, 0); PG8_STAGE(PG8_SA(0, 1), a2 + hstepA, voffA);
            PG8_WAIT_L(8); PG8_BAR; PG8_WAIT_L(0); PG8_MMA(0, 0, At, B0); PG8_BAR; PG8_SCHED;
            PG8_LDB(B1, 1, 1); PG8_STAGE(PG8_SB(1, 0), b3, voffB);
            PG8_BAR; PG8_WAIT_L(0); PG8_MMA(0, 1, At, B1); PG8_BAR;
            PG8_LDA(At, 1, 1); PG8_STAGE(PG8_SA(1, 0), a3, voffA);
            PG8_BAR; PG8_WAIT_L(0); PG8_MMA(1, 0, At, B0); PG8_BAR; PG8_SCHED;
            PG8_STAGE(PG8_SB(1, 1), b3 + hstepB, voffB);
            PG8_WAIT_V(6); PG8_BAR; PG8_MMA(1, 1, At, B1); PG8_BAR;
            }
        }
        if constexpr (ALIGN_EPI) { if (wr == 0) PG8_BAR; }
        if constexpr (!Epi::AFTER_DRAIN) { E(acc, cur, wr, wc, fr, fq); S.done(cur); }
        if (!has_next) break;
#pragma unroll
        for (int a = 0; a < 2; ++a)
#pragma unroll
            for (int b = 0; b < 2; ++b)
#pragma unroll
                for (int m = 0; m < 4; ++m)
#pragma unroll
                    for (int n = 0; n < 2; ++n) acc[a][b][m][n] = (f32x4){0.f, 0.f, 0.f, 0.f};
        cur = nxt; cA = nA; cB = nB; ++ui;
        if constexpr (ALIGN_EPI) { if (wr == 1) PG8_BAR; }
    }
    PG8_WAIT_V(0);
    if constexpr (!ALIGN_EPI) { if (wr == 0) PG8_BAR; }
    PG8_BAR;
    if constexpr (Epi::AFTER_DRAIN) { E.fused(acc, cur, wr, wc, fr, fq, lds, wid, lane); S.done(cur); }
#undef PG8_SA
#undef PG8_SB
#undef PG8_STAGE
#undef PG8_LDA
#undef PG8_LDB
#undef PG8_MMA
#undef PG8_WAIT_V
#undef PG8_WAIT_L
#undef PG8_BAR
#undef PG8_SCHED
}
}
namespace pg8 {
typedef float f32x2 __attribute__((ext_vector_type(2)));
struct SegTab { bf16_t* base[8]; int ldc[8]; int t0[8]; int gw[8]; int nseg; int pad_; };
struct EpiBf16R {
    static constexpr bool PERM = true, AFTER_DRAIN = false;
    SegTab T;
    __device__ __forceinline__ void operator()(const f32x4 (&acc)[2][2][4][2], const Unit& u, int wr, int wc, int fr, int fq) const {
        bf16_t* base = T.base[0]; int ldc = T.ldc[0], gw = T.gw[0], t0 = T.t0[0];
#pragma unroll
        for (int s = 1; s < 8; ++s) if (s < T.nseg && u.pn >= T.t0[s]) { base = T.base[s]; ldc = T.ldc[s]; gw = T.gw[s]; t0 = T.t0[s]; }
        const int colt = (u.pn - t0) * BM, row0 = u.pm * BM + wr * 64 + fr;
#pragma unroll
        for (int ai = 0; ai < 2; ++ai)
#pragma unroll
            for (int m = 0; m < 4; ++m) { const int row = row0 + ai * HALF + m * 16;
#pragma unroll
                for (int bj = 0; bj < 2; ++bj) { const int col = colt + bj * HALF + wc * 32 + 8 * fq;
                    const f32x4 v0 = acc[ai][bj][m][0], v1 = acc[ai][bj][m][1];
                    u32x4 w; w.x = cvt_pk_bf16(v0[0], v0[1]); w.y = cvt_pk_bf16(v0[2], v0[3]); w.z = cvt_pk_bf16(v1[0], v1[1]); w.w = cvt_pk_bf16(v1[2], v1[3]);
                    if (gw == -2) {
                        if ((row >> 5) < ldc) { bf16_t* d0 = base + ((size_t)(((col >> 5) * ldc + (row >> 5)) * 2 + ((col >> 4) & 1)) * 64 + (row & 31)) * 8 + 4 * ((col >> 3) & 1);
                            typedef unsigned u32x2_ __attribute__((ext_vector_type(2)));
                            *(u32x2_*)d0 = (u32x2_){w.x, w.y}; *(u32x2_*)(d0 + 32 * 8) = (u32x2_){w.z, w.w}; }
                        continue; }
                    bf16_t* dst;
                    if (gw == 0) dst = base + (size_t)row * ldc + col;
                    else if (gw == -1) { if ((col >> 4) >= ldc) continue; dst = base + ((size_t)((row >> 5) * ldc + (col >> 4)) * 64 + ((col >> 3) & 1) * 32 + (row & 31)) * 8; }
                    else { const int g = col / gw, d = col - g * gw; dst = base + ((size_t)((row >> 12) * 4 + g) * 4096 + (row & 4095)) * gw + d; }
                    *(u32x4*)dst = w; } }
    }
};
struct EpiGelu {
    static constexpr bool PERM = true, AFTER_DRAIN = false;
    bf16_t* O; int ldc; const float* bias;
    static __device__ __forceinline__ float gelu(float x) { const float u2 = 1.5957691216f * (x + 0.044715f * x * x * x); const float e = __builtin_amdgcn_exp2f(-u2 * 1.4426950409f); return x * __builtin_amdgcn_rcpf(1.0f + e); }
    __device__ __forceinline__ void operator()(const f32x4 (&acc)[2][2][4][2], const Unit& u, int wr, int wc, int fr, int fq) const {
        const int row0 = u.pm * BM + wr * 64 + fr, col0 = u.pn * BM + wc * 32 + 8 * fq;
#pragma unroll
        for (int bj = 0; bj < 2; ++bj) { const f32x4 b0 = *(const f32x4*)(bias + col0 + bj * HALF), b1 = *(const f32x4*)(bias + col0 + bj * HALF + 4);
#pragma unroll
            for (int ai = 0; ai < 2; ++ai)
#pragma unroll
                for (int m = 0; m < 4; ++m) { const f32x4 v0 = acc[ai][bj][m][0] + b0, v1 = acc[ai][bj][m][1] + b1;
                    u32x4 w; w.x = cvt_pk_bf16(gelu(v0[0]), gelu(v0[1])); w.y = cvt_pk_bf16(gelu(v0[2]), gelu(v0[3])); w.z = cvt_pk_bf16(gelu(v1[0]), gelu(v1[1])); w.w = cvt_pk_bf16(gelu(v1[2]), gelu(v1[3]));
                    *(u32x4*)(O + (size_t)(row0 + ai * HALF + m * 16) * ldc + col0 + bj * HALF) = w; } }
    }
};
struct EpiF32 {
    static constexpr bool PERM = false, AFTER_DRAIN = false;
    float* C; int ldc;
    __device__ __forceinline__ void operator()(const f32x4 (&acc)[2][2][4][2], const Unit& u, int wr, int wc, int fr, int fq) const {
        const int row0 = u.pm * BM + wr * 64 + fr, col0 = u.pn * BM + wc * 32 + 4 * fq;
#pragma unroll
        for (int ai = 0; ai < 2; ++ai)
#pragma unroll
            for (int m = 0; m < 4; ++m) { float* rowp = C + (size_t)(row0 + ai * HALF + m * 16) * ldc + col0;
#pragma unroll
                for (int bj = 0; bj < 2; ++bj)
#pragma unroll
                    for (int n = 0; n < 2; ++n) *(f32x4*)(rowp + bj * HALF + n * 16) = acc[ai][bj][m][n]; }
    }
};
struct EpiRes {
    static constexpr bool PERM = false, AFTER_DRAIN = false;
    const float* res; float* out; int ldc; int row_off;
    __device__ __forceinline__ void operator()(const f32x4 (&acc)[2][2][4][2], const Unit& u, int wr, int wc, int fr, int fq) const {
        const int row0 = row_off + u.pm * BM + wr * 64 + fr, col0 = u.pn * BM + wc * 32 + 4 * fq;
#pragma unroll
        for (int ai = 0; ai < 2; ++ai)
#pragma unroll
            for (int m = 0; m < 4; ++m) { const size_t off = (size_t)(row0 + ai * HALF + m * 16) * ldc + col0;
                f32x4 r[2][2];
#pragma unroll
                for (int bj = 0; bj < 2; ++bj)
#pragma unroll
                    for (int n = 0; n < 2; ++n) r[bj][n] = *(const f32x4*)(res + off + bj * HALF + n * 16);
#pragma unroll
                for (int bj = 0; bj < 2; ++bj)
#pragma unroll
                    for (int n = 0; n < 2; ++n) *(f32x4*)(out + off + bj * HALF + n * 16) = r[bj][n] + acc[ai][bj][m][n];
                asm volatile("" ::: "memory"); }
    }
};
struct EpiDry {
    static constexpr bool PERM = false, AFTER_DRAIN = false;
    float* D;
    __device__ __forceinline__ void operator()(const f32x4 (&acc)[2][2][4][2], const Unit& u, int wr, int wc, int fr, int fq) const {
        float* p = D + ((size_t)blockIdx.x * 512 + threadIdx.x) * 64;
#pragma unroll
        for (int ai = 0; ai < 2; ++ai)
#pragma unroll
            for (int m = 0; m < 4; ++m)
#pragma unroll
                for (int bj = 0; bj < 2; ++bj) *(f32x4*)(p + ((ai * 4 + m) * 2 + bj) * 4) = acc[ai][bj][m][0] + acc[ai][bj][m][1];
    }
};
struct EpiConvGlu {
    static constexpr bool PERM = true, AFTER_DRAIN = false;
    bf16_t* G; float* UB; const float* cw; const float* cb; PG8_LAS float* xb; int dff;
    static __device__ __forceinline__ float shr(float old, float src, int n) { const int o = __builtin_bit_cast(int, old), s = __builtin_bit_cast(int, src);
        return __builtin_bit_cast(float, n == 1 ? __builtin_amdgcn_update_dpp(o, s, 0x111, 0xf, 0xf, false) : __builtin_amdgcn_update_dpp(o, s, 0x112, 0xf, 0xf, false)); }
    static __device__ __forceinline__ float ror(float src, int n) { const int s = __builtin_bit_cast(int, src);
        return __builtin_bit_cast(float, n == 1 ? __builtin_amdgcn_update_dpp(0, s, 0x121, 0xf, 0xf, false) : __builtin_amdgcn_update_dpp(0, s, 0x122, 0xf, 0xf, false)); }
    __device__ __forceinline__ void operator()(const f32x4 (&acc)[2][2][4][2], const Unit& u, int wr, int wc, int fr, int fq) const {
        typedef unsigned u32x2_ __attribute__((ext_vector_type(2)));
        if (fr >= 14) {
#pragma unroll
            for (int ai = 0; ai < 2; ++ai)
#pragma unroll
                for (int bj = 0; bj < 2; ++bj)
#pragma unroll
                    for (int n = 0; n < 2; ++n) *(PG8_LAS f32x4*)(xb + (((((ai * 2 + wr) * 4 + wc) * 2 + (fr - 14)) * 4 + fq) * 16) + (bj * 2 + n) * 4) = acc[ai][bj][3][n];
        }
        { const int ncol = 4 * dff / 2;
          const bool top = (wr == 0 && fr < 2), bot = (wr == 1 && fr >= 14);
          if (top || bot) { float* ub = UB + ((size_t)(u.pm * 4 + (top ? fr : 2 + fr - 14)) * ncol) + u.pn * BM + wc * 32 + 8 * fq;
#pragma unroll
            for (int bj = 0; bj < 2; ++bj)
#pragma unroll
                for (int n = 0; n < 2; ++n) *(f32x4*)(ub + bj * HALF + 4 * n) = top ? acc[0][bj][0][n] : acc[1][bj][3][n]; } }
        asm volatile("s_waitcnt lgkmcnt(0)" ::: "memory"); __builtin_amdgcn_s_barrier(); asm volatile("" ::: "memory");
        u32x2_ res[2][4][2];
        const int ch0 = u.pn * HALF + wc * 32 + 8 * fq;
#pragma unroll
        for (int n = 0; n < 2; ++n) {
            const float* wp = cw + ch0 + 4 * n; const float* bp = cb + ch0 + 4 * n;
            const f32x4 w0g = *(const f32x4*)(wp), w1g = *(const f32x4*)(wp + 2 * dff), w2g = *(const f32x4*)(wp + 4 * dff), bg = *(const f32x4*)(bp);
            const f32x4 w0v = *(const f32x4*)(wp + dff), w1v = *(const f32x4*)(wp + 3 * dff), w2v = *(const f32x4*)(wp + 5 * dff), bv = *(const f32x4*)(bp + dff);
#pragma unroll
            for (int ai = 0; ai < 2; ++ai)
#pragma unroll
                for (int m = 0; m < 4; ++m) {
                    const f32x4 cg = acc[ai][0][m][n], cv = acc[ai][1][m][n];
                    f32x4 b1g, b2g, b1v, b2v;
                    if (m > 0) {
#pragma unroll
                        for (int e = 0; e < 4; ++e) { b1g[e] = ror(acc[ai][0][m - 1][n][e], 1); b2g[e] = ror(acc[ai][0][m - 1][n][e], 2); b1v[e] = ror(acc[ai][1][m - 1][n][e], 1); b2v[e] = ror(acc[ai][1][m - 1][n][e], 2); }
                    } else {
                        const int sai = wr ? ai : ai - 1, swr = wr ? 0 : 1;
                        f32x4 x14g = {0.f, 0.f, 0.f, 0.f}, x15g = x14g, x14v = x14g, x15v = x14g;
                        if (sai >= 0) { const PG8_LAS float* xp = xb + (((((sai * 2 + swr) * 4 + wc) * 2) * 4 + fq) * 16);
                            x14g = *(const PG8_LAS f32x4*)(xp + n * 4); x14v = *(const PG8_LAS f32x4*)(xp + (2 + n) * 4); x15g = *(const PG8_LAS f32x4*)(xp + 64 + n * 4); x15v = *(const PG8_LAS f32x4*)(xp + 64 + (2 + n) * 4); }
                        b1g = x15g; b1v = x15v; b2g = fr == 0 ? x14g : x15g; b2v = fr == 0 ? x14v : x15v;
                    }
                    float o[4];
#pragma unroll
                    for (int e = 0; e < 4; ++e) {
                        const float p1g = shr(b1g[e], cg[e], 1), p2g = shr(b2g[e], cg[e], 2), p1v = shr(b1v[e], cv[e], 1), p2v = shr(b2v[e], cv[e], 2);
                        const float yg = bg[e] + w0g[e] * p2g + w1g[e] * p1g + w2g[e] * cg[e], yv = bv[e] + w0v[e] * p2v + w1v[e] * p1v + w2v[e] * cv[e];
                        o[e] = yg * __builtin_amdgcn_rcpf(1.0f + __builtin_amdgcn_exp2f(-yg * 1.4426950409f)) * yv;
                    }
                    res[ai][m][n] = (u32x2_){cvt_pk_bf16(o[0], o[1]), cvt_pk_bf16(o[2], o[3])};
                }
        }
        const int row0 = u.pm * BM + wr * 64 + fr;
#pragma unroll
        for (int ai = 0; ai < 2; ++ai)
#pragma unroll
            for (int m = 0; m < 4; ++m) *(u32x4*)(G + (size_t)(row0 + ai * HALF + m * 16) * dff + ch0) = (u32x4){res[ai][m][0].x, res[ai][m][0].y, res[ai][m][1].x, res[ai][m][1].y};
    }
};
}
constexpr int BATCH = 8, SEQ = 4096, DM = 2048, MTOT = BATCH * SEQ, MC = MTOT / 2  , BPH = BATCH / 2;
constexpr int DFF = 5632;
constexpr float NORM_EPS = 1e-6f, LOG2E = 1.4426950408889634f;
constexpr int NWAVES = 8;
constexpr size_t MiB = 1u << 20;
constexpr size_t WS_CTL = 0, CTL_ZERO_BYTES = 1 * MiB;
constexpr size_t WS_TAB = 1 * MiB;
constexpr size_t TAB_COS48 = WS_TAB, TAB_SIN48 = WS_TAB + 3 * MiB, TAB_COS32 = WS_TAB + 6 * MiB, TAB_SIN32 = WS_TAB + 8 * MiB;
constexpr size_t WS_WMIX = 12 * MiB;
constexpr size_t WS_WFFN = 100 * MiB;
constexpr size_t WS_MISC = 168 * MiB;
constexpr size_t WS_XN = 170 * MiB;
constexpr size_t WS_AR = 234 * MiB;
constexpr size_t WS_END = 1010 * MiB;
constexpr size_t DUMMY_OFF = 700 * MiB;
constexpr int CW_TMO = 0;
constexpr int CW_BAR = 4096;
constexpr int RING_BYTES = 131072;
constexpr int LDSCTL_OFF = 135168;
constexpr int LDS_BYTES = 163840;

#define GAS __attribute__((address_space(1)))
#define LAS __attribute__((address_space(3)))
typedef unsigned short bf16;
typedef unsigned u32x4 __attribute__((ext_vector_type(4)));
typedef unsigned u32x2 __attribute__((ext_vector_type(2)));
typedef float f32x4 __attribute__((ext_vector_type(4)));
typedef float f32x16 __attribute__((ext_vector_type(16)));
typedef short bf16x8 __attribute__((ext_vector_type(8)));
typedef short s16x4 __attribute__((ext_vector_type(4)));
typedef short v4i16_t __attribute__((ext_vector_type(4)));
typedef __bf16 bf16x2_t __attribute__((ext_vector_type(2)));
typedef float f32x2_t __attribute__((ext_vector_type(2)));
#define LDS_WAIT() asm volatile("s_waitcnt lgkmcnt(0)" ::: "memory")
#define VM_WAIT() asm volatile("s_waitcnt vmcnt(0)" ::: "memory")
#define MFMA32(a, b, c) __builtin_amdgcn_mfma_f32_32x32x16_bf16((a), (b), (c), 0, 0, 0)
DI unsigned pk2(float lo, float hi) { f32x2_t v = {lo, hi}; bf16x2_t b = __builtin_convertvector(v, bf16x2_t); return __builtin_bit_cast(unsigned, b); }
DI float bf2f(unsigned short b) { return __builtin_bit_cast(float, (unsigned)b << 16); }
DI float bflo(unsigned w) { return __builtin_bit_cast(float, w << 16); }
DI float bfhi(unsigned w) { return __builtin_bit_cast(float, w & 0xffff0000u); }
DI unsigned short f2bf(float f) { return (unsigned short)(pk2(f, 0.f) & 0xffffu); }
DI float wave_sum(float v) {
#pragma unroll
    for (int o = 1; o < 64; o <<= 1) v += __shfl_xor(v, o);
    return v;
}
DI int crow(int i, int h) { return (i & 3) + 8 * (i >> 2) + 4 * h; }
#define XB_TMO      128
#define XB_XCNT(j)  (256  + 64 * (j))
#define XB_XSUB(j)  (1280 + 64 * (j))
#define XB_XGEN(j)  (2304 + 64 * (j))
#define XB_TOP      3328
#define XB_TOPGEN   3392
#define XCD_BAR_WORDS 3456
#define XB_SPIN_CAP (1u << 18)

__device__ __forceinline__ unsigned xb_ld(unsigned* p)              { return __hip_atomic_load(p, __ATOMIC_RELAXED, __HIP_MEMORY_SCOPE_AGENT); }
__device__ __forceinline__ unsigned xb_add(unsigned* p, unsigned v) { return __hip_atomic_fetch_add(p, v, __ATOMIC_RELAXED, __HIP_MEMORY_SCOPE_AGENT); }
__device__ __forceinline__ unsigned xb_xcc_id() { return (unsigned)__builtin_amdgcn_s_getreg((3 << 11) | 20) & 0xFu; }
#define XB_SPIN(cond, bar) do { unsigned _sp = 0; while (cond) { __builtin_amdgcn_s_sleep(1); \
    if ((++_sp & 255u) == 0u) { if (xb_ld(&(bar)[XB_TMO])) break; if (_sp > XB_SPIN_CAP) { atomicAdd(&(bar)[XB_TMO], 1u); break; } } } } while (0)

struct XcdBarrier {
    unsigned* bar; unsigned x;
    volatile LAS unsigned* st;
};

__device__ __forceinline__ XcdBarrier xcd_barrier_post(unsigned* bar, volatile LAS unsigned* st) {
    XcdBarrier b; b.bar = bar; b.x = xb_xcc_id(); b.st = st;
    if (threadIdx.x == 0) (void)xb_add(&bar[XB_XCNT(b.x)], 1u);
    return b;
}
__device__ __forceinline__ void xcd_barrier_complete(unsigned* bar, unsigned x, unsigned& nloc, unsigned& nx) {
    const unsigned G = gridDim.x * gridDim.y * gridDim.z;
    unsigned sum, cnt, mine, sp = 0u;
    for (;;) {
        sum = 0u; cnt = 0u; mine = 0u;
#pragma unroll
        for (unsigned j = 0; j < 16; ++j) { const unsigned c = xb_ld(&bar[XB_XCNT(j)]); sum += c; cnt += (c > 0u) ? 1u : 0u; mine = (j == x) ? c : mine; }
        if (sum == G) break;
        __builtin_amdgcn_s_sleep(1);
        if ((++sp & 255u) == 0u) { if (xb_ld(&bar[XB_TMO])) break; if (sp > XB_SPIN_CAP) { atomicAdd(&bar[XB_TMO], 1u); break; } }
    }
    nloc = mine > 0u ? mine : 1u; nx = cnt > 0u ? cnt : 1u;
}

__device__ __forceinline__ void xcd_barrier(const XcdBarrier& b) {
    asm volatile("s_waitcnt vmcnt(0)" ::: "memory");
    __syncthreads();
    if (threadIdx.x == 0) {
        unsigned* bar = b.bar;
        __builtin_amdgcn_s_waitcnt(0);
        unsigned nloc = b.st[0], nx = b.st[1];
        if (nloc == 0u) { xcd_barrier_complete(bar, b.x, nloc, nx); b.st[0] = nloc; b.st[1] = nx; }
        const unsigned old = xb_add(&bar[XB_XSUB(b.x)], 1u);
        const unsigned gen = old / nloc;
        if (old + 1u == (gen + 1u) * nloc) {
            __builtin_amdgcn_fence(__ATOMIC_RELEASE, "agent");
            asm volatile("s_waitcnt vmcnt(0)" ::: "memory");
            const unsigned og = xb_add(&bar[XB_TOP], 1u);
            const unsigned tg = og / nx;
            if (og + 1u == (tg + 1u) * nx) xb_add(&bar[XB_TOPGEN], 1u);
            else XB_SPIN(xb_ld(&bar[XB_TOPGEN]) == tg, bar);
            __builtin_amdgcn_fence(__ATOMIC_ACQUIRE, "agent");
            xb_add(&bar[XB_XGEN(b.x)], 1u);
            asm volatile("s_waitcnt vmcnt(0)" ::: "memory");
        } else {
            XB_SPIN(xb_ld(&bar[XB_XGEN(b.x)]) == gen, bar);
            __builtin_amdgcn_fence(__ATOMIC_ACQUIRE, "agent");
            asm volatile("s_waitcnt vmcnt(0)" ::: "memory");
        }
    }
    __syncthreads();
}
struct Frame {
    LAS unsigned char* lds; unsigned* ctl; unsigned char* ws;
    int tid, lane, wave, G, gw, NGW;
};
DI void ph_tables(const Frame& F, const int* pos) {
    float* c48 = (float*)(F.ws + TAB_COS48); float* s48 = (float*)(F.ws + TAB_SIN48); float* c32 = (float*)(F.ws + TAB_COS32); float* s32 = (float*)(F.ws + TAB_SIN32);
    const int gt = blockIdx.x * (NWAVES * 64) + F.tid, NT = F.G * NWAVES * 64;
    for (int i = gt; i < MTOT * 40; i += NT) {
        const int m = i / 40, j = i - m * 40; const float p = (float)pos[m];
        const bool a = j < 24; const int jj = a ? j : j - 24;
        const float inv = (float)exp(-(2.0 * jj / (a ? 48.0 : 32.0)) * 13.122363377404328);
        const float ang = p * inv; float sn, cs; sincosf(ang, &sn, &cs);
        if (a) { c48[m * 24 + jj] = cs; s48[m * 24 + jj] = sn; } else { c32[m * 16 + jj] = cs; s32[m * 16 + jj] = sn; }
    }
}
DI void cvt_load(float (&v)[32], const float* W, int ldw, int col0, int ncols, int item, int nblk, int lane) {
    const int kb = item / nblk, nb = item - kb * nblk, k0 = 64 * kb, n0 = 32 * nb, nn = n0 + (lane & 31); const bool ok = nn < ncols;
    const float* p = W + (size_t)(k0 + (lane >> 5)) * ldw + col0 + (ok ? nn : 0);
#pragma unroll
    for (int i = 0; i < 32; ++i) { const float x = p[(size_t)(2 * i) * ldw]; v[i] = ok ? x : 0.f; }
}
DI void cvt_store(const float (&v)[32], int ncols, bf16* WT, int ldt, int row_off, float scale, LAS float* scr, int item, int nblk, int lane) {
    const int kb = item / nblk, nb = item - kb * nblk, k0 = 64 * kb, n0 = 32 * nb;
#pragma unroll
    for (int i = 0; i < 32; ++i) scr[(2 * i + (lane >> 5)) * 33 + (lane & 31)] = v[i] * scale;
    LDS_WAIT();
    const int c = lane & 7;
#pragma unroll
    for (int j = 0; j < 4; ++j) { const int n = (lane >> 3) + 8 * j; const LAS float* s = scr + (8 * c) * 33 + n;
        u32x4 o; o.x = pk2(s[0 * 33], s[1 * 33]); o.y = pk2(s[2 * 33], s[3 * 33]); o.z = pk2(s[4 * 33], s[5 * 33]); o.w = pk2(s[6 * 33], s[7 * 33]);
        if (n0 + n < ncols) *(u32x4*)(WT + (size_t)(row_off + n0 + n) * ldt + k0 + 8 * c) = o; }
    LDS_WAIT();
}
DI void cvt_item(const float* W, int ldw, int col0, int ncols, bf16* WT, int ldt, int row_off, float scale, LAS float* scr, int item, int nblk, int lane) {
    float v[32]; cvt_load(v, W, ldw, col0, ncols, item, nblk, lane); cvt_store(v, ncols, WT, ldt, row_off, scale, scr, item, nblk, lane);
}
template <class MAP> DI void cvt_loop(const Frame& F, const float* W, int ldw, int ncols, bf16* WT, int ldt, float scale, int nitems, int nblk, const MAP& map) {
    LAS float* scr = (LAS float*)(F.lds + F.wave * 16384);
    int it = F.gw; float cur[32]; int c0 = 0, ro = 0, li = 0;
    if (it < nitems) { map(it, c0, ro, li); cvt_load(cur, W, ldw, c0, ncols, li, nblk, F.lane); }
#pragma unroll 1
    for (; it < nitems; it += F.NGW) {
        float nxt[32]; int c1 = 0, r1 = 0, l1 = 0; const int ni = it + F.NGW;
        if (ni < nitems) { map(ni, c1, r1, l1); cvt_load(nxt, W, ldw, c1, ncols, l1, nblk, F.lane); }
        cvt_store(cur, ncols, WT, ldt, ro, scale, scr, li, nblk, F.lane);
#pragma unroll
        for (int i = 0; i < 32; ++i) cur[i] = nxt[i];
        c0 = c1; ro = r1; li = l1;
    }
}
struct CvtPlain { int col0, row_off; DI void operator()(int it, int& c, int& r, int& l) const { c = col0; r = row_off; l = it; } };
DI void cvt_job(const Frame& F, const float* W, int ldw, int K, int col0, int ncols, bf16* WT, int ldt, int row_off, float scale) {
    const int nblk = (ncols + 31) / 32;
    cvt_loop(F, W, ldw, ncols, WT, ldt, scale, (K / 64) * nblk, nblk, CvtPlain{col0, row_off});
}
DI void zero_bf16(const Frame& F, bf16* p, size_t nelem) {
    const size_t gt = (size_t)blockIdx.x * (NWAVES * 64) + F.tid, NT = (size_t)F.G * NWAVES * 64;
    for (size_t i = gt; i < nelem / 8; i += NT) ((u32x4*)p)[i] = (u32x4){0u, 0u, 0u, 0u};
}
DI void ph_cvt_ffn(const Frame& F, const float* up, const float* down) {
    bf16* WUP = (bf16*)(F.ws + WS_WFFN); bf16* WDN = WUP + (size_t)2 * DFF * DM;
    struct UpMap { DI void operator()(int it, int& c, int& r, int& l) const { const int seg = it >> 7, pn = seg >> 1, isv = seg & 1; c = isv * DFF + pn * 128; r = pn * 256 + isv * 128; l = it & 127; } };
    cvt_loop(F, up, 2 * DFF, 128, WUP, DM, 1.f, 88 * 128, 4, UpMap{});
    cvt_job(F, down, DM, DFF, 0, DM, WDN, DFF, 0, 1.f);
}
DI void ph_conv_fix(const Frame& F, const float* UB, bf16* Gb, const float* cw, const float* cb, const int nrows = MC) {
    const int gt = blockIdx.x * (NWAVES * 64) + F.tid, NT = F.G * NWAVES * 64;
    for (int it = gt; it < (nrows / 256) * (DFF / 4); it += NT) {
        const int pm = it / (DFF / 4), c4 = it - pm * (DFF / 4), ch = c4 * 4, col = (ch >> 7) * 256 + (ch & 127);
        const float* ub = UB + (size_t)pm * 4 * (2 * DFF) + col; const bool has = (pm & 15) != 0;
        const f32x4 z = {0.f, 0.f, 0.f, 0.f};
        const f32x4 g0 = *(const f32x4*)(ub), g1 = *(const f32x4*)(ub + 2 * DFF), v0 = *(const f32x4*)(ub + 128), v1 = *(const f32x4*)(ub + 2 * DFF + 128);
        const f32x4 gm2 = has ? *(const f32x4*)(ub - 2 * (2 * DFF)) : z, gm1 = has ? *(const f32x4*)(ub - (2 * DFF)) : z, vm2 = has ? *(const f32x4*)(ub - 2 * (2 * DFF) + 128) : z, vm1 = has ? *(const f32x4*)(ub - (2 * DFF) + 128) : z;
        const f32x4 w0g = *(const f32x4*)(cw + ch), w1g = *(const f32x4*)(cw + 2 * DFF + ch), w2g = *(const f32x4*)(cw + 4 * DFF + ch), bg = *(const f32x4*)(cb + ch);
        const f32x4 w0v = *(const f32x4*)(cw + DFF + ch), w1v = *(const f32x4*)(cw + 3 * DFF + ch), w2v = *(const f32x4*)(cw + 5 * DFF + ch), bv = *(const f32x4*)(cb + DFF + ch);
        float o0[4], o1[4];
#pragma unroll
        for (int e = 0; e < 4; ++e) {
            const float yg0 = bg[e] + w0g[e] * gm2[e] + w1g[e] * gm1[e] + w2g[e] * g0[e], yv0 = bv[e] + w0v[e] * vm2[e] + w1v[e] * vm1[e] + w2v[e] * v0[e];
            const float yg1 = bg[e] + w0g[e] * gm1[e] + w1g[e] * g0[e] + w2g[e] * g1[e], yv1 = bv[e] + w0v[e] * vm1[e] + w1v[e] * v0[e] + w2v[e] * v1[e];
            o0[e] = yg0 * __builtin_amdgcn_rcpf(1.0f + __builtin_amdgcn_exp2f(-yg0 * LOG2E)) * yv0; o1[e] = yg1 * __builtin_amdgcn_rcpf(1.0f + __builtin_amdgcn_exp2f(-yg1 * LOG2E)) * yv1;
        }
        u32x2 a, b; a.x = pk2(o0[0], o0[1]); a.y = pk2(o0[2], o0[3]); b.x = pk2(o1[0], o1[1]); b.y = pk2(o1[2], o1[3]);
        *(u32x2*)(Gb + (size_t)(pm * 256) * DFF + ch) = a; *(u32x2*)(Gb + (size_t)(pm * 256 + 1) * DFF + ch) = b;
    }
}
DI void ph_rmsnorm(const Frame& F, const float* src, int row_off, const float* gain, bf16* XN, const int nrows = MC) {
    f32x4 g[8];
#pragma unroll
    for (int j = 0; j < 8; ++j) g[j] = *(const f32x4*)(gain + 4 * (F.lane + 64 * j));
    for (int ml = F.gw; ml < nrows; ml += F.NGW) {
        const f32x4* xr = (const f32x4*)(src + (size_t)(row_off + ml) * DM) + F.lane;
        f32x4 v[8]; float ss = 0.f;
#pragma unroll
        for (int j = 0; j < 8; ++j) { v[j] = xr[64 * j]; ss += (v[j].x * v[j].x + v[j].y * v[j].y) + (v[j].z * v[j].z + v[j].w * v[j].w); }
        const float rstd = 1.0f / sqrtf(wave_sum(ss) * (1.f / DM) + NORM_EPS);
        u32x2* o = (u32x2*)(XN + (size_t)ml * DM) + F.lane;
#pragma unroll
        for (int j = 0; j < 8; ++j) { const f32x4 y = v[j] * rstd * g[j]; u32x2 w; w.x = pk2(y.x, y.y); w.y = pk2(y.z, y.w); o[64 * j] = w; }
    }
}
DI void ph_final_norm(const Frame& F, float* h, const float* gain) {
    f32x4 g[8];
#pragma unroll
    for (int j = 0; j < 8; ++j) g[j] = *(const f32x4*)(gain + 4 * (F.lane + 64 * j));
    for (int m = F.gw; m < MTOT; m += F.NGW) {
        f32x4* xr = (f32x4*)(h + (size_t)m * DM) + F.lane;
        f32x4 v[8]; float ss = 0.f;
#pragma unroll
        for (int j = 0; j < 8; ++j) { v[j] = xr[64 * j]; ss += (v[j].x * v[j].x + v[j].y * v[j].y) + (v[j].z * v[j].z + v[j].w * v[j].w); }
        const float rstd = 1.0f / sqrtf(wave_sum(ss) * (1.f / DM) + NORM_EPS);
#pragma unroll
        for (int j = 0; j < 8; ++j) xr[64 * j] = v[j] * rstd * g[j];
    }
}
DI void ph_conv_glu(const Frame& F, const bf16* U, bf16* Gb, const float* cw, const float* cb) {
    constexpr int RC = 32, NCG = DFF / 8, NRC = MC / RC;
    const int gt = blockIdx.x * (NWAVES * 64) + F.tid, NT = F.G * NWAVES * 64;
    for (int it = gt; it < NCG * NRC; it += NT) {
        const int cg = it % NCG, rc = it / NCG, c0 = cg * 8, r0 = rc * RC;
        float w0g[8], w1g[8], w2g[8], bg[8], w0v[8], w1v[8], w2v[8], bv[8];
#pragma unroll
        for (int e = 0; e < 8; ++e) { w0g[e] = cw[c0 + e]; w1g[e] = cw[2 * DFF + c0 + e]; w2g[e] = cw[4 * DFF + c0 + e]; bg[e] = cb[c0 + e];
            w0v[e] = cw[DFF + c0 + e]; w1v[e] = cw[3 * DFF + c0 + e]; w2v[e] = cw[5 * DFF + c0 + e]; bv[e] = cb[DFF + c0 + e]; }
        float pg2[8], pg1[8], pv2[8], pv1[8];
        const bool has = (r0 & (SEQ - 1)) != 0;
        {
            u32x4 a = {0u, 0u, 0u, 0u}, b = a, c = a, d = a;
            if (has) { a = *(const u32x4*)(U + (size_t)(r0 - 2) * (2 * DFF) + c0); b = *(const u32x4*)(U + (size_t)(r0 - 1) * (2 * DFF) + c0);
                       c = *(const u32x4*)(U + (size_t)(r0 - 2) * (2 * DFF) + DFF + c0); d = *(const u32x4*)(U + (size_t)(r0 - 1) * (2 * DFF) + DFF + c0); }
#pragma unroll
            for (int e = 0; e < 4; ++e) { pg2[2 * e] = bflo(a[e]); pg2[2 * e + 1] = bfhi(a[e]); pg1[2 * e] = bflo(b[e]); pg1[2 * e + 1] = bfhi(b[e]);
                pv2[2 * e] = bflo(c[e]); pv2[2 * e + 1] = bfhi(c[e]); pv1[2 * e] = bflo(d[e]); pv1[2 * e + 1] = bfhi(d[e]); }
        }
        for (int r = 0; r < RC; ++r) {
            const u32x4 ug = *(const u32x4*)(U + (size_t)(r0 + r) * (2 * DFF) + c0), uv = *(const u32x4*)(U + (size_t)(r0 + r) * (2 * DFF) + DFF + c0);
            float cg_[8], cv_[8], o[8];
#pragma unroll
            for (int e = 0; e < 4; ++e) { cg_[2 * e] = bflo(ug[e]); cg_[2 * e + 1] = bfhi(ug[e]); cv_[2 * e] = bflo(uv[e]); cv_[2 * e + 1] = bfhi(uv[e]); }
#pragma unroll
            for (int e = 0; e < 8; ++e) {
                const float yg = bg[e] + w0g[e] * pg2[e] + w1g[e] * pg1[e] + w2g[e] * cg_[e];
                const float yv = bv[e] + w0v[e] * pv2[e] + w1v[e] * pv1[e] + w2v[e] * cv_[e];
                const float sg = yg * __builtin_amdgcn_rcpf(1.0f + __builtin_amdgcn_exp2f(-yg * LOG2E));
                o[e] = sg * yv; pg2[e] = pg1[e]; pg1[e] = cg_[e]; pv2[e] = pv1[e]; pv1[e] = cv_[e];
            }
            u32x4 w; w.x = pk2(o[0], o[1]); w.y = pk2(o[2], o[3]); w.z = pk2(o[4], o[5]); w.w = pk2(o[6], o[7]);
            *(u32x4*)(Gb + (size_t)(r0 + r) * DFF + c0) = w;
        }
    }
}
constexpr size_t DA_DIN = 0, DA_CQN = 64 * MiB, DA_LATC = 80 * MiB, DA_KPE = 88 * MiB, DA_KIDX = 90 * MiB, DA_WIDX = 94 * MiB, DA_QL = 96 * MiB, DA_QPE = 352 * MiB, DA_QIDX = 400 * MiB,
                 DA_SEL = 464 * MiB, DA_CNT = 472 * MiB, DA_SC = 474 * MiB, DA_O2 = 474 * MiB;
constexpr size_t DW_W1 = 0, DW_W2 = (size_t)1024 * 2048, DW_WO = DW_W2 + (size_t)11776 * 512, DW_BD = DW_WO + (size_t)2048 * 4096;
constexpr float DSA_QSCALE = 0.07216878364870322f * LOG2E;
constexpr float DSA_WIDX_SCALE = 0.25f * 0.08838834764831845f;

DI void ph_dsa_cvt(const Frame& F, const float* w_in, const float* w_qup, const float* w_uk, const float* w_uv, const float* w_out) {
    bf16* WB = (bf16*)(F.ws + WS_WMIX);
    cvt_job(F, w_in, 960, DM, 0, 960, WB + DW_W1, DM, 0, 1.f);
    zero_bf16(F, WB + DW_W1 + (size_t)960 * DM, (size_t)64 * DM);
    { LAS float* scr = (LAS float*)(F.lds + F.wave * 16384);
      for (int it = F.gw; it < 32 * 16; it += F.NGW) { const int h = it >> 4; cvt_item(w_qup, 8192, h * 192, 48, WB + DW_W2, 512, 8192 + h * 48, DSA_QSCALE, scr, it & 15, 2, F.lane); } }
    cvt_job(F, w_qup, 8192, 512, 6144, 2048, WB + DW_W2, 512, 9728, 1.f);
    __syncthreads();
    {
        LAS float* As = (LAS float*)F.lds; LAS float* Bs = As + 64 * 145;
        for (int u = blockIdx.x; u < 32 * 4 * 8; u += F.G) {
            const int h = u >> 5, r0 = ((u >> 3) & 3) * 64, k0 = (u & 7) * 64;
            for (int i = F.tid; i < 64 * 144; i += NWAVES * 64) { const int row = i / 144, col = i - row * 144;
                As[row * 145 + col] = w_uk[(size_t)(h * 256 + r0) * 144 + i]; Bs[row * 145 + col] = w_qup[(size_t)(k0 + row) * 8192 + h * 192 + 48 + col]; }
            __syncthreads();
            const int r = F.tid & 63, kg = F.tid >> 6; float acc[8];
#pragma unroll
            for (int j = 0; j < 8; ++j) acc[j] = 0.f;
            for (int n = 0; n < 144; ++n) { const float a = As[r * 145 + n];
#pragma unroll
                for (int j = 0; j < 8; ++j) acc[j] += a * Bs[(kg * 8 + j) * 145 + n]; }
            u32x4 o; o.x = pk2(acc[0] * DSA_QSCALE, acc[1] * DSA_QSCALE); o.y = pk2(acc[2] * DSA_QSCALE, acc[3] * DSA_QSCALE); o.z = pk2(acc[4] * DSA_QSCALE, acc[5] * DSA_QSCALE); o.w = pk2(acc[6] * DSA_QSCALE, acc[7] * DSA_QSCALE);
            *(u32x4*)(WB + DW_W2 + (size_t)(h * 256 + r0 + r) * 512 + k0 + kg * 8) = o;
            __syncthreads();
        }
    }
    { LAS float* scr = (LAS float*)(F.lds + F.wave * 16384);
      for (int it = F.gw; it < 32 * 16; it += F.NGW) { const int h = it >> 4; cvt_item(w_uv + (size_t)h * 256 * 128, 128, 0, 128, WB + DW_BD + (h & 1) * 256, 512, h * 128, 1.f, scr, it & 15, 4, F.lane); } }
    { const size_t gt = (size_t)blockIdx.x * (NWAVES * 64) + F.tid, NT = (size_t)F.G * NWAVES * 64;
      for (size_t i = gt; i < (size_t)4096 * 32; i += NT) { const int row = (int)(i >> 5), pc = (int)(i & 31); *(u32x4*)(WB + DW_BD + (size_t)row * 512 + (1 - ((row >> 7) & 1)) * 256 + pc * 8) = (u32x4){0u, 0u, 0u, 0u}; } }
    cvt_job(F, w_out, DM, 4096, 0, DM, WB + DW_WO, 4096, 0, 1.f);
}
DI void ph_dsa_post1(const Frame& F, int half, const float* qn, const float* kvn, const float* lng, const float* lnb) {
    unsigned char* ar = F.ws + WS_AR;
    const float* DIN = (const float*)(ar + DA_DIN); bf16* CQN = (bf16*)(ar + DA_CQN); bf16* LATC = (bf16*)(ar + DA_LATC); bf16* KPE = (bf16*)(ar + DA_KPE); bf16* KIDX = (bf16*)(ar + DA_KIDX); float* WIDX = (float*)(ar + DA_WIDX);
    const float* c48 = (const float*)(F.ws + TAB_COS48); const float* s48 = (const float*)(F.ws + TAB_SIN48); const float* c32 = (const float*)(F.ws + TAB_COS32); const float* s32 = (const float*)(F.ws + TAB_SIN32);
    LAS float* buf = (LAS float*)(F.lds + F.wave * 1024);
    const int lane = F.lane;
    for (int ml = F.gw; ml < MC; ml += F.NGW) {
        const int mg = half * MC + ml;
        const size_t kfb = ((size_t)(ml >> 5) * 8 * 64 + (ml & 31)) * 8;
        const float* row = DIN + (size_t)ml * 1024 + 16 * lane;
        f32x4 v[4]; float ss = 0.f, s1 = 0.f;
#pragma unroll
        for (int j = 0; j < 4; ++j) { v[j] = *(const f32x4*)(row + 4 * j); ss += (v[j].x * v[j].x + v[j].y * v[j].y) + (v[j].z * v[j].z + v[j].w * v[j].w); s1 += (v[j].x + v[j].y) + (v[j].z + v[j].w); }
        const bool isq = lane < 32, iskv = lane >= 32 && lane < 48, ispe = lane >= 48 && lane < 51, isix = lane >= 51 && lane < 59;
        const float ssq = wave_sum(isq ? ss : 0.f), sskv = wave_sum(iskv ? ss : 0.f), mean = wave_sum(isix ? s1 : 0.f) * (1.f / 128.f);
        float d2 = 0.f;
#pragma unroll
        for (int j = 0; j < 4; ++j) { const f32x4 d = v[j] - mean; d2 += (d.x * d.x + d.y * d.y) + (d.z * d.z + d.w * d.w); }
        const float var = wave_sum(isix ? d2 : 0.f) * (1.f / 128.f);
        const float rq = 1.0f / sqrtf(ssq * (1.f / 512.f) + NORM_EPS), rkv = 1.0f / sqrtf(sskv * (1.f / 256.f) + NORM_EPS), rstd = 1.0f / sqrtf(var + NORM_EPS);
        if (isq || iskv) {
            const float* gp = isq ? qn + 16 * lane : kvn + 16 * (lane - 32); const float rs = isq ? rq : rkv;
            bf16* dst = isq ? CQN + (size_t)ml * 512 + 16 * lane : LATC + (size_t)ml * 256 + 16 * (lane - 32);
            u32x4 o[2];
#pragma unroll
            for (int j = 0; j < 4; ++j) { const f32x4 g = *(const f32x4*)(gp + 4 * j); const f32x4 y = v[j] * rs * g; o[j >> 1][(j & 1) * 2] = pk2(y.x, y.y); o[j >> 1][(j & 1) * 2 + 1] = pk2(y.z, y.w); }
            *(u32x4*)dst = o[0]; *(u32x4*)(dst + 8) = o[1];
        } else if (ispe) {
#pragma unroll
            for (int j = 0; j < 4; ++j) *(LAS f32x4*)(buf + (lane - 48) * 16 + 4 * j) = v[j];
        } else if (isix) {
#pragma unroll
            for (int j = 0; j < 4; ++j) { const f32x4 g = *(const f32x4*)(lng + (lane - 51) * 16 + 4 * j), b = *(const f32x4*)(lnb + (lane - 51) * 16 + 4 * j); *(LAS f32x4*)(buf + 48 + (lane - 51) * 16 + 4 * j) = (v[j] - mean) * rstd * g + b; }
        } else if (lane == 59) {
#pragma unroll
            for (int j = 0; j < 4; ++j) *(f32x4*)(WIDX + (size_t)ml * 16 + 4 * j) = v[j] * DSA_WIDX_SCALE;
        }
        LDS_WAIT();
        if (lane < 24) { const float x1 = buf[lane], x2 = buf[24 + lane], c = c48[(size_t)mg * 24 + lane], s = s48[(size_t)mg * 24 + lane];
            KPE[(size_t)ml * 48 + lane] = f2bf(x1 * c - x2 * s); KPE[(size_t)ml * 48 + 24 + lane] = f2bf(x1 * s + x2 * c);
        } else if (lane < 40) { const int i = lane - 24; const float x1 = buf[48 + i], x2 = buf[48 + 16 + i], c = c32[(size_t)mg * 16 + i], s = s32[(size_t)mg * 16 + i];
            KIDX[kfb + (size_t)((i >> 3) * 32) * 8 + (i & 7)] = f2bf(x1 * c - x2 * s); KIDX[kfb + (size_t)(64 + (i >> 3) * 32) * 8 + (i & 7)] = f2bf(x1 * s + x2 * c);
        } else { const int d = 32 + 4 * (lane - 40); const f32x4 y = *(const LAS f32x4*)(buf + 48 + d); u32x2 w; w.x = pk2(y.x, y.y); w.y = pk2(y.z, y.w); *(u32x2*)(KIDX + kfb + (size_t)((d >> 4) * 64 + ((d >> 3) & 1) * 32) * 8 + (d & 7)) = w; }
        LDS_WAIT();
    }
}
DI void ph_dsa_rope(const Frame& F, int half) {
    unsigned char* ar = F.ws + WS_AR; bf16* QPE = (bf16*)(ar + DA_QPE); bf16* QIDX = (bf16*)(ar + DA_QIDX);
    const float* c48 = (const float*)(F.ws + TAB_COS48); const float* s48 = (const float*)(F.ws + TAB_SIN48); const float* c32 = (const float*)(F.ws + TAB_COS32); const float* s32 = (const float*)(F.ws + TAB_SIN32);
    for (int ml = F.gw; ml < MC; ml += F.NGW) {
        const size_t mg = (size_t)half * MC + ml;
        for (int p = F.lane; p < 768; p += 64) { const int hd = p / 24, i = p - hd * 24; bf16* q = QPE + (size_t)ml * 1536 + hd * 48 + i;
            const float x1 = bf2f(q[0]), x2 = bf2f(q[24]), c = c48[mg * 24 + i], s = s48[mg * 24 + i]; q[0] = f2bf(x1 * c - x2 * s); q[24] = f2bf(x1 * s + x2 * c); }
        for (int p = F.lane; p < 256; p += 64) { const int hd = p >> 4, i = p & 15; bf16* q = QIDX + (size_t)ml * 2048 + hd * 128 + i;
            const float x1 = bf2f(q[0]), x2 = bf2f(q[16]), c = c32[mg * 16 + i], s = s32[mg * 16 + i]; q[0] = f2bf(x1 * c - x2 * s); q[16] = f2bf(x1 * s + x2 * c); }
    }
}
DI int wave_iscan_dpp(int v) {
    v += __builtin_amdgcn_update_dpp(0, v, 0x111, 0xf, 0xf, true); v += __builtin_amdgcn_update_dpp(0, v, 0x112, 0xf, 0xf, true);
    v += __builtin_amdgcn_update_dpp(0, v, 0x114, 0xf, 0xf, true); v += __builtin_amdgcn_update_dpp(0, v, 0x118, 0xf, 0xf, true);
    v += __builtin_amdgcn_update_dpp(0, v, 0x142, 0xa, 0xf, false);
    v += __builtin_amdgcn_update_dpp(0, v, 0x143, 0xc, 0xf, false);
    return v;
}
DI int wave_isum_dpp(int v) {
    v += __builtin_amdgcn_update_dpp(0, v, 0x111, 0xf, 0xf, true); v += __builtin_amdgcn_update_dpp(0, v, 0x112, 0xf, 0xf, true);
    v += __builtin_amdgcn_update_dpp(0, v, 0x114, 0xf, 0xf, true); v += __builtin_amdgcn_update_dpp(0, v, 0x118, 0xf, 0xf, true);
    v += __builtin_amdgcn_update_dpp(0, v, 0x142, 0xa, 0xf, false);
    v += __builtin_amdgcn_update_dpp(0, v, 0x143, 0xc, 0xf, false);
    return __builtin_amdgcn_readlane(v, 63);
}
DI unsigned f2sortable(float s) { const unsigned b = __builtin_bit_cast(unsigned, s); return (b & 0x80000000u) ? ~b : (b | 0x80000000u); }
DI void ph_dsa_index(const Frame& F, const int dry = 0, const int parts = 3) {
    unsigned char* ar = F.ws + WS_AR;
    const bf16* QIDX = (const bf16*)(ar + DA_QIDX); const bf16* KIDX = (const bf16*)(ar + DA_KIDX); const float* WIDX = (const float*)(ar + DA_WIDX);
    unsigned short* SEL = (unsigned short*)(ar + DA_SEL); int* CNT = (int*)(ar + DA_CNT); float* SC = (float*)(ar + DA_SC) + (size_t)F.gw * 16384;
    const int lane = F.lane, r = lane & 31, hf = lane >> 5;
    LAS unsigned char* wl = F.lds + F.wave * 8192 + lane * 16;
    LAS unsigned* hist = (LAS unsigned*)(F.lds + 65536 + F.wave * 1024);
#pragma unroll 1
    for (int tile = blockIdx.x; tile < BPH * 128; tile += F.G) {
        const int j = tile >> 8, c8 = tile & 255, c7 = c8 & 127, bl = (c8 >> 7) * 2 + j, qt = j ? 127 - c7 : c7;
        const int q0 = qt * 32 + 4 * F.wave;
        const int ntile = (q0 + 3) / 32 + 1;
        bf16x8 qa[2][8];
#pragma unroll
        for (int pr = 0; pr < 2; ++pr) {
            const int mrow = bl * SEQ + q0 + 2 * pr + (r >> 4);
#pragma unroll
            for (int s = 0; s < 8; ++s) qa[pr][s] = *(const bf16x8*)(QIDX + (size_t)mrow * 2048 + (r & 15) * 128 + 16 * s + 8 * hf);
            float wv[2][16];
#pragma unroll
            for (int i = 0; i < 16; ++i) wv[pr][i] = WIDX[(size_t)(bl * SEQ + q0 + 2 * pr + (i >> 3)) * 16 + (i & 3) + 8 * ((i >> 2) & 1) + 4 * hf];
#pragma unroll
            for (int i = 0; i < 16; i += 4) *(LAS f32x4*)(wl + (pr * 4 + (i >> 2)) * 1024) = (f32x4){wv[pr][i], wv[pr][i + 1], wv[pr][i + 2], wv[pr][i + 3]};
        }
        LDS_WAIT();
        if (parts & 1) {
        bf16x8 kf[8];
        { const bf16* kp = KIDX + ((size_t)(bl * 128) * 8 * 64 + lane) * 8;
#pragma unroll
          for (int s = 0; s < 8; ++s) kf[s] = *(const bf16x8*)(kp + 512 * s); }
#pragma unroll 1
        for (int t = 0; t < ntile; ++t) {
            f32x16 accs[2];
#pragma unroll
            for (int pr = 0; pr < 2; ++pr) {
#pragma unroll
                for (int i = 0; i < 16; ++i) accs[pr][i] = 0.f;
#pragma unroll
                for (int s = 0; s < 8; ++s) accs[pr] = MFMA32(qa[pr][s], kf[s], accs[pr]);
            }
            if (t + 1 < ntile) { const bf16* kp = KIDX + ((size_t)(bl * 128 + t + 1) * 8 * 64 + lane) * 8;
#pragma unroll
                for (int s = 0; s < 8; ++s) kf[s] = *(const bf16x8*)(kp + 512 * s); }
#pragma unroll
            for (int pr = 0; pr < 2; ++pr) {
                const f32x16 acc = accs[pr];
                float wv[2][16];
                { unsigned wa_ = (unsigned)(size_t)wl; asm volatile("" : "+v"(wa_));
#pragma unroll
                  for (int i = 0; i < 16; i += 4) { const f32x4 w4 = *(const LAS f32x4*)((LAS unsigned char*)(size_t)wa_ + (pr * 4 + (i >> 2)) * 1024); wv[pr][i] = w4.x; wv[pr][i + 1] = w4.y; wv[pr][i + 2] = w4.z; wv[pr][i + 3] = w4.w; } }
                float p0 = 0.f, p1 = 0.f;
#pragma unroll
                for (int i = 0; i < 8; ++i) { p0 += wv[pr][i] * fmaxf(acc[i], 0.f); p1 += wv[pr][8 + i] * fmaxf(acc[8 + i], 0.f); }
                const float t0 = p0 + __shfl_xor(p0, 32), t1 = p1 + __shfl_xor(p1, 32);
                SC[(pr * 128 + t) * 64 + lane] = hf ? t1 : t0;
            }
        }
        }
        VM_WAIT();
        if (parts & 2)
#pragma unroll 1
        for (int qi = 0; qi < 4; ++qi) {
            const int tq = q0 + qi, pr = qi >> 1, qs = qi & 1;
            unsigned u[64];
            const unsigned* scp = (const unsigned*)(SC + pr * 8192 + hf * 64 + qs * 32 + r);
#pragma unroll
            for (int g8 = 0; g8 < 8; ++g8) {
#pragma unroll
                for (int e = 0; e < 8; ++e) { const int i = 8 * g8 + e; const float s = __builtin_bit_cast(float, __hip_atomic_load(scp + e * 128, __ATOMIC_RELAXED, __HIP_MEMORY_SCOPE_AGENT));
                    u[i] = (2 * i + hf < ntile && 64 * i + lane <= tq) ? f2sortable(s) : 0u; }
                scp += 1024; asm volatile("" : "+v"(scp));
            }
            unsigned prefix = 0u;
            if (tq >= 256) {
#pragma unroll 1
                for (int bit = 31; bit >= 0; --bit) {
                    const unsigned cand = prefix | (1u << bit); int c = 0;
#pragma unroll
                    for (int i = 0; i < 64; ++i) c += (u[i] >= cand) ? 1 : 0;
                    c = wave_isum_dpp(c);
                    if (c >= 256) prefix = cand;
                    if (c == 256) break;
                }
            }
            const unsigned T = prefix > 1u ? prefix : 1u;
            int nl = 0;
#pragma unroll
            for (int i = 0; i < 64; ++i) nl += (u[i] >= T) ? 1 : 0;
            const int inc = wave_iscan_dpp(nl), base = __builtin_amdgcn_readlane(inc, 63);
            int pos = inc - nl;
            unsigned short* sel = dry ? (unsigned short*)(ar + DUMMY_OFF) + (size_t)F.gw * 256 : SEL + (size_t)(bl * SEQ + tq) * 256;
#pragma unroll
            for (int i = 0; i < 64; ++i) { if (u[i] >= T) { if (pos < 256) sel[pos] = (unsigned short)(64 * i + lane); ++pos; } }
            if (lane == 0) (dry ? (int*)(ar + DUMMY_OFF + 32 * MiB) + F.gw : CNT + bl * SEQ + tq)[0] = base < 256 ? base : 256;
        }
    }
}
DI int dsa_fsw(int row) { return ((row & 3) << 2) | ((row >> 2) & 3); }
struct DsaPre { u32x4 row[16]; bf16x8 kpe[3]; bf16x8 q[3]; };
DI void dsa_prefetch(DsaPre& P, const bf16* LATC, const bf16* KPE, const bf16* QL, const bf16* QPE, int ml, int selv, int lane, int w) {
    const int bl = ml >> 12, r = lane & 31, h = lane >> 5;
#pragma unroll
    for (int it = 0; it < 16; ++it) { const int ki = __shfl(selv, (lane >> 5) + 2 * it); P.row[it] = *(const u32x4*)(LATC + (size_t)(bl * SEQ + ki) * 256 + (lane & 31) * 8); }
#pragma unroll
    for (int s = 0; s < 3; ++s) P.kpe[s] = *(const bf16x8*)(KPE + (size_t)(bl * SEQ + selv) * 48 + 16 * s + 8 * h);
#pragma unroll
    for (int j = 0; j < 3; ++j) { const int fi = w + 8 * j;
        if (fi < 16) P.q[j] = *(const bf16x8*)(QL + (size_t)ml * 8192 + r * 256 + 16 * fi + 8 * h);
        else if (fi < 19) P.q[j] = *(const bf16x8*)(QPE + (size_t)ml * 1536 + r * 48 + 16 * (fi - 16) + 8 * h); }
}
DI void ph_dsa_attn(const Frame& F, const int dry = 0) {
    unsigned char* ar = F.ws + WS_AR;
    bf16* QL = (bf16*)(ar + DA_QL); const bf16* QPE = (const bf16*)(ar + DA_QPE); const bf16* LATC = (const bf16*)(ar + DA_LATC); const bf16* KPE = (const bf16*)(ar + DA_KPE);
    const unsigned short* SEL = (const unsigned short*)(ar + DA_SEL); const int* CNT = (const int*)(ar + DA_CNT);
    const int lane = F.lane, r = lane & 31, h = lane >> 5, w = F.wave;
    LAS unsigned char* IMG = F.lds; LAS unsigned char* QB = F.lds + LDSCTL_OFF + 256; LAS float* MX = (LAS float*)(F.lds + LDSCTL_OFF + 256 + 19456); LAS float* SX = MX + 256;
    const int i16 = lane & 15, tq_ = i16 >> 2, tp_ = i16 & 3, blk = (lane >> 4) & 1;
    int ml = blockIdx.x;
    if (ml >= MC) return;
    DsaPre P;
    int cnt_c = CNT[ml];
    { const int slot = 32 * w + r; const int selv = slot < cnt_c ? (int)SEL[(size_t)ml * 256 + slot] : 0; dsa_prefetch(P, LATC, KPE, QL, QPE, ml, selv, lane, w); }
    int cnt_n = 0, selv_n = 0;
    if (ml + F.G < MC) { cnt_n = CNT[ml + F.G]; const int slot = 32 * w + r; selv_n = slot < cnt_n ? (int)SEL[(size_t)(ml + F.G) * 256 + slot] : 0; }
#pragma unroll 1
    for (; ml < MC; ml += F.G) {
        const int cnt = cnt_c, nch = (cnt + 31) >> 5; const bool act = w < nch;
#pragma unroll
        for (int it = 0; it < 16; ++it) { const int rr = (lane >> 5) + 2 * it; *(LAS u32x4*)(IMG + (32 * w + rr) * 512 + (((lane & 31) ^ dsa_fsw(rr)) * 16)) = P.row[it]; }
#pragma unroll
        for (int j = 0; j < 3; ++j) { const int fi = w + 8 * j; if (fi < 19) *(LAS bf16x8*)(QB + fi * 1024 + lane * 16) = P.q[j]; }
        bf16x8 kpe[3];
#pragma unroll
        for (int s = 0; s < 3; ++s) kpe[s] = P.kpe[s];
        LDS_WAIT(); __builtin_amdgcn_s_barrier(); asm volatile("" ::: "memory");
        if (ml + F.G < MC) {
            dsa_prefetch(P, LATC, KPE, QL, QPE, ml + F.G, selv_n, lane, w); cnt_c = cnt_n;
            if (ml + 2 * F.G < MC) { cnt_n = CNT[ml + 2 * F.G]; const int slot = 32 * w + r; selv_n = slot < cnt_n ? (int)SEL[(size_t)(ml + 2 * F.G) * 256 + slot] : 0; }
        }
        f32x16 S; float mx = -INFINITY;
#pragma unroll
        for (int i = 0; i < 16; ++i) S[i] = 0.f;
        if (act) {
#pragma unroll
            for (int s = 0; s < 16; ++s) S = MFMA32(*(const LAS bf16x8*)(IMG + (32 * w + r) * 512 + (((2 * s + h) ^ dsa_fsw(r)) * 16)), *(const LAS bf16x8*)(QB + s * 1024 + lane * 16), S);
#pragma unroll
            for (int s = 0; s < 3; ++s) S = MFMA32(kpe[s], *(const LAS bf16x8*)(QB + (16 + s) * 1024 + lane * 16), S);
#pragma unroll
            for (int i = 0; i < 16; ++i) { S[i] = (32 * w + crow(i, h) < cnt) ? S[i] : -INFINITY; mx = fmaxf(mx, S[i]); }
            mx = fmaxf(mx, __shfl_xor(mx, 32));
        }
        if (h == 0) MX[w * 32 + r] = mx;
        LDS_WAIT(); __builtin_amdgcn_s_barrier(); asm volatile("" ::: "memory");
        float M = MX[r];
#pragma unroll
        for (int k = 1; k < 8; ++k) M = fmaxf(M, MX[k * 32 + r]);
        float lsum = 0.f; bf16x8 pf[2] = {(bf16x8){0, 0, 0, 0, 0, 0, 0, 0}, (bf16x8){0, 0, 0, 0, 0, 0, 0, 0}};
        if (act) {
#pragma unroll
            for (int i = 0; i < 16; ++i) { S[i] = __builtin_amdgcn_exp2f(S[i] - M); lsum += S[i]; }
#pragma unroll
            for (int s = 0; s < 2; ++s) { u32x4 t; t.x = pk2(S[8 * s], S[8 * s + 1]); t.y = pk2(S[8 * s + 2], S[8 * s + 3]); t.z = pk2(S[8 * s + 4], S[8 * s + 5]); t.w = pk2(S[8 * s + 6], S[8 * s + 7]); pf[s] = __builtin_bit_cast(bf16x8, t); }
        }
        lsum += __shfl_xor(lsum, 32);
        if (h == 0) SX[w * 32 + r] = lsum;
        *(LAS bf16x8*)(QB + (2 * w) * 1024 + lane * 16) = pf[0]; *(LAS bf16x8*)(QB + (2 * w + 1) * 1024 + lane * 16) = pf[1];
        LDS_WAIT(); __builtin_amdgcn_s_barrier(); asm volatile("" ::: "memory");
        f32x16 O;
#pragma unroll
        for (int i = 0; i < 16; ++i) O[i] = 0.f;
#pragma unroll 2
        for (int ks = 0; ks < 2 * nch; ++ks) {
            const int r0 = 16 * ks + 4 * h + tq_, r1 = r0 + 8, pc = 4 * w + 2 * blk + (tp_ >> 1);
            const s16x4 lo = __builtin_bit_cast(s16x4, __builtin_amdgcn_ds_read_tr16_b64_v4i16((LAS v4i16_t*)(IMG + r0 * 512 + ((pc ^ dsa_fsw(r0)) * 16) + 8 * (tp_ & 1))));
            const s16x4 hi = __builtin_bit_cast(s16x4, __builtin_amdgcn_ds_read_tr16_b64_v4i16((LAS v4i16_t*)(IMG + r1 * 512 + ((pc ^ dsa_fsw(r1)) * 16) + 8 * (tp_ & 1))));
            O = MFMA32(__builtin_shufflevector(lo, hi, 0, 1, 2, 3, 4, 5, 6, 7), *(const LAS bf16x8*)(QB + ks * 1024 + lane * 16), O);
        }
        float l = SX[r];
#pragma unroll
        for (int k = 1; k < 8; ++k) l += SX[k * 32 + r];
        const float linv = 1.0f / l;
        bf16* o = (dry ? (bf16*)(ar + DUMMY_OFF) + (size_t)blockIdx.x * 8192 : QL + (size_t)ml * 8192) + r * 256 + 32 * w + 4 * h;
#pragma unroll
        for (int g = 0; g < 4; ++g) { u32x2 t; t.x = pk2(O[4 * g] * linv, O[4 * g + 1] * linv); t.y = pk2(O[4 * g + 2] * linv, O[4 * g + 3] * linv); *(u32x2*)(o + 8 * g) = t; }
        LDS_WAIT(); __builtin_amdgcn_s_barrier(); asm volatile("" ::: "memory");
    }
}
template <int NDB> DI void softmax_step(f32x16& S, float& m, float& l, f32x16 (&O)[NDB], bf16x8 (&pf)[2]) {
    float mx = S[0];
#pragma unroll
    for (int i = 1; i < 16; ++i) mx = fmaxf(mx, S[i]);
    mx = fmaxf(mx, __shfl_xor(mx, 32));
    const float mn = fmaxf(m, mx), ms = (mn == -INFINITY) ? 0.f : mn;
    const float alpha = __builtin_amdgcn_exp2f(m - ms);
    float sum = 0.f;
#pragma unroll
    for (int i = 0; i < 16; ++i) { S[i] = __builtin_amdgcn_exp2f(S[i] - ms); sum += S[i]; }
    l = l * alpha + sum; m = mn;
    if (__builtin_amdgcn_ballot_w64(alpha != 1.0f) != 0ull) {
#pragma unroll
        for (int db = 0; db < NDB; ++db)
#pragma unroll
            for (int i = 0; i < 16; ++i) O[db][i] *= alpha;
    }
#pragma unroll
    for (int s = 0; s < 2; ++s) { u32x4 w; w.x = pk2(S[8 * s], S[8 * s + 1]); w.y = pk2(S[8 * s + 2], S[8 * s + 3]); w.z = pk2(S[8 * s + 4], S[8 * s + 5]); w.w = pk2(S[8 * s + 6], S[8 * s + 7]); pf[s] = __builtin_bit_cast(bf16x8, w); }
}
template <int NQ, int NDB, bool PV, bool QL, bool FRAG, class KA, class VA, class MK>
DI void attn_run(const bf16x8 (&qf)[NQ], const LAS unsigned char* qlds, f32x16 (&O)[NDB], float& m, float& l, int tb, int te, const KA& ka, const VA& va, const MK& mk) {
    if (tb >= te) return;
    bf16x8 kf[NQ];
    { const bf16* kp = ka(tb);
#pragma unroll
      for (int s = 0; s < NQ; ++s) kf[s] = *(const bf16x8*)(kp + (FRAG ? 512 : 16) * s); }
    for (int t = tb; t < te; ++t) {
        bf16x8 vf[NDB][2];
        if (PV) {
#pragma unroll
            for (int db = 0; db < NDB; ++db) { const bf16* vp = va(t, db);
#pragma unroll
                for (int s = 0; s < 2; ++s) { if (FRAG) vf[db][s] = *(const bf16x8*)(vp + 512 * s); else vf[db][s] = __builtin_shufflevector(*(const s16x4*)(vp + 16 * s), *(const s16x4*)(vp + 16 * s + 8), 0, 1, 2, 3, 4, 5, 6, 7); } }
        }
        f32x16 S;
#pragma unroll
        for (int i = 0; i < 16; ++i) S[i] = 0.f;
#pragma unroll
        for (int s = 0; s < NQ; ++s) { if (QL) { unsigned qa_ = (unsigned)(size_t)qlds; asm volatile("" : "+v"(qa_)); S = MFMA32(kf[s], *(const LAS bf16x8*)((LAS unsigned char*)(size_t)qa_ + s * 1024), S); } else S = MFMA32(kf[s], qf[s], S); }
        if (t + 1 < te) { const bf16* kp = ka(t + 1);
#pragma unroll
            for (int s = 0; s < NQ; ++s) kf[s] = *(const bf16x8*)(kp + (FRAG ? 512 : 16) * s); }
        mk(t, S);
        bf16x8 pf[2]; softmax_step<NDB>(S, m, l, O, pf);
        if (PV) {
#pragma unroll
            for (int db = 0; db < NDB; ++db)
#pragma unroll
                for (int s = 0; s < 2; ++s) O[db] = MFMA32(vf[db][s], pf[s], O[db]);
        }
    }
}
template <bool ACC> DI void store_col(bf16* out, const f32x16 (&O)[4], float scale, int h) {
#pragma unroll
    for (int db = 0; db < 4; ++db)
#pragma unroll
        for (int g = 0; g < 4; ++g) { u32x2* p = (u32x2*)(out + db * 32 + 8 * g + 4 * h);
            float a = O[db][4 * g] * scale, b = O[db][4 * g + 1] * scale, c = O[db][4 * g + 2] * scale, d = O[db][4 * g + 3] * scale;
            if (ACC) { const u32x2 o = *p; a += bflo(o.x); b += bfhi(o.x); c += bflo(o.y); d += bfhi(o.y); }
            u32x2 w; w.x = pk2(a, b); w.y = pk2(c, d); *p = w; }
}
template <int NQ> struct TilePre { u32x4 a, b, c; };
template <int NQ, class SRC> DI void tile_fetch(TilePre<NQ>& p, const SRC& src, int T, int tid) {
    const bf16* k = src.k(T); const bf16* v = src.v(T);
    constexpr int NK = NQ * 64;
    p.a = *(const u32x4*)(k + (size_t)tid * 8);
    const int p1 = tid + 512; p.b = (p1 < NK) ? *(const u32x4*)(k + (size_t)p1 * 8) : *(const u32x4*)(v + (size_t)(p1 - NK) * 8);
    if (NQ * 64 + 512 > 1024) { const int p2 = tid + 1024; if (p2 < NK + 512) p.c = *(const u32x4*)(v + (size_t)(p2 - NK) * 8); }
}
template <int NQ> DI void tile_put(const TilePre<NQ>& p, LAS unsigned char* buf, int tid) {
    *(LAS u32x4*)(buf + tid * 16) = p.a; *(LAS u32x4*)(buf + (tid + 512) * 16) = p.b;
    if (NQ * 64 + 512 > 1024) { if (tid + 1024 < NQ * 64 + 512) *(LAS u32x4*)(buf + (tid + 1024) * 16) = p.c; }
}
template <int NQ, bool PV, class SRC, class MK>
DI void attn_run_sh(LAS unsigned char* tl, int tid, int lane, const bf16x8 (&qf)[NQ], f32x16 (&O)[4], float& m, float& l, int TB, int TE, int tb, int te, const SRC& src, const MK& mk) {
    constexpr int TBYTES = (NQ + 8) * 1024;
    if (TB >= TE) return;
    TilePre<NQ> pre;
    tile_fetch<NQ>(pre, src, TB, tid); tile_put<NQ>(pre, tl, tid);
    LDS_WAIT(); __builtin_amdgcn_s_barrier(); asm volatile("" ::: "memory");
#pragma unroll 1
    for (int T = TB; T < TE; ++T) {
        LAS unsigned char* cur = tl + ((T - TB) & 1) * TBYTES;
        if (T + 1 < TE) tile_fetch<NQ>(pre, src, T + 1, tid);
        if (T >= tb && T < te) {
            f32x16 S;
#pragma unroll
            for (int i = 0; i < 16; ++i) S[i] = 0.f;
#pragma unroll
            for (int s = 0; s < NQ; ++s) S = MFMA32(*(const LAS bf16x8*)(cur + s * 1024 + lane * 16), qf[s], S);
            mk(T, S);
            bf16x8 pf[2]; softmax_step<4>(S, m, l, O, pf);
            if (PV) {
#pragma unroll
                for (int db = 0; db < 4; ++db)
#pragma unroll
                    for (int s = 0; s < 2; ++s) O[db] = MFMA32(*(const LAS bf16x8*)(cur + (NQ + db * 2 + s) * 1024 + lane * 16), pf[s], O[db]);
            }
        }
        if (T + 1 < TE) tile_put<NQ>(pre, tl + ((T + 1 - TB) & 1) * TBYTES, tid);
        LDS_WAIT(); __builtin_amdgcn_s_barrier(); asm volatile("" ::: "memory");
    }
}
struct FragSrc { const bf16* kb; const bf16* vb; int nq; DI const bf16* k(int T) const { return kb + (size_t)T * nq * 512; } DI const bf16* v(int T) const { return vb + (size_t)T * 8 * 512; } };
constexpr size_t FA_Q = 0, FA_K = 64 * MiB, FA_F = 128 * MiB, FA_V = 136 * MiB, FA_CUM = 200 * MiB, FA_O = 202 * MiB, FA_KF = 266 * MiB, FA_VF = 330 * MiB;
constexpr size_t FW_IN = 0, FW_OUT = (size_t)6400 * 2048;
constexpr float FOX_QSCALE = 0.08838834764831845f * LOG2E;
DI void ph_fox_cvt(const Frame& F, const float* w_in, const float* w_out) {
    bf16* WB = (bf16*)(F.ws + WS_WMIX);
    cvt_job(F, w_in, 6160, DM, 0, 2048, WB + FW_IN, DM, 0, FOX_QSCALE);
    cvt_job(F, w_in, 6160, DM, 2048, 2048, WB + FW_IN, DM, 2048, 1.f);
    cvt_job(F, w_in, 6160, DM, 4096, 2048, WB + FW_IN, DM, 4096, 1.f);
    cvt_job(F, w_in, 6160, DM, 6144, 16, WB + FW_IN, DM, 6144, 1.f);
    zero_bf16(F, WB + FW_IN + (size_t)6160 * DM, (size_t)240 * DM);
    cvt_job(F, w_out, DM, DM, 0, DM, WB + FW_OUT, DM, 0, 1.f);
}
DI void ph_fox_scan(const Frame& F, const float* b_f) {
    unsigned char* ar = F.ws + WS_AR; const bf16* FB = (const bf16*)(ar + FA_F); float* CUM = (float*)(ar + FA_CUM);
    for (int w = F.gw; w < BPH * 16; w += F.NGW) {
        const int bl = w >> 4, hd = w & 15; const float bf_ = b_f[hd];
        float v[64]; float run = 0.f;
#pragma unroll
        for (int i = 0; i < 64; ++i) { const float x = bf2f(FB[(size_t)(bl * SEQ + F.lane * 64 + i) * 256 + hd]) + bf_;
            const float ls = fminf(x, 0.f) - log1pf(expf(-fabsf(x))); run += ls; v[i] = run; }
        float inc = run;
#pragma unroll
        for (int o = 1; o < 64; o <<= 1) { const float y = __shfl_up(inc, o); if (F.lane >= o) inc += y; }
        const float base = inc - run;
        float* dst = CUM + (size_t)w * SEQ + F.lane * 64;
#pragma unroll
        for (int i = 0; i < 64; i += 4) *(f32x4*)(dst + i) = (f32x4){(v[i] + base) * LOG2E, (v[i + 1] + base) * LOG2E, (v[i + 2] + base) * LOG2E, (v[i + 3] + base) * LOG2E};
    }
    const bf16* Kr = (const bf16*)(ar + FA_K); const bf16* Vr = (const bf16*)(ar + FA_V); bf16* KF = (bf16*)(ar + FA_KF); bf16* VF = (bf16*)(ar + FA_VF);
    const int r = F.lane & 31, h = F.lane >> 5;
    for (int u = F.gw; u < BPH * 16 * 128; u += F.NGW) {
        const int bh = u >> 7, tile = u & 127, bl = bh >> 4, hd = bh & 15;
        const bf16* krow_ = Kr + ((size_t)bl * SEQ + tile * 32 + r) * DM + hd * 128 + 8 * h;
        bf16* kd = KF + (((size_t)bh * 128 + tile) * 8 * 64 + F.lane) * 8;
#pragma unroll
        for (int s = 0; s < 8; ++s) *(u32x4*)(kd + s * 512) = *(const u32x4*)(krow_ + 16 * s);
        bf16* vd = VF + (((size_t)bh * 128 + tile) * 8 * 64 + F.lane) * 8;
#pragma unroll
        for (int db = 0; db < 4; ++db)
#pragma unroll
            for (int s = 0; s < 2; ++s) { unsigned short e[8];
#pragma unroll
                for (int j = 0; j < 8; ++j) e[j] = Vr[((size_t)bl * SEQ + tile * 32 + 16 * s + 8 * (j >> 2) + 4 * h + (j & 3)) * DM + hd * 128 + db * 32 + r];
                u32x4 w; w.x = e[0] | ((unsigned)e[1] << 16); w.y = e[2] | ((unsigned)e[3] << 16); w.z = e[4] | ((unsigned)e[5] << 16); w.w = e[6] | ((unsigned)e[7] << 16);
                *(u32x4*)(vd + (db * 2 + s) * 512) = w; }
    }
}
struct FragKA { const bf16* base; int nq; DI const bf16* operator()(int t) const { return base + (size_t)t * nq * 512; } };
struct FragVA { const bf16* base; DI const bf16* operator()(int t, int db) const { return base + ((size_t)t * 8 + db * 2) * 512; } };
struct FoxMK { const float* cum; float ct; int tq, h;
    DI void operator()(int t, f32x16& S) const {
        const int k0 = 32 * t + 4 * h;
#pragma unroll
        for (int g = 0; g < 4; ++g) { const f32x4 cs = *(const f32x4*)(cum + k0 + 8 * g);
#pragma unroll
            for (int e = 0; e < 4; ++e) S[4 * g + e] = (k0 + 8 * g + e <= tq) ? S[4 * g + e] + (ct - cs[e]) : -INFINITY; }
    } };
DI void ph_fox_attn(const Frame& F, const int dry = 0) {
    unsigned char* ar = F.ws + WS_AR; const bf16* Q = (const bf16*)(ar + FA_Q); const bf16* KF = (const bf16*)(ar + FA_KF); const bf16* VF = (const bf16*)(ar + FA_VF); const float* CUM = (const float*)(ar + FA_CUM); bf16* Ob = (bf16*)(ar + FA_O);
    const int r = F.lane & 31, h = F.lane >> 5;
    for (int wb = blockIdx.x; wb < BPH * 16 * 4; wb += F.G) {
        const int bh = wb >> 2, x = (wb & 3) * 8 + F.wave, bl = bh >> 4, hd = bh & 15;
#pragma unroll 1
        for (int k = 0; k < 4; ++k) {
            const int qt = (k == 0) ? x : (k == 1) ? 63 - x : (k == 2) ? 64 + x : 127 - x;
            const int qhi = (k == 0) ? (wb & 3) * 8 + 7 : (k == 1) ? 63 - (wb & 3) * 8 : (k == 2) ? 64 + (wb & 3) * 8 + 7 : 127 - (wb & 3) * 8;
            const int tq = qt * 32 + r; const size_t mrow = (size_t)bl * SEQ + tq;
            bf16x8 qf[8];
#pragma unroll
            for (int s = 0; s < 8; ++s) qf[s] = *(const bf16x8*)(Q + mrow * DM + hd * 128 + 16 * s + 8 * h);
            f32x16 O[4];
#pragma unroll
            for (int db = 0; db < 4; ++db)
#pragma unroll
                for (int i = 0; i < 16; ++i) O[db][i] = 0.f;
            float m = -INFINITY, l = 0.f;
            const float* cum = CUM + (size_t)bh * SEQ;
            const FragSrc src{KF + (size_t)bh * 128 * 8 * 512, VF + (size_t)bh * 128 * 8 * 512, 8}; const FoxMK mk{cum, cum[tq], tq, h};
            attn_run_sh<8, true>(F.lds, F.tid, F.lane, qf, O, m, l, 0, qhi + 1, 0, qt + 1, src, mk);
            l += __shfl_xor(l, 32);
            store_col<false>(dry ? (bf16*)(ar + DUMMY_OFF) + ((size_t)F.gw * 32 + r) * 128 : Ob + mrow * DM + hd * 128, O, l > 0.f ? 1.0f / l : 0.f, h);
        }
    }
}
typedef long fp8x8_t;
DI fp8x8_t pack_fp8x8(float a0, float a1, float a2, float a3, float a4, float a5, float a6, float a7) {
    int lo = 0, hi = 0;
    lo = __builtin_amdgcn_cvt_pk_fp8_f32(a0, a1, lo, false); lo = __builtin_amdgcn_cvt_pk_fp8_f32(a2, a3, lo, true);
    hi = __builtin_amdgcn_cvt_pk_fp8_f32(a4, a5, hi, false); hi = __builtin_amdgcn_cvt_pk_fp8_f32(a6, a7, hi, true);
    return (fp8x8_t)(((unsigned long long)(unsigned)hi << 32) | (unsigned long long)(unsigned)lo);
}
#define MFMA32F8(a, b, c) __builtin_amdgcn_mfma_f32_32x32x16_fp8_fp8((a), (b), (c), 0, 0, 0)
constexpr size_t NA_Q = 0, NA_KC = 288 * MiB, NA_VC = 313 * MiB, NA_KSR = 330 * MiB, NA_KWR = 354 * MiB, NA_GT = 378 * MiB, NA_VSR = 386 * MiB, NA_VWR = 402 * MiB, NA_GK = 418 * MiB, NA_GV = 420 * MiB,
                 NA_KCMP = 422 * MiB, NA_VCT = 424 * MiB, NA_SELB = 426 * MiB, NA_O = 428 * MiB,
                 NA_KSF = 620 * MiB, NA_KWF = 644 * MiB, NA_VSF = 668 * MiB, NA_VWF = 684 * MiB;
constexpr size_t NW_IN = 0, NW_W1K = (size_t)13312 * 2048, NW_W1V = NW_W1K + (size_t)256 * 6144, NW_W2K = NW_W1V + (size_t)256 * 4096, NW_W2V = NW_W2K + 65536, NW_OUT = NW_W2V + 65536;
constexpr float NSA_QSCALE = 0.07216878364870322f * LOG2E;
DI void ph_nsa_cvt(const Frame& F, const float* w_in, const float* k_pe, const float* k_w1, const float* k_b1, const float* k_w2, const float* v_pe, const float* v_w1, const float* v_b1, const float* v_w2, const float* w_out) {
    bf16* WB = (bf16*)(F.ws + WS_WMIX); float* BIAS = (float*)(F.ws + WS_MISC);
    cvt_job(F, w_in, 13200, DM, 0, 9216, WB + NW_IN, DM, 0, NSA_QSCALE);
    cvt_job(F, w_in, 13200, DM, 9216, 768, WB + NW_IN, DM, 9216, 1.f);
    cvt_job(F, w_in, 13200, DM, 9984, 512, WB + NW_IN, DM, 9984, 1.f);
    cvt_job(F, w_in, 13200, DM, 10496, 768, WB + NW_IN, DM, 10496, 1.f);
    cvt_job(F, w_in, 13200, DM, 11776, 768, WB + NW_IN, DM, 11264, 1.f);
    cvt_job(F, w_in, 13200, DM, 13056, 144, WB + NW_IN, DM, 12032, 1.f);
    zero_bf16(F, WB + NW_IN + (size_t)12176 * DM, (size_t)112 * DM);
    cvt_job(F, w_in, 13200, DM, 11264, 512, WB + NW_IN, DM, 12288, 1.f);
    cvt_job(F, w_in, 13200, DM, 12544, 512, WB + NW_IN, DM, 12800, 1.f);
    cvt_job(F, k_w1, 256, 6144, 0, 256, WB + NW_W1K, 6144, 0, 1.f);
    cvt_job(F, v_w1, 256, 4096, 0, 256, WB + NW_W1V, 4096, 0, 1.f);
    cvt_job(F, k_w2, 192, 256, 0, 192, WB + NW_W2K, 256, 0, 1.f); zero_bf16(F, WB + NW_W2K + 192 * 256, 64 * 256);
    cvt_job(F, v_w2, 128, 256, 0, 128, WB + NW_W2V, 256, 0, 1.f); zero_bf16(F, WB + NW_W2V + 128 * 256, 128 * 256);
    cvt_job(F, w_out, DM, 6144, 0, DM, WB + NW_OUT, 6144, 0, 1.f);
    for (int w = F.gw; w < 512; w += F.NGW) { const bool isk = w < 256; const int c = w & 255, n = isk ? 6144 : 4096; const float* pe = isk ? k_pe : v_pe; const float* w1 = isk ? k_w1 : v_w1;
        float s = 0.f; for (int i = F.lane; i < n; i += 64) s += pe[i] * w1[(size_t)i * 256 + c];
        s = wave_sum(s); if (F.lane == 0) BIAS[w] = s + (isk ? k_b1[c] : v_b1[c]); }
}
DI void ph_nsa_rope(const Frame& F, int half) {
    unsigned char* ar = F.ws + WS_AR; bf16* Q = (bf16*)(ar + NA_Q); bf16* KC = (bf16*)(ar + NA_KC);
    const bf16* KSR = (const bf16*)(ar + NA_KSR); const bf16* KWR = (const bf16*)(ar + NA_KWR); bf16* KSF = (bf16*)(ar + NA_KSF); bf16* KWF = (bf16*)(ar + NA_KWF);
    const float* c48 = (const float*)(F.ws + TAB_COS48); const float* s48 = (const float*)(F.ws + TAB_SIN48);
    for (int ml = F.gw; ml < MC; ml += F.NGW) {
        const size_t mg = (size_t)half * MC + ml; const int bl = ml >> 12, sq = ml & 4095;
        for (int p = F.lane; p < 1248; p += 64) {
            const int hd = p / 24, i = p - hd * 24; bf16* q;
            if (hd < 48) q = Q + (size_t)ml * 9216 + hd * 192 + i;
            else q = KC + ((size_t)(bl * 4 + hd - 48) * 4096 + sq) * 192 + i;
            const float x1 = bf2f(q[0]), x2 = bf2f(q[24]), c = c48[mg * 24 + i], s = s48[mg * 24 + i]; q[0] = f2bf(x1 * c - x2 * s); q[24] = f2bf(x1 * s + x2 * c);
        }
        const int tile = sq >> 5, rr = sq & 31;
        for (int u = F.lane; u < 168; u += 64) {
            const int tens = u / 84, uu = u - tens * 84, g = uu / 21, v = uu - g * 21;
            const bf16* src = (tens ? KWR : KSR) + (size_t)ml * 768 + g * 192;
            bf16* dst = (tens ? KWF : KSF) + ((size_t)((bl * 4 + g) * 128 + tile) * 12 * 64 + rr) * 8;
            if (v < 3) {
                const u32x4 a = *(const u32x4*)(src + 8 * v), b = *(const u32x4*)(src + 8 * v + 24); u32x4 o1, o2;
#pragma unroll
                for (int e = 0; e < 4; ++e) { const float c0 = c48[mg * 24 + 8 * v + 2 * e], s0 = s48[mg * 24 + 8 * v + 2 * e], c1 = c48[mg * 24 + 8 * v + 2 * e + 1], s1 = s48[mg * 24 + 8 * v + 2 * e + 1];
                    const float x1l = bflo(a[e]), x1h = bfhi(a[e]), x2l = bflo(b[e]), x2h = bfhi(b[e]);
                    o1[e] = pk2(x1l * c0 - x2l * s0, x1h * c1 - x2h * s1); o2[e] = pk2(x1l * s0 + x2l * c0, x1h * s1 + x2h * c1); }
                const int p1 = v, p2 = v + 3;
                if (tens) { *(u32x4*)(dst + ((p1 >> 1) * 64 + (p1 & 1) * 32) * 8) = o1; *(u32x4*)(dst + ((p2 >> 1) * 64 + (p2 & 1) * 32) * 8) = o2; }
                else { unsigned char* d8 = (unsigned char*)KSF + ((size_t)(((bl * 4 + g) * 128 + tile) * 2 + (rr >> 4)) * 6 * 64 + (rr & 15)) * 8;
                    *(fp8x8_t*)(d8 + ((p1 >> 2) * 64 + (p1 & 3) * 16) * 8) = pack_fp8x8(bflo(o1[0]), bfhi(o1[0]), bflo(o1[1]), bfhi(o1[1]), bflo(o1[2]), bfhi(o1[2]), bflo(o1[3]), bfhi(o1[3]));
                    *(fp8x8_t*)(d8 + ((p2 >> 2) * 64 + (p2 & 3) * 16) * 8) = pack_fp8x8(bflo(o2[0]), bfhi(o2[0]), bflo(o2[1]), bfhi(o2[1]), bflo(o2[2]), bfhi(o2[2]), bflo(o2[3]), bfhi(o2[3])); }
            } else { const int pc = v + 3; const u32x4 c = *(const u32x4*)(src + 8 * pc);
                if (tens) *(u32x4*)(dst + ((pc >> 1) * 64 + (pc & 1) * 32) * 8) = c;
                else { unsigned char* d8 = (unsigned char*)KSF + ((size_t)(((bl * 4 + g) * 128 + tile) * 2 + (rr >> 4)) * 6 * 64 + (rr & 15)) * 8;
                    *(fp8x8_t*)(d8 + ((pc >> 2) * 64 + (pc & 3) * 16) * 8) = pack_fp8x8(bflo(c[0]), bfhi(c[0]), bflo(c[1]), bfhi(c[1]), bflo(c[2]), bfhi(c[2]), bflo(c[3]), bfhi(c[3])); } }
        }
    }
    const bf16* VSR = (const bf16*)(ar + NA_VSR); const bf16* VWR = (const bf16*)(ar + NA_VWR); bf16* VSF = (bf16*)(ar + NA_VSF); bf16* VWF = (bf16*)(ar + NA_VWF);
    const int r = F.lane & 31, h = F.lane >> 5;
    for (int u = F.gw; u < 2 * BPH * 4 * 128; u += F.NGW) {
        const int tens = u >> 11, bg = (u >> 7) & 15, tile = u & 127, bl = bg >> 2, g = bg & 3;
        if (tens) {
            const bf16* src = VWR + ((size_t)bl * SEQ + tile * 32) * 512 + g * 128 + r;
            bf16* vd = VWF + (((size_t)bg * 128 + tile) * 8 * 64 + F.lane) * 8;
#pragma unroll
            for (int db = 0; db < 4; ++db)
#pragma unroll
                for (int s = 0; s < 2; ++s) { unsigned short e[8];
#pragma unroll
                    for (int j = 0; j < 8; ++j) e[j] = src[(size_t)(16 * s + 8 * (j >> 2) + 4 * h + (j & 3)) * 512 + db * 32];
                    u32x4 w; w.x = e[0] | ((unsigned)e[1] << 16); w.y = e[2] | ((unsigned)e[3] << 16); w.z = e[4] | ((unsigned)e[5] << 16); w.w = e[6] | ((unsigned)e[7] << 16);
                    *(u32x4*)(vd + (db * 2 + s) * 512) = w; }
        } else {
            const int d16 = F.lane & 15, kq = F.lane >> 4;
            const bf16* src = VSR + ((size_t)bl * SEQ + tile * 32) * 512 + g * 128 + d16;
            unsigned char* vd = (unsigned char*)VSF + (((size_t)bg * 128 + tile) * 8 * 64 + F.lane) * 8;
#pragma unroll
            for (int db = 0; db < 8; ++db) { float e[8];
#pragma unroll
                for (int j = 0; j < 8; ++j) e[j] = bf2f(src[(size_t)((j < 4 ? 4 * kq + j : 16 + 4 * kq + j - 4)) * 512 + db * 16]);
                *(fp8x8_t*)(vd + db * 512) = pack_fp8x8(e[0], e[1], e[2], e[3], e[4], e[5], e[6], e[7]); }
        }
    }
}
DI float sigmoidf_(float x) { return __builtin_amdgcn_rcpf(1.0f + __builtin_amdgcn_exp2f(-x * LOG2E)); }
struct LinKA { const bf16* base; size_t tstride; DI const bf16* operator()(int t) const { return base + (size_t)t * tstride; } };
struct LinVA { const bf16* base; size_t dbstride; DI const bf16* operator()(int t, int db) const { return base + (size_t)db * dbstride + t * 32; } };
struct CmpMK { int tq, h; DI void operator()(int t, f32x16& S) const {
#pragma unroll
    for (int i = 0; i < 16; ++i) { const int n = 32 * t + crow(i, h); S[i] = (16 * n + 31 <= tq) ? S[i] : -INFINITY; } } };
struct WinMK { int tq, h; DI void operator()(int t, f32x16& S) const {
#pragma unroll
    for (int i = 0; i < 16; ++i) { const int k = 32 * t + crow(i, h); S[i] = (k <= tq && k > tq - 512) ? S[i] : -INFINITY; } } };
DI void ph_nsa_cmp(const Frame& F, const int dry = 0) {
    unsigned char* ar = F.ws + WS_AR; const bf16* Q = (const bf16*)(ar + NA_Q); const bf16* KCMP = (const bf16*)(ar + NA_KCMP); const bf16* VCT = (const bf16*)(ar + NA_VCT); const bf16* GT = (const bf16*)(ar + NA_GT);
    unsigned char* SELB = ar + NA_SELB; bf16* Ob = (bf16*)(ar + NA_O);
    LAS float* imp = (LAS float*)F.lds;
    LAS unsigned char* tl = F.lds + 20480;
    const int lane = F.lane, r = lane & 31, h = lane >> 5, tid = F.tid;
    for (int u = blockIdx.x; u < BPH * 4 * 64; u += F.G) {
        const int bg = u >> 6, qt64 = ((u >> 8) & 1) ? 63 - (u & 63) : (u & 63), bl = bg >> 2, g = bg & 3;
        for (int i = F.tid; i < 64 * 65; i += NWAVES * 64) imp[i] = 0.f;
        __syncthreads();
        const FragSrc src{KCMP + (size_t)bg * 8 * 12 * 512, VCT + (size_t)bg * 8 * 8 * 512, 12};
        const int tqmaxb = qt64 * 64 + 63, TE = (tqmaxb >= 31) ? ((tqmaxb - 31) / 16) / 32 + 1 : 0;
#pragma unroll 1
        for (int k = 0; k < 3; ++k) {
            const int idx = F.wave * 3 + k, j = idx >> 1, sub = idx & 1, ql = sub * 32 + r, tq = qt64 * 64 + ql, hd = g * 12 + j;
            const size_t mrow = (size_t)bl * SEQ + tq;
            bf16x8 qf[12];
#pragma unroll
            for (int s = 0; s < 12; ++s) qf[s] = *(const bf16x8*)(Q + mrow * 9216 + hd * 192 + 16 * s + 8 * h);
            const int tqmax = qt64 * 64 + sub * 32 + 31, te = (tqmax >= 31) ? ((tqmax - 31) / 16) / 32 + 1 : 0;
            const CmpMK mk{tq, h};
            f32x16 O[4];
#pragma unroll
            for (int db = 0; db < 4; ++db)
#pragma unroll
                for (int i = 0; i < 16; ++i) O[db][i] = 0.f;
            float m = -INFINITY, l = 0.f;
            attn_run_sh<12, false>(tl, tid, lane, qf, O, m, l, 0, TE, 0, te, src, mk);
            l += __shfl_xor(l, 32);
            const float linv = l > 0.f ? 1.0f / l : 0.f, ms = (m == -INFINITY) ? 0.f : m;
            if (TE > 0) {
                TilePre<12> pre;
                tile_fetch<12>(pre, src, 0, tid); tile_put<12>(pre, tl, tid);
                LDS_WAIT(); __builtin_amdgcn_s_barrier(); asm volatile("" ::: "memory");
#pragma unroll 1
                for (int t = 0; t < TE; ++t) {
                    LAS unsigned char* cur = tl + (t & 1) * 20480;
                    if (t + 1 < TE) tile_fetch<12>(pre, src, t + 1, tid);
                    if (t < te) {
                        f32x16 S;
#pragma unroll
                        for (int i = 0; i < 16; ++i) S[i] = 0.f;
#pragma unroll
                        for (int s = 0; s < 12; ++s) S = MFMA32(*(const LAS bf16x8*)(cur + s * 1024 + lane * 16), qf[s], S);
                        mk(t, S);
#pragma unroll
                        for (int i = 0; i < 16; ++i) S[i] = __builtin_amdgcn_exp2f(S[i] - ms) * linv;
#pragma unroll
                        for (int g4 = 0; g4 < 4; ++g4) { const float gs = (S[4 * g4] + S[4 * g4 + 1]) + (S[4 * g4 + 2] + S[4 * g4 + 3]); const int mb = 8 * t + 2 * g4 + h;
                            __hip_atomic_fetch_add(imp + ql * 65 + mb, gs, __ATOMIC_RELAXED, __HIP_MEMORY_SCOPE_WORKGROUP);
                            if (mb + 1 < 64) __hip_atomic_fetch_add(imp + ql * 65 + mb + 1, S[4 * g4 + 3], __ATOMIC_RELAXED, __HIP_MEMORY_SCOPE_WORKGROUP); }
                        bf16x8 pf[2];
#pragma unroll
                        for (int s = 0; s < 2; ++s) { u32x4 w; w.x = pk2(S[8 * s], S[8 * s + 1]); w.y = pk2(S[8 * s + 2], S[8 * s + 3]); w.z = pk2(S[8 * s + 4], S[8 * s + 5]); w.w = pk2(S[8 * s + 6], S[8 * s + 7]); pf[s] = __builtin_bit_cast(bf16x8, w); }
#pragma unroll
                        for (int db = 0; db < 4; ++db)
#pragma unroll
                            for (int s = 0; s < 2; ++s) O[db] = MFMA32(*(const LAS bf16x8*)(cur + (12 + db * 2 + s) * 1024 + lane * 16), pf[s], O[db]);
                    }
                    if (t + 1 < TE) tile_put<12>(pre, tl + ((t + 1) & 1) * 20480, tid);
                    LDS_WAIT(); __builtin_amdgcn_s_barrier(); asm volatile("" ::: "memory");
                }
            }
            const float gate = sigmoidf_(bf2f(GT[mrow * 256 + hd]));
            store_col<false>(dry ? (bf16*)(ar + DUMMY_OFF) + ((size_t)F.gw * 32 + r) * 128 : Ob + mrow * 6144 + hd * 128, O, gate, h);
        }
        __syncthreads();
#pragma unroll 1
        for (int k = 0; k < 8; ++k) {
            const int ql = F.wave * 8 + k, tq = qt64 * 64 + ql, cur = tq >> 6, mb = lane;
            const bool causal = mb <= cur, forced = (mb == 0) || (mb == cur) || (mb == cur - 1);
            const float v = causal ? (forced ? INFINITY : imp[ql * 65 + mb]) : -INFINITY;
            int rank = 0;
            for (int o = 0; o < 64; ++o) { const float vo = __shfl(v, o); rank += (vo > v || (vo == v && o < mb)) ? 1 : 0; }
            if (rank < 16) (dry ? ar + DUMMY_OFF + 32 * MiB + (size_t)F.gw * 16 : SELB + ((size_t)bg * 4096 + tq) * 16)[rank] = causal ? (unsigned char)mb : (unsigned char)0xFF;
        }
        __syncthreads();
    }
}
DI int sel_tile(const u32x4& sel, int t) { const int b = t >> 1; const unsigned w = (b < 4) ? sel.x : (b < 8) ? sel.y : (b < 12) ? sel.z : sel.w; return (int)((w >> ((b & 3) * 8)) & 0xFFu) * 2 + (t & 1); }
struct SelKA { const bf16* base; u32x4 sel; DI const bf16* operator()(int t) const { return base + (size_t)sel_tile(sel, t) * 12 * 512; } };
struct SelVA { const bf16* base; u32x4 sel; DI const bf16* operator()(int t, int db) const { return base + ((size_t)sel_tile(sel, t) * 8 + db * 2) * 512; } };
struct SelMK { u32x4 sel; int tq, h; DI void operator()(int t, f32x16& S) const { const int k0 = sel_tile(sel, t) * 32;
#pragma unroll
    for (int i = 0; i < 16; ++i) S[i] = (k0 + crow(i, h) <= tq) ? S[i] : -INFINITY; } };
typedef float f32x4_ __attribute__((ext_vector_type(4)));
#define MFMA16F8(a, b, c) __builtin_amdgcn_mfma_f32_16x16x32_fp8_fp8((a), (b), (c), 0, 0, 0)
DI void ph_nsa_sel(const Frame& F, const int dry = 0) {
    unsigned char* ar = F.ws + WS_AR; const bf16* Q = (const bf16*)(ar + NA_Q); const unsigned char* KS8 = ar + NA_KSF; const unsigned char* VS8 = ar + NA_VSF; const bf16* GT = (const bf16*)(ar + NA_GT);
    const unsigned char* SELB = ar + NA_SELB; bf16* Ob = (bf16*)(ar + NA_O);
    const int c16 = F.lane & 15, kq = F.lane >> 4; const bool act = c16 < 12;
    for (int it = F.gw; it < BPH * 4 * SEQ; it += F.NGW) {
        const int bg = it >> 12, tq = ((it & 4095) + 256 * bg) & 4095, bl = bg >> 2, g = bg & 3; const size_t mrow = (size_t)bl * SEQ + tq; const int hd = g * 12 + (act ? c16 : 0);
        fp8x8_t qf[6];
#pragma unroll
        for (int s = 0; s < 6; ++s) { const u32x4 q = *(const u32x4*)(Q + mrow * 9216 + hd * 192 + 32 * s + 8 * kq); const float qs = act ? (1.0f / NSA_QSCALE) : 0.f;
            qf[s] = pack_fp8x8(bflo(q[0]) * qs, bfhi(q[0]) * qs, bflo(q[1]) * qs, bfhi(q[1]) * qs, bflo(q[2]) * qs, bfhi(q[2]) * qs, bflo(q[3]) * qs, bfhi(q[3]) * qs); }
        const u32x4 sel = *(const u32x4*)(SELB + ((size_t)bg * 4096 + tq) * 16);
        const int nv = ((tq >> 6) + 1 < 16) ? (tq >> 6) + 1 : 16, te = 2 * nv;
        const unsigned char* kb = KS8 + ((size_t)bg * 128 * 12 * 64 + F.lane) * 8; const unsigned char* vb = VS8 + ((size_t)bg * 128 * 8 * 64 + F.lane) * 8;
        f32x4_ O[8];
#pragma unroll
        for (int db = 0; db < 8; ++db) O[db] = (f32x4_){0.f, 0.f, 0.f, 0.f};
        float m = -INFINITY, l = 0.f;
        fp8x8_t kfA[12], kfB[12], vfA[8], vfB[8];
        { const unsigned char* kp = kb + (size_t)sel_tile(sel, 0) * 12 * 512; const unsigned char* kp1 = kb + (size_t)sel_tile(sel, 1) * 12 * 512; const unsigned char* vp = vb + (size_t)sel_tile(sel, 0) * 8 * 512;
#pragma unroll
          for (int s = 0; s < 12; ++s) { kfA[s] = *(const fp8x8_t*)(kp + s * 512); kfB[s] = *(const fp8x8_t*)(kp1 + s * 512); }
#pragma unroll
          for (int j = 0; j < 8; ++j) vfA[j] = *(const fp8x8_t*)(vp + j * 512); }
#define SEL_STEP(T_, KF_, VF_, VFN_) do { const int t_ = (T_); const int tile = sel_tile(sel, t_); \
            if (t_ + 1 < te) { const unsigned char* vp = vb + (size_t)sel_tile(sel, t_ + 1) * 8 * 512; _Pragma("unroll") for (int j = 0; j < 8; ++j) VFN_[j] = *(const fp8x8_t*)(vp + j * 512); } \
            f32x4_ S0 = {0.f, 0.f, 0.f, 0.f}, S1 = S0; \
            _Pragma("unroll") for (int s = 0; s < 6; ++s) { S0 = MFMA16F8(KF_[s], qf[s], S0); S1 = MFMA16F8(KF_[6 + s], qf[s], S1); } \
            if (t_ + 2 < te) { const unsigned char* kp = kb + (size_t)sel_tile(sel, t_ + 2) * 12 * 512; _Pragma("unroll") for (int s = 0; s < 12; ++s) KF_[s] = *(const fp8x8_t*)(kp + s * 512); } \
            const int k0 = tile * 32 + 4 * kq; float mx = -INFINITY; \
            _Pragma("unroll") for (int i = 0; i < 4; ++i) { S0[i] = (k0 + i <= tq) ? S0[i] * NSA_QSCALE : -INFINITY; S1[i] = (k0 + 16 + i <= tq) ? S1[i] * NSA_QSCALE : -INFINITY; mx = fmaxf(mx, fmaxf(S0[i], S1[i])); } \
            mx = fmaxf(mx, __shfl_xor(mx, 16)); mx = fmaxf(mx, __shfl_xor(mx, 32)); \
            const float mn = fmaxf(m, mx), ms = (mn == -INFINITY) ? 0.f : mn, alpha = __builtin_amdgcn_exp2f(m - ms); \
            float sum = 0.f; \
            _Pragma("unroll") for (int i = 0; i < 4; ++i) { S0[i] = __builtin_amdgcn_exp2f(S0[i] - ms); S1[i] = __builtin_amdgcn_exp2f(S1[i] - ms); sum += S0[i] + S1[i]; } \
            l = l * alpha + sum; m = mn; \
            if (__builtin_amdgcn_ballot_w64(alpha != 1.0f) != 0ull) { _Pragma("unroll") for (int db = 0; db < 8; ++db) O[db] = O[db] * alpha; } \
            const fp8x8_t p8 = pack_fp8x8(S0[0], S0[1], S0[2], S0[3], S1[0], S1[1], S1[2], S1[3]);       \
            _Pragma("unroll") for (int db = 0; db < 8; ++db) O[db] = MFMA16F8(VF_[db], p8, O[db]); } while (0)
#pragma unroll 1
        for (int t = 0; t < te; t += 2) { SEL_STEP(t, kfA, vfA, vfB); SEL_STEP(t + 1, kfB, vfB, vfA); }
#undef SEL_STEP
        l += __shfl_xor(l, 16); l += __shfl_xor(l, 32);
        if (act) { const float gate = sigmoidf_(bf2f(GT[mrow * 256 + 48 + hd])); const float sc = l > 0.f ? gate / l : 0.f;
            bf16* o = (dry ? (bf16*)(ar + DUMMY_OFF) + ((size_t)F.gw * 16 + c16) * 128 : Ob + mrow * 6144 + hd * 128) + 4 * kq;
#pragma unroll
            for (int db = 0; db < 8; ++db) { u32x2* p = (u32x2*)(o + db * 16); const u32x2 prev = *p;
                u32x2 w; w.x = pk2(O[db][0] * sc + bflo(prev.x), O[db][1] * sc + bfhi(prev.x)); w.y = pk2(O[db][2] * sc + bflo(prev.y), O[db][3] * sc + bfhi(prev.y)); *p = w; } }
    }
}
DI void ph_nsa_win(const Frame& F, const int dry = 0) {
    unsigned char* ar = F.ws + WS_AR; const bf16* Q = (const bf16*)(ar + NA_Q); const bf16* KWF = (const bf16*)(ar + NA_KWF); const bf16* VWF = (const bf16*)(ar + NA_VWF); const bf16* GT = (const bf16*)(ar + NA_GT); bf16* Ob = (bf16*)(ar + NA_O);
    const int r = F.lane & 31, h = F.lane >> 5;
    for (int idb = blockIdx.x; idb < BPH * 48 * 16; idb += F.G) {
        const int qt0 = (((idb & 15) + (idb >> 8)) & 15) * 8, qt = qt0 + F.wave, bh = idb >> 4, hd = bh % 48, bl = bh / 48, g = hd / 12, bg = bl * 4 + g, tq = qt * 32 + r; const size_t mrow = (size_t)bl * SEQ + tq;
        bf16x8 qf[12];
#pragma unroll
        for (int s = 0; s < 12; ++s) qf[s] = *(const bf16x8*)(Q + mrow * 9216 + hd * 192 + 16 * s + 8 * h);
        const FragSrc src{KWF + (size_t)bg * 128 * 12 * 512, VWF + (size_t)bg * 128 * 8 * 512, 12}; const WinMK mk{tq, h};
        f32x16 O[4];
#pragma unroll
        for (int db = 0; db < 4; ++db)
#pragma unroll
            for (int i = 0; i < 16; ++i) O[db][i] = 0.f;
        float m = -INFINITY, l = 0.f;
        attn_run_sh<12, true>(F.lds, F.tid, F.lane, qf, O, m, l, qt0 >= 16 ? qt0 - 16 : 0, qt0 + 8, qt >= 16 ? qt - 16 : 0, qt + 1, src, mk);
        l += __shfl_xor(l, 32);
        const float gate = sigmoidf_(bf2f(GT[mrow * 256 + 96 + hd]));
        store_col<true>(dry ? (bf16*)(ar + DUMMY_OFF) + ((size_t)F.gw * 32 + r) * 128 : Ob + mrow * 6144 + hd * 128, O, l > 0.f ? gate / l : 0.f, h);
    }
}
#ifndef MK_ONE_LAUNCH
#define MK_ONE_LAUNCH 1
#endif
constexpr int NPH = 86;
struct Args { const float* in[58]; float* out; unsigned char* ws; int ph_lo, ph_hi; };
#ifndef PROBE_GEMM
#define PROBE_GEMM 0
#endif
#ifndef PROBE_PH
#define PROBE_PH 0
#endif
#define GEMM_AKOFF 0
#define GEMM_CALL(EpiT, Evar, Aptr, Bptr, Mv, Nv, Kv, ldav, ldbv, cidx) do { if (PROBE_GEMM) { const pg8::Gemm g0_{(const pg8::bf16_t*)(Aptr), (const pg8::bf16_t*)(Bptr), (Mv), (Nv), (Kv), (ldav), (ldbv), GEMM_AKOFF}; \
    pg8::StaticOrder S0_; S0_.init((Mv), (Nv), F.G, (cidx)); pg8::EpiDry E0_{(float*)(ar + DUMMY_OFF)}; pg8::gemm_phase<pg8::EpiDry, pg8::StaticOrder, true, true>((PG8_LAS unsigned char*)F.lds, g0_, S0_, E0_); __syncthreads(); } \
    const pg8::Gemm g_{(const pg8::bf16_t*)(Aptr), (const pg8::bf16_t*)(Bptr), (Mv), (Nv), (Kv), (ldav), (ldbv), GEMM_AKOFF}; \
    pg8::StaticOrder S_; S_.init((Mv), (Nv), F.G, (cidx)); pg8::gemm_phase<EpiT, pg8::StaticOrder, true, true>((PG8_LAS unsigned char*)F.lds, g_, S_, Evar); } while (0)
DI pg8::EpiBf16R epi1(bf16* base, int ldc) { pg8::EpiBf16R e; for (int s = 0; s < 8; ++s) { e.T.base[s] = base; e.T.ldc[s] = ldc; e.T.t0[s] = 0; e.T.gw[s] = 0; } e.T.nseg = 1; e.T.pad_ = 0; return e; }
#define PH_BEGIN if (ph >= lo && ph < hi) { Frame F; { unsigned long long w_ = (unsigned long long)args.ws; asm volatile("" : "+s"(w_)); F.ws = (unsigned char*)w_; F.ctl = (unsigned*)(F.ws + WS_CTL); } \
    F.lds = lds; F.tid = threadIdx.x; F.lane = F.tid & 63; F.wave = __builtin_amdgcn_readfirstlane(F.tid >> 6); F.G = gridDim.x; F.gw = blockIdx.x * NWAVES + F.wave; F.NGW = F.G * NWAVES; \
    float* out; { unsigned long long o_ = (unsigned long long)args.out; asm volatile("" : "+s"(o_)); out = (float*)o_; } \
    unsigned char* const ar = F.ws + WS_AR; bf16* const XN = (bf16*)(F.ws + WS_XN); bf16* const WB = (bf16*)(F.ws + WS_WMIX); bf16* const WUP = (bf16*)(F.ws + WS_WFFN); bf16* const WDN = WUP + (size_t)2 * DFF * DM; \
    const float* const res_mix = (ib == 2) ? args.in[0] : (const float*)out; (void)ar; (void)XN; (void)WB; (void)WUP; (void)WDN; (void)res_mix; (void)iff;
#define PH_END   if (ph + 1 < hi) { XcdBarrier b_; b_.bar = (unsigned*)F.ctl + CW_BAR; b_.x = xb_xcc_id(); b_.st = MISC + 8; xcd_barrier(b_); } } ++ph;
template <int LAYER> DI void run_cvt(const Args& args, LAS unsigned char* lds, volatile LAS unsigned* MISC, int& ph, const int lo, const int hi) {
    constexpr int ib = (LAYER == 0) ? 2 : (LAYER == 1) ? 17 : (LAYER == 2) ? 26 : 42;
    constexpr int iff = (LAYER == 0) ? 12 : (LAYER == 1) ? 21 : (LAYER == 2) ? 37 : 52;
    constexpr int kind = (LAYER == 1) ? 1 : (LAYER == 2) ? 2 : 0;
        PH_BEGIN
          for (int rep_ = 0; rep_ < (PROBE_PH == 11 ? 2 : 1); ++rep_) {
            if constexpr (kind == 0) ph_dsa_cvt(F, args.in[ib + 1], args.in[ib + 6], args.in[ib + 7], args.in[ib + 8], args.in[ib + 9]);
            else if constexpr (kind == 1) ph_fox_cvt(F, args.in[ib + 1], args.in[ib + 3]);
            else ph_nsa_cvt(F, args.in[ib + 1], args.in[ib + 2], args.in[ib + 3], args.in[ib + 4], args.in[ib + 5], args.in[ib + 6], args.in[ib + 7], args.in[ib + 8], args.in[ib + 9], args.in[ib + 10]);
            ph_cvt_ffn(F, args.in[iff + 1], args.in[iff + 4]); __syncthreads();
          }
        PH_END
}
template <int LAYER, int HALF> DI void run_half(const Args& args, LAS unsigned char* lds, volatile LAS unsigned* MISC, int& ph, const int lo, const int hi) {
    constexpr int ib = (LAYER == 0) ? 2 : (LAYER == 1) ? 17 : (LAYER == 2) ? 26 : 42;
    constexpr int iff = (LAYER == 0) ? 12 : (LAYER == 1) ? 21 : (LAYER == 2) ? 37 : 52;
    constexpr int kind = (LAYER == 1) ? 1 : (LAYER == 2) ? 2 : 0;
    constexpr int half = HALF;
            const int roff = half * MC;
            PH_BEGIN if (PROBE_PH == 9) { ph_rmsnorm(F, res_mix, roff, args.in[ib], XN); __syncthreads(); } ph_rmsnorm(F, res_mix, roff, args.in[ib], XN); PH_END
            if constexpr (kind == 0) {
                PH_BEGIN { pg8::EpiF32 E{(float*)(ar + DA_DIN), 1024}; GEMM_CALL(pg8::EpiF32, E, XN, WB + DW_W1, MC, 1024, DM, DM, DM, (int)blockIdx.x); } PH_END
                PH_BEGIN if (PROBE_PH == 10) { ph_dsa_post1(F, half, args.in[ib + 2], args.in[ib + 3], args.in[ib + 4], args.in[ib + 5]); __syncthreads(); } ph_dsa_post1(F, half, args.in[ib + 2], args.in[ib + 3], args.in[ib + 4], args.in[ib + 5]); PH_END
                PH_BEGIN { pg8::EpiBf16R E = epi1((bf16*)(ar + DA_QL), 8192); E.T.base[1] = (bf16*)(ar + DA_QPE); E.T.ldc[1] = 1536; E.T.t0[1] = 32; E.T.base[2] = (bf16*)(ar + DA_QIDX); E.T.ldc[2] = 2048; E.T.t0[2] = 38; E.T.nseg = 3;
                    GEMM_CALL(pg8::EpiBf16R, E, ar + DA_CQN, WB + DW_W2, MC, 11776, 512, 512, 512, (int)blockIdx.x); } PH_END
                PH_BEGIN ph_dsa_rope(F, half); PH_END
                PH_BEGIN if (PROBE_PH == 1) { ph_dsa_index(F, 1); __syncthreads(); } if (PROBE_PH == 7) { ph_dsa_index(F, 1, 1); __syncthreads(); } if (PROBE_PH == 8) { ph_dsa_index(F, 1, 2); __syncthreads(); } ph_dsa_index(F); PH_END
                PH_BEGIN if (PROBE_PH == 2) { ph_dsa_attn(F, 1); __syncthreads(); } ph_dsa_attn(F); PH_END
                PH_BEGIN {
                    pg8::EpiBf16R E = epi1((bf16*)(ar + DA_O2), 4096);
                    { const pg8::Gemm g_{(const pg8::bf16_t*)(ar + DA_QL), (const pg8::bf16_t*)(WB + DW_BD), MC, 4096, 512, 8192, 512, 512}; pg8::StaticOrder S_; S_.init(MC, 4096, F.G, (int)blockIdx.x);
                      pg8::gemm_phase<pg8::EpiBf16R, pg8::StaticOrder, true, true>((PG8_LAS unsigned char*)F.lds, g_, S_, E); } } PH_END
                PH_BEGIN { pg8::EpiRes E{res_mix, out, DM, roff}; GEMM_CALL(pg8::EpiRes, E, ar + DA_O2, WB + DW_WO, MC, DM, 4096, 4096, 4096, (int)blockIdx.x); } PH_END
            } else if constexpr (kind == 1) {
                PH_BEGIN { pg8::EpiBf16R E = epi1((bf16*)(ar + FA_Q), DM); E.T.base[1] = (bf16*)(ar + FA_K); E.T.ldc[1] = DM; E.T.t0[1] = 8; E.T.base[2] = (bf16*)(ar + FA_V); E.T.ldc[2] = DM; E.T.t0[2] = 16;
                    E.T.base[3] = (bf16*)(ar + FA_F); E.T.ldc[3] = 256; E.T.t0[3] = 24; E.T.nseg = 4;
                    GEMM_CALL(pg8::EpiBf16R, E, XN, WB + FW_IN, MC, 6400, DM, DM, DM, (int)blockIdx.x); } PH_END
                PH_BEGIN if (PROBE_PH == 10) { ph_fox_scan(F, args.in[ib + 2]); __syncthreads(); } ph_fox_scan(F, args.in[ib + 2]); PH_END
                PH_BEGIN if (PROBE_PH == 3) { ph_fox_attn(F, 1); __syncthreads(); } ph_fox_attn(F); PH_END
                PH_BEGIN { pg8::EpiRes E{res_mix, out, DM, roff}; GEMM_CALL(pg8::EpiRes, E, ar + FA_O, WB + FW_OUT, MC, DM, DM, DM, DM, (int)blockIdx.x); } PH_END
            } else {
                PH_BEGIN { pg8::EpiBf16R E = epi1((bf16*)(ar + NA_Q), 9216);
                    E.T.base[1] = (bf16*)(ar + NA_KC); E.T.ldc[1] = 192; E.T.t0[1] = 36; E.T.gw[1] = 192;
                    E.T.base[2] = (bf16*)(ar + NA_VC); E.T.ldc[2] = 128; E.T.t0[2] = 39; E.T.gw[2] = 128;
                    E.T.base[3] = (bf16*)(ar + NA_KSR); E.T.ldc[3] = 768; E.T.t0[3] = 41;
                    E.T.base[4] = (bf16*)(ar + NA_KWR); E.T.ldc[4] = 768; E.T.t0[4] = 44;
                    E.T.base[5] = (bf16*)(ar + NA_GT); E.T.ldc[5] = 256; E.T.t0[5] = 47;
                    E.T.base[6] = (bf16*)(ar + NA_VSR); E.T.ldc[6] = 512; E.T.t0[6] = 48;
                    E.T.base[7] = (bf16*)(ar + NA_VWR); E.T.ldc[7] = 512; E.T.t0[7] = 50; E.T.nseg = 8;
                    GEMM_CALL(pg8::EpiBf16R, E, XN, WB + NW_IN, MC, 13312, DM, DM, DM, (int)blockIdx.x); } PH_END
                PH_BEGIN ph_nsa_rope(F, half); PH_END
                PH_BEGIN {
                    const float* BIAS = (const float*)(args.ws + WS_MISC);
                    { pg8::EpiGelu E{(bf16*)(ar + NA_GK), 256, BIAS}; GEMM_CALL(pg8::EpiGelu, E, ar + NA_KC, WB + NW_W1K, 4096, 256, 6144, 3072, 6144, (int)blockIdx.x); }
                    { pg8::EpiGelu E{(bf16*)(ar + NA_GV), 256, BIAS + 256}; GEMM_CALL(pg8::EpiGelu, E, ar + NA_VC, WB + NW_W1V, 4096, 256, 4096, 2048, 4096, (int)((blockIdx.x + F.G - 16) % F.G)); }
                } PH_END
                PH_BEGIN {
                    { pg8::EpiBf16R E = epi1((bf16*)(ar + NA_KCMP), 12); E.T.gw[0] = -1; GEMM_CALL(pg8::EpiBf16R, E, ar + NA_GK, WB + NW_W2K, 4096, 256, 256, 256, 256, (int)blockIdx.x); }
                    { pg8::EpiBf16R E = epi1((bf16*)(ar + NA_VCT), 4); E.T.gw[0] = -2; GEMM_CALL(pg8::EpiBf16R, E, WB + NW_W2V, ar + NA_GV, 256, 4096, 256, 256, 256, (int)((blockIdx.x + F.G - 16) % F.G)); }
                } PH_END
                PH_BEGIN if (PROBE_PH == 4) { ph_nsa_cmp(F, 1); __syncthreads(); } ph_nsa_cmp(F); PH_END
                PH_BEGIN if (PROBE_PH == 5) { ph_nsa_sel(F, 1); __syncthreads(); } ph_nsa_sel(F); PH_END
                PH_BEGIN if (PROBE_PH == 6) { ph_nsa_win(F, 1); __syncthreads(); } ph_nsa_win(F); PH_END
                PH_BEGIN { pg8::EpiRes E{res_mix, out, DM, roff}; GEMM_CALL(pg8::EpiRes, E, ar + NA_O, WB + NW_OUT, MC, DM, 6144, 6144, 6144, (int)blockIdx.x); } PH_END
            }
}
template <int LAYER> DI void run_ffn(const Args& args, LAS unsigned char* lds, volatile LAS unsigned* MISC, int& ph, const int lo, const int hi) {
    constexpr int ib = (LAYER == 0) ? 2 : (LAYER == 1) ? 17 : (LAYER == 2) ? 26 : 42;
    constexpr int iff = (LAYER == 0) ? 12 : (LAYER == 1) ? 21 : (LAYER == 2) ? 37 : 52;
    PH_BEGIN ph_rmsnorm(F, out, 0, args.in[iff], (bf16*)(ar + 400 * MiB), MTOT); PH_END
    PH_BEGIN { pg8::EpiConvGlu E{(pg8::bf16_t*)ar, (float*)(ar + 352 * MiB), args.in[iff + 2], args.in[iff + 3], (PG8_LAS float*)(F.lds + LDSCTL_OFF + 256), DFF};
        GEMM_CALL(pg8::EpiConvGlu, E, ar + 400 * MiB, WUP, MTOT, 2 * DFF, DM, DM, DM, (int)blockIdx.x); } PH_END
    PH_BEGIN ph_conv_fix(F, (const float*)(ar + 352 * MiB), (bf16*)ar, args.in[iff + 2], args.in[iff + 3], MTOT); PH_END
    PH_BEGIN { pg8::EpiRes E{out, out, DM, 0}; GEMM_CALL(pg8::EpiRes, E, ar, WDN, MTOT, DM, DFF, DFF, DFF, (int)blockIdx.x); } PH_END
}
__global__ void __launch_bounds__(NWAVES * 64, 2) mk_fwd(Args args) {
    extern __shared__ __attribute__((aligned(16))) unsigned char lds_[];
    LAS unsigned char* const lds = (LAS unsigned char*)lds_;
    volatile LAS unsigned* MISC = (volatile LAS unsigned*)(lds + LDSCTL_OFF);
    for (int u = threadIdx.x; u < 64; u += NWAVES * 64) ((LAS unsigned*)(lds + LDSCTL_OFF))[u] = 0u;
    __syncthreads();
    const int lo = args.ph_lo, hi = args.ph_hi;
    (void)xcd_barrier_post((unsigned*)(args.ws + WS_CTL) + CW_BAR, MISC + 8);
    int ph = 0;
    { constexpr int ib = 2, iff = 12; PH_BEGIN ph_tables(F, (const int*)args.in[1]); PH_END }
    run_cvt<0>(args, lds, MISC, ph, lo, hi); run_half<0, 0>(args, lds, MISC, ph, lo, hi); run_half<0, 1>(args, lds, MISC, ph, lo, hi); run_ffn<0>(args, lds, MISC, ph, lo, hi);
    run_cvt<1>(args, lds, MISC, ph, lo, hi); run_half<1, 0>(args, lds, MISC, ph, lo, hi); run_half<1, 1>(args, lds, MISC, ph, lo, hi); run_ffn<1>(args, lds, MISC, ph, lo, hi);
    run_cvt<2>(args, lds, MISC, ph, lo, hi); run_half<2, 0>(args, lds, MISC, ph, lo, hi); run_half<2, 1>(args, lds, MISC, ph, lo, hi); run_ffn<2>(args, lds, MISC, ph, lo, hi);
    run_cvt<3>(args, lds, MISC, ph, lo, hi); run_half<3, 0>(args, lds, MISC, ph, lo, hi); run_half<3, 1>(args, lds, MISC, ph, lo, hi); run_ffn<3>(args, lds, MISC, ph, lo, hi);
    { constexpr int ib = 42, iff = 52; PH_BEGIN ph_final_norm(F, out, args.in[57]); PH_END }
}
extern "C" void kernel_launch(void* const* d_in, const int* in_sizes, int n_in, void* d_out, int out_size, void* d_ws, size_t ws_size, hipStream_t stream) {
    static int grid = 0;
    if (grid == 0) {
        if (n_in != 58 || out_size != MTOT * DM || ws_size < WS_END) { fprintf(stderr, "kernel_launch: unexpected shapes (n_in %d, out %d, ws %zu)\n", n_in, out_size, ws_size); grid = -1; return; }
        int dev = 0, cus = 0;
        if (hipGetDevice(&dev) != hipSuccess || hipDeviceGetAttribute(&cus, hipDeviceAttributeMultiprocessorCount, dev) != hipSuccess) { grid = -1; return; }
        if (hipFuncSetAttribute((const void*)mk_fwd, hipFuncAttributeMaxDynamicSharedMemorySize, LDS_BYTES) != hipSuccess) { fprintf(stderr, "kernel_launch: hipFuncSetAttribute failed\n"); grid = -1; return; }
        int per_cu = 0;
        (void)hipOccupancyMaxActiveBlocksPerMultiprocessor(&per_cu, (const void*)mk_fwd, NWAVES * 64, LDS_BYTES);
        (void)hipGetLastError();
        grid = cus;
    }
    if (grid < 0) return;
    if (hipMemsetAsync((char*)d_ws + WS_CTL, 0, CTL_ZERO_BYTES, stream) != hipSuccess) return;
    Args a{};
    for (int i = 0; i < 58; ++i) a.in[i] = (const float*)d_in[i];
    a.out = (float*)d_out; a.ws = (unsigned char*)d_ws;
#if MK_ONE_LAUNCH
    a.ph_lo = 0; a.ph_hi = NPH;
    hipLaunchKernelGGL(mk_fwd, dim3(grid), dim3(NWAVES * 64), LDS_BYTES, stream, a);
#else
    for (int p = 0; p < NPH; ++p) { a.ph_lo = p; a.ph_hi = p + 1; hipLaunchKernelGGL(mk_fwd, dim3(grid), dim3(NWAVES * 64), LDS_BYTES, stream, a); }
#endif
}
```

```cpp
#include <hip/hip_runtime.h>
#include <cstdio>
#include <cstdint>
#define DI __device__ __forceinline__
namespace pg8 {
#define PG8_LAS __attribute__((address_space(3)))
typedef unsigned short bf16_t;
typedef short bf16x8 __attribute__((ext_vector_type(8)));
typedef float f32x4 __attribute__((ext_vector_type(4)));
typedef unsigned u32x4 __attribute__((ext_vector_type(4)));
constexpr int BM = 256, BK = 64, HALF = 128, HTB = HALF * BK * 2  , STAGE_BYTES = 8 * HTB, NXCD = 8, WGM = 8;

__host__ __device__ __forceinline__ int lds_byte(int r, int c) { const int st = (r >> 4) * 2 + (c >> 5), rr = r & 15, cc = c & 31, ob = rr * 64 + cc * 2; return st * 1024 + (ob ^ (((ob >> 9) & 1) << 5)); }
__host__ __device__ __forceinline__ void stage_rc(int b, int& R, int& C) { const int st = b / 1024, sb = b % 1024, swz = sb ^ (((sb >> 9) & 1) << 5); R = (st >> 1) * 16 + swz / 64; C = (st & 1) * 32 + (swz % 64) / 2; }
__host__ __device__ __forceinline__ int perm32(int rho) { const int n = rho >> 4, i = rho & 15; return 8 * (i >> 2) + 4 * n + (i & 3); }

struct Unit { int pm, pn; };
struct Gemm { const bf16_t* A; const bf16_t* Bt; int M, N, K, lda, ldb, akoff; };

struct StaticOrder {
    int nM, nN, nwg, G, c;
    __host__ __device__ void init(int M, int N, int G_, int c_) { nM = M / BM; nN = N / BM; nwg = nM * nN; G = G_; c = c_; }
    __host__ __device__ bool next(int i, Unit& u) const {
        const long L = (long)i * G + c; if (L >= nwg) return false;
        int wgid = (int)L; { const int q = nwg / NXCD, r = nwg % NXCD, xcd = wgid % NXCD, off = wgid / NXCD; wgid = (xcd < r ? xcd * (q + 1) : r * (q + 1) + (xcd - r) * q) + off; }
        const int nig = WGM * nN, gid = wgid / nig, fm = gid * WGM, gsz = (nM - fm) < WGM ? (nM - fm) : WGM;
        u.pm = fm + ((wgid % nig) % gsz); u.pn = (wgid % nig) / gsz; return true;
    }
    __device__ __forceinline__ void a_ready(const Unit&) const {}
    __device__ __forceinline__ void done(const Unit&) const {}
};
__device__ __forceinline__ unsigned cvt_pk_bf16(float lo, float hi) { unsigned r; asm volatile("v_cvt_pk_bf16_f32 %0, %1, %2" : "=v"(r) : "v"(lo), "v"(hi)); return r; }
template <class Epi, class Sched, bool ALIGN_EPI = false, bool SP2 = false>
__device__ __forceinline__ void gemm_phase(PG8_LAS unsigned char* lds, const Gemm g, const Sched& S, const Epi& E) {
    const int tid = threadIdx.x, wid = __builtin_amdgcn_readfirstlane(tid >> 6), lane = tid & 63, wr = wid >> 2, wc = wid & 3, fr = lane & 15, fq = lane >> 4;
    const int K = g.K, nt = K / BK;
    unsigned voffA[2], voffB[2];
#pragma unroll
    for (int i = 0; i < 2; ++i) { int R, C; stage_rc(tid * 16 + i * 8192, R, C); const int Rb = Epi::PERM ? ((R & ~31) + perm32(R & 31)) : R;
        voffA[i] = (unsigned)(R * g.lda + C) * 2u; voffB[i] = (unsigned)(Rb * g.ldb + C) * 2u; }
    const size_t kstep = (size_t)(BK * 2);
    const size_t hstepA = (size_t)HALF * g.lda * 2, hstepB = (size_t)HALF * g.ldb * 2;
    const size_t tstepA = 2 * hstepA, tstepB = 2 * hstepB;
    const unsigned ldsw = (unsigned)wid * 1024u;
    const int aoff = lds_byte(wr * 64 + fr, fq * 8), boff = lds_byte(wc * 32 + fr, fq * 8);
#define PG8_SA(b, h) (((b) * 2 + (h)) * HTB)
#define PG8_SB(b, h) ((4 + (b) * 2 + (h)) * HTB)
#define PG8_STAGE(bufoff, gbase, voff) do { _Pragma("unroll") for (int _i = 0; _i < 2; ++_i) \
        __builtin_amdgcn_global_load_lds((const unsigned*)((const char*)(gbase) + (voff)[_i]), (PG8_LAS unsigned*)(lds + (bufoff) + ldsw + _i * 8192), 16, 0, 0); } while (0)
#define PG8_LDA(dst, b, h) do { _Pragma("unroll") for (int m = 0; m < 4; ++m) _Pragma("unroll") for (int k = 0; k < 2; ++k) dst[m][k] = *(const PG8_LAS bf16x8*)(lds + PG8_SA(b, h) + aoff + m * 2048 + k * 1024); } while (0)
#define PG8_LDB(dst, b, h) do { _Pragma("unroll") for (int n = 0; n < 2; ++n) _Pragma("unroll") for (int k = 0; k < 2; ++k) dst[n][k] = *(const PG8_LAS bf16x8*)(lds + PG8_SB(b, h) + boff + n * 2048 + k * 1024); } while (0)
#define PG8_MMA(ai, bj, At, Bt) do { __builtin_amdgcn_s_setprio(1); _Pragma("unroll") for (int m = 0; m < 4; ++m) _Pragma("unroll") for (int n = 0; n < 2; ++n) _Pragma("unroll") for (int k = 0; k < 2; ++k) \
        acc[ai][bj][m][n] = __builtin_amdgcn_mfma_f32_16x16x32_bf16(Bt[n][k], At[m][k], acc[ai][bj][m][n], 0, 0, 0); __builtin_amdgcn_s_setprio(0); } while (0)
#define PG8_WAIT_V(n) asm volatile("s_waitcnt vmcnt(" #n ")" ::: "memory")
#define PG8_WAIT_L(n) asm volatile("s_waitcnt lgkmcnt(" #n ")" ::: "memory")
#define PG8_BAR __builtin_amdgcn_s_barrier()
#define PG8_SCHED __builtin_amdgcn_sched_barrier(0)
    Unit cur, nxt; int ui = 0;
    if (!S.next(0, cur)) return;
    f32x4 acc[2][2][4][2];
#pragma unroll
    for (int a = 0; a < 2; ++a)
#pragma unroll
        for (int b = 0; b < 2; ++b)
#pragma unroll
            for (int m = 0; m < 4; ++m)
#pragma unroll
                for (int n = 0; n < 2; ++n) acc[a][b][m][n] = (f32x4){0.f, 0.f, 0.f, 0.f};
    bf16x8 At[4][2], B0[2][2], B1[2][2];
    const char* cA = (const char*)g.A + (size_t)cur.pm * tstepA + (size_t)cur.pn * g.akoff * 2; const char* cB = (const char*)g.Bt + (size_t)cur.pn * tstepB;
    S.a_ready(cur);
    if constexpr (SP2) {
        PG8_STAGE(PG8_SB(0, 0), cB, voffB); PG8_STAGE(PG8_SB(0, 1), cB + hstepB, voffB); PG8_STAGE(PG8_SA(0, 0), cA, voffA); PG8_STAGE(PG8_SA(0, 1), cA + hstepA, voffA);
        if (wr == 1) PG8_BAR;
        PG8_WAIT_V(2); PG8_BAR;
        PG8_STAGE(PG8_SB(1, 0), cB + kstep, voffB); PG8_STAGE(PG8_SA(1, 0), cA + kstep, voffA); PG8_STAGE(PG8_SB(1, 1), cB + hstepB + kstep, voffB);
        PG8_WAIT_V(6); PG8_BAR;
    } else {
        PG8_STAGE(PG8_SB(0, 0), cB, voffB); PG8_STAGE(PG8_SA(0, 0), cA, voffA); PG8_STAGE(PG8_SB(0, 1), cB + hstepB, voffB); PG8_STAGE(PG8_SA(0, 1), cA + hstepA, voffA);
        if (wr == 1) PG8_BAR;
        PG8_WAIT_V(4); PG8_BAR;
        PG8_STAGE(PG8_SB(1, 0), cB + kstep, voffB); PG8_STAGE(PG8_SA(1, 0), cA + kstep, voffA); PG8_STAGE(PG8_SB(1, 1), cB + hstepB + kstep, voffB);
        PG8_WAIT_V(6); PG8_BAR;
    }
    for (;;) {
        const bool has_next = S.next(ui + 1, nxt);
        const char* nA = has_next ? (const char*)g.A + (size_t)nxt.pm * tstepA + (size_t)nxt.pn * g.akoff * 2 : cA; const char* nB = has_next ? (const char*)g.Bt + (size_t)nxt.pn * tstepB : cB;
        for (int t = 0; t < nt; t += 2) {
            const bool last = (t == nt - 2);
            const char* a1 = cA + (size_t)(t + 1) * kstep;
            const char* a2 = last ? nA : cA + (size_t)(t + 2) * kstep; const char* b2 = last ? nB : cB + (size_t)(t + 2) * kstep;
            const char* a3 = a2 + kstep; const char* b3 = b2 + kstep;
            if (last && has_next) S.a_ready(nxt);
            if constexpr (SP2) {
            PG8_LDB(B0, 0, 0); PG8_LDB(B1, 0, 1); PG8_SCHED; PG8_LDA(At, 0, 0); PG8_STAGE(PG8_SA(1, 1), a1 + hstepA, voffA);
            PG8_WAIT_V(8); PG8_WAIT_L(0); PG8_BAR; PG8_MMA(0, 0, At, B0); PG8_MMA(0, 1, At, B1); PG8_BAR; PG8_SCHED;
            PG8_LDA(At, 0, 1); PG8_STAGE(PG8_SB(0, 0), b2, voffB); PG8_STAGE(PG8_SB(0, 1), b2 + hstepB, voffB); PG8_STAGE(PG8_SA(0, 0), a2, voffA);
            PG8_WAIT_V(8); PG8_WAIT_L(0); PG8_BAR; PG8_MMA(1, 0, At, B0); PG8_MMA(1, 1, At, B1); PG8_BAR; PG8_SCHED;
            PG8_LDB(B0, 1, 0); PG8_LDB(B1, 1, 1); PG8_SCHED; PG8_LDA(At, 1, 0); PG8_STAGE(PG8_SA(0, 1), a2 + hstepA, voffA);
            PG8_WAIT_V(8); PG8_WAIT_L(0); PG8_BAR; PG8_MMA(0, 0, At, B0); PG8_MMA(0, 1, At, B1); PG8_BAR; PG8_SCHED;
            PG8_LDA(At, 1, 1); PG8_STAGE(PG8_SB(1, 0), b3, voffB); PG8_STAGE(PG8_SB(1, 1), b3 + hstepB, voffB); PG8_STAGE(PG8_SA(1, 0), a3, voffA);
            PG8_WAIT_V(8); PG8_WAIT_L(0); PG8_BAR; PG8_MMA(1, 0, At, B0); PG8_MMA(1, 1, At, B1); PG8_BAR; PG8_SCHED;
            } else {
            PG8_LDB(B0, 0, 0); PG8_SCHED; PG8_LDA(At, 0, 0); PG8_STAGE(PG8_SA(1, 1), a1 + hstepA, voffA);
            PG8_WAIT_L(8); PG8_BAR; PG8_WAIT_L(0); PG8_MMA(0, 0, At, B0); PG8_BAR; PG8_SCHED;
            PG8_LDB(B1, 0, 1); PG8_STAGE(PG8_SB(0, 0), b2, voffB);
            PG8_BAR; PG8_WAIT_L(0); PG8_MMA(0, 1, At, B1); PG8_BAR;
            PG8_LDA(At, 0, 1); PG8_STAGE(PG8_SA(0, 0), a2, voffA);
            PG8_BAR; PG8_WAIT_L(0); PG8_MMA(1, 0, At, B0); PG8_BAR; PG8_SCHED;
            PG8_STAGE(PG8_SB(0, 1), b2 + hstepB, voffB);
            PG8_WAIT_V(6); PG8_BAR; PG8_MMA(1, 1, At, B1); PG8_BAR;
            PG8_LDB(B0, 1, 0); PG8_SCHED; PG8_LDA(At, 1, 0); PG8_STAGE(PG8_SA(0, 1), a2 + hstepA, voffA);
            PG8_WAIT_L(8); PG8_BAR; PG8_WAIT_L(0); PG8_MMA(0, 0, At, B0); PG8_BAR; PG8_SCHED;
            PG8_LDB(B1, 1, 1); PG8_STAGE(PG8_SB(1, 0), b3, voffB);
            PG8_BAR; PG8_WAIT_L(0); PG8_MMA(0, 1, At, B1); PG8_BAR;
            PG8_LDA(At, 1, 1); PG8_STAGE(PG8_SA(1, 0), a3, voffA);
            PG8_BAR; PG8_WAIT_L(0); PG8_MMA(1, 0, At, B0); PG8_BAR; PG8_SCHED;
            PG8_STAGE(PG8_SB(1, 1), b3 + hstepB, voffB);
            PG8_WAIT_V(6); PG8_BAR; PG8_MMA(1, 1, At, B1); PG8_BAR;
            }
        }
        if constexpr (ALIGN_EPI) { if (wr == 0) PG8_BAR; }
        if constexpr (!Epi::AFTER_DRAIN) { E(acc, cur, wr, wc, fr, fq); S.done(cur); }
        if (!has_next) break;
#pragma unroll
        for (int a = 0; a < 2; ++a)
#pragma unroll
            for (int b = 0; b < 2; ++b)
#pragma unroll
                for (int m = 0; m < 4; ++m)
#pragma unroll
                    for (int n = 0; n < 2; ++n) acc[a][b][m][n] = (f32x4){0.f, 0.f, 0.f, 0.f};
        cur = nxt; cA = nA; cB = nB; ++ui;
        if constexpr (ALIGN_EPI) { if (wr == 1) PG8_BAR; }
    }
    PG8_WAIT_V(0);
    if constexpr (!ALIGN_EPI) { if (wr == 0) PG8_BAR; }
    PG8_BAR;
    if constexpr (Epi::AFTER_DRAIN) { E.fused(acc, cur, wr, wc, fr, fq, lds, wid, lane); S.done(cur); }
#undef PG8_SA
#undef PG8_SB
#undef PG8_STAGE
#undef PG8_LDA
#undef PG8_LDB
#undef PG8_MMA
#undef PG8_WAIT_V
#undef PG8_WAIT_L
#undef PG8_BAR
#undef PG8_SCHED
}
}
namespace pg8 {
typedef float f32x2 __attribute__((ext_vector_type(2)));
__device__ __forceinline__ float rms_rowscale(const float* ssq, int row) { const f32x4 a = *(const f32x4*)(ssq + (size_t)row * 8), b = *(const f32x4*)(ssq + (size_t)row * 8 + 4);
    return __builtin_amdgcn_rsqf((((a[0] + a[1]) + (a[2] + a[3])) + ((b[0] + b[1]) + (b[2] + b[3]))) * (1.0f / 2048.0f) + 1e-6f); }
struct SegTab { bf16_t* base[8]; int ldc[8]; int t0[8]; int gw[8]; int nseg; int pad_; };
struct EpiBf16R {
    static constexpr bool PERM = true, AFTER_DRAIN = false;
    SegTab T; const float* ssp; int ss_off;
    __device__ __forceinline__ void operator()(const f32x4 (&acc)[2][2][4][2], const Unit& u, int wr, int wc, int fr, int fq) const {
        bf16_t* base = T.base[0]; int ldc = T.ldc[0], gw = T.gw[0], t0 = T.t0[0];
#pragma unroll
        for (int s = 1; s < 8; ++s) if (s < T.nseg && u.pn >= T.t0[s]) { base = T.base[s]; ldc = T.ldc[s]; gw = T.gw[s]; t0 = T.t0[s]; }
        const int colt = (u.pn - t0) * BM, row0 = u.pm * BM + wr * 64 + fr;
#pragma unroll
        for (int ai = 0; ai < 2; ++ai)
#pragma unroll
            for (int m = 0; m < 4; ++m) { const int row = row0 + ai * HALF + m * 16;
                const float rs = ssp ? rms_rowscale(ssp, ss_off + row) : 1.0f;
#pragma unroll
                for (int bj = 0; bj < 2; ++bj) { const int col = colt + bj * HALF + wc * 32 + 8 * fq;
                    const f32x4 v0 = acc[ai][bj][m][0] * rs, v1 = acc[ai][bj][m][1] * rs;
                    u32x4 w; w.x = cvt_pk_bf16(v0[0], v0[1]); w.y = cvt_pk_bf16(v0[2], v0[3]); w.z = cvt_pk_bf16(v1[0], v1[1]); w.w = cvt_pk_bf16(v1[2], v1[3]);
                    if (gw == -2) {
                        if ((row >> 5) < ldc) { bf16_t* d0 = base + ((size_t)(((col >> 5) * ldc + (row >> 5)) * 2 + ((col >> 4) & 1)) * 64 + (row & 31)) * 8 + 4 * ((col >> 3) & 1);
                            typedef unsigned u32x2_ __attribute__((ext_vector_type(2)));
                            *(u32x2_*)d0 = (u32x2_){w.x, w.y}; *(u32x2_*)(d0 + 32 * 8) = (u32x2_){w.z, w.w}; }
                        continue; }
                    bf16_t* dst;
                    if (gw == 0) dst = base + (size_t)row * ldc + col;
                    else if (gw == -1) { if ((col >> 4) >= ldc) continue; dst = base + ((size_t)((row >> 5) * ldc + (col >> 4)) * 64 + ((col >> 3) & 1) * 32 + (row & 31)) * 8; }
                    else { const int g = col / gw, d = col - g * gw; dst = base + ((size_t)((row >> 12) * 4 + g) * 4096 + (row & 4095)) * gw + d; }
                    *(u32x4*)dst = w; } }
    }
};
struct EpiGelu {
    static constexpr bool PERM = true, AFTER_DRAIN = false;
    bf16_t* O; int ldc; const float* bias;
    static __device__ __forceinline__ float gelu(float x) { const float u2 = 1.5957691216f * (x + 0.044715f * x * x * x); const float e = __builtin_amdgcn_exp2f(-u2 * 1.4426950409f); return x * __builtin_amdgcn_rcpf(1.0f + e); }
    __device__ __forceinline__ void operator()(const f32x4 (&acc)[2][2][4][2], const Unit& u, int wr, int wc, int fr, int fq) const {
        const int row0 = u.pm * BM + wr * 64 + fr, col0 = u.pn * BM + wc * 32 + 8 * fq;
#pragma unroll
        for (int bj = 0; bj < 2; ++bj) { const f32x4 b0 = *(const f32x4*)(bias + col0 + bj * HALF), b1 = *(const f32x4*)(bias + col0 + bj * HALF + 4);
#pragma unroll
            for (int ai = 0; ai < 2; ++ai)
#pragma unroll
                for (int m = 0; m < 4; ++m) { const f32x4 v0 = acc[ai][bj][m][0] + b0, v1 = acc[ai][bj][m][1] + b1;
                    u32x4 w; w.x = cvt_pk_bf16(gelu(v0[0]), gelu(v0[1])); w.y = cvt_pk_bf16(gelu(v0[2]), gelu(v0[3])); w.z = cvt_pk_bf16(gelu(v1[0]), gelu(v1[1])); w.w = cvt_pk_bf16(gelu(v1[2]), gelu(v1[3]));
                    *(u32x4*)(O + (size_t)(row0 + ai * HALF + m * 16) * ldc + col0 + bj * HALF) = w; } }
    }
};
struct EpiF32 {
    static constexpr bool PERM = false, AFTER_DRAIN = false;
    float* C; int ldc; const float* ssp; int ss_off;
    __device__ __forceinline__ void operator()(const f32x4 (&acc)[2][2][4][2], const Unit& u, int wr, int wc, int fr, int fq) const {
        const int row0 = u.pm * BM + wr * 64 + fr, col0 = u.pn * BM + wc * 32 + 4 * fq;
#pragma unroll
        for (int ai = 0; ai < 2; ++ai)
#pragma unroll
            for (int m = 0; m < 4; ++m) { float* rowp = C + (size_t)(row0 + ai * HALF + m * 16) * ldc + col0;
                const float rs = ssp ? rms_rowscale(ssp, ss_off + row0 + ai * HALF + m * 16) : 1.0f;
#pragma unroll
                for (int bj = 0; bj < 2; ++bj)
#pragma unroll
                    for (int n = 0; n < 2; ++n) *(f32x4*)(rowp + bj * HALF + n * 16) = acc[ai][bj][m][n] * rs; }
    }
};
struct EpiRes {
    static constexpr bool PERM = false, AFTER_DRAIN = false;
    const float* res; float* out; int ldc; int row_off;
    __device__ __forceinline__ void operator()(const f32x4 (&acc)[2][2][4][2], const Unit& u, int wr, int wc, int fr, int fq) const {
        const int row0 = row_off + u.pm * BM + wr * 64 + fr, col0 = u.pn * BM + wc * 32 + 4 * fq;
#pragma unroll
        for (int ai = 0; ai < 2; ++ai)
#pragma unroll
            for (int m = 0; m < 4; ++m) { const size_t off = (size_t)(row0 + ai * HALF + m * 16) * ldc + col0;
                f32x4 r[2][2];
#pragma unroll
                for (int bj = 0; bj < 2; ++bj)
#pragma unroll
                    for (int n = 0; n < 2; ++n) r[bj][n] = *(const f32x4*)(res + off + bj * HALF + n * 16);
#pragma unroll
                for (int bj = 0; bj < 2; ++bj)
#pragma unroll
                    for (int n = 0; n < 2; ++n) *(f32x4*)(out + off + bj * HALF + n * 16) = r[bj][n] + acc[ai][bj][m][n];
                asm volatile("" ::: "memory"); }
    }
};
struct EpiDry {
    static constexpr bool PERM = false, AFTER_DRAIN = false;
    float* D;
    __device__ __forceinline__ void operator()(const f32x4 (&acc)[2][2][4][2], const Unit& u, int wr, int wc, int fr, int fq) const {
        float* p = D + ((size_t)blockIdx.x * 512 + threadIdx.x) * 64;
#pragma unroll
        for (int ai = 0; ai < 2; ++ai)
#pragma unroll
            for (int m = 0; m < 4; ++m)
#pragma unroll
                for (int bj = 0; bj < 2; ++bj) *(f32x4*)(p + ((ai * 4 + m) * 2 + bj) * 4) = acc[ai][bj][m][0] + acc[ai][bj][m][1];
    }
};
struct EpiResN {
    static constexpr bool PERM = false, AFTER_DRAIN = false;
    const float* res; float* out; int ldc; int row_off; const float* g; bf16_t* xn; float* ss; PG8_LAS float* xb;
    __device__ __forceinline__ void operator()(const f32x4 (&acc)[2][2][4][2], const Unit& u, int wr, int wc, int fr, int fq) const {
        typedef unsigned u32x2_ __attribute__((ext_vector_type(2)));
        const int row0 = row_off + u.pm * BM + wr * 64 + fr, col0 = u.pn * BM + wc * 32 + 4 * fq;
        f32x4 gv[2][2];
#pragma unroll
        for (int bj = 0; bj < 2; ++bj)
#pragma unroll
            for (int n = 0; n < 2; ++n) gv[bj][n] = *(const f32x4*)(g + col0 + bj * HALF + n * 16);
#pragma unroll
        for (int ai = 0; ai < 2; ++ai)
#pragma unroll
            for (int m = 0; m < 4; ++m) { const int row = row0 + ai * HALF + m * 16; const size_t off = (size_t)row * ldc + col0;
                f32x4 r[2][2]; float sq = 0.f;
#pragma unroll
                for (int bj = 0; bj < 2; ++bj)
#pragma unroll
                    for (int n = 0; n < 2; ++n) r[bj][n] = *(const f32x4*)(res + off + bj * HALF + n * 16);
#pragma unroll
                for (int bj = 0; bj < 2; ++bj)
#pragma unroll
                    for (int n = 0; n < 2; ++n) { const f32x4 o = r[bj][n] + acc[ai][bj][m][n]; *(f32x4*)(out + off + bj * HALF + n * 16) = o;
                        sq += (o[0] * o[0] + o[1] * o[1]) + (o[2] * o[2] + o[3] * o[3]);
                        const f32x4 y = o * gv[bj][n]; *(u32x2_*)(xn + off + bj * HALF + n * 16) = (u32x2_){cvt_pk_bf16(y[0], y[1]), cvt_pk_bf16(y[2], y[3])}; }
                sq += __shfl_xor(sq, 16); sq += __shfl_xor(sq, 32);
                if (fq == 0) xb[(ai * HALF + wr * 64 + m * 16 + fr) * 4 + wc] = sq;
                asm volatile("" ::: "memory"); }
        asm volatile("s_waitcnt lgkmcnt(0)" ::: "memory"); __builtin_amdgcn_s_barrier(); asm volatile("" ::: "memory");
        const int t = (wr * 4 + wc) * 64 + fq * 16 + fr;
        if (t < BM) { const f32x4 v = *(const PG8_LAS f32x4*)(xb + t * 4); ss[(size_t)(row_off + u.pm * BM + t) * 8 + u.pn] = (v[0] + v[1]) + (v[2] + v[3]); }
    }
};
struct EpiConvGlu {
    static constexpr bool PERM = true, AFTER_DRAIN = false;
    bf16_t* G; float* UB; const float* cw; const float* cb; PG8_LAS float* xb; int dff; const PG8_LAS float* rstd; int rbase;
    static __device__ __forceinline__ float shr(float old, float src, int n) { const int o = __builtin_bit_cast(int, old), s = __builtin_bit_cast(int, src);
        return __builtin_bit_cast(float, n == 1 ? __builtin_amdgcn_update_dpp(o, s, 0x111, 0xf, 0xf, false) : __builtin_amdgcn_update_dpp(o, s, 0x112, 0xf, 0xf, false)); }
    static __device__ __forceinline__ float ror(float src, int n) { const int s = __builtin_bit_cast(int, src);
        return __builtin_bit_cast(float, n == 1 ? __builtin_amdgcn_update_dpp(0, s, 0x121, 0xf, 0xf, false) : __builtin_amdgcn_update_dpp(0, s, 0x122, 0xf, 0xf, false)); }
    __device__ __forceinline__ void operator()(f32x4 (&acc)[2][2][4][2], const Unit& u, int wr, int wc, int fr, int fq) const {
        typedef unsigned u32x2_ __attribute__((ext_vector_type(2)));
        if (rstd) {
#pragma unroll
            for (int ai = 0; ai < 2; ++ai)
#pragma unroll
                for (int m = 0; m < 4; ++m) { const float rs = rstd[u.pm * BM + ai * HALF + wr * 64 + m * 16 + fr - rbase];
#pragma unroll
                    for (int bj = 0; bj < 2; ++bj)
#pragma unroll
                        for (int n = 0; n < 2; ++n) acc[ai][bj][m][n] = acc[ai][bj][m][n] * rs; }
        }
        if (fr >= 14) {
#pragma unroll
            for (int ai = 0; ai < 2; ++ai)
#pragma unroll
                for (int bj = 0; bj < 2; ++bj)
#pragma unroll
                    for (int n = 0; n < 2; ++n) *(PG8_LAS f32x4*)(xb + (((((ai * 2 + wr) * 4 + wc) * 2 + (fr - 14)) * 4 + fq) * 16) + (bj * 2 + n) * 4) = acc[ai][bj][3][n];
        }
        { const int ncol = 4 * dff / 2;
          const bool top = (wr == 0 && fr < 2), bot = (wr == 1 && fr >= 14);
          if (top || bot) { float* ub = UB + ((size_t)(u.pm * 4 + (top ? fr : 2 + fr - 14)) * ncol) + u.pn * BM + wc * 32 + 8 * fq;
#pragma unroll
            for (int bj = 0; bj < 2; ++bj)
#pragma unroll
                for (int n = 0; n < 2; ++n) *(f32x4*)(ub + bj * HALF + 4 * n) = top ? acc[0][bj][0][n] : acc[1][bj][3][n]; } }
        asm volatile("s_waitcnt lgkmcnt(0)" ::: "memory"); __builtin_amdgcn_s_barrier(); asm volatile("" ::: "memory");
        u32x2_ res[2][4][2];
        const int ch0 = u.pn * HALF + wc * 32 + 8 * fq;
#pragma unroll
        for (int n = 0; n < 2; ++n) {
            const float* wp = cw + ch0 + 4 * n; const float* bp = cb + ch0 + 4 * n;
            const f32x4 w0g = *(const f32x4*)(wp), w1g = *(const f32x4*)(wp + 2 * dff), w2g = *(const f32x4*)(wp + 4 * dff), bg = *(const f32x4*)(bp);
            const f32x4 w0v = *(const f32x4*)(wp + dff), w1v = *(const f32x4*)(wp + 3 * dff), w2v = *(const f32x4*)(wp + 5 * dff), bv = *(const f32x4*)(bp + dff);
#pragma unroll
            for (int ai = 0; ai < 2; ++ai)
#pragma unroll
                for (int m = 0; m < 4; ++m) {
                    const f32x4 cg = acc[ai][0][m][n], cv = acc[ai][1][m][n];
                    f32x4 b1g, b2g, b1v, b2v;
                    if (m > 0) {
#pragma unroll
                        for (int e = 0; e < 4; ++e) { b1g[e] = ror(acc[ai][0][m - 1][n][e], 1); b2g[e] = ror(acc[ai][0][m - 1][n][e], 2); b1v[e] = ror(acc[ai][1][m - 1][n][e], 1); b2v[e] = ror(acc[ai][1][m - 1][n][e], 2); }
                    } else {
                        const int sai = wr ? ai : ai - 1, swr = wr ? 0 : 1;
                        f32x4 x14g = {0.f, 0.f, 0.f, 0.f}, x15g = x14g, x14v = x14g, x15v = x14g;
                        if (sai >= 0) { const PG8_LAS float* xp = xb + (((((sai * 2 + swr) * 4 + wc) * 2) * 4 + fq) * 16);
                            x14g = *(const PG8_LAS f32x4*)(xp + n * 4); x14v = *(const PG8_LAS f32x4*)(xp + (2 + n) * 4); x15g = *(const PG8_LAS f32x4*)(xp + 64 + n * 4); x15v = *(const PG8_LAS f32x4*)(xp + 64 + (2 + n) * 4); }
                        b1g = x15g; b1v = x15v; b2g = fr == 0 ? x14g : x15g; b2v = fr == 0 ? x14v : x15v;
                    }
                    float o[4];
#pragma unroll
                    for (int e = 0; e < 4; ++e) {
                        const float p1g = shr(b1g[e], cg[e], 1), p2g = shr(b2g[e], cg[e], 2), p1v = shr(b1v[e], cv[e], 1), p2v = shr(b2v[e], cv[e], 2);
                        const float yg = bg[e] + w0g[e] * p2g + w1g[e] * p1g + w2g[e] * cg[e], yv = bv[e] + w0v[e] * p2v + w1v[e] * p1v + w2v[e] * cv[e];
                        o[e] = yg * __builtin_amdgcn_rcpf(1.0f + __builtin_amdgcn_exp2f(-yg * 1.4426950409f)) * yv;
                    }
                    res[ai][m][n] = (u32x2_){cvt_pk_bf16(o[0], o[1]), cvt_pk_bf16(o[2], o[3])};
                }
        }
        const int row0 = u.pm * BM + wr * 64 + fr;
#pragma unroll
        for (int ai = 0; ai < 2; ++ai)
#pragma unroll
            for (int m = 0; m < 4; ++m) *(u32x4*)(G + (size_t)(row0 + ai * HALF + m * 16) * dff + ch0) = (u32x4){res[ai][m][0].x, res[ai][m][0].y, res[ai][m][1].x, res[ai][m][1].y};
    }
};
}
constexpr int BATCH = 8, SEQ = 4096, DM = 2048, MTOT = BATCH * SEQ, MC = MTOT / 2  , BPH = BATCH / 2;
constexpr int DFF = 5632;
constexpr float NORM_EPS = 1e-6f, LOG2E = 1.4426950408889634f;
constexpr int NWAVES = 8;
constexpr size_t MiB = 1u << 20;
constexpr size_t WS_CTL = 0, CTL_ZERO_BYTES = 1 * MiB;
constexpr size_t WS_TAB = 1 * MiB;
constexpr size_t TAB_COS48 = WS_TAB, TAB_SIN48 = WS_TAB + 3 * MiB, TAB_COS32 = WS_TAB + 6 * MiB, TAB_SIN32 = WS_TAB + 8 * MiB;
constexpr size_t WS_WMIX = 12 * MiB;
constexpr size_t WS_WFFN = 100 * MiB;
constexpr size_t WS_MISC = 168 * MiB;
constexpr size_t WS_SS = 170 * MiB;
constexpr size_t WS_XN = 180 * MiB;
constexpr size_t WS_XNR = 1010 * MiB;
constexpr size_t WS_AR = 234 * MiB;
constexpr size_t WS_END = 1138 * MiB;
constexpr size_t DUMMY_OFF = 0;
constexpr int CW_TMO = 0;
constexpr int CW_BAR = 4096;
constexpr int RING_BYTES = 131072;
constexpr int LDSCTL_OFF = 135168;
constexpr int LDS_BYTES = 163840;

#define GAS __attribute__((address_space(1)))
#define LAS __attribute__((address_space(3)))
typedef unsigned short bf16;
typedef unsigned u32x4 __attribute__((ext_vector_type(4)));
typedef unsigned u32x2 __attribute__((ext_vector_type(2)));
typedef float f32x4 __attribute__((ext_vector_type(4)));
typedef float f32x16 __attribute__((ext_vector_type(16)));
typedef short bf16x8 __attribute__((ext_vector_type(8)));
typedef short s16x4 __attribute__((ext_vector_type(4)));
typedef short v4i16_t __attribute__((ext_vector_type(4)));
typedef __bf16 bf16x2_t __attribute__((ext_vector_type(2)));
typedef float f32x2_t __attribute__((ext_vector_type(2)));
#define LDS_WAIT() asm volatile("s_waitcnt lgkmcnt(0)" ::: "memory")
#define VM_WAIT() asm volatile("s_waitcnt vmcnt(0)" ::: "memory")
#define MFMA32(a, b, c) __builtin_amdgcn_mfma_f32_32x32x16_bf16((a), (b), (c), 0, 0, 0)
DI unsigned pk2(float lo, float hi) { f32x2_t v = {lo, hi}; bf16x2_t b = __builtin_convertvector(v, bf16x2_t); return __builtin_bit_cast(unsigned, b); }
DI float bf2f(unsigned short b) { return __builtin_bit_cast(float, (unsigned)b << 16); }
DI float bflo(unsigned w) { return __builtin_bit_cast(float, w << 16); }
DI float bfhi(unsigned w) { return __builtin_bit_cast(float, w & 0xffff0000u); }
DI unsigned short f2bf(float f) { return (unsigned short)(pk2(f, 0.f) & 0xffffu); }
DI float wave_sum(float v) {
#pragma unroll
    for (int o = 1; o < 64; o <<= 1) v += __shfl_xor(v, o);
    return v;
}
DI int crow(int i, int h) { return (i & 3) + 8 * (i >> 2) + 4 * h; }
#define XB_TMO      128
#define XB_XCNT(j)  (256  + 64 * (j))
#define XB_XSUB(j)  (1280 + 64 * (j))
#define XB_XGEN(j)  (2304 + 64 * (j))
#define XB_TOP      3328
#define XB_TOPGEN   3392
#define XCD_BAR_WORDS 3456
#define XB_SPIN_CAP (1u << 18)

__device__ __forceinline__ unsigned xb_ld(unsigned* p)              { return __hip_atomic_load(p, __ATOMIC_RELAXED, __HIP_MEMORY_SCOPE_AGENT); }
__device__ __forceinline__ unsigned xb_add(unsigned* p, unsigned v) { return __hip_atomic_fetch_add(p, v, __ATOMIC_RELAXED, __HIP_MEMORY_SCOPE_AGENT); }
__device__ __forceinline__ unsigned xb_xcc_id() { return (unsigned)__builtin_amdgcn_s_getreg((3 << 11) | 20) & 0xFu; }
#define XB_SPIN(cond, bar) do { unsigned _sp = 0; while (cond) { __builtin_amdgcn_s_sleep(1); \
    if ((++_sp & 255u) == 0u) { if (xb_ld(&(bar)[XB_TMO])) break; if (_sp > XB_SPIN_CAP) { atomicAdd(&(bar)[XB_TMO], 1u); break; } } } } while (0)

struct XcdBarrier {
    unsigned* bar; unsigned x;
    volatile LAS unsigned* st;
};

__device__ __forceinline__ XcdBarrier xcd_barrier_post(unsigned* bar, volatile LAS unsigned* st) {
    XcdBarrier b; b.bar = bar; b.x = xb_xcc_id(); b.st = st;
    if (threadIdx.x == 0) (void)xb_add(&bar[XB_XCNT(b.x)], 1u);
    return b;
}
__device__ __forceinline__ void xcd_barrier_complete(unsigned* bar, unsigned x, unsigned& nloc, unsigned& nx) {
    const unsigned G = gridDim.x * gridDim.y * gridDim.z;
    unsigned sum, cnt, mine, sp = 0u;
    for (;;) {
        sum = 0u; cnt = 0u; mine = 0u;
#pragma unroll
        for (unsigned j = 0; j < 16; ++j) { const unsigned c = xb_ld(&bar[XB_XCNT(j)]); sum += c; cnt += (c > 0u) ? 1u : 0u; mine = (j == x) ? c : mine; }
        if (sum == G) break;
        __builtin_amdgcn_s_sleep(1);
        if ((++sp & 255u) == 0u) { if (xb_ld(&bar[XB_TMO])) break; if (sp > XB_SPIN_CAP) { atomicAdd(&bar[XB_TMO], 1u); break; } }
    }
    nloc = mine > 0u ? mine : 1u; nx = cnt > 0u ? cnt : 1u;
}

__device__ __forceinline__ void xcd_barrier(const XcdBarrier& b) {
    asm volatile("s_waitcnt vmcnt(0)" ::: "memory");
    __syncthreads();
    if (threadIdx.x == 0) {
        unsigned* bar = b.bar;
        __builtin_amdgcn_s_waitcnt(0);
        unsigned nloc = b.st[0], nx = b.st[1];
        if (nloc == 0u) { xcd_barrier_complete(bar, b.x, nloc, nx); b.st[0] = nloc; b.st[1] = nx; }
        const unsigned old = xb_add(&bar[XB_XSUB(b.x)], 1u);
        const unsigned gen = old / nloc;
        if (old + 1u == (gen + 1u) * nloc) {
            __builtin_amdgcn_fence(__ATOMIC_RELEASE, "agent");
            asm volatile("s_waitcnt vmcnt(0)" ::: "memory");
            const unsigned og = xb_add(&bar[XB_TOP], 1u);
            const unsigned tg = og / nx;
            if (og + 1u == (tg + 1u) * nx) xb_add(&bar[XB_TOPGEN], 1u);
            else XB_SPIN(xb_ld(&bar[XB_TOPGEN]) == tg, bar);
            __builtin_amdgcn_fence(__ATOMIC_ACQUIRE, "agent");
            xb_add(&bar[XB_XGEN(b.x)], 1u);
            asm volatile("s_waitcnt vmcnt(0)" ::: "memory");
        } else {
            XB_SPIN(xb_ld(&bar[XB_XGEN(b.x)]) == gen, bar);
            __builtin_amdgcn_fence(__ATOMIC_ACQUIRE, "agent");
            asm volatile("s_waitcnt vmcnt(0)" ::: "memory");
        }
    }
    __syncthreads();
}
struct Frame {
    LAS unsigned char* lds; unsigned* ctl; unsigned char* ws;
    int tid, lane, wave, G, gw, NGW;
};
DI void ph_tables(const Frame& F, const int* pos) {
    float* c48 = (float*)(F.ws + TAB_COS48); float* s48 = (float*)(F.ws + TAB_SIN48); float* c32 = (float*)(F.ws + TAB_COS32); float* s32 = (float*)(F.ws + TAB_SIN32);
    const int gt = blockIdx.x * (NWAVES * 64) + F.tid, NT = F.G * NWAVES * 64;
    for (int i = gt; i < MTOT * 40; i += NT) {
        const int m = i / 40, j = i - m * 40; const float p = (float)pos[m];
        const bool a = j < 24; const int jj = a ? j : j - 24;
        const float inv = (float)exp(-(2.0 * jj / (a ? 48.0 : 32.0)) * 13.122363377404328);
        const float ang = p * inv; float sn, cs; sincosf(ang, &sn, &cs);
        if (a) { c48[m * 24 + jj] = cs; s48[m * 24 + jj] = sn; } else { c32[m * 16 + jj] = cs; s32[m * 16 + jj] = sn; }
    }
}
DI void cvt_load(float (&v)[32], const float* W, int ldw, int col0, int ncols, int item, int nblk, int lane) {
    const int kb = item / nblk, nb = item - kb * nblk, k0 = 64 * kb, n0 = 32 * nb, nn = n0 + (lane & 31); const bool ok = nn < ncols;
    const float* p = W + (size_t)(k0 + (lane >> 5)) * ldw + col0 + (ok ? nn : 0);
#pragma unroll
    for (int i = 0; i < 32; ++i) { const float x = p[(size_t)(2 * i) * ldw]; v[i] = ok ? x : 0.f; }
}
DI void cvt_store(const float (&v)[32], int ncols, bf16* WT, int ldt, int row_off, float scale, LAS float* scr, int item, int nblk, int lane) {
    const int kb = item / nblk, nb = item - kb * nblk, k0 = 64 * kb, n0 = 32 * nb;
#pragma unroll
    for (int i = 0; i < 32; ++i) scr[(2 * i + (lane >> 5)) * 33 + (lane & 31)] = v[i] * scale;
    LDS_WAIT();
    const int c = lane & 7;
#pragma unroll
    for (int j = 0; j < 4; ++j) { const int n = (lane >> 3) + 8 * j; const LAS float* s = scr + (8 * c) * 33 + n;
        u32x4 o; o.x = pk2(s[0 * 33], s[1 * 33]); o.y = pk2(s[2 * 33], s[3 * 33]); o.z = pk2(s[4 * 33], s[5 * 33]); o.w = pk2(s[6 * 33], s[7 * 33]);
        if (n0 + n < ncols) *(u32x4*)(WT + (size_t)(row_off + n0 + n) * ldt + k0 + 8 * c) = o; }
    LDS_WAIT();
}
DI void cvt_item(const float* W, int ldw, int col0, int ncols, bf16* WT, int ldt, int row_off, float scale, LAS float* scr, int item, int nblk, int lane) {
    float v[32]; cvt_load(v, W, ldw, col0, ncols, item, nblk, lane); cvt_store(v, ncols, WT, ldt, row_off, scale, scr, item, nblk, lane);
}
template <class MAP> DI void cvt_loop(const Frame& F, const float* W, int ldw, int ncols, bf16* WT, int ldt, float scale, int nitems, int nblk, const MAP& map) {
    LAS float* scr = (LAS float*)(F.lds + F.wave * 16384);
    int it = F.gw; float cur[32]; int c0 = 0, ro = 0, li = 0;
    if (it < nitems) { map(it, c0, ro, li); cvt_load(cur, W, ldw, c0, ncols, li, nblk, F.lane); }
#pragma unroll 1
    for (; it < nitems; it += F.NGW) {
        float nxt[32]; int c1 = 0, r1 = 0, l1 = 0; const int ni = it + F.NGW;
        if (ni < nitems) { map(ni, c1, r1, l1); cvt_load(nxt, W, ldw, c1, ncols, l1, nblk, F.lane); }
        cvt_store(cur, ncols, WT, ldt, ro, scale, scr, li, nblk, F.lane);
#pragma unroll
        for (int i = 0; i < 32; ++i) cur[i] = nxt[i];
        c0 = c1; ro = r1; li = l1;
    }
}
struct CvtPlain { int col0, row_off; DI void operator()(int it, int& c, int& r, int& l) const { c = col0; r = row_off; l = it; } };
DI void cvt_job(const Frame& F, const float* W, int ldw, int K, int col0, int ncols, bf16* WT, int ldt, int row_off, float scale) {
    const int nblk = (ncols + 31) / 32;
    cvt_loop(F, W, ldw, ncols, WT, ldt, scale, (K / 64) * nblk, nblk, CvtPlain{col0, row_off});
}
DI void zero_bf16(const Frame& F, bf16* p, size_t nelem) {
    const size_t gt = (size_t)blockIdx.x * (NWAVES * 64) + F.tid, NT = (size_t)F.G * NWAVES * 64;
    for (size_t i = gt; i < nelem / 8; i += NT) ((u32x4*)p)[i] = (u32x4){0u, 0u, 0u, 0u};
}
DI void ph_cvt_ffn(const Frame& F, const float* up, const float* down) {
    bf16* WUP = (bf16*)(F.ws + WS_WFFN); bf16* WDN = WUP + (size_t)2 * DFF * DM;
    struct UpMap { DI void operator()(int it, int& c, int& r, int& l) const { const int seg = it >> 7, pn = seg >> 1, isv = seg & 1; c = isv * DFF + pn * 128; r = pn * 256 + isv * 128; l = it & 127; } };
    cvt_loop(F, up, 2 * DFF, 128, WUP, DM, 1.f, 88 * 128, 4, UpMap{});
    cvt_job(F, down, DM, DFF, 0, DM, WDN, DFF, 0, 1.f);
}
DI void ph_conv_fix(const Frame& F, const float* UB, bf16* Gb, const float* cw, const float* cb, const int nrows = MC) {
    const int gt = blockIdx.x * (NWAVES * 64) + F.tid, NT = F.G * NWAVES * 64;
    for (int it = gt; it < (nrows / 256) * (DFF / 4); it += NT) {
        const int pm = it / (DFF / 4), c4 = it - pm * (DFF / 4), ch = c4 * 4, col = (ch >> 7) * 256 + (ch & 127);
        const float* ub = UB + (size_t)pm * 4 * (2 * DFF) + col; const bool has = (pm & 15) != 0;
        const f32x4 z = {0.f, 0.f, 0.f, 0.f};
        const f32x4 g0 = *(const f32x4*)(ub), g1 = *(const f32x4*)(ub + 2 * DFF), v0 = *(const f32x4*)(ub + 128), v1 = *(const f32x4*)(ub + 2 * DFF + 128);
        const f32x4 gm2 = has ? *(const f32x4*)(ub - 2 * (2 * DFF)) : z, gm1 = has ? *(const f32x4*)(ub - (2 * DFF)) : z, vm2 = has ? *(const f32x4*)(ub - 2 * (2 * DFF) + 128) : z, vm1 = has ? *(const f32x4*)(ub - (2 * DFF) + 128) : z;
        const f32x4 w0g = *(const f32x4*)(cw + ch), w1g = *(const f32x4*)(cw + 2 * DFF + ch), w2g = *(const f32x4*)(cw + 4 * DFF + ch), bg = *(const f32x4*)(cb + ch);
        const f32x4 w0v = *(const f32x4*)(cw + DFF + ch), w1v = *(const f32x4*)(cw + 3 * DFF + ch), w2v = *(const f32x4*)(cw + 5 * DFF + ch), bv = *(const f32x4*)(cb + DFF + ch);
        float o0[4], o1[4];
#pragma unroll
        for (int e = 0; e < 4; ++e) {
            const float yg0 = bg[e] + w0g[e] * gm2[e] + w1g[e] * gm1[e] + w2g[e] * g0[e], yv0 = bv[e] + w0v[e] * vm2[e] + w1v[e] * vm1[e] + w2v[e] * v0[e];
            const float yg1 = bg[e] + w0g[e] * gm1[e] + w1g[e] * g0[e] + w2g[e] * g1[e], yv1 = bv[e] + w0v[e] * vm1[e] + w1v[e] * v0[e] + w2v[e] * v1[e];
            o0[e] = yg0 * __builtin_amdgcn_rcpf(1.0f + __builtin_amdgcn_exp2f(-yg0 * LOG2E)) * yv0; o1[e] = yg1 * __builtin_amdgcn_rcpf(1.0f + __builtin_amdgcn_exp2f(-yg1 * LOG2E)) * yv1;
        }
        u32x2 a, b; a.x = pk2(o0[0], o0[1]); a.y = pk2(o0[2], o0[3]); b.x = pk2(o1[0], o1[1]); b.y = pk2(o1[2], o1[3]);
        *(u32x2*)(Gb + (size_t)(pm * 256) * DFF + ch) = a; *(u32x2*)(Gb + (size_t)(pm * 256 + 1) * DFF + ch) = b;
    }
}
DI void ph_rmsnorm(const Frame& F, const float* src, int row_off, const float* gain, bf16* XN, const int nrows = MC) {
    f32x4 g[8];
#pragma unroll
    for (int j = 0; j < 8; ++j) g[j] = *(const f32x4*)(gain + 4 * (F.lane + 64 * j));
    for (int ml = F.gw; ml < nrows; ml += F.NGW) {
        const f32x4* xr = (const f32x4*)(src + (size_t)(row_off + ml) * DM) + F.lane;
        f32x4 v[8]; float ss = 0.f;
#pragma unroll
        for (int j = 0; j < 8; ++j) { v[j] = xr[64 * j]; ss += (v[j].x * v[j].x + v[j].y * v[j].y) + (v[j].z * v[j].z + v[j].w * v[j].w); }
        const float rstd = 1.0f / sqrtf(wave_sum(ss) * (1.f / DM) + NORM_EPS);
        u32x2* o = (u32x2*)(XN + (size_t)ml * DM) + F.lane;
#pragma unroll
        for (int j = 0; j < 8; ++j) { const f32x4 y = v[j] * rstd * g[j]; u32x2 w; w.x = pk2(y.x, y.y); w.y = pk2(y.z, y.w); o[64 * j] = w; }
    }
}
DI void ph_norm_first(const Frame& F, const float* src, const float* gain, bf16* XNR, float* ss) {
    f32x4 g[8];
#pragma unroll
    for (int j = 0; j < 8; ++j) g[j] = *(const f32x4*)(gain + 4 * (F.lane + 64 * j));
    for (int m = F.gw; m < MTOT; m += F.NGW) {
        const f32x4* xr = (const f32x4*)(src + (size_t)m * DM) + F.lane;
        f32x4 v[8]; float s2 = 0.f;
#pragma unroll
        for (int j = 0; j < 8; ++j) { v[j] = xr[64 * j]; s2 += (v[j].x * v[j].x + v[j].y * v[j].y) + (v[j].z * v[j].z + v[j].w * v[j].w); }
        s2 = wave_sum(s2);
        if (F.lane < 2) *(f32x4*)(ss + (size_t)m * 8 + 4 * F.lane) = (f32x4){F.lane == 0 ? s2 : 0.f, 0.f, 0.f, 0.f};
        u32x2* o = (u32x2*)(XNR + (size_t)m * DM) + F.lane;
#pragma unroll
        for (int j = 0; j < 8; ++j) { const f32x4 y = v[j] * g[j]; u32x2 w; w.x = pk2(y.x, y.y); w.y = pk2(y.z, y.w); o[64 * j] = w; }
    }
}
DI void ph_final_norm(const Frame& F, float* h, const float* gain) {
    f32x4 g[8];
#pragma unroll
    for (int j = 0; j < 8; ++j) g[j] = *(const f32x4*)(gain + 4 * (F.lane + 64 * j));
    for (int m = F.gw; m < MTOT; m += F.NGW) {
        f32x4* xr = (f32x4*)(h + (size_t)m * DM) + F.lane;
        f32x4 v[8]; float ss = 0.f;
#pragma unroll
        for (int j = 0; j < 8; ++j) { v[j] = xr[64 * j]; ss += (v[j].x * v[j].x + v[j].y * v[j].y) + (v[j].z * v[j].z + v[j].w * v[j].w); }
        const float rstd = 1.0f / sqrtf(wave_sum(ss) * (1.f / DM) + NORM_EPS);
#pragma unroll
        for (int j = 0; j < 8; ++j) xr[64 * j] = v[j] * rstd * g[j];
    }
}
DI void ph_conv_glu(const Frame& F, const bf16* U, bf16* Gb, const float* cw, const float* cb) {
    constexpr int RC = 32, NCG = DFF / 8, NRC = MC / RC;
    const int gt = blockIdx.x * (NWAVES * 64) + F.tid, NT = F.G * NWAVES * 64;
    for (int it = gt; it < NCG * NRC; it += NT) {
        const int cg = it % NCG, rc = it / NCG, c0 = cg * 8, r0 = rc * RC;
        float w0g[8], w1g[8], w2g[8], bg[8], w0v[8], w1v[8], w2v[8], bv[8];
#pragma unroll
        for (int e = 0; e < 8; ++e) { w0g[e] = cw[c0 + e]; w1g[e] = cw[2 * DFF + c0 + e]; w2g[e] = cw[4 * DFF + c0 + e]; bg[e] = cb[c0 + e];
            w0v[e] = cw[DFF + c0 + e]; w1v[e] = cw[3 * DFF + c0 + e]; w2v[e] = cw[5 * DFF + c0 + e]; bv[e] = cb[DFF + c0 + e]; }
        float pg2[8], pg1[8], pv2[8], pv1[8];
        const bool has = (r0 & (SEQ - 1)) != 0;
        {
            u32x4 a = {0u, 0u, 0u, 0u}, b = a, c = a, d = a;
            if (has) { a = *(const u32x4*)(U + (size_t)(r0 - 2) * (2 * DFF) + c0); b = *(const u32x4*)(U + (size_t)(r0 - 1) * (2 * DFF) + c0);
                       c = *(const u32x4*)(U + (size_t)(r0 - 2) * (2 * DFF) + DFF + c0); d = *(const u32x4*)(U + (size_t)(r0 - 1) * (2 * DFF) + DFF + c0); }
#pragma unroll
            for (int e = 0; e < 4; ++e) { pg2[2 * e] = bflo(a[e]); pg2[2 * e + 1] = bfhi(a[e]); pg1[2 * e] = bflo(b[e]); pg1[2 * e + 1] = bfhi(b[e]);
                pv2[2 * e] = bflo(c[e]); pv2[2 * e + 1] = bfhi(c[e]); pv1[2 * e] = bflo(d[e]); pv1[2 * e + 1] = bfhi(d[e]); }
        }
        for (int r = 0; r < RC; ++r) {
            const u32x4 ug = *(const u32x4*)(U + (size_t)(r0 + r) * (2 * DFF) + c0), uv = *(const u32x4*)(U + (size_t)(r0 + r) * (2 * DFF) + DFF + c0);
            float cg_[8], cv_[8], o[8];
#pragma unroll
            for (int e = 0; e < 4; ++e) { cg_[2 * e] = bflo(ug[e]); cg_[2 * e + 1] = bfhi(ug[e]); cv_[2 * e] = bflo(uv[e]); cv_[2 * e + 1] = bfhi(uv[e]); }
#pragma unroll
            for (int e = 0; e < 8; ++e) {
                const float yg = bg[e] + w0g[e] * pg2[e] + w1g[e] * pg1[e] + w2g[e] * cg_[e];
                const float yv = bv[e] + w0v[e] * pv2[e] + w1v[e] * pv1[e] + w2v[e] * cv_[e];
                const float sg = yg * __builtin_amdgcn_rcpf(1.0f + __builtin_amdgcn_exp2f(-yg * LOG2E));
                o[e] = sg * yv; pg2[e] = pg1[e]; pg1[e] = cg_[e]; pv2[e] = pv1[e]; pv1[e] = cv_[e];
            }
            u32x4 w; w.x = pk2(o[0], o[1]); w.y = pk2(o[2], o[3]); w.z = pk2(o[4], o[5]); w.w = pk2(o[6], o[7]);
            *(u32x4*)(Gb + (size_t)(r0 + r) * DFF + c0) = w;
        }
    }
}
constexpr size_t DA_DIN = 0, DA_CQN = 64 * MiB, DA_LATC = 80 * MiB, DA_KPE = 88 * MiB, DA_KIDX = 90 * MiB, DA_WIDX = 94 * MiB, DA_QL = 96 * MiB, DA_QPE = 352 * MiB, DA_QIDX = 400 * MiB,
                 DA_SEL = 464 * MiB, DA_CNT = 472 * MiB, DA_SC = 474 * MiB, DA_O2 = 474 * MiB;
constexpr size_t DW_W1 = 0, DW_W2 = (size_t)1024 * 2048, DW_WO = DW_W2 + (size_t)11776 * 512, DW_BD = DW_WO + (size_t)2048 * 4096;
constexpr float DSA_QSCALE = 0.07216878364870322f * LOG2E;
constexpr float DSA_WIDX_SCALE = 0.25f * 0.08838834764831845f;

DI void ph_dsa_cvt(const Frame& F, const float* w_in, const float* w_qup, const float* w_uk, const float* w_uv, const float* w_out) {
    bf16* WB = (bf16*)(F.ws + WS_WMIX);
    cvt_job(F, w_in, 960, DM, 0, 960, WB + DW_W1, DM, 0, 1.f);
    zero_bf16(F, WB + DW_W1 + (size_t)960 * DM, (size_t)64 * DM);
    { LAS float* scr = (LAS float*)(F.lds + F.wave * 16384);
      for (int it = F.gw; it < 32 * 16; it += F.NGW) { const int h = it >> 4; cvt_item(w_qup, 8192, h * 192, 48, WB + DW_W2, 512, 8192 + h * 48, DSA_QSCALE, scr, it & 15, 2, F.lane); } }
    cvt_job(F, w_qup, 8192, 512, 6144, 2048, WB + DW_W2, 512, 9728, 1.f);
    __syncthreads();
    {
        LAS float* As = (LAS float*)F.lds; LAS float* Bs = As + 64 * 145;
        for (int u = blockIdx.x; u < 32 * 4 * 8; u += F.G) {
            const int h = u >> 5, r0 = ((u >> 3) & 3) * 64, k0 = (u & 7) * 64;
            for (int i = F.tid; i < 64 * 144; i += NWAVES * 64) { const int row = i / 144, col = i - row * 144;
                As[row * 145 + col] = w_uk[(size_t)(h * 256 + r0) * 144 + i]; Bs[row * 145 + col] = w_qup[(size_t)(k0 + row) * 8192 + h * 192 + 48 + col]; }
            __syncthreads();
            const int r = F.tid & 63, kg = F.tid >> 6; float acc[8];
#pragma unroll
            for (int j = 0; j < 8; ++j) acc[j] = 0.f;
            for (int n = 0; n < 144; ++n) { const float a = As[r * 145 + n];
#pragma unroll
                for (int j = 0; j < 8; ++j) acc[j] += a * Bs[(kg * 8 + j) * 145 + n]; }
            u32x4 o; o.x = pk2(acc[0] * DSA_QSCALE, acc[1] * DSA_QSCALE); o.y = pk2(acc[2] * DSA_QSCALE, acc[3] * DSA_QSCALE); o.z = pk2(acc[4] * DSA_QSCALE, acc[5] * DSA_QSCALE); o.w = pk2(acc[6] * DSA_QSCALE, acc[7] * DSA_QSCALE);
            *(u32x4*)(WB + DW_W2 + (size_t)(h * 256 + r0 + r) * 512 + k0 + kg * 8) = o;
            __syncthreads();
        }
    }
    { LAS float* scr = (LAS float*)(F.lds + F.wave * 16384);
      for (int it = F.gw; it < 32 * 16; it += F.NGW) { const int h = it >> 4; cvt_item(w_uv + (size_t)h * 256 * 128, 128, 0, 128, WB + DW_BD + (h & 1) * 256, 512, h * 128, 1.f, scr, it & 15, 4, F.lane); } }
    { const size_t gt = (size_t)blockIdx.x * (NWAVES * 64) + F.tid, NT = (size_t)F.G * NWAVES * 64;
      for (size_t i = gt; i < (size_t)4096 * 32; i += NT) { const int row = (int)(i >> 5), pc = (int)(i & 31); *(u32x4*)(WB + DW_BD + (size_t)row * 512 + (1 - ((row >> 7) & 1)) * 256 + pc * 8) = (u32x4){0u, 0u, 0u, 0u}; } }
    cvt_job(F, w_out, DM, 4096, 0, DM, WB + DW_WO, 4096, 0, 1.f);
}
DI void ph_dsa_post1(const Frame& F, int half, const float* qn, const float* kvn, const float* lng, const float* lnb) {
    unsigned char* ar = F.ws + WS_AR;
    const float* DIN = (const float*)(ar + DA_DIN); bf16* CQN = (bf16*)(ar + DA_CQN); bf16* LATC = (bf16*)(ar + DA_LATC); bf16* KPE = (bf16*)(ar + DA_KPE); bf16* KIDX = (bf16*)(ar + DA_KIDX); float* WIDX = (float*)(ar + DA_WIDX);
    const float* c48 = (const float*)(F.ws + TAB_COS48); const float* s48 = (const float*)(F.ws + TAB_SIN48); const float* c32 = (const float*)(F.ws + TAB_COS32); const float* s32 = (const float*)(F.ws + TAB_SIN32);
    LAS float* buf = (LAS float*)(F.lds + F.wave * 1024);
    const int lane = F.lane;
    for (int ml = F.gw; ml < MC; ml += F.NGW) {
        const int mg = half * MC + ml;
        const size_t kfb = ((size_t)(ml >> 5) * 8 * 64 + (ml & 31)) * 8;
        const float* row = DIN + (size_t)ml * 1024 + 16 * lane;
        f32x4 v[4]; float ss = 0.f, s1 = 0.f;
#pragma unroll
        for (int j = 0; j < 4; ++j) { v[j] = *(const f32x4*)(row + 4 * j); ss += (v[j].x * v[j].x + v[j].y * v[j].y) + (v[j].z * v[j].z + v[j].w * v[j].w); s1 += (v[j].x + v[j].y) + (v[j].z + v[j].w); }
        const bool isq = lane < 32, iskv = lane >= 32 && lane < 48, ispe = lane >= 48 && lane < 51, isix = lane >= 51 && lane < 59;
        const float ssq = wave_sum(isq ? ss : 0.f), sskv = wave_sum(iskv ? ss : 0.f), mean = wave_sum(isix ? s1 : 0.f) * (1.f / 128.f);
        float d2 = 0.f;
#pragma unroll
        for (int j = 0; j < 4; ++j) { const f32x4 d = v[j] - mean; d2 += (d.x * d.x + d.y * d.y) + (d.z * d.z + d.w * d.w); }
        const float var = wave_sum(isix ? d2 : 0.f) * (1.f / 128.f);
        const float rq = 1.0f / sqrtf(ssq * (1.f / 512.f) + NORM_EPS), rkv = 1.0f / sqrtf(sskv * (1.f / 256.f) + NORM_EPS), rstd = 1.0f / sqrtf(var + NORM_EPS);
        if (isq || iskv) {
            const float* gp = isq ? qn + 16 * lane : kvn + 16 * (lane - 32); const float rs = isq ? rq : rkv;
            bf16* dst = isq ? CQN + (size_t)ml * 512 + 16 * lane : LATC + (size_t)ml * 256 + 16 * (lane - 32);
            u32x4 o[2];
#pragma unroll
            for (int j = 0; j < 4; ++j) { const f32x4 g = *(const f32x4*)(gp + 4 * j); const f32x4 y = v[j] * rs * g; o[j >> 1][(j & 1) * 2] = pk2(y.x, y.y); o[j >> 1][(j & 1) * 2 + 1] = pk2(y.z, y.w); }
            *(u32x4*)dst = o[0]; *(u32x4*)(dst + 8) = o[1];
        } else if (ispe) {
#pragma unroll
            for (int j = 0; j < 4; ++j) *(LAS f32x4*)(buf + (lane - 48) * 16 + 4 * j) = v[j];
        } else if (isix) {
#pragma unroll
            for (int j = 0; j < 4; ++j) { const f32x4 g = *(const f32x4*)(lng + (lane - 51) * 16 + 4 * j), b = *(const f32x4*)(lnb + (lane - 51) * 16 + 4 * j); *(LAS f32x4*)(buf + 48 + (lane - 51) * 16 + 4 * j) = (v[j] - mean) * rstd * g + b; }
        } else if (lane == 59) {
#pragma unroll
            for (int j = 0; j < 4; ++j) *(f32x4*)(WIDX + (size_t)ml * 16 + 4 * j) = v[j] * DSA_WIDX_SCALE;
        }
        LDS_WAIT();
        if (lane < 24) { const float x1 = buf[lane], x2 = buf[24 + lane], c = c48[(size_t)mg * 24 + lane], s = s48[(size_t)mg * 24 + lane];
            KPE[(size_t)ml * 48 + lane] = f2bf(x1 * c - x2 * s); KPE[(size_t)ml * 48 + 24 + lane] = f2bf(x1 * s + x2 * c);
        } else if (lane < 40) { const int i = lane - 24; const float x1 = buf[48 + i], x2 = buf[48 + 16 + i], c = c32[(size_t)mg * 16 + i], s = s32[(size_t)mg * 16 + i];
            KIDX[kfb + (size_t)((i >> 3) * 32) * 8 + (i & 7)] = f2bf(x1 * c - x2 * s); KIDX[kfb + (size_t)(64 + (i >> 3) * 32) * 8 + (i & 7)] = f2bf(x1 * s + x2 * c);
        } else { const int d = 32 + 4 * (lane - 40); const f32x4 y = *(const LAS f32x4*)(buf + 48 + d); u32x2 w; w.x = pk2(y.x, y.y); w.y = pk2(y.z, y.w); *(u32x2*)(KIDX + kfb + (size_t)((d >> 4) * 64 + ((d >> 3) & 1) * 32) * 8 + (d & 7)) = w; }
        LDS_WAIT();
    }
}
DI void ph_dsa_rope(const Frame& F, int half) {
    unsigned char* ar = F.ws + WS_AR; bf16* QPE = (bf16*)(ar + DA_QPE); bf16* QIDX = (bf16*)(ar + DA_QIDX);
    const float* c48 = (const float*)(F.ws + TAB_COS48); const float* s48 = (const float*)(F.ws + TAB_SIN48); const float* c32 = (const float*)(F.ws + TAB_COS32); const float* s32 = (const float*)(F.ws + TAB_SIN32);
    for (int ml = F.gw; ml < MC; ml += F.NGW) {
        const size_t mg = (size_t)half * MC + ml;
        for (int p = F.lane; p < 768; p += 64) { const int hd = p / 24, i = p - hd * 24; bf16* q = QPE + (size_t)ml * 1536 + hd * 48 + i;
            const float x1 = bf2f(q[0]), x2 = bf2f(q[24]), c = c48[mg * 24 + i], s = s48[mg * 24 + i]; q[0] = f2bf(x1 * c - x2 * s); q[24] = f2bf(x1 * s + x2 * c); }
        for (int p = F.lane; p < 256; p += 64) { const int hd = p >> 4, i = p & 15; bf16* q = QIDX + (size_t)ml * 2048 + hd * 128 + i;
            const float x1 = bf2f(q[0]), x2 = bf2f(q[16]), c = c32[mg * 16 + i], s = s32[mg * 16 + i]; q[0] = f2bf(x1 * c - x2 * s); q[16] = f2bf(x1 * s + x2 * c); }
    }
}
DI int wave_iscan_dpp(int v) {
    v += __builtin_amdgcn_update_dpp(0, v, 0x111, 0xf, 0xf, true); v += __builtin_amdgcn_update_dpp(0, v, 0x112, 0xf, 0xf, true);
    v += __builtin_amdgcn_update_dpp(0, v, 0x114, 0xf, 0xf, true); v += __builtin_amdgcn_update_dpp(0, v, 0x118, 0xf, 0xf, true);
    v += __builtin_amdgcn_update_dpp(0, v, 0x142, 0xa, 0xf, false);
    v += __builtin_amdgcn_update_dpp(0, v, 0x143, 0xc, 0xf, false);
    return v;
}
DI int wave_isum_dpp(int v) {
    v += __builtin_amdgcn_update_dpp(0, v, 0x111, 0xf, 0xf, true); v += __builtin_amdgcn_update_dpp(0, v, 0x112, 0xf, 0xf, true);
    v += __builtin_amdgcn_update_dpp(0, v, 0x114, 0xf, 0xf, true); v += __builtin_amdgcn_update_dpp(0, v, 0x118, 0xf, 0xf, true);
    v += __builtin_amdgcn_update_dpp(0, v, 0x142, 0xa, 0xf, false);
    v += __builtin_amdgcn_update_dpp(0, v, 0x143, 0xc, 0xf, false);
    return __builtin_amdgcn_readlane(v, 63);
}
DI unsigned f2sortable(float s) { const unsigned b = __builtin_bit_cast(unsigned, s); return (b & 0x80000000u) ? ~b : (b | 0x80000000u); }
DI void ph_dsa_index(const Frame& F, const int dry = 0, const int parts = 3) {
    unsigned char* ar = F.ws + WS_AR;
    const bf16* QIDX = (const bf16*)(ar + DA_QIDX); const bf16* KIDX = (const bf16*)(ar + DA_KIDX); const float* WIDX = (const float*)(ar + DA_WIDX);
    unsigned short* SEL = (unsigned short*)(ar + DA_SEL); int* CNT = (int*)(ar + DA_CNT); float* SC = (float*)(ar + DA_SC) + (size_t)F.gw * 16384;
    const int lane = F.lane, r = lane & 31, hf = lane >> 5;
    LAS unsigned char* wl = F.lds + F.wave * 8192 + lane * 16;
    LAS unsigned* hist = (LAS unsigned*)(F.lds + 65536 + F.wave * 1024);
#pragma unroll 1
    for (int tile = blockIdx.x; tile < BPH * 128; tile += F.G) {
        const int j = tile >> 8, c8 = tile & 255, c7 = c8 & 127, bl = (c8 >> 7) * 2 + j, qt = j ? 127 - c7 : c7;
        const int q0 = qt * 32 + 4 * F.wave;
        const int ntile = (q0 + 3) / 32 + 1;
        bf16x8 qa[2][8];
#pragma unroll
        for (int pr = 0; pr < 2; ++pr) {
            const int mrow = bl * SEQ + q0 + 2 * pr + (r >> 4);
#pragma unroll
            for (int s = 0; s < 8; ++s) qa[pr][s] = *(const bf16x8*)(QIDX + (size_t)mrow * 2048 + (r & 15) * 128 + 16 * s + 8 * hf);
            float wv[2][16];
#pragma unroll
            for (int i = 0; i < 16; ++i) wv[pr][i] = WIDX[(size_t)(bl * SEQ + q0 + 2 * pr + (i >> 3)) * 16 + (i & 3) + 8 * ((i >> 2) & 1) + 4 * hf];
#pragma unroll
            for (int i = 0; i < 16; i += 4) *(LAS f32x4*)(wl + (pr * 4 + (i >> 2)) * 1024) = (f32x4){wv[pr][i], wv[pr][i + 1], wv[pr][i + 2], wv[pr][i + 3]};
        }
        LDS_WAIT();
        if (parts & 1) {
        bf16x8 kf[8];
        { const bf16* kp = KIDX + ((size_t)(bl * 128) * 8 * 64 + lane) * 8;
#pragma unroll
          for (int s = 0; s < 8; ++s) kf[s] = *(const bf16x8*)(kp + 512 * s); }
#pragma unroll 1
        for (int t = 0; t < ntile; ++t) {
            f32x16 accs[2];
#pragma unroll
            for (int pr = 0; pr < 2; ++pr) {
#pragma unroll
                for (int i = 0; i < 16; ++i) accs[pr][i] = 0.f;
#pragma unroll
                for (int s = 0; s < 8; ++s) accs[pr] = MFMA32(qa[pr][s], kf[s], accs[pr]);
            }
            if (t + 1 < ntile) { const bf16* kp = KIDX + ((size_t)(bl * 128 + t + 1) * 8 * 64 + lane) * 8;
#pragma unroll
                for (int s = 0; s < 8; ++s) kf[s] = *(const bf16x8*)(kp + 512 * s); }
#pragma unroll
            for (int pr = 0; pr < 2; ++pr) {
                const f32x16 acc = accs[pr];
                float wv[2][16];
                { unsigned wa_ = (unsigned)(size_t)wl; asm volatile("" : "+v"(wa_));
#pragma unroll
                  for (int i = 0; i < 16; i += 4) { const f32x4 w4 = *(const LAS f32x4*)((LAS unsigned char*)(size_t)wa_ + (pr * 4 + (i >> 2)) * 1024); wv[pr][i] = w4.x; wv[pr][i + 1] = w4.y; wv[pr][i + 2] = w4.z; wv[pr][i + 3] = w4.w; } }
                float p0 = 0.f, p1 = 0.f;
#pragma unroll
                for (int i = 0; i < 8; ++i) { p0 += wv[pr][i] * fmaxf(acc[i], 0.f); p1 += wv[pr][8 + i] * fmaxf(acc[8 + i], 0.f); }
                const float t0 = p0 + __shfl_xor(p0, 32), t1 = p1 + __shfl_xor(p1, 32);
                SC[(pr * 128 + t) * 64 + lane] = hf ? t1 : t0;
            }
        }
        }
        VM_WAIT();
        if (parts & 2)
#pragma unroll 1
        for (int qi = 0; qi < 4; ++qi) {
            const int tq = q0 + qi, pr = qi >> 1, qs = qi & 1;
            unsigned u[64];
            const unsigned* scp = (const unsigned*)(SC + pr * 8192 + hf * 64 + qs * 32 + r);
#pragma unroll
            for (int g8 = 0; g8 < 8; ++g8) {
#pragma unroll
                for (int e = 0; e < 8; ++e) { const int i = 8 * g8 + e; const float s = __builtin_bit_cast(float, __hip_atomic_load(scp + e * 128, __ATOMIC_RELAXED, __HIP_MEMORY_SCOPE_AGENT));
                    u[i] = (2 * i + hf < ntile && 64 * i + lane <= tq) ? f2sortable(s) : 0u; }
                scp += 1024; asm volatile("" : "+v"(scp));
            }
            unsigned prefix = 0u;
            if (tq >= 256) {
#pragma unroll 1
                for (int bit = 31; bit >= 0; --bit) {
                    const unsigned cand = prefix | (1u << bit); int c = 0;
#pragma unroll
                    for (int i = 0; i < 64; ++i) c += (u[i] >= cand) ? 1 : 0;
                    c = wave_isum_dpp(c);
                    if (c >= 256) prefix = cand;
                    if (c == 256) break;
                }
            }
            const unsigned T = prefix > 1u ? prefix : 1u;
            int nl = 0;
#pragma unroll
            for (int i = 0; i < 64; ++i) nl += (u[i] >= T) ? 1 : 0;
            const int inc = wave_iscan_dpp(nl), base = __builtin_amdgcn_readlane(inc, 63);
            int pos = inc - nl;
            unsigned short* sel = dry ? (unsigned short*)(ar + DUMMY_OFF) + (size_t)F.gw * 256 : SEL + (size_t)(bl * SEQ + tq) * 256;
#pragma unroll
            for (int i = 0; i < 64; ++i) { if (u[i] >= T) { if (pos < 256) sel[pos] = (unsigned short)(64 * i + lane); ++pos; } }
            if (lane == 0) (dry ? (int*)(ar + DUMMY_OFF + 32 * MiB) + F.gw : CNT + bl * SEQ + tq)[0] = base < 256 ? base : 256;
        }
    }
}
DI int dsa_fsw(int row) { return ((row & 3) << 2) | ((row >> 2) & 3); }
struct DsaPre { u32x4 row[16]; bf16x8 kpe[3]; bf16x8 q[3]; };
DI void dsa_prefetch(DsaPre& P, const bf16* LATC, const bf16* KPE, const bf16* QL, const bf16* QPE, int ml, int selv, int lane, int w) {
    const int bl = ml >> 12, r = lane & 31, h = lane >> 5;
#pragma unroll
    for (int it = 0; it < 16; ++it) { const int ki = __shfl(selv, (lane >> 5) + 2 * it); P.row[it] = *(const u32x4*)(LATC + (size_t)(bl * SEQ + ki) * 256 + (lane & 31) * 8); }
#pragma unroll
    for (int s = 0; s < 3; ++s) P.kpe[s] = *(const bf16x8*)(KPE + (size_t)(bl * SEQ + selv) * 48 + 16 * s + 8 * h);
#pragma unroll
    for (int j = 0; j < 3; ++j) { const int fi = w + 8 * j;
        if (fi < 16) P.q[j] = *(const bf16x8*)(QL + (size_t)ml * 8192 + r * 256 + 16 * fi + 8 * h);
        else if (fi < 19) P.q[j] = *(const bf16x8*)(QPE + (size_t)ml * 1536 + r * 48 + 16 * (fi - 16) + 8 * h); }
}
DI void ph_dsa_attn(const Frame& F, const int dry = 0) {
    unsigned char* ar = F.ws + WS_AR;
    bf16* QL = (bf16*)(ar + DA_QL); const bf16* QPE = (const bf16*)(ar + DA_QPE); const bf16* LATC = (const bf16*)(ar + DA_LATC); const bf16* KPE = (const bf16*)(ar + DA_KPE);
    const unsigned short* SEL = (const unsigned short*)(ar + DA_SEL); const int* CNT = (const int*)(ar + DA_CNT);
    const int lane = F.lane, r = lane & 31, h = lane >> 5, w = F.wave;
    LAS unsigned char* IMG = F.lds; LAS unsigned char* QB = F.lds + LDSCTL_OFF + 256; LAS float* MX = (LAS float*)(F.lds + LDSCTL_OFF + 256 + 19456); LAS float* SX = MX + 256;
    const int i16 = lane & 15, tq_ = i16 >> 2, tp_ = i16 & 3, blk = (lane >> 4) & 1;
    int ml = blockIdx.x;
    if (ml >= MC) return;
    DsaPre P;
    int cnt_c = CNT[ml];
    { const int slot = 32 * w + r; const int selv = slot < cnt_c ? (int)SEL[(size_t)ml * 256 + slot] : 0; dsa_prefetch(P, LATC, KPE, QL, QPE, ml, selv, lane, w); }
    int cnt_n = 0, selv_n = 0;
    if (ml + F.G < MC) { cnt_n = CNT[ml + F.G]; const int slot = 32 * w + r; selv_n = slot < cnt_n ? (int)SEL[(size_t)(ml + F.G) * 256 + slot] : 0; }
#pragma unroll 1
    for (; ml < MC; ml += F.G) {
        const int cnt = cnt_c, nch = (cnt + 31) >> 5; const bool act = w < nch;
#pragma unroll
        for (int it = 0; it < 16; ++it) { const int rr = (lane >> 5) + 2 * it; *(LAS u32x4*)(IMG + (32 * w + rr) * 512 + (((lane & 31) ^ dsa_fsw(rr)) * 16)) = P.row[it]; }
#pragma unroll
        for (int j = 0; j < 3; ++j) { const int fi = w + 8 * j; if (fi < 19) *(LAS bf16x8*)(QB + fi * 1024 + lane * 16) = P.q[j]; }
        bf16x8 kpe[3];
#pragma unroll
        for (int s = 0; s < 3; ++s) kpe[s] = P.kpe[s];
        LDS_WAIT(); __builtin_amdgcn_s_barrier(); asm volatile("" ::: "memory");
        if (ml + F.G < MC) {
            dsa_prefetch(P, LATC, KPE, QL, QPE, ml + F.G, selv_n, lane, w); cnt_c = cnt_n;
            if (ml + 2 * F.G < MC) { cnt_n = CNT[ml + 2 * F.G]; const int slot = 32 * w + r; selv_n = slot < cnt_n ? (int)SEL[(size_t)(ml + 2 * F.G) * 256 + slot] : 0; }
        }
        f32x16 S; float mx = -INFINITY;
#pragma unroll
        for (int i = 0; i < 16; ++i) S[i] = 0.f;
        if (act) {
#pragma unroll
            for (int s = 0; s < 16; ++s) S = MFMA32(*(const LAS bf16x8*)(IMG + (32 * w + r) * 512 + (((2 * s + h) ^ dsa_fsw(r)) * 16)), *(const LAS bf16x8*)(QB + s * 1024 + lane * 16), S);
#pragma unroll
            for (int s = 0; s < 3; ++s) S = MFMA32(kpe[s], *(const LAS bf16x8*)(QB + (16 + s) * 1024 + lane * 16), S);
#pragma unroll
            for (int i = 0; i < 16; ++i) { S[i] = (32 * w + crow(i, h) < cnt) ? S[i] : -INFINITY; mx = fmaxf(mx, S[i]); }
            mx = fmaxf(mx, __shfl_xor(mx, 32));
        }
        if (h == 0) MX[w * 32 + r] = mx;
        LDS_WAIT(); __builtin_amdgcn_s_barrier(); asm volatile("" ::: "memory");
        float M = MX[r];
#pragma unroll
        for (int k = 1; k < 8; ++k) M = fmaxf(M, MX[k * 32 + r]);
        float lsum = 0.f; bf16x8 pf[2] = {(bf16x8){0, 0, 0, 0, 0, 0, 0, 0}, (bf16x8){0, 0, 0, 0, 0, 0, 0, 0}};
        if (act) {
#pragma unroll
            for (int i = 0; i < 16; ++i) { S[i] = __builtin_amdgcn_exp2f(S[i] - M); lsum += S[i]; }
#pragma unroll
            for (int s = 0; s < 2; ++s) { u32x4 t; t.x = pk2(S[8 * s], S[8 * s + 1]); t.y = pk2(S[8 * s + 2], S[8 * s + 3]); t.z = pk2(S[8 * s + 4], S[8 * s + 5]); t.w = pk2(S[8 * s + 6], S[8 * s + 7]); pf[s] = __builtin_bit_cast(bf16x8, t); }
        }
        lsum += __shfl_xor(lsum, 32);
        if (h == 0) SX[w * 32 + r] = lsum;
        *(LAS bf16x8*)(QB + (2 * w) * 1024 + lane * 16) = pf[0]; *(LAS bf16x8*)(QB + (2 * w + 1) * 1024 + lane * 16) = pf[1];
        LDS_WAIT(); __builtin_amdgcn_s_barrier(); asm volatile("" ::: "memory");
        f32x16 O;
#pragma unroll
        for (int i = 0; i < 16; ++i) O[i] = 0.f;
#pragma unroll 2
        for (int ks = 0; ks < 2 * nch; ++ks) {
            const int r0 = 16 * ks + 4 * h + tq_, r1 = r0 + 8, pc = 4 * w + 2 * blk + (tp_ >> 1);
            const s16x4 lo = __builtin_bit_cast(s16x4, __builtin_amdgcn_ds_read_tr16_b64_v4i16((LAS v4i16_t*)(IMG + r0 * 512 + ((pc ^ dsa_fsw(r0)) * 16) + 8 * (tp_ & 1))));
            const s16x4 hi = __builtin_bit_cast(s16x4, __builtin_amdgcn_ds_read_tr16_b64_v4i16((LAS v4i16_t*)(IMG + r1 * 512 + ((pc ^ dsa_fsw(r1)) * 16) + 8 * (tp_ & 1))));
            O = MFMA32(__builtin_shufflevector(lo, hi, 0, 1, 2, 3, 4, 5, 6, 7), *(const LAS bf16x8*)(QB + ks * 1024 + lane * 16), O);
        }
        float l = SX[r];
#pragma unroll
        for (int k = 1; k < 8; ++k) l += SX[k * 32 + r];
        const float linv = 1.0f / l;
        bf16* o = (dry ? (bf16*)(ar + DUMMY_OFF) + (size_t)blockIdx.x * 8192 : QL + (size_t)ml * 8192) + r * 256 + 32 * w + 4 * h;
#pragma unroll
        for (int g = 0; g < 4; ++g) { u32x2 t; t.x = pk2(O[4 * g] * linv, O[4 * g + 1] * linv); t.y = pk2(O[4 * g + 2] * linv, O[4 * g + 3] * linv); *(u32x2*)(o + 8 * g) = t; }
        LDS_WAIT(); __builtin_amdgcn_s_barrier(); asm volatile("" ::: "memory");
    }
}
template <int NDB> DI void softmax_step(f32x16& S, float& m, float& l, f32x16 (&O)[NDB], bf16x8 (&pf)[2]) {
    float mx = S[0];
#pragma unroll
    for (int i = 1; i < 16; ++i) mx = fmaxf(mx, S[i]);
    mx = fmaxf(mx, __shfl_xor(mx, 32));
    const float mn = fmaxf(m, mx), ms = (mn == -INFINITY) ? 0.f : mn;
    const float alpha = __builtin_amdgcn_exp2f(m - ms);
    float sum = 0.f;
#pragma unroll
    for (int i = 0; i < 16; ++i) { S[i] = __builtin_amdgcn_exp2f(S[i] - ms); sum += S[i]; }
    l = l * alpha + sum; m = mn;
    if (__builtin_amdgcn_ballot_w64(alpha != 1.0f) != 0ull) {
#pragma unroll
        for (int db = 0; db < NDB; ++db)
#pragma unroll
            for (int i = 0; i < 16; ++i) O[db][i] *= alpha;
    }
#pragma unroll
    for (int s = 0; s < 2; ++s) { u32x4 w; w.x = pk2(S[8 * s], S[8 * s + 1]); w.y = pk2(S[8 * s + 2], S[8 * s + 3]); w.z = pk2(S[8 * s + 4], S[8 * s + 5]); w.w = pk2(S[8 * s + 6], S[8 * s + 7]); pf[s] = __builtin_bit_cast(bf16x8, w); }
}
template <int NQ, int NDB, bool PV, bool QL, bool FRAG, class KA, class VA, class MK>
DI void attn_run(const bf16x8 (&qf)[NQ], const LAS unsigned char* qlds, f32x16 (&O)[NDB], float& m, float& l, int tb, int te, const KA& ka, const VA& va, const MK& mk) {
    if (tb >= te) return;
    bf16x8 kf[NQ];
    { const bf16* kp = ka(tb);
#pragma unroll
      for (int s = 0; s < NQ; ++s) kf[s] = *(const bf16x8*)(kp + (FRAG ? 512 : 16) * s); }
    for (int t = tb; t < te; ++t) {
        bf16x8 vf[NDB][2];
        if (PV) {
#pragma unroll
            for (int db = 0; db < NDB; ++db) { const bf16* vp = va(t, db);
#pragma unroll
                for (int s = 0; s < 2; ++s) { if (FRAG) vf[db][s] = *(const bf16x8*)(vp + 512 * s); else vf[db][s] = __builtin_shufflevector(*(const s16x4*)(vp + 16 * s), *(const s16x4*)(vp + 16 * s + 8), 0, 1, 2, 3, 4, 5, 6, 7); } }
        }
        f32x16 S;
#pragma unroll
        for (int i = 0; i < 16; ++i) S[i] = 0.f;
#pragma unroll
        for (int s = 0; s < NQ; ++s) { if (QL) { unsigned qa_ = (unsigned)(size_t)qlds; asm volatile("" : "+v"(qa_)); S = MFMA32(kf[s], *(const LAS bf16x8*)((LAS unsigned char*)(size_t)qa_ + s * 1024), S); } else S = MFMA32(kf[s], qf[s], S); }
        if (t + 1 < te) { const bf16* kp = ka(t + 1);
#pragma unroll
            for (int s = 0; s < NQ; ++s) kf[s] = *(const bf16x8*)(kp + (FRAG ? 512 : 16) * s); }
        mk(t, S);
        bf16x8 pf[2]; softmax_step<NDB>(S, m, l, O, pf);
        if (PV) {
#pragma unroll
            for (int db = 0; db < NDB; ++db)
#pragma unroll
                for (int s = 0; s < 2; ++s) O[db] = MFMA32(vf[db][s], pf[s], O[db]);
        }
    }
}
template <bool ACC> DI void store_col(bf16* out, const f32x16 (&O)[4], float scale, int h) {
#pragma unroll
    for (int db = 0; db < 4; ++db)
#pragma unroll
        for (int g = 0; g < 4; ++g) { u32x2* p = (u32x2*)(out + db * 32 + 8 * g + 4 * h);
            float a = O[db][4 * g] * scale, b = O[db][4 * g + 1] * scale, c = O[db][4 * g + 2] * scale, d = O[db][4 * g + 3] * scale;
            if (ACC) { const u32x2 o = *p; a += bflo(o.x); b += bfhi(o.x); c += bflo(o.y); d += bfhi(o.y); }
            u32x2 w; w.x = pk2(a, b); w.y = pk2(c, d); *p = w; }
}
template <int NQ> struct TilePre { u32x4 a, b, c; };
template <int NQ, class SRC> DI void tile_fetch(TilePre<NQ>& p, const SRC& src, int T, int tid) {
    const bf16* k = src.k(T); const bf16* v = src.v(T);
    constexpr int NK = NQ * 64;
    p.a = *(const u32x4*)(k + (size_t)tid * 8);
    const int p1 = tid + 512; p.b = (p1 < NK) ? *(const u32x4*)(k + (size_t)p1 * 8) : *(const u32x4*)(v + (size_t)(p1 - NK) * 8);
    if (NQ * 64 + 512 > 1024) { const int p2 = tid + 1024; if (p2 < NK + 512) p.c = *(const u32x4*)(v + (size_t)(p2 - NK) * 8); }
}
template <int NQ> DI void tile_put(const TilePre<NQ>& p, LAS unsigned char* buf, int tid) {
    *(LAS u32x4*)(buf + tid * 16) = p.a; *(LAS u32x4*)(buf + (tid + 512) * 16) = p.b;
    if (NQ * 64 + 512 > 1024) { if (tid + 1024 < NQ * 64 + 512) *(LAS u32x4*)(buf + (tid + 1024) * 16) = p.c; }
}
template <int NQ, bool PV, class SRC, class MK>
DI void attn_run_sh(LAS unsigned char* tl, int tid, int lane, const bf16x8 (&qf)[NQ], f32x16 (&O)[4], float& m, float& l, int TB, int TE, int tb, int te, const SRC& src, const MK& mk) {
    constexpr int TBYTES = (NQ + 8) * 1024;
    if (TB >= TE) return;
    TilePre<NQ> pre;
    tile_fetch<NQ>(pre, src, TB, tid); tile_put<NQ>(pre, tl, tid);
    LDS_WAIT(); __builtin_amdgcn_s_barrier(); asm volatile("" ::: "memory");
#pragma unroll 1
    for (int T = TB; T < TE; ++T) {
        LAS unsigned char* cur = tl + ((T - TB) & 1) * TBYTES;
        if (T + 1 < TE) tile_fetch<NQ>(pre, src, T + 1, tid);
        if (T >= tb && T < te) {
            f32x16 S;
#pragma unroll
            for (int i = 0; i < 16; ++i) S[i] = 0.f;
#pragma unroll
            for (int s = 0; s < NQ; ++s) S = MFMA32(*(const LAS bf16x8*)(cur + s * 1024 + lane * 16), qf[s], S);
            mk(T, S);
            bf16x8 pf[2]; softmax_step<4>(S, m, l, O, pf);
            if (PV) {
#pragma unroll
                for (int db = 0; db < 4; ++db)
#pragma unroll
                    for (int s = 0; s < 2; ++s) O[db] = MFMA32(*(const LAS bf16x8*)(cur + (NQ + db * 2 + s) * 1024 + lane * 16), pf[s], O[db]);
            }
        }
        if (T + 1 < TE) tile_put<NQ>(pre, tl + ((T + 1 - TB) & 1) * TBYTES, tid);
        LDS_WAIT(); __builtin_amdgcn_s_barrier(); asm volatile("" ::: "memory");
    }
}
struct FragSrc { const bf16* kb; const bf16* vb; int nq; DI const bf16* k(int T) const { return kb + (size_t)T * nq * 512; } DI const bf16* v(int T) const { return vb + (size_t)T * 8 * 512; } };
constexpr size_t FA_Q = 0, FA_K = 64 * MiB, FA_F = 128 * MiB, FA_V = 136 * MiB, FA_CUM = 200 * MiB, FA_O = 202 * MiB, FA_KF = 266 * MiB, FA_VF = 330 * MiB;
constexpr size_t FW_IN = 0, FW_OUT = (size_t)6400 * 2048;
constexpr float FOX_QSCALE = 0.08838834764831845f * LOG2E;
DI void ph_fox_cvt(const Frame& F, const float* w_in, const float* w_out) {
    bf16* WB = (bf16*)(F.ws + WS_WMIX);
    cvt_job(F, w_in, 6160, DM, 0, 2048, WB + FW_IN, DM, 0, FOX_QSCALE);
    cvt_job(F, w_in, 6160, DM, 2048, 2048, WB + FW_IN, DM, 2048, 1.f);
    cvt_job(F, w_in, 6160, DM, 4096, 2048, WB + FW_IN, DM, 4096, 1.f);
    cvt_job(F, w_in, 6160, DM, 6144, 16, WB + FW_IN, DM, 6144, 1.f);
    zero_bf16(F, WB + FW_IN + (size_t)6160 * DM, (size_t)240 * DM);
    cvt_job(F, w_out, DM, DM, 0, DM, WB + FW_OUT, DM, 0, 1.f);
}
DI void ph_fox_scan(const Frame& F, const float* b_f) {
    unsigned char* ar = F.ws + WS_AR; const bf16* FB = (const bf16*)(ar + FA_F); float* CUM = (float*)(ar + FA_CUM);
    for (int w = F.gw; w < BPH * 16; w += F.NGW) {
        const int bl = w >> 4, hd = w & 15; const float bf_ = b_f[hd];
        float v[64]; float run = 0.f;
#pragma unroll
        for (int i = 0; i < 64; ++i) { const float x = bf2f(FB[(size_t)(bl * SEQ + F.lane * 64 + i) * 256 + hd]) + bf_;
            const float ls = fminf(x, 0.f) - log1pf(expf(-fabsf(x))); run += ls; v[i] = run; }
        float inc = run;
#pragma unroll
        for (int o = 1; o < 64; o <<= 1) { const float y = __shfl_up(inc, o); if (F.lane >= o) inc += y; }
        const float base = inc - run;
        float* dst = CUM + (size_t)w * SEQ + F.lane * 64;
#pragma unroll
        for (int i = 0; i < 64; i += 4) *(f32x4*)(dst + i) = (f32x4){(v[i] + base) * LOG2E, (v[i + 1] + base) * LOG2E, (v[i + 2] + base) * LOG2E, (v[i + 3] + base) * LOG2E};
    }
    const bf16* Kr = (const bf16*)(ar + FA_K); const bf16* Vr = (const bf16*)(ar + FA_V); bf16* KF = (bf16*)(ar + FA_KF); bf16* VF = (bf16*)(ar + FA_VF);
    const int r = F.lane & 31, h = F.lane >> 5;
    for (int u = F.gw; u < BPH * 16 * 128; u += F.NGW) {
        const int bh = u >> 7, tile = u & 127, bl = bh >> 4, hd = bh & 15;
        const bf16* krow_ = Kr + ((size_t)bl * SEQ + tile * 32 + r) * DM + hd * 128 + 8 * h;
        bf16* kd = KF + (((size_t)bh * 128 + tile) * 8 * 64 + F.lane) * 8;
#pragma unroll
        for (int s = 0; s < 8; ++s) *(u32x4*)(kd + s * 512) = *(const u32x4*)(krow_ + 16 * s);
        bf16* vd = VF + (((size_t)bh * 128 + tile) * 8 * 64 + F.lane) * 8;
#pragma unroll
        for (int db = 0; db < 4; ++db)
#pragma unroll
            for (int s = 0; s < 2; ++s) { unsigned short e[8];
#pragma unroll
                for (int j = 0; j < 8; ++j) e[j] = Vr[((size_t)bl * SEQ + tile * 32 + 16 * s + 8 * (j >> 2) + 4 * h + (j & 3)) * DM + hd * 128 + db * 32 + r];
                u32x4 w; w.x = e[0] | ((unsigned)e[1] << 16); w.y = e[2] | ((unsigned)e[3] << 16); w.z = e[4] | ((unsigned)e[5] << 16); w.w = e[6] | ((unsigned)e[7] << 16);
                *(u32x4*)(vd + (db * 2 + s) * 512) = w; }
    }
}
struct FragKA { const bf16* base; int nq; DI const bf16* operator()(int t) const { return base + (size_t)t * nq * 512; } };
struct FragVA { const bf16* base; DI const bf16* operator()(int t, int db) const { return base + ((size_t)t * 8 + db * 2) * 512; } };
struct FoxMK { const float* cum; float ct; int tq, h;
    DI void operator()(int t, f32x16& S) const {
        const int k0 = 32 * t + 4 * h;
#pragma unroll
        for (int g = 0; g < 4; ++g) { const f32x4 cs = *(const f32x4*)(cum + k0 + 8 * g);
#pragma unroll
            for (int e = 0; e < 4; ++e) S[4 * g + e] = (k0 + 8 * g + e <= tq) ? S[4 * g + e] + (ct - cs[e]) : -INFINITY; }
    } };
DI void ph_fox_attn(const Frame& F, const int dry = 0) {
    unsigned char* ar = F.ws + WS_AR; const bf16* Q = (const bf16*)(ar + FA_Q); const bf16* KF = (const bf16*)(ar + FA_KF); const bf16* VF = (const bf16*)(ar + FA_VF); const float* CUM = (const float*)(ar + FA_CUM); bf16* Ob = (bf16*)(ar + FA_O);
    const int r = F.lane & 31, h = F.lane >> 5;
    for (int wb = blockIdx.x; wb < BPH * 16 * 4; wb += F.G) {
        const int bh = wb >> 2, x = (wb & 3) * 8 + F.wave, bl = bh >> 4, hd = bh & 15;
#pragma unroll 1
        for (int k = 0; k < 4; ++k) {
            const int qt = (k == 0) ? x : (k == 1) ? 63 - x : (k == 2) ? 64 + x : 127 - x;
            const int qhi = (k == 0) ? (wb & 3) * 8 + 7 : (k == 1) ? 63 - (wb & 3) * 8 : (k == 2) ? 64 + (wb & 3) * 8 + 7 : 127 - (wb & 3) * 8;
            const int tq = qt * 32 + r; const size_t mrow = (size_t)bl * SEQ + tq;
            bf16x8 qf[8];
#pragma unroll
            for (int s = 0; s < 8; ++s) qf[s] = *(const bf16x8*)(Q + mrow * DM + hd * 128 + 16 * s + 8 * h);
            f32x16 O[4];
#pragma unroll
            for (int db = 0; db < 4; ++db)
#pragma unroll
                for (int i = 0; i < 16; ++i) O[db][i] = 0.f;
            float m = -INFINITY, l = 0.f;
            const float* cum = CUM + (size_t)bh * SEQ;
            const FragSrc src{KF + (size_t)bh * 128 * 8 * 512, VF + (size_t)bh * 128 * 8 * 512, 8}; const FoxMK mk{cum, cum[tq], tq, h};
            attn_run_sh<8, true>(F.lds, F.tid, F.lane, qf, O, m, l, 0, qhi + 1, 0, qt + 1, src, mk);
            l += __shfl_xor(l, 32);
            store_col<false>(dry ? (bf16*)(ar + DUMMY_OFF) + ((size_t)F.gw * 32 + r) * 128 : Ob + mrow * DM + hd * 128, O, l > 0.f ? 1.0f / l : 0.f, h);
        }
    }
}
typedef long fp8x8_t;
DI fp8x8_t pack_fp8x8(float a0, float a1, float a2, float a3, float a4, float a5, float a6, float a7) {
    int lo = 0, hi = 0;
    lo = __builtin_amdgcn_cvt_pk_fp8_f32(a0, a1, lo, false); lo = __builtin_amdgcn_cvt_pk_fp8_f32(a2, a3, lo, true);
    hi = __builtin_amdgcn_cvt_pk_fp8_f32(a4, a5, hi, false); hi = __builtin_amdgcn_cvt_pk_fp8_f32(a6, a7, hi, true);
    return (fp8x8_t)(((unsigned long long)(unsigned)hi << 32) | (unsigned long long)(unsigned)lo);
}
#define MFMA32F8(a, b, c) __builtin_amdgcn_mfma_f32_32x32x16_fp8_fp8((a), (b), (c), 0, 0, 0)
constexpr size_t NA_Q = 0, NA_KC = 288 * MiB, NA_VC = 313 * MiB, NA_KSR = 330 * MiB, NA_KWR = 354 * MiB, NA_GT = 378 * MiB, NA_VSR = 386 * MiB, NA_VWR = 402 * MiB, NA_GK = 418 * MiB, NA_GV = 420 * MiB,
                 NA_KCMP = 422 * MiB, NA_VCT = 424 * MiB, NA_SELB = 426 * MiB, NA_O = 428 * MiB,
                 NA_KSF = 620 * MiB, NA_KWF = 644 * MiB, NA_VSF = 668 * MiB, NA_VWF = 684 * MiB;
constexpr size_t NW_IN = 0, NW_W1K = (size_t)13312 * 2048, NW_W1V = NW_W1K + (size_t)256 * 6144, NW_W2K = NW_W1V + (size_t)256 * 4096, NW_W2V = NW_W2K + 65536, NW_OUT = NW_W2V + 65536;
constexpr float NSA_QSCALE = 0.07216878364870322f * LOG2E;
DI void ph_nsa_cvt(const Frame& F, const float* w_in, const float* k_pe, const float* k_w1, const float* k_b1, const float* k_w2, const float* v_pe, const float* v_w1, const float* v_b1, const float* v_w2, const float* w_out) {
    bf16* WB = (bf16*)(F.ws + WS_WMIX); float* BIAS = (float*)(F.ws + WS_MISC);
    cvt_job(F, w_in, 13200, DM, 0, 9216, WB + NW_IN, DM, 0, NSA_QSCALE);
    cvt_job(F, w_in, 13200, DM, 9216, 768, WB + NW_IN, DM, 9216, 1.f);
    cvt_job(F, w_in, 13200, DM, 9984, 512, WB + NW_IN, DM, 9984, 1.f);
    cvt_job(F, w_in, 13200, DM, 10496, 768, WB + NW_IN, DM, 10496, 1.f);
    cvt_job(F, w_in, 13200, DM, 11776, 768, WB + NW_IN, DM, 11264, 1.f);
    cvt_job(F, w_in, 13200, DM, 13056, 144, WB + NW_IN, DM, 12032, 1.f);
    zero_bf16(F, WB + NW_IN + (size_t)12176 * DM, (size_t)112 * DM);
    cvt_job(F, w_in, 13200, DM, 11264, 512, WB + NW_IN, DM, 12288, 1.f);
    cvt_job(F, w_in, 13200, DM, 12544, 512, WB + NW_IN, DM, 12800, 1.f);
    cvt_job(F, k_w1, 256, 6144, 0, 256, WB + NW_W1K, 6144, 0, 1.f);
    cvt_job(F, v_w1, 256, 4096, 0, 256, WB + NW_W1V, 4096, 0, 1.f);
    cvt_job(F, k_w2, 192, 256, 0, 192, WB + NW_W2K, 256, 0, 1.f); zero_bf16(F, WB + NW_W2K + 192 * 256, 64 * 256);
    cvt_job(F, v_w2, 128, 256, 0, 128, WB + NW_W2V, 256, 0, 1.f); zero_bf16(F, WB + NW_W2V + 128 * 256, 128 * 256);
    cvt_job(F, w_out, DM, 6144, 0, DM, WB + NW_OUT, 6144, 0, 1.f);
    for (int w = F.gw; w < 512; w += F.NGW) { const bool isk = w < 256; const int c = w & 255, n = isk ? 6144 : 4096; const float* pe = isk ? k_pe : v_pe; const float* w1 = isk ? k_w1 : v_w1;
        float s = 0.f; for (int i = F.lane; i < n; i += 64) s += pe[i] * w1[(size_t)i * 256 + c];
        s = wave_sum(s); if (F.lane == 0) BIAS[w] = s + (isk ? k_b1[c] : v_b1[c]); }
}
DI void ph_nsa_rope(const Frame& F, int half) {
    unsigned char* ar = F.ws + WS_AR; bf16* Q = (bf16*)(ar + NA_Q); bf16* KC = (bf16*)(ar + NA_KC);
    const bf16* KSR = (const bf16*)(ar + NA_KSR); const bf16* KWR = (const bf16*)(ar + NA_KWR); bf16* KSF = (bf16*)(ar + NA_KSF); bf16* KWF = (bf16*)(ar + NA_KWF);
    const float* c48 = (const float*)(F.ws + TAB_COS48); const float* s48 = (const float*)(F.ws + TAB_SIN48);
    for (int ml = F.gw; ml < MC; ml += F.NGW) {
        const size_t mg = (size_t)half * MC + ml; const int bl = ml >> 12, sq = ml & 4095;
        for (int p = F.lane; p < 1248; p += 64) {
            const int hd = p / 24, i = p - hd * 24; bf16* q;
            if (hd < 48) q = Q + (size_t)ml * 9216 + hd * 192 + i;
            else q = KC + ((size_t)(bl * 4 + hd - 48) * 4096 + sq) * 192 + i;
            const float x1 = bf2f(q[0]), x2 = bf2f(q[24]), c = c48[mg * 24 + i], s = s48[mg * 24 + i]; q[0] = f2bf(x1 * c - x2 * s); q[24] = f2bf(x1 * s + x2 * c);
        }
        const int tile = sq >> 5, rr = sq & 31;
        for (int u = F.lane; u < 168; u += 64) {
            const int tens = u / 84, uu = u - tens * 84, g = uu / 21, v = uu - g * 21;
            const bf16* src = (tens ? KWR : KSR) + (size_t)ml * 768 + g * 192;
            bf16* dst = (tens ? KWF : KSF) + ((size_t)((bl * 4 + g) * 128 + tile) * 12 * 64 + rr) * 8;
            if (v < 3) {
                const u32x4 a = *(const u32x4*)(src + 8 * v), b = *(const u32x4*)(src + 8 * v + 24); u32x4 o1, o2;
#pragma unroll
                for (int e = 0; e < 4; ++e) { const float c0 = c48[mg * 24 + 8 * v + 2 * e], s0 = s48[mg * 24 + 8 * v + 2 * e], c1 = c48[mg * 24 + 8 * v + 2 * e + 1], s1 = s48[mg * 24 + 8 * v + 2 * e + 1];
                    const float x1l = bflo(a[e]), x1h = bfhi(a[e]), x2l = bflo(b[e]), x2h = bfhi(b[e]);
                    o1[e] = pk2(x1l * c0 - x2l * s0, x1h * c1 - x2h * s1); o2[e] = pk2(x1l * s0 + x2l * c0, x1h * s1 + x2h * c1); }
                const int p1 = v, p2 = v + 3;
                if (tens) { *(u32x4*)(dst + ((p1 >> 1) * 64 + (p1 & 1) * 32) * 8) = o1; *(u32x4*)(dst + ((p2 >> 1) * 64 + (p2 & 1) * 32) * 8) = o2; }
                else { unsigned char* d8 = (unsigned char*)KSF + ((size_t)(((bl * 4 + g) * 128 + tile) * 2 + (rr >> 4)) * 6 * 64 + (rr & 15)) * 8;
                    *(fp8x8_t*)(d8 + ((p1 >> 2) * 64 + (p1 & 3) * 16) * 8) = pack_fp8x8(bflo(o1[0]), bfhi(o1[0]), bflo(o1[1]), bfhi(o1[1]), bflo(o1[2]), bfhi(o1[2]), bflo(o1[3]), bfhi(o1[3]));
                    *(fp8x8_t*)(d8 + ((p2 >> 2) * 64 + (p2 & 3) * 16) * 8) = pack_fp8x8(bflo(o2[0]), bfhi(o2[0]), bflo(o2[1]), bfhi(o2[1]), bflo(o2[2]), bfhi(o2[2]), bflo(o2[3]), bfhi(o2[3])); }
            } else { const int pc = v + 3; const u32x4 c = *(const u32x4*)(src + 8 * pc);
                if (tens) *(u32x4*)(dst + ((pc >> 1) * 64 + (pc & 1) * 32) * 8) = c;
                else { unsigned char* d8 = (unsigned char*)KSF + ((size_t)(((bl * 4 + g) * 128 + tile) * 2 + (rr >> 4)) * 6 * 64 + (rr & 15)) * 8;
                    *(fp8x8_t*)(d8 + ((pc >> 2) * 64 + (pc & 3) * 16) * 8) = pack_fp8x8(bflo(c[0]), bfhi(c[0]), bflo(c[1]), bfhi(c[1]), bflo(c[2]), bfhi(c[2]), bflo(c[3]), bfhi(c[3])); } }
        }
    }
    const bf16* VSR = (const bf16*)(ar + NA_VSR); const bf16* VWR = (const bf16*)(ar + NA_VWR); bf16* VSF = (bf16*)(ar + NA_VSF); bf16* VWF = (bf16*)(ar + NA_VWF);
    const int r = F.lane & 31, h = F.lane >> 5;
    for (int u = F.gw; u < 2 * BPH * 4 * 128; u += F.NGW) {
        const int tens = u >> 11, bg = (u >> 7) & 15, tile = u & 127, bl = bg >> 2, g = bg & 3;
        if (tens) {
            const bf16* src = VWR + ((size_t)bl * SEQ + tile * 32) * 512 + g * 128 + r;
            bf16* vd = VWF + (((size_t)bg * 128 + tile) * 8 * 64 + F.lane) * 8;
#pragma unroll
            for (int db = 0; db < 4; ++db)
#pragma unroll
                for (int s = 0; s < 2; ++s) { unsigned short e[8];
#pragma unroll
                    for (int j = 0; j < 8; ++j) e[j] = src[(size_t)(16 * s + 8 * (j >> 2) + 4 * h + (j & 3)) * 512 + db * 32];
                    u32x4 w; w.x = e[0] | ((unsigned)e[1] << 16); w.y = e[2] | ((unsigned)e[3] << 16); w.z = e[4] | ((unsigned)e[5] << 16); w.w = e[6] | ((unsigned)e[7] << 16);
                    *(u32x4*)(vd + (db * 2 + s) * 512) = w; }
        } else {
            const int d16 = F.lane & 15, kq = F.lane >> 4;
            const bf16* src = VSR + ((size_t)bl * SEQ + tile * 32) * 512 + g * 128 + d16;
            unsigned char* vd = (unsigned char*)VSF + (((size_t)bg * 128 + tile) * 8 * 64 + F.lane) * 8;
#pragma unroll
            for (int db = 0; db < 8; ++db) { float e[8];
#pragma unroll
                for (int j = 0; j < 8; ++j) e[j] = bf2f(src[(size_t)((j < 4 ? 4 * kq + j : 16 + 4 * kq + j - 4)) * 512 + db * 16]);
                *(fp8x8_t*)(vd + db * 512) = pack_fp8x8(e[0], e[1], e[2], e[3], e[4], e[5], e[6], e[7]); }
        }
    }
}
DI float sigmoidf_(float x) { return __builtin_amdgcn_rcpf(1.0f + __builtin_amdgcn_exp2f(-x * LOG2E)); }
struct LinKA { const bf16* base; size_t tstride; DI const bf16* operator()(int t) const { return base + (size_t)t * tstride; } };
struct LinVA { const bf16* base; size_t dbstride; DI const bf16* operator()(int t, int db) const { return base + (size_t)db * dbstride + t * 32; } };
struct CmpMK { int tq, h; DI void operator()(int t, f32x16& S) const {
#pragma unroll
    for (int i = 0; i < 16; ++i) { const int n = 32 * t + crow(i, h); S[i] = (16 * n + 31 <= tq) ? S[i] : -INFINITY; } } };
struct WinMK { int tq, h; DI void operator()(int t, f32x16& S) const {
#pragma unroll
    for (int i = 0; i < 16; ++i) { const int k = 32 * t + crow(i, h); S[i] = (k <= tq && k > tq - 512) ? S[i] : -INFINITY; } } };
DI void ph_nsa_cmp(const Frame& F, const int dry = 0) {
    unsigned char* ar = F.ws + WS_AR; const bf16* Q = (const bf16*)(ar + NA_Q); const bf16* KCMP = (const bf16*)(ar + NA_KCMP); const bf16* VCT = (const bf16*)(ar + NA_VCT); const bf16* GT = (const bf16*)(ar + NA_GT);
    unsigned char* SELB = ar + NA_SELB; bf16* Ob = (bf16*)(ar + NA_O);
    LAS float* imp = (LAS float*)F.lds;
    LAS unsigned char* tl = F.lds + 20480;
    const int lane = F.lane, r = lane & 31, h = lane >> 5, tid = F.tid;
    for (int u = blockIdx.x; u < BPH * 4 * 64; u += F.G) {
        const int bg = u >> 6, qt64 = ((u >> 8) & 1) ? 63 - (u & 63) : (u & 63), bl = bg >> 2, g = bg & 3;
        for (int i = F.tid; i < 64 * 65; i += NWAVES * 64) imp[i] = 0.f;
        __syncthreads();
        const FragSrc src{KCMP + (size_t)bg * 8 * 12 * 512, VCT + (size_t)bg * 8 * 8 * 512, 12};
        const int tqmaxb = qt64 * 64 + 63, TE = (tqmaxb >= 31) ? ((tqmaxb - 31) / 16) / 32 + 1 : 0;
#pragma unroll 1
        for (int k = 0; k < 3; ++k) {
            const int idx = F.wave * 3 + k, j = idx >> 1, sub = idx & 1, ql = sub * 32 + r, tq = qt64 * 64 + ql, hd = g * 12 + j;
            const size_t mrow = (size_t)bl * SEQ + tq;
            bf16x8 qf[12];
#pragma unroll
            for (int s = 0; s < 12; ++s) qf[s] = *(const bf16x8*)(Q + mrow * 9216 + hd * 192 + 16 * s + 8 * h);
            const int tqmax = qt64 * 64 + sub * 32 + 31, te = (tqmax >= 31) ? ((tqmax - 31) / 16) / 32 + 1 : 0;
            const CmpMK mk{tq, h};
            f32x16 O[4];
#pragma unroll
            for (int db = 0; db < 4; ++db)
#pragma unroll
                for (int i = 0; i < 16; ++i) O[db][i] = 0.f;
            float m = -INFINITY, l = 0.f;
            attn_run_sh<12, false>(tl, tid, lane, qf, O, m, l, 0, TE, 0, te, src, mk);
            l += __shfl_xor(l, 32);
            const float linv = l > 0.f ? 1.0f / l : 0.f, ms = (m == -INFINITY) ? 0.f : m;
            if (TE > 0) {
                TilePre<12> pre;
                tile_fetch<12>(pre, src, 0, tid); tile_put<12>(pre, tl, tid);
                LDS_WAIT(); __builtin_amdgcn_s_barrier(); asm volatile("" ::: "memory");
#pragma unroll 1
                for (int t = 0; t < TE; ++t) {
                    LAS unsigned char* cur = tl + (t & 1) * 20480;
                    if (t + 1 < TE) tile_fetch<12>(pre, src, t + 1, tid);
                    if (t < te) {
                        f32x16 S;
#pragma unroll
                        for (int i = 0; i < 16; ++i) S[i] = 0.f;
#pragma unroll
                        for (int s = 0; s < 12; ++s) S = MFMA32(*(const LAS bf16x8*)(cur + s * 1024 + lane * 16), qf[s], S);
                        mk(t, S);
#pragma unroll
                        for (int i = 0; i < 16; ++i) S[i] = __builtin_amdgcn_exp2f(S[i] - ms) * linv;
#pragma unroll
                        for (int g4 = 0; g4 < 4; ++g4) { const float gs = (S[4 * g4] + S[4 * g4 + 1]) + (S[4 * g4 + 2] + S[4 * g4 + 3]); const int mb = 8 * t + 2 * g4 + h;
                            __hip_atomic_fetch_add(imp + ql * 65 + mb, gs, __ATOMIC_RELAXED, __HIP_MEMORY_SCOPE_WORKGROUP);
                            if (mb + 1 < 64) __hip_atomic_fetch_add(imp + ql * 65 + mb + 1, S[4 * g4 + 3], __ATOMIC_RELAXED, __HIP_MEMORY_SCOPE_WORKGROUP); }
                        bf16x8 pf[2];
#pragma unroll
                        for (int s = 0; s < 2; ++s) { u32x4 w; w.x = pk2(S[8 * s], S[8 * s + 1]); w.y = pk2(S[8 * s + 2], S[8 * s + 3]); w.z = pk2(S[8 * s + 4], S[8 * s + 5]); w.w = pk2(S[8 * s + 6], S[8 * s + 7]); pf[s] = __builtin_bit_cast(bf16x8, w); }
#pragma unroll
                        for (int db = 0; db < 4; ++db)
#pragma unroll
                            for (int s = 0; s < 2; ++s) O[db] = MFMA32(*(const LAS bf16x8*)(cur + (12 + db * 2 + s) * 1024 + lane * 16), pf[s], O[db]);
                    }
                    if (t + 1 < TE) tile_put<12>(pre, tl + ((t + 1) & 1) * 20480, tid);
                    LDS_WAIT(); __builtin_amdgcn_s_barrier(); asm volatile("" ::: "memory");
                }
            }
            const float gate = sigmoidf_(bf2f(GT[mrow * 256 + hd]));
            store_col<false>(dry ? (bf16*)(ar + DUMMY_OFF) + ((size_t)F.gw * 32 + r) * 128 : Ob + mrow * 6144 + hd * 128, O, gate, h);
        }
        __syncthreads();
#pragma unroll 1
        for (int k = 0; k < 8; ++k) {
            const int ql = F.wave * 8 + k, tq = qt64 * 64 + ql, cur = tq >> 6, mb = lane;
            const bool causal = mb <= cur, forced = (mb == 0) || (mb == cur) || (mb == cur - 1);
            const float v = causal ? (forced ? INFINITY : imp[ql * 65 + mb]) : -INFINITY;
            int rank = 0;
            for (int o = 0; o < 64; ++o) { const float vo = __shfl(v, o); rank += (vo > v || (vo == v && o < mb)) ? 1 : 0; }
            if (rank < 16) (dry ? ar + DUMMY_OFF + 32 * MiB + (size_t)F.gw * 16 : SELB + ((size_t)bg * 4096 + tq) * 16)[rank] = causal ? (unsigned char)mb : (unsigned char)0xFF;
        }
        __syncthreads();
    }
}
DI int sel_tile(const u32x4& sel, int t) { const int b = t >> 1; const unsigned w = (b < 4) ? sel.x : (b < 8) ? sel.y : (b < 12) ? sel.z : sel.w; return (int)((w >> ((b & 3) * 8)) & 0xFFu) * 2 + (t & 1); }
struct SelKA { const bf16* base; u32x4 sel; DI const bf16* operator()(int t) const { return base + (size_t)sel_tile(sel, t) * 12 * 512; } };
struct SelVA { const bf16* base; u32x4 sel; DI const bf16* operator()(int t, int db) const { return base + ((size_t)sel_tile(sel, t) * 8 + db * 2) * 512; } };
struct SelMK { u32x4 sel; int tq, h; DI void operator()(int t, f32x16& S) const { const int k0 = sel_tile(sel, t) * 32;
#pragma unroll
    for (int i = 0; i < 16; ++i) S[i] = (k0 + crow(i, h) <= tq) ? S[i] : -INFINITY; } };
typedef float f32x4_ __attribute__((ext_vector_type(4)));
#define MFMA16F8(a, b, c) __builtin_amdgcn_mfma_f32_16x16x32_fp8_fp8((a), (b), (c), 0, 0, 0)
DI void ph_nsa_sel(const Frame& F, const int dry = 0) {
    unsigned char* ar = F.ws + WS_AR; const bf16* Q = (const bf16*)(ar + NA_Q); const unsigned char* KS8 = ar + NA_KSF; const unsigned char* VS8 = ar + NA_VSF; const bf16* GT = (const bf16*)(ar + NA_GT);
    const unsigned char* SELB = ar + NA_SELB; bf16* Ob = (bf16*)(ar + NA_O);
    const int c16 = F.lane & 15, kq = F.lane >> 4; const bool act = c16 < 12;
    for (int it = F.gw; it < BPH * 4 * SEQ; it += F.NGW) {
        const int bg = it >> 12, tq = ((it & 4095) + 256 * bg) & 4095, bl = bg >> 2, g = bg & 3; const size_t mrow = (size_t)bl * SEQ + tq; const int hd = g * 12 + (act ? c16 : 0);
        fp8x8_t qf[6];
#pragma unroll
        for (int s = 0; s < 6; ++s) { const u32x4 q = *(const u32x4*)(Q + mrow * 9216 + hd * 192 + 32 * s + 8 * kq); const float qs = act ? (1.0f / NSA_QSCALE) : 0.f;
            qf[s] = pack_fp8x8(bflo(q[0]) * qs, bfhi(q[0]) * qs, bflo(q[1]) * qs, bfhi(q[1]) * qs, bflo(q[2]) * qs, bfhi(q[2]) * qs, bflo(q[3]) * qs, bfhi(q[3]) * qs); }
        const u32x4 sel = *(const u32x4*)(SELB + ((size_t)bg * 4096 + tq) * 16);
        const int nv = ((tq >> 6) + 1 < 16) ? (tq >> 6) + 1 : 16, te = 2 * nv;
        const unsigned char* kb = KS8 + ((size_t)bg * 128 * 12 * 64 + F.lane) * 8; const unsigned char* vb = VS8 + ((size_t)bg * 128 * 8 * 64 + F.lane) * 8;
        f32x4_ O[8];
#pragma unroll
        for (int db = 0; db < 8; ++db) O[db] = (f32x4_){0.f, 0.f, 0.f, 0.f};
        float m = -INFINITY, l = 0.f;
        fp8x8_t kfA[12], kfB[12], vfA[8], vfB[8];
        { const unsigned char* kp = kb + (size_t)sel_tile(sel, 0) * 12 * 512; const unsigned char* kp1 = kb + (size_t)sel_tile(sel, 1) * 12 * 512; const unsigned char* vp = vb + (size_t)sel_tile(sel, 0) * 8 * 512;
#pragma unroll
          for (int s = 0; s < 12; ++s) { kfA[s] = *(const fp8x8_t*)(kp + s * 512); kfB[s] = *(const fp8x8_t*)(kp1 + s * 512); }
#pragma unroll
          for (int j = 0; j < 8; ++j) vfA[j] = *(const fp8x8_t*)(vp + j * 512); }
#define SEL_STEP(T_, KF_, VF_, VFN_) do { const int t_ = (T_); const int tile = sel_tile(sel, t_); \
            if (t_ + 1 < te) { const unsigned char* vp = vb + (size_t)sel_tile(sel, t_ + 1) * 8 * 512; _Pragma("unroll") for (int j = 0; j < 8; ++j) VFN_[j] = *(const fp8x8_t*)(vp + j * 512); } \
            f32x4_ S0 = {0.f, 0.f, 0.f, 0.f}, S1 = S0; \
            _Pragma("unroll") for (int s = 0; s < 6; ++s) { S0 = MFMA16F8(KF_[s], qf[s], S0); S1 = MFMA16F8(KF_[6 + s], qf[s], S1); } \
            if (t_ + 2 < te) { const unsigned char* kp = kb + (size_t)sel_tile(sel, t_ + 2) * 12 * 512; _Pragma("unroll") for (int s = 0; s < 12; ++s) KF_[s] = *(const fp8x8_t*)(kp + s * 512); } \
            const int k0 = tile * 32 + 4 * kq; float mx = -INFINITY; \
            _Pragma("unroll") for (int i = 0; i < 4; ++i) { S0[i] = (k0 + i <= tq) ? S0[i] * NSA_QSCALE : -INFINITY; S1[i] = (k0 + 16 + i <= tq) ? S1[i] * NSA_QSCALE : -INFINITY; mx = fmaxf(mx, fmaxf(S0[i], S1[i])); } \
            mx = fmaxf(mx, __shfl_xor(mx, 16)); mx = fmaxf(mx, __shfl_xor(mx, 32)); \
            const float mn = fmaxf(m, mx), ms = (mn == -INFINITY) ? 0.f : mn, alpha = __builtin_amdgcn_exp2f(m - ms); \
            float sum = 0.f; \
            _Pragma("unroll") for (int i = 0; i < 4; ++i) { S0[i] = __builtin_amdgcn_exp2f(S0[i] - ms); S1[i] = __builtin_amdgcn_exp2f(S1[i] - ms); sum += S0[i] + S1[i]; } \
            l = l * alpha + sum; m = mn; \
            if (__builtin_amdgcn_ballot_w64(alpha != 1.0f) != 0ull) { _Pragma("unroll") for (int db = 0; db < 8; ++db) O[db] = O[db] * alpha; } \
            const fp8x8_t p8 = pack_fp8x8(S0[0], S0[1], S0[2], S0[3], S1[0], S1[1], S1[2], S1[3]);       \
            _Pragma("unroll") for (int db = 0; db < 8; ++db) O[db] = MFMA16F8(VF_[db], p8, O[db]); } while (0)
#pragma unroll 1
        for (int t = 0; t < te; t += 2) { SEL_STEP(t, kfA, vfA, vfB); SEL_STEP(t + 1, kfB, vfB, vfA); }
#undef SEL_STEP
        l += __shfl_xor(l, 16); l += __shfl_xor(l, 32);
        if (act) { const float gate = sigmoidf_(bf2f(GT[mrow * 256 + 48 + hd])); const float sc = l > 0.f ? gate / l : 0.f;
            bf16* o = (dry ? (bf16*)(ar + DUMMY_OFF) + ((size_t)F.gw * 16 + c16) * 128 : Ob + mrow * 6144 + hd * 128) + 4 * kq;
#pragma unroll
            for (int db = 0; db < 8; ++db) { u32x2* p = (u32x2*)(o + db * 16); const u32x2 prev = *p;
                u32x2 w; w.x = pk2(O[db][0] * sc + bflo(prev.x), O[db][1] * sc + bfhi(prev.x)); w.y = pk2(O[db][2] * sc + bflo(prev.y), O[db][3] * sc + bfhi(prev.y)); *p = w; } }
    }
}
DI void ph_nsa_win(const Frame& F, const int dry = 0) {
    unsigned char* ar = F.ws + WS_AR; const bf16* Q = (const bf16*)(ar + NA_Q); const bf16* KWF = (const bf16*)(ar + NA_KWF); const bf16* VWF = (const bf16*)(ar + NA_VWF); const bf16* GT = (const bf16*)(ar + NA_GT); bf16* Ob = (bf16*)(ar + NA_O);
    const int r = F.lane & 31, h = F.lane >> 5;
    for (int idb = blockIdx.x; idb < BPH * 48 * 16; idb += F.G) {
        const int qt0 = (((idb & 15) + (idb >> 8)) & 15) * 8, qt = qt0 + F.wave, bh = idb >> 4, hd = bh % 48, bl = bh / 48, g = hd / 12, bg = bl * 4 + g, tq = qt * 32 + r; const size_t mrow = (size_t)bl * SEQ + tq;
        bf16x8 qf[12];
#pragma unroll
        for (int s = 0; s < 12; ++s) qf[s] = *(const bf16x8*)(Q + mrow * 9216 + hd * 192 + 16 * s + 8 * h);
        const FragSrc src{KWF + (size_t)bg * 128 * 12 * 512, VWF + (size_t)bg * 128 * 8 * 512, 12}; const WinMK mk{tq, h};
        f32x16 O[4];
#pragma unroll
        for (int db = 0; db < 4; ++db)
#pragma unroll
            for (int i = 0; i < 16; ++i) O[db][i] = 0.f;
        float m = -INFINITY, l = 0.f;
        attn_run_sh<12, true>(F.lds, F.tid, F.lane, qf, O, m, l, qt0 >= 16 ? qt0 - 16 : 0, qt0 + 8, qt >= 16 ? qt - 16 : 0, qt + 1, src, mk);
        l += __shfl_xor(l, 32);
        const float gate = sigmoidf_(bf2f(GT[mrow * 256 + 96 + hd]));
        store_col<true>(dry ? (bf16*)(ar + DUMMY_OFF) + ((size_t)F.gw * 32 + r) * 128 : Ob + mrow * 6144 + hd * 128, O, l > 0.f ? gate / l : 0.f, h);
    }
}
#ifndef MK_ONE_LAUNCH
#define MK_ONE_LAUNCH 1
#endif
constexpr int NPH = 74;
struct Args { const float* in[58]; float* out; unsigned char* ws; int ph_lo, ph_hi; };
#ifndef PROBE_GEMM
#define PROBE_GEMM 0
#endif
#ifndef PROBE_PH
#define PROBE_PH 0
#endif
#define GEMM_AKOFF 0
#define GEMM_CALL(EpiT, Evar, Aptr, Bptr, Mv, Nv, Kv, ldav, ldbv, cidx) do { if (PROBE_GEMM) { const pg8::Gemm g0_{(const pg8::bf16_t*)(Aptr), (const pg8::bf16_t*)(Bptr), (Mv), (Nv), (Kv), (ldav), (ldbv), GEMM_AKOFF}; \
    pg8::StaticOrder S0_; S0_.init((Mv), (Nv), F.G, (cidx)); pg8::EpiDry E0_{(float*)(ar + DUMMY_OFF)}; pg8::gemm_phase<pg8::EpiDry, pg8::StaticOrder, true, true>((PG8_LAS unsigned char*)F.lds, g0_, S0_, E0_); __syncthreads(); } \
    const pg8::Gemm g_{(const pg8::bf16_t*)(Aptr), (const pg8::bf16_t*)(Bptr), (Mv), (Nv), (Kv), (ldav), (ldbv), GEMM_AKOFF}; \
    pg8::StaticOrder S_; S_.init((Mv), (Nv), F.G, (cidx)); pg8::gemm_phase<EpiT, pg8::StaticOrder, true, true>((PG8_LAS unsigned char*)F.lds, g_, S_, Evar); } while (0)
DI pg8::EpiBf16R epi1(bf16* base, int ldc) { pg8::EpiBf16R e; for (int s = 0; s < 8; ++s) { e.T.base[s] = base; e.T.ldc[s] = ldc; e.T.t0[s] = 0; e.T.gw[s] = 0; } e.T.nseg = 1; e.T.pad_ = 0; e.ssp = nullptr; e.ss_off = 0; return e; }
#define PH_BEGIN if (ph >= lo && ph < hi) { Frame F; { unsigned long long w_ = (unsigned long long)args.ws; asm volatile("" : "+s"(w_)); F.ws = (unsigned char*)w_; F.ctl = (unsigned*)(F.ws + WS_CTL); } \
    F.lds = lds; F.tid = threadIdx.x; F.lane = F.tid & 63; F.wave = __builtin_amdgcn_readfirstlane(F.tid >> 6); F.G = gridDim.x; F.gw = blockIdx.x * NWAVES + F.wave; F.NGW = F.G * NWAVES; \
    float* out; { unsigned long long o_ = (unsigned long long)args.out; asm volatile("" : "+s"(o_)); out = (float*)o_; } \
    unsigned char* const ar = F.ws + WS_AR; bf16* const XN = (bf16*)(F.ws + WS_XNR); float* const SSB = (float*)(F.ws + WS_SS); bf16* const WB = (bf16*)(F.ws + WS_WMIX); bf16* const WUP = (bf16*)(F.ws + WS_WFFN); bf16* const WDN = WUP + (size_t)2 * DFF * DM; \
    const float* const res_mix = (ib == 2) ? args.in[0] : (const float*)out; (void)ar; (void)XN; (void)SSB; (void)WB; (void)WUP; (void)WDN; (void)res_mix; (void)iff;
#define PH_END   if (ph + 1 < hi) { XcdBarrier b_; b_.bar = (unsigned*)F.ctl + CW_BAR; b_.x = xb_xcc_id(); b_.st = MISC + 8; xcd_barrier(b_); } } ++ph;
template <int LAYER> DI void run_cvt(const Args& args, LAS unsigned char* lds, volatile LAS unsigned* MISC, int& ph, const int lo, const int hi) {
    constexpr int ib = (LAYER == 0) ? 2 : (LAYER == 1) ? 17 : (LAYER == 2) ? 26 : 42;
    constexpr int iff = (LAYER == 0) ? 12 : (LAYER == 1) ? 21 : (LAYER == 2) ? 37 : 52;
    constexpr int kind = (LAYER == 1) ? 1 : (LAYER == 2) ? 2 : 0;
        PH_BEGIN
          for (int rep_ = 0; rep_ < (PROBE_PH == 11 ? 2 : 1); ++rep_) {
            if constexpr (kind == 0) ph_dsa_cvt(F, args.in[ib + 1], args.in[ib + 6], args.in[ib + 7], args.in[ib + 8], args.in[ib + 9]);
            else if constexpr (kind == 1) ph_fox_cvt(F, args.in[ib + 1], args.in[ib + 3]);
            else ph_nsa_cvt(F, args.in[ib + 1], args.in[ib + 2], args.in[ib + 3], args.in[ib + 4], args.in[ib + 5], args.in[ib + 6], args.in[ib + 7], args.in[ib + 8], args.in[ib + 9], args.in[ib + 10]);
            ph_cvt_ffn(F, args.in[iff + 1], args.in[iff + 4]); __syncthreads();
          }
        PH_END
}
template <int LAYER, int HALF> DI void run_half(const Args& args, LAS unsigned char* lds, volatile LAS unsigned* MISC, int& ph, const int lo, const int hi) {
    constexpr int ib = (LAYER == 0) ? 2 : (LAYER == 1) ? 17 : (LAYER == 2) ? 26 : 42;
    constexpr int iff = (LAYER == 0) ? 12 : (LAYER == 1) ? 21 : (LAYER == 2) ? 37 : 52;
    constexpr int kind = (LAYER == 1) ? 1 : (LAYER == 2) ? 2 : 0;
    constexpr int half = HALF;
            const int roff = half * MC;
            const float* const ssin = nullptr; (void)ssin;
            if constexpr (kind == 0) {
                PH_BEGIN { pg8::EpiF32 E{(float*)(ar + DA_DIN), 1024, SSB + (size_t)(LAYER * 2) * MTOT * 8, roff}; GEMM_CALL(pg8::EpiF32, E, XN + (size_t)roff * DM, WB + DW_W1, MC, 1024, DM, DM, DM, (int)blockIdx.x); } PH_END
                PH_BEGIN if (PROBE_PH == 10) { ph_dsa_post1(F, half, args.in[ib + 2], args.in[ib + 3], args.in[ib + 4], args.in[ib + 5]); __syncthreads(); } ph_dsa_post1(F, half, args.in[ib + 2], args.in[ib + 3], args.in[ib + 4], args.in[ib + 5]); PH_END
                PH_BEGIN { pg8::EpiBf16R E = epi1((bf16*)(ar + DA_QL), 8192); E.T.base[1] = (bf16*)(ar + DA_QPE); E.T.ldc[1] = 1536; E.T.t0[1] = 32; E.T.base[2] = (bf16*)(ar + DA_QIDX); E.T.ldc[2] = 2048; E.T.t0[2] = 38; E.T.nseg = 3;
                    GEMM_CALL(pg8::EpiBf16R, E, ar + DA_CQN, WB + DW_W2, MC, 11776, 512, 512, 512, (int)blockIdx.x); } PH_END
                PH_BEGIN ph_dsa_rope(F, half); PH_END
                PH_BEGIN if (PROBE_PH == 1) { ph_dsa_index(F, 1); __syncthreads(); } if (PROBE_PH == 7) { ph_dsa_index(F, 1, 1); __syncthreads(); } if (PROBE_PH == 8) { ph_dsa_index(F, 1, 2); __syncthreads(); } ph_dsa_index(F); PH_END
                PH_BEGIN if (PROBE_PH == 2) { ph_dsa_attn(F, 1); __syncthreads(); } ph_dsa_attn(F); PH_END
                PH_BEGIN {
                    pg8::EpiBf16R E = epi1((bf16*)(ar + DA_O2), 4096);
                    { const pg8::Gemm g_{(const pg8::bf16_t*)(ar + DA_QL), (const pg8::bf16_t*)(WB + DW_BD), MC, 4096, 512, 8192, 512, 512}; pg8::StaticOrder S_; S_.init(MC, 4096, F.G, (int)blockIdx.x);
                      pg8::gemm_phase<pg8::EpiBf16R, pg8::StaticOrder, true, true>((PG8_LAS unsigned char*)F.lds, g_, S_, E); } } PH_END
                PH_BEGIN { pg8::EpiResN E{res_mix, out, DM, roff, args.in[iff], (pg8::bf16_t*)XN, SSB + (size_t)(LAYER * 2 + 1) * MTOT * 8, (PG8_LAS float*)(F.lds + LDSCTL_OFF + 256)}; GEMM_CALL(pg8::EpiResN, E, ar + DA_O2, WB + DW_WO, MC, DM, 4096, 4096, 4096, (int)blockIdx.x); } PH_END
            } else if constexpr (kind == 1) {
                PH_BEGIN { pg8::EpiBf16R E = epi1((bf16*)(ar + FA_Q), DM); E.T.base[1] = (bf16*)(ar + FA_K); E.T.ldc[1] = DM; E.T.t0[1] = 8; E.T.base[2] = (bf16*)(ar + FA_V); E.T.ldc[2] = DM; E.T.t0[2] = 16;
                    E.T.base[3] = (bf16*)(ar + FA_F); E.T.ldc[3] = 256; E.T.t0[3] = 24; E.T.nseg = 4; E.ssp = SSB + (size_t)(LAYER * 2) * MTOT * 8; E.ss_off = roff;
                    GEMM_CALL(pg8::EpiBf16R, E, XN + (size_t)roff * DM, WB + FW_IN, MC, 6400, DM, DM, DM, (int)blockIdx.x); } PH_END
                PH_BEGIN if (PROBE_PH == 10) { ph_fox_scan(F, args.in[ib + 2]); __syncthreads(); } ph_fox_scan(F, args.in[ib + 2]); PH_END
                PH_BEGIN if (PROBE_PH == 3) { ph_fox_attn(F, 1); __syncthreads(); } ph_fox_attn(F); PH_END
                PH_BEGIN { pg8::EpiResN E{res_mix, out, DM, roff, args.in[iff], (pg8::bf16_t*)XN, SSB + (size_t)(LAYER * 2 + 1) * MTOT * 8, (PG8_LAS float*)(F.lds + LDSCTL_OFF + 256)}; GEMM_CALL(pg8::EpiResN, E, ar + FA_O, WB + FW_OUT, MC, DM, DM, DM, DM, (int)blockIdx.x); } PH_END
            } else {
                PH_BEGIN { pg8::EpiBf16R E = epi1((bf16*)(ar + NA_Q), 9216);
                    E.T.base[1] = (bf16*)(ar + NA_KC); E.T.ldc[1] = 192; E.T.t0[1] = 36; E.T.gw[1] = 192;
                    E.T.base[2] = (bf16*)(ar + NA_VC); E.T.ldc[2] = 128; E.T.t0[2] = 39; E.T.gw[2] = 128;
                    E.T.base[3] = (bf16*)(ar + NA_KSR); E.T.ldc[3] = 768; E.T.t0[3] = 41;
                    E.T.base[4] = (bf16*)(ar + NA_KWR); E.T.ldc[4] = 768; E.T.t0[4] = 44;
                    E.T.base[5] = (bf16*)(ar + NA_GT); E.T.ldc[5] = 256; E.T.t0[5] = 47;
                    E.T.base[6] = (bf16*)(ar + NA_VSR); E.T.ldc[6] = 512; E.T.t0[6] = 48;
                    E.T.base[7] = (bf16*)(ar + NA_VWR); E.T.ldc[7] = 512; E.T.t0[7] = 50; E.T.nseg = 8; E.ssp = SSB + (size_t)(LAYER * 2) * MTOT * 8; E.ss_off = roff;
                    GEMM_CALL(pg8::EpiBf16R, E, XN + (size_t)roff * DM, WB + NW_IN, MC, 13312, DM, DM, DM, (int)blockIdx.x); } PH_END
                PH_BEGIN ph_nsa_rope(F, half); PH_END
                PH_BEGIN {
                    const float* BIAS = (const float*)(args.ws + WS_MISC);
                    { pg8::EpiGelu E{(bf16*)(ar + NA_GK), 256, BIAS}; GEMM_CALL(pg8::EpiGelu, E, ar + NA_KC, WB + NW_W1K, 4096, 256, 6144, 3072, 6144, (int)blockIdx.x); }
                    { pg8::EpiGelu E{(bf16*)(ar + NA_GV), 256, BIAS + 256}; GEMM_CALL(pg8::EpiGelu, E, ar + NA_VC, WB + NW_W1V, 4096, 256, 4096, 2048, 4096, (int)((blockIdx.x + F.G - 16) % F.G)); }
                } PH_END
                PH_BEGIN {
                    { pg8::EpiBf16R E = epi1((bf16*)(ar + NA_KCMP), 12); E.T.gw[0] = -1; GEMM_CALL(pg8::EpiBf16R, E, ar + NA_GK, WB + NW_W2K, 4096, 256, 256, 256, 256, (int)blockIdx.x); }
                    { pg8::EpiBf16R E = epi1((bf16*)(ar + NA_VCT), 4); E.T.gw[0] = -2; GEMM_CALL(pg8::EpiBf16R, E, WB + NW_W2V, ar + NA_GV, 256, 4096, 256, 256, 256, (int)((blockIdx.x + F.G - 16) % F.G)); }
                } PH_END
                PH_BEGIN if (PROBE_PH == 4) { ph_nsa_cmp(F, 1); __syncthreads(); } ph_nsa_cmp(F); PH_END
                PH_BEGIN if (PROBE_PH == 5) { ph_nsa_sel(F, 1); __syncthreads(); } ph_nsa_sel(F); PH_END
                PH_BEGIN if (PROBE_PH == 6) { ph_nsa_win(F, 1); __syncthreads(); } ph_nsa_win(F); PH_END
                PH_BEGIN { pg8::EpiResN E{res_mix, out, DM, roff, args.in[iff], (pg8::bf16_t*)XN, SSB + (size_t)(LAYER * 2 + 1) * MTOT * 8, (PG8_LAS float*)(F.lds + LDSCTL_OFF + 256)}; GEMM_CALL(pg8::EpiResN, E, ar + NA_O, WB + NW_OUT, MC, DM, 6144, 6144, 6144, (int)blockIdx.x); } PH_END
            }
}
template <int LAYER> DI void run_ffn(const Args& args, LAS unsigned char* lds, volatile LAS unsigned* MISC, int& ph, const int lo, const int hi) {
    constexpr int ib = (LAYER == 0) ? 2 : (LAYER == 1) ? 17 : (LAYER == 2) ? 26 : 42;
    constexpr int iff = (LAYER == 0) ? 12 : (LAYER == 1) ? 21 : (LAYER == 2) ? 37 : 52;
    PH_BEGIN {
        LAS float* rt = (LAS float*)(F.lds + LDSCTL_OFF + 256 + 8192); const int rbase = 4096 * (int)(blockIdx.x & 7); const float* ssq = SSB + (size_t)(LAYER * 2 + 1) * MTOT * 8;
        for (int i = F.tid; i < 4096; i += NWAVES * 64) rt[i] = pg8::rms_rowscale(ssq, rbase + i);
        __syncthreads();
        pg8::EpiConvGlu E{(pg8::bf16_t*)ar, (float*)(ar + 352 * MiB), args.in[iff + 2], args.in[iff + 3], (PG8_LAS float*)(F.lds + LDSCTL_OFF + 256), DFF, (const PG8_LAS float*)rt, rbase};
        GEMM_CALL(pg8::EpiConvGlu, E, XN, WUP, MTOT, 2 * DFF, DM, DM, DM, (int)blockIdx.x); } PH_END
    PH_BEGIN ph_conv_fix(F, (const float*)(ar + 352 * MiB), (bf16*)ar, args.in[iff + 2], args.in[iff + 3], MTOT); PH_END
    PH_BEGIN {
        if constexpr (LAYER < 3) { constexpr int ibn = (LAYER == 0) ? 17 : (LAYER == 1) ? 26 : 42;
            pg8::EpiResN E{out, out, DM, 0, args.in[ibn], (pg8::bf16_t*)XN, SSB + (size_t)((LAYER + 1) * 2) * MTOT * 8, (PG8_LAS float*)(F.lds + LDSCTL_OFF + 256)}; GEMM_CALL(pg8::EpiResN, E, ar, WDN, MTOT, DM, DFF, DFF, DFF, (int)blockIdx.x); }
        else { pg8::EpiRes E{out, out, DM, 0}; GEMM_CALL(pg8::EpiRes, E, ar, WDN, MTOT, DM, DFF, DFF, DFF, (int)blockIdx.x); }
    } PH_END
}
__global__ void __launch_bounds__(NWAVES * 64, 2) mk_fwd(Args args) {
    extern __shared__ __attribute__((aligned(16))) unsigned char lds_[];
    LAS unsigned char* const lds = (LAS unsigned char*)lds_;
    volatile LAS unsigned* MISC = (volatile LAS unsigned*)(lds + LDSCTL_OFF);
    for (int u = threadIdx.x; u < 64; u += NWAVES * 64) ((LAS unsigned*)(lds + LDSCTL_OFF))[u] = 0u;
    __syncthreads();
    const int lo = args.ph_lo, hi = args.ph_hi;
    (void)xcd_barrier_post((unsigned*)(args.ws + WS_CTL) + CW_BAR, MISC + 8);
    int ph = 0;
    { constexpr int ib = 2, iff = 12; PH_BEGIN ph_tables(F, (const int*)args.in[1]); ph_norm_first(F, args.in[0], args.in[2], XN, SSB); PH_END }
    run_cvt<0>(args, lds, MISC, ph, lo, hi); run_half<0, 0>(args, lds, MISC, ph, lo, hi); run_half<0, 1>(args, lds, MISC, ph, lo, hi); run_ffn<0>(args, lds, MISC, ph, lo, hi);
    run_cvt<1>(args, lds, MISC, ph, lo, hi); run_half<1, 0>(args, lds, MISC, ph, lo, hi); run_half<1, 1>(args, lds, MISC, ph, lo, hi); run_ffn<1>(args, lds, MISC, ph, lo, hi);
    run_cvt<2>(args, lds, MISC, ph, lo, hi); run_half<2, 0>(args, lds, MISC, ph, lo, hi); run_half<2, 1>(args, lds, MISC, ph, lo, hi); run_ffn<2>(args, lds, MISC, ph, lo, hi);
    run_cvt<3>(args, lds, MISC, ph, lo, hi); run_half<3, 0>(args, lds, MISC, ph, lo, hi); run_half<3, 1>(args, lds, MISC, ph, lo, hi); run_ffn<3>(args, lds, MISC, ph, lo, hi);
    { constexpr int ib = 42, iff = 52; PH_BEGIN ph_final_norm(F, out, args.in[57]); PH_END }
}
extern "C" void kernel_launch(void* const* d_in, const int* in_sizes, int n_in, void* d_out, int out_size, void* d_ws, size_t ws_size, hipStream_t stream) {
    static int grid = 0;
    if (grid == 0) {
        if (n_in != 58 || out_size != MTOT * DM || ws_size < WS_END) { fprintf(stderr, "kernel_launch: unexpected shapes (n_in %d, out %d, ws %zu)\n", n_in, out_size, ws_size); grid = -1; return; }
        int dev = 0, cus = 0;
        if (hipGetDevice(&dev) != hipSuccess || hipDeviceGetAttribute(&cus, hipDeviceAttributeMultiprocessorCount, dev) != hipSuccess) { grid = -1; return; }
        if (hipFuncSetAttribute((const void*)mk_fwd, hipFuncAttributeMaxDynamicSharedMemorySize, LDS_BYTES) != hipSuccess) { fprintf(stderr, "kernel_launch: hipFuncSetAttribute failed\n"); grid = -1; return; }
        int per_cu = 0;
        (void)hipOccupancyMaxActiveBlocksPerMultiprocessor(&per_cu, (const void*)mk_fwd, NWAVES * 64, LDS_BYTES);
        (void)hipGetLastError();
        grid = cus;
    }
    if (grid < 0) return;
    if (hipMemsetAsync((char*)d_ws + WS_CTL, 0, CTL_ZERO_BYTES, stream) != hipSuccess) return;
    Args a{};
    for (int i = 0; i < 58; ++i) a.in[i] = (const float*)d_in[i];
    a.out = (float*)d_out; a.ws = (unsigned char*)d_ws;
#if MK_ONE_LAUNCH
    a.ph_lo = 0; a.ph_hi = NPH;
    hipLaunchKernelGGL(mk_fwd, dim3(grid), dim3(NWAVES * 64), LDS_BYTES, stream, a);
#else
    for (int p = 0; p < NPH; ++p) { a.ph_lo = p; a.ph_hi = p + 1; hipLaunchKernelGGL(mk_fwd, dim3(grid), dim3(NWAVES * 64), LDS_BYTES, stream, a); }
#endif
}
```

```cpp
#include <hip/hip_runtime.h>
#include <cstdio>
#include <cstdint>
#define DI __device__ __forceinline__
namespace pg8 {
#define PG8_LAS __attribute__((address_space(3)))
typedef unsigned short bf16_t;
typedef short bf16x8 __attribute__((ext_vector_type(8)));
typedef float f32x4 __attribute__((ext_vector_type(4)));
typedef unsigned u32x4 __attribute__((ext_vector_type(4)));
constexpr int BM = 256, BK = 64, HALF = 128, HTB = HALF * BK * 2  , STAGE_BYTES = 8 * HTB, NXCD = 8, WGM = 8;

__host__ __device__ __forceinline__ int lds_byte(int r, int c) { const int st = (r >> 4) * 2 + (c >> 5), rr = r & 15, cc = c & 31, ob = rr * 64 + cc * 2; return st * 1024 + (ob ^ (((ob >> 9) & 1) << 5)); }
__host__ __device__ __forceinline__ void stage_rc(int b, int& R, int& C) { const int st = b / 1024, sb = b % 1024, swz = sb ^ (((sb >> 9) & 1) << 5); R = (st >> 1) * 16 + swz / 64; C = (st & 1) * 32 + (swz % 64) / 2; }
__host__ __device__ __forceinline__ int perm32(int rho) { const int n = rho >> 4, i = rho & 15; return 8 * (i >> 2) + 4 * n + (i & 3); }

struct Unit { int pm, pn; };
struct Gemm { const bf16_t* A; const bf16_t* Bt; int M, N, K, lda, ldb, akoff; };

struct StaticOrder {
    int nM, nN, nwg, G, c;
    __host__ __device__ void init(int M, int N, int G_, int c_) { nM = M / BM; nN = N / BM; nwg = nM * nN; G = G_; c = c_; }
    __host__ __device__ bool next(int i, Unit& u) const {
        const long L = (long)i * G + c; if (L >= nwg) return false;
        int wgid = (int)L; { const int q = nwg / NXCD, r = nwg % NXCD, xcd = wgid % NXCD, off = wgid / NXCD; wgid = (xcd < r ? xcd * (q + 1) : r * (q + 1) + (xcd - r) * q) + off; }
        const int nig = WGM * nN, gid = wgid / nig, fm = gid * WGM, gsz = (nM - fm) < WGM ? (nM - fm) : WGM;
        u.pm = fm + ((wgid % nig) % gsz); u.pn = (wgid % nig) / gsz; return true;
    }
    __device__ __forceinline__ void a_ready(const Unit&) const {}
    __device__ __forceinline__ void done(const Unit&) const {}
};
__device__ __forceinline__ unsigned cvt_pk_bf16(float lo, float hi) { unsigned r; asm volatile("v_cvt_pk_bf16_f32 %0, %1, %2" : "=v"(r) : "v"(lo), "v"(hi)); return r; }
template <class Epi, class Sched, bool ALIGN_EPI = false, bool SP2 = false>
__device__ __forceinline__ void gemm_phase(PG8_LAS unsigned char* lds, const Gemm g, const Sched& S, const Epi& E) {
    const int tid = threadIdx.x, wid = __builtin_amdgcn_readfirstlane(tid >> 6), lane = tid & 63, wr = wid >> 2, wc = wid & 3, fr = lane & 15, fq = lane >> 4;
    const int K = g.K, nt = K / BK;
    unsigned voffA[2], voffB[2];
#pragma unroll
    for (int i = 0; i < 2; ++i) { int R, C; stage_rc(tid * 16 + i * 8192, R, C); const int Rb = Epi::PERM ? ((R & ~31) + perm32(R & 31)) : R;
        voffA[i] = (unsigned)(R * g.lda + C) * 2u; voffB[i] = (unsigned)(Rb * g.ldb + C) * 2u; }
    const size_t kstep = (size_t)(BK * 2);
    const size_t hstepA = (size_t)HALF * g.lda * 2, hstepB = (size_t)HALF * g.ldb * 2;
    const size_t tstepA = 2 * hstepA, tstepB = 2 * hstepB;
    const unsigned ldsw = (unsigned)wid * 1024u;
    const int aoff = lds_byte(wr * 64 + fr, fq * 8), boff = lds_byte(wc * 32 + fr, fq * 8);
#define PG8_SA(b, h) (((b) * 2 + (h)) * HTB)
#define PG8_SB(b, h) ((4 + (b) * 2 + (h)) * HTB)
#define PG8_STAGE(bufoff, gbase, voff) do { _Pragma("unroll") for (int _i = 0; _i < 2; ++_i) \
        __builtin_amdgcn_global_load_lds((const unsigned*)((const char*)(gbase) + (voff)[_i]), (PG8_LAS unsigned*)(lds + (bufoff) + ldsw + _i * 8192), 16, 0, 0); } while (0)
#define PG8_LDA(dst, b, h) do { _Pragma("unroll") for (int m = 0; m < 4; ++m) _Pragma("unroll") for (int k = 0; k < 2; ++k) dst[m][k] = *(const PG8_LAS bf16x8*)(lds + PG8_SA(b, h) + aoff + m * 2048 + k * 1024); } while (0)
#define PG8_LDB(dst, b, h) do { _Pragma("unroll") for (int n = 0; n < 2; ++n) _Pragma("unroll") for (int k = 0; k < 2; ++k) dst[n][k] = *(const PG8_LAS bf16x8*)(lds + PG8_SB(b, h) + boff + n * 2048 + k * 1024); } while (0)
#define PG8_MMA(ai, bj, At, Bt) do { __builtin_amdgcn_s_setprio(1); _Pragma("unroll") for (int m = 0; m < 4; ++m) _Pragma("unroll") for (int n = 0; n < 2; ++n) _Pragma("unroll") for (int k = 0; k < 2; ++k) \
        acc[ai][bj][m][n] = __builtin_amdgcn_mfma_f32_16x16x32_bf16(Bt[n][k], At[m][k], acc[ai][bj][m][n], 0, 0, 0); __builtin_amdgcn_s_setprio(0); } while (0)
#define PG8_WAIT_V(n) asm volatile("s_waitcnt vmcnt(" #n ")" ::: "memory")
#define PG8_WAIT_L(n) asm volatile("s_waitcnt lgkmcnt(" #n ")" ::: "memory")
#define PG8_BAR __builtin_amdgcn_s_barrier()
#define PG8_SCHED __builtin_amdgcn_sched_barrier(0)
    Unit cur, nxt; int ui = 0;
    if (!S.next(0, cur)) return;
    f32x4 acc[2][2][4][2];
#pragma unroll
    for (int a = 0; a < 2; ++a)
#pragma unroll
        for (int b = 0; b < 2; ++b)
#pragma unroll
            for (int m = 0; m < 4; ++m)
#pragma unroll
                for (int n = 0; n < 2; ++n) acc[a][b][m][n] = (f32x4){0.f, 0.f, 0.f, 0.f};
    bf16x8 At[4][2], B0[2][2], B1[2][2];
    const char* cA = (const char*)g.A + (size_t)cur.pm * tstepA + (size_t)cur.pn * g.akoff * 2; const char* cB = (const char*)g.Bt + (size_t)cur.pn * tstepB;
    S.a_ready(cur);
    if constexpr (SP2) {
        PG8_STAGE(PG8_SB(0, 0), cB, voffB); PG8_STAGE(PG8_SB(0, 1), cB + hstepB, voffB); PG8_STAGE(PG8_SA(0, 0), cA, voffA); PG8_STAGE(PG8_SA(0, 1), cA + hstepA, voffA);
        if (wr == 1) PG8_BAR;
        PG8_WAIT_V(2); PG8_BAR;
        PG8_STAGE(PG8_SB(1, 0), cB + kstep, voffB); PG8_STAGE(PG8_SA(1, 0), cA + kstep, voffA); PG8_STAGE(PG8_SB(1, 1), cB + hstepB + kstep, voffB);
        PG8_WAIT_V(6); PG8_BAR;
    } else {
        PG8_STAGE(PG8_SB(0, 0), cB, voffB); PG8_STAGE(PG8_SA(0, 0), cA, voffA); PG8_STAGE(PG8_SB(0, 1), cB + hstepB, voffB); PG8_STAGE(PG8_SA(0, 1), cA + hstepA, voffA);
        if (wr == 1) PG8_BAR;
        PG8_WAIT_V(4); PG8_BAR;
        PG8_STAGE(PG8_SB(1, 0), cB + kstep, voffB); PG8_STAGE(PG8_SA(1, 0), cA + kstep, voffA); PG8_STAGE(PG8_SB(1, 1), cB + hstepB + kstep, voffB);
        PG8_WAIT_V(6); PG8_BAR;
    }
    for (;;) {
        const bool has_next = S.next(ui + 1, nxt);
        const char* nA = has_next ? (const char*)g.A + (size_t)nxt.pm * tstepA + (size_t)nxt.pn * g.akoff * 2 : cA; const char* nB = has_next ? (const char*)g.Bt + (size_t)nxt.pn * tstepB : cB;
        for (int t = 0; t < nt; t += 2) {
            const bool last = (t == nt - 2);
            const char* a1 = cA + (size_t)(t + 1) * kstep;
            const char* a2 = last ? nA : cA + (size_t)(t + 2) * kstep; const char* b2 = last ? nB : cB + (size_t)(t + 2) * kstep;
            const char* a3 = a2 + kstep; const char* b3 = b2 + kstep;
            if (last && has_next) S.a_ready(nxt);
            if constexpr (SP2) {
            PG8_LDB(B0, 0, 0); PG8_LDB(B1, 0, 1); PG8_SCHED; PG8_LDA(At, 0, 0); PG8_STAGE(PG8_SA(1, 1), a1 + hstepA, voffA);
            PG8_WAIT_V(8); PG8_WAIT_L(0); PG8_BAR; PG8_MMA(0, 0, At, B0); PG8_MMA(0, 1, At, B1); PG8_BAR; PG8_SCHED;
            PG8_LDA(At, 0, 1); PG8_STAGE(PG8_SB(0, 0), b2, voffB); PG8_STAGE(PG8_SB(0, 1), b2 + hstepB, voffB); PG8_STAGE(PG8_SA(0, 0), a2, voffA);
            PG8_WAIT_V(8); PG8_WAIT_L(0); PG8_BAR; PG8_MMA(1, 0, At, B0); PG8_MMA(1, 1, At, B1); PG8_BAR; PG8_SCHED;
            PG8_LDB(B0, 1, 0); PG8_LDB(B1, 1, 1); PG8_SCHED; PG8_LDA(At, 1, 0); PG8_STAGE(PG8_SA(0, 1), a2 + hstepA, voffA);
            PG8_WAIT_V(8); PG8_WAIT_L(0); PG8_BAR; PG8_MMA(0, 0, At, B0); PG8_MMA(0, 1, At, B1); PG8_BAR; PG8_SCHED;
            PG8_LDA(At, 1, 1); PG8_STAGE(PG8_SB(1, 0), b3, voffB); PG8_STAGE(PG8_SB(1, 1), b3 + hstepB, voffB); PG8_STAGE(PG8_SA(1, 0), a3, voffA);
            PG8_WAIT_V(8); PG8_WAIT_L(0); PG8_BAR; PG8_MMA(1, 0, At, B0); PG8_MMA(1, 1, At, B1); PG8_BAR; PG8_SCHED;
            } else {
            PG8_LDB(B0, 0, 0); PG8_SCHED; PG8_LDA(At, 0, 0); PG8_STAGE(PG8_SA(1, 1), a1 + hstepA, voffA);
            PG8_WAIT_L(8); PG8_BAR; PG8_WAIT_L(0); PG8_MMA(0, 0, At, B0); PG8_BAR; PG8_SCHED;
            PG8_LDB(B1, 0, 1); PG8_STAGE(PG8_SB(0, 0), b2, voffB);
            PG8_BAR; PG8_WAIT_L(0); PG8_MMA(0, 1, At, B1); PG8_BAR;
            PG8_LDA(At, 0, 1); PG8_STAGE(PG8_SA(0, 0), a2, voffA);
            PG8_BAR; PG8_WAIT_L(0); PG8_MMA(1, 0, At, B0); PG8_BAR; PG8_SCHED;
            PG8_STAGE(PG8_SB(0, 1), b2 + hstepB, voffB);
            PG8_WAIT_V(6); PG8_BAR; PG8_MMA(1, 1, At, B1); PG8_BAR;
            PG8_LDB(B0, 1, 0); PG8_SCHED; PG8_LDA(At, 1, 0); PG8_STAGE(PG8_SA(0, 1), a2 + hstepA, voffA);
            PG8_WAIT_L(8); PG8_BAR; PG8_WAIT_L(0); PG8_MMA(0, 0, At, B0); PG8_BAR; PG8_SCHED;
            PG8_LDB(B1, 1, 1); PG8_STAGE(PG8_SB(1, 0), b3, voffB);
            PG8_BAR; PG8_WAIT_L(0); PG8_MMA(0, 1, At, B1); PG8_BAR;
            PG8_LDA(At, 1, 1); PG8_STAGE(PG8_SA(1, 0), a3, voffA);
            PG8_BAR; PG8_WAIT_L(0); PG8_MMA(1, 0, At, B0); PG8_BAR; PG8_SCHED;
            PG8_STAGE(PG8_SB(1, 1), b3 + hstepB, voffB);
            PG8_WAIT_V(6); PG8_BAR; PG8_MMA(1, 1, At, B1); PG8_BAR;
            }
        }
        if constexpr (ALIGN_EPI) { if (wr == 0) PG8_BAR; }
        if constexpr (!Epi::AFTER_DRAIN) { E(acc, cur, wr, wc, fr, fq); S.done(cur); }
        if (!has_next) break;
#pragma unroll
        for (int a = 0; a < 2; ++a)
#pragma unroll
            for (int b = 0; b < 2; ++b)
#pragma unroll
                for (int m = 0; m < 4; ++m)
#pragma unroll
                    for (int n = 0; n < 2; ++n) acc[a][b][m][n] = (f32x4){0.f, 0.f, 0.f, 0.f};
        cur = nxt; cA = nA; cB = nB; ++ui;
        if constexpr (ALIGN_EPI) { if (wr == 1) PG8_BAR; }
    }
    PG8_WAIT_V(0);
    if constexpr (!ALIGN_EPI) { if (wr == 0) PG8_BAR; }
    PG8_BAR;
    if constexpr (Epi::AFTER_DRAIN) { E.fused(acc, cur, wr, wc, fr, fq, lds, wid, lane); S.done(cur); }
#undef PG8_SA
#undef PG8_SB
#undef PG8_STAGE
#undef PG8_LDA
#undef PG8_LDB
#undef PG8_MMA
#undef PG8_WAIT_V
#undef PG8_WAIT_L
#undef PG8_BAR
#undef PG8_SCHED
}
}
namespace pg8 {
typedef float f32x2 __attribute__((ext_vector_type(2)));
__device__ __forceinline__ float rms_rowscale(const float* ssq, int row) { const f32x4 a = *(const f32x4*)(ssq + (size_t)row * 8), b = *(const f32x4*)(ssq + (size_t)row * 8 + 4);
    return __builtin_amdgcn_rsqf((((a[0] + a[1]) + (a[2] + a[3])) + ((b[0] + b[1]) + (b[2] + b[3]))) * (1.0f / 2048.0f) + 1e-6f); }
struct SegTab { bf16_t* base[8]; int ldc[8]; int t0[8]; int gw[8]; int nseg; int pad_; };
struct EpiBf16R {
    static constexpr bool PERM = true, AFTER_DRAIN = false;
    SegTab T; const float* ssp; int ss_off;
    __device__ __forceinline__ void operator()(const f32x4 (&acc)[2][2][4][2], const Unit& u, int wr, int wc, int fr, int fq) const {
        bf16_t* base = T.base[0]; int ldc = T.ldc[0], gw = T.gw[0], t0 = T.t0[0];
#pragma unroll
        for (int s = 1; s < 8; ++s) if (s < T.nseg && u.pn >= T.t0[s]) { base = T.base[s]; ldc = T.ldc[s]; gw = T.gw[s]; t0 = T.t0[s]; }
        const int colt = (u.pn - t0) * BM, row0 = u.pm * BM + wr * 64 + fr;
#pragma unroll
        for (int ai = 0; ai < 2; ++ai)
#pragma unroll
            for (int m = 0; m < 4; ++m) { const int row = row0 + ai * HALF + m * 16;
                const float rs = ssp ? rms_rowscale(ssp, ss_off + row) : 1.0f;
#pragma unroll
                for (int bj = 0; bj < 2; ++bj) { const int col = colt + bj * HALF + wc * 32 + 8 * fq;
                    const f32x4 v0 = acc[ai][bj][m][0] * rs, v1 = acc[ai][bj][m][1] * rs;
                    u32x4 w; w.x = cvt_pk_bf16(v0[0], v0[1]); w.y = cvt_pk_bf16(v0[2], v0[3]); w.z = cvt_pk_bf16(v1[0], v1[1]); w.w = cvt_pk_bf16(v1[2], v1[3]);
                    if (gw == -2) {
                        if ((row >> 5) < ldc) { bf16_t* d0 = base + ((size_t)(((col >> 5) * ldc + (row >> 5)) * 2 + ((col >> 4) & 1)) * 64 + (row & 31)) * 8 + 4 * ((col >> 3) & 1);
                            typedef unsigned u32x2_ __attribute__((ext_vector_type(2)));
                            *(u32x2_*)d0 = (u32x2_){w.x, w.y}; *(u32x2_*)(d0 + 32 * 8) = (u32x2_){w.z, w.w}; }
                        continue; }
                    bf16_t* dst;
                    if (gw == 0) dst = base + (size_t)row * ldc + col;
                    else if (gw == -1) { if ((col >> 4) >= ldc) continue; dst = base + ((size_t)((row >> 5) * ldc + (col >> 4)) * 64 + ((col >> 3) & 1) * 32 + (row & 31)) * 8; }
                    else { const int g = col / gw, d = col - g * gw; dst = base + ((size_t)((row >> 12) * 4 + g) * 4096 + (row & 4095)) * gw + d; }
                    *(u32x4*)dst = w; } }
    }
};
struct EpiGelu {
    static constexpr bool PERM = true, AFTER_DRAIN = false;
    bf16_t* O; int ldc; const float* bias;
    static __device__ __forceinline__ float gelu(float x) { const float u2 = 1.5957691216f * (x + 0.044715f * x * x * x); const float e = __builtin_amdgcn_exp2f(-u2 * 1.4426950409f); return x * __builtin_amdgcn_rcpf(1.0f + e); }
    __device__ __forceinline__ void operator()(const f32x4 (&acc)[2][2][4][2], const Unit& u, int wr, int wc, int fr, int fq) const {
        const int row0 = u.pm * BM + wr * 64 + fr, col0 = u.pn * BM + wc * 32 + 8 * fq;
#pragma unroll
        for (int bj = 0; bj < 2; ++bj) { const f32x4 b0 = *(const f32x4*)(bias + col0 + bj * HALF), b1 = *(const f32x4*)(bias + col0 + bj * HALF + 4);
#pragma unroll
            for (int ai = 0; ai < 2; ++ai)
#pragma unroll
                for (int m = 0; m < 4; ++m) { const f32x4 v0 = acc[ai][bj][m][0] + b0, v1 = acc[ai][bj][m][1] + b1;
                    u32x4 w; w.x = cvt_pk_bf16(gelu(v0[0]), gelu(v0[1])); w.y = cvt_pk_bf16(gelu(v0[2]), gelu(v0[3])); w.z = cvt_pk_bf16(gelu(v1[0]), gelu(v1[1])); w.w = cvt_pk_bf16(gelu(v1[2]), gelu(v1[3]));
                    *(u32x4*)(O + (size_t)(row0 + ai * HALF + m * 16) * ldc + col0 + bj * HALF) = w; } }
    }
};
struct EpiF32 {
    static constexpr bool PERM = false, AFTER_DRAIN = false;
    float* C; int ldc; const float* ssp; int ss_off;
    __device__ __forceinline__ void operator()(const f32x4 (&acc)[2][2][4][2], const Unit& u, int wr, int wc, int fr, int fq) const {
        const int row0 = u.pm * BM + wr * 64 + fr, col0 = u.pn * BM + wc * 32 + 4 * fq;
#pragma unroll
        for (int ai = 0; ai < 2; ++ai)
#pragma unroll
            for (int m = 0; m < 4; ++m) { float* rowp = C + (size_t)(row0 + ai * HALF + m * 16) * ldc + col0;
                const float rs = ssp ? rms_rowscale(ssp, ss_off + row0 + ai * HALF + m * 16) : 1.0f;
#pragma unroll
                for (int bj = 0; bj < 2; ++bj)
#pragma unroll
                    for (int n = 0; n < 2; ++n) *(f32x4*)(rowp + bj * HALF + n * 16) = acc[ai][bj][m][n] * rs; }
    }
};
struct EpiRes {
    static constexpr bool PERM = false, AFTER_DRAIN = false;
    const float* res; float* out; int ldc; int row_off;
    __device__ __forceinline__ void operator()(const f32x4 (&acc)[2][2][4][2], const Unit& u, int wr, int wc, int fr, int fq) const {
        const int row0 = row_off + u.pm * BM + wr * 64 + fr, col0 = u.pn * BM + wc * 32 + 4 * fq;
#pragma unroll
        for (int ai = 0; ai < 2; ++ai)
#pragma unroll
            for (int m = 0; m < 4; ++m) { const size_t off = (size_t)(row0 + ai * HALF + m * 16) * ldc + col0;
                f32x4 r[2][2];
#pragma unroll
                for (int bj = 0; bj < 2; ++bj)
#pragma unroll
                    for (int n = 0; n < 2; ++n) r[bj][n] = *(const f32x4*)(res + off + bj * HALF + n * 16);
#pragma unroll
                for (int bj = 0; bj < 2; ++bj)
#pragma unroll
                    for (int n = 0; n < 2; ++n) *(f32x4*)(out + off + bj * HALF + n * 16) = r[bj][n] + acc[ai][bj][m][n];
                asm volatile("" ::: "memory"); }
    }
};
struct EpiDry {
    static constexpr bool PERM = false, AFTER_DRAIN = false;
    float* D;
    __device__ __forceinline__ void operator()(const f32x4 (&acc)[2][2][4][2], const Unit& u, int wr, int wc, int fr, int fq) const {
        float* p = D + ((size_t)blockIdx.x * 512 + threadIdx.x) * 64;
#pragma unroll
        for (int ai = 0; ai < 2; ++ai)
#pragma unroll
            for (int m = 0; m < 4; ++m)
#pragma unroll
                for (int bj = 0; bj < 2; ++bj) *(f32x4*)(p + ((ai * 4 + m) * 2 + bj) * 4) = acc[ai][bj][m][0] + acc[ai][bj][m][1];
    }
};
struct EpiResN {
    static constexpr bool PERM = false, AFTER_DRAIN = false;
    const float* res32; const float* gprev; float* out32; int ldc; int row_off; const float* g; bf16_t* xn; float* ss; PG8_LAS float* xb;
    __device__ __forceinline__ void operator()(const f32x4 (&acc)[2][2][4][2], const Unit& u, int wr, int wc, int fr, int fq) const {
        typedef unsigned u32x2_ __attribute__((ext_vector_type(2)));
        const int row0 = row_off + u.pm * BM + wr * 64 + fr, col0 = u.pn * BM + wc * 32 + 4 * fq;
        f32x4 gv[2][2], gi[2][2];
#pragma unroll
        for (int bj = 0; bj < 2; ++bj)
#pragma unroll
            for (int n = 0; n < 2; ++n) { gv[bj][n] = g ? *(const f32x4*)(g + col0 + bj * HALF + n * 16) : (f32x4){0.f, 0.f, 0.f, 0.f};
                if (!res32) { const f32x4 t = *(const f32x4*)(gprev + col0 + bj * HALF + n * 16); gi[bj][n] = (f32x4){1.0f / t[0], 1.0f / t[1], 1.0f / t[2], 1.0f / t[3]}; } else gi[bj][n] = (f32x4){1.f, 1.f, 1.f, 1.f}; }
#pragma unroll
        for (int ai = 0; ai < 2; ++ai)
#pragma unroll
            for (int m = 0; m < 4; ++m) { const int row = row0 + ai * HALF + m * 16; const size_t off = (size_t)row * ldc + col0;
                f32x4 r[2][2]; float sq = 0.f;
#pragma unroll
                for (int bj = 0; bj < 2; ++bj)
#pragma unroll
                    for (int n = 0; n < 2; ++n) {
                        if (res32) r[bj][n] = *(const f32x4*)(res32 + off + bj * HALF + n * 16);
                        else { const u32x2_ w = *(const u32x2_*)(xn + off + bj * HALF + n * 16);
                            r[bj][n] = (f32x4){__builtin_bit_cast(float, w.x << 16), __builtin_bit_cast(float, w.x & 0xffff0000u), __builtin_bit_cast(float, w.y << 16), __builtin_bit_cast(float, w.y & 0xffff0000u)} * gi[bj][n]; } }
#pragma unroll
                for (int bj = 0; bj < 2; ++bj)
#pragma unroll
                    for (int n = 0; n < 2; ++n) { const f32x4 o = r[bj][n] + acc[ai][bj][m][n];
                        if (out32) *(f32x4*)(out32 + off + bj * HALF + n * 16) = o;
                        if (g) { sq += (o[0] * o[0] + o[1] * o[1]) + (o[2] * o[2] + o[3] * o[3]);
                            const f32x4 y = o * gv[bj][n]; *(u32x2_*)(xn + off + bj * HALF + n * 16) = (u32x2_){cvt_pk_bf16(y[0], y[1]), cvt_pk_bf16(y[2], y[3])}; } }
                if (g) { sq += __shfl_xor(sq, 16); sq += __shfl_xor(sq, 32);
                    if (fq == 0) xb[(ai * HALF + wr * 64 + m * 16 + fr) * 4 + wc] = sq; }
                asm volatile("" ::: "memory"); }
        if (g) {
            asm volatile("s_waitcnt lgkmcnt(0)" ::: "memory"); __builtin_amdgcn_s_barrier(); asm volatile("" ::: "memory");
            const int t = (wr * 4 + wc) * 64 + fq * 16 + fr;
            if (t < BM) { const f32x4 v = *(const PG8_LAS f32x4*)(xb + t * 4); ss[(size_t)(row_off + u.pm * BM + t) * 8 + u.pn] = (v[0] + v[1]) + (v[2] + v[3]); }
        }
    }
};
struct EpiConvGlu {
    static constexpr bool PERM = true, AFTER_DRAIN = false;
    bf16_t* G; float* UB; const float* cw; const float* cb; PG8_LAS float* xb; int dff; const PG8_LAS float* rstd; int rbase;
    static __device__ __forceinline__ float shr(float old, float src, int n) { const int o = __builtin_bit_cast(int, old), s = __builtin_bit_cast(int, src);
        return __builtin_bit_cast(float, n == 1 ? __builtin_amdgcn_update_dpp(o, s, 0x111, 0xf, 0xf, false) : __builtin_amdgcn_update_dpp(o, s, 0x112, 0xf, 0xf, false)); }
    static __device__ __forceinline__ float ror(float src, int n) { const int s = __builtin_bit_cast(int, src);
        return __builtin_bit_cast(float, n == 1 ? __builtin_amdgcn_update_dpp(0, s, 0x121, 0xf, 0xf, false) : __builtin_amdgcn_update_dpp(0, s, 0x122, 0xf, 0xf, false)); }
    __device__ __forceinline__ void operator()(f32x4 (&acc)[2][2][4][2], const Unit& u, int wr, int wc, int fr, int fq) const {
        typedef unsigned u32x2_ __attribute__((ext_vector_type(2)));
        if (rstd) {
#pragma unroll
            for (int ai = 0; ai < 2; ++ai)
#pragma unroll
                for (int m = 0; m < 4; ++m) { const float rs = rstd[u.pm * BM + ai * HALF + wr * 64 + m * 16 + fr - rbase];
#pragma unroll
                    for (int bj = 0; bj < 2; ++bj)
#pragma unroll
                        for (int n = 0; n < 2; ++n) acc[ai][bj][m][n] = acc[ai][bj][m][n] * rs; }
        }
        if (fr >= 14) {
#pragma unroll
            for (int ai = 0; ai < 2; ++ai)
#pragma unroll
                for (int bj = 0; bj < 2; ++bj)
#pragma unroll
                    for (int n = 0; n < 2; ++n) *(PG8_LAS f32x4*)(xb + (((((ai * 2 + wr) * 4 + wc) * 2 + (fr - 14)) * 4 + fq) * 16) + (bj * 2 + n) * 4) = acc[ai][bj][3][n];
        }
        { const int ncol = 4 * dff / 2;
          const bool top = (wr == 0 && fr < 2), bot = (wr == 1 && fr >= 14);
          if (top || bot) { float* ub = UB + ((size_t)(u.pm * 4 + (top ? fr : 2 + fr - 14)) * ncol) + u.pn * BM + wc * 32 + 8 * fq;
#pragma unroll
            for (int bj = 0; bj < 2; ++bj)
#pragma unroll
                for (int n = 0; n < 2; ++n) *(f32x4*)(ub + bj * HALF + 4 * n) = top ? acc[0][bj][0][n] : acc[1][bj][3][n]; } }
        asm volatile("s_waitcnt lgkmcnt(0)" ::: "memory"); __builtin_amdgcn_s_barrier(); asm volatile("" ::: "memory");
        u32x2_ res[2][4][2];
        const int ch0 = u.pn * HALF + wc * 32 + 8 * fq;
#pragma unroll
        for (int n = 0; n < 2; ++n) {
            const float* wp = cw + ch0 + 4 * n; const float* bp = cb + ch0 + 4 * n;
            const f32x4 w0g = *(const f32x4*)(wp), w1g = *(const f32x4*)(wp + 2 * dff), w2g = *(const f32x4*)(wp + 4 * dff), bg = *(const f32x4*)(bp);
            const f32x4 w0v = *(const f32x4*)(wp + dff), w1v = *(const f32x4*)(wp + 3 * dff), w2v = *(const f32x4*)(wp + 5 * dff), bv = *(const f32x4*)(bp + dff);
#pragma unroll
            for (int ai = 0; ai < 2; ++ai)
#pragma unroll
                for (int m = 0; m < 4; ++m) {
                    const f32x4 cg = acc[ai][0][m][n], cv = acc[ai][1][m][n];
                    f32x4 b1g, b2g, b1v, b2v;
                    if (m > 0) {
#pragma unroll
                        for (int e = 0; e < 4; ++e) { b1g[e] = ror(acc[ai][0][m - 1][n][e], 1); b2g[e] = ror(acc[ai][0][m - 1][n][e], 2); b1v[e] = ror(acc[ai][1][m - 1][n][e], 1); b2v[e] = ror(acc[ai][1][m - 1][n][e], 2); }
                    } else {
                        const int sai = wr ? ai : ai - 1, swr = wr ? 0 : 1;
                        f32x4 x14g = {0.f, 0.f, 0.f, 0.f}, x15g = x14g, x14v = x14g, x15v = x14g;
                        if (sai >= 0) { const PG8_LAS float* xp = xb + (((((sai * 2 + swr) * 4 + wc) * 2) * 4 + fq) * 16);
                            x14g = *(const PG8_LAS f32x4*)(xp + n * 4); x14v = *(const PG8_LAS f32x4*)(xp + (2 + n) * 4); x15g = *(const PG8_LAS f32x4*)(xp + 64 + n * 4); x15v = *(const PG8_LAS f32x4*)(xp + 64 + (2 + n) * 4); }
                        b1g = x15g; b1v = x15v; b2g = fr == 0 ? x14g : x15g; b2v = fr == 0 ? x14v : x15v;
                    }
                    float o[4];
#pragma unroll
                    for (int e = 0; e < 4; ++e) {
                        const float p1g = shr(b1g[e], cg[e], 1), p2g = shr(b2g[e], cg[e], 2), p1v = shr(b1v[e], cv[e], 1), p2v = shr(b2v[e], cv[e], 2);
                        const float yg = bg[e] + w0g[e] * p2g + w1g[e] * p1g + w2g[e] * cg[e], yv = bv[e] + w0v[e] * p2v + w1v[e] * p1v + w2v[e] * cv[e];
                        o[e] = yg * __builtin_amdgcn_rcpf(1.0f + __builtin_amdgcn_exp2f(-yg * 1.4426950409f)) * yv;
                    }
                    res[ai][m][n] = (u32x2_){cvt_pk_bf16(o[0], o[1]), cvt_pk_bf16(o[2], o[3])};
                }
        }
        const int row0 = u.pm * BM + wr * 64 + fr;
#pragma unroll
        for (int ai = 0; ai < 2; ++ai)
#pragma unroll
            for (int m = 0; m < 4; ++m) *(u32x4*)(G + (size_t)(row0 + ai * HALF + m * 16) * dff + ch0) = (u32x4){res[ai][m][0].x, res[ai][m][0].y, res[ai][m][1].x, res[ai][m][1].y};
    }
};
}
constexpr int BATCH = 8, SEQ = 4096, DM = 2048, MTOT = BATCH * SEQ, MC = MTOT / 2  , BPH = BATCH / 2;
constexpr int DFF = 5632;
constexpr float NORM_EPS = 1e-6f, LOG2E = 1.4426950408889634f;
constexpr int NWAVES = 8;
constexpr size_t MiB = 1u << 20;
constexpr size_t WS_CTL = 0, CTL_ZERO_BYTES = 1 * MiB;
constexpr size_t WS_TAB = 1 * MiB;
constexpr size_t TAB_COS48 = WS_TAB, TAB_SIN48 = WS_TAB + 3 * MiB, TAB_COS32 = WS_TAB + 6 * MiB, TAB_SIN32 = WS_TAB + 8 * MiB;
constexpr size_t WS_WMIX = 12 * MiB;
constexpr size_t WS_WFFN = 100 * MiB;
constexpr size_t WS_MISC = 168 * MiB;
constexpr size_t WS_SS = 170 * MiB;
constexpr size_t WS_XN = 180 * MiB;
constexpr size_t WS_XNR = 1010 * MiB;
constexpr size_t WS_AR = 234 * MiB;
constexpr size_t WS_END = 1138 * MiB;
constexpr size_t DUMMY_OFF = 0;
constexpr int CW_TMO = 0;
constexpr int CW_BAR = 4096;
constexpr int RING_BYTES = 131072;
constexpr int LDSCTL_OFF = 135168;
constexpr int LDS_BYTES = 163840;

#define GAS __attribute__((address_space(1)))
#define LAS __attribute__((address_space(3)))
typedef unsigned short bf16;
typedef unsigned u32x4 __attribute__((ext_vector_type(4)));
typedef unsigned u32x2 __attribute__((ext_vector_type(2)));
typedef float f32x4 __attribute__((ext_vector_type(4)));
typedef float f32x16 __attribute__((ext_vector_type(16)));
typedef short bf16x8 __attribute__((ext_vector_type(8)));
typedef short s16x4 __attribute__((ext_vector_type(4)));
typedef short v4i16_t __attribute__((ext_vector_type(4)));
typedef __bf16 bf16x2_t __attribute__((ext_vector_type(2)));
typedef float f32x2_t __attribute__((ext_vector_type(2)));
#define LDS_WAIT() asm volatile("s_waitcnt lgkmcnt(0)" ::: "memory")
#define VM_WAIT() asm volatile("s_waitcnt vmcnt(0)" ::: "memory")
#define MFMA32(a, b, c) __builtin_amdgcn_mfma_f32_32x32x16_bf16((a), (b), (c), 0, 0, 0)
DI unsigned pk2(float lo, float hi) { f32x2_t v = {lo, hi}; bf16x2_t b = __builtin_convertvector(v, bf16x2_t); return __builtin_bit_cast(unsigned, b); }
DI float bf2f(unsigned short b) { return __builtin_bit_cast(float, (unsigned)b << 16); }
DI float bflo(unsigned w) { return __builtin_bit_cast(float, w << 16); }
DI float bfhi(unsigned w) { return __builtin_bit_cast(float, w & 0xffff0000u); }
DI unsigned short f2bf(float f) { return (unsigned short)(pk2(f, 0.f) & 0xffffu); }
DI float wave_sum(float v) {
#pragma unroll
    for (int o = 1; o < 64; o <<= 1) v += __shfl_xor(v, o);
    return v;
}
DI int crow(int i, int h) { return (i & 3) + 8 * (i >> 2) + 4 * h; }
#define XB_TMO      128
#define XB_XCNT(j)  (256  + 64 * (j))
#define XB_XSUB(j)  (1280 + 64 * (j))
#define XB_XGEN(j)  (2304 + 64 * (j))
#define XB_TOP      3328
#define XB_TOPGEN   3392
#define XCD_BAR_WORDS 3456
#define XB_SPIN_CAP (1u << 18)

__device__ __forceinline__ unsigned xb_ld(unsigned* p)              { return __hip_atomic_load(p, __ATOMIC_RELAXED, __HIP_MEMORY_SCOPE_AGENT); }
__device__ __forceinline__ unsigned xb_add(unsigned* p, unsigned v) { return __hip_atomic_fetch_add(p, v, __ATOMIC_RELAXED, __HIP_MEMORY_SCOPE_AGENT); }
__device__ __forceinline__ unsigned xb_xcc_id() { return (unsigned)__builtin_amdgcn_s_getreg((3 << 11) | 20) & 0xFu; }
#define XB_SPIN(cond, bar) do { unsigned _sp = 0; while (cond) { __builtin_amdgcn_s_sleep(1); \
    if ((++_sp & 255u) == 0u) { if (xb_ld(&(bar)[XB_TMO])) break; if (_sp > XB_SPIN_CAP) { atomicAdd(&(bar)[XB_TMO], 1u); break; } } } } while (0)

struct XcdBarrier {
    unsigned* bar; unsigned x;
    volatile LAS unsigned* st;
};

__device__ __forceinline__ XcdBarrier xcd_barrier_post(unsigned* bar, volatile LAS unsigned* st) {
    XcdBarrier b; b.bar = bar; b.x = xb_xcc_id(); b.st = st;
    if (threadIdx.x == 0) (void)xb_add(&bar[XB_XCNT(b.x)], 1u);
    return b;
}
__device__ __forceinline__ void xcd_barrier_complete(unsigned* bar, unsigned x, unsigned& nloc, unsigned& nx) {
    const unsigned G = gridDim.x * gridDim.y * gridDim.z;
    unsigned sum, cnt, mine, sp = 0u;
    for (;;) {
        sum = 0u; cnt = 0u; mine = 0u;
#pragma unroll
        for (unsigned j = 0; j < 16; ++j) { const unsigned c = xb_ld(&bar[XB_XCNT(j)]); sum += c; cnt += (c > 0u) ? 1u : 0u; mine = (j == x) ? c : mine; }
        if (sum == G) break;
        __builtin_amdgcn_s_sleep(1);
        if ((++sp & 255u) == 0u) { if (xb_ld(&bar[XB_TMO])) break; if (sp > XB_SPIN_CAP) { atomicAdd(&bar[XB_TMO], 1u); break; } }
    }
    nloc = mine > 0u ? mine : 1u; nx = cnt > 0u ? cnt : 1u;
}

__device__ __forceinline__ void xcd_barrier(const XcdBarrier& b) {
    asm volatile("s_waitcnt vmcnt(0)" ::: "memory");
    __syncthreads();
    if (threadIdx.x == 0) {
        unsigned* bar = b.bar;
        __builtin_amdgcn_s_waitcnt(0);
        unsigned nloc = b.st[0], nx = b.st[1];
        if (nloc == 0u) { xcd_barrier_complete(bar, b.x, nloc, nx); b.st[0] = nloc; b.st[1] = nx; }
        const unsigned old = xb_add(&bar[XB_XSUB(b.x)], 1u);
        const unsigned gen = old / nloc;
        if (old + 1u == (gen + 1u) * nloc) {
            __builtin_amdgcn_fence(__ATOMIC_RELEASE, "agent");
            asm volatile("s_waitcnt vmcnt(0)" ::: "memory");
            const unsigned og = xb_add(&bar[XB_TOP], 1u);
            const unsigned tg = og / nx;
            if (og + 1u == (tg + 1u) * nx) xb_add(&bar[XB_TOPGEN], 1u);
            else XB_SPIN(xb_ld(&bar[XB_TOPGEN]) == tg, bar);
            __builtin_amdgcn_fence(__ATOMIC_ACQUIRE, "agent");
            xb_add(&bar[XB_XGEN(b.x)], 1u);
            asm volatile("s_waitcnt vmcnt(0)" ::: "memory");
        } else {
            XB_SPIN(xb_ld(&bar[XB_XGEN(b.x)]) == gen, bar);
            __builtin_amdgcn_fence(__ATOMIC_ACQUIRE, "agent");
            asm volatile("s_waitcnt vmcnt(0)" ::: "memory");
        }
    }
    __syncthreads();
}
struct Frame {
    LAS unsigned char* lds; unsigned* ctl; unsigned char* ws;
    int tid, lane, wave, G, gw, NGW;
};
DI void ph_tables(const Frame& F, const int* pos) {
    float* c48 = (float*)(F.ws + TAB_COS48); float* s48 = (float*)(F.ws + TAB_SIN48); float* c32 = (float*)(F.ws + TAB_COS32); float* s32 = (float*)(F.ws + TAB_SIN32);
    const int gt = blockIdx.x * (NWAVES * 64) + F.tid, NT = F.G * NWAVES * 64;
    for (int i = gt; i < MTOT * 40; i += NT) {
        const int m = i / 40, j = i - m * 40; const float p = (float)pos[m];
        const bool a = j < 24; const int jj = a ? j : j - 24;
        const float inv = (float)exp(-(2.0 * jj / (a ? 48.0 : 32.0)) * 13.122363377404328);
        const float ang = p * inv; float sn, cs; sincosf(ang, &sn, &cs);
        if (a) { c48[m * 24 + jj] = cs; s48[m * 24 + jj] = sn; } else { c32[m * 16 + jj] = cs; s32[m * 16 + jj] = sn; }
    }
}
DI void cvt_load(float (&v)[32], const float* W, int ldw, int col0, int ncols, int item, int nblk, int lane) {
    const int kb = item / nblk, nb = item - kb * nblk, k0 = 64 * kb, n0 = 32 * nb, nn = n0 + (lane & 31); const bool ok = nn < ncols;
    const float* p = W + (size_t)(k0 + (lane >> 5)) * ldw + col0 + (ok ? nn : 0);
#pragma unroll
    for (int i = 0; i < 32; ++i) { const float x = p[(size_t)(2 * i) * ldw]; v[i] = ok ? x : 0.f; }
}
DI void cvt_store(const float (&v)[32], int ncols, bf16* WT, int ldt, int row_off, float scale, LAS float* scr, int item, int nblk, int lane) {
    const int kb = item / nblk, nb = item - kb * nblk, k0 = 64 * kb, n0 = 32 * nb;
#pragma unroll
    for (int i = 0; i < 32; ++i) scr[(2 * i + (lane >> 5)) * 33 + (lane & 31)] = v[i] * scale;
    LDS_WAIT();
    const int c = lane & 7;
#pragma unroll
    for (int j = 0; j < 4; ++j) { const int n = (lane >> 3) + 8 * j; const LAS float* s = scr + (8 * c) * 33 + n;
        u32x4 o; o.x = pk2(s[0 * 33], s[1 * 33]); o.y = pk2(s[2 * 33], s[3 * 33]); o.z = pk2(s[4 * 33], s[5 * 33]); o.w = pk2(s[6 * 33], s[7 * 33]);
        if (n0 + n < ncols) *(u32x4*)(WT + (size_t)(row_off + n0 + n) * ldt + k0 + 8 * c) = o; }
    LDS_WAIT();
}
DI void cvt_item(const float* W, int ldw, int col0, int ncols, bf16* WT, int ldt, int row_off, float scale, LAS float* scr, int item, int nblk, int lane) {
    float v[32]; cvt_load(v, W, ldw, col0, ncols, item, nblk, lane); cvt_store(v, ncols, WT, ldt, row_off, scale, scr, item, nblk, lane);
}
template <class MAP> DI void cvt_loop(const Frame& F, const float* W, int ldw, int ncols, bf16* WT, int ldt, float scale, int nitems, int nblk, const MAP& map) {
    LAS float* scr = (LAS float*)(F.lds + F.wave * 16384);
    int it = F.gw; float cur[32]; int c0 = 0, ro = 0, li = 0;
    if (it < nitems) { map(it, c0, ro, li); cvt_load(cur, W, ldw, c0, ncols, li, nblk, F.lane); }
#pragma unroll 1
    for (; it < nitems; it += F.NGW) {
        float nxt[32]; int c1 = 0, r1 = 0, l1 = 0; const int ni = it + F.NGW;
        if (ni < nitems) { map(ni, c1, r1, l1); cvt_load(nxt, W, ldw, c1, ncols, l1, nblk, F.lane); }
        cvt_store(cur, ncols, WT, ldt, ro, scale, scr, li, nblk, F.lane);
#pragma unroll
        for (int i = 0; i < 32; ++i) cur[i] = nxt[i];
        c0 = c1; ro = r1; li = l1;
    }
}
struct CvtPlain { int col0, row_off; DI void operator()(int it, int& c, int& r, int& l) const { c = col0; r = row_off; l = it; } };
DI void cvt_job(const Frame& F, const float* W, int ldw, int K, int col0, int ncols, bf16* WT, int ldt, int row_off, float scale) {
    const int nblk = (ncols + 31) / 32;
    cvt_loop(F, W, ldw, ncols, WT, ldt, scale, (K / 64) * nblk, nblk, CvtPlain{col0, row_off});
}
DI void zero_bf16(const Frame& F, bf16* p, size_t nelem) {
    const size_t gt = (size_t)blockIdx.x * (NWAVES * 64) + F.tid, NT = (size_t)F.G * NWAVES * 64;
    for (size_t i = gt; i < nelem / 8; i += NT) ((u32x4*)p)[i] = (u32x4){0u, 0u, 0u, 0u};
}
DI void ph_cvt_ffn(const Frame& F, const float* up, const float* down) {
    bf16* WUP = (bf16*)(F.ws + WS_WFFN); bf16* WDN = WUP + (size_t)2 * DFF * DM;
    struct UpMap { DI void operator()(int it, int& c, int& r, int& l) const { const int seg = it >> 7, pn = seg >> 1, isv = seg & 1; c = isv * DFF + pn * 128; r = pn * 256 + isv * 128; l = it & 127; } };
    cvt_loop(F, up, 2 * DFF, 128, WUP, DM, 1.f, 88 * 128, 4, UpMap{});
    cvt_job(F, down, DM, DFF, 0, DM, WDN, DFF, 0, 1.f);
}
DI void ph_conv_fix(const Frame& F, const float* UB, bf16* Gb, const float* cw, const float* cb, const int nrows = MC) {
    const int gt = blockIdx.x * (NWAVES * 64) + F.tid, NT = F.G * NWAVES * 64;
    for (int it = gt; it < (nrows / 256) * (DFF / 4); it += NT) {
        const int pm = it / (DFF / 4), c4 = it - pm * (DFF / 4), ch = c4 * 4, col = (ch >> 7) * 256 + (ch & 127);
        const float* ub = UB + (size_t)pm * 4 * (2 * DFF) + col; const bool has = (pm & 15) != 0;
        const f32x4 z = {0.f, 0.f, 0.f, 0.f};
        const f32x4 g0 = *(const f32x4*)(ub), g1 = *(const f32x4*)(ub + 2 * DFF), v0 = *(const f32x4*)(ub + 128), v1 = *(const f32x4*)(ub + 2 * DFF + 128);
        const f32x4 gm2 = has ? *(const f32x4*)(ub - 2 * (2 * DFF)) : z, gm1 = has ? *(const f32x4*)(ub - (2 * DFF)) : z, vm2 = has ? *(const f32x4*)(ub - 2 * (2 * DFF) + 128) : z, vm1 = has ? *(const f32x4*)(ub - (2 * DFF) + 128) : z;
        const f32x4 w0g = *(const f32x4*)(cw + ch), w1g = *(const f32x4*)(cw + 2 * DFF + ch), w2g = *(const f32x4*)(cw + 4 * DFF + ch), bg = *(const f32x4*)(cb + ch);
        const f32x4 w0v = *(const f32x4*)(cw + DFF + ch), w1v = *(const f32x4*)(cw + 3 * DFF + ch), w2v = *(const f32x4*)(cw + 5 * DFF + ch), bv = *(const f32x4*)(cb + DFF + ch);
        float o0[4], o1[4];
#pragma unroll
        for (int e = 0; e < 4; ++e) {
            const float yg0 = bg[e] + w0g[e] * gm2[e] + w1g[e] * gm1[e] + w2g[e] * g0[e], yv0 = bv[e] + w0v[e] * vm2[e] + w1v[e] * vm1[e] + w2v[e] * v0[e];
            const float yg1 = bg[e] + w0g[e] * gm1[e] + w1g[e] * g0[e] + w2g[e] * g1[e], yv1 = bv[e] + w0v[e] * vm1[e] + w1v[e] * v0[e] + w2v[e] * v1[e];
            o0[e] = yg0 * __builtin_amdgcn_rcpf(1.0f + __builtin_amdgcn_exp2f(-yg0 * LOG2E)) * yv0; o1[e] = yg1 * __builtin_amdgcn_rcpf(1.0f + __builtin_amdgcn_exp2f(-yg1 * LOG2E)) * yv1;
        }
        u32x2 a, b; a.x = pk2(o0[0], o0[1]); a.y = pk2(o0[2], o0[3]); b.x = pk2(o1[0], o1[1]); b.y = pk2(o1[2], o1[3]);
        *(u32x2*)(Gb + (size_t)(pm * 256) * DFF + ch) = a; *(u32x2*)(Gb + (size_t)(pm * 256 + 1) * DFF + ch) = b;
    }
}
DI void ph_rmsnorm(const Frame& F, const float* src, int row_off, const float* gain, bf16* XN, const int nrows = MC) {
    f32x4 g[8];
#pragma unroll
    for (int j = 0; j < 8; ++j) g[j] = *(const f32x4*)(gain + 4 * (F.lane + 64 * j));
    for (int ml = F.gw; ml < nrows; ml += F.NGW) {
        const f32x4* xr = (const f32x4*)(src + (size_t)(row_off + ml) * DM) + F.lane;
        f32x4 v[8]; float ss = 0.f;
#pragma unroll
        for (int j = 0; j < 8; ++j) { v[j] = xr[64 * j]; ss += (v[j].x * v[j].x + v[j].y * v[j].y) + (v[j].z * v[j].z + v[j].w * v[j].w); }
        const float rstd = 1.0f / sqrtf(wave_sum(ss) * (1.f / DM) + NORM_EPS);
        u32x2* o = (u32x2*)(XN + (size_t)ml * DM) + F.lane;
#pragma unroll
        for (int j = 0; j < 8; ++j) { const f32x4 y = v[j] * rstd * g[j]; u32x2 w; w.x = pk2(y.x, y.y); w.y = pk2(y.z, y.w); o[64 * j] = w; }
    }
}
DI void ph_norm_first(const Frame& F, const float* src, const float* gain, bf16* XNR, float* ss) {
    f32x4 g[8];
#pragma unroll
    for (int j = 0; j < 8; ++j) g[j] = *(const f32x4*)(gain + 4 * (F.lane + 64 * j));
    for (int m = F.gw; m < MTOT; m += F.NGW) {
        const f32x4* xr = (const f32x4*)(src + (size_t)m * DM) + F.lane;
        f32x4 v[8]; float s2 = 0.f;
#pragma unroll
        for (int j = 0; j < 8; ++j) { v[j] = xr[64 * j]; s2 += (v[j].x * v[j].x + v[j].y * v[j].y) + (v[j].z * v[j].z + v[j].w * v[j].w); }
        s2 = wave_sum(s2);
        if (F.lane < 2) *(f32x4*)(ss + (size_t)m * 8 + 4 * F.lane) = (f32x4){F.lane == 0 ? s2 : 0.f, 0.f, 0.f, 0.f};
        u32x2* o = (u32x2*)(XNR + (size_t)m * DM) + F.lane;
#pragma unroll
        for (int j = 0; j < 8; ++j) { const f32x4 y = v[j] * g[j]; u32x2 w; w.x = pk2(y.x, y.y); w.y = pk2(y.z, y.w); o[64 * j] = w; }
    }
}
DI void ph_final_norm(const Frame& F, float* h, const float* gain) {
    f32x4 g[8];
#pragma unroll
    for (int j = 0; j < 8; ++j) g[j] = *(const f32x4*)(gain + 4 * (F.lane + 64 * j));
    for (int m = F.gw; m < MTOT; m += F.NGW) {
        f32x4* xr = (f32x4*)(h + (size_t)m * DM) + F.lane;
        f32x4 v[8]; float ss = 0.f;
#pragma unroll
        for (int j = 0; j < 8; ++j) { v[j] = xr[64 * j]; ss += (v[j].x * v[j].x + v[j].y * v[j].y) + (v[j].z * v[j].z + v[j].w * v[j].w); }
        const float rstd = 1.0f / sqrtf(wave_sum(ss) * (1.f / DM) + NORM_EPS);
#pragma unroll
        for (int j = 0; j < 8; ++j) xr[64 * j] = v[j] * rstd * g[j];
    }
}
DI void ph_conv_glu(const Frame& F, const bf16* U, bf16* Gb, const float* cw, const float* cb) {
    constexpr int RC = 32, NCG = DFF / 8, NRC = MC / RC;
    const int gt = blockIdx.x * (NWAVES * 64) + F.tid, NT = F.G * NWAVES * 64;
    for (int it = gt; it < NCG * NRC; it += NT) {
        const int cg = it % NCG, rc = it / NCG, c0 = cg * 8, r0 = rc * RC;
        float w0g[8], w1g[8], w2g[8], bg[8], w0v[8], w1v[8], w2v[8], bv[8];
#pragma unroll
        for (int e = 0; e < 8; ++e) { w0g[e] = cw[c0 + e]; w1g[e] = cw[2 * DFF + c0 + e]; w2g[e] = cw[4 * DFF + c0 + e]; bg[e] = cb[c0 + e];
            w0v[e] = cw[DFF + c0 + e]; w1v[e] = cw[3 * DFF + c0 + e]; w2v[e] = cw[5 * DFF + c0 + e]; bv[e] = cb[DFF + c0 + e]; }
        float pg2[8], pg1[8], pv2[8], pv1[8];
        const bool has = (r0 & (SEQ - 1)) != 0;
        {
            u32x4 a = {0u, 0u, 0u, 0u}, b = a, c = a, d = a;
            if (has) { a = *(const u32x4*)(U + (size_t)(r0 - 2) * (2 * DFF) + c0); b = *(const u32x4*)(U + (size_t)(r0 - 1) * (2 * DFF) + c0);
                       c = *(const u32x4*)(U + (size_t)(r0 - 2) * (2 * DFF) + DFF + c0); d = *(const u32x4*)(U + (size_t)(r0 - 1) * (2 * DFF) + DFF + c0); }
#pragma unroll
            for (int e = 0; e < 4; ++e) { pg2[2 * e] = bflo(a[e]); pg2[2 * e + 1] = bfhi(a[e]); pg1[2 * e] = bflo(b[e]); pg1[2 * e + 1] = bfhi(b[e]);
                pv2[2 * e] = bflo(c[e]); pv2[2 * e + 1] = bfhi(c[e]); pv1[2 * e] = bflo(d[e]); pv1[2 * e + 1] = bfhi(d[e]); }
        }
        for (int r = 0; r < RC; ++r) {
            const u32x4 ug = *(const u32x4*)(U + (size_t)(r0 + r) * (2 * DFF) + c0), uv = *(const u32x4*)(U + (size_t)(r0 + r) * (2 * DFF) + DFF + c0);
            float cg_[8], cv_[8], o[8];
#pragma unroll
            for (int e = 0; e < 4; ++e) { cg_[2 * e] = bflo(ug[e]); cg_[2 * e + 1] = bfhi(ug[e]); cv_[2 * e] = bflo(uv[e]); cv_[2 * e + 1] = bfhi(uv[e]); }
#pragma unroll
            for (int e = 0; e < 8; ++e) {
                const float yg = bg[e] + w0g[e] * pg2[e] + w1g[e] * pg1[e] + w2g[e] * cg_[e];
                const float yv = bv[e] + w0v[e] * pv2[e] + w1v[e] * pv1[e] + w2v[e] * cv_[e];
                const float sg = yg * __builtin_amdgcn_rcpf(1.0f + __builtin_amdgcn_exp2f(-yg * LOG2E));
                o[e] = sg * yv; pg2[e] = pg1[e]; pg1[e] = cg_[e]; pv2[e] = pv1[e]; pv1[e] = cv_[e];
            }
            u32x4 w; w.x = pk2(o[0], o[1]); w.y = pk2(o[2], o[3]); w.z = pk2(o[4], o[5]); w.w = pk2(o[6], o[7]);
            *(u32x4*)(Gb + (size_t)(r0 + r) * DFF + c0) = w;
        }
    }
}
constexpr size_t DA_DIN = 0, DA_CQN = 64 * MiB, DA_LATC = 80 * MiB, DA_KPE = 88 * MiB, DA_KIDX = 90 * MiB, DA_WIDX = 94 * MiB, DA_QL = 96 * MiB, DA_QPE = 352 * MiB, DA_QIDX = 400 * MiB,
                 DA_SEL = 464 * MiB, DA_CNT = 472 * MiB, DA_SC = 474 * MiB, DA_O2 = 474 * MiB;
constexpr size_t DW_W1 = 0, DW_W2 = (size_t)1024 * 2048, DW_WO = DW_W2 + (size_t)11776 * 512, DW_BD = DW_WO + (size_t)2048 * 4096;
constexpr float DSA_QSCALE = 0.07216878364870322f * LOG2E;
constexpr float DSA_WIDX_SCALE = 0.25f * 0.08838834764831845f;

DI void ph_dsa_cvt(const Frame& F, const float* w_in, const float* w_qup, const float* w_uk, const float* w_uv, const float* w_out) {
    bf16* WB = (bf16*)(F.ws + WS_WMIX);
    cvt_job(F, w_in, 960, DM, 0, 960, WB + DW_W1, DM, 0, 1.f);
    zero_bf16(F, WB + DW_W1 + (size_t)960 * DM, (size_t)64 * DM);
    { LAS float* scr = (LAS float*)(F.lds + F.wave * 16384);
      for (int it = F.gw; it < 32 * 16; it += F.NGW) { const int h = it >> 4; cvt_item(w_qup, 8192, h * 192, 48, WB + DW_W2, 512, 8192 + h * 48, DSA_QSCALE, scr, it & 15, 2, F.lane); } }
    cvt_job(F, w_qup, 8192, 512, 6144, 2048, WB + DW_W2, 512, 9728, 1.f);
    __syncthreads();
    {
        LAS float* As = (LAS float*)F.lds; LAS float* Bs = As + 64 * 145;
        for (int u = blockIdx.x; u < 32 * 4 * 8; u += F.G) {
            const int h = u >> 5, r0 = ((u >> 3) & 3) * 64, k0 = (u & 7) * 64;
            for (int i = F.tid; i < 64 * 144; i += NWAVES * 64) { const int row = i / 144, col = i - row * 144;
                As[row * 145 + col] = w_uk[(size_t)(h * 256 + r0) * 144 + i]; Bs[row * 145 + col] = w_qup[(size_t)(k0 + row) * 8192 + h * 192 + 48 + col]; }
            __syncthreads();
            const int r = F.tid & 63, kg = F.tid >> 6; float acc[8];
#pragma unroll
            for (int j = 0; j < 8; ++j) acc[j] = 0.f;
            for (int n = 0; n < 144; ++n) { const float a = As[r * 145 + n];
#pragma unroll
                for (int j = 0; j < 8; ++j) acc[j] += a * Bs[(kg * 8 + j) * 145 + n]; }
            u32x4 o; o.x = pk2(acc[0] * DSA_QSCALE, acc[1] * DSA_QSCALE); o.y = pk2(acc[2] * DSA_QSCALE, acc[3] * DSA_QSCALE); o.z = pk2(acc[4] * DSA_QSCALE, acc[5] * DSA_QSCALE); o.w = pk2(acc[6] * DSA_QSCALE, acc[7] * DSA_QSCALE);
            *(u32x4*)(WB + DW_W2 + (size_t)(h * 256 + r0 + r) * 512 + k0 + kg * 8) = o;
            __syncthreads();
        }
    }
    { LAS float* scr = (LAS float*)(F.lds + F.wave * 16384);
      for (int it = F.gw; it < 32 * 16; it += F.NGW) { const int h = it >> 4; cvt_item(w_uv + (size_t)h * 256 * 128, 128, 0, 128, WB + DW_BD + (h & 1) * 256, 512, h * 128, 1.f, scr, it & 15, 4, F.lane); } }
    { const size_t gt = (size_t)blockIdx.x * (NWAVES * 64) + F.tid, NT = (size_t)F.G * NWAVES * 64;
      for (size_t i = gt; i < (size_t)4096 * 32; i += NT) { const int row = (int)(i >> 5), pc = (int)(i & 31); *(u32x4*)(WB + DW_BD + (size_t)row * 512 + (1 - ((row >> 7) & 1)) * 256 + pc * 8) = (u32x4){0u, 0u, 0u, 0u}; } }
    cvt_job(F, w_out, DM, 4096, 0, DM, WB + DW_WO, 4096, 0, 1.f);
}
DI void ph_dsa_post1(const Frame& F, int half, const float* qn, const float* kvn, const float* lng, const float* lnb) {
    unsigned char* ar = F.ws + WS_AR;
    const float* DIN = (const float*)(ar + DA_DIN); bf16* CQN = (bf16*)(ar + DA_CQN); bf16* LATC = (bf16*)(ar + DA_LATC); bf16* KPE = (bf16*)(ar + DA_KPE); bf16* KIDX = (bf16*)(ar + DA_KIDX); float* WIDX = (float*)(ar + DA_WIDX);
    const float* c48 = (const float*)(F.ws + TAB_COS48); const float* s48 = (const float*)(F.ws + TAB_SIN48); const float* c32 = (const float*)(F.ws + TAB_COS32); const float* s32 = (const float*)(F.ws + TAB_SIN32);
    LAS float* buf = (LAS float*)(F.lds + F.wave * 1024);
    const int lane = F.lane;
    for (int ml = F.gw; ml < MC; ml += F.NGW) {
        const int mg = half * MC + ml;
        const size_t kfb = ((size_t)(ml >> 5) * 8 * 64 + (ml & 31)) * 8;
        const float* row = DIN + (size_t)ml * 1024 + 16 * lane;
        f32x4 v[4]; float ss = 0.f, s1 = 0.f;
#pragma unroll
        for (int j = 0; j < 4; ++j) { v[j] = *(const f32x4*)(row + 4 * j); ss += (v[j].x * v[j].x + v[j].y * v[j].y) + (v[j].z * v[j].z + v[j].w * v[j].w); s1 += (v[j].x + v[j].y) + (v[j].z + v[j].w); }
        const bool isq = lane < 32, iskv = lane >= 32 && lane < 48, ispe = lane >= 48 && lane < 51, isix = lane >= 51 && lane < 59;
        const float ssq = wave_sum(isq ? ss : 0.f), sskv = wave_sum(iskv ? ss : 0.f), mean = wave_sum(isix ? s1 : 0.f) * (1.f / 128.f);
        float d2 = 0.f;
#pragma unroll
        for (int j = 0; j < 4; ++j) { const f32x4 d = v[j] - mean; d2 += (d.x * d.x + d.y * d.y) + (d.z * d.z + d.w * d.w); }
        const float var = wave_sum(isix ? d2 : 0.f) * (1.f / 128.f);
        const float rq = 1.0f / sqrtf(ssq * (1.f / 512.f) + NORM_EPS), rkv = 1.0f / sqrtf(sskv * (1.f / 256.f) + NORM_EPS), rstd = 1.0f / sqrtf(var + NORM_EPS);
        if (isq || iskv) {
            const float* gp = isq ? qn + 16 * lane : kvn + 16 * (lane - 32); const float rs = isq ? rq : rkv;
            bf16* dst = isq ? CQN + (size_t)ml * 512 + 16 * lane : LATC + (size_t)ml * 256 + 16 * (lane - 32);
            u32x4 o[2];
#pragma unroll
            for (int j = 0; j < 4; ++j) { const f32x4 g = *(const f32x4*)(gp + 4 * j); const f32x4 y = v[j] * rs * g; o[j >> 1][(j & 1) * 2] = pk2(y.x, y.y); o[j >> 1][(j & 1) * 2 + 1] = pk2(y.z, y.w); }
            *(u32x4*)dst = o[0]; *(u32x4*)(dst + 8) = o[1];
        } else if (ispe) {
#pragma unroll
            for (int j = 0; j < 4; ++j) *(LAS f32x4*)(buf + (lane - 48) * 16 + 4 * j) = v[j];
        } else if (isix) {
#pragma unroll
            for (int j = 0; j < 4; ++j) { const f32x4 g = *(const f32x4*)(lng + (lane - 51) * 16 + 4 * j), b = *(const f32x4*)(lnb + (lane - 51) * 16 + 4 * j); *(LAS f32x4*)(buf + 48 + (lane - 51) * 16 + 4 * j) = (v[j] - mean) * rstd * g + b; }
        } else if (lane == 59) {
#pragma unroll
            for (int j = 0; j < 4; ++j) *(f32x4*)(WIDX + (size_t)ml * 16 + 4 * j) = v[j] * DSA_WIDX_SCALE;
        }
        LDS_WAIT();
        if (lane < 24) { const float x1 = buf[lane], x2 = buf[24 + lane], c = c48[(size_t)mg * 24 + lane], s = s48[(size_t)mg * 24 + lane];
            KPE[(size_t)ml * 48 + lane] = f2bf(x1 * c - x2 * s); KPE[(size_t)ml * 48 + 24 + lane] = f2bf(x1 * s + x2 * c);
        } else if (lane < 40) { const int i = lane - 24; const float x1 = buf[48 + i], x2 = buf[48 + 16 + i], c = c32[(size_t)mg * 16 + i], s = s32[(size_t)mg * 16 + i];
            KIDX[kfb + (size_t)((i >> 3) * 32) * 8 + (i & 7)] = f2bf(x1 * c - x2 * s); KIDX[kfb + (size_t)(64 + (i >> 3) * 32) * 8 + (i & 7)] = f2bf(x1 * s + x2 * c);
        } else { const int d = 32 + 4 * (lane - 40); const f32x4 y = *(const LAS f32x4*)(buf + 48 + d); u32x2 w; w.x = pk2(y.x, y.y); w.y = pk2(y.z, y.w); *(u32x2*)(KIDX + kfb + (size_t)((d >> 4) * 64 + ((d >> 3) & 1) * 32) * 8 + (d & 7)) = w; }
        LDS_WAIT();
    }
}
DI void ph_dsa_rope(const Frame& F, int half) {
    unsigned char* ar = F.ws + WS_AR; bf16* QPE = (bf16*)(ar + DA_QPE); bf16* QIDX = (bf16*)(ar + DA_QIDX);
    const float* c48 = (const float*)(F.ws + TAB_COS48); const float* s48 = (const float*)(F.ws + TAB_SIN48); const float* c32 = (const float*)(F.ws + TAB_COS32); const float* s32 = (const float*)(F.ws + TAB_SIN32);
    for (int ml = F.gw; ml < MC; ml += F.NGW) {
        const size_t mg = (size_t)half * MC + ml;
        for (int p = F.lane; p < 768; p += 64) { const int hd = p / 24, i = p - hd * 24; bf16* q = QPE + (size_t)ml * 1536 + hd * 48 + i;
            const float x1 = bf2f(q[0]), x2 = bf2f(q[24]), c = c48[mg * 24 + i], s = s48[mg * 24 + i]; q[0] = f2bf(x1 * c - x2 * s); q[24] = f2bf(x1 * s + x2 * c); }
        for (int p = F.lane; p < 256; p += 64) { const int hd = p >> 4, i = p & 15; bf16* q = QIDX + (size_t)ml * 2048 + hd * 128 + i;
            const float x1 = bf2f(q[0]), x2 = bf2f(q[16]), c = c32[mg * 16 + i], s = s32[mg * 16 + i]; q[0] = f2bf(x1 * c - x2 * s); q[16] = f2bf(x1 * s + x2 * c); }
    }
}
DI int wave_iscan_dpp(int v) {
    v += __builtin_amdgcn_update_dpp(0, v, 0x111, 0xf, 0xf, true); v += __builtin_amdgcn_update_dpp(0, v, 0x112, 0xf, 0xf, true);
    v += __builtin_amdgcn_update_dpp(0, v, 0x114, 0xf, 0xf, true); v += __builtin_amdgcn_update_dpp(0, v, 0x118, 0xf, 0xf, true);
    v += __builtin_amdgcn_update_dpp(0, v, 0x142, 0xa, 0xf, false);
    v += __builtin_amdgcn_update_dpp(0, v, 0x143, 0xc, 0xf, false);
    return v;
}
DI int wave_isum_dpp(int v) {
    v += __builtin_amdgcn_update_dpp(0, v, 0x111, 0xf, 0xf, true); v += __builtin_amdgcn_update_dpp(0, v, 0x112, 0xf, 0xf, true);
    v += __builtin_amdgcn_update_dpp(0, v, 0x114, 0xf, 0xf, true); v += __builtin_amdgcn_update_dpp(0, v, 0x118, 0xf, 0xf, true);
    v += __builtin_amdgcn_update_dpp(0, v, 0x142, 0xa, 0xf, false);
    v += __builtin_amdgcn_update_dpp(0, v, 0x143, 0xc, 0xf, false);
    return __builtin_amdgcn_readlane(v, 63);
}
DI unsigned f2sortable(float s) { const unsigned b = __builtin_bit_cast(unsigned, s); return (b & 0x80000000u) ? ~b : (b | 0x80000000u); }
DI void ph_dsa_index(const Frame& F, const int dry = 0, const int parts = 3) {
    unsigned char* ar = F.ws + WS_AR;
    const bf16* QIDX = (const bf16*)(ar + DA_QIDX); const bf16* KIDX = (const bf16*)(ar + DA_KIDX); const float* WIDX = (const float*)(ar + DA_WIDX);
    unsigned short* SEL = (unsigned short*)(ar + DA_SEL); int* CNT = (int*)(ar + DA_CNT); float* SC = (float*)(ar + DA_SC) + (size_t)F.gw * 16384;
    const int lane = F.lane, r = lane & 31, hf = lane >> 5;
    LAS unsigned char* wl = F.lds + F.wave * 8192 + lane * 16;
    LAS unsigned* hist = (LAS unsigned*)(F.lds + 65536 + F.wave * 1024);
#pragma unroll 1
    for (int tile = blockIdx.x; tile < BPH * 128; tile += F.G) {
        const int j = tile >> 8, c8 = tile & 255, c7 = c8 & 127, bl = (c8 >> 7) * 2 + j, qt = j ? 127 - c7 : c7;
        const int q0 = qt * 32 + 4 * F.wave;
        const int ntile = (q0 + 3) / 32 + 1;
        bf16x8 qa[2][8];
#pragma unroll
        for (int pr = 0; pr < 2; ++pr) {
            const int mrow = bl * SEQ + q0 + 2 * pr + (r >> 4);
#pragma unroll
            for (int s = 0; s < 8; ++s) qa[pr][s] = *(const bf16x8*)(QIDX + (size_t)mrow * 2048 + (r & 15) * 128 + 16 * s + 8 * hf);
            float wv[2][16];
#pragma unroll
            for (int i = 0; i < 16; ++i) wv[pr][i] = WIDX[(size_t)(bl * SEQ + q0 + 2 * pr + (i >> 3)) * 16 + (i & 3) + 8 * ((i >> 2) & 1) + 4 * hf];
#pragma unroll
            for (int i = 0; i < 16; i += 4) *(LAS f32x4*)(wl + (pr * 4 + (i >> 2)) * 1024) = (f32x4){wv[pr][i], wv[pr][i + 1], wv[pr][i + 2], wv[pr][i + 3]};
        }
        LDS_WAIT();
        if (parts & 1) {
        bf16x8 kf[8];
        { const bf16* kp = KIDX + ((size_t)(bl * 128) * 8 * 64 + lane) * 8;
#pragma unroll
          for (int s = 0; s < 8; ++s) kf[s] = *(const bf16x8*)(kp + 512 * s); }
#pragma unroll 1
        for (int t = 0; t < ntile; ++t) {
            f32x16 accs[2];
#pragma unroll
            for (int pr = 0; pr < 2; ++pr) {
#pragma unroll
                for (int i = 0; i < 16; ++i) accs[pr][i] = 0.f;
#pragma unroll
                for (int s = 0; s < 8; ++s) accs[pr] = MFMA32(qa[pr][s], kf[s], accs[pr]);
            }
            if (t + 1 < ntile) { const bf16* kp = KIDX + ((size_t)(bl * 128 + t + 1) * 8 * 64 + lane) * 8;
#pragma unroll
                for (int s = 0; s < 8; ++s) kf[s] = *(const bf16x8*)(kp + 512 * s); }
#pragma unroll
            for (int pr = 0; pr < 2; ++pr) {
                const f32x16 acc = accs[pr];
                float wv[2][16];
                { unsigned wa_ = (unsigned)(size_t)wl; asm volatile("" : "+v"(wa_));
#pragma unroll
                  for (int i = 0; i < 16; i += 4) { const f32x4 w4 = *(const LAS f32x4*)((LAS unsigned char*)(size_t)wa_ + (pr * 4 + (i >> 2)) * 1024); wv[pr][i] = w4.x; wv[pr][i + 1] = w4.y; wv[pr][i + 2] = w4.z; wv[pr][i + 3] = w4.w; } }
                float p0 = 0.f, p1 = 0.f;
#pragma unroll
                for (int i = 0; i < 8; ++i) { p0 += wv[pr][i] * fmaxf(acc[i], 0.f); p1 += wv[pr][8 + i] * fmaxf(acc[8 + i], 0.f); }
                const float t0 = p0 + __shfl_xor(p0, 32), t1 = p1 + __shfl_xor(p1, 32);
                SC[(pr * 128 + t) * 64 + lane] = hf ? t1 : t0;
            }
        }
        }
        VM_WAIT();
        if (parts & 2)
#pragma unroll 1
        for (int qi = 0; qi < 4; ++qi) {
            const int tq = q0 + qi, pr = qi >> 1, qs = qi & 1;
            unsigned u[64];
            const unsigned* scp = (const unsigned*)(SC + pr * 8192 + hf * 64 + qs * 32 + r);
#pragma unroll
            for (int g8 = 0; g8 < 8; ++g8) {
#pragma unroll
                for (int e = 0; e < 8; ++e) { const int i = 8 * g8 + e; const float s = __builtin_bit_cast(float, __hip_atomic_load(scp + e * 128, __ATOMIC_RELAXED, __HIP_MEMORY_SCOPE_AGENT));
                    u[i] = (2 * i + hf < ntile && 64 * i + lane <= tq) ? f2sortable(s) : 0u; }
                scp += 1024; asm volatile("" : "+v"(scp));
            }
            unsigned prefix = 0u;
            if (tq >= 256) {
#pragma unroll 1
                for (int bit = 31; bit >= 0; --bit) {
                    const unsigned cand = prefix | (1u << bit); int c = 0;
#pragma unroll
                    for (int i = 0; i < 64; ++i) c += (u[i] >= cand) ? 1 : 0;
                    c = wave_isum_dpp(c);
                    if (c >= 256) prefix = cand;
                    if (c == 256) break;
                }
            }
            const unsigned T = prefix > 1u ? prefix : 1u;
            int nl = 0;
#pragma unroll
            for (int i = 0; i < 64; ++i) nl += (u[i] >= T) ? 1 : 0;
            const int inc = wave_iscan_dpp(nl), base = __builtin_amdgcn_readlane(inc, 63);
            int pos = inc - nl;
            unsigned short* sel = dry ? (unsigned short*)(ar + DUMMY_OFF) + (size_t)F.gw * 256 : SEL + (size_t)(bl * SEQ + tq) * 256;
#pragma unroll
            for (int i = 0; i < 64; ++i) { if (u[i] >= T) { if (pos < 256) sel[pos] = (unsigned short)(64 * i + lane); ++pos; } }
            if (lane == 0) (dry ? (int*)(ar + DUMMY_OFF + 32 * MiB) + F.gw : CNT + bl * SEQ + tq)[0] = base < 256 ? base : 256;
        }
    }
}
DI int dsa_fsw(int row) { return ((row & 3) << 2) | ((row >> 2) & 3); }
struct DsaPre { u32x4 row[16]; bf16x8 kpe[3]; bf16x8 q[3]; };
DI void dsa_prefetch(DsaPre& P, const bf16* LATC, const bf16* KPE, const bf16* QL, const bf16* QPE, int ml, int selv, int lane, int w) {
    const int bl = ml >> 12, r = lane & 31, h = lane >> 5;
#pragma unroll
    for (int it = 0; it < 16; ++it) { const int ki = __shfl(selv, (lane >> 5) + 2 * it); P.row[it] = *(const u32x4*)(LATC + (size_t)(bl * SEQ + ki) * 256 + (lane & 31) * 8); }
#pragma unroll
    for (int s = 0; s < 3; ++s) P.kpe[s] = *(const bf16x8*)(KPE + (size_t)(bl * SEQ + selv) * 48 + 16 * s + 8 * h);
#pragma unroll
    for (int j = 0; j < 3; ++j) { const int fi = w + 8 * j;
        if (fi < 16) P.q[j] = *(const bf16x8*)(QL + (size_t)ml * 8192 + r * 256 + 16 * fi + 8 * h);
        else if (fi < 19) P.q[j] = *(const bf16x8*)(QPE + (size_t)ml * 1536 + r * 48 + 16 * (fi - 16) + 8 * h); }
}
DI void ph_dsa_attn(const Frame& F, const int dry = 0) {
    unsigned char* ar = F.ws + WS_AR;
    bf16* QL = (bf16*)(ar + DA_QL); const bf16* QPE = (const bf16*)(ar + DA_QPE); const bf16* LATC = (const bf16*)(ar + DA_LATC); const bf16* KPE = (const bf16*)(ar + DA_KPE);
    const unsigned short* SEL = (const unsigned short*)(ar + DA_SEL); const int* CNT = (const int*)(ar + DA_CNT);
    const int lane = F.lane, r = lane & 31, h = lane >> 5, w = F.wave;
    LAS unsigned char* IMG = F.lds; LAS unsigned char* QB = F.lds + LDSCTL_OFF + 256; LAS float* MX = (LAS float*)(F.lds + LDSCTL_OFF + 256 + 19456); LAS float* SX = MX + 256;
    const int i16 = lane & 15, tq_ = i16 >> 2, tp_ = i16 & 3, blk = (lane >> 4) & 1;
    int ml = blockIdx.x;
    if (ml >= MC) return;
    DsaPre P;
    int cnt_c = CNT[ml];
    { const int slot = 32 * w + r; const int selv = slot < cnt_c ? (int)SEL[(size_t)ml * 256 + slot] : 0; dsa_prefetch(P, LATC, KPE, QL, QPE, ml, selv, lane, w); }
    int cnt_n = 0, selv_n = 0;
    if (ml + F.G < MC) { cnt_n = CNT[ml + F.G]; const int slot = 32 * w + r; selv_n = slot < cnt_n ? (int)SEL[(size_t)(ml + F.G) * 256 + slot] : 0; }
#pragma unroll 1
    for (; ml < MC; ml += F.G) {
        const int cnt = cnt_c, nch = (cnt + 31) >> 5; const bool act = w < nch;
#pragma unroll
        for (int it = 0; it < 16; ++it) { const int rr = (lane >> 5) + 2 * it; *(LAS u32x4*)(IMG + (32 * w + rr) * 512 + (((lane & 31) ^ dsa_fsw(rr)) * 16)) = P.row[it]; }
#pragma unroll
        for (int j = 0; j < 3; ++j) { const int fi = w + 8 * j; if (fi < 19) *(LAS bf16x8*)(QB + fi * 1024 + lane * 16) = P.q[j]; }
        bf16x8 kpe[3];
#pragma unroll
        for (int s = 0; s < 3; ++s) kpe[s] = P.kpe[s];
        LDS_WAIT(); __builtin_amdgcn_s_barrier(); asm volatile("" ::: "memory");
        if (ml + F.G < MC) {
            dsa_prefetch(P, LATC, KPE, QL, QPE, ml + F.G, selv_n, lane, w); cnt_c = cnt_n;
            if (ml + 2 * F.G < MC) { cnt_n = CNT[ml + 2 * F.G]; const int slot = 32 * w + r; selv_n = slot < cnt_n ? (int)SEL[(size_t)(ml + 2 * F.G) * 256 + slot] : 0; }
        }
        f32x16 S; float mx = -INFINITY;
#pragma unroll
        for (int i = 0; i < 16; ++i) S[i] = 0.f;
        if (act) {
#pragma unroll
            for (int s = 0; s < 16; ++s) S = MFMA32(*(const LAS bf16x8*)(IMG + (32 * w + r) * 512 + (((2 * s + h) ^ dsa_fsw(r)) * 16)), *(const LAS bf16x8*)(QB + s * 1024 + lane * 16), S);
#pragma unroll
            for (int s = 0; s < 3; ++s) S = MFMA32(kpe[s], *(const LAS bf16x8*)(QB + (16 + s) * 1024 + lane * 16), S);
#pragma unroll
            for (int i = 0; i < 16; ++i) { S[i] = (32 * w + crow(i, h) < cnt) ? S[i] : -INFINITY; mx = fmaxf(mx, S[i]); }
            mx = fmaxf(mx, __shfl_xor(mx, 32));
        }
        if (h == 0) MX[w * 32 + r] = mx;
        LDS_WAIT(); __builtin_amdgcn_s_barrier(); asm volatile("" ::: "memory");
        float M = MX[r];
#pragma unroll
        for (int k = 1; k < 8; ++k) M = fmaxf(M, MX[k * 32 + r]);
        float lsum = 0.f; bf16x8 pf[2] = {(bf16x8){0, 0, 0, 0, 0, 0, 0, 0}, (bf16x8){0, 0, 0, 0, 0, 0, 0, 0}};
        if (act) {
#pragma unroll
            for (int i = 0; i < 16; ++i) { S[i] = __builtin_amdgcn_exp2f(S[i] - M); lsum += S[i]; }
#pragma unroll
            for (int s = 0; s < 2; ++s) { u32x4 t; t.x = pk2(S[8 * s], S[8 * s + 1]); t.y = pk2(S[8 * s + 2], S[8 * s + 3]); t.z = pk2(S[8 * s + 4], S[8 * s + 5]); t.w = pk2(S[8 * s + 6], S[8 * s + 7]); pf[s] = __builtin_bit_cast(bf16x8, t); }
        }
        lsum += __shfl_xor(lsum, 32);
        if (h == 0) SX[w * 32 + r] = lsum;
        *(LAS bf16x8*)(QB + (2 * w) * 1024 + lane * 16) = pf[0]; *(LAS bf16x8*)(QB + (2 * w + 1) * 1024 + lane * 16) = pf[1];
        LDS_WAIT(); __builtin_amdgcn_s_barrier(); asm volatile("" ::: "memory");
        f32x16 O;
#pragma unroll
        for (int i = 0; i < 16; ++i) O[i] = 0.f;
#pragma unroll 2
        for (int ks = 0; ks < 2 * nch; ++ks) {
            const int r0 = 16 * ks + 4 * h + tq_, r1 = r0 + 8, pc = 4 * w + 2 * blk + (tp_ >> 1);
            const s16x4 lo = __builtin_bit_cast(s16x4, __builtin_amdgcn_ds_read_tr16_b64_v4i16((LAS v4i16_t*)(IMG + r0 * 512 + ((pc ^ dsa_fsw(r0)) * 16) + 8 * (tp_ & 1))));
            const s16x4 hi = __builtin_bit_cast(s16x4, __builtin_amdgcn_ds_read_tr16_b64_v4i16((LAS v4i16_t*)(IMG + r1 * 512 + ((pc ^ dsa_fsw(r1)) * 16) + 8 * (tp_ & 1))));
            O = MFMA32(__builtin_shufflevector(lo, hi, 0, 1, 2, 3, 4, 5, 6, 7), *(const LAS bf16x8*)(QB + ks * 1024 + lane * 16), O);
        }
        float l = SX[r];
#pragma unroll
        for (int k = 1; k < 8; ++k) l += SX[k * 32 + r];
        const float linv = 1.0f / l;
        bf16* o = (dry ? (bf16*)(ar + DUMMY_OFF) + (size_t)blockIdx.x * 8192 : QL + (size_t)ml * 8192) + r * 256 + 32 * w + 4 * h;
#pragma unroll
        for (int g = 0; g < 4; ++g) { u32x2 t; t.x = pk2(O[4 * g] * linv, O[4 * g + 1] * linv); t.y = pk2(O[4 * g + 2] * linv, O[4 * g + 3] * linv); *(u32x2*)(o + 8 * g) = t; }
        LDS_WAIT(); __builtin_amdgcn_s_barrier(); asm volatile("" ::: "memory");
    }
}
template <int NDB, bool RESC = true> DI void softmax_step(f32x16& S, float& m, float& l, f32x16 (&O)[NDB], bf16x8 (&pf)[2]) {
    float mx = S[0];
#pragma unroll
    for (int i = 1; i < 16; ++i) mx = fmaxf(mx, S[i]);
    mx = fmaxf(mx, __shfl_xor(mx, 32));
    const float mn = fmaxf(m, mx), ms = (mn == -INFINITY) ? 0.f : mn;
    const float alpha = __builtin_amdgcn_exp2f(m - ms);
    float sum = 0.f;
#pragma unroll
    for (int i = 0; i < 16; ++i) { S[i] = __builtin_amdgcn_exp2f(S[i] - ms); sum += S[i]; }
    l = l * alpha + sum; m = mn;
    if (RESC && __builtin_amdgcn_ballot_w64(alpha != 1.0f) != 0ull) {
#pragma unroll
        for (int db = 0; db < NDB; ++db)
#pragma unroll
            for (int i = 0; i < 16; ++i) O[db][i] *= alpha;
    }
#pragma unroll
    for (int s = 0; s < 2; ++s) { u32x4 w; w.x = pk2(S[8 * s], S[8 * s + 1]); w.y = pk2(S[8 * s + 2], S[8 * s + 3]); w.z = pk2(S[8 * s + 4], S[8 * s + 5]); w.w = pk2(S[8 * s + 6], S[8 * s + 7]); pf[s] = __builtin_bit_cast(bf16x8, w); }
}
template <int NQ, int NDB, bool PV, bool QL, bool FRAG, class KA, class VA, class MK>
DI void attn_run(const bf16x8 (&qf)[NQ], const LAS unsigned char* qlds, f32x16 (&O)[NDB], float& m, float& l, int tb, int te, const KA& ka, const VA& va, const MK& mk) {
    if (tb >= te) return;
    bf16x8 kf[NQ];
    { const bf16* kp = ka(tb);
#pragma unroll
      for (int s = 0; s < NQ; ++s) kf[s] = *(const bf16x8*)(kp + (FRAG ? 512 : 16) * s); }
    for (int t = tb; t < te; ++t) {
        bf16x8 vf[NDB][2];
        if (PV) {
#pragma unroll
            for (int db = 0; db < NDB; ++db) { const bf16* vp = va(t, db);
#pragma unroll
                for (int s = 0; s < 2; ++s) { if (FRAG) vf[db][s] = *(const bf16x8*)(vp + 512 * s); else vf[db][s] = __builtin_shufflevector(*(const s16x4*)(vp + 16 * s), *(const s16x4*)(vp + 16 * s + 8), 0, 1, 2, 3, 4, 5, 6, 7); } }
        }
        f32x16 S;
#pragma unroll
        for (int i = 0; i < 16; ++i) S[i] = 0.f;
#pragma unroll
        for (int s = 0; s < NQ; ++s) { if (QL) { unsigned qa_ = (unsigned)(size_t)qlds; asm volatile("" : "+v"(qa_)); S = MFMA32(kf[s], *(const LAS bf16x8*)((LAS unsigned char*)(size_t)qa_ + s * 1024), S); } else S = MFMA32(kf[s], qf[s], S); }
        if (t + 1 < te) { const bf16* kp = ka(t + 1);
#pragma unroll
            for (int s = 0; s < NQ; ++s) kf[s] = *(const bf16x8*)(kp + (FRAG ? 512 : 16) * s); }
        mk(t, S);
        bf16x8 pf[2]; softmax_step<NDB>(S, m, l, O, pf);
        if (PV) {
#pragma unroll
            for (int db = 0; db < NDB; ++db)
#pragma unroll
                for (int s = 0; s < 2; ++s) O[db] = MFMA32(vf[db][s], pf[s], O[db]);
        }
    }
}
template <bool ACC> DI void store_col(bf16* out, const f32x16 (&O)[4], float scale, int h) {
#pragma unroll
    for (int db = 0; db < 4; ++db)
#pragma unroll
        for (int g = 0; g < 4; ++g) { u32x2* p = (u32x2*)(out + db * 32 + 8 * g + 4 * h);
            float a = O[db][4 * g] * scale, b = O[db][4 * g + 1] * scale, c = O[db][4 * g + 2] * scale, d = O[db][4 * g + 3] * scale;
            if (ACC) { const u32x2 o = *p; a += bflo(o.x); b += bfhi(o.x); c += bflo(o.y); d += bfhi(o.y); }
            u32x2 w; w.x = pk2(a, b); w.y = pk2(c, d); *p = w; }
}
template <int NQ> struct TilePre { u32x4 a, b, c; };
template <int NQ, class SRC> DI void tile_fetch(TilePre<NQ>& p, const SRC& src, int T, int tid) {
    const bf16* k = src.k(T); const bf16* v = src.v(T);
    constexpr int NK = NQ * 64;
    p.a = *(const u32x4*)(k + (size_t)tid * 8);
    const int p1 = tid + 512; p.b = (p1 < NK) ? *(const u32x4*)(k + (size_t)p1 * 8) : *(const u32x4*)(v + (size_t)(p1 - NK) * 8);
    if (NQ * 64 + 512 > 1024) { const int p2 = tid + 1024; if (p2 < NK + 512) p.c = *(const u32x4*)(v + (size_t)(p2 - NK) * 8); }
}
template <int NQ> DI void tile_put(const TilePre<NQ>& p, LAS unsigned char* buf, int tid) {
    *(LAS u32x4*)(buf + tid * 16) = p.a; *(LAS u32x4*)(buf + (tid + 512) * 16) = p.b;
    if (NQ * 64 + 512 > 1024) { if (tid + 1024 < NQ * 64 + 512) *(LAS u32x4*)(buf + (tid + 1024) * 16) = p.c; }
}
template <int NQ, bool PV, class SRC, class MK>
DI void attn_run_sh(LAS unsigned char* tl, int tid, int lane, const bf16x8 (&qf)[NQ], f32x16 (&O)[4], float& m, float& l, int TB, int TE, int tb, int te, const SRC& src, const MK& mk) {
    constexpr int TBYTES = (NQ + 8) * 1024;
    if (TB >= TE) return;
    TilePre<NQ> pre;
    tile_fetch<NQ>(pre, src, TB, tid); tile_put<NQ>(pre, tl, tid);
    LDS_WAIT(); __builtin_amdgcn_s_barrier(); asm volatile("" ::: "memory");
#pragma unroll 1
    for (int T = TB; T < TE; ++T) {
        LAS unsigned char* cur = tl + ((T - TB) & 1) * TBYTES;
        if (T + 1 < TE) tile_fetch<NQ>(pre, src, T + 1, tid);
        if (T >= tb && T < te) {
            f32x16 S;
#pragma unroll
            for (int i = 0; i < 16; ++i) S[i] = 0.f;
#pragma unroll
            for (int s = 0; s < NQ; ++s) S = MFMA32(*(const LAS bf16x8*)(cur + s * 1024 + lane * 16), qf[s], S);
            mk(T, S);
            bf16x8 pf[2]; softmax_step<4, PV>(S, m, l, O, pf);
            if (PV) {
#pragma unroll
                for (int db = 0; db < 4; ++db)
#pragma unroll
                    for (int s = 0; s < 2; ++s) O[db] = MFMA32(*(const LAS bf16x8*)(cur + (NQ + db * 2 + s) * 1024 + lane * 16), pf[s], O[db]);
            }
        }
        if (T + 1 < TE) tile_put<NQ>(pre, tl + ((T + 1 - TB) & 1) * TBYTES, tid);
        LDS_WAIT(); __builtin_amdgcn_s_barrier(); asm volatile("" ::: "memory");
    }
}
struct FragSrc { const bf16* kb; const bf16* vb; int nq; DI const bf16* k(int T) const { return kb + (size_t)T * nq * 512; } DI const bf16* v(int T) const { return vb + (size_t)T * 8 * 512; } };
constexpr size_t FA_Q = 0, FA_K = 64 * MiB, FA_F = 128 * MiB, FA_V = 136 * MiB, FA_CUM = 200 * MiB, FA_O = 202 * MiB, FA_KF = 266 * MiB, FA_VF = 330 * MiB;
constexpr size_t FW_IN = 0, FW_OUT = (size_t)6400 * 2048;
constexpr float FOX_QSCALE = 0.08838834764831845f * LOG2E;
DI void ph_fox_cvt(const Frame& F, const float* w_in, const float* w_out) {
    bf16* WB = (bf16*)(F.ws + WS_WMIX);
    cvt_job(F, w_in, 6160, DM, 0, 2048, WB + FW_IN, DM, 0, FOX_QSCALE);
    cvt_job(F, w_in, 6160, DM, 2048, 2048, WB + FW_IN, DM, 2048, 1.f);
    cvt_job(F, w_in, 6160, DM, 4096, 2048, WB + FW_IN, DM, 4096, 1.f);
    cvt_job(F, w_in, 6160, DM, 6144, 16, WB + FW_IN, DM, 6144, 1.f);
    zero_bf16(F, WB + FW_IN + (size_t)6160 * DM, (size_t)240 * DM);
    cvt_job(F, w_out, DM, DM, 0, DM, WB + FW_OUT, DM, 0, 1.f);
}
DI void ph_fox_scan(const Frame& F, const float* b_f) {
    unsigned char* ar = F.ws + WS_AR; const bf16* FB = (const bf16*)(ar + FA_F); float* CUM = (float*)(ar + FA_CUM);
    for (int w = F.gw; w < BPH * 16; w += F.NGW) {
        const int bl = w >> 4, hd = w & 15; const float bf_ = b_f[hd];
        float v[64]; float run = 0.f;
#pragma unroll
        for (int i = 0; i < 64; ++i) { const float x = bf2f(FB[(size_t)(bl * SEQ + F.lane * 64 + i) * 256 + hd]) + bf_;
            const float ls = fminf(x, 0.f) - log1pf(expf(-fabsf(x))); run += ls; v[i] = run; }
        float inc = run;
#pragma unroll
        for (int o = 1; o < 64; o <<= 1) { const float y = __shfl_up(inc, o); if (F.lane >= o) inc += y; }
        const float base = inc - run;
        float* dst = CUM + (size_t)w * SEQ + F.lane * 64;
#pragma unroll
        for (int i = 0; i < 64; i += 4) *(f32x4*)(dst + i) = (f32x4){(v[i] + base) * LOG2E, (v[i + 1] + base) * LOG2E, (v[i + 2] + base) * LOG2E, (v[i + 3] + base) * LOG2E};
    }
    const bf16* Kr = (const bf16*)(ar + FA_K); const bf16* Vr = (const bf16*)(ar + FA_V); bf16* KF = (bf16*)(ar + FA_KF); bf16* VF = (bf16*)(ar + FA_VF);
    const int r = F.lane & 31, h = F.lane >> 5;
    for (int u = F.gw; u < BPH * 16 * 128; u += F.NGW) {
        const int bh = u >> 7, tile = u & 127, bl = bh >> 4, hd = bh & 15;
        const bf16* krow_ = Kr + ((size_t)bl * SEQ + tile * 32 + r) * DM + hd * 128 + 8 * h;
        bf16* kd = KF + (((size_t)bh * 128 + tile) * 8 * 64 + F.lane) * 8;
#pragma unroll
        for (int s = 0; s < 8; ++s) *(u32x4*)(kd + s * 512) = *(const u32x4*)(krow_ + 16 * s);
        bf16* vd = VF + (((size_t)bh * 128 + tile) * 8 * 64 + F.lane) * 8;
#pragma unroll
        for (int db = 0; db < 4; ++db)
#pragma unroll
            for (int s = 0; s < 2; ++s) { unsigned short e[8];
#pragma unroll
                for (int j = 0; j < 8; ++j) e[j] = Vr[((size_t)bl * SEQ + tile * 32 + 16 * s + 8 * (j >> 2) + 4 * h + (j & 3)) * DM + hd * 128 + db * 32 + r];
                u32x4 w; w.x = e[0] | ((unsigned)e[1] << 16); w.y = e[2] | ((unsigned)e[3] << 16); w.z = e[4] | ((unsigned)e[5] << 16); w.w = e[6] | ((unsigned)e[7] << 16);
                *(u32x4*)(vd + (db * 2 + s) * 512) = w; }
    }
}
struct FragKA { const bf16* base; int nq; DI const bf16* operator()(int t) const { return base + (size_t)t * nq * 512; } };
struct FragVA { const bf16* base; DI const bf16* operator()(int t, int db) const { return base + ((size_t)t * 8 + db * 2) * 512; } };
struct FoxMK { const float* cum; float ct; int tq, h;
    DI void operator()(int t, f32x16& S) const {
        const int k0 = 32 * t + 4 * h;
#pragma unroll
        for (int g = 0; g < 4; ++g) { const f32x4 cs = *(const f32x4*)(cum + k0 + 8 * g);
#pragma unroll
            for (int e = 0; e < 4; ++e) S[4 * g + e] = (k0 + 8 * g + e <= tq) ? S[4 * g + e] + (ct - cs[e]) : -INFINITY; }
    } };
DI void ph_fox_attn(const Frame& F, const int dry = 0) {
    unsigned char* ar = F.ws + WS_AR; const bf16* Q = (const bf16*)(ar + FA_Q); const bf16* KF = (const bf16*)(ar + FA_KF); const bf16* VF = (const bf16*)(ar + FA_VF); const float* CUM = (const float*)(ar + FA_CUM); bf16* Ob = (bf16*)(ar + FA_O);
    const int r = F.lane & 31, h = F.lane >> 5;
    for (int wb = blockIdx.x; wb < BPH * 16 * 4; wb += F.G) {
        const int bh = wb >> 2, x = (wb & 3) * 8 + F.wave, bl = bh >> 4, hd = bh & 15;
#pragma unroll 1
        for (int k = 0; k < 4; ++k) {
            const int qt = (k == 0) ? x : (k == 1) ? 63 - x : (k == 2) ? 64 + x : 127 - x;
            const int qhi = (k == 0) ? (wb & 3) * 8 + 7 : (k == 1) ? 63 - (wb & 3) * 8 : (k == 2) ? 64 + (wb & 3) * 8 + 7 : 127 - (wb & 3) * 8;
            const int tq = qt * 32 + r; const size_t mrow = (size_t)bl * SEQ + tq;
            bf16x8 qf[8];
#pragma unroll
            for (int s = 0; s < 8; ++s) qf[s] = *(const bf16x8*)(Q + mrow * DM + hd * 128 + 16 * s + 8 * h);
            f32x16 O[4];
#pragma unroll
            for (int db = 0; db < 4; ++db)
#pragma unroll
                for (int i = 0; i < 16; ++i) O[db][i] = 0.f;
            float m = -INFINITY, l = 0.f;
            const float* cum = CUM + (size_t)bh * SEQ;
            const FragSrc src{KF + (size_t)bh * 128 * 8 * 512, VF + (size_t)bh * 128 * 8 * 512, 8}; const FoxMK mk{cum, cum[tq], tq, h};
            attn_run_sh<8, true>(F.lds, F.tid, F.lane, qf, O, m, l, 0, qhi + 1, 0, qt + 1, src, mk);
            l += __shfl_xor(l, 32);
            store_col<false>(dry ? (bf16*)(ar + DUMMY_OFF) + ((size_t)F.gw * 32 + r) * 128 : Ob + mrow * DM + hd * 128, O, l > 0.f ? 1.0f / l : 0.f, h);
        }
    }
}
typedef long fp8x8_t;
DI fp8x8_t pack_fp8x8(float a0, float a1, float a2, float a3, float a4, float a5, float a6, float a7) {
    int lo = 0, hi = 0;
    lo = __builtin_amdgcn_cvt_pk_fp8_f32(a0, a1, lo, false); lo = __builtin_amdgcn_cvt_pk_fp8_f32(a2, a3, lo, true);
    hi = __builtin_amdgcn_cvt_pk_fp8_f32(a4, a5, hi, false); hi = __builtin_amdgcn_cvt_pk_fp8_f32(a6, a7, hi, true);
    return (fp8x8_t)(((unsigned long long)(unsigned)hi << 32) | (unsigned long long)(unsigned)lo);
}
#define MFMA32F8(a, b, c) __builtin_amdgcn_mfma_f32_32x32x16_fp8_fp8((a), (b), (c), 0, 0, 0)
constexpr size_t NA_Q = 0, NA_KC = 288 * MiB, NA_VC = 313 * MiB, NA_KSR = 330 * MiB, NA_KWR = 354 * MiB, NA_GT = 378 * MiB, NA_VSR = 386 * MiB, NA_VWR = 402 * MiB, NA_GK = 418 * MiB, NA_GV = 420 * MiB,
                 NA_KCMP = 422 * MiB, NA_VCT = 424 * MiB, NA_SELB = 426 * MiB, NA_O = 428 * MiB,
                 NA_KSF = 620 * MiB, NA_KWF = 644 * MiB, NA_VSF = 668 * MiB, NA_VWF = 684 * MiB;
constexpr size_t NW_IN = 0, NW_W1K = (size_t)13312 * 2048, NW_W1V = NW_W1K + (size_t)256 * 6144, NW_W2K = NW_W1V + (size_t)256 * 4096, NW_W2V = NW_W2K + 65536, NW_OUT = NW_W2V + 65536;
constexpr float NSA_QSCALE = 0.07216878364870322f * LOG2E;
DI void ph_nsa_cvt(const Frame& F, const float* w_in, const float* k_pe, const float* k_w1, const float* k_b1, const float* k_w2, const float* v_pe, const float* v_w1, const float* v_b1, const float* v_w2, const float* w_out) {
    bf16* WB = (bf16*)(F.ws + WS_WMIX); float* BIAS = (float*)(F.ws + WS_MISC);
    cvt_job(F, w_in, 13200, DM, 0, 9216, WB + NW_IN, DM, 0, NSA_QSCALE);
    cvt_job(F, w_in, 13200, DM, 9216, 768, WB + NW_IN, DM, 9216, 1.f);
    cvt_job(F, w_in, 13200, DM, 9984, 512, WB + NW_IN, DM, 9984, 1.f);
    cvt_job(F, w_in, 13200, DM, 10496, 768, WB + NW_IN, DM, 10496, 1.f);
    cvt_job(F, w_in, 13200, DM, 11776, 768, WB + NW_IN, DM, 11264, 1.f);
    cvt_job(F, w_in, 13200, DM, 13056, 144, WB + NW_IN, DM, 12032, 1.f);
    zero_bf16(F, WB + NW_IN + (size_t)12176 * DM, (size_t)112 * DM);
    cvt_job(F, w_in, 13200, DM, 11264, 512, WB + NW_IN, DM, 12288, 1.f);
    cvt_job(F, w_in, 13200, DM, 12544, 512, WB + NW_IN, DM, 12800, 1.f);
    cvt_job(F, k_w1, 256, 6144, 0, 256, WB + NW_W1K, 6144, 0, 1.f);
    cvt_job(F, v_w1, 256, 4096, 0, 256, WB + NW_W1V, 4096, 0, 1.f);
    cvt_job(F, k_w2, 192, 256, 0, 192, WB + NW_W2K, 256, 0, 1.f); zero_bf16(F, WB + NW_W2K + 192 * 256, 64 * 256);
    cvt_job(F, v_w2, 128, 256, 0, 128, WB + NW_W2V, 256, 0, 1.f); zero_bf16(F, WB + NW_W2V + 128 * 256, 128 * 256);
    cvt_job(F, w_out, DM, 6144, 0, DM, WB + NW_OUT, 6144, 0, 1.f);
    for (int w = F.gw; w < 512; w += F.NGW) { const bool isk = w < 256; const int c = w & 255, n = isk ? 6144 : 4096; const float* pe = isk ? k_pe : v_pe; const float* w1 = isk ? k_w1 : v_w1;
        float s = 0.f; for (int i = F.lane; i < n; i += 64) s += pe[i] * w1[(size_t)i * 256 + c];
        s = wave_sum(s); if (F.lane == 0) BIAS[w] = s + (isk ? k_b1[c] : v_b1[c]); }
}
DI void ph_nsa_rope(const Frame& F, int half) {
    unsigned char* ar = F.ws + WS_AR; bf16* Q = (bf16*)(ar + NA_Q); bf16* KC = (bf16*)(ar + NA_KC);
    const bf16* KSR = (const bf16*)(ar + NA_KSR); const bf16* KWR = (const bf16*)(ar + NA_KWR); bf16* KSF = (bf16*)(ar + NA_KSF); bf16* KWF = (bf16*)(ar + NA_KWF);
    const float* c48 = (const float*)(F.ws + TAB_COS48); const float* s48 = (const float*)(F.ws + TAB_SIN48);
    for (int ml = F.gw; ml < MC; ml += F.NGW) {
        const size_t mg = (size_t)half * MC + ml; const int bl = ml >> 12, sq = ml & 4095;
        for (int p = F.lane; p < 1248; p += 64) {
            const int hd = p / 24, i = p - hd * 24; bf16* q;
            if (hd < 48) q = Q + (size_t)ml * 9216 + hd * 192 + i;
            else q = KC + ((size_t)(bl * 4 + hd - 48) * 4096 + sq) * 192 + i;
            const float x1 = bf2f(q[0]), x2 = bf2f(q[24]), c = c48[mg * 24 + i], s = s48[mg * 24 + i]; q[0] = f2bf(x1 * c - x2 * s); q[24] = f2bf(x1 * s + x2 * c);
        }
        const int tile = sq >> 5, rr = sq & 31;
        for (int u = F.lane; u < 168; u += 64) {
            const int tens = u / 84, uu = u - tens * 84, g = uu / 21, v = uu - g * 21;
            const bf16* src = (tens ? KWR : KSR) + (size_t)ml * 768 + g * 192;
            bf16* dst = (tens ? KWF : KSF) + ((size_t)((bl * 4 + g) * 128 + tile) * 12 * 64 + rr) * 8;
            if (v < 3) {
                const u32x4 a = *(const u32x4*)(src + 8 * v), b = *(const u32x4*)(src + 8 * v + 24); u32x4 o1, o2;
#pragma unroll
                for (int e = 0; e < 4; ++e) { const float c0 = c48[mg * 24 + 8 * v + 2 * e], s0 = s48[mg * 24 + 8 * v + 2 * e], c1 = c48[mg * 24 + 8 * v + 2 * e + 1], s1 = s48[mg * 24 + 8 * v + 2 * e + 1];
                    const float x1l = bflo(a[e]), x1h = bfhi(a[e]), x2l = bflo(b[e]), x2h = bfhi(b[e]);
                    o1[e] = pk2(x1l * c0 - x2l * s0, x1h * c1 - x2h * s1); o2[e] = pk2(x1l * s0 + x2l * c0, x1h * s1 + x2h * c1); }
                const int p1 = v, p2 = v + 3;
                if (tens) { *(u32x4*)(dst + ((p1 >> 1) * 64 + (p1 & 1) * 32) * 8) = o1; *(u32x4*)(dst + ((p2 >> 1) * 64 + (p2 & 1) * 32) * 8) = o2; }
                else { unsigned char* d8 = (unsigned char*)KSF + ((size_t)(((bl * 4 + g) * 128 + tile) * 2 + (rr >> 4)) * 6 * 64 + (rr & 15)) * 8;
                    *(fp8x8_t*)(d8 + ((p1 >> 2) * 64 + (p1 & 3) * 16) * 8) = pack_fp8x8(bflo(o1[0]), bfhi(o1[0]), bflo(o1[1]), bfhi(o1[1]), bflo(o1[2]), bfhi(o1[2]), bflo(o1[3]), bfhi(o1[3]));
                    *(fp8x8_t*)(d8 + ((p2 >> 2) * 64 + (p2 & 3) * 16) * 8) = pack_fp8x8(bflo(o2[0]), bfhi(o2[0]), bflo(o2[1]), bfhi(o2[1]), bflo(o2[2]), bfhi(o2[2]), bflo(o2[3]), bfhi(o2[3])); }
            } else { const int pc = v + 3; const u32x4 c = *(const u32x4*)(src + 8 * pc);
                if (tens) *(u32x4*)(dst + ((pc >> 1) * 64 + (pc & 1) * 32) * 8) = c;
                else { unsigned char* d8 = (unsigned char*)KSF + ((size_t)(((bl * 4 + g) * 128 + tile) * 2 + (rr >> 4)) * 6 * 64 + (rr & 15)) * 8;
                    *(fp8x8_t*)(d8 + ((pc >> 2) * 64 + (pc & 3) * 16) * 8) = pack_fp8x8(bflo(c[0]), bfhi(c[0]), bflo(c[1]), bfhi(c[1]), bflo(c[2]), bfhi(c[2]), bflo(c[3]), bfhi(c[3])); } }
        }
    }
    const bf16* VSR = (const bf16*)(ar + NA_VSR); const bf16* VWR = (const bf16*)(ar + NA_VWR); bf16* VSF = (bf16*)(ar + NA_VSF); bf16* VWF = (bf16*)(ar + NA_VWF);
    const int r = F.lane & 31, h = F.lane >> 5;
    for (int u = F.gw; u < 2 * BPH * 4 * 128; u += F.NGW) {
        const int tens = u >> 11, bg = (u >> 7) & 15, tile = u & 127, bl = bg >> 2, g = bg & 3;
        if (tens) {
            const bf16* src = VWR + ((size_t)bl * SEQ + tile * 32) * 512 + g * 128 + r;
            bf16* vd = VWF + (((size_t)bg * 128 + tile) * 8 * 64 + F.lane) * 8;
#pragma unroll
            for (int db = 0; db < 4; ++db)
#pragma unroll
                for (int s = 0; s < 2; ++s) { unsigned short e[8];
#pragma unroll
                    for (int j = 0; j < 8; ++j) e[j] = src[(size_t)(16 * s + 8 * (j >> 2) + 4 * h + (j & 3)) * 512 + db * 32];
                    u32x4 w; w.x = e[0] | ((unsigned)e[1] << 16); w.y = e[2] | ((unsigned)e[3] << 16); w.z = e[4] | ((unsigned)e[5] << 16); w.w = e[6] | ((unsigned)e[7] << 16);
                    *(u32x4*)(vd + (db * 2 + s) * 512) = w; }
        } else {
            const int d16 = F.lane & 15, kq = F.lane >> 4;
            const bf16* src = VSR + ((size_t)bl * SEQ + tile * 32) * 512 + g * 128 + d16;
            unsigned char* vd = (unsigned char*)VSF + (((size_t)bg * 128 + tile) * 8 * 64 + F.lane) * 8;
#pragma unroll
            for (int db = 0; db < 8; ++db) { float e[8];
#pragma unroll
                for (int j = 0; j < 8; ++j) e[j] = bf2f(src[(size_t)((j < 4 ? 4 * kq + j : 16 + 4 * kq + j - 4)) * 512 + db * 16]);
                *(fp8x8_t*)(vd + db * 512) = pack_fp8x8(e[0], e[1], e[2], e[3], e[4], e[5], e[6], e[7]); }
        }
    }
}
DI float sigmoidf_(float x) { return __builtin_amdgcn_rcpf(1.0f + __builtin_amdgcn_exp2f(-x * LOG2E)); }
struct LinKA { const bf16* base; size_t tstride; DI const bf16* operator()(int t) const { return base + (size_t)t * tstride; } };
struct LinVA { const bf16* base; size_t dbstride; DI const bf16* operator()(int t, int db) const { return base + (size_t)db * dbstride + t * 32; } };
struct CmpMK { int tq, h; DI void operator()(int t, f32x16& S) const {
#pragma unroll
    for (int i = 0; i < 16; ++i) { const int n = 32 * t + crow(i, h); S[i] = (16 * n + 31 <= tq) ? S[i] : -INFINITY; } } };
struct WinMK { int tq, h; DI void operator()(int t, f32x16& S) const {
#pragma unroll
    for (int i = 0; i < 16; ++i) { const int k = 32 * t + crow(i, h); S[i] = (k <= tq && k > tq - 512) ? S[i] : -INFINITY; } } };
DI void ph_nsa_cmp(const Frame& F, const int dry = 0) {
    unsigned char* ar = F.ws + WS_AR; const bf16* Q = (const bf16*)(ar + NA_Q); const bf16* KCMP = (const bf16*)(ar + NA_KCMP); const bf16* VCT = (const bf16*)(ar + NA_VCT); const bf16* GT = (const bf16*)(ar + NA_GT);
    unsigned char* SELB = ar + NA_SELB; bf16* Ob = (bf16*)(ar + NA_O);
    LAS float* imp = (LAS float*)F.lds;
    LAS unsigned char* tl = F.lds + 20480;
    const int lane = F.lane, r = lane & 31, h = lane >> 5, tid = F.tid;
    for (int u = blockIdx.x; u < BPH * 4 * 64; u += F.G) {
        const int bg = u >> 6, qt64 = ((u >> 8) & 1) ? 63 - (u & 63) : (u & 63), bl = bg >> 2, g = bg & 3;
        for (int i = F.tid; i < 64 * 65; i += NWAVES * 64) imp[i] = 0.f;
        __syncthreads();
        const FragSrc src{KCMP + (size_t)bg * 8 * 12 * 512, VCT + (size_t)bg * 8 * 8 * 512, 12};
        const int tqmaxb = qt64 * 64 + 63, TE = (tqmaxb >= 31) ? ((tqmaxb - 31) / 16) / 32 + 1 : 0;
#pragma unroll 1
        for (int k = 0; k < 3; ++k) {
            const int idx = F.wave * 3 + k, j = idx >> 1, sub = idx & 1, ql = sub * 32 + r, tq = qt64 * 64 + ql, hd = g * 12 + j;
            const size_t mrow = (size_t)bl * SEQ + tq;
            bf16x8 qf[12];
#pragma unroll
            for (int s = 0; s < 12; ++s) qf[s] = *(const bf16x8*)(Q + mrow * 9216 + hd * 192 + 16 * s + 8 * h);
            const int tqmax = qt64 * 64 + sub * 32 + 31, te = (tqmax >= 31) ? ((tqmax - 31) / 16) / 32 + 1 : 0;
            const CmpMK mk{tq, h};
            float m = -INFINITY, l = 0.f;
            { f32x16 Od[4];
              attn_run_sh<12, false>(tl, tid, lane, qf, Od, m, l, 0, TE, 0, te, src, mk); }
            l += __shfl_xor(l, 32);
            const float linv = l > 0.f ? 1.0f / l : 0.f, ms = (m == -INFINITY) ? 0.f : m;
            f32x16 O[4];
#pragma unroll
            for (int db = 0; db < 4; ++db)
#pragma unroll
                for (int i = 0; i < 16; ++i) O[db][i] = 0.f;
            if (TE > 0) {
                TilePre<12> pre;
                tile_fetch<12>(pre, src, 0, tid); tile_put<12>(pre, tl, tid);
                LDS_WAIT(); __builtin_amdgcn_s_barrier(); asm volatile("" ::: "memory");
#pragma unroll 1
                for (int t = 0; t < TE; ++t) {
                    LAS unsigned char* cur = tl + (t & 1) * 20480;
                    if (t + 1 < TE) tile_fetch<12>(pre, src, t + 1, tid);
                    if (t < te) {
                        f32x16 S;
#pragma unroll
                        for (int i = 0; i < 16; ++i) S[i] = 0.f;
#pragma unroll
                        for (int s = 0; s < 12; ++s) S = MFMA32(*(const LAS bf16x8*)(cur + s * 1024 + lane * 16), qf[s], S);
                        mk(t, S);
#pragma unroll
                        for (int i = 0; i < 16; ++i) S[i] = __builtin_amdgcn_exp2f(S[i] - ms) * linv;
#pragma unroll
                        for (int g4 = 0; g4 < 4; ++g4) { const float gs = (S[4 * g4] + S[4 * g4 + 1]) + (S[4 * g4 + 2] + S[4 * g4 + 3]); const int mb = 8 * t + 2 * g4 + h;
                            __hip_atomic_fetch_add(imp + ql * 65 + mb, gs, __ATOMIC_RELAXED, __HIP_MEMORY_SCOPE_WORKGROUP);
                            if (mb + 1 < 64) __hip_atomic_fetch_add(imp + ql * 65 + mb + 1, S[4 * g4 + 3], __ATOMIC_RELAXED, __HIP_MEMORY_SCOPE_WORKGROUP); }
                        bf16x8 pf[2];
#pragma unroll
                        for (int s = 0; s < 2; ++s) { u32x4 w; w.x = pk2(S[8 * s], S[8 * s + 1]); w.y = pk2(S[8 * s + 2], S[8 * s + 3]); w.z = pk2(S[8 * s + 4], S[8 * s + 5]); w.w = pk2(S[8 * s + 6], S[8 * s + 7]); pf[s] = __builtin_bit_cast(bf16x8, w); }
#pragma unroll
                        for (int db = 0; db < 4; ++db)
#pragma unroll
                            for (int s = 0; s < 2; ++s) O[db] = MFMA32(*(const LAS bf16x8*)(cur + (12 + db * 2 + s) * 1024 + lane * 16), pf[s], O[db]);
                    }
                    if (t + 1 < TE) tile_put<12>(pre, tl + ((t + 1) & 1) * 20480, tid);
                    LDS_WAIT(); __builtin_amdgcn_s_barrier(); asm volatile("" ::: "memory");
                }
            }
            const float gate = sigmoidf_(bf2f(GT[mrow * 256 + hd]));
            store_col<false>(dry ? (bf16*)(ar + DUMMY_OFF) + ((size_t)F.gw * 32 + r) * 128 : Ob + mrow * 6144 + hd * 128, O, gate, h);
        }
        __syncthreads();
#pragma unroll 1
        for (int k = 0; k < 8; ++k) {
            const int ql = F.wave * 8 + k, tq = qt64 * 64 + ql, cur = tq >> 6, mb = lane;
            const bool causal = mb <= cur, forced = (mb == 0) || (mb == cur) || (mb == cur - 1);
            const float v = causal ? (forced ? INFINITY : imp[ql * 65 + mb]) : -INFINITY;
            int rank = 0;
            for (int o = 0; o < 64; ++o) { const float vo = __shfl(v, o); rank += (vo > v || (vo == v && o < mb)) ? 1 : 0; }
            if (rank < 16) (dry ? ar + DUMMY_OFF + 32 * MiB + (size_t)F.gw * 16 : SELB + ((size_t)bg * 4096 + tq) * 16)[rank] = causal ? (unsigned char)mb : (unsigned char)0xFF;
        }
        __syncthreads();
    }
}
DI int sel_tile(const u32x4& sel, int t) { const int b = t >> 1; const unsigned w = (b < 4) ? sel.x : (b < 8) ? sel.y : (b < 12) ? sel.z : sel.w; return (int)((w >> ((b & 3) * 8)) & 0xFFu) * 2 + (t & 1); }
struct SelKA { const bf16* base; u32x4 sel; DI const bf16* operator()(int t) const { return base + (size_t)sel_tile(sel, t) * 12 * 512; } };
struct SelVA { const bf16* base; u32x4 sel; DI const bf16* operator()(int t, int db) const { return base + ((size_t)sel_tile(sel, t) * 8 + db * 2) * 512; } };
struct SelMK { u32x4 sel; int tq, h; DI void operator()(int t, f32x16& S) const { const int k0 = sel_tile(sel, t) * 32;
#pragma unroll
    for (int i = 0; i < 16; ++i) S[i] = (k0 + crow(i, h) <= tq) ? S[i] : -INFINITY; } };
typedef float f32x4_ __attribute__((ext_vector_type(4)));
#define MFMA16F8(a, b, c) __builtin_amdgcn_mfma_f32_16x16x32_fp8_fp8((a), (b), (c), 0, 0, 0)
DI void ph_nsa_sel(const Frame& F, const int dry = 0) {
    unsigned char* ar = F.ws + WS_AR; const bf16* Q = (const bf16*)(ar + NA_Q); const unsigned char* KS8 = ar + NA_KSF; const unsigned char* VS8 = ar + NA_VSF; const bf16* GT = (const bf16*)(ar + NA_GT);
    const unsigned char* SELB = ar + NA_SELB; bf16* Ob = (bf16*)(ar + NA_O);
    const int c16 = F.lane & 15, kq = F.lane >> 4; const bool act = c16 < 12;
    for (int it = F.gw; it < BPH * 4 * SEQ; it += F.NGW) {
        const int bg = it >> 12, tq = ((it & 4095) + 256 * bg) & 4095, bl = bg >> 2, g = bg & 3; const size_t mrow = (size_t)bl * SEQ + tq; const int hd = g * 12 + (act ? c16 : 0);
        fp8x8_t qf[6];
#pragma unroll
        for (int s = 0; s < 6; ++s) { const u32x4 q = *(const u32x4*)(Q + mrow * 9216 + hd * 192 + 32 * s + 8 * kq); const float qs = act ? (1.0f / NSA_QSCALE) : 0.f;
            qf[s] = pack_fp8x8(bflo(q[0]) * qs, bfhi(q[0]) * qs, bflo(q[1]) * qs, bfhi(q[1]) * qs, bflo(q[2]) * qs, bfhi(q[2]) * qs, bflo(q[3]) * qs, bfhi(q[3]) * qs); }
        const u32x4 sel = *(const u32x4*)(SELB + ((size_t)bg * 4096 + tq) * 16);
        const int nv = ((tq >> 6) + 1 < 16) ? (tq >> 6) + 1 : 16, te = 2 * nv;
        const unsigned char* kb = KS8 + ((size_t)bg * 128 * 12 * 64 + F.lane) * 8; const unsigned char* vb = VS8 + ((size_t)bg * 128 * 8 * 64 + F.lane) * 8;
        f32x4_ O[8];
#pragma unroll
        for (int db = 0; db < 8; ++db) O[db] = (f32x4_){0.f, 0.f, 0.f, 0.f};
        float m = -INFINITY, l = 0.f;
        fp8x8_t kfA[12], kfB[12], vfA[8], vfB[8];
        { const unsigned char* kp = kb + (size_t)sel_tile(sel, 0) * 12 * 512; const unsigned char* kp1 = kb + (size_t)sel_tile(sel, 1) * 12 * 512; const unsigned char* vp = vb + (size_t)sel_tile(sel, 0) * 8 * 512;
#pragma unroll
          for (int s = 0; s < 12; ++s) { kfA[s] = *(const fp8x8_t*)(kp + s * 512); kfB[s] = *(const fp8x8_t*)(kp1 + s * 512); }
#pragma unroll
          for (int j = 0; j < 8; ++j) vfA[j] = *(const fp8x8_t*)(vp + j * 512); }
#define SEL_STEP(T_, KF_, VF_, VFN_) do { const int t_ = (T_); const int tile = sel_tile(sel, t_); \
            if (t_ + 1 < te) { const unsigned char* vp = vb + (size_t)sel_tile(sel, t_ + 1) * 8 * 512; _Pragma("unroll") for (int j = 0; j < 8; ++j) VFN_[j] = *(const fp8x8_t*)(vp + j * 512); } \
            f32x4_ S0 = {0.f, 0.f, 0.f, 0.f}, S1 = S0; \
            _Pragma("unroll") for (int s = 0; s < 6; ++s) { S0 = MFMA16F8(KF_[s], qf[s], S0); S1 = MFMA16F8(KF_[6 + s], qf[s], S1); } \
            if (t_ + 2 < te) { const unsigned char* kp = kb + (size_t)sel_tile(sel, t_ + 2) * 12 * 512; _Pragma("unroll") for (int s = 0; s < 12; ++s) KF_[s] = *(const fp8x8_t*)(kp + s * 512); } \
            const int k0 = tile * 32 + 4 * kq; float mx = -INFINITY; \
            _Pragma("unroll") for (int i = 0; i < 4; ++i) { S0[i] = (k0 + i <= tq) ? S0[i] * NSA_QSCALE : -INFINITY; S1[i] = (k0 + 16 + i <= tq) ? S1[i] * NSA_QSCALE : -INFINITY; mx = fmaxf(mx, fmaxf(S0[i], S1[i])); } \
            mx = fmaxf(mx, __shfl_xor(mx, 16)); mx = fmaxf(mx, __shfl_xor(mx, 32)); \
            const float mn = fmaxf(m, mx), ms = (mn == -INFINITY) ? 0.f : mn, alpha = __builtin_amdgcn_exp2f(m - ms); \
            float sum = 0.f; \
            _Pragma("unroll") for (int i = 0; i < 4; ++i) { S0[i] = __builtin_amdgcn_exp2f(S0[i] - ms); S1[i] = __builtin_amdgcn_exp2f(S1[i] - ms); sum += S0[i] + S1[i]; } \
            l = l * alpha + sum; m = mn; \
            if (__builtin_amdgcn_ballot_w64(alpha != 1.0f) != 0ull) { _Pragma("unroll") for (int db = 0; db < 8; ++db) O[db] = O[db] * alpha; } \
            const fp8x8_t p8 = pack_fp8x8(S0[0], S0[1], S0[2], S0[3], S1[0], S1[1], S1[2], S1[3]);       \
            _Pragma("unroll") for (int db = 0; db < 8; ++db) O[db] = MFMA16F8(VF_[db], p8, O[db]); } while (0)
#pragma unroll 1
        for (int t = 0; t < te; t += 2) { SEL_STEP(t, kfA, vfA, vfB); SEL_STEP(t + 1, kfB, vfB, vfA); }
#undef SEL_STEP
        l += __shfl_xor(l, 16); l += __shfl_xor(l, 32);
        if (act) { const float gate = sigmoidf_(bf2f(GT[mrow * 256 + 48 + hd])); const float sc = l > 0.f ? gate / l : 0.f;
            bf16* o = (dry ? (bf16*)(ar + DUMMY_OFF) + ((size_t)F.gw * 16 + c16) * 128 : Ob + mrow * 6144 + hd * 128) + 4 * kq;
#pragma unroll
            for (int db = 0; db < 8; ++db) { u32x2* p = (u32x2*)(o + db * 16); const u32x2 prev = *p;
                u32x2 w; w.x = pk2(O[db][0] * sc + bflo(prev.x), O[db][1] * sc + bfhi(prev.x)); w.y = pk2(O[db][2] * sc + bflo(prev.y), O[db][3] * sc + bfhi(prev.y)); *p = w; } }
    }
}
DI void ph_nsa_win(const Frame& F, const int dry = 0) {
    unsigned char* ar = F.ws + WS_AR; const bf16* Q = (const bf16*)(ar + NA_Q); const bf16* KWF = (const bf16*)(ar + NA_KWF); const bf16* VWF = (const bf16*)(ar + NA_VWF); const bf16* GT = (const bf16*)(ar + NA_GT); bf16* Ob = (bf16*)(ar + NA_O);
    const int r = F.lane & 31, h = F.lane >> 5;
    for (int idb = blockIdx.x; idb < BPH * 48 * 16; idb += F.G) {
        const int qt0 = (((idb & 15) + (idb >> 8)) & 15) * 8, qt = qt0 + F.wave, bh = idb >> 4, hd = bh % 48, bl = bh / 48, g = hd / 12, bg = bl * 4 + g, tq = qt * 32 + r; const size_t mrow = (size_t)bl * SEQ + tq;
        bf16x8 qf[12];
#pragma unroll
        for (int s = 0; s < 12; ++s) qf[s] = *(const bf16x8*)(Q + mrow * 9216 + hd * 192 + 16 * s + 8 * h);
        const FragSrc src{KWF + (size_t)bg * 128 * 12 * 512, VWF + (size_t)bg * 128 * 8 * 512, 12}; const WinMK mk{tq, h};
        f32x16 O[4];
#pragma unroll
        for (int db = 0; db < 4; ++db)
#pragma unroll
            for (int i = 0; i < 16; ++i) O[db][i] = 0.f;
        float m = -INFINITY, l = 0.f;
        attn_run_sh<12, true>(F.lds, F.tid, F.lane, qf, O, m, l, qt0 >= 16 ? qt0 - 16 : 0, qt0 + 8, qt >= 16 ? qt - 16 : 0, qt + 1, src, mk);
        l += __shfl_xor(l, 32);
        const float gate = sigmoidf_(bf2f(GT[mrow * 256 + 96 + hd]));
        store_col<true>(dry ? (bf16*)(ar + DUMMY_OFF) + ((size_t)F.gw * 32 + r) * 128 : Ob + mrow * 6144 + hd * 128, O, l > 0.f ? gate / l : 0.f, h);
    }
}
#ifndef MK_ONE_LAUNCH
#define MK_ONE_LAUNCH 1
#endif
constexpr int NPH = 74;
struct Args { const float* in[58]; float* out; unsigned char* ws; int ph_lo, ph_hi; };
#ifndef PROBE_GEMM
#define PROBE_GEMM 0
#endif
#ifndef PROBE_PH
#define PROBE_PH 0
#endif
#define GEMM_AKOFF 0
#define GEMM_CALL(EpiT, Evar, Aptr, Bptr, Mv, Nv, Kv, ldav, ldbv, cidx) do { if (PROBE_GEMM) { const pg8::Gemm g0_{(const pg8::bf16_t*)(Aptr), (const pg8::bf16_t*)(Bptr), (Mv), (Nv), (Kv), (ldav), (ldbv), GEMM_AKOFF}; \
    pg8::StaticOrder S0_; S0_.init((Mv), (Nv), F.G, (cidx)); pg8::EpiDry E0_{(float*)(ar + DUMMY_OFF)}; pg8::gemm_phase<pg8::EpiDry, pg8::StaticOrder, true, true>((PG8_LAS unsigned char*)F.lds, g0_, S0_, E0_); __syncthreads(); } \
    const pg8::Gemm g_{(const pg8::bf16_t*)(Aptr), (const pg8::bf16_t*)(Bptr), (Mv), (Nv), (Kv), (ldav), (ldbv), GEMM_AKOFF}; \
    pg8::StaticOrder S_; S_.init((Mv), (Nv), F.G, (cidx)); pg8::gemm_phase<EpiT, pg8::StaticOrder, true, true>((PG8_LAS unsigned char*)F.lds, g_, S_, Evar); } while (0)
DI pg8::EpiBf16R epi1(bf16* base, int ldc) { pg8::EpiBf16R e; for (int s = 0; s < 8; ++s) { e.T.base[s] = base; e.T.ldc[s] = ldc; e.T.t0[s] = 0; e.T.gw[s] = 0; } e.T.nseg = 1; e.T.pad_ = 0; e.ssp = nullptr; e.ss_off = 0; return e; }
#define PH_BEGIN if (ph >= lo && ph < hi) { Frame F; { unsigned long long w_ = (unsigned long long)args.ws; asm volatile("" : "+s"(w_)); F.ws = (unsigned char*)w_; F.ctl = (unsigned*)(F.ws + WS_CTL); } \
    F.lds = lds; F.tid = threadIdx.x; F.lane = F.tid & 63; F.wave = __builtin_amdgcn_readfirstlane(F.tid >> 6); F.G = gridDim.x; F.gw = blockIdx.x * NWAVES + F.wave; F.NGW = F.G * NWAVES; \
    float* out; { unsigned long long o_ = (unsigned long long)args.out; asm volatile("" : "+s"(o_)); out = (float*)o_; } \
    unsigned char* const ar = F.ws + WS_AR; bf16* const XN = (bf16*)(F.ws + WS_XNR); float* const SSB = (float*)(F.ws + WS_SS); bf16* const WB = (bf16*)(F.ws + WS_WMIX); bf16* const WUP = (bf16*)(F.ws + WS_WFFN); bf16* const WDN = WUP + (size_t)2 * DFF * DM; \
    const float* const res_mix = (ib == 2) ? args.in[0] : (const float*)out; (void)ar; (void)XN; (void)SSB; (void)WB; (void)WUP; (void)WDN; (void)res_mix; (void)iff;
#define PH_END   if (ph + 1 < hi) { XcdBarrier b_; b_.bar = (unsigned*)F.ctl + CW_BAR; b_.x = xb_xcc_id(); b_.st = MISC + 8; xcd_barrier(b_); } } ++ph;
template <int LAYER> DI void run_cvt(const Args& args, LAS unsigned char* lds, volatile LAS unsigned* MISC, int& ph, const int lo, const int hi) {
    constexpr int ib = (LAYER == 0) ? 2 : (LAYER == 1) ? 17 : (LAYER == 2) ? 26 : 42;
    constexpr int iff = (LAYER == 0) ? 12 : (LAYER == 1) ? 21 : (LAYER == 2) ? 37 : 52;
    constexpr int kind = (LAYER == 1) ? 1 : (LAYER == 2) ? 2 : 0;
        PH_BEGIN
          for (int rep_ = 0; rep_ < (PROBE_PH == 11 ? 2 : 1); ++rep_) {
            if constexpr (kind == 0) ph_dsa_cvt(F, args.in[ib + 1], args.in[ib + 6], args.in[ib + 7], args.in[ib + 8], args.in[ib + 9]);
            else if constexpr (kind == 1) ph_fox_cvt(F, args.in[ib + 1], args.in[ib + 3]);
            else ph_nsa_cvt(F, args.in[ib + 1], args.in[ib + 2], args.in[ib + 3], args.in[ib + 4], args.in[ib + 5], args.in[ib + 6], args.in[ib + 7], args.in[ib + 8], args.in[ib + 9], args.in[ib + 10]);
            ph_cvt_ffn(F, args.in[iff + 1], args.in[iff + 4]); __syncthreads();
          }
        PH_END
}
template <int LAYER, int HALF> DI void run_half(const Args& args, LAS unsigned char* lds, volatile LAS unsigned* MISC, int& ph, const int lo, const int hi) {
    constexpr int ib = (LAYER == 0) ? 2 : (LAYER == 1) ? 17 : (LAYER == 2) ? 26 : 42;
    constexpr int iff = (LAYER == 0) ? 12 : (LAYER == 1) ? 21 : (LAYER == 2) ? 37 : 52;
    constexpr int kind = (LAYER == 1) ? 1 : (LAYER == 2) ? 2 : 0;
    constexpr int half = HALF;
            const int roff = half * MC;
            const float* const ssin = nullptr; (void)ssin;
            if constexpr (kind == 0) {
                PH_BEGIN { pg8::EpiF32 E{(float*)(ar + DA_DIN), 1024, SSB + (size_t)(LAYER * 2) * MTOT * 8, roff}; GEMM_CALL(pg8::EpiF32, E, XN + (size_t)roff * DM, WB + DW_W1, MC, 1024, DM, DM, DM, (int)blockIdx.x); } PH_END
                PH_BEGIN if (PROBE_PH == 10) { ph_dsa_post1(F, half, args.in[ib + 2], args.in[ib + 3], args.in[ib + 4], args.in[ib + 5]); __syncthreads(); } ph_dsa_post1(F, half, args.in[ib + 2], args.in[ib + 3], args.in[ib + 4], args.in[ib + 5]); PH_END
                PH_BEGIN { pg8::EpiBf16R E = epi1((bf16*)(ar + DA_QL), 8192); E.T.base[1] = (bf16*)(ar + DA_QPE); E.T.ldc[1] = 1536; E.T.t0[1] = 32; E.T.base[2] = (bf16*)(ar + DA_QIDX); E.T.ldc[2] = 2048; E.T.t0[2] = 38; E.T.nseg = 3;
                    GEMM_CALL(pg8::EpiBf16R, E, ar + DA_CQN, WB + DW_W2, MC, 11776, 512, 512, 512, (int)blockIdx.x); } PH_END
                PH_BEGIN ph_dsa_rope(F, half); PH_END
                PH_BEGIN if (PROBE_PH == 1) { ph_dsa_index(F, 1); __syncthreads(); } if (PROBE_PH == 7) { ph_dsa_index(F, 1, 1); __syncthreads(); } if (PROBE_PH == 8) { ph_dsa_index(F, 1, 2); __syncthreads(); } ph_dsa_index(F); PH_END
                PH_BEGIN if (PROBE_PH == 2) { ph_dsa_attn(F, 1); __syncthreads(); } ph_dsa_attn(F); PH_END
                PH_BEGIN {
                    pg8::EpiBf16R E = epi1((bf16*)(ar + DA_O2), 4096);
                    { const pg8::Gemm g_{(const pg8::bf16_t*)(ar + DA_QL), (const pg8::bf16_t*)(WB + DW_BD), MC, 4096, 512, 8192, 512, 512}; pg8::StaticOrder S_; S_.init(MC, 4096, F.G, (int)blockIdx.x);
                      pg8::gemm_phase<pg8::EpiBf16R, pg8::StaticOrder, true, true>((PG8_LAS unsigned char*)F.lds, g_, S_, E); } } PH_END
                PH_BEGIN { pg8::EpiResN E{LAYER == 0 ? args.in[0] : nullptr, args.in[ib], nullptr, DM, roff, args.in[iff], (pg8::bf16_t*)XN, SSB + (size_t)(LAYER * 2 + 1) * MTOT * 8, (PG8_LAS float*)(F.lds + LDSCTL_OFF + 256)}; GEMM_CALL(pg8::EpiResN, E, ar + DA_O2, WB + DW_WO, MC, DM, 4096, 4096, 4096, (int)blockIdx.x); } PH_END
            } else if constexpr (kind == 1) {
                PH_BEGIN { pg8::EpiBf16R E = epi1((bf16*)(ar + FA_Q), DM); E.T.base[1] = (bf16*)(ar + FA_K); E.T.ldc[1] = DM; E.T.t0[1] = 8; E.T.base[2] = (bf16*)(ar + FA_V); E.T.ldc[2] = DM; E.T.t0[2] = 16;
                    E.T.base[3] = (bf16*)(ar + FA_F); E.T.ldc[3] = 256; E.T.t0[3] = 24; E.T.nseg = 4; E.ssp = SSB + (size_t)(LAYER * 2) * MTOT * 8; E.ss_off = roff;
                    GEMM_CALL(pg8::EpiBf16R, E, XN + (size_t)roff * DM, WB + FW_IN, MC, 6400, DM, DM, DM, (int)blockIdx.x); } PH_END
                PH_BEGIN if (PROBE_PH == 10) { ph_fox_scan(F, args.in[ib + 2]); __syncthreads(); } ph_fox_scan(F, args.in[ib + 2]); PH_END
                PH_BEGIN if (PROBE_PH == 3) { ph_fox_attn(F, 1); __syncthreads(); } ph_fox_attn(F); PH_END
                PH_BEGIN { pg8::EpiResN E{LAYER == 0 ? args.in[0] : nullptr, args.in[ib], nullptr, DM, roff, args.in[iff], (pg8::bf16_t*)XN, SSB + (size_t)(LAYER * 2 + 1) * MTOT * 8, (PG8_LAS float*)(F.lds + LDSCTL_OFF + 256)}; GEMM_CALL(pg8::EpiResN, E, ar + FA_O, WB + FW_OUT, MC, DM, DM, DM, DM, (int)blockIdx.x); } PH_END
            } else {
                PH_BEGIN { pg8::EpiBf16R E = epi1((bf16*)(ar + NA_Q), 9216);
                    E.T.base[1] = (bf16*)(ar + NA_KC); E.T.ldc[1] = 192; E.T.t0[1] = 36; E.T.gw[1] = 192;
                    E.T.base[2] = (bf16*)(ar + NA_VC); E.T.ldc[2] = 128; E.T.t0[2] = 39; E.T.gw[2] = 128;
                    E.T.base[3] = (bf16*)(ar + NA_KSR); E.T.ldc[3] = 768; E.T.t0[3] = 41;
                    E.T.base[4] = (bf16*)(ar + NA_KWR); E.T.ldc[4] = 768; E.T.t0[4] = 44;
                    E.T.base[5] = (bf16*)(ar + NA_GT); E.T.ldc[5] = 256; E.T.t0[5] = 47;
                    E.T.base[6] = (bf16*)(ar + NA_VSR); E.T.ldc[6] = 512; E.T.t0[6] = 48;
                    E.T.base[7] = (bf16*)(ar + NA_VWR); E.T.ldc[7] = 512; E.T.t0[7] = 50; E.T.nseg = 8; E.ssp = SSB + (size_t)(LAYER * 2) * MTOT * 8; E.ss_off = roff;
                    GEMM_CALL(pg8::EpiBf16R, E, XN + (size_t)roff * DM, WB + NW_IN, MC, 13312, DM, DM, DM, (int)blockIdx.x); } PH_END
                PH_BEGIN ph_nsa_rope(F, half); PH_END
                PH_BEGIN {
                    const float* BIAS = (const float*)(args.ws + WS_MISC);
                    { pg8::EpiGelu E{(bf16*)(ar + NA_GK), 256, BIAS}; GEMM_CALL(pg8::EpiGelu, E, ar + NA_KC, WB + NW_W1K, 4096, 256, 6144, 3072, 6144, (int)blockIdx.x); }
                    { pg8::EpiGelu E{(bf16*)(ar + NA_GV), 256, BIAS + 256}; GEMM_CALL(pg8::EpiGelu, E, ar + NA_VC, WB + NW_W1V, 4096, 256, 4096, 2048, 4096, (int)((blockIdx.x + F.G - 16) % F.G)); }
                } PH_END
                PH_BEGIN {
                    { pg8::EpiBf16R E = epi1((bf16*)(ar + NA_KCMP), 12); E.T.gw[0] = -1; GEMM_CALL(pg8::EpiBf16R, E, ar + NA_GK, WB + NW_W2K, 4096, 256, 256, 256, 256, (int)blockIdx.x); }
                    { pg8::EpiBf16R E = epi1((bf16*)(ar + NA_VCT), 4); E.T.gw[0] = -2; GEMM_CALL(pg8::EpiBf16R, E, WB + NW_W2V, ar + NA_GV, 256, 4096, 256, 256, 256, (int)((blockIdx.x + F.G - 16) % F.G)); }
                } PH_END
                PH_BEGIN if (PROBE_PH == 4) { ph_nsa_cmp(F, 1); __syncthreads(); } ph_nsa_cmp(F); PH_END
                PH_BEGIN if (PROBE_PH == 5) { ph_nsa_sel(F, 1); __syncthreads(); } ph_nsa_sel(F); PH_END
                PH_BEGIN if (PROBE_PH == 6) { ph_nsa_win(F, 1); __syncthreads(); } ph_nsa_win(F); PH_END
                PH_BEGIN { pg8::EpiResN E{LAYER == 0 ? args.in[0] : nullptr, args.in[ib], nullptr, DM, roff, args.in[iff], (pg8::bf16_t*)XN, SSB + (size_t)(LAYER * 2 + 1) * MTOT * 8, (PG8_LAS float*)(F.lds + LDSCTL_OFF + 256)}; GEMM_CALL(pg8::EpiResN, E, ar + NA_O, WB + NW_OUT, MC, DM, 6144, 6144, 6144, (int)blockIdx.x); } PH_END
            }
}
template <int LAYER> DI void run_ffn(const Args& args, LAS unsigned char* lds, volatile LAS unsigned* MISC, int& ph, const int lo, const int hi) {
    constexpr int ib = (LAYER == 0) ? 2 : (LAYER == 1) ? 17 : (LAYER == 2) ? 26 : 42;
    constexpr int iff = (LAYER == 0) ? 12 : (LAYER == 1) ? 21 : (LAYER == 2) ? 37 : 52;
    PH_BEGIN {
        LAS float* rt = (LAS float*)(F.lds + LDSCTL_OFF + 256 + 8192); const int rbase = 4096 * (int)(blockIdx.x & 7); const float* ssq = SSB + (size_t)(LAYER * 2 + 1) * MTOT * 8;
        for (int i = F.tid; i < 4096; i += NWAVES * 64) rt[i] = pg8::rms_rowscale(ssq, rbase + i);
        __syncthreads();
        pg8::EpiConvGlu E{(pg8::bf16_t*)ar, (float*)(ar + 352 * MiB), args.in[iff + 2], args.in[iff + 3], (PG8_LAS float*)(F.lds + LDSCTL_OFF + 256), DFF, (const PG8_LAS float*)rt, rbase};
        GEMM_CALL(pg8::EpiConvGlu, E, XN, WUP, MTOT, 2 * DFF, DM, DM, DM, (int)blockIdx.x); } PH_END
    PH_BEGIN ph_conv_fix(F, (const float*)(ar + 352 * MiB), (bf16*)ar, args.in[iff + 2], args.in[iff + 3], MTOT); PH_END
    PH_BEGIN {
        if constexpr (LAYER < 3) { constexpr int ibn = (LAYER == 0) ? 17 : (LAYER == 1) ? 26 : 42;
            pg8::EpiResN E{nullptr, args.in[iff], nullptr, DM, 0, args.in[ibn], (pg8::bf16_t*)XN, SSB + (size_t)((LAYER + 1) * 2) * MTOT * 8, (PG8_LAS float*)(F.lds + LDSCTL_OFF + 256)}; GEMM_CALL(pg8::EpiResN, E, ar, WDN, MTOT, DM, DFF, DFF, DFF, (int)blockIdx.x); }
        else { pg8::EpiResN E{nullptr, args.in[iff], out, DM, 0, nullptr, (pg8::bf16_t*)XN, nullptr, (PG8_LAS float*)(F.lds + LDSCTL_OFF + 256)}; GEMM_CALL(pg8::EpiResN, E, ar, WDN, MTOT, DM, DFF, DFF, DFF, (int)blockIdx.x); }
    } PH_END
}
__global__ void __launch_bounds__(NWAVES * 64, 2) mk_fwd(Args args) {
    extern __shared__ __attribute__((aligned(16))) unsigned char lds_[];
    LAS unsigned char* const lds = (LAS unsigned char*)lds_;
    volatile LAS unsigned* MISC = (volatile LAS unsigned*)(lds + LDSCTL_OFF);
    for (int u = threadIdx.x; u < 64; u += NWAVES * 64) ((LAS unsigned*)(lds + LDSCTL_OFF))[u] = 0u;
    __syncthreads();
    const int lo = args.ph_lo, hi = args.ph_hi;
    (void)xcd_barrier_post((unsigned*)(args.ws + WS_CTL) + CW_BAR, MISC + 8);
    int ph = 0;
    { constexpr int ib = 2, iff = 12; PH_BEGIN ph_tables(F, (const int*)args.in[1]); ph_norm_first(F, args.in[0], args.in[2], XN, SSB); PH_END }
    run_cvt<0>(args, lds, MISC, ph, lo, hi); run_half<0, 0>(args, lds, MISC, ph, lo, hi); run_half<0, 1>(args, lds, MISC, ph, lo, hi); run_ffn<0>(args, lds, MISC, ph, lo, hi);
    run_cvt<1>(args, lds, MISC, ph, lo, hi); run_half<1, 0>(args, lds, MISC, ph, lo, hi); run_half<1, 1>(args, lds, MISC, ph, lo, hi); run_ffn<1>(args, lds, MISC, ph, lo, hi);
    run_cvt<2>(args, lds, MISC, ph, lo, hi); run_half<2, 0>(args, lds, MISC, ph, lo, hi); run_half<2, 1>(args, lds, MISC, ph, lo, hi); run_ffn<2>(args, lds, MISC, ph, lo, hi);
    run_cvt<3>(args, lds, MISC, ph, lo, hi); run_half<3, 0>(args, lds, MISC, ph, lo, hi); run_half<3, 1>(args, lds, MISC, ph, lo, hi); run_ffn<3>(args, lds, MISC, ph, lo, hi);
    { constexpr int ib = 42, iff = 52; PH_BEGIN ph_final_norm(F, out, args.in[57]); PH_END }
}
extern "C" void kernel_launch(void* const* d_in, const int* in_sizes, int n_in, void* d_out, int out_size, void* d_ws, size_t ws_size, hipStream_t stream) {
    static int grid = 0;
    if (grid == 0) {
        if (n_in != 58 || out_size != MTOT * DM || ws_size < WS_END) { fprintf(stderr, "kernel_launch: unexpected shapes (n_in %d, out %d, ws %zu)\n", n_in, out_size, ws_size); grid = -1; return; }
        int dev = 0, cus = 0;
        if (hipGetDevice(&dev) != hipSuccess || hipDeviceGetAttribute(&cus, hipDeviceAttributeMultiprocessorCount, dev) != hipSuccess) { grid = -1; return; }
        if (hipFuncSetAttribute((const void*)mk_fwd, hipFuncAttributeMaxDynamicSharedMemorySize, LDS_BYTES) != hipSuccess) { fprintf(stderr, "kernel_launch: hipFuncSetAttribute failed\n"); grid = -1; return; }
        int per_cu = 0;
        (void)hipOccupancyMaxActiveBlocksPerMultiprocessor(&per_cu, (const void*)mk_fwd, NWAVES * 64, LDS_BYTES);
        (void)hipGetLastError();
        grid = cus;
    }
    if (grid < 0) return;
    if (hipMemsetAsync((char*)d_ws + WS_CTL, 0, CTL_ZERO_BYTES, stream) != hipSuccess) return;
    Args a{};
    for (int i = 0; i < 58; ++i) a.in[i] = (const float*)d_in[i];
    a.out = (float*)d_out; a.ws = (unsigned char*)d_ws;
#if MK_ONE_LAUNCH
    a.ph_lo = 0; a.ph_hi = NPH;
    hipLaunchKernelGGL(mk_fwd, dim3(grid), dim3(NWAVES * 64), LDS_BYTES, stream, a);
#else
    for (int p = 0; p < NPH; ++p) { a.ph_lo = p; a.ph_hi = p + 1; hipLaunchKernelGGL(mk_fwd, dim3(grid), dim3(NWAVES * 64), LDS_BYTES, stream, a); }
#endif
}
```

```cpp
#include <hip/hip_runtime.h>
#include <cstdio>
#include <cstdint>
#define DI __device__ __forceinline__
namespace pg8 {
#define PG8_LAS __attribute__((address_space(3)))
typedef unsigned short bf16_t;
typedef short bf16x8 __attribute__((ext_vector_type(8)));
typedef float f32x4 __attribute__((ext_vector_type(4)));
typedef unsigned u32x4 __attribute__((ext_vector_type(4)));
constexpr int BM = 256, BK = 64, HALF = 128, HTB = HALF * BK * 2  , STAGE_BYTES = 8 * HTB, NXCD = 8, WGM = 8;

__host__ __device__ __forceinline__ int lds_byte(int r, int c) { const int st = (r >> 4) * 2 + (c >> 5), rr = r & 15, cc = c & 31, ob = rr * 64 + cc * 2; return st * 1024 + (ob ^ (((ob >> 9) & 1) << 5)); }
__host__ __device__ __forceinline__ void stage_rc(int b, int& R, int& C) { const int st = b / 1024, sb = b % 1024, swz = sb ^ (((sb >> 9) & 1) << 5); R = (st >> 1) * 16 + swz / 64; C = (st & 1) * 32 + (swz % 64) / 2; }
__host__ __device__ __forceinline__ int perm32(int rho) { const int n = rho >> 4, i = rho & 15; return 8 * (i >> 2) + 4 * n + (i & 3); }

struct Unit { int pm, pn; };
struct Gemm { const bf16_t* A; const bf16_t* Bt; int M, N, K, lda, ldb, akoff; };

struct StaticOrder {
    int nM, nN, nwg, G, c;
    __host__ __device__ void init(int M, int N, int G_, int c_) { nM = M / BM; nN = N / BM; nwg = nM * nN; G = G_; c = c_; }
    __host__ __device__ bool next(int i, Unit& u) const {
        const long L = (long)i * G + c; if (L >= nwg) return false;
        int wgid = (int)L; { const int q = nwg / NXCD, r = nwg % NXCD, xcd = wgid % NXCD, off = wgid / NXCD; wgid = (xcd < r ? xcd * (q + 1) : r * (q + 1) + (xcd - r) * q) + off; }
        const int nig = WGM * nN, gid = wgid / nig, fm = gid * WGM, gsz = (nM - fm) < WGM ? (nM - fm) : WGM;
        u.pm = fm + ((wgid % nig) % gsz); u.pn = (wgid % nig) / gsz; return true;
    }
    __device__ __forceinline__ void a_ready(const Unit&) const {}
    __device__ __forceinline__ void done(const Unit&) const {}
};
__device__ __forceinline__ unsigned cvt_pk_bf16(float lo, float hi) { unsigned r; asm volatile("v_cvt_pk_bf16_f32 %0, %1, %2" : "=v"(r) : "v"(lo), "v"(hi)); return r; }
template <class Epi, class Sched, bool ALIGN_EPI = false, bool SP2 = false>
__device__ __forceinline__ void gemm_phase(PG8_LAS unsigned char* lds, const Gemm g, const Sched& S, const Epi& E) {
    const int tid = threadIdx.x, wid = __builtin_amdgcn_readfirstlane(tid >> 6), lane = tid & 63, wr = wid >> 2, wc = wid & 3, fr = lane & 15, fq = lane >> 4;
    const int K = g.K, nt = K / BK;
    unsigned voffA[2], voffB[2];
#pragma unroll
    for (int i = 0; i < 2; ++i) { int R, C; stage_rc(tid * 16 + i * 8192, R, C); const int Rb = Epi::PERM ? ((R & ~31) + perm32(R & 31)) : R;
        voffA[i] = (unsigned)(R * g.lda + C) * 2u; voffB[i] = (unsigned)(Rb * g.ldb + C) * 2u; }
    const size_t kstep = (size_t)(BK * 2);
    const size_t hstepA = (size_t)HALF * g.lda * 2, hstepB = (size_t)HALF * g.ldb * 2;
    const size_t tstepA = 2 * hstepA, tstepB = 2 * hstepB;
    const unsigned ldsw = (unsigned)wid * 1024u;
    const int aoff = lds_byte(wr * 64 + fr, fq * 8), boff = lds_byte(wc * 32 + fr, fq * 8);
#define PG8_SA(b, h) (((b) * 2 + (h)) * HTB)
#define PG8_SB(b, h) ((4 + (b) * 2 + (h)) * HTB)
#define PG8_STAGE(bufoff, gbase, voff) do { _Pragma("unroll") for (int _i = 0; _i < 2; ++_i) \
        __builtin_amdgcn_global_load_lds((const unsigned*)((const char*)(gbase) + (voff)[_i]), (PG8_LAS unsigned*)(lds + (bufoff) + ldsw + _i * 8192), 16, 0, 0); } while (0)
#define PG8_LDA(dst, b, h) do { _Pragma("unroll") for (int m = 0; m < 4; ++m) _Pragma("unroll") for (int k = 0; k < 2; ++k) dst[m][k] = *(const PG8_LAS bf16x8*)(lds + PG8_SA(b, h) + aoff + m * 2048 + k * 1024); } while (0)
#define PG8_LDB(dst, b, h) do { _Pragma("unroll") for (int n = 0; n < 2; ++n) _Pragma("unroll") for (int k = 0; k < 2; ++k) dst[n][k] = *(const PG8_LAS bf16x8*)(lds + PG8_SB(b, h) + boff + n * 2048 + k * 1024); } while (0)
#define PG8_MMA(ai, bj, At, Bt) do { __builtin_amdgcn_s_setprio(1); _Pragma("unroll") for (int m = 0; m < 4; ++m) _Pragma("unroll") for (int n = 0; n < 2; ++n) _Pragma("unroll") for (int k = 0; k < 2; ++k) \
        acc[ai][bj][m][n] = __builtin_amdgcn_mfma_f32_16x16x32_bf16(Bt[n][k], At[m][k], acc[ai][bj][m][n], 0, 0, 0); __builtin_amdgcn_s_setprio(0); } while (0)
#define PG8_WAIT_V(n) asm volatile("s_waitcnt vmcnt(" #n ")" ::: "memory")
#define PG8_WAIT_L(n) asm volatile("s_waitcnt lgkmcnt(" #n ")" ::: "memory")
#define PG8_BAR __builtin_amdgcn_s_barrier()
#define PG8_SCHED __builtin_amdgcn_sched_barrier(0)
    Unit cur, nxt; int ui = 0;
    if (!S.next(0, cur)) return;
    f32x4 acc[2][2][4][2];
#pragma unroll
    for (int a = 0; a < 2; ++a)
#pragma unroll
        for (int b = 0; b < 2; ++b)
#pragma unroll
            for (int m = 0; m < 4; ++m)
#pragma unroll
                for (int n = 0; n < 2; ++n) acc[a][b][m][n] = (f32x4){0.f, 0.f, 0.f, 0.f};
    bf16x8 At[4][2], B0[2][2], B1[2][2];
    const char* cA = (const char*)g.A + (size_t)cur.pm * tstepA + (size_t)cur.pn * g.akoff * 2; const char* cB = (const char*)g.Bt + (size_t)cur.pn * tstepB;
    S.a_ready(cur);
    if constexpr (SP2) {
        PG8_STAGE(PG8_SB(0, 0), cB, voffB); PG8_STAGE(PG8_SB(0, 1), cB + hstepB, voffB); PG8_STAGE(PG8_SA(0, 0), cA, voffA); PG8_STAGE(PG8_SA(0, 1), cA + hstepA, voffA);
        if (wr == 1) PG8_BAR;
        PG8_WAIT_V(2); PG8_BAR;
        PG8_STAGE(PG8_SB(1, 0), cB + kstep, voffB); PG8_STAGE(PG8_SA(1, 0), cA + kstep, voffA); PG8_STAGE(PG8_SB(1, 1), cB + hstepB + kstep, voffB);
        PG8_WAIT_V(6); PG8_BAR;
    } else {
        PG8_STAGE(PG8_SB(0, 0), cB, voffB); PG8_STAGE(PG8_SA(0, 0), cA, voffA); PG8_STAGE(PG8_SB(0, 1), cB + hstepB, voffB); PG8_STAGE(PG8_SA(0, 1), cA + hstepA, voffA);
        if (wr == 1) PG8_BAR;
        PG8_WAIT_V(4); PG8_BAR;
        PG8_STAGE(PG8_SB(1, 0), cB + kstep, voffB); PG8_STAGE(PG8_SA(1, 0), cA + kstep, voffA); PG8_STAGE(PG8_SB(1, 1), cB + hstepB + kstep, voffB);
        PG8_WAIT_V(6); PG8_BAR;
    }
    for (;;) {
        const bool has_next = S.next(ui + 1, nxt);
        const char* nA = has_next ? (const char*)g.A + (size_t)nxt.pm * tstepA + (size_t)nxt.pn * g.akoff * 2 : cA; const char* nB = has_next ? (const char*)g.Bt + (size_t)nxt.pn * tstepB : cB;
        for (int t = 0; t < nt; t += 2) {
            const bool last = (t == nt - 2);
            const char* a1 = cA + (size_t)(t + 1) * kstep;
            const char* a2 = last ? nA : cA + (size_t)(t + 2) * kstep; const char* b2 = last ? nB : cB + (size_t)(t + 2) * kstep;
            const char* a3 = a2 + kstep; const char* b3 = b2 + kstep;
            if (last && has_next) S.a_ready(nxt);
            if constexpr (SP2) {
            PG8_LDB(B0, 0, 0); PG8_LDB(B1, 0, 1); PG8_SCHED; PG8_LDA(At, 0, 0); PG8_STAGE(PG8_SA(1, 1), a1 + hstepA, voffA);
            PG8_WAIT_V(8); PG8_WAIT_L(0); PG8_BAR; PG8_MMA(0, 0, At, B0); PG8_MMA(0, 1, At, B1); PG8_BAR; PG8_SCHED;
            PG8_LDA(At, 0, 1); PG8_STAGE(PG8_SB(0, 0), b2, voffB); PG8_STAGE(PG8_SB(0, 1), b2 + hstepB, voffB); PG8_STAGE(PG8_SA(0, 0), a2, voffA);
            PG8_WAIT_V(8); PG8_WAIT_L(0); PG8_BAR; PG8_MMA(1, 0, At, B0); PG8_MMA(1, 1, At, B1); PG8_BAR; PG8_SCHED;
            PG8_LDB(B0, 1, 0); PG8_LDB(B1, 1, 1); PG8_SCHED; PG8_LDA(At, 1, 0); PG8_STAGE(PG8_SA(0, 1), a2 + hstepA, voffA);
            PG8_WAIT_V(8); PG8_WAIT_L(0); PG8_BAR; PG8_MMA(0, 0, At, B0); PG8_MMA(0, 1, At, B1); PG8_BAR; PG8_SCHED;
            PG8_LDA(At, 1, 1); PG8_STAGE(PG8_SB(1, 0), b3, voffB); PG8_STAGE(PG8_SB(1, 1), b3 + hstepB, voffB); PG8_STAGE(PG8_SA(1, 0), a3, voffA);
            PG8_WAIT_V(8); PG8_WAIT_L(0); PG8_BAR; PG8_MMA(1, 0, At, B0); PG8_MMA(1, 1, At, B1); PG8_BAR; PG8_SCHED;
            } else {
            PG8_LDB(B0, 0, 0); PG8_SCHED; PG8_LDA(At, 0, 0); PG8_STAGE(PG8_SA(1, 1), a1 + hstepA, voffA);
            PG8_WAIT_L(8); PG8_BAR; PG8_WAIT_L(0); PG8_MMA(0, 0, At, B0); PG8_BAR; PG8_SCHED;
            PG8_LDB(B1, 0, 1); PG8_STAGE(PG8_SB(0, 0), b2, voffB);
            PG8_BAR; PG8_WAIT_L(0); PG8_MMA(0, 1, At, B1); PG8_BAR;
            PG8_LDA(At, 0, 1); PG8_STAGE(PG8_SA(0, 0), a2, voffA);
            PG8_BAR; PG8_WAIT_L(0); PG8_MMA(1, 0, At, B0); PG8_BAR; PG8_SCHED;
            PG8_STAGE(PG8_SB(0, 1), b2 + hstepB, voffB);
            PG8_WAIT_V(6); PG8_BAR; PG8_MMA(1, 1, At, B1); PG8_BAR;
            PG8_LDB(B0, 1, 0); PG8_SCHED; PG8_LDA(At, 1, 0); PG8_STAGE(PG8_SA(0, 1), a2 + hstepA, voffA);
            PG8_WAIT_L(8); PG8_BAR; PG8_WAIT_L(0); PG8_MMA(0, 0, At, B0); PG8_BAR; PG8_SCHED;
            PG8_LDB(B1, 1, 1); PG8_STAGE(PG8_SB(1, 0), b3, voffB);
            PG8_BAR; PG8_WAIT_L(0); PG8_MMA(0, 1, At, B1); PG8_BAR;
            PG8_LDA(At, 1, 1); PG8_STAGE(PG8_SA(1, 0), a3, voffA);
            PG8_BAR; PG8_WAIT_L(0); PG8_MMA(1, 0, At, B0); PG8_BAR; PG8_SCHED;
            PG8_STAGE(PG8_SB(1, 1), b3 + hstepB, voffB);
            PG8_WAIT_V(6); PG8_BAR; PG8_MMA(1, 1, At, B1); PG8_BAR;
            }
        }
        if constexpr (ALIGN_EPI) { if (wr == 0) PG8_BAR; }
        if constexpr (!Epi::AFTER_DRAIN) { E(acc, cur, wr, wc, fr, fq); S.done(cur); }
        if (!has_next) break;
#pragma unroll
        for (int a = 0; a < 2; ++a)
#pragma unroll
            for (int b = 0; b < 2; ++b)
#pragma unroll
                for (int m = 0; m < 4; ++m)
#pragma unroll
                    for (int n = 0; n < 2; ++n) acc[a][b][m][n] = (f32x4){0.f, 0.f, 0.f, 0.f};
        cur = nxt; cA = nA; cB = nB; ++ui;
        if constexpr (ALIGN_EPI) { if (wr == 1) PG8_BAR; }
    }
    PG8_WAIT_V(0);
    if constexpr (!ALIGN_EPI) { if (wr == 0) PG8_BAR; }
    PG8_BAR;
    if constexpr (Epi::AFTER_DRAIN) { E.fused(acc, cur, wr, wc, fr, fq, lds, wid, lane); S.done(cur); }
#undef PG8_SA
#undef PG8_SB
#undef PG8_STAGE
#undef PG8_LDA
#undef PG8_LDB
#undef PG8_MMA
#undef PG8_WAIT_V
#undef PG8_WAIT_L
#undef PG8_BAR
#undef PG8_SCHED
}
}
namespace pg8 {
typedef float f32x2 __attribute__((ext_vector_type(2)));
__device__ __forceinline__ float rms_rowscale(const float* ssq, int row) { const f32x4 a = *(const f32x4*)(ssq + (size_t)row * 8), b = *(const f32x4*)(ssq + (size_t)row * 8 + 4);
    return __builtin_amdgcn_rsqf((((a[0] + a[1]) + (a[2] + a[3])) + ((b[0] + b[1]) + (b[2] + b[3]))) * (1.0f / 2048.0f) + 1e-6f); }
struct SegTab { bf16_t* base[8]; int ldc[8]; int t0[8]; int gw[8]; int nseg; int pad_; };
struct EpiBf16R {
    static constexpr bool PERM = true, AFTER_DRAIN = false;
    SegTab T; const float* ssp; int ss_off;
    __device__ __forceinline__ void operator()(const f32x4 (&acc)[2][2][4][2], const Unit& u, int wr, int wc, int fr, int fq) const {
        bf16_t* base = T.base[0]; int ldc = T.ldc[0], gw = T.gw[0], t0 = T.t0[0];
#pragma unroll
        for (int s = 1; s < 8; ++s) if (s < T.nseg && u.pn >= T.t0[s]) { base = T.base[s]; ldc = T.ldc[s]; gw = T.gw[s]; t0 = T.t0[s]; }
        const int colt = (u.pn - t0) * BM, row0 = u.pm * BM + wr * 64 + fr;
#pragma unroll
        for (int ai = 0; ai < 2; ++ai)
#pragma unroll
            for (int m = 0; m < 4; ++m) { const int row = row0 + ai * HALF + m * 16;
                const float rs = ssp ? rms_rowscale(ssp, ss_off + row) : 1.0f;
#pragma unroll
                for (int bj = 0; bj < 2; ++bj) { const int col = colt + bj * HALF + wc * 32 + 8 * fq;
                    const f32x4 v0 = acc[ai][bj][m][0] * rs, v1 = acc[ai][bj][m][1] * rs;
                    u32x4 w; w.x = cvt_pk_bf16(v0[0], v0[1]); w.y = cvt_pk_bf16(v0[2], v0[3]); w.z = cvt_pk_bf16(v1[0], v1[1]); w.w = cvt_pk_bf16(v1[2], v1[3]);
                    if (gw == -2) {
                        if ((row >> 5) < ldc) { bf16_t* d0 = base + ((size_t)(((col >> 5) * ldc + (row >> 5)) * 2 + ((col >> 4) & 1)) * 64 + (row & 31)) * 8 + 4 * ((col >> 3) & 1);
                            typedef unsigned u32x2_ __attribute__((ext_vector_type(2)));
                            *(u32x2_*)d0 = (u32x2_){w.x, w.y}; *(u32x2_*)(d0 + 32 * 8) = (u32x2_){w.z, w.w}; }
                        continue; }
                    bf16_t* dst;
                    if (gw == 0) dst = base + (size_t)row * ldc + col;
                    else if (gw == -1) { if ((col >> 4) >= ldc) continue; dst = base + ((size_t)((row >> 5) * ldc + (col >> 4)) * 64 + ((col >> 3) & 1) * 32 + (row & 31)) * 8; }
                    else { const int g = col / gw, d = col - g * gw; dst = base + ((size_t)((row >> 12) * 4 + g) * 4096 + (row & 4095)) * gw + d; }
                    *(u32x4*)dst = w; } }
    }
};
struct EpiGelu {
    static constexpr bool PERM = true, AFTER_DRAIN = false;
    bf16_t* O; int ldc; const float* bias;
    static __device__ __forceinline__ float gelu(float x) { const float u2 = 1.5957691216f * (x + 0.044715f * x * x * x); const float e = __builtin_amdgcn_exp2f(-u2 * 1.4426950409f); return x * __builtin_amdgcn_rcpf(1.0f + e); }
    __device__ __forceinline__ void operator()(const f32x4 (&acc)[2][2][4][2], const Unit& u, int wr, int wc, int fr, int fq) const {
        const int row0 = u.pm * BM + wr * 64 + fr, col0 = u.pn * BM + wc * 32 + 8 * fq;
#pragma unroll
        for (int bj = 0; bj < 2; ++bj) { const f32x4 b0 = *(const f32x4*)(bias + col0 + bj * HALF), b1 = *(const f32x4*)(bias + col0 + bj * HALF + 4);
#pragma unroll
            for (int ai = 0; ai < 2; ++ai)
#pragma unroll
                for (int m = 0; m < 4; ++m) { const f32x4 v0 = acc[ai][bj][m][0] + b0, v1 = acc[ai][bj][m][1] + b1;
                    u32x4 w; w.x = cvt_pk_bf16(gelu(v0[0]), gelu(v0[1])); w.y = cvt_pk_bf16(gelu(v0[2]), gelu(v0[3])); w.z = cvt_pk_bf16(gelu(v1[0]), gelu(v1[1])); w.w = cvt_pk_bf16(gelu(v1[2]), gelu(v1[3]));
                    *(u32x4*)(O + (size_t)(row0 + ai * HALF + m * 16) * ldc + col0 + bj * HALF) = w; } }
    }
};
struct EpiF32 {
    static constexpr bool PERM = false, AFTER_DRAIN = false;
    float* C; int ldc; const float* ssp; int ss_off;
    __device__ __forceinline__ void operator()(const f32x4 (&acc)[2][2][4][2], const Unit& u, int wr, int wc, int fr, int fq) const {
        const int row0 = u.pm * BM + wr * 64 + fr, col0 = u.pn * BM + wc * 32 + 4 * fq;
#pragma unroll
        for (int ai = 0; ai < 2; ++ai)
#pragma unroll
            for (int m = 0; m < 4; ++m) { float* rowp = C + (size_t)(row0 + ai * HALF + m * 16) * ldc + col0;
                const float rs = ssp ? rms_rowscale(ssp, ss_off + row0 + ai * HALF + m * 16) : 1.0f;
#pragma unroll
                for (int bj = 0; bj < 2; ++bj)
#pragma unroll
                    for (int n = 0; n < 2; ++n) *(f32x4*)(rowp + bj * HALF + n * 16) = acc[ai][bj][m][n] * rs; }
    }
};
struct EpiRes {
    static constexpr bool PERM = false, AFTER_DRAIN = false;
    const float* res; float* out; int ldc; int row_off;
    __device__ __forceinline__ void operator()(const f32x4 (&acc)[2][2][4][2], const Unit& u, int wr, int wc, int fr, int fq) const {
        const int row0 = row_off + u.pm * BM + wr * 64 + fr, col0 = u.pn * BM + wc * 32 + 4 * fq;
#pragma unroll
        for (int ai = 0; ai < 2; ++ai)
#pragma unroll
            for (int m = 0; m < 4; ++m) { const size_t off = (size_t)(row0 + ai * HALF + m * 16) * ldc + col0;
                f32x4 r[2][2];
#pragma unroll
                for (int bj = 0; bj < 2; ++bj)
#pragma unroll
                    for (int n = 0; n < 2; ++n) r[bj][n] = *(const f32x4*)(res + off + bj * HALF + n * 16);
#pragma unroll
                for (int bj = 0; bj < 2; ++bj)
#pragma unroll
                    for (int n = 0; n < 2; ++n) *(f32x4*)(out + off + bj * HALF + n * 16) = r[bj][n] + acc[ai][bj][m][n];
                asm volatile("" ::: "memory"); }
    }
};
struct EpiDry {
    static constexpr bool PERM = false, AFTER_DRAIN = false;
    float* D;
    __device__ __forceinline__ void operator()(const f32x4 (&acc)[2][2][4][2], const Unit& u, int wr, int wc, int fr, int fq) const {
        float* p = D + ((size_t)blockIdx.x * 512 + threadIdx.x) * 64;
#pragma unroll
        for (int ai = 0; ai < 2; ++ai)
#pragma unroll
            for (int m = 0; m < 4; ++m)
#pragma unroll
                for (int bj = 0; bj < 2; ++bj) *(f32x4*)(p + ((ai * 4 + m) * 2 + bj) * 4) = acc[ai][bj][m][0] + acc[ai][bj][m][1];
    }
};
struct EpiResN {
    static constexpr bool PERM = false, AFTER_DRAIN = false;
    const float* res32; const float* gprev; float* out32; int ldc; int row_off; const float* g; bf16_t* xn; float* ss; PG8_LAS float* xb;
    __device__ __forceinline__ void operator()(const f32x4 (&acc)[2][2][4][2], const Unit& u, int wr, int wc, int fr, int fq) const {
        typedef unsigned u32x2_ __attribute__((ext_vector_type(2)));
        const int row0 = row_off + u.pm * BM + wr * 64 + fr, col0 = u.pn * BM + wc * 32 + 4 * fq;
        f32x4 gv[2][2], gi[2][2];
#pragma unroll
        for (int bj = 0; bj < 2; ++bj)
#pragma unroll
            for (int n = 0; n < 2; ++n) { gv[bj][n] = g ? *(const f32x4*)(g + col0 + bj * HALF + n * 16) : (f32x4){0.f, 0.f, 0.f, 0.f};
                if (!res32) { const f32x4 t = *(const f32x4*)(gprev + col0 + bj * HALF + n * 16); gi[bj][n] = (f32x4){1.0f / t[0], 1.0f / t[1], 1.0f / t[2], 1.0f / t[3]}; } else gi[bj][n] = (f32x4){1.f, 1.f, 1.f, 1.f}; }
#pragma unroll
        for (int ai = 0; ai < 2; ++ai)
#pragma unroll
            for (int m = 0; m < 4; ++m) { const int row = row0 + ai * HALF + m * 16; const size_t off = (size_t)row * ldc + col0;
                f32x4 r[2][2]; float sq = 0.f;
#pragma unroll
                for (int bj = 0; bj < 2; ++bj)
#pragma unroll
                    for (int n = 0; n < 2; ++n) {
                        if (res32) r[bj][n] = *(const f32x4*)(res32 + off + bj * HALF + n * 16);
                        else { const u32x2_ w = *(const u32x2_*)(xn + off + bj * HALF + n * 16);
                            r[bj][n] = (f32x4){__builtin_bit_cast(float, w.x << 16), __builtin_bit_cast(float, w.x & 0xffff0000u), __builtin_bit_cast(float, w.y << 16), __builtin_bit_cast(float, w.y & 0xffff0000u)} * gi[bj][n]; } }
#pragma unroll
                for (int bj = 0; bj < 2; ++bj)
#pragma unroll
                    for (int n = 0; n < 2; ++n) { const f32x4 o = r[bj][n] + acc[ai][bj][m][n];
                        if (out32) *(f32x4*)(out32 + off + bj * HALF + n * 16) = o;
                        if (g) { sq += (o[0] * o[0] + o[1] * o[1]) + (o[2] * o[2] + o[3] * o[3]);
                            const f32x4 y = o * gv[bj][n]; *(u32x2_*)(xn + off + bj * HALF + n * 16) = (u32x2_){cvt_pk_bf16(y[0], y[1]), cvt_pk_bf16(y[2], y[3])}; } }
                if (g) { sq += __shfl_xor(sq, 16); sq += __shfl_xor(sq, 32);
                    if (fq == 0) xb[(ai * HALF + wr * 64 + m * 16 + fr) * 4 + wc] = sq; }
                asm volatile("" ::: "memory"); }
        if (g) {
            asm volatile("s_waitcnt lgkmcnt(0)" ::: "memory"); __builtin_amdgcn_s_barrier(); asm volatile("" ::: "memory");
            const int t = (wr * 4 + wc) * 64 + fq * 16 + fr;
            if (t < BM) { const f32x4 v = *(const PG8_LAS f32x4*)(xb + t * 4); ss[(size_t)(row_off + u.pm * BM + t) * 8 + u.pn] = (v[0] + v[1]) + (v[2] + v[3]); }
        }
    }
};
struct EpiConvGlu {
    static constexpr bool PERM = true, AFTER_DRAIN = false;
    bf16_t* G; float* UB; const float* cw; const float* cb; PG8_LAS float* xb; int dff; const PG8_LAS float* rstd; int rbase;
    static __device__ __forceinline__ float shr(float old, float src, int n) { const int o = __builtin_bit_cast(int, old), s = __builtin_bit_cast(int, src);
        return __builtin_bit_cast(float, n == 1 ? __builtin_amdgcn_update_dpp(o, s, 0x111, 0xf, 0xf, false) : __builtin_amdgcn_update_dpp(o, s, 0x112, 0xf, 0xf, false)); }
    static __device__ __forceinline__ float ror(float src, int n) { const int s = __builtin_bit_cast(int, src);
        return __builtin_bit_cast(float, n == 1 ? __builtin_amdgcn_update_dpp(0, s, 0x121, 0xf, 0xf, false) : __builtin_amdgcn_update_dpp(0, s, 0x122, 0xf, 0xf, false)); }
    __device__ __forceinline__ void operator()(f32x4 (&acc)[2][2][4][2], const Unit& u, int wr, int wc, int fr, int fq) const {
        typedef unsigned u32x2_ __attribute__((ext_vector_type(2)));
        if (rstd) {
#pragma unroll
            for (int ai = 0; ai < 2; ++ai)
#pragma unroll
                for (int m = 0; m < 4; ++m) { const float rs = rstd[u.pm * BM + ai * HALF + wr * 64 + m * 16 + fr - rbase];
#pragma unroll
                    for (int bj = 0; bj < 2; ++bj)
#pragma unroll
                        for (int n = 0; n < 2; ++n) acc[ai][bj][m][n] = acc[ai][bj][m][n] * rs; }
        }
        if (fr >= 14) {
#pragma unroll
            for (int ai = 0; ai < 2; ++ai)
#pragma unroll
                for (int bj = 0; bj < 2; ++bj)
#pragma unroll
                    for (int n = 0; n < 2; ++n) *(PG8_LAS f32x4*)(xb + (((((ai * 2 + wr) * 4 + wc) * 2 + (fr - 14)) * 4 + fq) * 16) + (bj * 2 + n) * 4) = acc[ai][bj][3][n];
        }
        { const int ncol = 4 * dff / 2;
          const bool top = (wr == 0 && fr < 2), bot = (wr == 1 && fr >= 14);
          if (top || bot) { float* ub = UB + ((size_t)(u.pm * 4 + (top ? fr : 2 + fr - 14)) * ncol) + u.pn * BM + wc * 32 + 8 * fq;
#pragma unroll
            for (int bj = 0; bj < 2; ++bj)
#pragma unroll
                for (int n = 0; n < 2; ++n) *(f32x4*)(ub + bj * HALF + 4 * n) = top ? acc[0][bj][0][n] : acc[1][bj][3][n]; } }
        asm volatile("s_waitcnt lgkmcnt(0)" ::: "memory"); __builtin_amdgcn_s_barrier(); asm volatile("" ::: "memory");
        u32x2_ res[2][4][2];
        const int ch0 = u.pn * HALF + wc * 32 + 8 * fq;
#pragma unroll
        for (int n = 0; n < 2; ++n) {
            const float* wp = cw + ch0 + 4 * n; const float* bp = cb + ch0 + 4 * n;
            const f32x4 w0g = *(const f32x4*)(wp), w1g = *(const f32x4*)(wp + 2 * dff), w2g = *(const f32x4*)(wp + 4 * dff), bg = *(const f32x4*)(bp);
            const f32x4 w0v = *(const f32x4*)(wp + dff), w1v = *(const f32x4*)(wp + 3 * dff), w2v = *(const f32x4*)(wp + 5 * dff), bv = *(const f32x4*)(bp + dff);
#pragma unroll
            for (int ai = 0; ai < 2; ++ai)
#pragma unroll
                for (int m = 0; m < 4; ++m) {
                    const f32x4 cg = acc[ai][0][m][n], cv = acc[ai][1][m][n];
                    f32x4 b1g, b2g, b1v, b2v;
                    if (m > 0) {
#pragma unroll
                        for (int e = 0; e < 4; ++e) { b1g[e] = ror(acc[ai][0][m - 1][n][e], 1); b2g[e] = ror(acc[ai][0][m - 1][n][e], 2); b1v[e] = ror(acc[ai][1][m - 1][n][e], 1); b2v[e] = ror(acc[ai][1][m - 1][n][e], 2); }
                    } else {
                        const int sai = wr ? ai : ai - 1, swr = wr ? 0 : 1;
                        f32x4 x14g = {0.f, 0.f, 0.f, 0.f}, x15g = x14g, x14v = x14g, x15v = x14g;
                        if (sai >= 0) { const PG8_LAS float* xp = xb + (((((sai * 2 + swr) * 4 + wc) * 2) * 4 + fq) * 16);
                            x14g = *(const PG8_LAS f32x4*)(xp + n * 4); x14v = *(const PG8_LAS f32x4*)(xp + (2 + n) * 4); x15g = *(const PG8_LAS f32x4*)(xp + 64 + n * 4); x15v = *(const PG8_LAS f32x4*)(xp + 64 + (2 + n) * 4); }
                        b1g = x15g; b1v = x15v; b2g = fr == 0 ? x14g : x15g; b2v = fr == 0 ? x14v : x15v;
                    }
                    float o[4];
#pragma unroll
                    for (int e = 0; e < 4; ++e) {
                        const float p1g = shr(b1g[e], cg[e], 1), p2g = shr(b2g[e], cg[e], 2), p1v = shr(b1v[e], cv[e], 1), p2v = shr(b2v[e], cv[e], 2);
                        const float yg = bg[e] + w0g[e] * p2g + w1g[e] * p1g + w2g[e] * cg[e], yv = bv[e] + w0v[e] * p2v + w1v[e] * p1v + w2v[e] * cv[e];
                        o[e] = yg * __builtin_amdgcn_rcpf(1.0f + __builtin_amdgcn_exp2f(-yg * 1.4426950409f)) * yv;
                    }
                    res[ai][m][n] = (u32x2_){cvt_pk_bf16(o[0], o[1]), cvt_pk_bf16(o[2], o[3])};
                }
        }
        const int row0 = u.pm * BM + wr * 64 + fr;
#pragma unroll
        for (int ai = 0; ai < 2; ++ai)
#pragma unroll
            for (int m = 0; m < 4; ++m) *(u32x4*)(G + (size_t)(row0 + ai * HALF + m * 16) * dff + ch0) = (u32x4){res[ai][m][0].x, res[ai][m][0].y, res[ai][m][1].x, res[ai][m][1].y};
    }
};
}
constexpr int BATCH = 8, SEQ = 4096, DM = 2048, MTOT = BATCH * SEQ, MC = MTOT / 2  , BPH = BATCH / 2;
constexpr int DFF = 5632;
constexpr float NORM_EPS = 1e-6f, LOG2E = 1.4426950408889634f;
constexpr int NWAVES = 8;
constexpr size_t MiB = 1u << 20;
constexpr size_t WS_CTL = 0, CTL_ZERO_BYTES = 1 * MiB;
constexpr size_t WS_TAB = 1 * MiB;
constexpr size_t TAB_COS48 = WS_TAB, TAB_SIN48 = WS_TAB + 3 * MiB, TAB_COS32 = WS_TAB + 6 * MiB, TAB_SIN32 = WS_TAB + 8 * MiB;
constexpr size_t WS_WMIX = 12 * MiB;
constexpr size_t WS_WFFN = 100 * MiB;
constexpr size_t WS_MISC = 168 * MiB;
constexpr size_t WS_SS = 170 * MiB;
constexpr size_t WS_XN = 180 * MiB;
constexpr size_t WS_XNR = 1010 * MiB;
constexpr size_t WS_AR = 234 * MiB;
constexpr size_t WS_END = 1138 * MiB;
constexpr size_t DUMMY_OFF = 0;
constexpr int CW_TMO = 0;
constexpr int CW_BAR = 4096;
constexpr int RING_BYTES = 131072;
constexpr int LDSCTL_OFF = 135168;
constexpr int LDS_BYTES = 163840;

#define GAS __attribute__((address_space(1)))
#define LAS __attribute__((address_space(3)))
typedef unsigned short bf16;
typedef unsigned u32x4 __attribute__((ext_vector_type(4)));
typedef unsigned u32x2 __attribute__((ext_vector_type(2)));
typedef float f32x4 __attribute__((ext_vector_type(4)));
typedef float f32x16 __attribute__((ext_vector_type(16)));
typedef short bf16x8 __attribute__((ext_vector_type(8)));
typedef short s16x4 __attribute__((ext_vector_type(4)));
typedef short v4i16_t __attribute__((ext_vector_type(4)));
typedef __bf16 bf16x2_t __attribute__((ext_vector_type(2)));
typedef float f32x2_t __attribute__((ext_vector_type(2)));
#define LDS_WAIT() asm volatile("s_waitcnt lgkmcnt(0)" ::: "memory")
#define VM_WAIT() asm volatile("s_waitcnt vmcnt(0)" ::: "memory")
#define MFMA32(a, b, c) __builtin_amdgcn_mfma_f32_32x32x16_bf16((a), (b), (c), 0, 0, 0)
DI unsigned pk2(float lo, float hi) { f32x2_t v = {lo, hi}; bf16x2_t b = __builtin_convertvector(v, bf16x2_t); return __builtin_bit_cast(unsigned, b); }
DI float bf2f(unsigned short b) { return __builtin_bit_cast(float, (unsigned)b << 16); }
DI float bflo(unsigned w) { return __builtin_bit_cast(float, w << 16); }
DI float bfhi(unsigned w) { return __builtin_bit_cast(float, w & 0xffff0000u); }
DI unsigned short f2bf(float f) { return (unsigned short)(pk2(f, 0.f) & 0xffffu); }
DI float wave_sum(float v) {
#pragma unroll
    for (int o = 1; o < 64; o <<= 1) v += __shfl_xor(v, o);
    return v;
}
DI int crow(int i, int h) { return (i & 3) + 8 * (i >> 2) + 4 * h; }
#define XB_TMO      128
#define XB_XCNT(j)  (256  + 64 * (j))
#define XB_XSUB(j)  (1280 + 64 * (j))
#define XB_XGEN(j)  (2304 + 64 * (j))
#define XB_TOP      3328
#define XB_TOPGEN   3392
#define XCD_BAR_WORDS 3456
#define XB_SPIN_CAP (1u << 18)

__device__ __forceinline__ unsigned xb_ld(unsigned* p)              { return __hip_atomic_load(p, __ATOMIC_RELAXED, __HIP_MEMORY_SCOPE_AGENT); }
__device__ __forceinline__ unsigned xb_add(unsigned* p, unsigned v) { return __hip_atomic_fetch_add(p, v, __ATOMIC_RELAXED, __HIP_MEMORY_SCOPE_AGENT); }
__device__ __forceinline__ unsigned xb_xcc_id() { return (unsigned)__builtin_amdgcn_s_getreg((3 << 11) | 20) & 0xFu; }
#define XB_SPIN(cond, bar) do { unsigned _sp = 0; while (cond) { __builtin_amdgcn_s_sleep(1); \
    if ((++_sp & 255u) == 0u) { if (xb_ld(&(bar)[XB_TMO])) break; if (_sp > XB_SPIN_CAP) { atomicAdd(&(bar)[XB_TMO], 1u); break; } } } } while (0)

struct XcdBarrier {
    unsigned* bar; unsigned x;
    volatile LAS unsigned* st;
};

__device__ __forceinline__ XcdBarrier xcd_barrier_post(unsigned* bar, volatile LAS unsigned* st) {
    XcdBarrier b; b.bar = bar; b.x = xb_xcc_id(); b.st = st;
    if (threadIdx.x == 0) (void)xb_add(&bar[XB_XCNT(b.x)], 1u);
    return b;
}
__device__ __forceinline__ void xcd_barrier_complete(unsigned* bar, unsigned x, unsigned& nloc, unsigned& nx) {
    const unsigned G = gridDim.x * gridDim.y * gridDim.z;
    unsigned sum, cnt, mine, sp = 0u;
    for (;;) {
        sum = 0u; cnt = 0u; mine = 0u;
#pragma unroll
        for (unsigned j = 0; j < 16; ++j) { const unsigned c = xb_ld(&bar[XB_XCNT(j)]); sum += c; cnt += (c > 0u) ? 1u : 0u; mine = (j == x) ? c : mine; }
        if (sum == G) break;
        __builtin_amdgcn_s_sleep(1);
        if ((++sp & 255u) == 0u) { if (xb_ld(&bar[XB_TMO])) break; if (sp > XB_SPIN_CAP) { atomicAdd(&bar[XB_TMO], 1u); break; } }
    }
    nloc = mine > 0u ? mine : 1u; nx = cnt > 0u ? cnt : 1u;
}

__device__ __forceinline__ void xcd_barrier(const XcdBarrier& b) {
    asm volatile("s_waitcnt vmcnt(0)" ::: "memory");
    __syncthreads();
    if (threadIdx.x == 0) {
        unsigned* bar = b.bar;
        __builtin_amdgcn_s_waitcnt(0);
        unsigned nloc = b.st[0], nx = b.st[1];
        if (nloc == 0u) { xcd_barrier_complete(bar, b.x, nloc, nx); b.st[0] = nloc; b.st[1] = nx; }
        const unsigned old = xb_add(&bar[XB_XSUB(b.x)], 1u);
        const unsigned gen = old / nloc;
        if (old + 1u == (gen + 1u) * nloc) {
            __builtin_amdgcn_fence(__ATOMIC_RELEASE, "agent");
            asm volatile("s_waitcnt vmcnt(0)" ::: "memory");
            const unsigned og = xb_add(&bar[XB_TOP], 1u);
            const unsigned tg = og / nx;
            if (og + 1u == (tg + 1u) * nx) xb_add(&bar[XB_TOPGEN], 1u);
            else XB_SPIN(xb_ld(&bar[XB_TOPGEN]) == tg, bar);
            __builtin_amdgcn_fence(__ATOMIC_ACQUIRE, "agent");
            xb_add(&bar[XB_XGEN(b.x)], 1u);
            asm volatile("s_waitcnt vmcnt(0)" ::: "memory");
        } else {
            XB_SPIN(xb_ld(&bar[XB_XGEN(b.x)]) == gen, bar);
            __builtin_amdgcn_fence(__ATOMIC_ACQUIRE, "agent");
            asm volatile("s_waitcnt vmcnt(0)" ::: "memory");
        }
    }
    __syncthreads();
}
struct Frame {
    LAS unsigned char* lds; unsigned* ctl; unsigned char* ws;
    int tid, lane, wave, G, gw, NGW;
};
DI void ph_tables(const Frame& F, const int* pos) {
    float* c48 = (float*)(F.ws + TAB_COS48); float* s48 = (float*)(F.ws + TAB_SIN48); float* c32 = (float*)(F.ws + TAB_COS32); float* s32 = (float*)(F.ws + TAB_SIN32);
    const int gt = blockIdx.x * (NWAVES * 64) + F.tid, NT = F.G * NWAVES * 64;
    for (int i = gt; i < MTOT * 40; i += NT) {
        const int m = i / 40, j = i - m * 40; const float p = (float)pos[m];
        const bool a = j < 24; const int jj = a ? j : j - 24;
        const float inv = (float)exp(-(2.0 * jj / (a ? 48.0 : 32.0)) * 13.122363377404328);
        const float ang = p * inv; float sn, cs; sincosf(ang, &sn, &cs);
        if (a) { c48[m * 24 + jj] = cs; s48[m * 24 + jj] = sn; } else { c32[m * 16 + jj] = cs; s32[m * 16 + jj] = sn; }
    }
}
DI void cvt_load(float (&v)[32], const float* W, int ldw, int col0, int ncols, int item, int nblk, int lane) {
    const int kb = item / nblk, nb = item - kb * nblk, k0 = 64 * kb, n0 = 32 * nb, nn = n0 + (lane & 31); const bool ok = nn < ncols;
    const float* p = W + (size_t)(k0 + (lane >> 5)) * ldw + col0 + (ok ? nn : 0);
#pragma unroll
    for (int i = 0; i < 32; ++i) { const float x = p[(size_t)(2 * i) * ldw]; v[i] = ok ? x : 0.f; }
}
DI void cvt_store(const float (&v)[32], int ncols, bf16* WT, int ldt, int row_off, float scale, LAS float* scr, int item, int nblk, int lane) {
    const int kb = item / nblk, nb = item - kb * nblk, k0 = 64 * kb, n0 = 32 * nb;
#pragma unroll
    for (int i = 0; i < 32; ++i) scr[(2 * i + (lane >> 5)) * 33 + (lane & 31)] = v[i] * scale;
    LDS_WAIT();
    const int c = lane & 7;
#pragma unroll
    for (int j = 0; j < 4; ++j) { const int n = (lane >> 3) + 8 * j; const LAS float* s = scr + (8 * c) * 33 + n;
        u32x4 o; o.x = pk2(s[0 * 33], s[1 * 33]); o.y = pk2(s[2 * 33], s[3 * 33]); o.z = pk2(s[4 * 33], s[5 * 33]); o.w = pk2(s[6 * 33], s[7 * 33]);
        if (n0 + n < ncols) *(u32x4*)(WT + (size_t)(row_off + n0 + n) * ldt + k0 + 8 * c) = o; }
    LDS_WAIT();
}
DI void cvt_item(const float* W, int ldw, int col0, int ncols, bf16* WT, int ldt, int row_off, float scale, LAS float* scr, int item, int nblk, int lane) {
    float v[32]; cvt_load(v, W, ldw, col0, ncols, item, nblk, lane); cvt_store(v, ncols, WT, ldt, row_off, scale, scr, item, nblk, lane);
}
template <class MAP> DI void cvt_loop(const Frame& F, const float* W, int ldw, int ncols, bf16* WT, int ldt, float scale, int nitems, int nblk, const MAP& map) {
    LAS float* scr = (LAS float*)(F.lds + F.wave * 16384);
    int it = F.gw; float cur[32]; int c0 = 0, ro = 0, li = 0;
    if (it < nitems) { map(it, c0, ro, li); cvt_load(cur, W, ldw, c0, ncols, li, nblk, F.lane); }
#pragma unroll 1
    for (; it < nitems; it += F.NGW) {
        float nxt[32]; int c1 = 0, r1 = 0, l1 = 0; const int ni = it + F.NGW;
        if (ni < nitems) { map(ni, c1, r1, l1); cvt_load(nxt, W, ldw, c1, ncols, l1, nblk, F.lane); }
        cvt_store(cur, ncols, WT, ldt, ro, scale, scr, li, nblk, F.lane);
#pragma unroll
        for (int i = 0; i < 32; ++i) cur[i] = nxt[i];
        c0 = c1; ro = r1; li = l1;
    }
}
struct CvtPlain { int col0, row_off; DI void operator()(int it, int& c, int& r, int& l) const { c = col0; r = row_off; l = it; } };
DI void cvt_job(const Frame& F, const float* W, int ldw, int K, int col0, int ncols, bf16* WT, int ldt, int row_off, float scale) {
    const int nblk = (ncols + 31) / 32;
    cvt_loop(F, W, ldw, ncols, WT, ldt, scale, (K / 64) * nblk, nblk, CvtPlain{col0, row_off});
}
DI void zero_bf16(const Frame& F, bf16* p, size_t nelem) {
    const size_t gt = (size_t)blockIdx.x * (NWAVES * 64) + F.tid, NT = (size_t)F.G * NWAVES * 64;
    for (size_t i = gt; i < nelem / 8; i += NT) ((u32x4*)p)[i] = (u32x4){0u, 0u, 0u, 0u};
}
DI void ph_cvt_ffn(const Frame& F, const float* up, const float* down) {
    bf16* WUP = (bf16*)(F.ws + WS_WFFN); bf16* WDN = WUP + (size_t)2 * DFF * DM;
    struct UpMap { DI void operator()(int it, int& c, int& r, int& l) const { const int seg = it >> 7, pn = seg >> 1, isv = seg & 1; c = isv * DFF + pn * 128; r = pn * 256 + isv * 128; l = it & 127; } };
    cvt_loop(F, up, 2 * DFF, 128, WUP, DM, 1.f, 88 * 128, 4, UpMap{});
    cvt_job(F, down, DM, DFF, 0, DM, WDN, DFF, 0, 1.f);
}
DI void ph_conv_fix(const Frame& F, const float* UB, bf16* Gb, const float* cw, const float* cb, const int nrows = MC) {
    const int gt = blockIdx.x * (NWAVES * 64) + F.tid, NT = F.G * NWAVES * 64;
    for (int it = gt; it < (nrows / 256) * (DFF / 4); it += NT) {
        const int pm = it / (DFF / 4), c4 = it - pm * (DFF / 4), ch = c4 * 4, col = (ch >> 7) * 256 + (ch & 127);
        const float* ub = UB + (size_t)pm * 4 * (2 * DFF) + col; const bool has = (pm & 15) != 0;
        const f32x4 z = {0.f, 0.f, 0.f, 0.f};
        const f32x4 g0 = *(const f32x4*)(ub), g1 = *(const f32x4*)(ub + 2 * DFF), v0 = *(const f32x4*)(ub + 128), v1 = *(const f32x4*)(ub + 2 * DFF + 128);
        const f32x4 gm2 = has ? *(const f32x4*)(ub - 2 * (2 * DFF)) : z, gm1 = has ? *(const f32x4*)(ub - (2 * DFF)) : z, vm2 = has ? *(const f32x4*)(ub - 2 * (2 * DFF) + 128) : z, vm1 = has ? *(const f32x4*)(ub - (2 * DFF) + 128) : z;
        const f32x4 w0g = *(const f32x4*)(cw + ch), w1g = *(const f32x4*)(cw + 2 * DFF + ch), w2g = *(const f32x4*)(cw + 4 * DFF + ch), bg = *(const f32x4*)(cb + ch);
        const f32x4 w0v = *(const f32x4*)(cw + DFF + ch), w1v = *(const f32x4*)(cw + 3 * DFF + ch), w2v = *(const f32x4*)(cw + 5 * DFF + ch), bv = *(const f32x4*)(cb + DFF + ch);
        float o0[4], o1[4];
#pragma unroll
        for (int e = 0; e < 4; ++e) {
            const float yg0 = bg[e] + w0g[e] * gm2[e] + w1g[e] * gm1[e] + w2g[e] * g0[e], yv0 = bv[e] + w0v[e] * vm2[e] + w1v[e] * vm1[e] + w2v[e] * v0[e];
            const float yg1 = bg[e] + w0g[e] * gm1[e] + w1g[e] * g0[e] + w2g[e] * g1[e], yv1 = bv[e] + w0v[e] * vm1[e] + w1v[e] * v0[e] + w2v[e] * v1[e];
            o0[e] = yg0 * __builtin_amdgcn_rcpf(1.0f + __builtin_amdgcn_exp2f(-yg0 * LOG2E)) * yv0; o1[e] = yg1 * __builtin_amdgcn_rcpf(1.0f + __builtin_amdgcn_exp2f(-yg1 * LOG2E)) * yv1;
        }
        u32x2 a, b; a.x = pk2(o0[0], o0[1]); a.y = pk2(o0[2], o0[3]); b.x = pk2(o1[0], o1[1]); b.y = pk2(o1[2], o1[3]);
        *(u32x2*)(Gb + (size_t)(pm * 256) * DFF + ch) = a; *(u32x2*)(Gb + (size_t)(pm * 256 + 1) * DFF + ch) = b;
    }
}
DI void ph_rmsnorm(const Frame& F, const float* src, int row_off, const float* gain, bf16* XN, const int nrows = MC) {
    f32x4 g[8];
#pragma unroll
    for (int j = 0; j < 8; ++j) g[j] = *(const f32x4*)(gain + 4 * (F.lane + 64 * j));
    for (int ml = F.gw; ml < nrows; ml += F.NGW) {
        const f32x4* xr = (const f32x4*)(src + (size_t)(row_off + ml) * DM) + F.lane;
        f32x4 v[8]; float ss = 0.f;
#pragma unroll
        for (int j = 0; j < 8; ++j) { v[j] = xr[64 * j]; ss += (v[j].x * v[j].x + v[j].y * v[j].y) + (v[j].z * v[j].z + v[j].w * v[j].w); }
        const float rstd = 1.0f / sqrtf(wave_sum(ss) * (1.f / DM) + NORM_EPS);
        u32x2* o = (u32x2*)(XN + (size_t)ml * DM) + F.lane;
#pragma unroll
        for (int j = 0; j < 8; ++j) { const f32x4 y = v[j] * rstd * g[j]; u32x2 w; w.x = pk2(y.x, y.y); w.y = pk2(y.z, y.w); o[64 * j] = w; }
    }
}
DI void ph_norm_first(const Frame& F, const float* src, const float* gain, bf16* XNR, float* ss) {
    f32x4 g[8];
#pragma unroll
    for (int j = 0; j < 8; ++j) g[j] = *(const f32x4*)(gain + 4 * (F.lane + 64 * j));
    for (int m = F.gw; m < MTOT; m += F.NGW) {
        const f32x4* xr = (const f32x4*)(src + (size_t)m * DM) + F.lane;
        f32x4 v[8]; float s2 = 0.f;
#pragma unroll
        for (int j = 0; j < 8; ++j) { v[j] = xr[64 * j]; s2 += (v[j].x * v[j].x + v[j].y * v[j].y) + (v[j].z * v[j].z + v[j].w * v[j].w); }
        s2 = wave_sum(s2);
        if (F.lane < 2) *(f32x4*)(ss + (size_t)m * 8 + 4 * F.lane) = (f32x4){F.lane == 0 ? s2 : 0.f, 0.f, 0.f, 0.f};
        u32x2* o = (u32x2*)(XNR + (size_t)m * DM) + F.lane;
#pragma unroll
        for (int j = 0; j < 8; ++j) { const f32x4 y = v[j] * g[j]; u32x2 w; w.x = pk2(y.x, y.y); w.y = pk2(y.z, y.w); o[64 * j] = w; }
    }
}
DI void ph_final_norm(const Frame& F, float* h, const float* gain) {
    f32x4 g[8];
#pragma unroll
    for (int j = 0; j < 8; ++j) g[j] = *(const f32x4*)(gain + 4 * (F.lane + 64 * j));
    for (int m = F.gw; m < MTOT; m += F.NGW) {
        f32x4* xr = (f32x4*)(h + (size_t)m * DM) + F.lane;
        f32x4 v[8]; float ss = 0.f;
#pragma unroll
        for (int j = 0; j < 8; ++j) { v[j] = xr[64 * j]; ss += (v[j].x * v[j].x + v[j].y * v[j].y) + (v[j].z * v[j].z + v[j].w * v[j].w); }
        const float rstd = 1.0f / sqrtf(wave_sum(ss) * (1.f / DM) + NORM_EPS);
#pragma unroll
        for (int j = 0; j < 8; ++j) xr[64 * j] = v[j] * rstd * g[j];
    }
}
DI void ph_conv_glu(const Frame& F, const bf16* U, bf16* Gb, const float* cw, const float* cb) {
    constexpr int RC = 32, NCG = DFF / 8, NRC = MC / RC;
    const int gt = blockIdx.x * (NWAVES * 64) + F.tid, NT = F.G * NWAVES * 64;
    for (int it = gt; it < NCG * NRC; it += NT) {
        const int cg = it % NCG, rc = it / NCG, c0 = cg * 8, r0 = rc * RC;
        float w0g[8], w1g[8], w2g[8], bg[8], w0v[8], w1v[8], w2v[8], bv[8];
#pragma unroll
        for (int e = 0; e < 8; ++e) { w0g[e] = cw[c0 + e]; w1g[e] = cw[2 * DFF + c0 + e]; w2g[e] = cw[4 * DFF + c0 + e]; bg[e] = cb[c0 + e];
            w0v[e] = cw[DFF + c0 + e]; w1v[e] = cw[3 * DFF + c0 + e]; w2v[e] = cw[5 * DFF + c0 + e]; bv[e] = cb[DFF + c0 + e]; }
        float pg2[8], pg1[8], pv2[8], pv1[8];
        const bool has = (r0 & (SEQ - 1)) != 0;
        {
            u32x4 a = {0u, 0u, 0u, 0u}, b = a, c = a, d = a;
            if (has) { a = *(const u32x4*)(U + (size_t)(r0 - 2) * (2 * DFF) + c0); b = *(const u32x4*)(U + (size_t)(r0 - 1) * (2 * DFF) + c0);
                       c = *(const u32x4*)(U + (size_t)(r0 - 2) * (2 * DFF) + DFF + c0); d = *(const u32x4*)(U + (size_t)(r0 - 1) * (2 * DFF) + DFF + c0); }
#pragma unroll
            for (int e = 0; e < 4; ++e) { pg2[2 * e] = bflo(a[e]); pg2[2 * e + 1] = bfhi(a[e]); pg1[2 * e] = bflo(b[e]); pg1[2 * e + 1] = bfhi(b[e]);
                pv2[2 * e] = bflo(c[e]); pv2[2 * e + 1] = bfhi(c[e]); pv1[2 * e] = bflo(d[e]); pv1[2 * e + 1] = bfhi(d[e]); }
        }
        for (int r = 0; r < RC; ++r) {
            const u32x4 ug = *(const u32x4*)(U + (size_t)(r0 + r) * (2 * DFF) + c0), uv = *(const u32x4*)(U + (size_t)(r0 + r) * (2 * DFF) + DFF + c0);
            float cg_[8], cv_[8], o[8];
#pragma unroll
            for (int e = 0; e < 4; ++e) { cg_[2 * e] = bflo(ug[e]); cg_[2 * e + 1] = bfhi(ug[e]); cv_[2 * e] = bflo(uv[e]); cv_[2 * e + 1] = bfhi(uv[e]); }
#pragma unroll
            for (int e = 0; e < 8; ++e) {
                const float yg = bg[e] + w0g[e] * pg2[e] + w1g[e] * pg1[e] + w2g[e] * cg_[e];
                const float yv = bv[e] + w0v[e] * pv2[e] + w1v[e] * pv1[e] + w2v[e] * cv_[e];
                const float sg = yg * __builtin_amdgcn_rcpf(1.0f + __builtin_amdgcn_exp2f(-yg * LOG2E));
                o[e] = sg * yv; pg2[e] = pg1[e]; pg1[e] = cg_[e]; pv2[e] = pv1[e]; pv1[e] = cv_[e];
            }
            u32x4 w; w.x = pk2(o[0], o[1]); w.y = pk2(o[2], o[3]); w.z = pk2(o[4], o[5]); w.w = pk2(o[6], o[7]);
            *(u32x4*)(Gb + (size_t)(r0 + r) * DFF + c0) = w;
        }
    }
}
constexpr size_t DA_DIN = 0, DA_CQN = 64 * MiB, DA_LATC = 80 * MiB, DA_KPE = 88 * MiB, DA_KIDX = 90 * MiB, DA_WIDX = 94 * MiB, DA_QL = 96 * MiB, DA_QPE = 352 * MiB, DA_QIDX = 400 * MiB,
                 DA_SEL = 464 * MiB, DA_CNT = 472 * MiB, DA_SC = 474 * MiB, DA_O2 = 474 * MiB;
constexpr size_t DW_W1 = 0, DW_W2 = (size_t)1024 * 2048, DW_WO = DW_W2 + (size_t)11776 * 512, DW_BD = DW_WO + (size_t)2048 * 4096;
constexpr float DSA_QSCALE = 0.07216878364870322f * LOG2E;
constexpr float DSA_WIDX_SCALE = 0.25f * 0.08838834764831845f;

DI void ph_dsa_cvt(const Frame& F, const float* w_in, const float* w_qup, const float* w_uk, const float* w_uv, const float* w_out) {
    bf16* WB = (bf16*)(F.ws + WS_WMIX);
    cvt_job(F, w_in, 960, DM, 0, 960, WB + DW_W1, DM, 0, 1.f);
    zero_bf16(F, WB + DW_W1 + (size_t)960 * DM, (size_t)64 * DM);
    { LAS float* scr = (LAS float*)(F.lds + F.wave * 16384);
      for (int it = F.gw; it < 32 * 16; it += F.NGW) { const int h = it >> 4; cvt_item(w_qup, 8192, h * 192, 48, WB + DW_W2, 512, 8192 + h * 48, DSA_QSCALE, scr, it & 15, 2, F.lane); } }
    cvt_job(F, w_qup, 8192, 512, 6144, 2048, WB + DW_W2, 512, 9728, 1.f);
    __syncthreads();
    {
        LAS float* As = (LAS float*)F.lds; LAS float* Bs = As + 64 * 145;
        for (int u = blockIdx.x; u < 32 * 4 * 8; u += F.G) {
            const int h = u >> 5, r0 = ((u >> 3) & 3) * 64, k0 = (u & 7) * 64;
            for (int i = F.tid; i < 64 * 144; i += NWAVES * 64) { const int row = i / 144, col = i - row * 144;
                As[row * 145 + col] = w_uk[(size_t)(h * 256 + r0) * 144 + i]; Bs[row * 145 + col] = w_qup[(size_t)(k0 + row) * 8192 + h * 192 + 48 + col]; }
            __syncthreads();
            const int r = F.tid & 63, kg = F.tid >> 6; float acc[8];
#pragma unroll
            for (int j = 0; j < 8; ++j) acc[j] = 0.f;
            for (int n = 0; n < 144; ++n) { const float a = As[r * 145 + n];
#pragma unroll
                for (int j = 0; j < 8; ++j) acc[j] += a * Bs[(kg * 8 + j) * 145 + n]; }
            u32x4 o; o.x = pk2(acc[0] * DSA_QSCALE, acc[1] * DSA_QSCALE); o.y = pk2(acc[2] * DSA_QSCALE, acc[3] * DSA_QSCALE); o.z = pk2(acc[4] * DSA_QSCALE, acc[5] * DSA_QSCALE); o.w = pk2(acc[6] * DSA_QSCALE, acc[7] * DSA_QSCALE);
            *(u32x4*)(WB + DW_W2 + (size_t)(h * 256 + r0 + r) * 512 + k0 + kg * 8) = o;
            __syncthreads();
        }
    }
    { LAS float* scr = (LAS float*)(F.lds + F.wave * 16384);
      for (int it = F.gw; it < 32 * 16; it += F.NGW) { const int h = it >> 4; cvt_item(w_uv + (size_t)h * 256 * 128, 128, 0, 128, WB + DW_BD + (h & 1) * 256, 512, h * 128, 1.f, scr, it & 15, 4, F.lane); } }
    { const size_t gt = (size_t)blockIdx.x * (NWAVES * 64) + F.tid, NT = (size_t)F.G * NWAVES * 64;
      for (size_t i = gt; i < (size_t)4096 * 32; i += NT) { const int row = (int)(i >> 5), pc = (int)(i & 31); *(u32x4*)(WB + DW_BD + (size_t)row * 512 + (1 - ((row >> 7) & 1)) * 256 + pc * 8) = (u32x4){0u, 0u, 0u, 0u}; } }
    cvt_job(F, w_out, DM, 4096, 0, DM, WB + DW_WO, 4096, 0, 1.f);
}
DI void ph_dsa_post1(const Frame& F, int half, const float* qn, const float* kvn, const float* lng, const float* lnb) {
    unsigned char* ar = F.ws + WS_AR;
    const float* DIN = (const float*)(ar + DA_DIN); bf16* CQN = (bf16*)(ar + DA_CQN); bf16* LATC = (bf16*)(ar + DA_LATC); bf16* KPE = (bf16*)(ar + DA_KPE); bf16* KIDX = (bf16*)(ar + DA_KIDX); float* WIDX = (float*)(ar + DA_WIDX);
    const float* c48 = (const float*)(F.ws + TAB_COS48); const float* s48 = (const float*)(F.ws + TAB_SIN48); const float* c32 = (const float*)(F.ws + TAB_COS32); const float* s32 = (const float*)(F.ws + TAB_SIN32);
    LAS float* buf = (LAS float*)(F.lds + F.wave * 1024);
    const int lane = F.lane;
    for (int ml = F.gw; ml < MC; ml += F.NGW) {
        const int mg = half * MC + ml;
        const size_t kfb = ((size_t)(ml >> 5) * 8 * 64 + (ml & 31)) * 8;
        const float* row = DIN + (size_t)ml * 1024 + 16 * lane;
        f32x4 v[4]; float ss = 0.f, s1 = 0.f;
#pragma unroll
        for (int j = 0; j < 4; ++j) { v[j] = *(const f32x4*)(row + 4 * j); ss += (v[j].x * v[j].x + v[j].y * v[j].y) + (v[j].z * v[j].z + v[j].w * v[j].w); s1 += (v[j].x + v[j].y) + (v[j].z + v[j].w); }
        const bool isq = lane < 32, iskv = lane >= 32 && lane < 48, ispe = lane >= 48 && lane < 51, isix = lane >= 51 && lane < 59;
        const float ssq = wave_sum(isq ? ss : 0.f), sskv = wave_sum(iskv ? ss : 0.f), mean = wave_sum(isix ? s1 : 0.f) * (1.f / 128.f);
        float d2 = 0.f;
#pragma unroll
        for (int j = 0; j < 4; ++j) { const f32x4 d = v[j] - mean; d2 += (d.x * d.x + d.y * d.y) + (d.z * d.z + d.w * d.w); }
        const float var = wave_sum(isix ? d2 : 0.f) * (1.f / 128.f);
        const float rq = 1.0f / sqrtf(ssq * (1.f / 512.f) + NORM_EPS), rkv = 1.0f / sqrtf(sskv * (1.f / 256.f) + NORM_EPS), rstd = 1.0f / sqrtf(var + NORM_EPS);
        if (isq || iskv) {
            const float* gp = isq ? qn + 16 * lane : kvn + 16 * (lane - 32); const float rs = isq ? rq : rkv;
            bf16* dst = isq ? CQN + (size_t)ml * 512 + 16 * lane : LATC + (size_t)ml * 256 + 16 * (lane - 32);
            u32x4 o[2];
#pragma unroll
            for (int j = 0; j < 4; ++j) { const f32x4 g = *(const f32x4*)(gp + 4 * j); const f32x4 y = v[j] * rs * g; o[j >> 1][(j & 1) * 2] = pk2(y.x, y.y); o[j >> 1][(j & 1) * 2 + 1] = pk2(y.z, y.w); }
            *(u32x4*)dst = o[0]; *(u32x4*)(dst + 8) = o[1];
        } else if (ispe) {
#pragma unroll
            for (int j = 0; j < 4; ++j) *(LAS f32x4*)(buf + (lane - 48) * 16 + 4 * j) = v[j];
        } else if (isix) {
#pragma unroll
            for (int j = 0; j < 4; ++j) { const f32x4 g = *(const f32x4*)(lng + (lane - 51) * 16 + 4 * j), b = *(const f32x4*)(lnb + (lane - 51) * 16 + 4 * j); *(LAS f32x4*)(buf + 48 + (lane - 51) * 16 + 4 * j) = (v[j] - mean) * rstd * g + b; }
        } else if (lane == 59) {
#pragma unroll
            for (int j = 0; j < 4; ++j) *(f32x4*)(WIDX + (size_t)ml * 16 + 4 * j) = v[j] * DSA_WIDX_SCALE;
        }
        LDS_WAIT();
        if (lane < 24) { const float x1 = buf[lane], x2 = buf[24 + lane], c = c48[(size_t)mg * 24 + lane], s = s48[(size_t)mg * 24 + lane];
            KPE[(size_t)ml * 48 + lane] = f2bf(x1 * c - x2 * s); KPE[(size_t)ml * 48 + 24 + lane] = f2bf(x1 * s + x2 * c);
        } else if (lane < 40) { const int i = lane - 24; const float x1 = buf[48 + i], x2 = buf[48 + 16 + i], c = c32[(size_t)mg * 16 + i], s = s32[(size_t)mg * 16 + i];
            KIDX[kfb + (size_t)((i >> 3) * 32) * 8 + (i & 7)] = f2bf(x1 * c - x2 * s); KIDX[kfb + (size_t)(64 + (i >> 3) * 32) * 8 + (i & 7)] = f2bf(x1 * s + x2 * c);
        } else { const int d = 32 + 4 * (lane - 40); const f32x4 y = *(const LAS f32x4*)(buf + 48 + d); u32x2 w; w.x = pk2(y.x, y.y); w.y = pk2(y.z, y.w); *(u32x2*)(KIDX + kfb + (size_t)((d >> 4) * 64 + ((d >> 3) & 1) * 32) * 8 + (d & 7)) = w; }
        LDS_WAIT();
    }
}
DI void ph_dsa_rope(const Frame& F, int half) {
    unsigned char* ar = F.ws + WS_AR; bf16* QPE = (bf16*)(ar + DA_QPE); bf16* QIDX = (bf16*)(ar + DA_QIDX);
    const float* c48 = (const float*)(F.ws + TAB_COS48); const float* s48 = (const float*)(F.ws + TAB_SIN48); const float* c32 = (const float*)(F.ws + TAB_COS32); const float* s32 = (const float*)(F.ws + TAB_SIN32);
    for (int ml = F.gw; ml < MC; ml += F.NGW) {
        const size_t mg = (size_t)half * MC + ml;
        for (int p = F.lane; p < 768; p += 64) { const int hd = p / 24, i = p - hd * 24; bf16* q = QPE + (size_t)ml * 1536 + hd * 48 + i;
            const float x1 = bf2f(q[0]), x2 = bf2f(q[24]), c = c48[mg * 24 + i], s = s48[mg * 24 + i]; q[0] = f2bf(x1 * c - x2 * s); q[24] = f2bf(x1 * s + x2 * c); }
        for (int p = F.lane; p < 256; p += 64) { const int hd = p >> 4, i = p & 15; bf16* q = QIDX + (size_t)ml * 2048 + hd * 128 + i;
            const float x1 = bf2f(q[0]), x2 = bf2f(q[16]), c = c32[mg * 16 + i], s = s32[mg * 16 + i]; q[0] = f2bf(x1 * c - x2 * s); q[16] = f2bf(x1 * s + x2 * c); }
    }
}
DI int wave_iscan_dpp(int v) {
    v += __builtin_amdgcn_update_dpp(0, v, 0x111, 0xf, 0xf, true); v += __builtin_amdgcn_update_dpp(0, v, 0x112, 0xf, 0xf, true);
    v += __builtin_amdgcn_update_dpp(0, v, 0x114, 0xf, 0xf, true); v += __builtin_amdgcn_update_dpp(0, v, 0x118, 0xf, 0xf, true);
    v += __builtin_amdgcn_update_dpp(0, v, 0x142, 0xa, 0xf, false);
    v += __builtin_amdgcn_update_dpp(0, v, 0x143, 0xc, 0xf, false);
    return v;
}
DI int wave_isum_dpp(int v) {
    v += __builtin_amdgcn_update_dpp(0, v, 0x111, 0xf, 0xf, true); v += __builtin_amdgcn_update_dpp(0, v, 0x112, 0xf, 0xf, true);
    v += __builtin_amdgcn_update_dpp(0, v, 0x114, 0xf, 0xf, true); v += __builtin_amdgcn_update_dpp(0, v, 0x118, 0xf, 0xf, true);
    v += __builtin_amdgcn_update_dpp(0, v, 0x142, 0xa, 0xf, false);
    v += __builtin_amdgcn_update_dpp(0, v, 0x143, 0xc, 0xf, false);
    return __builtin_amdgcn_readlane(v, 63);
}
DI unsigned f2sortable(float s) { const unsigned b = __builtin_bit_cast(unsigned, s); return (b & 0x80000000u) ? ~b : (b | 0x80000000u); }
DI void ph_dsa_index(const Frame& F, const int dry = 0, const int parts = 3) {
    unsigned char* ar = F.ws + WS_AR;
    const bf16* QIDX = (const bf16*)(ar + DA_QIDX); const bf16* KIDX = (const bf16*)(ar + DA_KIDX); const float* WIDX = (const float*)(ar + DA_WIDX);
    unsigned short* SEL = (unsigned short*)(ar + DA_SEL); int* CNT = (int*)(ar + DA_CNT); float* SC = (float*)(ar + DA_SC) + (size_t)F.gw * 16384;
    const int lane = F.lane, r = lane & 31, hf = lane >> 5;
    LAS unsigned char* wl = F.lds + F.wave * 8192 + lane * 16;
    LAS unsigned* hist = (LAS unsigned*)(F.lds + 65536 + F.wave * 1024);
#pragma unroll 1
    for (int tile = blockIdx.x; tile < BPH * 128; tile += F.G) {
        const int j = tile >> 8, c8 = tile & 255, c7 = c8 & 127, bl = (c8 >> 7) * 2 + j, qt = j ? 127 - c7 : c7;
        const int q0 = qt * 32 + 4 * F.wave;
        const int ntile = (q0 + 3) / 32 + 1;
        bf16x8 qa[2][8];
#pragma unroll
        for (int pr = 0; pr < 2; ++pr) {
            const int mrow = bl * SEQ + q0 + 2 * pr + (r >> 4);
#pragma unroll
            for (int s = 0; s < 8; ++s) qa[pr][s] = *(const bf16x8*)(QIDX + (size_t)mrow * 2048 + (r & 15) * 128 + 16 * s + 8 * hf);
            float wv[2][16];
#pragma unroll
            for (int i = 0; i < 16; ++i) wv[pr][i] = WIDX[(size_t)(bl * SEQ + q0 + 2 * pr + (i >> 3)) * 16 + (i & 3) + 8 * ((i >> 2) & 1) + 4 * hf];
#pragma unroll
            for (int i = 0; i < 16; i += 4) *(LAS f32x4*)(wl + (pr * 4 + (i >> 2)) * 1024) = (f32x4){wv[pr][i], wv[pr][i + 1], wv[pr][i + 2], wv[pr][i + 3]};
        }
        LDS_WAIT();
        if (parts & 1) {
        bf16x8 kf[8];
        { const bf16* kp = KIDX + ((size_t)(bl * 128) * 8 * 64 + lane) * 8;
#pragma unroll
          for (int s = 0; s < 8; ++s) kf[s] = *(const bf16x8*)(kp + 512 * s); }
#pragma unroll 1
        for (int t = 0; t < ntile; ++t) {
            f32x16 accs[2];
#pragma unroll
            for (int pr = 0; pr < 2; ++pr) {
#pragma unroll
                for (int i = 0; i < 16; ++i) accs[pr][i] = 0.f;
#pragma unroll
                for (int s = 0; s < 8; ++s) accs[pr] = MFMA32(qa[pr][s], kf[s], accs[pr]);
            }
            if (t + 1 < ntile) { const bf16* kp = KIDX + ((size_t)(bl * 128 + t + 1) * 8 * 64 + lane) * 8;
#pragma unroll
                for (int s = 0; s < 8; ++s) kf[s] = *(const bf16x8*)(kp + 512 * s); }
#pragma unroll
            for (int pr = 0; pr < 2; ++pr) {
                const f32x16 acc = accs[pr];
                float wv[2][16];
                { unsigned wa_ = (unsigned)(size_t)wl; asm volatile("" : "+v"(wa_));
#pragma unroll
                  for (int i = 0; i < 16; i += 4) { const f32x4 w4 = *(const LAS f32x4*)((LAS unsigned char*)(size_t)wa_ + (pr * 4 + (i >> 2)) * 1024); wv[pr][i] = w4.x; wv[pr][i + 1] = w4.y; wv[pr][i + 2] = w4.z; wv[pr][i + 3] = w4.w; } }
                float p0 = 0.f, p1 = 0.f;
#pragma unroll
                for (int i = 0; i < 8; ++i) { p0 += wv[pr][i] * fmaxf(acc[i], 0.f); p1 += wv[pr][8 + i] * fmaxf(acc[8 + i], 0.f); }
                const float t0 = p0 + __shfl_xor(p0, 32), t1 = p1 + __shfl_xor(p1, 32);
                SC[(pr * 128 + t) * 64 + lane] = hf ? t1 : t0;
            }
        }
        }
        VM_WAIT();
        if (parts & 2)
#pragma unroll 1
        for (int qi = 0; qi < 4; ++qi) {
            const int tq = q0 + qi, pr = qi >> 1, qs = qi & 1;
            unsigned u[64];
            const unsigned* scp = (const unsigned*)(SC + pr * 8192 + hf * 64 + qs * 32 + r);
#pragma unroll
            for (int g8 = 0; g8 < 8; ++g8) {
#pragma unroll
                for (int e = 0; e < 8; ++e) { const int i = 8 * g8 + e; const float s = __builtin_bit_cast(float, __hip_atomic_load(scp + e * 128, __ATOMIC_RELAXED, __HIP_MEMORY_SCOPE_AGENT));
                    u[i] = (2 * i + hf < ntile && 64 * i + lane <= tq) ? f2sortable(s) : 0u; }
                scp += 1024; asm volatile("" : "+v"(scp));
            }
            unsigned prefix = 0u;
            if (tq >= 256) {
#pragma unroll 1
                for (int bit = 31; bit >= 0; --bit) {
                    const unsigned cand = prefix | (1u << bit); int c = 0;
#pragma unroll
                    for (int g8 = 0; g8 < 8; ++g8) { if (g8 * 512 <= tq) {
#pragma unroll
                        for (int e = 0; e < 8; ++e) c += (u[8 * g8 + e] >= cand) ? 1 : 0; } }
                    c = wave_isum_dpp(c);
                    if (c >= 256) prefix = cand;
                    if (c == 256) break;
                }
            }
            const unsigned T = prefix > 1u ? prefix : 1u;
            int nl = 0;
#pragma unroll
            for (int g8 = 0; g8 < 8; ++g8) { if (g8 * 512 <= tq) {
#pragma unroll
                for (int e = 0; e < 8; ++e) nl += (u[8 * g8 + e] >= T) ? 1 : 0; } }
            const int inc = wave_iscan_dpp(nl), base = __builtin_amdgcn_readlane(inc, 63);
            int pos = inc - nl;
            unsigned short* sel = dry ? (unsigned short*)(ar + DUMMY_OFF) + (size_t)F.gw * 256 : SEL + (size_t)(bl * SEQ + tq) * 256;
#pragma unroll
            for (int g8 = 0; g8 < 8; ++g8) { if (g8 * 512 <= tq) {
#pragma unroll
                for (int e = 0; e < 8; ++e) { const int i = 8 * g8 + e; if (u[i] >= T) { if (pos < 256) sel[pos] = (unsigned short)(64 * i + lane); ++pos; } } } }
            if (lane == 0) (dry ? (int*)(ar + DUMMY_OFF + 32 * MiB) + F.gw : CNT + bl * SEQ + tq)[0] = base < 256 ? base : 256;
        }
    }
}
DI int dsa_fsw(int row) { return ((row & 3) << 2) | ((row >> 2) & 3); }
struct DsaPre { u32x4 row[16]; bf16x8 kpe[3]; bf16x8 q[3]; };
DI void dsa_prefetch(DsaPre& P, const bf16* LATC, const bf16* KPE, const bf16* QL, const bf16* QPE, int ml, int selv, int lane, int w) {
    const int bl = ml >> 12, r = lane & 31, h = lane >> 5;
#pragma unroll
    for (int it = 0; it < 16; ++it) { const int ki = __shfl(selv, (lane >> 5) + 2 * it); P.row[it] = *(const u32x4*)(LATC + (size_t)(bl * SEQ + ki) * 256 + (lane & 31) * 8); }
#pragma unroll
    for (int s = 0; s < 3; ++s) P.kpe[s] = *(const bf16x8*)(KPE + (size_t)(bl * SEQ + selv) * 48 + 16 * s + 8 * h);
#pragma unroll
    for (int j = 0; j < 3; ++j) { const int fi = w + 8 * j;
        if (fi < 16) P.q[j] = *(const bf16x8*)(QL + (size_t)ml * 8192 + r * 256 + 16 * fi + 8 * h);
        else if (fi < 19) P.q[j] = *(const bf16x8*)(QPE + (size_t)ml * 1536 + r * 48 + 16 * (fi - 16) + 8 * h); }
}
DI void ph_dsa_attn(const Frame& F, const int dry = 0) {
    unsigned char* ar = F.ws + WS_AR;
    bf16* QL = (bf16*)(ar + DA_QL); const bf16* QPE = (const bf16*)(ar + DA_QPE); const bf16* LATC = (const bf16*)(ar + DA_LATC); const bf16* KPE = (const bf16*)(ar + DA_KPE);
    const unsigned short* SEL = (const unsigned short*)(ar + DA_SEL); const int* CNT = (const int*)(ar + DA_CNT);
    const int lane = F.lane, r = lane & 31, h = lane >> 5, w = F.wave;
    LAS unsigned char* IMG = F.lds; LAS unsigned char* QB = F.lds + LDSCTL_OFF + 256; LAS float* MX = (LAS float*)(F.lds + LDSCTL_OFF + 256 + 19456); LAS float* SX = MX + 256;
    const int i16 = lane & 15, tq_ = i16 >> 2, tp_ = i16 & 3, blk = (lane >> 4) & 1;
    int ml = blockIdx.x;
    if (ml >= MC) return;
    DsaPre P;
    int cnt_c = CNT[ml];
    { const int slot = 32 * w + r; const int selv = slot < cnt_c ? (int)SEL[(size_t)ml * 256 + slot] : 0; dsa_prefetch(P, LATC, KPE, QL, QPE, ml, selv, lane, w); }
    int cnt_n = 0, selv_n = 0;
    if (ml + F.G < MC) { cnt_n = CNT[ml + F.G]; const int slot = 32 * w + r; selv_n = slot < cnt_n ? (int)SEL[(size_t)(ml + F.G) * 256 + slot] : 0; }
#pragma unroll 1
    for (; ml < MC; ml += F.G) {
        const int cnt = cnt_c, nch = (cnt + 31) >> 5; const bool act = w < nch;
#pragma unroll
        for (int it = 0; it < 16; ++it) { const int rr = (lane >> 5) + 2 * it; *(LAS u32x4*)(IMG + (32 * w + rr) * 512 + (((lane & 31) ^ dsa_fsw(rr)) * 16)) = P.row[it]; }
#pragma unroll
        for (int j = 0; j < 3; ++j) { const int fi = w + 8 * j; if (fi < 19) *(LAS bf16x8*)(QB + fi * 1024 + lane * 16) = P.q[j]; }
        bf16x8 kpe[3];
#pragma unroll
        for (int s = 0; s < 3; ++s) kpe[s] = P.kpe[s];
        LDS_WAIT(); __builtin_amdgcn_s_barrier(); asm volatile("" ::: "memory");
        if (ml + F.G < MC) {
            dsa_prefetch(P, LATC, KPE, QL, QPE, ml + F.G, selv_n, lane, w); cnt_c = cnt_n;
            if (ml + 2 * F.G < MC) { cnt_n = CNT[ml + 2 * F.G]; const int slot = 32 * w + r; selv_n = slot < cnt_n ? (int)SEL[(size_t)(ml + 2 * F.G) * 256 + slot] : 0; }
        }
        f32x16 S; float mx = -INFINITY;
#pragma unroll
        for (int i = 0; i < 16; ++i) S[i] = 0.f;
        if (act) {
#pragma unroll
            for (int s = 0; s < 16; ++s) S = MFMA32(*(const LAS bf16x8*)(IMG + (32 * w + r) * 512 + (((2 * s + h) ^ dsa_fsw(r)) * 16)), *(const LAS bf16x8*)(QB + s * 1024 + lane * 16), S);
#pragma unroll
            for (int s = 0; s < 3; ++s) S = MFMA32(kpe[s], *(const LAS bf16x8*)(QB + (16 + s) * 1024 + lane * 16), S);
#pragma unroll
            for (int i = 0; i < 16; ++i) { S[i] = (32 * w + crow(i, h) < cnt) ? S[i] : -INFINITY; mx = fmaxf(mx, S[i]); }
            mx = fmaxf(mx, __shfl_xor(mx, 32));
        }
        if (h == 0) MX[w * 32 + r] = mx;
        LDS_WAIT(); __builtin_amdgcn_s_barrier(); asm volatile("" ::: "memory");
        float M = MX[r];
#pragma unroll
        for (int k = 1; k < 8; ++k) M = fmaxf(M, MX[k * 32 + r]);
        float lsum = 0.f; bf16x8 pf[2] = {(bf16x8){0, 0, 0, 0, 0, 0, 0, 0}, (bf16x8){0, 0, 0, 0, 0, 0, 0, 0}};
        if (act) {
#pragma unroll
            for (int i = 0; i < 16; ++i) { S[i] = __builtin_amdgcn_exp2f(S[i] - M); lsum += S[i]; }
#pragma unroll
            for (int s = 0; s < 2; ++s) { u32x4 t; t.x = pk2(S[8 * s], S[8 * s + 1]); t.y = pk2(S[8 * s + 2], S[8 * s + 3]); t.z = pk2(S[8 * s + 4], S[8 * s + 5]); t.w = pk2(S[8 * s + 6], S[8 * s + 7]); pf[s] = __builtin_bit_cast(bf16x8, t); }
        }
        lsum += __shfl_xor(lsum, 32);
        if (h == 0) SX[w * 32 + r] = lsum;
        *(LAS bf16x8*)(QB + (2 * w) * 1024 + lane * 16) = pf[0]; *(LAS bf16x8*)(QB + (2 * w + 1) * 1024 + lane * 16) = pf[1];
        LDS_WAIT(); __builtin_amdgcn_s_barrier(); asm volatile("" ::: "memory");
        f32x16 O;
#pragma unroll
        for (int i = 0; i < 16; ++i) O[i] = 0.f;
#pragma unroll 2
        for (int ks = 0; ks < 2 * nch; ++ks) {
            const int r0 = 16 * ks + 4 * h + tq_, r1 = r0 + 8, pc = 4 * w + 2 * blk + (tp_ >> 1);
            const s16x4 lo = __builtin_bit_cast(s16x4, __builtin_amdgcn_ds_read_tr16_b64_v4i16((LAS v4i16_t*)(IMG + r0 * 512 + ((pc ^ dsa_fsw(r0)) * 16) + 8 * (tp_ & 1))));
            const s16x4 hi = __builtin_bit_cast(s16x4, __builtin_amdgcn_ds_read_tr16_b64_v4i16((LAS v4i16_t*)(IMG + r1 * 512 + ((pc ^ dsa_fsw(r1)) * 16) + 8 * (tp_ & 1))));
            O = MFMA32(__builtin_shufflevector(lo, hi, 0, 1, 2, 3, 4, 5, 6, 7), *(const LAS bf16x8*)(QB + ks * 1024 + lane * 16), O);
        }
        float l = SX[r];
#pragma unroll
        for (int k = 1; k < 8; ++k) l += SX[k * 32 + r];
        const float linv = 1.0f / l;
        bf16* o = (dry ? (bf16*)(ar + DUMMY_OFF) + (size_t)blockIdx.x * 8192 : QL + (size_t)ml * 8192) + r * 256 + 32 * w + 4 * h;
#pragma unroll
        for (int g = 0; g < 4; ++g) { u32x2 t; t.x = pk2(O[4 * g] * linv, O[4 * g + 1] * linv); t.y = pk2(O[4 * g + 2] * linv, O[4 * g + 3] * linv); *(u32x2*)(o + 8 * g) = t; }
        LDS_WAIT(); __builtin_amdgcn_s_barrier(); asm volatile("" ::: "memory");
    }
}
template <int NDB, bool RESC = true> DI void softmax_step(f32x16& S, float& m, float& l, f32x16 (&O)[NDB], bf16x8 (&pf)[2]) {
    float mx = S[0];
#pragma unroll
    for (int i = 1; i < 16; ++i) mx = fmaxf(mx, S[i]);
    mx = fmaxf(mx, __shfl_xor(mx, 32));
    const float mn = fmaxf(m, mx), ms = (mn == -INFINITY) ? 0.f : mn;
    const float alpha = __builtin_amdgcn_exp2f(m - ms);
    float sum = 0.f;
#pragma unroll
    for (int i = 0; i < 16; ++i) { S[i] = __builtin_amdgcn_exp2f(S[i] - ms); sum += S[i]; }
    l = l * alpha + sum; m = mn;
    if (RESC && __builtin_amdgcn_ballot_w64(alpha != 1.0f) != 0ull) {
#pragma unroll
        for (int db = 0; db < NDB; ++db)
#pragma unroll
            for (int i = 0; i < 16; ++i) O[db][i] *= alpha;
    }
#pragma unroll
    for (int s = 0; s < 2; ++s) { u32x4 w; w.x = pk2(S[8 * s], S[8 * s + 1]); w.y = pk2(S[8 * s + 2], S[8 * s + 3]); w.z = pk2(S[8 * s + 4], S[8 * s + 5]); w.w = pk2(S[8 * s + 6], S[8 * s + 7]); pf[s] = __builtin_bit_cast(bf16x8, w); }
}
template <int NQ, int NDB, bool PV, bool QL, bool FRAG, class KA, class VA, class MK>
DI void attn_run(const bf16x8 (&qf)[NQ], const LAS unsigned char* qlds, f32x16 (&O)[NDB], float& m, float& l, int tb, int te, const KA& ka, const VA& va, const MK& mk) {
    if (tb >= te) return;
    bf16x8 kf[NQ];
    { const bf16* kp = ka(tb);
#pragma unroll
      for (int s = 0; s < NQ; ++s) kf[s] = *(const bf16x8*)(kp + (FRAG ? 512 : 16) * s); }
    for (int t = tb; t < te; ++t) {
        bf16x8 vf[NDB][2];
        if (PV) {
#pragma unroll
            for (int db = 0; db < NDB; ++db) { const bf16* vp = va(t, db);
#pragma unroll
                for (int s = 0; s < 2; ++s) { if (FRAG) vf[db][s] = *(const bf16x8*)(vp + 512 * s); else vf[db][s] = __builtin_shufflevector(*(const s16x4*)(vp + 16 * s), *(const s16x4*)(vp + 16 * s + 8), 0, 1, 2, 3, 4, 5, 6, 7); } }
        }
        f32x16 S;
#pragma unroll
        for (int i = 0; i < 16; ++i) S[i] = 0.f;
#pragma unroll
        for (int s = 0; s < NQ; ++s) { if (QL) { unsigned qa_ = (unsigned)(size_t)qlds; asm volatile("" : "+v"(qa_)); S = MFMA32(kf[s], *(const LAS bf16x8*)((LAS unsigned char*)(size_t)qa_ + s * 1024), S); } else S = MFMA32(kf[s], qf[s], S); }
        if (t + 1 < te) { const bf16* kp = ka(t + 1);
#pragma unroll
            for (int s = 0; s < NQ; ++s) kf[s] = *(const bf16x8*)(kp + (FRAG ? 512 : 16) * s); }
        mk(t, S);
        bf16x8 pf[2]; softmax_step<NDB>(S, m, l, O, pf);
        if (PV) {
#pragma unroll
            for (int db = 0; db < NDB; ++db)
#pragma unroll
                for (int s = 0; s < 2; ++s) O[db] = MFMA32(vf[db][s], pf[s], O[db]);
        }
    }
}
template <bool ACC> DI void store_col(bf16* out, const f32x16 (&O)[4], float scale, int h) {
#pragma unroll
    for (int db = 0; db < 4; ++db)
#pragma unroll
        for (int g = 0; g < 4; ++g) { u32x2* p = (u32x2*)(out + db * 32 + 8 * g + 4 * h);
            float a = O[db][4 * g] * scale, b = O[db][4 * g + 1] * scale, c = O[db][4 * g + 2] * scale, d = O[db][4 * g + 3] * scale;
            if (ACC) { const u32x2 o = *p; a += bflo(o.x); b += bfhi(o.x); c += bflo(o.y); d += bfhi(o.y); }
            u32x2 w; w.x = pk2(a, b); w.y = pk2(c, d); *p = w; }
}
template <int NQ> struct TilePre { u32x4 a, b, c; };
template <int NQ, class SRC> DI void tile_fetch(TilePre<NQ>& p, const SRC& src, int T, int tid) {
    const bf16* k = src.k(T); const bf16* v = src.v(T);
    constexpr int NK = NQ * 64;
    p.a = *(const u32x4*)(k + (size_t)tid * 8);
    const int p1 = tid + 512; p.b = (p1 < NK) ? *(const u32x4*)(k + (size_t)p1 * 8) : *(const u32x4*)(v + (size_t)(p1 - NK) * 8);
    if (NQ * 64 + 512 > 1024) { const int p2 = tid + 1024; if (p2 < NK + 512) p.c = *(const u32x4*)(v + (size_t)(p2 - NK) * 8); }
}
template <int NQ> DI void tile_put(const TilePre<NQ>& p, LAS unsigned char* buf, int tid) {
    *(LAS u32x4*)(buf + tid * 16) = p.a; *(LAS u32x4*)(buf + (tid + 512) * 16) = p.b;
    if (NQ * 64 + 512 > 1024) { if (tid + 1024 < NQ * 64 + 512) *(LAS u32x4*)(buf + (tid + 1024) * 16) = p.c; }
}
template <int NQ, bool PV, class SRC, class MK>
DI void attn_run_sh(LAS unsigned char* tl, int tid, int lane, const bf16x8 (&qf)[NQ], f32x16 (&O)[4], float& m, float& l, int TB, int TE, int tb, int te, const SRC& src, const MK& mk) {
    constexpr int TBYTES = (NQ + 8) * 1024;
    if (TB >= TE) return;
    TilePre<NQ> pre;
    tile_fetch<NQ>(pre, src, TB, tid); tile_put<NQ>(pre, tl, tid);
    LDS_WAIT(); __builtin_amdgcn_s_barrier(); asm volatile("" ::: "memory");
#pragma unroll 1
    for (int T = TB; T < TE; ++T) {
        LAS unsigned char* cur = tl + ((T - TB) & 1) * TBYTES;
        if (T + 1 < TE) tile_fetch<NQ>(pre, src, T + 1, tid);
        if (T >= tb && T < te) {
            f32x16 S;
#pragma unroll
            for (int i = 0; i < 16; ++i) S[i] = 0.f;
#pragma unroll
            for (int s = 0; s < NQ; ++s) S = MFMA32(*(const LAS bf16x8*)(cur + s * 1024 + lane * 16), qf[s], S);
            mk(T, S);
            bf16x8 pf[2]; softmax_step<4, PV>(S, m, l, O, pf);
            if (PV) {
#pragma unroll
                for (int db = 0; db < 4; ++db)
#pragma unroll
                    for (int s = 0; s < 2; ++s) O[db] = MFMA32(*(const LAS bf16x8*)(cur + (NQ + db * 2 + s) * 1024 + lane * 16), pf[s], O[db]);
            }
        }
        if (T + 1 < TE) tile_put<NQ>(pre, tl + ((T + 1 - TB) & 1) * TBYTES, tid);
        LDS_WAIT(); __builtin_amdgcn_s_barrier(); asm volatile("" ::: "memory");
    }
}
struct FragSrc { const bf16* kb; const bf16* vb; int nq; DI const bf16* k(int T) const { return kb + (size_t)T * nq * 512; } DI const bf16* v(int T) const { return vb + (size_t)T * 8 * 512; } };
constexpr size_t FA_Q = 0, FA_K = 64 * MiB, FA_F = 128 * MiB, FA_V = 136 * MiB, FA_CUM = 200 * MiB, FA_O = 202 * MiB, FA_KF = 266 * MiB, FA_VF = 330 * MiB;
constexpr size_t FW_IN = 0, FW_OUT = (size_t)6400 * 2048;
constexpr float FOX_QSCALE = 0.08838834764831845f * LOG2E;
DI void ph_fox_cvt(const Frame& F, const float* w_in, const float* w_out) {
    bf16* WB = (bf16*)(F.ws + WS_WMIX);
    cvt_job(F, w_in, 6160, DM, 0, 2048, WB + FW_IN, DM, 0, FOX_QSCALE);
    cvt_job(F, w_in, 6160, DM, 2048, 2048, WB + FW_IN, DM, 2048, 1.f);
    cvt_job(F, w_in, 6160, DM, 4096, 2048, WB + FW_IN, DM, 4096, 1.f);
    cvt_job(F, w_in, 6160, DM, 6144, 16, WB + FW_IN, DM, 6144, 1.f);
    zero_bf16(F, WB + FW_IN + (size_t)6160 * DM, (size_t)240 * DM);
    cvt_job(F, w_out, DM, DM, 0, DM, WB + FW_OUT, DM, 0, 1.f);
}
DI void ph_fox_scan(const Frame& F, const float* b_f) {
    unsigned char* ar = F.ws + WS_AR; const bf16* FB = (const bf16*)(ar + FA_F); float* CUM = (float*)(ar + FA_CUM);
    for (int w = F.gw; w < BPH * 16; w += F.NGW) {
        const int bl = w >> 4, hd = w & 15; const float bf_ = b_f[hd];
        float v[64]; float run = 0.f;
#pragma unroll
        for (int i = 0; i < 64; ++i) { const float x = bf2f(FB[(size_t)(bl * SEQ + F.lane * 64 + i) * 256 + hd]) + bf_;
            const float ls = fminf(x, 0.f) - log1pf(expf(-fabsf(x))); run += ls; v[i] = run; }
        float inc = run;
#pragma unroll
        for (int o = 1; o < 64; o <<= 1) { const float y = __shfl_up(inc, o); if (F.lane >= o) inc += y; }
        const float base = inc - run;
        float* dst = CUM + (size_t)w * SEQ + F.lane * 64;
#pragma unroll
        for (int i = 0; i < 64; i += 4) *(f32x4*)(dst + i) = (f32x4){(v[i] + base) * LOG2E, (v[i + 1] + base) * LOG2E, (v[i + 2] + base) * LOG2E, (v[i + 3] + base) * LOG2E};
    }
    const bf16* Kr = (const bf16*)(ar + FA_K); const bf16* Vr = (const bf16*)(ar + FA_V); bf16* KF = (bf16*)(ar + FA_KF); bf16* VF = (bf16*)(ar + FA_VF);
    const int r = F.lane & 31, h = F.lane >> 5;
    for (int u = F.gw; u < BPH * 16 * 128; u += F.NGW) {
        const int bh = u >> 7, tile = u & 127, bl = bh >> 4, hd = bh & 15;
        const bf16* krow_ = Kr + ((size_t)bl * SEQ + tile * 32 + r) * DM + hd * 128 + 8 * h;
        bf16* kd = KF + (((size_t)bh * 128 + tile) * 8 * 64 + F.lane) * 8;
#pragma unroll
        for (int s = 0; s < 8; ++s) *(u32x4*)(kd + s * 512) = *(const u32x4*)(krow_ + 16 * s);
        bf16* vd = VF + (((size_t)bh * 128 + tile) * 8 * 64 + F.lane) * 8;
#pragma unroll
        for (int db = 0; db < 4; ++db)
#pragma unroll
            for (int s = 0; s < 2; ++s) { unsigned short e[8];
#pragma unroll
                for (int j = 0; j < 8; ++j) e[j] = Vr[((size_t)bl * SEQ + tile * 32 + 16 * s + 8 * (j >> 2) + 4 * h + (j & 3)) * DM + hd * 128 + db * 32 + r];
                u32x4 w; w.x = e[0] | ((unsigned)e[1] << 16); w.y = e[2] | ((unsigned)e[3] << 16); w.z = e[4] | ((unsigned)e[5] << 16); w.w = e[6] | ((unsigned)e[7] << 16);
                *(u32x4*)(vd + (db * 2 + s) * 512) = w; }
    }
}
struct FragKA { const bf16* base; int nq; DI const bf16* operator()(int t) const { return base + (size_t)t * nq * 512; } };
struct FragVA { const bf16* base; DI const bf16* operator()(int t, int db) const { return base + ((size_t)t * 8 + db * 2) * 512; } };
struct FoxMK { const float* cum; float ct; int tq, h;
    DI void operator()(int t, f32x16& S) const {
        const int k0 = 32 * t + 4 * h;
#pragma unroll
        for (int g = 0; g < 4; ++g) { const f32x4 cs = *(const f32x4*)(cum + k0 + 8 * g);
#pragma unroll
            for (int e = 0; e < 4; ++e) S[4 * g + e] = (k0 + 8 * g + e <= tq) ? S[4 * g + e] + (ct - cs[e]) : -INFINITY; }
    } };
DI void ph_fox_attn(const Frame& F, const int dry = 0) {
    unsigned char* ar = F.ws + WS_AR; const bf16* Q = (const bf16*)(ar + FA_Q); const bf16* KF = (const bf16*)(ar + FA_KF); const bf16* VF = (const bf16*)(ar + FA_VF); const float* CUM = (const float*)(ar + FA_CUM); bf16* Ob = (bf16*)(ar + FA_O);
    const int r = F.lane & 31, h = F.lane >> 5;
    for (int wb = blockIdx.x; wb < BPH * 16 * 4; wb += F.G) {
        const int bh = wb >> 2, x = (wb & 3) * 8 + F.wave, bl = bh >> 4, hd = bh & 15;
#pragma unroll 1
        for (int k = 0; k < 4; ++k) {
            const int qt = (k == 0) ? x : (k == 1) ? 63 - x : (k == 2) ? 64 + x : 127 - x;
            const int qhi = (k == 0) ? (wb & 3) * 8 + 7 : (k == 1) ? 63 - (wb & 3) * 8 : (k == 2) ? 64 + (wb & 3) * 8 + 7 : 127 - (wb & 3) * 8;
            const int tq = qt * 32 + r; const size_t mrow = (size_t)bl * SEQ + tq;
            bf16x8 qf[8];
#pragma unroll
            for (int s = 0; s < 8; ++s) qf[s] = *(const bf16x8*)(Q + mrow * DM + hd * 128 + 16 * s + 8 * h);
            f32x16 O[4];
#pragma unroll
            for (int db = 0; db < 4; ++db)
#pragma unroll
                for (int i = 0; i < 16; ++i) O[db][i] = 0.f;
            float m = -INFINITY, l = 0.f;
            const float* cum = CUM + (size_t)bh * SEQ;
            const FragSrc src{KF + (size_t)bh * 128 * 8 * 512, VF + (size_t)bh * 128 * 8 * 512, 8}; const FoxMK mk{cum, cum[tq], tq, h};
            attn_run_sh<8, true>(F.lds, F.tid, F.lane, qf, O, m, l, 0, qhi + 1, 0, qt + 1, src, mk);
            l += __shfl_xor(l, 32);
            store_col<false>(dry ? (bf16*)(ar + DUMMY_OFF) + ((size_t)F.gw * 32 + r) * 128 : Ob + mrow * DM + hd * 128, O, l > 0.f ? 1.0f / l : 0.f, h);
        }
    }
}
typedef long fp8x8_t;
DI fp8x8_t pack_fp8x8(float a0, float a1, float a2, float a3, float a4, float a5, float a6, float a7) {
    int lo = 0, hi = 0;
    lo = __builtin_amdgcn_cvt_pk_fp8_f32(a0, a1, lo, false); lo = __builtin_amdgcn_cvt_pk_fp8_f32(a2, a3, lo, true);
    hi = __builtin_amdgcn_cvt_pk_fp8_f32(a4, a5, hi, false); hi = __builtin_amdgcn_cvt_pk_fp8_f32(a6, a7, hi, true);
    return (fp8x8_t)(((unsigned long long)(unsigned)hi << 32) | (unsigned long long)(unsigned)lo);
}
#define MFMA32F8(a, b, c) __builtin_amdgcn_mfma_f32_32x32x16_fp8_fp8((a), (b), (c), 0, 0, 0)
constexpr size_t NA_Q = 0, NA_KC = 288 * MiB, NA_VC = 313 * MiB, NA_KSR = 330 * MiB, NA_KWR = 354 * MiB, NA_GT = 378 * MiB, NA_VSR = 386 * MiB, NA_VWR = 402 * MiB, NA_GK = 418 * MiB, NA_GV = 420 * MiB,
                 NA_KCMP = 422 * MiB, NA_VCT = 424 * MiB, NA_SELB = 426 * MiB, NA_O = 428 * MiB,
                 NA_KSF = 620 * MiB, NA_KWF = 644 * MiB, NA_VSF = 668 * MiB, NA_VWF = 684 * MiB;
constexpr size_t NW_IN = 0, NW_W1K = (size_t)13312 * 2048, NW_W1V = NW_W1K + (size_t)256 * 6144, NW_W2K = NW_W1V + (size_t)256 * 4096, NW_W2V = NW_W2K + 65536, NW_OUT = NW_W2V + 65536;
constexpr float NSA_QSCALE = 0.07216878364870322f * LOG2E;
DI void ph_nsa_cvt(const Frame& F, const float* w_in, const float* k_pe, const float* k_w1, const float* k_b1, const float* k_w2, const float* v_pe, const float* v_w1, const float* v_b1, const float* v_w2, const float* w_out) {
    bf16* WB = (bf16*)(F.ws + WS_WMIX); float* BIAS = (float*)(F.ws + WS_MISC);
    cvt_job(F, w_in, 13200, DM, 0, 9216, WB + NW_IN, DM, 0, NSA_QSCALE);
    cvt_job(F, w_in, 13200, DM, 9216, 768, WB + NW_IN, DM, 9216, 1.f);
    cvt_job(F, w_in, 13200, DM, 9984, 512, WB + NW_IN, DM, 9984, 1.f);
    cvt_job(F, w_in, 13200, DM, 10496, 768, WB + NW_IN, DM, 10496, 1.f);
    cvt_job(F, w_in, 13200, DM, 11776, 768, WB + NW_IN, DM, 11264, 1.f);
    cvt_job(F, w_in, 13200, DM, 13056, 144, WB + NW_IN, DM, 12032, 1.f);
    zero_bf16(F, WB + NW_IN + (size_t)12176 * DM, (size_t)112 * DM);
    cvt_job(F, w_in, 13200, DM, 11264, 512, WB + NW_IN, DM, 12288, 1.f);
    cvt_job(F, w_in, 13200, DM, 12544, 512, WB + NW_IN, DM, 12800, 1.f);
    cvt_job(F, k_w1, 256, 6144, 0, 256, WB + NW_W1K, 6144, 0, 1.f);
    cvt_job(F, v_w1, 256, 4096, 0, 256, WB + NW_W1V, 4096, 0, 1.f);
    cvt_job(F, k_w2, 192, 256, 0, 192, WB + NW_W2K, 256, 0, 1.f); zero_bf16(F, WB + NW_W2K + 192 * 256, 64 * 256);
    cvt_job(F, v_w2, 128, 256, 0, 128, WB + NW_W2V, 256, 0, 1.f); zero_bf16(F, WB + NW_W2V + 128 * 256, 128 * 256);
    cvt_job(F, w_out, DM, 6144, 0, DM, WB + NW_OUT, 6144, 0, 1.f);
    for (int w = F.gw; w < 512; w += F.NGW) { const bool isk = w < 256; const int c = w & 255, n = isk ? 6144 : 4096; const float* pe = isk ? k_pe : v_pe; const float* w1 = isk ? k_w1 : v_w1;
        float s = 0.f; for (int i = F.lane; i < n; i += 64) s += pe[i] * w1[(size_t)i * 256 + c];
        s = wave_sum(s); if (F.lane == 0) BIAS[w] = s + (isk ? k_b1[c] : v_b1[c]); }
}
DI void ph_nsa_rope(const Frame& F, int half) {
    unsigned char* ar = F.ws + WS_AR; bf16* Q = (bf16*)(ar + NA_Q); bf16* KC = (bf16*)(ar + NA_KC);
    const bf16* KSR = (const bf16*)(ar + NA_KSR); const bf16* KWR = (const bf16*)(ar + NA_KWR); bf16* KSF = (bf16*)(ar + NA_KSF); bf16* KWF = (bf16*)(ar + NA_KWF);
    const float* c48 = (const float*)(F.ws + TAB_COS48); const float* s48 = (const float*)(F.ws + TAB_SIN48);
    for (int ml = F.gw; ml < MC; ml += F.NGW) {
        const size_t mg = (size_t)half * MC + ml; const int bl = ml >> 12, sq = ml & 4095;
        for (int p = F.lane; p < 96; p += 64) {
            const int hd = 48 + p / 24, i = p - (p / 24) * 24; bf16* q;
            q = KC + ((size_t)(bl * 4 + hd - 48) * 4096 + sq) * 192 + i;
            const float x1 = bf2f(q[0]), x2 = bf2f(q[24]), c = c48[mg * 24 + i], s = s48[mg * 24 + i]; q[0] = f2bf(x1 * c - x2 * s); q[24] = f2bf(x1 * s + x2 * c);
        }
        const int tile = sq >> 5, rr = sq & 31;
        for (int u = F.lane; u < 168; u += 64) {
            const int tens = u / 84, uu = u - tens * 84, g = uu / 21, v = uu - g * 21;
            const bf16* src = (tens ? KWR : KSR) + (size_t)ml * 768 + g * 192;
            bf16* dst = (tens ? KWF : KSF) + ((size_t)((bl * 4 + g) * 128 + tile) * 12 * 64 + rr) * 8;
            if (v < 3) {
                const u32x4 a = *(const u32x4*)(src + 8 * v), b = *(const u32x4*)(src + 8 * v + 24); u32x4 o1, o2;
#pragma unroll
                for (int e = 0; e < 4; ++e) { const float c0 = c48[mg * 24 + 8 * v + 2 * e], s0 = s48[mg * 24 + 8 * v + 2 * e], c1 = c48[mg * 24 + 8 * v + 2 * e + 1], s1 = s48[mg * 24 + 8 * v + 2 * e + 1];
                    const float x1l = bflo(a[e]), x1h = bfhi(a[e]), x2l = bflo(b[e]), x2h = bfhi(b[e]);
                    o1[e] = pk2(x1l * c0 - x2l * s0, x1h * c1 - x2h * s1); o2[e] = pk2(x1l * s0 + x2l * c0, x1h * s1 + x2h * c1); }
                const int p1 = v, p2 = v + 3;
                if (tens) { *(u32x4*)(dst + ((p1 >> 1) * 64 + (p1 & 1) * 32) * 8) = o1; *(u32x4*)(dst + ((p2 >> 1) * 64 + (p2 & 1) * 32) * 8) = o2; }
                else { unsigned char* d8 = (unsigned char*)KSF + ((size_t)(((bl * 4 + g) * 128 + tile) * 2 + (rr >> 4)) * 6 * 64 + (rr & 15)) * 8;
                    *(fp8x8_t*)(d8 + ((p1 >> 2) * 64 + (p1 & 3) * 16) * 8) = pack_fp8x8(bflo(o1[0]), bfhi(o1[0]), bflo(o1[1]), bfhi(o1[1]), bflo(o1[2]), bfhi(o1[2]), bflo(o1[3]), bfhi(o1[3]));
                    *(fp8x8_t*)(d8 + ((p2 >> 2) * 64 + (p2 & 3) * 16) * 8) = pack_fp8x8(bflo(o2[0]), bfhi(o2[0]), bflo(o2[1]), bfhi(o2[1]), bflo(o2[2]), bfhi(o2[2]), bflo(o2[3]), bfhi(o2[3])); }
            } else { const int pc = v + 3; const u32x4 c = *(const u32x4*)(src + 8 * pc);
                if (tens) *(u32x4*)(dst + ((pc >> 1) * 64 + (pc & 1) * 32) * 8) = c;
                else { unsigned char* d8 = (unsigned char*)KSF + ((size_t)(((bl * 4 + g) * 128 + tile) * 2 + (rr >> 4)) * 6 * 64 + (rr & 15)) * 8;
                    *(fp8x8_t*)(d8 + ((pc >> 2) * 64 + (pc & 3) * 16) * 8) = pack_fp8x8(bflo(c[0]), bfhi(c[0]), bflo(c[1]), bfhi(c[1]), bflo(c[2]), bfhi(c[2]), bflo(c[3]), bfhi(c[3])); } }
        }
    }
    const bf16* VSR = (const bf16*)(ar + NA_VSR); const bf16* VWR = (const bf16*)(ar + NA_VWR); bf16* VSF = (bf16*)(ar + NA_VSF); bf16* VWF = (bf16*)(ar + NA_VWF);
    const int r = F.lane & 31, h = F.lane >> 5;
    for (int u = F.gw; u < 2 * BPH * 4 * 128; u += F.NGW) {
        const int tens = u >> 11, bg = (u >> 7) & 15, tile = u & 127, bl = bg >> 2, g = bg & 3;
        if (tens) {
            const bf16* src = VWR + ((size_t)bl * SEQ + tile * 32) * 512 + g * 128 + r;
            bf16* vd = VWF + (((size_t)bg * 128 + tile) * 8 * 64 + F.lane) * 8;
#pragma unroll
            for (int db = 0; db < 4; ++db)
#pragma unroll
                for (int s = 0; s < 2; ++s) { unsigned short e[8];
#pragma unroll
                    for (int j = 0; j < 8; ++j) e[j] = src[(size_t)(16 * s + 8 * (j >> 2) + 4 * h + (j & 3)) * 512 + db * 32];
                    u32x4 w; w.x = e[0] | ((unsigned)e[1] << 16); w.y = e[2] | ((unsigned)e[3] << 16); w.z = e[4] | ((unsigned)e[5] << 16); w.w = e[6] | ((unsigned)e[7] << 16);
                    *(u32x4*)(vd + (db * 2 + s) * 512) = w; }
        } else {
            const int d16 = F.lane & 15, kq = F.lane >> 4;
            const bf16* src = VSR + ((size_t)bl * SEQ + tile * 32) * 512 + g * 128 + d16;
            unsigned char* vd = (unsigned char*)VSF + (((size_t)bg * 128 + tile) * 8 * 64 + F.lane) * 8;
#pragma unroll
            for (int db = 0; db < 8; ++db) { float e[8];
#pragma unroll
                for (int j = 0; j < 8; ++j) e[j] = bf2f(src[(size_t)((j < 4 ? 4 * kq + j : 16 + 4 * kq + j - 4)) * 512 + db * 16]);
                *(fp8x8_t*)(vd + db * 512) = pack_fp8x8(e[0], e[1], e[2], e[3], e[4], e[5], e[6], e[7]); }
        }
    }
}
DI void rope_piece(const bf16* qrow, int p, const float* cs, const float* sn, float (&o)[8]) {
    const bool lo = p < 3; const int pp = lo ? p + 3 : p - 3, i0 = 8 * (lo ? p : p - 3);
    const u32x4 a = *(const u32x4*)(qrow + 8 * p), b = *(const u32x4*)(qrow + 8 * pp);
    const f32x4 c0 = *(const f32x4*)(cs + i0), c1 = *(const f32x4*)(cs + i0 + 4), s0 = *(const f32x4*)(sn + i0), s1 = *(const f32x4*)(sn + i0 + 4);
#pragma unroll
    for (int e = 0; e < 4; ++e) { const float c_l = e < 2 ? c0[2 * e] : c1[2 * e - 4], c_h = e < 2 ? c0[2 * e + 1] : c1[2 * e - 3], s_l = e < 2 ? s0[2 * e] : s1[2 * e - 4], s_h = e < 2 ? s0[2 * e + 1] : s1[2 * e - 3];
        const float al = bflo(a[e]), ah = bfhi(a[e]), bl_ = bflo(b[e]), bh_ = bfhi(b[e]);
        o[2 * e] = lo ? al * c_l - bl_ * s_l : bl_ * s_l + al * c_l; o[2 * e + 1] = lo ? ah * c_h - bh_ * s_h : bh_ * s_h + ah * c_h; }
}
DI bf16x8 rope_frag32(const bf16* qrow, int s, int h, const float* cs, const float* sn) {
    float o[8]; rope_piece(qrow, 2 * s + h, cs, sn, o);
    u32x4 w; w.x = pk2(o[0], o[1]); w.y = pk2(o[2], o[3]); w.z = pk2(o[4], o[5]); w.w = pk2(o[6], o[7]); return __builtin_bit_cast(bf16x8, w);
}
DI float sigmoidf_(float x) { return __builtin_amdgcn_rcpf(1.0f + __builtin_amdgcn_exp2f(-x * LOG2E)); }
struct LinKA { const bf16* base; size_t tstride; DI const bf16* operator()(int t) const { return base + (size_t)t * tstride; } };
struct LinVA { const bf16* base; size_t dbstride; DI const bf16* operator()(int t, int db) const { return base + (size_t)db * dbstride + t * 32; } };
struct CmpMK { int tq, h; DI void operator()(int t, f32x16& S) const {
#pragma unroll
    for (int i = 0; i < 16; ++i) { const int n = 32 * t + crow(i, h); S[i] = (16 * n + 31 <= tq) ? S[i] : -INFINITY; } } };
struct WinMK { int tq, h; DI void operator()(int t, f32x16& S) const {
#pragma unroll
    for (int i = 0; i < 16; ++i) { const int k = 32 * t + crow(i, h); S[i] = (k <= tq && k > tq - 512) ? S[i] : -INFINITY; } } };
DI void ph_nsa_cmp(const Frame& F, const int half, const int dry = 0) {
    const float* c48 = (const float*)(F.ws + TAB_COS48); const float* s48 = (const float*)(F.ws + TAB_SIN48);
    unsigned char* ar = F.ws + WS_AR; const bf16* Q = (const bf16*)(ar + NA_Q); const bf16* KCMP = (const bf16*)(ar + NA_KCMP); const bf16* VCT = (const bf16*)(ar + NA_VCT); const bf16* GT = (const bf16*)(ar + NA_GT);
    unsigned char* SELB = ar + NA_SELB; bf16* Ob = (bf16*)(ar + NA_O);
    LAS float* imp = (LAS float*)F.lds;
    LAS unsigned char* tl = F.lds + 20480;
    const int lane = F.lane, r = lane & 31, h = lane >> 5, tid = F.tid;
    for (int u = blockIdx.x; u < BPH * 4 * 64; u += F.G) {
        const int bg = u >> 6, qt64 = ((u >> 8) & 1) ? 63 - (u & 63) : (u & 63), bl = bg >> 2, g = bg & 3;
        for (int i = F.tid; i < 64 * 65; i += NWAVES * 64) imp[i] = 0.f;
        __syncthreads();
        const FragSrc src{KCMP + (size_t)bg * 8 * 12 * 512, VCT + (size_t)bg * 8 * 8 * 512, 12};
        const int tqmaxb = qt64 * 64 + 63, TE = (tqmaxb >= 31) ? ((tqmaxb - 31) / 16) / 32 + 1 : 0;
#pragma unroll 1
        for (int k = 0; k < 3; ++k) {
            const int idx = F.wave * 3 + k, j = idx >> 1, sub = idx & 1, ql = sub * 32 + r, tq = qt64 * 64 + ql, hd = g * 12 + j;
            const size_t mrow = (size_t)bl * SEQ + tq;
            bf16x8 qf[12];
#pragma unroll
            for (int s = 3; s < 12; ++s) qf[s] = *(const bf16x8*)(Q + mrow * 9216 + hd * 192 + 16 * s + 8 * h);
            { const float* cs = c48 + ((size_t)half * MC + mrow) * 24; const float* sn = s48 + ((size_t)half * MC + mrow) * 24;
#pragma unroll
              for (int s = 0; s < 3; ++s) qf[s] = rope_frag32(Q + mrow * 9216 + hd * 192, s, h, cs, sn); }
            const int tqmax = qt64 * 64 + sub * 32 + 31, te = (tqmax >= 31) ? ((tqmax - 31) / 16) / 32 + 1 : 0;
            const CmpMK mk{tq, h};
            float m = -INFINITY, l = 0.f;
            { f32x16 Od[4];
              attn_run_sh<12, false>(tl, tid, lane, qf, Od, m, l, 0, TE, 0, te, src, mk); }
            l += __shfl_xor(l, 32);
            const float linv = l > 0.f ? 1.0f / l : 0.f, ms = (m == -INFINITY) ? 0.f : m;
            f32x16 O[4];
#pragma unroll
            for (int db = 0; db < 4; ++db)
#pragma unroll
                for (int i = 0; i < 16; ++i) O[db][i] = 0.f;
            if (TE > 0) {
                TilePre<12> pre;
                tile_fetch<12>(pre, src, 0, tid); tile_put<12>(pre, tl, tid);
                LDS_WAIT(); __builtin_amdgcn_s_barrier(); asm volatile("" ::: "memory");
#pragma unroll 1
                for (int t = 0; t < TE; ++t) {
                    LAS unsigned char* cur = tl + (t & 1) * 20480;
                    if (t + 1 < TE) tile_fetch<12>(pre, src, t + 1, tid);
                    if (t < te) {
                        f32x16 S;
#pragma unroll
                        for (int i = 0; i < 16; ++i) S[i] = 0.f;
#pragma unroll
                        for (int s = 0; s < 12; ++s) S = MFMA32(*(const LAS bf16x8*)(cur + s * 1024 + lane * 16), qf[s], S);
                        mk(t, S);
#pragma unroll
                        for (int i = 0; i < 16; ++i) S[i] = __builtin_amdgcn_exp2f(S[i] - ms) * linv;
#pragma unroll
                        for (int g4 = 0; g4 < 4; ++g4) { const float gs = (S[4 * g4] + S[4 * g4 + 1]) + (S[4 * g4 + 2] + S[4 * g4 + 3]); const int mb = 8 * t + 2 * g4 + h;
                            __hip_atomic_fetch_add(imp + ql * 65 + mb, gs, __ATOMIC_RELAXED, __HIP_MEMORY_SCOPE_WORKGROUP);
                            if (mb + 1 < 64) __hip_atomic_fetch_add(imp + ql * 65 + mb + 1, S[4 * g4 + 3], __ATOMIC_RELAXED, __HIP_MEMORY_SCOPE_WORKGROUP); }
                        bf16x8 pf[2];
#pragma unroll
                        for (int s = 0; s < 2; ++s) { u32x4 w; w.x = pk2(S[8 * s], S[8 * s + 1]); w.y = pk2(S[8 * s + 2], S[8 * s + 3]); w.z = pk2(S[8 * s + 4], S[8 * s + 5]); w.w = pk2(S[8 * s + 6], S[8 * s + 7]); pf[s] = __builtin_bit_cast(bf16x8, w); }
#pragma unroll
                        for (int db = 0; db < 4; ++db)
#pragma unroll
                            for (int s = 0; s < 2; ++s) O[db] = MFMA32(*(const LAS bf16x8*)(cur + (12 + db * 2 + s) * 1024 + lane * 16), pf[s], O[db]);
                    }
                    if (t + 1 < TE) tile_put<12>(pre, tl + ((t + 1) & 1) * 20480, tid);
                    LDS_WAIT(); __builtin_amdgcn_s_barrier(); asm volatile("" ::: "memory");
                }
            }
            const float gate = sigmoidf_(bf2f(GT[mrow * 256 + hd]));
            store_col<false>(dry ? (bf16*)(ar + DUMMY_OFF) + ((size_t)F.gw * 32 + r) * 128 : Ob + mrow * 6144 + hd * 128, O, gate, h);
        }
        __syncthreads();
#pragma unroll 1
        for (int k = 0; k < 8; ++k) {
            const int ql = F.wave * 8 + k, tq = qt64 * 64 + ql, cur = tq >> 6, mb = lane;
            const bool causal = mb <= cur, forced = (mb == 0) || (mb == cur) || (mb == cur - 1);
            const float v = causal ? (forced ? INFINITY : imp[ql * 65 + mb]) : -INFINITY;
            int rank = 0;
            for (int o = 0; o < 64; ++o) { const float vo = __shfl(v, o); rank += (vo > v || (vo == v && o < mb)) ? 1 : 0; }
            if (rank < 16) (dry ? ar + DUMMY_OFF + 32 * MiB + (size_t)F.gw * 16 : SELB + ((size_t)bg * 4096 + tq) * 16)[rank] = causal ? (unsigned char)mb : (unsigned char)0xFF;
        }
        __syncthreads();
    }
}
DI int sel_tile(const u32x4& sel, int t) { const int b = t >> 1; const unsigned w = (b < 4) ? sel.x : (b < 8) ? sel.y : (b < 12) ? sel.z : sel.w; return (int)((w >> ((b & 3) * 8)) & 0xFFu) * 2 + (t & 1); }
struct SelKA { const bf16* base; u32x4 sel; DI const bf16* operator()(int t) const { return base + (size_t)sel_tile(sel, t) * 12 * 512; } };
struct SelVA { const bf16* base; u32x4 sel; DI const bf16* operator()(int t, int db) const { return base + ((size_t)sel_tile(sel, t) * 8 + db * 2) * 512; } };
struct SelMK { u32x4 sel; int tq, h; DI void operator()(int t, f32x16& S) const { const int k0 = sel_tile(sel, t) * 32;
#pragma unroll
    for (int i = 0; i < 16; ++i) S[i] = (k0 + crow(i, h) <= tq) ? S[i] : -INFINITY; } };
typedef float f32x4_ __attribute__((ext_vector_type(4)));
#define MFMA16F8(a, b, c) __builtin_amdgcn_mfma_f32_16x16x32_fp8_fp8((a), (b), (c), 0, 0, 0)
DI void ph_nsa_sel(const Frame& F, const int half, const int dry = 0) {
    const float* c48 = (const float*)(F.ws + TAB_COS48); const float* s48 = (const float*)(F.ws + TAB_SIN48);
    unsigned char* ar = F.ws + WS_AR; const bf16* Q = (const bf16*)(ar + NA_Q); const unsigned char* KS8 = ar + NA_KSF; const unsigned char* VS8 = ar + NA_VSF; const bf16* GT = (const bf16*)(ar + NA_GT);
    const unsigned char* SELB = ar + NA_SELB; bf16* Ob = (bf16*)(ar + NA_O);
    const int c16 = F.lane & 15, kq = F.lane >> 4; const bool act = c16 < 12;
    for (int it = F.gw; it < BPH * 4 * SEQ; it += F.NGW) {
        const int bg = it >> 12, tq = ((it & 4095) + 256 * bg) & 4095, bl = bg >> 2, g = bg & 3; const size_t mrow = (size_t)bl * SEQ + tq; const int hd = g * 12 + (act ? c16 : 0);
        fp8x8_t qf[6];
#pragma unroll
        for (int s = 0; s < 6; ++s) { const float qs = act ? (1.0f / NSA_QSCALE) : 0.f; const int p = 4 * s + kq;
            if (s < 2 && p < 6) { float o[8]; rope_piece(Q + mrow * 9216 + hd * 192, p, c48 + ((size_t)half * MC + mrow) * 24, s48 + ((size_t)half * MC + mrow) * 24, o);
                qf[s] = pack_fp8x8(o[0] * qs, o[1] * qs, o[2] * qs, o[3] * qs, o[4] * qs, o[5] * qs, o[6] * qs, o[7] * qs); }
            else { const u32x4 q = *(const u32x4*)(Q + mrow * 9216 + hd * 192 + 32 * s + 8 * kq);
                qf[s] = pack_fp8x8(bflo(q[0]) * qs, bfhi(q[0]) * qs, bflo(q[1]) * qs, bfhi(q[1]) * qs, bflo(q[2]) * qs, bfhi(q[2]) * qs, bflo(q[3]) * qs, bfhi(q[3]) * qs); } }
        const u32x4 sel = *(const u32x4*)(SELB + ((size_t)bg * 4096 + tq) * 16);
        const int nv = ((tq >> 6) + 1 < 16) ? (tq >> 6) + 1 : 16, te = 2 * nv;
        const unsigned char* kb = KS8 + ((size_t)bg * 128 * 12 * 64 + F.lane) * 8; const unsigned char* vb = VS8 + ((size_t)bg * 128 * 8 * 64 + F.lane) * 8;
        f32x4_ O[8];
#pragma unroll
        for (int db = 0; db < 8; ++db) O[db] = (f32x4_){0.f, 0.f, 0.f, 0.f};
        float m = -INFINITY, l = 0.f;
        fp8x8_t kfA[12], kfB[12], vfA[8], vfB[8];
        { const unsigned char* kp = kb + (size_t)sel_tile(sel, 0) * 12 * 512; const unsigned char* kp1 = kb + (size_t)sel_tile(sel, 1) * 12 * 512; const unsigned char* vp = vb + (size_t)sel_tile(sel, 0) * 8 * 512;
#pragma unroll
          for (int s = 0; s < 12; ++s) { kfA[s] = *(const fp8x8_t*)(kp + s * 512); kfB[s] = *(const fp8x8_t*)(kp1 + s * 512); }
#pragma unroll
          for (int j = 0; j < 8; ++j) vfA[j] = *(const fp8x8_t*)(vp + j * 512); }
#define SEL_STEP(T_, KF_, VF_, VFN_) do { const int t_ = (T_); const int tile = sel_tile(sel, t_); \
            if (t_ + 1 < te) { const unsigned char* vp = vb + (size_t)sel_tile(sel, t_ + 1) * 8 * 512; _Pragma("unroll") for (int j = 0; j < 8; ++j) VFN_[j] = *(const fp8x8_t*)(vp + j * 512); } \
            f32x4_ S0 = {0.f, 0.f, 0.f, 0.f}, S1 = S0; \
            _Pragma("unroll") for (int s = 0; s < 6; ++s) { S0 = MFMA16F8(KF_[s], qf[s], S0); S1 = MFMA16F8(KF_[6 + s], qf[s], S1); } \
            if (t_ + 2 < te) { const unsigned char* kp = kb + (size_t)sel_tile(sel, t_ + 2) * 12 * 512; _Pragma("unroll") for (int s = 0; s < 12; ++s) KF_[s] = *(const fp8x8_t*)(kp + s * 512); } \
            const int k0 = tile * 32 + 4 * kq; float mx = -INFINITY; \
            _Pragma("unroll") for (int i = 0; i < 4; ++i) { S0[i] = (k0 + i <= tq) ? S0[i] * NSA_QSCALE : -INFINITY; S1[i] = (k0 + 16 + i <= tq) ? S1[i] * NSA_QSCALE : -INFINITY; mx = fmaxf(mx, fmaxf(S0[i], S1[i])); } \
            mx = fmaxf(mx, __shfl_xor(mx, 16)); mx = fmaxf(mx, __shfl_xor(mx, 32)); \
            const float mn = fmaxf(m, mx), ms = (mn == -INFINITY) ? 0.f : mn, alpha = __builtin_amdgcn_exp2f(m - ms); \
            float sum = 0.f; \
            _Pragma("unroll") for (int i = 0; i < 4; ++i) { S0[i] = __builtin_amdgcn_exp2f(S0[i] - ms); S1[i] = __builtin_amdgcn_exp2f(S1[i] - ms); sum += S0[i] + S1[i]; } \
            l = l * alpha + sum; m = mn; \
            if (__builtin_amdgcn_ballot_w64(alpha != 1.0f) != 0ull) { _Pragma("unroll") for (int db = 0; db < 8; ++db) O[db] = O[db] * alpha; } \
            const fp8x8_t p8 = pack_fp8x8(S0[0], S0[1], S0[2], S0[3], S1[0], S1[1], S1[2], S1[3]);       \
            _Pragma("unroll") for (int db = 0; db < 8; ++db) O[db] = MFMA16F8(VF_[db], p8, O[db]); } while (0)
#pragma unroll 1
        for (int t = 0; t < te; t += 2) { SEL_STEP(t, kfA, vfA, vfB); SEL_STEP(t + 1, kfB, vfB, vfA); }
#undef SEL_STEP
        l += __shfl_xor(l, 16); l += __shfl_xor(l, 32);
        if (act) { const float gate = sigmoidf_(bf2f(GT[mrow * 256 + 48 + hd])); const float sc = l > 0.f ? gate / l : 0.f;
            bf16* o = (dry ? (bf16*)(ar + DUMMY_OFF) + ((size_t)F.gw * 16 + c16) * 128 : Ob + mrow * 6144 + hd * 128) + 4 * kq;
#pragma unroll
            for (int db = 0; db < 8; ++db) { u32x2* p = (u32x2*)(o + db * 16); const u32x2 prev = *p;
                u32x2 w; w.x = pk2(O[db][0] * sc + bflo(prev.x), O[db][1] * sc + bfhi(prev.x)); w.y = pk2(O[db][2] * sc + bflo(prev.y), O[db][3] * sc + bfhi(prev.y)); *p = w; } }
    }
}
DI void ph_nsa_win(const Frame& F, const int half, const int dry = 0) {
    const float* c48 = (const float*)(F.ws + TAB_COS48); const float* s48 = (const float*)(F.ws + TAB_SIN48);
    unsigned char* ar = F.ws + WS_AR; const bf16* Q = (const bf16*)(ar + NA_Q); const bf16* KWF = (const bf16*)(ar + NA_KWF); const bf16* VWF = (const bf16*)(ar + NA_VWF); const bf16* GT = (const bf16*)(ar + NA_GT); bf16* Ob = (bf16*)(ar + NA_O);
    const int r = F.lane & 31, h = F.lane >> 5;
    for (int idb = blockIdx.x; idb < BPH * 48 * 16; idb += F.G) {
        const int qt0 = (((idb & 15) + (idb >> 8)) & 15) * 8, qt = qt0 + F.wave, bh = idb >> 4, hd = bh % 48, bl = bh / 48, g = hd / 12, bg = bl * 4 + g, tq = qt * 32 + r; const size_t mrow = (size_t)bl * SEQ + tq;
        bf16x8 qf[12];
#pragma unroll
        for (int s = 3; s < 12; ++s) qf[s] = *(const bf16x8*)(Q + mrow * 9216 + hd * 192 + 16 * s + 8 * h);
        { const float* cs = c48 + ((size_t)half * MC + mrow) * 24; const float* sn = s48 + ((size_t)half * MC + mrow) * 24;
#pragma unroll
          for (int s = 0; s < 3; ++s) qf[s] = rope_frag32(Q + mrow * 9216 + hd * 192, s, h, cs, sn); }
        const FragSrc src{KWF + (size_t)bg * 128 * 12 * 512, VWF + (size_t)bg * 128 * 8 * 512, 12}; const WinMK mk{tq, h};
        f32x16 O[4];
#pragma unroll
        for (int db = 0; db < 4; ++db)
#pragma unroll
            for (int i = 0; i < 16; ++i) O[db][i] = 0.f;
        float m = -INFINITY, l = 0.f;
        attn_run_sh<12, true>(F.lds, F.tid, F.lane, qf, O, m, l, qt0 >= 16 ? qt0 - 16 : 0, qt0 + 8, qt >= 16 ? qt - 16 : 0, qt + 1, src, mk);
        l += __shfl_xor(l, 32);
        const float gate = sigmoidf_(bf2f(GT[mrow * 256 + 96 + hd]));
        store_col<true>(dry ? (bf16*)(ar + DUMMY_OFF) + ((size_t)F.gw * 32 + r) * 128 : Ob + mrow * 6144 + hd * 128, O, l > 0.f ? gate / l : 0.f, h);
    }
}
#ifndef MK_ONE_LAUNCH
#define MK_ONE_LAUNCH 1
#endif
constexpr int NPH = 74;
struct Args { const float* in[58]; float* out; unsigned char* ws; int ph_lo, ph_hi; };
#ifndef PROBE_GEMM
#define PROBE_GEMM 0
#endif
#ifndef PROBE_PH
#define PROBE_PH 0
#endif
#define GEMM_AKOFF 0
#define GEMM_CALL(EpiT, Evar, Aptr, Bptr, Mv, Nv, Kv, ldav, ldbv, cidx) do { if (PROBE_GEMM) { const pg8::Gemm g0_{(const pg8::bf16_t*)(Aptr), (const pg8::bf16_t*)(Bptr), (Mv), (Nv), (Kv), (ldav), (ldbv), GEMM_AKOFF}; \
    pg8::StaticOrder S0_; S0_.init((Mv), (Nv), F.G, (cidx)); pg8::EpiDry E0_{(float*)(ar + DUMMY_OFF)}; pg8::gemm_phase<pg8::EpiDry, pg8::StaticOrder, true, true>((PG8_LAS unsigned char*)F.lds, g0_, S0_, E0_); __syncthreads(); } \
    const pg8::Gemm g_{(const pg8::bf16_t*)(Aptr), (const pg8::bf16_t*)(Bptr), (Mv), (Nv), (Kv), (ldav), (ldbv), GEMM_AKOFF}; \
    pg8::StaticOrder S_; S_.init((Mv), (Nv), F.G, (cidx)); pg8::gemm_phase<EpiT, pg8::StaticOrder, true, true>((PG8_LAS unsigned char*)F.lds, g_, S_, Evar); } while (0)
DI pg8::EpiBf16R epi1(bf16* base, int ldc) { pg8::EpiBf16R e; for (int s = 0; s < 8; ++s) { e.T.base[s] = base; e.T.ldc[s] = ldc; e.T.t0[s] = 0; e.T.gw[s] = 0; } e.T.nseg = 1; e.T.pad_ = 0; e.ssp = nullptr; e.ss_off = 0; return e; }
#define PH_BEGIN if (ph >= lo && ph < hi) { Frame F; { unsigned long long w_ = (unsigned long long)args.ws; asm volatile("" : "+s"(w_)); F.ws = (unsigned char*)w_; F.ctl = (unsigned*)(F.ws + WS_CTL); } \
    F.lds = lds; F.tid = threadIdx.x; F.lane = F.tid & 63; F.wave = __builtin_amdgcn_readfirstlane(F.tid >> 6); F.G = gridDim.x; F.gw = blockIdx.x * NWAVES + F.wave; F.NGW = F.G * NWAVES; \
    float* out; { unsigned long long o_ = (unsigned long long)args.out; asm volatile("" : "+s"(o_)); out = (float*)o_; } \
    unsigned char* const ar = F.ws + WS_AR; bf16* const XN = (bf16*)(F.ws + WS_XNR); float* const SSB = (float*)(F.ws + WS_SS); bf16* const WB = (bf16*)(F.ws + WS_WMIX); bf16* const WUP = (bf16*)(F.ws + WS_WFFN); bf16* const WDN = WUP + (size_t)2 * DFF * DM; \
    const float* const res_mix = (ib == 2) ? args.in[0] : (const float*)out; (void)ar; (void)XN; (void)SSB; (void)WB; (void)WUP; (void)WDN; (void)res_mix; (void)iff;
#define PH_END   if (ph + 1 < hi) { XcdBarrier b_; b_.bar = (unsigned*)F.ctl + CW_BAR; b_.x = xb_xcc_id(); b_.st = MISC + 8; xcd_barrier(b_); } } ++ph;
template <int LAYER> DI void run_cvt(const Args& args, LAS unsigned char* lds, volatile LAS unsigned* MISC, int& ph, const int lo, const int hi) {
    constexpr int ib = (LAYER == 0) ? 2 : (LAYER == 1) ? 17 : (LAYER == 2) ? 26 : 42;
    constexpr int iff = (LAYER == 0) ? 12 : (LAYER == 1) ? 21 : (LAYER == 2) ? 37 : 52;
    constexpr int kind = (LAYER == 1) ? 1 : (LAYER == 2) ? 2 : 0;
        PH_BEGIN
          for (int rep_ = 0; rep_ < (PROBE_PH == 11 ? 2 : 1); ++rep_) {
            if constexpr (kind == 0) ph_dsa_cvt(F, args.in[ib + 1], args.in[ib + 6], args.in[ib + 7], args.in[ib + 8], args.in[ib + 9]);
            else if constexpr (kind == 1) ph_fox_cvt(F, args.in[ib + 1], args.in[ib + 3]);
            else ph_nsa_cvt(F, args.in[ib + 1], args.in[ib + 2], args.in[ib + 3], args.in[ib + 4], args.in[ib + 5], args.in[ib + 6], args.in[ib + 7], args.in[ib + 8], args.in[ib + 9], args.in[ib + 10]);
            ph_cvt_ffn(F, args.in[iff + 1], args.in[iff + 4]); __syncthreads();
          }
        PH_END
}
template <int LAYER, int HALF> DI void run_half(const Args& args, LAS unsigned char* lds, volatile LAS unsigned* MISC, int& ph, const int lo, const int hi) {
    constexpr int ib = (LAYER == 0) ? 2 : (LAYER == 1) ? 17 : (LAYER == 2) ? 26 : 42;
    constexpr int iff = (LAYER == 0) ? 12 : (LAYER == 1) ? 21 : (LAYER == 2) ? 37 : 52;
    constexpr int kind = (LAYER == 1) ? 1 : (LAYER == 2) ? 2 : 0;
    constexpr int half = HALF;
            const int roff = half * MC;
            const float* const ssin = nullptr; (void)ssin;
            if constexpr (kind == 0) {
                PH_BEGIN { pg8::EpiF32 E{(float*)(ar + DA_DIN), 1024, SSB + (size_t)(LAYER * 2) * MTOT * 8, roff}; GEMM_CALL(pg8::EpiF32, E, XN + (size_t)roff * DM, WB + DW_W1, MC, 1024, DM, DM, DM, (int)blockIdx.x); } PH_END
                PH_BEGIN if (PROBE_PH == 10) { ph_dsa_post1(F, half, args.in[ib + 2], args.in[ib + 3], args.in[ib + 4], args.in[ib + 5]); __syncthreads(); } ph_dsa_post1(F, half, args.in[ib + 2], args.in[ib + 3], args.in[ib + 4], args.in[ib + 5]); PH_END
                PH_BEGIN { pg8::EpiBf16R E = epi1((bf16*)(ar + DA_QL), 8192); E.T.base[1] = (bf16*)(ar + DA_QPE); E.T.ldc[1] = 1536; E.T.t0[1] = 32; E.T.base[2] = (bf16*)(ar + DA_QIDX); E.T.ldc[2] = 2048; E.T.t0[2] = 38; E.T.nseg = 3;
                    GEMM_CALL(pg8::EpiBf16R, E, ar + DA_CQN, WB + DW_W2, MC, 11776, 512, 512, 512, (int)blockIdx.x); } PH_END
                PH_BEGIN ph_dsa_rope(F, half); PH_END
                PH_BEGIN if (PROBE_PH == 1) { ph_dsa_index(F, 1); __syncthreads(); } if (PROBE_PH == 7) { ph_dsa_index(F, 1, 1); __syncthreads(); } if (PROBE_PH == 8) { ph_dsa_index(F, 1, 2); __syncthreads(); } ph_dsa_index(F); PH_END
                PH_BEGIN if (PROBE_PH == 2) { ph_dsa_attn(F, 1); __syncthreads(); } ph_dsa_attn(F); PH_END
                PH_BEGIN {
                    pg8::EpiBf16R E = epi1((bf16*)(ar + DA_O2), 4096);
                    { const pg8::Gemm g_{(const pg8::bf16_t*)(ar + DA_QL), (const pg8::bf16_t*)(WB + DW_BD), MC, 4096, 512, 8192, 512, 512}; pg8::StaticOrder S_; S_.init(MC, 4096, F.G, (int)blockIdx.x);
                      pg8::gemm_phase<pg8::EpiBf16R, pg8::StaticOrder, true, true>((PG8_LAS unsigned char*)F.lds, g_, S_, E); } } PH_END
                PH_BEGIN { pg8::EpiResN E{LAYER == 0 ? args.in[0] : nullptr, args.in[ib], nullptr, DM, roff, args.in[iff], (pg8::bf16_t*)XN, SSB + (size_t)(LAYER * 2 + 1) * MTOT * 8, (PG8_LAS float*)(F.lds + LDSCTL_OFF + 256)}; GEMM_CALL(pg8::EpiResN, E, ar + DA_O2, WB + DW_WO, MC, DM, 4096, 4096, 4096, (int)blockIdx.x); } PH_END
            } else if constexpr (kind == 1) {
                PH_BEGIN { pg8::EpiBf16R E = epi1((bf16*)(ar + FA_Q), DM); E.T.base[1] = (bf16*)(ar + FA_K); E.T.ldc[1] = DM; E.T.t0[1] = 8; E.T.base[2] = (bf16*)(ar + FA_V); E.T.ldc[2] = DM; E.T.t0[2] = 16;
                    E.T.base[3] = (bf16*)(ar + FA_F); E.T.ldc[3] = 256; E.T.t0[3] = 24; E.T.nseg = 4; E.ssp = SSB + (size_t)(LAYER * 2) * MTOT * 8; E.ss_off = roff;
                    GEMM_CALL(pg8::EpiBf16R, E, XN + (size_t)roff * DM, WB + FW_IN, MC, 6400, DM, DM, DM, (int)blockIdx.x); } PH_END
                PH_BEGIN if (PROBE_PH == 10) { ph_fox_scan(F, args.in[ib + 2]); __syncthreads(); } ph_fox_scan(F, args.in[ib + 2]); PH_END
                PH_BEGIN if (PROBE_PH == 3) { ph_fox_attn(F, 1); __syncthreads(); } ph_fox_attn(F); PH_END
                PH_BEGIN { pg8::EpiResN E{LAYER == 0 ? args.in[0] : nullptr, args.in[ib], nullptr, DM, roff, args.in[iff], (pg8::bf16_t*)XN, SSB + (size_t)(LAYER * 2 + 1) * MTOT * 8, (PG8_LAS float*)(F.lds + LDSCTL_OFF + 256)}; GEMM_CALL(pg8::EpiResN, E, ar + FA_O, WB + FW_OUT, MC, DM, DM, DM, DM, (int)blockIdx.x); } PH_END
            } else {
                PH_BEGIN { pg8::EpiBf16R E = epi1((bf16*)(ar + NA_Q), 9216);
                    E.T.base[1] = (bf16*)(ar + NA_KC); E.T.ldc[1] = 192; E.T.t0[1] = 36; E.T.gw[1] = 192;
                    E.T.base[2] = (bf16*)(ar + NA_VC); E.T.ldc[2] = 128; E.T.t0[2] = 39; E.T.gw[2] = 128;
                    E.T.base[3] = (bf16*)(ar + NA_KSR); E.T.ldc[3] = 768; E.T.t0[3] = 41;
                    E.T.base[4] = (bf16*)(ar + NA_KWR); E.T.ldc[4] = 768; E.T.t0[4] = 44;
                    E.T.base[5] = (bf16*)(ar + NA_GT); E.T.ldc[5] = 256; E.T.t0[5] = 47;
                    E.T.base[6] = (bf16*)(ar + NA_VSR); E.T.ldc[6] = 512; E.T.t0[6] = 48;
                    E.T.base[7] = (bf16*)(ar + NA_VWR); E.T.ldc[7] = 512; E.T.t0[7] = 50; E.T.nseg = 8; E.ssp = SSB + (size_t)(LAYER * 2) * MTOT * 8; E.ss_off = roff;
                    GEMM_CALL(pg8::EpiBf16R, E, XN + (size_t)roff * DM, WB + NW_IN, MC, 13312, DM, DM, DM, (int)blockIdx.x); } PH_END
                PH_BEGIN ph_nsa_rope(F, half); PH_END
                PH_BEGIN {
                    const float* BIAS = (const float*)(args.ws + WS_MISC);
                    { pg8::EpiGelu E{(bf16*)(ar + NA_GK), 256, BIAS}; GEMM_CALL(pg8::EpiGelu, E, ar + NA_KC, WB + NW_W1K, 4096, 256, 6144, 3072, 6144, (int)blockIdx.x); }
                    { pg8::EpiGelu E{(bf16*)(ar + NA_GV), 256, BIAS + 256}; GEMM_CALL(pg8::EpiGelu, E, ar + NA_VC, WB + NW_W1V, 4096, 256, 4096, 2048, 4096, (int)((blockIdx.x + F.G - 16) % F.G)); }
                } PH_END
                PH_BEGIN {
                    { pg8::EpiBf16R E = epi1((bf16*)(ar + NA_KCMP), 12); E.T.gw[0] = -1; GEMM_CALL(pg8::EpiBf16R, E, ar + NA_GK, WB + NW_W2K, 4096, 256, 256, 256, 256, (int)blockIdx.x); }
                    { pg8::EpiBf16R E = epi1((bf16*)(ar + NA_VCT), 4); E.T.gw[0] = -2; GEMM_CALL(pg8::EpiBf16R, E, WB + NW_W2V, ar + NA_GV, 256, 4096, 256, 256, 256, (int)((blockIdx.x + F.G - 16) % F.G)); }
                } PH_END
                PH_BEGIN ph_nsa_cmp(F, half); PH_END
                PH_BEGIN ph_nsa_sel(F, half); PH_END
                PH_BEGIN ph_nsa_win(F, half); PH_END
                PH_BEGIN { pg8::EpiResN E{LAYER == 0 ? args.in[0] : nullptr, args.in[ib], nullptr, DM, roff, args.in[iff], (pg8::bf16_t*)XN, SSB + (size_t)(LAYER * 2 + 1) * MTOT * 8, (PG8_LAS float*)(F.lds + LDSCTL_OFF + 256)}; GEMM_CALL(pg8::EpiResN, E, ar + NA_O, WB + NW_OUT, MC, DM, 6144, 6144, 6144, (int)blockIdx.x); } PH_END
            }
}
template <int LAYER> DI void run_ffn(const Args& args, LAS unsigned char* lds, volatile LAS unsigned* MISC, int& ph, const int lo, const int hi) {
    constexpr int ib = (LAYER == 0) ? 2 : (LAYER == 1) ? 17 : (LAYER == 2) ? 26 : 42;
    constexpr int iff = (LAYER == 0) ? 12 : (LAYER == 1) ? 21 : (LAYER == 2) ? 37 : 52;
    PH_BEGIN {
        LAS float* rt = (LAS float*)(F.lds + LDSCTL_OFF + 256 + 8192); const int rbase = 4096 * (int)(blockIdx.x & 7); const float* ssq = SSB + (size_t)(LAYER * 2 + 1) * MTOT * 8;
        for (int i = F.tid; i < 4096; i += NWAVES * 64) rt[i] = pg8::rms_rowscale(ssq, rbase + i);
        __syncthreads();
        pg8::EpiConvGlu E{(pg8::bf16_t*)ar, (float*)(ar + 352 * MiB), args.in[iff + 2], args.in[iff + 3], (PG8_LAS float*)(F.lds + LDSCTL_OFF + 256), DFF, (const PG8_LAS float*)rt, rbase};
        GEMM_CALL(pg8::EpiConvGlu, E, XN, WUP, MTOT, 2 * DFF, DM, DM, DM, (int)blockIdx.x); } PH_END
    PH_BEGIN ph_conv_fix(F, (const float*)(ar + 352 * MiB), (bf16*)ar, args.in[iff + 2], args.in[iff + 3], MTOT); PH_END
    PH_BEGIN {
        if constexpr (LAYER < 3) { constexpr int ibn = (LAYER == 0) ? 17 : (LAYER == 1) ? 26 : 42;
            pg8::EpiResN E{nullptr, args.in[iff], nullptr, DM, 0, args.in[ibn], (pg8::bf16_t*)XN, SSB + (size_t)((LAYER + 1) * 2) * MTOT * 8, (PG8_LAS float*)(F.lds + LDSCTL_OFF + 256)}; GEMM_CALL(pg8::EpiResN, E, ar, WDN, MTOT, DM, DFF, DFF, DFF, (int)blockIdx.x); }
        else { pg8::EpiResN E{nullptr, args.in[iff], out, DM, 0, nullptr, (pg8::bf16_t*)XN, nullptr, (PG8_LAS float*)(F.lds + LDSCTL_OFF + 256)}; GEMM_CALL(pg8::EpiResN, E, ar, WDN, MTOT, DM, DFF, DFF, DFF, (int)blockIdx.x); }
    } PH_END
}
__global__ void __launch_bounds__(NWAVES * 64, 2) mk_fwd(Args args) {
    extern __shared__ __attribute__((aligned(16))) unsigned char lds_[];
    LAS unsigned char* const lds = (LAS unsigned char*)lds_;
    volatile LAS unsigned* MISC = (volatile LAS unsigned*)(lds + LDSCTL_OFF);
    for (int u = threadIdx.x; u < 64; u += NWAVES * 64) ((LAS unsigned*)(lds + LDSCTL_OFF))[u] = 0u;
    __syncthreads();
    const int lo = args.ph_lo, hi = args.ph_hi;
    (void)xcd_barrier_post((unsigned*)(args.ws + WS_CTL) + CW_BAR, MISC + 8);
    int ph = 0;
    { constexpr int ib = 2, iff = 12; PH_BEGIN ph_tables(F, (const int*)args.in[1]); ph_norm_first(F, args.in[0], args.in[2], XN, SSB); PH_END }
    run_cvt<0>(args, lds, MISC, ph, lo, hi); run_half<0, 0>(args, lds, MISC, ph, lo, hi); run_half<0, 1>(args, lds, MISC, ph, lo, hi); run_ffn<0>(args, lds, MISC, ph, lo, hi);
    run_cvt<1>(args, lds, MISC, ph, lo, hi); run_half<1, 0>(args, lds, MISC, ph, lo, hi); run_half<1, 1>(args, lds, MISC, ph, lo, hi); run_ffn<1>(args, lds, MISC, ph, lo, hi);
    run_cvt<2>(args, lds, MISC, ph, lo, hi); run_half<2, 0>(args, lds, MISC, ph, lo, hi); run_half<2, 1>(args, lds, MISC, ph, lo, hi); run_ffn<2>(args, lds, MISC, ph, lo, hi);
    run_cvt<3>(args, lds, MISC, ph, lo, hi); run_half<3, 0>(args, lds, MISC, ph, lo, hi); run_half<3, 1>(args, lds, MISC, ph, lo, hi); run_ffn<3>(args, lds, MISC, ph, lo, hi);
    { constexpr int ib = 42, iff = 52; PH_BEGIN ph_final_norm(F, out, args.in[57]); PH_END }
}
extern "C" void kernel_launch(void* const* d_in, const int* in_sizes, int n_in, void* d_out, int out_size, void* d_ws, size_t ws_size, hipStream_t stream) {
    static int grid = 0;
    if (grid == 0) {
        if (n_in != 58 || out_size != MTOT * DM || ws_size < WS_END) { fprintf(stderr, "kernel_launch: unexpected shapes (n_in %d, out %d, ws %zu)\n", n_in, out_size, ws_size); grid = -1; return; }
        int dev = 0, cus = 0;
        if (hipGetDevice(&dev) != hipSuccess || hipDeviceGetAttribute(&cus, hipDeviceAttributeMultiprocessorCount, dev) != hipSuccess) { grid = -1; return; }
        if (hipFuncSetAttribute((const void*)mk_fwd, hipFuncAttributeMaxDynamicSharedMemorySize, LDS_BYTES) != hipSuccess) { fprintf(stderr, "kernel_launch: hipFuncSetAttribute failed\n"); grid = -1; return; }
        int per_cu = 0;
        (void)hipOccupancyMaxActiveBlocksPerMultiprocessor(&per_cu, (const void*)mk_fwd, NWAVES * 64, LDS_BYTES);
        (void)hipGetLastError();
        grid = cus;
    }
    if (grid < 0) return;
    if (hipMemsetAsync((char*)d_ws + WS_CTL, 0, CTL_ZERO_BYTES, stream) != hipSuccess) return;
    Args a{};
    for (int i = 0; i < 58; ++i) a.in[i] = (const float*)d_in[i];
    a.out = (float*)d_out; a.ws = (unsigned char*)d_ws;
#if MK_ONE_LAUNCH
    a.ph_lo = 0; a.ph_hi = NPH;
    hipLaunchKernelGGL(mk_fwd, dim3(grid), dim3(NWAVES * 64), LDS_BYTES, stream, a);
#else
    for (int p = 0; p < NPH; ++p) { a.ph_lo = p; a.ph_hi = p + 1; hipLaunchKernelGGL(mk_fwd, dim3(grid), dim3(NWAVES * 64), LDS_BYTES, stream, a); }
#endif
}
```

```cpp
#include <hip/hip_runtime.h>
#include <cstdio>
#include <cstdint>
#define DI __device__ __forceinline__
namespace pg8 {
#define PG8_LAS __attribute__((address_space(3)))
typedef unsigned short bf16_t;
typedef short bf16x8 __attribute__((ext_vector_type(8)));
typedef float f32x4 __attribute__((ext_vector_type(4)));
typedef unsigned u32x4 __attribute__((ext_vector_type(4)));
constexpr int BM = 256, BK = 64, HALF = 128, HTB = HALF * BK * 2  , STAGE_BYTES = 8 * HTB, NXCD = 8, WGM = 8;

__host__ __device__ __forceinline__ int lds_byte(int r, int c) { const int st = (r >> 4) * 2 + (c >> 5), rr = r & 15, cc = c & 31, ob = rr * 64 + cc * 2; return st * 1024 + (ob ^ (((ob >> 9) & 1) << 5)); }
__host__ __device__ __forceinline__ void stage_rc(int b, int& R, int& C) { const int st = b / 1024, sb = b % 1024, swz = sb ^ (((sb >> 9) & 1) << 5); R = (st >> 1) * 16 + swz / 64; C = (st & 1) * 32 + (swz % 64) / 2; }
__host__ __device__ __forceinline__ int perm32(int rho) { const int n = rho >> 4, i = rho & 15; return 8 * (i >> 2) + 4 * n + (i & 3); }

struct Unit { int pm, pn; };
struct Gemm { const bf16_t* A; const bf16_t* Bt; int M, N, K, lda, ldb, akoff; };

struct StaticOrder {
    int nM, nN, nwg, G, c;
    __host__ __device__ void init(int M, int N, int G_, int c_) { nM = M / BM; nN = N / BM; nwg = nM * nN; G = G_; c = c_; }
    __host__ __device__ bool next(int i, Unit& u) const {
        const long L = (long)i * G + c; if (L >= nwg) return false;
        int wgid = (int)L; { const int q = nwg / NXCD, r = nwg % NXCD, xcd = wgid % NXCD, off = wgid / NXCD; wgid = (xcd < r ? xcd * (q + 1) : r * (q + 1) + (xcd - r) * q) + off; }
        const int nig = WGM * nN, gid = wgid / nig, fm = gid * WGM, gsz = (nM - fm) < WGM ? (nM - fm) : WGM;
        u.pm = fm + ((wgid % nig) % gsz); u.pn = (wgid % nig) / gsz; return true;
    }
    __device__ __forceinline__ void a_ready(const Unit&) const {}
    __device__ __forceinline__ void done(const Unit&) const {}
};
__device__ __forceinline__ unsigned cvt_pk_bf16(float lo, float hi) { unsigned r; asm volatile("v_cvt_pk_bf16_f32 %0, %1, %2" : "=v"(r) : "v"(lo), "v"(hi)); return r; }
template <class Epi, class Sched, bool ALIGN_EPI = false, bool SP2 = false>
__device__ __forceinline__ void gemm_phase(PG8_LAS unsigned char* lds, const Gemm g, const Sched& S, const Epi& E) {
    const int tid = threadIdx.x, wid = __builtin_amdgcn_readfirstlane(tid >> 6), lane = tid & 63, wr = wid >> 2, wc = wid & 3, fr = lane & 15, fq = lane >> 4;
    const int K = g.K, nt = K / BK;
    unsigned voffA[2], voffB[2];
#pragma unroll
    for (int i = 0; i < 2; ++i) { int R, C; stage_rc(tid * 16 + i * 8192, R, C); const int Rb = Epi::PERM ? ((R & ~31) + perm32(R & 31)) : R;
        voffA[i] = (unsigned)(R * g.lda + C) * 2u; voffB[i] = (unsigned)(Rb * g.ldb + C) * 2u; }
    const size_t kstep = (size_t)(BK * 2);
    const size_t hstepA = (size_t)HALF * g.lda * 2, hstepB = (size_t)HALF * g.ldb * 2;
    const size_t tstepA = 2 * hstepA, tstepB = 2 * hstepB;
    const unsigned ldsw = (unsigned)wid * 1024u;
    const int aoff = lds_byte(wr * 64 + fr, fq * 8), boff = lds_byte(wc * 32 + fr, fq * 8);
#define PG8_SA(b, h) (((b) * 2 + (h)) * HTB)
#define PG8_SB(b, h) ((4 + (b) * 2 + (h)) * HTB)
#define PG8_STAGE(bufoff, gbase, voff) do { _Pragma("unroll") for (int _i = 0; _i < 2; ++_i) \
        __builtin_amdgcn_global_load_lds((const unsigned*)((const char*)(gbase) + (voff)[_i]), (PG8_LAS unsigned*)(lds + (bufoff) + ldsw + _i * 8192), 16, 0, 0); } while (0)
#define PG8_LDA(dst, b, h) do { _Pragma("unroll") for (int m = 0; m < 4; ++m) _Pragma("unroll") for (int k = 0; k < 2; ++k) dst[m][k] = *(const PG8_LAS bf16x8*)(lds + PG8_SA(b, h) + aoff + m * 2048 + k * 1024); } while (0)
#define PG8_LDB(dst, b, h) do { _Pragma("unroll") for (int n = 0; n < 2; ++n) _Pragma("unroll") for (int k = 0; k < 2; ++k) dst[n][k] = *(const PG8_LAS bf16x8*)(lds + PG8_SB(b, h) + boff + n * 2048 + k * 1024); } while (0)
#define PG8_MMA(ai, bj, At, Bt) do { __builtin_amdgcn_s_setprio(1); _Pragma("unroll") for (int m = 0; m < 4; ++m) _Pragma("unroll") for (int n = 0; n < 2; ++n) _Pragma("unroll") for (int k = 0; k < 2; ++k) \
        acc[ai][bj][m][n] = __builtin_amdgcn_mfma_f32_16x16x32_bf16(Bt[n][k], At[m][k], acc[ai][bj][m][n], 0, 0, 0); __builtin_amdgcn_s_setprio(0); } while (0)
#define PG8_WAIT_V(n) asm volatile("s_waitcnt vmcnt(" #n ")" ::: "memory")
#define PG8_WAIT_L(n) asm volatile("s_waitcnt lgkmcnt(" #n ")" ::: "memory")
#define PG8_BAR __builtin_amdgcn_s_barrier()
#define PG8_SCHED __builtin_amdgcn_sched_barrier(0)
    Unit cur, nxt; int ui = 0;
    if (!S.next(0, cur)) return;
    f32x4 acc[2][2][4][2];
#pragma unroll
    for (int a = 0; a < 2; ++a)
#pragma unroll
        for (int b = 0; b < 2; ++b)
#pragma unroll
            for (int m = 0; m < 4; ++m)
#pragma unroll
                for (int n = 0; n < 2; ++n) acc[a][b][m][n] = (f32x4){0.f, 0.f, 0.f, 0.f};
    bf16x8 At[4][2], B0[2][2], B1[2][2];
    const char* cA = (const char*)g.A + (size_t)cur.pm * tstepA + (size_t)cur.pn * g.akoff * 2; const char* cB = (const char*)g.Bt + (size_t)cur.pn * tstepB;
    S.a_ready(cur);
    if constexpr (SP2) {
        PG8_STAGE(PG8_SB(0, 0), cB, voffB); PG8_STAGE(PG8_SB(0, 1), cB + hstepB, voffB); PG8_STAGE(PG8_SA(0, 0), cA, voffA); PG8_STAGE(PG8_SA(0, 1), cA + hstepA, voffA);
        if (wr == 1) PG8_BAR;
        PG8_WAIT_V(2); PG8_BAR;
        PG8_STAGE(PG8_SB(1, 0), cB + kstep, voffB); PG8_STAGE(PG8_SA(1, 0), cA + kstep, voffA); PG8_STAGE(PG8_SB(1, 1), cB + hstepB + kstep, voffB);
        PG8_WAIT_V(6); PG8_BAR;
    } else {
        PG8_STAGE(PG8_SB(0, 0), cB, voffB); PG8_STAGE(PG8_SA(0, 0), cA, voffA); PG8_STAGE(PG8_SB(0, 1), cB + hstepB, voffB); PG8_STAGE(PG8_SA(0, 1), cA + hstepA, voffA);
        if (wr == 1) PG8_BAR;
        PG8_WAIT_V(4); PG8_BAR;
        PG8_STAGE(PG8_SB(1, 0), cB + kstep, voffB); PG8_STAGE(PG8_SA(1, 0), cA + kstep, voffA); PG8_STAGE(PG8_SB(1, 1), cB + hstepB + kstep, voffB);
        PG8_WAIT_V(6); PG8_BAR;
    }
    for (;;) {
        const bool has_next = S.next(ui + 1, nxt);
        const char* nA = has_next ? (const char*)g.A + (size_t)nxt.pm * tstepA + (size_t)nxt.pn * g.akoff * 2 : cA; const char* nB = has_next ? (const char*)g.Bt + (size_t)nxt.pn * tstepB : cB;
        for (int t = 0; t < nt; t += 2) {
            const bool last = (t == nt - 2);
            const char* a1 = cA + (size_t)(t + 1) * kstep;
            const char* a2 = last ? nA : cA + (size_t)(t + 2) * kstep; const char* b2 = last ? nB : cB + (size_t)(t + 2) * kstep;
            const char* a3 = a2 + kstep; const char* b3 = b2 + kstep;
            if (last && has_next) S.a_ready(nxt);
            if constexpr (SP2) {
            PG8_LDB(B0, 0, 0); PG8_LDB(B1, 0, 1); PG8_SCHED; PG8_LDA(At, 0, 0); PG8_STAGE(PG8_SA(1, 1), a1 + hstepA, voffA);
            PG8_WAIT_V(8); PG8_WAIT_L(0); PG8_BAR; PG8_MMA(0, 0, At, B0); PG8_MMA(0, 1, At, B1); PG8_BAR; PG8_SCHED;
            PG8_LDA(At, 0, 1); PG8_STAGE(PG8_SB(0, 0), b2, voffB); PG8_STAGE(PG8_SB(0, 1), b2 + hstepB, voffB); PG8_STAGE(PG8_SA(0, 0), a2, voffA);
            PG8_WAIT_V(8); PG8_WAIT_L(0); PG8_BAR; PG8_MMA(1, 0, At, B0); PG8_MMA(1, 1, At, B1); PG8_BAR; PG8_SCHED;
            PG8_LDB(B0, 1, 0); PG8_LDB(B1, 1, 1); PG8_SCHED; PG8_LDA(At, 1, 0); PG8_STAGE(PG8_SA(0, 1), a2 + hstepA, voffA);
            PG8_WAIT_V(8); PG8_WAIT_L(0); PG8_BAR; PG8_MMA(0, 0, At, B0); PG8_MMA(0, 1, At, B1); PG8_BAR; PG8_SCHED;
            PG8_LDA(At, 1, 1); PG8_STAGE(PG8_SB(1, 0), b3, voffB); PG8_STAGE(PG8_SB(1, 1), b3 + hstepB, voffB); PG8_STAGE(PG8_SA(1, 0), a3, voffA);
            PG8_WAIT_V(8); PG8_WAIT_L(0); PG8_BAR; PG8_MMA(1, 0, At, B0); PG8_MMA(1, 1, At, B1); PG8_BAR; PG8_SCHED;
            } else {
            PG8_LDB(B0, 0, 0); PG8_SCHED; PG8_LDA(At, 0, 0); PG8_STAGE(PG8_SA(1, 1), a1 + hstepA, voffA);
            PG8_WAIT_L(8); PG8_BAR; PG8_WAIT_L(0); PG8_MMA(0, 0, At, B0); PG8_BAR; PG8_SCHED;
            PG8_LDB(B1, 0, 1); PG8_STAGE(PG8_SB(0, 0), b2, voffB);
            PG8_BAR; PG8_WAIT_L(0); PG8_MMA(0, 1, At, B1); PG8_BAR;
            PG8_LDA(At, 0, 1); PG8_STAGE(PG8_SA(0, 0), a2, voffA);
            PG8_BAR; PG8_WAIT_L(0); PG8_MMA(1, 0, At, B0); PG8_BAR; PG8_SCHED;
            PG8_STAGE(PG8_SB(0, 1), b2 + hstepB, voffB);
            PG8_WAIT_V(6); PG8_BAR; PG8_MMA(1, 1, At, B1); PG8_BAR;
            PG8_LDB(B0, 1, 0); PG8_SCHED; PG8_LDA(At, 1, 0); PG8_STAGE(PG8_SA(0, 1), a2 + hstepA, voffA);
            PG8_WAIT_L(8); PG8_BAR; PG8_WAIT_L(0); PG8_MMA(0, 0, At, B0); PG8_BAR; PG8_SCHED;
            PG8_LDB(B1, 1, 1); PG8_STAGE(PG8_SB(1, 0), b3, voffB);
            PG8_BAR; PG8_WAIT_L(0); PG8_MMA(0, 1, At, B1); PG8_BAR;
            PG8_LDA(At, 1, 1); PG8_STAGE(PG8_SA(1, 0), a3, voffA);
            PG8_BAR; PG8_WAIT_L(0); PG8_MMA(1, 0, At, B0); PG8_BAR; PG8_SCHED;
            PG8_STAGE(PG8_SB(1, 1), b3 + hstepB, voffB);
            PG8_WAIT_V(6); PG8_BAR; PG8_MMA(1, 1, At, B1); PG8_BAR;
            }
        }
        if constexpr (ALIGN_EPI) { if (wr == 0) PG8_BAR; }
        if constexpr (!Epi::AFTER_DRAIN) { E(acc, cur, wr, wc, fr, fq); S.done(cur); }
        if (!has_next) break;
#pragma unroll
        for (int a = 0; a < 2; ++a)
#pragma unroll
            for (int b = 0; b < 2; ++b)
#pragma unroll
                for (int m = 0; m < 4; ++m)
#pragma unroll
                    for (int n = 0; n < 2; ++n) acc[a][b][m][n] = (f32x4){0.f, 0.f, 0.f, 0.f};
        cur = nxt; cA = nA; cB = nB; ++ui;
        if constexpr (ALIGN_EPI) { if (wr == 1) PG8_BAR; }
    }
    PG8_WAIT_V(0);
    if constexpr (!ALIGN_EPI) { if (wr == 0) PG8_BAR; }
    PG8_BAR;
    if constexpr (Epi::AFTER_DRAIN) { E.fused(acc, cur, wr, wc, fr, fq, lds, wid, lane); S.done(cur); }
#undef PG8_SA
#undef PG8_SB
#undef PG8_STAGE
#undef PG8_LDA
#undef PG8_LDB
#undef PG8_MMA
#undef PG8_WAIT_V
#undef PG8_WAIT_L
#undef PG8_BAR
#undef PG8_SCHED
}
}
namespace pg8 {
typedef float f32x2 __attribute__((ext_vector_type(2)));
__device__ __forceinline__ float rms_rowscale(const float* ssq, int row) { const f32x4 a = *(const f32x4*)(ssq + (size_t)row * 8), b = *(const f32x4*)(ssq + (size_t)row * 8 + 4);
    return __builtin_amdgcn_rsqf((((a[0] + a[1]) + (a[2] + a[3])) + ((b[0] + b[1]) + (b[2] + b[3]))) * (1.0f / 2048.0f) + 1e-6f); }
struct SegTab { bf16_t* base[8]; int ldc[8]; int t0[8]; int gw[8]; int nseg; int pad_; };
struct EpiBf16R {
    static constexpr bool PERM = true, AFTER_DRAIN = false;
    SegTab T; const float* ssp; int ss_off;
    __device__ __forceinline__ void operator()(const f32x4 (&acc)[2][2][4][2], const Unit& u, int wr, int wc, int fr, int fq) const {
        bf16_t* base = T.base[0]; int ldc = T.ldc[0], gw = T.gw[0], t0 = T.t0[0];
#pragma unroll
        for (int s = 1; s < 8; ++s) if (s < T.nseg && u.pn >= T.t0[s]) { base = T.base[s]; ldc = T.ldc[s]; gw = T.gw[s]; t0 = T.t0[s]; }
        const int colt = (u.pn - t0) * BM, row0 = u.pm * BM + wr * 64 + fr;
#pragma unroll
        for (int ai = 0; ai < 2; ++ai)
#pragma unroll
            for (int m = 0; m < 4; ++m) { const int row = row0 + ai * HALF + m * 16;
                const float rs = ssp ? rms_rowscale(ssp, ss_off + row) : 1.0f;
#pragma unroll
                for (int bj = 0; bj < 2; ++bj) { const int col = colt + bj * HALF + wc * 32 + 8 * fq;
                    const f32x4 v0 = acc[ai][bj][m][0] * rs, v1 = acc[ai][bj][m][1] * rs;
                    u32x4 w; w.x = cvt_pk_bf16(v0[0], v0[1]); w.y = cvt_pk_bf16(v0[2], v0[3]); w.z = cvt_pk_bf16(v1[0], v1[1]); w.w = cvt_pk_bf16(v1[2], v1[3]);
                    if (gw == -2) {
                        if ((row >> 5) < ldc) { bf16_t* d0 = base + ((size_t)(((col >> 5) * ldc + (row >> 5)) * 2 + ((col >> 4) & 1)) * 64 + (row & 31)) * 8 + 4 * ((col >> 3) & 1);
                            typedef unsigned u32x2_ __attribute__((ext_vector_type(2)));
                            *(u32x2_*)d0 = (u32x2_){w.x, w.y}; *(u32x2_*)(d0 + 32 * 8) = (u32x2_){w.z, w.w}; }
                        continue; }
                    bf16_t* dst;
                    if (gw == 0) dst = base + (size_t)row * ldc + col;
                    else if (gw == -1) { if ((col >> 4) >= ldc) continue; dst = base + ((size_t)((row >> 5) * ldc + (col >> 4)) * 64 + ((col >> 3) & 1) * 32 + (row & 31)) * 8; }
                    else { const int g = col / gw, d = col - g * gw; dst = base + ((size_t)((row >> 12) * 4 + g) * 4096 + (row & 4095)) * gw + d; }
                    *(u32x4*)dst = w; } }
    }
};
struct EpiGelu {
    static constexpr bool PERM = true, AFTER_DRAIN = false;
    bf16_t* O; int ldc; const float* bias;
    static __device__ __forceinline__ float gelu(float x) { const float u2 = 1.5957691216f * (x + 0.044715f * x * x * x); const float e = __builtin_amdgcn_exp2f(-u2 * 1.4426950409f); return x * __builtin_amdgcn_rcpf(1.0f + e); }
    __device__ __forceinline__ void operator()(const f32x4 (&acc)[2][2][4][2], const Unit& u, int wr, int wc, int fr, int fq) const {
        const int row0 = u.pm * BM + wr * 64 + fr, col0 = u.pn * BM + wc * 32 + 8 * fq;
#pragma unroll
        for (int bj = 0; bj < 2; ++bj) { const f32x4 b0 = *(const f32x4*)(bias + col0 + bj * HALF), b1 = *(const f32x4*)(bias + col0 + bj * HALF + 4);
#pragma unroll
            for (int ai = 0; ai < 2; ++ai)
#pragma unroll
                for (int m = 0; m < 4; ++m) { const f32x4 v0 = acc[ai][bj][m][0] + b0, v1 = acc[ai][bj][m][1] + b1;
                    u32x4 w; w.x = cvt_pk_bf16(gelu(v0[0]), gelu(v0[1])); w.y = cvt_pk_bf16(gelu(v0[2]), gelu(v0[3])); w.z = cvt_pk_bf16(gelu(v1[0]), gelu(v1[1])); w.w = cvt_pk_bf16(gelu(v1[2]), gelu(v1[3]));
                    *(u32x4*)(O + (size_t)(row0 + ai * HALF + m * 16) * ldc + col0 + bj * HALF) = w; } }
    }
};
struct EpiF32 {
    static constexpr bool PERM = false, AFTER_DRAIN = false;
    float* C; int ldc; const float* ssp; int ss_off;
    __device__ __forceinline__ void operator()(const f32x4 (&acc)[2][2][4][2], const Unit& u, int wr, int wc, int fr, int fq) const {
        const int row0 = u.pm * BM + wr * 64 + fr, col0 = u.pn * BM + wc * 32 + 4 * fq;
#pragma unroll
        for (int ai = 0; ai < 2; ++ai)
#pragma unroll
            for (int m = 0; m < 4; ++m) { float* rowp = C + (size_t)(row0 + ai * HALF + m * 16) * ldc + col0;
                const float rs = ssp ? rms_rowscale(ssp, ss_off + row0 + ai * HALF + m * 16) : 1.0f;
#pragma unroll
                for (int bj = 0; bj < 2; ++bj)
#pragma unroll
                    for (int n = 0; n < 2; ++n) *(f32x4*)(rowp + bj * HALF + n * 16) = acc[ai][bj][m][n] * rs; }
    }
};
struct EpiRes {
    static constexpr bool PERM = false, AFTER_DRAIN = false;
    const float* res; float* out; int ldc; int row_off;
    __device__ __forceinline__ void operator()(const f32x4 (&acc)[2][2][4][2], const Unit& u, int wr, int wc, int fr, int fq) const {
        const int row0 = row_off + u.pm * BM + wr * 64 + fr, col0 = u.pn * BM + wc * 32 + 4 * fq;
#pragma unroll
        for (int ai = 0; ai < 2; ++ai)
#pragma unroll
            for (int m = 0; m < 4; ++m) { const size_t off = (size_t)(row0 + ai * HALF + m * 16) * ldc + col0;
                f32x4 r[2][2];
#pragma unroll
                for (int bj = 0; bj < 2; ++bj)
#pragma unroll
                    for (int n = 0; n < 2; ++n) r[bj][n] = *(const f32x4*)(res + off + bj * HALF + n * 16);
#pragma unroll
                for (int bj = 0; bj < 2; ++bj)
#pragma unroll
                    for (int n = 0; n < 2; ++n) *(f32x4*)(out + off + bj * HALF + n * 16) = r[bj][n] + acc[ai][bj][m][n];
                asm volatile("" ::: "memory"); }
    }
};
struct EpiDry {
    static constexpr bool PERM = false, AFTER_DRAIN = false;
    float* D;
    __device__ __forceinline__ void operator()(const f32x4 (&acc)[2][2][4][2], const Unit& u, int wr, int wc, int fr, int fq) const {
        float* p = D + ((size_t)blockIdx.x * 512 + threadIdx.x) * 64;
#pragma unroll
        for (int ai = 0; ai < 2; ++ai)
#pragma unroll
            for (int m = 0; m < 4; ++m)
#pragma unroll
                for (int bj = 0; bj < 2; ++bj) *(f32x4*)(p + ((ai * 4 + m) * 2 + bj) * 4) = acc[ai][bj][m][0] + acc[ai][bj][m][1];
    }
};
struct EpiResN {
    static constexpr bool PERM = false, AFTER_DRAIN = false;
    const float* res32; const float* gprev; float* out32; int ldc; int row_off; const float* g; bf16_t* xn; float* ss; PG8_LAS float* xb;
    __device__ __forceinline__ void operator()(const f32x4 (&acc)[2][2][4][2], const Unit& u, int wr, int wc, int fr, int fq) const {
        typedef unsigned u32x2_ __attribute__((ext_vector_type(2)));
        const int row0 = row_off + u.pm * BM + wr * 64 + fr, col0 = u.pn * BM + wc * 32 + 4 * fq;
        f32x4 gv[2][2], gi[2][2];
#pragma unroll
        for (int bj = 0; bj < 2; ++bj)
#pragma unroll
            for (int n = 0; n < 2; ++n) { gv[bj][n] = g ? *(const f32x4*)(g + col0 + bj * HALF + n * 16) : (f32x4){0.f, 0.f, 0.f, 0.f};
                if (!res32) { const f32x4 t = *(const f32x4*)(gprev + col0 + bj * HALF + n * 16); gi[bj][n] = (f32x4){1.0f / t[0], 1.0f / t[1], 1.0f / t[2], 1.0f / t[3]}; } else gi[bj][n] = (f32x4){1.f, 1.f, 1.f, 1.f}; }
#pragma unroll
        for (int ai = 0; ai < 2; ++ai)
#pragma unroll
            for (int m = 0; m < 4; ++m) { const int row = row0 + ai * HALF + m * 16; const size_t off = (size_t)row * ldc + col0;
                f32x4 r[2][2]; float sq = 0.f;
#pragma unroll
                for (int bj = 0; bj < 2; ++bj)
#pragma unroll
                    for (int n = 0; n < 2; ++n) {
                        if (res32) r[bj][n] = *(const f32x4*)(res32 + off + bj * HALF + n * 16);
                        else { const u32x2_ w = *(const u32x2_*)(xn + off + bj * HALF + n * 16);
                            r[bj][n] = (f32x4){__builtin_bit_cast(float, w.x << 16), __builtin_bit_cast(float, w.x & 0xffff0000u), __builtin_bit_cast(float, w.y << 16), __builtin_bit_cast(float, w.y & 0xffff0000u)} * gi[bj][n]; } }
#pragma unroll
                for (int bj = 0; bj < 2; ++bj)
#pragma unroll
                    for (int n = 0; n < 2; ++n) { const f32x4 o = r[bj][n] + acc[ai][bj][m][n];
                        if (out32) *(f32x4*)(out32 + off + bj * HALF + n * 16) = o;
                        if (g) { sq += (o[0] * o[0] + o[1] * o[1]) + (o[2] * o[2] + o[3] * o[3]);
                            const f32x4 y = o * gv[bj][n]; *(u32x2_*)(xn + off + bj * HALF + n * 16) = (u32x2_){cvt_pk_bf16(y[0], y[1]), cvt_pk_bf16(y[2], y[3])}; } }
                if (g) { sq += __shfl_xor(sq, 16); sq += __shfl_xor(sq, 32);
                    if (fq == 0) xb[(ai * HALF + wr * 64 + m * 16 + fr) * 4 + wc] = sq; }
                asm volatile("" ::: "memory"); }
        if (g) {
            asm volatile("s_waitcnt lgkmcnt(0)" ::: "memory"); __builtin_amdgcn_s_barrier(); asm volatile("" ::: "memory");
            const int t = (wr * 4 + wc) * 64 + fq * 16 + fr;
            if (t < BM) { const f32x4 v = *(const PG8_LAS f32x4*)(xb + t * 4); ss[(size_t)(row_off + u.pm * BM + t) * 8 + u.pn] = (v[0] + v[1]) + (v[2] + v[3]); }
        }
    }
};
struct EpiConvGlu {
    static constexpr bool PERM = true, AFTER_DRAIN = false;
    bf16_t* G; float* UB; const float* cw; const float* cb; PG8_LAS float* xb; int dff; const PG8_LAS float* rstd; int rbase;
    static __device__ __forceinline__ float shr(float old, float src, int n) { const int o = __builtin_bit_cast(int, old), s = __builtin_bit_cast(int, src);
        return __builtin_bit_cast(float, n == 1 ? __builtin_amdgcn_update_dpp(o, s, 0x111, 0xf, 0xf, false) : __builtin_amdgcn_update_dpp(o, s, 0x112, 0xf, 0xf, false)); }
    static __device__ __forceinline__ float ror(float src, int n) { const int s = __builtin_bit_cast(int, src);
        return __builtin_bit_cast(float, n == 1 ? __builtin_amdgcn_update_dpp(0, s, 0x121, 0xf, 0xf, false) : __builtin_amdgcn_update_dpp(0, s, 0x122, 0xf, 0xf, false)); }
    __device__ __forceinline__ void operator()(f32x4 (&acc)[2][2][4][2], const Unit& u, int wr, int wc, int fr, int fq) const {
        typedef unsigned u32x2_ __attribute__((ext_vector_type(2)));
        if (rstd) {
#pragma unroll
            for (int ai = 0; ai < 2; ++ai)
#pragma unroll
                for (int m = 0; m < 4; ++m) { const float rs = rstd[u.pm * BM + ai * HALF + wr * 64 + m * 16 + fr - rbase];
#pragma unroll
                    for (int bj = 0; bj < 2; ++bj)
#pragma unroll
                        for (int n = 0; n < 2; ++n) acc[ai][bj][m][n] = acc[ai][bj][m][n] * rs; }
        }
        if (fr >= 14) {
#pragma unroll
            for (int ai = 0; ai < 2; ++ai)
#pragma unroll
                for (int bj = 0; bj < 2; ++bj)
#pragma unroll
                    for (int n = 0; n < 2; ++n) *(PG8_LAS f32x4*)(xb + (((((ai * 2 + wr) * 4 + wc) * 2 + (fr - 14)) * 4 + fq) * 16) + (bj * 2 + n) * 4) = acc[ai][bj][3][n];
        }
        { const int ncol = 4 * dff / 2;
          const bool top = (wr == 0 && fr < 2), bot = (wr == 1 && fr >= 14);
          if (top || bot) { float* ub = UB + ((size_t)(u.pm * 4 + (top ? fr : 2 + fr - 14)) * ncol) + u.pn * BM + wc * 32 + 8 * fq;
#pragma unroll
            for (int bj = 0; bj < 2; ++bj)
#pragma unroll
                for (int n = 0; n < 2; ++n) *(f32x4*)(ub + bj * HALF + 4 * n) = top ? acc[0][bj][0][n] : acc[1][bj][3][n]; } }
        asm volatile("s_waitcnt lgkmcnt(0)" ::: "memory"); __builtin_amdgcn_s_barrier(); asm volatile("" ::: "memory");
        u32x2_ res[2][4][2];
        const int ch0 = u.pn * HALF + wc * 32 + 8 * fq;
#pragma unroll
        for (int n = 0; n < 2; ++n) {
            const float* wp = cw + ch0 + 4 * n; const float* bp = cb + ch0 + 4 * n;
            const f32x4 w0g = *(const f32x4*)(wp), w1g = *(const f32x4*)(wp + 2 * dff), w2g = *(const f32x4*)(wp + 4 * dff), bg = *(const f32x4*)(bp);
            const f32x4 w0v = *(const f32x4*)(wp + dff), w1v = *(const f32x4*)(wp + 3 * dff), w2v = *(const f32x4*)(wp + 5 * dff), bv = *(const f32x4*)(bp + dff);
#pragma unroll
            for (int ai = 0; ai < 2; ++ai)
#pragma unroll
                for (int m = 0; m < 4; ++m) {
                    const f32x4 cg = acc[ai][0][m][n], cv = acc[ai][1][m][n];
                    f32x4 b1g, b2g, b1v, b2v;
                    if (m > 0) {
#pragma unroll
                        for (int e = 0; e < 4; ++e) { b1g[e] = ror(acc[ai][0][m - 1][n][e], 1); b2g[e] = ror(acc[ai][0][m - 1][n][e], 2); b1v[e] = ror(acc[ai][1][m - 1][n][e], 1); b2v[e] = ror(acc[ai][1][m - 1][n][e], 2); }
                    } else {
                        const int sai = wr ? ai : ai - 1, swr = wr ? 0 : 1;
                        f32x4 x14g = {0.f, 0.f, 0.f, 0.f}, x15g = x14g, x14v = x14g, x15v = x14g;
                        if (sai >= 0) { const PG8_LAS float* xp = xb + (((((sai * 2 + swr) * 4 + wc) * 2) * 4 + fq) * 16);
                            x14g = *(const PG8_LAS f32x4*)(xp + n * 4); x14v = *(const PG8_LAS f32x4*)(xp + (2 + n) * 4); x15g = *(const PG8_LAS f32x4*)(xp + 64 + n * 4); x15v = *(const PG8_LAS f32x4*)(xp + 64 + (2 + n) * 4); }
                        b1g = x15g; b1v = x15v; b2g = fr == 0 ? x14g : x15g; b2v = fr == 0 ? x14v : x15v;
                    }
                    float o[4];
#pragma unroll
                    for (int e = 0; e < 4; ++e) {
                        const float p1g = shr(b1g[e], cg[e], 1), p2g = shr(b2g[e], cg[e], 2), p1v = shr(b1v[e], cv[e], 1), p2v = shr(b2v[e], cv[e], 2);
                        const float yg = bg[e] + w0g[e] * p2g + w1g[e] * p1g + w2g[e] * cg[e], yv = bv[e] + w0v[e] * p2v + w1v[e] * p1v + w2v[e] * cv[e];
                        o[e] = yg * __builtin_amdgcn_rcpf(1.0f + __builtin_amdgcn_exp2f(-yg * 1.4426950409f)) * yv;
                    }
                    res[ai][m][n] = (u32x2_){cvt_pk_bf16(o[0], o[1]), cvt_pk_bf16(o[2], o[3])};
                }
        }
        const int row0 = u.pm * BM + wr * 64 + fr;
#pragma unroll
        for (int ai = 0; ai < 2; ++ai)
#pragma unroll
            for (int m = 0; m < 4; ++m) *(u32x4*)(G + (size_t)(row0 + ai * HALF + m * 16) * dff + ch0) = (u32x4){res[ai][m][0].x, res[ai][m][0].y, res[ai][m][1].x, res[ai][m][1].y};
    }
};
}
constexpr int BATCH = 8, SEQ = 4096, DM = 2048, MTOT = BATCH * SEQ, MC = MTOT / 2  , BPH = BATCH / 2;
constexpr int DFF = 5632;
constexpr float NORM_EPS = 1e-6f, LOG2E = 1.4426950408889634f;
constexpr int NWAVES = 8;
constexpr size_t MiB = 1u << 20;
constexpr size_t WS_CTL = 0, CTL_ZERO_BYTES = 1 * MiB;
constexpr size_t WS_TAB = 1 * MiB;
constexpr size_t TAB_COS48 = WS_TAB, TAB_SIN48 = WS_TAB + 3 * MiB, TAB_COS32 = WS_TAB + 6 * MiB, TAB_SIN32 = WS_TAB + 8 * MiB;
constexpr size_t WS_WMIX = 12 * MiB;
constexpr size_t WS_WFFN = 100 * MiB;
constexpr size_t WS_MISC = 168 * MiB;
constexpr size_t WS_SS = 170 * MiB;
constexpr size_t WS_XN = 180 * MiB;
constexpr size_t WS_XNR = 1010 * MiB;
constexpr size_t WS_AR = 234 * MiB;
constexpr size_t WS_END = 1138 * MiB;
constexpr size_t DUMMY_OFF = 0;
constexpr int CW_TMO = 0;
constexpr int CW_BAR = 4096;
constexpr int RING_BYTES = 131072;
constexpr int LDSCTL_OFF = 135168;
constexpr int LDS_BYTES = 163840;

#define GAS __attribute__((address_space(1)))
#define LAS __attribute__((address_space(3)))
typedef unsigned short bf16;
typedef unsigned u32x4 __attribute__((ext_vector_type(4)));
typedef unsigned u32x2 __attribute__((ext_vector_type(2)));
typedef float f32x4 __attribute__((ext_vector_type(4)));
typedef float f32x16 __attribute__((ext_vector_type(16)));
typedef short bf16x8 __attribute__((ext_vector_type(8)));
typedef short s16x4 __attribute__((ext_vector_type(4)));
typedef short v4i16_t __attribute__((ext_vector_type(4)));
typedef __bf16 bf16x2_t __attribute__((ext_vector_type(2)));
typedef float f32x2_t __attribute__((ext_vector_type(2)));
#define LDS_WAIT() asm volatile("s_waitcnt lgkmcnt(0)" ::: "memory")
#define VM_WAIT() asm volatile("s_waitcnt vmcnt(0)" ::: "memory")
#define MFMA32(a, b, c) __builtin_amdgcn_mfma_f32_32x32x16_bf16((a), (b), (c), 0, 0, 0)
DI unsigned pk2(float lo, float hi) { f32x2_t v = {lo, hi}; bf16x2_t b = __builtin_convertvector(v, bf16x2_t); return __builtin_bit_cast(unsigned, b); }
DI float bf2f(unsigned short b) { return __builtin_bit_cast(float, (unsigned)b << 16); }
DI float bflo(unsigned w) { return __builtin_bit_cast(float, w << 16); }
DI float bfhi(unsigned w) { return __builtin_bit_cast(float, w & 0xffff0000u); }
DI unsigned short f2bf(float f) { return (unsigned short)(pk2(f, 0.f) & 0xffffu); }
DI float wave_sum(float v) {
#pragma unroll
    for (int o = 1; o < 64; o <<= 1) v += __shfl_xor(v, o);
    return v;
}
DI int crow(int i, int h) { return (i & 3) + 8 * (i >> 2) + 4 * h; }
#define XB_TMO      128
#define XB_XCNT(j)  (256  + 64 * (j))
#define XB_XSUB(j)  (1280 + 64 * (j))
#define XB_XGEN(j)  (2304 + 64 * (j))
#define XB_TOP      3328
#define XB_TOPGEN   3392
#define XCD_BAR_WORDS 3456
#define XB_SPIN_CAP (1u << 18)

__device__ __forceinline__ unsigned xb_ld(unsigned* p)              { return __hip_atomic_load(p, __ATOMIC_RELAXED, __HIP_MEMORY_SCOPE_AGENT); }
__device__ __forceinline__ unsigned xb_add(unsigned* p, unsigned v) { return __hip_atomic_fetch_add(p, v, __ATOMIC_RELAXED, __HIP_MEMORY_SCOPE_AGENT); }
__device__ __forceinline__ unsigned xb_xcc_id() { return (unsigned)__builtin_amdgcn_s_getreg((3 << 11) | 20) & 0xFu; }
#define XB_SPIN(cond, bar) do { unsigned _sp = 0; while (cond) { __builtin_amdgcn_s_sleep(1); \
    if ((++_sp & 255u) == 0u) { if (xb_ld(&(bar)[XB_TMO])) break; if (_sp > XB_SPIN_CAP) { atomicAdd(&(bar)[XB_TMO], 1u); break; } } } } while (0)

struct XcdBarrier {
    unsigned* bar; unsigned x;
    volatile LAS unsigned* st;
};

__device__ __forceinline__ XcdBarrier xcd_barrier_post(unsigned* bar, volatile LAS unsigned* st) {
    XcdBarrier b; b.bar = bar; b.x = xb_xcc_id(); b.st = st;
    if (threadIdx.x == 0) (void)xb_add(&bar[XB_XCNT(b.x)], 1u);
    return b;
}
__device__ __forceinline__ void xcd_barrier_complete(unsigned* bar, unsigned x, unsigned& nloc, unsigned& nx) {
    const unsigned G = gridDim.x * gridDim.y * gridDim.z;
    unsigned sum, cnt, mine, sp = 0u;
    for (;;) {
        sum = 0u; cnt = 0u; mine = 0u;
#pragma unroll
        for (unsigned j = 0; j < 16; ++j) { const unsigned c = xb_ld(&bar[XB_XCNT(j)]); sum += c; cnt += (c > 0u) ? 1u : 0u; mine = (j == x) ? c : mine; }
        if (sum == G) break;
        __builtin_amdgcn_s_sleep(1);
        if ((++sp & 255u) == 0u) { if (xb_ld(&bar[XB_TMO])) break; if (sp > XB_SPIN_CAP) { atomicAdd(&bar[XB_TMO], 1u); break; } }
    }
    nloc = mine > 0u ? mine : 1u; nx = cnt > 0u ? cnt : 1u;
}

__device__ __forceinline__ void xcd_barrier(const XcdBarrier& b) {
    asm volatile("s_waitcnt vmcnt(0)" ::: "memory");
    __syncthreads();
    if (threadIdx.x == 0) {
        unsigned* bar = b.bar;
        __builtin_amdgcn_s_waitcnt(0);
        unsigned nloc = b.st[0], nx = b.st[1];
        if (nloc == 0u) { xcd_barrier_complete(bar, b.x, nloc, nx); b.st[0] = nloc; b.st[1] = nx; }
        const unsigned old = xb_add(&bar[XB_XSUB(b.x)], 1u);
        const unsigned gen = old / nloc;
        if (old + 1u == (gen + 1u) * nloc) {
            __builtin_amdgcn_fence(__ATOMIC_RELEASE, "agent");
            asm volatile("s_waitcnt vmcnt(0)" ::: "memory");
            const unsigned og = xb_add(&bar[XB_TOP], 1u);
            const unsigned tg = og / nx;
            if (og + 1u == (tg + 1u) * nx) xb_add(&bar[XB_TOPGEN], 1u);
            else XB_SPIN(xb_ld(&bar[XB_TOPGEN]) == tg, bar);
            __builtin_amdgcn_fence(__ATOMIC_ACQUIRE, "agent");
            xb_add(&bar[XB_XGEN(b.x)], 1u);
            asm volatile("s_waitcnt vmcnt(0)" ::: "memory");
        } else {
            XB_SPIN(xb_ld(&bar[XB_XGEN(b.x)]) == gen, bar);
            __builtin_amdgcn_fence(__ATOMIC_ACQUIRE, "agent");
            asm volatile("s_waitcnt vmcnt(0)" ::: "memory");
        }
    }
    __syncthreads();
}
struct Frame {
    LAS unsigned char* lds; unsigned* ctl; unsigned char* ws;
    int tid, lane, wave, G, gw, NGW;
};
DI void ph_tables(const Frame& F, const int* pos) {
    float* c48 = (float*)(F.ws + TAB_COS48); float* s48 = (float*)(F.ws + TAB_SIN48); float* c32 = (float*)(F.ws + TAB_COS32); float* s32 = (float*)(F.ws + TAB_SIN32);
    const int gt = blockIdx.x * (NWAVES * 64) + F.tid, NT = F.G * NWAVES * 64;
    for (int i = gt; i < MTOT * 40; i += NT) {
        const int m = i / 40, j = i - m * 40; const float p = (float)pos[m];
        const bool a = j < 24; const int jj = a ? j : j - 24;
        const float inv = (float)exp(-(2.0 * jj / (a ? 48.0 : 32.0)) * 13.122363377404328);
        const float ang = p * inv; float sn, cs; sincosf(ang, &sn, &cs);
        if (a) { c48[m * 24 + jj] = cs; s48[m * 24 + jj] = sn; } else { c32[m * 16 + jj] = cs; s32[m * 16 + jj] = sn; }
    }
}
DI void cvt_load(float (&v)[32], const float* W, int ldw, int col0, int ncols, int item, int nblk, int lane) {
    const int kb = item / nblk, nb = item - kb * nblk, k0 = 64 * kb, n0 = 32 * nb, nn = n0 + (lane & 31); const bool ok = nn < ncols;
    const float* p = W + (size_t)(k0 + (lane >> 5)) * ldw + col0 + (ok ? nn : 0);
#pragma unroll
    for (int i = 0; i < 32; ++i) { const float x = p[(size_t)(2 * i) * ldw]; v[i] = ok ? x : 0.f; }
}
DI void cvt_store(const float (&v)[32], int ncols, bf16* WT, int ldt, int row_off, float scale, LAS float* scr, int item, int nblk, int lane) {
    const int kb = item / nblk, nb = item - kb * nblk, k0 = 64 * kb, n0 = 32 * nb;
#pragma unroll
    for (int i = 0; i < 32; ++i) scr[(2 * i + (lane >> 5)) * 33 + (lane & 31)] = v[i] * scale;
    LDS_WAIT();
    const int c = lane & 7;
#pragma unroll
    for (int j = 0; j < 4; ++j) { const int n = (lane >> 3) + 8 * j; const LAS float* s = scr + (8 * c) * 33 + n;
        u32x4 o; o.x = pk2(s[0 * 33], s[1 * 33]); o.y = pk2(s[2 * 33], s[3 * 33]); o.z = pk2(s[4 * 33], s[5 * 33]); o.w = pk2(s[6 * 33], s[7 * 33]);
        if (n0 + n < ncols) *(u32x4*)(WT + (size_t)(row_off + n0 + n) * ldt + k0 + 8 * c) = o; }
    LDS_WAIT();
}
DI void cvt_item(const float* W, int ldw, int col0, int ncols, bf16* WT, int ldt, int row_off, float scale, LAS float* scr, int item, int nblk, int lane) {
    float v[32]; cvt_load(v, W, ldw, col0, ncols, item, nblk, lane); cvt_store(v, ncols, WT, ldt, row_off, scale, scr, item, nblk, lane);
}
template <class MAP> DI void cvt_loop(const Frame& F, const float* W, int ldw, int ncols, bf16* WT, int ldt, float scale, int nitems, int nblk, const MAP& map) {
    LAS float* scr = (LAS float*)(F.lds + F.wave * 16384);
    int it = F.gw; float cur[32]; int c0 = 0, ro = 0, li = 0;
    if (it < nitems) { map(it, c0, ro, li); cvt_load(cur, W, ldw, c0, ncols, li, nblk, F.lane); }
#pragma unroll 1
    for (; it < nitems; it += F.NGW) {
        float nxt[32]; int c1 = 0, r1 = 0, l1 = 0; const int ni = it + F.NGW;
        if (ni < nitems) { map(ni, c1, r1, l1); cvt_load(nxt, W, ldw, c1, ncols, l1, nblk, F.lane); }
        cvt_store(cur, ncols, WT, ldt, ro, scale, scr, li, nblk, F.lane);
#pragma unroll
        for (int i = 0; i < 32; ++i) cur[i] = nxt[i];
        c0 = c1; ro = r1; li = l1;
    }
}
struct CvtPlain { int col0, row_off; DI void operator()(int it, int& c, int& r, int& l) const { c = col0; r = row_off; l = it; } };
DI void cvt_job(const Frame& F, const float* W, int ldw, int K, int col0, int ncols, bf16* WT, int ldt, int row_off, float scale) {
    const int nblk = (ncols + 31) / 32;
    cvt_loop(F, W, ldw, ncols, WT, ldt, scale, (K / 64) * nblk, nblk, CvtPlain{col0, row_off});
}
DI void zero_bf16(const Frame& F, bf16* p, size_t nelem) {
    const size_t gt = (size_t)blockIdx.x * (NWAVES * 64) + F.tid, NT = (size_t)F.G * NWAVES * 64;
    for (size_t i = gt; i < nelem / 8; i += NT) ((u32x4*)p)[i] = (u32x4){0u, 0u, 0u, 0u};
}
DI void ph_cvt_ffn(const Frame& F, const float* up, const float* down) {
    bf16* WUP = (bf16*)(F.ws + WS_WFFN); bf16* WDN = WUP + (size_t)2 * DFF * DM;
    struct UpMap { DI void operator()(int it, int& c, int& r, int& l) const { const int seg = it >> 7, pn = seg >> 1, isv = seg & 1; c = isv * DFF + pn * 128; r = pn * 256 + isv * 128; l = it & 127; } };
    cvt_loop(F, up, 2 * DFF, 128, WUP, DM, 1.f, 88 * 128, 4, UpMap{});
    cvt_job(F, down, DM, DFF, 0, DM, WDN, DFF, 0, 1.f);
}
DI void ph_conv_fix(const Frame& F, const float* UB, bf16* Gb, const float* cw, const float* cb, const int nrows = MC) {
    const int gt = blockIdx.x * (NWAVES * 64) + F.tid, NT = F.G * NWAVES * 64;
    for (int it = gt; it < (nrows / 256) * (DFF / 4); it += NT) {
        const int pm = it / (DFF / 4), c4 = it - pm * (DFF / 4), ch = c4 * 4, col = (ch >> 7) * 256 + (ch & 127);
        const float* ub = UB + (size_t)pm * 4 * (2 * DFF) + col; const bool has = (pm & 15) != 0;
        const f32x4 z = {0.f, 0.f, 0.f, 0.f};
        const f32x4 g0 = *(const f32x4*)(ub), g1 = *(const f32x4*)(ub + 2 * DFF), v0 = *(const f32x4*)(ub + 128), v1 = *(const f32x4*)(ub + 2 * DFF + 128);
        const f32x4 gm2 = has ? *(const f32x4*)(ub - 2 * (2 * DFF)) : z, gm1 = has ? *(const f32x4*)(ub - (2 * DFF)) : z, vm2 = has ? *(const f32x4*)(ub - 2 * (2 * DFF) + 128) : z, vm1 = has ? *(const f32x4*)(ub - (2 * DFF) + 128) : z;
        const f32x4 w0g = *(const f32x4*)(cw + ch), w1g = *(const f32x4*)(cw + 2 * DFF + ch), w2g = *(const f32x4*)(cw + 4 * DFF + ch), bg = *(const f32x4*)(cb + ch);
        const f32x4 w0v = *(const f32x4*)(cw + DFF + ch), w1v = *(const f32x4*)(cw + 3 * DFF + ch), w2v = *(const f32x4*)(cw + 5 * DFF + ch), bv = *(const f32x4*)(cb + DFF + ch);
        float o0[4], o1[4];
#pragma unroll
        for (int e = 0; e < 4; ++e) {
            const float yg0 = bg[e] + w0g[e] * gm2[e] + w1g[e] * gm1[e] + w2g[e] * g0[e], yv0 = bv[e] + w0v[e] * vm2[e] + w1v[e] * vm1[e] + w2v[e] * v0[e];
            const float yg1 = bg[e] + w0g[e] * gm1[e] + w1g[e] * g0[e] + w2g[e] * g1[e], yv1 = bv[e] + w0v[e] * vm1[e] + w1v[e] * v0[e] + w2v[e] * v1[e];
            o0[e] = yg0 * __builtin_amdgcn_rcpf(1.0f + __builtin_amdgcn_exp2f(-yg0 * LOG2E)) * yv0; o1[e] = yg1 * __builtin_amdgcn_rcpf(1.0f + __builtin_amdgcn_exp2f(-yg1 * LOG2E)) * yv1;
        }
        u32x2 a, b; a.x = pk2(o0[0], o0[1]); a.y = pk2(o0[2], o0[3]); b.x = pk2(o1[0], o1[1]); b.y = pk2(o1[2], o1[3]);
        *(u32x2*)(Gb + (size_t)(pm * 256) * DFF + ch) = a; *(u32x2*)(Gb + (size_t)(pm * 256 + 1) * DFF + ch) = b;
    }
}
DI void ph_rmsnorm(const Frame& F, const float* src, int row_off, const float* gain, bf16* XN, const int nrows = MC) {
    f32x4 g[8];
#pragma unroll
    for (int j = 0; j < 8; ++j) g[j] = *(const f32x4*)(gain + 4 * (F.lane + 64 * j));
    for (int ml = F.gw; ml < nrows; ml += F.NGW) {
        const f32x4* xr = (const f32x4*)(src + (size_t)(row_off + ml) * DM) + F.lane;
        f32x4 v[8]; float ss = 0.f;
#pragma unroll
        for (int j = 0; j < 8; ++j) { v[j] = xr[64 * j]; ss += (v[j].x * v[j].x + v[j].y * v[j].y) + (v[j].z * v[j].z + v[j].w * v[j].w); }
        const float rstd = 1.0f / sqrtf(wave_sum(ss) * (1.f / DM) + NORM_EPS);
        u32x2* o = (u32x2*)(XN + (size_t)ml * DM) + F.lane;
#pragma unroll
        for (int j = 0; j < 8; ++j) { const f32x4 y = v[j] * rstd * g[j]; u32x2 w; w.x = pk2(y.x, y.y); w.y = pk2(y.z, y.w); o[64 * j] = w; }
    }
}
DI void ph_norm_first(const Frame& F, const float* src, const float* gain, bf16* XNR, float* ss) {
    f32x4 g[8];
#pragma unroll
    for (int j = 0; j < 8; ++j) g[j] = *(const f32x4*)(gain + 4 * (F.lane + 64 * j));
    for (int m = F.gw; m < MTOT; m += F.NGW) {
        const f32x4* xr = (const f32x4*)(src + (size_t)m * DM) + F.lane;
        f32x4 v[8]; float s2 = 0.f;
#pragma unroll
        for (int j = 0; j < 8; ++j) { v[j] = xr[64 * j]; s2 += (v[j].x * v[j].x + v[j].y * v[j].y) + (v[j].z * v[j].z + v[j].w * v[j].w); }
        s2 = wave_sum(s2);
        if (F.lane < 2) *(f32x4*)(ss + (size_t)m * 8 + 4 * F.lane) = (f32x4){F.lane == 0 ? s2 : 0.f, 0.f, 0.f, 0.f};
        u32x2* o = (u32x2*)(XNR + (size_t)m * DM) + F.lane;
#pragma unroll
        for (int j = 0; j < 8; ++j) { const f32x4 y = v[j] * g[j]; u32x2 w; w.x = pk2(y.x, y.y); w.y = pk2(y.z, y.w); o[64 * j] = w; }
    }
}
DI void ph_final_norm(const Frame& F, float* h, const float* gain) {
    f32x4 g[8];
#pragma unroll
    for (int j = 0; j < 8; ++j) g[j] = *(const f32x4*)(gain + 4 * (F.lane + 64 * j));
    for (int m = F.gw; m < MTOT; m += F.NGW) {
        f32x4* xr = (f32x4*)(h + (size_t)m * DM) + F.lane;
        f32x4 v[8]; float ss = 0.f;
#pragma unroll
        for (int j = 0; j < 8; ++j) { v[j] = xr[64 * j]; ss += (v[j].x * v[j].x + v[j].y * v[j].y) + (v[j].z * v[j].z + v[j].w * v[j].w); }
        const float rstd = 1.0f / sqrtf(wave_sum(ss) * (1.f / DM) + NORM_EPS);
#pragma unroll
        for (int j = 0; j < 8; ++j) xr[64 * j] = v[j] * rstd * g[j];
    }
}
DI void ph_conv_glu(const Frame& F, const bf16* U, bf16* Gb, const float* cw, const float* cb) {
    constexpr int RC = 32, NCG = DFF / 8, NRC = MC / RC;
    const int gt = blockIdx.x * (NWAVES * 64) + F.tid, NT = F.G * NWAVES * 64;
    for (int it = gt; it < NCG * NRC; it += NT) {
        const int cg = it % NCG, rc = it / NCG, c0 = cg * 8, r0 = rc * RC;
        float w0g[8], w1g[8], w2g[8], bg[8], w0v[8], w1v[8], w2v[8], bv[8];
#pragma unroll
        for (int e = 0; e < 8; ++e) { w0g[e] = cw[c0 + e]; w1g[e] = cw[2 * DFF + c0 + e]; w2g[e] = cw[4 * DFF + c0 + e]; bg[e] = cb[c0 + e];
            w0v[e] = cw[DFF + c0 + e]; w1v[e] = cw[3 * DFF + c0 + e]; w2v[e] = cw[5 * DFF + c0 + e]; bv[e] = cb[DFF + c0 + e]; }
        float pg2[8], pg1[8], pv2[8], pv1[8];
        const bool has = (r0 & (SEQ - 1)) != 0;
        {
            u32x4 a = {0u, 0u, 0u, 0u}, b = a, c = a, d = a;
            if (has) { a = *(const u32x4*)(U + (size_t)(r0 - 2) * (2 * DFF) + c0); b = *(const u32x4*)(U + (size_t)(r0 - 1) * (2 * DFF) + c0);
                       c = *(const u32x4*)(U + (size_t)(r0 - 2) * (2 * DFF) + DFF + c0); d = *(const u32x4*)(U + (size_t)(r0 - 1) * (2 * DFF) + DFF + c0); }
#pragma unroll
            for (int e = 0; e < 4; ++e) { pg2[2 * e] = bflo(a[e]); pg2[2 * e + 1] = bfhi(a[e]); pg1[2 * e] = bflo(b[e]); pg1[2 * e + 1] = bfhi(b[e]);
                pv2[2 * e] = bflo(c[e]); pv2[2 * e + 1] = bfhi(c[e]); pv1[2 * e] = bflo(d[e]); pv1[2 * e + 1] = bfhi(d[e]); }
        }
        for (int r = 0; r < RC; ++r) {
            const u32x4 ug = *(const u32x4*)(U + (size_t)(r0 + r) * (2 * DFF) + c0), uv = *(const u32x4*)(U + (size_t)(r0 + r) * (2 * DFF) + DFF + c0);
            float cg_[8], cv_[8], o[8];
#pragma unroll
            for (int e = 0; e < 4; ++e) { cg_[2 * e] = bflo(ug[e]); cg_[2 * e + 1] = bfhi(ug[e]); cv_[2 * e] = bflo(uv[e]); cv_[2 * e + 1] = bfhi(uv[e]); }
#pragma unroll
            for (int e = 0; e < 8; ++e) {
                const float yg = bg[e] + w0g[e] * pg2[e] + w1g[e] * pg1[e] + w2g[e] * cg_[e];
                const float yv = bv[e] + w0v[e] * pv2[e] + w1v[e] * pv1[e] + w2v[e] * cv_[e];
                const float sg = yg * __builtin_amdgcn_rcpf(1.0f + __builtin_amdgcn_exp2f(-yg * LOG2E));
                o[e] = sg * yv; pg2[e] = pg1[e]; pg1[e] = cg_[e]; pv2[e] = pv1[e]; pv1[e] = cv_[e];
            }
            u32x4 w; w.x = pk2(o[0], o[1]); w.y = pk2(o[2], o[3]); w.z = pk2(o[4], o[5]); w.w = pk2(o[6], o[7]);
            *(u32x4*)(Gb + (size_t)(r0 + r) * DFF + c0) = w;
        }
    }
}
constexpr size_t DA_DIN = 0, DA_CQN = 64 * MiB, DA_LATC = 80 * MiB, DA_KPE = 88 * MiB, DA_KIDX = 90 * MiB, DA_WIDX = 94 * MiB, DA_QL = 96 * MiB, DA_QPE = 352 * MiB, DA_QIDX = 400 * MiB,
                 DA_SEL = 464 * MiB, DA_CNT = 472 * MiB, DA_SC = 474 * MiB, DA_O2 = 474 * MiB;
constexpr size_t DW_W1 = 0, DW_W2 = (size_t)1024 * 2048, DW_WO = DW_W2 + (size_t)11776 * 512, DW_BD = DW_WO + (size_t)2048 * 4096;
constexpr float DSA_QSCALE = 0.07216878364870322f * LOG2E;
constexpr float DSA_WIDX_SCALE = 0.25f * 0.08838834764831845f;

DI void ph_dsa_cvt(const Frame& F, const float* w_in, const float* w_qup, const float* w_uk, const float* w_uv, const float* w_out) {
    bf16* WB = (bf16*)(F.ws + WS_WMIX);
    cvt_job(F, w_in, 960, DM, 0, 960, WB + DW_W1, DM, 0, 1.f);
    zero_bf16(F, WB + DW_W1 + (size_t)960 * DM, (size_t)64 * DM);
    { LAS float* scr = (LAS float*)(F.lds + F.wave * 16384);
      for (int it = F.gw; it < 32 * 16; it += F.NGW) { const int h = it >> 4; cvt_item(w_qup, 8192, h * 192, 48, WB + DW_W2, 512, 8192 + h * 48, DSA_QSCALE, scr, it & 15, 2, F.lane); } }
    cvt_job(F, w_qup, 8192, 512, 6144, 2048, WB + DW_W2, 512, 9728, 1.f);
    __syncthreads();
    {
        LAS float* As = (LAS float*)F.lds; LAS float* Bs = As + 64 * 145;
        for (int u = blockIdx.x; u < 32 * 4 * 8; u += F.G) {
            const int h = u >> 5, r0 = ((u >> 3) & 3) * 64, k0 = (u & 7) * 64;
            for (int i = F.tid; i < 64 * 144; i += NWAVES * 64) { const int row = i / 144, col = i - row * 144;
                As[row * 145 + col] = w_uk[(size_t)(h * 256 + r0) * 144 + i]; Bs[row * 145 + col] = w_qup[(size_t)(k0 + row) * 8192 + h * 192 + 48 + col]; }
            __syncthreads();
            const int r = F.tid & 63, kg = F.tid >> 6; float acc[8];
#pragma unroll
            for (int j = 0; j < 8; ++j) acc[j] = 0.f;
            for (int n = 0; n < 144; ++n) { const float a = As[r * 145 + n];
#pragma unroll
                for (int j = 0; j < 8; ++j) acc[j] += a * Bs[(kg * 8 + j) * 145 + n]; }
            u32x4 o; o.x = pk2(acc[0] * DSA_QSCALE, acc[1] * DSA_QSCALE); o.y = pk2(acc[2] * DSA_QSCALE, acc[3] * DSA_QSCALE); o.z = pk2(acc[4] * DSA_QSCALE, acc[5] * DSA_QSCALE); o.w = pk2(acc[6] * DSA_QSCALE, acc[7] * DSA_QSCALE);
            *(u32x4*)(WB + DW_W2 + (size_t)(h * 256 + r0 + r) * 512 + k0 + kg * 8) = o;
            __syncthreads();
        }
    }
    { LAS float* scr = (LAS float*)(F.lds + F.wave * 16384);
      for (int it = F.gw; it < 32 * 16; it += F.NGW) { const int h = it >> 4; cvt_item(w_uv + (size_t)h * 256 * 128, 128, 0, 128, WB + DW_BD + (h & 1) * 256, 512, h * 128, 1.f, scr, it & 15, 4, F.lane); } }
    { const size_t gt = (size_t)blockIdx.x * (NWAVES * 64) + F.tid, NT = (size_t)F.G * NWAVES * 64;
      for (size_t i = gt; i < (size_t)4096 * 32; i += NT) { const int row = (int)(i >> 5), pc = (int)(i & 31); *(u32x4*)(WB + DW_BD + (size_t)row * 512 + (1 - ((row >> 7) & 1)) * 256 + pc * 8) = (u32x4){0u, 0u, 0u, 0u}; } }
    cvt_job(F, w_out, DM, 4096, 0, DM, WB + DW_WO, 4096, 0, 1.f);
}
DI void ph_dsa_post1(const Frame& F, int half, const float* qn, const float* kvn, const float* lng, const float* lnb) {
    unsigned char* ar = F.ws + WS_AR;
    const float* DIN = (const float*)(ar + DA_DIN); bf16* CQN = (bf16*)(ar + DA_CQN); bf16* LATC = (bf16*)(ar + DA_LATC); bf16* KPE = (bf16*)(ar + DA_KPE); bf16* KIDX = (bf16*)(ar + DA_KIDX); float* WIDX = (float*)(ar + DA_WIDX);
    const float* c48 = (const float*)(F.ws + TAB_COS48); const float* s48 = (const float*)(F.ws + TAB_SIN48); const float* c32 = (const float*)(F.ws + TAB_COS32); const float* s32 = (const float*)(F.ws + TAB_SIN32);
    LAS float* buf = (LAS float*)(F.lds + F.wave * 1024);
    const int lane = F.lane;
    for (int ml = F.gw; ml < MC; ml += F.NGW) {
        const int mg = half * MC + ml;
        const size_t kfb = ((size_t)(ml >> 5) * 8 * 64 + (ml & 31)) * 8;
        const float* row = DIN + (size_t)ml * 1024 + 16 * lane;
        f32x4 v[4]; float ss = 0.f, s1 = 0.f;
#pragma unroll
        for (int j = 0; j < 4; ++j) { v[j] = *(const f32x4*)(row + 4 * j); ss += (v[j].x * v[j].x + v[j].y * v[j].y) + (v[j].z * v[j].z + v[j].w * v[j].w); s1 += (v[j].x + v[j].y) + (v[j].z + v[j].w); }
        const bool isq = lane < 32, iskv = lane >= 32 && lane < 48, ispe = lane >= 48 && lane < 51, isix = lane >= 51 && lane < 59;
        const float ssq = wave_sum(isq ? ss : 0.f), sskv = wave_sum(iskv ? ss : 0.f), mean = wave_sum(isix ? s1 : 0.f) * (1.f / 128.f);
        float d2 = 0.f;
#pragma unroll
        for (int j = 0; j < 4; ++j) { const f32x4 d = v[j] - mean; d2 += (d.x * d.x + d.y * d.y) + (d.z * d.z + d.w * d.w); }
        const float var = wave_sum(isix ? d2 : 0.f) * (1.f / 128.f);
        const float rq = 1.0f / sqrtf(ssq * (1.f / 512.f) + NORM_EPS), rkv = 1.0f / sqrtf(sskv * (1.f / 256.f) + NORM_EPS), rstd = 1.0f / sqrtf(var + NORM_EPS);
        if (isq || iskv) {
            const float* gp = isq ? qn + 16 * lane : kvn + 16 * (lane - 32); const float rs = isq ? rq : rkv;
            bf16* dst = isq ? CQN + (size_t)ml * 512 + 16 * lane : LATC + (size_t)ml * 256 + 16 * (lane - 32);
            u32x4 o[2];
#pragma unroll
            for (int j = 0; j < 4; ++j) { const f32x4 g = *(const f32x4*)(gp + 4 * j); const f32x4 y = v[j] * rs * g; o[j >> 1][(j & 1) * 2] = pk2(y.x, y.y); o[j >> 1][(j & 1) * 2 + 1] = pk2(y.z, y.w); }
            *(u32x4*)dst = o[0]; *(u32x4*)(dst + 8) = o[1];
        } else if (ispe) {
#pragma unroll
            for (int j = 0; j < 4; ++j) *(LAS f32x4*)(buf + (lane - 48) * 16 + 4 * j) = v[j];
        } else if (isix) {
#pragma unroll
            for (int j = 0; j < 4; ++j) { const f32x4 g = *(const f32x4*)(lng + (lane - 51) * 16 + 4 * j), b = *(const f32x4*)(lnb + (lane - 51) * 16 + 4 * j); *(LAS f32x4*)(buf + 48 + (lane - 51) * 16 + 4 * j) = (v[j] - mean) * rstd * g + b; }
        } else if (lane == 59) {
#pragma unroll
            for (int j = 0; j < 4; ++j) *(f32x4*)(WIDX + (size_t)ml * 16 + 4 * j) = v[j] * DSA_WIDX_SCALE;
        }
        LDS_WAIT();
        if (lane < 24) { const float x1 = buf[lane], x2 = buf[24 + lane], c = c48[(size_t)mg * 24 + lane], s = s48[(size_t)mg * 24 + lane];
            KPE[(size_t)ml * 48 + lane] = f2bf(x1 * c - x2 * s); KPE[(size_t)ml * 48 + 24 + lane] = f2bf(x1 * s + x2 * c);
        } else if (lane < 40) { const int i = lane - 24; const float x1 = buf[48 + i], x2 = buf[48 + 16 + i], c = c32[(size_t)mg * 16 + i], s = s32[(size_t)mg * 16 + i];
            KIDX[kfb + (size_t)((i >> 3) * 32) * 8 + (i & 7)] = f2bf(x1 * c - x2 * s); KIDX[kfb + (size_t)(64 + (i >> 3) * 32) * 8 + (i & 7)] = f2bf(x1 * s + x2 * c);
        } else { const int d = 32 + 4 * (lane - 40); const f32x4 y = *(const LAS f32x4*)(buf + 48 + d); u32x2 w; w.x = pk2(y.x, y.y); w.y = pk2(y.z, y.w); *(u32x2*)(KIDX + kfb + (size_t)((d >> 4) * 64 + ((d >> 3) & 1) * 32) * 8 + (d & 7)) = w; }
        LDS_WAIT();
    }
}
DI void ph_dsa_rope(const Frame& F, int half) {
    unsigned char* ar = F.ws + WS_AR; bf16* QPE = (bf16*)(ar + DA_QPE); bf16* QIDX = (bf16*)(ar + DA_QIDX);
    const float* c48 = (const float*)(F.ws + TAB_COS48); const float* s48 = (const float*)(F.ws + TAB_SIN48); const float* c32 = (const float*)(F.ws + TAB_COS32); const float* s32 = (const float*)(F.ws + TAB_SIN32);
    for (int ml = F.gw; ml < MC; ml += F.NGW) {
        const size_t mg = (size_t)half * MC + ml;
        for (int p = F.lane; p < 768; p += 64) { const int hd = p / 24, i = p - hd * 24; bf16* q = QPE + (size_t)ml * 1536 + hd * 48 + i;
            const float x1 = bf2f(q[0]), x2 = bf2f(q[24]), c = c48[mg * 24 + i], s = s48[mg * 24 + i]; q[0] = f2bf(x1 * c - x2 * s); q[24] = f2bf(x1 * s + x2 * c); }
        for (int p = F.lane; p < 256; p += 64) { const int hd = p >> 4, i = p & 15; bf16* q = QIDX + (size_t)ml * 2048 + hd * 128 + i;
            const float x1 = bf2f(q[0]), x2 = bf2f(q[16]), c = c32[mg * 16 + i], s = s32[mg * 16 + i]; q[0] = f2bf(x1 * c - x2 * s); q[16] = f2bf(x1 * s + x2 * c); }
    }
}
DI int wave_iscan_dpp(int v) {
    v += __builtin_amdgcn_update_dpp(0, v, 0x111, 0xf, 0xf, true); v += __builtin_amdgcn_update_dpp(0, v, 0x112, 0xf, 0xf, true);
    v += __builtin_amdgcn_update_dpp(0, v, 0x114, 0xf, 0xf, true); v += __builtin_amdgcn_update_dpp(0, v, 0x118, 0xf, 0xf, true);
    v += __builtin_amdgcn_update_dpp(0, v, 0x142, 0xa, 0xf, false);
    v += __builtin_amdgcn_update_dpp(0, v, 0x143, 0xc, 0xf, false);
    return v;
}
DI int wave_isum_dpp(int v) {
    v += __builtin_amdgcn_update_dpp(0, v, 0x111, 0xf, 0xf, true); v += __builtin_amdgcn_update_dpp(0, v, 0x112, 0xf, 0xf, true);
    v += __builtin_amdgcn_update_dpp(0, v, 0x114, 0xf, 0xf, true); v += __builtin_amdgcn_update_dpp(0, v, 0x118, 0xf, 0xf, true);
    v += __builtin_amdgcn_update_dpp(0, v, 0x142, 0xa, 0xf, false);
    v += __builtin_amdgcn_update_dpp(0, v, 0x143, 0xc, 0xf, false);
    return __builtin_amdgcn_readlane(v, 63);
}
DI unsigned f2sortable(float s) { const unsigned b = __builtin_bit_cast(unsigned, s); return (b & 0x80000000u) ? ~b : (b | 0x80000000u); }
DI void ph_dsa_index(const Frame& F, const int dry = 0, const int parts = 3) {
    unsigned char* ar = F.ws + WS_AR;
    const bf16* QIDX = (const bf16*)(ar + DA_QIDX); const bf16* KIDX = (const bf16*)(ar + DA_KIDX); const float* WIDX = (const float*)(ar + DA_WIDX);
    unsigned short* SEL = (unsigned short*)(ar + DA_SEL); int* CNT = (int*)(ar + DA_CNT); float* SC = (float*)(ar + DA_SC) + (size_t)F.gw * 16384;
    const int lane = F.lane, r = lane & 31, hf = lane >> 5;
    LAS unsigned char* wl = F.lds + F.wave * 8192 + lane * 16;
    LAS unsigned* hist = (LAS unsigned*)(F.lds + 65536 + F.wave * 1024);
#pragma unroll 1
    for (int tile = blockIdx.x; tile < BPH * 128; tile += F.G) {
        const int j = tile >> 8, c8 = tile & 255, c7 = c8 & 127, bl = (c8 >> 7) * 2 + j, qt = j ? 127 - c7 : c7;
        const int q0 = qt * 32 + 4 * F.wave;
        const int ntile = (q0 + 3) / 32 + 1;
        bf16x8 qa[2][8];
#pragma unroll
        for (int pr = 0; pr < 2; ++pr) {
            const int mrow = bl * SEQ + q0 + 2 * pr + (r >> 4);
#pragma unroll
            for (int s = 0; s < 8; ++s) qa[pr][s] = *(const bf16x8*)(QIDX + (size_t)mrow * 2048 + (r & 15) * 128 + 16 * s + 8 * hf);
            float wv[2][16];
#pragma unroll
            for (int i = 0; i < 16; ++i) wv[pr][i] = WIDX[(size_t)(bl * SEQ + q0 + 2 * pr + (i >> 3)) * 16 + (i & 3) + 8 * ((i >> 2) & 1) + 4 * hf];
#pragma unroll
            for (int i = 0; i < 16; i += 4) *(LAS f32x4*)(wl + (pr * 4 + (i >> 2)) * 1024) = (f32x4){wv[pr][i], wv[pr][i + 1], wv[pr][i + 2], wv[pr][i + 3]};
        }
        LDS_WAIT();
        if (parts & 1) {
        bf16x8 kf[8];
        { const bf16* kp = KIDX + ((size_t)(bl * 128) * 8 * 64 + lane) * 8;
#pragma unroll
          for (int s = 0; s < 8; ++s) kf[s] = *(const bf16x8*)(kp + 512 * s); }
#pragma unroll 1
        for (int t = 0; t < ntile; ++t) {
            f32x16 accs[2];
#pragma unroll
            for (int pr = 0; pr < 2; ++pr) {
#pragma unroll
                for (int i = 0; i < 16; ++i) accs[pr][i] = 0.f;
#pragma unroll
                for (int s = 0; s < 8; ++s) accs[pr] = MFMA32(qa[pr][s], kf[s], accs[pr]);
            }
            if (t + 1 < ntile) { const bf16* kp = KIDX + ((size_t)(bl * 128 + t + 1) * 8 * 64 + lane) * 8;
#pragma unroll
                for (int s = 0; s < 8; ++s) kf[s] = *(const bf16x8*)(kp + 512 * s); }
#pragma unroll
            for (int pr = 0; pr < 2; ++pr) {
                const f32x16 acc = accs[pr];
                float wv[2][16];
                { unsigned wa_ = (unsigned)(size_t)wl; asm volatile("" : "+v"(wa_));
#pragma unroll
                  for (int i = 0; i < 16; i += 4) { const f32x4 w4 = *(const LAS f32x4*)((LAS unsigned char*)(size_t)wa_ + (pr * 4 + (i >> 2)) * 1024); wv[pr][i] = w4.x; wv[pr][i + 1] = w4.y; wv[pr][i + 2] = w4.z; wv[pr][i + 3] = w4.w; } }
                float p0 = 0.f, p1 = 0.f;
#pragma unroll
                for (int i = 0; i < 8; ++i) { p0 += wv[pr][i] * fmaxf(acc[i], 0.f); p1 += wv[pr][8 + i] * fmaxf(acc[8 + i], 0.f); }
                const float t0 = p0 + __shfl_xor(p0, 32), t1 = p1 + __shfl_xor(p1, 32);
                SC[(pr * 128 + t) * 64 + lane] = hf ? t1 : t0;
            }
        }
        }
        VM_WAIT();
        if (parts & 2)
#pragma unroll 1
        for (int qi = 0; qi < 4; ++qi) {
            const int tq = q0 + qi, pr = qi >> 1, qs = qi & 1;
            unsigned u[64];
            const unsigned* scp = (const unsigned*)(SC + pr * 8192 + hf * 64 + qs * 32 + r);
#pragma unroll
            for (int g8 = 0; g8 < 8; ++g8) {
#pragma unroll
                for (int e = 0; e < 8; ++e) { const int i = 8 * g8 + e; const float s = __builtin_bit_cast(float, __hip_atomic_load(scp + e * 128, __ATOMIC_RELAXED, __HIP_MEMORY_SCOPE_AGENT));
                    u[i] = (2 * i + hf < ntile && 64 * i + lane <= tq) ? f2sortable(s) : 0u; }
                scp += 1024; asm volatile("" : "+v"(scp));
            }
            unsigned prefix = 0u;
            if (tq >= 256) {
#pragma unroll 1
                for (int bit = 31; bit >= 0; --bit) {
                    const unsigned cand = prefix | (1u << bit); int c = 0;
#pragma unroll
                    for (int g8 = 0; g8 < 8; ++g8) { if (g8 * 512 <= tq) {
#pragma unroll
                        for (int e = 0; e < 8; ++e) c += (u[8 * g8 + e] >= cand) ? 1 : 0; } }
                    c = wave_isum_dpp(c);
                    if (c >= 256) prefix = cand;
                    if (c == 256) break;
                }
            }
            const unsigned T = prefix > 1u ? prefix : 1u;
            int nl = 0;
#pragma unroll
            for (int g8 = 0; g8 < 8; ++g8) { if (g8 * 512 <= tq) {
#pragma unroll
                for (int e = 0; e < 8; ++e) nl += (u[8 * g8 + e] >= T) ? 1 : 0; } }
            const int inc = wave_iscan_dpp(nl), base = __builtin_amdgcn_readlane(inc, 63);
            int pos = inc - nl;
            unsigned short* sel = dry ? (unsigned short*)(ar + DUMMY_OFF) + (size_t)F.gw * 256 : SEL + (size_t)(bl * SEQ + tq) * 256;
#pragma unroll
            for (int g8 = 0; g8 < 8; ++g8) { if (g8 * 512 <= tq) {
#pragma unroll
                for (int e = 0; e < 8; ++e) { const int i = 8 * g8 + e; if (u[i] >= T) { if (pos < 256) sel[pos] = (unsigned short)(64 * i + lane); ++pos; } } } }
            if (lane == 0) (dry ? (int*)(ar + DUMMY_OFF + 32 * MiB) + F.gw : CNT + bl * SEQ + tq)[0] = base < 256 ? base : 256;
        }
    }
}
DI int dsa_fsw(int row) { return ((row & 3) << 2) | ((row >> 2) & 3); }
struct DsaPre { u32x4 row[16]; bf16x8 kpe[3]; bf16x8 q[3]; };
DI void dsa_prefetch(DsaPre& P, const bf16* LATC, const bf16* KPE, const bf16* QL, const bf16* QPE, int ml, int selv, int lane, int w) {
    const int bl = ml >> 12, r = lane & 31, h = lane >> 5;
#pragma unroll
    for (int it = 0; it < 16; ++it) { const int ki = __shfl(selv, (lane >> 5) + 2 * it); P.row[it] = *(const u32x4*)(LATC + (size_t)(bl * SEQ + ki) * 256 + (lane & 31) * 8); }
#pragma unroll
    for (int s = 0; s < 3; ++s) P.kpe[s] = *(const bf16x8*)(KPE + (size_t)(bl * SEQ + selv) * 48 + 16 * s + 8 * h);
#pragma unroll
    for (int j = 0; j < 3; ++j) { const int fi = w + 8 * j;
        if (fi < 16) P.q[j] = *(const bf16x8*)(QL + (size_t)ml * 8192 + r * 256 + 16 * fi + 8 * h);
        else if (fi < 19) P.q[j] = *(const bf16x8*)(QPE + (size_t)ml * 1536 + r * 48 + 16 * (fi - 16) + 8 * h); }
}
DI void ph_dsa_attn(const Frame& F, const int dry = 0) {
    unsigned char* ar = F.ws + WS_AR;
    bf16* QL = (bf16*)(ar + DA_QL); const bf16* QPE = (const bf16*)(ar + DA_QPE); const bf16* LATC = (const bf16*)(ar + DA_LATC); const bf16* KPE = (const bf16*)(ar + DA_KPE);
    const unsigned short* SEL = (const unsigned short*)(ar + DA_SEL); const int* CNT = (const int*)(ar + DA_CNT);
    const int lane = F.lane, r = lane & 31, h = lane >> 5, w = F.wave;
    LAS unsigned char* IMG = F.lds; LAS unsigned char* QB = F.lds + LDSCTL_OFF + 256; LAS float* MX = (LAS float*)(F.lds + LDSCTL_OFF + 256 + 19456); LAS float* SX = MX + 256;
    const int i16 = lane & 15, tq_ = i16 >> 2, tp_ = i16 & 3, blk = (lane >> 4) & 1;
    int ml = blockIdx.x;
    if (ml >= MC) return;
    DsaPre P;
    int cnt_c = CNT[ml];
    { const int slot = 32 * w + r; const int selv = slot < cnt_c ? (int)SEL[(size_t)ml * 256 + slot] : 0; dsa_prefetch(P, LATC, KPE, QL, QPE, ml, selv, lane, w); }
    int cnt_n = 0, selv_n = 0;
    if (ml + F.G < MC) { cnt_n = CNT[ml + F.G]; const int slot = 32 * w + r; selv_n = slot < cnt_n ? (int)SEL[(size_t)(ml + F.G) * 256 + slot] : 0; }
#pragma unroll 1
    for (; ml < MC; ml += F.G) {
        const int cnt = cnt_c, nch = (cnt + 31) >> 5; const bool act = w < nch;
#pragma unroll
        for (int it = 0; it < 16; ++it) { const int rr = (lane >> 5) + 2 * it; *(LAS u32x4*)(IMG + (32 * w + rr) * 512 + (((lane & 31) ^ dsa_fsw(rr)) * 16)) = P.row[it]; }
#pragma unroll
        for (int j = 0; j < 3; ++j) { const int fi = w + 8 * j; if (fi < 19) *(LAS bf16x8*)(QB + fi * 1024 + lane * 16) = P.q[j]; }
        bf16x8 kpe[3];
#pragma unroll
        for (int s = 0; s < 3; ++s) kpe[s] = P.kpe[s];
        LDS_WAIT(); __builtin_amdgcn_s_barrier(); asm volatile("" ::: "memory");
        if (ml + F.G < MC) {
            dsa_prefetch(P, LATC, KPE, QL, QPE, ml + F.G, selv_n, lane, w); cnt_c = cnt_n;
            if (ml + 2 * F.G < MC) { cnt_n = CNT[ml + 2 * F.G]; const int slot = 32 * w + r; selv_n = slot < cnt_n ? (int)SEL[(size_t)(ml + 2 * F.G) * 256 + slot] : 0; }
        }
        f32x16 S; float mx = -INFINITY;
#pragma unroll
        for (int i = 0; i < 16; ++i) S[i] = 0.f;
        if (act) {
#pragma unroll
            for (int s = 0; s < 16; ++s) S = MFMA32(*(const LAS bf16x8*)(IMG + (32 * w + r) * 512 + (((2 * s + h) ^ dsa_fsw(r)) * 16)), *(const LAS bf16x8*)(QB + s * 1024 + lane * 16), S);
#pragma unroll
            for (int s = 0; s < 3; ++s) S = MFMA32(kpe[s], *(const LAS bf16x8*)(QB + (16 + s) * 1024 + lane * 16), S);
#pragma unroll
            for (int i = 0; i < 16; ++i) { S[i] = (32 * w + crow(i, h) < cnt) ? S[i] : -INFINITY; mx = fmaxf(mx, S[i]); }
            mx = fmaxf(mx, __shfl_xor(mx, 32));
        }
        if (h == 0) MX[w * 32 + r] = mx;
        LDS_WAIT(); __builtin_amdgcn_s_barrier(); asm volatile("" ::: "memory");
        float M = MX[r];
#pragma unroll
        for (int k = 1; k < 8; ++k) M = fmaxf(M, MX[k * 32 + r]);
        float lsum = 0.f; bf16x8 pf[2] = {(bf16x8){0, 0, 0, 0, 0, 0, 0, 0}, (bf16x8){0, 0, 0, 0, 0, 0, 0, 0}};
        if (act) {
#pragma unroll
            for (int i = 0; i < 16; ++i) { S[i] = __builtin_amdgcn_exp2f(S[i] - M); lsum += S[i]; }
#pragma unroll
            for (int s = 0; s < 2; ++s) { u32x4 t; t.x = pk2(S[8 * s], S[8 * s + 1]); t.y = pk2(S[8 * s + 2], S[8 * s + 3]); t.z = pk2(S[8 * s + 4], S[8 * s + 5]); t.w = pk2(S[8 * s + 6], S[8 * s + 7]); pf[s] = __builtin_bit_cast(bf16x8, t); }
        }
        lsum += __shfl_xor(lsum, 32);
        if (h == 0) SX[w * 32 + r] = lsum;
        *(LAS bf16x8*)(QB + (2 * w) * 1024 + lane * 16) = pf[0]; *(LAS bf16x8*)(QB + (2 * w + 1) * 1024 + lane * 16) = pf[1];
        LDS_WAIT(); __builtin_amdgcn_s_barrier(); asm volatile("" ::: "memory");
        f32x16 O;
#pragma unroll
        for (int i = 0; i < 16; ++i) O[i] = 0.f;
#pragma unroll 2
        for (int ks = 0; ks < 2 * nch; ++ks) {
            const int r0 = 16 * ks + 4 * h + tq_, r1 = r0 + 8, pc = 4 * w + 2 * blk + (tp_ >> 1);
            const s16x4 lo = __builtin_bit_cast(s16x4, __builtin_amdgcn_ds_read_tr16_b64_v4i16((LAS v4i16_t*)(IMG + r0 * 512 + ((pc ^ dsa_fsw(r0)) * 16) + 8 * (tp_ & 1))));
            const s16x4 hi = __builtin_bit_cast(s16x4, __builtin_amdgcn_ds_read_tr16_b64_v4i16((LAS v4i16_t*)(IMG + r1 * 512 + ((pc ^ dsa_fsw(r1)) * 16) + 8 * (tp_ & 1))));
            O = MFMA32(__builtin_shufflevector(lo, hi, 0, 1, 2, 3, 4, 5, 6, 7), *(const LAS bf16x8*)(QB + ks * 1024 + lane * 16), O);
        }
        float l = SX[r];
#pragma unroll
        for (int k = 1; k < 8; ++k) l += SX[k * 32 + r];
        const float linv = 1.0f / l;
        bf16* o = (dry ? (bf16*)(ar + DUMMY_OFF) + (size_t)blockIdx.x * 8192 : QL + (size_t)ml * 8192) + r * 256 + 32 * w + 4 * h;
#pragma unroll
        for (int g = 0; g < 4; ++g) { u32x2 t; t.x = pk2(O[4 * g] * linv, O[4 * g + 1] * linv); t.y = pk2(O[4 * g + 2] * linv, O[4 * g + 3] * linv); *(u32x2*)(o + 8 * g) = t; }
        LDS_WAIT(); __builtin_amdgcn_s_barrier(); asm volatile("" ::: "memory");
    }
}
template <int NDB, bool RESC = true> DI void softmax_step(f32x16& S, float& m, float& l, f32x16 (&O)[NDB], bf16x8 (&pf)[2]) {
    float mx = fmaxf(S[0], S[1]);
#pragma unroll
    for (int i = 2; i < 16; i += 2) mx = __builtin_fmaxf(mx, __builtin_fmaxf(S[i], S[i + 1]));
    mx = fmaxf(mx, __shfl_xor(mx, 32));
    const float mn = fmaxf(m, mx), ms = (mn == -INFINITY) ? 0.f : mn;
    const float alpha = __builtin_amdgcn_exp2f(m - ms);
    float sum = 0.f;
#pragma unroll
    for (int i = 0; i < 16; ++i) { S[i] = __builtin_amdgcn_exp2f(S[i] - ms); sum += S[i]; }
    l = l * alpha + sum; m = mn;
    if (RESC && __builtin_amdgcn_ballot_w64(alpha != 1.0f) != 0ull) {
#pragma unroll
        for (int db = 0; db < NDB; ++db)
#pragma unroll
            for (int i = 0; i < 16; ++i) O[db][i] *= alpha;
    }
#pragma unroll
    for (int s = 0; s < 2; ++s) { u32x4 w; w.x = pk2(S[8 * s], S[8 * s + 1]); w.y = pk2(S[8 * s + 2], S[8 * s + 3]); w.z = pk2(S[8 * s + 4], S[8 * s + 5]); w.w = pk2(S[8 * s + 6], S[8 * s + 7]); pf[s] = __builtin_bit_cast(bf16x8, w); }
}
template <int NQ, int NDB, bool PV, bool QL, bool FRAG, class KA, class VA, class MK>
DI void attn_run(const bf16x8 (&qf)[NQ], const LAS unsigned char* qlds, f32x16 (&O)[NDB], float& m, float& l, int tb, int te, const KA& ka, const VA& va, const MK& mk) {
    if (tb >= te) return;
    bf16x8 kf[NQ];
    { const bf16* kp = ka(tb);
#pragma unroll
      for (int s = 0; s < NQ; ++s) kf[s] = *(const bf16x8*)(kp + (FRAG ? 512 : 16) * s); }
    for (int t = tb; t < te; ++t) {
        bf16x8 vf[NDB][2];
        if (PV) {
#pragma unroll
            for (int db = 0; db < NDB; ++db) { const bf16* vp = va(t, db);
#pragma unroll
                for (int s = 0; s < 2; ++s) { if (FRAG) vf[db][s] = *(const bf16x8*)(vp + 512 * s); else vf[db][s] = __builtin_shufflevector(*(const s16x4*)(vp + 16 * s), *(const s16x4*)(vp + 16 * s + 8), 0, 1, 2, 3, 4, 5, 6, 7); } }
        }
        f32x16 S;
#pragma unroll
        for (int i = 0; i < 16; ++i) S[i] = 0.f;
#pragma unroll
        for (int s = 0; s < NQ; ++s) { if (QL) { unsigned qa_ = (unsigned)(size_t)qlds; asm volatile("" : "+v"(qa_)); S = MFMA32(kf[s], *(const LAS bf16x8*)((LAS unsigned char*)(size_t)qa_ + s * 1024), S); } else S = MFMA32(kf[s], qf[s], S); }
        if (t + 1 < te) { const bf16* kp = ka(t + 1);
#pragma unroll
            for (int s = 0; s < NQ; ++s) kf[s] = *(const bf16x8*)(kp + (FRAG ? 512 : 16) * s); }
        mk(t, S);
        bf16x8 pf[2]; softmax_step<NDB>(S, m, l, O, pf);
        if (PV) {
#pragma unroll
            for (int db = 0; db < NDB; ++db)
#pragma unroll
                for (int s = 0; s < 2; ++s) O[db] = MFMA32(vf[db][s], pf[s], O[db]);
        }
    }
}
template <bool ACC> DI void store_col(bf16* out, const f32x16 (&O)[4], float scale, int h) {
#pragma unroll
    for (int db = 0; db < 4; ++db)
#pragma unroll
        for (int g = 0; g < 4; ++g) { u32x2* p = (u32x2*)(out + db * 32 + 8 * g + 4 * h);
            float a = O[db][4 * g] * scale, b = O[db][4 * g + 1] * scale, c = O[db][4 * g + 2] * scale, d = O[db][4 * g + 3] * scale;
            if (ACC) { const u32x2 o = *p; a += bflo(o.x); b += bfhi(o.x); c += bflo(o.y); d += bfhi(o.y); }
            u32x2 w; w.x = pk2(a, b); w.y = pk2(c, d); *p = w; }
}
template <int NQ> struct TilePre { u32x4 a, b, c; };
template <int NQ, class SRC> DI void tile_fetch(TilePre<NQ>& p, const SRC& src, int T, int tid) {
    const bf16* k = src.k(T); const bf16* v = src.v(T);
    constexpr int NK = NQ * 64;
    p.a = *(const u32x4*)(k + (size_t)tid * 8);
    const int p1 = tid + 512; p.b = (p1 < NK) ? *(const u32x4*)(k + (size_t)p1 * 8) : *(const u32x4*)(v + (size_t)(p1 - NK) * 8);
    if (NQ * 64 + 512 > 1024) { const int p2 = tid + 1024; if (p2 < NK + 512) p.c = *(const u32x4*)(v + (size_t)(p2 - NK) * 8); }
}
template <int NQ> DI void tile_put(const TilePre<NQ>& p, LAS unsigned char* buf, int tid) {
    *(LAS u32x4*)(buf + tid * 16) = p.a; *(LAS u32x4*)(buf + (tid + 512) * 16) = p.b;
    if (NQ * 64 + 512 > 1024) { if (tid + 1024 < NQ * 64 + 512) *(LAS u32x4*)(buf + (tid + 1024) * 16) = p.c; }
}
template <int NQ, bool PV, class SRC, class MK>
DI void attn_run_sh(LAS unsigned char* tl, int tid, int lane, const bf16x8 (&qf)[NQ], f32x16 (&O)[4], float& m, float& l, int TB, int TE, int tb, int te, const SRC& src, const MK& mk) {
    constexpr int TBYTES = (NQ + 8) * 1024;
    if (TB >= TE) return;
    TilePre<NQ> pre;
    tile_fetch<NQ>(pre, src, TB, tid); tile_put<NQ>(pre, tl, tid);
    LDS_WAIT(); __builtin_amdgcn_s_barrier(); asm volatile("" ::: "memory");
#pragma unroll 1
    for (int T = TB; T < TE; ++T) {
        LAS unsigned char* cur = tl + ((T - TB) & 1) * TBYTES;
        if (T + 1 < TE) tile_fetch<NQ>(pre, src, T + 1, tid);
        if (T >= tb && T < te) {
            f32x16 S;
#pragma unroll
            for (int i = 0; i < 16; ++i) S[i] = 0.f;
#pragma unroll
            for (int s = 0; s < NQ; ++s) S = MFMA32(*(const LAS bf16x8*)(cur + s * 1024 + lane * 16), qf[s], S);
            if (mk.need(T)) mk(T, S);
            bf16x8 pf[2]; softmax_step<4, PV>(S, m, l, O, pf);
            if (PV) {
#pragma unroll
                for (int db = 0; db < 4; ++db)
#pragma unroll
                    for (int s = 0; s < 2; ++s) O[db] = MFMA32(*(const LAS bf16x8*)(cur + (NQ + db * 2 + s) * 1024 + lane * 16), pf[s], O[db]);
            }
        }
        if (T + 1 < TE) tile_put<NQ>(pre, tl + ((T + 1 - TB) & 1) * TBYTES, tid);
        LDS_WAIT(); __builtin_amdgcn_s_barrier(); asm volatile("" ::: "memory");
    }
}
struct FragSrc { const bf16* kb; const bf16* vb; int nq; DI const bf16* k(int T) const { return kb + (size_t)T * nq * 512; } DI const bf16* v(int T) const { return vb + (size_t)T * 8 * 512; } };
constexpr size_t FA_Q = 0, FA_K = 64 * MiB, FA_F = 128 * MiB, FA_V = 136 * MiB, FA_CUM = 200 * MiB, FA_O = 202 * MiB, FA_KF = 266 * MiB, FA_VF = 338 * MiB;
constexpr size_t FW_IN = 0, FW_OUT = (size_t)6400 * 2048;
constexpr float FOX_QSCALE = 0.08838834764831845f * LOG2E;
DI void ph_fox_cvt(const Frame& F, const float* w_in, const float* w_out) {
    bf16* WB = (bf16*)(F.ws + WS_WMIX);
    cvt_job(F, w_in, 6160, DM, 0, 2048, WB + FW_IN, DM, 0, FOX_QSCALE);
    cvt_job(F, w_in, 6160, DM, 2048, 2048, WB + FW_IN, DM, 2048, 1.f);
    cvt_job(F, w_in, 6160, DM, 4096, 2048, WB + FW_IN, DM, 4096, 1.f);
    cvt_job(F, w_in, 6160, DM, 6144, 16, WB + FW_IN, DM, 6144, 1.f);
    zero_bf16(F, WB + FW_IN + (size_t)6160 * DM, (size_t)240 * DM);
    cvt_job(F, w_out, DM, DM, 0, DM, WB + FW_OUT, DM, 0, 1.f);
}
DI void ph_fox_scan(const Frame& F, const float* b_f) {
    unsigned char* ar = F.ws + WS_AR; const bf16* FB = (const bf16*)(ar + FA_F); float* CUM = (float*)(ar + FA_CUM);
    for (int w = F.gw; w < BPH * 16; w += F.NGW) {
        const int bl = w >> 4, hd = w & 15; const float bf_ = b_f[hd];
        float v[64]; float run = 0.f;
#pragma unroll
        for (int i = 0; i < 64; ++i) { const float x = bf2f(FB[(size_t)(bl * SEQ + F.lane * 64 + i) * 256 + hd]) + bf_;
            const float ls = fminf(x, 0.f) - log1pf(expf(-fabsf(x))); run += ls; v[i] = run; }
        float inc = run;
#pragma unroll
        for (int o = 1; o < 64; o <<= 1) { const float y = __shfl_up(inc, o); if (F.lane >= o) inc += y; }
        const float base = inc - run;
        float* dst = CUM + (size_t)w * SEQ + F.lane * 64;
#pragma unroll
        for (int i = 0; i < 64; i += 4) *(f32x4*)(dst + i) = (f32x4){(v[i] + base) * LOG2E, (v[i + 1] + base) * LOG2E, (v[i + 2] + base) * LOG2E, (v[i + 3] + base) * LOG2E};
        bf16* KF9 = (bf16*)(ar + FA_KF) + (size_t)w * 128 * 9 * 512;
#pragma unroll
        for (int i = 0; i < 64; ++i) { const int p = F.lane * 64 + i, tile = p >> 5, r_ = p & 31; const float c = (v[i] + base) * LOG2E;
            const unsigned short hi = f2bf(c); const float c1 = c - bf2f(hi); const unsigned short mid = f2bf(c1); const unsigned short lo = f2bf(c1 - bf2f(mid));
            u32x4 wv; wv.x = 0x3F803F80u; wv.y = 0x3F80u | ((unsigned)(hi ^ 0x8000u) << 16); wv.z = (unsigned)(mid ^ 0x8000u) | ((unsigned)(lo ^ 0x8000u) << 16); wv.w = 0u;
            bf16* d = KF9 + ((size_t)(tile * 9 + 8) * 64 + r_) * 8;
            *(u32x4*)d = wv; *(u32x4*)(d + 32 * 8) = (u32x4){0u, 0u, 0u, 0u}; }
    }
    const bf16* Kr = (const bf16*)(ar + FA_K); const bf16* Vr = (const bf16*)(ar + FA_V); bf16* KF = (bf16*)(ar + FA_KF); bf16* VF = (bf16*)(ar + FA_VF);
    const int r = F.lane & 31, h = F.lane >> 5;
    for (int u = F.gw; u < BPH * 16 * 128; u += F.NGW) {
        const int bh = u >> 7, tile = u & 127, bl = bh >> 4, hd = bh & 15;
        const bf16* krow_ = Kr + ((size_t)bl * SEQ + tile * 32 + r) * DM + hd * 128 + 8 * h;
        bf16* kd = KF + (((size_t)bh * 128 + tile) * 9 * 64 + F.lane) * 8;
#pragma unroll
        for (int s = 0; s < 8; ++s) *(u32x4*)(kd + s * 512) = *(const u32x4*)(krow_ + 16 * s);
        bf16* vd = VF + (((size_t)bh * 128 + tile) * 8 * 64 + F.lane) * 8;
#pragma unroll
        for (int db = 0; db < 4; ++db)
#pragma unroll
            for (int s = 0; s < 2; ++s) { unsigned short e[8];
#pragma unroll
                for (int j = 0; j < 8; ++j) e[j] = Vr[((size_t)bl * SEQ + tile * 32 + 16 * s + 8 * (j >> 2) + 4 * h + (j & 3)) * DM + hd * 128 + db * 32 + r];
                u32x4 w; w.x = e[0] | ((unsigned)e[1] << 16); w.y = e[2] | ((unsigned)e[3] << 16); w.z = e[4] | ((unsigned)e[5] << 16); w.w = e[6] | ((unsigned)e[7] << 16);
                *(u32x4*)(vd + (db * 2 + s) * 512) = w; }
    }
}
struct FragKA { const bf16* base; int nq; DI const bf16* operator()(int t) const { return base + (size_t)t * nq * 512; } };
struct FragVA { const bf16* base; DI const bf16* operator()(int t, int db) const { return base + ((size_t)t * 8 + db * 2) * 512; } };
struct FoxMK { int tq, h, qt; DI bool need(int t) const { return t == qt; }
    DI void operator()(int t, f32x16& S) const {
#pragma unroll
        for (int i = 0; i < 16; ++i) S[i] = (32 * t + crow(i, h) <= tq) ? S[i] : -INFINITY;
    } };
DI void ph_fox_attn(const Frame& F, const int dry = 0) {
    unsigned char* ar = F.ws + WS_AR; const bf16* Q = (const bf16*)(ar + FA_Q); const bf16* KF = (const bf16*)(ar + FA_KF); const bf16* VF = (const bf16*)(ar + FA_VF); const float* CUM = (const float*)(ar + FA_CUM); bf16* Ob = (bf16*)(ar + FA_O);
    const int r = F.lane & 31, h = F.lane >> 5;
    for (int wb = blockIdx.x; wb < BPH * 16 * 4; wb += F.G) {
        const int bh = wb >> 2, x = (wb & 3) * 8 + F.wave, bl = bh >> 4, hd = bh & 15;
#pragma unroll 1
        for (int k = 0; k < 4; ++k) {
            const int qt = (k == 0) ? x : (k == 1) ? 63 - x : (k == 2) ? 64 + x : 127 - x;
            const int qhi = (k == 0) ? (wb & 3) * 8 + 7 : (k == 1) ? 63 - (wb & 3) * 8 : (k == 2) ? 64 + (wb & 3) * 8 + 7 : 127 - (wb & 3) * 8;
            const int tq = qt * 32 + r; const size_t mrow = (size_t)bl * SEQ + tq;
            bf16x8 qf[9];
#pragma unroll
            for (int s = 0; s < 8; ++s) qf[s] = *(const bf16x8*)(Q + mrow * DM + hd * 128 + 16 * s + 8 * h);
            { const float ct = CUM[(size_t)bh * SEQ + tq]; const unsigned short hi = f2bf(ct); const float c1 = ct - bf2f(hi); const unsigned short mid = f2bf(c1); const unsigned short lo = f2bf(c1 - bf2f(mid));
              u32x4 wq; wq.x = (unsigned)hi | ((unsigned)mid << 16); wq.y = (unsigned)lo | (0x3F80u << 16); wq.z = 0x3F803F80u; wq.w = 0u;
              if (h) wq = (u32x4){0u, 0u, 0u, 0u};
              qf[8] = __builtin_bit_cast(bf16x8, wq); }
            f32x16 O[4];
#pragma unroll
            for (int db = 0; db < 4; ++db)
#pragma unroll
                for (int i = 0; i < 16; ++i) O[db][i] = 0.f;
            float m = -INFINITY, l = 0.f;
            const FragSrc src{KF + (size_t)bh * 128 * 9 * 512, VF + (size_t)bh * 128 * 8 * 512, 9}; const FoxMK mk{tq, h, qt};
            attn_run_sh<9, true>(F.lds, F.tid, F.lane, qf, O, m, l, 0, qhi + 1, 0, qt + 1, src, mk);
            l += __shfl_xor(l, 32);
            store_col<false>(dry ? (bf16*)(ar + DUMMY_OFF) + ((size_t)F.gw * 32 + r) * 128 : Ob + mrow * DM + hd * 128, O, l > 0.f ? 1.0f / l : 0.f, h);
        }
    }
}
typedef long fp8x8_t;
DI fp8x8_t pack_fp8x8(float a0, float a1, float a2, float a3, float a4, float a5, float a6, float a7) {
    int lo = 0, hi = 0;
    lo = __builtin_amdgcn_cvt_pk_fp8_f32(a0, a1, lo, false); lo = __builtin_amdgcn_cvt_pk_fp8_f32(a2, a3, lo, true);
    hi = __builtin_amdgcn_cvt_pk_fp8_f32(a4, a5, hi, false); hi = __builtin_amdgcn_cvt_pk_fp8_f32(a6, a7, hi, true);
    return (fp8x8_t)(((unsigned long long)(unsigned)hi << 32) | (unsigned long long)(unsigned)lo);
}
#define MFMA32F8(a, b, c) __builtin_amdgcn_mfma_f32_32x32x16_fp8_fp8((a), (b), (c), 0, 0, 0)
constexpr size_t NA_Q = 0, NA_KC = 288 * MiB, NA_VC = 313 * MiB, NA_KSR = 330 * MiB, NA_KWR = 354 * MiB, NA_GT = 378 * MiB, NA_VSR = 386 * MiB, NA_VWR = 402 * MiB, NA_GK = 418 * MiB, NA_GV = 420 * MiB,
                 NA_KCMP = 422 * MiB, NA_VCT = 424 * MiB, NA_SELB = 426 * MiB, NA_O = 428 * MiB,
                 NA_KSF = 620 * MiB, NA_KWF = 644 * MiB, NA_VSF = 668 * MiB, NA_VWF = 684 * MiB;
constexpr size_t NW_IN = 0, NW_W1K = (size_t)13312 * 2048, NW_W1V = NW_W1K + (size_t)256 * 6144, NW_W2K = NW_W1V + (size_t)256 * 4096, NW_W2V = NW_W2K + 65536, NW_OUT = NW_W2V + 65536;
constexpr float NSA_QSCALE = 0.07216878364870322f * LOG2E;
DI void ph_nsa_cvt(const Frame& F, const float* w_in, const float* k_pe, const float* k_w1, const float* k_b1, const float* k_w2, const float* v_pe, const float* v_w1, const float* v_b1, const float* v_w2, const float* w_out) {
    bf16* WB = (bf16*)(F.ws + WS_WMIX); float* BIAS = (float*)(F.ws + WS_MISC);
    cvt_job(F, w_in, 13200, DM, 0, 9216, WB + NW_IN, DM, 0, NSA_QSCALE);
    cvt_job(F, w_in, 13200, DM, 9216, 768, WB + NW_IN, DM, 9216, 1.f);
    cvt_job(F, w_in, 13200, DM, 9984, 512, WB + NW_IN, DM, 9984, 1.f);
    cvt_job(F, w_in, 13200, DM, 10496, 768, WB + NW_IN, DM, 10496, 1.f);
    cvt_job(F, w_in, 13200, DM, 11776, 768, WB + NW_IN, DM, 11264, 1.f);
    cvt_job(F, w_in, 13200, DM, 13056, 144, WB + NW_IN, DM, 12032, 1.f);
    zero_bf16(F, WB + NW_IN + (size_t)12176 * DM, (size_t)112 * DM);
    cvt_job(F, w_in, 13200, DM, 11264, 512, WB + NW_IN, DM, 12288, 1.f);
    cvt_job(F, w_in, 13200, DM, 12544, 512, WB + NW_IN, DM, 12800, 1.f);
    cvt_job(F, k_w1, 256, 6144, 0, 256, WB + NW_W1K, 6144, 0, 1.f);
    cvt_job(F, v_w1, 256, 4096, 0, 256, WB + NW_W1V, 4096, 0, 1.f);
    cvt_job(F, k_w2, 192, 256, 0, 192, WB + NW_W2K, 256, 0, 1.f); zero_bf16(F, WB + NW_W2K + 192 * 256, 64 * 256);
    cvt_job(F, v_w2, 128, 256, 0, 128, WB + NW_W2V, 256, 0, 1.f); zero_bf16(F, WB + NW_W2V + 128 * 256, 128 * 256);
    cvt_job(F, w_out, DM, 6144, 0, DM, WB + NW_OUT, 6144, 0, 1.f);
    for (int w = F.gw; w < 512; w += F.NGW) { const bool isk = w < 256; const int c = w & 255, n = isk ? 6144 : 4096; const float* pe = isk ? k_pe : v_pe; const float* w1 = isk ? k_w1 : v_w1;
        float s = 0.f; for (int i = F.lane; i < n; i += 64) s += pe[i] * w1[(size_t)i * 256 + c];
        s = wave_sum(s); if (F.lane == 0) BIAS[w] = s + (isk ? k_b1[c] : v_b1[c]); }
}
DI void ph_nsa_rope(const Frame& F, int half) {
    unsigned char* ar = F.ws + WS_AR; bf16* Q = (bf16*)(ar + NA_Q); bf16* KC = (bf16*)(ar + NA_KC);
    const bf16* KSR = (const bf16*)(ar + NA_KSR); const bf16* KWR = (const bf16*)(ar + NA_KWR); bf16* KSF = (bf16*)(ar + NA_KSF); bf16* KWF = (bf16*)(ar + NA_KWF);
    const float* c48 = (const float*)(F.ws + TAB_COS48); const float* s48 = (const float*)(F.ws + TAB_SIN48);
    for (int ml = F.gw; ml < MC; ml += F.NGW) {
        const size_t mg = (size_t)half * MC + ml; const int bl = ml >> 12, sq = ml & 4095;
        for (int p = F.lane; p < 96; p += 64) {
            const int hd = 48 + p / 24, i = p - (p / 24) * 24; bf16* q;
            q = KC + ((size_t)(bl * 4 + hd - 48) * 4096 + sq) * 192 + i;
            const float x1 = bf2f(q[0]), x2 = bf2f(q[24]), c = c48[mg * 24 + i], s = s48[mg * 24 + i]; q[0] = f2bf(x1 * c - x2 * s); q[24] = f2bf(x1 * s + x2 * c);
        }
        const int tile = sq >> 5, rr = sq & 31;
        for (int u = F.lane; u < 168; u += 64) {
            const int tens = u / 84, uu = u - tens * 84, g = uu / 21, v = uu - g * 21;
            const bf16* src = (tens ? KWR : KSR) + (size_t)ml * 768 + g * 192;
            bf16* dst = (tens ? KWF : KSF) + ((size_t)((bl * 4 + g) * 128 + tile) * 12 * 64 + rr) * 8;
            if (v < 3) {
                const u32x4 a = *(const u32x4*)(src + 8 * v), b = *(const u32x4*)(src + 8 * v + 24); u32x4 o1, o2;
#pragma unroll
                for (int e = 0; e < 4; ++e) { const float c0 = c48[mg * 24 + 8 * v + 2 * e], s0 = s48[mg * 24 + 8 * v + 2 * e], c1 = c48[mg * 24 + 8 * v + 2 * e + 1], s1 = s48[mg * 24 + 8 * v + 2 * e + 1];
                    const float x1l = bflo(a[e]), x1h = bfhi(a[e]), x2l = bflo(b[e]), x2h = bfhi(b[e]);
                    o1[e] = pk2(x1l * c0 - x2l * s0, x1h * c1 - x2h * s1); o2[e] = pk2(x1l * s0 + x2l * c0, x1h * s1 + x2h * c1); }
                const int p1 = v, p2 = v + 3;
                if (tens) { *(u32x4*)(dst + ((p1 >> 1) * 64 + (p1 & 1) * 32) * 8) = o1; *(u32x4*)(dst + ((p2 >> 1) * 64 + (p2 & 1) * 32) * 8) = o2; }
                else { unsigned char* d8 = (unsigned char*)KSF + ((size_t)(((bl * 4 + g) * 128 + tile) * 2 + (rr >> 4)) * 6 * 64 + (rr & 15)) * 8;
                    *(fp8x8_t*)(d8 + ((p1 >> 2) * 64 + (p1 & 3) * 16) * 8) = pack_fp8x8(bflo(o1[0]), bfhi(o1[0]), bflo(o1[1]), bfhi(o1[1]), bflo(o1[2]), bfhi(o1[2]), bflo(o1[3]), bfhi(o1[3]));
                    *(fp8x8_t*)(d8 + ((p2 >> 2) * 64 + (p2 & 3) * 16) * 8) = pack_fp8x8(bflo(o2[0]), bfhi(o2[0]), bflo(o2[1]), bfhi(o2[1]), bflo(o2[2]), bfhi(o2[2]), bflo(o2[3]), bfhi(o2[3])); }
            } else { const int pc = v + 3; const u32x4 c = *(const u32x4*)(src + 8 * pc);
                if (tens) *(u32x4*)(dst + ((pc >> 1) * 64 + (pc & 1) * 32) * 8) = c;
                else { unsigned char* d8 = (unsigned char*)KSF + ((size_t)(((bl * 4 + g) * 128 + tile) * 2 + (rr >> 4)) * 6 * 64 + (rr & 15)) * 8;
                    *(fp8x8_t*)(d8 + ((pc >> 2) * 64 + (pc & 3) * 16) * 8) = pack_fp8x8(bflo(c[0]), bfhi(c[0]), bflo(c[1]), bfhi(c[1]), bflo(c[2]), bfhi(c[2]), bflo(c[3]), bfhi(c[3])); } }
        }
    }
    const bf16* VSR = (const bf16*)(ar + NA_VSR); const bf16* VWR = (const bf16*)(ar + NA_VWR); bf16* VSF = (bf16*)(ar + NA_VSF); bf16* VWF = (bf16*)(ar + NA_VWF);
    const int r = F.lane & 31, h = F.lane >> 5;
    for (int u = F.gw; u < 2 * BPH * 4 * 128; u += F.NGW) {
        const int tens = u >> 11, bg = (u >> 7) & 15, tile = u & 127, bl = bg >> 2, g = bg & 3;
        if (tens) {
            const bf16* src = VWR + ((size_t)bl * SEQ + tile * 32) * 512 + g * 128 + r;
            bf16* vd = VWF + (((size_t)bg * 128 + tile) * 8 * 64 + F.lane) * 8;
#pragma unroll
            for (int db = 0; db < 4; ++db)
#pragma unroll
                for (int s = 0; s < 2; ++s) { unsigned short e[8];
#pragma unroll
                    for (int j = 0; j < 8; ++j) e[j] = src[(size_t)(16 * s + 8 * (j >> 2) + 4 * h + (j & 3)) * 512 + db * 32];
                    u32x4 w; w.x = e[0] | ((unsigned)e[1] << 16); w.y = e[2] | ((unsigned)e[3] << 16); w.z = e[4] | ((unsigned)e[5] << 16); w.w = e[6] | ((unsigned)e[7] << 16);
                    *(u32x4*)(vd + (db * 2 + s) * 512) = w; }
        } else {
            const int d16 = F.lane & 15, kq = F.lane >> 4;
            const bf16* src = VSR + ((size_t)bl * SEQ + tile * 32) * 512 + g * 128 + d16;
            unsigned char* vd = (unsigned char*)VSF + (((size_t)bg * 128 + tile) * 8 * 64 + F.lane) * 8;
#pragma unroll
            for (int db = 0; db < 8; ++db) { float e[8];
#pragma unroll
                for (int j = 0; j < 8; ++j) e[j] = bf2f(src[(size_t)((j < 4 ? 4 * kq + j : 16 + 4 * kq + j - 4)) * 512 + db * 16]);
                *(fp8x8_t*)(vd + db * 512) = pack_fp8x8(e[0], e[1], e[2], e[3], e[4], e[5], e[6], e[7]); }
        }
    }
}
DI void rope_piece(const bf16* qrow, int p, const float* cs, const float* sn, float (&o)[8]) {
    const bool lo = p < 3; const int pp = lo ? p + 3 : p - 3, i0 = 8 * (lo ? p : p - 3);
    const u32x4 a = *(const u32x4*)(qrow + 8 * p), b = *(const u32x4*)(qrow + 8 * pp);
    const f32x4 c0 = *(const f32x4*)(cs + i0), c1 = *(const f32x4*)(cs + i0 + 4), s0 = *(const f32x4*)(sn + i0), s1 = *(const f32x4*)(sn + i0 + 4);
#pragma unroll
    for (int e = 0; e < 4; ++e) { const float c_l = e < 2 ? c0[2 * e] : c1[2 * e - 4], c_h = e < 2 ? c0[2 * e + 1] : c1[2 * e - 3], s_l = e < 2 ? s0[2 * e] : s1[2 * e - 4], s_h = e < 2 ? s0[2 * e + 1] : s1[2 * e - 3];
        const float al = bflo(a[e]), ah = bfhi(a[e]), bl_ = bflo(b[e]), bh_ = bfhi(b[e]);
        o[2 * e] = lo ? al * c_l - bl_ * s_l : bl_ * s_l + al * c_l; o[2 * e + 1] = lo ? ah * c_h - bh_ * s_h : bh_ * s_h + ah * c_h; }
}
DI bf16x8 rope_frag32(const bf16* qrow, int s, int h, const float* cs, const float* sn) {
    float o[8]; rope_piece(qrow, 2 * s + h, cs, sn, o);
    u32x4 w; w.x = pk2(o[0], o[1]); w.y = pk2(o[2], o[3]); w.z = pk2(o[4], o[5]); w.w = pk2(o[6], o[7]); return __builtin_bit_cast(bf16x8, w);
}
DI float sigmoidf_(float x) { return __builtin_amdgcn_rcpf(1.0f + __builtin_amdgcn_exp2f(-x * LOG2E)); }
struct LinKA { const bf16* base; size_t tstride; DI const bf16* operator()(int t) const { return base + (size_t)t * tstride; } };
struct LinVA { const bf16* base; size_t dbstride; DI const bf16* operator()(int t, int db) const { return base + (size_t)db * dbstride + t * 32; } };
struct CmpMK { int tq, h, q0; DI bool need(int t) const { return 512 * t + 527 > q0; }
    DI void operator()(int t, f32x16& S) const {
#pragma unroll
    for (int i = 0; i < 16; ++i) { const int n = 32 * t + crow(i, h); S[i] = (16 * n + 31 <= tq) ? S[i] : -INFINITY; } } };
struct WinMK { int tq, h, qt; DI bool need(int t) const { return t == qt || t == qt - 16; }
    DI void operator()(int t, f32x16& S) const {
#pragma unroll
    for (int i = 0; i < 16; ++i) { const int k = 32 * t + crow(i, h); S[i] = (k <= tq && k > tq - 512) ? S[i] : -INFINITY; } } };
DI void ph_nsa_cmp(const Frame& F, const int half, const int dry = 0) {
    const float* c48 = (const float*)(F.ws + TAB_COS48); const float* s48 = (const float*)(F.ws + TAB_SIN48);
    unsigned char* ar = F.ws + WS_AR; const bf16* Q = (const bf16*)(ar + NA_Q); const bf16* KCMP = (const bf16*)(ar + NA_KCMP); const bf16* VCT = (const bf16*)(ar + NA_VCT); const bf16* GT = (const bf16*)(ar + NA_GT);
    unsigned char* SELB = ar + NA_SELB; bf16* Ob = (bf16*)(ar + NA_O);
    LAS float* imp = (LAS float*)F.lds;
    LAS unsigned char* tl = F.lds + 20480;
    const int lane = F.lane, r = lane & 31, h = lane >> 5, tid = F.tid;
    for (int u = blockIdx.x; u < BPH * 4 * 64; u += F.G) {
        const int bg = u >> 6, qt64 = ((u >> 8) & 1) ? 63 - (u & 63) : (u & 63), bl = bg >> 2, g = bg & 3;
        for (int i = F.tid; i < 64 * 65; i += NWAVES * 64) imp[i] = 0.f;
        __syncthreads();
        const FragSrc src{KCMP + (size_t)bg * 8 * 12 * 512, VCT + (size_t)bg * 8 * 8 * 512, 12};
        const int tqmaxb = qt64 * 64 + 63, TE = (tqmaxb >= 31) ? ((tqmaxb - 31) / 16) / 32 + 1 : 0;
#pragma unroll 1
        for (int k = 0; k < 3; ++k) {
            const int idx = F.wave * 3 + k, j = idx >> 1, sub = idx & 1, ql = sub * 32 + r, tq = qt64 * 64 + ql, hd = g * 12 + j;
            const size_t mrow = (size_t)bl * SEQ + tq;
            bf16x8 qf[12];
#pragma unroll
            for (int s = 3; s < 12; ++s) qf[s] = *(const bf16x8*)(Q + mrow * 9216 + hd * 192 + 16 * s + 8 * h);
            { const float* cs = c48 + ((size_t)half * MC + mrow) * 24; const float* sn = s48 + ((size_t)half * MC + mrow) * 24;
#pragma unroll
              for (int s = 0; s < 3; ++s) qf[s] = rope_frag32(Q + mrow * 9216 + hd * 192, s, h, cs, sn); }
            const int tqmax = qt64 * 64 + sub * 32 + 31, te = (tqmax >= 31) ? ((tqmax - 31) / 16) / 32 + 1 : 0;
            const CmpMK mk{tq, h, qt64 * 64 + sub * 32};
            float m = -INFINITY, l = 0.f;
            { f32x16 Od[4];
              attn_run_sh<12, false>(tl, tid, lane, qf, Od, m, l, 0, TE, 0, te, src, mk); }
            l += __shfl_xor(l, 32);
            const float linv = l > 0.f ? 1.0f / l : 0.f, ms = (m == -INFINITY) ? 0.f : m;
            f32x16 O[4];
#pragma unroll
            for (int db = 0; db < 4; ++db)
#pragma unroll
                for (int i = 0; i < 16; ++i) O[db][i] = 0.f;
            if (TE > 0) {
                TilePre<12> pre;
                tile_fetch<12>(pre, src, 0, tid); tile_put<12>(pre, tl, tid);
                LDS_WAIT(); __builtin_amdgcn_s_barrier(); asm volatile("" ::: "memory");
#pragma unroll 1
                for (int t = 0; t < TE; ++t) {
                    LAS unsigned char* cur = tl + (t & 1) * 20480;
                    if (t + 1 < TE) tile_fetch<12>(pre, src, t + 1, tid);
                    if (t < te) {
                        f32x16 S;
#pragma unroll
                        for (int i = 0; i < 16; ++i) S[i] = 0.f;
#pragma unroll
                        for (int s = 0; s < 12; ++s) S = MFMA32(*(const LAS bf16x8*)(cur + s * 1024 + lane * 16), qf[s], S);
                        if (mk.need(t)) mk(t, S);
#pragma unroll
                        for (int i = 0; i < 16; ++i) S[i] = __builtin_amdgcn_exp2f(S[i] - ms) * linv;
#pragma unroll
                        for (int g4 = 0; g4 < 4; ++g4) { const float gs = (S[4 * g4] + S[4 * g4 + 1]) + (S[4 * g4 + 2] + S[4 * g4 + 3]); const int mb = 8 * t + 2 * g4 + h;
                            __hip_atomic_fetch_add(imp + ql * 65 + mb, gs, __ATOMIC_RELAXED, __HIP_MEMORY_SCOPE_WORKGROUP);
                            if (mb + 1 < 64) __hip_atomic_fetch_add(imp + ql * 65 + mb + 1, S[4 * g4 + 3], __ATOMIC_RELAXED, __HIP_MEMORY_SCOPE_WORKGROUP); }
                        bf16x8 pf[2];
#pragma unroll
                        for (int s = 0; s < 2; ++s) { u32x4 w; w.x = pk2(S[8 * s], S[8 * s + 1]); w.y = pk2(S[8 * s + 2], S[8 * s + 3]); w.z = pk2(S[8 * s + 4], S[8 * s + 5]); w.w = pk2(S[8 * s + 6], S[8 * s + 7]); pf[s] = __builtin_bit_cast(bf16x8, w); }
#pragma unroll
                        for (int db = 0; db < 4; ++db)
#pragma unroll
                            for (int s = 0; s < 2; ++s) O[db] = MFMA32(*(const LAS bf16x8*)(cur + (12 + db * 2 + s) * 1024 + lane * 16), pf[s], O[db]);
                    }
                    if (t + 1 < TE) tile_put<12>(pre, tl + ((t + 1) & 1) * 20480, tid);
                    LDS_WAIT(); __builtin_amdgcn_s_barrier(); asm volatile("" ::: "memory");
                }
            }
            const float gate = sigmoidf_(bf2f(GT[mrow * 256 + hd]));
            store_col<false>(dry ? (bf16*)(ar + DUMMY_OFF) + ((size_t)F.gw * 32 + r) * 128 : Ob + mrow * 6144 + hd * 128, O, gate, h);
        }
        __syncthreads();
#pragma unroll 1
        for (int k = 0; k < 8; ++k) {
            const int ql = F.wave * 8 + k, tq = qt64 * 64 + ql, cur = tq >> 6, mb = lane;
            const bool causal = mb <= cur, forced = (mb == 0) || (mb == cur) || (mb == cur - 1);
            const float v = causal ? (forced ? INFINITY : imp[ql * 65 + mb]) : -INFINITY;
            int rank = 0;
            for (int o = 0; o < 64; ++o) { const float vo = __shfl(v, o); rank += (vo > v || (vo == v && o < mb)) ? 1 : 0; }
            if (rank < 16) (dry ? ar + DUMMY_OFF + 32 * MiB + (size_t)F.gw * 16 : SELB + ((size_t)bg * 4096 + tq) * 16)[rank] = causal ? (unsigned char)mb : (unsigned char)0xFF;
        }
        __syncthreads();
    }
}
DI int sel_tile(const u32x4& sel, int t) { const int b = t >> 1; const unsigned w = (b < 4) ? sel.x : (b < 8) ? sel.y : (b < 12) ? sel.z : sel.w; return (int)((w >> ((b & 3) * 8)) & 0xFFu) * 2 + (t & 1); }
struct SelKA { const bf16* base; u32x4 sel; DI const bf16* operator()(int t) const { return base + (size_t)sel_tile(sel, t) * 12 * 512; } };
struct SelVA { const bf16* base; u32x4 sel; DI const bf16* operator()(int t, int db) const { return base + ((size_t)sel_tile(sel, t) * 8 + db * 2) * 512; } };
struct SelMK { u32x4 sel; int tq, h; DI void operator()(int t, f32x16& S) const { const int k0 = sel_tile(sel, t) * 32;
#pragma unroll
    for (int i = 0; i < 16; ++i) S[i] = (k0 + crow(i, h) <= tq) ? S[i] : -INFINITY; } };
typedef float f32x4_ __attribute__((ext_vector_type(4)));
#define MFMA16F8(a, b, c) __builtin_amdgcn_mfma_f32_16x16x32_fp8_fp8((a), (b), (c), 0, 0, 0)
DI void ph_nsa_sel(const Frame& F, const int half, const int dry = 0) {
    const float* c48 = (const float*)(F.ws + TAB_COS48); const float* s48 = (const float*)(F.ws + TAB_SIN48);
    unsigned char* ar = F.ws + WS_AR; const bf16* Q = (const bf16*)(ar + NA_Q); const unsigned char* KS8 = ar + NA_KSF; const unsigned char* VS8 = ar + NA_VSF; const bf16* GT = (const bf16*)(ar + NA_GT);
    const unsigned char* SELB = ar + NA_SELB; bf16* Ob = (bf16*)(ar + NA_O);
    const int c16 = F.lane & 15, kq = F.lane >> 4; const bool act = c16 < 12;
    for (int it = F.gw; it < BPH * 4 * SEQ; it += F.NGW) {
        const int bg = it >> 12, tq = ((it & 4095) + 256 * bg) & 4095, bl = bg >> 2, g = bg & 3; const size_t mrow = (size_t)bl * SEQ + tq; const int hd = g * 12 + (act ? c16 : 0);
        fp8x8_t qf[6];
#pragma unroll
        for (int s = 0; s < 6; ++s) { const float qs = act ? (1.0f / NSA_QSCALE) : 0.f; const int p = 4 * s + kq;
            if (s < 2 && p < 6) { float o[8]; rope_piece(Q + mrow * 9216 + hd * 192, p, c48 + ((size_t)half * MC + mrow) * 24, s48 + ((size_t)half * MC + mrow) * 24, o);
                qf[s] = pack_fp8x8(o[0] * qs, o[1] * qs, o[2] * qs, o[3] * qs, o[4] * qs, o[5] * qs, o[6] * qs, o[7] * qs); }
            else { const u32x4 q = *(const u32x4*)(Q + mrow * 9216 + hd * 192 + 32 * s + 8 * kq);
                qf[s] = pack_fp8x8(bflo(q[0]) * qs, bfhi(q[0]) * qs, bflo(q[1]) * qs, bfhi(q[1]) * qs, bflo(q[2]) * qs, bfhi(q[2]) * qs, bflo(q[3]) * qs, bfhi(q[3]) * qs); } }
        const u32x4 sel = *(const u32x4*)(SELB + ((size_t)bg * 4096 + tq) * 16);
        const int nv = ((tq >> 6) + 1 < 16) ? (tq >> 6) + 1 : 16, te = 2 * nv;
        const unsigned char* kb = KS8 + ((size_t)bg * 128 * 12 * 64 + F.lane) * 8; const unsigned char* vb = VS8 + ((size_t)bg * 128 * 8 * 64 + F.lane) * 8;
        f32x4_ O[8];
#pragma unroll
        for (int db = 0; db < 8; ++db) O[db] = (f32x4_){0.f, 0.f, 0.f, 0.f};
        float m = -INFINITY, l = 0.f;
        fp8x8_t kfA[12], kfB[12], vfA[8], vfB[8];
        { const unsigned char* kp = kb + (size_t)sel_tile(sel, 0) * 12 * 512; const unsigned char* kp1 = kb + (size_t)sel_tile(sel, 1) * 12 * 512; const unsigned char* vp = vb + (size_t)sel_tile(sel, 0) * 8 * 512;
#pragma unroll
          for (int s = 0; s < 12; ++s) { kfA[s] = *(const fp8x8_t*)(kp + s * 512); kfB[s] = *(const fp8x8_t*)(kp1 + s * 512); }
#pragma unroll
          for (int j = 0; j < 8; ++j) vfA[j] = *(const fp8x8_t*)(vp + j * 512); }
#define SEL_STEP(T_, KF_, VF_, VFN_) do { const int t_ = (T_); const int tile = sel_tile(sel, t_); \
            if (t_ + 1 < te) { const unsigned char* vp = vb + (size_t)sel_tile(sel, t_ + 1) * 8 * 512; _Pragma("unroll") for (int j = 0; j < 8; ++j) VFN_[j] = *(const fp8x8_t*)(vp + j * 512); } \
            f32x4_ S0 = {0.f, 0.f, 0.f, 0.f}, S1 = S0; \
            _Pragma("unroll") for (int s = 0; s < 6; ++s) { S0 = MFMA16F8(KF_[s], qf[s], S0); S1 = MFMA16F8(KF_[6 + s], qf[s], S1); } \
            if (t_ + 2 < te) { const unsigned char* kp = kb + (size_t)sel_tile(sel, t_ + 2) * 12 * 512; _Pragma("unroll") for (int s = 0; s < 12; ++s) KF_[s] = *(const fp8x8_t*)(kp + s * 512); } \
            const int k0 = tile * 32 + 4 * kq; float mx = -INFINITY; \
            _Pragma("unroll") for (int i = 0; i < 4; ++i) { S0[i] = (k0 + i <= tq) ? S0[i] * NSA_QSCALE : -INFINITY; S1[i] = (k0 + 16 + i <= tq) ? S1[i] * NSA_QSCALE : -INFINITY; mx = fmaxf(mx, fmaxf(S0[i], S1[i])); } \
            mx = fmaxf(mx, __shfl_xor(mx, 16)); mx = fmaxf(mx, __shfl_xor(mx, 32)); \
            const float mn = fmaxf(m, mx), ms = (mn == -INFINITY) ? 0.f : mn, alpha = __builtin_amdgcn_exp2f(m - ms); \
            float sum = 0.f; \
            _Pragma("unroll") for (int i = 0; i < 4; ++i) { S0[i] = __builtin_amdgcn_exp2f(S0[i] - ms); S1[i] = __builtin_amdgcn_exp2f(S1[i] - ms); sum += S0[i] + S1[i]; } \
            l = l * alpha + sum; m = mn; \
            if (__builtin_amdgcn_ballot_w64(alpha != 1.0f) != 0ull) { _Pragma("unroll") for (int db = 0; db < 8; ++db) O[db] = O[db] * alpha; } \
            const fp8x8_t p8 = pack_fp8x8(S0[0], S0[1], S0[2], S0[3], S1[0], S1[1], S1[2], S1[3]);       \
            _Pragma("unroll") for (int db = 0; db < 8; ++db) O[db] = MFMA16F8(VF_[db], p8, O[db]); } while (0)
#pragma unroll 1
        for (int t = 0; t < te; t += 2) { SEL_STEP(t, kfA, vfA, vfB); SEL_STEP(t + 1, kfB, vfB, vfA); }
#undef SEL_STEP
        l += __shfl_xor(l, 16); l += __shfl_xor(l, 32);
        if (act) { const float gate = sigmoidf_(bf2f(GT[mrow * 256 + 48 + hd])); const float sc = l > 0.f ? gate / l : 0.f;
            bf16* o = (dry ? (bf16*)(ar + DUMMY_OFF) + ((size_t)F.gw * 16 + c16) * 128 : Ob + mrow * 6144 + hd * 128) + 4 * kq;
#pragma unroll
            for (int db = 0; db < 8; ++db) { u32x2* p = (u32x2*)(o + db * 16); const u32x2 prev = *p;
                u32x2 w; w.x = pk2(O[db][0] * sc + bflo(prev.x), O[db][1] * sc + bfhi(prev.x)); w.y = pk2(O[db][2] * sc + bflo(prev.y), O[db][3] * sc + bfhi(prev.y)); *p = w; } }
    }
}
DI void ph_nsa_win(const Frame& F, const int half, const int dry = 0) {
    const float* c48 = (const float*)(F.ws + TAB_COS48); const float* s48 = (const float*)(F.ws + TAB_SIN48);
    unsigned char* ar = F.ws + WS_AR; const bf16* Q = (const bf16*)(ar + NA_Q); const bf16* KWF = (const bf16*)(ar + NA_KWF); const bf16* VWF = (const bf16*)(ar + NA_VWF); const bf16* GT = (const bf16*)(ar + NA_GT); bf16* Ob = (bf16*)(ar + NA_O);
    const int r = F.lane & 31, h = F.lane >> 5;
    for (int idb = blockIdx.x; idb < BPH * 48 * 16; idb += F.G) {
        const int qt0 = (((idb & 15) + (idb >> 8)) & 15) * 8, qt = qt0 + F.wave, bh = idb >> 4, hd = bh % 48, bl = bh / 48, g = hd / 12, bg = bl * 4 + g, tq = qt * 32 + r; const size_t mrow = (size_t)bl * SEQ + tq;
        bf16x8 qf[12];
#pragma unroll
        for (int s = 3; s < 12; ++s) qf[s] = *(const bf16x8*)(Q + mrow * 9216 + hd * 192 + 16 * s + 8 * h);
        { const float* cs = c48 + ((size_t)half * MC + mrow) * 24; const float* sn = s48 + ((size_t)half * MC + mrow) * 24;
#pragma unroll
          for (int s = 0; s < 3; ++s) qf[s] = rope_frag32(Q + mrow * 9216 + hd * 192, s, h, cs, sn); }
        const FragSrc src{KWF + (size_t)bg * 128 * 12 * 512, VWF + (size_t)bg * 128 * 8 * 512, 12}; const WinMK mk{tq, h, qt};
        f32x16 O[4];
#pragma unroll
        for (int db = 0; db < 4; ++db)
#pragma unroll
            for (int i = 0; i < 16; ++i) O[db][i] = 0.f;
        float m = -INFINITY, l = 0.f;
        attn_run_sh<12, true>(F.lds, F.tid, F.lane, qf, O, m, l, qt0 >= 16 ? qt0 - 16 : 0, qt0 + 8, qt >= 16 ? qt - 16 : 0, qt + 1, src, mk);
        l += __shfl_xor(l, 32);
        const float gate = sigmoidf_(bf2f(GT[mrow * 256 + 96 + hd]));
        store_col<true>(dry ? (bf16*)(ar + DUMMY_OFF) + ((size_t)F.gw * 32 + r) * 128 : Ob + mrow * 6144 + hd * 128, O, l > 0.f ? gate / l : 0.f, h);
    }
}
#ifndef MK_ONE_LAUNCH
#define MK_ONE_LAUNCH 1
#endif
constexpr int NPH = 74;
struct Args { const float* in[58]; float* out; unsigned char* ws; int ph_lo, ph_hi; };
#ifndef PROBE_GEMM
#define PROBE_GEMM 0
#endif
#ifndef PROBE_PH
#define PROBE_PH 0
#endif
#define GEMM_AKOFF 0
#define GEMM_CALL(EpiT, Evar, Aptr, Bptr, Mv, Nv, Kv, ldav, ldbv, cidx) do { if (PROBE_GEMM) { const pg8::Gemm g0_{(const pg8::bf16_t*)(Aptr), (const pg8::bf16_t*)(Bptr), (Mv), (Nv), (Kv), (ldav), (ldbv), GEMM_AKOFF}; \
    pg8::StaticOrder S0_; S0_.init((Mv), (Nv), F.G, (cidx)); pg8::EpiDry E0_{(float*)(ar + DUMMY_OFF)}; pg8::gemm_phase<pg8::EpiDry, pg8::StaticOrder, true, true>((PG8_LAS unsigned char*)F.lds, g0_, S0_, E0_); __syncthreads(); } \
    const pg8::Gemm g_{(const pg8::bf16_t*)(Aptr), (const pg8::bf16_t*)(Bptr), (Mv), (Nv), (Kv), (ldav), (ldbv), GEMM_AKOFF}; \
    pg8::StaticOrder S_; S_.init((Mv), (Nv), F.G, (cidx)); pg8::gemm_phase<EpiT, pg8::StaticOrder, true, true>((PG8_LAS unsigned char*)F.lds, g_, S_, Evar); } while (0)
DI pg8::EpiBf16R epi1(bf16* base, int ldc) { pg8::EpiBf16R e; for (int s = 0; s < 8; ++s) { e.T.base[s] = base; e.T.ldc[s] = ldc; e.T.t0[s] = 0; e.T.gw[s] = 0; } e.T.nseg = 1; e.T.pad_ = 0; e.ssp = nullptr; e.ss_off = 0; return e; }
#define PH_BEGIN if (ph >= lo && ph < hi) { Frame F; { unsigned long long w_ = (unsigned long long)args.ws; asm volatile("" : "+s"(w_)); F.ws = (unsigned char*)w_; F.ctl = (unsigned*)(F.ws + WS_CTL); } \
    F.lds = lds; F.tid = threadIdx.x; F.lane = F.tid & 63; F.wave = __builtin_amdgcn_readfirstlane(F.tid >> 6); F.G = gridDim.x; F.gw = blockIdx.x * NWAVES + F.wave; F.NGW = F.G * NWAVES; \
    float* out; { unsigned long long o_ = (unsigned long long)args.out; asm volatile("" : "+s"(o_)); out = (float*)o_; } \
    unsigned char* const ar = F.ws + WS_AR; bf16* const XN = (bf16*)(F.ws + WS_XNR); float* const SSB = (float*)(F.ws + WS_SS); bf16* const WB = (bf16*)(F.ws + WS_WMIX); bf16* const WUP = (bf16*)(F.ws + WS_WFFN); bf16* const WDN = WUP + (size_t)2 * DFF * DM; \
    const float* const res_mix = (ib == 2) ? args.in[0] : (const float*)out; (void)ar; (void)XN; (void)SSB; (void)WB; (void)WUP; (void)WDN; (void)res_mix; (void)iff;
#define PH_END   if (ph + 1 < hi) { XcdBarrier b_; b_.bar = (unsigned*)F.ctl + CW_BAR; b_.x = xb_xcc_id(); b_.st = MISC + 8; xcd_barrier(b_); } } ++ph;
template <int LAYER> DI void run_cvt(const Args& args, LAS unsigned char* lds, volatile LAS unsigned* MISC, int& ph, const int lo, const int hi) {
    constexpr int ib = (LAYER == 0) ? 2 : (LAYER == 1) ? 17 : (LAYER == 2) ? 26 : 42;
    constexpr int iff = (LAYER == 0) ? 12 : (LAYER == 1) ? 21 : (LAYER == 2) ? 37 : 52;
    constexpr int kind = (LAYER == 1) ? 1 : (LAYER == 2) ? 2 : 0;
        PH_BEGIN
          for (int rep_ = 0; rep_ < (PROBE_PH == 11 ? 2 : 1); ++rep_) {
            if constexpr (kind == 0) ph_dsa_cvt(F, args.in[ib + 1], args.in[ib + 6], args.in[ib + 7], args.in[ib + 8], args.in[ib + 9]);
            else if constexpr (kind == 1) ph_fox_cvt(F, args.in[ib + 1], args.in[ib + 3]);
            else ph_nsa_cvt(F, args.in[ib + 1], args.in[ib + 2], args.in[ib + 3], args.in[ib + 4], args.in[ib + 5], args.in[ib + 6], args.in[ib + 7], args.in[ib + 8], args.in[ib + 9], args.in[ib + 10]);
            ph_cvt_ffn(F, args.in[iff + 1], args.in[iff + 4]); __syncthreads();
          }
        PH_END
}
template <int LAYER, int HALF> DI void run_half(const Args& args, LAS unsigned char* lds, volatile LAS unsigned* MISC, int& ph, const int lo, const int hi) {
    constexpr int ib = (LAYER == 0) ? 2 : (LAYER == 1) ? 17 : (LAYER == 2) ? 26 : 42;
    constexpr int iff = (LAYER == 0) ? 12 : (LAYER == 1) ? 21 : (LAYER == 2) ? 37 : 52;
    constexpr int kind = (LAYER == 1) ? 1 : (LAYER == 2) ? 2 : 0;
    constexpr int half = HALF;
            const int roff = half * MC;
            const float* const ssin = nullptr; (void)ssin;
            if constexpr (kind == 0) {
                PH_BEGIN { pg8::EpiF32 E{(float*)(ar + DA_DIN), 1024, SSB + (size_t)(LAYER * 2) * MTOT * 8, roff}; GEMM_CALL(pg8::EpiF32, E, XN + (size_t)roff * DM, WB + DW_W1, MC, 1024, DM, DM, DM, (int)blockIdx.x); } PH_END
                PH_BEGIN if (PROBE_PH == 10) { ph_dsa_post1(F, half, args.in[ib + 2], args.in[ib + 3], args.in[ib + 4], args.in[ib + 5]); __syncthreads(); } ph_dsa_post1(F, half, args.in[ib + 2], args.in[ib + 3], args.in[ib + 4], args.in[ib + 5]); PH_END
                PH_BEGIN { pg8::EpiBf16R E = epi1((bf16*)(ar + DA_QL), 8192); E.T.base[1] = (bf16*)(ar + DA_QPE); E.T.ldc[1] = 1536; E.T.t0[1] = 32; E.T.base[2] = (bf16*)(ar + DA_QIDX); E.T.ldc[2] = 2048; E.T.t0[2] = 38; E.T.nseg = 3;
                    GEMM_CALL(pg8::EpiBf16R, E, ar + DA_CQN, WB + DW_W2, MC, 11776, 512, 512, 512, (int)blockIdx.x); } PH_END
                PH_BEGIN ph_dsa_rope(F, half); PH_END
                PH_BEGIN if (PROBE_PH == 1) { ph_dsa_index(F, 1); __syncthreads(); } if (PROBE_PH == 7) { ph_dsa_index(F, 1, 1); __syncthreads(); } if (PROBE_PH == 8) { ph_dsa_index(F, 1, 2); __syncthreads(); } ph_dsa_index(F); PH_END
                PH_BEGIN if (PROBE_PH == 2) { ph_dsa_attn(F, 1); __syncthreads(); } ph_dsa_attn(F); PH_END
                PH_BEGIN {
                    pg8::EpiBf16R E = epi1((bf16*)(ar + DA_O2), 4096);
                    { const pg8::Gemm g_{(const pg8::bf16_t*)(ar + DA_QL), (const pg8::bf16_t*)(WB + DW_BD), MC, 4096, 512, 8192, 512, 512}; pg8::StaticOrder S_; S_.init(MC, 4096, F.G, (int)blockIdx.x);
                      pg8::gemm_phase<pg8::EpiBf16R, pg8::StaticOrder, true, true>((PG8_LAS unsigned char*)F.lds, g_, S_, E); } } PH_END
                PH_BEGIN { pg8::EpiResN E{LAYER == 0 ? args.in[0] : nullptr, args.in[ib], nullptr, DM, roff, args.in[iff], (pg8::bf16_t*)XN, SSB + (size_t)(LAYER * 2 + 1) * MTOT * 8, (PG8_LAS float*)(F.lds + LDSCTL_OFF + 256)}; GEMM_CALL(pg8::EpiResN, E, ar + DA_O2, WB + DW_WO, MC, DM, 4096, 4096, 4096, (int)blockIdx.x); } PH_END
            } else if constexpr (kind == 1) {
                PH_BEGIN { pg8::EpiBf16R E = epi1((bf16*)(ar + FA_Q), DM); E.T.base[1] = (bf16*)(ar + FA_K); E.T.ldc[1] = DM; E.T.t0[1] = 8; E.T.base[2] = (bf16*)(ar + FA_V); E.T.ldc[2] = DM; E.T.t0[2] = 16;
                    E.T.base[3] = (bf16*)(ar + FA_F); E.T.ldc[3] = 256; E.T.t0[3] = 24; E.T.nseg = 4; E.ssp = SSB + (size_t)(LAYER * 2) * MTOT * 8; E.ss_off = roff;
                    GEMM_CALL(pg8::EpiBf16R, E, XN + (size_t)roff * DM, WB + FW_IN, MC, 6400, DM, DM, DM, (int)blockIdx.x); } PH_END
                PH_BEGIN if (PROBE_PH == 10) { ph_fox_scan(F, args.in[ib + 2]); __syncthreads(); } ph_fox_scan(F, args.in[ib + 2]); PH_END
                PH_BEGIN if (PROBE_PH == 3) { ph_fox_attn(F, 1); __syncthreads(); } ph_fox_attn(F); PH_END
                PH_BEGIN { pg8::EpiResN E{LAYER == 0 ? args.in[0] : nullptr, args.in[ib], nullptr, DM, roff, args.in[iff], (pg8::bf16_t*)XN, SSB + (size_t)(LAYER * 2 + 1) * MTOT * 8, (PG8_LAS float*)(F.lds + LDSCTL_OFF + 256)}; GEMM_CALL(pg8::EpiResN, E, ar + FA_O, WB + FW_OUT, MC, DM, DM, DM, DM, (int)blockIdx.x); } PH_END
            } else {
                PH_BEGIN { pg8::EpiBf16R E = epi1((bf16*)(ar + NA_Q), 9216);
                    E.T.base[1] = (bf16*)(ar + NA_KC); E.T.ldc[1] = 192; E.T.t0[1] = 36; E.T.gw[1] = 192;
                    E.T.base[2] = (bf16*)(ar + NA_VC); E.T.ldc[2] = 128; E.T.t0[2] = 39; E.T.gw[2] = 128;
                    E.T.base[3] = (bf16*)(ar + NA_KSR); E.T.ldc[3] = 768; E.T.t0[3] = 41;
                    E.T.base[4] = (bf16*)(ar + NA_KWR); E.T.ldc[4] = 768; E.T.t0[4] = 44;
                    E.T.base[5] = (bf16*)(ar + NA_GT); E.T.ldc[5] = 256; E.T.t0[5] = 47;
                    E.T.base[6] = (bf16*)(ar + NA_VSR); E.T.ldc[6] = 512; E.T.t0[6] = 48;
                    E.T.base[7] = (bf16*)(ar + NA_VWR); E.T.ldc[7] = 512; E.T.t0[7] = 50; E.T.nseg = 8; E.ssp = SSB + (size_t)(LAYER * 2) * MTOT * 8; E.ss_off = roff;
                    GEMM_CALL(pg8::EpiBf16R, E, XN + (size_t)roff * DM, WB + NW_IN, MC, 13312, DM, DM, DM, (int)blockIdx.x); } PH_END
                PH_BEGIN ph_nsa_rope(F, half); PH_END
                PH_BEGIN {
                    const float* BIAS = (const float*)(args.ws + WS_MISC);
                    { pg8::EpiGelu E{(bf16*)(ar + NA_GK), 256, BIAS}; GEMM_CALL(pg8::EpiGelu, E, ar + NA_KC, WB + NW_W1K, 4096, 256, 6144, 3072, 6144, (int)blockIdx.x); }
                    { pg8::EpiGelu E{(bf16*)(ar + NA_GV), 256, BIAS + 256}; GEMM_CALL(pg8::EpiGelu, E, ar + NA_VC, WB + NW_W1V, 4096, 256, 4096, 2048, 4096, (int)((blockIdx.x + F.G - 16) % F.G)); }
                } PH_END
                PH_BEGIN {
                    { pg8::EpiBf16R E = epi1((bf16*)(ar + NA_KCMP), 12); E.T.gw[0] = -1; GEMM_CALL(pg8::EpiBf16R, E, ar + NA_GK, WB + NW_W2K, 4096, 256, 256, 256, 256, (int)blockIdx.x); }
                    { pg8::EpiBf16R E = epi1((bf16*)(ar + NA_VCT), 4); E.T.gw[0] = -2; GEMM_CALL(pg8::EpiBf16R, E, WB + NW_W2V, ar + NA_GV, 256, 4096, 256, 256, 256, (int)((blockIdx.x + F.G - 16) % F.G)); }
                } PH_END
                PH_BEGIN ph_nsa_cmp(F, half); PH_END
                PH_BEGIN ph_nsa_sel(F, half); PH_END
                PH_BEGIN ph_nsa_win(F, half); PH_END
                PH_BEGIN { pg8::EpiResN E{LAYER == 0 ? args.in[0] : nullptr, args.in[ib], nullptr, DM, roff, args.in[iff], (pg8::bf16_t*)XN, SSB + (size_t)(LAYER * 2 + 1) * MTOT * 8, (PG8_LAS float*)(F.lds + LDSCTL_OFF + 256)}; GEMM_CALL(pg8::EpiResN, E, ar + NA_O, WB + NW_OUT, MC, DM, 6144, 6144, 6144, (int)blockIdx.x); } PH_END
            }
}
template <int LAYER> DI void run_ffn(const Args& args, LAS unsigned char* lds, volatile LAS unsigned* MISC, int& ph, const int lo, const int hi) {
    constexpr int ib = (LAYER == 0) ? 2 : (LAYER == 1) ? 17 : (LAYER == 2) ? 26 : 42;
    constexpr int iff = (LAYER == 0) ? 12 : (LAYER == 1) ? 21 : (LAYER == 2) ? 37 : 52;
    PH_BEGIN {
        LAS float* rt = (LAS float*)(F.lds + LDSCTL_OFF + 256 + 8192); const int rbase = 4096 * (int)(blockIdx.x & 7); const float* ssq = SSB + (size_t)(LAYER * 2 + 1) * MTOT * 8;
        for (int i = F.tid; i < 4096; i += NWAVES * 64) rt[i] = pg8::rms_rowscale(ssq, rbase + i);
        __syncthreads();
        pg8::EpiConvGlu E{(pg8::bf16_t*)ar, (float*)(ar + 352 * MiB), args.in[iff + 2], args.in[iff + 3], (PG8_LAS float*)(F.lds + LDSCTL_OFF + 256), DFF, (const PG8_LAS float*)rt, rbase};
        GEMM_CALL(pg8::EpiConvGlu, E, XN, WUP, MTOT, 2 * DFF, DM, DM, DM, (int)blockIdx.x); } PH_END
    PH_BEGIN ph_conv_fix(F, (const float*)(ar + 352 * MiB), (bf16*)ar, args.in[iff + 2], args.in[iff + 3], MTOT); PH_END
    PH_BEGIN {
        if constexpr (LAYER < 3) { constexpr int ibn = (LAYER == 0) ? 17 : (LAYER == 1) ? 26 : 42;
            pg8::EpiResN E{nullptr, args.in[iff], nullptr, DM, 0, args.in[ibn], (pg8::bf16_t*)XN, SSB + (size_t)((LAYER + 1) * 2) * MTOT * 8, (PG8_LAS float*)(F.lds + LDSCTL_OFF + 256)}; GEMM_CALL(pg8::EpiResN, E, ar, WDN, MTOT, DM, DFF, DFF, DFF, (int)blockIdx.x); }
        else { pg8::EpiResN E{nullptr, args.in[iff], out, DM, 0, nullptr, (pg8::bf16_t*)XN, nullptr, (PG8_LAS float*)(F.lds + LDSCTL_OFF + 256)}; GEMM_CALL(pg8::EpiResN, E, ar, WDN, MTOT, DM, DFF, DFF, DFF, (int)blockIdx.x); }
    } PH_END
}
__global__ void __launch_bounds__(NWAVES * 64, 2) mk_fwd(Args args) {
    extern __shared__ __attribute__((aligned(16))) unsigned char lds_[];
    LAS unsigned char* const lds = (LAS unsigned char*)lds_;
    volatile LAS unsigned* MISC = (volatile LAS unsigned*)(lds + LDSCTL_OFF);
    for (int u = threadIdx.x; u < 64; u += NWAVES * 64) ((LAS unsigned*)(lds + LDSCTL_OFF))[u] = 0u;
    __syncthreads();
    const int lo = args.ph_lo, hi = args.ph_hi;
    (void)xcd_barrier_post((unsigned*)(args.ws + WS_CTL) + CW_BAR, MISC + 8);
    int ph = 0;
    { constexpr int ib = 2, iff = 12; PH_BEGIN ph_tables(F, (const int*)args.in[1]); ph_norm_first(F, args.in[0], args.in[2], XN, SSB); PH_END }
    run_cvt<0>(args, lds, MISC, ph, lo, hi); run_half<0, 0>(args, lds, MISC, ph, lo, hi); run_half<0, 1>(args, lds, MISC, ph, lo, hi); run_ffn<0>(args, lds, MISC, ph, lo, hi);
    run_cvt<1>(args, lds, MISC, ph, lo, hi); run_half<1, 0>(args, lds, MISC, ph, lo, hi); run_half<1, 1>(args, lds, MISC, ph, lo, hi); run_ffn<1>(args, lds, MISC, ph, lo, hi);
    run_cvt<2>(args, lds, MISC, ph, lo, hi); run_half<2, 0>(args, lds, MISC, ph, lo, hi); run_half<2, 1>(args, lds, MISC, ph, lo, hi); run_ffn<2>(args, lds, MISC, ph, lo, hi);
    run_cvt<3>(args, lds, MISC, ph, lo, hi); run_half<3, 0>(args, lds, MISC, ph, lo, hi); run_half<3, 1>(args, lds, MISC, ph, lo, hi); run_ffn<3>(args, lds, MISC, ph, lo, hi);
    { constexpr int ib = 42, iff = 52; PH_BEGIN ph_final_norm(F, out, args.in[57]); PH_END }
}
extern "C" void kernel_launch(void* const* d_in, const int* in_sizes, int n_in, void* d_out, int out_size, void* d_ws, size_t ws_size, hipStream_t stream) {
    static int grid = 0;
    if (grid == 0) {
        if (n_in != 58 || out_size != MTOT * DM || ws_size < WS_END) { fprintf(stderr, "kernel_launch: unexpected shapes (n_in %d, out %d, ws %zu)\n", n_in, out_size, ws_size); grid = -1; return; }
        int dev = 0, cus = 0;
        if (hipGetDevice(&dev) != hipSuccess || hipDeviceGetAttribute(&cus, hipDeviceAttributeMultiprocessorCount, dev) != hipSuccess) { grid = -1; return; }
        if (hipFuncSetAttribute((const void*)mk_fwd, hipFuncAttributeMaxDynamicSharedMemorySize, LDS_BYTES) != hipSuccess) { fprintf(stderr, "kernel_launch: hipFuncSetAttribute failed\n"); grid = -1; return; }
        int per_cu = 0;
        (void)hipOccupancyMaxActiveBlocksPerMultiprocessor(&per_cu, (const void*)mk_fwd, NWAVES * 64, LDS_BYTES);
        (void)hipGetLastError();
        grid = cus;
    }
    if (grid < 0) return;
    if (hipMemsetAsync((char*)d_ws + WS_CTL, 0, CTL_ZERO_BYTES, stream) != hipSuccess) return;
    Args a{};
    for (int i = 0; i < 58; ++i) a.in[i] = (const float*)d_in[i];
    a.out = (float*)d_out; a.ws = (unsigned char*)d_ws;
#if MK_ONE_LAUNCH
    a.ph_lo = 0; a.ph_hi = NPH;
    hipLaunchKernelGGL(mk_fwd, dim3(grid), dim3(NWAVES * 64), LDS_BYTES, stream, a);
#else
    for (int p = 0; p < NPH; ++p) { a.ph_lo = p; a.ph_hi = p + 1; hipLaunchKernelGGL(mk_fwd, dim3(grid), dim3(NWAVES * 64), LDS_BYTES, stream, a); }
#endif
}
```

```cpp
#include <hip/hip_runtime.h>
#include <cstdio>
#include <cstdint>
#define DI __device__ __forceinline__
namespace pg8 {
#define PG8_LAS __attribute__((address_space(3)))
typedef unsigned short bf16_t;
typedef short bf16x8 __attribute__((ext_vector_type(8)));
typedef float f32x4 __attribute__((ext_vector_type(4)));
typedef unsigned u32x4 __attribute__((ext_vector_type(4)));
constexpr int BM = 256, BK = 64, HALF = 128, HTB = HALF * BK * 2  , STAGE_BYTES = 8 * HTB, NXCD = 8, WGM = 8;

__host__ __device__ __forceinline__ int lds_byte(int r, int c) { const int st = (r >> 4) * 2 + (c >> 5), rr = r & 15, cc = c & 31, ob = rr * 64 + cc * 2; return st * 1024 + (ob ^ (((ob >> 9) & 1) << 5)); }
__host__ __device__ __forceinline__ void stage_rc(int b, int& R, int& C) { const int st = b / 1024, sb = b % 1024, swz = sb ^ (((sb >> 9) & 1) << 5); R = (st >> 1) * 16 + swz / 64; C = (st & 1) * 32 + (swz % 64) / 2; }
__host__ __device__ __forceinline__ int perm32(int rho) { const int n = rho >> 4, i = rho & 15; return 8 * (i >> 2) + 4 * n + (i & 3); }

struct Unit { int pm, pn; };
struct Gemm { const bf16_t* A; const bf16_t* Bt; int M, N, K, lda, ldb, akoff; };

struct StaticOrder {
    int nM, nN, nwg, G, c;
    __host__ __device__ void init(int M, int N, int G_, int c_) { nM = M / BM; nN = N / BM; nwg = nM * nN; G = G_; c = c_; }
    __host__ __device__ bool next(int i, Unit& u) const {
        const long L = (long)i * G + c; if (L >= nwg) return false;
        int wgid = (int)L; { const int q = nwg / NXCD, r = nwg % NXCD, xcd = wgid % NXCD, off = wgid / NXCD; wgid = (xcd < r ? xcd * (q + 1) : r * (q + 1) + (xcd - r) * q) + off; }
        const int nig = WGM * nN, gid = wgid / nig, fm = gid * WGM, gsz = (nM - fm) < WGM ? (nM - fm) : WGM;
        u.pm = fm + ((wgid % nig) % gsz); u.pn = (wgid % nig) / gsz; return true;
    }
    __device__ __forceinline__ void a_ready(const Unit&) const {}
    __device__ __forceinline__ void done(const Unit&) const {}
};
__device__ __forceinline__ unsigned cvt_pk_bf16(float lo, float hi) { unsigned r; asm volatile("v_cvt_pk_bf16_f32 %0, %1, %2" : "=v"(r) : "v"(lo), "v"(hi)); return r; }
template <class Epi, class Sched, bool ALIGN_EPI = false, bool SP2 = false>
__device__ __forceinline__ void gemm_phase(PG8_LAS unsigned char* lds, const Gemm g, const Sched& S, const Epi& E) {
    const int tid = threadIdx.x, wid = __builtin_amdgcn_readfirstlane(tid >> 6), lane = tid & 63, wr = wid >> 2, wc = wid & 3, fr = lane & 15, fq = lane >> 4;
    const int K = g.K, nt = K / BK;
    unsigned voffA[2], voffB[2];
#pragma unroll
    for (int i = 0; i < 2; ++i) { int R, C; stage_rc(tid * 16 + i * 8192, R, C); const int Rb = Epi::PERM ? ((R & ~31) + perm32(R & 31)) : R;
        voffA[i] = (unsigned)(R * g.lda + C) * 2u; voffB[i] = (unsigned)(Rb * g.ldb + C) * 2u; }
    const size_t kstep = (size_t)(BK * 2);
    const size_t hstepA = (size_t)HALF * g.lda * 2, hstepB = (size_t)HALF * g.ldb * 2;
    const size_t tstepA = 2 * hstepA, tstepB = 2 * hstepB;
    const unsigned ldsw = (unsigned)wid * 1024u;
    const int aoff = lds_byte(wr * 64 + fr, fq * 8), boff = lds_byte(wc * 32 + fr, fq * 8);
#define PG8_SA(b, h) (((b) * 2 + (h)) * HTB)
#define PG8_SB(b, h) ((4 + (b) * 2 + (h)) * HTB)
#define PG8_STAGE(bufoff, gbase, voff) do { _Pragma("unroll") for (int _i = 0; _i < 2; ++_i) \
        __builtin_amdgcn_global_load_lds((const unsigned*)((const char*)(gbase) + (voff)[_i]), (PG8_LAS unsigned*)(lds + (bufoff) + ldsw + _i * 8192), 16, 0, 0); } while (0)
#define PG8_LDA(dst, b, h) do { _Pragma("unroll") for (int m = 0; m < 4; ++m) _Pragma("unroll") for (int k = 0; k < 2; ++k) dst[m][k] = *(const PG8_LAS bf16x8*)(lds + PG8_SA(b, h) + aoff + m * 2048 + k * 1024); } while (0)
#define PG8_LDB(dst, b, h) do { _Pragma("unroll") for (int n = 0; n < 2; ++n) _Pragma("unroll") for (int k = 0; k < 2; ++k) dst[n][k] = *(const PG8_LAS bf16x8*)(lds + PG8_SB(b, h) + boff + n * 2048 + k * 1024); } while (0)
#define PG8_MMA(ai, bj, At, Bt) do { __builtin_amdgcn_s_setprio(1); _Pragma("unroll") for (int m = 0; m < 4; ++m) _Pragma("unroll") for (int n = 0; n < 2; ++n) _Pragma("unroll") for (int k = 0; k < 2; ++k) \
        acc[ai][bj][m][n] = __builtin_amdgcn_mfma_f32_16x16x32_bf16(Bt[n][k], At[m][k], acc[ai][bj][m][n], 0, 0, 0); __builtin_amdgcn_s_setprio(0); } while (0)
#define PG8_WAIT_V(n) asm volatile("s_waitcnt vmcnt(" #n ")" ::: "memory")
#define PG8_WAIT_L(n) asm volatile("s_waitcnt lgkmcnt(" #n ")" ::: "memory")
#define PG8_BAR __builtin_amdgcn_s_barrier()
#define PG8_SCHED __builtin_amdgcn_sched_barrier(0)
    Unit cur, nxt; int ui = 0;
    if (!S.next(0, cur)) return;
    f32x4 acc[2][2][4][2];
#pragma unroll
    for (int a = 0; a < 2; ++a)
#pragma unroll
        for (int b = 0; b < 2; ++b)
#pragma unroll
            for (int m = 0; m < 4; ++m)
#pragma unroll
                for (int n = 0; n < 2; ++n) acc[a][b][m][n] = (f32x4){0.f, 0.f, 0.f, 0.f};
    bf16x8 At[4][2], B0[2][2], B1[2][2];
    const char* cA = (const char*)g.A + (size_t)cur.pm * tstepA + (size_t)cur.pn * g.akoff * 2; const char* cB = (const char*)g.Bt + (size_t)cur.pn * tstepB;
    S.a_ready(cur);
    if constexpr (SP2) {
        PG8_STAGE(PG8_SB(0, 0), cB, voffB); PG8_STAGE(PG8_SB(0, 1), cB + hstepB, voffB); PG8_STAGE(PG8_SA(0, 0), cA, voffA); PG8_STAGE(PG8_SA(0, 1), cA + hstepA, voffA);
        if (wr == 1) PG8_BAR;
        PG8_WAIT_V(2); PG8_BAR;
        PG8_STAGE(PG8_SB(1, 0), cB + kstep, voffB); PG8_STAGE(PG8_SA(1, 0), cA + kstep, voffA); PG8_STAGE(PG8_SB(1, 1), cB + hstepB + kstep, voffB);
        PG8_WAIT_V(6); PG8_BAR;
    } else {
        PG8_STAGE(PG8_SB(0, 0), cB, voffB); PG8_STAGE(PG8_SA(0, 0), cA, voffA); PG8_STAGE(PG8_SB(0, 1), cB + hstepB, voffB); PG8_STAGE(PG8_SA(0, 1), cA + hstepA, voffA);
        if (wr == 1) PG8_BAR;
        PG8_WAIT_V(4); PG8_BAR;
        PG8_STAGE(PG8_SB(1, 0), cB + kstep, voffB); PG8_STAGE(PG8_SA(1, 0), cA + kstep, voffA); PG8_STAGE(PG8_SB(1, 1), cB + hstepB + kstep, voffB);
        PG8_WAIT_V(6); PG8_BAR;
    }
    for (;;) {
        const bool has_next = S.next(ui + 1, nxt);
        const char* nA = has_next ? (const char*)g.A + (size_t)nxt.pm * tstepA + (size_t)nxt.pn * g.akoff * 2 : cA; const char* nB = has_next ? (const char*)g.Bt + (size_t)nxt.pn * tstepB : cB;
        for (int t = 0; t < nt; t += 2) {
            const bool last = (t == nt - 2);
            const char* a1 = cA + (size_t)(t + 1) * kstep;
            const char* a2 = last ? nA : cA + (size_t)(t + 2) * kstep; const char* b2 = last ? nB : cB + (size_t)(t + 2) * kstep;
            const char* a3 = a2 + kstep; const char* b3 = b2 + kstep;
            if (last && has_next) S.a_ready(nxt);
            if constexpr (SP2) {
            PG8_LDB(B0, 0, 0); PG8_LDB(B1, 0, 1); PG8_SCHED; PG8_LDA(At, 0, 0); PG8_STAGE(PG8_SA(1, 1), a1 + hstepA, voffA);
            PG8_WAIT_V(8); PG8_WAIT_L(0); PG8_BAR; PG8_MMA(0, 0, At, B0); PG8_MMA(0, 1, At, B1); PG8_BAR; PG8_SCHED;
            PG8_LDA(At, 0, 1); PG8_STAGE(PG8_SB(0, 0), b2, voffB); PG8_STAGE(PG8_SB(0, 1), b2 + hstepB, voffB); PG8_STAGE(PG8_SA(0, 0), a2, voffA);
            PG8_WAIT_V(8); PG8_WAIT_L(0); PG8_BAR; PG8_MMA(1, 0, At, B0); PG8_MMA(1, 1, At, B1); PG8_BAR; PG8_SCHED;
            PG8_LDB(B0, 1, 0); PG8_LDB(B1, 1, 1); PG8_SCHED; PG8_LDA(At, 1, 0); PG8_STAGE(PG8_SA(0, 1), a2 + hstepA, voffA);
            PG8_WAIT_V(8); PG8_WAIT_L(0); PG8_BAR; PG8_MMA(0, 0, At, B0); PG8_MMA(0, 1, At, B1); PG8_BAR; PG8_SCHED;
            PG8_LDA(At, 1, 1); PG8_STAGE(PG8_SB(1, 0), b3, voffB); PG8_STAGE(PG8_SB(1, 1), b3 + hstepB, voffB); PG8_STAGE(PG8_SA(1, 0), a3, voffA);
            PG8_WAIT_V(8); PG8_WAIT_L(0); PG8_BAR; PG8_MMA(1, 0, At, B0); PG8_MMA(1, 1, At, B1); PG8_BAR; PG8_SCHED;
            } else {
            PG8_LDB(B0, 0, 0); PG8_SCHED; PG8_LDA(At, 0, 0); PG8_STAGE(PG8_SA(1, 1), a1 + hstepA, voffA);
            PG8_WAIT_L(8); PG8_BAR; PG8_WAIT_L(0); PG8_MMA(0, 0, At, B0); PG8_BAR; PG8_SCHED;
            PG8_LDB(B1, 0, 1); PG8_STAGE(PG8_SB(0, 0), b2, voffB);
            PG8_BAR; PG8_WAIT_L(0); PG8_MMA(0, 1, At, B1); PG8_BAR;
            PG8_LDA(At, 0, 1); PG8_STAGE(PG8_SA(0, 0), a2, voffA);
            PG8_BAR; PG8_WAIT_L(0); PG8_MMA(1, 0, At, B0); PG8_BAR; PG8_SCHED;
            PG8_STAGE(PG8_SB(0, 1), b2 + hstepB, voffB);
            PG8_WAIT_V(6); PG8_BAR; PG8_MMA(1, 1, At, B1); PG8_BAR;
            PG8_LDB(B0, 1, 0); PG8_SCHED; PG8_LDA(At, 1, 0); PG8_STAGE(PG8_SA(0, 1), a2 + hstepA, voffA);
            PG8_WAIT_L(8); PG8_BAR; PG8_WAIT_L(0); PG8_MMA(0, 0, At, B0); PG8_BAR; PG8_SCHED;
            PG8_LDB(B1, 1, 1); PG8_STAGE(PG8_SB(1, 0), b3, voffB);
            PG8_BAR; PG8_WAIT_L(0); PG8_MMA(0, 1, At, B1); PG8_BAR;
            PG8_LDA(At, 1, 1); PG8_STAGE(PG8_SA(1, 0), a3, voffA);
            PG8_BAR; PG8_WAIT_L(0); PG8_MMA(1, 0, At, B0); PG8_BAR; PG8_SCHED;
            PG8_STAGE(PG8_SB(1, 1), b3 + hstepB, voffB);
            PG8_WAIT_V(6); PG8_BAR; PG8_MMA(1, 1, At, B1); PG8_BAR;
            }
        }
        if constexpr (ALIGN_EPI) { if (wr == 0) PG8_BAR; }
        if constexpr (!Epi::AFTER_DRAIN) { E(acc, cur, wr, wc, fr, fq); S.done(cur); }
        if (!has_next) break;
#pragma unroll
        for (int a = 0; a < 2; ++a)
#pragma unroll
            for (int b = 0; b < 2; ++b)
#pragma unroll
                for (int m = 0; m < 4; ++m)
#pragma unroll
                    for (int n = 0; n < 2; ++n) acc[a][b][m][n] = (f32x4){0.f, 0.f, 0.f, 0.f};
        cur = nxt; cA = nA; cB = nB; ++ui;
        if constexpr (ALIGN_EPI) { if (wr == 1) PG8_BAR; }
    }
    PG8_WAIT_V(0);
    if constexpr (!ALIGN_EPI) { if (wr == 0) PG8_BAR; }
    PG8_BAR;
    if constexpr (Epi::AFTER_DRAIN) { E.fused(acc, cur, wr, wc, fr, fq, lds, wid, lane); S.done(cur); }
#undef PG8_SA
#undef PG8_SB
#undef PG8_STAGE
#undef PG8_LDA
#undef PG8_LDB
#undef PG8_MMA
#undef PG8_WAIT_V
#undef PG8_WAIT_L
#undef PG8_BAR
#undef PG8_SCHED
}
}
namespace pg8 {
typedef float f32x2 __attribute__((ext_vector_type(2)));
__device__ __forceinline__ float rms_rowscale(const float* ssq, int row) { const f32x4 a = *(const f32x4*)(ssq + (size_t)row * 8), b = *(const f32x4*)(ssq + (size_t)row * 8 + 4);
    return __builtin_amdgcn_rsqf((((a[0] + a[1]) + (a[2] + a[3])) + ((b[0] + b[1]) + (b[2] + b[3]))) * (1.0f / 2048.0f) + 1e-6f); }
struct SegTab { bf16_t* base[8]; int ldc[8]; int t0[8]; int gw[8]; int nseg; int pad_; };
struct EpiBf16R {
    static constexpr bool PERM = true, AFTER_DRAIN = false;
    SegTab T; const float* ssp; int ss_off;
    __device__ __forceinline__ void operator()(const f32x4 (&acc)[2][2][4][2], const Unit& u, int wr, int wc, int fr, int fq) const {
        bf16_t* base = T.base[0]; int ldc = T.ldc[0], gw = T.gw[0], t0 = T.t0[0];
#pragma unroll
        for (int s = 1; s < 8; ++s) if (s < T.nseg && u.pn >= T.t0[s]) { base = T.base[s]; ldc = T.ldc[s]; gw = T.gw[s]; t0 = T.t0[s]; }
        const int colt = (u.pn - t0) * BM, row0 = u.pm * BM + wr * 64 + fr;
#pragma unroll
        for (int ai = 0; ai < 2; ++ai)
#pragma unroll
            for (int m = 0; m < 4; ++m) { const int row = row0 + ai * HALF + m * 16;
                const float rs = ssp ? rms_rowscale(ssp, ss_off + row) : 1.0f;
#pragma unroll
                for (int bj = 0; bj < 2; ++bj) { const int col = colt + bj * HALF + wc * 32 + 8 * fq;
                    const f32x4 v0 = acc[ai][bj][m][0] * rs, v1 = acc[ai][bj][m][1] * rs;
                    u32x4 w; w.x = cvt_pk_bf16(v0[0], v0[1]); w.y = cvt_pk_bf16(v0[2], v0[3]); w.z = cvt_pk_bf16(v1[0], v1[1]); w.w = cvt_pk_bf16(v1[2], v1[3]);
                    if (gw == -2) {
                        if ((row >> 5) < ldc) { bf16_t* d0 = base + ((size_t)(((col >> 5) * ldc + (row >> 5)) * 2 + ((col >> 4) & 1)) * 64 + (row & 31)) * 8 + 4 * ((col >> 3) & 1);
                            typedef unsigned u32x2_ __attribute__((ext_vector_type(2)));
                            *(u32x2_*)d0 = (u32x2_){w.x, w.y}; *(u32x2_*)(d0 + 32 * 8) = (u32x2_){w.z, w.w}; }
                        continue; }
                    bf16_t* dst;
                    if (gw == 0) dst = base + (size_t)row * ldc + col;
                    else if (gw == -1) { if ((col >> 4) >= ldc) continue; dst = base + ((size_t)((row >> 5) * ldc + (col >> 4)) * 64 + ((col >> 3) & 1) * 32 + (row & 31)) * 8; }
                    else { const int g = col / gw, d = col - g * gw; dst = base + ((size_t)((row >> 12) * 4 + g) * 4096 + (row & 4095)) * gw + d; }
                    *(u32x4*)dst = w; } }
    }
};
struct EpiGelu {
    static constexpr bool PERM = true, AFTER_DRAIN = false;
    bf16_t* O; int ldc; const float* bias;
    static __device__ __forceinline__ float gelu(float x) { const float u2 = 1.5957691216f * (x + 0.044715f * x * x * x); const float e = __builtin_amdgcn_exp2f(-u2 * 1.4426950409f); return x * __builtin_amdgcn_rcpf(1.0f + e); }
    __device__ __forceinline__ void operator()(const f32x4 (&acc)[2][2][4][2], const Unit& u, int wr, int wc, int fr, int fq) const {
        const int row0 = u.pm * BM + wr * 64 + fr, col0 = u.pn * BM + wc * 32 + 8 * fq;
#pragma unroll
        for (int bj = 0; bj < 2; ++bj) { const f32x4 b0 = *(const f32x4*)(bias + col0 + bj * HALF), b1 = *(const f32x4*)(bias + col0 + bj * HALF + 4);
#pragma unroll
            for (int ai = 0; ai < 2; ++ai)
#pragma unroll
                for (int m = 0; m < 4; ++m) { const f32x4 v0 = acc[ai][bj][m][0] + b0, v1 = acc[ai][bj][m][1] + b1;
                    u32x4 w; w.x = cvt_pk_bf16(gelu(v0[0]), gelu(v0[1])); w.y = cvt_pk_bf16(gelu(v0[2]), gelu(v0[3])); w.z = cvt_pk_bf16(gelu(v1[0]), gelu(v1[1])); w.w = cvt_pk_bf16(gelu(v1[2]), gelu(v1[3]));
                    *(u32x4*)(O + (size_t)(row0 + ai * HALF + m * 16) * ldc + col0 + bj * HALF) = w; } }
    }
};
struct EpiF32 {
    static constexpr bool PERM = false, AFTER_DRAIN = false;
    float* C; int ldc; const float* ssp; int ss_off;
    __device__ __forceinline__ void operator()(const f32x4 (&acc)[2][2][4][2], const Unit& u, int wr, int wc, int fr, int fq) const {
        const int row0 = u.pm * BM + wr * 64 + fr, col0 = u.pn * BM + wc * 32 + 4 * fq;
#pragma unroll
        for (int ai = 0; ai < 2; ++ai)
#pragma unroll
            for (int m = 0; m < 4; ++m) { float* rowp = C + (size_t)(row0 + ai * HALF + m * 16) * ldc + col0;
                const float rs = ssp ? rms_rowscale(ssp, ss_off + row0 + ai * HALF + m * 16) : 1.0f;
#pragma unroll
                for (int bj = 0; bj < 2; ++bj)
#pragma unroll
                    for (int n = 0; n < 2; ++n) *(f32x4*)(rowp + bj * HALF + n * 16) = acc[ai][bj][m][n] * rs; }
    }
};
struct EpiResN {
    static constexpr bool PERM = false, AFTER_DRAIN = false;
    const float* res32; const float* gprev; float* out32; int ldc; int row_off; const float* g; bf16_t* xn; float* ss; PG8_LAS float* xb;
    __device__ __forceinline__ void operator()(const f32x4 (&acc)[2][2][4][2], const Unit& u, int wr, int wc, int fr, int fq) const {
        typedef unsigned u32x2_ __attribute__((ext_vector_type(2)));
        const int row0 = row_off + u.pm * BM + wr * 64 + fr, col0 = u.pn * BM + wc * 32 + 4 * fq;
        f32x4 gv[2][2], gi[2][2];
#pragma unroll
        for (int bj = 0; bj < 2; ++bj)
#pragma unroll
            for (int n = 0; n < 2; ++n) { gv[bj][n] = g ? *(const f32x4*)(g + col0 + bj * HALF + n * 16) : (f32x4){0.f, 0.f, 0.f, 0.f};
                if (!res32) { const f32x4 t = *(const f32x4*)(gprev + col0 + bj * HALF + n * 16); gi[bj][n] = (f32x4){1.0f / t[0], 1.0f / t[1], 1.0f / t[2], 1.0f / t[3]}; } else gi[bj][n] = (f32x4){1.f, 1.f, 1.f, 1.f}; }
#pragma unroll
        for (int ai = 0; ai < 2; ++ai)
#pragma unroll
            for (int m = 0; m < 4; ++m) { const int row = row0 + ai * HALF + m * 16; const size_t off = (size_t)row * ldc + col0;
                f32x4 r[2][2]; float sq = 0.f;
#pragma unroll
                for (int bj = 0; bj < 2; ++bj)
#pragma unroll
                    for (int n = 0; n < 2; ++n) {
                        if (res32) r[bj][n] = *(const f32x4*)(res32 + off + bj * HALF + n * 16);
                        else { const u32x2_ w = *(const u32x2_*)(xn + off + bj * HALF + n * 16);
                            r[bj][n] = (f32x4){__builtin_bit_cast(float, w.x << 16), __builtin_bit_cast(float, w.x & 0xffff0000u), __builtin_bit_cast(float, w.y << 16), __builtin_bit_cast(float, w.y & 0xffff0000u)} * gi[bj][n]; } }
#pragma unroll
                for (int bj = 0; bj < 2; ++bj)
#pragma unroll
                    for (int n = 0; n < 2; ++n) { const f32x4 o = r[bj][n] + acc[ai][bj][m][n];
                        if (out32) *(f32x4*)(out32 + off + bj * HALF + n * 16) = o;
                        if (g) { sq += (o[0] * o[0] + o[1] * o[1]) + (o[2] * o[2] + o[3] * o[3]);
                            const f32x4 y = o * gv[bj][n]; *(u32x2_*)(xn + off + bj * HALF + n * 16) = (u32x2_){cvt_pk_bf16(y[0], y[1]), cvt_pk_bf16(y[2], y[3])}; } }
                if (g) { sq += __shfl_xor(sq, 16); sq += __shfl_xor(sq, 32);
                    if (fq == 0) xb[(ai * HALF + wr * 64 + m * 16 + fr) * 4 + wc] = sq; }
                asm volatile("" ::: "memory"); }
        if (g) {
            asm volatile("s_waitcnt lgkmcnt(0)" ::: "memory"); __builtin_amdgcn_s_barrier(); asm volatile("" ::: "memory");
            const int t = (wr * 4 + wc) * 64 + fq * 16 + fr;
            if (t < BM) { const f32x4 v = *(const PG8_LAS f32x4*)(xb + t * 4); ss[(size_t)(row_off + u.pm * BM + t) * 8 + u.pn] = (v[0] + v[1]) + (v[2] + v[3]); }
        }
    }
};
struct EpiConvGlu {
    static constexpr bool PERM = true, AFTER_DRAIN = false;
    bf16_t* G; float* UB; const float* cw; const float* cb; PG8_LAS float* xb; int dff; const PG8_LAS float* rstd; int rbase;
    static __device__ __forceinline__ float shr(float old, float src, int n) { const int o = __builtin_bit_cast(int, old), s = __builtin_bit_cast(int, src);
        return __builtin_bit_cast(float, n == 1 ? __builtin_amdgcn_update_dpp(o, s, 0x111, 0xf, 0xf, false) : __builtin_amdgcn_update_dpp(o, s, 0x112, 0xf, 0xf, false)); }
    static __device__ __forceinline__ float ror(float src, int n) { const int s = __builtin_bit_cast(int, src);
        return __builtin_bit_cast(float, n == 1 ? __builtin_amdgcn_update_dpp(0, s, 0x121, 0xf, 0xf, false) : __builtin_amdgcn_update_dpp(0, s, 0x122, 0xf, 0xf, false)); }
    __device__ __forceinline__ void operator()(f32x4 (&acc)[2][2][4][2], const Unit& u, int wr, int wc, int fr, int fq) const {
        typedef unsigned u32x2_ __attribute__((ext_vector_type(2)));
        if (rstd) {
#pragma unroll
            for (int ai = 0; ai < 2; ++ai)
#pragma unroll
                for (int m = 0; m < 4; ++m) { const float rs = rstd[u.pm * BM + ai * HALF + wr * 64 + m * 16 + fr - rbase];
#pragma unroll
                    for (int bj = 0; bj < 2; ++bj)
#pragma unroll
                        for (int n = 0; n < 2; ++n) acc[ai][bj][m][n] = acc[ai][bj][m][n] * rs; }
        }
        if (fr >= 14) {
#pragma unroll
            for (int ai = 0; ai < 2; ++ai)
#pragma unroll
                for (int bj = 0; bj < 2; ++bj)
#pragma unroll
                    for (int n = 0; n < 2; ++n) *(PG8_LAS f32x4*)(xb + (((((ai * 2 + wr) * 4 + wc) * 2 + (fr - 14)) * 4 + fq) * 16) + (bj * 2 + n) * 4) = acc[ai][bj][3][n];
        }
        { const int ncol = 4 * dff / 2;
          const bool top = (wr == 0 && fr < 2), bot = (wr == 1 && fr >= 14);
          if (top || bot) { float* ub = UB + ((size_t)(u.pm * 4 + (top ? fr : 2 + fr - 14)) * ncol) + u.pn * BM + wc * 32 + 8 * fq;
#pragma unroll
            for (int bj = 0; bj < 2; ++bj)
#pragma unroll
                for (int n = 0; n < 2; ++n) *(f32x4*)(ub + bj * HALF + 4 * n) = top ? acc[0][bj][0][n] : acc[1][bj][3][n]; } }
        asm volatile("s_waitcnt lgkmcnt(0)" ::: "memory"); __builtin_amdgcn_s_barrier(); asm volatile("" ::: "memory");
        u32x2_ res[2][4][2];
        const int ch0 = u.pn * HALF + wc * 32 + 8 * fq;
#pragma unroll
        for (int n = 0; n < 2; ++n) {
            const float* wp = cw + ch0 + 4 * n; const float* bp = cb + ch0 + 4 * n;
            const f32x4 w0g = *(const f32x4*)(wp), w1g = *(const f32x4*)(wp + 2 * dff), w2g = *(const f32x4*)(wp + 4 * dff), bg = *(const f32x4*)(bp);
            const f32x4 w0v = *(const f32x4*)(wp + dff), w1v = *(const f32x4*)(wp + 3 * dff), w2v = *(const f32x4*)(wp + 5 * dff), bv = *(const f32x4*)(bp + dff);
#pragma unroll
            for (int ai = 0; ai < 2; ++ai)
#pragma unroll
                for (int m = 0; m < 4; ++m) {
                    const f32x4 cg = acc[ai][0][m][n], cv = acc[ai][1][m][n];
                    f32x4 b1g, b2g, b1v, b2v;
                    if (m > 0) {
#pragma unroll
                        for (int e = 0; e < 4; ++e) { b1g[e] = ror(acc[ai][0][m - 1][n][e], 1); b2g[e] = ror(acc[ai][0][m - 1][n][e], 2); b1v[e] = ror(acc[ai][1][m - 1][n][e], 1); b2v[e] = ror(acc[ai][1][m - 1][n][e], 2); }
                    } else {
                        const int sai = wr ? ai : ai - 1, swr = wr ? 0 : 1;
                        f32x4 x14g = {0.f, 0.f, 0.f, 0.f}, x15g = x14g, x14v = x14g, x15v = x14g;
                        if (sai >= 0) { const PG8_LAS float* xp = xb + (((((sai * 2 + swr) * 4 + wc) * 2) * 4 + fq) * 16);
                            x14g = *(const PG8_LAS f32x4*)(xp + n * 4); x14v = *(const PG8_LAS f32x4*)(xp + (2 + n) * 4); x15g = *(const PG8_LAS f32x4*)(xp + 64 + n * 4); x15v = *(const PG8_LAS f32x4*)(xp + 64 + (2 + n) * 4); }
                        b1g = x15g; b1v = x15v; b2g = fr == 0 ? x14g : x15g; b2v = fr == 0 ? x14v : x15v;
                    }
                    float o[4];
#pragma unroll
                    for (int e = 0; e < 4; ++e) {
                        const float p1g = shr(b1g[e], cg[e], 1), p2g = shr(b2g[e], cg[e], 2), p1v = shr(b1v[e], cv[e], 1), p2v = shr(b2v[e], cv[e], 2);
                        const float yg = bg[e] + w0g[e] * p2g + w1g[e] * p1g + w2g[e] * cg[e], yv = bv[e] + w0v[e] * p2v + w1v[e] * p1v + w2v[e] * cv[e];
                        o[e] = yg * __builtin_amdgcn_rcpf(1.0f + __builtin_amdgcn_exp2f(-yg * 1.4426950409f)) * yv;
                    }
                    res[ai][m][n] = (u32x2_){cvt_pk_bf16(o[0], o[1]), cvt_pk_bf16(o[2], o[3])};
                }
        }
        const int row0 = u.pm * BM + wr * 64 + fr;
#pragma unroll
        for (int ai = 0; ai < 2; ++ai)
#pragma unroll
            for (int m = 0; m < 4; ++m) *(u32x4*)(G + (size_t)(row0 + ai * HALF + m * 16) * dff + ch0) = (u32x4){res[ai][m][0].x, res[ai][m][0].y, res[ai][m][1].x, res[ai][m][1].y};
    }
};
}
constexpr int BATCH = 8, SEQ = 4096, DM = 2048, MTOT = BATCH * SEQ, MC = MTOT / 2  , BPH = BATCH / 2;
constexpr int DFF = 5632;
constexpr float NORM_EPS = 1e-6f, LOG2E = 1.4426950408889634f;
constexpr int NWAVES = 8;
constexpr size_t MiB = 1u << 20;
constexpr size_t WS_CTL = 0, CTL_ZERO_BYTES = 1 * MiB;
constexpr size_t WS_TAB = 1 * MiB;
constexpr size_t TAB_COS48 = WS_TAB, TAB_SIN48 = WS_TAB + 3 * MiB, TAB_COS32 = WS_TAB + 6 * MiB, TAB_SIN32 = WS_TAB + 8 * MiB;
constexpr size_t WS_WMIX = 12 * MiB;
constexpr size_t WS_WFFN = 100 * MiB;
constexpr size_t WS_MISC = 168 * MiB;
constexpr size_t WS_SS = 170 * MiB;
constexpr size_t WS_XNR = 1010 * MiB;
constexpr size_t WS_AR = 234 * MiB;
constexpr size_t WS_END = 1138 * MiB;
constexpr int CW_TMO = 0;
constexpr int CW_BAR = 4096;
constexpr int RING_BYTES = 131072;
constexpr int LDSCTL_OFF = 135168;
constexpr int LDS_BYTES = 163840;

#define GAS __attribute__((address_space(1)))
#define LAS __attribute__((address_space(3)))
typedef unsigned short bf16;
typedef unsigned u32x4 __attribute__((ext_vector_type(4)));
typedef unsigned u32x2 __attribute__((ext_vector_type(2)));
typedef float f32x4 __attribute__((ext_vector_type(4)));
typedef float f32x16 __attribute__((ext_vector_type(16)));
typedef short bf16x8 __attribute__((ext_vector_type(8)));
typedef short s16x4 __attribute__((ext_vector_type(4)));
typedef short v4i16_t __attribute__((ext_vector_type(4)));
typedef __bf16 bf16x2_t __attribute__((ext_vector_type(2)));
typedef float f32x2_t __attribute__((ext_vector_type(2)));
#define LDS_WAIT() asm volatile("s_waitcnt lgkmcnt(0)" ::: "memory")
#define VM_WAIT() asm volatile("s_waitcnt vmcnt(0)" ::: "memory")
#define MFMA32(a, b, c) __builtin_amdgcn_mfma_f32_32x32x16_bf16((a), (b), (c), 0, 0, 0)
DI unsigned pk2(float lo, float hi) { f32x2_t v = {lo, hi}; bf16x2_t b = __builtin_convertvector(v, bf16x2_t); return __builtin_bit_cast(unsigned, b); }
DI float bf2f(unsigned short b) { return __builtin_bit_cast(float, (unsigned)b << 16); }
DI float bflo(unsigned w) { return __builtin_bit_cast(float, w << 16); }
DI float bfhi(unsigned w) { return __builtin_bit_cast(float, w & 0xffff0000u); }
DI unsigned short f2bf(float f) { return (unsigned short)(pk2(f, 0.f) & 0xffffu); }
DI float wave_sum(float v) {
#pragma unroll
    for (int o = 1; o < 64; o <<= 1) v += __shfl_xor(v, o);
    return v;
}
DI int crow(int i, int h) { return (i & 3) + 8 * (i >> 2) + 4 * h; }
#define XB_TMO      128
#define XB_XCNT(j)  (256  + 64 * (j))
#define XB_XSUB(j)  (1280 + 64 * (j))
#define XB_XGEN(j)  (2304 + 64 * (j))
#define XB_TOP      3328
#define XB_TOPGEN   3392
#define XCD_BAR_WORDS 3456
#define XB_SPIN_CAP (1u << 18)

__device__ __forceinline__ unsigned xb_ld(unsigned* p)              { return __hip_atomic_load(p, __ATOMIC_RELAXED, __HIP_MEMORY_SCOPE_AGENT); }
__device__ __forceinline__ unsigned xb_add(unsigned* p, unsigned v) { return __hip_atomic_fetch_add(p, v, __ATOMIC_RELAXED, __HIP_MEMORY_SCOPE_AGENT); }
__device__ __forceinline__ unsigned xb_xcc_id() { return (unsigned)__builtin_amdgcn_s_getreg((3 << 11) | 20) & 0xFu; }
#define XB_SPIN(cond, bar) do { unsigned _sp = 0; while (cond) { __builtin_amdgcn_s_sleep(1); \
    if ((++_sp & 255u) == 0u) { if (xb_ld(&(bar)[XB_TMO])) break; if (_sp > XB_SPIN_CAP) { atomicAdd(&(bar)[XB_TMO], 1u); break; } } } } while (0)

struct XcdBarrier {
    unsigned* bar; unsigned x;
    volatile LAS unsigned* st;
};

__device__ __forceinline__ XcdBarrier xcd_barrier_post(unsigned* bar, volatile LAS unsigned* st) {
    XcdBarrier b; b.bar = bar; b.x = xb_xcc_id(); b.st = st;
    if (threadIdx.x == 0) (void)xb_add(&bar[XB_XCNT(b.x)], 1u);
    return b;
}
__device__ __forceinline__ void xcd_barrier_complete(unsigned* bar, unsigned x, unsigned& nloc, unsigned& nx) {
    const unsigned G = gridDim.x * gridDim.y * gridDim.z;
    unsigned sum, cnt, mine, sp = 0u;
    for (;;) {
        sum = 0u; cnt = 0u; mine = 0u;
#pragma unroll
        for (unsigned j = 0; j < 16; ++j) { const unsigned c = xb_ld(&bar[XB_XCNT(j)]); sum += c; cnt += (c > 0u) ? 1u : 0u; mine = (j == x) ? c : mine; }
        if (sum == G) break;
        __builtin_amdgcn_s_sleep(1);
        if ((++sp & 255u) == 0u) { if (xb_ld(&bar[XB_TMO])) break; if (sp > XB_SPIN_CAP) { atomicAdd(&bar[XB_TMO], 1u); break; } }
    }
    nloc = mine > 0u ? mine : 1u; nx = cnt > 0u ? cnt : 1u;
}

__device__ __forceinline__ void xcd_barrier(const XcdBarrier& b) {
    asm volatile("s_waitcnt vmcnt(0)" ::: "memory");
    __syncthreads();
    if (threadIdx.x == 0) {
        unsigned* bar = b.bar;
        __builtin_amdgcn_s_waitcnt(0);
        unsigned nloc = b.st[0], nx = b.st[1];
        if (nloc == 0u) { xcd_barrier_complete(bar, b.x, nloc, nx); b.st[0] = nloc; b.st[1] = nx; }
        const unsigned old = xb_add(&bar[XB_XSUB(b.x)], 1u);
        const unsigned gen = old / nloc;
        if (old + 1u == (gen + 1u) * nloc) {
            __builtin_amdgcn_fence(__ATOMIC_RELEASE, "agent");
            asm volatile("s_waitcnt vmcnt(0)" ::: "memory");
            const unsigned og = xb_add(&bar[XB_TOP], 1u);
            const unsigned tg = og / nx;
            if (og + 1u == (tg + 1u) * nx) xb_add(&bar[XB_TOPGEN], 1u);
            else XB_SPIN(xb_ld(&bar[XB_TOPGEN]) == tg, bar);
            __builtin_amdgcn_fence(__ATOMIC_ACQUIRE, "agent");
            xb_add(&bar[XB_XGEN(b.x)], 1u);
            asm volatile("s_waitcnt vmcnt(0)" ::: "memory");
        } else {
            XB_SPIN(xb_ld(&bar[XB_XGEN(b.x)]) == gen, bar);
            __builtin_amdgcn_fence(__ATOMIC_ACQUIRE, "agent");
            asm volatile("s_waitcnt vmcnt(0)" ::: "memory");
        }
    }
    __syncthreads();
}
struct Frame {
    LAS unsigned char* lds; unsigned* ctl; unsigned char* ws;
    int tid, lane, wave, G, gw, NGW;
};
DI void ph_tables(const Frame& F, const int* pos) {
    float* c48 = (float*)(F.ws + TAB_COS48); float* s48 = (float*)(F.ws + TAB_SIN48); float* c32 = (float*)(F.ws + TAB_COS32); float* s32 = (float*)(F.ws + TAB_SIN32);
    const int gt = blockIdx.x * (NWAVES * 64) + F.tid, NT = F.G * NWAVES * 64;
    for (int i = gt; i < MTOT * 40; i += NT) {
        const int m = i / 40, j = i - m * 40; const float p = (float)pos[m];
        const bool a = j < 24; const int jj = a ? j : j - 24;
        const float inv = (float)exp(-(2.0 * jj / (a ? 48.0 : 32.0)) * 13.122363377404328);
        const float ang = p * inv; float sn, cs; sincosf(ang, &sn, &cs);
        if (a) { c48[m * 24 + jj] = cs; s48[m * 24 + jj] = sn; } else { c32[m * 16 + jj] = cs; s32[m * 16 + jj] = sn; }
    }
}
DI void cvt_load(float (&v)[32], const float* W, int ldw, int col0, int ncols, int item, int nblk, int lane) {
    const int kb = item / nblk, nb = item - kb * nblk, k0 = 64 * kb, n0 = 32 * nb, nn = n0 + (lane & 31); const bool ok = nn < ncols;
    const float* p = W + (size_t)(k0 + (lane >> 5)) * ldw + col0 + (ok ? nn : 0);
#pragma unroll
    for (int i = 0; i < 32; ++i) { const float x = p[(size_t)(2 * i) * ldw]; v[i] = ok ? x : 0.f; }
}
DI void cvt_store(const float (&v)[32], int ncols, bf16* WT, int ldt, int row_off, float scale, LAS float* scr, int item, int nblk, int lane) {
    const int kb = item / nblk, nb = item - kb * nblk, k0 = 64 * kb, n0 = 32 * nb;
#pragma unroll
    for (int i = 0; i < 32; ++i) scr[(2 * i + (lane >> 5)) * 33 + (lane & 31)] = v[i] * scale;
    LDS_WAIT();
    const int c = lane & 7;
#pragma unroll
    for (int j = 0; j < 4; ++j) { const int n = (lane >> 3) + 8 * j; const LAS float* s = scr + (8 * c) * 33 + n;
        u32x4 o; o.x = pk2(s[0 * 33], s[1 * 33]); o.y = pk2(s[2 * 33], s[3 * 33]); o.z = pk2(s[4 * 33], s[5 * 33]); o.w = pk2(s[6 * 33], s[7 * 33]);
        if (n0 + n < ncols) *(u32x4*)(WT + (size_t)(row_off + n0 + n) * ldt + k0 + 8 * c) = o; }
    LDS_WAIT();
}
DI void cvt_item(const float* W, int ldw, int col0, int ncols, bf16* WT, int ldt, int row_off, float scale, LAS float* scr, int item, int nblk, int lane) {
    float v[32]; cvt_load(v, W, ldw, col0, ncols, item, nblk, lane); cvt_store(v, ncols, WT, ldt, row_off, scale, scr, item, nblk, lane);
}
template <class MAP> DI void cvt_loop(const Frame& F, const float* W, int ldw, int ncols, bf16* WT, int ldt, float scale, int nitems, int nblk, const MAP& map) {
    LAS float* scr = (LAS float*)(F.lds + F.wave * 16384);
    int it = F.gw; float cur[32]; int c0 = 0, ro = 0, li = 0;
    if (it < nitems) { map(it, c0, ro, li); cvt_load(cur, W, ldw, c0, ncols, li, nblk, F.lane); }
#pragma unroll 1
    for (; it < nitems; it += F.NGW) {
        float nxt[32]; int c1 = 0, r1 = 0, l1 = 0; const int ni = it + F.NGW;
        if (ni < nitems) { map(ni, c1, r1, l1); cvt_load(nxt, W, ldw, c1, ncols, l1, nblk, F.lane); }
        cvt_store(cur, ncols, WT, ldt, ro, scale, scr, li, nblk, F.lane);
#pragma unroll
        for (int i = 0; i < 32; ++i) cur[i] = nxt[i];
        c0 = c1; ro = r1; li = l1;
    }
}
struct CvtPlain { int col0, row_off; DI void operator()(int it, int& c, int& r, int& l) const { c = col0; r = row_off; l = it; } };
DI void cvt_job(const Frame& F, const float* W, int ldw, int K, int col0, int ncols, bf16* WT, int ldt, int row_off, float scale) {
    const int nblk = (ncols + 31) / 32;
    cvt_loop(F, W, ldw, ncols, WT, ldt, scale, (K / 64) * nblk, nblk, CvtPlain{col0, row_off});
}
DI void zero_bf16(const Frame& F, bf16* p, size_t nelem) {
    const size_t gt = (size_t)blockIdx.x * (NWAVES * 64) + F.tid, NT = (size_t)F.G * NWAVES * 64;
    for (size_t i = gt; i < nelem / 8; i += NT) ((u32x4*)p)[i] = (u32x4){0u, 0u, 0u, 0u};
}
DI void ph_cvt_ffn(const Frame& F, const float* up, const float* down) {
    bf16* WUP = (bf16*)(F.ws + WS_WFFN); bf16* WDN = WUP + (size_t)2 * DFF * DM;
    struct UpMap { DI void operator()(int it, int& c, int& r, int& l) const { const int seg = it >> 7, pn = seg >> 1, isv = seg & 1; c = isv * DFF + pn * 128; r = pn * 256 + isv * 128; l = it & 127; } };
    cvt_loop(F, up, 2 * DFF, 128, WUP, DM, 1.f, 88 * 128, 4, UpMap{});
    cvt_job(F, down, DM, DFF, 0, DM, WDN, DFF, 0, 1.f);
}
DI void ph_conv_fix(const Frame& F, const float* UB, bf16* Gb, const float* cw, const float* cb, const int nrows = MC) {
    const int gt = blockIdx.x * (NWAVES * 64) + F.tid, NT = F.G * NWAVES * 64;
    for (int it = gt; it < (nrows / 256) * (DFF / 4); it += NT) {
        const int pm = it / (DFF / 4), c4 = it - pm * (DFF / 4), ch = c4 * 4, col = (ch >> 7) * 256 + (ch & 127);
        const float* ub = UB + (size_t)pm * 4 * (2 * DFF) + col; const bool has = (pm & 15) != 0;
        const f32x4 z = {0.f, 0.f, 0.f, 0.f};
        const f32x4 g0 = *(const f32x4*)(ub), g1 = *(const f32x4*)(ub + 2 * DFF), v0 = *(const f32x4*)(ub + 128), v1 = *(const f32x4*)(ub + 2 * DFF + 128);
        const f32x4 gm2 = has ? *(const f32x4*)(ub - 2 * (2 * DFF)) : z, gm1 = has ? *(const f32x4*)(ub - (2 * DFF)) : z, vm2 = has ? *(const f32x4*)(ub - 2 * (2 * DFF) + 128) : z, vm1 = has ? *(const f32x4*)(ub - (2 * DFF) + 128) : z;
        const f32x4 w0g = *(const f32x4*)(cw + ch), w1g = *(const f32x4*)(cw + 2 * DFF + ch), w2g = *(const f32x4*)(cw + 4 * DFF + ch), bg = *(const f32x4*)(cb + ch);
        const f32x4 w0v = *(const f32x4*)(cw + DFF + ch), w1v = *(const f32x4*)(cw + 3 * DFF + ch), w2v = *(const f32x4*)(cw + 5 * DFF + ch), bv = *(const f32x4*)(cb + DFF + ch);
        float o0[4], o1[4];
#pragma unroll
        for (int e = 0; e < 4; ++e) {
            const float yg0 = bg[e] + w0g[e] * gm2[e] + w1g[e] * gm1[e] + w2g[e] * g0[e], yv0 = bv[e] + w0v[e] * vm2[e] + w1v[e] * vm1[e] + w2v[e] * v0[e];
            const float yg1 = bg[e] + w0g[e] * gm1[e] + w1g[e] * g0[e] + w2g[e] * g1[e], yv1 = bv[e] + w0v[e] * vm1[e] + w1v[e] * v0[e] + w2v[e] * v1[e];
            o0[e] = yg0 * __builtin_amdgcn_rcpf(1.0f + __builtin_amdgcn_exp2f(-yg0 * LOG2E)) * yv0; o1[e] = yg1 * __builtin_amdgcn_rcpf(1.0f + __builtin_amdgcn_exp2f(-yg1 * LOG2E)) * yv1;
        }
        u32x2 a, b; a.x = pk2(o0[0], o0[1]); a.y = pk2(o0[2], o0[3]); b.x = pk2(o1[0], o1[1]); b.y = pk2(o1[2], o1[3]);
        *(u32x2*)(Gb + (size_t)(pm * 256) * DFF + ch) = a; *(u32x2*)(Gb + (size_t)(pm * 256 + 1) * DFF + ch) = b;
    }
}
DI void ph_norm_first(const Frame& F, const float* src, const float* gain, bf16* XNR, float* ss) {
    f32x4 g[8];
#pragma unroll
    for (int j = 0; j < 8; ++j) g[j] = *(const f32x4*)(gain + 4 * (F.lane + 64 * j));
    for (int m = F.gw; m < MTOT; m += F.NGW) {
        const f32x4* xr = (const f32x4*)(src + (size_t)m * DM) + F.lane;
        f32x4 v[8]; float s2 = 0.f;
#pragma unroll
        for (int j = 0; j < 8; ++j) { v[j] = xr[64 * j]; s2 += (v[j].x * v[j].x + v[j].y * v[j].y) + (v[j].z * v[j].z + v[j].w * v[j].w); }
        s2 = wave_sum(s2);
        if (F.lane < 2) *(f32x4*)(ss + (size_t)m * 8 + 4 * F.lane) = (f32x4){F.lane == 0 ? s2 : 0.f, 0.f, 0.f, 0.f};
        u32x2* o = (u32x2*)(XNR + (size_t)m * DM) + F.lane;
#pragma unroll
        for (int j = 0; j < 8; ++j) { const f32x4 y = v[j] * g[j]; u32x2 w; w.x = pk2(y.x, y.y); w.y = pk2(y.z, y.w); o[64 * j] = w; }
    }
}
DI void ph_final_norm(const Frame& F, float* h, const float* gain) {
    f32x4 g[8];
#pragma unroll
    for (int j = 0; j < 8; ++j) g[j] = *(const f32x4*)(gain + 4 * (F.lane + 64 * j));
    for (int m = F.gw; m < MTOT; m += F.NGW) {
        f32x4* xr = (f32x4*)(h + (size_t)m * DM) + F.lane;
        f32x4 v[8]; float ss = 0.f;
#pragma unroll
        for (int j = 0; j < 8; ++j) { v[j] = xr[64 * j]; ss += (v[j].x * v[j].x + v[j].y * v[j].y) + (v[j].z * v[j].z + v[j].w * v[j].w); }
        const float rstd = 1.0f / sqrtf(wave_sum(ss) * (1.f / DM) + NORM_EPS);
#pragma unroll
        for (int j = 0; j < 8; ++j) xr[64 * j] = v[j] * rstd * g[j];
    }
}
constexpr size_t DA_DIN = 0, DA_CQN = 64 * MiB, DA_LATC = 80 * MiB, DA_KPE = 88 * MiB, DA_KIDX = 90 * MiB, DA_WIDX = 94 * MiB, DA_QL = 96 * MiB, DA_QPE = 352 * MiB, DA_QIDX = 400 * MiB,
                 DA_SEL = 464 * MiB, DA_CNT = 472 * MiB, DA_SC = 474 * MiB, DA_O2 = 474 * MiB;
constexpr size_t DW_W1 = 0, DW_W2 = (size_t)1024 * 2048, DW_WO = DW_W2 + (size_t)11776 * 512, DW_BD = DW_WO + (size_t)2048 * 4096;
constexpr float DSA_QSCALE = 0.07216878364870322f * LOG2E;
constexpr float DSA_WIDX_SCALE = 0.25f * 0.08838834764831845f;

DI void ph_dsa_cvt(const Frame& F, const float* w_in, const float* w_qup, const float* w_uk, const float* w_uv, const float* w_out) {
    bf16* WB = (bf16*)(F.ws + WS_WMIX);
    cvt_job(F, w_in, 960, DM, 0, 960, WB + DW_W1, DM, 0, 1.f);
    zero_bf16(F, WB + DW_W1 + (size_t)960 * DM, (size_t)64 * DM);
    { LAS float* scr = (LAS float*)(F.lds + F.wave * 16384);
      for (int it = F.gw; it < 32 * 16; it += F.NGW) { const int h = it >> 4; cvt_item(w_qup, 8192, h * 192, 48, WB + DW_W2, 512, 8192 + h * 48, DSA_QSCALE, scr, it & 15, 2, F.lane); } }
    cvt_job(F, w_qup, 8192, 512, 6144, 2048, WB + DW_W2, 512, 9728, 1.f);
    __syncthreads();
    {
        LAS float* As = (LAS float*)F.lds; LAS float* Bs = As + 64 * 145;
        for (int u = blockIdx.x; u < 32 * 4 * 8; u += F.G) {
            const int h = u >> 5, r0 = ((u >> 3) & 3) * 64, k0 = (u & 7) * 64;
            for (int i = F.tid; i < 64 * 144; i += NWAVES * 64) { const int row = i / 144, col = i - row * 144;
                As[row * 145 + col] = w_uk[(size_t)(h * 256 + r0) * 144 + i]; Bs[row * 145 + col] = w_qup[(size_t)(k0 + row) * 8192 + h * 192 + 48 + col]; }
            __syncthreads();
            const int r = F.tid & 63, kg = F.tid >> 6; float acc[8];
#pragma unroll
            for (int j = 0; j < 8; ++j) acc[j] = 0.f;
            for (int n = 0; n < 144; ++n) { const float a = As[r * 145 + n];
#pragma unroll
                for (int j = 0; j < 8; ++j) acc[j] += a * Bs[(kg * 8 + j) * 145 + n]; }
            u32x4 o; o.x = pk2(acc[0] * DSA_QSCALE, acc[1] * DSA_QSCALE); o.y = pk2(acc[2] * DSA_QSCALE, acc[3] * DSA_QSCALE); o.z = pk2(acc[4] * DSA_QSCALE, acc[5] * DSA_QSCALE); o.w = pk2(acc[6] * DSA_QSCALE, acc[7] * DSA_QSCALE);
            *(u32x4*)(WB + DW_W2 + (size_t)(h * 256 + r0 + r) * 512 + k0 + kg * 8) = o;
            __syncthreads();
        }
    }
    { LAS float* scr = (LAS float*)(F.lds + F.wave * 16384);
      for (int it = F.gw; it < 32 * 16; it += F.NGW) { const int h = it >> 4; cvt_item(w_uv + (size_t)h * 256 * 128, 128, 0, 128, WB + DW_BD + (h & 1) * 256, 512, h * 128, 1.f, scr, it & 15, 4, F.lane); } }
    { const size_t gt = (size_t)blockIdx.x * (NWAVES * 64) + F.tid, NT = (size_t)F.G * NWAVES * 64;
      for (size_t i = gt; i < (size_t)4096 * 32; i += NT) { const int row = (int)(i >> 5), pc = (int)(i & 31); *(u32x4*)(WB + DW_BD + (size_t)row * 512 + (1 - ((row >> 7) & 1)) * 256 + pc * 8) = (u32x4){0u, 0u, 0u, 0u}; } }
    cvt_job(F, w_out, DM, 4096, 0, DM, WB + DW_WO, 4096, 0, 1.f);
}
DI void ph_dsa_post1(const Frame& F, int half, const float* qn, const float* kvn, const float* lng, const float* lnb) {
    unsigned char* ar = F.ws + WS_AR;
    const float* DIN = (const float*)(ar + DA_DIN); bf16* CQN = (bf16*)(ar + DA_CQN); bf16* LATC = (bf16*)(ar + DA_LATC); bf16* KPE = (bf16*)(ar + DA_KPE); bf16* KIDX = (bf16*)(ar + DA_KIDX); float* WIDX = (float*)(ar + DA_WIDX);
    const float* c48 = (const float*)(F.ws + TAB_COS48); const float* s48 = (const float*)(F.ws + TAB_SIN48); const float* c32 = (const float*)(F.ws + TAB_COS32); const float* s32 = (const float*)(F.ws + TAB_SIN32);
    LAS float* buf = (LAS float*)(F.lds + F.wave * 1024);
    const int lane = F.lane;
    for (int ml = F.gw; ml < MC; ml += F.NGW) {
        const int mg = half * MC + ml;
        const size_t kfb = ((size_t)(ml >> 5) * 8 * 64 + (ml & 31)) * 8;
        const float* row = DIN + (size_t)ml * 1024 + 16 * lane;
        f32x4 v[4]; float ss = 0.f, s1 = 0.f;
#pragma unroll
        for (int j = 0; j < 4; ++j) { v[j] = *(const f32x4*)(row + 4 * j); ss += (v[j].x * v[j].x + v[j].y * v[j].y) + (v[j].z * v[j].z + v[j].w * v[j].w); s1 += (v[j].x + v[j].y) + (v[j].z + v[j].w); }
        const bool isq = lane < 32, iskv = lane >= 32 && lane < 48, ispe = lane >= 48 && lane < 51, isix = lane >= 51 && lane < 59;
        const float ssq = wave_sum(isq ? ss : 0.f), sskv = wave_sum(iskv ? ss : 0.f), mean = wave_sum(isix ? s1 : 0.f) * (1.f / 128.f);
        float d2 = 0.f;
#pragma unroll
        for (int j = 0; j < 4; ++j) { const f32x4 d = v[j] - mean; d2 += (d.x * d.x + d.y * d.y) + (d.z * d.z + d.w * d.w); }
        const float var = wave_sum(isix ? d2 : 0.f) * (1.f / 128.f);
        const float rq = 1.0f / sqrtf(ssq * (1.f / 512.f) + NORM_EPS), rkv = 1.0f / sqrtf(sskv * (1.f / 256.f) + NORM_EPS), rstd = 1.0f / sqrtf(var + NORM_EPS);
        if (isq || iskv) {
            const float* gp = isq ? qn + 16 * lane : kvn + 16 * (lane - 32); const float rs = isq ? rq : rkv;
            bf16* dst = isq ? CQN + (size_t)ml * 512 + 16 * lane : LATC + (size_t)ml * 256 + 16 * (lane - 32);
            u32x4 o[2];
#pragma unroll
            for (int j = 0; j < 4; ++j) { const f32x4 g = *(const f32x4*)(gp + 4 * j); const f32x4 y = v[j] * rs * g; o[j >> 1][(j & 1) * 2] = pk2(y.x, y.y); o[j >> 1][(j & 1) * 2 + 1] = pk2(y.z, y.w); }
            *(u32x4*)dst = o[0]; *(u32x4*)(dst + 8) = o[1];
        } else if (ispe) {
#pragma unroll
            for (int j = 0; j < 4; ++j) *(LAS f32x4*)(buf + (lane - 48) * 16 + 4 * j) = v[j];
        } else if (isix) {
#pragma unroll
            for (int j = 0; j < 4; ++j) { const f32x4 g = *(const f32x4*)(lng + (lane - 51) * 16 + 4 * j), b = *(const f32x4*)(lnb + (lane - 51) * 16 + 4 * j); *(LAS f32x4*)(buf + 48 + (lane - 51) * 16 + 4 * j) = (v[j] - mean) * rstd * g + b; }
        } else if (lane == 59) {
#pragma unroll
            for (int j = 0; j < 4; ++j) *(f32x4*)(WIDX + (size_t)ml * 16 + 4 * j) = v[j] * DSA_WIDX_SCALE;
        }
        LDS_WAIT();
        if (lane < 24) { const float x1 = buf[lane], x2 = buf[24 + lane], c = c48[(size_t)mg * 24 + lane], s = s48[(size_t)mg * 24 + lane];
            KPE[(size_t)ml * 48 + lane] = f2bf(x1 * c - x2 * s); KPE[(size_t)ml * 48 + 24 + lane] = f2bf(x1 * s + x2 * c);
        } else if (lane < 40) { const int i = lane - 24; const float x1 = buf[48 + i], x2 = buf[48 + 16 + i], c = c32[(size_t)mg * 16 + i], s = s32[(size_t)mg * 16 + i];
            KIDX[kfb + (size_t)((i >> 3) * 32) * 8 + (i & 7)] = f2bf(x1 * c - x2 * s); KIDX[kfb + (size_t)(64 + (i >> 3) * 32) * 8 + (i & 7)] = f2bf(x1 * s + x2 * c);
        } else { const int d = 32 + 4 * (lane - 40); const f32x4 y = *(const LAS f32x4*)(buf + 48 + d); u32x2 w; w.x = pk2(y.x, y.y); w.y = pk2(y.z, y.w); *(u32x2*)(KIDX + kfb + (size_t)((d >> 4) * 64 + ((d >> 3) & 1) * 32) * 8 + (d & 7)) = w; }
        LDS_WAIT();
    }
}
DI void ph_dsa_rope(const Frame& F, int half) {
    unsigned char* ar = F.ws + WS_AR; bf16* QPE = (bf16*)(ar + DA_QPE); bf16* QIDX = (bf16*)(ar + DA_QIDX);
    const float* c48 = (const float*)(F.ws + TAB_COS48); const float* s48 = (const float*)(F.ws + TAB_SIN48); const float* c32 = (const float*)(F.ws + TAB_COS32); const float* s32 = (const float*)(F.ws + TAB_SIN32);
    for (int ml = F.gw; ml < MC; ml += F.NGW) {
        const size_t mg = (size_t)half * MC + ml;
        for (int p = F.lane; p < 768; p += 64) { const int hd = p / 24, i = p - hd * 24; bf16* q = QPE + (size_t)ml * 1536 + hd * 48 + i;
            const float x1 = bf2f(q[0]), x2 = bf2f(q[24]), c = c48[mg * 24 + i], s = s48[mg * 24 + i]; q[0] = f2bf(x1 * c - x2 * s); q[24] = f2bf(x1 * s + x2 * c); }
        for (int p = F.lane; p < 256; p += 64) { const int hd = p >> 4, i = p & 15; bf16* q = QIDX + (size_t)ml * 2048 + hd * 128 + i;
            const float x1 = bf2f(q[0]), x2 = bf2f(q[16]), c = c32[mg * 16 + i], s = s32[mg * 16 + i]; q[0] = f2bf(x1 * c - x2 * s); q[16] = f2bf(x1 * s + x2 * c); }
    }
}
DI int wave_iscan_dpp(int v) {
    v += __builtin_amdgcn_update_dpp(0, v, 0x111, 0xf, 0xf, true); v += __builtin_amdgcn_update_dpp(0, v, 0x112, 0xf, 0xf, true);
    v += __builtin_amdgcn_update_dpp(0, v, 0x114, 0xf, 0xf, true); v += __builtin_amdgcn_update_dpp(0, v, 0x118, 0xf, 0xf, true);
    v += __builtin_amdgcn_update_dpp(0, v, 0x142, 0xa, 0xf, false);
    v += __builtin_amdgcn_update_dpp(0, v, 0x143, 0xc, 0xf, false);
    return v;
}
DI int wave_isum_dpp(int v) {
    v += __builtin_amdgcn_update_dpp(0, v, 0x111, 0xf, 0xf, true); v += __builtin_amdgcn_update_dpp(0, v, 0x112, 0xf, 0xf, true);
    v += __builtin_amdgcn_update_dpp(0, v, 0x114, 0xf, 0xf, true); v += __builtin_amdgcn_update_dpp(0, v, 0x118, 0xf, 0xf, true);
    v += __builtin_amdgcn_update_dpp(0, v, 0x142, 0xa, 0xf, false);
    v += __builtin_amdgcn_update_dpp(0, v, 0x143, 0xc, 0xf, false);
    return __builtin_amdgcn_readlane(v, 63);
}
DI unsigned f2sortable(float s) { const unsigned b = __builtin_bit_cast(unsigned, s); return (b & 0x80000000u) ? ~b : (b | 0x80000000u); }
DI void ph_dsa_index(const Frame& F) {
    unsigned char* ar = F.ws + WS_AR;
    const bf16* QIDX = (const bf16*)(ar + DA_QIDX); const bf16* KIDX = (const bf16*)(ar + DA_KIDX); const float* WIDX = (const float*)(ar + DA_WIDX);
    unsigned short* SEL = (unsigned short*)(ar + DA_SEL); int* CNT = (int*)(ar + DA_CNT); float* SC = (float*)(ar + DA_SC) + (size_t)F.gw * 16384;
    const int lane = F.lane, r = lane & 31, hf = lane >> 5;
    LAS unsigned char* wl = F.lds + F.wave * 8192 + lane * 16;
    LAS unsigned* hist = (LAS unsigned*)(F.lds + 65536 + F.wave * 1024);
#pragma unroll 1
    for (int tile = blockIdx.x; tile < BPH * 128; tile += F.G) {
        const int j = tile >> 8, c8 = tile & 255, c7 = c8 & 127, bl = (c8 >> 7) * 2 + j, qt = j ? 127 - c7 : c7;
        const int q0 = qt * 32 + 4 * F.wave;
        const int ntile = (q0 + 3) / 32 + 1;
        bf16x8 qa[2][8];
#pragma unroll
        for (int pr = 0; pr < 2; ++pr) {
            const int mrow = bl * SEQ + q0 + 2 * pr + (r >> 4);
#pragma unroll
            for (int s = 0; s < 8; ++s) qa[pr][s] = *(const bf16x8*)(QIDX + (size_t)mrow * 2048 + (r & 15) * 128 + 16 * s + 8 * hf);
            float wv[2][16];
#pragma unroll
            for (int i = 0; i < 16; ++i) wv[pr][i] = WIDX[(size_t)(bl * SEQ + q0 + 2 * pr + (i >> 3)) * 16 + (i & 3) + 8 * ((i >> 2) & 1) + 4 * hf];
#pragma unroll
            for (int i = 0; i < 16; i += 4) *(LAS f32x4*)(wl + (pr * 4 + (i >> 2)) * 1024) = (f32x4){wv[pr][i], wv[pr][i + 1], wv[pr][i + 2], wv[pr][i + 3]};
        }
        LDS_WAIT();
        {
        bf16x8 kf[8];
        { const bf16* kp = KIDX + ((size_t)(bl * 128) * 8 * 64 + lane) * 8;
#pragma unroll
          for (int s = 0; s < 8; ++s) kf[s] = *(const bf16x8*)(kp + 512 * s); }
#pragma unroll 1
        for (int t = 0; t < ntile; ++t) {
            f32x16 accs[2];
#pragma unroll
            for (int pr = 0; pr < 2; ++pr) {
#pragma unroll
                for (int i = 0; i < 16; ++i) accs[pr][i] = 0.f;
#pragma unroll
                for (int s = 0; s < 8; ++s) accs[pr] = MFMA32(qa[pr][s], kf[s], accs[pr]);
            }
            if (t + 1 < ntile) { const bf16* kp = KIDX + ((size_t)(bl * 128 + t + 1) * 8 * 64 + lane) * 8;
#pragma unroll
                for (int s = 0; s < 8; ++s) kf[s] = *(const bf16x8*)(kp + 512 * s); }
#pragma unroll
            for (int pr = 0; pr < 2; ++pr) {
                const f32x16 acc = accs[pr];
                float wv[2][16];
                { unsigned wa_ = (unsigned)(size_t)wl; asm volatile("" : "+v"(wa_));
#pragma unroll
                  for (int i = 0; i < 16; i += 4) { const f32x4 w4 = *(const LAS f32x4*)((LAS unsigned char*)(size_t)wa_ + (pr * 4 + (i >> 2)) * 1024); wv[pr][i] = w4.x; wv[pr][i + 1] = w4.y; wv[pr][i + 2] = w4.z; wv[pr][i + 3] = w4.w; } }
                float p0 = 0.f, p1 = 0.f;
#pragma unroll
                for (int i = 0; i < 8; ++i) { p0 += wv[pr][i] * fmaxf(acc[i], 0.f); p1 += wv[pr][8 + i] * fmaxf(acc[8 + i], 0.f); }
                const float t0 = p0 + __shfl_xor(p0, 32), t1 = p1 + __shfl_xor(p1, 32);
                SC[(pr * 128 + t) * 64 + lane] = hf ? t1 : t0;
            }
        }
        }
        VM_WAIT();
#pragma unroll 1
        for (int qi = 0; qi < 4; ++qi) {
            const int tq = q0 + qi, pr = qi >> 1, qs = qi & 1;
            unsigned u[64];
            const unsigned* scp = (const unsigned*)(SC + pr * 8192 + hf * 64 + qs * 32 + r);
#pragma unroll
            for (int g8 = 0; g8 < 8; ++g8) {
#pragma unroll
                for (int e = 0; e < 8; ++e) { const int i = 8 * g8 + e; const float s = __builtin_bit_cast(float, __hip_atomic_load(scp + e * 128, __ATOMIC_RELAXED, __HIP_MEMORY_SCOPE_AGENT));
                    u[i] = (2 * i + hf < ntile && 64 * i + lane <= tq) ? f2sortable(s) : 0u; }
                scp += 1024; asm volatile("" : "+v"(scp));
            }
            unsigned prefix = 0u;
            if (tq >= 256) {
#pragma unroll 1
                for (int bit = 31; bit >= 0; --bit) {
                    const unsigned cand = prefix | (1u << bit); int c = 0;
#pragma unroll
                    for (int g8 = 0; g8 < 8; ++g8) { if (g8 * 512 <= tq) {
#pragma unroll
                        for (int e = 0; e < 8; ++e) c += (u[8 * g8 + e] >= cand) ? 1 : 0; } }
                    c = wave_isum_dpp(c);
                    if (c >= 256) prefix = cand;
                    if (c == 256) break;
                }
            }
            const unsigned T = prefix > 1u ? prefix : 1u;
            int nl = 0;
#pragma unroll
            for (int g8 = 0; g8 < 8; ++g8) { if (g8 * 512 <= tq) {
#pragma unroll
                for (int e = 0; e < 8; ++e) nl += (u[8 * g8 + e] >= T) ? 1 : 0; } }
            const int inc = wave_iscan_dpp(nl), base = __builtin_amdgcn_readlane(inc, 63);
            int pos = inc - nl;
            unsigned short* sel = SEL + (size_t)(bl * SEQ + tq) * 256;
#pragma unroll
            for (int g8 = 0; g8 < 8; ++g8) { if (g8 * 512 <= tq) {
#pragma unroll
                for (int e = 0; e < 8; ++e) { const int i = 8 * g8 + e; if (u[i] >= T) { if (pos < 256) sel[pos] = (unsigned short)(64 * i + lane); ++pos; } } } }
            if (lane == 0) CNT[bl * SEQ + tq] = base < 256 ? base : 256;
        }
    }
}
DI int dsa_fsw(int row) { return ((row & 3) << 2) | ((row >> 2) & 3); }
struct DsaPre { u32x4 row[16]; bf16x8 kpe[3]; bf16x8 q[3]; };
DI void dsa_prefetch(DsaPre& P, const bf16* LATC, const bf16* KPE, const bf16* QL, const bf16* QPE, int ml, int selv, int lane, int w) {
    const int bl = ml >> 12, r = lane & 31, h = lane >> 5;
#pragma unroll
    for (int it = 0; it < 16; ++it) { const int ki = __shfl(selv, (lane >> 5) + 2 * it); P.row[it] = *(const u32x4*)(LATC + (size_t)(bl * SEQ + ki) * 256 + (lane & 31) * 8); }
#pragma unroll
    for (int s = 0; s < 3; ++s) P.kpe[s] = *(const bf16x8*)(KPE + (size_t)(bl * SEQ + selv) * 48 + 16 * s + 8 * h);
#pragma unroll
    for (int j = 0; j < 3; ++j) { const int fi = w + 8 * j;
        if (fi < 16) P.q[j] = *(const bf16x8*)(QL + (size_t)ml * 8192 + r * 256 + 16 * fi + 8 * h);
        else if (fi < 19) P.q[j] = *(const bf16x8*)(QPE + (size_t)ml * 1536 + r * 48 + 16 * (fi - 16) + 8 * h); }
}
DI void ph_dsa_attn(const Frame& F) {
    unsigned char* ar = F.ws + WS_AR;
    bf16* QL = (bf16*)(ar + DA_QL); const bf16* QPE = (const bf16*)(ar + DA_QPE); const bf16* LATC = (const bf16*)(ar + DA_LATC); const bf16* KPE = (const bf16*)(ar + DA_KPE);
    const unsigned short* SEL = (const unsigned short*)(ar + DA_SEL); const int* CNT = (const int*)(ar + DA_CNT);
    const int lane = F.lane, r = lane & 31, h = lane >> 5, w = F.wave;
    LAS unsigned char* IMG = F.lds; LAS unsigned char* QB = F.lds + LDSCTL_OFF + 256; LAS float* MX = (LAS float*)(F.lds + LDSCTL_OFF + 256 + 19456); LAS float* SX = MX + 256;
    const int i16 = lane & 15, tq_ = i16 >> 2, tp_ = i16 & 3, blk = (lane >> 4) & 1;
    int ml = blockIdx.x;
    if (ml >= MC) return;
    DsaPre P;
    int cnt_c = CNT[ml];
    { const int slot = 32 * w + r; const int selv = slot < cnt_c ? (int)SEL[(size_t)ml * 256 + slot] : 0; dsa_prefetch(P, LATC, KPE, QL, QPE, ml, selv, lane, w); }
    int cnt_n = 0, selv_n = 0;
    if (ml + F.G < MC) { cnt_n = CNT[ml + F.G]; const int slot = 32 * w + r; selv_n = slot < cnt_n ? (int)SEL[(size_t)(ml + F.G) * 256 + slot] : 0; }
#pragma unroll 1
    for (; ml < MC; ml += F.G) {
        const int cnt = cnt_c, nch = (cnt + 31) >> 5; const bool act = w < nch;
#pragma unroll
        for (int it = 0; it < 16; ++it) { const int rr = (lane >> 5) + 2 * it; *(LAS u32x4*)(IMG + (32 * w + rr) * 512 + (((lane & 31) ^ dsa_fsw(rr)) * 16)) = P.row[it]; }
#pragma unroll
        for (int j = 0; j < 3; ++j) { const int fi = w + 8 * j; if (fi < 19) *(LAS bf16x8*)(QB + fi * 1024 + lane * 16) = P.q[j]; }
        bf16x8 kpe[3];
#pragma unroll
        for (int s = 0; s < 3; ++s) kpe[s] = P.kpe[s];
        LDS_WAIT(); __builtin_amdgcn_s_barrier(); asm volatile("" ::: "memory");
        if (ml + F.G < MC) {
            dsa_prefetch(P, LATC, KPE, QL, QPE, ml + F.G, selv_n, lane, w); cnt_c = cnt_n;
            if (ml + 2 * F.G < MC) { cnt_n = CNT[ml + 2 * F.G]; const int slot = 32 * w + r; selv_n = slot < cnt_n ? (int)SEL[(size_t)(ml + 2 * F.G) * 256 + slot] : 0; }
        }
        f32x16 S; float mx = -INFINITY;
#pragma unroll
        for (int i = 0; i < 16; ++i) S[i] = 0.f;
        if (act) {
#pragma unroll
            for (int s = 0; s < 16; ++s) S = MFMA32(*(const LAS bf16x8*)(IMG + (32 * w + r) * 512 + (((2 * s + h) ^ dsa_fsw(r)) * 16)), *(const LAS bf16x8*)(QB + s * 1024 + lane * 16), S);
#pragma unroll
            for (int s = 0; s < 3; ++s) S = MFMA32(kpe[s], *(const LAS bf16x8*)(QB + (16 + s) * 1024 + lane * 16), S);
#pragma unroll
            for (int i = 0; i < 16; ++i) { S[i] = (32 * w + crow(i, h) < cnt) ? S[i] : -INFINITY; mx = fmaxf(mx, S[i]); }
            mx = fmaxf(mx, __shfl_xor(mx, 32));
        }
        if (h == 0) MX[w * 32 + r] = mx;
        LDS_WAIT(); __builtin_amdgcn_s_barrier(); asm volatile("" ::: "memory");
        float M = MX[r];
#pragma unroll
        for (int k = 1; k < 8; ++k) M = fmaxf(M, MX[k * 32 + r]);
        float lsum = 0.f; bf16x8 pf[2] = {(bf16x8){0, 0, 0, 0, 0, 0, 0, 0}, (bf16x8){0, 0, 0, 0, 0, 0, 0, 0}};
        if (act) {
#pragma unroll
            for (int i = 0; i < 16; ++i) { S[i] = __builtin_amdgcn_exp2f(S[i] - M); lsum += S[i]; }
#pragma unroll
            for (int s = 0; s < 2; ++s) { u32x4 t; t.x = pk2(S[8 * s], S[8 * s + 1]); t.y = pk2(S[8 * s + 2], S[8 * s + 3]); t.z = pk2(S[8 * s + 4], S[8 * s + 5]); t.w = pk2(S[8 * s + 6], S[8 * s + 7]); pf[s] = __builtin_bit_cast(bf16x8, t); }
        }
        lsum += __shfl_xor(lsum, 32);
        if (h == 0) SX[w * 32 + r] = lsum;
        *(LAS bf16x8*)(QB + (2 * w) * 1024 + lane * 16) = pf[0]; *(LAS bf16x8*)(QB + (2 * w + 1) * 1024 + lane * 16) = pf[1];
        LDS_WAIT(); __builtin_amdgcn_s_barrier(); asm volatile("" ::: "memory");
        f32x16 O;
#pragma unroll
        for (int i = 0; i < 16; ++i) O[i] = 0.f;
#pragma unroll 2
        for (int ks = 0; ks < 2 * nch; ++ks) {
            const int r0 = 16 * ks + 4 * h + tq_, r1 = r0 + 8, pc = 4 * w + 2 * blk + (tp_ >> 1);
            const s16x4 lo = __builtin_bit_cast(s16x4, __builtin_amdgcn_ds_read_tr16_b64_v4i16((LAS v4i16_t*)(IMG + r0 * 512 + ((pc ^ dsa_fsw(r0)) * 16) + 8 * (tp_ & 1))));
            const s16x4 hi = __builtin_bit_cast(s16x4, __builtin_amdgcn_ds_read_tr16_b64_v4i16((LAS v4i16_t*)(IMG + r1 * 512 + ((pc ^ dsa_fsw(r1)) * 16) + 8 * (tp_ & 1))));
            O = MFMA32(__builtin_shufflevector(lo, hi, 0, 1, 2, 3, 4, 5, 6, 7), *(const LAS bf16x8*)(QB + ks * 1024 + lane * 16), O);
        }
        float l = SX[r];
#pragma unroll
        for (int k = 1; k < 8; ++k) l += SX[k * 32 + r];
        const float linv = 1.0f / l;
        bf16* o = QL + (size_t)ml * 8192 + r * 256 + 32 * w + 4 * h;
#pragma unroll
        for (int g = 0; g < 4; ++g) { u32x2 t; t.x = pk2(O[4 * g] * linv, O[4 * g + 1] * linv); t.y = pk2(O[4 * g + 2] * linv, O[4 * g + 3] * linv); *(u32x2*)(o + 8 * g) = t; }
        LDS_WAIT(); __builtin_amdgcn_s_barrier(); asm volatile("" ::: "memory");
    }
}
template <int NDB, bool RESC = true> DI void softmax_step(f32x16& S, float& m, float& l, f32x16 (&O)[NDB], bf16x8 (&pf)[2]) {
    float mx = fmaxf(S[0], S[1]);
#pragma unroll
    for (int i = 2; i < 16; i += 2) mx = __builtin_fmaxf(mx, __builtin_fmaxf(S[i], S[i + 1]));
    mx = fmaxf(mx, __shfl_xor(mx, 32));
    const float mn = fmaxf(m, mx), ms = (mn == -INFINITY) ? 0.f : mn;
    const float alpha = __builtin_amdgcn_exp2f(m - ms);
    float sum = 0.f;
#pragma unroll
    for (int i = 0; i < 16; ++i) { S[i] = __builtin_amdgcn_exp2f(S[i] - ms); sum += S[i]; }
    l = l * alpha + sum; m = mn;
    if (RESC && __builtin_amdgcn_ballot_w64(alpha != 1.0f) != 0ull) {
#pragma unroll
        for (int db = 0; db < NDB; ++db)
#pragma unroll
            for (int i = 0; i < 16; ++i) O[db][i] *= alpha;
    }
#pragma unroll
    for (int s = 0; s < 2; ++s) { u32x4 w; w.x = pk2(S[8 * s], S[8 * s + 1]); w.y = pk2(S[8 * s + 2], S[8 * s + 3]); w.z = pk2(S[8 * s + 4], S[8 * s + 5]); w.w = pk2(S[8 * s + 6], S[8 * s + 7]); pf[s] = __builtin_bit_cast(bf16x8, w); }
}
template <bool ACC> DI void store_col(bf16* out, const f32x16 (&O)[4], float scale, int h) {
#pragma unroll
    for (int db = 0; db < 4; ++db)
#pragma unroll
        for (int g = 0; g < 4; ++g) { u32x2* p = (u32x2*)(out + db * 32 + 8 * g + 4 * h);
            float a = O[db][4 * g] * scale, b = O[db][4 * g + 1] * scale, c = O[db][4 * g + 2] * scale, d = O[db][4 * g + 3] * scale;
            if (ACC) { const u32x2 o = *p; a += bflo(o.x); b += bfhi(o.x); c += bflo(o.y); d += bfhi(o.y); }
            u32x2 w; w.x = pk2(a, b); w.y = pk2(c, d); *p = w; }
}
template <int NQ> struct TilePre { u32x4 a, b, c; };
template <int NQ, class SRC> DI void tile_fetch(TilePre<NQ>& p, const SRC& src, int T, int tid) {
    const bf16* k = src.k(T); const bf16* v = src.v(T);
    constexpr int NK = NQ * 64;
    p.a = *(const u32x4*)(k + (size_t)tid * 8);
    const int p1 = tid + 512; p.b = (p1 < NK) ? *(const u32x4*)(k + (size_t)p1 * 8) : *(const u32x4*)(v + (size_t)(p1 - NK) * 8);
    if (NQ * 64 + 512 > 1024) { const int p2 = tid + 1024; if (p2 < NK + 512) p.c = *(const u32x4*)(v + (size_t)(p2 - NK) * 8); }
}
template <int NQ> DI void tile_put(const TilePre<NQ>& p, LAS unsigned char* buf, int tid) {
    *(LAS u32x4*)(buf + tid * 16) = p.a; *(LAS u32x4*)(buf + (tid + 512) * 16) = p.b;
    if (NQ * 64 + 512 > 1024) { if (tid + 1024 < NQ * 64 + 512) *(LAS u32x4*)(buf + (tid + 1024) * 16) = p.c; }
}
template <int NQ, bool PV, class SRC, class MK>
DI void attn_run_sh(LAS unsigned char* tl, int tid, int lane, const bf16x8 (&qf)[NQ], f32x16 (&O)[4], float& m, float& l, int TB, int TE, int tb, int te, const SRC& src, const MK& mk) {
    constexpr int TBYTES = (NQ + 8) * 1024;
    if (TB >= TE) return;
    TilePre<NQ> pre;
    tile_fetch<NQ>(pre, src, TB, tid); tile_put<NQ>(pre, tl, tid);
    LDS_WAIT(); __builtin_amdgcn_s_barrier(); asm volatile("" ::: "memory");
#pragma unroll 1
    for (int T = TB; T < TE; ++T) {
        LAS unsigned char* cur = tl + ((T - TB) & 1) * TBYTES;
        if (T + 1 < TE) tile_fetch<NQ>(pre, src, T + 1, tid);
        if (T >= tb && T < te) {
            f32x16 S;
#pragma unroll
            for (int i = 0; i < 16; ++i) S[i] = 0.f;
#pragma unroll
            for (int s = 0; s < NQ; ++s) S = MFMA32(*(const LAS bf16x8*)(cur + s * 1024 + lane * 16), qf[s], S);
            if (mk.need(T)) mk(T, S);
            bf16x8 pf[2]; softmax_step<4, PV>(S, m, l, O, pf);
            if (PV) {
#pragma unroll
                for (int db = 0; db < 4; ++db)
#pragma unroll
                    for (int s = 0; s < 2; ++s) O[db] = MFMA32(*(const LAS bf16x8*)(cur + (NQ + db * 2 + s) * 1024 + lane * 16), pf[s], O[db]);
            }
        }
        if (T + 1 < TE) tile_put<NQ>(pre, tl + ((T + 1 - TB) & 1) * TBYTES, tid);
        LDS_WAIT(); __builtin_amdgcn_s_barrier(); asm volatile("" ::: "memory");
    }
}
struct FragSrc { const bf16* kb; const bf16* vb; int nq; DI const bf16* k(int T) const { return kb + (size_t)T * nq * 512; } DI const bf16* v(int T) const { return vb + (size_t)T * 8 * 512; } };
constexpr size_t FA_Q = 0, FA_K = 64 * MiB, FA_F = 128 * MiB, FA_V = 136 * MiB, FA_CUM = 200 * MiB, FA_O = 202 * MiB, FA_KF = 266 * MiB, FA_VF = 338 * MiB;
constexpr size_t FW_IN = 0, FW_OUT = (size_t)6400 * 2048;
constexpr float FOX_QSCALE = 0.08838834764831845f * LOG2E;
DI void ph_fox_cvt(const Frame& F, const float* w_in, const float* w_out) {
    bf16* WB = (bf16*)(F.ws + WS_WMIX);
    cvt_job(F, w_in, 6160, DM, 0, 2048, WB + FW_IN, DM, 0, FOX_QSCALE);
    cvt_job(F, w_in, 6160, DM, 2048, 2048, WB + FW_IN, DM, 2048, 1.f);
    cvt_job(F, w_in, 6160, DM, 4096, 2048, WB + FW_IN, DM, 4096, 1.f);
    cvt_job(F, w_in, 6160, DM, 6144, 16, WB + FW_IN, DM, 6144, 1.f);
    zero_bf16(F, WB + FW_IN + (size_t)6160 * DM, (size_t)240 * DM);
    cvt_job(F, w_out, DM, DM, 0, DM, WB + FW_OUT, DM, 0, 1.f);
}
DI void ph_fox_scan(const Frame& F, const float* b_f) {
    unsigned char* ar = F.ws + WS_AR; const bf16* FB = (const bf16*)(ar + FA_F); float* CUM = (float*)(ar + FA_CUM);
    for (int w = F.gw; w < BPH * 16; w += F.NGW) {
        const int bl = w >> 4, hd = w & 15; const float bf_ = b_f[hd];
        float v[64]; float run = 0.f;
#pragma unroll
        for (int i = 0; i < 64; ++i) { const float x = bf2f(FB[(size_t)(bl * SEQ + F.lane * 64 + i) * 256 + hd]) + bf_;
            const float ls = fminf(x, 0.f) - log1pf(expf(-fabsf(x))); run += ls; v[i] = run; }
        float inc = run;
#pragma unroll
        for (int o = 1; o < 64; o <<= 1) { const float y = __shfl_up(inc, o); if (F.lane >= o) inc += y; }
        const float base = inc - run;
        float* dst = CUM + (size_t)w * SEQ + F.lane * 64;
#pragma unroll
        for (int i = 0; i < 64; i += 4) *(f32x4*)(dst + i) = (f32x4){(v[i] + base) * LOG2E, (v[i + 1] + base) * LOG2E, (v[i + 2] + base) * LOG2E, (v[i + 3] + base) * LOG2E};
        bf16* KF9 = (bf16*)(ar + FA_KF) + (size_t)w * 128 * 9 * 512;
#pragma unroll
        for (int i = 0; i < 64; ++i) { const int p = F.lane * 64 + i, tile = p >> 5, r_ = p & 31; const float c = (v[i] + base) * LOG2E;
            const unsigned short hi = f2bf(c); const float c1 = c - bf2f(hi); const unsigned short mid = f2bf(c1); const unsigned short lo = f2bf(c1 - bf2f(mid));
            u32x4 wv; wv.x = 0x3F803F80u; wv.y = 0x3F80u | ((unsigned)(hi ^ 0x8000u) << 16); wv.z = (unsigned)(mid ^ 0x8000u) | ((unsigned)(lo ^ 0x8000u) << 16); wv.w = 0u;
            bf16* d = KF9 + ((size_t)(tile * 9 + 8) * 64 + r_) * 8;
            *(u32x4*)d = wv; *(u32x4*)(d + 32 * 8) = (u32x4){0u, 0u, 0u, 0u}; }
    }
    const bf16* Kr = (const bf16*)(ar + FA_K); const bf16* Vr = (const bf16*)(ar + FA_V); bf16* KF = (bf16*)(ar + FA_KF); bf16* VF = (bf16*)(ar + FA_VF);
    const int r = F.lane & 31, h = F.lane >> 5;
    for (int u = F.gw; u < BPH * 16 * 128; u += F.NGW) {
        const int bh = u >> 7, tile = u & 127, bl = bh >> 4, hd = bh & 15;
        const bf16* krow_ = Kr + ((size_t)bl * SEQ + tile * 32 + r) * DM + hd * 128 + 8 * h;
        bf16* kd = KF + (((size_t)bh * 128 + tile) * 9 * 64 + F.lane) * 8;
#pragma unroll
        for (int s = 0; s < 8; ++s) *(u32x4*)(kd + s * 512) = *(const u32x4*)(krow_ + 16 * s);
        bf16* vd = VF + (((size_t)bh * 128 + tile) * 8 * 64 + F.lane) * 8;
#pragma unroll
        for (int db = 0; db < 4; ++db)
#pragma unroll
            for (int s = 0; s < 2; ++s) { unsigned short e[8];
#pragma unroll
                for (int j = 0; j < 8; ++j) e[j] = Vr[((size_t)bl * SEQ + tile * 32 + 16 * s + 8 * (j >> 2) + 4 * h + (j & 3)) * DM + hd * 128 + db * 32 + r];
                u32x4 w; w.x = e[0] | ((unsigned)e[1] << 16); w.y = e[2] | ((unsigned)e[3] << 16); w.z = e[4] | ((unsigned)e[5] << 16); w.w = e[6] | ((unsigned)e[7] << 16);
                *(u32x4*)(vd + (db * 2 + s) * 512) = w; }
    }
}
struct FoxMK { int tq, h, qt; DI bool need(int t) const { return t == qt; }
    DI void operator()(int t, f32x16& S) const {
#pragma unroll
        for (int i = 0; i < 16; ++i) S[i] = (32 * t + crow(i, h) <= tq) ? S[i] : -INFINITY;
    } };
DI void ph_fox_attn(const Frame& F) {
    unsigned char* ar = F.ws + WS_AR; const bf16* Q = (const bf16*)(ar + FA_Q); const bf16* KF = (const bf16*)(ar + FA_KF); const bf16* VF = (const bf16*)(ar + FA_VF); const float* CUM = (const float*)(ar + FA_CUM); bf16* Ob = (bf16*)(ar + FA_O);
    const int r = F.lane & 31, h = F.lane >> 5;
    for (int wb = blockIdx.x; wb < BPH * 16 * 4; wb += F.G) {
        const int bh = wb >> 2, x = (wb & 3) * 8 + F.wave, bl = bh >> 4, hd = bh & 15;
#pragma unroll 1
        for (int k = 0; k < 4; ++k) {
            const int qt = (k == 0) ? x : (k == 1) ? 63 - x : (k == 2) ? 64 + x : 127 - x;
            const int qhi = (k == 0) ? (wb & 3) * 8 + 7 : (k == 1) ? 63 - (wb & 3) * 8 : (k == 2) ? 64 + (wb & 3) * 8 + 7 : 127 - (wb & 3) * 8;
            const int tq = qt * 32 + r; const size_t mrow = (size_t)bl * SEQ + tq;
            bf16x8 qf[9];
#pragma unroll
            for (int s = 0; s < 8; ++s) qf[s] = *(const bf16x8*)(Q + mrow * DM + hd * 128 + 16 * s + 8 * h);
            { const float ct = CUM[(size_t)bh * SEQ + tq]; const unsigned short hi = f2bf(ct); const float c1 = ct - bf2f(hi); const unsigned short mid = f2bf(c1); const unsigned short lo = f2bf(c1 - bf2f(mid));
              u32x4 wq; wq.x = (unsigned)hi | ((unsigned)mid << 16); wq.y = (unsigned)lo | (0x3F80u << 16); wq.z = 0x3F803F80u; wq.w = 0u;
              if (h) wq = (u32x4){0u, 0u, 0u, 0u};
              qf[8] = __builtin_bit_cast(bf16x8, wq); }
            f32x16 O[4];
#pragma unroll
            for (int db = 0; db < 4; ++db)
#pragma unroll
                for (int i = 0; i < 16; ++i) O[db][i] = 0.f;
            float m = -INFINITY, l = 0.f;
            const FragSrc src{KF + (size_t)bh * 128 * 9 * 512, VF + (size_t)bh * 128 * 8 * 512, 9}; const FoxMK mk{tq, h, qt};
            attn_run_sh<9, true>(F.lds, F.tid, F.lane, qf, O, m, l, 0, qhi + 1, 0, qt + 1, src, mk);
            l += __shfl_xor(l, 32);
            store_col<false>(Ob + mrow * DM + hd * 128, O, l > 0.f ? 1.0f / l : 0.f, h);
        }
    }
}
typedef long fp8x8_t;
DI fp8x8_t pack_fp8x8(float a0, float a1, float a2, float a3, float a4, float a5, float a6, float a7) {
    int lo = 0, hi = 0;
    lo = __builtin_amdgcn_cvt_pk_fp8_f32(a0, a1, lo, false); lo = __builtin_amdgcn_cvt_pk_fp8_f32(a2, a3, lo, true);
    hi = __builtin_amdgcn_cvt_pk_fp8_f32(a4, a5, hi, false); hi = __builtin_amdgcn_cvt_pk_fp8_f32(a6, a7, hi, true);
    return (fp8x8_t)(((unsigned long long)(unsigned)hi << 32) | (unsigned long long)(unsigned)lo);
}
#define MFMA32F8(a, b, c) __builtin_amdgcn_mfma_f32_32x32x16_fp8_fp8((a), (b), (c), 0, 0, 0)
constexpr size_t NA_Q = 0, NA_KC = 288 * MiB, NA_VC = 313 * MiB, NA_KSR = 330 * MiB, NA_KWR = 354 * MiB, NA_GT = 378 * MiB, NA_VSR = 386 * MiB, NA_VWR = 402 * MiB, NA_GK = 418 * MiB, NA_GV = 420 * MiB,
                 NA_KCMP = 422 * MiB, NA_VCT = 424 * MiB, NA_SELB = 426 * MiB, NA_O = 428 * MiB,
                 NA_KSF = 620 * MiB, NA_KWF = 644 * MiB, NA_VSF = 668 * MiB, NA_VWF = 684 * MiB;
constexpr size_t NW_IN = 0, NW_W1K = (size_t)13312 * 2048, NW_W1V = NW_W1K + (size_t)256 * 6144, NW_W2K = NW_W1V + (size_t)256 * 4096, NW_W2V = NW_W2K + 65536, NW_OUT = NW_W2V + 65536;
constexpr float NSA_QSCALE = 0.07216878364870322f * LOG2E;
DI void ph_nsa_cvt(const Frame& F, const float* w_in, const float* k_pe, const float* k_w1, const float* k_b1, const float* k_w2, const float* v_pe, const float* v_w1, const float* v_b1, const float* v_w2, const float* w_out) {
    bf16* WB = (bf16*)(F.ws + WS_WMIX); float* BIAS = (float*)(F.ws + WS_MISC);
    cvt_job(F, w_in, 13200, DM, 0, 9216, WB + NW_IN, DM, 0, NSA_QSCALE);
    cvt_job(F, w_in, 13200, DM, 9216, 768, WB + NW_IN, DM, 9216, 1.f);
    cvt_job(F, w_in, 13200, DM, 9984, 512, WB + NW_IN, DM, 9984, 1.f);
    cvt_job(F, w_in, 13200, DM, 10496, 768, WB + NW_IN, DM, 10496, 1.f);
    cvt_job(F, w_in, 13200, DM, 11776, 768, WB + NW_IN, DM, 11264, 1.f);
    cvt_job(F, w_in, 13200, DM, 13056, 144, WB + NW_IN, DM, 12032, 1.f);
    zero_bf16(F, WB + NW_IN + (size_t)12176 * DM, (size_t)112 * DM);
    cvt_job(F, w_in, 13200, DM, 11264, 512, WB + NW_IN, DM, 12288, 1.f);
    cvt_job(F, w_in, 13200, DM, 12544, 512, WB + NW_IN, DM, 12800, 1.f);
    cvt_job(F, k_w1, 256, 6144, 0, 256, WB + NW_W1K, 6144, 0, 1.f);
    cvt_job(F, v_w1, 256, 4096, 0, 256, WB + NW_W1V, 4096, 0, 1.f);
    cvt_job(F, k_w2, 192, 256, 0, 192, WB + NW_W2K, 256, 0, 1.f); zero_bf16(F, WB + NW_W2K + 192 * 256, 64 * 256);
    cvt_job(F, v_w2, 128, 256, 0, 128, WB + NW_W2V, 256, 0, 1.f); zero_bf16(F, WB + NW_W2V + 128 * 256, 128 * 256);
    cvt_job(F, w_out, DM, 6144, 0, DM, WB + NW_OUT, 6144, 0, 1.f);
    for (int w = F.gw; w < 512; w += F.NGW) { const bool isk = w < 256; const int c = w & 255, n = isk ? 6144 : 4096; const float* pe = isk ? k_pe : v_pe; const float* w1 = isk ? k_w1 : v_w1;
        float s = 0.f; for (int i = F.lane; i < n; i += 64) s += pe[i] * w1[(size_t)i * 256 + c];
        s = wave_sum(s); if (F.lane == 0) BIAS[w] = s + (isk ? k_b1[c] : v_b1[c]); }
}
DI void ph_nsa_rope(const Frame& F, int half) {
    unsigned char* ar = F.ws + WS_AR; bf16* Q = (bf16*)(ar + NA_Q); bf16* KC = (bf16*)(ar + NA_KC);
    const bf16* KSR = (const bf16*)(ar + NA_KSR); const bf16* KWR = (const bf16*)(ar + NA_KWR); bf16* KSF = (bf16*)(ar + NA_KSF); bf16* KWF = (bf16*)(ar + NA_KWF);
    const float* c48 = (const float*)(F.ws + TAB_COS48); const float* s48 = (const float*)(F.ws + TAB_SIN48);
    for (int ml = F.gw; ml < MC; ml += F.NGW) {
        const size_t mg = (size_t)half * MC + ml; const int bl = ml >> 12, sq = ml & 4095;
        for (int p = F.lane; p < 96; p += 64) {
            const int hd = 48 + p / 24, i = p - (p / 24) * 24; bf16* q;
            q = KC + ((size_t)(bl * 4 + hd - 48) * 4096 + sq) * 192 + i;
            const float x1 = bf2f(q[0]), x2 = bf2f(q[24]), c = c48[mg * 24 + i], s = s48[mg * 24 + i]; q[0] = f2bf(x1 * c - x2 * s); q[24] = f2bf(x1 * s + x2 * c);
        }
        const int tile = sq >> 5, rr = sq & 31;
        for (int u = F.lane; u < 168; u += 64) {
            const int tens = u / 84, uu = u - tens * 84, g = uu / 21, v = uu - g * 21;
            const bf16* src = (tens ? KWR : KSR) + (size_t)ml * 768 + g * 192;
            bf16* dst = (tens ? KWF : KSF) + ((size_t)((bl * 4 + g) * 128 + tile) * 12 * 64 + rr) * 8;
            if (v < 3) {
                const u32x4 a = *(const u32x4*)(src + 8 * v), b = *(const u32x4*)(src + 8 * v + 24); u32x4 o1, o2;
#pragma unroll
                for (int e = 0; e < 4; ++e) { const float c0 = c48[mg * 24 + 8 * v + 2 * e], s0 = s48[mg * 24 + 8 * v + 2 * e], c1 = c48[mg * 24 + 8 * v + 2 * e + 1], s1 = s48[mg * 24 + 8 * v + 2 * e + 1];
                    const float x1l = bflo(a[e]), x1h = bfhi(a[e]), x2l = bflo(b[e]), x2h = bfhi(b[e]);
                    o1[e] = pk2(x1l * c0 - x2l * s0, x1h * c1 - x2h * s1); o2[e] = pk2(x1l * s0 + x2l * c0, x1h * s1 + x2h * c1); }
                const int p1 = v, p2 = v + 3;
                if (tens) { *(u32x4*)(dst + ((p1 >> 1) * 64 + (p1 & 1) * 32) * 8) = o1; *(u32x4*)(dst + ((p2 >> 1) * 64 + (p2 & 1) * 32) * 8) = o2; }
                else { unsigned char* d8 = (unsigned char*)KSF + ((size_t)(((bl * 4 + g) * 128 + tile) * 2 + (rr >> 4)) * 6 * 64 + (rr & 15)) * 8;
                    *(fp8x8_t*)(d8 + ((p1 >> 2) * 64 + (p1 & 3) * 16) * 8) = pack_fp8x8(bflo(o1[0]), bfhi(o1[0]), bflo(o1[1]), bfhi(o1[1]), bflo(o1[2]), bfhi(o1[2]), bflo(o1[3]), bfhi(o1[3]));
                    *(fp8x8_t*)(d8 + ((p2 >> 2) * 64 + (p2 & 3) * 16) * 8) = pack_fp8x8(bflo(o2[0]), bfhi(o2[0]), bflo(o2[1]), bfhi(o2[1]), bflo(o2[2]), bfhi(o2[2]), bflo(o2[3]), bfhi(o2[3])); }
            } else { const int pc = v + 3; const u32x4 c = *(const u32x4*)(src + 8 * pc);
                if (tens) *(u32x4*)(dst + ((pc >> 1) * 64 + (pc & 1) * 32) * 8) = c;
                else { unsigned char* d8 = (unsigned char*)KSF + ((size_t)(((bl * 4 + g) * 128 + tile) * 2 + (rr >> 4)) * 6 * 64 + (rr & 15)) * 8;
                    *(fp8x8_t*)(d8 + ((pc >> 2) * 64 + (pc & 3) * 16) * 8) = pack_fp8x8(bflo(c[0]), bfhi(c[0]), bflo(c[1]), bfhi(c[1]), bflo(c[2]), bfhi(c[2]), bflo(c[3]), bfhi(c[3])); } }
        }
    }
    const bf16* VSR = (const bf16*)(ar + NA_VSR); const bf16* VWR = (const bf16*)(ar + NA_VWR); bf16* VSF = (bf16*)(ar + NA_VSF); bf16* VWF = (bf16*)(ar + NA_VWF);
    const int r = F.lane & 31, h = F.lane >> 5;
    for (int u = F.gw; u < 2 * BPH * 4 * 128; u += F.NGW) {
        const int tens = u >> 11, bg = (u >> 7) & 15, tile = u & 127, bl = bg >> 2, g = bg & 3;
        if (tens) {
            const bf16* src = VWR + ((size_t)bl * SEQ + tile * 32) * 512 + g * 128 + r;
            bf16* vd = VWF + (((size_t)bg * 128 + tile) * 8 * 64 + F.lane) * 8;
#pragma unroll
            for (int db = 0; db < 4; ++db)
#pragma unroll
                for (int s = 0; s < 2; ++s) { unsigned short e[8];
#pragma unroll
                    for (int j = 0; j < 8; ++j) e[j] = src[(size_t)(16 * s + 8 * (j >> 2) + 4 * h + (j & 3)) * 512 + db * 32];
                    u32x4 w; w.x = e[0] | ((unsigned)e[1] << 16); w.y = e[2] | ((unsigned)e[3] << 16); w.z = e[4] | ((unsigned)e[5] << 16); w.w = e[6] | ((unsigned)e[7] << 16);
                    *(u32x4*)(vd + (db * 2 + s) * 512) = w; }
        } else {
            const int d16 = F.lane & 15, kq = F.lane >> 4;
            const bf16* src = VSR + ((size_t)bl * SEQ + tile * 32) * 512 + g * 128 + d16;
            unsigned char* vd = (unsigned char*)VSF + (((size_t)bg * 128 + tile) * 8 * 64 + F.lane) * 8;
#pragma unroll
            for (int db = 0; db < 8; ++db) { float e[8];
#pragma unroll
                for (int j = 0; j < 8; ++j) e[j] = bf2f(src[(size_t)((j < 4 ? 4 * kq + j : 16 + 4 * kq + j - 4)) * 512 + db * 16]);
                *(fp8x8_t*)(vd + db * 512) = pack_fp8x8(e[0], e[1], e[2], e[3], e[4], e[5], e[6], e[7]); }
        }
    }
}
DI void rope_piece(const bf16* qrow, int p, const float* cs, const float* sn, float (&o)[8]) {
    const bool lo = p < 3; const int pp = lo ? p + 3 : p - 3, i0 = 8 * (lo ? p : p - 3);
    const u32x4 a = *(const u32x4*)(qrow + 8 * p), b = *(const u32x4*)(qrow + 8 * pp);
    const f32x4 c0 = *(const f32x4*)(cs + i0), c1 = *(const f32x4*)(cs + i0 + 4), s0 = *(const f32x4*)(sn + i0), s1 = *(const f32x4*)(sn + i0 + 4);
#pragma unroll
    for (int e = 0; e < 4; ++e) { const float c_l = e < 2 ? c0[2 * e] : c1[2 * e - 4], c_h = e < 2 ? c0[2 * e + 1] : c1[2 * e - 3], s_l = e < 2 ? s0[2 * e] : s1[2 * e - 4], s_h = e < 2 ? s0[2 * e + 1] : s1[2 * e - 3];
        const float al = bflo(a[e]), ah = bfhi(a[e]), bl_ = bflo(b[e]), bh_ = bfhi(b[e]);
        o[2 * e] = lo ? al * c_l - bl_ * s_l : bl_ * s_l + al * c_l; o[2 * e + 1] = lo ? ah * c_h - bh_ * s_h : bh_ * s_h + ah * c_h; }
}
DI bf16x8 rope_frag32(const bf16* qrow, int s, int h, const float* cs, const float* sn) {
    float o[8]; rope_piece(qrow, 2 * s + h, cs, sn, o);
    u32x4 w; w.x = pk2(o[0], o[1]); w.y = pk2(o[2], o[3]); w.z = pk2(o[4], o[5]); w.w = pk2(o[6], o[7]); return __builtin_bit_cast(bf16x8, w);
}
DI float sigmoidf_(float x) { return __builtin_amdgcn_rcpf(1.0f + __builtin_amdgcn_exp2f(-x * LOG2E)); }
struct CmpMK { int tq, h, q0; DI bool need(int t) const { return 512 * t + 527 > q0; }
    DI void operator()(int t, f32x16& S) const {
#pragma unroll
    for (int i = 0; i < 16; ++i) { const int n = 32 * t + crow(i, h); S[i] = (16 * n + 31 <= tq) ? S[i] : -INFINITY; } } };
struct WinMK { int tq, h, qt; DI bool need(int t) const { return t == qt || t == qt - 16; }
    DI void operator()(int t, f32x16& S) const {
#pragma unroll
    for (int i = 0; i < 16; ++i) { const int k = 32 * t + crow(i, h); S[i] = (k <= tq && k > tq - 512) ? S[i] : -INFINITY; } } };
DI void ph_nsa_cmp(const Frame& F, const int half) {
    const float* c48 = (const float*)(F.ws + TAB_COS48); const float* s48 = (const float*)(F.ws + TAB_SIN48);
    unsigned char* ar = F.ws + WS_AR; const bf16* Q = (const bf16*)(ar + NA_Q); const bf16* KCMP = (const bf16*)(ar + NA_KCMP); const bf16* VCT = (const bf16*)(ar + NA_VCT); const bf16* GT = (const bf16*)(ar + NA_GT);
    unsigned char* SELB = ar + NA_SELB; bf16* Ob = (bf16*)(ar + NA_O);
    LAS float* imp = (LAS float*)F.lds;
    LAS unsigned char* tl = F.lds + 20480;
    const int lane = F.lane, r = lane & 31, h = lane >> 5, tid = F.tid;
    for (int u = blockIdx.x; u < BPH * 4 * 64; u += F.G) {
        const int bg = u >> 6, qt64 = ((u >> 8) & 1) ? 63 - (u & 63) : (u & 63), bl = bg >> 2, g = bg & 3;
        for (int i = F.tid; i < 64 * 65; i += NWAVES * 64) imp[i] = 0.f;
        __syncthreads();
        const FragSrc src{KCMP + (size_t)bg * 8 * 12 * 512, VCT + (size_t)bg * 8 * 8 * 512, 12};
        const int tqmaxb = qt64 * 64 + 63, TE = (tqmaxb >= 31) ? ((tqmaxb - 31) / 16) / 32 + 1 : 0;
#pragma unroll 1
        for (int k = 0; k < 3; ++k) {
            const int idx = F.wave * 3 + k, j = idx >> 1, sub = idx & 1, ql = sub * 32 + r, tq = qt64 * 64 + ql, hd = g * 12 + j;
            const size_t mrow = (size_t)bl * SEQ + tq;
            bf16x8 qf[12];
#pragma unroll
            for (int s = 3; s < 12; ++s) qf[s] = *(const bf16x8*)(Q + mrow * 9216 + hd * 192 + 16 * s + 8 * h);
            { const float* cs = c48 + ((size_t)half * MC + mrow) * 24; const float* sn = s48 + ((size_t)half * MC + mrow) * 24;
#pragma unroll
              for (int s = 0; s < 3; ++s) qf[s] = rope_frag32(Q + mrow * 9216 + hd * 192, s, h, cs, sn); }
            const int tqmax = qt64 * 64 + sub * 32 + 31, te = (tqmax >= 31) ? ((tqmax - 31) / 16) / 32 + 1 : 0;
            const CmpMK mk{tq, h, qt64 * 64 + sub * 32};
            float m = -INFINITY, l = 0.f;
            { f32x16 Od[4];
              attn_run_sh<12, false>(tl, tid, lane, qf, Od, m, l, 0, TE, 0, te, src, mk); }
            l += __shfl_xor(l, 32);
            const float linv = l > 0.f ? 1.0f / l : 0.f, ms = (m == -INFINITY) ? 0.f : m;
            f32x16 O[4];
#pragma unroll
            for (int db = 0; db < 4; ++db)
#pragma unroll
                for (int i = 0; i < 16; ++i) O[db][i] = 0.f;
            if (TE > 0) {
                TilePre<12> pre;
                tile_fetch<12>(pre, src, 0, tid); tile_put<12>(pre, tl, tid);
                LDS_WAIT(); __builtin_amdgcn_s_barrier(); asm volatile("" ::: "memory");
#pragma unroll 1
                for (int t = 0; t < TE; ++t) {
                    LAS unsigned char* cur = tl + (t & 1) * 20480;
                    if (t + 1 < TE) tile_fetch<12>(pre, src, t + 1, tid);
                    if (t < te) {
                        f32x16 S;
#pragma unroll
                        for (int i = 0; i < 16; ++i) S[i] = 0.f;
#pragma unroll
                        for (int s = 0; s < 12; ++s) S = MFMA32(*(const LAS bf16x8*)(cur + s * 1024 + lane * 16), qf[s], S);
                        if (mk.need(t)) mk(t, S);
#pragma unroll
                        for (int i = 0; i < 16; ++i) S[i] = __builtin_amdgcn_exp2f(S[i] - ms) * linv;
#pragma unroll
                        for (int g4 = 0; g4 < 4; ++g4) { const float gs = (S[4 * g4] + S[4 * g4 + 1]) + (S[4 * g4 + 2] + S[4 * g4 + 3]); const int mb = 8 * t + 2 * g4 + h;
                            __hip_atomic_fetch_add(imp + ql * 65 + mb, gs, __ATOMIC_RELAXED, __HIP_MEMORY_SCOPE_WORKGROUP);
                            if (mb + 1 < 64) __hip_atomic_fetch_add(imp + ql * 65 + mb + 1, S[4 * g4 + 3], __ATOMIC_RELAXED, __HIP_MEMORY_SCOPE_WORKGROUP); }
                        bf16x8 pf[2];
#pragma unroll
                        for (int s = 0; s < 2; ++s) { u32x4 w; w.x = pk2(S[8 * s], S[8 * s + 1]); w.y = pk2(S[8 * s + 2], S[8 * s + 3]); w.z = pk2(S[8 * s + 4], S[8 * s + 5]); w.w = pk2(S[8 * s + 6], S[8 * s + 7]); pf[s] = __builtin_bit_cast(bf16x8, w); }
#pragma unroll
                        for (int db = 0; db < 4; ++db)
#pragma unroll
                            for (int s = 0; s < 2; ++s) O[db] = MFMA32(*(const LAS bf16x8*)(cur + (12 + db * 2 + s) * 1024 + lane * 16), pf[s], O[db]);
                    }
                    if (t + 1 < TE) tile_put<12>(pre, tl + ((t + 1) & 1) * 20480, tid);
                    LDS_WAIT(); __builtin_amdgcn_s_barrier(); asm volatile("" ::: "memory");
                }
            }
            const float gate = sigmoidf_(bf2f(GT[mrow * 256 + hd]));
            store_col<false>(Ob + mrow * 6144 + hd * 128, O, gate, h);
        }
        __syncthreads();
#pragma unroll 1
        for (int k = 0; k < 8; ++k) {
            const int ql = F.wave * 8 + k, tq = qt64 * 64 + ql, cur = tq >> 6, mb = lane;
            const bool causal = mb <= cur, forced = (mb == 0) || (mb == cur) || (mb == cur - 1);
            const float v = causal ? (forced ? INFINITY : imp[ql * 65 + mb]) : -INFINITY;
            int rank = 0;
            for (int o = 0; o < 64; ++o) { const float vo = __shfl(v, o); rank += (vo > v || (vo == v && o < mb)) ? 1 : 0; }
            if (rank < 16) SELB[((size_t)bg * 4096 + tq) * 16 + rank] = causal ? (unsigned char)mb : (unsigned char)0xFF;
        }
        __syncthreads();
    }
}
DI int sel_tile(const u32x4& sel, int t) { const int b = t >> 1; const unsigned w = (b < 4) ? sel.x : (b < 8) ? sel.y : (b < 12) ? sel.z : sel.w; return (int)((w >> ((b & 3) * 8)) & 0xFFu) * 2 + (t & 1); }
struct SelMK { u32x4 sel; int tq, h; DI void operator()(int t, f32x16& S) const { const int k0 = sel_tile(sel, t) * 32;
#pragma unroll
    for (int i = 0; i < 16; ++i) S[i] = (k0 + crow(i, h) <= tq) ? S[i] : -INFINITY; } };
typedef float f32x4_ __attribute__((ext_vector_type(4)));
#define MFMA16F8(a, b, c) __builtin_amdgcn_mfma_f32_16x16x32_fp8_fp8((a), (b), (c), 0, 0, 0)
DI void ph_nsa_sel(const Frame& F, const int half) {
    const float* c48 = (const float*)(F.ws + TAB_COS48); const float* s48 = (const float*)(F.ws + TAB_SIN48);
    unsigned char* ar = F.ws + WS_AR; const bf16* Q = (const bf16*)(ar + NA_Q); const unsigned char* KS8 = ar + NA_KSF; const unsigned char* VS8 = ar + NA_VSF; const bf16* GT = (const bf16*)(ar + NA_GT);
    const unsigned char* SELB = ar + NA_SELB; bf16* Ob = (bf16*)(ar + NA_O);
    const int c16 = F.lane & 15, kq = F.lane >> 4; const bool act = c16 < 12;
    for (int it = F.gw; it < BPH * 4 * SEQ; it += F.NGW) {
        const int bg = it >> 12, tq = ((it & 4095) + 256 * bg) & 4095, bl = bg >> 2, g = bg & 3; const size_t mrow = (size_t)bl * SEQ + tq; const int hd = g * 12 + (act ? c16 : 0);
        fp8x8_t qf[6];
#pragma unroll
        for (int s = 0; s < 6; ++s) { const float qs = act ? (1.0f / NSA_QSCALE) : 0.f; const int p = 4 * s + kq;
            if (s < 2 && p < 6) { float o[8]; rope_piece(Q + mrow * 9216 + hd * 192, p, c48 + ((size_t)half * MC + mrow) * 24, s48 + ((size_t)half * MC + mrow) * 24, o);
                qf[s] = pack_fp8x8(o[0] * qs, o[1] * qs, o[2] * qs, o[3] * qs, o[4] * qs, o[5] * qs, o[6] * qs, o[7] * qs); }
            else { const u32x4 q = *(const u32x4*)(Q + mrow * 9216 + hd * 192 + 32 * s + 8 * kq);
                qf[s] = pack_fp8x8(bflo(q[0]) * qs, bfhi(q[0]) * qs, bflo(q[1]) * qs, bfhi(q[1]) * qs, bflo(q[2]) * qs, bfhi(q[2]) * qs, bflo(q[3]) * qs, bfhi(q[3]) * qs); } }
        const u32x4 sel = *(const u32x4*)(SELB + ((size_t)bg * 4096 + tq) * 16);
        const int nv = ((tq >> 6) + 1 < 16) ? (tq >> 6) + 1 : 16, te = 2 * nv;
        const unsigned char* kb = KS8 + ((size_t)bg * 128 * 12 * 64 + F.lane) * 8; const unsigned char* vb = VS8 + ((size_t)bg * 128 * 8 * 64 + F.lane) * 8;
        f32x4_ O[8];
#pragma unroll
        for (int db = 0; db < 8; ++db) O[db] = (f32x4_){0.f, 0.f, 0.f, 0.f};
        float m = -INFINITY, l = 0.f;
        fp8x8_t kfA[12], kfB[12], vfA[8], vfB[8];
        { const unsigned char* kp = kb + (size_t)sel_tile(sel, 0) * 12 * 512; const unsigned char* kp1 = kb + (size_t)sel_tile(sel, 1) * 12 * 512; const unsigned char* vp = vb + (size_t)sel_tile(sel, 0) * 8 * 512;
#pragma unroll
          for (int s = 0; s < 12; ++s) { kfA[s] = *(const fp8x8_t*)(kp + s * 512); kfB[s] = *(const fp8x8_t*)(kp1 + s * 512); }
#pragma unroll
          for (int j = 0; j < 8; ++j) vfA[j] = *(const fp8x8_t*)(vp + j * 512); }
#define SEL_STEP(T_, KF_, VF_, VFN_) do { const int t_ = (T_); const int tile = sel_tile(sel, t_); \
            if (t_ + 1 < te) { const unsigned char* vp = vb + (size_t)sel_tile(sel, t_ + 1) * 8 * 512; _Pragma("unroll") for (int j = 0; j < 8; ++j) VFN_[j] = *(const fp8x8_t*)(vp + j * 512); } \
            f32x4_ S0 = {0.f, 0.f, 0.f, 0.f}, S1 = S0; \
            _Pragma("unroll") for (int s = 0; s < 6; ++s) { S0 = MFMA16F8(KF_[s], qf[s], S0); S1 = MFMA16F8(KF_[6 + s], qf[s], S1); } \
            if (t_ + 2 < te) { const unsigned char* kp = kb + (size_t)sel_tile(sel, t_ + 2) * 12 * 512; _Pragma("unroll") for (int s = 0; s < 12; ++s) KF_[s] = *(const fp8x8_t*)(kp + s * 512); } \
            const int k0 = tile * 32 + 4 * kq; float mx = -INFINITY; \
            _Pragma("unroll") for (int i = 0; i < 4; ++i) { S0[i] = (k0 + i <= tq) ? S0[i] * NSA_QSCALE : -INFINITY; S1[i] = (k0 + 16 + i <= tq) ? S1[i] * NSA_QSCALE : -INFINITY; mx = fmaxf(mx, fmaxf(S0[i], S1[i])); } \
            mx = fmaxf(mx, __shfl_xor(mx, 16)); mx = fmaxf(mx, __shfl_xor(mx, 32)); \
            const float mn = fmaxf(m, mx), ms = (mn == -INFINITY) ? 0.f : mn, alpha = __builtin_amdgcn_exp2f(m - ms); \
            float sum = 0.f; \
            _Pragma("unroll") for (int i = 0; i < 4; ++i) { S0[i] = __builtin_amdgcn_exp2f(S0[i] - ms); S1[i] = __builtin_amdgcn_exp2f(S1[i] - ms); sum += S0[i] + S1[i]; } \
            l = l * alpha + sum; m = mn; \
            if (__builtin_amdgcn_ballot_w64(alpha != 1.0f) != 0ull) { _Pragma("unroll") for (int db = 0; db < 8; ++db) O[db] = O[db] * alpha; } \
            const fp8x8_t p8 = pack_fp8x8(S0[0], S0[1], S0[2], S0[3], S1[0], S1[1], S1[2], S1[3]);       \
            _Pragma("unroll") for (int db = 0; db < 8; ++db) O[db] = MFMA16F8(VF_[db], p8, O[db]); } while (0)
#pragma unroll 1
        for (int t = 0; t < te; t += 2) { SEL_STEP(t, kfA, vfA, vfB); SEL_STEP(t + 1, kfB, vfB, vfA); }
#undef SEL_STEP
        l += __shfl_xor(l, 16); l += __shfl_xor(l, 32);
        if (act) { const float gate = sigmoidf_(bf2f(GT[mrow * 256 + 48 + hd])); const float sc = l > 0.f ? gate / l : 0.f;
            bf16* o = Ob + mrow * 6144 + hd * 128 + 4 * kq;
#pragma unroll
            for (int db = 0; db < 8; ++db) { u32x2* p = (u32x2*)(o + db * 16); const u32x2 prev = *p;
                u32x2 w; w.x = pk2(O[db][0] * sc + bflo(prev.x), O[db][1] * sc + bfhi(prev.x)); w.y = pk2(O[db][2] * sc + bflo(prev.y), O[db][3] * sc + bfhi(prev.y)); *p = w; } }
    }
}
DI void ph_nsa_win(const Frame& F, const int half) {
    const float* c48 = (const float*)(F.ws + TAB_COS48); const float* s48 = (const float*)(F.ws + TAB_SIN48);
    unsigned char* ar = F.ws + WS_AR; const bf16* Q = (const bf16*)(ar + NA_Q); const bf16* KWF = (const bf16*)(ar + NA_KWF); const bf16* VWF = (const bf16*)(ar + NA_VWF); const bf16* GT = (const bf16*)(ar + NA_GT); bf16* Ob = (bf16*)(ar + NA_O);
    const int r = F.lane & 31, h = F.lane >> 5;
    for (int idb = blockIdx.x; idb < BPH * 48 * 16; idb += F.G) {
        const int qt0 = (((idb & 15) + (idb >> 8)) & 15) * 8, qt = qt0 + F.wave, bh = idb >> 4, hd = bh % 48, bl = bh / 48, g = hd / 12, bg = bl * 4 + g, tq = qt * 32 + r; const size_t mrow = (size_t)bl * SEQ + tq;
        bf16x8 qf[12];
#pragma unroll
        for (int s = 3; s < 12; ++s) qf[s] = *(const bf16x8*)(Q + mrow * 9216 + hd * 192 + 16 * s + 8 * h);
        { const float* cs = c48 + ((size_t)half * MC + mrow) * 24; const float* sn = s48 + ((size_t)half * MC + mrow) * 24;
#pragma unroll
          for (int s = 0; s < 3; ++s) qf[s] = rope_frag32(Q + mrow * 9216 + hd * 192, s, h, cs, sn); }
        const FragSrc src{KWF + (size_t)bg * 128 * 12 * 512, VWF + (size_t)bg * 128 * 8 * 512, 12}; const WinMK mk{tq, h, qt};
        f32x16 O[4];
#pragma unroll
        for (int db = 0; db < 4; ++db)
#pragma unroll
            for (int i = 0; i < 16; ++i) O[db][i] = 0.f;
        float m = -INFINITY, l = 0.f;
        attn_run_sh<12, true>(F.lds, F.tid, F.lane, qf, O, m, l, qt0 >= 16 ? qt0 - 16 : 0, qt0 + 8, qt >= 16 ? qt - 16 : 0, qt + 1, src, mk);
        l += __shfl_xor(l, 32);
        const float gate = sigmoidf_(bf2f(GT[mrow * 256 + 96 + hd]));
        store_col<true>(Ob + mrow * 6144 + hd * 128, O, l > 0.f ? gate / l : 0.f, h);
    }
}
#ifndef MK_ONE_LAUNCH
#define MK_ONE_LAUNCH 1
#endif
constexpr int NPH = 74;
struct Args { const float* in[58]; float* out; unsigned char* ws; int ph_lo, ph_hi; };
#define GEMM_AKOFF 0
#define GEMM_CALL(EpiT, Evar, Aptr, Bptr, Mv, Nv, Kv, ldav, ldbv, cidx) do { const pg8::Gemm g_{(const pg8::bf16_t*)(Aptr), (const pg8::bf16_t*)(Bptr), (Mv), (Nv), (Kv), (ldav), (ldbv), GEMM_AKOFF}; \
    pg8::StaticOrder S_; S_.init((Mv), (Nv), F.G, (cidx)); pg8::gemm_phase<EpiT, pg8::StaticOrder, true, true>((PG8_LAS unsigned char*)F.lds, g_, S_, Evar); } while (0)
DI pg8::EpiBf16R epi1(bf16* base, int ldc) { pg8::EpiBf16R e; for (int s = 0; s < 8; ++s) { e.T.base[s] = base; e.T.ldc[s] = ldc; e.T.t0[s] = 0; e.T.gw[s] = 0; } e.T.nseg = 1; e.T.pad_ = 0; e.ssp = nullptr; e.ss_off = 0; return e; }
#define PH_BEGIN if (ph >= lo && ph < hi) { Frame F; { unsigned long long w_ = (unsigned long long)args.ws; asm volatile("" : "+s"(w_)); F.ws = (unsigned char*)w_; F.ctl = (unsigned*)(F.ws + WS_CTL); } \
    F.lds = lds; F.tid = threadIdx.x; F.lane = F.tid & 63; F.wave = __builtin_amdgcn_readfirstlane(F.tid >> 6); F.G = gridDim.x; F.gw = blockIdx.x * NWAVES + F.wave; F.NGW = F.G * NWAVES; \
    float* out; { unsigned long long o_ = (unsigned long long)args.out; asm volatile("" : "+s"(o_)); out = (float*)o_; } \
    unsigned char* const ar = F.ws + WS_AR; bf16* const XN = (bf16*)(F.ws + WS_XNR); float* const SSB = (float*)(F.ws + WS_SS); bf16* const WB = (bf16*)(F.ws + WS_WMIX); bf16* const WUP = (bf16*)(F.ws + WS_WFFN); bf16* const WDN = WUP + (size_t)2 * DFF * DM; \
    const float* const res_mix = (ib == 2) ? args.in[0] : (const float*)out; (void)ar; (void)XN; (void)SSB; (void)WB; (void)WUP; (void)WDN; (void)res_mix; (void)iff;
#define PH_END   if (ph + 1 < hi) { XcdBarrier b_; b_.bar = (unsigned*)F.ctl + CW_BAR; b_.x = xb_xcc_id(); b_.st = MISC + 8; xcd_barrier(b_); } } ++ph;
template <int LAYER> DI void run_cvt(const Args& args, LAS unsigned char* lds, volatile LAS unsigned* MISC, int& ph, const int lo, const int hi) {
    constexpr int ib = (LAYER == 0) ? 2 : (LAYER == 1) ? 17 : (LAYER == 2) ? 26 : 42;
    constexpr int iff = (LAYER == 0) ? 12 : (LAYER == 1) ? 21 : (LAYER == 2) ? 37 : 52;
    constexpr int kind = (LAYER == 1) ? 1 : (LAYER == 2) ? 2 : 0;
        PH_BEGIN
            if constexpr (kind == 0) ph_dsa_cvt(F, args.in[ib + 1], args.in[ib + 6], args.in[ib + 7], args.in[ib + 8], args.in[ib + 9]);
            else if constexpr (kind == 1) ph_fox_cvt(F, args.in[ib + 1], args.in[ib + 3]);
            else ph_nsa_cvt(F, args.in[ib + 1], args.in[ib + 2], args.in[ib + 3], args.in[ib + 4], args.in[ib + 5], args.in[ib + 6], args.in[ib + 7], args.in[ib + 8], args.in[ib + 9], args.in[ib + 10]);
            ph_cvt_ffn(F, args.in[iff + 1], args.in[iff + 4]);
        PH_END
}
template <int LAYER, int HALF> DI void run_half(const Args& args, LAS unsigned char* lds, volatile LAS unsigned* MISC, int& ph, const int lo, const int hi) {
    constexpr int ib = (LAYER == 0) ? 2 : (LAYER == 1) ? 17 : (LAYER == 2) ? 26 : 42;
    constexpr int iff = (LAYER == 0) ? 12 : (LAYER == 1) ? 21 : (LAYER == 2) ? 37 : 52;
    constexpr int kind = (LAYER == 1) ? 1 : (LAYER == 2) ? 2 : 0;
    constexpr int half = HALF;
            const int roff = half * MC;
            if constexpr (kind == 0) {
                PH_BEGIN { pg8::EpiF32 E{(float*)(ar + DA_DIN), 1024, SSB + (size_t)(LAYER * 2) * MTOT * 8, roff}; GEMM_CALL(pg8::EpiF32, E, XN + (size_t)roff * DM, WB + DW_W1, MC, 1024, DM, DM, DM, (int)blockIdx.x); } PH_END
                PH_BEGIN ph_dsa_post1(F, half, args.in[ib + 2], args.in[ib + 3], args.in[ib + 4], args.in[ib + 5]); PH_END
                PH_BEGIN { pg8::EpiBf16R E = epi1((bf16*)(ar + DA_QL), 8192); E.T.base[1] = (bf16*)(ar + DA_QPE); E.T.ldc[1] = 1536; E.T.t0[1] = 32; E.T.base[2] = (bf16*)(ar + DA_QIDX); E.T.ldc[2] = 2048; E.T.t0[2] = 38; E.T.nseg = 3;
                    GEMM_CALL(pg8::EpiBf16R, E, ar + DA_CQN, WB + DW_W2, MC, 11776, 512, 512, 512, (int)blockIdx.x); } PH_END
                PH_BEGIN ph_dsa_rope(F, half); PH_END
                PH_BEGIN ph_dsa_index(F); PH_END
                PH_BEGIN ph_dsa_attn(F); PH_END
                PH_BEGIN {
                    pg8::EpiBf16R E = epi1((bf16*)(ar + DA_O2), 4096);
                    { const pg8::Gemm g_{(const pg8::bf16_t*)(ar + DA_QL), (const pg8::bf16_t*)(WB + DW_BD), MC, 4096, 512, 8192, 512, 512}; pg8::StaticOrder S_; S_.init(MC, 4096, F.G, (int)blockIdx.x);
                      pg8::gemm_phase<pg8::EpiBf16R, pg8::StaticOrder, true, true>((PG8_LAS unsigned char*)F.lds, g_, S_, E); } } PH_END
                PH_BEGIN { pg8::EpiResN E{LAYER == 0 ? args.in[0] : nullptr, args.in[ib], nullptr, DM, roff, args.in[iff], (pg8::bf16_t*)XN, SSB + (size_t)(LAYER * 2 + 1) * MTOT * 8, (PG8_LAS float*)(F.lds + LDSCTL_OFF + 256)}; GEMM_CALL(pg8::EpiResN, E, ar + DA_O2, WB + DW_WO, MC, DM, 4096, 4096, 4096, (int)blockIdx.x); } PH_END
            } else if constexpr (kind == 1) {
                PH_BEGIN { pg8::EpiBf16R E = epi1((bf16*)(ar + FA_Q), DM); E.T.base[1] = (bf16*)(ar + FA_K); E.T.ldc[1] = DM; E.T.t0[1] = 8; E.T.base[2] = (bf16*)(ar + FA_V); E.T.ldc[2] = DM; E.T.t0[2] = 16;
                    E.T.base[3] = (bf16*)(ar + FA_F); E.T.ldc[3] = 256; E.T.t0[3] = 24; E.T.nseg = 4; E.ssp = SSB + (size_t)(LAYER * 2) * MTOT * 8; E.ss_off = roff;
                    GEMM_CALL(pg8::EpiBf16R, E, XN + (size_t)roff * DM, WB + FW_IN, MC, 6400, DM, DM, DM, (int)blockIdx.x); } PH_END
                PH_BEGIN ph_fox_scan(F, args.in[ib + 2]); PH_END
                PH_BEGIN ph_fox_attn(F); PH_END
                PH_BEGIN { pg8::EpiResN E{LAYER == 0 ? args.in[0] : nullptr, args.in[ib], nullptr, DM, roff, args.in[iff], (pg8::bf16_t*)XN, SSB + (size_t)(LAYER * 2 + 1) * MTOT * 8, (PG8_LAS float*)(F.lds + LDSCTL_OFF + 256)}; GEMM_CALL(pg8::EpiResN, E, ar + FA_O, WB + FW_OUT, MC, DM, DM, DM, DM, (int)blockIdx.x); } PH_END
            } else {
                PH_BEGIN { pg8::EpiBf16R E = epi1((bf16*)(ar + NA_Q), 9216);
                    E.T.base[1] = (bf16*)(ar + NA_KC); E.T.ldc[1] = 192; E.T.t0[1] = 36; E.T.gw[1] = 192;
                    E.T.base[2] = (bf16*)(ar + NA_VC); E.T.ldc[2] = 128; E.T.t0[2] = 39; E.T.gw[2] = 128;
                    E.T.base[3] = (bf16*)(ar + NA_KSR); E.T.ldc[3] = 768; E.T.t0[3] = 41;
                    E.T.base[4] = (bf16*)(ar + NA_KWR); E.T.ldc[4] = 768; E.T.t0[4] = 44;
                    E.T.base[5] = (bf16*)(ar + NA_GT); E.T.ldc[5] = 256; E.T.t0[5] = 47;
                    E.T.base[6] = (bf16*)(ar + NA_VSR); E.T.ldc[6] = 512; E.T.t0[6] = 48;
                    E.T.base[7] = (bf16*)(ar + NA_VWR); E.T.ldc[7] = 512; E.T.t0[7] = 50; E.T.nseg = 8; E.ssp = SSB + (size_t)(LAYER * 2) * MTOT * 8; E.ss_off = roff;
                    GEMM_CALL(pg8::EpiBf16R, E, XN + (size_t)roff * DM, WB + NW_IN, MC, 13312, DM, DM, DM, (int)blockIdx.x); } PH_END
                PH_BEGIN ph_nsa_rope(F, half); PH_END
                PH_BEGIN {
                    const float* BIAS = (const float*)(args.ws + WS_MISC);
                    { pg8::EpiGelu E{(bf16*)(ar + NA_GK), 256, BIAS}; GEMM_CALL(pg8::EpiGelu, E, ar + NA_KC, WB + NW_W1K, 4096, 256, 6144, 3072, 6144, (int)blockIdx.x); }
                    { pg8::EpiGelu E{(bf16*)(ar + NA_GV), 256, BIAS + 256}; GEMM_CALL(pg8::EpiGelu, E, ar + NA_VC, WB + NW_W1V, 4096, 256, 4096, 2048, 4096, (int)((blockIdx.x + F.G - 16) % F.G)); }
                } PH_END
                PH_BEGIN {
                    { pg8::EpiBf16R E = epi1((bf16*)(ar + NA_KCMP), 12); E.T.gw[0] = -1; GEMM_CALL(pg8::EpiBf16R, E, ar + NA_GK, WB + NW_W2K, 4096, 256, 256, 256, 256, (int)blockIdx.x); }
                    { pg8::EpiBf16R E = epi1((bf16*)(ar + NA_VCT), 4); E.T.gw[0] = -2; GEMM_CALL(pg8::EpiBf16R, E, WB + NW_W2V, ar + NA_GV, 256, 4096, 256, 256, 256, (int)((blockIdx.x + F.G - 16) % F.G)); }
                } PH_END
                PH_BEGIN ph_nsa_cmp(F, half); PH_END
                PH_BEGIN ph_nsa_sel(F, half); PH_END
                PH_BEGIN ph_nsa_win(F, half); PH_END
                PH_BEGIN { pg8::EpiResN E{LAYER == 0 ? args.in[0] : nullptr, args.in[ib], nullptr, DM, roff, args.in[iff], (pg8::bf16_t*)XN, SSB + (size_t)(LAYER * 2 + 1) * MTOT * 8, (PG8_LAS float*)(F.lds + LDSCTL_OFF + 256)}; GEMM_CALL(pg8::EpiResN, E, ar + NA_O, WB + NW_OUT, MC, DM, 6144, 6144, 6144, (int)blockIdx.x); } PH_END
            }
}
template <int LAYER> DI void run_ffn(const Args& args, LAS unsigned char* lds, volatile LAS unsigned* MISC, int& ph, const int lo, const int hi) {
    constexpr int ib = (LAYER == 0) ? 2 : (LAYER == 1) ? 17 : (LAYER == 2) ? 26 : 42;
    constexpr int iff = (LAYER == 0) ? 12 : (LAYER == 1) ? 21 : (LAYER == 2) ? 37 : 52;
    PH_BEGIN {
        LAS float* rt = (LAS float*)(F.lds + LDSCTL_OFF + 256 + 8192); const int rbase = 4096 * (int)(blockIdx.x & 7); const float* ssq = SSB + (size_t)(LAYER * 2 + 1) * MTOT * 8;
        for (int i = F.tid; i < 4096; i += NWAVES * 64) rt[i] = pg8::rms_rowscale(ssq, rbase + i);
        __syncthreads();
        pg8::EpiConvGlu E{(pg8::bf16_t*)ar, (float*)(ar + 352 * MiB), args.in[iff + 2], args.in[iff + 3], (PG8_LAS float*)(F.lds + LDSCTL_OFF + 256), DFF, (const PG8_LAS float*)rt, rbase};
        GEMM_CALL(pg8::EpiConvGlu, E, XN, WUP, MTOT, 2 * DFF, DM, DM, DM, (int)blockIdx.x); } PH_END
    PH_BEGIN ph_conv_fix(F, (const float*)(ar + 352 * MiB), (bf16*)ar, args.in[iff + 2], args.in[iff + 3], MTOT); PH_END
    PH_BEGIN {
        if constexpr (LAYER < 3) { constexpr int ibn = (LAYER == 0) ? 17 : (LAYER == 1) ? 26 : 42;
            pg8::EpiResN E{nullptr, args.in[iff], nullptr, DM, 0, args.in[ibn], (pg8::bf16_t*)XN, SSB + (size_t)((LAYER + 1) * 2) * MTOT * 8, (PG8_LAS float*)(F.lds + LDSCTL_OFF + 256)}; GEMM_CALL(pg8::EpiResN, E, ar, WDN, MTOT, DM, DFF, DFF, DFF, (int)blockIdx.x); }
        else { pg8::EpiResN E{nullptr, args.in[iff], out, DM, 0, nullptr, (pg8::bf16_t*)XN, nullptr, (PG8_LAS float*)(F.lds + LDSCTL_OFF + 256)}; GEMM_CALL(pg8::EpiResN, E, ar, WDN, MTOT, DM, DFF, DFF, DFF, (int)blockIdx.x); }
    } PH_END
}
__global__ void __launch_bounds__(NWAVES * 64, 2) mk_fwd(Args args) {
    extern __shared__ __attribute__((aligned(16))) unsigned char lds_[];
    LAS unsigned char* const lds = (LAS unsigned char*)lds_;
    volatile LAS unsigned* MISC = (volatile LAS unsigned*)(lds + LDSCTL_OFF);
    for (int u = threadIdx.x; u < 64; u += NWAVES * 64) ((LAS unsigned*)(lds + LDSCTL_OFF))[u] = 0u;
    __syncthreads();
    const int lo = args.ph_lo, hi = args.ph_hi;
    (void)xcd_barrier_post((unsigned*)(args.ws + WS_CTL) + CW_BAR, MISC + 8);
    int ph = 0;
    { constexpr int ib = 2, iff = 12; PH_BEGIN ph_tables(F, (const int*)args.in[1]); ph_norm_first(F, args.in[0], args.in[2], XN, SSB); PH_END }
    run_cvt<0>(args, lds, MISC, ph, lo, hi); run_half<0, 0>(args, lds, MISC, ph, lo, hi); run_half<0, 1>(args, lds, MISC, ph, lo, hi); run_ffn<0>(args, lds, MISC, ph, lo, hi);
    run_cvt<1>(args, lds, MISC, ph, lo, hi); run_half<1, 0>(args, lds, MISC, ph, lo, hi); run_half<1, 1>(args, lds, MISC, ph, lo, hi); run_ffn<1>(args, lds, MISC, ph, lo, hi);
    run_cvt<2>(args, lds, MISC, ph, lo, hi); run_half<2, 0>(args, lds, MISC, ph, lo, hi); run_half<2, 1>(args, lds, MISC, ph, lo, hi); run_ffn<2>(args, lds, MISC, ph, lo, hi);
    run_cvt<3>(args, lds, MISC, ph, lo, hi); run_half<3, 0>(args, lds, MISC, ph, lo, hi); run_half<3, 1>(args, lds, MISC, ph, lo, hi); run_ffn<3>(args, lds, MISC, ph, lo, hi);
    { constexpr int ib = 42, iff = 52; PH_BEGIN ph_final_norm(F, out, args.in[57]); PH_END }
}
extern "C" void kernel_launch(void* const* d_in, const int* in_sizes, int n_in, void* d_out, int out_size, void* d_ws, size_t ws_size, hipStream_t stream) {
    static int grid = 0;
    if (grid == 0) {
        if (n_in != 58 || out_size != MTOT * DM || ws_size < WS_END) { fprintf(stderr, "kernel_launch: unexpected shapes (n_in %d, out %d, ws %zu)\n", n_in, out_size, ws_size); grid = -1; return; }
        int dev = 0, cus = 0;
        if (hipGetDevice(&dev) != hipSuccess || hipDeviceGetAttribute(&cus, hipDeviceAttributeMultiprocessorCount, dev) != hipSuccess) { grid = -1; return; }
        if (hipFuncSetAttribute((const void*)mk_fwd, hipFuncAttributeMaxDynamicSharedMemorySize, LDS_BYTES) != hipSuccess) { fprintf(stderr, "kernel_launch: hipFuncSetAttribute failed\n"); grid = -1; return; }
        int per_cu = 0;
        (void)hipOccupancyMaxActiveBlocksPerMultiprocessor(&per_cu, (const void*)mk_fwd, NWAVES * 64, LDS_BYTES);
        (void)hipGetLastError();
        grid = cus;
    }
    if (grid < 0) return;
    if (hipMemsetAsync((char*)d_ws + WS_CTL, 0, CTL_ZERO_BYTES, stream) != hipSuccess) return;
    Args a{};
    for (int i = 0; i < 58; ++i) a.in[i] = (const float*)d_in[i];
    a.out = (float*)d_out; a.ws = (unsigned char*)d_ws;
#if MK_ONE_LAUNCH
    a.ph_lo = 0; a.ph_hi = NPH;
    hipLaunchKernelGGL(mk_fwd, dim3(grid), dim3(NWAVES * 64), LDS_BYTES, stream, a);
#else
    for (int p = 0; p < NPH; ++p) { a.ph_lo = p; a.ph_hi = p + 1; hipLaunchKernelGGL(mk_fwd, dim3(grid), dim3(NWAVES * 64), LDS_BYTES, stream, a); }
#endif
}
```

```cpp
#include <hip/hip_runtime.h>
#include <cstdio>
#include <cstdint>
#define DI __device__ __forceinline__
namespace pg8 {
#define PG8_LAS __attribute__((address_space(3)))
typedef unsigned short bf16_t;
typedef short bf16x8 __attribute__((ext_vector_type(8)));
typedef float f32x4 __attribute__((ext_vector_type(4)));
typedef unsigned u32x4 __attribute__((ext_vector_type(4)));
constexpr int BM = 256, BK = 64, HALF = 128, HTB = HALF * BK * 2  , STAGE_BYTES = 8 * HTB, NXCD = 8, WGM = 8;

__host__ __device__ __forceinline__ int lds_byte(int r, int c) { const int st = (r >> 4) * 2 + (c >> 5), rr = r & 15, cc = c & 31, ob = rr * 64 + cc * 2; return st * 1024 + (ob ^ (((ob >> 9) & 1) << 5)); }
__host__ __device__ __forceinline__ void stage_rc(int b, int& R, int& C) { const int st = b / 1024, sb = b % 1024, swz = sb ^ (((sb >> 9) & 1) << 5); R = (st >> 1) * 16 + swz / 64; C = (st & 1) * 32 + (swz % 64) / 2; }
__host__ __device__ __forceinline__ int perm32(int rho) { const int n = rho >> 4, i = rho & 15; return 8 * (i >> 2) + 4 * n + (i & 3); }

struct Unit { int pm, pn; };
struct Gemm { const bf16_t* A; const bf16_t* Bt; int M, N, K, lda, ldb, akoff; };

struct StaticOrder {
    int nM, nN, nwg, G, c;
    __host__ __device__ void init(int M, int N, int G_, int c_) { nM = M / BM; nN = N / BM; nwg = nM * nN; G = G_; c = c_; }
    __host__ __device__ bool next(int i, Unit& u) const {
        const long L = (long)i * G + c; if (L >= nwg) return false;
        int wgid = (int)L; { const int q = nwg / NXCD, r = nwg % NXCD, xcd = wgid % NXCD, off = wgid / NXCD; wgid = (xcd < r ? xcd * (q + 1) : r * (q + 1) + (xcd - r) * q) + off; }
        const int nig = WGM * nN, gid = wgid / nig, fm = gid * WGM, gsz = (nM - fm) < WGM ? (nM - fm) : WGM;
        u.pm = fm + ((wgid % nig) % gsz); u.pn = (wgid % nig) / gsz; return true;
    }
    __device__ __forceinline__ void a_ready(const Unit&) const {}
    __device__ __forceinline__ void done(const Unit&) const {}
};
__device__ __forceinline__ unsigned cvt_pk_bf16(float lo, float hi) { unsigned r; asm volatile("v_cvt_pk_bf16_f32 %0, %1, %2" : "=v"(r) : "v"(lo), "v"(hi)); return r; }
template <class Epi, class Sched, bool ALIGN_EPI = false, bool SP2 = false>
__device__ __forceinline__ void gemm_phase(PG8_LAS unsigned char* lds, const Gemm g, const Sched& S, const Epi& E) {
    const int tid = threadIdx.x, wid = __builtin_amdgcn_readfirstlane(tid >> 6), lane = tid & 63, wr = wid >> 2, wc = wid & 3, fr = lane & 15, fq = lane >> 4;
    const int K = g.K, nt = K / BK;
    unsigned voffA[2], voffB[2];
#pragma unroll
    for (int i = 0; i < 2; ++i) { int R, C; stage_rc(tid * 16 + i * 8192, R, C); const int Rb = Epi::PERM ? ((R & ~31) + perm32(R & 31)) : R;
        voffA[i] = (unsigned)(R * g.lda + C) * 2u; voffB[i] = (unsigned)(Rb * g.ldb + C) * 2u; }
    const size_t kstep = (size_t)(BK * 2);
    const size_t hstepA = (size_t)HALF * g.lda * 2, hstepB = (size_t)HALF * g.ldb * 2;
    const size_t tstepA = 2 * hstepA, tstepB = 2 * hstepB;
    const unsigned ldsw = (unsigned)wid * 1024u;
    const int aoff = lds_byte(wr * 64 + fr, fq * 8), boff = lds_byte(wc * 32 + fr, fq * 8);
#define PG8_SA(b, h) (((b) * 2 + (h)) * HTB)
#define PG8_SB(b, h) ((4 + (b) * 2 + (h)) * HTB)
#define PG8_STAGE(bufoff, gbase, voff) do { _Pragma("unroll") for (int _i = 0; _i < 2; ++_i) \
        __builtin_amdgcn_global_load_lds((const unsigned*)((const char*)(gbase) + (voff)[_i]), (PG8_LAS unsigned*)(lds + (bufoff) + ldsw + _i * 8192), 16, 0, 0); } while (0)
#define PG8_LDA(dst, b, h) do { _Pragma("unroll") for (int m = 0; m < 4; ++m) _Pragma("unroll") for (int k = 0; k < 2; ++k) dst[m][k] = *(const PG8_LAS bf16x8*)(lds + PG8_SA(b, h) + aoff + m * 2048 + k * 1024); } while (0)
#define PG8_LDB(dst, b, h) do { _Pragma("unroll") for (int n = 0; n < 2; ++n) _Pragma("unroll") for (int k = 0; k < 2; ++k) dst[n][k] = *(const PG8_LAS bf16x8*)(lds + PG8_SB(b, h) + boff + n * 2048 + k * 1024); } while (0)
#define PG8_MMA(ai, bj, At, Bt) do { __builtin_amdgcn_s_setprio(1); _Pragma("unroll") for (int m = 0; m < 4; ++m) _Pragma("unroll") for (int n = 0; n < 2; ++n) _Pragma("unroll") for (int k = 0; k < 2; ++k) \
        acc[ai][bj][m][n] = __builtin_amdgcn_mfma_f32_16x16x32_bf16(Bt[n][k], At[m][k], acc[ai][bj][m][n], 0, 0, 0); __builtin_amdgcn_s_setprio(0); } while (0)
#define PG8_WAIT_V(n) asm volatile("s_waitcnt vmcnt(" #n ")" ::: "memory")
#define PG8_WAIT_L(n) asm volatile("s_waitcnt lgkmcnt(" #n ")" ::: "memory")
#define PG8_BAR __builtin_amdgcn_s_barrier()
#define PG8_SCHED __builtin_amdgcn_sched_barrier(0)
    Unit cur, nxt; int ui = 0;
    if (!S.next(0, cur)) return;
    f32x4 acc[2][2][4][2];
#pragma unroll
    for (int a = 0; a < 2; ++a)
#pragma unroll
        for (int b = 0; b < 2; ++b)
#pragma unroll
            for (int m = 0; m < 4; ++m)
#pragma unroll
                for (int n = 0; n < 2; ++n) acc[a][b][m][n] = (f32x4){0.f, 0.f, 0.f, 0.f};
    bf16x8 At[4][2], B0[2][2], B1[2][2];
    const char* cA = (const char*)g.A + (size_t)cur.pm * tstepA + (size_t)cur.pn * g.akoff * 2; const char* cB = (const char*)g.Bt + (size_t)cur.pn * tstepB;
    S.a_ready(cur);
    if constexpr (SP2) {
        PG8_STAGE(PG8_SB(0, 0), cB, voffB); PG8_STAGE(PG8_SB(0, 1), cB + hstepB, voffB); PG8_STAGE(PG8_SA(0, 0), cA, voffA); PG8_STAGE(PG8_SA(0, 1), cA + hstepA, voffA);
        if (wr == 1) PG8_BAR;
        PG8_WAIT_V(2); PG8_BAR;
        PG8_STAGE(PG8_SB(1, 0), cB + kstep, voffB); PG8_STAGE(PG8_SA(1, 0), cA + kstep, voffA); PG8_STAGE(PG8_SB(1, 1), cB + hstepB + kstep, voffB);
        PG8_WAIT_V(6); PG8_BAR;
    } else {
        PG8_STAGE(PG8_SB(0, 0), cB, voffB); PG8_STAGE(PG8_SA(0, 0), cA, voffA); PG8_STAGE(PG8_SB(0, 1), cB + hstepB, voffB); PG8_STAGE(PG8_SA(0, 1), cA + hstepA, voffA);
        if (wr == 1) PG8_BAR;
        PG8_WAIT_V(4); PG8_BAR;
        PG8_STAGE(PG8_SB(1, 0), cB + kstep, voffB); PG8_STAGE(PG8_SA(1, 0), cA + kstep, voffA); PG8_STAGE(PG8_SB(1, 1), cB + hstepB + kstep, voffB);
        PG8_WAIT_V(6); PG8_BAR;
    }
    for (;;) {
        const bool has_next = S.next(ui + 1, nxt);
        const char* nA = has_next ? (const char*)g.A + (size_t)nxt.pm * tstepA + (size_t)nxt.pn * g.akoff * 2 : cA; const char* nB = has_next ? (const char*)g.Bt + (size_t)nxt.pn * tstepB : cB;
        for (int t = 0; t < nt; t += 2) {
            const bool last = (t == nt - 2);
            const char* a1 = cA + (size_t)(t + 1) * kstep;
            const char* a2 = last ? nA : cA + (size_t)(t + 2) * kstep; const char* b2 = last ? nB : cB + (size_t)(t + 2) * kstep;
            const char* a3 = a2 + kstep; const char* b3 = b2 + kstep;
            if (last && has_next) S.a_ready(nxt);
            if constexpr (SP2) {
            PG8_LDB(B0, 0, 0); PG8_LDB(B1, 0, 1); PG8_SCHED; PG8_LDA(At, 0, 0); PG8_STAGE(PG8_SA(1, 1), a1 + hstepA, voffA);
            PG8_WAIT_V(8); PG8_WAIT_L(0); PG8_BAR; PG8_MMA(0, 0, At, B0); PG8_MMA(0, 1, At, B1); PG8_BAR; PG8_SCHED;
            PG8_LDA(At, 0, 1); PG8_STAGE(PG8_SB(0, 0), b2, voffB); PG8_STAGE(PG8_SB(0, 1), b2 + hstepB, voffB); PG8_STAGE(PG8_SA(0, 0), a2, voffA);
            PG8_WAIT_V(8); PG8_WAIT_L(0); PG8_BAR; PG8_MMA(1, 0, At, B0); PG8_MMA(1, 1, At, B1); PG8_BAR; PG8_SCHED;
            PG8_LDB(B0, 1, 0); PG8_LDB(B1, 1, 1); PG8_SCHED; PG8_LDA(At, 1, 0); PG8_STAGE(PG8_SA(0, 1), a2 + hstepA, voffA);
            PG8_WAIT_V(8); PG8_WAIT_L(0); PG8_BAR; PG8_MMA(0, 0, At, B0); PG8_MMA(0, 1, At, B1); PG8_BAR; PG8_SCHED;
            PG8_LDA(At, 1, 1); PG8_STAGE(PG8_SB(1, 0), b3, voffB); PG8_STAGE(PG8_SB(1, 1), b3 + hstepB, voffB); PG8_STAGE(PG8_SA(1, 0), a3, voffA);
            PG8_WAIT_V(8); PG8_WAIT_L(0); PG8_BAR; PG8_MMA(1, 0, At, B0); PG8_MMA(1, 1, At, B1); PG8_BAR; PG8_SCHED;
            } else {
            PG8_LDB(B0, 0, 0); PG8_SCHED; PG8_LDA(At, 0, 0); PG8_STAGE(PG8_SA(1, 1), a1 + hstepA, voffA);
            PG8_WAIT_L(8); PG8_BAR; PG8_WAIT_L(0); PG8_MMA(0, 0, At, B0); PG8_BAR; PG8_SCHED;
            PG8_LDB(B1, 0, 1); PG8_STAGE(PG8_SB(0, 0), b2, voffB);
            PG8_BAR; PG8_WAIT_L(0); PG8_MMA(0, 1, At, B1); PG8_BAR;
            PG8_LDA(At, 0, 1); PG8_STAGE(PG8_SA(0, 0), a2, voffA);
            PG8_BAR; PG8_WAIT_L(0); PG8_MMA(1, 0, At, B0); PG8_BAR; PG8_SCHED;
            PG8_STAGE(PG8_SB(0, 1), b2 + hstepB, voffB);
            PG8_WAIT_V(6); PG8_BAR; PG8_MMA(1, 1, At, B1); PG8_BAR;
            PG8_LDB(B0, 1, 0); PG8_SCHED; PG8_LDA(At, 1, 0); PG8_STAGE(PG8_SA(0, 1), a2 + hstepA, voffA);
            PG8_WAIT_L(8); PG8_BAR; PG8_WAIT_L(0); PG8_MMA(0, 0, At, B0); PG8_BAR; PG8_SCHED;
            PG8_LDB(B1, 1, 1); PG8_STAGE(PG8_SB(1, 0), b3, voffB);
            PG8_BAR; PG8_WAIT_L(0); PG8_MMA(0, 1, At, B1); PG8_BAR;
            PG8_LDA(At, 1, 1); PG8_STAGE(PG8_SA(1, 0), a3, voffA);
            PG8_BAR; PG8_WAIT_L(0); PG8_MMA(1, 0, At, B0); PG8_BAR; PG8_SCHED;
            PG8_STAGE(PG8_SB(1, 1), b3 + hstepB, voffB);
            PG8_WAIT_V(6); PG8_BAR; PG8_MMA(1, 1, At, B1); PG8_BAR;
            }
        }
        if constexpr (ALIGN_EPI) { if (wr == 0) PG8_BAR; }
        if constexpr (!Epi::AFTER_DRAIN) { E(acc, cur, wr, wc, fr, fq); S.done(cur); }
        if (!has_next) break;
#pragma unroll
        for (int a = 0; a < 2; ++a)
#pragma unroll
            for (int b = 0; b < 2; ++b)
#pragma unroll
                for (int m = 0; m < 4; ++m)
#pragma unroll
                    for (int n = 0; n < 2; ++n) acc[a][b][m][n] = (f32x4){0.f, 0.f, 0.f, 0.f};
        cur = nxt; cA = nA; cB = nB; ++ui;
        if constexpr (ALIGN_EPI) { if (wr == 1) PG8_BAR; }
    }
    PG8_WAIT_V(0);
    if constexpr (!ALIGN_EPI) { if (wr == 0) PG8_BAR; }
    PG8_BAR;
    if constexpr (Epi::AFTER_DRAIN) { E.fused(acc, cur, wr, wc, fr, fq, lds, wid, lane); S.done(cur); }
#undef PG8_SA
#undef PG8_SB
#undef PG8_STAGE
#undef PG8_LDA
#undef PG8_LDB
#undef PG8_MMA
#undef PG8_WAIT_V
#undef PG8_WAIT_L
#undef PG8_BAR
#undef PG8_SCHED
}
}
namespace pg8 {
typedef float f32x2 __attribute__((ext_vector_type(2)));
__device__ __forceinline__ float rms_rowscale(const float* ssq, int row) { const f32x4 a = *(const f32x4*)(ssq + (size_t)row * 8), b = *(const f32x4*)(ssq + (size_t)row * 8 + 4);
    return __builtin_amdgcn_rsqf((((a[0] + a[1]) + (a[2] + a[3])) + ((b[0] + b[1]) + (b[2] + b[3]))) * (1.0f / 2048.0f) + 1e-6f); }
struct SegTab { bf16_t* base[8]; int ldc[8]; int t0[8]; int gw[8]; int nseg; int pad_; };
struct EpiBf16R {
    static constexpr bool PERM = true, AFTER_DRAIN = false;
    SegTab T; const float* ssp; int ss_off;
    __device__ __forceinline__ void operator()(const f32x4 (&acc)[2][2][4][2], const Unit& u, int wr, int wc, int fr, int fq) const {
        bf16_t* base = T.base[0]; int ldc = T.ldc[0], gw = T.gw[0], t0 = T.t0[0];
#pragma unroll
        for (int s = 1; s < 8; ++s) if (s < T.nseg && u.pn >= T.t0[s]) { base = T.base[s]; ldc = T.ldc[s]; gw = T.gw[s]; t0 = T.t0[s]; }
        const int colt = (u.pn - t0) * BM, row0 = u.pm * BM + wr * 64 + fr;
#pragma unroll
        for (int ai = 0; ai < 2; ++ai)
#pragma unroll
            for (int m = 0; m < 4; ++m) { const int row = row0 + ai * HALF + m * 16;
                const float rs = ssp ? rms_rowscale(ssp, ss_off + row) : 1.0f;
#pragma unroll
                for (int bj = 0; bj < 2; ++bj) { const int col = colt + bj * HALF + wc * 32 + 8 * fq;
                    const f32x4 v0 = acc[ai][bj][m][0] * rs, v1 = acc[ai][bj][m][1] * rs;
                    u32x4 w; w.x = cvt_pk_bf16(v0[0], v0[1]); w.y = cvt_pk_bf16(v0[2], v0[3]); w.z = cvt_pk_bf16(v1[0], v1[1]); w.w = cvt_pk_bf16(v1[2], v1[3]);
                    if (gw == -2) {
                        if ((row >> 5) < ldc) { bf16_t* d0 = base + ((size_t)(((col >> 5) * ldc + (row >> 5)) * 2 + ((col >> 4) & 1)) * 64 + (row & 31)) * 8 + 4 * ((col >> 3) & 1);
                            typedef unsigned u32x2_ __attribute__((ext_vector_type(2)));
                            *(u32x2_*)d0 = (u32x2_){w.x, w.y}; *(u32x2_*)(d0 + 32 * 8) = (u32x2_){w.z, w.w}; }
                        continue; }
                    bf16_t* dst;
                    if (gw == 0) dst = base + (size_t)row * ldc + col;
                    else if (gw == -1) { if ((col >> 4) >= ldc) continue; dst = base + ((size_t)((row >> 5) * ldc + (col >> 4)) * 64 + ((col >> 3) & 1) * 32 + (row & 31)) * 8; }
                    else { const int g = col / gw, d = col - g * gw; dst = base + ((size_t)((row >> 12) * 4 + g) * 4096 + (row & 4095)) * gw + d; }
                    *(u32x4*)dst = w; } }
    }
};
struct EpiGelu {
    static constexpr bool PERM = true, AFTER_DRAIN = false;
    bf16_t* O; int ldc; const float* bias;
    static __device__ __forceinline__ float gelu(float x) { const float u2 = 1.5957691216f * (x + 0.044715f * x * x * x); const float e = __builtin_amdgcn_exp2f(-u2 * 1.4426950409f); return x * __builtin_amdgcn_rcpf(1.0f + e); }
    __device__ __forceinline__ void operator()(const f32x4 (&acc)[2][2][4][2], const Unit& u, int wr, int wc, int fr, int fq) const {
        const int row0 = u.pm * BM + wr * 64 + fr, col0 = u.pn * BM + wc * 32 + 8 * fq;
#pragma unroll
        for (int bj = 0; bj < 2; ++bj) { const f32x4 b0 = *(const f32x4*)(bias + col0 + bj * HALF), b1 = *(const f32x4*)(bias + col0 + bj * HALF + 4);
#pragma unroll
            for (int ai = 0; ai < 2; ++ai)
#pragma unroll
                for (int m = 0; m < 4; ++m) { const f32x4 v0 = acc[ai][bj][m][0] + b0, v1 = acc[ai][bj][m][1] + b1;
                    u32x4 w; w.x = cvt_pk_bf16(gelu(v0[0]), gelu(v0[1])); w.y = cvt_pk_bf16(gelu(v0[2]), gelu(v0[3])); w.z = cvt_pk_bf16(gelu(v1[0]), gelu(v1[1])); w.w = cvt_pk_bf16(gelu(v1[2]), gelu(v1[3]));
                    *(u32x4*)(O + (size_t)(row0 + ai * HALF + m * 16) * ldc + col0 + bj * HALF) = w; } }
    }
};
struct EpiF32 {
    static constexpr bool PERM = false, AFTER_DRAIN = false;
    float* C; int ldc; const float* ssp; int ss_off;
    __device__ __forceinline__ void operator()(const f32x4 (&acc)[2][2][4][2], const Unit& u, int wr, int wc, int fr, int fq) const {
        const int row0 = u.pm * BM + wr * 64 + fr, col0 = u.pn * BM + wc * 32 + 4 * fq;
#pragma unroll
        for (int ai = 0; ai < 2; ++ai)
#pragma unroll
            for (int m = 0; m < 4; ++m) { float* rowp = C + (size_t)(row0 + ai * HALF + m * 16) * ldc + col0;
                const float rs = ssp ? rms_rowscale(ssp, ss_off + row0 + ai * HALF + m * 16) : 1.0f;
#pragma unroll
                for (int bj = 0; bj < 2; ++bj)
#pragma unroll
                    for (int n = 0; n < 2; ++n) *(f32x4*)(rowp + bj * HALF + n * 16) = acc[ai][bj][m][n] * rs; }
    }
};
struct EpiResN {
    static constexpr bool PERM = false, AFTER_DRAIN = false;
    const float* res32; const float* gprev; float* out32; int ldc; int row_off; const float* g; bf16_t* xn; float* ss; PG8_LAS float* xb;
    __device__ __forceinline__ void operator()(const f32x4 (&acc)[2][2][4][2], const Unit& u, int wr, int wc, int fr, int fq) const {
        typedef unsigned u32x2_ __attribute__((ext_vector_type(2)));
        const int row0 = row_off + u.pm * BM + wr * 64 + fr, col0 = u.pn * BM + wc * 32 + 4 * fq;
        f32x4 gv[2][2], gi[2][2];
#pragma unroll
        for (int bj = 0; bj < 2; ++bj)
#pragma unroll
            for (int n = 0; n < 2; ++n) { gv[bj][n] = g ? *(const f32x4*)(g + col0 + bj * HALF + n * 16) : (f32x4){0.f, 0.f, 0.f, 0.f};
                if (!res32) { const f32x4 t = *(const f32x4*)(gprev + col0 + bj * HALF + n * 16); gi[bj][n] = (f32x4){1.0f / t[0], 1.0f / t[1], 1.0f / t[2], 1.0f / t[3]}; } else gi[bj][n] = (f32x4){1.f, 1.f, 1.f, 1.f}; }
#pragma unroll
        for (int ai = 0; ai < 2; ++ai)
#pragma unroll
            for (int m = 0; m < 4; ++m) { const int row = row0 + ai * HALF + m * 16; const size_t off = (size_t)row * ldc + col0;
                f32x4 r[2][2]; float sq = 0.f;
#pragma unroll
                for (int bj = 0; bj < 2; ++bj)
#pragma unroll
                    for (int n = 0; n < 2; ++n) {
                        if (res32) r[bj][n] = *(const f32x4*)(res32 + off + bj * HALF + n * 16);
                        else { const u32x2_ w = *(const u32x2_*)(xn + off + bj * HALF + n * 16);
                            r[bj][n] = (f32x4){__builtin_bit_cast(float, w.x << 16), __builtin_bit_cast(float, w.x & 0xffff0000u), __builtin_bit_cast(float, w.y << 16), __builtin_bit_cast(float, w.y & 0xffff0000u)} * gi[bj][n]; } }
#pragma unroll
                for (int bj = 0; bj < 2; ++bj)
#pragma unroll
                    for (int n = 0; n < 2; ++n) { const f32x4 o = r[bj][n] + acc[ai][bj][m][n];
                        if (out32) *(f32x4*)(out32 + off + bj * HALF + n * 16) = o;
                        if (g) { sq += (o[0] * o[0] + o[1] * o[1]) + (o[2] * o[2] + o[3] * o[3]);
                            const f32x4 y = o * gv[bj][n]; *(u32x2_*)(xn + off + bj * HALF + n * 16) = (u32x2_){cvt_pk_bf16(y[0], y[1]), cvt_pk_bf16(y[2], y[3])}; } }
                if (g) { sq += __shfl_xor(sq, 16); sq += __shfl_xor(sq, 32);
                    if (fq == 0) xb[(ai * HALF + wr * 64 + m * 16 + fr) * 4 + wc] = sq; }
                asm volatile("" ::: "memory"); }
        if (g) {
            asm volatile("s_waitcnt lgkmcnt(0)" ::: "memory"); __builtin_amdgcn_s_barrier(); asm volatile("" ::: "memory");
            const int t = (wr * 4 + wc) * 64 + fq * 16 + fr;
            if (t < BM) { const f32x4 v = *(const PG8_LAS f32x4*)(xb + t * 4); ss[(size_t)(row_off + u.pm * BM + t) * 8 + u.pn] = (v[0] + v[1]) + (v[2] + v[3]); }
        }
    }
};
struct EpiConvGlu {
    static constexpr bool PERM = true, AFTER_DRAIN = false;
    bf16_t* G; float* UB; const float* cw; const float* cb; PG8_LAS float* xb; int dff; const PG8_LAS float* rstd; int rbase;
    static __device__ __forceinline__ float shr(float old, float src, int n) { const int o = __builtin_bit_cast(int, old), s = __builtin_bit_cast(int, src);
        return __builtin_bit_cast(float, n == 1 ? __builtin_amdgcn_update_dpp(o, s, 0x111, 0xf, 0xf, false) : __builtin_amdgcn_update_dpp(o, s, 0x112, 0xf, 0xf, false)); }
    static __device__ __forceinline__ float ror(float src, int n) { const int s = __builtin_bit_cast(int, src);
        return __builtin_bit_cast(float, n == 1 ? __builtin_amdgcn_update_dpp(0, s, 0x121, 0xf, 0xf, false) : __builtin_amdgcn_update_dpp(0, s, 0x122, 0xf, 0xf, false)); }
    __device__ __forceinline__ void operator()(f32x4 (&acc)[2][2][4][2], const Unit& u, int wr, int wc, int fr, int fq) const {
        typedef unsigned u32x2_ __attribute__((ext_vector_type(2)));
        if (rstd) {
#pragma unroll
            for (int ai = 0; ai < 2; ++ai)
#pragma unroll
                for (int m = 0; m < 4; ++m) { const float rs = rstd[u.pm * BM + ai * HALF + wr * 64 + m * 16 + fr - rbase];
#pragma unroll
                    for (int bj = 0; bj < 2; ++bj)
#pragma unroll
                        for (int n = 0; n < 2; ++n) acc[ai][bj][m][n] = acc[ai][bj][m][n] * rs; }
        }
        if (fr >= 14) {
#pragma unroll
            for (int ai = 0; ai < 2; ++ai)
#pragma unroll
                for (int bj = 0; bj < 2; ++bj)
#pragma unroll
                    for (int n = 0; n < 2; ++n) *(PG8_LAS f32x4*)(xb + (((((ai * 2 + wr) * 4 + wc) * 2 + (fr - 14)) * 4 + fq) * 16) + (bj * 2 + n) * 4) = acc[ai][bj][3][n];
        }
        { const int ncol = 4 * dff / 2;
          const bool top = (wr == 0 && fr < 2), bot = (wr == 1 && fr >= 14);
          if (top || bot) { float* ub = UB + ((size_t)(u.pm * 4 + (top ? fr : 2 + fr - 14)) * ncol) + u.pn * BM + wc * 32 + 8 * fq;
#pragma unroll
            for (int bj = 0; bj < 2; ++bj)
#pragma unroll
                for (int n = 0; n < 2; ++n) *(f32x4*)(ub + bj * HALF + 4 * n) = top ? acc[0][bj][0][n] : acc[1][bj][3][n]; } }
        asm volatile("s_waitcnt lgkmcnt(0)" ::: "memory"); __builtin_amdgcn_s_barrier(); asm volatile("" ::: "memory");
        u32x2_ res[2][4][2];
        const int ch0 = u.pn * HALF + wc * 32 + 8 * fq;
#pragma unroll
        for (int n = 0; n < 2; ++n) {
            const float* wp = cw + ch0 + 4 * n; const float* bp = cb + ch0 + 4 * n;
            const f32x4 w0g = *(const f32x4*)(wp), w1g = *(const f32x4*)(wp + 2 * dff), w2g = *(const f32x4*)(wp + 4 * dff), bg = *(const f32x4*)(bp);
            const f32x4 w0v = *(const f32x4*)(wp + dff), w1v = *(const f32x4*)(wp + 3 * dff), w2v = *(const f32x4*)(wp + 5 * dff), bv = *(const f32x4*)(bp + dff);
#pragma unroll
            for (int ai = 0; ai < 2; ++ai)
#pragma unroll
                for (int m = 0; m < 4; ++m) {
                    const f32x4 cg = acc[ai][0][m][n], cv = acc[ai][1][m][n];
                    f32x4 b1g, b2g, b1v, b2v;
                    if (m > 0) {
#pragma unroll
                        for (int e = 0; e < 4; ++e) { b1g[e] = ror(acc[ai][0][m - 1][n][e], 1); b2g[e] = ror(acc[ai][0][m - 1][n][e], 2); b1v[e] = ror(acc[ai][1][m - 1][n][e], 1); b2v[e] = ror(acc[ai][1][m - 1][n][e], 2); }
                    } else {
                        const int sai = wr ? ai : ai - 1, swr = wr ? 0 : 1;
                        f32x4 x14g = {0.f, 0.f, 0.f, 0.f}, x15g = x14g, x14v = x14g, x15v = x14g;
                        if (sai >= 0) { const PG8_LAS float* xp = xb + (((((sai * 2 + swr) * 4 + wc) * 2) * 4 + fq) * 16);
                            x14g = *(const PG8_LAS f32x4*)(xp + n * 4); x14v = *(const PG8_LAS f32x4*)(xp + (2 + n) * 4); x15g = *(const PG8_LAS f32x4*)(xp + 64 + n * 4); x15v = *(const PG8_LAS f32x4*)(xp + 64 + (2 + n) * 4); }
                        b1g = x15g; b1v = x15v; b2g = fr == 0 ? x14g : x15g; b2v = fr == 0 ? x14v : x15v;
                    }
                    float o[4];
#pragma unroll
                    for (int e = 0; e < 4; ++e) {
                        const float p1g = shr(b1g[e], cg[e], 1), p2g = shr(b2g[e], cg[e], 2), p1v = shr(b1v[e], cv[e], 1), p2v = shr(b2v[e], cv[e], 2);
                        const float yg = bg[e] + w0g[e] * p2g + w1g[e] * p1g + w2g[e] * cg[e], yv = bv[e] + w0v[e] * p2v + w1v[e] * p1v + w2v[e] * cv[e];
                        o[e] = yg * __builtin_amdgcn_rcpf(1.0f + __builtin_amdgcn_exp2f(-yg * 1.4426950409f)) * yv;
                    }
                    res[ai][m][n] = (u32x2_){cvt_pk_bf16(o[0], o[1]), cvt_pk_bf16(o[2], o[3])};
                }
        }
        const int row0 = u.pm * BM + wr * 64 + fr;
#pragma unroll
        for (int ai = 0; ai < 2; ++ai)
#pragma unroll
            for (int m = 0; m < 4; ++m) *(u32x4*)(G + (size_t)(row0 + ai * HALF + m * 16) * dff + ch0) = (u32x4){res[ai][m][0].x, res[ai][m][0].y, res[ai][m][1].x, res[ai][m][1].y};
    }
};
}
constexpr int BATCH = 8, SEQ = 4096, DM = 2048, MTOT = BATCH * SEQ, MC = MTOT / 2  , BPH = BATCH / 2;
constexpr int DFF = 5632;
constexpr float NORM_EPS = 1e-6f, LOG2E = 1.4426950408889634f;
constexpr int NWAVES = 8;
constexpr size_t MiB = 1u << 20;
constexpr size_t WS_CTL = 0, CTL_ZERO_BYTES = 1 * MiB;
constexpr size_t WS_TAB = 1 * MiB;
constexpr size_t TAB_COS48 = WS_TAB, TAB_SIN48 = WS_TAB + 3 * MiB, TAB_COS32 = WS_TAB + 6 * MiB, TAB_SIN32 = WS_TAB + 8 * MiB;
constexpr size_t WS_WMIX = 12 * MiB;
constexpr size_t WS_WFFN = 100 * MiB;
constexpr size_t WS_MISC = 168 * MiB;
constexpr size_t WS_SS = 170 * MiB;
constexpr size_t WS_XNR = 1010 * MiB;
constexpr size_t WS_AR = 234 * MiB;
constexpr size_t WS_END = 1138 * MiB;
constexpr int CW_TMO = 0;
constexpr int CW_BAR = 4096;
constexpr int RING_BYTES = 131072;
constexpr int LDSCTL_OFF = 135168;
constexpr int LDS_BYTES = 163840;

#define GAS __attribute__((address_space(1)))
#define LAS __attribute__((address_space(3)))
typedef unsigned short bf16;
typedef unsigned u32x4 __attribute__((ext_vector_type(4)));
typedef unsigned u32x2 __attribute__((ext_vector_type(2)));
typedef float f32x4 __attribute__((ext_vector_type(4)));
typedef float f32x16 __attribute__((ext_vector_type(16)));
typedef short bf16x8 __attribute__((ext_vector_type(8)));
typedef short s16x4 __attribute__((ext_vector_type(4)));
typedef short v4i16_t __attribute__((ext_vector_type(4)));
typedef __bf16 bf16x2_t __attribute__((ext_vector_type(2)));
typedef float f32x2_t __attribute__((ext_vector_type(2)));
#define LDS_WAIT() asm volatile("s_waitcnt lgkmcnt(0)" ::: "memory")
#define VM_WAIT() asm volatile("s_waitcnt vmcnt(0)" ::: "memory")
#define MFMA32(a, b, c) __builtin_amdgcn_mfma_f32_32x32x16_bf16((a), (b), (c), 0, 0, 0)
DI unsigned pk2(float lo, float hi) { f32x2_t v = {lo, hi}; bf16x2_t b = __builtin_convertvector(v, bf16x2_t); return __builtin_bit_cast(unsigned, b); }
DI float bf2f(unsigned short b) { return __builtin_bit_cast(float, (unsigned)b << 16); }
DI float bflo(unsigned w) { return __builtin_bit_cast(float, w << 16); }
DI float bfhi(unsigned w) { return __builtin_bit_cast(float, w & 0xffff0000u); }
DI unsigned short f2bf(float f) { return (unsigned short)(pk2(f, 0.f) & 0xffffu); }
DI float wave_sum(float v) {
#pragma unroll
    for (int o = 1; o < 64; o <<= 1) v += __shfl_xor(v, o);
    return v;
}
DI int crow(int i, int h) { return (i & 3) + 8 * (i >> 2) + 4 * h; }
#define XB_TMO      128
#define XB_XCNT(j)  (256  + 64 * (j))
#define XB_XSUB(j)  (1280 + 64 * (j))
#define XB_XGEN(j)  (2304 + 64 * (j))
#define XB_TOP      3328
#define XB_TOPGEN   3392
#define XCD_BAR_WORDS 3456
#define XB_SPIN_CAP (1u << 18)

__device__ __forceinline__ unsigned xb_ld(unsigned* p)              { return __hip_atomic_load(p, __ATOMIC_RELAXED, __HIP_MEMORY_SCOPE_AGENT); }
__device__ __forceinline__ unsigned xb_add(unsigned* p, unsigned v) { return __hip_atomic_fetch_add(p, v, __ATOMIC_RELAXED, __HIP_MEMORY_SCOPE_AGENT); }
__device__ __forceinline__ unsigned xb_xcc_id() { return (unsigned)__builtin_amdgcn_s_getreg((3 << 11) | 20) & 0xFu; }
#define XB_SPIN(cond, bar) do { unsigned _sp = 0; while (cond) { __builtin_amdgcn_s_sleep(1); \
    if ((++_sp & 255u) == 0u) { if (xb_ld(&(bar)[XB_TMO])) break; if (_sp > XB_SPIN_CAP) { atomicAdd(&(bar)[XB_TMO], 1u); break; } } } } while (0)

struct XcdBarrier {
    unsigned* bar; unsigned x;
    volatile LAS unsigned* st;
};

__device__ __forceinline__ XcdBarrier xcd_barrier_post(unsigned* bar, volatile LAS unsigned* st) {
    XcdBarrier b; b.bar = bar; b.x = xb_xcc_id(); b.st = st;
    if (threadIdx.x == 0) (void)xb_add(&bar[XB_XCNT(b.x)], 1u);
    return b;
}
__device__ __forceinline__ void xcd_barrier_complete(unsigned* bar, unsigned x, unsigned& nloc, unsigned& nx) {
    const unsigned G = gridDim.x * gridDim.y * gridDim.z;
    unsigned sum, cnt, mine, sp = 0u;
    for (;;) {
        sum = 0u; cnt = 0u; mine = 0u;
#pragma unroll
        for (unsigned j = 0; j < 16; ++j) { const unsigned c = xb_ld(&bar[XB_XCNT(j)]); sum += c; cnt += (c > 0u) ? 1u : 0u; mine = (j == x) ? c : mine; }
        if (sum == G) break;
        __builtin_amdgcn_s_sleep(1);
        if ((++sp & 255u) == 0u) { if (xb_ld(&bar[XB_TMO])) break; if (sp > XB_SPIN_CAP) { atomicAdd(&bar[XB_TMO], 1u); break; } }
    }
    nloc = mine > 0u ? mine : 1u; nx = cnt > 0u ? cnt : 1u;
}

__device__ __forceinline__ void xcd_barrier(const XcdBarrier& b) {
    asm volatile("s_waitcnt vmcnt(0)" ::: "memory");
    __syncthreads();
    if (threadIdx.x == 0) {
        unsigned* bar = b.bar;
        __builtin_amdgcn_s_waitcnt(0);
        unsigned nloc = b.st[0], nx = b.st[1];
        if (nloc == 0u) { xcd_barrier_complete(bar, b.x, nloc, nx); b.st[0] = nloc; b.st[1] = nx; }
        const unsigned old = xb_add(&bar[XB_XSUB(b.x)], 1u);
        const unsigned gen = old / nloc;
        if (old + 1u == (gen + 1u) * nloc) {
            __builtin_amdgcn_fence(__ATOMIC_RELEASE, "agent");
            asm volatile("s_waitcnt vmcnt(0)" ::: "memory");
            const unsigned og = xb_add(&bar[XB_TOP], 1u);
            const unsigned tg = og / nx;
            if (og + 1u == (tg + 1u) * nx) xb_add(&bar[XB_TOPGEN], 1u);
            else XB_SPIN(xb_ld(&bar[XB_TOPGEN]) == tg, bar);
            __builtin_amdgcn_fence(__ATOMIC_ACQUIRE, "agent");
            xb_add(&bar[XB_XGEN(b.x)], 1u);
            asm volatile("s_waitcnt vmcnt(0)" ::: "memory");
        } else {
            XB_SPIN(xb_ld(&bar[XB_XGEN(b.x)]) == gen, bar);
            __builtin_amdgcn_fence(__ATOMIC_ACQUIRE, "agent");
            asm volatile("s_waitcnt vmcnt(0)" ::: "memory");
        }
    }
    __syncthreads();
}
struct Frame {
    LAS unsigned char* lds; unsigned* ctl; unsigned char* ws;
    int tid, lane, wave, G, gw, NGW;
};
DI void ph_tables(const Frame& F, const int* pos) {
    float* c48 = (float*)(F.ws + TAB_COS48); float* s48 = (float*)(F.ws + TAB_SIN48); float* c32 = (float*)(F.ws + TAB_COS32); float* s32 = (float*)(F.ws + TAB_SIN32);
    const int gt = blockIdx.x * (NWAVES * 64) + F.tid, NT = F.G * NWAVES * 64;
    for (int i = gt; i < MTOT * 40; i += NT) {
        const int m = i / 40, j = i - m * 40; const float p = (float)pos[m];
        const bool a = j < 24; const int jj = a ? j : j - 24;
        const float inv = (float)exp(-(2.0 * jj / (a ? 48.0 : 32.0)) * 13.122363377404328);
        const float ang = p * inv; float sn, cs; sincosf(ang, &sn, &cs);
        if (a) { c48[m * 24 + jj] = cs; s48[m * 24 + jj] = sn; } else { c32[m * 16 + jj] = cs; s32[m * 16 + jj] = sn; }
    }
}
DI void cvt_load(float (&v)[32], const float* W, int ldw, int col0, int ncols, int item, int nblk, int lane) {
    const int kb = item / nblk, nb = item - kb * nblk, k0 = 64 * kb, n0 = 32 * nb, nn = n0 + (lane & 31); const bool ok = nn < ncols;
    const float* p = W + (size_t)(k0 + (lane >> 5)) * ldw + col0 + (ok ? nn : 0);
#pragma unroll
    for (int i = 0; i < 32; ++i) { const float x = p[(size_t)(2 * i) * ldw]; v[i] = ok ? x : 0.f; }
}
DI void cvt_store(const float (&v)[32], int ncols, bf16* WT, int ldt, int row_off, float scale, LAS float* scr, int item, int nblk, int lane) {
    const int kb = item / nblk, nb = item - kb * nblk, k0 = 64 * kb, n0 = 32 * nb;
#pragma unroll
    for (int i = 0; i < 32; ++i) scr[(2 * i + (lane >> 5)) * 33 + (lane & 31)] = v[i] * scale;
    LDS_WAIT();
    const int c = lane & 7;
#pragma unroll
    for (int j = 0; j < 4; ++j) { const int n = (lane >> 3) + 8 * j; const LAS float* s = scr + (8 * c) * 33 + n;
        u32x4 o; o.x = pk2(s[0 * 33], s[1 * 33]); o.y = pk2(s[2 * 33], s[3 * 33]); o.z = pk2(s[4 * 33], s[5 * 33]); o.w = pk2(s[6 * 33], s[7 * 33]);
        if (n0 + n < ncols) *(u32x4*)(WT + (size_t)(row_off + n0 + n) * ldt + k0 + 8 * c) = o; }
    LDS_WAIT();
}
DI void cvt_item(const float* W, int ldw, int col0, int ncols, bf16* WT, int ldt, int row_off, float scale, LAS float* scr, int item, int nblk, int lane) {
    float v[32]; cvt_load(v, W, ldw, col0, ncols, item, nblk, lane); cvt_store(v, ncols, WT, ldt, row_off, scale, scr, item, nblk, lane);
}
template <class MAP> DI void cvt_loop(const Frame& F, const float* W, int ldw, int ncols, bf16* WT, int ldt, float scale, int nitems, int nblk, const MAP& map) {
    LAS float* scr = (LAS float*)(F.lds + F.wave * 16384);
    int it = F.gw; float cur[32]; int c0 = 0, ro = 0, li = 0;
    if (it < nitems) { map(it, c0, ro, li); cvt_load(cur, W, ldw, c0, ncols, li, nblk, F.lane); }
#pragma unroll 1
    for (; it < nitems; it += F.NGW) {
        float nxt[32]; int c1 = 0, r1 = 0, l1 = 0; const int ni = it + F.NGW;
        if (ni < nitems) { map(ni, c1, r1, l1); cvt_load(nxt, W, ldw, c1, ncols, l1, nblk, F.lane); }
        cvt_store(cur, ncols, WT, ldt, ro, scale, scr, li, nblk, F.lane);
#pragma unroll
        for (int i = 0; i < 32; ++i) cur[i] = nxt[i];
        c0 = c1; ro = r1; li = l1;
    }
}
struct CvtPlain { int col0, row_off; DI void operator()(int it, int& c, int& r, int& l) const { c = col0; r = row_off; l = it; } };
DI void cvt_job(const Frame& F, const float* W, int ldw, int K, int col0, int ncols, bf16* WT, int ldt, int row_off, float scale) {
    const int nblk = (ncols + 31) / 32;
    cvt_loop(F, W, ldw, ncols, WT, ldt, scale, (K / 64) * nblk, nblk, CvtPlain{col0, row_off});
}
DI void zero_bf16(const Frame& F, bf16* p, size_t nelem) {
    const size_t gt = (size_t)blockIdx.x * (NWAVES * 64) + F.tid, NT = (size_t)F.G * NWAVES * 64;
    for (size_t i = gt; i < nelem / 8; i += NT) ((u32x4*)p)[i] = (u32x4){0u, 0u, 0u, 0u};
}
DI void ph_cvt_ffn(const Frame& F, const float* up, const float* down) {
    bf16* WUP = (bf16*)(F.ws + WS_WFFN); bf16* WDN = WUP + (size_t)2 * DFF * DM;
    struct UpMap { DI void operator()(int it, int& c, int& r, int& l) const { const int seg = it >> 7, pn = seg >> 1, isv = seg & 1; c = isv * DFF + pn * 128; r = pn * 256 + isv * 128; l = it & 127; } };
    cvt_loop(F, up, 2 * DFF, 128, WUP, DM, 1.f, 88 * 128, 4, UpMap{});
    cvt_job(F, down, DM, DFF, 0, DM, WDN, DFF, 0, 1.f);
}
DI void ph_conv_fix(const Frame& F, const float* UB, bf16* Gb, const float* cw, const float* cb, const int nrows = MC) {
    const int gt = blockIdx.x * (NWAVES * 64) + F.tid, NT = F.G * NWAVES * 64;
    for (int it = gt; it < (nrows / 256) * (DFF / 4); it += NT) {
        const int pm = it / (DFF / 4), c4 = it - pm * (DFF / 4), ch = c4 * 4, col = (ch >> 7) * 256 + (ch & 127);
        const float* ub = UB + (size_t)pm * 4 * (2 * DFF) + col; const bool has = (pm & 15) != 0;
        const f32x4 z = {0.f, 0.f, 0.f, 0.f};
        const f32x4 g0 = *(const f32x4*)(ub), g1 = *(const f32x4*)(ub + 2 * DFF), v0 = *(const f32x4*)(ub + 128), v1 = *(const f32x4*)(ub + 2 * DFF + 128);
        const f32x4 gm2 = has ? *(const f32x4*)(ub - 2 * (2 * DFF)) : z, gm1 = has ? *(const f32x4*)(ub - (2 * DFF)) : z, vm2 = has ? *(const f32x4*)(ub - 2 * (2 * DFF) + 128) : z, vm1 = has ? *(const f32x4*)(ub - (2 * DFF) + 128) : z;
        const f32x4 w0g = *(const f32x4*)(cw + ch), w1g = *(const f32x4*)(cw + 2 * DFF + ch), w2g = *(const f32x4*)(cw + 4 * DFF + ch), bg = *(const f32x4*)(cb + ch);
        const f32x4 w0v = *(const f32x4*)(cw + DFF + ch), w1v = *(const f32x4*)(cw + 3 * DFF + ch), w2v = *(const f32x4*)(cw + 5 * DFF + ch), bv = *(const f32x4*)(cb + DFF + ch);
        float o0[4], o1[4];
#pragma unroll
        for (int e = 0; e < 4; ++e) {
            const float yg0 = bg[e] + w0g[e] * gm2[e] + w1g[e] * gm1[e] + w2g[e] * g0[e], yv0 = bv[e] + w0v[e] * vm2[e] + w1v[e] * vm1[e] + w2v[e] * v0[e];
            const float yg1 = bg[e] + w0g[e] * gm1[e] + w1g[e] * g0[e] + w2g[e] * g1[e], yv1 = bv[e] + w0v[e] * vm1[e] + w1v[e] * v0[e] + w2v[e] * v1[e];
            o0[e] = yg0 * __builtin_amdgcn_rcpf(1.0f + __builtin_amdgcn_exp2f(-yg0 * LOG2E)) * yv0; o1[e] = yg1 * __builtin_amdgcn_rcpf(1.0f + __builtin_amdgcn_exp2f(-yg1 * LOG2E)) * yv1;
        }
        u32x2 a, b; a.x = pk2(o0[0], o0[1]); a.y = pk2(o0[2], o0[3]); b.x = pk2(o1[0], o1[1]); b.y = pk2(o1[2], o1[3]);
        *(u32x2*)(Gb + (size_t)(pm * 256) * DFF + ch) = a; *(u32x2*)(Gb + (size_t)(pm * 256 + 1) * DFF + ch) = b;
    }
}
DI void ph_norm_first(const Frame& F, const float* src, const float* gain, bf16* XNR, float* ss) {
    f32x4 g[8];
#pragma unroll
    for (int j = 0; j < 8; ++j) g[j] = *(const f32x4*)(gain + 4 * (F.lane + 64 * j));
    for (int m = F.gw; m < MTOT; m += F.NGW) {
        const f32x4* xr = (const f32x4*)(src + (size_t)m * DM) + F.lane;
        f32x4 v[8]; float s2 = 0.f;
#pragma unroll
        for (int j = 0; j < 8; ++j) { v[j] = xr[64 * j]; s2 += (v[j].x * v[j].x + v[j].y * v[j].y) + (v[j].z * v[j].z + v[j].w * v[j].w); }
        s2 = wave_sum(s2);
        if (F.lane < 2) *(f32x4*)(ss + (size_t)m * 8 + 4 * F.lane) = (f32x4){F.lane == 0 ? s2 : 0.f, 0.f, 0.f, 0.f};
        u32x2* o = (u32x2*)(XNR + (size_t)m * DM) + F.lane;
#pragma unroll
        for (int j = 0; j < 8; ++j) { const f32x4 y = v[j] * g[j]; u32x2 w; w.x = pk2(y.x, y.y); w.y = pk2(y.z, y.w); o[64 * j] = w; }
    }
}
DI void ph_final_norm(const Frame& F, float* h, const float* gain) {
    f32x4 g[8];
#pragma unroll
    for (int j = 0; j < 8; ++j) g[j] = *(const f32x4*)(gain + 4 * (F.lane + 64 * j));
    for (int m = F.gw; m < MTOT; m += F.NGW) {
        f32x4* xr = (f32x4*)(h + (size_t)m * DM) + F.lane;
        f32x4 v[8]; float ss = 0.f;
#pragma unroll
        for (int j = 0; j < 8; ++j) { v[j] = xr[64 * j]; ss += (v[j].x * v[j].x + v[j].y * v[j].y) + (v[j].z * v[j].z + v[j].w * v[j].w); }
        const float rstd = 1.0f / sqrtf(wave_sum(ss) * (1.f / DM) + NORM_EPS);
#pragma unroll
        for (int j = 0; j < 8; ++j) xr[64 * j] = v[j] * rstd * g[j];
    }
}
DI void rope_piece(const bf16* qrow, int p, const float* cs, const float* sn, float (&o)[8]) {
    const bool lo = p < 3; const int pp = lo ? p + 3 : p - 3, i0 = 8 * (lo ? p : p - 3);
    const u32x4 a = *(const u32x4*)(qrow + 8 * p), b = *(const u32x4*)(qrow + 8 * pp);
    const f32x4 c0 = *(const f32x4*)(cs + i0), c1 = *(const f32x4*)(cs + i0 + 4), s0 = *(const f32x4*)(sn + i0), s1 = *(const f32x4*)(sn + i0 + 4);
#pragma unroll
    for (int e = 0; e < 4; ++e) { const float c_l = e < 2 ? c0[2 * e] : c1[2 * e - 4], c_h = e < 2 ? c0[2 * e + 1] : c1[2 * e - 3], s_l = e < 2 ? s0[2 * e] : s1[2 * e - 4], s_h = e < 2 ? s0[2 * e + 1] : s1[2 * e - 3];
        const float al = bflo(a[e]), ah = bfhi(a[e]), bl_ = bflo(b[e]), bh_ = bfhi(b[e]);
        o[2 * e] = lo ? al * c_l - bl_ * s_l : bl_ * s_l + al * c_l; o[2 * e + 1] = lo ? ah * c_h - bh_ * s_h : bh_ * s_h + ah * c_h; }
}
DI bf16x8 rope_frag32(const bf16* qrow, int s, int h, const float* cs, const float* sn) {
    float o[8]; rope_piece(qrow, 2 * s + h, cs, sn, o);
    u32x4 w; w.x = pk2(o[0], o[1]); w.y = pk2(o[2], o[3]); w.z = pk2(o[4], o[5]); w.w = pk2(o[6], o[7]); return __builtin_bit_cast(bf16x8, w);
}
constexpr size_t DA_DIN = 0, DA_CQN = 64 * MiB, DA_LATC = 80 * MiB, DA_KPE = 88 * MiB, DA_KIDX = 90 * MiB, DA_WIDX = 94 * MiB, DA_QL = 96 * MiB, DA_QPE = 352 * MiB, DA_QIDX = 400 * MiB,
                 DA_SEL = 464 * MiB, DA_CNT = 472 * MiB, DA_SC = 474 * MiB, DA_O2 = 474 * MiB;
constexpr size_t DW_W1 = 0, DW_W2 = (size_t)1024 * 2048, DW_WO = DW_W2 + (size_t)11776 * 512, DW_BD = DW_WO + (size_t)2048 * 4096;
constexpr float DSA_QSCALE = 0.07216878364870322f * LOG2E;
constexpr float DSA_WIDX_SCALE = 0.25f * 0.08838834764831845f;

DI void ph_dsa_cvt(const Frame& F, const float* w_in, const float* w_qup, const float* w_uk, const float* w_uv, const float* w_out) {
    bf16* WB = (bf16*)(F.ws + WS_WMIX);
    cvt_job(F, w_in, 960, DM, 0, 960, WB + DW_W1, DM, 0, 1.f);
    zero_bf16(F, WB + DW_W1 + (size_t)960 * DM, (size_t)64 * DM);
    { LAS float* scr = (LAS float*)(F.lds + F.wave * 16384);
      for (int it = F.gw; it < 32 * 16; it += F.NGW) { const int h = it >> 4; cvt_item(w_qup, 8192, h * 192, 48, WB + DW_W2, 512, 8192 + h * 48, DSA_QSCALE, scr, it & 15, 2, F.lane); } }
    cvt_job(F, w_qup, 8192, 512, 6144, 2048, WB + DW_W2, 512, 9728, 1.f);
    __syncthreads();
    {
        LAS float* As = (LAS float*)F.lds; LAS float* Bs = As + 64 * 145;
        for (int u = blockIdx.x; u < 32 * 4 * 8; u += F.G) {
            const int h = u >> 5, r0 = ((u >> 3) & 3) * 64, k0 = (u & 7) * 64;
            for (int i = F.tid; i < 64 * 144; i += NWAVES * 64) { const int row = i / 144, col = i - row * 144;
                As[row * 145 + col] = w_uk[(size_t)(h * 256 + r0) * 144 + i]; Bs[row * 145 + col] = w_qup[(size_t)(k0 + row) * 8192 + h * 192 + 48 + col]; }
            __syncthreads();
            const int r = F.tid & 63, kg = F.tid >> 6; float acc[8];
#pragma unroll
            for (int j = 0; j < 8; ++j) acc[j] = 0.f;
            for (int n = 0; n < 144; ++n) { const float a = As[r * 145 + n];
#pragma unroll
                for (int j = 0; j < 8; ++j) acc[j] += a * Bs[(kg * 8 + j) * 145 + n]; }
            u32x4 o; o.x = pk2(acc[0] * DSA_QSCALE, acc[1] * DSA_QSCALE); o.y = pk2(acc[2] * DSA_QSCALE, acc[3] * DSA_QSCALE); o.z = pk2(acc[4] * DSA_QSCALE, acc[5] * DSA_QSCALE); o.w = pk2(acc[6] * DSA_QSCALE, acc[7] * DSA_QSCALE);
            *(u32x4*)(WB + DW_W2 + (size_t)(h * 256 + r0 + r) * 512 + k0 + kg * 8) = o;
            __syncthreads();
        }
    }
    { LAS float* scr = (LAS float*)(F.lds + F.wave * 16384);
      for (int it = F.gw; it < 32 * 16; it += F.NGW) { const int h = it >> 4; cvt_item(w_uv + (size_t)h * 256 * 128, 128, 0, 128, WB + DW_BD + (h & 1) * 256, 512, h * 128, 1.f, scr, it & 15, 4, F.lane); } }
    { const size_t gt = (size_t)blockIdx.x * (NWAVES * 64) + F.tid, NT = (size_t)F.G * NWAVES * 64;
      for (size_t i = gt; i < (size_t)4096 * 32; i += NT) { const int row = (int)(i >> 5), pc = (int)(i & 31); *(u32x4*)(WB + DW_BD + (size_t)row * 512 + (1 - ((row >> 7) & 1)) * 256 + pc * 8) = (u32x4){0u, 0u, 0u, 0u}; } }
    cvt_job(F, w_out, DM, 4096, 0, DM, WB + DW_WO, 4096, 0, 1.f);
}
DI void ph_dsa_post1(const Frame& F, int half, const float* qn, const float* kvn, const float* lng, const float* lnb) {
    unsigned char* ar = F.ws + WS_AR;
    const float* DIN = (const float*)(ar + DA_DIN); bf16* CQN = (bf16*)(ar + DA_CQN); bf16* LATC = (bf16*)(ar + DA_LATC); bf16* KPE = (bf16*)(ar + DA_KPE); bf16* KIDX = (bf16*)(ar + DA_KIDX); float* WIDX = (float*)(ar + DA_WIDX);
    const float* c48 = (const float*)(F.ws + TAB_COS48); const float* s48 = (const float*)(F.ws + TAB_SIN48); const float* c32 = (const float*)(F.ws + TAB_COS32); const float* s32 = (const float*)(F.ws + TAB_SIN32);
    LAS float* buf = (LAS float*)(F.lds + F.wave * 1024);
    const int lane = F.lane;
    for (int ml = F.gw; ml < MC; ml += F.NGW) {
        const int mg = half * MC + ml;
        const size_t kfb = ((size_t)(ml >> 5) * 8 * 64 + (ml & 31)) * 8;
        const float* row = DIN + (size_t)ml * 1024 + 16 * lane;
        f32x4 v[4]; float ss = 0.f, s1 = 0.f;
#pragma unroll
        for (int j = 0; j < 4; ++j) { v[j] = *(const f32x4*)(row + 4 * j); ss += (v[j].x * v[j].x + v[j].y * v[j].y) + (v[j].z * v[j].z + v[j].w * v[j].w); s1 += (v[j].x + v[j].y) + (v[j].z + v[j].w); }
        const bool isq = lane < 32, iskv = lane >= 32 && lane < 48, ispe = lane >= 48 && lane < 51, isix = lane >= 51 && lane < 59;
        const float ssq = wave_sum(isq ? ss : 0.f), sskv = wave_sum(iskv ? ss : 0.f), mean = wave_sum(isix ? s1 : 0.f) * (1.f / 128.f);
        float d2 = 0.f;
#pragma unroll
        for (int j = 0; j < 4; ++j) { const f32x4 d = v[j] - mean; d2 += (d.x * d.x + d.y * d.y) + (d.z * d.z + d.w * d.w); }
        const float var = wave_sum(isix ? d2 : 0.f) * (1.f / 128.f);
        const float rq = 1.0f / sqrtf(ssq * (1.f / 512.f) + NORM_EPS), rkv = 1.0f / sqrtf(sskv * (1.f / 256.f) + NORM_EPS), rstd = 1.0f / sqrtf(var + NORM_EPS);
        if (isq || iskv) {
            const float* gp = isq ? qn + 16 * lane : kvn + 16 * (lane - 32); const float rs = isq ? rq : rkv;
            bf16* dst = isq ? CQN + (size_t)ml * 512 + 16 * lane : LATC + (size_t)ml * 256 + 16 * (lane - 32);
            u32x4 o[2];
#pragma unroll
            for (int j = 0; j < 4; ++j) { const f32x4 g = *(const f32x4*)(gp + 4 * j); const f32x4 y = v[j] * rs * g; o[j >> 1][(j & 1) * 2] = pk2(y.x, y.y); o[j >> 1][(j & 1) * 2 + 1] = pk2(y.z, y.w); }
            *(u32x4*)dst = o[0]; *(u32x4*)(dst + 8) = o[1];
        } else if (ispe) {
#pragma unroll
            for (int j = 0; j < 4; ++j) *(LAS f32x4*)(buf + (lane - 48) * 16 + 4 * j) = v[j];
        } else if (isix) {
#pragma unroll
            for (int j = 0; j < 4; ++j) { const f32x4 g = *(const f32x4*)(lng + (lane - 51) * 16 + 4 * j), b = *(const f32x4*)(lnb + (lane - 51) * 16 + 4 * j); *(LAS f32x4*)(buf + 48 + (lane - 51) * 16 + 4 * j) = (v[j] - mean) * rstd * g + b; }
        } else if (lane == 59) {
#pragma unroll
            for (int j = 0; j < 4; ++j) *(f32x4*)(WIDX + (size_t)ml * 16 + 4 * j) = v[j] * DSA_WIDX_SCALE;
        }
        LDS_WAIT();
        if (lane < 24) { const float x1 = buf[lane], x2 = buf[24 + lane], c = c48[(size_t)mg * 24 + lane], s = s48[(size_t)mg * 24 + lane];
            KPE[(size_t)ml * 48 + lane] = f2bf(x1 * c - x2 * s); KPE[(size_t)ml * 48 + 24 + lane] = f2bf(x1 * s + x2 * c);
        } else if (lane < 40) { const int i = lane - 24; const float x1 = buf[48 + i], x2 = buf[48 + 16 + i], c = c32[(size_t)mg * 16 + i], s = s32[(size_t)mg * 16 + i];
            KIDX[kfb + (size_t)((i >> 3) * 32) * 8 + (i & 7)] = f2bf(x1 * c - x2 * s); KIDX[kfb + (size_t)(64 + (i >> 3) * 32) * 8 + (i & 7)] = f2bf(x1 * s + x2 * c);
        } else { const int d = 32 + 4 * (lane - 40); const f32x4 y = *(const LAS f32x4*)(buf + 48 + d); u32x2 w; w.x = pk2(y.x, y.y); w.y = pk2(y.z, y.w); *(u32x2*)(KIDX + kfb + (size_t)((d >> 4) * 64 + ((d >> 3) & 1) * 32) * 8 + (d & 7)) = w; }
        LDS_WAIT();
    }
}
DI int wave_iscan_dpp(int v) {
    v += __builtin_amdgcn_update_dpp(0, v, 0x111, 0xf, 0xf, true); v += __builtin_amdgcn_update_dpp(0, v, 0x112, 0xf, 0xf, true);
    v += __builtin_amdgcn_update_dpp(0, v, 0x114, 0xf, 0xf, true); v += __builtin_amdgcn_update_dpp(0, v, 0x118, 0xf, 0xf, true);
    v += __builtin_amdgcn_update_dpp(0, v, 0x142, 0xa, 0xf, false);
    v += __builtin_amdgcn_update_dpp(0, v, 0x143, 0xc, 0xf, false);
    return v;
}
DI int wave_isum_dpp(int v) {
    v += __builtin_amdgcn_update_dpp(0, v, 0x111, 0xf, 0xf, true); v += __builtin_amdgcn_update_dpp(0, v, 0x112, 0xf, 0xf, true);
    v += __builtin_amdgcn_update_dpp(0, v, 0x114, 0xf, 0xf, true); v += __builtin_amdgcn_update_dpp(0, v, 0x118, 0xf, 0xf, true);
    v += __builtin_amdgcn_update_dpp(0, v, 0x142, 0xa, 0xf, false);
    v += __builtin_amdgcn_update_dpp(0, v, 0x143, 0xc, 0xf, false);
    return __builtin_amdgcn_readlane(v, 63);
}
DI unsigned f2sortable(float s) { const unsigned b = __builtin_bit_cast(unsigned, s); return (b & 0x80000000u) ? ~b : (b | 0x80000000u); }
DI void ph_dsa_index(const Frame& F, const int half) {
    const float* c32 = (const float*)(F.ws + TAB_COS32); const float* s32 = (const float*)(F.ws + TAB_SIN32);
    unsigned char* ar = F.ws + WS_AR;
    const bf16* QIDX = (const bf16*)(ar + DA_QIDX); const bf16* KIDX = (const bf16*)(ar + DA_KIDX); const float* WIDX = (const float*)(ar + DA_WIDX);
    unsigned short* SEL = (unsigned short*)(ar + DA_SEL); int* CNT = (int*)(ar + DA_CNT); float* SC = (float*)(ar + DA_SC) + (size_t)F.gw * 16384;
    const int lane = F.lane, r = lane & 31, hf = lane >> 5;
    LAS unsigned char* wl = F.lds + F.wave * 8192 + lane * 16;
    LAS unsigned* hist = (LAS unsigned*)(F.lds + 65536 + F.wave * 1024);
#pragma unroll 1
    for (int tile = blockIdx.x; tile < BPH * 128; tile += F.G) {
        const int j = tile >> 8, c8 = tile & 255, c7 = c8 & 127, bl = (c8 >> 7) * 2 + j, qt = j ? 127 - c7 : c7;
        const int q0 = qt * 32 + 4 * F.wave;
        const int ntile = (q0 + 3) / 32 + 1;
        bf16x8 qa[2][8];
#pragma unroll
        for (int pr = 0; pr < 2; ++pr) {
            const int mrow = bl * SEQ + q0 + 2 * pr + (r >> 4);
#pragma unroll
            for (int s = 0; s < 8; ++s) qa[pr][s] = *(const bf16x8*)(QIDX + (size_t)mrow * 2048 + (r & 15) * 128 + 16 * s + 8 * hf);
            { const float* cs = c32 + ((size_t)half * MC + mrow) * 16 + 8 * hf; const float* sn = s32 + ((size_t)half * MC + mrow) * 16 + 8 * hf;
              const f32x4 c0 = *(const f32x4*)cs, c1 = *(const f32x4*)(cs + 4), s0 = *(const f32x4*)sn, s1 = *(const f32x4*)(sn + 4);
              const u32x4 a = __builtin_bit_cast(u32x4, qa[pr][0]), b = __builtin_bit_cast(u32x4, qa[pr][1]); u32x4 o1, o2;
#pragma unroll
              for (int e = 0; e < 4; ++e) { const float c_l = e < 2 ? c0[2 * e] : c1[2 * e - 4], c_h = e < 2 ? c0[2 * e + 1] : c1[2 * e - 3], s_l = e < 2 ? s0[2 * e] : s1[2 * e - 4], s_h = e < 2 ? s0[2 * e + 1] : s1[2 * e - 3];
                  const float x1l = bflo(a[e]), x1h = bfhi(a[e]), x2l = bflo(b[e]), x2h = bfhi(b[e]);
                  o1[e] = pk2(x1l * c_l - x2l * s_l, x1h * c_h - x2h * s_h); o2[e] = pk2(x1l * s_l + x2l * c_l, x1h * s_h + x2h * c_h); }
              qa[pr][0] = __builtin_bit_cast(bf16x8, o1); qa[pr][1] = __builtin_bit_cast(bf16x8, o2); }
            float wv[2][16];
#pragma unroll
            for (int i = 0; i < 16; ++i) wv[pr][i] = WIDX[(size_t)(bl * SEQ + q0 + 2 * pr + (i >> 3)) * 16 + (i & 3) + 8 * ((i >> 2) & 1) + 4 * hf];
#pragma unroll
            for (int i = 0; i < 16; i += 4) *(LAS f32x4*)(wl + (pr * 4 + (i >> 2)) * 1024) = (f32x4){wv[pr][i], wv[pr][i + 1], wv[pr][i + 2], wv[pr][i + 3]};
        }
        LDS_WAIT();
        {
        bf16x8 kf[8];
        { const bf16* kp = KIDX + ((size_t)(bl * 128) * 8 * 64 + lane) * 8;
#pragma unroll
          for (int s = 0; s < 8; ++s) kf[s] = *(const bf16x8*)(kp + 512 * s); }
#pragma unroll 1
        for (int t = 0; t < ntile; ++t) {
            f32x16 accs[2];
#pragma unroll
            for (int pr = 0; pr < 2; ++pr) {
#pragma unroll
                for (int i = 0; i < 16; ++i) accs[pr][i] = 0.f;
#pragma unroll
                for (int s = 0; s < 8; ++s) accs[pr] = MFMA32(qa[pr][s], kf[s], accs[pr]);
            }
            if (t + 1 < ntile) { const bf16* kp = KIDX + ((size_t)(bl * 128 + t + 1) * 8 * 64 + lane) * 8;
#pragma unroll
                for (int s = 0; s < 8; ++s) kf[s] = *(const bf16x8*)(kp + 512 * s); }
#pragma unroll
            for (int pr = 0; pr < 2; ++pr) {
                const f32x16 acc = accs[pr];
                float wv[2][16];
                { unsigned wa_ = (unsigned)(size_t)wl; asm volatile("" : "+v"(wa_));
#pragma unroll
                  for (int i = 0; i < 16; i += 4) { const f32x4 w4 = *(const LAS f32x4*)((LAS unsigned char*)(size_t)wa_ + (pr * 4 + (i >> 2)) * 1024); wv[pr][i] = w4.x; wv[pr][i + 1] = w4.y; wv[pr][i + 2] = w4.z; wv[pr][i + 3] = w4.w; } }
                float p0 = 0.f, p1 = 0.f;
#pragma unroll
                for (int i = 0; i < 8; ++i) { p0 += wv[pr][i] * fmaxf(acc[i], 0.f); p1 += wv[pr][8 + i] * fmaxf(acc[8 + i], 0.f); }
                const float t0 = p0 + __shfl_xor(p0, 32), t1 = p1 + __shfl_xor(p1, 32);
                SC[(pr * 128 + t) * 64 + lane] = hf ? t1 : t0;
            }
        }
        }
        VM_WAIT();
#pragma unroll 1
        for (int qi = 0; qi < 4; ++qi) {
            const int tq = q0 + qi, pr = qi >> 1, qs = qi & 1;
            unsigned u[64];
            const unsigned* scp = (const unsigned*)(SC + pr * 8192 + hf * 64 + qs * 32 + r);
#pragma unroll
            for (int g8 = 0; g8 < 8; ++g8) {
#pragma unroll
                for (int e = 0; e < 8; ++e) { const int i = 8 * g8 + e; const float s = __builtin_bit_cast(float, __hip_atomic_load(scp + e * 128, __ATOMIC_RELAXED, __HIP_MEMORY_SCOPE_AGENT));
                    u[i] = (2 * i + hf < ntile && 64 * i + lane <= tq) ? f2sortable(s) : 0u; }
                scp += 1024; asm volatile("" : "+v"(scp));
            }
            unsigned prefix = 0u;
            if (tq >= 256) {
#pragma unroll 1
                for (int bit = 31; bit >= 0; --bit) {
                    const unsigned cand = prefix | (1u << bit); int c = 0;
#pragma unroll
                    for (int g8 = 0; g8 < 8; ++g8) { if (g8 * 512 <= tq) {
#pragma unroll
                        for (int e = 0; e < 8; ++e) c += (u[8 * g8 + e] >= cand) ? 1 : 0; } }
                    c = wave_isum_dpp(c);
                    if (c >= 256) prefix = cand;
                    if (c == 256) break;
                }
            }
            const unsigned T = prefix > 1u ? prefix : 1u;
            int nl = 0;
#pragma unroll
            for (int g8 = 0; g8 < 8; ++g8) { if (g8 * 512 <= tq) {
#pragma unroll
                for (int e = 0; e < 8; ++e) nl += (u[8 * g8 + e] >= T) ? 1 : 0; } }
            const int inc = wave_iscan_dpp(nl), base = __builtin_amdgcn_readlane(inc, 63);
            int pos = inc - nl;
            unsigned short* sel = SEL + (size_t)(bl * SEQ + tq) * 256;
#pragma unroll
            for (int g8 = 0; g8 < 8; ++g8) { if (g8 * 512 <= tq) {
#pragma unroll
                for (int e = 0; e < 8; ++e) { const int i = 8 * g8 + e; if (u[i] >= T) { if (pos < 256) sel[pos] = (unsigned short)(64 * i + lane); ++pos; } } } }
            if (lane == 0) CNT[bl * SEQ + tq] = base < 256 ? base : 256;
        }
    }
}
DI int dsa_fsw(int row) { return ((row & 3) << 2) | ((row >> 2) & 3); }
struct DsaPre { u32x4 row[16]; bf16x8 kpe[3]; bf16x8 q[3]; };
DI void dsa_prefetch(DsaPre& P, const bf16* LATC, const bf16* KPE, const bf16* QL, const bf16* QPE, const float* c48, const float* s48, int half, int ml, int selv, int lane, int w) {
    const int bl = ml >> 12, r = lane & 31, h = lane >> 5;
#pragma unroll
    for (int it = 0; it < 16; ++it) { const int ki = __shfl(selv, (lane >> 5) + 2 * it); P.row[it] = *(const u32x4*)(LATC + (size_t)(bl * SEQ + ki) * 256 + (lane & 31) * 8); }
#pragma unroll
    for (int s = 0; s < 3; ++s) P.kpe[s] = *(const bf16x8*)(KPE + (size_t)(bl * SEQ + selv) * 48 + 16 * s + 8 * h);
#pragma unroll
    for (int j = 0; j < 3; ++j) { const int fi = w + 8 * j;
        if (fi < 16) P.q[j] = *(const bf16x8*)(QL + (size_t)ml * 8192 + r * 256 + 16 * fi + 8 * h);
        else if (fi < 19) P.q[j] = rope_frag32(QPE + (size_t)ml * 1536 + r * 48, fi - 16, h, c48 + ((size_t)half * MC + ml) * 24, s48 + ((size_t)half * MC + ml) * 24); }
}
DI void ph_dsa_attn(const Frame& F, const int half) {
    const float* c48 = (const float*)(F.ws + TAB_COS48); const float* s48 = (const float*)(F.ws + TAB_SIN48);
    unsigned char* ar = F.ws + WS_AR;
    bf16* QL = (bf16*)(ar + DA_QL); const bf16* QPE = (const bf16*)(ar + DA_QPE); const bf16* LATC = (const bf16*)(ar + DA_LATC); const bf16* KPE = (const bf16*)(ar + DA_KPE);
    const unsigned short* SEL = (const unsigned short*)(ar + DA_SEL); const int* CNT = (const int*)(ar + DA_CNT);
    const int lane = F.lane, r = lane & 31, h = lane >> 5, w = F.wave;
    LAS unsigned char* IMG = F.lds; LAS unsigned char* QB = F.lds + LDSCTL_OFF + 256; LAS float* MX = (LAS float*)(F.lds + LDSCTL_OFF + 256 + 19456); LAS float* SX = MX + 256;
    const int i16 = lane & 15, tq_ = i16 >> 2, tp_ = i16 & 3, blk = (lane >> 4) & 1;
    int ml = blockIdx.x;
    if (ml >= MC) return;
    DsaPre P;
    int cnt_c = CNT[ml];
    { const int slot = 32 * w + r; const int selv = slot < cnt_c ? (int)SEL[(size_t)ml * 256 + slot] : 0; dsa_prefetch(P, LATC, KPE, QL, QPE, c48, s48, half, ml, selv, lane, w); }
    int cnt_n = 0, selv_n = 0;
    if (ml + F.G < MC) { cnt_n = CNT[ml + F.G]; const int slot = 32 * w + r; selv_n = slot < cnt_n ? (int)SEL[(size_t)(ml + F.G) * 256 + slot] : 0; }
#pragma unroll 1
    for (; ml < MC; ml += F.G) {
        const int cnt = cnt_c, nch = (cnt + 31) >> 5; const bool act = w < nch;
#pragma unroll
        for (int it = 0; it < 16; ++it) { const int rr = (lane >> 5) + 2 * it; *(LAS u32x4*)(IMG + (32 * w + rr) * 512 + (((lane & 31) ^ dsa_fsw(rr)) * 16)) = P.row[it]; }
#pragma unroll
        for (int j = 0; j < 3; ++j) { const int fi = w + 8 * j; if (fi < 19) *(LAS bf16x8*)(QB + fi * 1024 + lane * 16) = P.q[j]; }
        bf16x8 kpe[3];
#pragma unroll
        for (int s = 0; s < 3; ++s) kpe[s] = P.kpe[s];
        LDS_WAIT(); __builtin_amdgcn_s_barrier(); asm volatile("" ::: "memory");
        if (ml + F.G < MC) {
            dsa_prefetch(P, LATC, KPE, QL, QPE, c48, s48, half, ml + F.G, selv_n, lane, w); cnt_c = cnt_n;
            if (ml + 2 * F.G < MC) { cnt_n = CNT[ml + 2 * F.G]; const int slot = 32 * w + r; selv_n = slot < cnt_n ? (int)SEL[(size_t)(ml + 2 * F.G) * 256 + slot] : 0; }
        }
        f32x16 S; float mx = -INFINITY;
#pragma unroll
        for (int i = 0; i < 16; ++i) S[i] = 0.f;
        if (act) {
#pragma unroll
            for (int s = 0; s < 16; ++s) S = MFMA32(*(const LAS bf16x8*)(IMG + (32 * w + r) * 512 + (((2 * s + h) ^ dsa_fsw(r)) * 16)), *(const LAS bf16x8*)(QB + s * 1024 + lane * 16), S);
#pragma unroll
            for (int s = 0; s < 3; ++s) S = MFMA32(kpe[s], *(const LAS bf16x8*)(QB + (16 + s) * 1024 + lane * 16), S);
#pragma unroll
            for (int i = 0; i < 16; ++i) { S[i] = (32 * w + crow(i, h) < cnt) ? S[i] : -INFINITY; mx = fmaxf(mx, S[i]); }
            mx = fmaxf(mx, __shfl_xor(mx, 32));
        }
        if (h == 0) MX[w * 32 + r] = mx;
        LDS_WAIT(); __builtin_amdgcn_s_barrier(); asm volatile("" ::: "memory");
        float M = MX[r];
#pragma unroll
        for (int k = 1; k < 8; ++k) M = fmaxf(M, MX[k * 32 + r]);
        float lsum = 0.f; bf16x8 pf[2] = {(bf16x8){0, 0, 0, 0, 0, 0, 0, 0}, (bf16x8){0, 0, 0, 0, 0, 0, 0, 0}};
        if (act) {
#pragma unroll
            for (int i = 0; i < 16; ++i) { S[i] = __builtin_amdgcn_exp2f(S[i] - M); lsum += S[i]; }
#pragma unroll
            for (int s = 0; s < 2; ++s) { u32x4 t; t.x = pk2(S[8 * s], S[8 * s + 1]); t.y = pk2(S[8 * s + 2], S[8 * s + 3]); t.z = pk2(S[8 * s + 4], S[8 * s + 5]); t.w = pk2(S[8 * s + 6], S[8 * s + 7]); pf[s] = __builtin_bit_cast(bf16x8, t); }
        }
        lsum += __shfl_xor(lsum, 32);
        if (h == 0) SX[w * 32 + r] = lsum;
        *(LAS bf16x8*)(QB + (2 * w) * 1024 + lane * 16) = pf[0]; *(LAS bf16x8*)(QB + (2 * w + 1) * 1024 + lane * 16) = pf[1];
        LDS_WAIT(); __builtin_amdgcn_s_barrier(); asm volatile("" ::: "memory");
        f32x16 O;
#pragma unroll
        for (int i = 0; i < 16; ++i) O[i] = 0.f;
#pragma unroll 2
        for (int ks = 0; ks < 2 * nch; ++ks) {
            const int r0 = 16 * ks + 4 * h + tq_, r1 = r0 + 8, pc = 4 * w + 2 * blk + (tp_ >> 1);
            const s16x4 lo = __builtin_bit_cast(s16x4, __builtin_amdgcn_ds_read_tr16_b64_v4i16((LAS v4i16_t*)(IMG + r0 * 512 + ((pc ^ dsa_fsw(r0)) * 16) + 8 * (tp_ & 1))));
            const s16x4 hi = __builtin_bit_cast(s16x4, __builtin_amdgcn_ds_read_tr16_b64_v4i16((LAS v4i16_t*)(IMG + r1 * 512 + ((pc ^ dsa_fsw(r1)) * 16) + 8 * (tp_ & 1))));
            O = MFMA32(__builtin_shufflevector(lo, hi, 0, 1, 2, 3, 4, 5, 6, 7), *(const LAS bf16x8*)(QB + ks * 1024 + lane * 16), O);
        }
        float l = SX[r];
#pragma unroll
        for (int k = 1; k < 8; ++k) l += SX[k * 32 + r];
        const float linv = 1.0f / l;
        bf16* o = QL + (size_t)ml * 8192 + r * 256 + 32 * w + 4 * h;
#pragma unroll
        for (int g = 0; g < 4; ++g) { u32x2 t; t.x = pk2(O[4 * g] * linv, O[4 * g + 1] * linv); t.y = pk2(O[4 * g + 2] * linv, O[4 * g + 3] * linv); *(u32x2*)(o + 8 * g) = t; }
        LDS_WAIT(); __builtin_amdgcn_s_barrier(); asm volatile("" ::: "memory");
    }
}
template <int NDB, bool RESC = true> DI void softmax_step(f32x16& S, float& m, float& l, f32x16 (&O)[NDB], bf16x8 (&pf)[2]) {
    float mx = fmaxf(S[0], S[1]);
#pragma unroll
    for (int i = 2; i < 16; i += 2) mx = __builtin_fmaxf(mx, __builtin_fmaxf(S[i], S[i + 1]));
    mx = fmaxf(mx, __shfl_xor(mx, 32));
    const float mn = fmaxf(m, mx), ms = (mn == -INFINITY) ? 0.f : mn;
    const float alpha = __builtin_amdgcn_exp2f(m - ms);
    float sum = 0.f;
#pragma unroll
    for (int i = 0; i < 16; ++i) { S[i] = __builtin_amdgcn_exp2f(S[i] - ms); sum += S[i]; }
    l = l * alpha + sum; m = mn;
    if (RESC && __builtin_amdgcn_ballot_w64(alpha != 1.0f) != 0ull) {
#pragma unroll
        for (int db = 0; db < NDB; ++db)
#pragma unroll
            for (int i = 0; i < 16; ++i) O[db][i] *= alpha;
    }
#pragma unroll
    for (int s = 0; s < 2; ++s) { u32x4 w; w.x = pk2(S[8 * s], S[8 * s + 1]); w.y = pk2(S[8 * s + 2], S[8 * s + 3]); w.z = pk2(S[8 * s + 4], S[8 * s + 5]); w.w = pk2(S[8 * s + 6], S[8 * s + 7]); pf[s] = __builtin_bit_cast(bf16x8, w); }
}
template <bool ACC> DI void store_col(bf16* out, const f32x16 (&O)[4], float scale, int h) {
#pragma unroll
    for (int db = 0; db < 4; ++db)
#pragma unroll
        for (int g = 0; g < 4; ++g) { u32x2* p = (u32x2*)(out + db * 32 + 8 * g + 4 * h);
            float a = O[db][4 * g] * scale, b = O[db][4 * g + 1] * scale, c = O[db][4 * g + 2] * scale, d = O[db][4 * g + 3] * scale;
            if (ACC) { const u32x2 o = *p; a += bflo(o.x); b += bfhi(o.x); c += bflo(o.y); d += bfhi(o.y); }
            u32x2 w; w.x = pk2(a, b); w.y = pk2(c, d); *p = w; }
}
template <int NQ> struct TilePre { u32x4 a, b, c; };
template <int NQ, class SRC> DI void tile_fetch(TilePre<NQ>& p, const SRC& src, int T, int tid) {
    const bf16* k = src.k(T); const bf16* v = src.v(T);
    constexpr int NK = NQ * 64;
    p.a = *(const u32x4*)(k + (size_t)tid * 8);
    const int p1 = tid + 512; p.b = (p1 < NK) ? *(const u32x4*)(k + (size_t)p1 * 8) : *(const u32x4*)(v + (size_t)(p1 - NK) * 8);
    if (NQ * 64 + 512 > 1024) { const int p2 = tid + 1024; if (p2 < NK + 512) p.c = *(const u32x4*)(v + (size_t)(p2 - NK) * 8); }
}
template <int NQ> DI void tile_put(const TilePre<NQ>& p, LAS unsigned char* buf, int tid) {
    *(LAS u32x4*)(buf + tid * 16) = p.a; *(LAS u32x4*)(buf + (tid + 512) * 16) = p.b;
    if (NQ * 64 + 512 > 1024) { if (tid + 1024 < NQ * 64 + 512) *(LAS u32x4*)(buf + (tid + 1024) * 16) = p.c; }
}
template <int NQ, bool PV, class SRC, class MK>
DI void attn_run_sh(LAS unsigned char* tl, int tid, int lane, const bf16x8 (&qf)[NQ], f32x16 (&O)[4], float& m, float& l, int TB, int TE, int tb, int te, const SRC& src, const MK& mk) {
    constexpr int TBYTES = (NQ + 8) * 1024;
    if (TB >= TE) return;
    TilePre<NQ> pre;
    tile_fetch<NQ>(pre, src, TB, tid); tile_put<NQ>(pre, tl, tid);
    LDS_WAIT(); __builtin_amdgcn_s_barrier(); asm volatile("" ::: "memory");
#pragma unroll 1
    for (int T = TB; T < TE; ++T) {
        LAS unsigned char* cur = tl + ((T - TB) & 1) * TBYTES;
        if (T + 1 < TE) tile_fetch<NQ>(pre, src, T + 1, tid);
        if (T >= tb && T < te) {
            f32x16 S;
#pragma unroll
            for (int i = 0; i < 16; ++i) S[i] = 0.f;
#pragma unroll
            for (int s = 0; s < NQ; ++s) S = MFMA32(*(const LAS bf16x8*)(cur + s * 1024 + lane * 16), qf[s], S);
            if (mk.need(T)) mk(T, S);
            bf16x8 pf[2]; softmax_step<4, PV>(S, m, l, O, pf);
            if (PV) {
#pragma unroll
                for (int db = 0; db < 4; ++db)
#pragma unroll
                    for (int s = 0; s < 2; ++s) O[db] = MFMA32(*(const LAS bf16x8*)(cur + (NQ + db * 2 + s) * 1024 + lane * 16), pf[s], O[db]);
            }
        }
        if (T + 1 < TE) tile_put<NQ>(pre, tl + ((T + 1 - TB) & 1) * TBYTES, tid);
        LDS_WAIT(); __builtin_amdgcn_s_barrier(); asm volatile("" ::: "memory");
    }
}
struct FragSrc { const bf16* kb; const bf16* vb; int nq; DI const bf16* k(int T) const { return kb + (size_t)T * nq * 512; } DI const bf16* v(int T) const { return vb + (size_t)T * 8 * 512; } };
constexpr size_t FA_Q = 0, FA_K = 64 * MiB, FA_F = 128 * MiB, FA_V = 136 * MiB, FA_CUM = 200 * MiB, FA_O = 202 * MiB, FA_KF = 266 * MiB, FA_VF = 338 * MiB;
constexpr size_t FW_IN = 0, FW_OUT = (size_t)6400 * 2048;
constexpr float FOX_QSCALE = 0.08838834764831845f * LOG2E;
DI void ph_fox_cvt(const Frame& F, const float* w_in, const float* w_out) {
    bf16* WB = (bf16*)(F.ws + WS_WMIX);
    cvt_job(F, w_in, 6160, DM, 0, 2048, WB + FW_IN, DM, 0, FOX_QSCALE);
    cvt_job(F, w_in, 6160, DM, 2048, 2048, WB + FW_IN, DM, 2048, 1.f);
    cvt_job(F, w_in, 6160, DM, 4096, 2048, WB + FW_IN, DM, 4096, 1.f);
    cvt_job(F, w_in, 6160, DM, 6144, 16, WB + FW_IN, DM, 6144, 1.f);
    zero_bf16(F, WB + FW_IN + (size_t)6160 * DM, (size_t)240 * DM);
    cvt_job(F, w_out, DM, DM, 0, DM, WB + FW_OUT, DM, 0, 1.f);
}
DI void ph_fox_scan(const Frame& F, const float* b_f) {
    unsigned char* ar = F.ws + WS_AR; const bf16* FB = (const bf16*)(ar + FA_F); float* CUM = (float*)(ar + FA_CUM);
    for (int w = F.gw; w < BPH * 16; w += F.NGW) {
        const int bl = w >> 4, hd = w & 15; const float bf_ = b_f[hd];
        float v[64]; float run = 0.f;
#pragma unroll
        for (int i = 0; i < 64; ++i) { const float x = bf2f(FB[(size_t)(bl * SEQ + F.lane * 64 + i) * 256 + hd]) + bf_;
            const float ls = fminf(x, 0.f) - log1pf(expf(-fabsf(x))); run += ls; v[i] = run; }
        float inc = run;
#pragma unroll
        for (int o = 1; o < 64; o <<= 1) { const float y = __shfl_up(inc, o); if (F.lane >= o) inc += y; }
        const float base = inc - run;
        float* dst = CUM + (size_t)w * SEQ + F.lane * 64;
#pragma unroll
        for (int i = 0; i < 64; i += 4) *(f32x4*)(dst + i) = (f32x4){(v[i] + base) * LOG2E, (v[i + 1] + base) * LOG2E, (v[i + 2] + base) * LOG2E, (v[i + 3] + base) * LOG2E};
        bf16* KF9 = (bf16*)(ar + FA_KF) + (size_t)w * 128 * 9 * 512;
#pragma unroll
        for (int i = 0; i < 64; ++i) { const int p = F.lane * 64 + i, tile = p >> 5, r_ = p & 31; const float c = (v[i] + base) * LOG2E;
            const unsigned short hi = f2bf(c); const float c1 = c - bf2f(hi); const unsigned short mid = f2bf(c1); const unsigned short lo = f2bf(c1 - bf2f(mid));
            u32x4 wv; wv.x = 0x3F803F80u; wv.y = 0x3F80u | ((unsigned)(hi ^ 0x8000u) << 16); wv.z = (unsigned)(mid ^ 0x8000u) | ((unsigned)(lo ^ 0x8000u) << 16); wv.w = 0u;
            bf16* d = KF9 + ((size_t)(tile * 9 + 8) * 64 + r_) * 8;
            *(u32x4*)d = wv; *(u32x4*)(d + 32 * 8) = (u32x4){0u, 0u, 0u, 0u}; }
    }
    const bf16* Kr = (const bf16*)(ar + FA_K); const bf16* Vr = (const bf16*)(ar + FA_V); bf16* KF = (bf16*)(ar + FA_KF); bf16* VF = (bf16*)(ar + FA_VF);
    const int r = F.lane & 31, h = F.lane >> 5;
    for (int u = F.gw; u < BPH * 16 * 128; u += F.NGW) {
        const int bh = u >> 7, tile = u & 127, bl = bh >> 4, hd = bh & 15;
        const bf16* krow_ = Kr + ((size_t)bl * SEQ + tile * 32 + r) * DM + hd * 128 + 8 * h;
        bf16* kd = KF + (((size_t)bh * 128 + tile) * 9 * 64 + F.lane) * 8;
#pragma unroll
        for (int s = 0; s < 8; ++s) *(u32x4*)(kd + s * 512) = *(const u32x4*)(krow_ + 16 * s);
        bf16* vd = VF + (((size_t)bh * 128 + tile) * 8 * 64 + F.lane) * 8;
#pragma unroll
        for (int db = 0; db < 4; ++db)
#pragma unroll
            for (int s = 0; s < 2; ++s) { unsigned short e[8];
#pragma unroll
                for (int j = 0; j < 8; ++j) e[j] = Vr[((size_t)bl * SEQ + tile * 32 + 16 * s + 8 * (j >> 2) + 4 * h + (j & 3)) * DM + hd * 128 + db * 32 + r];
                u32x4 w; w.x = e[0] | ((unsigned)e[1] << 16); w.y = e[2] | ((unsigned)e[3] << 16); w.z = e[4] | ((unsigned)e[5] << 16); w.w = e[6] | ((unsigned)e[7] << 16);
                *(u32x4*)(vd + (db * 2 + s) * 512) = w; }
    }
}
struct FoxMK { int tq, h, qt; DI bool need(int t) const { return t == qt; }
    DI void operator()(int t, f32x16& S) const {
#pragma unroll
        for (int i = 0; i < 16; ++i) S[i] = (32 * t + crow(i, h) <= tq) ? S[i] : -INFINITY;
    } };
DI void ph_fox_attn(const Frame& F) {
    unsigned char* ar = F.ws + WS_AR; const bf16* Q = (const bf16*)(ar + FA_Q); const bf16* KF = (const bf16*)(ar + FA_KF); const bf16* VF = (const bf16*)(ar + FA_VF); const float* CUM = (const float*)(ar + FA_CUM); bf16* Ob = (bf16*)(ar + FA_O);
    const int r = F.lane & 31, h = F.lane >> 5;
    for (int wb = blockIdx.x; wb < BPH * 16 * 4; wb += F.G) {
        const int bh = wb >> 2, x = (wb & 3) * 8 + F.wave, bl = bh >> 4, hd = bh & 15;
#pragma unroll 1
        for (int k = 0; k < 4; ++k) {
            const int qt = (k == 0) ? x : (k == 1) ? 63 - x : (k == 2) ? 64 + x : 127 - x;
            const int qhi = (k == 0) ? (wb & 3) * 8 + 7 : (k == 1) ? 63 - (wb & 3) * 8 : (k == 2) ? 64 + (wb & 3) * 8 + 7 : 127 - (wb & 3) * 8;
            const int tq = qt * 32 + r; const size_t mrow = (size_t)bl * SEQ + tq;
            bf16x8 qf[9];
#pragma unroll
            for (int s = 0; s < 8; ++s) qf[s] = *(const bf16x8*)(Q + mrow * DM + hd * 128 + 16 * s + 8 * h);
            { const float ct = CUM[(size_t)bh * SEQ + tq]; const unsigned short hi = f2bf(ct); const float c1 = ct - bf2f(hi); const unsigned short mid = f2bf(c1); const unsigned short lo = f2bf(c1 - bf2f(mid));
              u32x4 wq; wq.x = (unsigned)hi | ((unsigned)mid << 16); wq.y = (unsigned)lo | (0x3F80u << 16); wq.z = 0x3F803F80u; wq.w = 0u;
              if (h) wq = (u32x4){0u, 0u, 0u, 0u};
              qf[8] = __builtin_bit_cast(bf16x8, wq); }
            f32x16 O[4];
#pragma unroll
            for (int db = 0; db < 4; ++db)
#pragma unroll
                for (int i = 0; i < 16; ++i) O[db][i] = 0.f;
            float m = -INFINITY, l = 0.f;
            const FragSrc src{KF + (size_t)bh * 128 * 9 * 512, VF + (size_t)bh * 128 * 8 * 512, 9}; const FoxMK mk{tq, h, qt};
            attn_run_sh<9, true>(F.lds, F.tid, F.lane, qf, O, m, l, 0, qhi + 1, 0, qt + 1, src, mk);
            l += __shfl_xor(l, 32);
            store_col<false>(Ob + mrow * DM + hd * 128, O, l > 0.f ? 1.0f / l : 0.f, h);
        }
    }
}
typedef long fp8x8_t;
DI fp8x8_t pack_fp8x8(float a0, float a1, float a2, float a3, float a4, float a5, float a6, float a7) {
    int lo = 0, hi = 0;
    lo = __builtin_amdgcn_cvt_pk_fp8_f32(a0, a1, lo, false); lo = __builtin_amdgcn_cvt_pk_fp8_f32(a2, a3, lo, true);
    hi = __builtin_amdgcn_cvt_pk_fp8_f32(a4, a5, hi, false); hi = __builtin_amdgcn_cvt_pk_fp8_f32(a6, a7, hi, true);
    return (fp8x8_t)(((unsigned long long)(unsigned)hi << 32) | (unsigned long long)(unsigned)lo);
}
#define MFMA32F8(a, b, c) __builtin_amdgcn_mfma_f32_32x32x16_fp8_fp8((a), (b), (c), 0, 0, 0)
constexpr size_t NA_Q = 0, NA_KC = 288 * MiB, NA_VC = 313 * MiB, NA_KSR = 330 * MiB, NA_KWR = 354 * MiB, NA_GT = 378 * MiB, NA_VSR = 386 * MiB, NA_VWR = 402 * MiB, NA_GK = 418 * MiB, NA_GV = 420 * MiB,
                 NA_KCMP = 422 * MiB, NA_VCT = 424 * MiB, NA_SELB = 426 * MiB, NA_O = 428 * MiB,
                 NA_KSF = 620 * MiB, NA_KWF = 644 * MiB, NA_VSF = 668 * MiB, NA_VWF = 684 * MiB;
constexpr size_t NW_IN = 0, NW_W1K = (size_t)13312 * 2048, NW_W1V = NW_W1K + (size_t)256 * 6144, NW_W2K = NW_W1V + (size_t)256 * 4096, NW_W2V = NW_W2K + 65536, NW_OUT = NW_W2V + 65536;
constexpr float NSA_QSCALE = 0.07216878364870322f * LOG2E;
DI void ph_nsa_cvt(const Frame& F, const float* w_in, const float* k_pe, const float* k_w1, const float* k_b1, const float* k_w2, const float* v_pe, const float* v_w1, const float* v_b1, const float* v_w2, const float* w_out) {
    bf16* WB = (bf16*)(F.ws + WS_WMIX); float* BIAS = (float*)(F.ws + WS_MISC);
    cvt_job(F, w_in, 13200, DM, 0, 9216, WB + NW_IN, DM, 0, NSA_QSCALE);
    cvt_job(F, w_in, 13200, DM, 9216, 768, WB + NW_IN, DM, 9216, 1.f);
    cvt_job(F, w_in, 13200, DM, 9984, 512, WB + NW_IN, DM, 9984, 1.f);
    cvt_job(F, w_in, 13200, DM, 10496, 768, WB + NW_IN, DM, 10496, 1.f);
    cvt_job(F, w_in, 13200, DM, 11776, 768, WB + NW_IN, DM, 11264, 1.f);
    cvt_job(F, w_in, 13200, DM, 13056, 144, WB + NW_IN, DM, 12032, 1.f);
    zero_bf16(F, WB + NW_IN + (size_t)12176 * DM, (size_t)112 * DM);
    cvt_job(F, w_in, 13200, DM, 11264, 512, WB + NW_IN, DM, 12288, 1.f);
    cvt_job(F, w_in, 13200, DM, 12544, 512, WB + NW_IN, DM, 12800, 1.f);
    cvt_job(F, k_w1, 256, 6144, 0, 256, WB + NW_W1K, 6144, 0, 1.f);
    cvt_job(F, v_w1, 256, 4096, 0, 256, WB + NW_W1V, 4096, 0, 1.f);
    cvt_job(F, k_w2, 192, 256, 0, 192, WB + NW_W2K, 256, 0, 1.f); zero_bf16(F, WB + NW_W2K + 192 * 256, 64 * 256);
    cvt_job(F, v_w2, 128, 256, 0, 128, WB + NW_W2V, 256, 0, 1.f); zero_bf16(F, WB + NW_W2V + 128 * 256, 128 * 256);
    cvt_job(F, w_out, DM, 6144, 0, DM, WB + NW_OUT, 6144, 0, 1.f);
    for (int w = F.gw; w < 512; w += F.NGW) { const bool isk = w < 256; const int c = w & 255, n = isk ? 6144 : 4096; const float* pe = isk ? k_pe : v_pe; const float* w1 = isk ? k_w1 : v_w1;
        float s = 0.f; for (int i = F.lane; i < n; i += 64) s += pe[i] * w1[(size_t)i * 256 + c];
        s = wave_sum(s); if (F.lane == 0) BIAS[w] = s + (isk ? k_b1[c] : v_b1[c]); }
}
DI void ph_nsa_rope(const Frame& F, int half) {
    unsigned char* ar = F.ws + WS_AR; bf16* Q = (bf16*)(ar + NA_Q); bf16* KC = (bf16*)(ar + NA_KC);
    const bf16* KSR = (const bf16*)(ar + NA_KSR); const bf16* KWR = (const bf16*)(ar + NA_KWR); bf16* KSF = (bf16*)(ar + NA_KSF); bf16* KWF = (bf16*)(ar + NA_KWF);
    const float* c48 = (const float*)(F.ws + TAB_COS48); const float* s48 = (const float*)(F.ws + TAB_SIN48);
    for (int ml = F.gw; ml < MC; ml += F.NGW) {
        const size_t mg = (size_t)half * MC + ml; const int bl = ml >> 12, sq = ml & 4095;
        for (int p = F.lane; p < 96; p += 64) {
            const int hd = 48 + p / 24, i = p - (p / 24) * 24; bf16* q;
            q = KC + ((size_t)(bl * 4 + hd - 48) * 4096 + sq) * 192 + i;
            const float x1 = bf2f(q[0]), x2 = bf2f(q[24]), c = c48[mg * 24 + i], s = s48[mg * 24 + i]; q[0] = f2bf(x1 * c - x2 * s); q[24] = f2bf(x1 * s + x2 * c);
        }
        const int tile = sq >> 5, rr = sq & 31;
        for (int u = F.lane; u < 168; u += 64) {
            const int tens = u / 84, uu = u - tens * 84, g = uu / 21, v = uu - g * 21;
            const bf16* src = (tens ? KWR : KSR) + (size_t)ml * 768 + g * 192;
            bf16* dst = (tens ? KWF : KSF) + ((size_t)((bl * 4 + g) * 128 + tile) * 12 * 64 + rr) * 8;
            if (v < 3) {
                const u32x4 a = *(const u32x4*)(src + 8 * v), b = *(const u32x4*)(src + 8 * v + 24); u32x4 o1, o2;
#pragma unroll
                for (int e = 0; e < 4; ++e) { const float c0 = c48[mg * 24 + 8 * v + 2 * e], s0 = s48[mg * 24 + 8 * v + 2 * e], c1 = c48[mg * 24 + 8 * v + 2 * e + 1], s1 = s48[mg * 24 + 8 * v + 2 * e + 1];
                    const float x1l = bflo(a[e]), x1h = bfhi(a[e]), x2l = bflo(b[e]), x2h = bfhi(b[e]);
                    o1[e] = pk2(x1l * c0 - x2l * s0, x1h * c1 - x2h * s1); o2[e] = pk2(x1l * s0 + x2l * c0, x1h * s1 + x2h * c1); }
                const int p1 = v, p2 = v + 3;
                if (tens) { *(u32x4*)(dst + ((p1 >> 1) * 64 + (p1 & 1) * 32) * 8) = o1; *(u32x4*)(dst + ((p2 >> 1) * 64 + (p2 & 1) * 32) * 8) = o2; }
                else { unsigned char* d8 = (unsigned char*)KSF + ((size_t)(((bl * 4 + g) * 128 + tile) * 2 + (rr >> 4)) * 6 * 64 + (rr & 15)) * 8;
                    *(fp8x8_t*)(d8 + ((p1 >> 2) * 64 + (p1 & 3) * 16) * 8) = pack_fp8x8(bflo(o1[0]), bfhi(o1[0]), bflo(o1[1]), bfhi(o1[1]), bflo(o1[2]), bfhi(o1[2]), bflo(o1[3]), bfhi(o1[3]));
                    *(fp8x8_t*)(d8 + ((p2 >> 2) * 64 + (p2 & 3) * 16) * 8) = pack_fp8x8(bflo(o2[0]), bfhi(o2[0]), bflo(o2[1]), bfhi(o2[1]), bflo(o2[2]), bfhi(o2[2]), bflo(o2[3]), bfhi(o2[3])); }
            } else { const int pc = v + 3; const u32x4 c = *(const u32x4*)(src + 8 * pc);
                if (tens) *(u32x4*)(dst + ((pc >> 1) * 64 + (pc & 1) * 32) * 8) = c;
                else { unsigned char* d8 = (unsigned char*)KSF + ((size_t)(((bl * 4 + g) * 128 + tile) * 2 + (rr >> 4)) * 6 * 64 + (rr & 15)) * 8;
                    *(fp8x8_t*)(d8 + ((pc >> 2) * 64 + (pc & 3) * 16) * 8) = pack_fp8x8(bflo(c[0]), bfhi(c[0]), bflo(c[1]), bfhi(c[1]), bflo(c[2]), bfhi(c[2]), bflo(c[3]), bfhi(c[3])); } }
        }
    }
    const bf16* VSR = (const bf16*)(ar + NA_VSR); const bf16* VWR = (const bf16*)(ar + NA_VWR); bf16* VSF = (bf16*)(ar + NA_VSF); bf16* VWF = (bf16*)(ar + NA_VWF);
    const int r = F.lane & 31, h = F.lane >> 5;
    for (int u = F.gw; u < 2 * BPH * 4 * 128; u += F.NGW) {
        const int tens = u >> 11, bg = (u >> 7) & 15, tile = u & 127, bl = bg >> 2, g = bg & 3;
        if (tens) {
            const bf16* src = VWR + ((size_t)bl * SEQ + tile * 32) * 512 + g * 128 + r;
            bf16* vd = VWF + (((size_t)bg * 128 + tile) * 8 * 64 + F.lane) * 8;
#pragma unroll
            for (int db = 0; db < 4; ++db)
#pragma unroll
                for (int s = 0; s < 2; ++s) { unsigned short e[8];
#pragma unroll
                    for (int j = 0; j < 8; ++j) e[j] = src[(size_t)(16 * s + 8 * (j >> 2) + 4 * h + (j & 3)) * 512 + db * 32];
                    u32x4 w; w.x = e[0] | ((unsigned)e[1] << 16); w.y = e[2] | ((unsigned)e[3] << 16); w.z = e[4] | ((unsigned)e[5] << 16); w.w = e[6] | ((unsigned)e[7] << 16);
                    *(u32x4*)(vd + (db * 2 + s) * 512) = w; }
        } else {
            const int d16 = F.lane & 15, kq = F.lane >> 4;
            const bf16* src = VSR + ((size_t)bl * SEQ + tile * 32) * 512 + g * 128 + d16;
            unsigned char* vd = (unsigned char*)VSF + (((size_t)bg * 128 + tile) * 8 * 64 + F.lane) * 8;
#pragma unroll
            for (int db = 0; db < 8; ++db) { float e[8];
#pragma unroll
                for (int j = 0; j < 8; ++j) e[j] = bf2f(src[(size_t)((j < 4 ? 4 * kq + j : 16 + 4 * kq + j - 4)) * 512 + db * 16]);
                *(fp8x8_t*)(vd + db * 512) = pack_fp8x8(e[0], e[1], e[2], e[3], e[4], e[5], e[6], e[7]); }
        }
    }
}
DI float sigmoidf_(float x) { return __builtin_amdgcn_rcpf(1.0f + __builtin_amdgcn_exp2f(-x * LOG2E)); }
struct CmpMK { int tq, h, q0; DI bool need(int t) const { return 512 * t + 527 > q0; }
    DI void operator()(int t, f32x16& S) const {
#pragma unroll
    for (int i = 0; i < 16; ++i) { const int n = 32 * t + crow(i, h); S[i] = (16 * n + 31 <= tq) ? S[i] : -INFINITY; } } };
struct WinMK { int tq, h, qt; DI bool need(int t) const { return t == qt || t == qt - 16; }
    DI void operator()(int t, f32x16& S) const {
#pragma unroll
    for (int i = 0; i < 16; ++i) { const int k = 32 * t + crow(i, h); S[i] = (k <= tq && k > tq - 512) ? S[i] : -INFINITY; } } };
DI void ph_nsa_cmp(const Frame& F, const int half) {
    const float* c48 = (const float*)(F.ws + TAB_COS48); const float* s48 = (const float*)(F.ws + TAB_SIN48);
    unsigned char* ar = F.ws + WS_AR; const bf16* Q = (const bf16*)(ar + NA_Q); const bf16* KCMP = (const bf16*)(ar + NA_KCMP); const bf16* VCT = (const bf16*)(ar + NA_VCT); const bf16* GT = (const bf16*)(ar + NA_GT);
    unsigned char* SELB = ar + NA_SELB; bf16* Ob = (bf16*)(ar + NA_O);
    LAS float* imp = (LAS float*)F.lds;
    LAS unsigned char* kres = F.lds + 20480;
    LAS unsigned char* vring = F.lds + 20480 + 98304;
    const int lane = F.lane, r = lane & 31, h = lane >> 5, tid = F.tid;
    for (int u = blockIdx.x; u < BPH * 4 * 64; u += F.G) {
        const int bg = u >> 6, qt64 = ((u >> 8) & 1) ? 63 - (u & 63) : (u & 63), bl = bg >> 2, g = bg & 3;
        const int tqmaxb = qt64 * 64 + 63, TE = (tqmaxb >= 31) ? ((tqmaxb - 31) / 16) / 32 + 1 : 0;
        const bf16* ksrc = KCMP + (size_t)bg * 8 * 12 * 512; const bf16* vsrc = VCT + (size_t)bg * 8 * 8 * 512;
        for (int i = F.tid; i < 64 * 65; i += NWAVES * 64) imp[i] = 0.f;
        for (int p = tid; p < TE * 768; p += NWAVES * 64) *(LAS u32x4*)(kres + p * 16) = *(const u32x4*)(ksrc + (size_t)p * 8);
        __syncthreads();
#pragma unroll 1
        for (int k = 0; k < 3; ++k) {
            const int idx = F.wave * 3 + k, j = idx >> 1, sub = idx & 1, ql = sub * 32 + r, tq = qt64 * 64 + ql, hd = g * 12 + j;
            const size_t mrow = (size_t)bl * SEQ + tq;
            bf16x8 qf[12];
#pragma unroll
            for (int s = 3; s < 12; ++s) qf[s] = *(const bf16x8*)(Q + mrow * 9216 + hd * 192 + 16 * s + 8 * h);
            { const float* cs = c48 + ((size_t)half * MC + mrow) * 24; const float* sn = s48 + ((size_t)half * MC + mrow) * 24;
#pragma unroll
              for (int s = 0; s < 3; ++s) qf[s] = rope_frag32(Q + mrow * 9216 + hd * 192, s, h, cs, sn); }
            const int tqmax = qt64 * 64 + sub * 32 + 31, te = (tqmax >= 31) ? ((tqmax - 31) / 16) / 32 + 1 : 0;
            const CmpMK mk{tq, h, qt64 * 64 + sub * 32};
            float m = -INFINITY, l = 0.f;
            {
                f32x16 Od[4];
#pragma unroll 1
                for (int t = 0; t < te; ++t) {
                    const LAS unsigned char* cur = kres + t * 12288;
                    f32x16 S;
#pragma unroll
                    for (int i = 0; i < 16; ++i) S[i] = 0.f;
#pragma unroll
                    for (int s = 0; s < 12; ++s) S = MFMA32(*(const LAS bf16x8*)(cur + s * 1024 + lane * 16), qf[s], S);
                    if (mk.need(t)) mk(t, S);
                    bf16x8 pfd[2]; softmax_step<4, false>(S, m, l, Od, pfd);
                }
            }
            l += __shfl_xor(l, 32);
            const float linv = l > 0.f ? 1.0f / l : 0.f, ms = (m == -INFINITY) ? 0.f : m;
            f32x16 O[4];
#pragma unroll
            for (int db = 0; db < 4; ++db)
#pragma unroll
                for (int i = 0; i < 16; ++i) O[db][i] = 0.f;
            if (TE > 0) {
                u32x4 pv = *(const u32x4*)(vsrc + (size_t)tid * 8);
                *(LAS u32x4*)(vring + tid * 16) = pv;
                LDS_WAIT(); __builtin_amdgcn_s_barrier(); asm volatile("" ::: "memory");
#pragma unroll 1
                for (int t = 0; t < TE; ++t) {
                    const LAS unsigned char* cur = kres + t * 12288; const LAS unsigned char* vcur = vring + (t & 1) * 8192;
                    if (t + 1 < TE) pv = *(const u32x4*)(vsrc + ((size_t)(t + 1) * 512 + tid) * 8);
                    if (t < te) {
                        f32x16 S;
#pragma unroll
                        for (int i = 0; i < 16; ++i) S[i] = 0.f;
#pragma unroll
                        for (int s = 0; s < 12; ++s) S = MFMA32(*(const LAS bf16x8*)(cur + s * 1024 + lane * 16), qf[s], S);
                        if (mk.need(t)) mk(t, S);
#pragma unroll
                        for (int i = 0; i < 16; ++i) S[i] = __builtin_amdgcn_exp2f(S[i] - ms) * linv;
#pragma unroll
                        for (int g4 = 0; g4 < 4; ++g4) { const float gs = (S[4 * g4] + S[4 * g4 + 1]) + (S[4 * g4 + 2] + S[4 * g4 + 3]); const int mb = 8 * t + 2 * g4 + h;
                            __hip_atomic_fetch_add(imp + ql * 65 + mb, gs, __ATOMIC_RELAXED, __HIP_MEMORY_SCOPE_WORKGROUP);
                            if (mb + 1 < 64) __hip_atomic_fetch_add(imp + ql * 65 + mb + 1, S[4 * g4 + 3], __ATOMIC_RELAXED, __HIP_MEMORY_SCOPE_WORKGROUP); }
                        bf16x8 pf[2];
#pragma unroll
                        for (int s = 0; s < 2; ++s) { u32x4 w; w.x = pk2(S[8 * s], S[8 * s + 1]); w.y = pk2(S[8 * s + 2], S[8 * s + 3]); w.z = pk2(S[8 * s + 4], S[8 * s + 5]); w.w = pk2(S[8 * s + 6], S[8 * s + 7]); pf[s] = __builtin_bit_cast(bf16x8, w); }
#pragma unroll
                        for (int db = 0; db < 4; ++db)
#pragma unroll
                            for (int s = 0; s < 2; ++s) O[db] = MFMA32(*(const LAS bf16x8*)(vcur + (db * 2 + s) * 1024 + lane * 16), pf[s], O[db]);
                    }
                    if (t + 1 < TE) *(LAS u32x4*)(vring + ((t + 1) & 1) * 8192 + tid * 16) = pv;
                    LDS_WAIT(); __builtin_amdgcn_s_barrier(); asm volatile("" ::: "memory");
                }
            }
            const float gate = sigmoidf_(bf2f(GT[mrow * 256 + hd]));
            store_col<false>(Ob + mrow * 6144 + hd * 128, O, gate, h);
        }
        __syncthreads();
#pragma unroll 1
        for (int k = 0; k < 8; ++k) {
            const int ql = F.wave * 8 + k, tq = qt64 * 64 + ql, cur = tq >> 6, mb = lane;
            const bool causal = mb <= cur, forced = (mb == 0) || (mb == cur) || (mb == cur - 1);
            const float v = causal ? (forced ? INFINITY : imp[ql * 65 + mb]) : -INFINITY;
            int rank = 0;
            for (int o = 0; o < 64; ++o) { const float vo = __shfl(v, o); rank += (vo > v || (vo == v && o < mb)) ? 1 : 0; }
            if (rank < 16) SELB[((size_t)bg * 4096 + tq) * 16 + rank] = causal ? (unsigned char)mb : (unsigned char)0xFF;
        }
        __syncthreads();
    }
}
DI int sel_tile(const u32x4& sel, int t) { const int b = t >> 1; const unsigned w = (b < 4) ? sel.x : (b < 8) ? sel.y : (b < 12) ? sel.z : sel.w; return (int)((w >> ((b & 3) * 8)) & 0xFFu) * 2 + (t & 1); }
struct SelMK { u32x4 sel; int tq, h; DI void operator()(int t, f32x16& S) const { const int k0 = sel_tile(sel, t) * 32;
#pragma unroll
    for (int i = 0; i < 16; ++i) S[i] = (k0 + crow(i, h) <= tq) ? S[i] : -INFINITY; } };
typedef float f32x4_ __attribute__((ext_vector_type(4)));
#define MFMA16F8(a, b, c) __builtin_amdgcn_mfma_f32_16x16x32_fp8_fp8((a), (b), (c), 0, 0, 0)
DI void ph_nsa_sel(const Frame& F, const int half) {
    const float* c48 = (const float*)(F.ws + TAB_COS48); const float* s48 = (const float*)(F.ws + TAB_SIN48);
    unsigned char* ar = F.ws + WS_AR; const bf16* Q = (const bf16*)(ar + NA_Q); const unsigned char* KS8 = ar + NA_KSF; const unsigned char* VS8 = ar + NA_VSF; const bf16* GT = (const bf16*)(ar + NA_GT);
    const unsigned char* SELB = ar + NA_SELB; bf16* Ob = (bf16*)(ar + NA_O);
    const int c16 = F.lane & 15, kq = F.lane >> 4; const bool act = c16 < 12;
    for (int it = F.gw; it < BPH * 4 * SEQ; it += F.NGW) {
        const int bg = it >> 12, tq = ((it & 4095) + 256 * bg) & 4095, bl = bg >> 2, g = bg & 3; const size_t mrow = (size_t)bl * SEQ + tq; const int hd = g * 12 + (act ? c16 : 0);
        fp8x8_t qf[6];
#pragma unroll
        for (int s = 0; s < 6; ++s) { const float qs = act ? (1.0f / NSA_QSCALE) : 0.f; const int p = 4 * s + kq;
            if (s < 2 && p < 6) { float o[8]; rope_piece(Q + mrow * 9216 + hd * 192, p, c48 + ((size_t)half * MC + mrow) * 24, s48 + ((size_t)half * MC + mrow) * 24, o);
                qf[s] = pack_fp8x8(o[0] * qs, o[1] * qs, o[2] * qs, o[3] * qs, o[4] * qs, o[5] * qs, o[6] * qs, o[7] * qs); }
            else { const u32x4 q = *(const u32x4*)(Q + mrow * 9216 + hd * 192 + 32 * s + 8 * kq);
                qf[s] = pack_fp8x8(bflo(q[0]) * qs, bfhi(q[0]) * qs, bflo(q[1]) * qs, bfhi(q[1]) * qs, bflo(q[2]) * qs, bfhi(q[2]) * qs, bflo(q[3]) * qs, bfhi(q[3]) * qs); } }
        const u32x4 sel = *(const u32x4*)(SELB + ((size_t)bg * 4096 + tq) * 16);
        const int nv = ((tq >> 6) + 1 < 16) ? (tq >> 6) + 1 : 16, te = 2 * nv;
        const unsigned char* kb = KS8 + ((size_t)bg * 128 * 12 * 64 + F.lane) * 8; const unsigned char* vb = VS8 + ((size_t)bg * 128 * 8 * 64 + F.lane) * 8;
        f32x4_ O[8];
#pragma unroll
        for (int db = 0; db < 8; ++db) O[db] = (f32x4_){0.f, 0.f, 0.f, 0.f};
        float m = -INFINITY, l = 0.f;
        fp8x8_t kfA[12], kfB[12], vfA[8], vfB[8];
        { const unsigned char* kp = kb + (size_t)sel_tile(sel, 0) * 12 * 512; const unsigned char* kp1 = kb + (size_t)sel_tile(sel, 1) * 12 * 512; const unsigned char* vp = vb + (size_t)sel_tile(sel, 0) * 8 * 512;
#pragma unroll
          for (int s = 0; s < 12; ++s) { kfA[s] = *(const fp8x8_t*)(kp + s * 512); kfB[s] = *(const fp8x8_t*)(kp1 + s * 512); }
#pragma unroll
          for (int j = 0; j < 8; ++j) vfA[j] = *(const fp8x8_t*)(vp + j * 512); }
#define SEL_STEP(T_, KF_, VF_, VFN_) do { const int t_ = (T_); const int tile = sel_tile(sel, t_); \
            if (t_ + 1 < te) { const unsigned char* vp = vb + (size_t)sel_tile(sel, t_ + 1) * 8 * 512; _Pragma("unroll") for (int j = 0; j < 8; ++j) VFN_[j] = *(const fp8x8_t*)(vp + j * 512); } \
            f32x4_ S0 = {0.f, 0.f, 0.f, 0.f}, S1 = S0; \
            _Pragma("unroll") for (int s = 0; s < 6; ++s) { S0 = MFMA16F8(KF_[s], qf[s], S0); S1 = MFMA16F8(KF_[6 + s], qf[s], S1); } \
            if (t_ + 2 < te) { const unsigned char* kp = kb + (size_t)sel_tile(sel, t_ + 2) * 12 * 512; _Pragma("unroll") for (int s = 0; s < 12; ++s) KF_[s] = *(const fp8x8_t*)(kp + s * 512); } \
            const int k0 = tile * 32 + 4 * kq; float mx = -INFINITY; \
            _Pragma("unroll") for (int i = 0; i < 4; ++i) { S0[i] = (k0 + i <= tq) ? S0[i] * NSA_QSCALE : -INFINITY; S1[i] = (k0 + 16 + i <= tq) ? S1[i] * NSA_QSCALE : -INFINITY; mx = fmaxf(mx, fmaxf(S0[i], S1[i])); } \
            mx = fmaxf(mx, __shfl_xor(mx, 16)); mx = fmaxf(mx, __shfl_xor(mx, 32)); \
            const float mn = fmaxf(m, mx), ms = (mn == -INFINITY) ? 0.f : mn, alpha = __builtin_amdgcn_exp2f(m - ms); \
            float sum = 0.f; \
            _Pragma("unroll") for (int i = 0; i < 4; ++i) { S0[i] = __builtin_amdgcn_exp2f(S0[i] - ms); S1[i] = __builtin_amdgcn_exp2f(S1[i] - ms); sum += S0[i] + S1[i]; } \
            l = l * alpha + sum; m = mn; \
            if (__builtin_amdgcn_ballot_w64(alpha != 1.0f) != 0ull) { _Pragma("unroll") for (int db = 0; db < 8; ++db) O[db] = O[db] * alpha; } \
            const fp8x8_t p8 = pack_fp8x8(S0[0], S0[1], S0[2], S0[3], S1[0], S1[1], S1[2], S1[3]);       \
            _Pragma("unroll") for (int db = 0; db < 8; ++db) O[db] = MFMA16F8(VF_[db], p8, O[db]); } while (0)
#pragma unroll 1
        for (int t = 0; t < te; t += 2) { SEL_STEP(t, kfA, vfA, vfB); SEL_STEP(t + 1, kfB, vfB, vfA); }
#undef SEL_STEP
        l += __shfl_xor(l, 16); l += __shfl_xor(l, 32);
        if (act) { const float gate = sigmoidf_(bf2f(GT[mrow * 256 + 48 + hd])); const float sc = l > 0.f ? gate / l : 0.f;
            bf16* o = Ob + mrow * 6144 + hd * 128 + 4 * kq;
#pragma unroll
            for (int db = 0; db < 8; ++db) { u32x2* p = (u32x2*)(o + db * 16); const u32x2 prev = *p;
                u32x2 w; w.x = pk2(O[db][0] * sc + bflo(prev.x), O[db][1] * sc + bfhi(prev.x)); w.y = pk2(O[db][2] * sc + bflo(prev.y), O[db][3] * sc + bfhi(prev.y)); *p = w; } }
    }
}
DI void ph_nsa_win(const Frame& F, const int half) {
    const float* c48 = (const float*)(F.ws + TAB_COS48); const float* s48 = (const float*)(F.ws + TAB_SIN48);
    unsigned char* ar = F.ws + WS_AR; const bf16* Q = (const bf16*)(ar + NA_Q); const bf16* KWF = (const bf16*)(ar + NA_KWF); const bf16* VWF = (const bf16*)(ar + NA_VWF); const bf16* GT = (const bf16*)(ar + NA_GT); bf16* Ob = (bf16*)(ar + NA_O);
    const int r = F.lane & 31, h = F.lane >> 5;
    for (int idb = blockIdx.x; idb < BPH * 48 * 16; idb += F.G) {
        const int qt0 = (((idb & 15) + (idb >> 8)) & 15) * 8, qt = qt0 + F.wave, bh = idb >> 4, hd = bh % 48, bl = bh / 48, g = hd / 12, bg = bl * 4 + g, tq = qt * 32 + r; const size_t mrow = (size_t)bl * SEQ + tq;
        bf16x8 qf[12];
#pragma unroll
        for (int s = 3; s < 12; ++s) qf[s] = *(const bf16x8*)(Q + mrow * 9216 + hd * 192 + 16 * s + 8 * h);
        { const float* cs = c48 + ((size_t)half * MC + mrow) * 24; const float* sn = s48 + ((size_t)half * MC + mrow) * 24;
#pragma unroll
          for (int s = 0; s < 3; ++s) qf[s] = rope_frag32(Q + mrow * 9216 + hd * 192, s, h, cs, sn); }
        const FragSrc src{KWF + (size_t)bg * 128 * 12 * 512, VWF + (size_t)bg * 128 * 8 * 512, 12}; const WinMK mk{tq, h, qt};
        f32x16 O[4];
#pragma unroll
        for (int db = 0; db < 4; ++db)
#pragma unroll
            for (int i = 0; i < 16; ++i) O[db][i] = 0.f;
        float m = -INFINITY, l = 0.f;
        attn_run_sh<12, true>(F.lds, F.tid, F.lane, qf, O, m, l, qt0 >= 16 ? qt0 - 16 : 0, qt0 + 8, qt >= 16 ? qt - 16 : 0, qt + 1, src, mk);
        l += __shfl_xor(l, 32);
        const float gate = sigmoidf_(bf2f(GT[mrow * 256 + 96 + hd]));
        store_col<true>(Ob + mrow * 6144 + hd * 128, O, l > 0.f ? gate / l : 0.f, h);
    }
}
#ifndef MK_ONE_LAUNCH
#define MK_ONE_LAUNCH 1
#endif
constexpr int NPH = 69;
struct Args { const float* in[58]; float* out; unsigned char* ws; int ph_lo, ph_hi; };
#define GEMM_AKOFF 0
#define GEMM_CALL(EpiT, Evar, Aptr, Bptr, Mv, Nv, Kv, ldav, ldbv, cidx) do { const pg8::Gemm g_{(const pg8::bf16_t*)(Aptr), (const pg8::bf16_t*)(Bptr), (Mv), (Nv), (Kv), (ldav), (ldbv), GEMM_AKOFF}; \
    pg8::StaticOrder S_; S_.init((Mv), (Nv), F.G, (cidx)); pg8::gemm_phase<EpiT, pg8::StaticOrder, true, true>((PG8_LAS unsigned char*)F.lds, g_, S_, Evar); } while (0)
DI pg8::EpiBf16R epi1(bf16* base, int ldc) { pg8::EpiBf16R e; for (int s = 0; s < 8; ++s) { e.T.base[s] = base; e.T.ldc[s] = ldc; e.T.t0[s] = 0; e.T.gw[s] = 0; } e.T.nseg = 1; e.T.pad_ = 0; e.ssp = nullptr; e.ss_off = 0; return e; }
#define PH_BEGIN if (ph >= lo && ph < hi) { Frame F; { unsigned long long w_ = (unsigned long long)args.ws; asm volatile("" : "+s"(w_)); F.ws = (unsigned char*)w_; F.ctl = (unsigned*)(F.ws + WS_CTL); } \
    F.lds = lds; F.tid = threadIdx.x; F.lane = F.tid & 63; F.wave = __builtin_amdgcn_readfirstlane(F.tid >> 6); F.G = gridDim.x; F.gw = blockIdx.x * NWAVES + F.wave; F.NGW = F.G * NWAVES; \
    float* out; { unsigned long long o_ = (unsigned long long)args.out; asm volatile("" : "+s"(o_)); out = (float*)o_; } \
    unsigned char* const ar = F.ws + WS_AR; bf16* const XN = (bf16*)(F.ws + WS_XNR); float* const SSB = (float*)(F.ws + WS_SS); bf16* const WB = (bf16*)(F.ws + WS_WMIX); bf16* const WUP = (bf16*)(F.ws + WS_WFFN); bf16* const WDN = WUP + (size_t)2 * DFF * DM; \
    const float* const res_mix = (ib == 2) ? args.in[0] : (const float*)out; (void)ar; (void)XN; (void)SSB; (void)WB; (void)WUP; (void)WDN; (void)res_mix; (void)iff;
#define PH_END   if (ph + 1 < hi) { XcdBarrier b_; b_.bar = (unsigned*)F.ctl + CW_BAR; b_.x = xb_xcc_id(); b_.st = MISC + 8; xcd_barrier(b_); } } ++ph;
template <int LAYER> DI void run_cvt(const Args& args, LAS unsigned char* lds, volatile LAS unsigned* MISC, int& ph, const int lo, const int hi) {
    constexpr int ib = (LAYER == 0) ? 2 : (LAYER == 1) ? 17 : (LAYER == 2) ? 26 : 42;
    constexpr int iff = (LAYER == 0) ? 12 : (LAYER == 1) ? 21 : (LAYER == 2) ? 37 : 52;
    constexpr int kind = (LAYER == 1) ? 1 : (LAYER == 2) ? 2 : 0;
        PH_BEGIN
            if constexpr (LAYER == 0) { ph_tables(F, (const int*)args.in[1]); ph_norm_first(F, args.in[0], args.in[2], XN, SSB); }
            if constexpr (kind == 0) ph_dsa_cvt(F, args.in[ib + 1], args.in[ib + 6], args.in[ib + 7], args.in[ib + 8], args.in[ib + 9]);
            else if constexpr (kind == 1) ph_fox_cvt(F, args.in[ib + 1], args.in[ib + 3]);
            else ph_nsa_cvt(F, args.in[ib + 1], args.in[ib + 2], args.in[ib + 3], args.in[ib + 4], args.in[ib + 5], args.in[ib + 6], args.in[ib + 7], args.in[ib + 8], args.in[ib + 9], args.in[ib + 10]);
            ph_cvt_ffn(F, args.in[iff + 1], args.in[iff + 4]);
        PH_END
}
template <int LAYER, int HALF> DI void run_half(const Args& args, LAS unsigned char* lds, volatile LAS unsigned* MISC, int& ph, const int lo, const int hi) {
    constexpr int ib = (LAYER == 0) ? 2 : (LAYER == 1) ? 17 : (LAYER == 2) ? 26 : 42;
    constexpr int iff = (LAYER == 0) ? 12 : (LAYER == 1) ? 21 : (LAYER == 2) ? 37 : 52;
    constexpr int kind = (LAYER == 1) ? 1 : (LAYER == 2) ? 2 : 0;
    constexpr int half = HALF;
            const int roff = half * MC;
            if constexpr (kind == 0) {
                PH_BEGIN { pg8::EpiF32 E{(float*)(ar + DA_DIN), 1024, SSB + (size_t)(LAYER * 2) * MTOT * 8, roff}; GEMM_CALL(pg8::EpiF32, E, XN + (size_t)roff * DM, WB + DW_W1, MC, 1024, DM, DM, DM, (int)blockIdx.x); } PH_END
                PH_BEGIN ph_dsa_post1(F, half, args.in[ib + 2], args.in[ib + 3], args.in[ib + 4], args.in[ib + 5]); PH_END
                PH_BEGIN { pg8::EpiBf16R E = epi1((bf16*)(ar + DA_QL), 8192); E.T.base[1] = (bf16*)(ar + DA_QPE); E.T.ldc[1] = 1536; E.T.t0[1] = 32; E.T.base[2] = (bf16*)(ar + DA_QIDX); E.T.ldc[2] = 2048; E.T.t0[2] = 38; E.T.nseg = 3;
                    GEMM_CALL(pg8::EpiBf16R, E, ar + DA_CQN, WB + DW_W2, MC, 11776, 512, 512, 512, (int)blockIdx.x); } PH_END
                PH_BEGIN ph_dsa_index(F, half); PH_END
                PH_BEGIN ph_dsa_attn(F, half); PH_END
                PH_BEGIN {
                    pg8::EpiBf16R E = epi1((bf16*)(ar + DA_O2), 4096);
                    { const pg8::Gemm g_{(const pg8::bf16_t*)(ar + DA_QL), (const pg8::bf16_t*)(WB + DW_BD), MC, 4096, 512, 8192, 512, 512}; pg8::StaticOrder S_; S_.init(MC, 4096, F.G, (int)blockIdx.x);
                      pg8::gemm_phase<pg8::EpiBf16R, pg8::StaticOrder, true, true>((PG8_LAS unsigned char*)F.lds, g_, S_, E); } } PH_END
                PH_BEGIN { pg8::EpiResN E{LAYER == 0 ? args.in[0] : nullptr, args.in[ib], nullptr, DM, roff, args.in[iff], (pg8::bf16_t*)XN, SSB + (size_t)(LAYER * 2 + 1) * MTOT * 8, (PG8_LAS float*)(F.lds + LDSCTL_OFF + 256)}; GEMM_CALL(pg8::EpiResN, E, ar + DA_O2, WB + DW_WO, MC, DM, 4096, 4096, 4096, (int)blockIdx.x); } PH_END
            } else if constexpr (kind == 1) {
                PH_BEGIN { pg8::EpiBf16R E = epi1((bf16*)(ar + FA_Q), DM); E.T.base[1] = (bf16*)(ar + FA_K); E.T.ldc[1] = DM; E.T.t0[1] = 8; E.T.base[2] = (bf16*)(ar + FA_V); E.T.ldc[2] = DM; E.T.t0[2] = 16;
                    E.T.base[3] = (bf16*)(ar + FA_F); E.T.ldc[3] = 256; E.T.t0[3] = 24; E.T.nseg = 4; E.ssp = SSB + (size_t)(LAYER * 2) * MTOT * 8; E.ss_off = roff;
                    GEMM_CALL(pg8::EpiBf16R, E, XN + (size_t)roff * DM, WB + FW_IN, MC, 6400, DM, DM, DM, (int)blockIdx.x); } PH_END
                PH_BEGIN ph_fox_scan(F, args.in[ib + 2]); PH_END
                PH_BEGIN ph_fox_attn(F); PH_END
                PH_BEGIN { pg8::EpiResN E{LAYER == 0 ? args.in[0] : nullptr, args.in[ib], nullptr, DM, roff, args.in[iff], (pg8::bf16_t*)XN, SSB + (size_t)(LAYER * 2 + 1) * MTOT * 8, (PG8_LAS float*)(F.lds + LDSCTL_OFF + 256)}; GEMM_CALL(pg8::EpiResN, E, ar + FA_O, WB + FW_OUT, MC, DM, DM, DM, DM, (int)blockIdx.x); } PH_END
            } else {
                PH_BEGIN { pg8::EpiBf16R E = epi1((bf16*)(ar + NA_Q), 9216);
                    E.T.base[1] = (bf16*)(ar + NA_KC); E.T.ldc[1] = 192; E.T.t0[1] = 36; E.T.gw[1] = 192;
                    E.T.base[2] = (bf16*)(ar + NA_VC); E.T.ldc[2] = 128; E.T.t0[2] = 39; E.T.gw[2] = 128;
                    E.T.base[3] = (bf16*)(ar + NA_KSR); E.T.ldc[3] = 768; E.T.t0[3] = 41;
                    E.T.base[4] = (bf16*)(ar + NA_KWR); E.T.ldc[4] = 768; E.T.t0[4] = 44;
                    E.T.base[5] = (bf16*)(ar + NA_GT); E.T.ldc[5] = 256; E.T.t0[5] = 47;
                    E.T.base[6] = (bf16*)(ar + NA_VSR); E.T.ldc[6] = 512; E.T.t0[6] = 48;
                    E.T.base[7] = (bf16*)(ar + NA_VWR); E.T.ldc[7] = 512; E.T.t0[7] = 50; E.T.nseg = 8; E.ssp = SSB + (size_t)(LAYER * 2) * MTOT * 8; E.ss_off = roff;
                    GEMM_CALL(pg8::EpiBf16R, E, XN + (size_t)roff * DM, WB + NW_IN, MC, 13312, DM, DM, DM, (int)blockIdx.x); } PH_END
                PH_BEGIN ph_nsa_rope(F, half); PH_END
                PH_BEGIN {
                    const float* BIAS = (const float*)(args.ws + WS_MISC);
                    { pg8::EpiGelu E{(bf16*)(ar + NA_GK), 256, BIAS}; GEMM_CALL(pg8::EpiGelu, E, ar + NA_KC, WB + NW_W1K, 4096, 256, 6144, 3072, 6144, (int)blockIdx.x); }
                    { pg8::EpiGelu E{(bf16*)(ar + NA_GV), 256, BIAS + 256}; GEMM_CALL(pg8::EpiGelu, E, ar + NA_VC, WB + NW_W1V, 4096, 256, 4096, 2048, 4096, (int)((blockIdx.x + F.G - 16) % F.G)); }
                } PH_END
                PH_BEGIN {
                    { pg8::EpiBf16R E = epi1((bf16*)(ar + NA_KCMP), 12); E.T.gw[0] = -1; GEMM_CALL(pg8::EpiBf16R, E, ar + NA_GK, WB + NW_W2K, 4096, 256, 256, 256, 256, (int)blockIdx.x); }
                    { pg8::EpiBf16R E = epi1((bf16*)(ar + NA_VCT), 4); E.T.gw[0] = -2; GEMM_CALL(pg8::EpiBf16R, E, WB + NW_W2V, ar + NA_GV, 256, 4096, 256, 256, 256, (int)((blockIdx.x + F.G - 16) % F.G)); }
                } PH_END
                PH_BEGIN ph_nsa_cmp(F, half); PH_END
                PH_BEGIN ph_nsa_sel(F, half); PH_END
                PH_BEGIN ph_nsa_win(F, half); PH_END
                PH_BEGIN { pg8::EpiResN E{LAYER == 0 ? args.in[0] : nullptr, args.in[ib], nullptr, DM, roff, args.in[iff], (pg8::bf16_t*)XN, SSB + (size_t)(LAYER * 2 + 1) * MTOT * 8, (PG8_LAS float*)(F.lds + LDSCTL_OFF + 256)}; GEMM_CALL(pg8::EpiResN, E, ar + NA_O, WB + NW_OUT, MC, DM, 6144, 6144, 6144, (int)blockIdx.x); } PH_END
            }
}
template <int LAYER> DI void run_ffn(const Args& args, LAS unsigned char* lds, volatile LAS unsigned* MISC, int& ph, const int lo, const int hi) {
    constexpr int ib = (LAYER == 0) ? 2 : (LAYER == 1) ? 17 : (LAYER == 2) ? 26 : 42;
    constexpr int iff = (LAYER == 0) ? 12 : (LAYER == 1) ? 21 : (LAYER == 2) ? 37 : 52;
    PH_BEGIN {
        LAS float* rt = (LAS float*)(F.lds + LDSCTL_OFF + 256 + 8192); const int rbase = 4096 * (int)(blockIdx.x & 7); const float* ssq = SSB + (size_t)(LAYER * 2 + 1) * MTOT * 8;
        for (int i = F.tid; i < 4096; i += NWAVES * 64) rt[i] = pg8::rms_rowscale(ssq, rbase + i);
        __syncthreads();
        pg8::EpiConvGlu E{(pg8::bf16_t*)ar, (float*)(ar + 352 * MiB), args.in[iff + 2], args.in[iff + 3], (PG8_LAS float*)(F.lds + LDSCTL_OFF + 256), DFF, (const PG8_LAS float*)rt, rbase};
        GEMM_CALL(pg8::EpiConvGlu, E, XN, WUP, MTOT, 2 * DFF, DM, DM, DM, (int)blockIdx.x); } PH_END
    PH_BEGIN ph_conv_fix(F, (const float*)(ar + 352 * MiB), (bf16*)ar, args.in[iff + 2], args.in[iff + 3], MTOT); PH_END
    PH_BEGIN {
        if constexpr (LAYER < 3) { constexpr int ibn = (LAYER == 0) ? 17 : (LAYER == 1) ? 26 : 42;
            pg8::EpiResN E{nullptr, args.in[iff], nullptr, DM, 0, args.in[ibn], (pg8::bf16_t*)XN, SSB + (size_t)((LAYER + 1) * 2) * MTOT * 8, (PG8_LAS float*)(F.lds + LDSCTL_OFF + 256)}; GEMM_CALL(pg8::EpiResN, E, ar, WDN, MTOT, DM, DFF, DFF, DFF, (int)blockIdx.x); }
        else { pg8::EpiResN E{nullptr, args.in[iff], out, DM, 0, nullptr, (pg8::bf16_t*)XN, nullptr, (PG8_LAS float*)(F.lds + LDSCTL_OFF + 256)}; GEMM_CALL(pg8::EpiResN, E, ar, WDN, MTOT, DM, DFF, DFF, DFF, (int)blockIdx.x); }
    } PH_END
}
__global__ void __launch_bounds__(NWAVES * 64, 2) mk_fwd(Args args) {
    extern __shared__ __attribute__((aligned(16))) unsigned char lds_[];
    LAS unsigned char* const lds = (LAS unsigned char*)lds_;
    volatile LAS unsigned* MISC = (volatile LAS unsigned*)(lds + LDSCTL_OFF);
    for (int u = threadIdx.x; u < 64; u += NWAVES * 64) ((LAS unsigned*)(lds + LDSCTL_OFF))[u] = 0u;
    __syncthreads();
    const int lo = args.ph_lo, hi = args.ph_hi;
    (void)xcd_barrier_post((unsigned*)(args.ws + WS_CTL) + CW_BAR, MISC + 8);
    int ph = 0;
    run_cvt<0>(args, lds, MISC, ph, lo, hi); run_half<0, 0>(args, lds, MISC, ph, lo, hi); run_half<0, 1>(args, lds, MISC, ph, lo, hi); run_ffn<0>(args, lds, MISC, ph, lo, hi);
    run_cvt<1>(args, lds, MISC, ph, lo, hi); run_half<1, 0>(args, lds, MISC, ph, lo, hi); run_half<1, 1>(args, lds, MISC, ph, lo, hi); run_ffn<1>(args, lds, MISC, ph, lo, hi);
    run_cvt<2>(args, lds, MISC, ph, lo, hi); run_half<2, 0>(args, lds, MISC, ph, lo, hi); run_half<2, 1>(args, lds, MISC, ph, lo, hi); run_ffn<2>(args, lds, MISC, ph, lo, hi);
    run_cvt<3>(args, lds, MISC, ph, lo, hi); run_half<3, 0>(args, lds, MISC, ph, lo, hi); run_half<3, 1>(args, lds, MISC, ph, lo, hi); run_ffn<3>(args, lds, MISC, ph, lo, hi);
    { constexpr int ib = 42, iff = 52; PH_BEGIN ph_final_norm(F, out, args.in[57]); PH_END }
}
extern "C" void kernel_launch(void* const* d_in, const int* in_sizes, int n_in, void* d_out, int out_size, void* d_ws, size_t ws_size, hipStream_t stream) {
    static int grid = 0;
    if (grid == 0) {
        if (n_in != 58 || out_size != MTOT * DM || ws_size < WS_END) { fprintf(stderr, "kernel_launch: unexpected shapes (n_in %d, out %d, ws %zu)\n", n_in, out_size, ws_size); grid = -1; return; }
        int dev = 0, cus = 0;
        if (hipGetDevice(&dev) != hipSuccess || hipDeviceGetAttribute(&cus, hipDeviceAttributeMultiprocessorCount, dev) != hipSuccess) { grid = -1; return; }
        if (hipFuncSetAttribute((const void*)mk_fwd, hipFuncAttributeMaxDynamicSharedMemorySize, LDS_BYTES) != hipSuccess) { fprintf(stderr, "kernel_launch: hipFuncSetAttribute failed\n"); grid = -1; return; }
        int per_cu = 0;
        (void)hipOccupancyMaxActiveBlocksPerMultiprocessor(&per_cu, (const void*)mk_fwd, NWAVES * 64, LDS_BYTES);
        (void)hipGetLastError();
        grid = cus;
    }
    if (grid < 0) return;
    if (hipMemsetAsync((char*)d_ws + WS_CTL, 0, CTL_ZERO_BYTES, stream) != hipSuccess) return;
    Args a{};
    for (int i = 0; i < 58; ++i) a.in[i] = (const float*)d_in[i];
    a.out = (float*)d_out; a.ws = (unsigned char*)d_ws;
#if MK_ONE_LAUNCH
    a.ph_lo = 0; a.ph_hi = NPH;
    hipLaunchKernelGGL(mk_fwd, dim3(grid), dim3(NWAVES * 64), LDS_BYTES, stream, a);
#else
    for (int p = 0; p < NPH; ++p) { a.ph_lo = p; a.ph_hi = p + 1; hipLaunchKernelGGL(mk_fwd, dim3(grid), dim3(NWAVES * 64), LDS_BYTES, stream, a); }
#endif
}
```

```cpp
#include <hip/hip_runtime.h>
#include <cstdio>
#include <cstdint>
#define DI __device__ __forceinline__
namespace pg8 {
#define PG8_LAS __attribute__((address_space(3)))
typedef unsigned short bf16_t;
typedef short bf16x8 __attribute__((ext_vector_type(8)));
typedef float f32x4 __attribute__((ext_vector_type(4)));
typedef unsigned u32x4 __attribute__((ext_vector_type(4)));
constexpr int BM = 256, BK = 64, HALF = 128, HTB = HALF * BK * 2  , STAGE_BYTES = 8 * HTB, NXCD = 8, WGM = 8;

__host__ __device__ __forceinline__ int lds_byte(int r, int c) { const int st = (r >> 4) * 2 + (c >> 5), rr = r & 15, cc = c & 31, ob = rr * 64 + cc * 2; return st * 1024 + (ob ^ (((ob >> 9) & 1) << 5)); }
__host__ __device__ __forceinline__ void stage_rc(int b, int& R, int& C) { const int st = b / 1024, sb = b % 1024, swz = sb ^ (((sb >> 9) & 1) << 5); R = (st >> 1) * 16 + swz / 64; C = (st & 1) * 32 + (swz % 64) / 2; }
__host__ __device__ __forceinline__ int perm32(int rho) { const int n = rho >> 4, i = rho & 15; return 8 * (i >> 2) + 4 * n + (i & 3); }

struct Unit { int pm, pn; };
struct Gemm { const bf16_t* A; const bf16_t* Bt; int M, N, K, lda, ldb, akoff; };

struct StaticOrder {
    int nM, nN, nwg, G, c;
    __host__ __device__ void init(int M, int N, int G_, int c_) { nM = M / BM; nN = N / BM; nwg = nM * nN; G = G_; c = c_; }
    __host__ __device__ bool next(int i, Unit& u) const {
        const long L = (long)i * G + c; if (L >= nwg) return false;
        int wgid = (int)L; { const int q = nwg / NXCD, r = nwg % NXCD, xcd = wgid % NXCD, off = wgid / NXCD; wgid = (xcd < r ? xcd * (q + 1) : r * (q + 1) + (xcd - r) * q) + off; }
        const int nig = WGM * nN, gid = wgid / nig, fm = gid * WGM, gsz = (nM - fm) < WGM ? (nM - fm) : WGM;
        u.pm = fm + ((wgid % nig) % gsz); u.pn = (wgid % nig) / gsz; return true;
    }
    __device__ __forceinline__ void a_ready(const Unit&) const {}
    __device__ __forceinline__ void done(const Unit&) const {}
};
__device__ __forceinline__ unsigned cvt_pk_bf16(float lo, float hi) { unsigned r; asm volatile("v_cvt_pk_bf16_f32 %0, %1, %2" : "=v"(r) : "v"(lo), "v"(hi)); return r; }
template <class Epi, class Sched, bool ALIGN_EPI = false, bool SP2 = false>
__device__ __forceinline__ void gemm_phase(PG8_LAS unsigned char* lds, const Gemm g, const Sched& S, const Epi& E) {
    const int tid = threadIdx.x, wid = __builtin_amdgcn_readfirstlane(tid >> 6), lane = tid & 63, wr = wid >> 2, wc = wid & 3, fr = lane & 15, fq = lane >> 4;
    const int K = g.K, nt = K / BK;
    unsigned voffA[2], voffB[2];
#pragma unroll
    for (int i = 0; i < 2; ++i) { int R, C; stage_rc(tid * 16 + i * 8192, R, C); const int Rb = Epi::PERM ? ((R & ~31) + perm32(R & 31)) : R;
        voffA[i] = (unsigned)(R * g.lda + C) * 2u; voffB[i] = (unsigned)(Rb * g.ldb + C) * 2u; }
    const size_t kstep = (size_t)(BK * 2);
    const size_t hstepA = (size_t)HALF * g.lda * 2, hstepB = (size_t)HALF * g.ldb * 2;
    const size_t tstepA = 2 * hstepA, tstepB = 2 * hstepB;
    const unsigned ldsw = (unsigned)wid * 1024u;
    const int aoff = lds_byte(wr * 64 + fr, fq * 8), boff = lds_byte(wc * 32 + fr, fq * 8);
#define PG8_SA(b, h) (((b) * 2 + (h)) * HTB)
#define PG8_SB(b, h) ((4 + (b) * 2 + (h)) * HTB)
#define PG8_STAGE(bufoff, gbase, voff) do { _Pragma("unroll") for (int _i = 0; _i < 2; ++_i) \
        __builtin_amdgcn_global_load_lds((const unsigned*)((const char*)(gbase) + (voff)[_i]), (PG8_LAS unsigned*)(lds + (bufoff) + ldsw + _i * 8192), 16, 0, 0); } while (0)
#define PG8_LDA(dst, b, h) do { _Pragma("unroll") for (int m = 0; m < 4; ++m) _Pragma("unroll") for (int k = 0; k < 2; ++k) dst[m][k] = *(const PG8_LAS bf16x8*)(lds + PG8_SA(b, h) + aoff + m * 2048 + k * 1024); } while (0)
#define PG8_LDB(dst, b, h) do { _Pragma("unroll") for (int n = 0; n < 2; ++n) _Pragma("unroll") for (int k = 0; k < 2; ++k) dst[n][k] = *(const PG8_LAS bf16x8*)(lds + PG8_SB(b, h) + boff + n * 2048 + k * 1024); } while (0)
#define PG8_MMA(ai, bj, At, Bt) do { __builtin_amdgcn_s_setprio(1); _Pragma("unroll") for (int m = 0; m < 4; ++m) _Pragma("unroll") for (int n = 0; n < 2; ++n) _Pragma("unroll") for (int k = 0; k < 2; ++k) \
        acc[ai][bj][m][n] = __builtin_amdgcn_mfma_f32_16x16x32_bf16(Bt[n][k], At[m][k], acc[ai][bj][m][n], 0, 0, 0); __builtin_amdgcn_s_setprio(0); } while (0)
#define PG8_WAIT_V(n) asm volatile("s_waitcnt vmcnt(" #n ")" ::: "memory")
#define PG8_WAIT_L(n) asm volatile("s_waitcnt lgkmcnt(" #n ")" ::: "memory")
#define PG8_BAR __builtin_amdgcn_s_barrier()
#define PG8_SCHED __builtin_amdgcn_sched_barrier(0)
    Unit cur, nxt; int ui = 0;
    if (!S.next(0, cur)) return;
    f32x4 acc[2][2][4][2];
#pragma unroll
    for (int a = 0; a < 2; ++a)
#pragma unroll
        for (int b = 0; b < 2; ++b)
#pragma unroll
            for (int m = 0; m < 4; ++m)
#pragma unroll
                for (int n = 0; n < 2; ++n) acc[a][b][m][n] = (f32x4){0.f, 0.f, 0.f, 0.f};
    bf16x8 At[4][2], B0[2][2], B1[2][2];
    const char* cA = (const char*)g.A + (size_t)cur.pm * tstepA + (size_t)cur.pn * g.akoff * 2; const char* cB = (const char*)g.Bt + (size_t)cur.pn * tstepB;
    S.a_ready(cur);
    if constexpr (SP2) {
        PG8_STAGE(PG8_SB(0, 0), cB, voffB); PG8_STAGE(PG8_SB(0, 1), cB + hstepB, voffB); PG8_STAGE(PG8_SA(0, 0), cA, voffA); PG8_STAGE(PG8_SA(0, 1), cA + hstepA, voffA);
        if (wr == 1) PG8_BAR;
        PG8_WAIT_V(2); PG8_BAR;
        PG8_STAGE(PG8_SB(1, 0), cB + kstep, voffB); PG8_STAGE(PG8_SA(1, 0), cA + kstep, voffA); PG8_STAGE(PG8_SB(1, 1), cB + hstepB + kstep, voffB);
        PG8_WAIT_V(6); PG8_BAR;
    } else {
        PG8_STAGE(PG8_SB(0, 0), cB, voffB); PG8_STAGE(PG8_SA(0, 0), cA, voffA); PG8_STAGE(PG8_SB(0, 1), cB + hstepB, voffB); PG8_STAGE(PG8_SA(0, 1), cA + hstepA, voffA);
        if (wr == 1) PG8_BAR;
        PG8_WAIT_V(4); PG8_BAR;
        PG8_STAGE(PG8_SB(1, 0), cB + kstep, voffB); PG8_STAGE(PG8_SA(1, 0), cA + kstep, voffA); PG8_STAGE(PG8_SB(1, 1), cB + hstepB + kstep, voffB);
        PG8_WAIT_V(6); PG8_BAR;
    }
    for (;;) {
        const bool has_next = S.next(ui + 1, nxt);
        const char* nA = has_next ? (const char*)g.A + (size_t)nxt.pm * tstepA + (size_t)nxt.pn * g.akoff * 2 : cA; const char* nB = has_next ? (const char*)g.Bt + (size_t)nxt.pn * tstepB : cB;
        for (int t = 0; t < nt; t += 2) {
            const bool last = (t == nt - 2);
            const char* a1 = cA + (size_t)(t + 1) * kstep;
            const char* a2 = last ? nA : cA + (size_t)(t + 2) * kstep; const char* b2 = last ? nB : cB + (size_t)(t + 2) * kstep;
            const char* a3 = a2 + kstep; const char* b3 = b2 + kstep;
            if (last && has_next) S.a_ready(nxt);
            if constexpr (SP2) {
            PG8_LDB(B0, 0, 0); PG8_LDB(B1, 0, 1); PG8_SCHED; PG8_LDA(At, 0, 0); PG8_STAGE(PG8_SA(1, 1), a1 + hstepA, voffA);
            PG8_WAIT_V(8); PG8_WAIT_L(0); PG8_BAR; PG8_MMA(0, 0, At, B0); PG8_MMA(0, 1, At, B1); PG8_BAR; PG8_SCHED;
            PG8_LDA(At, 0, 1); PG8_STAGE(PG8_SB(0, 0), b2, voffB); PG8_STAGE(PG8_SB(0, 1), b2 + hstepB, voffB); PG8_STAGE(PG8_SA(0, 0), a2, voffA);
            PG8_WAIT_V(8); PG8_WAIT_L(0); PG8_BAR; PG8_MMA(1, 0, At, B0); PG8_MMA(1, 1, At, B1); PG8_BAR; PG8_SCHED;
            PG8_LDB(B0, 1, 0); PG8_LDB(B1, 1, 1); PG8_SCHED; PG8_LDA(At, 1, 0); PG8_STAGE(PG8_SA(0, 1), a2 + hstepA, voffA);
            PG8_WAIT_V(8); PG8_WAIT_L(0); PG8_BAR; PG8_MMA(0, 0, At, B0); PG8_MMA(0, 1, At, B1); PG8_BAR; PG8_SCHED;
            PG8_LDA(At, 1, 1); PG8_STAGE(PG8_SB(1, 0), b3, voffB); PG8_STAGE(PG8_SB(1, 1), b3 + hstepB, voffB); PG8_STAGE(PG8_SA(1, 0), a3, voffA);
            PG8_WAIT_V(8); PG8_WAIT_L(0); PG8_BAR; PG8_MMA(1, 0, At, B0); PG8_MMA(1, 1, At, B1); PG8_BAR; PG8_SCHED;
            } else {
            PG8_LDB(B0, 0, 0); PG8_SCHED; PG8_LDA(At, 0, 0); PG8_STAGE(PG8_SA(1, 1), a1 + hstepA, voffA);
            PG8_WAIT_L(8); PG8_BAR; PG8_WAIT_L(0); PG8_MMA(0, 0, At, B0); PG8_BAR; PG8_SCHED;
            PG8_LDB(B1, 0, 1); PG8_STAGE(PG8_SB(0, 0), b2, voffB);
            PG8_BAR; PG8_WAIT_L(0); PG8_MMA(0, 1, At, B1); PG8_BAR;
            PG8_LDA(At, 0, 1); PG8_STAGE(PG8_SA(0, 0), a2, voffA);
            PG8_BAR; PG8_WAIT_L(0); PG8_MMA(1, 0, At, B0); PG8_BAR; PG8_SCHED;
            PG8_STAGE(PG8_SB(0, 1), b2 + hstepB, voffB);
            PG8_WAIT_V(6); PG8_BAR; PG8_MMA(1, 1, At, B1); PG8_BAR;
            PG8_LDB(B0, 1, 0); PG8_SCHED; PG8_LDA(At, 1, 0); PG8_STAGE(PG8_SA(0, 1), a2 + hstepA, voffA);
            PG8_WAIT_L(8); PG8_BAR; PG8_WAIT_L(0); PG8_MMA(0, 0, At, B0); PG8_BAR; PG8_SCHED;
            PG8_LDB(B1, 1, 1); PG8_STAGE(PG8_SB(1, 0), b3, voffB);
            PG8_BAR; PG8_WAIT_L(0); PG8_MMA(0, 1, At, B1); PG8_BAR;
            PG8_LDA(At, 1, 1); PG8_STAGE(PG8_SA(1, 0), a3, voffA);
            PG8_BAR; PG8_WAIT_L(0); PG8_MMA(1, 0, At, B0); PG8_BAR; PG8_SCHED;
            PG8_STAGE(PG8_SB(1, 1), b3 + hstepB, voffB);
            PG8_WAIT_V(6); PG8_BAR; PG8_MMA(1, 1, At, B1); PG8_BAR;
            }
        }
        if constexpr (ALIGN_EPI) { if (wr == 0) PG8_BAR; }
        if constexpr (!Epi::AFTER_DRAIN) { E(acc, cur, wr, wc, fr, fq); S.done(cur); }
        if (!has_next) break;
#pragma unroll
        for (int a = 0; a < 2; ++a)
#pragma unroll
            for (int b = 0; b < 2; ++b)
#pragma unroll
                for (int m = 0; m < 4; ++m)
#pragma unroll
                    for (int n = 0; n < 2; ++n) acc[a][b][m][n] = (f32x4){0.f, 0.f, 0.f, 0.f};
        cur = nxt; cA = nA; cB = nB; ++ui;
        if constexpr (ALIGN_EPI) { if (wr == 1) PG8_BAR; }
    }
    PG8_WAIT_V(0);
    if constexpr (!ALIGN_EPI) { if (wr == 0) PG8_BAR; }
    PG8_BAR;
    if constexpr (Epi::AFTER_DRAIN) { E.fused(acc, cur, wr, wc, fr, fq, lds, wid, lane); S.done(cur); }
#undef PG8_SA
#undef PG8_SB
#undef PG8_STAGE
#undef PG8_LDA
#undef PG8_LDB
#undef PG8_MMA
#undef PG8_WAIT_V
#undef PG8_WAIT_L
#undef PG8_BAR
#undef PG8_SCHED
}
}
namespace pg8 {
typedef float f32x2 __attribute__((ext_vector_type(2)));
__device__ __forceinline__ float rms_rowscale(const float* ssq, int row) { const f32x4 a = *(const f32x4*)(ssq + (size_t)row * 8), b = *(const f32x4*)(ssq + (size_t)row * 8 + 4);
    return __builtin_amdgcn_rsqf((((a[0] + a[1]) + (a[2] + a[3])) + ((b[0] + b[1]) + (b[2] + b[3]))) * (1.0f / 2048.0f) + 1e-6f); }
struct SegTab { bf16_t* base[8]; int ldc[8]; int t0[8]; int gw[8]; int nseg; int pad_; };
struct EpiBf16R {
    static constexpr bool PERM = true, AFTER_DRAIN = false;
    SegTab T; const float* ssp; int ss_off;
    __device__ __forceinline__ void operator()(const f32x4 (&acc)[2][2][4][2], const Unit& u, int wr, int wc, int fr, int fq) const {
        bf16_t* base = T.base[0]; int ldc = T.ldc[0], gw = T.gw[0], t0 = T.t0[0];
#pragma unroll
        for (int s = 1; s < 8; ++s) if (s < T.nseg && u.pn >= T.t0[s]) { base = T.base[s]; ldc = T.ldc[s]; gw = T.gw[s]; t0 = T.t0[s]; }
        const int colt = (u.pn - t0) * BM, row0 = u.pm * BM + wr * 64 + fr;
#pragma unroll
        for (int ai = 0; ai < 2; ++ai)
#pragma unroll
            for (int m = 0; m < 4; ++m) { const int row = row0 + ai * HALF + m * 16;
                const float rs = ssp ? rms_rowscale(ssp, ss_off + row) : 1.0f;
#pragma unroll
                for (int bj = 0; bj < 2; ++bj) { const int col = colt + bj * HALF + wc * 32 + 8 * fq;
                    const f32x4 v0 = acc[ai][bj][m][0] * rs, v1 = acc[ai][bj][m][1] * rs;
                    u32x4 w; w.x = cvt_pk_bf16(v0[0], v0[1]); w.y = cvt_pk_bf16(v0[2], v0[3]); w.z = cvt_pk_bf16(v1[0], v1[1]); w.w = cvt_pk_bf16(v1[2], v1[3]);
                    if (gw == -2) {
                        if ((row >> 5) < ldc) { bf16_t* d0 = base + ((size_t)(((col >> 5) * ldc + (row >> 5)) * 2 + ((col >> 4) & 1)) * 64 + (row & 31)) * 8 + 4 * ((col >> 3) & 1);
                            typedef unsigned u32x2_ __attribute__((ext_vector_type(2)));
                            *(u32x2_*)d0 = (u32x2_){w.x, w.y}; *(u32x2_*)(d0 + 32 * 8) = (u32x2_){w.z, w.w}; }
                        continue; }
                    bf16_t* dst;
                    if (gw == 0) dst = base + (size_t)row * ldc + col;
                    else if (gw == -1) { if ((col >> 4) >= ldc) continue; dst = base + ((size_t)((row >> 5) * ldc + (col >> 4)) * 64 + ((col >> 3) & 1) * 32 + (row & 31)) * 8; }
                    else { const int g = col / gw, d = col - g * gw; dst = base + ((size_t)((row >> 12) * 4 + g) * 4096 + (row & 4095)) * gw + d; }
                    *(u32x4*)dst = w; } }
    }
};
struct EpiGelu {
    static constexpr bool PERM = true, AFTER_DRAIN = false;
    bf16_t* O; int ldc; const float* bias;
    static __device__ __forceinline__ float gelu(float x) { const float u2 = 1.5957691216f * (x + 0.044715f * x * x * x); const float e = __builtin_amdgcn_exp2f(-u2 * 1.4426950409f); return x * __builtin_amdgcn_rcpf(1.0f + e); }
    __device__ __forceinline__ void operator()(const f32x4 (&acc)[2][2][4][2], const Unit& u, int wr, int wc, int fr, int fq) const {
        const int row0 = u.pm * BM + wr * 64 + fr, col0 = u.pn * BM + wc * 32 + 8 * fq;
#pragma unroll
        for (int bj = 0; bj < 2; ++bj) { const f32x4 b0 = *(const f32x4*)(bias + col0 + bj * HALF), b1 = *(const f32x4*)(bias + col0 + bj * HALF + 4);
#pragma unroll
            for (int ai = 0; ai < 2; ++ai)
#pragma unroll
                for (int m = 0; m < 4; ++m) { const f32x4 v0 = acc[ai][bj][m][0] + b0, v1 = acc[ai][bj][m][1] + b1;
                    u32x4 w; w.x = cvt_pk_bf16(gelu(v0[0]), gelu(v0[1])); w.y = cvt_pk_bf16(gelu(v0[2]), gelu(v0[3])); w.z = cvt_pk_bf16(gelu(v1[0]), gelu(v1[1])); w.w = cvt_pk_bf16(gelu(v1[2]), gelu(v1[3]));
                    *(u32x4*)(O + (size_t)(row0 + ai * HALF + m * 16) * ldc + col0 + bj * HALF) = w; } }
    }
};
struct EpiF32 {
    static constexpr bool PERM = false, AFTER_DRAIN = false;
    float* C; int ldc; const float* ssp; int ss_off;
    __device__ __forceinline__ void operator()(const f32x4 (&acc)[2][2][4][2], const Unit& u, int wr, int wc, int fr, int fq) const {
        const int row0 = u.pm * BM + wr * 64 + fr, col0 = u.pn * BM + wc * 32 + 4 * fq;
#pragma unroll
        for (int ai = 0; ai < 2; ++ai)
#pragma unroll
            for (int m = 0; m < 4; ++m) { float* rowp = C + (size_t)(row0 + ai * HALF + m * 16) * ldc + col0;
                const float rs = ssp ? rms_rowscale(ssp, ss_off + row0 + ai * HALF + m * 16) : 1.0f;
#pragma unroll
                for (int bj = 0; bj < 2; ++bj)
#pragma unroll
                    for (int n = 0; n < 2; ++n) *(f32x4*)(rowp + bj * HALF + n * 16) = acc[ai][bj][m][n] * rs; }
    }
};
struct EpiResN {
    static constexpr bool PERM = false, AFTER_DRAIN = false;
    const float* res32; const float* gprev; float* out32; int ldc; int row_off; const float* g; bf16_t* xn; float* ss; PG8_LAS float* xb;
    __device__ __forceinline__ void operator()(const f32x4 (&acc)[2][2][4][2], const Unit& u, int wr, int wc, int fr, int fq) const {
        typedef unsigned u32x2_ __attribute__((ext_vector_type(2)));
        const int row0 = row_off + u.pm * BM + wr * 64 + fr, col0 = u.pn * BM + wc * 32 + 4 * fq;
        f32x4 gv[2][2], gi[2][2];
#pragma unroll
        for (int bj = 0; bj < 2; ++bj)
#pragma unroll
            for (int n = 0; n < 2; ++n) { gv[bj][n] = g ? *(const f32x4*)(g + col0 + bj * HALF + n * 16) : (f32x4){0.f, 0.f, 0.f, 0.f};
                if (!res32) { const f32x4 t = *(const f32x4*)(gprev + col0 + bj * HALF + n * 16); gi[bj][n] = (f32x4){1.0f / t[0], 1.0f / t[1], 1.0f / t[2], 1.0f / t[3]}; } else gi[bj][n] = (f32x4){1.f, 1.f, 1.f, 1.f}; }
#pragma unroll
        for (int ai = 0; ai < 2; ++ai)
#pragma unroll
            for (int m = 0; m < 4; ++m) { const int row = row0 + ai * HALF + m * 16; const size_t off = (size_t)row * ldc + col0;
                f32x4 r[2][2]; float sq = 0.f;
#pragma unroll
                for (int bj = 0; bj < 2; ++bj)
#pragma unroll
                    for (int n = 0; n < 2; ++n) {
                        if (res32) r[bj][n] = *(const f32x4*)(res32 + off + bj * HALF + n * 16);
                        else { const u32x2_ w = *(const u32x2_*)(xn + off + bj * HALF + n * 16);
                            r[bj][n] = (f32x4){__builtin_bit_cast(float, w.x << 16), __builtin_bit_cast(float, w.x & 0xffff0000u), __builtin_bit_cast(float, w.y << 16), __builtin_bit_cast(float, w.y & 0xffff0000u)} * gi[bj][n]; } }
#pragma unroll
                for (int bj = 0; bj < 2; ++bj)
#pragma unroll
                    for (int n = 0; n < 2; ++n) { const f32x4 o = r[bj][n] + acc[ai][bj][m][n];
                        if (out32) *(f32x4*)(out32 + off + bj * HALF + n * 16) = o;
                        if (g) { sq += (o[0] * o[0] + o[1] * o[1]) + (o[2] * o[2] + o[3] * o[3]);
                            const f32x4 y = o * gv[bj][n]; *(u32x2_*)(xn + off + bj * HALF + n * 16) = (u32x2_){cvt_pk_bf16(y[0], y[1]), cvt_pk_bf16(y[2], y[3])}; } }
                if (g) { sq += __shfl_xor(sq, 16); sq += __shfl_xor(sq, 32);
                    if (fq == 0) xb[(ai * HALF + wr * 64 + m * 16 + fr) * 4 + wc] = sq; }
                asm volatile("" ::: "memory"); }
        if (g) {
            asm volatile("s_waitcnt lgkmcnt(0)" ::: "memory"); __builtin_amdgcn_s_barrier(); asm volatile("" ::: "memory");
            const int t = (wr * 4 + wc) * 64 + fq * 16 + fr;
            if (t < BM) { const f32x4 v = *(const PG8_LAS f32x4*)(xb + t * 4); ss[(size_t)(row_off + u.pm * BM + t) * 8 + u.pn] = (v[0] + v[1]) + (v[2] + v[3]); }
        }
    }
};
struct EpiConvGlu {
    static constexpr bool PERM = true, AFTER_DRAIN = false;
    bf16_t* G; float* UB; const float* cw; const float* cb; PG8_LAS float* xb; int dff; const PG8_LAS float* rstd; int rbase;
    static __device__ __forceinline__ float shr(float old, float src, int n) { const int o = __builtin_bit_cast(int, old), s = __builtin_bit_cast(int, src);
        return __builtin_bit_cast(float, n == 1 ? __builtin_amdgcn_update_dpp(o, s, 0x111, 0xf, 0xf, false) : __builtin_amdgcn_update_dpp(o, s, 0x112, 0xf, 0xf, false)); }
    static __device__ __forceinline__ float ror(float src, int n) { const int s = __builtin_bit_cast(int, src);
        return __builtin_bit_cast(float, n == 1 ? __builtin_amdgcn_update_dpp(0, s, 0x121, 0xf, 0xf, false) : __builtin_amdgcn_update_dpp(0, s, 0x122, 0xf, 0xf, false)); }
    __device__ __forceinline__ void operator()(f32x4 (&acc)[2][2][4][2], const Unit& u, int wr, int wc, int fr, int fq) const {
        typedef unsigned u32x2_ __attribute__((ext_vector_type(2)));
        if (rstd) {
#pragma unroll
            for (int ai = 0; ai < 2; ++ai)
#pragma unroll
                for (int m = 0; m < 4; ++m) { const float rs = rstd[u.pm * BM + ai * HALF + wr * 64 + m * 16 + fr - rbase];
#pragma unroll
                    for (int bj = 0; bj < 2; ++bj)
#pragma unroll
                        for (int n = 0; n < 2; ++n) acc[ai][bj][m][n] = acc[ai][bj][m][n] * rs; }
        }
        if (fr >= 14) {
#pragma unroll
            for (int ai = 0; ai < 2; ++ai)
#pragma unroll
                for (int bj = 0; bj < 2; ++bj)
#pragma unroll
                    for (int n = 0; n < 2; ++n) *(PG8_LAS f32x4*)(xb + (((((ai * 2 + wr) * 4 + wc) * 2 + (fr - 14)) * 4 + fq) * 16) + (bj * 2 + n) * 4) = acc[ai][bj][3][n];
        }
        { const int ncol = 4 * dff / 2;
          const bool top = (wr == 0 && fr < 2), bot = (wr == 1 && fr >= 14);
          if (top || bot) { float* ub = UB + ((size_t)(u.pm * 4 + (top ? fr : 2 + fr - 14)) * ncol) + u.pn * BM + wc * 32 + 8 * fq;
#pragma unroll
            for (int bj = 0; bj < 2; ++bj)
#pragma unroll
                for (int n = 0; n < 2; ++n) *(f32x4*)(ub + bj * HALF + 4 * n) = top ? acc[0][bj][0][n] : acc[1][bj][3][n]; } }
        asm volatile("s_waitcnt lgkmcnt(0)" ::: "memory"); __builtin_amdgcn_s_barrier(); asm volatile("" ::: "memory");
        u32x2_ res[2][4][2];
        const int ch0 = u.pn * HALF + wc * 32 + 8 * fq;
#pragma unroll
        for (int n = 0; n < 2; ++n) {
            const float* wp = cw + ch0 + 4 * n; const float* bp = cb + ch0 + 4 * n;
            const f32x4 w0g = *(const f32x4*)(wp), w1g = *(const f32x4*)(wp + 2 * dff), w2g = *(const f32x4*)(wp + 4 * dff), bg = *(const f32x4*)(bp);
            const f32x4 w0v = *(const f32x4*)(wp + dff), w1v = *(const f32x4*)(wp + 3 * dff), w2v = *(const f32x4*)(wp + 5 * dff), bv = *(const f32x4*)(bp + dff);
#pragma unroll
            for (int ai = 0; ai < 2; ++ai)
#pragma unroll
                for (int m = 0; m < 4; ++m) {
                    const f32x4 cg = acc[ai][0][m][n], cv = acc[ai][1][m][n];
                    f32x4 b1g, b2g, b1v, b2v;
                    if (m > 0) {
#pragma unroll
                        for (int e = 0; e < 4; ++e) { b1g[e] = ror(acc[ai][0][m - 1][n][e], 1); b2g[e] = ror(acc[ai][0][m - 1][n][e], 2); b1v[e] = ror(acc[ai][1][m - 1][n][e], 1); b2v[e] = ror(acc[ai][1][m - 1][n][e], 2); }
                    } else {
                        const int sai = wr ? ai : ai - 1, swr = wr ? 0 : 1;
                        f32x4 x14g = {0.f, 0.f, 0.f, 0.f}, x15g = x14g, x14v = x14g, x15v = x14g;
                        if (sai >= 0) { const PG8_LAS float* xp = xb + (((((sai * 2 + swr) * 4 + wc) * 2) * 4 + fq) * 16);
                            x14g = *(const PG8_LAS f32x4*)(xp + n * 4); x14v = *(const PG8_LAS f32x4*)(xp + (2 + n) * 4); x15g = *(const PG8_LAS f32x4*)(xp + 64 + n * 4); x15v = *(const PG8_LAS f32x4*)(xp + 64 + (2 + n) * 4); }
                        b1g = x15g; b1v = x15v; b2g = fr == 0 ? x14g : x15g; b2v = fr == 0 ? x14v : x15v;
                    }
                    float o[4];
#pragma unroll
                    for (int e = 0; e < 4; ++e) {
                        const float p1g = shr(b1g[e], cg[e], 1), p2g = shr(b2g[e], cg[e], 2), p1v = shr(b1v[e], cv[e], 1), p2v = shr(b2v[e], cv[e], 2);
                        const float yg = bg[e] + w0g[e] * p2g + w1g[e] * p1g + w2g[e] * cg[e], yv = bv[e] + w0v[e] * p2v + w1v[e] * p1v + w2v[e] * cv[e];
                        o[e] = yg * __builtin_amdgcn_rcpf(1.0f + __builtin_amdgcn_exp2f(-yg * 1.4426950409f)) * yv;
                    }
                    res[ai][m][n] = (u32x2_){cvt_pk_bf16(o[0], o[1]), cvt_pk_bf16(o[2], o[3])};
                }
        }
        const int row0 = u.pm * BM + wr * 64 + fr;
#pragma unroll
        for (int ai = 0; ai < 2; ++ai)
#pragma unroll
            for (int m = 0; m < 4; ++m) *(u32x4*)(G + (size_t)(row0 + ai * HALF + m * 16) * dff + ch0) = (u32x4){res[ai][m][0].x, res[ai][m][0].y, res[ai][m][1].x, res[ai][m][1].y};
    }
};
}
constexpr int BATCH = 8, SEQ = 4096, DM = 2048, MTOT = BATCH * SEQ, MC = MTOT / 2  , BPH = BATCH / 2;
constexpr int DFF = 5632;
constexpr float NORM_EPS = 1e-6f, LOG2E = 1.4426950408889634f;
constexpr int NWAVES = 8;
constexpr size_t MiB = 1u << 20;
constexpr size_t WS_CTL = 0, CTL_ZERO_BYTES = 1 * MiB;
constexpr size_t WS_TAB = 1 * MiB;
constexpr size_t TAB_COS48 = WS_TAB, TAB_SIN48 = WS_TAB + 3 * MiB, TAB_COS32 = WS_TAB + 6 * MiB, TAB_SIN32 = WS_TAB + 8 * MiB;
constexpr size_t WS_WMIX = 12 * MiB;
constexpr size_t WS_WFFN = 100 * MiB;
constexpr size_t WS_MISC = 168 * MiB;
constexpr size_t WS_SS = 170 * MiB;
constexpr size_t WS_XNR = 1010 * MiB;
constexpr size_t WS_AR = 234 * MiB;
constexpr size_t WS_END = 1138 * MiB;
constexpr int CW_TMO = 0;
constexpr int CW_BAR = 4096;
constexpr int RING_BYTES = 131072;
constexpr int LDSCTL_OFF = 135168;
constexpr int LDS_BYTES = 163840;

#define GAS __attribute__((address_space(1)))
#define LAS __attribute__((address_space(3)))
typedef unsigned short bf16;
typedef unsigned u32x4 __attribute__((ext_vector_type(4)));
typedef unsigned u32x2 __attribute__((ext_vector_type(2)));
typedef float f32x4 __attribute__((ext_vector_type(4)));
typedef float f32x16 __attribute__((ext_vector_type(16)));
typedef short bf16x8 __attribute__((ext_vector_type(8)));
typedef short s16x4 __attribute__((ext_vector_type(4)));
typedef short v4i16_t __attribute__((ext_vector_type(4)));
typedef __bf16 bf16x2_t __attribute__((ext_vector_type(2)));
typedef float f32x2_t __attribute__((ext_vector_type(2)));
#define LDS_WAIT() asm volatile("s_waitcnt lgkmcnt(0)" ::: "memory")
#define VM_WAIT() asm volatile("s_waitcnt vmcnt(0)" ::: "memory")
#define MFMA32(a, b, c) __builtin_amdgcn_mfma_f32_32x32x16_bf16((a), (b), (c), 0, 0, 0)
DI unsigned pk2(float lo, float hi) { f32x2_t v = {lo, hi}; bf16x2_t b = __builtin_convertvector(v, bf16x2_t); return __builtin_bit_cast(unsigned, b); }
DI float bf2f(unsigned short b) { return __builtin_bit_cast(float, (unsigned)b << 16); }
DI float bflo(unsigned w) { return __builtin_bit_cast(float, w << 16); }
DI float bfhi(unsigned w) { return __builtin_bit_cast(float, w & 0xffff0000u); }
DI unsigned short f2bf(float f) { return (unsigned short)(pk2(f, 0.f) & 0xffffu); }
DI float wave_sum(float v) {
#pragma unroll
    for (int o = 1; o < 64; o <<= 1) v += __shfl_xor(v, o);
    return v;
}
DI int crow(int i, int h) { return (i & 3) + 8 * (i >> 2) + 4 * h; }
#define XB_TMO      128
#define XB_XCNT(j)  (256  + 64 * (j))
#define XB_XSUB(j)  (1280 + 64 * (j))
#define XB_XGEN(j)  (2304 + 64 * (j))
#define XB_TOP      3328
#define XB_TOPGEN   3392
#define XCD_BAR_WORDS 3456
#define XB_SPIN_CAP (1u << 18)

__device__ __forceinline__ unsigned xb_ld(unsigned* p)              { return __hip_atomic_load(p, __ATOMIC_RELAXED, __HIP_MEMORY_SCOPE_AGENT); }
__device__ __forceinline__ unsigned xb_add(unsigned* p, unsigned v) { return __hip_atomic_fetch_add(p, v, __ATOMIC_RELAXED, __HIP_MEMORY_SCOPE_AGENT); }
__device__ __forceinline__ unsigned xb_xcc_id() { return (unsigned)__builtin_amdgcn_s_getreg((3 << 11) | 20) & 0xFu; }
#define XB_SPIN(cond, bar) do { unsigned _sp = 0; while (cond) { __builtin_amdgcn_s_sleep(1); \
    if ((++_sp & 255u) == 0u) { if (xb_ld(&(bar)[XB_TMO])) break; if (_sp > XB_SPIN_CAP) { atomicAdd(&(bar)[XB_TMO], 1u); break; } } } } while (0)

struct XcdBarrier {
    unsigned* bar; unsigned x;
    volatile LAS unsigned* st;
};

__device__ __forceinline__ XcdBarrier xcd_barrier_post(unsigned* bar, volatile LAS unsigned* st) {
    XcdBarrier b; b.bar = bar; b.x = xb_xcc_id(); b.st = st;
    if (threadIdx.x == 0) (void)xb_add(&bar[XB_XCNT(b.x)], 1u);
    return b;
}
__device__ __forceinline__ void xcd_barrier_complete(unsigned* bar, unsigned x, unsigned& nloc, unsigned& nx) {
    const unsigned G = gridDim.x * gridDim.y * gridDim.z;
    unsigned sum, cnt, mine, sp = 0u;
    for (;;) {
        sum = 0u; cnt = 0u; mine = 0u;
#pragma unroll
        for (unsigned j = 0; j < 16; ++j) { const unsigned c = xb_ld(&bar[XB_XCNT(j)]); sum += c; cnt += (c > 0u) ? 1u : 0u; mine = (j == x) ? c : mine; }
        if (sum == G) break;
        __builtin_amdgcn_s_sleep(1);
        if ((++sp & 255u) == 0u) { if (xb_ld(&bar[XB_TMO])) break; if (sp > XB_SPIN_CAP) { atomicAdd(&bar[XB_TMO], 1u); break; } }
    }
    nloc = mine > 0u ? mine : 1u; nx = cnt > 0u ? cnt : 1u;
}

__device__ __forceinline__ void xcd_barrier(const XcdBarrier& b) {
    asm volatile("s_waitcnt vmcnt(0)" ::: "memory");
    __syncthreads();
    if (threadIdx.x == 0) {
        unsigned* bar = b.bar;
        __builtin_amdgcn_s_waitcnt(0);
        unsigned nloc = b.st[0], nx = b.st[1];
        if (nloc == 0u) { xcd_barrier_complete(bar, b.x, nloc, nx); b.st[0] = nloc; b.st[1] = nx; }
        const unsigned old = xb_add(&bar[XB_XSUB(b.x)], 1u);
        const unsigned gen = old / nloc;
        if (old + 1u == (gen + 1u) * nloc) {
            __builtin_amdgcn_fence(__ATOMIC_RELEASE, "agent");
            asm volatile("s_waitcnt vmcnt(0)" ::: "memory");
            const unsigned og = xb_add(&bar[XB_TOP], 1u);
            const unsigned tg = og / nx;
            if (og + 1u == (tg + 1u) * nx) xb_add(&bar[XB_TOPGEN], 1u);
            else XB_SPIN(xb_ld(&bar[XB_TOPGEN]) == tg, bar);
            __builtin_amdgcn_fence(__ATOMIC_ACQUIRE, "agent");
            xb_add(&bar[XB_XGEN(b.x)], 1u);
            asm volatile("s_waitcnt vmcnt(0)" ::: "memory");
        } else {
            XB_SPIN(xb_ld(&bar[XB_XGEN(b.x)]) == gen, bar);
            __builtin_amdgcn_fence(__ATOMIC_ACQUIRE, "agent");
            asm volatile("s_waitcnt vmcnt(0)" ::: "memory");
        }
    }
    __syncthreads();
}
struct Frame {
    LAS unsigned char* lds; unsigned* ctl; unsigned char* ws;
    int tid, lane, wave, G, gw, NGW;
};
DI void ph_tables(const Frame& F, const int* pos) {
    float* c48 = (float*)(F.ws + TAB_COS48); float* s48 = (float*)(F.ws + TAB_SIN48); float* c32 = (float*)(F.ws + TAB_COS32); float* s32 = (float*)(F.ws + TAB_SIN32);
    const int gt = blockIdx.x * (NWAVES * 64) + F.tid, NT = F.G * NWAVES * 64;
    for (int i = gt; i < MTOT * 40; i += NT) {
        const int m = i / 40, j = i - m * 40; const float p = (float)pos[m];
        const bool a = j < 24; const int jj = a ? j : j - 24;
        const float inv = (float)exp(-(2.0 * jj / (a ? 48.0 : 32.0)) * 13.122363377404328);
        const float ang = p * inv; float sn, cs; sincosf(ang, &sn, &cs);
        if (a) { c48[m * 24 + jj] = cs; s48[m * 24 + jj] = sn; } else { c32[m * 16 + jj] = cs; s32[m * 16 + jj] = sn; }
    }
}
DI void cvt_load(float (&v)[32], const float* W, int ldw, int col0, int ncols, int item, int nblk, int lane) {
    const int kb = item / nblk, nb = item - kb * nblk, k0 = 64 * kb, n0 = 32 * nb, nn = n0 + (lane & 31); const bool ok = nn < ncols;
    const float* p = W + (size_t)(k0 + (lane >> 5)) * ldw + col0 + (ok ? nn : 0);
#pragma unroll
    for (int i = 0; i < 32; ++i) { const float x = p[(size_t)(2 * i) * ldw]; v[i] = ok ? x : 0.f; }
}
DI void cvt_store(const float (&v)[32], int ncols, bf16* WT, int ldt, int row_off, float scale, LAS float* scr, int item, int nblk, int lane) {
    const int kb = item / nblk, nb = item - kb * nblk, k0 = 64 * kb, n0 = 32 * nb;
#pragma unroll
    for (int i = 0; i < 32; ++i) scr[(2 * i + (lane >> 5)) * 33 + (lane & 31)] = v[i] * scale;
    LDS_WAIT();
    const int c = lane & 7;
#pragma unroll
    for (int j = 0; j < 4; ++j) { const int n = (lane >> 3) + 8 * j; const LAS float* s = scr + (8 * c) * 33 + n;
        u32x4 o; o.x = pk2(s[0 * 33], s[1 * 33]); o.y = pk2(s[2 * 33], s[3 * 33]); o.z = pk2(s[4 * 33], s[5 * 33]); o.w = pk2(s[6 * 33], s[7 * 33]);
        if (n0 + n < ncols) *(u32x4*)(WT + (size_t)(row_off + n0 + n) * ldt + k0 + 8 * c) = o; }
    LDS_WAIT();
}
DI void cvt_item(const float* W, int ldw, int col0, int ncols, bf16* WT, int ldt, int row_off, float scale, LAS float* scr, int item, int nblk, int lane) {
    float v[32]; cvt_load(v, W, ldw, col0, ncols, item, nblk, lane); cvt_store(v, ncols, WT, ldt, row_off, scale, scr, item, nblk, lane);
}
template <class MAP> DI void cvt_loop(const Frame& F, const float* W, int ldw, int ncols, bf16* WT, int ldt, float scale, int nitems, int nblk, const MAP& map) {
    LAS float* scr = (LAS float*)(F.lds + F.wave * 16384);
    int it = F.gw; float cur[32]; int c0 = 0, ro = 0, li = 0;
    if (it < nitems) { map(it, c0, ro, li); cvt_load(cur, W, ldw, c0, ncols, li, nblk, F.lane); }
#pragma unroll 1
    for (; it < nitems; it += F.NGW) {
        float nxt[32]; int c1 = 0, r1 = 0, l1 = 0; const int ni = it + F.NGW;
        if (ni < nitems) { map(ni, c1, r1, l1); cvt_load(nxt, W, ldw, c1, ncols, l1, nblk, F.lane); }
        cvt_store(cur, ncols, WT, ldt, ro, scale, scr, li, nblk, F.lane);
#pragma unroll
        for (int i = 0; i < 32; ++i) cur[i] = nxt[i];
        c0 = c1; ro = r1; li = l1;
    }
}
struct CvtPlain { int col0, row_off; DI void operator()(int it, int& c, int& r, int& l) const { c = col0; r = row_off; l = it; } };
DI void cvt_job(const Frame& F, const float* W, int ldw, int K, int col0, int ncols, bf16* WT, int ldt, int row_off, float scale) {
    const int nblk = (ncols + 31) / 32;
    cvt_loop(F, W, ldw, ncols, WT, ldt, scale, (K / 64) * nblk, nblk, CvtPlain{col0, row_off});
}
DI void zero_bf16(const Frame& F, bf16* p, size_t nelem) {
    const size_t gt = (size_t)blockIdx.x * (NWAVES * 64) + F.tid, NT = (size_t)F.G * NWAVES * 64;
    for (size_t i = gt; i < nelem / 8; i += NT) ((u32x4*)p)[i] = (u32x4){0u, 0u, 0u, 0u};
}
DI void ph_cvt_ffn(const Frame& F, const float* up, const float* down) {
    bf16* WUP = (bf16*)(F.ws + WS_WFFN); bf16* WDN = WUP + (size_t)2 * DFF * DM;
    struct UpMap { DI void operator()(int it, int& c, int& r, int& l) const { const int seg = it >> 7, pn = seg >> 1, isv = seg & 1; c = isv * DFF + pn * 128; r = pn * 256 + isv * 128; l = it & 127; } };
    cvt_loop(F, up, 2 * DFF, 128, WUP, DM, 1.f, 88 * 128, 4, UpMap{});
    cvt_job(F, down, DM, DFF, 0, DM, WDN, DFF, 0, 1.f);
}
DI void ph_conv_fix(const Frame& F, const float* UB, bf16* Gb, const float* cw, const float* cb, const int nrows = MC) {
    const int gt = blockIdx.x * (NWAVES * 64) + F.tid, NT = F.G * NWAVES * 64;
    for (int it = gt; it < (nrows / 256) * (DFF / 4); it += NT) {
        const int pm = it / (DFF / 4), c4 = it - pm * (DFF / 4), ch = c4 * 4, col = (ch >> 7) * 256 + (ch & 127);
        const float* ub = UB + (size_t)pm * 4 * (2 * DFF) + col; const bool has = (pm & 15) != 0;
        const f32x4 z = {0.f, 0.f, 0.f, 0.f};
        const f32x4 g0 = *(const f32x4*)(ub), g1 = *(const f32x4*)(ub + 2 * DFF), v0 = *(const f32x4*)(ub + 128), v1 = *(const f32x4*)(ub + 2 * DFF + 128);
        const f32x4 gm2 = has ? *(const f32x4*)(ub - 2 * (2 * DFF)) : z, gm1 = has ? *(const f32x4*)(ub - (2 * DFF)) : z, vm2 = has ? *(const f32x4*)(ub - 2 * (2 * DFF) + 128) : z, vm1 = has ? *(const f32x4*)(ub - (2 * DFF) + 128) : z;
        const f32x4 w0g = *(const f32x4*)(cw + ch), w1g = *(const f32x4*)(cw + 2 * DFF + ch), w2g = *(const f32x4*)(cw + 4 * DFF + ch), bg = *(const f32x4*)(cb + ch);
        const f32x4 w0v = *(const f32x4*)(cw + DFF + ch), w1v = *(const f32x4*)(cw + 3 * DFF + ch), w2v = *(const f32x4*)(cw + 5 * DFF + ch), bv = *(const f32x4*)(cb + DFF + ch);
        float o0[4], o1[4];
#pragma unroll
        for (int e = 0; e < 4; ++e) {
            const float yg0 = bg[e] + w0g[e] * gm2[e] + w1g[e] * gm1[e] + w2g[e] * g0[e], yv0 = bv[e] + w0v[e] * vm2[e] + w1v[e] * vm1[e] + w2v[e] * v0[e];
            const float yg1 = bg[e] + w0g[e] * gm1[e] + w1g[e] * g0[e] + w2g[e] * g1[e], yv1 = bv[e] + w0v[e] * vm1[e] + w1v[e] * v0[e] + w2v[e] * v1[e];
            o0[e] = yg0 * __builtin_amdgcn_rcpf(1.0f + __builtin_amdgcn_exp2f(-yg0 * LOG2E)) * yv0; o1[e] = yg1 * __builtin_amdgcn_rcpf(1.0f + __builtin_amdgcn_exp2f(-yg1 * LOG2E)) * yv1;
        }
        u32x2 a, b; a.x = pk2(o0[0], o0[1]); a.y = pk2(o0[2], o0[3]); b.x = pk2(o1[0], o1[1]); b.y = pk2(o1[2], o1[3]);
        *(u32x2*)(Gb + (size_t)(pm * 256) * DFF + ch) = a; *(u32x2*)(Gb + (size_t)(pm * 256 + 1) * DFF + ch) = b;
    }
}
DI void ph_norm_first(const Frame& F, const float* src, const float* gain, bf16* XNR, float* ss) {
    f32x4 g[8];
#pragma unroll
    for (int j = 0; j < 8; ++j) g[j] = *(const f32x4*)(gain + 4 * (F.lane + 64 * j));
    for (int m = F.gw; m < MTOT; m += F.NGW) {
        const f32x4* xr = (const f32x4*)(src + (size_t)m * DM) + F.lane;
        f32x4 v[8]; float s2 = 0.f;
#pragma unroll
        for (int j = 0; j < 8; ++j) { v[j] = xr[64 * j]; s2 += (v[j].x * v[j].x + v[j].y * v[j].y) + (v[j].z * v[j].z + v[j].w * v[j].w); }
        s2 = wave_sum(s2);
        if (F.lane < 2) *(f32x4*)(ss + (size_t)m * 8 + 4 * F.lane) = (f32x4){F.lane == 0 ? s2 : 0.f, 0.f, 0.f, 0.f};
        u32x2* o = (u32x2*)(XNR + (size_t)m * DM) + F.lane;
#pragma unroll
        for (int j = 0; j < 8; ++j) { const f32x4 y = v[j] * g[j]; u32x2 w; w.x = pk2(y.x, y.y); w.y = pk2(y.z, y.w); o[64 * j] = w; }
    }
}
DI void ph_final_norm(const Frame& F, float* h, const float* gain) {
    f32x4 g[8];
#pragma unroll
    for (int j = 0; j < 8; ++j) g[j] = *(const f32x4*)(gain + 4 * (F.lane + 64 * j));
    for (int m = F.gw; m < MTOT; m += F.NGW) {
        f32x4* xr = (f32x4*)(h + (size_t)m * DM) + F.lane;
        f32x4 v[8]; float ss = 0.f;
#pragma unroll
        for (int j = 0; j < 8; ++j) { v[j] = xr[64 * j]; ss += (v[j].x * v[j].x + v[j].y * v[j].y) + (v[j].z * v[j].z + v[j].w * v[j].w); }
        const float rstd = 1.0f / sqrtf(wave_sum(ss) * (1.f / DM) + NORM_EPS);
#pragma unroll
        for (int j = 0; j < 8; ++j) xr[64 * j] = v[j] * rstd * g[j];
    }
}
DI void rope_piece(const bf16* qrow, int p, const float* cs, const float* sn, float (&o)[8]) {
    const bool lo = p < 3; const int pp = lo ? p + 3 : p - 3, i0 = 8 * (lo ? p : p - 3);
    const u32x4 a = *(const u32x4*)(qrow + 8 * p), b = *(const u32x4*)(qrow + 8 * pp);
    const f32x4 c0 = *(const f32x4*)(cs + i0), c1 = *(const f32x4*)(cs + i0 + 4), s0 = *(const f32x4*)(sn + i0), s1 = *(const f32x4*)(sn + i0 + 4);
#pragma unroll
    for (int e = 0; e < 4; ++e) { const float c_l = e < 2 ? c0[2 * e] : c1[2 * e - 4], c_h = e < 2 ? c0[2 * e + 1] : c1[2 * e - 3], s_l = e < 2 ? s0[2 * e] : s1[2 * e - 4], s_h = e < 2 ? s0[2 * e + 1] : s1[2 * e - 3];
        const float al = bflo(a[e]), ah = bfhi(a[e]), bl_ = bflo(b[e]), bh_ = bfhi(b[e]);
        o[2 * e] = lo ? al * c_l - bl_ * s_l : bl_ * s_l + al * c_l; o[2 * e + 1] = lo ? ah * c_h - bh_ * s_h : bh_ * s_h + ah * c_h; }
}
DI bf16x8 rope_frag32(const bf16* qrow, int s, int h, const float* cs, const float* sn) {
    float o[8]; rope_piece(qrow, 2 * s + h, cs, sn, o);
    u32x4 w; w.x = pk2(o[0], o[1]); w.y = pk2(o[2], o[3]); w.z = pk2(o[4], o[5]); w.w = pk2(o[6], o[7]); return __builtin_bit_cast(bf16x8, w);
}
constexpr size_t DA_DIN = 0, DA_CQN = 64 * MiB, DA_LATC = 80 * MiB, DA_KPE = 88 * MiB, DA_KIDX = 90 * MiB, DA_WIDX = 94 * MiB, DA_QL = 96 * MiB, DA_QPE = 352 * MiB, DA_QIDX = 400 * MiB,
                 DA_SEL = 464 * MiB, DA_CNT = 472 * MiB, DA_SC = 474 * MiB, DA_O2 = 474 * MiB;
constexpr size_t DW_W1 = 0, DW_W2 = (size_t)1024 * 2048, DW_WO = DW_W2 + (size_t)11776 * 512, DW_BD = DW_WO + (size_t)2048 * 4096;
constexpr float DSA_QSCALE = 0.07216878364870322f * LOG2E;
constexpr float DSA_WIDX_SCALE = 0.25f * 0.08838834764831845f;

DI void ph_dsa_cvt(const Frame& F, const float* w_in, const float* w_qup, const float* w_uk, const float* w_uv, const float* w_out) {
    bf16* WB = (bf16*)(F.ws + WS_WMIX);
    cvt_job(F, w_in, 960, DM, 0, 960, WB + DW_W1, DM, 0, 1.f);
    zero_bf16(F, WB + DW_W1 + (size_t)960 * DM, (size_t)64 * DM);
    { LAS float* scr = (LAS float*)(F.lds + F.wave * 16384);
      for (int it = F.gw; it < 32 * 16; it += F.NGW) { const int h = it >> 4; cvt_item(w_qup, 8192, h * 192, 48, WB + DW_W2, 512, 8192 + h * 48, DSA_QSCALE, scr, it & 15, 2, F.lane); } }
    cvt_job(F, w_qup, 8192, 512, 6144, 2048, WB + DW_W2, 512, 9728, 1.f);
    __syncthreads();
    {
        LAS float* As = (LAS float*)F.lds; LAS float* Bs = As + 64 * 145;
        for (int u = blockIdx.x; u < 32 * 4 * 8; u += F.G) {
            const int h = u >> 5, r0 = ((u >> 3) & 3) * 64, k0 = (u & 7) * 64;
            for (int i = F.tid; i < 64 * 144; i += NWAVES * 64) { const int row = i / 144, col = i - row * 144;
                As[row * 145 + col] = w_uk[(size_t)(h * 256 + r0) * 144 + i]; Bs[row * 145 + col] = w_qup[(size_t)(k0 + row) * 8192 + h * 192 + 48 + col]; }
            __syncthreads();
            const int r = F.tid & 63, kg = F.tid >> 6; float acc[8];
#pragma unroll
            for (int j = 0; j < 8; ++j) acc[j] = 0.f;
            for (int n = 0; n < 144; ++n) { const float a = As[r * 145 + n];
#pragma unroll
                for (int j = 0; j < 8; ++j) acc[j] += a * Bs[(kg * 8 + j) * 145 + n]; }
            u32x4 o; o.x = pk2(acc[0] * DSA_QSCALE, acc[1] * DSA_QSCALE); o.y = pk2(acc[2] * DSA_QSCALE, acc[3] * DSA_QSCALE); o.z = pk2(acc[4] * DSA_QSCALE, acc[5] * DSA_QSCALE); o.w = pk2(acc[6] * DSA_QSCALE, acc[7] * DSA_QSCALE);
            *(u32x4*)(WB + DW_W2 + (size_t)(h * 256 + r0 + r) * 512 + k0 + kg * 8) = o;
            __syncthreads();
        }
    }
    { LAS float* scr = (LAS float*)(F.lds + F.wave * 16384);
      for (int it = F.gw; it < 32 * 16; it += F.NGW) { const int h = it >> 4; cvt_item(w_uv + (size_t)h * 256 * 128, 128, 0, 128, WB + DW_BD + (h & 1) * 256, 512, h * 128, 1.f, scr, it & 15, 4, F.lane); } }
    { const size_t gt = (size_t)blockIdx.x * (NWAVES * 64) + F.tid, NT = (size_t)F.G * NWAVES * 64;
      for (size_t i = gt; i < (size_t)4096 * 32; i += NT) { const int row = (int)(i >> 5), pc = (int)(i & 31); *(u32x4*)(WB + DW_BD + (size_t)row * 512 + (1 - ((row >> 7) & 1)) * 256 + pc * 8) = (u32x4){0u, 0u, 0u, 0u}; } }
    cvt_job(F, w_out, DM, 4096, 0, DM, WB + DW_WO, 4096, 0, 1.f);
}
DI void ph_dsa_post1(const Frame& F, int half, const float* qn, const float* kvn, const float* lng, const float* lnb) {
    unsigned char* ar = F.ws + WS_AR;
    const float* DIN = (const float*)(ar + DA_DIN); bf16* CQN = (bf16*)(ar + DA_CQN); bf16* LATC = (bf16*)(ar + DA_LATC); bf16* KPE = (bf16*)(ar + DA_KPE); bf16* KIDX = (bf16*)(ar + DA_KIDX); float* WIDX = (float*)(ar + DA_WIDX);
    const float* c48 = (const float*)(F.ws + TAB_COS48); const float* s48 = (const float*)(F.ws + TAB_SIN48); const float* c32 = (const float*)(F.ws + TAB_COS32); const float* s32 = (const float*)(F.ws + TAB_SIN32);
    LAS float* buf = (LAS float*)(F.lds + F.wave * 1024);
    const int lane = F.lane;
    for (int ml = F.gw; ml < MC; ml += F.NGW) {
        const int mg = half * MC + ml;
        const size_t kfb = ((size_t)(ml >> 5) * 8 * 64 + (ml & 31)) * 8;
        const float* row = DIN + (size_t)ml * 1024 + 16 * lane;
        f32x4 v[4]; float ss = 0.f, s1 = 0.f;
#pragma unroll
        for (int j = 0; j < 4; ++j) { v[j] = *(const f32x4*)(row + 4 * j); ss += (v[j].x * v[j].x + v[j].y * v[j].y) + (v[j].z * v[j].z + v[j].w * v[j].w); s1 += (v[j].x + v[j].y) + (v[j].z + v[j].w); }
        const bool isq = lane < 32, iskv = lane >= 32 && lane < 48, ispe = lane >= 48 && lane < 51, isix = lane >= 51 && lane < 59;
        const float ssq = wave_sum(isq ? ss : 0.f), sskv = wave_sum(iskv ? ss : 0.f), mean = wave_sum(isix ? s1 : 0.f) * (1.f / 128.f);
        float d2 = 0.f;
#pragma unroll
        for (int j = 0; j < 4; ++j) { const f32x4 d = v[j] - mean; d2 += (d.x * d.x + d.y * d.y) + (d.z * d.z + d.w * d.w); }
        const float var = wave_sum(isix ? d2 : 0.f) * (1.f / 128.f);
        const float rq = 1.0f / sqrtf(ssq * (1.f / 512.f) + NORM_EPS), rkv = 1.0f / sqrtf(sskv * (1.f / 256.f) + NORM_EPS), rstd = 1.0f / sqrtf(var + NORM_EPS);
        if (isq || iskv) {
            const float* gp = isq ? qn + 16 * lane : kvn + 16 * (lane - 32); const float rs = isq ? rq : rkv;
            bf16* dst = isq ? CQN + (size_t)ml * 512 + 16 * lane : LATC + (size_t)ml * 256 + 16 * (lane - 32);
            u32x4 o[2];
#pragma unroll
            for (int j = 0; j < 4; ++j) { const f32x4 g = *(const f32x4*)(gp + 4 * j); const f32x4 y = v[j] * rs * g; o[j >> 1][(j & 1) * 2] = pk2(y.x, y.y); o[j >> 1][(j & 1) * 2 + 1] = pk2(y.z, y.w); }
            *(u32x4*)dst = o[0]; *(u32x4*)(dst + 8) = o[1];
        } else if (ispe) {
#pragma unroll
            for (int j = 0; j < 4; ++j) *(LAS f32x4*)(buf + (lane - 48) * 16 + 4 * j) = v[j];
        } else if (isix) {
#pragma unroll
            for (int j = 0; j < 4; ++j) { const f32x4 g = *(const f32x4*)(lng + (lane - 51) * 16 + 4 * j), b = *(const f32x4*)(lnb + (lane - 51) * 16 + 4 * j); *(LAS f32x4*)(buf + 48 + (lane - 51) * 16 + 4 * j) = (v[j] - mean) * rstd * g + b; }
        } else if (lane == 59) {
#pragma unroll
            for (int j = 0; j < 4; ++j) *(f32x4*)(WIDX + (size_t)ml * 16 + 4 * j) = v[j] * DSA_WIDX_SCALE;
        }
        LDS_WAIT();
        if (lane < 24) { const float x1 = buf[lane], x2 = buf[24 + lane], c = c48[(size_t)mg * 24 + lane], s = s48[(size_t)mg * 24 + lane];
            KPE[(size_t)ml * 48 + lane] = f2bf(x1 * c - x2 * s); KPE[(size_t)ml * 48 + 24 + lane] = f2bf(x1 * s + x2 * c);
        } else if (lane < 40) { const int i = lane - 24; const float x1 = buf[48 + i], x2 = buf[48 + 16 + i], c = c32[(size_t)mg * 16 + i], s = s32[(size_t)mg * 16 + i];
            KIDX[kfb + (size_t)((i >> 3) * 32) * 8 + (i & 7)] = f2bf(x1 * c - x2 * s); KIDX[kfb + (size_t)(64 + (i >> 3) * 32) * 8 + (i & 7)] = f2bf(x1 * s + x2 * c);
        } else { const int d = 32 + 4 * (lane - 40); const f32x4 y = *(const LAS f32x4*)(buf + 48 + d); u32x2 w; w.x = pk2(y.x, y.y); w.y = pk2(y.z, y.w); *(u32x2*)(KIDX + kfb + (size_t)((d >> 4) * 64 + ((d >> 3) & 1) * 32) * 8 + (d & 7)) = w; }
        LDS_WAIT();
    }
}
DI int wave_iscan_dpp(int v) {
    v += __builtin_amdgcn_update_dpp(0, v, 0x111, 0xf, 0xf, true); v += __builtin_amdgcn_update_dpp(0, v, 0x112, 0xf, 0xf, true);
    v += __builtin_amdgcn_update_dpp(0, v, 0x114, 0xf, 0xf, true); v += __builtin_amdgcn_update_dpp(0, v, 0x118, 0xf, 0xf, true);
    v += __builtin_amdgcn_update_dpp(0, v, 0x142, 0xa, 0xf, false);
    v += __builtin_amdgcn_update_dpp(0, v, 0x143, 0xc, 0xf, false);
    return v;
}
DI int wave_isum_dpp(int v) {
    v += __builtin_amdgcn_update_dpp(0, v, 0x111, 0xf, 0xf, true); v += __builtin_amdgcn_update_dpp(0, v, 0x112, 0xf, 0xf, true);
    v += __builtin_amdgcn_update_dpp(0, v, 0x114, 0xf, 0xf, true); v += __builtin_amdgcn_update_dpp(0, v, 0x118, 0xf, 0xf, true);
    v += __builtin_amdgcn_update_dpp(0, v, 0x142, 0xa, 0xf, false);
    v += __builtin_amdgcn_update_dpp(0, v, 0x143, 0xc, 0xf, false);
    return __builtin_amdgcn_readlane(v, 63);
}
DI unsigned f2sortable(float s) { const unsigned b = __builtin_bit_cast(unsigned, s); return (b & 0x80000000u) ? ~b : (b | 0x80000000u); }
DI void ph_dsa_index(const Frame& F, const int half) {
    const float* c32 = (const float*)(F.ws + TAB_COS32); const float* s32 = (const float*)(F.ws + TAB_SIN32);
    unsigned char* ar = F.ws + WS_AR;
    const bf16* QIDX = (const bf16*)(ar + DA_QIDX); const bf16* KIDX = (const bf16*)(ar + DA_KIDX); const float* WIDX = (const float*)(ar + DA_WIDX);
    unsigned short* SEL = (unsigned short*)(ar + DA_SEL); int* CNT = (int*)(ar + DA_CNT); float* SC = (float*)(ar + DA_SC) + (size_t)F.gw * 16384;
    const int lane = F.lane, r = lane & 31, hf = lane >> 5;
    LAS unsigned char* wl = F.lds + F.wave * 8192 + lane * 16;
    LAS unsigned* hist = (LAS unsigned*)(F.lds + 65536 + F.wave * 1024);
#pragma unroll 1
    for (int tile = blockIdx.x; tile < BPH * 128; tile += F.G) {
        const int j = tile >> 8, c8 = tile & 255, c7 = c8 & 127, bl = (c8 >> 7) * 2 + j, qt = j ? 127 - c7 : c7;
        const int q0 = qt * 32 + 4 * F.wave;
        const int ntile = (q0 + 3) / 32 + 1;
        bf16x8 qa[2][8];
#pragma unroll
        for (int pr = 0; pr < 2; ++pr) {
            const int mrow = bl * SEQ + q0 + 2 * pr + (r >> 4);
#pragma unroll
            for (int s = 0; s < 8; ++s) qa[pr][s] = *(const bf16x8*)(QIDX + (size_t)mrow * 2048 + (r & 15) * 128 + 16 * s + 8 * hf);
            { const float* cs = c32 + ((size_t)half * MC + mrow) * 16 + 8 * hf; const float* sn = s32 + ((size_t)half * MC + mrow) * 16 + 8 * hf;
              const f32x4 c0 = *(const f32x4*)cs, c1 = *(const f32x4*)(cs + 4), s0 = *(const f32x4*)sn, s1 = *(const f32x4*)(sn + 4);
              const u32x4 a = __builtin_bit_cast(u32x4, qa[pr][0]), b = __builtin_bit_cast(u32x4, qa[pr][1]); u32x4 o1, o2;
#pragma unroll
              for (int e = 0; e < 4; ++e) { const float c_l = e < 2 ? c0[2 * e] : c1[2 * e - 4], c_h = e < 2 ? c0[2 * e + 1] : c1[2 * e - 3], s_l = e < 2 ? s0[2 * e] : s1[2 * e - 4], s_h = e < 2 ? s0[2 * e + 1] : s1[2 * e - 3];
                  const float x1l = bflo(a[e]), x1h = bfhi(a[e]), x2l = bflo(b[e]), x2h = bfhi(b[e]);
                  o1[e] = pk2(x1l * c_l - x2l * s_l, x1h * c_h - x2h * s_h); o2[e] = pk2(x1l * s_l + x2l * c_l, x1h * s_h + x2h * c_h); }
              qa[pr][0] = __builtin_bit_cast(bf16x8, o1); qa[pr][1] = __builtin_bit_cast(bf16x8, o2); }
            float wv[2][16];
#pragma unroll
            for (int i = 0; i < 16; ++i) wv[pr][i] = WIDX[(size_t)(bl * SEQ + q0 + 2 * pr + (i >> 3)) * 16 + (i & 3) + 8 * ((i >> 2) & 1) + 4 * hf];
#pragma unroll
            for (int i = 0; i < 16; i += 4) *(LAS f32x4*)(wl + (pr * 4 + (i >> 2)) * 1024) = (f32x4){wv[pr][i], wv[pr][i + 1], wv[pr][i + 2], wv[pr][i + 3]};
        }
        LDS_WAIT();
        {
        bf16x8 kf[8];
        { const bf16* kp = KIDX + ((size_t)(bl * 128) * 8 * 64 + lane) * 8;
#pragma unroll
          for (int s = 0; s < 8; ++s) kf[s] = *(const bf16x8*)(kp + 512 * s); }
#pragma unroll 1
        for (int t = 0; t < ntile; ++t) {
            f32x16 accs[2];
#pragma unroll
            for (int pr = 0; pr < 2; ++pr) {
#pragma unroll
                for (int i = 0; i < 16; ++i) accs[pr][i] = 0.f;
#pragma unroll
                for (int s = 0; s < 8; ++s) accs[pr] = MFMA32(qa[pr][s], kf[s], accs[pr]);
            }
            if (t + 1 < ntile) { const bf16* kp = KIDX + ((size_t)(bl * 128 + t + 1) * 8 * 64 + lane) * 8;
#pragma unroll
                for (int s = 0; s < 8; ++s) kf[s] = *(const bf16x8*)(kp + 512 * s); }
#pragma unroll
            for (int pr = 0; pr < 2; ++pr) {
                const f32x16 acc = accs[pr];
                float wv[2][16];
                { unsigned wa_ = (unsigned)(size_t)wl; asm volatile("" : "+v"(wa_));
#pragma unroll
                  for (int i = 0; i < 16; i += 4) { const f32x4 w4 = *(const LAS f32x4*)((LAS unsigned char*)(size_t)wa_ + (pr * 4 + (i >> 2)) * 1024); wv[pr][i] = w4.x; wv[pr][i + 1] = w4.y; wv[pr][i + 2] = w4.z; wv[pr][i + 3] = w4.w; } }
                float p0 = 0.f, p1 = 0.f;
#pragma unroll
                for (int i = 0; i < 8; ++i) { p0 += wv[pr][i] * fmaxf(acc[i], 0.f); p1 += wv[pr][8 + i] * fmaxf(acc[8 + i], 0.f); }
                const float t0 = p0 + __shfl_xor(p0, 32), t1 = p1 + __shfl_xor(p1, 32);
                SC[(pr * 128 + t) * 64 + lane] = hf ? t1 : t0;
            }
        }
        }
        VM_WAIT();
#pragma unroll 1
        for (int qi = 0; qi < 4; ++qi) {
            const int tq = q0 + qi, pr = qi >> 1, qs = qi & 1;
            unsigned u[64];
            const unsigned* scp = (const unsigned*)(SC + pr * 8192 + hf * 64 + qs * 32 + r);
#pragma unroll
            for (int g8 = 0; g8 < 8; ++g8) {
#pragma unroll
                for (int e = 0; e < 8; ++e) { const int i = 8 * g8 + e; const float s = __builtin_bit_cast(float, __hip_atomic_load(scp + e * 128, __ATOMIC_RELAXED, __HIP_MEMORY_SCOPE_AGENT));
                    u[i] = (2 * i + hf < ntile && 64 * i + lane <= tq) ? f2sortable(s) : 0u; }
                scp += 1024; asm volatile("" : "+v"(scp));
            }
            unsigned prefix = 0u;
            if (tq >= 256) {
#pragma unroll 1
                for (int bit = 31; bit >= 0; --bit) {
                    const unsigned cand = prefix | (1u << bit); int c = 0;
#pragma unroll
                    for (int g8 = 0; g8 < 8; ++g8) { if (g8 * 512 <= tq) {
#pragma unroll
                        for (int e = 0; e < 8; ++e) c += (u[8 * g8 + e] >= cand) ? 1 : 0; } }
                    c = wave_isum_dpp(c);
                    if (c >= 256) prefix = cand;
                    if (c == 256) break;
                }
            }
            const unsigned T = prefix > 1u ? prefix : 1u;
            int nl = 0;
#pragma unroll
            for (int g8 = 0; g8 < 8; ++g8) { if (g8 * 512 <= tq) {
#pragma unroll
                for (int e = 0; e < 8; ++e) nl += (u[8 * g8 + e] >= T) ? 1 : 0; } }
            const int inc = wave_iscan_dpp(nl), base = __builtin_amdgcn_readlane(inc, 63);
            int pos = inc - nl;
            unsigned short* sel = SEL + (size_t)(bl * SEQ + tq) * 256;
#pragma unroll
            for (int g8 = 0; g8 < 8; ++g8) { if (g8 * 512 <= tq) {
#pragma unroll
                for (int e = 0; e < 8; ++e) { const int i = 8 * g8 + e; if (u[i] >= T) { if (pos < 256) sel[pos] = (unsigned short)(64 * i + lane); ++pos; } } } }
            if (lane == 0) CNT[bl * SEQ + tq] = base < 256 ? base : 256;
        }
    }
}
DI int dsa_fsw(int row) { return ((row & 3) << 2) | ((row >> 2) & 3); }
struct DsaPre { u32x4 row[16]; bf16x8 kpe[3]; bf16x8 q[3]; };
DI void dsa_prefetch(DsaPre& P, const bf16* LATC, const bf16* KPE, const bf16* QL, const bf16* QPE, const float* c48, const float* s48, int half, int ml, int selv, int lane, int w) {
    const int bl = ml >> 12, r = lane & 31, h = lane >> 5;
#pragma unroll
    for (int it = 0; it < 16; ++it) { const int ki = __shfl(selv, (lane >> 5) + 2 * it); P.row[it] = *(const u32x4*)(LATC + (size_t)(bl * SEQ + ki) * 256 + (lane & 31) * 8); }
#pragma unroll
    for (int s = 0; s < 3; ++s) P.kpe[s] = *(const bf16x8*)(KPE + (size_t)(bl * SEQ + selv) * 48 + 16 * s + 8 * h);
#pragma unroll
    for (int j = 0; j < 3; ++j) { const int fi = w + 8 * j;
        if (fi < 16) P.q[j] = *(const bf16x8*)(QL + (size_t)ml * 8192 + r * 256 + 16 * fi + 8 * h);
        else if (fi < 19) P.q[j] = rope_frag32(QPE + (size_t)ml * 1536 + r * 48, fi - 16, h, c48 + ((size_t)half * MC + ml) * 24, s48 + ((size_t)half * MC + ml) * 24); }
}
DI void ph_dsa_attn(const Frame& F, const int half) {
    const float* c48 = (const float*)(F.ws + TAB_COS48); const float* s48 = (const float*)(F.ws + TAB_SIN48);
    unsigned char* ar = F.ws + WS_AR;
    bf16* QL = (bf16*)(ar + DA_QL); const bf16* QPE = (const bf16*)(ar + DA_QPE); const bf16* LATC = (const bf16*)(ar + DA_LATC); const bf16* KPE = (const bf16*)(ar + DA_KPE);
    const unsigned short* SEL = (const unsigned short*)(ar + DA_SEL); const int* CNT = (const int*)(ar + DA_CNT);
    const int lane = F.lane, r = lane & 31, h = lane >> 5, w = F.wave;
    LAS unsigned char* IMG = F.lds; LAS unsigned char* QB = F.lds + LDSCTL_OFF + 256; LAS float* MX = (LAS float*)(F.lds + LDSCTL_OFF + 256 + 19456); LAS float* SX = MX + 256;
    const int i16 = lane & 15, tq_ = i16 >> 2, tp_ = i16 & 3, blk = (lane >> 4) & 1;
    int ml = blockIdx.x;
    if (ml >= MC) return;
    DsaPre P;
    int cnt_c = CNT[ml];
    { const int slot = 32 * w + r; const int selv = slot < cnt_c ? (int)SEL[(size_t)ml * 256 + slot] : 0; dsa_prefetch(P, LATC, KPE, QL, QPE, c48, s48, half, ml, selv, lane, w); }
    int cnt_n = 0, selv_n = 0;
    if (ml + F.G < MC) { cnt_n = CNT[ml + F.G]; const int slot = 32 * w + r; selv_n = slot < cnt_n ? (int)SEL[(size_t)(ml + F.G) * 256 + slot] : 0; }
#pragma unroll 1
    for (; ml < MC; ml += F.G) {
        const int cnt = cnt_c, nch = (cnt + 31) >> 5; const bool act = w < nch;
#pragma unroll
        for (int it = 0; it < 16; ++it) { const int rr = (lane >> 5) + 2 * it; *(LAS u32x4*)(IMG + (32 * w + rr) * 512 + (((lane & 31) ^ dsa_fsw(rr)) * 16)) = P.row[it]; }
#pragma unroll
        for (int j = 0; j < 3; ++j) { const int fi = w + 8 * j; if (fi < 19) *(LAS bf16x8*)(QB + fi * 1024 + lane * 16) = P.q[j]; }
        bf16x8 kpe[3];
#pragma unroll
        for (int s = 0; s < 3; ++s) kpe[s] = P.kpe[s];
        LDS_WAIT(); __builtin_amdgcn_s_barrier(); asm volatile("" ::: "memory");
        if (ml + F.G < MC) {
            dsa_prefetch(P, LATC, KPE, QL, QPE, c48, s48, half, ml + F.G, selv_n, lane, w); cnt_c = cnt_n;
            if (ml + 2 * F.G < MC) { cnt_n = CNT[ml + 2 * F.G]; const int slot = 32 * w + r; selv_n = slot < cnt_n ? (int)SEL[(size_t)(ml + 2 * F.G) * 256 + slot] : 0; }
        }
        f32x16 S; float mx = -INFINITY;
#pragma unroll
        for (int i = 0; i < 16; ++i) S[i] = 0.f;
        if (act) {
#pragma unroll
            for (int s = 0; s < 16; ++s) S = MFMA32(*(const LAS bf16x8*)(IMG + (32 * w + r) * 512 + (((2 * s + h) ^ dsa_fsw(r)) * 16)), *(const LAS bf16x8*)(QB + s * 1024 + lane * 16), S);
#pragma unroll
            for (int s = 0; s < 3; ++s) S = MFMA32(kpe[s], *(const LAS bf16x8*)(QB + (16 + s) * 1024 + lane * 16), S);
#pragma unroll
            for (int i = 0; i < 16; ++i) { S[i] = (32 * w + crow(i, h) < cnt) ? S[i] : -INFINITY; mx = fmaxf(mx, S[i]); }
            mx = fmaxf(mx, __shfl_xor(mx, 32));
        }
        if (h == 0) MX[w * 32 + r] = mx;
        LDS_WAIT(); __builtin_amdgcn_s_barrier(); asm volatile("" ::: "memory");
        float M = MX[r];
#pragma unroll
        for (int k = 1; k < 8; ++k) M = fmaxf(M, MX[k * 32 + r]);
        float lsum = 0.f; bf16x8 pf[2] = {(bf16x8){0, 0, 0, 0, 0, 0, 0, 0}, (bf16x8){0, 0, 0, 0, 0, 0, 0, 0}};
        if (act) {
#pragma unroll
            for (int i = 0; i < 16; ++i) { S[i] = __builtin_amdgcn_exp2f(S[i] - M); lsum += S[i]; }
#pragma unroll
            for (int s = 0; s < 2; ++s) { u32x4 t; t.x = pk2(S[8 * s], S[8 * s + 1]); t.y = pk2(S[8 * s + 2], S[8 * s + 3]); t.z = pk2(S[8 * s + 4], S[8 * s + 5]); t.w = pk2(S[8 * s + 6], S[8 * s + 7]); pf[s] = __builtin_bit_cast(bf16x8, t); }
        }
        lsum += __shfl_xor(lsum, 32);
        if (h == 0) SX[w * 32 + r] = lsum;
        *(LAS bf16x8*)(QB + (2 * w) * 1024 + lane * 16) = pf[0]; *(LAS bf16x8*)(QB + (2 * w + 1) * 1024 + lane * 16) = pf[1];
        LDS_WAIT(); __builtin_amdgcn_s_barrier(); asm volatile("" ::: "memory");
        f32x16 O;
#pragma unroll
        for (int i = 0; i < 16; ++i) O[i] = 0.f;
#pragma unroll 2
        for (int ks = 0; ks < 2 * nch; ++ks) {
            const int r0 = 16 * ks + 4 * h + tq_, r1 = r0 + 8, pc = 4 * w + 2 * blk + (tp_ >> 1);
            const s16x4 lo = __builtin_bit_cast(s16x4, __builtin_amdgcn_ds_read_tr16_b64_v4i16((LAS v4i16_t*)(IMG + r0 * 512 + ((pc ^ dsa_fsw(r0)) * 16) + 8 * (tp_ & 1))));
            const s16x4 hi = __builtin_bit_cast(s16x4, __builtin_amdgcn_ds_read_tr16_b64_v4i16((LAS v4i16_t*)(IMG + r1 * 512 + ((pc ^ dsa_fsw(r1)) * 16) + 8 * (tp_ & 1))));
            O = MFMA32(__builtin_shufflevector(lo, hi, 0, 1, 2, 3, 4, 5, 6, 7), *(const LAS bf16x8*)(QB + ks * 1024 + lane * 16), O);
        }
        float l = SX[r];
#pragma unroll
        for (int k = 1; k < 8; ++k) l += SX[k * 32 + r];
        const float linv = 1.0f / l;
        bf16* o = QL + (size_t)ml * 8192 + r * 256 + 32 * w + 4 * h;
#pragma unroll
        for (int g = 0; g < 4; ++g) { u32x2 t; t.x = pk2(O[4 * g] * linv, O[4 * g + 1] * linv); t.y = pk2(O[4 * g + 2] * linv, O[4 * g + 3] * linv); *(u32x2*)(o + 8 * g) = t; }
        LDS_WAIT(); __builtin_amdgcn_s_barrier(); asm volatile("" ::: "memory");
    }
}
template <int NDB, bool RESC = true> DI void softmax_step(f32x16& S, float& m, float& l, f32x16 (&O)[NDB], bf16x8 (&pf)[2]) {
    float mx = fmaxf(S[0], S[1]);
#pragma unroll
    for (int i = 2; i < 16; i += 2) mx = __builtin_fmaxf(mx, __builtin_fmaxf(S[i], S[i + 1]));
    mx = fmaxf(mx, __shfl_xor(mx, 32));
    const float mn = fmaxf(m, mx), ms = (mn == -INFINITY) ? 0.f : mn;
    const float alpha = __builtin_amdgcn_exp2f(m - ms);
    float sum = 0.f;
#pragma unroll
    for (int i = 0; i < 16; ++i) { S[i] = __builtin_amdgcn_exp2f(S[i] - ms); sum += S[i]; }
    l = l * alpha + sum; m = mn;
    if (RESC && __builtin_amdgcn_ballot_w64(alpha != 1.0f) != 0ull) {
#pragma unroll
        for (int db = 0; db < NDB; ++db)
#pragma unroll
            for (int i = 0; i < 16; ++i) O[db][i] *= alpha;
    }
#pragma unroll
    for (int s = 0; s < 2; ++s) { u32x4 w; w.x = pk2(S[8 * s], S[8 * s + 1]); w.y = pk2(S[8 * s + 2], S[8 * s + 3]); w.z = pk2(S[8 * s + 4], S[8 * s + 5]); w.w = pk2(S[8 * s + 6], S[8 * s + 7]); pf[s] = __builtin_bit_cast(bf16x8, w); }
}
template <bool ACC> DI void store_col(bf16* out, const f32x16 (&O)[4], float scale, int h) {
#pragma unroll
    for (int db = 0; db < 4; ++db)
#pragma unroll
        for (int g = 0; g < 4; ++g) { u32x2* p = (u32x2*)(out + db * 32 + 8 * g + 4 * h);
            float a = O[db][4 * g] * scale, b = O[db][4 * g + 1] * scale, c = O[db][4 * g + 2] * scale, d = O[db][4 * g + 3] * scale;
            if (ACC) { const u32x2 o = *p; a += bflo(o.x); b += bfhi(o.x); c += bflo(o.y); d += bfhi(o.y); }
            u32x2 w; w.x = pk2(a, b); w.y = pk2(c, d); *p = w; }
}
template <int NQ> struct TilePre { u32x4 a, b, c; };
template <int NQ, class SRC> DI void tile_fetch(TilePre<NQ>& p, const SRC& src, int T, int tid) {
    const bf16* k = src.k(T); const bf16* v = src.v(T);
    constexpr int NK = NQ * 64;
    p.a = *(const u32x4*)(k + (size_t)tid * 8);
    const int p1 = tid + 512; p.b = (p1 < NK) ? *(const u32x4*)(k + (size_t)p1 * 8) : *(const u32x4*)(v + (size_t)(p1 - NK) * 8);
    if (NQ * 64 + 512 > 1024) { const int p2 = tid + 1024; if (p2 < NK + 512) p.c = *(const u32x4*)(v + (size_t)(p2 - NK) * 8); }
}
template <int NQ> DI void tile_put(const TilePre<NQ>& p, LAS unsigned char* buf, int tid) {
    *(LAS u32x4*)(buf + tid * 16) = p.a; *(LAS u32x4*)(buf + (tid + 512) * 16) = p.b;
    if (NQ * 64 + 512 > 1024) { if (tid + 1024 < NQ * 64 + 512) *(LAS u32x4*)(buf + (tid + 1024) * 16) = p.c; }
}
template <int NQ, bool PV, class SRC, class MK>
DI void attn_run_sh(LAS unsigned char* tl, int tid, int lane, const bf16x8 (&qf)[NQ], f32x16 (&O)[4], float& m, float& l, int TB, int TE, int tb, int te, const SRC& src, const MK& mk) {
    constexpr int TBYTES = (NQ + 8) * 1024;
    if (TB >= TE) return;
    TilePre<NQ> pre;
    tile_fetch<NQ>(pre, src, TB, tid); tile_put<NQ>(pre, tl, tid);
    LDS_WAIT(); __builtin_amdgcn_s_barrier(); asm volatile("" ::: "memory");
#pragma unroll 1
    for (int T = TB; T < TE; ++T) {
        LAS unsigned char* cur = tl + ((T - TB) & 1) * TBYTES;
        if (T + 1 < TE) tile_fetch<NQ>(pre, src, T + 1, tid);
        if (T >= tb && T < te) {
            f32x16 S;
#pragma unroll
            for (int i = 0; i < 16; ++i) S[i] = 0.f;
#pragma unroll
            for (int s = 0; s < NQ; ++s) S = MFMA32(*(const LAS bf16x8*)(cur + s * 1024 + lane * 16), qf[s], S);
            if (mk.need(T)) mk(T, S);
            bf16x8 pf[2]; softmax_step<4, PV>(S, m, l, O, pf);
            if (PV) {
#pragma unroll
                for (int db = 0; db < 4; ++db)
#pragma unroll
                    for (int s = 0; s < 2; ++s) O[db] = MFMA32(*(const LAS bf16x8*)(cur + (NQ + db * 2 + s) * 1024 + lane * 16), pf[s], O[db]);
            }
        }
        if (T + 1 < TE) tile_put<NQ>(pre, tl + ((T + 1 - TB) & 1) * TBYTES, tid);
        LDS_WAIT(); __builtin_amdgcn_s_barrier(); asm volatile("" ::: "memory");
    }
}
struct FragSrc { const bf16* kb; const bf16* vb; int nq; DI const bf16* k(int T) const { return kb + (size_t)T * nq * 512; } DI const bf16* v(int T) const { return vb + (size_t)T * 8 * 512; } };
constexpr size_t FA_Q = 0, FA_K = 64 * MiB, FA_F = 128 * MiB, FA_V = 136 * MiB, FA_CUM = 200 * MiB, FA_O = 202 * MiB, FA_KF = 266 * MiB, FA_VF = 338 * MiB;
constexpr size_t FW_IN = 0, FW_OUT = (size_t)6400 * 2048;
constexpr float FOX_QSCALE = 0.08838834764831845f * LOG2E;
DI void ph_fox_cvt(const Frame& F, const float* w_in, const float* w_out) {
    bf16* WB = (bf16*)(F.ws + WS_WMIX);
    cvt_job(F, w_in, 6160, DM, 0, 2048, WB + FW_IN, DM, 0, FOX_QSCALE);
    cvt_job(F, w_in, 6160, DM, 2048, 2048, WB + FW_IN, DM, 2048, 1.f);
    cvt_job(F, w_in, 6160, DM, 4096, 2048, WB + FW_IN, DM, 4096, 1.f);
    cvt_job(F, w_in, 6160, DM, 6144, 16, WB + FW_IN, DM, 6144, 1.f);
    zero_bf16(F, WB + FW_IN + (size_t)6160 * DM, (size_t)240 * DM);
    cvt_job(F, w_out, DM, DM, 0, DM, WB + FW_OUT, DM, 0, 1.f);
}
DI void ph_fox_scan(const Frame& F, const float* b_f) {
    unsigned char* ar = F.ws + WS_AR; const bf16* FB = (const bf16*)(ar + FA_F); float* CUM = (float*)(ar + FA_CUM);
    for (int w = F.gw; w < BPH * 16; w += F.NGW) {
        const int bl = w >> 4, hd = w & 15; const float bf_ = b_f[hd];
        float v[64]; float run = 0.f;
#pragma unroll
        for (int i = 0; i < 64; ++i) { const float x = bf2f(FB[(size_t)(bl * SEQ + F.lane * 64 + i) * 256 + hd]) + bf_;
            const float ls = fminf(x, 0.f) - log1pf(expf(-fabsf(x))); run += ls; v[i] = run; }
        float inc = run;
#pragma unroll
        for (int o = 1; o < 64; o <<= 1) { const float y = __shfl_up(inc, o); if (F.lane >= o) inc += y; }
        const float base = inc - run;
        float* dst = CUM + (size_t)w * SEQ + F.lane * 64;
#pragma unroll
        for (int i = 0; i < 64; i += 4) *(f32x4*)(dst + i) = (f32x4){(v[i] + base) * LOG2E, (v[i + 1] + base) * LOG2E, (v[i + 2] + base) * LOG2E, (v[i + 3] + base) * LOG2E};
        bf16* KF9 = (bf16*)(ar + FA_KF) + (size_t)w * 128 * 9 * 512;
#pragma unroll
        for (int i = 0; i < 64; ++i) { const int p = F.lane * 64 + i, tile = p >> 5, r_ = p & 31; const float c = (v[i] + base) * LOG2E;
            const unsigned short hi = f2bf(c); const float c1 = c - bf2f(hi); const unsigned short mid = f2bf(c1); const unsigned short lo = f2bf(c1 - bf2f(mid));
            u32x4 wv; wv.x = 0x3F803F80u; wv.y = 0x3F80u | ((unsigned)(hi ^ 0x8000u) << 16); wv.z = (unsigned)(mid ^ 0x8000u) | ((unsigned)(lo ^ 0x8000u) << 16); wv.w = 0u;
            bf16* d = KF9 + ((size_t)(tile * 9 + 8) * 64 + r_) * 8;
            *(u32x4*)d = wv; *(u32x4*)(d + 32 * 8) = (u32x4){0u, 0u, 0u, 0u}; }
    }
    const bf16* Kr = (const bf16*)(ar + FA_K); const bf16* Vr = (const bf16*)(ar + FA_V); bf16* KF = (bf16*)(ar + FA_KF); bf16* VF = (bf16*)(ar + FA_VF);
    const int r = F.lane & 31, h = F.lane >> 5;
    for (int u = F.gw; u < BPH * 16 * 128; u += F.NGW) {
        const int bh = u >> 7, tile = u & 127, bl = bh >> 4, hd = bh & 15;
        const bf16* krow_ = Kr + ((size_t)bl * SEQ + tile * 32 + r) * DM + hd * 128 + 8 * h;
        bf16* kd = KF + (((size_t)bh * 128 + tile) * 9 * 64 + F.lane) * 8;
#pragma unroll
        for (int s = 0; s < 8; ++s) *(u32x4*)(kd + s * 512) = *(const u32x4*)(krow_ + 16 * s);
        bf16* vd = VF + (((size_t)bh * 128 + tile) * 8 * 64 + F.lane) * 8;
#pragma unroll
        for (int db = 0; db < 4; ++db)
#pragma unroll
            for (int s = 0; s < 2; ++s) { unsigned short e[8];
#pragma unroll
                for (int j = 0; j < 8; ++j) e[j] = Vr[((size_t)bl * SEQ + tile * 32 + 16 * s + 8 * (j >> 2) + 4 * h + (j & 3)) * DM + hd * 128 + db * 32 + r];
                u32x4 w; w.x = e[0] | ((unsigned)e[1] << 16); w.y = e[2] | ((unsigned)e[3] << 16); w.z = e[4] | ((unsigned)e[5] << 16); w.w = e[6] | ((unsigned)e[7] << 16);
                *(u32x4*)(vd + (db * 2 + s) * 512) = w; }
    }
}
struct FoxMK { int tq, h, qt; DI bool need(int t) const { return t == qt; }
    DI void operator()(int t, f32x16& S) const {
#pragma unroll
        for (int i = 0; i < 16; ++i) S[i] = (32 * t + crow(i, h) <= tq) ? S[i] : -INFINITY;
    } };
DI void ph_fox_attn(const Frame& F) {
    unsigned char* ar = F.ws + WS_AR; const bf16* Q = (const bf16*)(ar + FA_Q); const bf16* KF = (const bf16*)(ar + FA_KF); const bf16* VF = (const bf16*)(ar + FA_VF); const float* CUM = (const float*)(ar + FA_CUM); bf16* Ob = (bf16*)(ar + FA_O);
    const int r = F.lane & 31, h = F.lane >> 5;
    for (int wb = blockIdx.x; wb < BPH * 16 * 4; wb += F.G) {
        const int bh = wb >> 2, x = (wb & 3) * 8 + F.wave, bl = bh >> 4, hd = bh & 15;
#pragma unroll 1
        for (int k = 0; k < 4; ++k) {
            const int qt = (k == 0) ? x : (k == 1) ? 63 - x : (k == 2) ? 64 + x : 127 - x;
            const int qhi = (k == 0) ? (wb & 3) * 8 + 7 : (k == 1) ? 63 - (wb & 3) * 8 : (k == 2) ? 64 + (wb & 3) * 8 + 7 : 127 - (wb & 3) * 8;
            const int tq = qt * 32 + r; const size_t mrow = (size_t)bl * SEQ + tq;
            bf16x8 qf[9];
#pragma unroll
            for (int s = 0; s < 8; ++s) qf[s] = *(const bf16x8*)(Q + mrow * DM + hd * 128 + 16 * s + 8 * h);
            { const float ct = CUM[(size_t)bh * SEQ + tq]; const unsigned short hi = f2bf(ct); const float c1 = ct - bf2f(hi); const unsigned short mid = f2bf(c1); const unsigned short lo = f2bf(c1 - bf2f(mid));
              u32x4 wq; wq.x = (unsigned)hi | ((unsigned)mid << 16); wq.y = (unsigned)lo | (0x3F80u << 16); wq.z = 0x3F803F80u; wq.w = 0u;
              if (h) wq = (u32x4){0u, 0u, 0u, 0u};
              qf[8] = __builtin_bit_cast(bf16x8, wq); }
            f32x16 O[4];
#pragma unroll
            for (int db = 0; db < 4; ++db)
#pragma unroll
                for (int i = 0; i < 16; ++i) O[db][i] = 0.f;
            float m = -INFINITY, l = 0.f;
            const FragSrc src{KF + (size_t)bh * 128 * 9 * 512, VF + (size_t)bh * 128 * 8 * 512, 9}; const FoxMK mk{tq, h, qt};
            attn_run_sh<9, true>(F.lds, F.tid, F.lane, qf, O, m, l, 0, qhi + 1, 0, qt + 1, src, mk);
            l += __shfl_xor(l, 32);
            store_col<false>(Ob + mrow * DM + hd * 128, O, l > 0.f ? 1.0f / l : 0.f, h);
        }
    }
}
typedef long fp8x8_t;
DI fp8x8_t pack_fp8x8(float a0, float a1, float a2, float a3, float a4, float a5, float a6, float a7) {
    int lo = 0, hi = 0;
    lo = __builtin_amdgcn_cvt_pk_fp8_f32(a0, a1, lo, false); lo = __builtin_amdgcn_cvt_pk_fp8_f32(a2, a3, lo, true);
    hi = __builtin_amdgcn_cvt_pk_fp8_f32(a4, a5, hi, false); hi = __builtin_amdgcn_cvt_pk_fp8_f32(a6, a7, hi, true);
    return (fp8x8_t)(((unsigned long long)(unsigned)hi << 32) | (unsigned long long)(unsigned)lo);
}
#define MFMA32F8(a, b, c) __builtin_amdgcn_mfma_f32_32x32x16_fp8_fp8((a), (b), (c), 0, 0, 0)
constexpr size_t NA_Q = 0, NA_KC = 288 * MiB, NA_VC = 313 * MiB, NA_KSR = 330 * MiB, NA_KWR = 354 * MiB, NA_GT = 378 * MiB, NA_VSR = 386 * MiB, NA_VWR = 402 * MiB, NA_GK = 418 * MiB, NA_GV = 420 * MiB,
                 NA_KCMP = 422 * MiB, NA_VCT = 424 * MiB, NA_SELB = 426 * MiB, NA_O = 428 * MiB,
                 NA_KSF = 620 * MiB, NA_KWF = 644 * MiB, NA_VSF = 668 * MiB, NA_VWF = 684 * MiB;
constexpr size_t NW_IN = 0, NW_W1K = (size_t)13312 * 2048, NW_W1V = NW_W1K + (size_t)256 * 6144, NW_W2K = NW_W1V + (size_t)256 * 4096, NW_W2V = NW_W2K + 65536, NW_OUT = NW_W2V + 65536;
constexpr float NSA_QSCALE = 0.07216878364870322f * LOG2E;
DI void ph_nsa_cvt(const Frame& F, const float* w_in, const float* k_pe, const float* k_w1, const float* k_b1, const float* k_w2, const float* v_pe, const float* v_w1, const float* v_b1, const float* v_w2, const float* w_out) {
    bf16* WB = (bf16*)(F.ws + WS_WMIX); float* BIAS = (float*)(F.ws + WS_MISC);
    cvt_job(F, w_in, 13200, DM, 0, 9216, WB + NW_IN, DM, 0, NSA_QSCALE);
    cvt_job(F, w_in, 13200, DM, 9216, 768, WB + NW_IN, DM, 9216, 1.f);
    cvt_job(F, w_in, 13200, DM, 9984, 512, WB + NW_IN, DM, 9984, 1.f);
    cvt_job(F, w_in, 13200, DM, 10496, 768, WB + NW_IN, DM, 10496, 1.f);
    cvt_job(F, w_in, 13200, DM, 11776, 768, WB + NW_IN, DM, 11264, 1.f);
    cvt_job(F, w_in, 13200, DM, 13056, 144, WB + NW_IN, DM, 12032, 1.f);
    zero_bf16(F, WB + NW_IN + (size_t)12176 * DM, (size_t)112 * DM);
    cvt_job(F, w_in, 13200, DM, 11264, 512, WB + NW_IN, DM, 12288, 1.f);
    cvt_job(F, w_in, 13200, DM, 12544, 512, WB + NW_IN, DM, 12800, 1.f);
    cvt_job(F, k_w1, 256, 6144, 0, 256, WB + NW_W1K, 6144, 0, 1.f);
    cvt_job(F, v_w1, 256, 4096, 0, 256, WB + NW_W1V, 4096, 0, 1.f);
    cvt_job(F, k_w2, 192, 256, 0, 192, WB + NW_W2K, 256, 0, 1.f); zero_bf16(F, WB + NW_W2K + 192 * 256, 64 * 256);
    cvt_job(F, v_w2, 128, 256, 0, 128, WB + NW_W2V, 256, 0, 1.f); zero_bf16(F, WB + NW_W2V + 128 * 256, 128 * 256);
    cvt_job(F, w_out, DM, 6144, 0, DM, WB + NW_OUT, 6144, 0, 1.f);
    for (int w = F.gw; w < 512; w += F.NGW) { const bool isk = w < 256; const int c = w & 255, n = isk ? 6144 : 4096; const float* pe = isk ? k_pe : v_pe; const float* w1 = isk ? k_w1 : v_w1;
        float s = 0.f; for (int i = F.lane; i < n; i += 64) s += pe[i] * w1[(size_t)i * 256 + c];
        s = wave_sum(s); if (F.lane == 0) BIAS[w] = s + (isk ? k_b1[c] : v_b1[c]); }
}
DI void ph_nsa_rope(const Frame& F, int half) {
    unsigned char* ar = F.ws + WS_AR; bf16* Q = (bf16*)(ar + NA_Q); bf16* KC = (bf16*)(ar + NA_KC);
    const bf16* KSR = (const bf16*)(ar + NA_KSR); const bf16* KWR = (const bf16*)(ar + NA_KWR); bf16* KSF = (bf16*)(ar + NA_KSF); bf16* KWF = (bf16*)(ar + NA_KWF);
    const float* c48 = (const float*)(F.ws + TAB_COS48); const float* s48 = (const float*)(F.ws + TAB_SIN48);
    for (int ml = F.gw; ml < MC; ml += F.NGW) {
        const size_t mg = (size_t)half * MC + ml; const int bl = ml >> 12, sq = ml & 4095;
        for (int p = F.lane; p < 96; p += 64) {
            const int hd = 48 + p / 24, i = p - (p / 24) * 24; bf16* q;
            q = KC + ((size_t)(bl * 4 + hd - 48) * 4096 + sq) * 192 + i;
            const float x1 = bf2f(q[0]), x2 = bf2f(q[24]), c = c48[mg * 24 + i], s = s48[mg * 24 + i]; q[0] = f2bf(x1 * c - x2 * s); q[24] = f2bf(x1 * s + x2 * c);
        }
        const int tile = sq >> 5, rr = sq & 31;
        for (int u = F.lane; u < 168; u += 64) {
            const int tens = u / 84, uu = u - tens * 84, g = uu / 21, v = uu - g * 21;
            const bf16* src = (tens ? KWR : KSR) + (size_t)ml * 768 + g * 192;
            bf16* dst = (tens ? KWF : KSF) + ((size_t)((bl * 4 + g) * 128 + tile) * 12 * 64 + rr) * 8;
            if (v < 3) {
                const u32x4 a = *(const u32x4*)(src + 8 * v), b = *(const u32x4*)(src + 8 * v + 24); u32x4 o1, o2;
#pragma unroll
                for (int e = 0; e < 4; ++e) { const float c0 = c48[mg * 24 + 8 * v + 2 * e], s0 = s48[mg * 24 + 8 * v + 2 * e], c1 = c48[mg * 24 + 8 * v + 2 * e + 1], s1 = s48[mg * 24 + 8 * v + 2 * e + 1];
                    const float x1l = bflo(a[e]), x1h = bfhi(a[e]), x2l = bflo(b[e]), x2h = bfhi(b[e]);
                    o1[e] = pk2(x1l * c0 - x2l * s0, x1h * c1 - x2h * s1); o2[e] = pk2(x1l * s0 + x2l * c0, x1h * s1 + x2h * c1); }
                const int p1 = v, p2 = v + 3;
                if (tens) { *(u32x4*)(dst + ((p1 >> 1) * 64 + (p1 & 1) * 32) * 8) = o1; *(u32x4*)(dst + ((p2 >> 1) * 64 + (p2 & 1) * 32) * 8) = o2; }
                else { unsigned char* d8 = (unsigned char*)KSF + ((size_t)(((bl * 4 + g) * 128 + tile) * 2 + (rr >> 4)) * 6 * 64 + (rr & 15)) * 8;
                    *(fp8x8_t*)(d8 + ((p1 >> 2) * 64 + (p1 & 3) * 16) * 8) = pack_fp8x8(bflo(o1[0]), bfhi(o1[0]), bflo(o1[1]), bfhi(o1[1]), bflo(o1[2]), bfhi(o1[2]), bflo(o1[3]), bfhi(o1[3]));
                    *(fp8x8_t*)(d8 + ((p2 >> 2) * 64 + (p2 & 3) * 16) * 8) = pack_fp8x8(bflo(o2[0]), bfhi(o2[0]), bflo(o2[1]), bfhi(o2[1]), bflo(o2[2]), bfhi(o2[2]), bflo(o2[3]), bfhi(o2[3])); }
            } else { const int pc = v + 3; const u32x4 c = *(const u32x4*)(src + 8 * pc);
                if (tens) *(u32x4*)(dst + ((pc >> 1) * 64 + (pc & 1) * 32) * 8) = c;
                else { unsigned char* d8 = (unsigned char*)KSF + ((size_t)(((bl * 4 + g) * 128 + tile) * 2 + (rr >> 4)) * 6 * 64 + (rr & 15)) * 8;
                    *(fp8x8_t*)(d8 + ((pc >> 2) * 64 + (pc & 3) * 16) * 8) = pack_fp8x8(bflo(c[0]), bfhi(c[0]), bflo(c[1]), bfhi(c[1]), bflo(c[2]), bfhi(c[2]), bflo(c[3]), bfhi(c[3])); } }
        }
    }
    const bf16* VSR = (const bf16*)(ar + NA_VSR); const bf16* VWR = (const bf16*)(ar + NA_VWR); bf16* VSF = (bf16*)(ar + NA_VSF); bf16* VWF = (bf16*)(ar + NA_VWF);
    const int r = F.lane & 31, h = F.lane >> 5;
    for (int u = F.gw; u < 2 * BPH * 4 * 128; u += F.NGW) {
        const int tens = u >> 11, bg = (u >> 7) & 15, tile = u & 127, bl = bg >> 2, g = bg & 3;
        if (tens) {
            const bf16* src = VWR + ((size_t)bl * SEQ + tile * 32) * 512 + g * 128 + r;
            bf16* vd = VWF + (((size_t)bg * 128 + tile) * 8 * 64 + F.lane) * 8;
#pragma unroll
            for (int db = 0; db < 4; ++db)
#pragma unroll
                for (int s = 0; s < 2; ++s) { unsigned short e[8];
#pragma unroll
                    for (int j = 0; j < 8; ++j) e[j] = src[(size_t)(16 * s + 8 * (j >> 2) + 4 * h + (j & 3)) * 512 + db * 32];
                    u32x4 w; w.x = e[0] | ((unsigned)e[1] << 16); w.y = e[2] | ((unsigned)e[3] << 16); w.z = e[4] | ((unsigned)e[5] << 16); w.w = e[6] | ((unsigned)e[7] << 16);
                    *(u32x4*)(vd + (db * 2 + s) * 512) = w; }
        } else {
            const int d16 = F.lane & 15, kq = F.lane >> 4;
            const bf16* src = VSR + ((size_t)bl * SEQ + tile * 32) * 512 + g * 128 + d16;
            unsigned char* vd = (unsigned char*)VSF + (((size_t)bg * 128 + tile) * 8 * 64 + F.lane) * 8;
#pragma unroll
            for (int db = 0; db < 8; ++db) { float e[8];
#pragma unroll
                for (int j = 0; j < 8; ++j) e[j] = bf2f(src[(size_t)((j < 4 ? 4 * kq + j : 16 + 4 * kq + j - 4)) * 512 + db * 16]);
                *(fp8x8_t*)(vd + db * 512) = pack_fp8x8(e[0], e[1], e[2], e[3], e[4], e[5], e[6], e[7]); }
        }
    }
}
DI float sigmoidf_(float x) { return __builtin_amdgcn_rcpf(1.0f + __builtin_amdgcn_exp2f(-x * LOG2E)); }
struct CmpMK { int tq, h, q0; DI bool need(int t) const { return 512 * t + 527 > q0; }
    DI void operator()(int t, f32x16& S) const {
#pragma unroll
    for (int i = 0; i < 16; ++i) { const int n = 32 * t + crow(i, h); S[i] = (16 * n + 31 <= tq) ? S[i] : -INFINITY; } } };
struct WinMK { int tq, h, qt; DI bool need(int t) const { return t == qt || t == qt - 16; }
    DI void operator()(int t, f32x16& S) const {
#pragma unroll
    for (int i = 0; i < 16; ++i) { const int k = 32 * t + crow(i, h); S[i] = (k <= tq && k > tq - 512) ? S[i] : -INFINITY; } } };
DI void ph_nsa_cmp(const Frame& F, const int half) {
    const float* c48 = (const float*)(F.ws + TAB_COS48); const float* s48 = (const float*)(F.ws + TAB_SIN48);
    unsigned char* ar = F.ws + WS_AR; const bf16* Q = (const bf16*)(ar + NA_Q); const bf16* KCMP = (const bf16*)(ar + NA_KCMP); const bf16* VCT = (const bf16*)(ar + NA_VCT); const bf16* GT = (const bf16*)(ar + NA_GT);
    unsigned char* SELB = ar + NA_SELB; bf16* Ob = (bf16*)(ar + NA_O);
    LAS float* imp = (LAS float*)F.lds;
    LAS unsigned char* kres = F.lds + 20480;
    LAS unsigned char* vring = F.lds + 20480 + 98304;
    const int lane = F.lane, r = lane & 31, h = lane >> 5, tid = F.tid;
    for (int u = blockIdx.x; u < BPH * 4 * 64; u += F.G) {
        const int bg = u >> 6, qt64 = ((u >> 8) & 1) ? 63 - (u & 63) : (u & 63), bl = bg >> 2, g = bg & 3;
        const int tqmaxb = qt64 * 64 + 63, TE = (tqmaxb >= 31) ? ((tqmaxb - 31) / 16) / 32 + 1 : 0;
        const bf16* ksrc = KCMP + (size_t)bg * 8 * 12 * 512; const bf16* vsrc = VCT + (size_t)bg * 8 * 8 * 512;
        for (int i = F.tid; i < 64 * 65; i += NWAVES * 64) imp[i] = 0.f;
        for (int p = tid; p < TE * 768; p += NWAVES * 64) *(LAS u32x4*)(kres + p * 16) = *(const u32x4*)(ksrc + (size_t)p * 8);
        __syncthreads();
#pragma unroll 1
        for (int k = 0; k < 3; ++k) {
            const int idx = F.wave * 3 + k, j = idx >> 1, sub = idx & 1, ql = sub * 32 + r, tq = qt64 * 64 + ql, hd = g * 12 + j;
            const size_t mrow = (size_t)bl * SEQ + tq;
            bf16x8 qf[12];
#pragma unroll
            for (int s = 3; s < 12; ++s) qf[s] = *(const bf16x8*)(Q + mrow * 9216 + hd * 192 + 16 * s + 8 * h);
            { const float* cs = c48 + ((size_t)half * MC + mrow) * 24; const float* sn = s48 + ((size_t)half * MC + mrow) * 24;
#pragma unroll
              for (int s = 0; s < 3; ++s) qf[s] = rope_frag32(Q + mrow * 9216 + hd * 192, s, h, cs, sn); }
            const int tqmax = qt64 * 64 + sub * 32 + 31, te = (tqmax >= 31) ? ((tqmax - 31) / 16) / 32 + 1 : 0;
            const CmpMK mk{tq, h, qt64 * 64 + sub * 32};
            float m = -INFINITY, l = 0.f;
            {
                f32x16 Od[4];
#pragma unroll 1
                for (int t = 0; t < te; ++t) {
                    const LAS unsigned char* cur = kres + t * 12288;
                    f32x16 S;
#pragma unroll
                    for (int i = 0; i < 16; ++i) S[i] = 0.f;
#pragma unroll
                    for (int s = 0; s < 12; ++s) S = MFMA32(*(const LAS bf16x8*)(cur + s * 1024 + lane * 16), qf[s], S);
                    if (mk.need(t)) mk(t, S);
                    bf16x8 pfd[2]; softmax_step<4, false>(S, m, l, Od, pfd);
                }
            }
            l += __shfl_xor(l, 32);
            const float linv = l > 0.f ? 1.0f / l : 0.f, ms = (m == -INFINITY) ? 0.f : m;
            f32x16 O[4];
#pragma unroll
            for (int db = 0; db < 4; ++db)
#pragma unroll
                for (int i = 0; i < 16; ++i) O[db][i] = 0.f;
            if (TE > 0) {
                u32x4 pv = *(const u32x4*)(vsrc + (size_t)tid * 8);
                *(LAS u32x4*)(vring + tid * 16) = pv;
                LDS_WAIT(); __builtin_amdgcn_s_barrier(); asm volatile("" ::: "memory");
#pragma unroll 1
                for (int t = 0; t < TE; ++t) {
                    const LAS unsigned char* cur = kres + t * 12288; const LAS unsigned char* vcur = vring + (t & 1) * 8192;
                    if (t + 1 < TE) pv = *(const u32x4*)(vsrc + ((size_t)(t + 1) * 512 + tid) * 8);
                    if (t < te) {
                        f32x16 S;
#pragma unroll
                        for (int i = 0; i < 16; ++i) S[i] = 0.f;
#pragma unroll
                        for (int s = 0; s < 12; ++s) S = MFMA32(*(const LAS bf16x8*)(cur + s * 1024 + lane * 16), qf[s], S);
                        if (mk.need(t)) mk(t, S);
#pragma unroll
                        for (int i = 0; i < 16; ++i) S[i] = __builtin_amdgcn_exp2f(S[i] - ms) * linv;
#pragma unroll
                        for (int g4 = 0; g4 < 4; ++g4) { const float gs = (S[4 * g4] + S[4 * g4 + 1]) + (S[4 * g4 + 2] + S[4 * g4 + 3]); const int mb = 8 * t + 2 * g4 + h;
                            __hip_atomic_fetch_add(imp + ql * 65 + mb, gs, __ATOMIC_RELAXED, __HIP_MEMORY_SCOPE_WORKGROUP);
                            if (mb + 1 < 64) __hip_atomic_fetch_add(imp + ql * 65 + mb + 1, S[4 * g4 + 3], __ATOMIC_RELAXED, __HIP_MEMORY_SCOPE_WORKGROUP); }
                        bf16x8 pf[2];
#pragma unroll
                        for (int s = 0; s < 2; ++s) { u32x4 w; w.x = pk2(S[8 * s], S[8 * s + 1]); w.y = pk2(S[8 * s + 2], S[8 * s + 3]); w.z = pk2(S[8 * s + 4], S[8 * s + 5]); w.w = pk2(S[8 * s + 6], S[8 * s + 7]); pf[s] = __builtin_bit_cast(bf16x8, w); }
#pragma unroll
                        for (int db = 0; db < 4; ++db)
#pragma unroll
                            for (int s = 0; s < 2; ++s) O[db] = MFMA32(*(const LAS bf16x8*)(vcur + (db * 2 + s) * 1024 + lane * 16), pf[s], O[db]);
                    }
                    if (t + 1 < TE) *(LAS u32x4*)(vring + ((t + 1) & 1) * 8192 + tid * 16) = pv;
                    LDS_WAIT(); __builtin_amdgcn_s_barrier(); asm volatile("" ::: "memory");
                }
            }
            const float gate = sigmoidf_(bf2f(GT[mrow * 256 + hd]));
            store_col<false>(Ob + mrow * 6144 + hd * 128, O, gate, h);
        }
        __syncthreads();
#pragma unroll 1
        for (int k = 0; k < 8; ++k) {
            const int ql = F.wave * 8 + k, tq = qt64 * 64 + ql, cur = tq >> 6, mb = lane;
            const bool causal = mb <= cur, forced = (mb == 0) || (mb == cur) || (mb == cur - 1);
            const float v = causal ? (forced ? INFINITY : imp[ql * 65 + mb]) : -INFINITY;
            int rank = 0;
            for (int o = 0; o < 64; ++o) { const float vo = __shfl(v, o); rank += (vo > v || (vo == v && o < mb)) ? 1 : 0; }
            if (rank < 16) SELB[((size_t)bg * 4096 + tq) * 16 + rank] = causal ? (unsigned char)mb : (unsigned char)0xFF;
        }
        __syncthreads();
    }
}
DI int sel_tile(const u32x4& sel, int t) { const int b = t >> 1; const unsigned w = (b < 4) ? sel.x : (b < 8) ? sel.y : (b < 12) ? sel.z : sel.w; return (int)((w >> ((b & 3) * 8)) & 0xFFu) * 2 + (t & 1); }
struct SelMK { u32x4 sel; int tq, h; DI void operator()(int t, f32x16& S) const { const int k0 = sel_tile(sel, t) * 32;
#pragma unroll
    for (int i = 0; i < 16; ++i) S[i] = (k0 + crow(i, h) <= tq) ? S[i] : -INFINITY; } };
typedef float f32x4_ __attribute__((ext_vector_type(4)));
#define MFMA16F8(a, b, c) __builtin_amdgcn_mfma_f32_16x16x32_fp8_fp8((a), (b), (c), 0, 0, 0)
DI void ph_nsa_sel(const Frame& F, const int half) {
    const float* c48 = (const float*)(F.ws + TAB_COS48); const float* s48 = (const float*)(F.ws + TAB_SIN48);
    unsigned char* ar = F.ws + WS_AR; const bf16* Q = (const bf16*)(ar + NA_Q); const unsigned char* KS8 = ar + NA_KSF; const unsigned char* VS8 = ar + NA_VSF; const bf16* GT = (const bf16*)(ar + NA_GT);
    const unsigned char* SELB = ar + NA_SELB; bf16* Ob = (bf16*)(ar + NA_O);
    const int c16 = F.lane & 15, kq = F.lane >> 4; const bool act = c16 < 12;
    for (int it = F.gw; it < BPH * 4 * SEQ; it += F.NGW) {
        const int bg = it >> 12, tq = ((it & 4095) + 256 * bg) & 4095, bl = bg >> 2, g = bg & 3; const size_t mrow = (size_t)bl * SEQ + tq; const int hd = g * 12 + (act ? c16 : 0);
        fp8x8_t qf[6];
#pragma unroll
        for (int s = 0; s < 6; ++s) { const float qs = act ? (1.0f / NSA_QSCALE) : 0.f; const int p = 4 * s + kq;
            if (s < 2 && p < 6) { float o[8]; rope_piece(Q + mrow * 9216 + hd * 192, p, c48 + ((size_t)half * MC + mrow) * 24, s48 + ((size_t)half * MC + mrow) * 24, o);
                qf[s] = pack_fp8x8(o[0] * qs, o[1] * qs, o[2] * qs, o[3] * qs, o[4] * qs, o[5] * qs, o[6] * qs, o[7] * qs); }
            else { const u32x4 q = *(const u32x4*)(Q + mrow * 9216 + hd * 192 + 32 * s + 8 * kq);
                qf[s] = pack_fp8x8(bflo(q[0]) * qs, bfhi(q[0]) * qs, bflo(q[1]) * qs, bfhi(q[1]) * qs, bflo(q[2]) * qs, bfhi(q[2]) * qs, bflo(q[3]) * qs, bfhi(q[3]) * qs); } }
        const u32x4 sel = *(const u32x4*)(SELB + ((size_t)bg * 4096 + tq) * 16);
        const int nv = ((tq >> 6) + 1 < 16) ? (tq >> 6) + 1 : 16, te = 2 * nv;
        const unsigned char* kb = KS8 + ((size_t)bg * 128 * 12 * 64 + F.lane) * 8; const unsigned char* vb = VS8 + ((size_t)bg * 128 * 8 * 64 + F.lane) * 8;
        f32x4_ O[8];
#pragma unroll
        for (int db = 0; db < 8; ++db) O[db] = (f32x4_){0.f, 0.f, 0.f, 0.f};
        float m = -INFINITY, l = 0.f;
        fp8x8_t kfA[12], kfB[12], vfA[8], vfB[8];
        { const unsigned char* kp = kb + (size_t)sel_tile(sel, 0) * 12 * 512; const unsigned char* kp1 = kb + (size_t)sel_tile(sel, 1) * 12 * 512; const unsigned char* vp = vb + (size_t)sel_tile(sel, 0) * 8 * 512;
#pragma unroll
          for (int s = 0; s < 12; ++s) { kfA[s] = *(const fp8x8_t*)(kp + s * 512); kfB[s] = *(const fp8x8_t*)(kp1 + s * 512); }
#pragma unroll
          for (int j = 0; j < 8; ++j) vfA[j] = *(const fp8x8_t*)(vp + j * 512); }
#define SEL_STEP(T_, KF_, VF_, VFN_) do { const int t_ = (T_); const int tile = sel_tile(sel, t_); \
            if (t_ + 1 < te) { const unsigned char* vp = vb + (size_t)sel_tile(sel, t_ + 1) * 8 * 512; _Pragma("unroll") for (int j = 0; j < 8; ++j) VFN_[j] = *(const fp8x8_t*)(vp + j * 512); } \
            f32x4_ S0 = {0.f, 0.f, 0.f, 0.f}, S1 = S0; \
            _Pragma("unroll") for (int s = 0; s < 6; ++s) { S0 = MFMA16F8(KF_[s], qf[s], S0); S1 = MFMA16F8(KF_[6 + s], qf[s], S1); } \
            if (t_ + 2 < te) { const unsigned char* kp = kb + (size_t)sel_tile(sel, t_ + 2) * 12 * 512; _Pragma("unroll") for (int s = 0; s < 12; ++s) KF_[s] = *(const fp8x8_t*)(kp + s * 512); } \
            const int k0 = tile * 32 + 4 * kq; float mx = -INFINITY; \
            _Pragma("unroll") for (int i = 0; i < 4; ++i) { S0[i] = (k0 + i <= tq) ? S0[i] * NSA_QSCALE : -INFINITY; S1[i] = (k0 + 16 + i <= tq) ? S1[i] * NSA_QSCALE : -INFINITY; mx = fmaxf(mx, fmaxf(S0[i], S1[i])); } \
            mx = fmaxf(mx, __shfl_xor(mx, 16)); mx = fmaxf(mx, __shfl_xor(mx, 32)); \
            const float mn = fmaxf(m, mx), ms = (mn == -INFINITY) ? 0.f : mn, alpha = __builtin_amdgcn_exp2f(m - ms); \
            float sum = 0.f; \
            _Pragma("unroll") for (int i = 0; i < 4; ++i) { S0[i] = __builtin_amdgcn_exp2f(S0[i] - ms); S1[i] = __builtin_amdgcn_exp2f(S1[i] - ms); sum += S0[i] + S1[i]; } \
            l = l * alpha + sum; m = mn; \
            if (__builtin_amdgcn_ballot_w64(alpha != 1.0f) != 0ull) { _Pragma("unroll") for (int db = 0; db < 8; ++db) O[db] = O[db] * alpha; } \
            const fp8x8_t p8 = pack_fp8x8(S0[0], S0[1], S0[2], S0[3], S1[0], S1[1], S1[2], S1[3]);       \
            _Pragma("unroll") for (int db = 0; db < 8; ++db) O[db] = MFMA16F8(VF_[db], p8, O[db]); } while (0)
#pragma unroll 1
        for (int t = 0; t < te; t += 2) { SEL_STEP(t, kfA, vfA, vfB); SEL_STEP(t + 1, kfB, vfB, vfA); }
#undef SEL_STEP
        l += __shfl_xor(l, 16); l += __shfl_xor(l, 32);
        if (act) { const float gate = sigmoidf_(bf2f(GT[mrow * 256 + 48 + hd])); const float sc = l > 0.f ? gate / l : 0.f;
            bf16* o = Ob + mrow * 6144 + hd * 128 + 4 * kq;
#pragma unroll
            for (int db = 0; db < 8; ++db) { u32x2* p = (u32x2*)(o + db * 16); const u32x2 prev = *p;
                u32x2 w; w.x = pk2(O[db][0] * sc + bflo(prev.x), O[db][1] * sc + bfhi(prev.x)); w.y = pk2(O[db][2] * sc + bflo(prev.y), O[db][3] * sc + bfhi(prev.y)); *p = w; } }
    }
}
DI void ph_nsa_win(const Frame& F, const int half) {
    const float* c48 = (const float*)(F.ws + TAB_COS48); const float* s48 = (const float*)(F.ws + TAB_SIN48);
    unsigned char* ar = F.ws + WS_AR; const bf16* Q = (const bf16*)(ar + NA_Q); const bf16* KWF = (const bf16*)(ar + NA_KWF); const bf16* VWF = (const bf16*)(ar + NA_VWF); const bf16* GT = (const bf16*)(ar + NA_GT); bf16* Ob = (bf16*)(ar + NA_O);
    const int r = F.lane & 31, h = F.lane >> 5;
    for (int idb = blockIdx.x; idb < BPH * 4 * 3 * 64; idb += F.G) {
        const int qt0 = (((idb & 63) + (idb >> 8)) & 63) * 2, qt = qt0 + (F.wave & 1), rest = idb >> 6, hq = rest % 3, bg = rest / 3, bl = bg >> 2, g = bg & 3, hd = g * 12 + hq * 4 + (F.wave >> 1), tq = qt * 32 + r; const size_t mrow = (size_t)bl * SEQ + tq;
        bf16x8 qf[12];
#pragma unroll
        for (int s = 3; s < 12; ++s) qf[s] = *(const bf16x8*)(Q + mrow * 9216 + hd * 192 + 16 * s + 8 * h);
        { const float* cs = c48 + ((size_t)half * MC + mrow) * 24; const float* sn = s48 + ((size_t)half * MC + mrow) * 24;
#pragma unroll
          for (int s = 0; s < 3; ++s) qf[s] = rope_frag32(Q + mrow * 9216 + hd * 192, s, h, cs, sn); }
        const FragSrc src{KWF + (size_t)bg * 128 * 12 * 512, VWF + (size_t)bg * 128 * 8 * 512, 12}; const WinMK mk{tq, h, qt};
        f32x16 O[4];
#pragma unroll
        for (int db = 0; db < 4; ++db)
#pragma unroll
            for (int i = 0; i < 16; ++i) O[db][i] = 0.f;
        float m = -INFINITY, l = 0.f;
        attn_run_sh<12, true>(F.lds, F.tid, F.lane, qf, O, m, l, qt0 >= 16 ? qt0 - 16 : 0, qt0 + 2, qt >= 16 ? qt - 16 : 0, qt + 1, src, mk);
        l += __shfl_xor(l, 32);
        const float gate = sigmoidf_(bf2f(GT[mrow * 256 + 96 + hd]));
        store_col<true>(Ob + mrow * 6144 + hd * 128, O, l > 0.f ? gate / l : 0.f, h);
    }
}
#ifndef MK_ONE_LAUNCH
#define MK_ONE_LAUNCH 1
#endif
constexpr int NPH = 69;
struct Args { const float* in[58]; float* out; unsigned char* ws; int ph_lo, ph_hi; };
#define GEMM_AKOFF 0
#define GEMM_CALL(EpiT, Evar, Aptr, Bptr, Mv, Nv, Kv, ldav, ldbv, cidx) do { const pg8::Gemm g_{(const pg8::bf16_t*)(Aptr), (const pg8::bf16_t*)(Bptr), (Mv), (Nv), (Kv), (ldav), (ldbv), GEMM_AKOFF}; \
    pg8::StaticOrder S_; S_.init((Mv), (Nv), F.G, (cidx)); pg8::gemm_phase<EpiT, pg8::StaticOrder, true, true>((PG8_LAS unsigned char*)F.lds, g_, S_, Evar); } while (0)
DI pg8::EpiBf16R epi1(bf16* base, int ldc) { pg8::EpiBf16R e; for (int s = 0; s < 8; ++s) { e.T.base[s] = base; e.T.ldc[s] = ldc; e.T.t0[s] = 0; e.T.gw[s] = 0; } e.T.nseg = 1; e.T.pad_ = 0; e.ssp = nullptr; e.ss_off = 0; return e; }
#define PH_BEGIN if (ph >= lo && ph < hi) { Frame F; { unsigned long long w_ = (unsigned long long)args.ws; asm volatile("" : "+s"(w_)); F.ws = (unsigned char*)w_; F.ctl = (unsigned*)(F.ws + WS_CTL); } \
    F.lds = lds; F.tid = threadIdx.x; F.lane = F.tid & 63; F.wave = __builtin_amdgcn_readfirstlane(F.tid >> 6); F.G = gridDim.x; F.gw = blockIdx.x * NWAVES + F.wave; F.NGW = F.G * NWAVES; \
    float* out; { unsigned long long o_ = (unsigned long long)args.out; asm volatile("" : "+s"(o_)); out = (float*)o_; } \
    unsigned char* const ar = F.ws + WS_AR; bf16* const XN = (bf16*)(F.ws + WS_XNR); float* const SSB = (float*)(F.ws + WS_SS); bf16* const WB = (bf16*)(F.ws + WS_WMIX); bf16* const WUP = (bf16*)(F.ws + WS_WFFN); bf16* const WDN = WUP + (size_t)2 * DFF * DM; \
    const float* const res_mix = (ib == 2) ? args.in[0] : (const float*)out; (void)ar; (void)XN; (void)SSB; (void)WB; (void)WUP; (void)WDN; (void)res_mix; (void)iff;
#define PH_END   if (ph + 1 < hi) { XcdBarrier b_; b_.bar = (unsigned*)F.ctl + CW_BAR; b_.x = xb_xcc_id(); b_.st = MISC + 8; xcd_barrier(b_); } } ++ph;
template <int LAYER> DI void run_cvt(const Args& args, LAS unsigned char* lds, volatile LAS unsigned* MISC, int& ph, const int lo, const int hi) {
    constexpr int ib = (LAYER == 0) ? 2 : (LAYER == 1) ? 17 : (LAYER == 2) ? 26 : 42;
    constexpr int iff = (LAYER == 0) ? 12 : (LAYER == 1) ? 21 : (LAYER == 2) ? 37 : 52;
    constexpr int kind = (LAYER == 1) ? 1 : (LAYER == 2) ? 2 : 0;
        PH_BEGIN
            if constexpr (LAYER == 0) { ph_tables(F, (const int*)args.in[1]); ph_norm_first(F, args.in[0], args.in[2], XN, SSB); }
            if constexpr (kind == 0) ph_dsa_cvt(F, args.in[ib + 1], args.in[ib + 6], args.in[ib + 7], args.in[ib + 8], args.in[ib + 9]);
            else if constexpr (kind == 1) ph_fox_cvt(F, args.in[ib + 1], args.in[ib + 3]);
            else ph_nsa_cvt(F, args.in[ib + 1], args.in[ib + 2], args.in[ib + 3], args.in[ib + 4], args.in[ib + 5], args.in[ib + 6], args.in[ib + 7], args.in[ib + 8], args.in[ib + 9], args.in[ib + 10]);
            ph_cvt_ffn(F, args.in[iff + 1], args.in[iff + 4]);
        PH_END
}
template <int LAYER, int HALF> DI void run_half(const Args& args, LAS unsigned char* lds, volatile LAS unsigned* MISC, int& ph, const int lo, const int hi) {
    constexpr int ib = (LAYER == 0) ? 2 : (LAYER == 1) ? 17 : (LAYER == 2) ? 26 : 42;
    constexpr int iff = (LAYER == 0) ? 12 : (LAYER == 1) ? 21 : (LAYER == 2) ? 37 : 52;
    constexpr int kind = (LAYER == 1) ? 1 : (LAYER == 2) ? 2 : 0;
    constexpr int half = HALF;
            const int roff = half * MC;
            if constexpr (kind == 0) {
                PH_BEGIN { pg8::EpiF32 E{(float*)(ar + DA_DIN), 1024, SSB + (size_t)(LAYER * 2) * MTOT * 8, roff}; GEMM_CALL(pg8::EpiF32, E, XN + (size_t)roff * DM, WB + DW_W1, MC, 1024, DM, DM, DM, (int)blockIdx.x); } PH_END
                PH_BEGIN ph_dsa_post1(F, half, args.in[ib + 2], args.in[ib + 3], args.in[ib + 4], args.in[ib + 5]); PH_END
                PH_BEGIN { pg8::EpiBf16R E = epi1((bf16*)(ar + DA_QL), 8192); E.T.base[1] = (bf16*)(ar + DA_QPE); E.T.ldc[1] = 1536; E.T.t0[1] = 32; E.T.base[2] = (bf16*)(ar + DA_QIDX); E.T.ldc[2] = 2048; E.T.t0[2] = 38; E.T.nseg = 3;
                    GEMM_CALL(pg8::EpiBf16R, E, ar + DA_CQN, WB + DW_W2, MC, 11776, 512, 512, 512, (int)blockIdx.x); } PH_END
                PH_BEGIN ph_dsa_index(F, half); PH_END
                PH_BEGIN ph_dsa_attn(F, half); PH_END
                PH_BEGIN {
                    pg8::EpiBf16R E = epi1((bf16*)(ar + DA_O2), 4096);
                    { const pg8::Gemm g_{(const pg8::bf16_t*)(ar + DA_QL), (const pg8::bf16_t*)(WB + DW_BD), MC, 4096, 512, 8192, 512, 512}; pg8::StaticOrder S_; S_.init(MC, 4096, F.G, (int)blockIdx.x);
                      pg8::gemm_phase<pg8::EpiBf16R, pg8::StaticOrder, true, true>((PG8_LAS unsigned char*)F.lds, g_, S_, E); } } PH_END
                PH_BEGIN { pg8::EpiResN E{LAYER == 0 ? args.in[0] : nullptr, args.in[ib], nullptr, DM, roff, args.in[iff], (pg8::bf16_t*)XN, SSB + (size_t)(LAYER * 2 + 1) * MTOT * 8, (PG8_LAS float*)(F.lds + LDSCTL_OFF + 256)}; GEMM_CALL(pg8::EpiResN, E, ar + DA_O2, WB + DW_WO, MC, DM, 4096, 4096, 4096, (int)blockIdx.x); } PH_END
            } else if constexpr (kind == 1) {
                PH_BEGIN { pg8::EpiBf16R E = epi1((bf16*)(ar + FA_Q), DM); E.T.base[1] = (bf16*)(ar + FA_K); E.T.ldc[1] = DM; E.T.t0[1] = 8; E.T.base[2] = (bf16*)(ar + FA_V); E.T.ldc[2] = DM; E.T.t0[2] = 16;
                    E.T.base[3] = (bf16*)(ar + FA_F); E.T.ldc[3] = 256; E.T.t0[3] = 24; E.T.nseg = 4; E.ssp = SSB + (size_t)(LAYER * 2) * MTOT * 8; E.ss_off = roff;
                    GEMM_CALL(pg8::EpiBf16R, E, XN + (size_t)roff * DM, WB + FW_IN, MC, 6400, DM, DM, DM, (int)blockIdx.x); } PH_END
                PH_BEGIN ph_fox_scan(F, args.in[ib + 2]); PH_END
                PH_BEGIN ph_fox_attn(F); PH_END
                PH_BEGIN { pg8::EpiResN E{LAYER == 0 ? args.in[0] : nullptr, args.in[ib], nullptr, DM, roff, args.in[iff], (pg8::bf16_t*)XN, SSB + (size_t)(LAYER * 2 + 1) * MTOT * 8, (PG8_LAS float*)(F.lds + LDSCTL_OFF + 256)}; GEMM_CALL(pg8::EpiResN, E, ar + FA_O, WB + FW_OUT, MC, DM, DM, DM, DM, (int)blockIdx.x); } PH_END
            } else {
                PH_BEGIN { pg8::EpiBf16R E = epi1((bf16*)(ar + NA_Q), 9216);
                    E.T.base[1] = (bf16*)(ar + NA_KC); E.T.ldc[1] = 192; E.T.t0[1] = 36; E.T.gw[1] = 192;
                    E.T.base[2] = (bf16*)(ar + NA_VC); E.T.ldc[2] = 128; E.T.t0[2] = 39; E.T.gw[2] = 128;
                    E.T.base[3] = (bf16*)(ar + NA_KSR); E.T.ldc[3] = 768; E.T.t0[3] = 41;
                    E.T.base[4] = (bf16*)(ar + NA_KWR); E.T.ldc[4] = 768; E.T.t0[4] = 44;
                    E.T.base[5] = (bf16*)(ar + NA_GT); E.T.ldc[5] = 256; E.T.t0[5] = 47;
                    E.T.base[6] = (bf16*)(ar + NA_VSR); E.T.ldc[6] = 512; E.T.t0[6] = 48;
                    E.T.base[7] = (bf16*)(ar + NA_VWR); E.T.ldc[7] = 512; E.T.t0[7] = 50; E.T.nseg = 8; E.ssp = SSB + (size_t)(LAYER * 2) * MTOT * 8; E.ss_off = roff;
                    GEMM_CALL(pg8::EpiBf16R, E, XN + (size_t)roff * DM, WB + NW_IN, MC, 13312, DM, DM, DM, (int)blockIdx.x); } PH_END
                PH_BEGIN ph_nsa_rope(F, half); PH_END
                PH_BEGIN {
                    const float* BIAS = (const float*)(args.ws + WS_MISC);
                    { pg8::EpiGelu E{(bf16*)(ar + NA_GK), 256, BIAS}; GEMM_CALL(pg8::EpiGelu, E, ar + NA_KC, WB + NW_W1K, 4096, 256, 6144, 3072, 6144, (int)blockIdx.x); }
                    { pg8::EpiGelu E{(bf16*)(ar + NA_GV), 256, BIAS + 256}; GEMM_CALL(pg8::EpiGelu, E, ar + NA_VC, WB + NW_W1V, 4096, 256, 4096, 2048, 4096, (int)((blockIdx.x + F.G - 16) % F.G)); }
                } PH_END
                PH_BEGIN {
                    { pg8::EpiBf16R E = epi1((bf16*)(ar + NA_KCMP), 12); E.T.gw[0] = -1; GEMM_CALL(pg8::EpiBf16R, E, ar + NA_GK, WB + NW_W2K, 4096, 256, 256, 256, 256, (int)blockIdx.x); }
                    { pg8::EpiBf16R E = epi1((bf16*)(ar + NA_VCT), 4); E.T.gw[0] = -2; GEMM_CALL(pg8::EpiBf16R, E, WB + NW_W2V, ar + NA_GV, 256, 4096, 256, 256, 256, (int)((blockIdx.x + F.G - 16) % F.G)); }
                } PH_END
                PH_BEGIN ph_nsa_cmp(F, half); PH_END
                PH_BEGIN ph_nsa_sel(F, half); PH_END
                PH_BEGIN ph_nsa_win(F, half); PH_END
                PH_BEGIN { pg8::EpiResN E{LAYER == 0 ? args.in[0] : nullptr, args.in[ib], nullptr, DM, roff, args.in[iff], (pg8::bf16_t*)XN, SSB + (size_t)(LAYER * 2 + 1) * MTOT * 8, (PG8_LAS float*)(F.lds + LDSCTL_OFF + 256)}; GEMM_CALL(pg8::EpiResN, E, ar + NA_O, WB + NW_OUT, MC, DM, 6144, 6144, 6144, (int)blockIdx.x); } PH_END
            }
}
template <int LAYER> DI void run_ffn(const Args& args, LAS unsigned char* lds, volatile LAS unsigned* MISC, int& ph, const int lo, const int hi) {
    constexpr int ib = (LAYER == 0) ? 2 : (LAYER == 1) ? 17 : (LAYER == 2) ? 26 : 42;
    constexpr int iff = (LAYER == 0) ? 12 : (LAYER == 1) ? 21 : (LAYER == 2) ? 37 : 52;
    PH_BEGIN {
        LAS float* rt = (LAS float*)(F.lds + LDSCTL_OFF + 256 + 8192); const int rbase = 4096 * (int)(blockIdx.x & 7); const float* ssq = SSB + (size_t)(LAYER * 2 + 1) * MTOT * 8;
        for (int i = F.tid; i < 4096; i += NWAVES * 64) rt[i] = pg8::rms_rowscale(ssq, rbase + i);
        __syncthreads();
        pg8::EpiConvGlu E{(pg8::bf16_t*)ar, (float*)(ar + 352 * MiB), args.in[iff + 2], args.in[iff + 3], (PG8_LAS float*)(F.lds + LDSCTL_OFF + 256), DFF, (const PG8_LAS float*)rt, rbase};
        GEMM_CALL(pg8::EpiConvGlu, E, XN, WUP, MTOT, 2 * DFF, DM, DM, DM, (int)blockIdx.x); } PH_END
    PH_BEGIN ph_conv_fix(F, (const float*)(ar + 352 * MiB), (bf16*)ar, args.in[iff + 2], args.in[iff + 3], MTOT); PH_END
    PH_BEGIN {
        if constexpr (LAYER < 3) { constexpr int ibn = (LAYER == 0) ? 17 : (LAYER == 1) ? 26 : 42;
            pg8::EpiResN E{nullptr, args.in[iff], nullptr, DM, 0, args.in[ibn], (pg8::bf16_t*)XN, SSB + (size_t)((LAYER + 1) * 2) * MTOT * 8, (PG8_LAS float*)(F.lds + LDSCTL_OFF + 256)}; GEMM_CALL(pg8::EpiResN, E, ar, WDN, MTOT, DM, DFF, DFF, DFF, (int)blockIdx.x); }
        else { pg8::EpiResN E{nullptr, args.in[iff], out, DM, 0, nullptr, (pg8::bf16_t*)XN, nullptr, (PG8_LAS float*)(F.lds + LDSCTL_OFF + 256)}; GEMM_CALL(pg8::EpiResN, E, ar, WDN, MTOT, DM, DFF, DFF, DFF, (int)blockIdx.x); }
    } PH_END
}
__global__ void __launch_bounds__(NWAVES * 64, 2) mk_fwd(Args args) {
    extern __shared__ __attribute__((aligned(16))) unsigned char lds_[];
    LAS unsigned char* const lds = (LAS unsigned char*)lds_;
    volatile LAS unsigned* MISC = (volatile LAS unsigned*)(lds + LDSCTL_OFF);
    for (int u = threadIdx.x; u < 64; u += NWAVES * 64) ((LAS unsigned*)(lds + LDSCTL_OFF))[u] = 0u;
    __syncthreads();
    const int lo = args.ph_lo, hi = args.ph_hi;
    (void)xcd_barrier_post((unsigned*)(args.ws + WS_CTL) + CW_BAR, MISC + 8);
    int ph = 0;
    run_cvt<0>(args, lds, MISC, ph, lo, hi); run_half<0, 0>(args, lds, MISC, ph, lo, hi); run_half<0, 1>(args, lds, MISC, ph, lo, hi); run_ffn<0>(args, lds, MISC, ph, lo, hi);
    run_cvt<1>(args, lds, MISC, ph, lo, hi); run_half<1, 0>(args, lds, MISC, ph, lo, hi); run_half<1, 1>(args, lds, MISC, ph, lo, hi); run_ffn<1>(args, lds, MISC, ph, lo, hi);
    run_cvt<2>(args, lds, MISC, ph, lo, hi); run_half<2, 0>(args, lds, MISC, ph, lo, hi); run_half<2, 1>(args, lds, MISC, ph, lo, hi); run_ffn<2>(args, lds, MISC, ph, lo, hi);
    run_cvt<3>(args, lds, MISC, ph, lo, hi); run_half<3, 0>(args, lds, MISC, ph, lo, hi); run_half<3, 1>(args, lds, MISC, ph, lo, hi); run_ffn<3>(args, lds, MISC, ph, lo, hi);
    { constexpr int ib = 42, iff = 52; PH_BEGIN ph_final_norm(F, out, args.in[57]); PH_END }
}
extern "C" void kernel_launch(void* const* d_in, const int* in_sizes, int n_in, void* d_out, int out_size, void* d_ws, size_t ws_size, hipStream_t stream) {
    static int grid = 0;
    if (grid == 0) {
        if (n_in != 58 || out_size != MTOT * DM || ws_size < WS_END) { fprintf(stderr, "kernel_launch: unexpected shapes (n_in %d, out %d, ws %zu)\n", n_in, out_size, ws_size); grid = -1; return; }
        int dev = 0, cus = 0;
        if (hipGetDevice(&dev) != hipSuccess || hipDeviceGetAttribute(&cus, hipDeviceAttributeMultiprocessorCount, dev) != hipSuccess) { grid = -1; return; }
        if (hipFuncSetAttribute((const void*)mk_fwd, hipFuncAttributeMaxDynamicSharedMemorySize, LDS_BYTES) != hipSuccess) { fprintf(stderr, "kernel_launch: hipFuncSetAttribute failed\n"); grid = -1; return; }
        int per_cu = 0;
        (void)hipOccupancyMaxActiveBlocksPerMultiprocessor(&per_cu, (const void*)mk_fwd, NWAVES * 64, LDS_BYTES);
        (void)hipGetLastError();
        grid = cus;
    }
    if (grid < 0) return;
    if (hipMemsetAsync((char*)d_ws + WS_CTL, 0, CTL_ZERO_BYTES, stream) != hipSuccess) return;
    Args a{};
    for (int i = 0; i < 58; ++i) a.in[i] = (const float*)d_in[i];
    a.out = (float*)d_out; a.ws = (unsigned char*)d_ws;
#if MK_ONE_LAUNCH
    a.ph_lo = 0; a.ph_hi = NPH;
    hipLaunchKernelGGL(mk_fwd, dim3(grid), dim3(NWAVES * 64), LDS_BYTES, stream, a);
#else
    for (int p = 0; p < NPH; ++p) { a.ph_lo = p; a.ph_hi = p + 1; hipLaunchKernelGGL(mk_fwd, dim3(grid), dim3(NWAVES * 64), LDS_BYTES, stream, a); }
#endif
}
```

```cpp
#include <hip/hip_runtime.h>
#include <cstdio>
#include <cstdint>
#define DI __device__ __forceinline__
namespace pg8 {
#define PG8_LAS __attribute__((address_space(3)))
typedef unsigned short bf16_t;
typedef short bf16x8 __attribute__((ext_vector_type(8)));
typedef float f32x4 __attribute__((ext_vector_type(4)));
typedef unsigned u32x4 __attribute__((ext_vector_type(4)));
constexpr int BM = 256, BK = 64, HALF = 128, HTB = HALF * BK * 2  , STAGE_BYTES = 8 * HTB, NXCD = 8, WGM = 8;

__host__ __device__ __forceinline__ int lds_byte(int r, int c) { const int st = (r >> 4) * 2 + (c >> 5), rr = r & 15, cc = c & 31, ob = rr * 64 + cc * 2; return st * 1024 + (ob ^ (((ob >> 9) & 1) << 5)); }
__host__ __device__ __forceinline__ void stage_rc(int b, int& R, int& C) { const int st = b / 1024, sb = b % 1024, swz = sb ^ (((sb >> 9) & 1) << 5); R = (st >> 1) * 16 + swz / 64; C = (st & 1) * 32 + (swz % 64) / 2; }
__host__ __device__ __forceinline__ int perm32(int rho) { const int n = rho >> 4, i = rho & 15; return 8 * (i >> 2) + 4 * n + (i & 3); }

struct Unit { int pm, pn; };
struct Gemm { const bf16_t* A; const bf16_t* Bt; int M, N, K, lda, ldb, akoff; };

struct StaticOrder {
    int nM, nN, nwg, G, c;
    __host__ __device__ void init(int M, int N, int G_, int c_) { nM = M / BM; nN = N / BM; nwg = nM * nN; G = G_; c = c_; }
    __host__ __device__ bool next(int i, Unit& u) const {
        const long L = (long)i * G + c; if (L >= nwg) return false;
        int wgid = (int)L; { const int q = nwg / NXCD, r = nwg % NXCD, xcd = wgid % NXCD, off = wgid / NXCD; wgid = (xcd < r ? xcd * (q + 1) : r * (q + 1) + (xcd - r) * q) + off; }
        const int nig = WGM * nN, gid = wgid / nig, fm = gid * WGM, gsz = (nM - fm) < WGM ? (nM - fm) : WGM;
        u.pm = fm + ((wgid % nig) % gsz); u.pn = (wgid % nig) / gsz; return true;
    }
    __device__ __forceinline__ void a_ready(const Unit&) const {}
    __device__ __forceinline__ void done(const Unit&) const {}
};
__device__ __forceinline__ unsigned cvt_pk_bf16(float lo, float hi) { unsigned r; asm volatile("v_cvt_pk_bf16_f32 %0, %1, %2" : "=v"(r) : "v"(lo), "v"(hi)); return r; }
template <class Epi, class Sched, bool ALIGN_EPI = false, bool SP2 = false>
__device__ __forceinline__ void gemm_phase(PG8_LAS unsigned char* lds, const Gemm g, const Sched& S, const Epi& E) {
    const int tid = threadIdx.x, wid = __builtin_amdgcn_readfirstlane(tid >> 6), lane = tid & 63, wr = wid >> 2, wc = wid & 3, fr = lane & 15, fq = lane >> 4;
    const int K = g.K, nt = K / BK;
    unsigned voffA[2], voffB[2];
#pragma unroll
    for (int i = 0; i < 2; ++i) { int R, C; stage_rc(tid * 16 + i * 8192, R, C); const int Rb = Epi::PERM ? ((R & ~31) + perm32(R & 31)) : R;
        voffA[i] = (unsigned)(R * g.lda + C) * 2u; voffB[i] = (unsigned)(Rb * g.ldb + C) * 2u; }
    const size_t kstep = (size_t)(BK * 2);
    const size_t hstepA = (size_t)HALF * g.lda * 2, hstepB = (size_t)HALF * g.ldb * 2;
    const size_t tstepA = 2 * hstepA, tstepB = 2 * hstepB;
    const unsigned ldsw = (unsigned)wid * 1024u;
    const int aoff = lds_byte(wr * 64 + fr, fq * 8), boff = lds_byte(wc * 32 + fr, fq * 8);
#define PG8_SA(b, h) (((b) * 2 + (h)) * HTB)
#define PG8_SB(b, h) ((4 + (b) * 2 + (h)) * HTB)
#define PG8_STAGE(bufoff, gbase, voff) do { _Pragma("unroll") for (int _i = 0; _i < 2; ++_i) \
        __builtin_amdgcn_global_load_lds((const unsigned*)((const char*)(gbase) + (voff)[_i]), (PG8_LAS unsigned*)(lds + (bufoff) + ldsw + _i * 8192), 16, 0, 0); } while (0)
#define PG8_LDA(dst, b, h) do { _Pragma("unroll") for (int m = 0; m < 4; ++m) _Pragma("unroll") for (int k = 0; k < 2; ++k) dst[m][k] = *(const PG8_LAS bf16x8*)(lds + PG8_SA(b, h) + aoff + m * 2048 + k * 1024); } while (0)
#define PG8_LDB(dst, b, h) do { _Pragma("unroll") for (int n = 0; n < 2; ++n) _Pragma("unroll") for (int k = 0; k < 2; ++k) dst[n][k] = *(const PG8_LAS bf16x8*)(lds + PG8_SB(b, h) + boff + n * 2048 + k * 1024); } while (0)
#define PG8_MMA(ai, bj, At, Bt) do { __builtin_amdgcn_s_setprio(1); _Pragma("unroll") for (int m = 0; m < 4; ++m) _Pragma("unroll") for (int n = 0; n < 2; ++n) _Pragma("unroll") for (int k = 0; k < 2; ++k) \
        acc[ai][bj][m][n] = __builtin_amdgcn_mfma_f32_16x16x32_bf16(Bt[n][k], At[m][k], acc[ai][bj][m][n], 0, 0, 0); __builtin_amdgcn_s_setprio(0); } while (0)
#define PG8_WAIT_V(n) asm volatile("s_waitcnt vmcnt(" #n ")" ::: "memory")
#define PG8_WAIT_L(n) asm volatile("s_waitcnt lgkmcnt(" #n ")" ::: "memory")
#define PG8_BAR __builtin_amdgcn_s_barrier()
#define PG8_SCHED __builtin_amdgcn_sched_barrier(0)
    Unit cur, nxt; int ui = 0;
    if (!S.next(0, cur)) return;
    f32x4 acc[2][2][4][2];
#pragma unroll
    for (int a = 0; a < 2; ++a)
#pragma unroll
        for (int b = 0; b < 2; ++b)
#pragma unroll
            for (int m = 0; m < 4; ++m)
#pragma unroll
                for (int n = 0; n < 2; ++n) acc[a][b][m][n] = (f32x4){0.f, 0.f, 0.f, 0.f};
    bf16x8 At[4][2], B0[2][2], B1[2][2];
    const char* cA = (const char*)g.A + (size_t)cur.pm * tstepA + (size_t)cur.pn * g.akoff * 2; const char* cB = (const char*)g.Bt + (size_t)cur.pn * tstepB;
    S.a_ready(cur);
    if constexpr (SP2) {
        PG8_STAGE(PG8_SB(0, 0), cB, voffB); PG8_STAGE(PG8_SB(0, 1), cB + hstepB, voffB); PG8_STAGE(PG8_SA(0, 0), cA, voffA); PG8_STAGE(PG8_SA(0, 1), cA + hstepA, voffA);
        if (wr == 1) PG8_BAR;
        PG8_WAIT_V(2); PG8_BAR;
        PG8_STAGE(PG8_SB(1, 0), cB + kstep, voffB); PG8_STAGE(PG8_SA(1, 0), cA + kstep, voffA); PG8_STAGE(PG8_SB(1, 1), cB + hstepB + kstep, voffB);
        PG8_WAIT_V(6); PG8_BAR;
    } else {
        PG8_STAGE(PG8_SB(0, 0), cB, voffB); PG8_STAGE(PG8_SA(0, 0), cA, voffA); PG8_STAGE(PG8_SB(0, 1), cB + hstepB, voffB); PG8_STAGE(PG8_SA(0, 1), cA + hstepA, voffA);
        if (wr == 1) PG8_BAR;
        PG8_WAIT_V(4); PG8_BAR;
        PG8_STAGE(PG8_SB(1, 0), cB + kstep, voffB); PG8_STAGE(PG8_SA(1, 0), cA + kstep, voffA); PG8_STAGE(PG8_SB(1, 1), cB + hstepB + kstep, voffB);
        PG8_WAIT_V(6); PG8_BAR;
    }
    for (;;) {
        const bool has_next = S.next(ui + 1, nxt);
        const char* nA = has_next ? (const char*)g.A + (size_t)nxt.pm * tstepA + (size_t)nxt.pn * g.akoff * 2 : cA; const char* nB = has_next ? (const char*)g.Bt + (size_t)nxt.pn * tstepB : cB;
        for (int t = 0; t < nt; t += 2) {
            const bool last = (t == nt - 2);
            const char* a1 = cA + (size_t)(t + 1) * kstep;
            const char* a2 = last ? nA : cA + (size_t)(t + 2) * kstep; const char* b2 = last ? nB : cB + (size_t)(t + 2) * kstep;
            const char* a3 = a2 + kstep; const char* b3 = b2 + kstep;
            if (last && has_next) S.a_ready(nxt);
            if constexpr (SP2) {
            PG8_LDB(B0, 0, 0); PG8_LDB(B1, 0, 1); PG8_SCHED; PG8_LDA(At, 0, 0); PG8_STAGE(PG8_SA(1, 1), a1 + hstepA, voffA);
            PG8_WAIT_V(8); PG8_WAIT_L(0); PG8_BAR; PG8_MMA(0, 0, At, B0); PG8_MMA(0, 1, At, B1); PG8_BAR; PG8_SCHED;
            PG8_LDA(At, 0, 1); PG8_STAGE(PG8_SB(0, 0), b2, voffB); PG8_STAGE(PG8_SB(0, 1), b2 + hstepB, voffB); PG8_STAGE(PG8_SA(0, 0), a2, voffA);
            PG8_WAIT_V(8); PG8_WAIT_L(0); PG8_BAR; PG8_MMA(1, 0, At, B0); PG8_MMA(1, 1, At, B1); PG8_BAR; PG8_SCHED;
            PG8_LDB(B0, 1, 0); PG8_LDB(B1, 1, 1); PG8_SCHED; PG8_LDA(At, 1, 0); PG8_STAGE(PG8_SA(0, 1), a2 + hstepA, voffA);
            PG8_WAIT_V(8); PG8_WAIT_L(0); PG8_BAR; PG8_MMA(0, 0, At, B0); PG8_MMA(0, 1, At, B1); PG8_BAR; PG8_SCHED;
            PG8_LDA(At, 1, 1); PG8_STAGE(PG8_SB(1, 0), b3, voffB); PG8_STAGE(PG8_SB(1, 1), b3 + hstepB, voffB); PG8_STAGE(PG8_SA(1, 0), a3, voffA);
            PG8_WAIT_V(8); PG8_WAIT_L(0); PG8_BAR; PG8_MMA(1, 0, At, B0); PG8_MMA(1, 1, At, B1); PG8_BAR; PG8_SCHED;
            } else {
            PG8_LDB(B0, 0, 0); PG8_SCHED; PG8_LDA(At, 0, 0); PG8_STAGE(PG8_SA(1, 1), a1 + hstepA, voffA);
            PG8_WAIT_L(8); PG8_BAR; PG8_WAIT_L(0); PG8_MMA(0, 0, At, B0); PG8_BAR; PG8_SCHED;
            PG8_LDB(B1, 0, 1); PG8_STAGE(PG8_SB(0, 0), b2, voffB);
            PG8_BAR; PG8_WAIT_L(0); PG8_MMA(0, 1, At, B1); PG8_BAR;
            PG8_LDA(At, 0, 1); PG8_STAGE(PG8_SA(0, 0), a2, voffA);
            PG8_BAR; PG8_WAIT_L(0); PG8_MMA(1, 0, At, B0); PG8_BAR; PG8_SCHED;
            PG8_STAGE(PG8_SB(0, 1), b2 + hstepB, voffB);
            PG8_WAIT_V(6); PG8_BAR; PG8_MMA(1, 1, At, B1); PG8_BAR;
            PG8_LDB(B0, 1, 0); PG8_SCHED; PG8_LDA(At, 1, 0); PG8_STAGE(PG8_SA(0, 1), a2 + hstepA, voffA);
            PG8_WAIT_L(8); PG8_BAR; PG8_WAIT_L(0); PG8_MMA(0, 0, At, B0); PG8_BAR; PG8_SCHED;
            PG8_LDB(B1, 1, 1); PG8_STAGE(PG8_SB(1, 0), b3, voffB);
            PG8_BAR; PG8_WAIT_L(0); PG8_MMA(0, 1, At, B1); PG8_BAR;
            PG8_LDA(At, 1, 1); PG8_STAGE(PG8_SA(1, 0), a3, voffA);
            PG8_BAR; PG8_WAIT_L(0); PG8_MMA(1, 0, At, B0); PG8_BAR; PG8_SCHED;
            PG8_STAGE(PG8_SB(1, 1), b3 + hstepB, voffB);
            PG8_WAIT_V(6); PG8_BAR; PG8_MMA(1, 1, At, B1); PG8_BAR;
            }
        }
        if constexpr (ALIGN_EPI) { if (wr == 0) PG8_BAR; }
        if constexpr (!Epi::AFTER_DRAIN) { E(acc, cur, wr, wc, fr, fq); S.done(cur); }
        if (!has_next) break;
#pragma unroll
        for (int a = 0; a < 2; ++a)
#pragma unroll
            for (int b = 0; b < 2; ++b)
#pragma unroll
                for (int m = 0; m < 4; ++m)
#pragma unroll
                    for (int n = 0; n < 2; ++n) acc[a][b][m][n] = (f32x4){0.f, 0.f, 0.f, 0.f};
        cur = nxt; cA = nA; cB = nB; ++ui;
        if constexpr (ALIGN_EPI) { if (wr == 1) PG8_BAR; }
    }
    PG8_WAIT_V(0);
    if constexpr (!ALIGN_EPI) { if (wr == 0) PG8_BAR; }
    PG8_BAR;
    if constexpr (Epi::AFTER_DRAIN) { E.fused(acc, cur, wr, wc, fr, fq, lds, wid, lane); S.done(cur); }
#undef PG8_SA
#undef PG8_SB
#undef PG8_STAGE
#undef PG8_LDA
#undef PG8_LDB
#undef PG8_MMA
#undef PG8_WAIT_V
#undef PG8_WAIT_L
#undef PG8_BAR
#undef PG8_SCHED
}
}
namespace pg8 {
typedef float f32x2 __attribute__((ext_vector_type(2)));
__device__ __forceinline__ float rms_rowscale(const float* ssq, int row) { const f32x4 a = *(const f32x4*)(ssq + (size_t)row * 8), b = *(const f32x4*)(ssq + (size_t)row * 8 + 4);
    return __builtin_amdgcn_rsqf((((a[0] + a[1]) + (a[2] + a[3])) + ((b[0] + b[1]) + (b[2] + b[3]))) * (1.0f / 2048.0f) + 1e-6f); }
struct SegTab { bf16_t* base[8]; int ldc[8]; int t0[8]; int gw[8]; int nseg; int pad_; };
struct EpiBf16R {
    static constexpr bool PERM = true, AFTER_DRAIN = false;
    SegTab T; const float* ssp; int ss_off;
    __device__ __forceinline__ void operator()(const f32x4 (&acc)[2][2][4][2], const Unit& u, int wr, int wc, int fr, int fq) const {
        bf16_t* base = T.base[0]; int ldc = T.ldc[0], gw = T.gw[0], t0 = T.t0[0];
#pragma unroll
        for (int s = 1; s < 8; ++s) if (s < T.nseg && u.pn >= T.t0[s]) { base = T.base[s]; ldc = T.ldc[s]; gw = T.gw[s]; t0 = T.t0[s]; }
        const int colt = (u.pn - t0) * BM, row0 = u.pm * BM + wr * 64 + fr;
#pragma unroll
        for (int ai = 0; ai < 2; ++ai)
#pragma unroll
            for (int m = 0; m < 4; ++m) { const int row = row0 + ai * HALF + m * 16;
                const float rs = ssp ? rms_rowscale(ssp, ss_off + row) : 1.0f;
#pragma unroll
                for (int bj = 0; bj < 2; ++bj) { const int col = colt + bj * HALF + wc * 32 + 8 * fq;
                    const f32x4 v0 = acc[ai][bj][m][0] * rs, v1 = acc[ai][bj][m][1] * rs;
                    u32x4 w; w.x = cvt_pk_bf16(v0[0], v0[1]); w.y = cvt_pk_bf16(v0[2], v0[3]); w.z = cvt_pk_bf16(v1[0], v1[1]); w.w = cvt_pk_bf16(v1[2], v1[3]);
                    if (gw == -2) {
                        if ((row >> 5) < ldc) { bf16_t* d0 = base + ((size_t)(((col >> 5) * ldc + (row >> 5)) * 2 + ((col >> 4) & 1)) * 64 + (row & 31)) * 8 + 4 * ((col >> 3) & 1);
                            typedef unsigned u32x2_ __attribute__((ext_vector_type(2)));
                            *(u32x2_*)d0 = (u32x2_){w.x, w.y}; *(u32x2_*)(d0 + 32 * 8) = (u32x2_){w.z, w.w}; }
                        continue; }
                    bf16_t* dst;
                    if (gw == 0) dst = base + (size_t)row * ldc + col;
                    else if (gw == -1) { if ((col >> 4) >= ldc) continue; dst = base + ((size_t)((row >> 5) * ldc + (col >> 4)) * 64 + ((col >> 3) & 1) * 32 + (row & 31)) * 8; }
                    else { const int g = col / gw, d = col - g * gw; dst = base + ((size_t)((row >> 12) * 4 + g) * 4096 + (row & 4095)) * gw + d; }
                    *(u32x4*)dst = w; } }
    }
};
struct EpiGelu {
    static constexpr bool PERM = true, AFTER_DRAIN = false;
    bf16_t* O; int ldc; const float* bias;
    static __device__ __forceinline__ float gelu(float x) { const float u2 = 1.5957691216f * (x + 0.044715f * x * x * x); const float e = __builtin_amdgcn_exp2f(-u2 * 1.4426950409f); return x * __builtin_amdgcn_rcpf(1.0f + e); }
    __device__ __forceinline__ void operator()(const f32x4 (&acc)[2][2][4][2], const Unit& u, int wr, int wc, int fr, int fq) const {
        const int row0 = u.pm * BM + wr * 64 + fr, col0 = u.pn * BM + wc * 32 + 8 * fq;
#pragma unroll
        for (int bj = 0; bj < 2; ++bj) { const f32x4 b0 = *(const f32x4*)(bias + col0 + bj * HALF), b1 = *(const f32x4*)(bias + col0 + bj * HALF + 4);
#pragma unroll
            for (int ai = 0; ai < 2; ++ai)
#pragma unroll
                for (int m = 0; m < 4; ++m) { const f32x4 v0 = acc[ai][bj][m][0] + b0, v1 = acc[ai][bj][m][1] + b1;
                    u32x4 w; w.x = cvt_pk_bf16(gelu(v0[0]), gelu(v0[1])); w.y = cvt_pk_bf16(gelu(v0[2]), gelu(v0[3])); w.z = cvt_pk_bf16(gelu(v1[0]), gelu(v1[1])); w.w = cvt_pk_bf16(gelu(v1[2]), gelu(v1[3]));
                    *(u32x4*)(O + (size_t)(row0 + ai * HALF + m * 16) * ldc + col0 + bj * HALF) = w; } }
    }
};
struct EpiF32 {
    static constexpr bool PERM = false, AFTER_DRAIN = false;
    float* C; int ldc; const float* ssp; int ss_off;
    __device__ __forceinline__ void operator()(const f32x4 (&acc)[2][2][4][2], const Unit& u, int wr, int wc, int fr, int fq) const {
        const int row0 = u.pm * BM + wr * 64 + fr, col0 = u.pn * BM + wc * 32 + 4 * fq;
#pragma unroll
        for (int ai = 0; ai < 2; ++ai)
#pragma unroll
            for (int m = 0; m < 4; ++m) { float* rowp = C + (size_t)(row0 + ai * HALF + m * 16) * ldc + col0;
                const float rs = ssp ? rms_rowscale(ssp, ss_off + row0 + ai * HALF + m * 16) : 1.0f;
#pragma unroll
                for (int bj = 0; bj < 2; ++bj)
#pragma unroll
                    for (int n = 0; n < 2; ++n) *(f32x4*)(rowp + bj * HALF + n * 16) = acc[ai][bj][m][n] * rs; }
    }
};
struct EpiResN {
    static constexpr bool PERM = false, AFTER_DRAIN = false;
    const float* res32; const float* gprev; float* out32; int ldc; int row_off; const float* g; bf16_t* xn; float* ss; PG8_LAS float* xb;
    __device__ __forceinline__ void operator()(const f32x4 (&acc)[2][2][4][2], const Unit& u, int wr, int wc, int fr, int fq) const {
        typedef unsigned u32x2_ __attribute__((ext_vector_type(2)));
        const int row0 = row_off + u.pm * BM + wr * 64 + fr, col0 = u.pn * BM + wc * 32 + 4 * fq;
        f32x4 gv[2][2], gi[2][2];
#pragma unroll
        for (int bj = 0; bj < 2; ++bj)
#pragma unroll
            for (int n = 0; n < 2; ++n) { gv[bj][n] = g ? *(const f32x4*)(g + col0 + bj * HALF + n * 16) : (f32x4){0.f, 0.f, 0.f, 0.f};
                if (!res32) { const f32x4 t = *(const f32x4*)(gprev + col0 + bj * HALF + n * 16); gi[bj][n] = (f32x4){1.0f / t[0], 1.0f / t[1], 1.0f / t[2], 1.0f / t[3]}; } else gi[bj][n] = (f32x4){1.f, 1.f, 1.f, 1.f}; }
#pragma unroll
        for (int ai = 0; ai < 2; ++ai)
#pragma unroll
            for (int m = 0; m < 4; ++m) { const int row = row0 + ai * HALF + m * 16; const size_t off = (size_t)row * ldc + col0;
                f32x4 r[2][2]; float sq = 0.f;
#pragma unroll
                for (int bj = 0; bj < 2; ++bj)
#pragma unroll
                    for (int n = 0; n < 2; ++n) {
                        if (res32) r[bj][n] = *(const f32x4*)(res32 + off + bj * HALF + n * 16);
                        else { const u32x2_ w = *(const u32x2_*)(xn + off + bj * HALF + n * 16);
                            r[bj][n] = (f32x4){__builtin_bit_cast(float, w.x << 16), __builtin_bit_cast(float, w.x & 0xffff0000u), __builtin_bit_cast(float, w.y << 16), __builtin_bit_cast(float, w.y & 0xffff0000u)} * gi[bj][n]; } }
#pragma unroll
                for (int bj = 0; bj < 2; ++bj)
#pragma unroll
                    for (int n = 0; n < 2; ++n) { const f32x4 o = r[bj][n] + acc[ai][bj][m][n];
                        if (out32) *(f32x4*)(out32 + off + bj * HALF + n * 16) = o;
                        if (g) { sq += (o[0] * o[0] + o[1] * o[1]) + (o[2] * o[2] + o[3] * o[3]);
                            const f32x4 y = o * gv[bj][n]; *(u32x2_*)(xn + off + bj * HALF + n * 16) = (u32x2_){cvt_pk_bf16(y[0], y[1]), cvt_pk_bf16(y[2], y[3])}; } }
                if (g) { sq += __shfl_xor(sq, 16); sq += __shfl_xor(sq, 32);
                    if (fq == 0) xb[(ai * HALF + wr * 64 + m * 16 + fr) * 4 + wc] = sq; }
                asm volatile("" ::: "memory"); }
        if (g) {
            asm volatile("s_waitcnt lgkmcnt(0)" ::: "memory"); __builtin_amdgcn_s_barrier(); asm volatile("" ::: "memory");
            const int t = (wr * 4 + wc) * 64 + fq * 16 + fr;
            if (t < BM) { const f32x4 v = *(const PG8_LAS f32x4*)(xb + t * 4); ss[(size_t)(row_off + u.pm * BM + t) * 8 + u.pn] = (v[0] + v[1]) + (v[2] + v[3]); }
        }
    }
};
struct EpiConvGlu {
    static constexpr bool PERM = true, AFTER_DRAIN = false;
    bf16_t* G; float* UB; const float* cw; const float* cb; PG8_LAS float* xb; int dff; const PG8_LAS float* rstd; int rbase;
    static __device__ __forceinline__ float shr(float old, float src, int n) { const int o = __builtin_bit_cast(int, old), s = __builtin_bit_cast(int, src);
        return __builtin_bit_cast(float, n == 1 ? __builtin_amdgcn_update_dpp(o, s, 0x111, 0xf, 0xf, false) : __builtin_amdgcn_update_dpp(o, s, 0x112, 0xf, 0xf, false)); }
    static __device__ __forceinline__ float ror(float src, int n) { const int s = __builtin_bit_cast(int, src);
        return __builtin_bit_cast(float, n == 1 ? __builtin_amdgcn_update_dpp(0, s, 0x121, 0xf, 0xf, false) : __builtin_amdgcn_update_dpp(0, s, 0x122, 0xf, 0xf, false)); }
    __device__ __forceinline__ void operator()(f32x4 (&acc)[2][2][4][2], const Unit& u, int wr, int wc, int fr, int fq) const {
        typedef unsigned u32x2_ __attribute__((ext_vector_type(2)));
        if (rstd) {
#pragma unroll
            for (int ai = 0; ai < 2; ++ai)
#pragma unroll
                for (int m = 0; m < 4; ++m) { const float rs = rstd[u.pm * BM + ai * HALF + wr * 64 + m * 16 + fr - rbase];
#pragma unroll
                    for (int bj = 0; bj < 2; ++bj)
#pragma unroll
                        for (int n = 0; n < 2; ++n) acc[ai][bj][m][n] = acc[ai][bj][m][n] * rs; }
        }
        if (fr >= 14) {
#pragma unroll
            for (int ai = 0; ai < 2; ++ai)
#pragma unroll
                for (int bj = 0; bj < 2; ++bj)
#pragma unroll
                    for (int n = 0; n < 2; ++n) *(PG8_LAS f32x4*)(xb + (((((ai * 2 + wr) * 4 + wc) * 2 + (fr - 14)) * 4 + fq) * 16) + (bj * 2 + n) * 4) = acc[ai][bj][3][n];
        }
        { const int ncol = 4 * dff / 2;
          const bool top = (wr == 0 && fr < 2), bot = (wr == 1 && fr >= 14);
          if (top || bot) { float* ub = UB + ((size_t)(u.pm * 4 + (top ? fr : 2 + fr - 14)) * ncol) + u.pn * BM + wc * 32 + 8 * fq;
#pragma unroll
            for (int bj = 0; bj < 2; ++bj)
#pragma unroll
                for (int n = 0; n < 2; ++n) *(f32x4*)(ub + bj * HALF + 4 * n) = top ? acc[0][bj][0][n] : acc[1][bj][3][n]; } }
        asm volatile("s_waitcnt lgkmcnt(0)" ::: "memory"); __builtin_amdgcn_s_barrier(); asm volatile("" ::: "memory");
        u32x2_ res[2][4][2];
        const int ch0 = u.pn * HALF + wc * 32 + 8 * fq;
#pragma unroll
        for (int n = 0; n < 2; ++n) {
            const float* wp = cw + ch0 + 4 * n; const float* bp = cb + ch0 + 4 * n;
            const f32x4 w0g = *(const f32x4*)(wp), w1g = *(const f32x4*)(wp + 2 * dff), w2g = *(const f32x4*)(wp + 4 * dff), bg = *(const f32x4*)(bp);
            const f32x4 w0v = *(const f32x4*)(wp + dff), w1v = *(const f32x4*)(wp + 3 * dff), w2v = *(const f32x4*)(wp + 5 * dff), bv = *(const f32x4*)(bp + dff);
#pragma unroll
            for (int ai = 0; ai < 2; ++ai)
#pragma unroll
                for (int m = 0; m < 4; ++m) {
                    const f32x4 cg = acc[ai][0][m][n], cv = acc[ai][1][m][n];
                    f32x4 b1g, b2g, b1v, b2v;
                    if (m > 0) {
#pragma unroll
                        for (int e = 0; e < 4; ++e) { b1g[e] = ror(acc[ai][0][m - 1][n][e], 1); b2g[e] = ror(acc[ai][0][m - 1][n][e], 2); b1v[e] = ror(acc[ai][1][m - 1][n][e], 1); b2v[e] = ror(acc[ai][1][m - 1][n][e], 2); }
                    } else {
                        const int sai = wr ? ai : ai - 1, swr = wr ? 0 : 1;
                        f32x4 x14g = {0.f, 0.f, 0.f, 0.f}, x15g = x14g, x14v = x14g, x15v = x14g;
                        if (sai >= 0) { const PG8_LAS float* xp = xb + (((((sai * 2 + swr) * 4 + wc) * 2) * 4 + fq) * 16);
                            x14g = *(const PG8_LAS f32x4*)(xp + n * 4); x14v = *(const PG8_LAS f32x4*)(xp + (2 + n) * 4); x15g = *(const PG8_LAS f32x4*)(xp + 64 + n * 4); x15v = *(const PG8_LAS f32x4*)(xp + 64 + (2 + n) * 4); }
                        b1g = x15g; b1v = x15v; b2g = fr == 0 ? x14g : x15g; b2v = fr == 0 ? x14v : x15v;
                    }
                    float o[4];
#pragma unroll
                    for (int e = 0; e < 4; ++e) {
                        const float p1g = shr(b1g[e], cg[e], 1), p2g = shr(b2g[e], cg[e], 2), p1v = shr(b1v[e], cv[e], 1), p2v = shr(b2v[e], cv[e], 2);
                        const float yg = bg[e] + w0g[e] * p2g + w1g[e] * p1g + w2g[e] * cg[e], yv = bv[e] + w0v[e] * p2v + w1v[e] * p1v + w2v[e] * cv[e];
                        o[e] = yg * __builtin_amdgcn_rcpf(1.0f + __builtin_amdgcn_exp2f(-yg * 1.4426950409f)) * yv;
                    }
                    res[ai][m][n] = (u32x2_){cvt_pk_bf16(o[0], o[1]), cvt_pk_bf16(o[2], o[3])};
                }
        }
        const int row0 = u.pm * BM + wr * 64 + fr;
#pragma unroll
        for (int ai = 0; ai < 2; ++ai)
#pragma unroll
            for (int m = 0; m < 4; ++m) *(u32x4*)(G + (size_t)(row0 + ai * HALF + m * 16) * dff + ch0) = (u32x4){res[ai][m][0].x, res[ai][m][0].y, res[ai][m][1].x, res[ai][m][1].y};
    }
};
}
constexpr int BATCH = 8, SEQ = 4096, DM = 2048, MTOT = BATCH * SEQ, MC = MTOT / 2  , BPH = BATCH / 2;
constexpr int DFF = 5632;
constexpr float NORM_EPS = 1e-6f, LOG2E = 1.4426950408889634f;
constexpr int NWAVES = 8;
constexpr size_t MiB = 1u << 20;
constexpr size_t WS_CTL = 0, CTL_ZERO_BYTES = 1 * MiB;
constexpr size_t WS_TAB = 1 * MiB;
constexpr size_t TAB_COS48 = WS_TAB, TAB_SIN48 = WS_TAB + 3 * MiB, TAB_COS32 = WS_TAB + 6 * MiB, TAB_SIN32 = WS_TAB + 8 * MiB;
constexpr size_t WS_WMIX = 12 * MiB;
constexpr size_t WS_WFFN = 100 * MiB;
constexpr size_t WS_MISC = 168 * MiB;
constexpr size_t WS_SS = 170 * MiB;
constexpr size_t WS_XNR = 1010 * MiB;
constexpr size_t WS_AR = 234 * MiB;
constexpr size_t WS_END = 1138 * MiB;
constexpr int CW_TMO = 0;
constexpr int CW_BAR = 4096;
constexpr int RING_BYTES = 131072;
constexpr int LDSCTL_OFF = 135168;
constexpr int LDS_BYTES = 163840;

#define GAS __attribute__((address_space(1)))
#define LAS __attribute__((address_space(3)))
typedef unsigned short bf16;
typedef unsigned u32x4 __attribute__((ext_vector_type(4)));
typedef unsigned u32x2 __attribute__((ext_vector_type(2)));
typedef float f32x4 __attribute__((ext_vector_type(4)));
typedef float f32x16 __attribute__((ext_vector_type(16)));
typedef short bf16x8 __attribute__((ext_vector_type(8)));
typedef short s16x4 __attribute__((ext_vector_type(4)));
typedef short v4i16_t __attribute__((ext_vector_type(4)));
typedef __bf16 bf16x2_t __attribute__((ext_vector_type(2)));
typedef float f32x2_t __attribute__((ext_vector_type(2)));
#define LDS_WAIT() asm volatile("s_waitcnt lgkmcnt(0)" ::: "memory")
#define VM_WAIT() asm volatile("s_waitcnt vmcnt(0)" ::: "memory")
#define MFMA32(a, b, c) __builtin_amdgcn_mfma_f32_32x32x16_bf16((a), (b), (c), 0, 0, 0)
DI unsigned pk2(float lo, float hi) { f32x2_t v = {lo, hi}; bf16x2_t b = __builtin_convertvector(v, bf16x2_t); return __builtin_bit_cast(unsigned, b); }
DI float bf2f(unsigned short b) { return __builtin_bit_cast(float, (unsigned)b << 16); }
DI float bflo(unsigned w) { return __builtin_bit_cast(float, w << 16); }
DI float bfhi(unsigned w) { return __builtin_bit_cast(float, w & 0xffff0000u); }
DI unsigned short f2bf(float f) { return (unsigned short)(pk2(f, 0.f) & 0xffffu); }
DI float wave_sum(float v) {
#pragma unroll
    for (int o = 1; o < 64; o <<= 1) v += __shfl_xor(v, o);
    return v;
}
DI int crow(int i, int h) { return (i & 3) + 8 * (i >> 2) + 4 * h; }
#define XB_TMO      128
#define XB_XCNT(j)  (256  + 64 * (j))
#define XB_XSUB(j)  (1280 + 64 * (j))
#define XB_XGEN(j)  (2304 + 64 * (j))
#define XB_TOP      3328
#define XB_TOPGEN   3392
#define XCD_BAR_WORDS 3456
#define XB_SPIN_CAP (1u << 18)

__device__ __forceinline__ unsigned xb_ld(unsigned* p)              { return __hip_atomic_load(p, __ATOMIC_RELAXED, __HIP_MEMORY_SCOPE_AGENT); }
__device__ __forceinline__ unsigned xb_add(unsigned* p, unsigned v) { return __hip_atomic_fetch_add(p, v, __ATOMIC_RELAXED, __HIP_MEMORY_SCOPE_AGENT); }
__device__ __forceinline__ unsigned xb_xcc_id() { return (unsigned)__builtin_amdgcn_s_getreg((3 << 11) | 20) & 0xFu; }
#define XB_SPIN(cond, bar) do { unsigned _sp = 0; while (cond) { __builtin_amdgcn_s_sleep(1); \
    if ((++_sp & 255u) == 0u) { if (xb_ld(&(bar)[XB_TMO])) break; if (_sp > XB_SPIN_CAP) { atomicAdd(&(bar)[XB_TMO], 1u); break; } } } } while (0)

struct XcdBarrier {
    unsigned* bar; unsigned x;
    volatile LAS unsigned* st;
};

__device__ __forceinline__ XcdBarrier xcd_barrier_post(unsigned* bar, volatile LAS unsigned* st) {
    XcdBarrier b; b.bar = bar; b.x = xb_xcc_id(); b.st = st;
    if (threadIdx.x == 0) (void)xb_add(&bar[XB_XCNT(b.x)], 1u);
    return b;
}
__device__ __forceinline__ void xcd_barrier_complete(unsigned* bar, unsigned x, unsigned& nloc, unsigned& nx) {
    const unsigned G = gridDim.x * gridDim.y * gridDim.z;
    unsigned sum, cnt, mine, sp = 0u;
    for (;;) {
        sum = 0u; cnt = 0u; mine = 0u;
#pragma unroll
        for (unsigned j = 0; j < 16; ++j) { const unsigned c = xb_ld(&bar[XB_XCNT(j)]); sum += c; cnt += (c > 0u) ? 1u : 0u; mine = (j == x) ? c : mine; }
        if (sum == G) break;
        __builtin_amdgcn_s_sleep(1);
        if ((++sp & 255u) == 0u) { if (xb_ld(&bar[XB_TMO])) break; if (sp > XB_SPIN_CAP) { atomicAdd(&bar[XB_TMO], 1u); break; } }
    }
    nloc = mine > 0u ? mine : 1u; nx = cnt > 0u ? cnt : 1u;
}

__device__ __forceinline__ void xcd_barrier(const XcdBarrier& b) {
    asm volatile("s_waitcnt vmcnt(0)" ::: "memory");
    __syncthreads();
    if (threadIdx.x == 0) {
        unsigned* bar = b.bar;
        __builtin_amdgcn_s_waitcnt(0);
        unsigned nloc = b.st[0], nx = b.st[1];
        if (nloc == 0u) { xcd_barrier_complete(bar, b.x, nloc, nx); b.st[0] = nloc; b.st[1] = nx; }
        const unsigned old = xb_add(&bar[XB_XSUB(b.x)], 1u);
        const unsigned gen = old / nloc;
        if (old + 1u == (gen + 1u) * nloc) {
            __builtin_amdgcn_fence(__ATOMIC_RELEASE, "agent");
            asm volatile("s_waitcnt vmcnt(0)" ::: "memory");
            const unsigned og = xb_add(&bar[XB_TOP], 1u);
            const unsigned tg = og / nx;
            if (og + 1u == (tg + 1u) * nx) xb_add(&bar[XB_TOPGEN], 1u);
            else XB_SPIN(xb_ld(&bar[XB_TOPGEN]) == tg, bar);
            __builtin_amdgcn_fence(__ATOMIC_ACQUIRE, "agent");
            xb_add(&bar[XB_XGEN(b.x)], 1u);
            asm volatile("s_waitcnt vmcnt(0)" ::: "memory");
        } else {
            XB_SPIN(xb_ld(&bar[XB_XGEN(b.x)]) == gen, bar);
            __builtin_amdgcn_fence(__ATOMIC_ACQUIRE, "agent");
            asm volatile("s_waitcnt vmcnt(0)" ::: "memory");
        }
    }
    __syncthreads();
}
struct Frame {
    LAS unsigned char* lds; unsigned* ctl; unsigned char* ws;
    int tid, lane, wave, G, gw, NGW;
};
DI void ph_tables(const Frame& F, const int* pos) {
    float* c48 = (float*)(F.ws + TAB_COS48); float* s48 = (float*)(F.ws + TAB_SIN48); float* c32 = (float*)(F.ws + TAB_COS32); float* s32 = (float*)(F.ws + TAB_SIN32);
    const int gt = blockIdx.x * (NWAVES * 64) + F.tid, NT = F.G * NWAVES * 64;
    for (int i = gt; i < MTOT * 40; i += NT) {
        const int m = i / 40, j = i - m * 40; const float p = (float)pos[m];
        const bool a = j < 24; const int jj = a ? j : j - 24;
        const float inv = (float)exp(-(2.0 * jj / (a ? 48.0 : 32.0)) * 13.122363377404328);
        const float ang = p * inv; float sn, cs; sincosf(ang, &sn, &cs);
        if (a) { c48[m * 24 + jj] = cs; s48[m * 24 + jj] = sn; } else { c32[m * 16 + jj] = cs; s32[m * 16 + jj] = sn; }
    }
}
DI void cvt_load(float (&v)[32], const float* W, int ldw, int col0, int ncols, int item, int nblk, int lane) {
    const int kb = item / nblk, nb = item - kb * nblk, k0 = 64 * kb, n0 = 32 * nb, nn = n0 + (lane & 31); const bool ok = nn < ncols;
    const float* p = W + (size_t)(k0 + (lane >> 5)) * ldw + col0 + (ok ? nn : 0);
#pragma unroll
    for (int i = 0; i < 32; ++i) { const float x = p[(size_t)(2 * i) * ldw]; v[i] = ok ? x : 0.f; }
}
DI void cvt_store(const float (&v)[32], int ncols, bf16* WT, int ldt, int row_off, float scale, LAS float* scr, int item, int nblk, int lane) {
    const int kb = item / nblk, nb = item - kb * nblk, k0 = 64 * kb, n0 = 32 * nb;
#pragma unroll
    for (int i = 0; i < 32; ++i) scr[(2 * i + (lane >> 5)) * 33 + (lane & 31)] = v[i] * scale;
    LDS_WAIT();
    const int c = lane & 7;
#pragma unroll
    for (int j = 0; j < 4; ++j) { const int n = (lane >> 3) + 8 * j; const LAS float* s = scr + (8 * c) * 33 + n;
        u32x4 o; o.x = pk2(s[0 * 33], s[1 * 33]); o.y = pk2(s[2 * 33], s[3 * 33]); o.z = pk2(s[4 * 33], s[5 * 33]); o.w = pk2(s[6 * 33], s[7 * 33]);
        if (n0 + n < ncols) *(u32x4*)(WT + (size_t)(row_off + n0 + n) * ldt + k0 + 8 * c) = o; }
    LDS_WAIT();
}
DI void cvt_item(const float* W, int ldw, int col0, int ncols, bf16* WT, int ldt, int row_off, float scale, LAS float* scr, int item, int nblk, int lane) {
    float v[32]; cvt_load(v, W, ldw, col0, ncols, item, nblk, lane); cvt_store(v, ncols, WT, ldt, row_off, scale, scr, item, nblk, lane);
}
template <class MAP> DI void cvt_loop(const Frame& F, const float* W, int ldw, int ncols, bf16* WT, int ldt, float scale, int nitems, int nblk, const MAP& map) {
    LAS float* scr = (LAS float*)(F.lds + F.wave * 16384);
    int it = F.gw; float cur[32]; int c0 = 0, ro = 0, li = 0;
    if (it < nitems) { map(it, c0, ro, li); cvt_load(cur, W, ldw, c0, ncols, li, nblk, F.lane); }
#pragma unroll 1
    for (; it < nitems; it += F.NGW) {
        float nxt[32]; int c1 = 0, r1 = 0, l1 = 0; const int ni = it + F.NGW;
        if (ni < nitems) { map(ni, c1, r1, l1); cvt_load(nxt, W, ldw, c1, ncols, l1, nblk, F.lane); }
        cvt_store(cur, ncols, WT, ldt, ro, scale, scr, li, nblk, F.lane);
#pragma unroll
        for (int i = 0; i < 32; ++i) cur[i] = nxt[i];
        c0 = c1; ro = r1; li = l1;
    }
}
struct CvtPlain { int col0, row_off; DI void operator()(int it, int& c, int& r, int& l) const { c = col0; r = row_off; l = it; } };
DI void cvt_job(const Frame& F, const float* W, int ldw, int K, int col0, int ncols, bf16* WT, int ldt, int row_off, float scale) {
    const int nblk = (ncols + 31) / 32;
    cvt_loop(F, W, ldw, ncols, WT, ldt, scale, (K / 64) * nblk, nblk, CvtPlain{col0, row_off});
}
DI void zero_bf16(const Frame& F, bf16* p, size_t nelem) {
    const size_t gt = (size_t)blockIdx.x * (NWAVES * 64) + F.tid, NT = (size_t)F.G * NWAVES * 64;
    for (size_t i = gt; i < nelem / 8; i += NT) ((u32x4*)p)[i] = (u32x4){0u, 0u, 0u, 0u};
}
DI void ph_cvt_ffn(const Frame& F, const float* up, const float* down) {
    bf16* WUP = (bf16*)(F.ws + WS_WFFN); bf16* WDN = WUP + (size_t)2 * DFF * DM;
    struct UpMap { DI void operator()(int it, int& c, int& r, int& l) const { const int seg = it >> 7, pn = seg >> 1, isv = seg & 1; c = isv * DFF + pn * 128; r = pn * 256 + isv * 128; l = it & 127; } };
    cvt_loop(F, up, 2 * DFF, 128, WUP, DM, 1.f, 88 * 128, 4, UpMap{});
    cvt_job(F, down, DM, DFF, 0, DM, WDN, DFF, 0, 1.f);
}
DI void ph_conv_fix(const Frame& F, const float* UB, bf16* Gb, const float* cw, const float* cb, const int nrows = MC) {
    const int gt = blockIdx.x * (NWAVES * 64) + F.tid, NT = F.G * NWAVES * 64;
    for (int it = gt; it < (nrows / 256) * (DFF / 4); it += NT) {
        const int pm = it / (DFF / 4), c4 = it - pm * (DFF / 4), ch = c4 * 4, col = (ch >> 7) * 256 + (ch & 127);
        const float* ub = UB + (size_t)pm * 4 * (2 * DFF) + col; const bool has = (pm & 15) != 0;
        const f32x4 z = {0.f, 0.f, 0.f, 0.f};
        const f32x4 g0 = *(const f32x4*)(ub), g1 = *(const f32x4*)(ub + 2 * DFF), v0 = *(const f32x4*)(ub + 128), v1 = *(const f32x4*)(ub + 2 * DFF + 128);
        const f32x4 gm2 = has ? *(const f32x4*)(ub - 2 * (2 * DFF)) : z, gm1 = has ? *(const f32x4*)(ub - (2 * DFF)) : z, vm2 = has ? *(const f32x4*)(ub - 2 * (2 * DFF) + 128) : z, vm1 = has ? *(const f32x4*)(ub - (2 * DFF) + 128) : z;
        const f32x4 w0g = *(const f32x4*)(cw + ch), w1g = *(const f32x4*)(cw + 2 * DFF + ch), w2g = *(const f32x4*)(cw + 4 * DFF + ch), bg = *(const f32x4*)(cb + ch);
        const f32x4 w0v = *(const f32x4*)(cw + DFF + ch), w1v = *(const f32x4*)(cw + 3 * DFF + ch), w2v = *(const f32x4*)(cw + 5 * DFF + ch), bv = *(const f32x4*)(cb + DFF + ch);
        float o0[4], o1[4];
#pragma unroll
        for (int e = 0; e < 4; ++e) {
            const float yg0 = bg[e] + w0g[e] * gm2[e] + w1g[e] * gm1[e] + w2g[e] * g0[e], yv0 = bv[e] + w0v[e] * vm2[e] + w1v[e] * vm1[e] + w2v[e] * v0[e];
            const float yg1 = bg[e] + w0g[e] * gm1[e] + w1g[e] * g0[e] + w2g[e] * g1[e], yv1 = bv[e] + w0v[e] * vm1[e] + w1v[e] * v0[e] + w2v[e] * v1[e];
            o0[e] = yg0 * __builtin_amdgcn_rcpf(1.0f + __builtin_amdgcn_exp2f(-yg0 * LOG2E)) * yv0; o1[e] = yg1 * __builtin_amdgcn_rcpf(1.0f + __builtin_amdgcn_exp2f(-yg1 * LOG2E)) * yv1;
        }
        u32x2 a, b; a.x = pk2(o0[0], o0[1]); a.y = pk2(o0[2], o0[3]); b.x = pk2(o1[0], o1[1]); b.y = pk2(o1[2], o1[3]);
        *(u32x2*)(Gb + (size_t)(pm * 256) * DFF + ch) = a; *(u32x2*)(Gb + (size_t)(pm * 256 + 1) * DFF + ch) = b;
    }
}
DI void ph_norm_first(const Frame& F, const float* src, const float* gain, bf16* XNR, float* ss) {
    f32x4 g[8];
#pragma unroll
    for (int j = 0; j < 8; ++j) g[j] = *(const f32x4*)(gain + 4 * (F.lane + 64 * j));
    for (int m = F.gw; m < MTOT; m += F.NGW) {
        const f32x4* xr = (const f32x4*)(src + (size_t)m * DM) + F.lane;
        f32x4 v[8]; float s2 = 0.f;
#pragma unroll
        for (int j = 0; j < 8; ++j) { v[j] = xr[64 * j]; s2 += (v[j].x * v[j].x + v[j].y * v[j].y) + (v[j].z * v[j].z + v[j].w * v[j].w); }
        s2 = wave_sum(s2);
        if (F.lane < 2) *(f32x4*)(ss + (size_t)m * 8 + 4 * F.lane) = (f32x4){F.lane == 0 ? s2 : 0.f, 0.f, 0.f, 0.f};
        u32x2* o = (u32x2*)(XNR + (size_t)m * DM) + F.lane;
#pragma unroll
        for (int j = 0; j < 8; ++j) { const f32x4 y = v[j] * g[j]; u32x2 w; w.x = pk2(y.x, y.y); w.y = pk2(y.z, y.w); o[64 * j] = w; }
    }
}
DI void ph_final_norm(const Frame& F, const bf16* xn, const float* ss, float* out) {
    for (int m = F.gw; m < MTOT; m += F.NGW) {
        const float rs = pg8::rms_rowscale(ss, m);
        u32x4 v[4];
#pragma unroll
        for (int j = 0; j < 4; ++j) v[j] = *(const u32x4*)(xn + (size_t)m * DM + j * 512 + F.lane * 8);
#pragma unroll
        for (int j = 0; j < 4; ++j) { float* o = out + (size_t)m * DM + j * 512 + F.lane * 8;
            *(f32x4*)o = (f32x4){__builtin_bit_cast(float, v[j].x << 16), __builtin_bit_cast(float, v[j].x & 0xffff0000u), __builtin_bit_cast(float, v[j].y << 16), __builtin_bit_cast(float, v[j].y & 0xffff0000u)} * rs;
            *(f32x4*)(o + 4) = (f32x4){__builtin_bit_cast(float, v[j].z << 16), __builtin_bit_cast(float, v[j].z & 0xffff0000u), __builtin_bit_cast(float, v[j].w << 16), __builtin_bit_cast(float, v[j].w & 0xffff0000u)} * rs; }
    }
}
DI void rope_piece(const bf16* qrow, int p, const float* cs, const float* sn, float (&o)[8]) {
    const bool lo = p < 3; const int pp = lo ? p + 3 : p - 3, i0 = 8 * (lo ? p : p - 3);
    const u32x4 a = *(const u32x4*)(qrow + 8 * p), b = *(const u32x4*)(qrow + 8 * pp);
    const f32x4 c0 = *(const f32x4*)(cs + i0), c1 = *(const f32x4*)(cs + i0 + 4), s0 = *(const f32x4*)(sn + i0), s1 = *(const f32x4*)(sn + i0 + 4);
#pragma unroll
    for (int e = 0; e < 4; ++e) { const float c_l = e < 2 ? c0[2 * e] : c1[2 * e - 4], c_h = e < 2 ? c0[2 * e + 1] : c1[2 * e - 3], s_l = e < 2 ? s0[2 * e] : s1[2 * e - 4], s_h = e < 2 ? s0[2 * e + 1] : s1[2 * e - 3];
        const float al = bflo(a[e]), ah = bfhi(a[e]), bl_ = bflo(b[e]), bh_ = bfhi(b[e]);
        o[2 * e] = lo ? al * c_l - bl_ * s_l : bl_ * s_l + al * c_l; o[2 * e + 1] = lo ? ah * c_h - bh_ * s_h : bh_ * s_h + ah * c_h; }
}
DI bf16x8 rope_frag32(const bf16* qrow, int s, int h, const float* cs, const float* sn) {
    float o[8]; rope_piece(qrow, 2 * s + h, cs, sn, o);
    u32x4 w; w.x = pk2(o[0], o[1]); w.y = pk2(o[2], o[3]); w.z = pk2(o[4], o[5]); w.w = pk2(o[6], o[7]); return __builtin_bit_cast(bf16x8, w);
}
constexpr size_t DA_DIN = 0, DA_CQN = 64 * MiB, DA_LATC = 80 * MiB, DA_KPE = 88 * MiB, DA_KIDX = 90 * MiB, DA_WIDX = 94 * MiB, DA_QL = 96 * MiB, DA_QPE = 352 * MiB, DA_QIDX = 400 * MiB,
                 DA_SEL = 464 * MiB, DA_CNT = 472 * MiB, DA_SC = 474 * MiB, DA_O2 = 474 * MiB;
constexpr size_t DW_W1 = 0, DW_W2 = (size_t)1024 * 2048, DW_WO = DW_W2 + (size_t)11776 * 512, DW_BD = DW_WO + (size_t)2048 * 4096;
constexpr float DSA_QSCALE = 0.07216878364870322f * LOG2E;
constexpr float DSA_WIDX_SCALE = 0.25f * 0.08838834764831845f;

DI void ph_dsa_cvt(const Frame& F, const float* w_in, const float* w_qup, const float* w_uk, const float* w_uv, const float* w_out) {
    bf16* WB = (bf16*)(F.ws + WS_WMIX);
    cvt_job(F, w_in, 960, DM, 0, 960, WB + DW_W1, DM, 0, 1.f);
    zero_bf16(F, WB + DW_W1 + (size_t)960 * DM, (size_t)64 * DM);
    { LAS float* scr = (LAS float*)(F.lds + F.wave * 16384);
      for (int it = F.gw; it < 32 * 16; it += F.NGW) { const int h = it >> 4; cvt_item(w_qup, 8192, h * 192, 48, WB + DW_W2, 512, 8192 + h * 48, DSA_QSCALE, scr, it & 15, 2, F.lane); } }
    cvt_job(F, w_qup, 8192, 512, 6144, 2048, WB + DW_W2, 512, 9728, 1.f);
    __syncthreads();
    {
        LAS float* As = (LAS float*)F.lds; LAS float* Bs = As + 64 * 145;
        for (int u = blockIdx.x; u < 32 * 4 * 8; u += F.G) {
            const int h = u >> 5, r0 = ((u >> 3) & 3) * 64, k0 = (u & 7) * 64;
            for (int i = F.tid; i < 64 * 144; i += NWAVES * 64) { const int row = i / 144, col = i - row * 144;
                As[row * 145 + col] = w_uk[(size_t)(h * 256 + r0) * 144 + i]; Bs[row * 145 + col] = w_qup[(size_t)(k0 + row) * 8192 + h * 192 + 48 + col]; }
            __syncthreads();
            const int r = F.tid & 63, kg = F.tid >> 6; float acc[8];
#pragma unroll
            for (int j = 0; j < 8; ++j) acc[j] = 0.f;
            for (int n = 0; n < 144; ++n) { const float a = As[r * 145 + n];
#pragma unroll
                for (int j = 0; j < 8; ++j) acc[j] += a * Bs[(kg * 8 + j) * 145 + n]; }
            u32x4 o; o.x = pk2(acc[0] * DSA_QSCALE, acc[1] * DSA_QSCALE); o.y = pk2(acc[2] * DSA_QSCALE, acc[3] * DSA_QSCALE); o.z = pk2(acc[4] * DSA_QSCALE, acc[5] * DSA_QSCALE); o.w = pk2(acc[6] * DSA_QSCALE, acc[7] * DSA_QSCALE);
            *(u32x4*)(WB + DW_W2 + (size_t)(h * 256 + r0 + r) * 512 + k0 + kg * 8) = o;
            __syncthreads();
        }
    }
    { LAS float* scr = (LAS float*)(F.lds + F.wave * 16384);
      for (int it = F.gw; it < 32 * 16; it += F.NGW) { const int h = it >> 4; cvt_item(w_uv + (size_t)h * 256 * 128, 128, 0, 128, WB + DW_BD + (h & 1) * 256, 512, h * 128, 1.f, scr, it & 15, 4, F.lane); } }
    { const size_t gt = (size_t)blockIdx.x * (NWAVES * 64) + F.tid, NT = (size_t)F.G * NWAVES * 64;
      for (size_t i = gt; i < (size_t)4096 * 32; i += NT) { const int row = (int)(i >> 5), pc = (int)(i & 31); *(u32x4*)(WB + DW_BD + (size_t)row * 512 + (1 - ((row >> 7) & 1)) * 256 + pc * 8) = (u32x4){0u, 0u, 0u, 0u}; } }
    cvt_job(F, w_out, DM, 4096, 0, DM, WB + DW_WO, 4096, 0, 1.f);
}
DI void ph_dsa_post1(const Frame& F, int half, const float* qn, const float* kvn, const float* lng, const float* lnb) {
    unsigned char* ar = F.ws + WS_AR;
    const float* DIN = (const float*)(ar + DA_DIN); bf16* CQN = (bf16*)(ar + DA_CQN); bf16* LATC = (bf16*)(ar + DA_LATC); bf16* KPE = (bf16*)(ar + DA_KPE); bf16* KIDX = (bf16*)(ar + DA_KIDX); float* WIDX = (float*)(ar + DA_WIDX);
    const float* c48 = (const float*)(F.ws + TAB_COS48); const float* s48 = (const float*)(F.ws + TAB_SIN48); const float* c32 = (const float*)(F.ws + TAB_COS32); const float* s32 = (const float*)(F.ws + TAB_SIN32);
    LAS float* buf = (LAS float*)(F.lds + F.wave * 1024);
    const int lane = F.lane;
    for (int ml = F.gw; ml < MC; ml += F.NGW) {
        const int mg = half * MC + ml;
        const size_t kfb = ((size_t)(ml >> 5) * 8 * 64 + (ml & 31)) * 8;
        const float* row = DIN + (size_t)ml * 1024 + 16 * lane;
        f32x4 v[4]; float ss = 0.f, s1 = 0.f;
#pragma unroll
        for (int j = 0; j < 4; ++j) { v[j] = *(const f32x4*)(row + 4 * j); ss += (v[j].x * v[j].x + v[j].y * v[j].y) + (v[j].z * v[j].z + v[j].w * v[j].w); s1 += (v[j].x + v[j].y) + (v[j].z + v[j].w); }
        const bool isq = lane < 32, iskv = lane >= 32 && lane < 48, ispe = lane >= 48 && lane < 51, isix = lane >= 51 && lane < 59;
        const float ssq = wave_sum(isq ? ss : 0.f), sskv = wave_sum(iskv ? ss : 0.f), mean = wave_sum(isix ? s1 : 0.f) * (1.f / 128.f);
        float d2 = 0.f;
#pragma unroll
        for (int j = 0; j < 4; ++j) { const f32x4 d = v[j] - mean; d2 += (d.x * d.x + d.y * d.y) + (d.z * d.z + d.w * d.w); }
        const float var = wave_sum(isix ? d2 : 0.f) * (1.f / 128.f);
        const float rq = 1.0f / sqrtf(ssq * (1.f / 512.f) + NORM_EPS), rkv = 1.0f / sqrtf(sskv * (1.f / 256.f) + NORM_EPS), rstd = 1.0f / sqrtf(var + NORM_EPS);
        if (isq || iskv) {
            const float* gp = isq ? qn + 16 * lane : kvn + 16 * (lane - 32); const float rs = isq ? rq : rkv;
            bf16* dst = isq ? CQN + (size_t)ml * 512 + 16 * lane : LATC + (size_t)ml * 256 + 16 * (lane - 32);
            u32x4 o[2];
#pragma unroll
            for (int j = 0; j < 4; ++j) { const f32x4 g = *(const f32x4*)(gp + 4 * j); const f32x4 y = v[j] * rs * g; o[j >> 1][(j & 1) * 2] = pk2(y.x, y.y); o[j >> 1][(j & 1) * 2 + 1] = pk2(y.z, y.w); }
            *(u32x4*)dst = o[0]; *(u32x4*)(dst + 8) = o[1];
        } else if (ispe) {
#pragma unroll
            for (int j = 0; j < 4; ++j) *(LAS f32x4*)(buf + (lane - 48) * 16 + 4 * j) = v[j];
        } else if (isix) {
#pragma unroll
            for (int j = 0; j < 4; ++j) { const f32x4 g = *(const f32x4*)(lng + (lane - 51) * 16 + 4 * j), b = *(const f32x4*)(lnb + (lane - 51) * 16 + 4 * j); *(LAS f32x4*)(buf + 48 + (lane - 51) * 16 + 4 * j) = (v[j] - mean) * rstd * g + b; }
        } else if (lane == 59) {
#pragma unroll
            for (int j = 0; j < 4; ++j) *(f32x4*)(WIDX + (size_t)ml * 16 + 4 * j) = v[j] * DSA_WIDX_SCALE;
        }
        LDS_WAIT();
        if (lane < 24) { const float x1 = buf[lane], x2 = buf[24 + lane], c = c48[(size_t)mg * 24 + lane], s = s48[(size_t)mg * 24 + lane];
            KPE[(size_t)ml * 48 + lane] = f2bf(x1 * c - x2 * s); KPE[(size_t)ml * 48 + 24 + lane] = f2bf(x1 * s + x2 * c);
        } else if (lane < 40) { const int i = lane - 24; const float x1 = buf[48 + i], x2 = buf[48 + 16 + i], c = c32[(size_t)mg * 16 + i], s = s32[(size_t)mg * 16 + i];
            KIDX[kfb + (size_t)((i >> 3) * 32) * 8 + (i & 7)] = f2bf(x1 * c - x2 * s); KIDX[kfb + (size_t)(64 + (i >> 3) * 32) * 8 + (i & 7)] = f2bf(x1 * s + x2 * c);
        } else { const int d = 32 + 4 * (lane - 40); const f32x4 y = *(const LAS f32x4*)(buf + 48 + d); u32x2 w; w.x = pk2(y.x, y.y); w.y = pk2(y.z, y.w); *(u32x2*)(KIDX + kfb + (size_t)((d >> 4) * 64 + ((d >> 3) & 1) * 32) * 8 + (d & 7)) = w; }
        LDS_WAIT();
    }
}
DI int wave_iscan_dpp(int v) {
    v += __builtin_amdgcn_update_dpp(0, v, 0x111, 0xf, 0xf, true); v += __builtin_amdgcn_update_dpp(0, v, 0x112, 0xf, 0xf, true);
    v += __builtin_amdgcn_update_dpp(0, v, 0x114, 0xf, 0xf, true); v += __builtin_amdgcn_update_dpp(0, v, 0x118, 0xf, 0xf, true);
    v += __builtin_amdgcn_update_dpp(0, v, 0x142, 0xa, 0xf, false);
    v += __builtin_amdgcn_update_dpp(0, v, 0x143, 0xc, 0xf, false);
    return v;
}
DI int wave_isum_dpp(int v) {
    v += __builtin_amdgcn_update_dpp(0, v, 0x111, 0xf, 0xf, true); v += __builtin_amdgcn_update_dpp(0, v, 0x112, 0xf, 0xf, true);
    v += __builtin_amdgcn_update_dpp(0, v, 0x114, 0xf, 0xf, true); v += __builtin_amdgcn_update_dpp(0, v, 0x118, 0xf, 0xf, true);
    v += __builtin_amdgcn_update_dpp(0, v, 0x142, 0xa, 0xf, false);
    v += __builtin_amdgcn_update_dpp(0, v, 0x143, 0xc, 0xf, false);
    return __builtin_amdgcn_readlane(v, 63);
}
DI unsigned f2sortable(float s) { const unsigned b = __builtin_bit_cast(unsigned, s); return (b & 0x80000000u) ? ~b : (b | 0x80000000u); }
DI void ph_dsa_index(const Frame& F, const int half) {
    const float* c32 = (const float*)(F.ws + TAB_COS32); const float* s32 = (const float*)(F.ws + TAB_SIN32);
    unsigned char* ar = F.ws + WS_AR;
    const bf16* QIDX = (const bf16*)(ar + DA_QIDX); const bf16* KIDX = (const bf16*)(ar + DA_KIDX); const float* WIDX = (const float*)(ar + DA_WIDX);
    unsigned short* SEL = (unsigned short*)(ar + DA_SEL); int* CNT = (int*)(ar + DA_CNT); float* SC = (float*)(ar + DA_SC) + (size_t)F.gw * 16384;
    const int lane = F.lane, r = lane & 31, hf = lane >> 5;
    LAS unsigned char* wl = F.lds + F.wave * 8192 + lane * 16;
    LAS unsigned* hist = (LAS unsigned*)(F.lds + 65536 + F.wave * 1024);
#pragma unroll 1
    for (int tile = blockIdx.x; tile < BPH * 128; tile += F.G) {
        const int j = tile >> 8, c8 = tile & 255, c7 = c8 & 127, bl = (c8 >> 7) * 2 + j, qt = j ? 127 - c7 : c7;
        const int q0 = qt * 32 + 4 * F.wave;
        const int ntile = (q0 + 3) / 32 + 1;
        bf16x8 qa[2][8];
#pragma unroll
        for (int pr = 0; pr < 2; ++pr) {
            const int mrow = bl * SEQ + q0 + 2 * pr + (r >> 4);
#pragma unroll
            for (int s = 0; s < 8; ++s) qa[pr][s] = *(const bf16x8*)(QIDX + (size_t)mrow * 2048 + (r & 15) * 128 + 16 * s + 8 * hf);
            { const float* cs = c32 + ((size_t)half * MC + mrow) * 16 + 8 * hf; const float* sn = s32 + ((size_t)half * MC + mrow) * 16 + 8 * hf;
              const f32x4 c0 = *(const f32x4*)cs, c1 = *(const f32x4*)(cs + 4), s0 = *(const f32x4*)sn, s1 = *(const f32x4*)(sn + 4);
              const u32x4 a = __builtin_bit_cast(u32x4, qa[pr][0]), b = __builtin_bit_cast(u32x4, qa[pr][1]); u32x4 o1, o2;
#pragma unroll
              for (int e = 0; e < 4; ++e) { const float c_l = e < 2 ? c0[2 * e] : c1[2 * e - 4], c_h = e < 2 ? c0[2 * e + 1] : c1[2 * e - 3], s_l = e < 2 ? s0[2 * e] : s1[2 * e - 4], s_h = e < 2 ? s0[2 * e + 1] : s1[2 * e - 3];
                  const float x1l = bflo(a[e]), x1h = bfhi(a[e]), x2l = bflo(b[e]), x2h = bfhi(b[e]);
                  o1[e] = pk2(x1l * c_l - x2l * s_l, x1h * c_h - x2h * s_h); o2[e] = pk2(x1l * s_l + x2l * c_l, x1h * s_h + x2h * c_h); }
              qa[pr][0] = __builtin_bit_cast(bf16x8, o1); qa[pr][1] = __builtin_bit_cast(bf16x8, o2); }
            float wv[2][16];
#pragma unroll
            for (int i = 0; i < 16; ++i) wv[pr][i] = WIDX[(size_t)(bl * SEQ + q0 + 2 * pr + (i >> 3)) * 16 + (i & 3) + 8 * ((i >> 2) & 1) + 4 * hf];
#pragma unroll
            for (int i = 0; i < 16; i += 4) *(LAS f32x4*)(wl + (pr * 4 + (i >> 2)) * 1024) = (f32x4){wv[pr][i], wv[pr][i + 1], wv[pr][i + 2], wv[pr][i + 3]};
        }
        LDS_WAIT();
        {
        bf16x8 kf[8];
        { const bf16* kp = KIDX + ((size_t)(bl * 128) * 8 * 64 + lane) * 8;
#pragma unroll
          for (int s = 0; s < 8; ++s) kf[s] = *(const bf16x8*)(kp + 512 * s); }
#pragma unroll 1
        for (int t = 0; t < ntile; ++t) {
            f32x16 accs[2];
#pragma unroll
            for (int pr = 0; pr < 2; ++pr) {
#pragma unroll
                for (int i = 0; i < 16; ++i) accs[pr][i] = 0.f;
#pragma unroll
                for (int s = 0; s < 8; ++s) accs[pr] = MFMA32(qa[pr][s], kf[s], accs[pr]);
            }
            if (t + 1 < ntile) { const bf16* kp = KIDX + ((size_t)(bl * 128 + t + 1) * 8 * 64 + lane) * 8;
#pragma unroll
                for (int s = 0; s < 8; ++s) kf[s] = *(const bf16x8*)(kp + 512 * s); }
#pragma unroll
            for (int pr = 0; pr < 2; ++pr) {
                const f32x16 acc = accs[pr];
                float wv[2][16];
                { unsigned wa_ = (unsigned)(size_t)wl; asm volatile("" : "+v"(wa_));
#pragma unroll
                  for (int i = 0; i < 16; i += 4) { const f32x4 w4 = *(const LAS f32x4*)((LAS unsigned char*)(size_t)wa_ + (pr * 4 + (i >> 2)) * 1024); wv[pr][i] = w4.x; wv[pr][i + 1] = w4.y; wv[pr][i + 2] = w4.z; wv[pr][i + 3] = w4.w; } }
                float p0 = 0.f, p1 = 0.f;
#pragma unroll
                for (int i = 0; i < 8; ++i) { p0 += wv[pr][i] * fmaxf(acc[i], 0.f); p1 += wv[pr][8 + i] * fmaxf(acc[8 + i], 0.f); }
                const float t0 = p0 + __shfl_xor(p0, 32), t1 = p1 + __shfl_xor(p1, 32);
                SC[(pr * 128 + t) * 64 + lane] = hf ? t1 : t0;
            }
        }
        }
        VM_WAIT();
#pragma unroll 1
        for (int qi = 0; qi < 4; ++qi) {
            const int tq = q0 + qi, pr = qi >> 1, qs = qi & 1;
            unsigned u[64];
            const unsigned* scp = (const unsigned*)(SC + pr * 8192 + hf * 64 + qs * 32 + r);
#pragma unroll
            for (int g8 = 0; g8 < 8; ++g8) {
#pragma unroll
                for (int e = 0; e < 8; ++e) { const int i = 8 * g8 + e; const float s = __builtin_bit_cast(float, __hip_atomic_load(scp + e * 128, __ATOMIC_RELAXED, __HIP_MEMORY_SCOPE_AGENT));
                    u[i] = (2 * i + hf < ntile && 64 * i + lane <= tq) ? f2sortable(s) : 0u; }
                scp += 1024; asm volatile("" : "+v"(scp));
            }
            unsigned prefix = 0u;
            if (tq >= 256) {
#pragma unroll 1
                for (int bit = 31; bit >= 0; --bit) {
                    const unsigned cand = prefix | (1u << bit); int c = 0;
#pragma unroll
                    for (int g8 = 0; g8 < 8; ++g8) { if (g8 * 512 <= tq) {
#pragma unroll
                        for (int e = 0; e < 8; ++e) c += (u[8 * g8 + e] >= cand) ? 1 : 0; } }
                    c = wave_isum_dpp(c);
                    if (c >= 256) prefix = cand;
                    if (c == 256) break;
                }
            }
            const unsigned T = prefix > 1u ? prefix : 1u;
            int nl = 0;
#pragma unroll
            for (int g8 = 0; g8 < 8; ++g8) { if (g8 * 512 <= tq) {
#pragma unroll
                for (int e = 0; e < 8; ++e) nl += (u[8 * g8 + e] >= T) ? 1 : 0; } }
            const int inc = wave_iscan_dpp(nl), base = __builtin_amdgcn_readlane(inc, 63);
            int pos = inc - nl;
            unsigned short* sel = SEL + (size_t)(bl * SEQ + tq) * 256;
#pragma unroll
            for (int g8 = 0; g8 < 8; ++g8) { if (g8 * 512 <= tq) {
#pragma unroll
                for (int e = 0; e < 8; ++e) { const int i = 8 * g8 + e; if (u[i] >= T) { if (pos < 256) sel[pos] = (unsigned short)(64 * i + lane); ++pos; } } } }
            if (lane == 0) CNT[bl * SEQ + tq] = base < 256 ? base : 256;
        }
    }
}
DI int dsa_fsw(int row) { return ((row & 3) << 2) | ((row >> 2) & 3); }
struct DsaPre { u32x4 row[16]; bf16x8 kpe[3]; bf16x8 q[3]; };
DI void dsa_prefetch(DsaPre& P, const bf16* LATC, const bf16* KPE, const bf16* QL, const bf16* QPE, const float* c48, const float* s48, int half, int ml, int selv, int lane, int w) {
    const int bl = ml >> 12, r = lane & 31, h = lane >> 5;
#pragma unroll
    for (int it = 0; it < 16; ++it) { const int ki = __shfl(selv, (lane >> 5) + 2 * it); P.row[it] = *(const u32x4*)(LATC + (size_t)(bl * SEQ + ki) * 256 + (lane & 31) * 8); }
#pragma unroll
    for (int s = 0; s < 3; ++s) P.kpe[s] = *(const bf16x8*)(KPE + (size_t)(bl * SEQ + selv) * 48 + 16 * s + 8 * h);
#pragma unroll
    for (int j = 0; j < 3; ++j) { const int fi = w + 8 * j;
        if (fi < 16) P.q[j] = *(const bf16x8*)(QL + (size_t)ml * 8192 + r * 256 + 16 * fi + 8 * h);
        else if (fi < 19) P.q[j] = rope_frag32(QPE + (size_t)ml * 1536 + r * 48, fi - 16, h, c48 + ((size_t)half * MC + ml) * 24, s48 + ((size_t)half * MC + ml) * 24); }
}
DI void ph_dsa_attn(const Frame& F, const int half) {
    const float* c48 = (const float*)(F.ws + TAB_COS48); const float* s48 = (const float*)(F.ws + TAB_SIN48);
    unsigned char* ar = F.ws + WS_AR;
    bf16* QL = (bf16*)(ar + DA_QL); const bf16* QPE = (const bf16*)(ar + DA_QPE); const bf16* LATC = (const bf16*)(ar + DA_LATC); const bf16* KPE = (const bf16*)(ar + DA_KPE);
    const unsigned short* SEL = (const unsigned short*)(ar + DA_SEL); const int* CNT = (const int*)(ar + DA_CNT);
    const int lane = F.lane, r = lane & 31, h = lane >> 5, w = F.wave;
    LAS unsigned char* IMG = F.lds; LAS unsigned char* QB = F.lds + LDSCTL_OFF + 256; LAS float* MX = (LAS float*)(F.lds + LDSCTL_OFF + 256 + 19456); LAS float* SX = MX + 256;
    const int i16 = lane & 15, tq_ = i16 >> 2, tp_ = i16 & 3, blk = (lane >> 4) & 1;
    int ml = blockIdx.x;
    if (ml >= MC) return;
    DsaPre P;
    int cnt_c = CNT[ml];
    { const int slot = 32 * w + r; const int selv = slot < cnt_c ? (int)SEL[(size_t)ml * 256 + slot] : 0; dsa_prefetch(P, LATC, KPE, QL, QPE, c48, s48, half, ml, selv, lane, w); }
    int cnt_n = 0, selv_n = 0;
    if (ml + F.G < MC) { cnt_n = CNT[ml + F.G]; const int slot = 32 * w + r; selv_n = slot < cnt_n ? (int)SEL[(size_t)(ml + F.G) * 256 + slot] : 0; }
#pragma unroll 1
    for (; ml < MC; ml += F.G) {
        const int cnt = cnt_c, nch = (cnt + 31) >> 5; const bool act = w < nch;
#pragma unroll
        for (int it = 0; it < 16; ++it) { const int rr = (lane >> 5) + 2 * it; *(LAS u32x4*)(IMG + (32 * w + rr) * 512 + (((lane & 31) ^ dsa_fsw(rr)) * 16)) = P.row[it]; }
#pragma unroll
        for (int j = 0; j < 3; ++j) { const int fi = w + 8 * j; if (fi < 19) *(LAS bf16x8*)(QB + fi * 1024 + lane * 16) = P.q[j]; }
        bf16x8 kpe[3];
#pragma unroll
        for (int s = 0; s < 3; ++s) kpe[s] = P.kpe[s];
        LDS_WAIT(); __builtin_amdgcn_s_barrier(); asm volatile("" ::: "memory");
        if (ml + F.G < MC) {
            dsa_prefetch(P, LATC, KPE, QL, QPE, c48, s48, half, ml + F.G, selv_n, lane, w); cnt_c = cnt_n;
            if (ml + 2 * F.G < MC) { cnt_n = CNT[ml + 2 * F.G]; const int slot = 32 * w + r; selv_n = slot < cnt_n ? (int)SEL[(size_t)(ml + 2 * F.G) * 256 + slot] : 0; }
        }
        f32x16 S; float mx = -INFINITY;
#pragma unroll
        for (int i = 0; i < 16; ++i) S[i] = 0.f;
        if (act) {
#pragma unroll
            for (int s = 0; s < 16; ++s) S = MFMA32(*(const LAS bf16x8*)(IMG + (32 * w + r) * 512 + (((2 * s + h) ^ dsa_fsw(r)) * 16)), *(const LAS bf16x8*)(QB + s * 1024 + lane * 16), S);
#pragma unroll
            for (int s = 0; s < 3; ++s) S = MFMA32(kpe[s], *(const LAS bf16x8*)(QB + (16 + s) * 1024 + lane * 16), S);
#pragma unroll
            for (int i = 0; i < 16; ++i) { S[i] = (32 * w + crow(i, h) < cnt) ? S[i] : -INFINITY; mx = fmaxf(mx, S[i]); }
            mx = fmaxf(mx, __shfl_xor(mx, 32));
        }
        if (h == 0) MX[w * 32 + r] = mx;
        LDS_WAIT(); __builtin_amdgcn_s_barrier(); asm volatile("" ::: "memory");
        float M = MX[r];
#pragma unroll
        for (int k = 1; k < 8; ++k) M = fmaxf(M, MX[k * 32 + r]);
        float lsum = 0.f; bf16x8 pf[2] = {(bf16x8){0, 0, 0, 0, 0, 0, 0, 0}, (bf16x8){0, 0, 0, 0, 0, 0, 0, 0}};
        if (act) {
#pragma unroll
            for (int i = 0; i < 16; ++i) { S[i] = __builtin_amdgcn_exp2f(S[i] - M); lsum += S[i]; }
#pragma unroll
            for (int s = 0; s < 2; ++s) { u32x4 t; t.x = pk2(S[8 * s], S[8 * s + 1]); t.y = pk2(S[8 * s + 2], S[8 * s + 3]); t.z = pk2(S[8 * s + 4], S[8 * s + 5]); t.w = pk2(S[8 * s + 6], S[8 * s + 7]); pf[s] = __builtin_bit_cast(bf16x8, t); }
        }
        lsum += __shfl_xor(lsum, 32);
        if (h == 0) SX[w * 32 + r] = lsum;
        *(LAS bf16x8*)(QB + (2 * w) * 1024 + lane * 16) = pf[0]; *(LAS bf16x8*)(QB + (2 * w + 1) * 1024 + lane * 16) = pf[1];
        LDS_WAIT(); __builtin_amdgcn_s_barrier(); asm volatile("" ::: "memory");
        f32x16 O;
#pragma unroll
        for (int i = 0; i < 16; ++i) O[i] = 0.f;
#pragma unroll 2
        for (int ks = 0; ks < 2 * nch; ++ks) {
            const int r0 = 16 * ks + 4 * h + tq_, r1 = r0 + 8, pc = 4 * w + 2 * blk + (tp_ >> 1);
            const s16x4 lo = __builtin_bit_cast(s16x4, __builtin_amdgcn_ds_read_tr16_b64_v4i16((LAS v4i16_t*)(IMG + r0 * 512 + ((pc ^ dsa_fsw(r0)) * 16) + 8 * (tp_ & 1))));
            const s16x4 hi = __builtin_bit_cast(s16x4, __builtin_amdgcn_ds_read_tr16_b64_v4i16((LAS v4i16_t*)(IMG + r1 * 512 + ((pc ^ dsa_fsw(r1)) * 16) + 8 * (tp_ & 1))));
            O = MFMA32(__builtin_shufflevector(lo, hi, 0, 1, 2, 3, 4, 5, 6, 7), *(const LAS bf16x8*)(QB + ks * 1024 + lane * 16), O);
        }
        float l = SX[r];
#pragma unroll
        for (int k = 1; k < 8; ++k) l += SX[k * 32 + r];
        const float linv = 1.0f / l;
        bf16* o = QL + (size_t)ml * 8192 + r * 256 + 32 * w + 4 * h;
#pragma unroll
        for (int g = 0; g < 4; ++g) { u32x2 t; t.x = pk2(O[4 * g] * linv, O[4 * g + 1] * linv); t.y = pk2(O[4 * g + 2] * linv, O[4 * g + 3] * linv); *(u32x2*)(o + 8 * g) = t; }
        LDS_WAIT(); __builtin_amdgcn_s_barrier(); asm volatile("" ::: "memory");
    }
}
template <int NDB, bool RESC = true> DI void softmax_step(f32x16& S, float& m, float& l, f32x16 (&O)[NDB], bf16x8 (&pf)[2]) {
    float mx = fmaxf(S[0], S[1]);
#pragma unroll
    for (int i = 2; i < 16; i += 2) mx = __builtin_fmaxf(mx, __builtin_fmaxf(S[i], S[i + 1]));
    mx = fmaxf(mx, __shfl_xor(mx, 32));
    const float mn = fmaxf(m, mx), ms = (mn == -INFINITY) ? 0.f : mn;
    const float alpha = __builtin_amdgcn_exp2f(m - ms);
    float sum = 0.f;
#pragma unroll
    for (int i = 0; i < 16; ++i) { S[i] = __builtin_amdgcn_exp2f(S[i] - ms); sum += S[i]; }
    l = l * alpha + sum; m = mn;
    if (RESC && __builtin_amdgcn_ballot_w64(alpha != 1.0f) != 0ull) {
#pragma unroll
        for (int db = 0; db < NDB; ++db)
#pragma unroll
            for (int i = 0; i < 16; ++i) O[db][i] *= alpha;
    }
#pragma unroll
    for (int s = 0; s < 2; ++s) { u32x4 w; w.x = pk2(S[8 * s], S[8 * s + 1]); w.y = pk2(S[8 * s + 2], S[8 * s + 3]); w.z = pk2(S[8 * s + 4], S[8 * s + 5]); w.w = pk2(S[8 * s + 6], S[8 * s + 7]); pf[s] = __builtin_bit_cast(bf16x8, w); }
}
template <bool ACC> DI void store_col(bf16* out, const f32x16 (&O)[4], float scale, int h) {
#pragma unroll
    for (int db = 0; db < 4; ++db)
#pragma unroll
        for (int g = 0; g < 4; ++g) { u32x2* p = (u32x2*)(out + db * 32 + 8 * g + 4 * h);
            float a = O[db][4 * g] * scale, b = O[db][4 * g + 1] * scale, c = O[db][4 * g + 2] * scale, d = O[db][4 * g + 3] * scale;
            if (ACC) { const u32x2 o = *p; a += bflo(o.x); b += bfhi(o.x); c += bflo(o.y); d += bfhi(o.y); }
            u32x2 w; w.x = pk2(a, b); w.y = pk2(c, d); *p = w; }
}
template <int NQ> struct TilePre { u32x4 a, b, c; };
template <int NQ, class SRC> DI void tile_fetch(TilePre<NQ>& p, const SRC& src, int T, int tid) {
    const bf16* k = src.k(T); const bf16* v = src.v(T);
    constexpr int NK = NQ * 64;
    p.a = *(const u32x4*)(k + (size_t)tid * 8);
    const int p1 = tid + 512; p.b = (p1 < NK) ? *(const u32x4*)(k + (size_t)p1 * 8) : *(const u32x4*)(v + (size_t)(p1 - NK) * 8);
    if (NQ * 64 + 512 > 1024) { const int p2 = tid + 1024; if (p2 < NK + 512) p.c = *(const u32x4*)(v + (size_t)(p2 - NK) * 8); }
}
template <int NQ> DI void tile_put(const TilePre<NQ>& p, LAS unsigned char* buf, int tid) {
    *(LAS u32x4*)(buf + tid * 16) = p.a; *(LAS u32x4*)(buf + (tid + 512) * 16) = p.b;
    if (NQ * 64 + 512 > 1024) { if (tid + 1024 < NQ * 64 + 512) *(LAS u32x4*)(buf + (tid + 1024) * 16) = p.c; }
}
template <int NQ, bool PV, class SRC, class MK>
DI void attn_run_sh(LAS unsigned char* tl, int tid, int lane, const bf16x8 (&qf)[NQ], f32x16 (&O)[4], float& m, float& l, int TB, int TE, int tb, int te, const SRC& src, const MK& mk) {
    constexpr int TBYTES = (NQ + 8) * 1024;
    if (TB >= TE) return;
    TilePre<NQ> pre;
    tile_fetch<NQ>(pre, src, TB, tid); tile_put<NQ>(pre, tl, tid);
    LDS_WAIT(); __builtin_amdgcn_s_barrier(); asm volatile("" ::: "memory");
#pragma unroll 1
    for (int T = TB; T < TE; ++T) {
        LAS unsigned char* cur = tl + ((T - TB) & 1) * TBYTES;
        if (T + 1 < TE) tile_fetch<NQ>(pre, src, T + 1, tid);
        if (T >= tb && T < te) {
            f32x16 S;
#pragma unroll
            for (int i = 0; i < 16; ++i) S[i] = 0.f;
#pragma unroll
            for (int s = 0; s < NQ; ++s) S = MFMA32(*(const LAS bf16x8*)(cur + s * 1024 + lane * 16), qf[s], S);
            if (mk.need(T)) mk(T, S);
            bf16x8 pf[2]; softmax_step<4, PV>(S, m, l, O, pf);
            if (PV) {
#pragma unroll
                for (int db = 0; db < 4; ++db)
#pragma unroll
                    for (int s = 0; s < 2; ++s) O[db] = MFMA32(*(const LAS bf16x8*)(cur + (NQ + db * 2 + s) * 1024 + lane * 16), pf[s], O[db]);
            }
        }
        if (T + 1 < TE) tile_put<NQ>(pre, tl + ((T + 1 - TB) & 1) * TBYTES, tid);
        LDS_WAIT(); __builtin_amdgcn_s_barrier(); asm volatile("" ::: "memory");
    }
}
struct FragSrc { const bf16* kb; const bf16* vb; int nq; DI const bf16* k(int T) const { return kb + (size_t)T * nq * 512; } DI const bf16* v(int T) const { return vb + (size_t)T * 8 * 512; } };
constexpr size_t FA_Q = 0, FA_K = 64 * MiB, FA_F = 128 * MiB, FA_V = 136 * MiB, FA_CUM = 200 * MiB, FA_O = 202 * MiB, FA_KF = 266 * MiB, FA_VF = 338 * MiB;
constexpr size_t FW_IN = 0, FW_OUT = (size_t)6400 * 2048;
constexpr float FOX_QSCALE = 0.08838834764831845f * LOG2E;
DI void ph_fox_cvt(const Frame& F, const float* w_in, const float* w_out) {
    bf16* WB = (bf16*)(F.ws + WS_WMIX);
    cvt_job(F, w_in, 6160, DM, 0, 2048, WB + FW_IN, DM, 0, FOX_QSCALE);
    cvt_job(F, w_in, 6160, DM, 2048, 2048, WB + FW_IN, DM, 2048, 1.f);
    cvt_job(F, w_in, 6160, DM, 4096, 2048, WB + FW_IN, DM, 4096, 1.f);
    cvt_job(F, w_in, 6160, DM, 6144, 16, WB + FW_IN, DM, 6144, 1.f);
    zero_bf16(F, WB + FW_IN + (size_t)6160 * DM, (size_t)240 * DM);
    cvt_job(F, w_out, DM, DM, 0, DM, WB + FW_OUT, DM, 0, 1.f);
}
DI void ph_fox_scan(const Frame& F, const float* b_f) {
    unsigned char* ar = F.ws + WS_AR; const bf16* FB = (const bf16*)(ar + FA_F); float* CUM = (float*)(ar + FA_CUM);
    for (int w = F.gw; w < BPH * 16; w += F.NGW) {
        const int bl = w >> 4, hd = w & 15; const float bf_ = b_f[hd];
        float v[64]; float run = 0.f;
#pragma unroll
        for (int i = 0; i < 64; ++i) { const float x = bf2f(FB[(size_t)(bl * SEQ + F.lane * 64 + i) * 256 + hd]) + bf_;
            const float ls = fminf(x, 0.f) - log1pf(expf(-fabsf(x))); run += ls; v[i] = run; }
        float inc = run;
#pragma unroll
        for (int o = 1; o < 64; o <<= 1) { const float y = __shfl_up(inc, o); if (F.lane >= o) inc += y; }
        const float base = inc - run;
        float* dst = CUM + (size_t)w * SEQ + F.lane * 64;
#pragma unroll
        for (int i = 0; i < 64; i += 4) *(f32x4*)(dst + i) = (f32x4){(v[i] + base) * LOG2E, (v[i + 1] + base) * LOG2E, (v[i + 2] + base) * LOG2E, (v[i + 3] + base) * LOG2E};
        bf16* KF9 = (bf16*)(ar + FA_KF) + (size_t)w * 128 * 9 * 512;
#pragma unroll
        for (int i = 0; i < 64; ++i) { const int p = F.lane * 64 + i, tile = p >> 5, r_ = p & 31; const float c = (v[i] + base) * LOG2E;
            const unsigned short hi = f2bf(c); const float c1 = c - bf2f(hi); const unsigned short mid = f2bf(c1); const unsigned short lo = f2bf(c1 - bf2f(mid));
            u32x4 wv; wv.x = 0x3F803F80u; wv.y = 0x3F80u | ((unsigned)(hi ^ 0x8000u) << 16); wv.z = (unsigned)(mid ^ 0x8000u) | ((unsigned)(lo ^ 0x8000u) << 16); wv.w = 0u;
            bf16* d = KF9 + ((size_t)(tile * 9 + 8) * 64 + r_) * 8;
            *(u32x4*)d = wv; *(u32x4*)(d + 32 * 8) = (u32x4){0u, 0u, 0u, 0u}; }
    }
    const bf16* Kr = (const bf16*)(ar + FA_K); const bf16* Vr = (const bf16*)(ar + FA_V); bf16* KF = (bf16*)(ar + FA_KF); bf16* VF = (bf16*)(ar + FA_VF);
    const int r = F.lane & 31, h = F.lane >> 5;
    for (int u = F.gw; u < BPH * 16 * 128; u += F.NGW) {
        const int bh = u >> 7, tile = u & 127, bl = bh >> 4, hd = bh & 15;
        const bf16* krow_ = Kr + ((size_t)bl * SEQ + tile * 32 + r) * DM + hd * 128 + 8 * h;
        bf16* kd = KF + (((size_t)bh * 128 + tile) * 9 * 64 + F.lane) * 8;
#pragma unroll
        for (int s = 0; s < 8; ++s) *(u32x4*)(kd + s * 512) = *(const u32x4*)(krow_ + 16 * s);
        bf16* vd = VF + (((size_t)bh * 128 + tile) * 8 * 64 + F.lane) * 8;
#pragma unroll
        for (int db = 0; db < 4; ++db)
#pragma unroll
            for (int s = 0; s < 2; ++s) { unsigned short e[8];
#pragma unroll
                for (int j = 0; j < 8; ++j) e[j] = Vr[((size_t)bl * SEQ + tile * 32 + 16 * s + 8 * (j >> 2) + 4 * h + (j & 3)) * DM + hd * 128 + db * 32 + r];
                u32x4 w; w.x = e[0] | ((unsigned)e[1] << 16); w.y = e[2] | ((unsigned)e[3] << 16); w.z = e[4] | ((unsigned)e[5] << 16); w.w = e[6] | ((unsigned)e[7] << 16);
                *(u32x4*)(vd + (db * 2 + s) * 512) = w; }
    }
}
struct FoxMK { int tq, h, qt; DI bool need(int t) const { return t == qt; }
    DI void operator()(int t, f32x16& S) const {
#pragma unroll
        for (int i = 0; i < 16; ++i) S[i] = (32 * t + crow(i, h) <= tq) ? S[i] : -INFINITY;
    } };
DI void ph_fox_attn(const Frame& F) {
    unsigned char* ar = F.ws + WS_AR; const bf16* Q = (const bf16*)(ar + FA_Q); const bf16* KF = (const bf16*)(ar + FA_KF); const bf16* VF = (const bf16*)(ar + FA_VF); const float* CUM = (const float*)(ar + FA_CUM); bf16* Ob = (bf16*)(ar + FA_O);
    const int r = F.lane & 31, h = F.lane >> 5;
    for (int wb = blockIdx.x; wb < BPH * 16 * 4; wb += F.G) {
        const int bh = wb >> 2, x = (wb & 3) * 8 + F.wave, bl = bh >> 4, hd = bh & 15;
#pragma unroll 1
        for (int k = 0; k < 4; ++k) {
            const int qt = (k == 0) ? x : (k == 1) ? 63 - x : (k == 2) ? 64 + x : 127 - x;
            const int qhi = (k == 0) ? (wb & 3) * 8 + 7 : (k == 1) ? 63 - (wb & 3) * 8 : (k == 2) ? 64 + (wb & 3) * 8 + 7 : 127 - (wb & 3) * 8;
            const int tq = qt * 32 + r; const size_t mrow = (size_t)bl * SEQ + tq;
            bf16x8 qf[9];
#pragma unroll
            for (int s = 0; s < 8; ++s) qf[s] = *(const bf16x8*)(Q + mrow * DM + hd * 128 + 16 * s + 8 * h);
            { const float ct = CUM[(size_t)bh * SEQ + tq]; const unsigned short hi = f2bf(ct); const float c1 = ct - bf2f(hi); const unsigned short mid = f2bf(c1); const unsigned short lo = f2bf(c1 - bf2f(mid));
              u32x4 wq; wq.x = (unsigned)hi | ((unsigned)mid << 16); wq.y = (unsigned)lo | (0x3F80u << 16); wq.z = 0x3F803F80u; wq.w = 0u;
              if (h) wq = (u32x4){0u, 0u, 0u, 0u};
              qf[8] = __builtin_bit_cast(bf16x8, wq); }
            f32x16 O[4];
#pragma unroll
            for (int db = 0; db < 4; ++db)
#pragma unroll
                for (int i = 0; i < 16; ++i) O[db][i] = 0.f;
            float m = -INFINITY, l = 0.f;
            const FragSrc src{KF + (size_t)bh * 128 * 9 * 512, VF + (size_t)bh * 128 * 8 * 512, 9}; const FoxMK mk{tq, h, qt};
            attn_run_sh<9, true>(F.lds, F.tid, F.lane, qf, O, m, l, 0, qhi + 1, 0, qt + 1, src, mk);
            l += __shfl_xor(l, 32);
            store_col<false>(Ob + mrow * DM + hd * 128, O, l > 0.f ? 1.0f / l : 0.f, h);
        }
    }
}
typedef long fp8x8_t;
DI fp8x8_t pack_fp8x8(float a0, float a1, float a2, float a3, float a4, float a5, float a6, float a7) {
    int lo = 0, hi = 0;
    lo = __builtin_amdgcn_cvt_pk_fp8_f32(a0, a1, lo, false); lo = __builtin_amdgcn_cvt_pk_fp8_f32(a2, a3, lo, true);
    hi = __builtin_amdgcn_cvt_pk_fp8_f32(a4, a5, hi, false); hi = __builtin_amdgcn_cvt_pk_fp8_f32(a6, a7, hi, true);
    return (fp8x8_t)(((unsigned long long)(unsigned)hi << 32) | (unsigned long long)(unsigned)lo);
}
#define MFMA32F8(a, b, c) __builtin_amdgcn_mfma_f32_32x32x16_fp8_fp8((a), (b), (c), 0, 0, 0)
constexpr size_t NA_Q = 0, NA_KC = 288 * MiB, NA_VC = 313 * MiB, NA_KSR = 330 * MiB, NA_KWR = 354 * MiB, NA_GT = 378 * MiB, NA_VSR = 386 * MiB, NA_VWR = 402 * MiB, NA_GK = 418 * MiB, NA_GV = 420 * MiB,
                 NA_KCMP = 422 * MiB, NA_VCT = 424 * MiB, NA_SELB = 426 * MiB, NA_O = 428 * MiB,
                 NA_KSF = 620 * MiB, NA_KWF = 644 * MiB, NA_VSF = 668 * MiB, NA_VWF = 684 * MiB;
constexpr size_t NW_IN = 0, NW_W1K = (size_t)13312 * 2048, NW_W1V = NW_W1K + (size_t)256 * 6144, NW_W2K = NW_W1V + (size_t)256 * 4096, NW_W2V = NW_W2K + 65536, NW_OUT = NW_W2V + 65536;
constexpr float NSA_QSCALE = 0.07216878364870322f * LOG2E;
DI void ph_nsa_cvt(const Frame& F, const float* w_in, const float* k_pe, const float* k_w1, const float* k_b1, const float* k_w2, const float* v_pe, const float* v_w1, const float* v_b1, const float* v_w2, const float* w_out) {
    bf16* WB = (bf16*)(F.ws + WS_WMIX); float* BIAS = (float*)(F.ws + WS_MISC);
    cvt_job(F, w_in, 13200, DM, 0, 9216, WB + NW_IN, DM, 0, NSA_QSCALE);
    cvt_job(F, w_in, 13200, DM, 9216, 768, WB + NW_IN, DM, 9216, 1.f);
    cvt_job(F, w_in, 13200, DM, 9984, 512, WB + NW_IN, DM, 9984, 1.f);
    cvt_job(F, w_in, 13200, DM, 10496, 768, WB + NW_IN, DM, 10496, 1.f);
    cvt_job(F, w_in, 13200, DM, 11776, 768, WB + NW_IN, DM, 11264, 1.f);
    cvt_job(F, w_in, 13200, DM, 13056, 144, WB + NW_IN, DM, 12032, 1.f);
    zero_bf16(F, WB + NW_IN + (size_t)12176 * DM, (size_t)112 * DM);
    cvt_job(F, w_in, 13200, DM, 11264, 512, WB + NW_IN, DM, 12288, 1.f);
    cvt_job(F, w_in, 13200, DM, 12544, 512, WB + NW_IN, DM, 12800, 1.f);
    cvt_job(F, k_w1, 256, 6144, 0, 256, WB + NW_W1K, 6144, 0, 1.f);
    cvt_job(F, v_w1, 256, 4096, 0, 256, WB + NW_W1V, 4096, 0, 1.f);
    cvt_job(F, k_w2, 192, 256, 0, 192, WB + NW_W2K, 256, 0, 1.f); zero_bf16(F, WB + NW_W2K + 192 * 256, 64 * 256);
    cvt_job(F, v_w2, 128, 256, 0, 128, WB + NW_W2V, 256, 0, 1.f); zero_bf16(F, WB + NW_W2V + 128 * 256, 128 * 256);
    cvt_job(F, w_out, DM, 6144, 0, DM, WB + NW_OUT, 6144, 0, 1.f);
    for (int w = F.gw; w < 512; w += F.NGW) { const bool isk = w < 256; const int c = w & 255, n = isk ? 6144 : 4096; const float* pe = isk ? k_pe : v_pe; const float* w1 = isk ? k_w1 : v_w1;
        float s = 0.f; for (int i = F.lane; i < n; i += 64) s += pe[i] * w1[(size_t)i * 256 + c];
        s = wave_sum(s); if (F.lane == 0) BIAS[w] = s + (isk ? k_b1[c] : v_b1[c]); }
}
DI void ph_nsa_rope(const Frame& F, int half) {
    unsigned char* ar = F.ws + WS_AR; bf16* Q = (bf16*)(ar + NA_Q); bf16* KC = (bf16*)(ar + NA_KC);
    const bf16* KSR = (const bf16*)(ar + NA_KSR); const bf16* KWR = (const bf16*)(ar + NA_KWR); bf16* KSF = (bf16*)(ar + NA_KSF); bf16* KWF = (bf16*)(ar + NA_KWF);
    const float* c48 = (const float*)(F.ws + TAB_COS48); const float* s48 = (const float*)(F.ws + TAB_SIN48);
    for (int ml = F.gw; ml < MC; ml += F.NGW) {
        const size_t mg = (size_t)half * MC + ml; const int bl = ml >> 12, sq = ml & 4095;
        for (int p = F.lane; p < 96; p += 64) {
            const int hd = 48 + p / 24, i = p - (p / 24) * 24; bf16* q;
            q = KC + ((size_t)(bl * 4 + hd - 48) * 4096 + sq) * 192 + i;
            const float x1 = bf2f(q[0]), x2 = bf2f(q[24]), c = c48[mg * 24 + i], s = s48[mg * 24 + i]; q[0] = f2bf(x1 * c - x2 * s); q[24] = f2bf(x1 * s + x2 * c);
        }
        const int tile = sq >> 5, rr = sq & 31;
        for (int u = F.lane; u < 168; u += 64) {
            const int tens = u / 84, uu = u - tens * 84, g = uu / 21, v = uu - g * 21;
            const bf16* src = (tens ? KWR : KSR) + (size_t)ml * 768 + g * 192;
            bf16* dst = (tens ? KWF : KSF) + ((size_t)((bl * 4 + g) * 128 + tile) * 12 * 64 + rr) * 8;
            if (v < 3) {
                const u32x4 a = *(const u32x4*)(src + 8 * v), b = *(const u32x4*)(src + 8 * v + 24); u32x4 o1, o2;
#pragma unroll
                for (int e = 0; e < 4; ++e) { const float c0 = c48[mg * 24 + 8 * v + 2 * e], s0 = s48[mg * 24 + 8 * v + 2 * e], c1 = c48[mg * 24 + 8 * v + 2 * e + 1], s1 = s48[mg * 24 + 8 * v + 2 * e + 1];
                    const float x1l = bflo(a[e]), x1h = bfhi(a[e]), x2l = bflo(b[e]), x2h = bfhi(b[e]);
                    o1[e] = pk2(x1l * c0 - x2l * s0, x1h * c1 - x2h * s1); o2[e] = pk2(x1l * s0 + x2l * c0, x1h * s1 + x2h * c1); }
                const int p1 = v, p2 = v + 3;
                if (tens) { *(u32x4*)(dst + ((p1 >> 1) * 64 + (p1 & 1) * 32) * 8) = o1; *(u32x4*)(dst + ((p2 >> 1) * 64 + (p2 & 1) * 32) * 8) = o2; }
                else { unsigned char* d8 = (unsigned char*)KSF + ((size_t)(((bl * 4 + g) * 128 + tile) * 2 + (rr >> 4)) * 6 * 64 + (rr & 15)) * 8;
                    *(fp8x8_t*)(d8 + ((p1 >> 2) * 64 + (p1 & 3) * 16) * 8) = pack_fp8x8(bflo(o1[0]), bfhi(o1[0]), bflo(o1[1]), bfhi(o1[1]), bflo(o1[2]), bfhi(o1[2]), bflo(o1[3]), bfhi(o1[3]));
                    *(fp8x8_t*)(d8 + ((p2 >> 2) * 64 + (p2 & 3) * 16) * 8) = pack_fp8x8(bflo(o2[0]), bfhi(o2[0]), bflo(o2[1]), bfhi(o2[1]), bflo(o2[2]), bfhi(o2[2]), bflo(o2[3]), bfhi(o2[3])); }
            } else { const int pc = v + 3; const u32x4 c = *(const u32x4*)(src + 8 * pc);
                if (tens) *(u32x4*)(dst + ((pc >> 1) * 64 + (pc & 1) * 32) * 8) = c;
                else { unsigned char* d8 = (unsigned char*)KSF + ((size_t)(((bl * 4 + g) * 128 + tile) * 2 + (rr >> 4)) * 6 * 64 + (rr & 15)) * 8;
                    *(fp8x8_t*)(d8 + ((pc >> 2) * 64 + (pc & 3) * 16) * 8) = pack_fp8x8(bflo(c[0]), bfhi(c[0]), bflo(c[1]), bfhi(c[1]), bflo(c[2]), bfhi(c[2]), bflo(c[3]), bfhi(c[3])); } }
        }
    }
    const bf16* VSR = (const bf16*)(ar + NA_VSR); const bf16* VWR = (const bf16*)(ar + NA_VWR); bf16* VSF = (bf16*)(ar + NA_VSF); bf16* VWF = (bf16*)(ar + NA_VWF);
    const int r = F.lane & 31, h = F.lane >> 5;
    for (int u = F.gw; u < 2 * BPH * 4 * 128; u += F.NGW) {
        const int tens = u >> 11, bg = (u >> 7) & 15, tile = u & 127, bl = bg >> 2, g = bg & 3;
        if (tens) {
            const bf16* src = VWR + ((size_t)bl * SEQ + tile * 32) * 512 + g * 128 + r;
            bf16* vd = VWF + (((size_t)bg * 128 + tile) * 8 * 64 + F.lane) * 8;
#pragma unroll
            for (int db = 0; db < 4; ++db)
#pragma unroll
                for (int s = 0; s < 2; ++s) { unsigned short e[8];
#pragma unroll
                    for (int j = 0; j < 8; ++j) e[j] = src[(size_t)(16 * s + 8 * (j >> 2) + 4 * h + (j & 3)) * 512 + db * 32];
                    u32x4 w; w.x = e[0] | ((unsigned)e[1] << 16); w.y = e[2] | ((unsigned)e[3] << 16); w.z = e[4] | ((unsigned)e[5] << 16); w.w = e[6] | ((unsigned)e[7] << 16);
                    *(u32x4*)(vd + (db * 2 + s) * 512) = w; }
        } else {
            const int d16 = F.lane & 15, kq = F.lane >> 4;
            const bf16* src = VSR + ((size_t)bl * SEQ + tile * 32) * 512 + g * 128 + d16;
            unsigned char* vd = (unsigned char*)VSF + (((size_t)bg * 128 + tile) * 8 * 64 + F.lane) * 8;
#pragma unroll
            for (int db = 0; db < 8; ++db) { float e[8];
#pragma unroll
                for (int j = 0; j < 8; ++j) e[j] = bf2f(src[(size_t)((j < 4 ? 4 * kq + j : 16 + 4 * kq + j - 4)) * 512 + db * 16]);
                *(fp8x8_t*)(vd + db * 512) = pack_fp8x8(e[0], e[1], e[2], e[3], e[4], e[5], e[6], e[7]); }
        }
    }
}
DI float sigmoidf_(float x) { return __builtin_amdgcn_rcpf(1.0f + __builtin_amdgcn_exp2f(-x * LOG2E)); }
struct CmpMK { int tq, h, q0; DI bool need(int t) const { return 512 * t + 527 > q0; }
    DI void operator()(int t, f32x16& S) const {
#pragma unroll
    for (int i = 0; i < 16; ++i) { const int n = 32 * t + crow(i, h); S[i] = (16 * n + 31 <= tq) ? S[i] : -INFINITY; } } };
struct WinMK { int tq, h, qt; DI bool need(int t) const { return t == qt || t == qt - 16; }
    DI void operator()(int t, f32x16& S) const {
#pragma unroll
    for (int i = 0; i < 16; ++i) { const int k = 32 * t + crow(i, h); S[i] = (k <= tq && k > tq - 512) ? S[i] : -INFINITY; } } };
DI void ph_nsa_cmp(const Frame& F, const int half) {
    const float* c48 = (const float*)(F.ws + TAB_COS48); const float* s48 = (const float*)(F.ws + TAB_SIN48);
    unsigned char* ar = F.ws + WS_AR; const bf16* Q = (const bf16*)(ar + NA_Q); const bf16* KCMP = (const bf16*)(ar + NA_KCMP); const bf16* VCT = (const bf16*)(ar + NA_VCT); const bf16* GT = (const bf16*)(ar + NA_GT);
    unsigned char* SELB = ar + NA_SELB; bf16* Ob = (bf16*)(ar + NA_O);
    LAS float* imp = (LAS float*)F.lds;
    LAS unsigned char* kres = F.lds + 20480;
    LAS unsigned char* vring = F.lds + 20480 + 98304;
    const int lane = F.lane, r = lane & 31, h = lane >> 5, tid = F.tid;
    for (int u = blockIdx.x; u < BPH * 4 * 64; u += F.G) {
        const int bg = u >> 6, qt64 = ((u >> 8) & 1) ? 63 - (u & 63) : (u & 63), bl = bg >> 2, g = bg & 3;
        const int tqmaxb = qt64 * 64 + 63, TE = (tqmaxb >= 31) ? ((tqmaxb - 31) / 16) / 32 + 1 : 0;
        const bf16* ksrc = KCMP + (size_t)bg * 8 * 12 * 512; const bf16* vsrc = VCT + (size_t)bg * 8 * 8 * 512;
        for (int i = F.tid; i < 64 * 65; i += NWAVES * 64) imp[i] = 0.f;
        for (int p = tid; p < TE * 768; p += NWAVES * 64) *(LAS u32x4*)(kres + p * 16) = *(const u32x4*)(ksrc + (size_t)p * 8);
        __syncthreads();
#pragma unroll 1
        for (int k = 0; k < 3; ++k) {
            const int idx = F.wave * 3 + k, j = idx >> 1, sub = idx & 1, ql = sub * 32 + r, tq = qt64 * 64 + ql, hd = g * 12 + j;
            const size_t mrow = (size_t)bl * SEQ + tq;
            bf16x8 qf[12];
#pragma unroll
            for (int s = 3; s < 12; ++s) qf[s] = *(const bf16x8*)(Q + mrow * 9216 + hd * 192 + 16 * s + 8 * h);
            { const float* cs = c48 + ((size_t)half * MC + mrow) * 24; const float* sn = s48 + ((size_t)half * MC + mrow) * 24;
#pragma unroll
              for (int s = 0; s < 3; ++s) qf[s] = rope_frag32(Q + mrow * 9216 + hd * 192, s, h, cs, sn); }
            const int tqmax = qt64 * 64 + sub * 32 + 31, te = (tqmax >= 31) ? ((tqmax - 31) / 16) / 32 + 1 : 0;
            const CmpMK mk{tq, h, qt64 * 64 + sub * 32};
            float m = -INFINITY, l = 0.f;
            {
                f32x16 Od[4];
#pragma unroll 1
                for (int t = 0; t < te; ++t) {
                    const LAS unsigned char* cur = kres + t * 12288;
                    f32x16 S;
#pragma unroll
                    for (int i = 0; i < 16; ++i) S[i] = 0.f;
#pragma unroll
                    for (int s = 0; s < 12; ++s) S = MFMA32(*(const LAS bf16x8*)(cur + s * 1024 + lane * 16), qf[s], S);
                    if (mk.need(t)) mk(t, S);
                    bf16x8 pfd[2]; softmax_step<4, false>(S, m, l, Od, pfd);
                }
            }
            l += __shfl_xor(l, 32);
            const float linv = l > 0.f ? 1.0f / l : 0.f, ms = (m == -INFINITY) ? 0.f : m;
            f32x16 O[4];
#pragma unroll
            for (int db = 0; db < 4; ++db)
#pragma unroll
                for (int i = 0; i < 16; ++i) O[db][i] = 0.f;
            if (TE > 0) {
                u32x4 pv = *(const u32x4*)(vsrc + (size_t)tid * 8);
                *(LAS u32x4*)(vring + tid * 16) = pv;
                LDS_WAIT(); __builtin_amdgcn_s_barrier(); asm volatile("" ::: "memory");
#pragma unroll 1
                for (int t = 0; t < TE; ++t) {
                    const LAS unsigned char* cur = kres + t * 12288; const LAS unsigned char* vcur = vring + (t & 1) * 8192;
                    if (t + 1 < TE) pv = *(const u32x4*)(vsrc + ((size_t)(t + 1) * 512 + tid) * 8);
                    if (t < te) {
                        f32x16 S;
#pragma unroll
                        for (int i = 0; i < 16; ++i) S[i] = 0.f;
#pragma unroll
                        for (int s = 0; s < 12; ++s) S = MFMA32(*(const LAS bf16x8*)(cur + s * 1024 + lane * 16), qf[s], S);
                        if (mk.need(t)) mk(t, S);
#pragma unroll
                        for (int i = 0; i < 16; ++i) S[i] = __builtin_amdgcn_exp2f(S[i] - ms) * linv;
#pragma unroll
                        for (int g4 = 0; g4 < 4; ++g4) { const float gs = (S[4 * g4] + S[4 * g4 + 1]) + (S[4 * g4 + 2] + S[4 * g4 + 3]); const int mb = 8 * t + 2 * g4 + h;
                            __hip_atomic_fetch_add(imp + ql * 65 + mb, gs, __ATOMIC_RELAXED, __HIP_MEMORY_SCOPE_WORKGROUP);
                            if (mb + 1 < 64) __hip_atomic_fetch_add(imp + ql * 65 + mb + 1, S[4 * g4 + 3], __ATOMIC_RELAXED, __HIP_MEMORY_SCOPE_WORKGROUP); }
                        bf16x8 pf[2];
#pragma unroll
                        for (int s = 0; s < 2; ++s) { u32x4 w; w.x = pk2(S[8 * s], S[8 * s + 1]); w.y = pk2(S[8 * s + 2], S[8 * s + 3]); w.z = pk2(S[8 * s + 4], S[8 * s + 5]); w.w = pk2(S[8 * s + 6], S[8 * s + 7]); pf[s] = __builtin_bit_cast(bf16x8, w); }
#pragma unroll
                        for (int db = 0; db < 4; ++db)
#pragma unroll
                            for (int s = 0; s < 2; ++s) O[db] = MFMA32(*(const LAS bf16x8*)(vcur + (db * 2 + s) * 1024 + lane * 16), pf[s], O[db]);
                    }
                    if (t + 1 < TE) *(LAS u32x4*)(vring + ((t + 1) & 1) * 8192 + tid * 16) = pv;
                    LDS_WAIT(); __builtin_amdgcn_s_barrier(); asm volatile("" ::: "memory");
                }
            }
            const float gate = sigmoidf_(bf2f(GT[mrow * 256 + hd]));
            store_col<false>(Ob + mrow * 6144 + hd * 128, O, gate, h);
        }
        __syncthreads();
#pragma unroll 1
        for (int k = 0; k < 8; ++k) {
            const int ql = F.wave * 8 + k, tq = qt64 * 64 + ql, cur = tq >> 6, mb = lane;
            const bool causal = mb <= cur, forced = (mb == 0) || (mb == cur) || (mb == cur - 1);
            const float v = causal ? (forced ? INFINITY : imp[ql * 65 + mb]) : -INFINITY;
            int rank = 0;
            for (int o = 0; o < 64; ++o) { const float vo = __shfl(v, o); rank += (vo > v || (vo == v && o < mb)) ? 1 : 0; }
            if (rank < 16) SELB[((size_t)bg * 4096 + tq) * 16 + rank] = causal ? (unsigned char)mb : (unsigned char)0xFF;
        }
        __syncthreads();
    }
}
DI int sel_tile(const u32x4& sel, int t) { const int b = t >> 1; const unsigned w = (b < 4) ? sel.x : (b < 8) ? sel.y : (b < 12) ? sel.z : sel.w; return (int)((w >> ((b & 3) * 8)) & 0xFFu) * 2 + (t & 1); }
struct SelMK { u32x4 sel; int tq, h; DI void operator()(int t, f32x16& S) const { const int k0 = sel_tile(sel, t) * 32;
#pragma unroll
    for (int i = 0; i < 16; ++i) S[i] = (k0 + crow(i, h) <= tq) ? S[i] : -INFINITY; } };
typedef float f32x4_ __attribute__((ext_vector_type(4)));
#define MFMA16F8(a, b, c) __builtin_amdgcn_mfma_f32_16x16x32_fp8_fp8((a), (b), (c), 0, 0, 0)
DI void ph_nsa_sel(const Frame& F, const int half) {
    const float* c48 = (const float*)(F.ws + TAB_COS48); const float* s48 = (const float*)(F.ws + TAB_SIN48);
    unsigned char* ar = F.ws + WS_AR; const bf16* Q = (const bf16*)(ar + NA_Q); const unsigned char* KS8 = ar + NA_KSF; const unsigned char* VS8 = ar + NA_VSF; const bf16* GT = (const bf16*)(ar + NA_GT);
    const unsigned char* SELB = ar + NA_SELB; bf16* Ob = (bf16*)(ar + NA_O);
    const int c16 = F.lane & 15, kq = F.lane >> 4; const bool act = c16 < 12;
    for (int it = F.gw; it < BPH * 4 * SEQ; it += F.NGW) {
        const int bg = it >> 12, tq = ((it & 4095) + 256 * bg) & 4095, bl = bg >> 2, g = bg & 3; const size_t mrow = (size_t)bl * SEQ + tq; const int hd = g * 12 + (act ? c16 : 0);
        fp8x8_t qf[6];
#pragma unroll
        for (int s = 0; s < 6; ++s) { const float qs = act ? (1.0f / NSA_QSCALE) : 0.f; const int p = 4 * s + kq;
            if (s < 2 && p < 6) { float o[8]; rope_piece(Q + mrow * 9216 + hd * 192, p, c48 + ((size_t)half * MC + mrow) * 24, s48 + ((size_t)half * MC + mrow) * 24, o);
                qf[s] = pack_fp8x8(o[0] * qs, o[1] * qs, o[2] * qs, o[3] * qs, o[4] * qs, o[5] * qs, o[6] * qs, o[7] * qs); }
            else { const u32x4 q = *(const u32x4*)(Q + mrow * 9216 + hd * 192 + 32 * s + 8 * kq);
                qf[s] = pack_fp8x8(bflo(q[0]) * qs, bfhi(q[0]) * qs, bflo(q[1]) * qs, bfhi(q[1]) * qs, bflo(q[2]) * qs, bfhi(q[2]) * qs, bflo(q[3]) * qs, bfhi(q[3]) * qs); } }
        const u32x4 sel = *(const u32x4*)(SELB + ((size_t)bg * 4096 + tq) * 16);
        const int nv = ((tq >> 6) + 1 < 16) ? (tq >> 6) + 1 : 16, te = 2 * nv;
        const unsigned char* kb = KS8 + ((size_t)bg * 128 * 12 * 64 + F.lane) * 8; const unsigned char* vb = VS8 + ((size_t)bg * 128 * 8 * 64 + F.lane) * 8;
        f32x4_ O[8];
#pragma unroll
        for (int db = 0; db < 8; ++db) O[db] = (f32x4_){0.f, 0.f, 0.f, 0.f};
        float m = -INFINITY, l = 0.f;
        fp8x8_t kfA[12], kfB[12], vfA[8], vfB[8];
        { const unsigned char* kp = kb + (size_t)sel_tile(sel, 0) * 12 * 512; const unsigned char* kp1 = kb + (size_t)sel_tile(sel, 1) * 12 * 512; const unsigned char* vp = vb + (size_t)sel_tile(sel, 0) * 8 * 512;
#pragma unroll
          for (int s = 0; s < 12; ++s) { kfA[s] = *(const fp8x8_t*)(kp + s * 512); kfB[s] = *(const fp8x8_t*)(kp1 + s * 512); }
#pragma unroll
          for (int j = 0; j < 8; ++j) vfA[j] = *(const fp8x8_t*)(vp + j * 512); }
#define SEL_STEP(T_, KF_, VF_, VFN_) do { const int t_ = (T_); const int tile = sel_tile(sel, t_); \
            if (t_ + 1 < te) { const unsigned char* vp = vb + (size_t)sel_tile(sel, t_ + 1) * 8 * 512; _Pragma("unroll") for (int j = 0; j < 8; ++j) VFN_[j] = *(const fp8x8_t*)(vp + j * 512); } \
            f32x4_ S0 = {0.f, 0.f, 0.f, 0.f}, S1 = S0; \
            _Pragma("unroll") for (int s = 0; s < 6; ++s) { S0 = MFMA16F8(KF_[s], qf[s], S0); S1 = MFMA16F8(KF_[6 + s], qf[s], S1); } \
            if (t_ + 2 < te) { const unsigned char* kp = kb + (size_t)sel_tile(sel, t_ + 2) * 12 * 512; _Pragma("unroll") for (int s = 0; s < 12; ++s) KF_[s] = *(const fp8x8_t*)(kp + s * 512); } \
            const int k0 = tile * 32 + 4 * kq; float mx = -INFINITY; \
            _Pragma("unroll") for (int i = 0; i < 4; ++i) { S0[i] = (k0 + i <= tq) ? S0[i] * NSA_QSCALE : -INFINITY; S1[i] = (k0 + 16 + i <= tq) ? S1[i] * NSA_QSCALE : -INFINITY; mx = fmaxf(mx, fmaxf(S0[i], S1[i])); } \
            mx = fmaxf(mx, __shfl_xor(mx, 16)); mx = fmaxf(mx, __shfl_xor(mx, 32)); \
            const float mn = fmaxf(m, mx), ms = (mn == -INFINITY) ? 0.f : mn, alpha = __builtin_amdgcn_exp2f(m - ms); \
            float sum = 0.f; \
            _Pragma("unroll") for (int i = 0; i < 4; ++i) { S0[i] = __builtin_amdgcn_exp2f(S0[i] - ms); S1[i] = __builtin_amdgcn_exp2f(S1[i] - ms); sum += S0[i] + S1[i]; } \
            l = l * alpha + sum; m = mn; \
            if (__builtin_amdgcn_ballot_w64(alpha != 1.0f) != 0ull) { _Pragma("unroll") for (int db = 0; db < 8; ++db) O[db] = O[db] * alpha; } \
            const fp8x8_t p8 = pack_fp8x8(S0[0], S0[1], S0[2], S0[3], S1[0], S1[1], S1[2], S1[3]);       \
            _Pragma("unroll") for (int db = 0; db < 8; ++db) O[db] = MFMA16F8(VF_[db], p8, O[db]); } while (0)
#pragma unroll 1
        for (int t = 0; t < te; t += 2) { SEL_STEP(t, kfA, vfA, vfB); SEL_STEP(t + 1, kfB, vfB, vfA); }
#undef SEL_STEP
        l += __shfl_xor(l, 16); l += __shfl_xor(l, 32);
        if (act) { const float gate = sigmoidf_(bf2f(GT[mrow * 256 + 48 + hd])); const float sc = l > 0.f ? gate / l : 0.f;
            bf16* o = Ob + mrow * 6144 + hd * 128 + 4 * kq;
#pragma unroll
            for (int db = 0; db < 8; ++db) { u32x2* p = (u32x2*)(o + db * 16); const u32x2 prev = *p;
                u32x2 w; w.x = pk2(O[db][0] * sc + bflo(prev.x), O[db][1] * sc + bfhi(prev.x)); w.y = pk2(O[db][2] * sc + bflo(prev.y), O[db][3] * sc + bfhi(prev.y)); *p = w; } }
    }
}
DI void ph_nsa_win(const Frame& F, const int half) {
    const float* c48 = (const float*)(F.ws + TAB_COS48); const float* s48 = (const float*)(F.ws + TAB_SIN48);
    unsigned char* ar = F.ws + WS_AR; const bf16* Q = (const bf16*)(ar + NA_Q); const bf16* KWF = (const bf16*)(ar + NA_KWF); const bf16* VWF = (const bf16*)(ar + NA_VWF); const bf16* GT = (const bf16*)(ar + NA_GT); bf16* Ob = (bf16*)(ar + NA_O);
    const int r = F.lane & 31, h = F.lane >> 5;
    for (int idb = blockIdx.x; idb < BPH * 4 * 3 * 64; idb += F.G) {
        const int qt0 = (((idb & 63) + (idb >> 8)) & 63) * 2, qt = qt0 + (F.wave & 1), rest = idb >> 6, hq = rest % 3, bg = rest / 3, bl = bg >> 2, g = bg & 3, hd = g * 12 + hq * 4 + (F.wave >> 1), tq = qt * 32 + r; const size_t mrow = (size_t)bl * SEQ + tq;
        bf16x8 qf[12];
#pragma unroll
        for (int s = 3; s < 12; ++s) qf[s] = *(const bf16x8*)(Q + mrow * 9216 + hd * 192 + 16 * s + 8 * h);
        { const float* cs = c48 + ((size_t)half * MC + mrow) * 24; const float* sn = s48 + ((size_t)half * MC + mrow) * 24;
#pragma unroll
          for (int s = 0; s < 3; ++s) qf[s] = rope_frag32(Q + mrow * 9216 + hd * 192, s, h, cs, sn); }
        const FragSrc src{KWF + (size_t)bg * 128 * 12 * 512, VWF + (size_t)bg * 128 * 8 * 512, 12}; const WinMK mk{tq, h, qt};
        f32x16 O[4];
#pragma unroll
        for (int db = 0; db < 4; ++db)
#pragma unroll
            for (int i = 0; i < 16; ++i) O[db][i] = 0.f;
        float m = -INFINITY, l = 0.f;
        attn_run_sh<12, true>(F.lds, F.tid, F.lane, qf, O, m, l, qt0 >= 16 ? qt0 - 16 : 0, qt0 + 2, qt >= 16 ? qt - 16 : 0, qt + 1, src, mk);
        l += __shfl_xor(l, 32);
        const float gate = sigmoidf_(bf2f(GT[mrow * 256 + 96 + hd]));
        store_col<true>(Ob + mrow * 6144 + hd * 128, O, l > 0.f ? gate / l : 0.f, h);
    }
}
#ifndef MK_ONE_LAUNCH
#define MK_ONE_LAUNCH 1
#endif
constexpr int NPH = 69;
struct Args { const float* in[58]; float* out; unsigned char* ws; int ph_lo, ph_hi; };
#define GEMM_AKOFF 0
#define GEMM_CALL(EpiT, Evar, Aptr, Bptr, Mv, Nv, Kv, ldav, ldbv, cidx) do { const pg8::Gemm g_{(const pg8::bf16_t*)(Aptr), (const pg8::bf16_t*)(Bptr), (Mv), (Nv), (Kv), (ldav), (ldbv), GEMM_AKOFF}; \
    pg8::StaticOrder S_; S_.init((Mv), (Nv), F.G, (cidx)); pg8::gemm_phase<EpiT, pg8::StaticOrder, true, true>((PG8_LAS unsigned char*)F.lds, g_, S_, Evar); } while (0)
DI pg8::EpiBf16R epi1(bf16* base, int ldc) { pg8::EpiBf16R e; for (int s = 0; s < 8; ++s) { e.T.base[s] = base; e.T.ldc[s] = ldc; e.T.t0[s] = 0; e.T.gw[s] = 0; } e.T.nseg = 1; e.T.pad_ = 0; e.ssp = nullptr; e.ss_off = 0; return e; }
#define PH_BEGIN if (ph >= lo && ph < hi) { Frame F; { unsigned long long w_ = (unsigned long long)args.ws; asm volatile("" : "+s"(w_)); F.ws = (unsigned char*)w_; F.ctl = (unsigned*)(F.ws + WS_CTL); } \
    F.lds = lds; F.tid = threadIdx.x; F.lane = F.tid & 63; F.wave = __builtin_amdgcn_readfirstlane(F.tid >> 6); F.G = gridDim.x; F.gw = blockIdx.x * NWAVES + F.wave; F.NGW = F.G * NWAVES; \
    float* out; { unsigned long long o_ = (unsigned long long)args.out; asm volatile("" : "+s"(o_)); out = (float*)o_; } \
    unsigned char* const ar = F.ws + WS_AR; bf16* const XN = (bf16*)(F.ws + WS_XNR); float* const SSB = (float*)(F.ws + WS_SS); bf16* const WB = (bf16*)(F.ws + WS_WMIX); bf16* const WUP = (bf16*)(F.ws + WS_WFFN); bf16* const WDN = WUP + (size_t)2 * DFF * DM; \
    const float* const res_mix = (ib == 2) ? args.in[0] : (const float*)out; (void)ar; (void)XN; (void)SSB; (void)WB; (void)WUP; (void)WDN; (void)res_mix; (void)iff;
#define PH_END   if (ph + 1 < hi) { XcdBarrier b_; b_.bar = (unsigned*)F.ctl + CW_BAR; b_.x = xb_xcc_id(); b_.st = MISC + 8; xcd_barrier(b_); } } ++ph;
template <int LAYER> DI void run_cvt(const Args& args, LAS unsigned char* lds, volatile LAS unsigned* MISC, int& ph, const int lo, const int hi) {
    constexpr int ib = (LAYER == 0) ? 2 : (LAYER == 1) ? 17 : (LAYER == 2) ? 26 : 42;
    constexpr int iff = (LAYER == 0) ? 12 : (LAYER == 1) ? 21 : (LAYER == 2) ? 37 : 52;
    constexpr int kind = (LAYER == 1) ? 1 : (LAYER == 2) ? 2 : 0;
        PH_BEGIN
            if constexpr (LAYER == 0) { ph_tables(F, (const int*)args.in[1]); ph_norm_first(F, args.in[0], args.in[2], XN, SSB); }
            if constexpr (kind == 0) ph_dsa_cvt(F, args.in[ib + 1], args.in[ib + 6], args.in[ib + 7], args.in[ib + 8], args.in[ib + 9]);
            else if constexpr (kind == 1) ph_fox_cvt(F, args.in[ib + 1], args.in[ib + 3]);
            else ph_nsa_cvt(F, args.in[ib + 1], args.in[ib + 2], args.in[ib + 3], args.in[ib + 4], args.in[ib + 5], args.in[ib + 6], args.in[ib + 7], args.in[ib + 8], args.in[ib + 9], args.in[ib + 10]);
            ph_cvt_ffn(F, args.in[iff + 1], args.in[iff + 4]);
        PH_END
}
template <int LAYER, int HALF> DI void run_half(const Args& args, LAS unsigned char* lds, volatile LAS unsigned* MISC, int& ph, const int lo, const int hi) {
    constexpr int ib = (LAYER == 0) ? 2 : (LAYER == 1) ? 17 : (LAYER == 2) ? 26 : 42;
    constexpr int iff = (LAYER == 0) ? 12 : (LAYER == 1) ? 21 : (LAYER == 2) ? 37 : 52;
    constexpr int kind = (LAYER == 1) ? 1 : (LAYER == 2) ? 2 : 0;
    constexpr int half = HALF;
            const int roff = half * MC;
            if constexpr (kind == 0) {
                PH_BEGIN { pg8::EpiF32 E{(float*)(ar + DA_DIN), 1024, SSB + (size_t)(LAYER * 2) * MTOT * 8, roff}; GEMM_CALL(pg8::EpiF32, E, XN + (size_t)roff * DM, WB + DW_W1, MC, 1024, DM, DM, DM, (int)blockIdx.x); } PH_END
                PH_BEGIN ph_dsa_post1(F, half, args.in[ib + 2], args.in[ib + 3], args.in[ib + 4], args.in[ib + 5]); PH_END
                PH_BEGIN { pg8::EpiBf16R E = epi1((bf16*)(ar + DA_QL), 8192); E.T.base[1] = (bf16*)(ar + DA_QPE); E.T.ldc[1] = 1536; E.T.t0[1] = 32; E.T.base[2] = (bf16*)(ar + DA_QIDX); E.T.ldc[2] = 2048; E.T.t0[2] = 38; E.T.nseg = 3;
                    GEMM_CALL(pg8::EpiBf16R, E, ar + DA_CQN, WB + DW_W2, MC, 11776, 512, 512, 512, (int)blockIdx.x); } PH_END
                PH_BEGIN ph_dsa_index(F, half); PH_END
                PH_BEGIN ph_dsa_attn(F, half); PH_END
                PH_BEGIN {
                    pg8::EpiBf16R E = epi1((bf16*)(ar + DA_O2), 4096);
                    { const pg8::Gemm g_{(const pg8::bf16_t*)(ar + DA_QL), (const pg8::bf16_t*)(WB + DW_BD), MC, 4096, 512, 8192, 512, 512}; pg8::StaticOrder S_; S_.init(MC, 4096, F.G, (int)blockIdx.x);
                      pg8::gemm_phase<pg8::EpiBf16R, pg8::StaticOrder, true, true>((PG8_LAS unsigned char*)F.lds, g_, S_, E); } } PH_END
                PH_BEGIN { pg8::EpiResN E{LAYER == 0 ? args.in[0] : nullptr, args.in[ib], nullptr, DM, roff, args.in[iff], (pg8::bf16_t*)XN, SSB + (size_t)(LAYER * 2 + 1) * MTOT * 8, (PG8_LAS float*)(F.lds + LDSCTL_OFF + 256)}; GEMM_CALL(pg8::EpiResN, E, ar + DA_O2, WB + DW_WO, MC, DM, 4096, 4096, 4096, (int)blockIdx.x); } PH_END
            } else if constexpr (kind == 1) {
                PH_BEGIN { pg8::EpiBf16R E = epi1((bf16*)(ar + FA_Q), DM); E.T.base[1] = (bf16*)(ar + FA_K); E.T.ldc[1] = DM; E.T.t0[1] = 8; E.T.base[2] = (bf16*)(ar + FA_V); E.T.ldc[2] = DM; E.T.t0[2] = 16;
                    E.T.base[3] = (bf16*)(ar + FA_F); E.T.ldc[3] = 256; E.T.t0[3] = 24; E.T.nseg = 4; E.ssp = SSB + (size_t)(LAYER * 2) * MTOT * 8; E.ss_off = roff;
                    GEMM_CALL(pg8::EpiBf16R, E, XN + (size_t)roff * DM, WB + FW_IN, MC, 6400, DM, DM, DM, (int)blockIdx.x); } PH_END
                PH_BEGIN ph_fox_scan(F, args.in[ib + 2]); PH_END
                PH_BEGIN ph_fox_attn(F); PH_END
                PH_BEGIN { pg8::EpiResN E{LAYER == 0 ? args.in[0] : nullptr, args.in[ib], nullptr, DM, roff, args.in[iff], (pg8::bf16_t*)XN, SSB + (size_t)(LAYER * 2 + 1) * MTOT * 8, (PG8_LAS float*)(F.lds + LDSCTL_OFF + 256)}; GEMM_CALL(pg8::EpiResN, E, ar + FA_O, WB + FW_OUT, MC, DM, DM, DM, DM, (int)blockIdx.x); } PH_END
            } else {
                PH_BEGIN { pg8::EpiBf16R E = epi1((bf16*)(ar + NA_Q), 9216);
                    E.T.base[1] = (bf16*)(ar + NA_KC); E.T.ldc[1] = 192; E.T.t0[1] = 36; E.T.gw[1] = 192;
                    E.T.base[2] = (bf16*)(ar + NA_VC); E.T.ldc[2] = 128; E.T.t0[2] = 39; E.T.gw[2] = 128;
                    E.T.base[3] = (bf16*)(ar + NA_KSR); E.T.ldc[3] = 768; E.T.t0[3] = 41;
                    E.T.base[4] = (bf16*)(ar + NA_KWR); E.T.ldc[4] = 768; E.T.t0[4] = 44;
                    E.T.base[5] = (bf16*)(ar + NA_GT); E.T.ldc[5] = 256; E.T.t0[5] = 47;
                    E.T.base[6] = (bf16*)(ar + NA_VSR); E.T.ldc[6] = 512; E.T.t0[6] = 48;
                    E.T.base[7] = (bf16*)(ar + NA_VWR); E.T.ldc[7] = 512; E.T.t0[7] = 50; E.T.nseg = 8; E.ssp = SSB + (size_t)(LAYER * 2) * MTOT * 8; E.ss_off = roff;
                    GEMM_CALL(pg8::EpiBf16R, E, XN + (size_t)roff * DM, WB + NW_IN, MC, 13312, DM, DM, DM, (int)blockIdx.x); } PH_END
                PH_BEGIN ph_nsa_rope(F, half); PH_END
                PH_BEGIN {
                    const float* BIAS = (const float*)(args.ws + WS_MISC);
                    { pg8::EpiGelu E{(bf16*)(ar + NA_GK), 256, BIAS}; GEMM_CALL(pg8::EpiGelu, E, ar + NA_KC, WB + NW_W1K, 4096, 256, 6144, 3072, 6144, (int)blockIdx.x); }
                    { pg8::EpiGelu E{(bf16*)(ar + NA_GV), 256, BIAS + 256}; GEMM_CALL(pg8::EpiGelu, E, ar + NA_VC, WB + NW_W1V, 4096, 256, 4096, 2048, 4096, (int)((blockIdx.x + F.G - 16) % F.G)); }
                } PH_END
                PH_BEGIN {
                    { pg8::EpiBf16R E = epi1((bf16*)(ar + NA_KCMP), 12); E.T.gw[0] = -1; GEMM_CALL(pg8::EpiBf16R, E, ar + NA_GK, WB + NW_W2K, 4096, 256, 256, 256, 256, (int)blockIdx.x); }
                    { pg8::EpiBf16R E = epi1((bf16*)(ar + NA_VCT), 4); E.T.gw[0] = -2; GEMM_CALL(pg8::EpiBf16R, E, WB + NW_W2V, ar + NA_GV, 256, 4096, 256, 256, 256, (int)((blockIdx.x + F.G - 16) % F.G)); }
                } PH_END
                PH_BEGIN ph_nsa_cmp(F, half); PH_END
                PH_BEGIN ph_nsa_sel(F, half); PH_END
                PH_BEGIN ph_nsa_win(F, half); PH_END
                PH_BEGIN { pg8::EpiResN E{LAYER == 0 ? args.in[0] : nullptr, args.in[ib], nullptr, DM, roff, args.in[iff], (pg8::bf16_t*)XN, SSB + (size_t)(LAYER * 2 + 1) * MTOT * 8, (PG8_LAS float*)(F.lds + LDSCTL_OFF + 256)}; GEMM_CALL(pg8::EpiResN, E, ar + NA_O, WB + NW_OUT, MC, DM, 6144, 6144, 6144, (int)blockIdx.x); } PH_END
            }
}
template <int LAYER> DI void run_ffn(const Args& args, LAS unsigned char* lds, volatile LAS unsigned* MISC, int& ph, const int lo, const int hi) {
    constexpr int ib = (LAYER == 0) ? 2 : (LAYER == 1) ? 17 : (LAYER == 2) ? 26 : 42;
    constexpr int iff = (LAYER == 0) ? 12 : (LAYER == 1) ? 21 : (LAYER == 2) ? 37 : 52;
    PH_BEGIN {
        LAS float* rt = (LAS float*)(F.lds + LDSCTL_OFF + 256 + 8192); const int rbase = 4096 * (int)(blockIdx.x & 7); const float* ssq = SSB + (size_t)(LAYER * 2 + 1) * MTOT * 8;
        for (int i = F.tid; i < 4096; i += NWAVES * 64) rt[i] = pg8::rms_rowscale(ssq, rbase + i);
        __syncthreads();
        pg8::EpiConvGlu E{(pg8::bf16_t*)ar, (float*)(ar + 352 * MiB), args.in[iff + 2], args.in[iff + 3], (PG8_LAS float*)(F.lds + LDSCTL_OFF + 256), DFF, (const PG8_LAS float*)rt, rbase};
        GEMM_CALL(pg8::EpiConvGlu, E, XN, WUP, MTOT, 2 * DFF, DM, DM, DM, (int)blockIdx.x); } PH_END
    PH_BEGIN ph_conv_fix(F, (const float*)(ar + 352 * MiB), (bf16*)ar, args.in[iff + 2], args.in[iff + 3], MTOT); PH_END
    PH_BEGIN {
        if constexpr (LAYER < 3) { constexpr int ibn = (LAYER == 0) ? 17 : (LAYER == 1) ? 26 : 42;
            pg8::EpiResN E{nullptr, args.in[iff], nullptr, DM, 0, args.in[ibn], (pg8::bf16_t*)XN, SSB + (size_t)((LAYER + 1) * 2) * MTOT * 8, (PG8_LAS float*)(F.lds + LDSCTL_OFF + 256)}; GEMM_CALL(pg8::EpiResN, E, ar, WDN, MTOT, DM, DFF, DFF, DFF, (int)blockIdx.x); }
        else { pg8::EpiResN E{nullptr, args.in[iff], nullptr, DM, 0, args.in[57], (pg8::bf16_t*)XN, SSB, (PG8_LAS float*)(F.lds + LDSCTL_OFF + 256)}; GEMM_CALL(pg8::EpiResN, E, ar, WDN, MTOT, DM, DFF, DFF, DFF, (int)blockIdx.x); }
    } PH_END
}
__global__ void __launch_bounds__(NWAVES * 64, 2) mk_fwd(Args args) {
    extern __shared__ __attribute__((aligned(16))) unsigned char lds_[];
    LAS unsigned char* const lds = (LAS unsigned char*)lds_;
    volatile LAS unsigned* MISC = (volatile LAS unsigned*)(lds + LDSCTL_OFF);
    for (int u = threadIdx.x; u < 64; u += NWAVES * 64) ((LAS unsigned*)(lds + LDSCTL_OFF))[u] = 0u;
    __syncthreads();
    const int lo = args.ph_lo, hi = args.ph_hi;
    (void)xcd_barrier_post((unsigned*)(args.ws + WS_CTL) + CW_BAR, MISC + 8);
    int ph = 0;
    run_cvt<0>(args, lds, MISC, ph, lo, hi); run_half<0, 0>(args, lds, MISC, ph, lo, hi); run_half<0, 1>(args, lds, MISC, ph, lo, hi); run_ffn<0>(args, lds, MISC, ph, lo, hi);
    run_cvt<1>(args, lds, MISC, ph, lo, hi); run_half<1, 0>(args, lds, MISC, ph, lo, hi); run_half<1, 1>(args, lds, MISC, ph, lo, hi); run_ffn<1>(args, lds, MISC, ph, lo, hi);
    run_cvt<2>(args, lds, MISC, ph, lo, hi); run_half<2, 0>(args, lds, MISC, ph, lo, hi); run_half<2, 1>(args, lds, MISC, ph, lo, hi); run_ffn<2>(args, lds, MISC, ph, lo, hi);
    run_cvt<3>(args, lds, MISC, ph, lo, hi); run_half<3, 0>(args, lds, MISC, ph, lo, hi); run_half<3, 1>(args, lds, MISC, ph, lo, hi); run_ffn<3>(args, lds, MISC, ph, lo, hi);
    { constexpr int ib = 42, iff = 52; PH_BEGIN ph_final_norm(F, (const bf16*)XN, SSB, out); PH_END }
}
extern "C" void kernel_launch(void* const* d_in, const int* in_sizes, int n_in, void* d_out, int out_size, void* d_ws, size_t ws_size, hipStream_t stream) {
    static int grid = 0;
    if (grid == 0) {
        if (n_in != 58 || out_size != MTOT * DM || ws_size < WS_END) { fprintf(stderr, "kernel_launch: unexpected shapes (n_in %d, out %d, ws %zu)\n", n_in, out_size, ws_size); grid = -1; return; }
        int dev = 0, cus = 0;
        if (hipGetDevice(&dev) != hipSuccess || hipDeviceGetAttribute(&cus, hipDeviceAttributeMultiprocessorCount, dev) != hipSuccess) { grid = -1; return; }
        if (hipFuncSetAttribute((const void*)mk_fwd, hipFuncAttributeMaxDynamicSharedMemorySize, LDS_BYTES) != hipSuccess) { fprintf(stderr, "kernel_launch: hipFuncSetAttribute failed\n"); grid = -1; return; }
        int per_cu = 0;
        (void)hipOccupancyMaxActiveBlocksPerMultiprocessor(&per_cu, (const void*)mk_fwd, NWAVES * 64, LDS_BYTES);
        (void)hipGetLastError();
        grid = cus;
    }
    if (grid < 0) return;
    if (hipMemsetAsync((char*)d_ws + WS_CTL, 0, CTL_ZERO_BYTES, stream) != hipSuccess) return;
    Args a{};
    for (int i = 0; i < 58; ++i) a.in[i] = (const float*)d_in[i];
    a.out = (float*)d_out; a.ws = (unsigned char*)d_ws;
#if MK_ONE_LAUNCH
    a.ph_lo = 0; a.ph_hi = NPH;
    hipLaunchKernelGGL(mk_fwd, dim3(grid), dim3(NWAVES * 64), LDS_BYTES, stream, a);
#else
    for (int p = 0; p < NPH; ++p) { a.ph_lo = p; a.ph_hi = p + 1; hipLaunchKernelGGL(mk_fwd, dim3(grid), dim3(NWAVES * 64), LDS_BYTES, stream, a); }
#endif
}
```

```cpp
#include <hip/hip_runtime.h>
#include <cstdio>
#include <cstdint>
#define DI __device__ __forceinline__
namespace pg8 {
#define PG8_LAS __attribute__((address_space(3)))
typedef unsigned short bf16_t;
typedef short bf16x8 __attribute__((ext_vector_type(8)));
typedef float f32x4 __attribute__((ext_vector_type(4)));
typedef unsigned u32x4 __attribute__((ext_vector_type(4)));
constexpr int BM = 256, BK = 64, HALF = 128, HTB = HALF * BK * 2  , STAGE_BYTES = 8 * HTB, NXCD = 8, WGM = 8;

__host__ __device__ __forceinline__ int lds_byte(int r, int c) { const int st = (r >> 4) * 2 + (c >> 5), rr = r & 15, cc = c & 31, ob = rr * 64 + cc * 2; return st * 1024 + (ob ^ (((ob >> 9) & 1) << 5)); }
__host__ __device__ __forceinline__ void stage_rc(int b, int& R, int& C) { const int st = b / 1024, sb = b % 1024, swz = sb ^ (((sb >> 9) & 1) << 5); R = (st >> 1) * 16 + swz / 64; C = (st & 1) * 32 + (swz % 64) / 2; }
__host__ __device__ __forceinline__ int perm32(int rho) { const int n = rho >> 4, i = rho & 15; return 8 * (i >> 2) + 4 * n + (i & 3); }

struct Unit { int pm, pn; };
struct Gemm { const bf16_t* A; const bf16_t* Bt; int M, N, K, lda, ldb, akoff; };

struct StaticOrder {
    int nM, nN, nwg, G, c;
    __host__ __device__ void init(int M, int N, int G_, int c_) { nM = M / BM; nN = N / BM; nwg = nM * nN; G = G_; c = c_; }
    __host__ __device__ bool next(int i, Unit& u) const {
        const long L = (long)i * G + c; if (L >= nwg) return false;
        int wgid = (int)L; { const int q = nwg / NXCD, r = nwg % NXCD, xcd = wgid % NXCD, off = wgid / NXCD; wgid = (xcd < r ? xcd * (q + 1) : r * (q + 1) + (xcd - r) * q) + off; }
        const int nig = WGM * nN, gid = wgid / nig, fm = gid * WGM, gsz = (nM - fm) < WGM ? (nM - fm) : WGM;
        u.pm = fm + ((wgid % nig) % gsz); u.pn = (wgid % nig) / gsz; return true;
    }
    __device__ __forceinline__ void a_ready(const Unit&) const {}
    __device__ __forceinline__ void done(const Unit&) const {}
};
__device__ __forceinline__ unsigned cvt_pk_bf16(float lo, float hi) { unsigned r; asm volatile("v_cvt_pk_bf16_f32 %0, %1, %2" : "=v"(r) : "v"(lo), "v"(hi)); return r; }
template <class Epi, class Sched, bool ALIGN_EPI = false, bool SP2 = false>
__device__ __forceinline__ void gemm_phase(PG8_LAS unsigned char* lds, const Gemm g, const Sched& S, const Epi& E) {
    const int tid = threadIdx.x, wid = __builtin_amdgcn_readfirstlane(tid >> 6), lane = tid & 63, wr = wid >> 2, wc = wid & 3, fr = lane & 15, fq = lane >> 4;
    const int K = g.K, nt = K / BK;
    unsigned voffA[2], voffB[2];
#pragma unroll
    for (int i = 0; i < 2; ++i) { int R, C; stage_rc(tid * 16 + i * 8192, R, C); const int Rb = Epi::PERM ? ((R & ~31) + perm32(R & 31)) : R;
        voffA[i] = (unsigned)(R * g.lda + C) * 2u; voffB[i] = (unsigned)(Rb * g.ldb + C) * 2u; }
    const size_t kstep = (size_t)(BK * 2);
    const size_t hstepA = (size_t)HALF * g.lda * 2, hstepB = (size_t)HALF * g.ldb * 2;
    const size_t tstepA = 2 * hstepA, tstepB = 2 * hstepB;
    const unsigned ldsw = (unsigned)wid * 1024u;
    const int aoff = lds_byte(wr * 64 + fr, fq * 8), boff = lds_byte(wc * 32 + fr, fq * 8);
#define PG8_SA(b, h) (((b) * 2 + (h)) * HTB)
#define PG8_SB(b, h) ((4 + (b) * 2 + (h)) * HTB)
#define PG8_STAGE(bufoff, gbase, voff) do { _Pragma("unroll") for (int _i = 0; _i < 2; ++_i) \
        __builtin_amdgcn_global_load_lds((const unsigned*)((const char*)(gbase) + (voff)[_i]), (PG8_LAS unsigned*)(lds + (bufoff) + ldsw + _i * 8192), 16, 0, 0); } while (0)
#define PG8_LDA(dst, b, h) do { _Pragma("unroll") for (int m = 0; m < 4; ++m) _Pragma("unroll") for (int k = 0; k < 2; ++k) dst[m][k] = *(const PG8_LAS bf16x8*)(lds + PG8_SA(b, h) + aoff + m * 2048 + k * 1024); } while (0)
#define PG8_LDB(dst, b, h) do { _Pragma("unroll") for (int n = 0; n < 2; ++n) _Pragma("unroll") for (int k = 0; k < 2; ++k) dst[n][k] = *(const PG8_LAS bf16x8*)(lds + PG8_SB(b, h) + boff + n * 2048 + k * 1024); } while (0)
#define PG8_MMA(ai, bj, At, Bt) do { __builtin_amdgcn_s_setprio(1); _Pragma("unroll") for (int m = 0; m < 4; ++m) _Pragma("unroll") for (int n = 0; n < 2; ++n) _Pragma("unroll") for (int k = 0; k < 2; ++k) \
        acc[ai][bj][m][n] = __builtin_amdgcn_mfma_f32_16x16x32_bf16(Bt[n][k], At[m][k], acc[ai][bj][m][n], 0, 0, 0); __builtin_amdgcn_s_setprio(0); } while (0)
#define PG8_WAIT_V(n) asm volatile("s_waitcnt vmcnt(" #n ")" ::: "memory")
#define PG8_WAIT_L(n) asm volatile("s_waitcnt lgkmcnt(" #n ")" ::: "memory")
#define PG8_BAR __builtin_amdgcn_s_barrier()
#define PG8_SCHED __builtin_amdgcn_sched_barrier(0)
    Unit cur, nxt; int ui = 0;
    if (!S.next(0, cur)) return;
    f32x4 acc[2][2][4][2];
#pragma unroll
    for (int a = 0; a < 2; ++a)
#pragma unroll
        for (int b = 0; b < 2; ++b)
#pragma unroll
            for (int m = 0; m < 4; ++m)
#pragma unroll
                for (int n = 0; n < 2; ++n) acc[a][b][m][n] = (f32x4){0.f, 0.f, 0.f, 0.f};
    bf16x8 At[4][2], B0[2][2], B1[2][2];
    const char* cA = (const char*)g.A + (size_t)cur.pm * tstepA + (size_t)cur.pn * g.akoff * 2; const char* cB = (const char*)g.Bt + (size_t)cur.pn * tstepB;
    S.a_ready(cur);
    if constexpr (SP2) {
        PG8_STAGE(PG8_SB(0, 0), cB, voffB); PG8_STAGE(PG8_SB(0, 1), cB + hstepB, voffB); PG8_STAGE(PG8_SA(0, 0), cA, voffA); PG8_STAGE(PG8_SA(0, 1), cA + hstepA, voffA);
        if (wr == 1) PG8_BAR;
        PG8_WAIT_V(2); PG8_BAR;
        PG8_STAGE(PG8_SB(1, 0), cB + kstep, voffB); PG8_STAGE(PG8_SA(1, 0), cA + kstep, voffA); PG8_STAGE(PG8_SB(1, 1), cB + hstepB + kstep, voffB);
        PG8_WAIT_V(6); PG8_BAR;
    } else {
        PG8_STAGE(PG8_SB(0, 0), cB, voffB); PG8_STAGE(PG8_SA(0, 0), cA, voffA); PG8_STAGE(PG8_SB(0, 1), cB + hstepB, voffB); PG8_STAGE(PG8_SA(0, 1), cA + hstepA, voffA);
        if (wr == 1) PG8_BAR;
        PG8_WAIT_V(4); PG8_BAR;
        PG8_STAGE(PG8_SB(1, 0), cB + kstep, voffB); PG8_STAGE(PG8_SA(1, 0), cA + kstep, voffA); PG8_STAGE(PG8_SB(1, 1), cB + hstepB + kstep, voffB);
        PG8_WAIT_V(6); PG8_BAR;
    }
    for (;;) {
        const bool has_next = S.next(ui + 1, nxt);
        const char* nA = has_next ? (const char*)g.A + (size_t)nxt.pm * tstepA + (size_t)nxt.pn * g.akoff * 2 : cA; const char* nB = has_next ? (const char*)g.Bt + (size_t)nxt.pn * tstepB : cB;
        for (int t = 0; t < nt; t += 2) {
            const bool last = (t == nt - 2);
            const char* a1 = cA + (size_t)(t + 1) * kstep;
            const char* a2 = last ? nA : cA + (size_t)(t + 2) * kstep; const char* b2 = last ? nB : cB + (size_t)(t + 2) * kstep;
            const char* a3 = a2 + kstep; const char* b3 = b2 + kstep;
            if (last && has_next) S.a_ready(nxt);
            if constexpr (SP2) {
            PG8_LDB(B0, 0, 0); PG8_LDB(B1, 0, 1); PG8_SCHED; PG8_LDA(At, 0, 0); PG8_STAGE(PG8_SA(1, 1), a1 + hstepA, voffA);
            PG8_WAIT_V(8); PG8_WAIT_L(0); PG8_BAR; PG8_MMA(0, 0, At, B0); PG8_MMA(0, 1, At, B1); PG8_BAR; PG8_SCHED;
            PG8_LDA(At, 0, 1); PG8_STAGE(PG8_SB(0, 0), b2, voffB); PG8_STAGE(PG8_SB(0, 1), b2 + hstepB, voffB); PG8_STAGE(PG8_SA(0, 0), a2, voffA);
            PG8_WAIT_V(8); PG8_WAIT_L(0); PG8_BAR; PG8_MMA(1, 0, At, B0); PG8_MMA(1, 1, At, B1); PG8_BAR; PG8_SCHED;
            PG8_LDB(B0, 1, 0); PG8_LDB(B1, 1, 1); PG8_SCHED; PG8_LDA(At, 1, 0); PG8_STAGE(PG8_SA(0, 1), a2 + hstepA, voffA);
            PG8_WAIT_V(8); PG8_WAIT_L(0); PG8_BAR; PG8_MMA(0, 0, At, B0); PG8_MMA(0, 1, At, B1); PG8_BAR; PG8_SCHED;
            PG8_LDA(At, 1, 1); PG8_STAGE(PG8_SB(1, 0), b3, voffB); PG8_STAGE(PG8_SB(1, 1), b3 + hstepB, voffB); PG8_STAGE(PG8_SA(1, 0), a3, voffA);
            PG8_WAIT_V(8); PG8_WAIT_L(0); PG8_BAR; PG8_MMA(1, 0, At, B0); PG8_MMA(1, 1, At, B1); PG8_BAR; PG8_SCHED;
            } else {
            PG8_LDB(B0, 0, 0); PG8_SCHED; PG8_LDA(At, 0, 0); PG8_STAGE(PG8_SA(1, 1), a1 + hstepA, voffA);
            PG8_WAIT_L(8); PG8_BAR; PG8_WAIT_L(0); PG8_MMA(0, 0, At, B0); PG8_BAR; PG8_SCHED;
            PG8_LDB(B1, 0, 1); PG8_STAGE(PG8_SB(0, 0), b2, voffB);
            PG8_BAR; PG8_WAIT_L(0); PG8_MMA(0, 1, At, B1); PG8_BAR;
            PG8_LDA(At, 0, 1); PG8_STAGE(PG8_SA(0, 0), a2, voffA);
            PG8_BAR; PG8_WAIT_L(0); PG8_MMA(1, 0, At, B0); PG8_BAR; PG8_SCHED;
            PG8_STAGE(PG8_SB(0, 1), b2 + hstepB, voffB);
            PG8_WAIT_V(6); PG8_BAR; PG8_MMA(1, 1, At, B1); PG8_BAR;
            PG8_LDB(B0, 1, 0); PG8_SCHED; PG8_LDA(At, 1, 0); PG8_STAGE(PG8_SA(0, 1), a2 + hstepA, voffA);
            PG8_WAIT_L(8); PG8_BAR; PG8_WAIT_L(0); PG8_MMA(0, 0, At, B0); PG8_BAR; PG8_SCHED;
            PG8_LDB(B1, 1, 1); PG8_STAGE(PG8_SB(1, 0), b3, voffB);
            PG8_BAR; PG8_WAIT_L(0); PG8_MMA(0, 1, At, B1); PG8_BAR;
            PG8_LDA(At, 1, 1); PG8_STAGE(PG8_SA(1, 0), a3, voffA);
            PG8_BAR; PG8_WAIT_L(0); PG8_MMA(1, 0, At, B0); PG8_BAR; PG8_SCHED;
            PG8_STAGE(PG8_SB(1, 1), b3 + hstepB, voffB);
            PG8_WAIT_V(6); PG8_BAR; PG8_MMA(1, 1, At, B1); PG8_BAR;
            }
        }
        if constexpr (ALIGN_EPI) { if (wr == 0) PG8_BAR; }
        if constexpr (!Epi::AFTER_DRAIN) { E(acc, cur, wr, wc, fr, fq); S.done(cur); }
        if (!has_next) break;
#pragma unroll
        for (int a = 0; a < 2; ++a)
#pragma unroll
            for (int b = 0; b < 2; ++b)
#pragma unroll
                for (int m = 0; m < 4; ++m)
#pragma unroll
                    for (int n = 0; n < 2; ++n) acc[a][b][m][n] = (f32x4){0.f, 0.f, 0.f, 0.f};
        cur = nxt; cA = nA; cB = nB; ++ui;
        if constexpr (ALIGN_EPI) { if (wr == 1) PG8_BAR; }
    }
    PG8_WAIT_V(0);
    if constexpr (!ALIGN_EPI) { if (wr == 0) PG8_BAR; }
    PG8_BAR;
    if constexpr (Epi::AFTER_DRAIN) { E.fused(acc, cur, wr, wc, fr, fq, lds, wid, lane); S.done(cur); }
#undef PG8_SA
#undef PG8_SB
#undef PG8_STAGE
#undef PG8_LDA
#undef PG8_LDB
#undef PG8_MMA
#undef PG8_WAIT_V
#undef PG8_WAIT_L
#undef PG8_BAR
#undef PG8_SCHED
}
}
namespace pg8 {
typedef float f32x2 __attribute__((ext_vector_type(2)));
__device__ __forceinline__ float rms_rowscale(const float* ssq, int row) { const f32x4 a = *(const f32x4*)(ssq + (size_t)row * 8), b = *(const f32x4*)(ssq + (size_t)row * 8 + 4);
    return __builtin_amdgcn_rsqf((((a[0] + a[1]) + (a[2] + a[3])) + ((b[0] + b[1]) + (b[2] + b[3]))) * (1.0f / 2048.0f) + 1e-6f); }
struct SegTab { bf16_t* base[8]; int ldc[8]; int t0[8]; int gw[8]; int nseg; int pad_; };
struct EpiBf16R {
    static constexpr bool PERM = true, AFTER_DRAIN = false;
    SegTab T; const float* ssp; int ss_off;
    __device__ __forceinline__ void operator()(const f32x4 (&acc)[2][2][4][2], const Unit& u, int wr, int wc, int fr, int fq) const {
        bf16_t* base = T.base[0]; int ldc = T.ldc[0], gw = T.gw[0], t0 = T.t0[0];
#pragma unroll
        for (int s = 1; s < 8; ++s) if (s < T.nseg && u.pn >= T.t0[s]) { base = T.base[s]; ldc = T.ldc[s]; gw = T.gw[s]; t0 = T.t0[s]; }
        const int colt = (u.pn - t0) * BM, row0 = u.pm * BM + wr * 64 + fr;
        if (gw == -4) {
            typedef unsigned u32x2_ __attribute__((ext_vector_type(2)));
#pragma unroll
            for (int bj = 0; bj < 2; ++bj) { const int col = colt + bj * HALF + wc * 32 + 8 * fq;
                f32x4 c0 = {1.f, 1.f, 1.f, 1.f}, c1 = {1.f, 1.f, 1.f, 1.f};
                if (ssp) {
#pragma unroll
                    for (int j = 0; j < 4; ++j) { c0[j] = rms_rowscale(ssp, ss_off + col + j); c1[j] = rms_rowscale(ssp, ss_off + col + 4 + j); } }
#pragma unroll
                for (int ai = 0; ai < 2; ++ai)
#pragma unroll
                    for (int m = 0; m < 4; ++m) { const int row = row0 + ai * HALF + m * 16;
                        const f32x4 v0 = acc[ai][bj][m][0] * c0, v1 = acc[ai][bj][m][1] * c1;
                        bf16_t* d0 = base + ((size_t)(((((col >> 12) * 16 + (row >> 7)) * 128 + ((col & 4095) >> 5)) * 8 + ((row >> 5) & 3) * 2 + ((col >> 4) & 1)) * 64) + (row & 31)) * 8 + 4 * ((col >> 3) & 1);
                        *(u32x2_*)d0 = (u32x2_){cvt_pk_bf16(v0[0], v0[1]), cvt_pk_bf16(v0[2], v0[3])}; *(u32x2_*)(d0 + 32 * 8) = (u32x2_){cvt_pk_bf16(v1[0], v1[1]), cvt_pk_bf16(v1[2], v1[3])}; } }
            return; }
#pragma unroll
        for (int ai = 0; ai < 2; ++ai)
#pragma unroll
            for (int m = 0; m < 4; ++m) { const int row = row0 + ai * HALF + m * 16;
                const float rs = ssp ? rms_rowscale(ssp, ss_off + row) : 1.0f;
#pragma unroll
                for (int bj = 0; bj < 2; ++bj) { const int col = colt + bj * HALF + wc * 32 + 8 * fq;
                    const f32x4 v0 = acc[ai][bj][m][0] * rs, v1 = acc[ai][bj][m][1] * rs;
                    u32x4 w; w.x = cvt_pk_bf16(v0[0], v0[1]); w.y = cvt_pk_bf16(v0[2], v0[3]); w.z = cvt_pk_bf16(v1[0], v1[1]); w.w = cvt_pk_bf16(v1[2], v1[3]);
                    if (gw == -2) {
                        if ((row >> 5) < ldc) { bf16_t* d0 = base + ((size_t)(((col >> 5) * ldc + (row >> 5)) * 2 + ((col >> 4) & 1)) * 64 + (row & 31)) * 8 + 4 * ((col >> 3) & 1);
                            typedef unsigned u32x2_ __attribute__((ext_vector_type(2)));
                            *(u32x2_*)d0 = (u32x2_){w.x, w.y}; *(u32x2_*)(d0 + 32 * 8) = (u32x2_){w.z, w.w}; }
                        continue; }
                    bf16_t* dst;
                    if (gw == 0) dst = base + (size_t)row * ldc + col;
                    else if (gw == -1) { if ((col >> 4) >= ldc) continue; dst = base + ((size_t)((row >> 5) * ldc + (col >> 4)) * 64 + ((col >> 3) & 1) * 32 + (row & 31)) * 8; }
                    else if (gw == -3) dst = base + ((size_t)(((((row >> 12) * 16 + (col >> 7)) * 128 + ((row & 4095) >> 5)) * 9 + ((col >> 4) & 7)) * 64) + ((col >> 3) & 1) * 32 + (row & 31)) * 8;
                    else { const int g = col / gw, d = col - g * gw; dst = base + ((size_t)((row >> 12) * 4 + g) * 4096 + (row & 4095)) * gw + d; }
                    *(u32x4*)dst = w; } }
    }
};
struct EpiGelu {
    static constexpr bool PERM = true, AFTER_DRAIN = false;
    bf16_t* O; int ldc; const float* bias;
    static __device__ __forceinline__ float gelu(float x) { const float u2 = 1.5957691216f * (x + 0.044715f * x * x * x); const float e = __builtin_amdgcn_exp2f(-u2 * 1.4426950409f); return x * __builtin_amdgcn_rcpf(1.0f + e); }
    __device__ __forceinline__ void operator()(const f32x4 (&acc)[2][2][4][2], const Unit& u, int wr, int wc, int fr, int fq) const {
        const int row0 = u.pm * BM + wr * 64 + fr, col0 = u.pn * BM + wc * 32 + 8 * fq;
#pragma unroll
        for (int bj = 0; bj < 2; ++bj) { const f32x4 b0 = *(const f32x4*)(bias + col0 + bj * HALF), b1 = *(const f32x4*)(bias + col0 + bj * HALF + 4);
#pragma unroll
            for (int ai = 0; ai < 2; ++ai)
#pragma unroll
                for (int m = 0; m < 4; ++m) { const f32x4 v0 = acc[ai][bj][m][0] + b0, v1 = acc[ai][bj][m][1] + b1;
                    u32x4 w; w.x = cvt_pk_bf16(gelu(v0[0]), gelu(v0[1])); w.y = cvt_pk_bf16(gelu(v0[2]), gelu(v0[3])); w.z = cvt_pk_bf16(gelu(v1[0]), gelu(v1[1])); w.w = cvt_pk_bf16(gelu(v1[2]), gelu(v1[3]));
                    *(u32x4*)(O + (size_t)(row0 + ai * HALF + m * 16) * ldc + col0 + bj * HALF) = w; } }
    }
};
struct EpiF32 {
    static constexpr bool PERM = false, AFTER_DRAIN = false;
    float* C; int ldc; const float* ssp; int ss_off;
    __device__ __forceinline__ void operator()(const f32x4 (&acc)[2][2][4][2], const Unit& u, int wr, int wc, int fr, int fq) const {
        const int row0 = u.pm * BM + wr * 64 + fr, col0 = u.pn * BM + wc * 32 + 4 * fq;
#pragma unroll
        for (int ai = 0; ai < 2; ++ai)
#pragma unroll
            for (int m = 0; m < 4; ++m) { float* rowp = C + (size_t)(row0 + ai * HALF + m * 16) * ldc + col0;
                const float rs = ssp ? rms_rowscale(ssp, ss_off + row0 + ai * HALF + m * 16) : 1.0f;
#pragma unroll
                for (int bj = 0; bj < 2; ++bj)
#pragma unroll
                    for (int n = 0; n < 2; ++n) *(f32x4*)(rowp + bj * HALF + n * 16) = acc[ai][bj][m][n] * rs; }
    }
};
struct EpiResN {
    static constexpr bool PERM = false, AFTER_DRAIN = false;
    const float* res32; const float* gprev; float* out32; int ldc; int row_off; const float* g; bf16_t* xn; float* ss; PG8_LAS float* xb;
    __device__ __forceinline__ void operator()(const f32x4 (&acc)[2][2][4][2], const Unit& u, int wr, int wc, int fr, int fq) const {
        typedef unsigned u32x2_ __attribute__((ext_vector_type(2)));
        const int row0 = row_off + u.pm * BM + wr * 64 + fr, col0 = u.pn * BM + wc * 32 + 4 * fq;
        f32x4 gv[2][2], gi[2][2];
#pragma unroll
        for (int bj = 0; bj < 2; ++bj)
#pragma unroll
            for (int n = 0; n < 2; ++n) { gv[bj][n] = g ? *(const f32x4*)(g + col0 + bj * HALF + n * 16) : (f32x4){0.f, 0.f, 0.f, 0.f};
                if (!res32) { const f32x4 t = *(const f32x4*)(gprev + col0 + bj * HALF + n * 16); gi[bj][n] = (f32x4){1.0f / t[0], 1.0f / t[1], 1.0f / t[2], 1.0f / t[3]}; } else gi[bj][n] = (f32x4){1.f, 1.f, 1.f, 1.f}; }
#pragma unroll
        for (int ai = 0; ai < 2; ++ai)
#pragma unroll
            for (int m = 0; m < 4; ++m) { const int row = row0 + ai * HALF + m * 16; const size_t off = (size_t)row * ldc + col0;
                f32x4 r[2][2]; float sq = 0.f;
#pragma unroll
                for (int bj = 0; bj < 2; ++bj)
#pragma unroll
                    for (int n = 0; n < 2; ++n) {
                        if (res32) r[bj][n] = *(const f32x4*)(res32 + off + bj * HALF + n * 16);
                        else { const u32x2_ w = *(const u32x2_*)(xn + off + bj * HALF + n * 16);
                            r[bj][n] = (f32x4){__builtin_bit_cast(float, w.x << 16), __builtin_bit_cast(float, w.x & 0xffff0000u), __builtin_bit_cast(float, w.y << 16), __builtin_bit_cast(float, w.y & 0xffff0000u)} * gi[bj][n]; } }
#pragma unroll
                for (int bj = 0; bj < 2; ++bj)
#pragma unroll
                    for (int n = 0; n < 2; ++n) { const f32x4 o = r[bj][n] + acc[ai][bj][m][n];
                        if (out32) *(f32x4*)(out32 + off + bj * HALF + n * 16) = o;
                        if (g) { sq += (o[0] * o[0] + o[1] * o[1]) + (o[2] * o[2] + o[3] * o[3]);
                            const f32x4 y = o * gv[bj][n]; *(u32x2_*)(xn + off + bj * HALF + n * 16) = (u32x2_){cvt_pk_bf16(y[0], y[1]), cvt_pk_bf16(y[2], y[3])}; } }
                if (g) { sq += __shfl_xor(sq, 16); sq += __shfl_xor(sq, 32);
                    if (fq == 0) xb[(ai * HALF + wr * 64 + m * 16 + fr) * 4 + wc] = sq; }
                asm volatile("" ::: "memory"); }
        if (g) {
            asm volatile("s_waitcnt lgkmcnt(0)" ::: "memory"); __builtin_amdgcn_s_barrier(); asm volatile("" ::: "memory");
            const int t = (wr * 4 + wc) * 64 + fq * 16 + fr;
            if (t < BM) { const f32x4 v = *(const PG8_LAS f32x4*)(xb + t * 4); ss[(size_t)(row_off + u.pm * BM + t) * 8 + u.pn] = (v[0] + v[1]) + (v[2] + v[3]); }
        }
    }
};
struct EpiConvGlu {
    static constexpr bool PERM = true, AFTER_DRAIN = false;
    bf16_t* G; float* UB; const float* cw; const float* cb; PG8_LAS float* xb; int dff; const PG8_LAS float* rstd; int rbase;
    static __device__ __forceinline__ float shr(float old, float src, int n) { const int o = __builtin_bit_cast(int, old), s = __builtin_bit_cast(int, src);
        return __builtin_bit_cast(float, n == 1 ? __builtin_amdgcn_update_dpp(o, s, 0x111, 0xf, 0xf, false) : __builtin_amdgcn_update_dpp(o, s, 0x112, 0xf, 0xf, false)); }
    static __device__ __forceinline__ float ror(float src, int n) { const int s = __builtin_bit_cast(int, src);
        return __builtin_bit_cast(float, n == 1 ? __builtin_amdgcn_update_dpp(0, s, 0x121, 0xf, 0xf, false) : __builtin_amdgcn_update_dpp(0, s, 0x122, 0xf, 0xf, false)); }
    __device__ __forceinline__ void operator()(f32x4 (&acc)[2][2][4][2], const Unit& u, int wr, int wc, int fr, int fq) const {
        typedef unsigned u32x2_ __attribute__((ext_vector_type(2)));
        if (rstd) {
#pragma unroll
            for (int ai = 0; ai < 2; ++ai)
#pragma unroll
                for (int m = 0; m < 4; ++m) { const float rs = rstd[u.pm * BM + ai * HALF + wr * 64 + m * 16 + fr - rbase];
#pragma unroll
                    for (int bj = 0; bj < 2; ++bj)
#pragma unroll
                        for (int n = 0; n < 2; ++n) acc[ai][bj][m][n] = acc[ai][bj][m][n] * rs; }
        }
        if (fr >= 14) {
#pragma unroll
            for (int ai = 0; ai < 2; ++ai)
#pragma unroll
                for (int bj = 0; bj < 2; ++bj)
#pragma unroll
                    for (int n = 0; n < 2; ++n) *(PG8_LAS f32x4*)(xb + (((((ai * 2 + wr) * 4 + wc) * 2 + (fr - 14)) * 4 + fq) * 16) + (bj * 2 + n) * 4) = acc[ai][bj][3][n];
        }
        { const int ncol = 4 * dff / 2;
          const bool top = (wr == 0 && fr < 2), bot = (wr == 1 && fr >= 14);
          if (top || bot) { float* ub = UB + ((size_t)(u.pm * 4 + (top ? fr : 2 + fr - 14)) * ncol) + u.pn * BM + wc * 32 + 8 * fq;
#pragma unroll
            for (int bj = 0; bj < 2; ++bj)
#pragma unroll
                for (int n = 0; n < 2; ++n) *(f32x4*)(ub + bj * HALF + 4 * n) = top ? acc[0][bj][0][n] : acc[1][bj][3][n]; } }
        asm volatile("s_waitcnt lgkmcnt(0)" ::: "memory"); __builtin_amdgcn_s_barrier(); asm volatile("" ::: "memory");
        u32x2_ res[2][4][2];
        const int ch0 = u.pn * HALF + wc * 32 + 8 * fq;
#pragma unroll
        for (int n = 0; n < 2; ++n) {
            const float* wp = cw + ch0 + 4 * n; const float* bp = cb + ch0 + 4 * n;
            const f32x4 w0g = *(const f32x4*)(wp), w1g = *(const f32x4*)(wp + 2 * dff), w2g = *(const f32x4*)(wp + 4 * dff), bg = *(const f32x4*)(bp);
            const f32x4 w0v = *(const f32x4*)(wp + dff), w1v = *(const f32x4*)(wp + 3 * dff), w2v = *(const f32x4*)(wp + 5 * dff), bv = *(const f32x4*)(bp + dff);
#pragma unroll
            for (int ai = 0; ai < 2; ++ai)
#pragma unroll
                for (int m = 0; m < 4; ++m) {
                    const f32x4 cg = acc[ai][0][m][n], cv = acc[ai][1][m][n];
                    f32x4 b1g, b2g, b1v, b2v;
                    if (m > 0) {
#pragma unroll
                        for (int e = 0; e < 4; ++e) { b1g[e] = ror(acc[ai][0][m - 1][n][e], 1); b2g[e] = ror(acc[ai][0][m - 1][n][e], 2); b1v[e] = ror(acc[ai][1][m - 1][n][e], 1); b2v[e] = ror(acc[ai][1][m - 1][n][e], 2); }
                    } else {
                        const int sai = wr ? ai : ai - 1, swr = wr ? 0 : 1;
                        f32x4 x14g = {0.f, 0.f, 0.f, 0.f}, x15g = x14g, x14v = x14g, x15v = x14g;
                        if (sai >= 0) { const PG8_LAS float* xp = xb + (((((sai * 2 + swr) * 4 + wc) * 2) * 4 + fq) * 16);
                            x14g = *(const PG8_LAS f32x4*)(xp + n * 4); x14v = *(const PG8_LAS f32x4*)(xp + (2 + n) * 4); x15g = *(const PG8_LAS f32x4*)(xp + 64 + n * 4); x15v = *(const PG8_LAS f32x4*)(xp + 64 + (2 + n) * 4); }
                        b1g = x15g; b1v = x15v; b2g = fr == 0 ? x14g : x15g; b2v = fr == 0 ? x14v : x15v;
                    }
                    float o[4];
#pragma unroll
                    for (int e = 0; e < 4; ++e) {
                        const float p1g = shr(b1g[e], cg[e], 1), p2g = shr(b2g[e], cg[e], 2), p1v = shr(b1v[e], cv[e], 1), p2v = shr(b2v[e], cv[e], 2);
                        const float yg = bg[e] + w0g[e] * p2g + w1g[e] * p1g + w2g[e] * cg[e], yv = bv[e] + w0v[e] * p2v + w1v[e] * p1v + w2v[e] * cv[e];
                        o[e] = yg * __builtin_amdgcn_rcpf(1.0f + __builtin_amdgcn_exp2f(-yg * 1.4426950409f)) * yv;
                    }
                    res[ai][m][n] = (u32x2_){cvt_pk_bf16(o[0], o[1]), cvt_pk_bf16(o[2], o[3])};
                }
        }
        const int row0 = u.pm * BM + wr * 64 + fr;
#pragma unroll
        for (int ai = 0; ai < 2; ++ai)
#pragma unroll
            for (int m = 0; m < 4; ++m) *(u32x4*)(G + (size_t)(row0 + ai * HALF + m * 16) * dff + ch0) = (u32x4){res[ai][m][0].x, res[ai][m][0].y, res[ai][m][1].x, res[ai][m][1].y};
    }
};
}
constexpr int BATCH = 8, SEQ = 4096, DM = 2048, MTOT = BATCH * SEQ, MC = MTOT / 2  , BPH = BATCH / 2;
constexpr int DFF = 5632;
constexpr float NORM_EPS = 1e-6f, LOG2E = 1.4426950408889634f;
constexpr int NWAVES = 8;
constexpr size_t MiB = 1u << 20;
constexpr size_t WS_CTL = 0, CTL_ZERO_BYTES = 1 * MiB;
constexpr size_t WS_TAB = 1 * MiB;
constexpr size_t TAB_COS48 = WS_TAB, TAB_SIN48 = WS_TAB + 3 * MiB, TAB_COS32 = WS_TAB + 6 * MiB, TAB_SIN32 = WS_TAB + 8 * MiB;
constexpr size_t WS_WMIX = 12 * MiB;
constexpr size_t WS_WFFN = 100 * MiB;
constexpr size_t WS_MISC = 168 * MiB;
constexpr size_t WS_SS = 170 * MiB;
constexpr size_t WS_XNR = 1010 * MiB;
constexpr size_t WS_AR = 234 * MiB;
constexpr size_t WS_END = 1138 * MiB;
constexpr int CW_TMO = 0;
constexpr int CW_BAR = 4096;
constexpr int RING_BYTES = 131072;
constexpr int LDSCTL_OFF = 135168;
constexpr int LDS_BYTES = 163840;

#define GAS __attribute__((address_space(1)))
#define LAS __attribute__((address_space(3)))
typedef unsigned short bf16;
typedef unsigned u32x4 __attribute__((ext_vector_type(4)));
typedef unsigned u32x2 __attribute__((ext_vector_type(2)));
typedef float f32x4 __attribute__((ext_vector_type(4)));
typedef float f32x16 __attribute__((ext_vector_type(16)));
typedef short bf16x8 __attribute__((ext_vector_type(8)));
typedef short s16x4 __attribute__((ext_vector_type(4)));
typedef short v4i16_t __attribute__((ext_vector_type(4)));
typedef __bf16 bf16x2_t __attribute__((ext_vector_type(2)));
typedef float f32x2_t __attribute__((ext_vector_type(2)));
#define LDS_WAIT() asm volatile("s_waitcnt lgkmcnt(0)" ::: "memory")
#define VM_WAIT() asm volatile("s_waitcnt vmcnt(0)" ::: "memory")
#define MFMA32(a, b, c) __builtin_amdgcn_mfma_f32_32x32x16_bf16((a), (b), (c), 0, 0, 0)
DI unsigned pk2(float lo, float hi) { f32x2_t v = {lo, hi}; bf16x2_t b = __builtin_convertvector(v, bf16x2_t); return __builtin_bit_cast(unsigned, b); }
DI float bf2f(unsigned short b) { return __builtin_bit_cast(float, (unsigned)b << 16); }
DI float bflo(unsigned w) { return __builtin_bit_cast(float, w << 16); }
DI float bfhi(unsigned w) { return __builtin_bit_cast(float, w & 0xffff0000u); }
DI unsigned short f2bf(float f) { return (unsigned short)(pk2(f, 0.f) & 0xffffu); }
DI float wave_sum(float v) {
#pragma unroll
    for (int o = 1; o < 64; o <<= 1) v += __shfl_xor(v, o);
    return v;
}
DI int crow(int i, int h) { return (i & 3) + 8 * (i >> 2) + 4 * h; }
#define XB_TMO      128
#define XB_XCNT(j)  (256  + 64 * (j))
#define XB_XSUB(j)  (1280 + 64 * (j))
#define XB_XGEN(j)  (2304 + 64 * (j))
#define XB_TOP      3328
#define XB_TOPGEN   3392
#define XCD_BAR_WORDS 3456
#define XB_SPIN_CAP (1u << 18)

__device__ __forceinline__ unsigned xb_ld(unsigned* p)              { return __hip_atomic_load(p, __ATOMIC_RELAXED, __HIP_MEMORY_SCOPE_AGENT); }
__device__ __forceinline__ unsigned xb_add(unsigned* p, unsigned v) { return __hip_atomic_fetch_add(p, v, __ATOMIC_RELAXED, __HIP_MEMORY_SCOPE_AGENT); }
__device__ __forceinline__ unsigned xb_xcc_id() { return (unsigned)__builtin_amdgcn_s_getreg((3 << 11) | 20) & 0xFu; }
#define XB_SPIN(cond, bar) do { unsigned _sp = 0; while (cond) { __builtin_amdgcn_s_sleep(1); \
    if ((++_sp & 255u) == 0u) { if (xb_ld(&(bar)[XB_TMO])) break; if (_sp > XB_SPIN_CAP) { atomicAdd(&(bar)[XB_TMO], 1u); break; } } } } while (0)

struct XcdBarrier {
    unsigned* bar; unsigned x;
    volatile LAS unsigned* st;
};

__device__ __forceinline__ XcdBarrier xcd_barrier_post(unsigned* bar, volatile LAS unsigned* st) {
    XcdBarrier b; b.bar = bar; b.x = xb_xcc_id(); b.st = st;
    if (threadIdx.x == 0) (void)xb_add(&bar[XB_XCNT(b.x)], 1u);
    return b;
}
__device__ __forceinline__ void xcd_barrier_complete(unsigned* bar, unsigned x, unsigned& nloc, unsigned& nx) {
    const unsigned G = gridDim.x * gridDim.y * gridDim.z;
    unsigned sum, cnt, mine, sp = 0u;
    for (;;) {
        sum = 0u; cnt = 0u; mine = 0u;
#pragma unroll
        for (unsigned j = 0; j < 16; ++j) { const unsigned c = xb_ld(&bar[XB_XCNT(j)]); sum += c; cnt += (c > 0u) ? 1u : 0u; mine = (j == x) ? c : mine; }
        if (sum == G) break;
        __builtin_amdgcn_s_sleep(1);
        if ((++sp & 255u) == 0u) { if (xb_ld(&bar[XB_TMO])) break; if (sp > XB_SPIN_CAP) { atomicAdd(&bar[XB_TMO], 1u); break; } }
    }
    nloc = mine > 0u ? mine : 1u; nx = cnt > 0u ? cnt : 1u;
}

__device__ __forceinline__ void xcd_barrier(const XcdBarrier& b) {
    asm volatile("s_waitcnt vmcnt(0)" ::: "memory");
    __syncthreads();
    if (threadIdx.x == 0) {
        unsigned* bar = b.bar;
        __builtin_amdgcn_s_waitcnt(0);
        unsigned nloc = b.st[0], nx = b.st[1];
        if (nloc == 0u) { xcd_barrier_complete(bar, b.x, nloc, nx); b.st[0] = nloc; b.st[1] = nx; }
        const unsigned old = xb_add(&bar[XB_XSUB(b.x)], 1u);
        const unsigned gen = old / nloc;
        if (old + 1u == (gen + 1u) * nloc) {
            __builtin_amdgcn_fence(__ATOMIC_RELEASE, "agent");
            asm volatile("s_waitcnt vmcnt(0)" ::: "memory");
            const unsigned og = xb_add(&bar[XB_TOP], 1u);
            const unsigned tg = og / nx;
            if (og + 1u == (tg + 1u) * nx) xb_add(&bar[XB_TOPGEN], 1u);
            else XB_SPIN(xb_ld(&bar[XB_TOPGEN]) == tg, bar);
            __builtin_amdgcn_fence(__ATOMIC_ACQUIRE, "agent");
            xb_add(&bar[XB_XGEN(b.x)], 1u);
            asm volatile("s_waitcnt vmcnt(0)" ::: "memory");
        } else {
            XB_SPIN(xb_ld(&bar[XB_XGEN(b.x)]) == gen, bar);
            __builtin_amdgcn_fence(__ATOMIC_ACQUIRE, "agent");
            asm volatile("s_waitcnt vmcnt(0)" ::: "memory");
        }
    }
    __syncthreads();
}
struct Frame {
    LAS unsigned char* lds; unsigned* ctl; unsigned char* ws;
    int tid, lane, wave, G, gw, NGW;
};
DI void ph_tables(const Frame& F, const int* pos) {
    float* c48 = (float*)(F.ws + TAB_COS48); float* s48 = (float*)(F.ws + TAB_SIN48); float* c32 = (float*)(F.ws + TAB_COS32); float* s32 = (float*)(F.ws + TAB_SIN32);
    const int gt = blockIdx.x * (NWAVES * 64) + F.tid, NT = F.G * NWAVES * 64;
    for (int i = gt; i < MTOT * 40; i += NT) {
        const int m = i / 40, j = i - m * 40; const float p = (float)pos[m];
        const bool a = j < 24; const int jj = a ? j : j - 24;
        const float inv = (float)exp(-(2.0 * jj / (a ? 48.0 : 32.0)) * 13.122363377404328);
        const float ang = p * inv; float sn, cs; sincosf(ang, &sn, &cs);
        if (a) { c48[m * 24 + jj] = cs; s48[m * 24 + jj] = sn; } else { c32[m * 16 + jj] = cs; s32[m * 16 + jj] = sn; }
    }
}
DI void cvt_load(float (&v)[32], const float* W, int ldw, int col0, int ncols, int item, int nblk, int lane) {
    const int kb = item / nblk, nb = item - kb * nblk, k0 = 64 * kb, n0 = 32 * nb, nn = n0 + (lane & 31); const bool ok = nn < ncols;
    const float* p = W + (size_t)(k0 + (lane >> 5)) * ldw + col0 + (ok ? nn : 0);
#pragma unroll
    for (int i = 0; i < 32; ++i) { const float x = p[(size_t)(2 * i) * ldw]; v[i] = ok ? x : 0.f; }
}
DI void cvt_store(const float (&v)[32], int ncols, bf16* WT, int ldt, int row_off, float scale, LAS float* scr, int item, int nblk, int lane) {
    const int kb = item / nblk, nb = item - kb * nblk, k0 = 64 * kb, n0 = 32 * nb;
#pragma unroll
    for (int i = 0; i < 32; ++i) scr[(2 * i + (lane >> 5)) * 33 + (lane & 31)] = v[i] * scale;
    LDS_WAIT();
    const int c = lane & 7;
#pragma unroll
    for (int j = 0; j < 4; ++j) { const int n = (lane >> 3) + 8 * j; const LAS float* s = scr + (8 * c) * 33 + n;
        u32x4 o; o.x = pk2(s[0 * 33], s[1 * 33]); o.y = pk2(s[2 * 33], s[3 * 33]); o.z = pk2(s[4 * 33], s[5 * 33]); o.w = pk2(s[6 * 33], s[7 * 33]);
        if (n0 + n < ncols) *(u32x4*)(WT + (size_t)(row_off + n0 + n) * ldt + k0 + 8 * c) = o; }
    LDS_WAIT();
}
DI void cvt_item(const float* W, int ldw, int col0, int ncols, bf16* WT, int ldt, int row_off, float scale, LAS float* scr, int item, int nblk, int lane) {
    float v[32]; cvt_load(v, W, ldw, col0, ncols, item, nblk, lane); cvt_store(v, ncols, WT, ldt, row_off, scale, scr, item, nblk, lane);
}
template <class MAP> DI void cvt_loop(const Frame& F, const float* W, int ldw, int ncols, bf16* WT, int ldt, float scale, int nitems, int nblk, const MAP& map) {
    LAS float* scr = (LAS float*)(F.lds + F.wave * 16384);
    int it = F.gw; float cur[32]; int c0 = 0, ro = 0, li = 0;
    if (it < nitems) { map(it, c0, ro, li); cvt_load(cur, W, ldw, c0, ncols, li, nblk, F.lane); }
#pragma unroll 1
    for (; it < nitems; it += F.NGW) {
        float nxt[32]; int c1 = 0, r1 = 0, l1 = 0; const int ni = it + F.NGW;
        if (ni < nitems) { map(ni, c1, r1, l1); cvt_load(nxt, W, ldw, c1, ncols, l1, nblk, F.lane); }
        cvt_store(cur, ncols, WT, ldt, ro, scale, scr, li, nblk, F.lane);
#pragma unroll
        for (int i = 0; i < 32; ++i) cur[i] = nxt[i];
        c0 = c1; ro = r1; li = l1;
    }
}
struct CvtPlain { int col0, row_off; DI void operator()(int it, int& c, int& r, int& l) const { c = col0; r = row_off; l = it; } };
DI void cvt_job(const Frame& F, const float* W, int ldw, int K, int col0, int ncols, bf16* WT, int ldt, int row_off, float scale) {
    const int nblk = (ncols + 31) / 32;
    cvt_loop(F, W, ldw, ncols, WT, ldt, scale, (K / 64) * nblk, nblk, CvtPlain{col0, row_off});
}
DI void zero_bf16(const Frame& F, bf16* p, size_t nelem) {
    const size_t gt = (size_t)blockIdx.x * (NWAVES * 64) + F.tid, NT = (size_t)F.G * NWAVES * 64;
    for (size_t i = gt; i < nelem / 8; i += NT) ((u32x4*)p)[i] = (u32x4){0u, 0u, 0u, 0u};
}
DI void ph_cvt_ffn(const Frame& F, const float* up, const float* down) {
    bf16* WUP = (bf16*)(F.ws + WS_WFFN); bf16* WDN = WUP + (size_t)2 * DFF * DM;
    struct UpMap { DI void operator()(int it, int& c, int& r, int& l) const { const int seg = it >> 7, pn = seg >> 1, isv = seg & 1; c = isv * DFF + pn * 128; r = pn * 256 + isv * 128; l = it & 127; } };
    cvt_loop(F, up, 2 * DFF, 128, WUP, DM, 1.f, 88 * 128, 4, UpMap{});
    cvt_job(F, down, DM, DFF, 0, DM, WDN, DFF, 0, 1.f);
}
DI void ph_conv_fix(const Frame& F, const float* UB, bf16* Gb, const float* cw, const float* cb, const int nrows = MC) {
    const int gt = blockIdx.x * (NWAVES * 64) + F.tid, NT = F.G * NWAVES * 64;
    for (int it = gt; it < (nrows / 256) * (DFF / 4); it += NT) {
        const int pm = it / (DFF / 4), c4 = it - pm * (DFF / 4), ch = c4 * 4, col = (ch >> 7) * 256 + (ch & 127);
        const float* ub = UB + (size_t)pm * 4 * (2 * DFF) + col; const bool has = (pm & 15) != 0;
        const f32x4 z = {0.f, 0.f, 0.f, 0.f};
        const f32x4 g0 = *(const f32x4*)(ub), g1 = *(const f32x4*)(ub + 2 * DFF), v0 = *(const f32x4*)(ub + 128), v1 = *(const f32x4*)(ub + 2 * DFF + 128);
        const f32x4 gm2 = has ? *(const f32x4*)(ub - 2 * (2 * DFF)) : z, gm1 = has ? *(const f32x4*)(ub - (2 * DFF)) : z, vm2 = has ? *(const f32x4*)(ub - 2 * (2 * DFF) + 128) : z, vm1 = has ? *(const f32x4*)(ub - (2 * DFF) + 128) : z;
        const f32x4 w0g = *(const f32x4*)(cw + ch), w1g = *(const f32x4*)(cw + 2 * DFF + ch), w2g = *(const f32x4*)(cw + 4 * DFF + ch), bg = *(const f32x4*)(cb + ch);
        const f32x4 w0v = *(const f32x4*)(cw + DFF + ch), w1v = *(const f32x4*)(cw + 3 * DFF + ch), w2v = *(const f32x4*)(cw + 5 * DFF + ch), bv = *(const f32x4*)(cb + DFF + ch);
        float o0[4], o1[4];
#pragma unroll
        for (int e = 0; e < 4; ++e) {
            const float yg0 = bg[e] + w0g[e] * gm2[e] + w1g[e] * gm1[e] + w2g[e] * g0[e], yv0 = bv[e] + w0v[e] * vm2[e] + w1v[e] * vm1[e] + w2v[e] * v0[e];
            const float yg1 = bg[e] + w0g[e] * gm1[e] + w1g[e] * g0[e] + w2g[e] * g1[e], yv1 = bv[e] + w0v[e] * vm1[e] + w1v[e] * v0[e] + w2v[e] * v1[e];
            o0[e] = yg0 * __builtin_amdgcn_rcpf(1.0f + __builtin_amdgcn_exp2f(-yg0 * LOG2E)) * yv0; o1[e] = yg1 * __builtin_amdgcn_rcpf(1.0f + __builtin_amdgcn_exp2f(-yg1 * LOG2E)) * yv1;
        }
        u32x2 a, b; a.x = pk2(o0[0], o0[1]); a.y = pk2(o0[2], o0[3]); b.x = pk2(o1[0], o1[1]); b.y = pk2(o1[2], o1[3]);
        *(u32x2*)(Gb + (size_t)(pm * 256) * DFF + ch) = a; *(u32x2*)(Gb + (size_t)(pm * 256 + 1) * DFF + ch) = b;
    }
}
DI void ph_norm_first(const Frame& F, const float* src, const float* gain, bf16* XNR, float* ss) {
    f32x4 g[8];
#pragma unroll
    for (int j = 0; j < 8; ++j) g[j] = *(const f32x4*)(gain + 4 * (F.lane + 64 * j));
    for (int m = F.gw; m < MTOT; m += F.NGW) {
        const f32x4* xr = (const f32x4*)(src + (size_t)m * DM) + F.lane;
        f32x4 v[8]; float s2 = 0.f;
#pragma unroll
        for (int j = 0; j < 8; ++j) { v[j] = xr[64 * j]; s2 += (v[j].x * v[j].x + v[j].y * v[j].y) + (v[j].z * v[j].z + v[j].w * v[j].w); }
        s2 = wave_sum(s2);
        if (F.lane < 2) *(f32x4*)(ss + (size_t)m * 8 + 4 * F.lane) = (f32x4){F.lane == 0 ? s2 : 0.f, 0.f, 0.f, 0.f};
        u32x2* o = (u32x2*)(XNR + (size_t)m * DM) + F.lane;
#pragma unroll
        for (int j = 0; j < 8; ++j) { const f32x4 y = v[j] * g[j]; u32x2 w; w.x = pk2(y.x, y.y); w.y = pk2(y.z, y.w); o[64 * j] = w; }
    }
}
DI void ph_final_norm(const Frame& F, const bf16* xn, const float* ss, float* out) {
    for (int m = F.gw; m < MTOT; m += F.NGW) {
        const float rs = pg8::rms_rowscale(ss, m);
        u32x4 v[4];
#pragma unroll
        for (int j = 0; j < 4; ++j) v[j] = *(const u32x4*)(xn + (size_t)m * DM + j * 512 + F.lane * 8);
#pragma unroll
        for (int j = 0; j < 4; ++j) { float* o = out + (size_t)m * DM + j * 512 + F.lane * 8;
            *(f32x4*)o = (f32x4){__builtin_bit_cast(float, v[j].x << 16), __builtin_bit_cast(float, v[j].x & 0xffff0000u), __builtin_bit_cast(float, v[j].y << 16), __builtin_bit_cast(float, v[j].y & 0xffff0000u)} * rs;
            *(f32x4*)(o + 4) = (f32x4){__builtin_bit_cast(float, v[j].z << 16), __builtin_bit_cast(float, v[j].z & 0xffff0000u), __builtin_bit_cast(float, v[j].w << 16), __builtin_bit_cast(float, v[j].w & 0xffff0000u)} * rs; }
    }
}
DI void rope_piece(const bf16* qrow, int p, const float* cs, const float* sn, float (&o)[8]) {
    const bool lo = p < 3; const int pp = lo ? p + 3 : p - 3, i0 = 8 * (lo ? p : p - 3);
    const u32x4 a = *(const u32x4*)(qrow + 8 * p), b = *(const u32x4*)(qrow + 8 * pp);
    const f32x4 c0 = *(const f32x4*)(cs + i0), c1 = *(const f32x4*)(cs + i0 + 4), s0 = *(const f32x4*)(sn + i0), s1 = *(const f32x4*)(sn + i0 + 4);
#pragma unroll
    for (int e = 0; e < 4; ++e) { const float c_l = e < 2 ? c0[2 * e] : c1[2 * e - 4], c_h = e < 2 ? c0[2 * e + 1] : c1[2 * e - 3], s_l = e < 2 ? s0[2 * e] : s1[2 * e - 4], s_h = e < 2 ? s0[2 * e + 1] : s1[2 * e - 3];
        const float al = bflo(a[e]), ah = bfhi(a[e]), bl_ = bflo(b[e]), bh_ = bfhi(b[e]);
        o[2 * e] = lo ? al * c_l - bl_ * s_l : bl_ * s_l + al * c_l; o[2 * e + 1] = lo ? ah * c_h - bh_ * s_h : bh_ * s_h + ah * c_h; }
}
DI bf16x8 rope_frag32(const bf16* qrow, int s, int h, const float* cs, const float* sn) {
    float o[8]; rope_piece(qrow, 2 * s + h, cs, sn, o);
    u32x4 w; w.x = pk2(o[0], o[1]); w.y = pk2(o[2], o[3]); w.z = pk2(o[4], o[5]); w.w = pk2(o[6], o[7]); return __builtin_bit_cast(bf16x8, w);
}
constexpr size_t DA_DIN = 0, DA_CQN = 64 * MiB, DA_LATC = 80 * MiB, DA_KPE = 88 * MiB, DA_KIDX = 90 * MiB, DA_WIDX = 94 * MiB, DA_QL = 96 * MiB, DA_QPE = 352 * MiB, DA_QIDX = 400 * MiB,
                 DA_SEL = 464 * MiB, DA_CNT = 472 * MiB, DA_SC = 474 * MiB, DA_O2 = 474 * MiB;
constexpr size_t DW_W1 = 0, DW_W2 = (size_t)1024 * 2048, DW_WO = DW_W2 + (size_t)11776 * 512, DW_BD = DW_WO + (size_t)2048 * 4096;
constexpr float DSA_QSCALE = 0.07216878364870322f * LOG2E;
constexpr float DSA_WIDX_SCALE = 0.25f * 0.08838834764831845f;

DI void ph_dsa_cvt(const Frame& F, const float* w_in, const float* w_qup, const float* w_uk, const float* w_uv, const float* w_out) {
    bf16* WB = (bf16*)(F.ws + WS_WMIX);
    cvt_job(F, w_in, 960, DM, 0, 960, WB + DW_W1, DM, 0, 1.f);
    zero_bf16(F, WB + DW_W1 + (size_t)960 * DM, (size_t)64 * DM);
    { LAS float* scr = (LAS float*)(F.lds + F.wave * 16384);
      for (int it = F.gw; it < 32 * 16; it += F.NGW) { const int h = it >> 4; cvt_item(w_qup, 8192, h * 192, 48, WB + DW_W2, 512, 8192 + h * 48, DSA_QSCALE, scr, it & 15, 2, F.lane); } }
    cvt_job(F, w_qup, 8192, 512, 6144, 2048, WB + DW_W2, 512, 9728, 1.f);
    __syncthreads();
    {
        LAS float* As = (LAS float*)F.lds; LAS float* Bs = As + 64 * 145;
        for (int u = blockIdx.x; u < 32 * 4 * 8; u += F.G) {
            const int h = u >> 5, r0 = ((u >> 3) & 3) * 64, k0 = (u & 7) * 64;
            for (int i = F.tid; i < 64 * 144; i += NWAVES * 64) { const int row = i / 144, col = i - row * 144;
                As[row * 145 + col] = w_uk[(size_t)(h * 256 + r0) * 144 + i]; Bs[row * 145 + col] = w_qup[(size_t)(k0 + row) * 8192 + h * 192 + 48 + col]; }
            __syncthreads();
            const int r = F.tid & 63, kg = F.tid >> 6; float acc[8];
#pragma unroll
            for (int j = 0; j < 8; ++j) acc[j] = 0.f;
            for (int n = 0; n < 144; ++n) { const float a = As[r * 145 + n];
#pragma unroll
                for (int j = 0; j < 8; ++j) acc[j] += a * Bs[(kg * 8 + j) * 145 + n]; }
            u32x4 o; o.x = pk2(acc[0] * DSA_QSCALE, acc[1] * DSA_QSCALE); o.y = pk2(acc[2] * DSA_QSCALE, acc[3] * DSA_QSCALE); o.z = pk2(acc[4] * DSA_QSCALE, acc[5] * DSA_QSCALE); o.w = pk2(acc[6] * DSA_QSCALE, acc[7] * DSA_QSCALE);
            *(u32x4*)(WB + DW_W2 + (size_t)(h * 256 + r0 + r) * 512 + k0 + kg * 8) = o;
            __syncthreads();
        }
    }
    { LAS float* scr = (LAS float*)(F.lds + F.wave * 16384);
      for (int it = F.gw; it < 32 * 16; it += F.NGW) { const int h = it >> 4; cvt_item(w_uv + (size_t)h * 256 * 128, 128, 0, 128, WB + DW_BD + (h & 1) * 256, 512, h * 128, 1.f, scr, it & 15, 4, F.lane); } }
    { const size_t gt = (size_t)blockIdx.x * (NWAVES * 64) + F.tid, NT = (size_t)F.G * NWAVES * 64;
      for (size_t i = gt; i < (size_t)4096 * 32; i += NT) { const int row = (int)(i >> 5), pc = (int)(i & 31); *(u32x4*)(WB + DW_BD + (size_t)row * 512 + (1 - ((row >> 7) & 1)) * 256 + pc * 8) = (u32x4){0u, 0u, 0u, 0u}; } }
    cvt_job(F, w_out, DM, 4096, 0, DM, WB + DW_WO, 4096, 0, 1.f);
}
DI void ph_dsa_post1(const Frame& F, int half, const float* qn, const float* kvn, const float* lng, const float* lnb) {
    unsigned char* ar = F.ws + WS_AR;
    const float* DIN = (const float*)(ar + DA_DIN); bf16* CQN = (bf16*)(ar + DA_CQN); bf16* LATC = (bf16*)(ar + DA_LATC); bf16* KPE = (bf16*)(ar + DA_KPE); bf16* KIDX = (bf16*)(ar + DA_KIDX); float* WIDX = (float*)(ar + DA_WIDX);
    const float* c48 = (const float*)(F.ws + TAB_COS48); const float* s48 = (const float*)(F.ws + TAB_SIN48); const float* c32 = (const float*)(F.ws + TAB_COS32); const float* s32 = (const float*)(F.ws + TAB_SIN32);
    LAS float* buf = (LAS float*)(F.lds + F.wave * 1024);
    const int lane = F.lane;
    for (int ml = F.gw; ml < MC; ml += F.NGW) {
        const int mg = half * MC + ml;
        const size_t kfb = ((size_t)(ml >> 5) * 8 * 64 + (ml & 31)) * 8;
        const float* row = DIN + (size_t)ml * 1024 + 16 * lane;
        f32x4 v[4]; float ss = 0.f, s1 = 0.f;
#pragma unroll
        for (int j = 0; j < 4; ++j) { v[j] = *(const f32x4*)(row + 4 * j); ss += (v[j].x * v[j].x + v[j].y * v[j].y) + (v[j].z * v[j].z + v[j].w * v[j].w); s1 += (v[j].x + v[j].y) + (v[j].z + v[j].w); }
        const bool isq = lane < 32, iskv = lane >= 32 && lane < 48, ispe = lane >= 48 && lane < 51, isix = lane >= 51 && lane < 59;
        const float ssq = wave_sum(isq ? ss : 0.f), sskv = wave_sum(iskv ? ss : 0.f), mean = wave_sum(isix ? s1 : 0.f) * (1.f / 128.f);
        float d2 = 0.f;
#pragma unroll
        for (int j = 0; j < 4; ++j) { const f32x4 d = v[j] - mean; d2 += (d.x * d.x + d.y * d.y) + (d.z * d.z + d.w * d.w); }
        const float var = wave_sum(isix ? d2 : 0.f) * (1.f / 128.f);
        const float rq = 1.0f / sqrtf(ssq * (1.f / 512.f) + NORM_EPS), rkv = 1.0f / sqrtf(sskv * (1.f / 256.f) + NORM_EPS), rstd = 1.0f / sqrtf(var + NORM_EPS);
        if (isq || iskv) {
            const float* gp = isq ? qn + 16 * lane : kvn + 16 * (lane - 32); const float rs = isq ? rq : rkv;
            bf16* dst = isq ? CQN + (size_t)ml * 512 + 16 * lane : LATC + (size_t)ml * 256 + 16 * (lane - 32);
            u32x4 o[2];
#pragma unroll
            for (int j = 0; j < 4; ++j) { const f32x4 g = *(const f32x4*)(gp + 4 * j); const f32x4 y = v[j] * rs * g; o[j >> 1][(j & 1) * 2] = pk2(y.x, y.y); o[j >> 1][(j & 1) * 2 + 1] = pk2(y.z, y.w); }
            *(u32x4*)dst = o[0]; *(u32x4*)(dst + 8) = o[1];
        } else if (ispe) {
#pragma unroll
            for (int j = 0; j < 4; ++j) *(LAS f32x4*)(buf + (lane - 48) * 16 + 4 * j) = v[j];
        } else if (isix) {
#pragma unroll
            for (int j = 0; j < 4; ++j) { const f32x4 g = *(const f32x4*)(lng + (lane - 51) * 16 + 4 * j), b = *(const f32x4*)(lnb + (lane - 51) * 16 + 4 * j); *(LAS f32x4*)(buf + 48 + (lane - 51) * 16 + 4 * j) = (v[j] - mean) * rstd * g + b; }
        } else if (lane == 59) {
#pragma unroll
            for (int j = 0; j < 4; ++j) *(f32x4*)(WIDX + (size_t)ml * 16 + 4 * j) = v[j] * DSA_WIDX_SCALE;
        }
        LDS_WAIT();
        if (lane < 24) { const float x1 = buf[lane], x2 = buf[24 + lane], c = c48[(size_t)mg * 24 + lane], s = s48[(size_t)mg * 24 + lane];
            KPE[(size_t)ml * 48 + lane] = f2bf(x1 * c - x2 * s); KPE[(size_t)ml * 48 + 24 + lane] = f2bf(x1 * s + x2 * c);
        } else if (lane < 40) { const int i = lane - 24; const float x1 = buf[48 + i], x2 = buf[48 + 16 + i], c = c32[(size_t)mg * 16 + i], s = s32[(size_t)mg * 16 + i];
            KIDX[kfb + (size_t)((i >> 3) * 32) * 8 + (i & 7)] = f2bf(x1 * c - x2 * s); KIDX[kfb + (size_t)(64 + (i >> 3) * 32) * 8 + (i & 7)] = f2bf(x1 * s + x2 * c);
        } else { const int d = 32 + 4 * (lane - 40); const f32x4 y = *(const LAS f32x4*)(buf + 48 + d); u32x2 w; w.x = pk2(y.x, y.y); w.y = pk2(y.z, y.w); *(u32x2*)(KIDX + kfb + (size_t)((d >> 4) * 64 + ((d >> 3) & 1) * 32) * 8 + (d & 7)) = w; }
        LDS_WAIT();
    }
}
DI int wave_iscan_dpp(int v) {
    v += __builtin_amdgcn_update_dpp(0, v, 0x111, 0xf, 0xf, true); v += __builtin_amdgcn_update_dpp(0, v, 0x112, 0xf, 0xf, true);
    v += __builtin_amdgcn_update_dpp(0, v, 0x114, 0xf, 0xf, true); v += __builtin_amdgcn_update_dpp(0, v, 0x118, 0xf, 0xf, true);
    v += __builtin_amdgcn_update_dpp(0, v, 0x142, 0xa, 0xf, false);
    v += __builtin_amdgcn_update_dpp(0, v, 0x143, 0xc, 0xf, false);
    return v;
}
DI int wave_isum_dpp(int v) {
    v += __builtin_amdgcn_update_dpp(0, v, 0x111, 0xf, 0xf, true); v += __builtin_amdgcn_update_dpp(0, v, 0x112, 0xf, 0xf, true);
    v += __builtin_amdgcn_update_dpp(0, v, 0x114, 0xf, 0xf, true); v += __builtin_amdgcn_update_dpp(0, v, 0x118, 0xf, 0xf, true);
    v += __builtin_amdgcn_update_dpp(0, v, 0x142, 0xa, 0xf, false);
    v += __builtin_amdgcn_update_dpp(0, v, 0x143, 0xc, 0xf, false);
    return __builtin_amdgcn_readlane(v, 63);
}
DI unsigned f2sortable(float s) { const unsigned b = __builtin_bit_cast(unsigned, s); return (b & 0x80000000u) ? ~b : (b | 0x80000000u); }
DI void ph_dsa_index(const Frame& F, const int half) {
    const float* c32 = (const float*)(F.ws + TAB_COS32); const float* s32 = (const float*)(F.ws + TAB_SIN32);
    unsigned char* ar = F.ws + WS_AR;
    const bf16* QIDX = (const bf16*)(ar + DA_QIDX); const bf16* KIDX = (const bf16*)(ar + DA_KIDX); const float* WIDX = (const float*)(ar + DA_WIDX);
    unsigned short* SEL = (unsigned short*)(ar + DA_SEL); int* CNT = (int*)(ar + DA_CNT); float* SC = (float*)(ar + DA_SC) + (size_t)F.gw * 16384;
    const int lane = F.lane, r = lane & 31, hf = lane >> 5;
    LAS unsigned char* wl = F.lds + F.wave * 8192 + lane * 16;
    LAS unsigned* hist = (LAS unsigned*)(F.lds + 65536 + F.wave * 1024);
#pragma unroll 1
    for (int tile = blockIdx.x; tile < BPH * 128; tile += F.G) {
        const int j = tile >> 8, c8 = tile & 255, c7 = c8 & 127, bl = (c8 >> 7) * 2 + j, qt = j ? 127 - c7 : c7;
        const int q0 = qt * 32 + 4 * F.wave;
        const int ntile = (q0 + 3) / 32 + 1;
        bf16x8 qa[2][8];
#pragma unroll
        for (int pr = 0; pr < 2; ++pr) {
            const int mrow = bl * SEQ + q0 + 2 * pr + (r >> 4);
#pragma unroll
            for (int s = 0; s < 8; ++s) qa[pr][s] = *(const bf16x8*)(QIDX + (size_t)mrow * 2048 + (r & 15) * 128 + 16 * s + 8 * hf);
            { const float* cs = c32 + ((size_t)half * MC + mrow) * 16 + 8 * hf; const float* sn = s32 + ((size_t)half * MC + mrow) * 16 + 8 * hf;
              const f32x4 c0 = *(const f32x4*)cs, c1 = *(const f32x4*)(cs + 4), s0 = *(const f32x4*)sn, s1 = *(const f32x4*)(sn + 4);
              const u32x4 a = __builtin_bit_cast(u32x4, qa[pr][0]), b = __builtin_bit_cast(u32x4, qa[pr][1]); u32x4 o1, o2;
#pragma unroll
              for (int e = 0; e < 4; ++e) { const float c_l = e < 2 ? c0[2 * e] : c1[2 * e - 4], c_h = e < 2 ? c0[2 * e + 1] : c1[2 * e - 3], s_l = e < 2 ? s0[2 * e] : s1[2 * e - 4], s_h = e < 2 ? s0[2 * e + 1] : s1[2 * e - 3];
                  const float x1l = bflo(a[e]), x1h = bfhi(a[e]), x2l = bflo(b[e]), x2h = bfhi(b[e]);
                  o1[e] = pk2(x1l * c_l - x2l * s_l, x1h * c_h - x2h * s_h); o2[e] = pk2(x1l * s_l + x2l * c_l, x1h * s_h + x2h * c_h); }
              qa[pr][0] = __builtin_bit_cast(bf16x8, o1); qa[pr][1] = __builtin_bit_cast(bf16x8, o2); }
            float wv[2][16];
#pragma unroll
            for (int i = 0; i < 16; ++i) wv[pr][i] = WIDX[(size_t)(bl * SEQ + q0 + 2 * pr + (i >> 3)) * 16 + (i & 3) + 8 * ((i >> 2) & 1) + 4 * hf];
#pragma unroll
            for (int i = 0; i < 16; i += 4) *(LAS f32x4*)(wl + (pr * 4 + (i >> 2)) * 1024) = (f32x4){wv[pr][i], wv[pr][i + 1], wv[pr][i + 2], wv[pr][i + 3]};
        }
        LDS_WAIT();
        {
        bf16x8 kf[8];
        { const bf16* kp = KIDX + ((size_t)(bl * 128) * 8 * 64 + lane) * 8;
#pragma unroll
          for (int s = 0; s < 8; ++s) kf[s] = *(const bf16x8*)(kp + 512 * s); }
#pragma unroll 1
        for (int t = 0; t < ntile; ++t) {
            f32x16 accs[2];
#pragma unroll
            for (int pr = 0; pr < 2; ++pr) {
#pragma unroll
                for (int i = 0; i < 16; ++i) accs[pr][i] = 0.f;
#pragma unroll
                for (int s = 0; s < 8; ++s) accs[pr] = MFMA32(qa[pr][s], kf[s], accs[pr]);
            }
            if (t + 1 < ntile) { const bf16* kp = KIDX + ((size_t)(bl * 128 + t + 1) * 8 * 64 + lane) * 8;
#pragma unroll
                for (int s = 0; s < 8; ++s) kf[s] = *(const bf16x8*)(kp + 512 * s); }
#pragma unroll
            for (int pr = 0; pr < 2; ++pr) {
                const f32x16 acc = accs[pr];
                float wv[2][16];
                { unsigned wa_ = (unsigned)(size_t)wl; asm volatile("" : "+v"(wa_));
#pragma unroll
                  for (int i = 0; i < 16; i += 4) { const f32x4 w4 = *(const LAS f32x4*)((LAS unsigned char*)(size_t)wa_ + (pr * 4 + (i >> 2)) * 1024); wv[pr][i] = w4.x; wv[pr][i + 1] = w4.y; wv[pr][i + 2] = w4.z; wv[pr][i + 3] = w4.w; } }
                float p0 = 0.f, p1 = 0.f;
#pragma unroll
                for (int i = 0; i < 8; ++i) { p0 += wv[pr][i] * fmaxf(acc[i], 0.f); p1 += wv[pr][8 + i] * fmaxf(acc[8 + i], 0.f); }
                const float t0 = p0 + __shfl_xor(p0, 32), t1 = p1 + __shfl_xor(p1, 32);
                SC[(pr * 128 + t) * 64 + lane] = hf ? t1 : t0;
            }
        }
        }
        VM_WAIT();
#pragma unroll 1
        for (int qi = 0; qi < 4; ++qi) {
            const int tq = q0 + qi, pr = qi >> 1, qs = qi & 1;
            unsigned u[64];
            const unsigned* scp = (const unsigned*)(SC + pr * 8192 + hf * 64 + qs * 32 + r);
#pragma unroll
            for (int g8 = 0; g8 < 8; ++g8) {
#pragma unroll
                for (int e = 0; e < 8; ++e) { const int i = 8 * g8 + e; const float s = __builtin_bit_cast(float, __hip_atomic_load(scp + e * 128, __ATOMIC_RELAXED, __HIP_MEMORY_SCOPE_AGENT));
                    u[i] = (2 * i + hf < ntile && 64 * i + lane <= tq) ? f2sortable(s) : 0u; }
                scp += 1024; asm volatile("" : "+v"(scp));
            }
            unsigned prefix = 0u;
            if (tq >= 256) {
#pragma unroll 1
                for (int bit = 31; bit >= 0; --bit) {
                    const unsigned cand = prefix | (1u << bit); int c = 0;
#pragma unroll
                    for (int g8 = 0; g8 < 8; ++g8) { if (g8 * 512 <= tq) {
#pragma unroll
                        for (int e = 0; e < 8; ++e) c += (u[8 * g8 + e] >= cand) ? 1 : 0; } }
                    c = wave_isum_dpp(c);
                    if (c >= 256) prefix = cand;
                    if (c == 256) break;
                }
            }
            const unsigned T = prefix > 1u ? prefix : 1u;
            int nl = 0;
#pragma unroll
            for (int g8 = 0; g8 < 8; ++g8) { if (g8 * 512 <= tq) {
#pragma unroll
                for (int e = 0; e < 8; ++e) nl += (u[8 * g8 + e] >= T) ? 1 : 0; } }
            const int inc = wave_iscan_dpp(nl), base = __builtin_amdgcn_readlane(inc, 63);
            int pos = inc - nl;
            unsigned short* sel = SEL + (size_t)(bl * SEQ + tq) * 256;
#pragma unroll
            for (int g8 = 0; g8 < 8; ++g8) { if (g8 * 512 <= tq) {
#pragma unroll
                for (int e = 0; e < 8; ++e) { const int i = 8 * g8 + e; if (u[i] >= T) { if (pos < 256) sel[pos] = (unsigned short)(64 * i + lane); ++pos; } } } }
            if (lane == 0) CNT[bl * SEQ + tq] = base < 256 ? base : 256;
        }
    }
}
DI int dsa_fsw(int row) { return ((row & 3) << 2) | ((row >> 2) & 3); }
struct DsaPre { u32x4 row[16]; bf16x8 kpe[3]; bf16x8 q[3]; };
DI void dsa_prefetch(DsaPre& P, const bf16* LATC, const bf16* KPE, const bf16* QL, const bf16* QPE, const float* c48, const float* s48, int half, int ml, int selv, int lane, int w) {
    const int bl = ml >> 12, r = lane & 31, h = lane >> 5;
#pragma unroll
    for (int it = 0; it < 16; ++it) { const int ki = __shfl(selv, (lane >> 5) + 2 * it); P.row[it] = *(const u32x4*)(LATC + (size_t)(bl * SEQ + ki) * 256 + (lane & 31) * 8); }
#pragma unroll
    for (int s = 0; s < 3; ++s) P.kpe[s] = *(const bf16x8*)(KPE + (size_t)(bl * SEQ + selv) * 48 + 16 * s + 8 * h);
#pragma unroll
    for (int j = 0; j < 3; ++j) { const int fi = w + 8 * j;
        if (fi < 16) P.q[j] = *(const bf16x8*)(QL + (size_t)ml * 8192 + r * 256 + 16 * fi + 8 * h);
        else if (fi < 19) P.q[j] = rope_frag32(QPE + (size_t)ml * 1536 + r * 48, fi - 16, h, c48 + ((size_t)half * MC + ml) * 24, s48 + ((size_t)half * MC + ml) * 24); }
}
DI void ph_dsa_attn(const Frame& F, const int half) {
    const float* c48 = (const float*)(F.ws + TAB_COS48); const float* s48 = (const float*)(F.ws + TAB_SIN48);
    unsigned char* ar = F.ws + WS_AR;
    bf16* QL = (bf16*)(ar + DA_QL); const bf16* QPE = (const bf16*)(ar + DA_QPE); const bf16* LATC = (const bf16*)(ar + DA_LATC); const bf16* KPE = (const bf16*)(ar + DA_KPE);
    const unsigned short* SEL = (const unsigned short*)(ar + DA_SEL); const int* CNT = (const int*)(ar + DA_CNT);
    const int lane = F.lane, r = lane & 31, h = lane >> 5, w = F.wave;
    LAS unsigned char* IMG = F.lds; LAS unsigned char* QB = F.lds + LDSCTL_OFF + 256; LAS float* MX = (LAS float*)(F.lds + LDSCTL_OFF + 256 + 19456); LAS float* SX = MX + 256;
    const int i16 = lane & 15, tq_ = i16 >> 2, tp_ = i16 & 3, blk = (lane >> 4) & 1;
    int ml = blockIdx.x;
    if (ml >= MC) return;
    DsaPre P;
    int cnt_c = CNT[ml];
    { const int slot = 32 * w + r; const int selv = slot < cnt_c ? (int)SEL[(size_t)ml * 256 + slot] : 0; dsa_prefetch(P, LATC, KPE, QL, QPE, c48, s48, half, ml, selv, lane, w); }
    int cnt_n = 0, selv_n = 0;
    if (ml + F.G < MC) { cnt_n = CNT[ml + F.G]; const int slot = 32 * w + r; selv_n = slot < cnt_n ? (int)SEL[(size_t)(ml + F.G) * 256 + slot] : 0; }
#pragma unroll 1
    for (; ml < MC; ml += F.G) {
        const int cnt = cnt_c, nch = (cnt + 31) >> 5; const bool act = w < nch;
#pragma unroll
        for (int it = 0; it < 16; ++it) { const int rr = (lane >> 5) + 2 * it; *(LAS u32x4*)(IMG + (32 * w + rr) * 512 + (((lane & 31) ^ dsa_fsw(rr)) * 16)) = P.row[it]; }
#pragma unroll
        for (int j = 0; j < 3; ++j) { const int fi = w + 8 * j; if (fi < 19) *(LAS bf16x8*)(QB + fi * 1024 + lane * 16) = P.q[j]; }
        bf16x8 kpe[3];
#pragma unroll
        for (int s = 0; s < 3; ++s) kpe[s] = P.kpe[s];
        LDS_WAIT(); __builtin_amdgcn_s_barrier(); asm volatile("" ::: "memory");
        if (ml + F.G < MC) {
            dsa_prefetch(P, LATC, KPE, QL, QPE, c48, s48, half, ml + F.G, selv_n, lane, w); cnt_c = cnt_n;
            if (ml + 2 * F.G < MC) { cnt_n = CNT[ml + 2 * F.G]; const int slot = 32 * w + r; selv_n = slot < cnt_n ? (int)SEL[(size_t)(ml + 2 * F.G) * 256 + slot] : 0; }
        }
        f32x16 S; float mx = -INFINITY;
#pragma unroll
        for (int i = 0; i < 16; ++i) S[i] = 0.f;
        if (act) {
#pragma unroll
            for (int s = 0; s < 16; ++s) S = MFMA32(*(const LAS bf16x8*)(IMG + (32 * w + r) * 512 + (((2 * s + h) ^ dsa_fsw(r)) * 16)), *(const LAS bf16x8*)(QB + s * 1024 + lane * 16), S);
#pragma unroll
            for (int s = 0; s < 3; ++s) S = MFMA32(kpe[s], *(const LAS bf16x8*)(QB + (16 + s) * 1024 + lane * 16), S);
#pragma unroll
            for (int i = 0; i < 16; ++i) { S[i] = (32 * w + crow(i, h) < cnt) ? S[i] : -INFINITY; mx = fmaxf(mx, S[i]); }
            mx = fmaxf(mx, __shfl_xor(mx, 32));
        }
        if (h == 0) MX[w * 32 + r] = mx;
        LDS_WAIT(); __builtin_amdgcn_s_barrier(); asm volatile("" ::: "memory");
        float M = MX[r];
#pragma unroll
        for (int k = 1; k < 8; ++k) M = fmaxf(M, MX[k * 32 + r]);
        float lsum = 0.f; bf16x8 pf[2] = {(bf16x8){0, 0, 0, 0, 0, 0, 0, 0}, (bf16x8){0, 0, 0, 0, 0, 0, 0, 0}};
        if (act) {
#pragma unroll
            for (int i = 0; i < 16; ++i) { S[i] = __builtin_amdgcn_exp2f(S[i] - M); lsum += S[i]; }
#pragma unroll
            for (int s = 0; s < 2; ++s) { u32x4 t; t.x = pk2(S[8 * s], S[8 * s + 1]); t.y = pk2(S[8 * s + 2], S[8 * s + 3]); t.z = pk2(S[8 * s + 4], S[8 * s + 5]); t.w = pk2(S[8 * s + 6], S[8 * s + 7]); pf[s] = __builtin_bit_cast(bf16x8, t); }
        }
        lsum += __shfl_xor(lsum, 32);
        if (h == 0) SX[w * 32 + r] = lsum;
        *(LAS bf16x8*)(QB + (2 * w) * 1024 + lane * 16) = pf[0]; *(LAS bf16x8*)(QB + (2 * w + 1) * 1024 + lane * 16) = pf[1];
        LDS_WAIT(); __builtin_amdgcn_s_barrier(); asm volatile("" ::: "memory");
        f32x16 O;
#pragma unroll
        for (int i = 0; i < 16; ++i) O[i] = 0.f;
#pragma unroll 2
        for (int ks = 0; ks < 2 * nch; ++ks) {
            const int r0 = 16 * ks + 4 * h + tq_, r1 = r0 + 8, pc = 4 * w + 2 * blk + (tp_ >> 1);
            const s16x4 lo = __builtin_bit_cast(s16x4, __builtin_amdgcn_ds_read_tr16_b64_v4i16((LAS v4i16_t*)(IMG + r0 * 512 + ((pc ^ dsa_fsw(r0)) * 16) + 8 * (tp_ & 1))));
            const s16x4 hi = __builtin_bit_cast(s16x4, __builtin_amdgcn_ds_read_tr16_b64_v4i16((LAS v4i16_t*)(IMG + r1 * 512 + ((pc ^ dsa_fsw(r1)) * 16) + 8 * (tp_ & 1))));
            O = MFMA32(__builtin_shufflevector(lo, hi, 0, 1, 2, 3, 4, 5, 6, 7), *(const LAS bf16x8*)(QB + ks * 1024 + lane * 16), O);
        }
        float l = SX[r];
#pragma unroll
        for (int k = 1; k < 8; ++k) l += SX[k * 32 + r];
        const float linv = 1.0f / l;
        bf16* o = QL + (size_t)ml * 8192 + r * 256 + 32 * w + 4 * h;
#pragma unroll
        for (int g = 0; g < 4; ++g) { u32x2 t; t.x = pk2(O[4 * g] * linv, O[4 * g + 1] * linv); t.y = pk2(O[4 * g + 2] * linv, O[4 * g + 3] * linv); *(u32x2*)(o + 8 * g) = t; }
        LDS_WAIT(); __builtin_amdgcn_s_barrier(); asm volatile("" ::: "memory");
    }
}
template <int NDB, bool RESC = true> DI void softmax_step(f32x16& S, float& m, float& l, f32x16 (&O)[NDB], bf16x8 (&pf)[2]) {
    float mx = fmaxf(S[0], S[1]);
#pragma unroll
    for (int i = 2; i < 16; i += 2) mx = __builtin_fmaxf(mx, __builtin_fmaxf(S[i], S[i + 1]));
    mx = fmaxf(mx, __shfl_xor(mx, 32));
    const float mn = fmaxf(m, mx), ms = (mn == -INFINITY) ? 0.f : mn;
    const float alpha = __builtin_amdgcn_exp2f(m - ms);
    float sum = 0.f;
#pragma unroll
    for (int i = 0; i < 16; ++i) { S[i] = __builtin_amdgcn_exp2f(S[i] - ms); sum += S[i]; }
    l = l * alpha + sum; m = mn;
    if (RESC && __builtin_amdgcn_ballot_w64(alpha != 1.0f) != 0ull) {
#pragma unroll
        for (int db = 0; db < NDB; ++db)
#pragma unroll
            for (int i = 0; i < 16; ++i) O[db][i] *= alpha;
    }
#pragma unroll
    for (int s = 0; s < 2; ++s) { u32x4 w; w.x = pk2(S[8 * s], S[8 * s + 1]); w.y = pk2(S[8 * s + 2], S[8 * s + 3]); w.z = pk2(S[8 * s + 4], S[8 * s + 5]); w.w = pk2(S[8 * s + 6], S[8 * s + 7]); pf[s] = __builtin_bit_cast(bf16x8, w); }
}
template <bool ACC> DI void store_col(bf16* out, const f32x16 (&O)[4], float scale, int h) {
#pragma unroll
    for (int db = 0; db < 4; ++db)
#pragma unroll
        for (int g = 0; g < 4; ++g) { u32x2* p = (u32x2*)(out + db * 32 + 8 * g + 4 * h);
            float a = O[db][4 * g] * scale, b = O[db][4 * g + 1] * scale, c = O[db][4 * g + 2] * scale, d = O[db][4 * g + 3] * scale;
            if (ACC) { const u32x2 o = *p; a += bflo(o.x); b += bfhi(o.x); c += bflo(o.y); d += bfhi(o.y); }
            u32x2 w; w.x = pk2(a, b); w.y = pk2(c, d); *p = w; }
}
template <int NQ> struct TilePre { u32x4 a, b, c; };
template <int NQ, class SRC> DI void tile_fetch(TilePre<NQ>& p, const SRC& src, int T, int tid) {
    const bf16* k = src.k(T); const bf16* v = src.v(T);
    constexpr int NK = NQ * 64;
    p.a = *(const u32x4*)(k + (size_t)tid * 8);
    const int p1 = tid + 512; p.b = (p1 < NK) ? *(const u32x4*)(k + (size_t)p1 * 8) : *(const u32x4*)(v + (size_t)(p1 - NK) * 8);
    if (NQ * 64 + 512 > 1024) { const int p2 = tid + 1024; if (p2 < NK + 512) p.c = *(const u32x4*)(v + (size_t)(p2 - NK) * 8); }
}
template <int NQ> DI void tile_put(const TilePre<NQ>& p, LAS unsigned char* buf, int tid) {
    *(LAS u32x4*)(buf + tid * 16) = p.a; *(LAS u32x4*)(buf + (tid + 512) * 16) = p.b;
    if (NQ * 64 + 512 > 1024) { if (tid + 1024 < NQ * 64 + 512) *(LAS u32x4*)(buf + (tid + 1024) * 16) = p.c; }
}
template <int NQ, bool PV, class SRC, class MK>
DI void attn_run_sh(LAS unsigned char* tl, int tid, int lane, const bf16x8 (&qf)[NQ], f32x16 (&O)[4], float& m, float& l, int TB, int TE, int tb, int te, const SRC& src, const MK& mk) {
    constexpr int TBYTES = (NQ + 8) * 1024;
    if (TB >= TE) return;
    TilePre<NQ> pre;
    tile_fetch<NQ>(pre, src, TB, tid); tile_put<NQ>(pre, tl, tid);
    LDS_WAIT(); __builtin_amdgcn_s_barrier(); asm volatile("" ::: "memory");
#pragma unroll 1
    for (int T = TB; T < TE; ++T) {
        LAS unsigned char* cur = tl + ((T - TB) & 1) * TBYTES;
        if (T + 1 < TE) tile_fetch<NQ>(pre, src, T + 1, tid);
        if (T >= tb && T < te) {
            f32x16 S;
#pragma unroll
            for (int i = 0; i < 16; ++i) S[i] = 0.f;
#pragma unroll
            for (int s = 0; s < NQ; ++s) S = MFMA32(*(const LAS bf16x8*)(cur + s * 1024 + lane * 16), qf[s], S);
            if (mk.need(T)) mk(T, S);
            bf16x8 pf[2]; softmax_step<4, PV>(S, m, l, O, pf);
            if (PV) {
#pragma unroll
                for (int db = 0; db < 4; ++db)
#pragma unroll
                    for (int s = 0; s < 2; ++s) O[db] = MFMA32(*(const LAS bf16x8*)(cur + (NQ + db * 2 + s) * 1024 + lane * 16), pf[s], O[db]);
            }
        }
        if (T + 1 < TE) tile_put<NQ>(pre, tl + ((T + 1 - TB) & 1) * TBYTES, tid);
        LDS_WAIT(); __builtin_amdgcn_s_barrier(); asm volatile("" ::: "memory");
    }
}
struct FragSrc { const bf16* kb; const bf16* vb; int nq; DI const bf16* k(int T) const { return kb + (size_t)T * nq * 512; } DI const bf16* v(int T) const { return vb + (size_t)T * 8 * 512; } };
constexpr size_t FA_Q = 0, FA_K = 64 * MiB, FA_F = 128 * MiB, FA_V = 136 * MiB, FA_CUM = 200 * MiB, FA_O = 202 * MiB, FA_KF = 266 * MiB, FA_VF = 338 * MiB;
constexpr size_t FW_IN = 0, FW_OUT = (size_t)6400 * 2048;
constexpr float FOX_QSCALE = 0.08838834764831845f * LOG2E;
DI void ph_fox_cvt(const Frame& F, const float* w_in, const float* w_out) {
    bf16* WB = (bf16*)(F.ws + WS_WMIX);
    cvt_job(F, w_in, 6160, DM, 0, 2048, WB + FW_IN, DM, 0, FOX_QSCALE);
    cvt_job(F, w_in, 6160, DM, 2048, 2048, WB + FW_IN, DM, 2048, 1.f);
    cvt_job(F, w_in, 6160, DM, 4096, 2048, WB + FW_IN, DM, 4352, 1.f);
    cvt_job(F, w_in, 6160, DM, 6144, 16, WB + FW_IN, DM, 4096, 1.f);
    zero_bf16(F, WB + FW_IN + (size_t)4112 * DM, (size_t)240 * DM);
    cvt_job(F, w_out, DM, DM, 0, DM, WB + FW_OUT, DM, 0, 1.f);
}
DI void ph_fox_scan(const Frame& F, const float* b_f) {
    unsigned char* ar = F.ws + WS_AR; const bf16* FB = (const bf16*)(ar + FA_F); float* CUM = (float*)(ar + FA_CUM);
    for (int w = F.gw; w < BPH * 16; w += F.NGW) {
        const int bl = w >> 4, hd = w & 15; const float bf_ = b_f[hd];
        float v[64]; float run = 0.f;
#pragma unroll
        for (int i = 0; i < 64; ++i) { const float x = bf2f(FB[(size_t)(bl * SEQ + F.lane * 64 + i) * 256 + hd]) + bf_;
            const float ls = fminf(x, 0.f) - log1pf(expf(-fabsf(x))); run += ls; v[i] = run; }
        float inc = run;
#pragma unroll
        for (int o = 1; o < 64; o <<= 1) { const float y = __shfl_up(inc, o); if (F.lane >= o) inc += y; }
        const float base = inc - run;
        float* dst = CUM + (size_t)w * SEQ + F.lane * 64;
#pragma unroll
        for (int i = 0; i < 64; i += 4) *(f32x4*)(dst + i) = (f32x4){(v[i] + base) * LOG2E, (v[i + 1] + base) * LOG2E, (v[i + 2] + base) * LOG2E, (v[i + 3] + base) * LOG2E};
        bf16* KF9 = (bf16*)(ar + FA_KF) + (size_t)w * 128 * 9 * 512;
#pragma unroll
        for (int i = 0; i < 64; ++i) { const int p = F.lane * 64 + i, tile = p >> 5, r_ = p & 31; const float c = (v[i] + base) * LOG2E;
            const unsigned short hi = f2bf(c); const float c1 = c - bf2f(hi); const unsigned short mid = f2bf(c1); const unsigned short lo = f2bf(c1 - bf2f(mid));
            u32x4 wv; wv.x = 0x3F803F80u; wv.y = 0x3F80u | ((unsigned)(hi ^ 0x8000u) << 16); wv.z = (unsigned)(mid ^ 0x8000u) | ((unsigned)(lo ^ 0x8000u) << 16); wv.w = 0u;
            bf16* d = KF9 + ((size_t)(tile * 9 + 8) * 64 + r_) * 8;
            *(u32x4*)d = wv; *(u32x4*)(d + 32 * 8) = (u32x4){0u, 0u, 0u, 0u}; }
    }
}
struct FoxMK { int tq, h, qt; DI bool need(int t) const { return t == qt; }
    DI void operator()(int t, f32x16& S) const {
#pragma unroll
        for (int i = 0; i < 16; ++i) S[i] = (32 * t + crow(i, h) <= tq) ? S[i] : -INFINITY;
    } };
DI void ph_fox_attn(const Frame& F) {
    unsigned char* ar = F.ws + WS_AR; const bf16* Q = (const bf16*)(ar + FA_Q); const bf16* KF = (const bf16*)(ar + FA_KF); const bf16* VF = (const bf16*)(ar + FA_VF); const float* CUM = (const float*)(ar + FA_CUM); bf16* Ob = (bf16*)(ar + FA_O);
    const int r = F.lane & 31, h = F.lane >> 5;
    for (int wb = blockIdx.x; wb < BPH * 16 * 4; wb += F.G) {
        const int bh = wb >> 2, x = (wb & 3) * 8 + F.wave, bl = bh >> 4, hd = bh & 15;
#pragma unroll 1
        for (int k = 0; k < 4; ++k) {
            const int qt = (k == 0) ? x : (k == 1) ? 63 - x : (k == 2) ? 64 + x : 127 - x;
            const int qhi = (k == 0) ? (wb & 3) * 8 + 7 : (k == 1) ? 63 - (wb & 3) * 8 : (k == 2) ? 64 + (wb & 3) * 8 + 7 : 127 - (wb & 3) * 8;
            const int tq = qt * 32 + r; const size_t mrow = (size_t)bl * SEQ + tq;
            bf16x8 qf[9];
#pragma unroll
            for (int s = 0; s < 8; ++s) qf[s] = *(const bf16x8*)(Q + mrow * DM + hd * 128 + 16 * s + 8 * h);
            { const float ct = CUM[(size_t)bh * SEQ + tq]; const unsigned short hi = f2bf(ct); const float c1 = ct - bf2f(hi); const unsigned short mid = f2bf(c1); const unsigned short lo = f2bf(c1 - bf2f(mid));
              u32x4 wq; wq.x = (unsigned)hi | ((unsigned)mid << 16); wq.y = (unsigned)lo | (0x3F80u << 16); wq.z = 0x3F803F80u; wq.w = 0u;
              if (h) wq = (u32x4){0u, 0u, 0u, 0u};
              qf[8] = __builtin_bit_cast(bf16x8, wq); }
            f32x16 O[4];
#pragma unroll
            for (int db = 0; db < 4; ++db)
#pragma unroll
                for (int i = 0; i < 16; ++i) O[db][i] = 0.f;
            float m = -INFINITY, l = 0.f;
            const FragSrc src{KF + (size_t)bh * 128 * 9 * 512, VF + (size_t)bh * 128 * 8 * 512, 9}; const FoxMK mk{tq, h, qt};
            attn_run_sh<9, true>(F.lds, F.tid, F.lane, qf, O, m, l, 0, qhi + 1, 0, qt + 1, src, mk);
            l += __shfl_xor(l, 32);
            store_col<false>(Ob + mrow * DM + hd * 128, O, l > 0.f ? 1.0f / l : 0.f, h);
        }
    }
}
typedef long fp8x8_t;
DI fp8x8_t pack_fp8x8(float a0, float a1, float a2, float a3, float a4, float a5, float a6, float a7) {
    int lo = 0, hi = 0;
    lo = __builtin_amdgcn_cvt_pk_fp8_f32(a0, a1, lo, false); lo = __builtin_amdgcn_cvt_pk_fp8_f32(a2, a3, lo, true);
    hi = __builtin_amdgcn_cvt_pk_fp8_f32(a4, a5, hi, false); hi = __builtin_amdgcn_cvt_pk_fp8_f32(a6, a7, hi, true);
    return (fp8x8_t)(((unsigned long long)(unsigned)hi << 32) | (unsigned long long)(unsigned)lo);
}
#define MFMA32F8(a, b, c) __builtin_amdgcn_mfma_f32_32x32x16_fp8_fp8((a), (b), (c), 0, 0, 0)
constexpr size_t NA_Q = 0, NA_KC = 288 * MiB, NA_VC = 313 * MiB, NA_KSR = 330 * MiB, NA_KWR = 354 * MiB, NA_GT = 378 * MiB, NA_VSR = 386 * MiB, NA_VWR = 402 * MiB, NA_GK = 418 * MiB, NA_GV = 420 * MiB,
                 NA_KCMP = 422 * MiB, NA_VCT = 424 * MiB, NA_SELB = 426 * MiB, NA_O = 428 * MiB,
                 NA_KSF = 620 * MiB, NA_KWF = 644 * MiB, NA_VSF = 668 * MiB, NA_VWF = 684 * MiB;
constexpr size_t NW_IN = 0, NW_W1K = (size_t)13312 * 2048, NW_W1V = NW_W1K + (size_t)256 * 6144, NW_W2K = NW_W1V + (size_t)256 * 4096, NW_W2V = NW_W2K + 65536, NW_OUT = NW_W2V + 65536;
constexpr float NSA_QSCALE = 0.07216878364870322f * LOG2E;
DI void ph_nsa_cvt(const Frame& F, const float* w_in, const float* k_pe, const float* k_w1, const float* k_b1, const float* k_w2, const float* v_pe, const float* v_w1, const float* v_b1, const float* v_w2, const float* w_out) {
    bf16* WB = (bf16*)(F.ws + WS_WMIX); float* BIAS = (float*)(F.ws + WS_MISC);
    cvt_job(F, w_in, 13200, DM, 0, 9216, WB + NW_IN, DM, 0, NSA_QSCALE);
    cvt_job(F, w_in, 13200, DM, 9216, 768, WB + NW_IN, DM, 9216, 1.f);
    cvt_job(F, w_in, 13200, DM, 9984, 512, WB + NW_IN, DM, 9984, 1.f);
    cvt_job(F, w_in, 13200, DM, 10496, 768, WB + NW_IN, DM, 10496, 1.f);
    cvt_job(F, w_in, 13200, DM, 11776, 768, WB + NW_IN, DM, 11264, 1.f);
    cvt_job(F, w_in, 13200, DM, 13056, 144, WB + NW_IN, DM, 12032, 1.f);
    zero_bf16(F, WB + NW_IN + (size_t)12176 * DM, (size_t)112 * DM);
    cvt_job(F, w_in, 13200, DM, 11264, 512, WB + NW_IN, DM, 12288, 1.f);
    cvt_job(F, w_in, 13200, DM, 12544, 512, WB + NW_IN, DM, 12800, 1.f);
    cvt_job(F, k_w1, 256, 6144, 0, 256, WB + NW_W1K, 6144, 0, 1.f);
    cvt_job(F, v_w1, 256, 4096, 0, 256, WB + NW_W1V, 4096, 0, 1.f);
    cvt_job(F, k_w2, 192, 256, 0, 192, WB + NW_W2K, 256, 0, 1.f); zero_bf16(F, WB + NW_W2K + 192 * 256, 64 * 256);
    cvt_job(F, v_w2, 128, 256, 0, 128, WB + NW_W2V, 256, 0, 1.f); zero_bf16(F, WB + NW_W2V + 128 * 256, 128 * 256);
    cvt_job(F, w_out, DM, 6144, 0, DM, WB + NW_OUT, 6144, 0, 1.f);
    for (int w = F.gw; w < 512; w += F.NGW) { const bool isk = w < 256; const int c = w & 255, n = isk ? 6144 : 4096; const float* pe = isk ? k_pe : v_pe; const float* w1 = isk ? k_w1 : v_w1;
        float s = 0.f; for (int i = F.lane; i < n; i += 64) s += pe[i] * w1[(size_t)i * 256 + c];
        s = wave_sum(s); if (F.lane == 0) BIAS[w] = s + (isk ? k_b1[c] : v_b1[c]); }
}
DI void ph_nsa_rope(const Frame& F, int half) {
    unsigned char* ar = F.ws + WS_AR; bf16* Q = (bf16*)(ar + NA_Q); bf16* KC = (bf16*)(ar + NA_KC);
    const bf16* KSR = (const bf16*)(ar + NA_KSR); const bf16* KWR = (const bf16*)(ar + NA_KWR); bf16* KSF = (bf16*)(ar + NA_KSF); bf16* KWF = (bf16*)(ar + NA_KWF);
    const float* c48 = (const float*)(F.ws + TAB_COS48); const float* s48 = (const float*)(F.ws + TAB_SIN48);
    for (int ml = F.gw; ml < MC; ml += F.NGW) {
        const size_t mg = (size_t)half * MC + ml; const int bl = ml >> 12, sq = ml & 4095;
        for (int p = F.lane; p < 96; p += 64) {
            const int hd = 48 + p / 24, i = p - (p / 24) * 24; bf16* q;
            q = KC + ((size_t)(bl * 4 + hd - 48) * 4096 + sq) * 192 + i;
            const float x1 = bf2f(q[0]), x2 = bf2f(q[24]), c = c48[mg * 24 + i], s = s48[mg * 24 + i]; q[0] = f2bf(x1 * c - x2 * s); q[24] = f2bf(x1 * s + x2 * c);
        }
        const int tile = sq >> 5, rr = sq & 31;
        for (int u = F.lane; u < 168; u += 64) {
            const int tens = u / 84, uu = u - tens * 84, g = uu / 21, v = uu - g * 21;
            const bf16* src = (tens ? KWR : KSR) + (size_t)ml * 768 + g * 192;
            bf16* dst = (tens ? KWF : KSF) + ((size_t)((bl * 4 + g) * 128 + tile) * 12 * 64 + rr) * 8;
            if (v < 3) {
                const u32x4 a = *(const u32x4*)(src + 8 * v), b = *(const u32x4*)(src + 8 * v + 24); u32x4 o1, o2;
#pragma unroll
                for (int e = 0; e < 4; ++e) { const float c0 = c48[mg * 24 + 8 * v + 2 * e], s0 = s48[mg * 24 + 8 * v + 2 * e], c1 = c48[mg * 24 + 8 * v + 2 * e + 1], s1 = s48[mg * 24 + 8 * v + 2 * e + 1];
                    const float x1l = bflo(a[e]), x1h = bfhi(a[e]), x2l = bflo(b[e]), x2h = bfhi(b[e]);
                    o1[e] = pk2(x1l * c0 - x2l * s0, x1h * c1 - x2h * s1); o2[e] = pk2(x1l * s0 + x2l * c0, x1h * s1 + x2h * c1); }
                const int p1 = v, p2 = v + 3;
                if (tens) { *(u32x4*)(dst + ((p1 >> 1) * 64 + (p1 & 1) * 32) * 8) = o1; *(u32x4*)(dst + ((p2 >> 1) * 64 + (p2 & 1) * 32) * 8) = o2; }
                else { unsigned char* d8 = (unsigned char*)KSF + ((size_t)(((bl * 4 + g) * 128 + tile) * 2 + (rr >> 4)) * 6 * 64 + (rr & 15)) * 8;
                    *(fp8x8_t*)(d8 + ((p1 >> 2) * 64 + (p1 & 3) * 16) * 8) = pack_fp8x8(bflo(o1[0]), bfhi(o1[0]), bflo(o1[1]), bfhi(o1[1]), bflo(o1[2]), bfhi(o1[2]), bflo(o1[3]), bfhi(o1[3]));
                    *(fp8x8_t*)(d8 + ((p2 >> 2) * 64 + (p2 & 3) * 16) * 8) = pack_fp8x8(bflo(o2[0]), bfhi(o2[0]), bflo(o2[1]), bfhi(o2[1]), bflo(o2[2]), bfhi(o2[2]), bflo(o2[3]), bfhi(o2[3])); }
            } else { const int pc = v + 3; const u32x4 c = *(const u32x4*)(src + 8 * pc);
                if (tens) *(u32x4*)(dst + ((pc >> 1) * 64 + (pc & 1) * 32) * 8) = c;
                else { unsigned char* d8 = (unsigned char*)KSF + ((size_t)(((bl * 4 + g) * 128 + tile) * 2 + (rr >> 4)) * 6 * 64 + (rr & 15)) * 8;
                    *(fp8x8_t*)(d8 + ((pc >> 2) * 64 + (pc & 3) * 16) * 8) = pack_fp8x8(bflo(c[0]), bfhi(c[0]), bflo(c[1]), bfhi(c[1]), bflo(c[2]), bfhi(c[2]), bflo(c[3]), bfhi(c[3])); } }
        }
    }
    const bf16* VSR = (const bf16*)(ar + NA_VSR); const bf16* VWR = (const bf16*)(ar + NA_VWR); bf16* VSF = (bf16*)(ar + NA_VSF); bf16* VWF = (bf16*)(ar + NA_VWF);
    const int r = F.lane & 31, h = F.lane >> 5;
    for (int u = F.gw; u < 2 * BPH * 4 * 128; u += F.NGW) {
        const int tens = u >> 11, bg = (u >> 7) & 15, tile = u & 127, bl = bg >> 2, g = bg & 3;
        if (tens) {
            const bf16* src = VWR + ((size_t)bl * SEQ + tile * 32) * 512 + g * 128 + r;
            bf16* vd = VWF + (((size_t)bg * 128 + tile) * 8 * 64 + F.lane) * 8;
#pragma unroll
            for (int db = 0; db < 4; ++db)
#pragma unroll
                for (int s = 0; s < 2; ++s) { unsigned short e[8];
#pragma unroll
                    for (int j = 0; j < 8; ++j) e[j] = src[(size_t)(16 * s + 8 * (j >> 2) + 4 * h + (j & 3)) * 512 + db * 32];
                    u32x4 w; w.x = e[0] | ((unsigned)e[1] << 16); w.y = e[2] | ((unsigned)e[3] << 16); w.z = e[4] | ((unsigned)e[5] << 16); w.w = e[6] | ((unsigned)e[7] << 16);
                    *(u32x4*)(vd + (db * 2 + s) * 512) = w; }
        } else {
            const int d16 = F.lane & 15, kq = F.lane >> 4;
            const bf16* src = VSR + ((size_t)bl * SEQ + tile * 32) * 512 + g * 128 + d16;
            unsigned char* vd = (unsigned char*)VSF + (((size_t)bg * 128 + tile) * 8 * 64 + F.lane) * 8;
#pragma unroll
            for (int db = 0; db < 8; ++db) { float e[8];
#pragma unroll
                for (int j = 0; j < 8; ++j) e[j] = bf2f(src[(size_t)((j < 4 ? 4 * kq + j : 16 + 4 * kq + j - 4)) * 512 + db * 16]);
                *(fp8x8_t*)(vd + db * 512) = pack_fp8x8(e[0], e[1], e[2], e[3], e[4], e[5], e[6], e[7]); }
        }
    }
}
DI float sigmoidf_(float x) { return __builtin_amdgcn_rcpf(1.0f + __builtin_amdgcn_exp2f(-x * LOG2E)); }
struct CmpMK { int tq, h, q0; DI bool need(int t) const { return 512 * t + 527 > q0; }
    DI void operator()(int t, f32x16& S) const {
#pragma unroll
    for (int i = 0; i < 16; ++i) { const int n = 32 * t + crow(i, h); S[i] = (16 * n + 31 <= tq) ? S[i] : -INFINITY; } } };
struct WinMK { int tq, h, qt; DI bool need(int t) const { return t == qt || t == qt - 16; }
    DI void operator()(int t, f32x16& S) const {
#pragma unroll
    for (int i = 0; i < 16; ++i) { const int k = 32 * t + crow(i, h); S[i] = (k <= tq && k > tq - 512) ? S[i] : -INFINITY; } } };
DI void ph_nsa_cmp(const Frame& F, const int half) {
    const float* c48 = (const float*)(F.ws + TAB_COS48); const float* s48 = (const float*)(F.ws + TAB_SIN48);
    unsigned char* ar = F.ws + WS_AR; const bf16* Q = (const bf16*)(ar + NA_Q); const bf16* KCMP = (const bf16*)(ar + NA_KCMP); const bf16* VCT = (const bf16*)(ar + NA_VCT); const bf16* GT = (const bf16*)(ar + NA_GT);
    unsigned char* SELB = ar + NA_SELB; bf16* Ob = (bf16*)(ar + NA_O);
    LAS float* imp = (LAS float*)F.lds;
    LAS unsigned char* kres = F.lds + 20480;
    LAS unsigned char* vring = F.lds + 20480 + 98304;
    const int lane = F.lane, r = lane & 31, h = lane >> 5, tid = F.tid;
    for (int u = blockIdx.x; u < BPH * 4 * 64; u += F.G) {
        const int bg = u >> 6, qt64 = ((u >> 8) & 1) ? 63 - (u & 63) : (u & 63), bl = bg >> 2, g = bg & 3;
        const int tqmaxb = qt64 * 64 + 63, TE = (tqmaxb >= 31) ? ((tqmaxb - 31) / 16) / 32 + 1 : 0;
        const bf16* ksrc = KCMP + (size_t)bg * 8 * 12 * 512; const bf16* vsrc = VCT + (size_t)bg * 8 * 8 * 512;
        for (int i = F.tid; i < 64 * 65; i += NWAVES * 64) imp[i] = 0.f;
        for (int p = tid; p < TE * 768; p += NWAVES * 64) *(LAS u32x4*)(kres + p * 16) = *(const u32x4*)(ksrc + (size_t)p * 8);
        __syncthreads();
#pragma unroll 1
        for (int k = 0; k < 3; ++k) {
            const int idx = F.wave * 3 + k, j = idx >> 1, sub = idx & 1, ql = sub * 32 + r, tq = qt64 * 64 + ql, hd = g * 12 + j;
            const size_t mrow = (size_t)bl * SEQ + tq;
            bf16x8 qf[12];
#pragma unroll
            for (int s = 3; s < 12; ++s) qf[s] = *(const bf16x8*)(Q + mrow * 9216 + hd * 192 + 16 * s + 8 * h);
            { const float* cs = c48 + ((size_t)half * MC + mrow) * 24; const float* sn = s48 + ((size_t)half * MC + mrow) * 24;
#pragma unroll
              for (int s = 0; s < 3; ++s) qf[s] = rope_frag32(Q + mrow * 9216 + hd * 192, s, h, cs, sn); }
            const int tqmax = qt64 * 64 + sub * 32 + 31, te = (tqmax >= 31) ? ((tqmax - 31) / 16) / 32 + 1 : 0;
            const CmpMK mk{tq, h, qt64 * 64 + sub * 32};
            float m = -INFINITY, l = 0.f;
            {
                f32x16 Od[4];
#pragma unroll 1
                for (int t = 0; t < te; ++t) {
                    const LAS unsigned char* cur = kres + t * 12288;
                    f32x16 S;
#pragma unroll
                    for (int i = 0; i < 16; ++i) S[i] = 0.f;
#pragma unroll
                    for (int s = 0; s < 12; ++s) S = MFMA32(*(const LAS bf16x8*)(cur + s * 1024 + lane * 16), qf[s], S);
                    if (mk.need(t)) mk(t, S);
                    bf16x8 pfd[2]; softmax_step<4, false>(S, m, l, Od, pfd);
                }
            }
            l += __shfl_xor(l, 32);
            const float linv = l > 0.f ? 1.0f / l : 0.f, ms = (m == -INFINITY) ? 0.f : m;
            f32x16 O[4];
#pragma unroll
            for (int db = 0; db < 4; ++db)
#pragma unroll
                for (int i = 0; i < 16; ++i) O[db][i] = 0.f;
            if (TE > 0) {
                u32x4 pv = *(const u32x4*)(vsrc + (size_t)tid * 8);
                *(LAS u32x4*)(vring + tid * 16) = pv;
                LDS_WAIT(); __builtin_amdgcn_s_barrier(); asm volatile("" ::: "memory");
#pragma unroll 1
                for (int t = 0; t < TE; ++t) {
                    const LAS unsigned char* cur = kres + t * 12288; const LAS unsigned char* vcur = vring + (t & 1) * 8192;
                    if (t + 1 < TE) pv = *(const u32x4*)(vsrc + ((size_t)(t + 1) * 512 + tid) * 8);
                    if (t < te) {
                        f32x16 S;
#pragma unroll
                        for (int i = 0; i < 16; ++i) S[i] = 0.f;
#pragma unroll
                        for (int s = 0; s < 12; ++s) S = MFMA32(*(const LAS bf16x8*)(cur + s * 1024 + lane * 16), qf[s], S);
                        if (mk.need(t)) mk(t, S);
#pragma unroll
                        for (int i = 0; i < 16; ++i) S[i] = __builtin_amdgcn_exp2f(S[i] - ms) * linv;
#pragma unroll
                        for (int g4 = 0; g4 < 4; ++g4) { const float gs = (S[4 * g4] + S[4 * g4 + 1]) + (S[4 * g4 + 2] + S[4 * g4 + 3]); const int mb = 8 * t + 2 * g4 + h;
                            __hip_atomic_fetch_add(imp + ql * 65 + mb, gs, __ATOMIC_RELAXED, __HIP_MEMORY_SCOPE_WORKGROUP);
                            if (mb + 1 < 64) __hip_atomic_fetch_add(imp + ql * 65 + mb + 1, S[4 * g4 + 3], __ATOMIC_RELAXED, __HIP_MEMORY_SCOPE_WORKGROUP); }
                        bf16x8 pf[2];
#pragma unroll
                        for (int s = 0; s < 2; ++s) { u32x4 w; w.x = pk2(S[8 * s], S[8 * s + 1]); w.y = pk2(S[8 * s + 2], S[8 * s + 3]); w.z = pk2(S[8 * s + 4], S[8 * s + 5]); w.w = pk2(S[8 * s + 6], S[8 * s + 7]); pf[s] = __builtin_bit_cast(bf16x8, w); }
#pragma unroll
                        for (int db = 0; db < 4; ++db)
#pragma unroll
                            for (int s = 0; s < 2; ++s) O[db] = MFMA32(*(const LAS bf16x8*)(vcur + (db * 2 + s) * 1024 + lane * 16), pf[s], O[db]);
                    }
                    if (t + 1 < TE) *(LAS u32x4*)(vring + ((t + 1) & 1) * 8192 + tid * 16) = pv;
                    LDS_WAIT(); __builtin_amdgcn_s_barrier(); asm volatile("" ::: "memory");
                }
            }
            const float gate = sigmoidf_(bf2f(GT[mrow * 256 + hd]));
            store_col<false>(Ob + mrow * 6144 + hd * 128, O, gate, h);
        }
        __syncthreads();
#pragma unroll 1
        for (int k = 0; k < 8; ++k) {
            const int ql = F.wave * 8 + k, tq = qt64 * 64 + ql, cur = tq >> 6, mb = lane;
            const bool causal = mb <= cur, forced = (mb == 0) || (mb == cur) || (mb == cur - 1);
            const float v = causal ? (forced ? INFINITY : imp[ql * 65 + mb]) : -INFINITY;
            int rank = 0;
            for (int o = 0; o < 64; ++o) { const float vo = __shfl(v, o); rank += (vo > v || (vo == v && o < mb)) ? 1 : 0; }
            if (rank < 16) SELB[((size_t)bg * 4096 + tq) * 16 + rank] = causal ? (unsigned char)mb : (unsigned char)0xFF;
        }
        __syncthreads();
    }
}
DI int sel_tile(const u32x4& sel, int t) { const int b = t >> 1; const unsigned w = (b < 4) ? sel.x : (b < 8) ? sel.y : (b < 12) ? sel.z : sel.w; return (int)((w >> ((b & 3) * 8)) & 0xFFu) * 2 + (t & 1); }
struct SelMK { u32x4 sel; int tq, h; DI void operator()(int t, f32x16& S) const { const int k0 = sel_tile(sel, t) * 32;
#pragma unroll
    for (int i = 0; i < 16; ++i) S[i] = (k0 + crow(i, h) <= tq) ? S[i] : -INFINITY; } };
typedef float f32x4_ __attribute__((ext_vector_type(4)));
#define MFMA16F8(a, b, c) __builtin_amdgcn_mfma_f32_16x16x32_fp8_fp8((a), (b), (c), 0, 0, 0)
DI void ph_nsa_sel(const Frame& F, const int half) {
    const float* c48 = (const float*)(F.ws + TAB_COS48); const float* s48 = (const float*)(F.ws + TAB_SIN48);
    unsigned char* ar = F.ws + WS_AR; const bf16* Q = (const bf16*)(ar + NA_Q); const unsigned char* KS8 = ar + NA_KSF; const unsigned char* VS8 = ar + NA_VSF; const bf16* GT = (const bf16*)(ar + NA_GT);
    const unsigned char* SELB = ar + NA_SELB; bf16* Ob = (bf16*)(ar + NA_O);
    const int c16 = F.lane & 15, kq = F.lane >> 4; const bool act = c16 < 12;
    for (int it = F.gw; it < BPH * 4 * SEQ; it += F.NGW) {
        const int bg = it >> 12, tq = ((it & 4095) + 256 * bg) & 4095, bl = bg >> 2, g = bg & 3; const size_t mrow = (size_t)bl * SEQ + tq; const int hd = g * 12 + (act ? c16 : 0);
        fp8x8_t qf[6];
#pragma unroll
        for (int s = 0; s < 6; ++s) { const float qs = act ? (1.0f / NSA_QSCALE) : 0.f; const int p = 4 * s + kq;
            if (s < 2 && p < 6) { float o[8]; rope_piece(Q + mrow * 9216 + hd * 192, p, c48 + ((size_t)half * MC + mrow) * 24, s48 + ((size_t)half * MC + mrow) * 24, o);
                qf[s] = pack_fp8x8(o[0] * qs, o[1] * qs, o[2] * qs, o[3] * qs, o[4] * qs, o[5] * qs, o[6] * qs, o[7] * qs); }
            else { const u32x4 q = *(const u32x4*)(Q + mrow * 9216 + hd * 192 + 32 * s + 8 * kq);
                qf[s] = pack_fp8x8(bflo(q[0]) * qs, bfhi(q[0]) * qs, bflo(q[1]) * qs, bfhi(q[1]) * qs, bflo(q[2]) * qs, bfhi(q[2]) * qs, bflo(q[3]) * qs, bfhi(q[3]) * qs); } }
        const u32x4 sel = *(const u32x4*)(SELB + ((size_t)bg * 4096 + tq) * 16);
        const int nv = ((tq >> 6) + 1 < 16) ? (tq >> 6) + 1 : 16, te = 2 * nv;
        const unsigned char* kb = KS8 + ((size_t)bg * 128 * 12 * 64 + F.lane) * 8; const unsigned char* vb = VS8 + ((size_t)bg * 128 * 8 * 64 + F.lane) * 8;
        f32x4_ O[8];
#pragma unroll
        for (int db = 0; db < 8; ++db) O[db] = (f32x4_){0.f, 0.f, 0.f, 0.f};
        float m = -INFINITY, l = 0.f;
        fp8x8_t kfA[12], kfB[12], vfA[8], vfB[8];
        { const unsigned char* kp = kb + (size_t)sel_tile(sel, 0) * 12 * 512; const unsigned char* kp1 = kb + (size_t)sel_tile(sel, 1) * 12 * 512; const unsigned char* vp = vb + (size_t)sel_tile(sel, 0) * 8 * 512;
#pragma unroll
          for (int s = 0; s < 12; ++s) { kfA[s] = *(const fp8x8_t*)(kp + s * 512); kfB[s] = *(const fp8x8_t*)(kp1 + s * 512); }
#pragma unroll
          for (int j = 0; j < 8; ++j) vfA[j] = *(const fp8x8_t*)(vp + j * 512); }
#define SEL_STEP(T_, KF_, VF_, VFN_) do { const int t_ = (T_); const int tile = sel_tile(sel, t_); \
            if (t_ + 1 < te) { const unsigned char* vp = vb + (size_t)sel_tile(sel, t_ + 1) * 8 * 512; _Pragma("unroll") for (int j = 0; j < 8; ++j) VFN_[j] = *(const fp8x8_t*)(vp + j * 512); } \
            f32x4_ S0 = {0.f, 0.f, 0.f, 0.f}, S1 = S0; \
            _Pragma("unroll") for (int s = 0; s < 6; ++s) { S0 = MFMA16F8(KF_[s], qf[s], S0); S1 = MFMA16F8(KF_[6 + s], qf[s], S1); } \
            if (t_ + 2 < te) { const unsigned char* kp = kb + (size_t)sel_tile(sel, t_ + 2) * 12 * 512; _Pragma("unroll") for (int s = 0; s < 12; ++s) KF_[s] = *(const fp8x8_t*)(kp + s * 512); } \
            const int k0 = tile * 32 + 4 * kq; float mx = -INFINITY; \
            _Pragma("unroll") for (int i = 0; i < 4; ++i) { S0[i] = (k0 + i <= tq) ? S0[i] * NSA_QSCALE : -INFINITY; S1[i] = (k0 + 16 + i <= tq) ? S1[i] * NSA_QSCALE : -INFINITY; mx = fmaxf(mx, fmaxf(S0[i], S1[i])); } \
            mx = fmaxf(mx, __shfl_xor(mx, 16)); mx = fmaxf(mx, __shfl_xor(mx, 32)); \
            const float mn = fmaxf(m, mx), ms = (mn == -INFINITY) ? 0.f : mn, alpha = __builtin_amdgcn_exp2f(m - ms); \
            float sum = 0.f; \
            _Pragma("unroll") for (int i = 0; i < 4; ++i) { S0[i] = __builtin_amdgcn_exp2f(S0[i] - ms); S1[i] = __builtin_amdgcn_exp2f(S1[i] - ms); sum += S0[i] + S1[i]; } \
            l = l * alpha + sum; m = mn; \
            if (__builtin_amdgcn_ballot_w64(alpha != 1.0f) != 0ull) { _Pragma("unroll") for (int db = 0; db < 8; ++db) O[db] = O[db] * alpha; } \
            const fp8x8_t p8 = pack_fp8x8(S0[0], S0[1], S0[2], S0[3], S1[0], S1[1], S1[2], S1[3]);       \
            _Pragma("unroll") for (int db = 0; db < 8; ++db) O[db] = MFMA16F8(VF_[db], p8, O[db]); } while (0)
#pragma unroll 1
        for (int t = 0; t < te; t += 2) { SEL_STEP(t, kfA, vfA, vfB); SEL_STEP(t + 1, kfB, vfB, vfA); }
#undef SEL_STEP
        l += __shfl_xor(l, 16); l += __shfl_xor(l, 32);
        if (act) { const float gate = sigmoidf_(bf2f(GT[mrow * 256 + 48 + hd])); const float sc = l > 0.f ? gate / l : 0.f;
            bf16* o = Ob + mrow * 6144 + hd * 128 + 4 * kq;
#pragma unroll
            for (int db = 0; db < 8; ++db) { u32x2* p = (u32x2*)(o + db * 16); const u32x2 prev = *p;
                u32x2 w; w.x = pk2(O[db][0] * sc + bflo(prev.x), O[db][1] * sc + bfhi(prev.x)); w.y = pk2(O[db][2] * sc + bflo(prev.y), O[db][3] * sc + bfhi(prev.y)); *p = w; } }
    }
}
DI void ph_nsa_win(const Frame& F, const int half) {
    const float* c48 = (const float*)(F.ws + TAB_COS48); const float* s48 = (const float*)(F.ws + TAB_SIN48);
    unsigned char* ar = F.ws + WS_AR; const bf16* Q = (const bf16*)(ar + NA_Q); const bf16* KWF = (const bf16*)(ar + NA_KWF); const bf16* VWF = (const bf16*)(ar + NA_VWF); const bf16* GT = (const bf16*)(ar + NA_GT); bf16* Ob = (bf16*)(ar + NA_O);
    const int r = F.lane & 31, h = F.lane >> 5;
    for (int idb = blockIdx.x; idb < BPH * 4 * 3 * 64; idb += F.G) {
        const int qt0 = (((idb & 63) + (idb >> 8)) & 63) * 2, qt = qt0 + (F.wave & 1), rest = idb >> 6, hq = rest % 3, bg = rest / 3, bl = bg >> 2, g = bg & 3, hd = g * 12 + hq * 4 + (F.wave >> 1), tq = qt * 32 + r; const size_t mrow = (size_t)bl * SEQ + tq;
        bf16x8 qf[12];
#pragma unroll
        for (int s = 3; s < 12; ++s) qf[s] = *(const bf16x8*)(Q + mrow * 9216 + hd * 192 + 16 * s + 8 * h);
        { const float* cs = c48 + ((size_t)half * MC + mrow) * 24; const float* sn = s48 + ((size_t)half * MC + mrow) * 24;
#pragma unroll
          for (int s = 0; s < 3; ++s) qf[s] = rope_frag32(Q + mrow * 9216 + hd * 192, s, h, cs, sn); }
        const FragSrc src{KWF + (size_t)bg * 128 * 12 * 512, VWF + (size_t)bg * 128 * 8 * 512, 12}; const WinMK mk{tq, h, qt};
        f32x16 O[4];
#pragma unroll
        for (int db = 0; db < 4; ++db)
#pragma unroll
            for (int i = 0; i < 16; ++i) O[db][i] = 0.f;
        float m = -INFINITY, l = 0.f;
        attn_run_sh<12, true>(F.lds, F.tid, F.lane, qf, O, m, l, qt0 >= 16 ? qt0 - 16 : 0, qt0 + 2, qt >= 16 ? qt - 16 : 0, qt + 1, src, mk);
        l += __shfl_xor(l, 32);
        const float gate = sigmoidf_(bf2f(GT[mrow * 256 + 96 + hd]));
        store_col<true>(Ob + mrow * 6144 + hd * 128, O, l > 0.f ? gate / l : 0.f, h);
    }
}
#ifndef MK_ONE_LAUNCH
#define MK_ONE_LAUNCH 1
#endif
constexpr int NPH = 69;
struct Args { const float* in[58]; float* out; unsigned char* ws; int ph_lo, ph_hi; };
#define GEMM_AKOFF 0
#define GEMM_CALL(EpiT, Evar, Aptr, Bptr, Mv, Nv, Kv, ldav, ldbv, cidx) do { const pg8::Gemm g_{(const pg8::bf16_t*)(Aptr), (const pg8::bf16_t*)(Bptr), (Mv), (Nv), (Kv), (ldav), (ldbv), GEMM_AKOFF}; \
    pg8::StaticOrder S_; S_.init((Mv), (Nv), F.G, (cidx)); pg8::gemm_phase<EpiT, pg8::StaticOrder, true, true>((PG8_LAS unsigned char*)F.lds, g_, S_, Evar); } while (0)
DI pg8::EpiBf16R epi1(bf16* base, int ldc) { pg8::EpiBf16R e; for (int s = 0; s < 8; ++s) { e.T.base[s] = base; e.T.ldc[s] = ldc; e.T.t0[s] = 0; e.T.gw[s] = 0; } e.T.nseg = 1; e.T.pad_ = 0; e.ssp = nullptr; e.ss_off = 0; return e; }
#define PH_BEGIN if (ph >= lo && ph < hi) { Frame F; { unsigned long long w_ = (unsigned long long)args.ws; asm volatile("" : "+s"(w_)); F.ws = (unsigned char*)w_; F.ctl = (unsigned*)(F.ws + WS_CTL); } \
    F.lds = lds; F.tid = threadIdx.x; F.lane = F.tid & 63; F.wave = __builtin_amdgcn_readfirstlane(F.tid >> 6); F.G = gridDim.x; F.gw = blockIdx.x * NWAVES + F.wave; F.NGW = F.G * NWAVES; \
    float* out; { unsigned long long o_ = (unsigned long long)args.out; asm volatile("" : "+s"(o_)); out = (float*)o_; } \
    unsigned char* const ar = F.ws + WS_AR; bf16* const XN = (bf16*)(F.ws + WS_XNR); float* const SSB = (float*)(F.ws + WS_SS); bf16* const WB = (bf16*)(F.ws + WS_WMIX); bf16* const WUP = (bf16*)(F.ws + WS_WFFN); bf16* const WDN = WUP + (size_t)2 * DFF * DM; \
    const float* const res_mix = (ib == 2) ? args.in[0] : (const float*)out; (void)ar; (void)XN; (void)SSB; (void)WB; (void)WUP; (void)WDN; (void)res_mix; (void)iff;
#define PH_END   if (ph + 1 < hi) { XcdBarrier b_; b_.bar = (unsigned*)F.ctl + CW_BAR; b_.x = xb_xcc_id(); b_.st = MISC + 8; xcd_barrier(b_); } } ++ph;
template <int LAYER> DI void run_cvt(const Args& args, LAS unsigned char* lds, volatile LAS unsigned* MISC, int& ph, const int lo, const int hi) {
    constexpr int ib = (LAYER == 0) ? 2 : (LAYER == 1) ? 17 : (LAYER == 2) ? 26 : 42;
    constexpr int iff = (LAYER == 0) ? 12 : (LAYER == 1) ? 21 : (LAYER == 2) ? 37 : 52;
    constexpr int kind = (LAYER == 1) ? 1 : (LAYER == 2) ? 2 : 0;
        PH_BEGIN
            if constexpr (LAYER == 0) { ph_tables(F, (const int*)args.in[1]); ph_norm_first(F, args.in[0], args.in[2], XN, SSB); }
            if constexpr (kind == 0) ph_dsa_cvt(F, args.in[ib + 1], args.in[ib + 6], args.in[ib + 7], args.in[ib + 8], args.in[ib + 9]);
            else if constexpr (kind == 1) ph_fox_cvt(F, args.in[ib + 1], args.in[ib + 3]);
            else ph_nsa_cvt(F, args.in[ib + 1], args.in[ib + 2], args.in[ib + 3], args.in[ib + 4], args.in[ib + 5], args.in[ib + 6], args.in[ib + 7], args.in[ib + 8], args.in[ib + 9], args.in[ib + 10]);
            ph_cvt_ffn(F, args.in[iff + 1], args.in[iff + 4]);
        PH_END
}
template <int LAYER, int HALF> DI void run_half(const Args& args, LAS unsigned char* lds, volatile LAS unsigned* MISC, int& ph, const int lo, const int hi) {
    constexpr int ib = (LAYER == 0) ? 2 : (LAYER == 1) ? 17 : (LAYER == 2) ? 26 : 42;
    constexpr int iff = (LAYER == 0) ? 12 : (LAYER == 1) ? 21 : (LAYER == 2) ? 37 : 52;
    constexpr int kind = (LAYER == 1) ? 1 : (LAYER == 2) ? 2 : 0;
    constexpr int half = HALF;
            const int roff = half * MC;
            if constexpr (kind == 0) {
                PH_BEGIN { pg8::EpiF32 E{(float*)(ar + DA_DIN), 1024, SSB + (size_t)(LAYER * 2) * MTOT * 8, roff}; GEMM_CALL(pg8::EpiF32, E, XN + (size_t)roff * DM, WB + DW_W1, MC, 1024, DM, DM, DM, (int)blockIdx.x); } PH_END
                PH_BEGIN ph_dsa_post1(F, half, args.in[ib + 2], args.in[ib + 3], args.in[ib + 4], args.in[ib + 5]); PH_END
                PH_BEGIN { pg8::EpiBf16R E = epi1((bf16*)(ar + DA_QL), 8192); E.T.base[1] = (bf16*)(ar + DA_QPE); E.T.ldc[1] = 1536; E.T.t0[1] = 32; E.T.base[2] = (bf16*)(ar + DA_QIDX); E.T.ldc[2] = 2048; E.T.t0[2] = 38; E.T.nseg = 3;
                    GEMM_CALL(pg8::EpiBf16R, E, ar + DA_CQN, WB + DW_W2, MC, 11776, 512, 512, 512, (int)blockIdx.x); } PH_END
                PH_BEGIN ph_dsa_index(F, half); PH_END
                PH_BEGIN ph_dsa_attn(F, half); PH_END
                PH_BEGIN {
                    pg8::EpiBf16R E = epi1((bf16*)(ar + DA_O2), 4096);
                    { const pg8::Gemm g_{(const pg8::bf16_t*)(ar + DA_QL), (const pg8::bf16_t*)(WB + DW_BD), MC, 4096, 512, 8192, 512, 512}; pg8::StaticOrder S_; S_.init(MC, 4096, F.G, (int)blockIdx.x);
                      pg8::gemm_phase<pg8::EpiBf16R, pg8::StaticOrder, true, true>((PG8_LAS unsigned char*)F.lds, g_, S_, E); } } PH_END
                PH_BEGIN { pg8::EpiResN E{LAYER == 0 ? args.in[0] : nullptr, args.in[ib], nullptr, DM, roff, args.in[iff], (pg8::bf16_t*)XN, SSB + (size_t)(LAYER * 2 + 1) * MTOT * 8, (PG8_LAS float*)(F.lds + LDSCTL_OFF + 256)}; GEMM_CALL(pg8::EpiResN, E, ar + DA_O2, WB + DW_WO, MC, DM, 4096, 4096, 4096, (int)blockIdx.x); } PH_END
            } else if constexpr (kind == 1) {
                PH_BEGIN {
                    { pg8::EpiBf16R E = epi1((bf16*)(ar + FA_Q), DM); E.T.base[1] = (bf16*)(ar + FA_KF); E.T.ldc[1] = 9; E.T.t0[1] = 8; E.T.gw[1] = -3;
                      E.T.base[2] = (bf16*)(ar + FA_F); E.T.ldc[2] = 256; E.T.t0[2] = 16; E.T.nseg = 3; E.ssp = SSB + (size_t)(LAYER * 2) * MTOT * 8; E.ss_off = roff;
                      GEMM_CALL(pg8::EpiBf16R, E, XN + (size_t)roff * DM, WB + FW_IN, MC, 4352, DM, DM, DM, (int)blockIdx.x); }
                    { pg8::EpiBf16R E = epi1((bf16*)(ar + FA_VF), 8); E.T.gw[0] = -4; E.ssp = SSB + (size_t)(LAYER * 2) * MTOT * 8; E.ss_off = roff;
                      GEMM_CALL(pg8::EpiBf16R, E, WB + FW_IN + (size_t)4352 * DM, XN + (size_t)roff * DM, DM, MC, DM, DM, DM, (int)((blockIdx.x + F.G - 64) % F.G)); }
                } PH_END
                PH_BEGIN ph_fox_scan(F, args.in[ib + 2]); PH_END
                PH_BEGIN ph_fox_attn(F); PH_END
                PH_BEGIN { pg8::EpiResN E{LAYER == 0 ? args.in[0] : nullptr, args.in[ib], nullptr, DM, roff, args.in[iff], (pg8::bf16_t*)XN, SSB + (size_t)(LAYER * 2 + 1) * MTOT * 8, (PG8_LAS float*)(F.lds + LDSCTL_OFF + 256)}; GEMM_CALL(pg8::EpiResN, E, ar + FA_O, WB + FW_OUT, MC, DM, DM, DM, DM, (int)blockIdx.x); } PH_END
            } else {
                PH_BEGIN { pg8::EpiBf16R E = epi1((bf16*)(ar + NA_Q), 9216);
                    E.T.base[1] = (bf16*)(ar + NA_KC); E.T.ldc[1] = 192; E.T.t0[1] = 36; E.T.gw[1] = 192;
                    E.T.base[2] = (bf16*)(ar + NA_VC); E.T.ldc[2] = 128; E.T.t0[2] = 39; E.T.gw[2] = 128;
                    E.T.base[3] = (bf16*)(ar + NA_KSR); E.T.ldc[3] = 768; E.T.t0[3] = 41;
                    E.T.base[4] = (bf16*)(ar + NA_KWR); E.T.ldc[4] = 768; E.T.t0[4] = 44;
                    E.T.base[5] = (bf16*)(ar + NA_GT); E.T.ldc[5] = 256; E.T.t0[5] = 47;
                    E.T.base[6] = (bf16*)(ar + NA_VSR); E.T.ldc[6] = 512; E.T.t0[6] = 48;
                    E.T.base[7] = (bf16*)(ar + NA_VWR); E.T.ldc[7] = 512; E.T.t0[7] = 50; E.T.nseg = 8; E.ssp = SSB + (size_t)(LAYER * 2) * MTOT * 8; E.ss_off = roff;
                    GEMM_CALL(pg8::EpiBf16R, E, XN + (size_t)roff * DM, WB + NW_IN, MC, 13312, DM, DM, DM, (int)blockIdx.x); } PH_END
                PH_BEGIN ph_nsa_rope(F, half); PH_END
                PH_BEGIN {
                    const float* BIAS = (const float*)(args.ws + WS_MISC);
                    { pg8::EpiGelu E{(bf16*)(ar + NA_GK), 256, BIAS}; GEMM_CALL(pg8::EpiGelu, E, ar + NA_KC, WB + NW_W1K, 4096, 256, 6144, 3072, 6144, (int)blockIdx.x); }
                    { pg8::EpiGelu E{(bf16*)(ar + NA_GV), 256, BIAS + 256}; GEMM_CALL(pg8::EpiGelu, E, ar + NA_VC, WB + NW_W1V, 4096, 256, 4096, 2048, 4096, (int)((blockIdx.x + F.G - 16) % F.G)); }
                } PH_END
                PH_BEGIN {
                    { pg8::EpiBf16R E = epi1((bf16*)(ar + NA_KCMP), 12); E.T.gw[0] = -1; GEMM_CALL(pg8::EpiBf16R, E, ar + NA_GK, WB + NW_W2K, 4096, 256, 256, 256, 256, (int)blockIdx.x); }
                    { pg8::EpiBf16R E = epi1((bf16*)(ar + NA_VCT), 4); E.T.gw[0] = -2; GEMM_CALL(pg8::EpiBf16R, E, WB + NW_W2V, ar + NA_GV, 256, 4096, 256, 256, 256, (int)((blockIdx.x + F.G - 16) % F.G)); }
                } PH_END
                PH_BEGIN ph_nsa_cmp(F, half); PH_END
                PH_BEGIN ph_nsa_sel(F, half); PH_END
                PH_BEGIN ph_nsa_win(F, half); PH_END
                PH_BEGIN { pg8::EpiResN E{LAYER == 0 ? args.in[0] : nullptr, args.in[ib], nullptr, DM, roff, args.in[iff], (pg8::bf16_t*)XN, SSB + (size_t)(LAYER * 2 + 1) * MTOT * 8, (PG8_LAS float*)(F.lds + LDSCTL_OFF + 256)}; GEMM_CALL(pg8::EpiResN, E, ar + NA_O, WB + NW_OUT, MC, DM, 6144, 6144, 6144, (int)blockIdx.x); } PH_END
            }
}
template <int LAYER> DI void run_ffn(const Args& args, LAS unsigned char* lds, volatile LAS unsigned* MISC, int& ph, const int lo, const int hi) {
    constexpr int ib = (LAYER == 0) ? 2 : (LAYER == 1) ? 17 : (LAYER == 2) ? 26 : 42;
    constexpr int iff = (LAYER == 0) ? 12 : (LAYER == 1) ? 21 : (LAYER == 2) ? 37 : 52;
    PH_BEGIN {
        LAS float* rt = (LAS float*)(F.lds + LDSCTL_OFF + 256 + 8192); const int rbase = 4096 * (int)(blockIdx.x & 7); const float* ssq = SSB + (size_t)(LAYER * 2 + 1) * MTOT * 8;
        for (int i = F.tid; i < 4096; i += NWAVES * 64) rt[i] = pg8::rms_rowscale(ssq, rbase + i);
        __syncthreads();
        pg8::EpiConvGlu E{(pg8::bf16_t*)ar, (float*)(ar + 352 * MiB), args.in[iff + 2], args.in[iff + 3], (PG8_LAS float*)(F.lds + LDSCTL_OFF + 256), DFF, (const PG8_LAS float*)rt, rbase};
        GEMM_CALL(pg8::EpiConvGlu, E, XN, WUP, MTOT, 2 * DFF, DM, DM, DM, (int)blockIdx.x); } PH_END
    PH_BEGIN ph_conv_fix(F, (const float*)(ar + 352 * MiB), (bf16*)ar, args.in[iff + 2], args.in[iff + 3], MTOT); PH_END
    PH_BEGIN {
        if constexpr (LAYER < 3) { constexpr int ibn = (LAYER == 0) ? 17 : (LAYER == 1) ? 26 : 42;
            pg8::EpiResN E{nullptr, args.in[iff], nullptr, DM, 0, args.in[ibn], (pg8::bf16_t*)XN, SSB + (size_t)((LAYER + 1) * 2) * MTOT * 8, (PG8_LAS float*)(F.lds + LDSCTL_OFF + 256)}; GEMM_CALL(pg8::EpiResN, E, ar, WDN, MTOT, DM, DFF, DFF, DFF, (int)blockIdx.x); }
        else { pg8::EpiResN E{nullptr, args.in[iff], nullptr, DM, 0, args.in[57], (pg8::bf16_t*)XN, SSB, (PG8_LAS float*)(F.lds + LDSCTL_OFF + 256)}; GEMM_CALL(pg8::EpiResN, E, ar, WDN, MTOT, DM, DFF, DFF, DFF, (int)blockIdx.x); }
    } PH_END
}
__global__ void __launch_bounds__(NWAVES * 64, 2) mk_fwd(Args args) {
    extern __shared__ __attribute__((aligned(16))) unsigned char lds_[];
    LAS unsigned char* const lds = (LAS unsigned char*)lds_;
    volatile LAS unsigned* MISC = (volatile LAS unsigned*)(lds + LDSCTL_OFF);
    for (int u = threadIdx.x; u < 64; u += NWAVES * 64) ((LAS unsigned*)(lds + LDSCTL_OFF))[u] = 0u;
    __syncthreads();
    const int lo = args.ph_lo, hi = args.ph_hi;
    (void)xcd_barrier_post((unsigned*)(args.ws + WS_CTL) + CW_BAR, MISC + 8);
    int ph = 0;
    run_cvt<0>(args, lds, MISC, ph, lo, hi); run_half<0, 0>(args, lds, MISC, ph, lo, hi); run_half<0, 1>(args, lds, MISC, ph, lo, hi); run_ffn<0>(args, lds, MISC, ph, lo, hi);
    run_cvt<1>(args, lds, MISC, ph, lo, hi); run_half<1, 0>(args, lds, MISC, ph, lo, hi); run_half<1, 1>(args, lds, MISC, ph, lo, hi); run_ffn<1>(args, lds, MISC, ph, lo, hi);
    run_cvt<2>(args, lds, MISC, ph, lo, hi); run_half<2, 0>(args, lds, MISC, ph, lo, hi); run_half<2, 1>(args, lds, MISC, ph, lo, hi); run_ffn<2>(args, lds, MISC, ph, lo, hi);
    run_cvt<3>(args, lds, MISC, ph, lo, hi); run_half<3, 0>(args, lds, MISC, ph, lo, hi); run_half<3, 1>(args, lds, MISC, ph, lo, hi); run_ffn<3>(args, lds, MISC, ph, lo, hi);
    { constexpr int ib = 42, iff = 52; PH_BEGIN ph_final_norm(F, (const bf16*)XN, SSB, out); PH_END }
}
extern "C" void kernel_launch(void* const* d_in, const int* in_sizes, int n_in, void* d_out, int out_size, void* d_ws, size_t ws_size, hipStream_t stream) {
    static int grid = 0;
    if (grid == 0) {
        if (n_in != 58 || out_size != MTOT * DM || ws_size < WS_END) { fprintf(stderr, "kernel_launch: unexpected shapes (n_in %d, out %d, ws %zu)\n", n_in, out_size, ws_size); grid = -1; return; }
        int dev = 0, cus = 0;
        if (hipGetDevice(&dev) != hipSuccess || hipDeviceGetAttribute(&cus, hipDeviceAttributeMultiprocessorCount, dev) != hipSuccess) { grid = -1; return; }
        if (hipFuncSetAttribute((const void*)mk_fwd, hipFuncAttributeMaxDynamicSharedMemorySize, LDS_BYTES) != hipSuccess) { fprintf(stderr, "kernel_launch: hipFuncSetAttribute failed\n"); grid = -1; return; }
        int per_cu = 0;
        (void)hipOccupancyMaxActiveBlocksPerMultiprocessor(&per_cu, (const void*)mk_fwd, NWAVES * 64, LDS_BYTES);
        (void)hipGetLastError();
        grid = cus;
    }
    if (grid < 0) return;
    if (hipMemsetAsync((char*)d_ws + WS_CTL, 0, CTL_ZERO_BYTES, stream) != hipSuccess) return;
    Args a{};
    for (int i = 0; i < 58; ++i) a.in[i] = (const float*)d_in[i];
    a.out = (float*)d_out; a.ws = (unsigned char*)d_ws;
#if MK_ONE_LAUNCH
    a.ph_lo = 0; a.ph_hi = NPH;
    hipLaunchKernelGGL(mk_fwd, dim3(grid), dim3(NWAVES * 64), LDS_BYTES, stream, a);
#else
    for (int p = 0; p < NPH; ++p) { a.ph_lo = p; a.ph_hi = p + 1; hipLaunchKernelGGL(mk_fwd, dim3(grid), dim3(NWAVES * 64), LDS_BYTES, stream, a); }
#endif
}
```

```cpp
#include <hip/hip_runtime.h>
#include <cstdio>
#include <cstdint>
#define DI __device__ __forceinline__
namespace pg8 {
#define PG8_LAS __attribute__((address_space(3)))
typedef unsigned short bf16_t;
typedef short bf16x8 __attribute__((ext_vector_type(8)));
typedef float f32x4 __attribute__((ext_vector_type(4)));
typedef unsigned u32x4 __attribute__((ext_vector_type(4)));
constexpr int BM = 256, BK = 64, HALF = 128, HTB = HALF * BK * 2  , STAGE_BYTES = 8 * HTB, NXCD = 8, WGM = 8;

__host__ __device__ __forceinline__ int lds_byte(int r, int c) { const int st = (r >> 4) * 2 + (c >> 5), rr = r & 15, cc = c & 31, ob = rr * 64 + cc * 2; return st * 1024 + (ob ^ (((ob >> 9) & 1) << 5)); }
__host__ __device__ __forceinline__ void stage_rc(int b, int& R, int& C) { const int st = b / 1024, sb = b % 1024, swz = sb ^ (((sb >> 9) & 1) << 5); R = (st >> 1) * 16 + swz / 64; C = (st & 1) * 32 + (swz % 64) / 2; }
__host__ __device__ __forceinline__ int perm32(int rho) { const int n = rho >> 4, i = rho & 15; return 8 * (i >> 2) + 4 * n + (i & 3); }

struct Unit { int pm, pn; };
struct Gemm { const bf16_t* A; const bf16_t* Bt; int M, N, K, lda, ldb, akoff; };

struct StaticOrder {
    int nM, nN, nwg, G, c;
    __host__ __device__ void init(int M, int N, int G_, int c_) { nM = M / BM; nN = N / BM; nwg = nM * nN; G = G_; c = c_; }
    __host__ __device__ bool next(int i, Unit& u) const {
        const long L = (long)i * G + c; if (L >= nwg) return false;
        int wgid = (int)L; { const int q = nwg / NXCD, r = nwg % NXCD, xcd = wgid % NXCD, off = wgid / NXCD; wgid = (xcd < r ? xcd * (q + 1) : r * (q + 1) + (xcd - r) * q) + off; }
        const int nig = WGM * nN, gid = wgid / nig, fm = gid * WGM, gsz = (nM - fm) < WGM ? (nM - fm) : WGM;
        u.pm = fm + ((wgid % nig) % gsz); u.pn = (wgid % nig) / gsz; return true;
    }
    __device__ __forceinline__ void a_ready(const Unit&) const {}
    __device__ __forceinline__ void done(const Unit&) const {}
};
__device__ __forceinline__ unsigned cvt_pk_bf16(float lo, float hi) { unsigned r; asm volatile("v_cvt_pk_bf16_f32 %0, %1, %2" : "=v"(r) : "v"(lo), "v"(hi)); return r; }
template <class Epi, class Sched, bool ALIGN_EPI = false, bool SP2 = false>
__device__ __forceinline__ void gemm_phase(PG8_LAS unsigned char* lds, const Gemm g, const Sched& S, const Epi& E) {
    const int tid = threadIdx.x, wid = __builtin_amdgcn_readfirstlane(tid >> 6), lane = tid & 63, wr = wid >> 2, wc = wid & 3, fr = lane & 15, fq = lane >> 4;
    const int K = g.K, nt = K / BK;
    unsigned voffA[2], voffB[2];
#pragma unroll
    for (int i = 0; i < 2; ++i) { int R, C; stage_rc(tid * 16 + i * 8192, R, C); const int Rb = Epi::PERM ? ((R & ~31) + perm32(R & 31)) : R;
        voffA[i] = (unsigned)(R * g.lda + C) * 2u; voffB[i] = (unsigned)(Rb * g.ldb + C) * 2u; }
    const size_t kstep = (size_t)(BK * 2);
    const size_t hstepA = (size_t)HALF * g.lda * 2, hstepB = (size_t)HALF * g.ldb * 2;
    const size_t tstepA = 2 * hstepA, tstepB = 2 * hstepB;
    const unsigned ldsw = (unsigned)wid * 1024u;
    const int aoff = lds_byte(wr * 64 + fr, fq * 8), boff = lds_byte(wc * 32 + fr, fq * 8);
#define PG8_SA(b, h) (((b) * 2 + (h)) * HTB)
#define PG8_SB(b, h) ((4 + (b) * 2 + (h)) * HTB)
#define PG8_STAGE(bufoff, gbase, voff) do { _Pragma("unroll") for (int _i = 0; _i < 2; ++_i) \
        __builtin_amdgcn_global_load_lds((const unsigned*)((const char*)(gbase) + (voff)[_i]), (PG8_LAS unsigned*)(lds + (bufoff) + ldsw + _i * 8192), 16, 0, 0); } while (0)
#define PG8_LDA(dst, b, h) do { _Pragma("unroll") for (int m = 0; m < 4; ++m) _Pragma("unroll") for (int k = 0; k < 2; ++k) dst[m][k] = *(const PG8_LAS bf16x8*)(lds + PG8_SA(b, h) + aoff + m * 2048 + k * 1024); } while (0)
#define PG8_LDB(dst, b, h) do { _Pragma("unroll") for (int n = 0; n < 2; ++n) _Pragma("unroll") for (int k = 0; k < 2; ++k) dst[n][k] = *(const PG8_LAS bf16x8*)(lds + PG8_SB(b, h) + boff + n * 2048 + k * 1024); } while (0)
#define PG8_MMA(ai, bj, At, Bt) do { __builtin_amdgcn_s_setprio(1); _Pragma("unroll") for (int m = 0; m < 4; ++m) _Pragma("unroll") for (int n = 0; n < 2; ++n) _Pragma("unroll") for (int k = 0; k < 2; ++k) \
        acc[ai][bj][m][n] = __builtin_amdgcn_mfma_f32_16x16x32_bf16(Bt[n][k], At[m][k], acc[ai][bj][m][n], 0, 0, 0); __builtin_amdgcn_s_setprio(0); } while (0)
#define PG8_WAIT_V(n) asm volatile("s_waitcnt vmcnt(" #n ")" ::: "memory")
#define PG8_WAIT_L(n) asm volatile("s_waitcnt lgkmcnt(" #n ")" ::: "memory")
#define PG8_BAR __builtin_amdgcn_s_barrier()
#define PG8_SCHED __builtin_amdgcn_sched_barrier(0)
    Unit cur, nxt; int ui = 0;
    if (!S.next(0, cur)) return;
    f32x4 acc[2][2][4][2];
#pragma unroll
    for (int a = 0; a < 2; ++a)
#pragma unroll
        for (int b = 0; b < 2; ++b)
#pragma unroll
            for (int m = 0; m < 4; ++m)
#pragma unroll
                for (int n = 0; n < 2; ++n) acc[a][b][m][n] = (f32x4){0.f, 0.f, 0.f, 0.f};
    bf16x8 At[4][2], B0[2][2], B1[2][2];
    const char* cA = (const char*)g.A + (size_t)cur.pm * tstepA + (size_t)cur.pn * g.akoff * 2; const char* cB = (const char*)g.Bt + (size_t)cur.pn * tstepB;
    S.a_ready(cur);
    if constexpr (SP2) {
        PG8_STAGE(PG8_SB(0, 0), cB, voffB); PG8_STAGE(PG8_SB(0, 1), cB + hstepB, voffB); PG8_STAGE(PG8_SA(0, 0), cA, voffA); PG8_STAGE(PG8_SA(0, 1), cA + hstepA, voffA);
        if (wr == 1) PG8_BAR;
        PG8_WAIT_V(2); PG8_BAR;
        PG8_STAGE(PG8_SB(1, 0), cB + kstep, voffB); PG8_STAGE(PG8_SA(1, 0), cA + kstep, voffA); PG8_STAGE(PG8_SB(1, 1), cB + hstepB + kstep, voffB);
        PG8_WAIT_V(6); PG8_BAR;
    } else {
        PG8_STAGE(PG8_SB(0, 0), cB, voffB); PG8_STAGE(PG8_SA(0, 0), cA, voffA); PG8_STAGE(PG8_SB(0, 1), cB + hstepB, voffB); PG8_STAGE(PG8_SA(0, 1), cA + hstepA, voffA);
        if (wr == 1) PG8_BAR;
        PG8_WAIT_V(4); PG8_BAR;
        PG8_STAGE(PG8_SB(1, 0), cB + kstep, voffB); PG8_STAGE(PG8_SA(1, 0), cA + kstep, voffA); PG8_STAGE(PG8_SB(1, 1), cB + hstepB + kstep, voffB);
        PG8_WAIT_V(6); PG8_BAR;
    }
    for (;;) {
        const bool has_next = S.next(ui + 1, nxt);
        const char* nA = has_next ? (const char*)g.A + (size_t)nxt.pm * tstepA + (size_t)nxt.pn * g.akoff * 2 : cA; const char* nB = has_next ? (const char*)g.Bt + (size_t)nxt.pn * tstepB : cB;
        for (int t = 0; t < nt; t += 2) {
            const bool last = (t == nt - 2);
            const char* a1 = cA + (size_t)(t + 1) * kstep;
            const char* a2 = last ? nA : cA + (size_t)(t + 2) * kstep; const char* b2 = last ? nB : cB + (size_t)(t + 2) * kstep;
            const char* a3 = a2 + kstep; const char* b3 = b2 + kstep;
            if (last && has_next) S.a_ready(nxt);
            if constexpr (SP2) {
            PG8_LDB(B0, 0, 0); PG8_LDB(B1, 0, 1); PG8_SCHED; PG8_LDA(At, 0, 0); PG8_STAGE(PG8_SA(1, 1), a1 + hstepA, voffA);
            PG8_WAIT_V(8); PG8_WAIT_L(0); PG8_BAR; PG8_MMA(0, 0, At, B0); PG8_MMA(0, 1, At, B1); PG8_BAR; PG8_SCHED;
            PG8_LDA(At, 0, 1); PG8_STAGE(PG8_SB(0, 0), b2, voffB); PG8_STAGE(PG8_SB(0, 1), b2 + hstepB, voffB); PG8_STAGE(PG8_SA(0, 0), a2, voffA);
            PG8_WAIT_V(8); PG8_WAIT_L(0); PG8_BAR; PG8_MMA(1, 0, At, B0); PG8_MMA(1, 1, At, B1); PG8_BAR; PG8_SCHED;
            PG8_LDB(B0, 1, 0); PG8_LDB(B1, 1, 1); PG8_SCHED; PG8_LDA(At, 1, 0); PG8_STAGE(PG8_SA(0, 1), a2 + hstepA, voffA);
            PG8_WAIT_V(8); PG8_WAIT_L(0); PG8_BAR; PG8_MMA(0, 0, At, B0); PG8_MMA(0, 1, At, B1); PG8_BAR; PG8_SCHED;
            PG8_LDA(At, 1, 1); PG8_STAGE(PG8_SB(1, 0), b3, voffB); PG8_STAGE(PG8_SB(1, 1), b3 + hstepB, voffB); PG8_STAGE(PG8_SA(1, 0), a3, voffA);
            PG8_WAIT_V(8); PG8_WAIT_L(0); PG8_BAR; PG8_MMA(1, 0, At, B0); PG8_MMA(1, 1, At, B1); PG8_BAR; PG8_SCHED;
            } else {
            PG8_LDB(B0, 0, 0); PG8_SCHED; PG8_LDA(At, 0, 0); PG8_STAGE(PG8_SA(1, 1), a1 + hstepA, voffA);
            PG8_WAIT_L(8); PG8_BAR; PG8_WAIT_L(0); PG8_MMA(0, 0, At, B0); PG8_BAR; PG8_SCHED;
            PG8_LDB(B1, 0, 1); PG8_STAGE(PG8_SB(0, 0), b2, voffB);
            PG8_BAR; PG8_WAIT_L(0); PG8_MMA(0, 1, At, B1); PG8_BAR;
            PG8_LDA(At, 0, 1); PG8_STAGE(PG8_SA(0, 0), a2, voffA);
            PG8_BAR; PG8_WAIT_L(0); PG8_MMA(1, 0, At, B0); PG8_BAR; PG8_SCHED;
            PG8_STAGE(PG8_SB(0, 1), b2 + hstepB, voffB);
            PG8_WAIT_V(6); PG8_BAR; PG8_MMA(1, 1, At, B1); PG8_BAR;
            PG8_LDB(B0, 1, 0); PG8_SCHED; PG8_LDA(At, 1, 0); PG8_STAGE(PG8_SA(0, 1), a2 + hstepA, voffA);
            PG8_WAIT_L(8); PG8_BAR; PG8_WAIT_L(0); PG8_MMA(0, 0, At, B0); PG8_BAR; PG8_SCHED;
            PG8_LDB(B1, 1, 1); PG8_STAGE(PG8_SB(1, 0), b3, voffB);
            PG8_BAR; PG8_WAIT_L(0); PG8_MMA(0, 1, At, B1); PG8_BAR;
            PG8_LDA(At, 1, 1); PG8_STAGE(PG8_SA(1, 0), a3, voffA);
            PG8_BAR; PG8_WAIT_L(0); PG8_MMA(1, 0, At, B0); PG8_BAR; PG8_SCHED;
            PG8_STAGE(PG8_SB(1, 1), b3 + hstepB, voffB);
            PG8_WAIT_V(6); PG8_BAR; PG8_MMA(1, 1, At, B1); PG8_BAR;
            }
        }
        if constexpr (ALIGN_EPI) { if (wr == 0) PG8_BAR; }
        if constexpr (!Epi::AFTER_DRAIN) { E(acc, cur, wr, wc, fr, fq); S.done(cur); }
        if (!has_next) break;
#pragma unroll
        for (int a = 0; a < 2; ++a)
#pragma unroll
            for (int b = 0; b < 2; ++b)
#pragma unroll
                for (int m = 0; m < 4; ++m)
#pragma unroll
                    for (int n = 0; n < 2; ++n) acc[a][b][m][n] = (f32x4){0.f, 0.f, 0.f, 0.f};
        cur = nxt; cA = nA; cB = nB; ++ui;
        if constexpr (ALIGN_EPI) { if (wr == 1) PG8_BAR; }
    }
    PG8_WAIT_V(0);
    if constexpr (!ALIGN_EPI) { if (wr == 0) PG8_BAR; }
    PG8_BAR;
    if constexpr (Epi::AFTER_DRAIN) { E.fused(acc, cur, wr, wc, fr, fq, lds, wid, lane); S.done(cur); }
#undef PG8_SA
#undef PG8_SB
#undef PG8_STAGE
#undef PG8_LDA
#undef PG8_LDB
#undef PG8_MMA
#undef PG8_WAIT_V
#undef PG8_WAIT_L
#undef PG8_BAR
#undef PG8_SCHED
}
}
namespace pg8 {
typedef float f32x2 __attribute__((ext_vector_type(2)));
__device__ __forceinline__ float rms_rowscale(const float* ssq, int row) { const f32x4 a = *(const f32x4*)(ssq + (size_t)row * 8), b = *(const f32x4*)(ssq + (size_t)row * 8 + 4);
    return __builtin_amdgcn_rsqf((((a[0] + a[1]) + (a[2] + a[3])) + ((b[0] + b[1]) + (b[2] + b[3]))) * (1.0f / 2048.0f) + 1e-6f); }
struct SegTab { bf16_t* base[8]; int ldc[8]; int t0[8]; int gw[8]; int nseg; int pad_; };
struct EpiBf16R {
    static constexpr bool PERM = true, AFTER_DRAIN = false;
    SegTab T; const float* ssp; int ss_off;
    __device__ __forceinline__ void operator()(const f32x4 (&acc)[2][2][4][2], const Unit& u, int wr, int wc, int fr, int fq) const {
        bf16_t* base = T.base[0]; int ldc = T.ldc[0], gw = T.gw[0], t0 = T.t0[0];
#pragma unroll
        for (int s = 1; s < 8; ++s) if (s < T.nseg && u.pn >= T.t0[s]) { base = T.base[s]; ldc = T.ldc[s]; gw = T.gw[s]; t0 = T.t0[s]; }
        const int colt = (u.pn - t0) * BM, row0 = u.pm * BM + wr * 64 + fr;
        if (gw <= -4) {
            typedef unsigned u32x2_ __attribute__((ext_vector_type(2)));
#pragma unroll
            for (int bj = 0; bj < 2; ++bj) { const int col = colt + bj * HALF + wc * 32 + 8 * fq;
                f32x4 c0 = {1.f, 1.f, 1.f, 1.f}, c1 = {1.f, 1.f, 1.f, 1.f};
                if (ssp) {
#pragma unroll
                    for (int j = 0; j < 4; ++j) { c0[j] = rms_rowscale(ssp, ss_off + col + j); c1[j] = rms_rowscale(ssp, ss_off + col + 4 + j); } }
                const int bt = ((col >> 12) * ldc) * 128 + ((col & 4095) >> 5);
#pragma unroll
                for (int ai = 0; ai < 2; ++ai)
#pragma unroll
                    for (int m = 0; m < 4; ++m) { const int row = row0 + ai * HALF + m * 16;
                        const f32x4 v0 = acc[ai][bj][m][0] * c0, v1 = acc[ai][bj][m][1] * c1;
                        if (gw == -4) {
                            bf16_t* d0 = base + ((size_t)(((bt + (row >> 7) * 128) * 8 + ((row >> 5) & 3) * 2 + ((col >> 4) & 1)) * 64) + (row & 31)) * 8 + 4 * ((col >> 3) & 1);
                            *(u32x2_*)d0 = (u32x2_){cvt_pk_bf16(v0[0], v0[1]), cvt_pk_bf16(v0[2], v0[3])}; *(u32x2_*)(d0 + 32 * 8) = (u32x2_){cvt_pk_bf16(v1[0], v1[1]), cvt_pk_bf16(v1[2], v1[3])};
                        } else {
                            const int k0 = col & 31, kq = (k0 & 15) >> 2, j0 = (k0 >> 4) * 4;
                            unsigned char* d8 = (unsigned char*)base + ((size_t)(((bt + (row >> 7) * 128) * 8 + ((row >> 4) & 7)) * 64) + 16 * kq + (row & 15)) * 8 + j0;
                            int lo = 0, hi = 0;
                            lo = __builtin_amdgcn_cvt_pk_fp8_f32(v0[0], v0[1], lo, false); lo = __builtin_amdgcn_cvt_pk_fp8_f32(v0[2], v0[3], lo, true);
                            hi = __builtin_amdgcn_cvt_pk_fp8_f32(v1[0], v1[1], hi, false); hi = __builtin_amdgcn_cvt_pk_fp8_f32(v1[2], v1[3], hi, true);
                            *(int*)d8 = lo; *(int*)(d8 + 16 * 8) = hi; } } }
            return; }
#pragma unroll
        for (int ai = 0; ai < 2; ++ai)
#pragma unroll
            for (int m = 0; m < 4; ++m) { const int row = row0 + ai * HALF + m * 16;
                const float rs = ssp ? rms_rowscale(ssp, ss_off + row) : 1.0f;
#pragma unroll
                for (int bj = 0; bj < 2; ++bj) { const int col = colt + bj * HALF + wc * 32 + 8 * fq;
                    const f32x4 v0 = acc[ai][bj][m][0] * rs, v1 = acc[ai][bj][m][1] * rs;
                    u32x4 w; w.x = cvt_pk_bf16(v0[0], v0[1]); w.y = cvt_pk_bf16(v0[2], v0[3]); w.z = cvt_pk_bf16(v1[0], v1[1]); w.w = cvt_pk_bf16(v1[2], v1[3]);
                    if (gw == -2) {
                        if ((row >> 5) < ldc) { bf16_t* d0 = base + ((size_t)(((col >> 5) * ldc + (row >> 5)) * 2 + ((col >> 4) & 1)) * 64 + (row & 31)) * 8 + 4 * ((col >> 3) & 1);
                            typedef unsigned u32x2_ __attribute__((ext_vector_type(2)));
                            *(u32x2_*)d0 = (u32x2_){w.x, w.y}; *(u32x2_*)(d0 + 32 * 8) = (u32x2_){w.z, w.w}; }
                        continue; }
                    bf16_t* dst;
                    if (gw == 0) dst = base + (size_t)row * ldc + col;
                    else if (gw == -1) { if ((col >> 4) >= ldc) continue; dst = base + ((size_t)((row >> 5) * ldc + (col >> 4)) * 64 + ((col >> 3) & 1) * 32 + (row & 31)) * 8; }
                    else if (gw == -3) dst = base + ((size_t)(((((row >> 12) * 16 + (col >> 7)) * 128 + ((row & 4095) >> 5)) * 9 + ((col >> 4) & 7)) * 64) + ((col >> 3) & 1) * 32 + (row & 31)) * 8;
                    else { const int g = col / gw, d = col - g * gw; dst = base + ((size_t)((row >> 12) * 4 + g) * 4096 + (row & 4095)) * gw + d; }
                    *(u32x4*)dst = w; } }
    }
};
struct EpiGelu {
    static constexpr bool PERM = true, AFTER_DRAIN = false;
    bf16_t* O; int ldc; const float* bias;
    static __device__ __forceinline__ float gelu(float x) { const float u2 = 1.5957691216f * (x + 0.044715f * x * x * x); const float e = __builtin_amdgcn_exp2f(-u2 * 1.4426950409f); return x * __builtin_amdgcn_rcpf(1.0f + e); }
    __device__ __forceinline__ void operator()(const f32x4 (&acc)[2][2][4][2], const Unit& u, int wr, int wc, int fr, int fq) const {
        const int row0 = u.pm * BM + wr * 64 + fr, col0 = u.pn * BM + wc * 32 + 8 * fq;
#pragma unroll
        for (int bj = 0; bj < 2; ++bj) { const f32x4 b0 = *(const f32x4*)(bias + col0 + bj * HALF), b1 = *(const f32x4*)(bias + col0 + bj * HALF + 4);
#pragma unroll
            for (int ai = 0; ai < 2; ++ai)
#pragma unroll
                for (int m = 0; m < 4; ++m) { const f32x4 v0 = acc[ai][bj][m][0] + b0, v1 = acc[ai][bj][m][1] + b1;
                    u32x4 w; w.x = cvt_pk_bf16(gelu(v0[0]), gelu(v0[1])); w.y = cvt_pk_bf16(gelu(v0[2]), gelu(v0[3])); w.z = cvt_pk_bf16(gelu(v1[0]), gelu(v1[1])); w.w = cvt_pk_bf16(gelu(v1[2]), gelu(v1[3]));
                    *(u32x4*)(O + (size_t)(row0 + ai * HALF + m * 16) * ldc + col0 + bj * HALF) = w; } }
    }
};
struct EpiF32 {
    static constexpr bool PERM = false, AFTER_DRAIN = false;
    float* C; int ldc; const float* ssp; int ss_off;
    __device__ __forceinline__ void operator()(const f32x4 (&acc)[2][2][4][2], const Unit& u, int wr, int wc, int fr, int fq) const {
        const int row0 = u.pm * BM + wr * 64 + fr, col0 = u.pn * BM + wc * 32 + 4 * fq;
#pragma unroll
        for (int ai = 0; ai < 2; ++ai)
#pragma unroll
            for (int m = 0; m < 4; ++m) { float* rowp = C + (size_t)(row0 + ai * HALF + m * 16) * ldc + col0;
                const float rs = ssp ? rms_rowscale(ssp, ss_off + row0 + ai * HALF + m * 16) : 1.0f;
#pragma unroll
                for (int bj = 0; bj < 2; ++bj)
#pragma unroll
                    for (int n = 0; n < 2; ++n) *(f32x4*)(rowp + bj * HALF + n * 16) = acc[ai][bj][m][n] * rs; }
    }
};
struct EpiResN {
    static constexpr bool PERM = false, AFTER_DRAIN = false;
    const float* res32; const float* gprev; float* out32; int ldc; int row_off; const float* g; bf16_t* xn; float* ss; PG8_LAS float* xb;
    __device__ __forceinline__ void operator()(const f32x4 (&acc)[2][2][4][2], const Unit& u, int wr, int wc, int fr, int fq) const {
        typedef unsigned u32x2_ __attribute__((ext_vector_type(2)));
        const int row0 = row_off + u.pm * BM + wr * 64 + fr, col0 = u.pn * BM + wc * 32 + 4 * fq;
        f32x4 gv[2][2], gi[2][2];
#pragma unroll
        for (int bj = 0; bj < 2; ++bj)
#pragma unroll
            for (int n = 0; n < 2; ++n) { gv[bj][n] = g ? *(const f32x4*)(g + col0 + bj * HALF + n * 16) : (f32x4){0.f, 0.f, 0.f, 0.f};
                if (!res32) { const f32x4 t = *(const f32x4*)(gprev + col0 + bj * HALF + n * 16); gi[bj][n] = (f32x4){1.0f / t[0], 1.0f / t[1], 1.0f / t[2], 1.0f / t[3]}; } else gi[bj][n] = (f32x4){1.f, 1.f, 1.f, 1.f}; }
#pragma unroll
        for (int ai = 0; ai < 2; ++ai)
#pragma unroll
            for (int m = 0; m < 4; ++m) { const int row = row0 + ai * HALF + m * 16; const size_t off = (size_t)row * ldc + col0;
                f32x4 r[2][2]; float sq = 0.f;
#pragma unroll
                for (int bj = 0; bj < 2; ++bj)
#pragma unroll
                    for (int n = 0; n < 2; ++n) {
                        if (res32) r[bj][n] = *(const f32x4*)(res32 + off + bj * HALF + n * 16);
                        else { const u32x2_ w = *(const u32x2_*)(xn + off + bj * HALF + n * 16);
                            r[bj][n] = (f32x4){__builtin_bit_cast(float, w.x << 16), __builtin_bit_cast(float, w.x & 0xffff0000u), __builtin_bit_cast(float, w.y << 16), __builtin_bit_cast(float, w.y & 0xffff0000u)} * gi[bj][n]; } }
#pragma unroll
                for (int bj = 0; bj < 2; ++bj)
#pragma unroll
                    for (int n = 0; n < 2; ++n) { const f32x4 o = r[bj][n] + acc[ai][bj][m][n];
                        if (out32) *(f32x4*)(out32 + off + bj * HALF + n * 16) = o;
                        if (g) { sq += (o[0] * o[0] + o[1] * o[1]) + (o[2] * o[2] + o[3] * o[3]);
                            const f32x4 y = o * gv[bj][n]; *(u32x2_*)(xn + off + bj * HALF + n * 16) = (u32x2_){cvt_pk_bf16(y[0], y[1]), cvt_pk_bf16(y[2], y[3])}; } }
                if (g) { sq += __shfl_xor(sq, 16); sq += __shfl_xor(sq, 32);
                    if (fq == 0) xb[(ai * HALF + wr * 64 + m * 16 + fr) * 4 + wc] = sq; }
                asm volatile("" ::: "memory"); }
        if (g) {
            asm volatile("s_waitcnt lgkmcnt(0)" ::: "memory"); __builtin_amdgcn_s_barrier(); asm volatile("" ::: "memory");
            const int t = (wr * 4 + wc) * 64 + fq * 16 + fr;
            if (t < BM) { const f32x4 v = *(const PG8_LAS f32x4*)(xb + t * 4); ss[(size_t)(row_off + u.pm * BM + t) * 8 + u.pn] = (v[0] + v[1]) + (v[2] + v[3]); }
        }
    }
};
struct EpiConvGlu {
    static constexpr bool PERM = true, AFTER_DRAIN = false;
    bf16_t* G; float* UB; const float* cw; const float* cb; PG8_LAS float* xb; int dff; const PG8_LAS float* rstd; int rbase;
    static __device__ __forceinline__ float shr(float old, float src, int n) { const int o = __builtin_bit_cast(int, old), s = __builtin_bit_cast(int, src);
        return __builtin_bit_cast(float, n == 1 ? __builtin_amdgcn_update_dpp(o, s, 0x111, 0xf, 0xf, false) : __builtin_amdgcn_update_dpp(o, s, 0x112, 0xf, 0xf, false)); }
    static __device__ __forceinline__ float ror(float src, int n) { const int s = __builtin_bit_cast(int, src);
        return __builtin_bit_cast(float, n == 1 ? __builtin_amdgcn_update_dpp(0, s, 0x121, 0xf, 0xf, false) : __builtin_amdgcn_update_dpp(0, s, 0x122, 0xf, 0xf, false)); }
    __device__ __forceinline__ void operator()(f32x4 (&acc)[2][2][4][2], const Unit& u, int wr, int wc, int fr, int fq) const {
        typedef unsigned u32x2_ __attribute__((ext_vector_type(2)));
        if (rstd) {
#pragma unroll
            for (int ai = 0; ai < 2; ++ai)
#pragma unroll
                for (int m = 0; m < 4; ++m) { const float rs = rstd[u.pm * BM + ai * HALF + wr * 64 + m * 16 + fr - rbase];
#pragma unroll
                    for (int bj = 0; bj < 2; ++bj)
#pragma unroll
                        for (int n = 0; n < 2; ++n) acc[ai][bj][m][n] = acc[ai][bj][m][n] * rs; }
        }
        if (fr >= 14) {
#pragma unroll
            for (int ai = 0; ai < 2; ++ai)
#pragma unroll
                for (int bj = 0; bj < 2; ++bj)
#pragma unroll
                    for (int n = 0; n < 2; ++n) *(PG8_LAS f32x4*)(xb + (((((ai * 2 + wr) * 4 + wc) * 2 + (fr - 14)) * 4 + fq) * 16) + (bj * 2 + n) * 4) = acc[ai][bj][3][n];
        }
        { const int ncol = 4 * dff / 2;
          const bool top = (wr == 0 && fr < 2), bot = (wr == 1 && fr >= 14);
          if (top || bot) { float* ub = UB + ((size_t)(u.pm * 4 + (top ? fr : 2 + fr - 14)) * ncol) + u.pn * BM + wc * 32 + 8 * fq;
#pragma unroll
            for (int bj = 0; bj < 2; ++bj)
#pragma unroll
                for (int n = 0; n < 2; ++n) *(f32x4*)(ub + bj * HALF + 4 * n) = top ? acc[0][bj][0][n] : acc[1][bj][3][n]; } }
        asm volatile("s_waitcnt lgkmcnt(0)" ::: "memory"); __builtin_amdgcn_s_barrier(); asm volatile("" ::: "memory");
        u32x2_ res[2][4][2];
        const int ch0 = u.pn * HALF + wc * 32 + 8 * fq;
#pragma unroll
        for (int n = 0; n < 2; ++n) {
            const float* wp = cw + ch0 + 4 * n; const float* bp = cb + ch0 + 4 * n;
            const f32x4 w0g = *(const f32x4*)(wp), w1g = *(const f32x4*)(wp + 2 * dff), w2g = *(const f32x4*)(wp + 4 * dff), bg = *(const f32x4*)(bp);
            const f32x4 w0v = *(const f32x4*)(wp + dff), w1v = *(const f32x4*)(wp + 3 * dff), w2v = *(const f32x4*)(wp + 5 * dff), bv = *(const f32x4*)(bp + dff);
#pragma unroll
            for (int ai = 0; ai < 2; ++ai)
#pragma unroll
                for (int m = 0; m < 4; ++m) {
                    const f32x4 cg = acc[ai][0][m][n], cv = acc[ai][1][m][n];
                    f32x4 b1g, b2g, b1v, b2v;
                    if (m > 0) {
#pragma unroll
                        for (int e = 0; e < 4; ++e) { b1g[e] = ror(acc[ai][0][m - 1][n][e], 1); b2g[e] = ror(acc[ai][0][m - 1][n][e], 2); b1v[e] = ror(acc[ai][1][m - 1][n][e], 1); b2v[e] = ror(acc[ai][1][m - 1][n][e], 2); }
                    } else {
                        const int sai = wr ? ai : ai - 1, swr = wr ? 0 : 1;
                        f32x4 x14g = {0.f, 0.f, 0.f, 0.f}, x15g = x14g, x14v = x14g, x15v = x14g;
                        if (sai >= 0) { const PG8_LAS float* xp = xb + (((((sai * 2 + swr) * 4 + wc) * 2) * 4 + fq) * 16);
                            x14g = *(const PG8_LAS f32x4*)(xp + n * 4); x14v = *(const PG8_LAS f32x4*)(xp + (2 + n) * 4); x15g = *(const PG8_LAS f32x4*)(xp + 64 + n * 4); x15v = *(const PG8_LAS f32x4*)(xp + 64 + (2 + n) * 4); }
                        b1g = x15g; b1v = x15v; b2g = fr == 0 ? x14g : x15g; b2v = fr == 0 ? x14v : x15v;
                    }
                    float o[4];
#pragma unroll
                    for (int e = 0; e < 4; ++e) {
                        const float p1g = shr(b1g[e], cg[e], 1), p2g = shr(b2g[e], cg[e], 2), p1v = shr(b1v[e], cv[e], 1), p2v = shr(b2v[e], cv[e], 2);
                        const float yg = bg[e] + w0g[e] * p2g + w1g[e] * p1g + w2g[e] * cg[e], yv = bv[e] + w0v[e] * p2v + w1v[e] * p1v + w2v[e] * cv[e];
                        o[e] = yg * __builtin_amdgcn_rcpf(1.0f + __builtin_amdgcn_exp2f(-yg * 1.4426950409f)) * yv;
                    }
                    res[ai][m][n] = (u32x2_){cvt_pk_bf16(o[0], o[1]), cvt_pk_bf16(o[2], o[3])};
                }
        }
        const int row0 = u.pm * BM + wr * 64 + fr;
#pragma unroll
        for (int ai = 0; ai < 2; ++ai)
#pragma unroll
            for (int m = 0; m < 4; ++m) *(u32x4*)(G + (size_t)(row0 + ai * HALF + m * 16) * dff + ch0) = (u32x4){res[ai][m][0].x, res[ai][m][0].y, res[ai][m][1].x, res[ai][m][1].y};
    }
};
}
constexpr int BATCH = 8, SEQ = 4096, DM = 2048, MTOT = BATCH * SEQ, MC = MTOT / 2  , BPH = BATCH / 2;
constexpr int DFF = 5632;
constexpr float NORM_EPS = 1e-6f, LOG2E = 1.4426950408889634f;
constexpr int NWAVES = 8;
constexpr size_t MiB = 1u << 20;
constexpr size_t WS_CTL = 0, CTL_ZERO_BYTES = 1 * MiB;
constexpr size_t WS_TAB = 1 * MiB;
constexpr size_t TAB_COS48 = WS_TAB, TAB_SIN48 = WS_TAB + 3 * MiB, TAB_COS32 = WS_TAB + 6 * MiB, TAB_SIN32 = WS_TAB + 8 * MiB;
constexpr size_t WS_WMIX = 12 * MiB;
constexpr size_t WS_WFFN = 100 * MiB;
constexpr size_t WS_MISC = 168 * MiB;
constexpr size_t WS_SS = 170 * MiB;
constexpr size_t WS_XNR = 1010 * MiB;
constexpr size_t WS_AR = 234 * MiB;
constexpr size_t WS_END = 1138 * MiB;
constexpr int CW_TMO = 0;
constexpr int CW_BAR = 4096;
constexpr int RING_BYTES = 131072;
constexpr int LDSCTL_OFF = 135168;
constexpr int LDS_BYTES = 163840;

#define GAS __attribute__((address_space(1)))
#define LAS __attribute__((address_space(3)))
typedef unsigned short bf16;
typedef unsigned u32x4 __attribute__((ext_vector_type(4)));
typedef unsigned u32x2 __attribute__((ext_vector_type(2)));
typedef float f32x4 __attribute__((ext_vector_type(4)));
typedef float f32x16 __attribute__((ext_vector_type(16)));
typedef short bf16x8 __attribute__((ext_vector_type(8)));
typedef short s16x4 __attribute__((ext_vector_type(4)));
typedef short v4i16_t __attribute__((ext_vector_type(4)));
typedef __bf16 bf16x2_t __attribute__((ext_vector_type(2)));
typedef float f32x2_t __attribute__((ext_vector_type(2)));
#define LDS_WAIT() asm volatile("s_waitcnt lgkmcnt(0)" ::: "memory")
#define VM_WAIT() asm volatile("s_waitcnt vmcnt(0)" ::: "memory")
#define MFMA32(a, b, c) __builtin_amdgcn_mfma_f32_32x32x16_bf16((a), (b), (c), 0, 0, 0)
DI unsigned pk2(float lo, float hi) { f32x2_t v = {lo, hi}; bf16x2_t b = __builtin_convertvector(v, bf16x2_t); return __builtin_bit_cast(unsigned, b); }
DI float bf2f(unsigned short b) { return __builtin_bit_cast(float, (unsigned)b << 16); }
DI float bflo(unsigned w) { return __builtin_bit_cast(float, w << 16); }
DI float bfhi(unsigned w) { return __builtin_bit_cast(float, w & 0xffff0000u); }
DI unsigned short f2bf(float f) { return (unsigned short)(pk2(f, 0.f) & 0xffffu); }
DI float wave_sum(float v) {
#pragma unroll
    for (int o = 1; o < 64; o <<= 1) v += __shfl_xor(v, o);
    return v;
}
DI int crow(int i, int h) { return (i & 3) + 8 * (i >> 2) + 4 * h; }
#define XB_TMO      128
#define XB_XCNT(j)  (256  + 64 * (j))
#define XB_XSUB(j)  (1280 + 64 * (j))
#define XB_XGEN(j)  (2304 + 64 * (j))
#define XB_TOP      3328
#define XB_TOPGEN   3392
#define XCD_BAR_WORDS 3456
#define XB_SPIN_CAP (1u << 18)

__device__ __forceinline__ unsigned xb_ld(unsigned* p)              { return __hip_atomic_load(p, __ATOMIC_RELAXED, __HIP_MEMORY_SCOPE_AGENT); }
__device__ __forceinline__ unsigned xb_add(unsigned* p, unsigned v) { return __hip_atomic_fetch_add(p, v, __ATOMIC_RELAXED, __HIP_MEMORY_SCOPE_AGENT); }
__device__ __forceinline__ unsigned xb_xcc_id() { return (unsigned)__builtin_amdgcn_s_getreg((3 << 11) | 20) & 0xFu; }
#define XB_SPIN(cond, bar) do { unsigned _sp = 0; while (cond) { __builtin_amdgcn_s_sleep(1); \
    if ((++_sp & 255u) == 0u) { if (xb_ld(&(bar)[XB_TMO])) break; if (_sp > XB_SPIN_CAP) { atomicAdd(&(bar)[XB_TMO], 1u); break; } } } } while (0)

struct XcdBarrier {
    unsigned* bar; unsigned x;
    volatile LAS unsigned* st;
};

__device__ __forceinline__ XcdBarrier xcd_barrier_post(unsigned* bar, volatile LAS unsigned* st) {
    XcdBarrier b; b.bar = bar; b.x = xb_xcc_id(); b.st = st;
    if (threadIdx.x == 0) (void)xb_add(&bar[XB_XCNT(b.x)], 1u);
    return b;
}
__device__ __forceinline__ void xcd_barrier_complete(unsigned* bar, unsigned x, unsigned& nloc, unsigned& nx) {
    const unsigned G = gridDim.x * gridDim.y * gridDim.z;
    unsigned sum, cnt, mine, sp = 0u;
    for (;;) {
        sum = 0u; cnt = 0u; mine = 0u;
#pragma unroll
        for (unsigned j = 0; j < 16; ++j) { const unsigned c = xb_ld(&bar[XB_XCNT(j)]); sum += c; cnt += (c > 0u) ? 1u : 0u; mine = (j == x) ? c : mine; }
        if (sum == G) break;
        __builtin_amdgcn_s_sleep(1);
        if ((++sp & 255u) == 0u) { if (xb_ld(&bar[XB_TMO])) break; if (sp > XB_SPIN_CAP) { atomicAdd(&bar[XB_TMO], 1u); break; } }
    }
    nloc = mine > 0u ? mine : 1u; nx = cnt > 0u ? cnt : 1u;
}

__device__ __forceinline__ void xcd_barrier(const XcdBarrier& b) {
    asm volatile("s_waitcnt vmcnt(0)" ::: "memory");
    __syncthreads();
    if (threadIdx.x == 0) {
        unsigned* bar = b.bar;
        __builtin_amdgcn_s_waitcnt(0);
        unsigned nloc = b.st[0], nx = b.st[1];
        if (nloc == 0u) { xcd_barrier_complete(bar, b.x, nloc, nx); b.st[0] = nloc; b.st[1] = nx; }
        const unsigned old = xb_add(&bar[XB_XSUB(b.x)], 1u);
        const unsigned gen = old / nloc;
        if (old + 1u == (gen + 1u) * nloc) {
            __builtin_amdgcn_fence(__ATOMIC_RELEASE, "agent");
            asm volatile("s_waitcnt vmcnt(0)" ::: "memory");
            const unsigned og = xb_add(&bar[XB_TOP], 1u);
            const unsigned tg = og / nx;
            if (og + 1u == (tg + 1u) * nx) xb_add(&bar[XB_TOPGEN], 1u);
            else XB_SPIN(xb_ld(&bar[XB_TOPGEN]) == tg, bar);
            __builtin_amdgcn_fence(__ATOMIC_ACQUIRE, "agent");
            xb_add(&bar[XB_XGEN(b.x)], 1u);
            asm volatile("s_waitcnt vmcnt(0)" ::: "memory");
        } else {
            XB_SPIN(xb_ld(&bar[XB_XGEN(b.x)]) == gen, bar);
            __builtin_amdgcn_fence(__ATOMIC_ACQUIRE, "agent");
            asm volatile("s_waitcnt vmcnt(0)" ::: "memory");
        }
    }
    __syncthreads();
}
struct Frame {
    LAS unsigned char* lds; unsigned* ctl; unsigned char* ws;
    int tid, lane, wave, G, gw, NGW;
};
DI void ph_tables(const Frame& F, const int* pos) {
    float* c48 = (float*)(F.ws + TAB_COS48); float* s48 = (float*)(F.ws + TAB_SIN48); float* c32 = (float*)(F.ws + TAB_COS32); float* s32 = (float*)(F.ws + TAB_SIN32);
    const int gt = blockIdx.x * (NWAVES * 64) + F.tid, NT = F.G * NWAVES * 64;
    for (int i = gt; i < MTOT * 40; i += NT) {
        const int m = i / 40, j = i - m * 40; const float p = (float)pos[m];
        const bool a = j < 24; const int jj = a ? j : j - 24;
        const float inv = (float)exp(-(2.0 * jj / (a ? 48.0 : 32.0)) * 13.122363377404328);
        const float ang = p * inv; float sn, cs; sincosf(ang, &sn, &cs);
        if (a) { c48[m * 24 + jj] = cs; s48[m * 24 + jj] = sn; } else { c32[m * 16 + jj] = cs; s32[m * 16 + jj] = sn; }
    }
}
DI void cvt_load(float (&v)[32], const float* W, int ldw, int col0, int ncols, int item, int nblk, int lane) {
    const int kb = item / nblk, nb = item - kb * nblk, k0 = 64 * kb, n0 = 32 * nb, nn = n0 + (lane & 31); const bool ok = nn < ncols;
    const float* p = W + (size_t)(k0 + (lane >> 5)) * ldw + col0 + (ok ? nn : 0);
#pragma unroll
    for (int i = 0; i < 32; ++i) { const float x = p[(size_t)(2 * i) * ldw]; v[i] = ok ? x : 0.f; }
}
DI void cvt_store(const float (&v)[32], int ncols, bf16* WT, int ldt, int row_off, float scale, LAS float* scr, int item, int nblk, int lane) {
    const int kb = item / nblk, nb = item - kb * nblk, k0 = 64 * kb, n0 = 32 * nb;
#pragma unroll
    for (int i = 0; i < 32; ++i) scr[(2 * i + (lane >> 5)) * 33 + (lane & 31)] = v[i] * scale;
    LDS_WAIT();
    const int c = lane & 7;
#pragma unroll
    for (int j = 0; j < 4; ++j) { const int n = (lane >> 3) + 8 * j; const LAS float* s = scr + (8 * c) * 33 + n;
        u32x4 o; o.x = pk2(s[0 * 33], s[1 * 33]); o.y = pk2(s[2 * 33], s[3 * 33]); o.z = pk2(s[4 * 33], s[5 * 33]); o.w = pk2(s[6 * 33], s[7 * 33]);
        if (n0 + n < ncols) *(u32x4*)(WT + (size_t)(row_off + n0 + n) * ldt + k0 + 8 * c) = o; }
    LDS_WAIT();
}
DI void cvt_item(const float* W, int ldw, int col0, int ncols, bf16* WT, int ldt, int row_off, float scale, LAS float* scr, int item, int nblk, int lane) {
    float v[32]; cvt_load(v, W, ldw, col0, ncols, item, nblk, lane); cvt_store(v, ncols, WT, ldt, row_off, scale, scr, item, nblk, lane);
}
template <class MAP> DI void cvt_loop(const Frame& F, const float* W, int ldw, int ncols, bf16* WT, int ldt, float scale, int nitems, int nblk, const MAP& map) {
    LAS float* scr = (LAS float*)(F.lds + F.wave * 16384);
    int it = F.gw; float cur[32]; int c0 = 0, ro = 0, li = 0;
    if (it < nitems) { map(it, c0, ro, li); cvt_load(cur, W, ldw, c0, ncols, li, nblk, F.lane); }
#pragma unroll 1
    for (; it < nitems; it += F.NGW) {
        float nxt[32]; int c1 = 0, r1 = 0, l1 = 0; const int ni = it + F.NGW;
        if (ni < nitems) { map(ni, c1, r1, l1); cvt_load(nxt, W, ldw, c1, ncols, l1, nblk, F.lane); }
        cvt_store(cur, ncols, WT, ldt, ro, scale, scr, li, nblk, F.lane);
#pragma unroll
        for (int i = 0; i < 32; ++i) cur[i] = nxt[i];
        c0 = c1; ro = r1; li = l1;
    }
}
struct CvtPlain { int col0, row_off; DI void operator()(int it, int& c, int& r, int& l) const { c = col0; r = row_off; l = it; } };
DI void cvt_job(const Frame& F, const float* W, int ldw, int K, int col0, int ncols, bf16* WT, int ldt, int row_off, float scale) {
    const int nblk = (ncols + 31) / 32;
    cvt_loop(F, W, ldw, ncols, WT, ldt, scale, (K / 64) * nblk, nblk, CvtPlain{col0, row_off});
}
DI void zero_bf16(const Frame& F, bf16* p, size_t nelem) {
    const size_t gt = (size_t)blockIdx.x * (NWAVES * 64) + F.tid, NT = (size_t)F.G * NWAVES * 64;
    for (size_t i = gt; i < nelem / 8; i += NT) ((u32x4*)p)[i] = (u32x4){0u, 0u, 0u, 0u};
}
DI void ph_cvt_ffn(const Frame& F, const float* up, const float* down) {
    bf16* WUP = (bf16*)(F.ws + WS_WFFN); bf16* WDN = WUP + (size_t)2 * DFF * DM;
    struct UpMap { DI void operator()(int it, int& c, int& r, int& l) const { const int seg = it >> 7, pn = seg >> 1, isv = seg & 1; c = isv * DFF + pn * 128; r = pn * 256 + isv * 128; l = it & 127; } };
    cvt_loop(F, up, 2 * DFF, 128, WUP, DM, 1.f, 88 * 128, 4, UpMap{});
    cvt_job(F, down, DM, DFF, 0, DM, WDN, DFF, 0, 1.f);
}
DI void ph_conv_fix(const Frame& F, const float* UB, bf16* Gb, const float* cw, const float* cb, const int nrows = MC) {
    const int gt = blockIdx.x * (NWAVES * 64) + F.tid, NT = F.G * NWAVES * 64;
    for (int it = gt; it < (nrows / 256) * (DFF / 4); it += NT) {
        const int pm = it / (DFF / 4), c4 = it - pm * (DFF / 4), ch = c4 * 4, col = (ch >> 7) * 256 + (ch & 127);
        const float* ub = UB + (size_t)pm * 4 * (2 * DFF) + col; const bool has = (pm & 15) != 0;
        const f32x4 z = {0.f, 0.f, 0.f, 0.f};
        const f32x4 g0 = *(const f32x4*)(ub), g1 = *(const f32x4*)(ub + 2 * DFF), v0 = *(const f32x4*)(ub + 128), v1 = *(const f32x4*)(ub + 2 * DFF + 128);
        const f32x4 gm2 = has ? *(const f32x4*)(ub - 2 * (2 * DFF)) : z, gm1 = has ? *(const f32x4*)(ub - (2 * DFF)) : z, vm2 = has ? *(const f32x4*)(ub - 2 * (2 * DFF) + 128) : z, vm1 = has ? *(const f32x4*)(ub - (2 * DFF) + 128) : z;
        const f32x4 w0g = *(const f32x4*)(cw + ch), w1g = *(const f32x4*)(cw + 2 * DFF + ch), w2g = *(const f32x4*)(cw + 4 * DFF + ch), bg = *(const f32x4*)(cb + ch);
        const f32x4 w0v = *(const f32x4*)(cw + DFF + ch), w1v = *(const f32x4*)(cw + 3 * DFF + ch), w2v = *(const f32x4*)(cw + 5 * DFF + ch), bv = *(const f32x4*)(cb + DFF + ch);
        float o0[4], o1[4];
#pragma unroll
        for (int e = 0; e < 4; ++e) {
            const float yg0 = bg[e] + w0g[e] * gm2[e] + w1g[e] * gm1[e] + w2g[e] * g0[e], yv0 = bv[e] + w0v[e] * vm2[e] + w1v[e] * vm1[e] + w2v[e] * v0[e];
            const float yg1 = bg[e] + w0g[e] * gm1[e] + w1g[e] * g0[e] + w2g[e] * g1[e], yv1 = bv[e] + w0v[e] * vm1[e] + w1v[e] * v0[e] + w2v[e] * v1[e];
            o0[e] = yg0 * __builtin_amdgcn_rcpf(1.0f + __builtin_amdgcn_exp2f(-yg0 * LOG2E)) * yv0; o1[e] = yg1 * __builtin_amdgcn_rcpf(1.0f + __builtin_amdgcn_exp2f(-yg1 * LOG2E)) * yv1;
        }
        u32x2 a, b; a.x = pk2(o0[0], o0[1]); a.y = pk2(o0[2], o0[3]); b.x = pk2(o1[0], o1[1]); b.y = pk2(o1[2], o1[3]);
        *(u32x2*)(Gb + (size_t)(pm * 256) * DFF + ch) = a; *(u32x2*)(Gb + (size_t)(pm * 256 + 1) * DFF + ch) = b;
    }
}
DI void ph_norm_first(const Frame& F, const float* src, const float* gain, bf16* XNR, float* ss) {
    f32x4 g[8];
#pragma unroll
    for (int j = 0; j < 8; ++j) g[j] = *(const f32x4*)(gain + 4 * (F.lane + 64 * j));
    for (int m = F.gw; m < MTOT; m += F.NGW) {
        const f32x4* xr = (const f32x4*)(src + (size_t)m * DM) + F.lane;
        f32x4 v[8]; float s2 = 0.f;
#pragma unroll
        for (int j = 0; j < 8; ++j) { v[j] = xr[64 * j]; s2 += (v[j].x * v[j].x + v[j].y * v[j].y) + (v[j].z * v[j].z + v[j].w * v[j].w); }
        s2 = wave_sum(s2);
        if (F.lane < 2) *(f32x4*)(ss + (size_t)m * 8 + 4 * F.lane) = (f32x4){F.lane == 0 ? s2 : 0.f, 0.f, 0.f, 0.f};
        u32x2* o = (u32x2*)(XNR + (size_t)m * DM) + F.lane;
#pragma unroll
        for (int j = 0; j < 8; ++j) { const f32x4 y = v[j] * g[j]; u32x2 w; w.x = pk2(y.x, y.y); w.y = pk2(y.z, y.w); o[64 * j] = w; }
    }
}
DI void ph_final_norm(const Frame& F, const bf16* xn, const float* ss, float* out) {
    for (int m = F.gw; m < MTOT; m += F.NGW) {
        const float rs = pg8::rms_rowscale(ss, m);
        u32x4 v[4];
#pragma unroll
        for (int j = 0; j < 4; ++j) v[j] = *(const u32x4*)(xn + (size_t)m * DM + j * 512 + F.lane * 8);
#pragma unroll
        for (int j = 0; j < 4; ++j) { float* o = out + (size_t)m * DM + j * 512 + F.lane * 8;
            *(f32x4*)o = (f32x4){__builtin_bit_cast(float, v[j].x << 16), __builtin_bit_cast(float, v[j].x & 0xffff0000u), __builtin_bit_cast(float, v[j].y << 16), __builtin_bit_cast(float, v[j].y & 0xffff0000u)} * rs;
            *(f32x4*)(o + 4) = (f32x4){__builtin_bit_cast(float, v[j].z << 16), __builtin_bit_cast(float, v[j].z & 0xffff0000u), __builtin_bit_cast(float, v[j].w << 16), __builtin_bit_cast(float, v[j].w & 0xffff0000u)} * rs; }
    }
}
DI void rope_piece(const bf16* qrow, int p, const float* cs, const float* sn, float (&o)[8]) {
    const bool lo = p < 3; const int pp = lo ? p + 3 : p - 3, i0 = 8 * (lo ? p : p - 3);
    const u32x4 a = *(const u32x4*)(qrow + 8 * p), b = *(const u32x4*)(qrow + 8 * pp);
    const f32x4 c0 = *(const f32x4*)(cs + i0), c1 = *(const f32x4*)(cs + i0 + 4), s0 = *(const f32x4*)(sn + i0), s1 = *(const f32x4*)(sn + i0 + 4);
#pragma unroll
    for (int e = 0; e < 4; ++e) { const float c_l = e < 2 ? c0[2 * e] : c1[2 * e - 4], c_h = e < 2 ? c0[2 * e + 1] : c1[2 * e - 3], s_l = e < 2 ? s0[2 * e] : s1[2 * e - 4], s_h = e < 2 ? s0[2 * e + 1] : s1[2 * e - 3];
        const float al = bflo(a[e]), ah = bfhi(a[e]), bl_ = bflo(b[e]), bh_ = bfhi(b[e]);
        o[2 * e] = lo ? al * c_l - bl_ * s_l : bl_ * s_l + al * c_l; o[2 * e + 1] = lo ? ah * c_h - bh_ * s_h : bh_ * s_h + ah * c_h; }
}
DI bf16x8 rope_frag32(const bf16* qrow, int s, int h, const float* cs, const float* sn) {
    float o[8]; rope_piece(qrow, 2 * s + h, cs, sn, o);
    u32x4 w; w.x = pk2(o[0], o[1]); w.y = pk2(o[2], o[3]); w.z = pk2(o[4], o[5]); w.w = pk2(o[6], o[7]); return __builtin_bit_cast(bf16x8, w);
}
constexpr size_t DA_DIN = 0, DA_CQN = 64 * MiB, DA_LATC = 80 * MiB, DA_KPE = 88 * MiB, DA_KIDX = 90 * MiB, DA_WIDX = 94 * MiB, DA_QL = 96 * MiB, DA_QPE = 352 * MiB, DA_QIDX = 400 * MiB,
                 DA_SEL = 464 * MiB, DA_CNT = 472 * MiB, DA_SC = 474 * MiB, DA_O2 = 474 * MiB;
constexpr size_t DW_W1 = 0, DW_W2 = (size_t)1024 * 2048, DW_WO = DW_W2 + (size_t)11776 * 512, DW_BD = DW_WO + (size_t)2048 * 4096;
constexpr float DSA_QSCALE = 0.07216878364870322f * LOG2E;
constexpr float DSA_WIDX_SCALE = 0.25f * 0.08838834764831845f;

DI void ph_dsa_cvt(const Frame& F, const float* w_in, const float* w_qup, const float* w_uk, const float* w_uv, const float* w_out) {
    bf16* WB = (bf16*)(F.ws + WS_WMIX);
    cvt_job(F, w_in, 960, DM, 0, 960, WB + DW_W1, DM, 0, 1.f);
    zero_bf16(F, WB + DW_W1 + (size_t)960 * DM, (size_t)64 * DM);
    { LAS float* scr = (LAS float*)(F.lds + F.wave * 16384);
      for (int it = F.gw; it < 32 * 16; it += F.NGW) { const int h = it >> 4; cvt_item(w_qup, 8192, h * 192, 48, WB + DW_W2, 512, 8192 + h * 48, DSA_QSCALE, scr, it & 15, 2, F.lane); } }
    cvt_job(F, w_qup, 8192, 512, 6144, 2048, WB + DW_W2, 512, 9728, 1.f);
    __syncthreads();
    {
        LAS float* As = (LAS float*)F.lds; LAS float* Bs = As + 64 * 145;
        for (int u = blockIdx.x; u < 32 * 4 * 8; u += F.G) {
            const int h = u >> 5, r0 = ((u >> 3) & 3) * 64, k0 = (u & 7) * 64;
            for (int i = F.tid; i < 64 * 144; i += NWAVES * 64) { const int row = i / 144, col = i - row * 144;
                As[row * 145 + col] = w_uk[(size_t)(h * 256 + r0) * 144 + i]; Bs[row * 145 + col] = w_qup[(size_t)(k0 + row) * 8192 + h * 192 + 48 + col]; }
            __syncthreads();
            const int r = F.tid & 63, kg = F.tid >> 6; float acc[8];
#pragma unroll
            for (int j = 0; j < 8; ++j) acc[j] = 0.f;
            for (int n = 0; n < 144; ++n) { const float a = As[r * 145 + n];
#pragma unroll
                for (int j = 0; j < 8; ++j) acc[j] += a * Bs[(kg * 8 + j) * 145 + n]; }
            u32x4 o; o.x = pk2(acc[0] * DSA_QSCALE, acc[1] * DSA_QSCALE); o.y = pk2(acc[2] * DSA_QSCALE, acc[3] * DSA_QSCALE); o.z = pk2(acc[4] * DSA_QSCALE, acc[5] * DSA_QSCALE); o.w = pk2(acc[6] * DSA_QSCALE, acc[7] * DSA_QSCALE);
            *(u32x4*)(WB + DW_W2 + (size_t)(h * 256 + r0 + r) * 512 + k0 + kg * 8) = o;
            __syncthreads();
        }
    }
    { LAS float* scr = (LAS float*)(F.lds + F.wave * 16384);
      for (int it = F.gw; it < 32 * 16; it += F.NGW) { const int h = it >> 4; cvt_item(w_uv + (size_t)h * 256 * 128, 128, 0, 128, WB + DW_BD + (h & 1) * 256, 512, h * 128, 1.f, scr, it & 15, 4, F.lane); } }
    { const size_t gt = (size_t)blockIdx.x * (NWAVES * 64) + F.tid, NT = (size_t)F.G * NWAVES * 64;
      for (size_t i = gt; i < (size_t)4096 * 32; i += NT) { const int row = (int)(i >> 5), pc = (int)(i & 31); *(u32x4*)(WB + DW_BD + (size_t)row * 512 + (1 - ((row >> 7) & 1)) * 256 + pc * 8) = (u32x4){0u, 0u, 0u, 0u}; } }
    cvt_job(F, w_out, DM, 4096, 0, DM, WB + DW_WO, 4096, 0, 1.f);
}
DI void ph_dsa_post1(const Frame& F, int half, const float* qn, const float* kvn, const float* lng, const float* lnb) {
    unsigned char* ar = F.ws + WS_AR;
    const float* DIN = (const float*)(ar + DA_DIN); bf16* CQN = (bf16*)(ar + DA_CQN); bf16* LATC = (bf16*)(ar + DA_LATC); bf16* KPE = (bf16*)(ar + DA_KPE); bf16* KIDX = (bf16*)(ar + DA_KIDX); float* WIDX = (float*)(ar + DA_WIDX);
    const float* c48 = (const float*)(F.ws + TAB_COS48); const float* s48 = (const float*)(F.ws + TAB_SIN48); const float* c32 = (const float*)(F.ws + TAB_COS32); const float* s32 = (const float*)(F.ws + TAB_SIN32);
    LAS float* buf = (LAS float*)(F.lds + F.wave * 1024);
    const int lane = F.lane;
    for (int ml = F.gw; ml < MC; ml += F.NGW) {
        const int mg = half * MC + ml;
        const size_t kfb = ((size_t)(ml >> 5) * 8 * 64 + (ml & 31)) * 8;
        const float* row = DIN + (size_t)ml * 1024 + 16 * lane;
        f32x4 v[4]; float ss = 0.f, s1 = 0.f;
#pragma unroll
        for (int j = 0; j < 4; ++j) { v[j] = *(const f32x4*)(row + 4 * j); ss += (v[j].x * v[j].x + v[j].y * v[j].y) + (v[j].z * v[j].z + v[j].w * v[j].w); s1 += (v[j].x + v[j].y) + (v[j].z + v[j].w); }
        const bool isq = lane < 32, iskv = lane >= 32 && lane < 48, ispe = lane >= 48 && lane < 51, isix = lane >= 51 && lane < 59;
        const float ssq = wave_sum(isq ? ss : 0.f), sskv = wave_sum(iskv ? ss : 0.f), mean = wave_sum(isix ? s1 : 0.f) * (1.f / 128.f);
        float d2 = 0.f;
#pragma unroll
        for (int j = 0; j < 4; ++j) { const f32x4 d = v[j] - mean; d2 += (d.x * d.x + d.y * d.y) + (d.z * d.z + d.w * d.w); }
        const float var = wave_sum(isix ? d2 : 0.f) * (1.f / 128.f);
        const float rq = 1.0f / sqrtf(ssq * (1.f / 512.f) + NORM_EPS), rkv = 1.0f / sqrtf(sskv * (1.f / 256.f) + NORM_EPS), rstd = 1.0f / sqrtf(var + NORM_EPS);
        if (isq || iskv) {
            const float* gp = isq ? qn + 16 * lane : kvn + 16 * (lane - 32); const float rs = isq ? rq : rkv;
            bf16* dst = isq ? CQN + (size_t)ml * 512 + 16 * lane : LATC + (size_t)ml * 256 + 16 * (lane - 32);
            u32x4 o[2];
#pragma unroll
            for (int j = 0; j < 4; ++j) { const f32x4 g = *(const f32x4*)(gp + 4 * j); const f32x4 y = v[j] * rs * g; o[j >> 1][(j & 1) * 2] = pk2(y.x, y.y); o[j >> 1][(j & 1) * 2 + 1] = pk2(y.z, y.w); }
            *(u32x4*)dst = o[0]; *(u32x4*)(dst + 8) = o[1];
        } else if (ispe) {
#pragma unroll
            for (int j = 0; j < 4; ++j) *(LAS f32x4*)(buf + (lane - 48) * 16 + 4 * j) = v[j];
        } else if (isix) {
#pragma unroll
            for (int j = 0; j < 4; ++j) { const f32x4 g = *(const f32x4*)(lng + (lane - 51) * 16 + 4 * j), b = *(const f32x4*)(lnb + (lane - 51) * 16 + 4 * j); *(LAS f32x4*)(buf + 48 + (lane - 51) * 16 + 4 * j) = (v[j] - mean) * rstd * g + b; }
        } else if (lane == 59) {
#pragma unroll
            for (int j = 0; j < 4; ++j) *(f32x4*)(WIDX + (size_t)ml * 16 + 4 * j) = v[j] * DSA_WIDX_SCALE;
        }
        LDS_WAIT();
        if (lane < 24) { const float x1 = buf[lane], x2 = buf[24 + lane], c = c48[(size_t)mg * 24 + lane], s = s48[(size_t)mg * 24 + lane];
            KPE[(size_t)ml * 48 + lane] = f2bf(x1 * c - x2 * s); KPE[(size_t)ml * 48 + 24 + lane] = f2bf(x1 * s + x2 * c);
        } else if (lane < 40) { const int i = lane - 24; const float x1 = buf[48 + i], x2 = buf[48 + 16 + i], c = c32[(size_t)mg * 16 + i], s = s32[(size_t)mg * 16 + i];
            KIDX[kfb + (size_t)((i >> 3) * 32) * 8 + (i & 7)] = f2bf(x1 * c - x2 * s); KIDX[kfb + (size_t)(64 + (i >> 3) * 32) * 8 + (i & 7)] = f2bf(x1 * s + x2 * c);
        } else { const int d = 32 + 4 * (lane - 40); const f32x4 y = *(const LAS f32x4*)(buf + 48 + d); u32x2 w; w.x = pk2(y.x, y.y); w.y = pk2(y.z, y.w); *(u32x2*)(KIDX + kfb + (size_t)((d >> 4) * 64 + ((d >> 3) & 1) * 32) * 8 + (d & 7)) = w; }
        LDS_WAIT();
    }
}
DI int wave_iscan_dpp(int v) {
    v += __builtin_amdgcn_update_dpp(0, v, 0x111, 0xf, 0xf, true); v += __builtin_amdgcn_update_dpp(0, v, 0x112, 0xf, 0xf, true);
    v += __builtin_amdgcn_update_dpp(0, v, 0x114, 0xf, 0xf, true); v += __builtin_amdgcn_update_dpp(0, v, 0x118, 0xf, 0xf, true);
    v += __builtin_amdgcn_update_dpp(0, v, 0x142, 0xa, 0xf, false);
    v += __builtin_amdgcn_update_dpp(0, v, 0x143, 0xc, 0xf, false);
    return v;
}
DI int wave_isum_dpp(int v) {
    v += __builtin_amdgcn_update_dpp(0, v, 0x111, 0xf, 0xf, true); v += __builtin_amdgcn_update_dpp(0, v, 0x112, 0xf, 0xf, true);
    v += __builtin_amdgcn_update_dpp(0, v, 0x114, 0xf, 0xf, true); v += __builtin_amdgcn_update_dpp(0, v, 0x118, 0xf, 0xf, true);
    v += __builtin_amdgcn_update_dpp(0, v, 0x142, 0xa, 0xf, false);
    v += __builtin_amdgcn_update_dpp(0, v, 0x143, 0xc, 0xf, false);
    return __builtin_amdgcn_readlane(v, 63);
}
DI unsigned f2sortable(float s) { const unsigned b = __builtin_bit_cast(unsigned, s); return (b & 0x80000000u) ? ~b : (b | 0x80000000u); }
DI void ph_dsa_index(const Frame& F, const int half) {
    const float* c32 = (const float*)(F.ws + TAB_COS32); const float* s32 = (const float*)(F.ws + TAB_SIN32);
    unsigned char* ar = F.ws + WS_AR;
    const bf16* QIDX = (const bf16*)(ar + DA_QIDX); const bf16* KIDX = (const bf16*)(ar + DA_KIDX); const float* WIDX = (const float*)(ar + DA_WIDX);
    unsigned short* SEL = (unsigned short*)(ar + DA_SEL); int* CNT = (int*)(ar + DA_CNT); float* SC = (float*)(ar + DA_SC) + (size_t)F.gw * 16384;
    const int lane = F.lane, r = lane & 31, hf = lane >> 5;
    LAS unsigned char* wl = F.lds + F.wave * 8192 + lane * 16;
    LAS unsigned* hist = (LAS unsigned*)(F.lds + 65536 + F.wave * 1024);
#pragma unroll 1
    for (int tile = blockIdx.x; tile < BPH * 128; tile += F.G) {
        const int j = tile >> 8, c8 = tile & 255, c7 = c8 & 127, bl = (c8 >> 7) * 2 + j, qt = j ? 127 - c7 : c7;
        const int q0 = qt * 32 + 4 * F.wave;
        const int ntile = (q0 + 3) / 32 + 1;
        bf16x8 qa[2][8];
#pragma unroll
        for (int pr = 0; pr < 2; ++pr) {
            const int mrow = bl * SEQ + q0 + 2 * pr + (r >> 4);
#pragma unroll
            for (int s = 0; s < 8; ++s) qa[pr][s] = *(const bf16x8*)(QIDX + (size_t)mrow * 2048 + (r & 15) * 128 + 16 * s + 8 * hf);
            { const float* cs = c32 + ((size_t)half * MC + mrow) * 16 + 8 * hf; const float* sn = s32 + ((size_t)half * MC + mrow) * 16 + 8 * hf;
              const f32x4 c0 = *(const f32x4*)cs, c1 = *(const f32x4*)(cs + 4), s0 = *(const f32x4*)sn, s1 = *(const f32x4*)(sn + 4);
              const u32x4 a = __builtin_bit_cast(u32x4, qa[pr][0]), b = __builtin_bit_cast(u32x4, qa[pr][1]); u32x4 o1, o2;
#pragma unroll
              for (int e = 0; e < 4; ++e) { const float c_l = e < 2 ? c0[2 * e] : c1[2 * e - 4], c_h = e < 2 ? c0[2 * e + 1] : c1[2 * e - 3], s_l = e < 2 ? s0[2 * e] : s1[2 * e - 4], s_h = e < 2 ? s0[2 * e + 1] : s1[2 * e - 3];
                  const float x1l = bflo(a[e]), x1h = bfhi(a[e]), x2l = bflo(b[e]), x2h = bfhi(b[e]);
                  o1[e] = pk2(x1l * c_l - x2l * s_l, x1h * c_h - x2h * s_h); o2[e] = pk2(x1l * s_l + x2l * c_l, x1h * s_h + x2h * c_h); }
              qa[pr][0] = __builtin_bit_cast(bf16x8, o1); qa[pr][1] = __builtin_bit_cast(bf16x8, o2); }
            float wv[2][16];
#pragma unroll
            for (int i = 0; i < 16; ++i) wv[pr][i] = WIDX[(size_t)(bl * SEQ + q0 + 2 * pr + (i >> 3)) * 16 + (i & 3) + 8 * ((i >> 2) & 1) + 4 * hf];
#pragma unroll
            for (int i = 0; i < 16; i += 4) *(LAS f32x4*)(wl + (pr * 4 + (i >> 2)) * 1024) = (f32x4){wv[pr][i], wv[pr][i + 1], wv[pr][i + 2], wv[pr][i + 3]};
        }
        LDS_WAIT();
        {
        bf16x8 kf[8];
        { const bf16* kp = KIDX + ((size_t)(bl * 128) * 8 * 64 + lane) * 8;
#pragma unroll
          for (int s = 0; s < 8; ++s) kf[s] = *(const bf16x8*)(kp + 512 * s); }
#pragma unroll 1
        for (int t = 0; t < ntile; ++t) {
            f32x16 accs[2];
#pragma unroll
            for (int pr = 0; pr < 2; ++pr) {
#pragma unroll
                for (int i = 0; i < 16; ++i) accs[pr][i] = 0.f;
#pragma unroll
                for (int s = 0; s < 8; ++s) accs[pr] = MFMA32(qa[pr][s], kf[s], accs[pr]);
            }
            if (t + 1 < ntile) { const bf16* kp = KIDX + ((size_t)(bl * 128 + t + 1) * 8 * 64 + lane) * 8;
#pragma unroll
                for (int s = 0; s < 8; ++s) kf[s] = *(const bf16x8*)(kp + 512 * s); }
#pragma unroll
            for (int pr = 0; pr < 2; ++pr) {
                const f32x16 acc = accs[pr];
                float wv[2][16];
                { unsigned wa_ = (unsigned)(size_t)wl; asm volatile("" : "+v"(wa_));
#pragma unroll
                  for (int i = 0; i < 16; i += 4) { const f32x4 w4 = *(const LAS f32x4*)((LAS unsigned char*)(size_t)wa_ + (pr * 4 + (i >> 2)) * 1024); wv[pr][i] = w4.x; wv[pr][i + 1] = w4.y; wv[pr][i + 2] = w4.z; wv[pr][i + 3] = w4.w; } }
                float p0 = 0.f, p1 = 0.f;
#pragma unroll
                for (int i = 0; i < 8; ++i) { p0 += wv[pr][i] * fmaxf(acc[i], 0.f); p1 += wv[pr][8 + i] * fmaxf(acc[8 + i], 0.f); }
                const float t0 = p0 + __shfl_xor(p0, 32), t1 = p1 + __shfl_xor(p1, 32);
                SC[(pr * 128 + t) * 64 + lane] = hf ? t1 : t0;
            }
        }
        }
        VM_WAIT();
#pragma unroll 1
        for (int qi = 0; qi < 4; ++qi) {
            const int tq = q0 + qi, pr = qi >> 1, qs = qi & 1;
            unsigned u[64];
            const unsigned* scp = (const unsigned*)(SC + pr * 8192 + hf * 64 + qs * 32 + r);
#pragma unroll
            for (int g8 = 0; g8 < 8; ++g8) {
#pragma unroll
                for (int e = 0; e < 8; ++e) { const int i = 8 * g8 + e; const float s = __builtin_bit_cast(float, __hip_atomic_load(scp + e * 128, __ATOMIC_RELAXED, __HIP_MEMORY_SCOPE_AGENT));
                    u[i] = (2 * i + hf < ntile && 64 * i + lane <= tq) ? f2sortable(s) : 0u; }
                scp += 1024; asm volatile("" : "+v"(scp));
            }
            unsigned prefix = 0u;
            if (tq >= 256) {
#pragma unroll 1
                for (int bit = 31; bit >= 0; --bit) {
                    const unsigned cand = prefix | (1u << bit); int c = 0;
#pragma unroll
                    for (int g8 = 0; g8 < 8; ++g8) { if (g8 * 512 <= tq) {
#pragma unroll
                        for (int e = 0; e < 8; ++e) c += (u[8 * g8 + e] >= cand) ? 1 : 0; } }
                    c = wave_isum_dpp(c);
                    if (c >= 256) prefix = cand;
                    if (c == 256) break;
                }
            }
            const unsigned T = prefix > 1u ? prefix : 1u;
            int nl = 0;
#pragma unroll
            for (int g8 = 0; g8 < 8; ++g8) { if (g8 * 512 <= tq) {
#pragma unroll
                for (int e = 0; e < 8; ++e) nl += (u[8 * g8 + e] >= T) ? 1 : 0; } }
            const int inc = wave_iscan_dpp(nl), base = __builtin_amdgcn_readlane(inc, 63);
            int pos = inc - nl;
            unsigned short* sel = SEL + (size_t)(bl * SEQ + tq) * 256;
#pragma unroll
            for (int g8 = 0; g8 < 8; ++g8) { if (g8 * 512 <= tq) {
#pragma unroll
                for (int e = 0; e < 8; ++e) { const int i = 8 * g8 + e; if (u[i] >= T) { if (pos < 256) sel[pos] = (unsigned short)(64 * i + lane); ++pos; } } } }
            if (lane == 0) CNT[bl * SEQ + tq] = base < 256 ? base : 256;
        }
    }
}
DI int dsa_fsw(int row) { return ((row & 3) << 2) | ((row >> 2) & 3); }
struct DsaPre { u32x4 row[16]; bf16x8 kpe[3]; bf16x8 q[3]; };
DI void dsa_prefetch(DsaPre& P, const bf16* LATC, const bf16* KPE, const bf16* QL, const bf16* QPE, const float* c48, const float* s48, int half, int ml, int selv, int lane, int w) {
    const int bl = ml >> 12, r = lane & 31, h = lane >> 5;
#pragma unroll
    for (int it = 0; it < 16; ++it) { const int ki = __shfl(selv, (lane >> 5) + 2 * it); P.row[it] = *(const u32x4*)(LATC + (size_t)(bl * SEQ + ki) * 256 + (lane & 31) * 8); }
#pragma unroll
    for (int s = 0; s < 3; ++s) P.kpe[s] = *(const bf16x8*)(KPE + (size_t)(bl * SEQ + selv) * 48 + 16 * s + 8 * h);
#pragma unroll
    for (int j = 0; j < 3; ++j) { const int fi = w + 8 * j;
        if (fi < 16) P.q[j] = *(const bf16x8*)(QL + (size_t)ml * 8192 + r * 256 + 16 * fi + 8 * h);
        else if (fi < 19) P.q[j] = rope_frag32(QPE + (size_t)ml * 1536 + r * 48, fi - 16, h, c48 + ((size_t)half * MC + ml) * 24, s48 + ((size_t)half * MC + ml) * 24); }
}
DI void ph_dsa_attn(const Frame& F, const int half) {
    const float* c48 = (const float*)(F.ws + TAB_COS48); const float* s48 = (const float*)(F.ws + TAB_SIN48);
    unsigned char* ar = F.ws + WS_AR;
    bf16* QL = (bf16*)(ar + DA_QL); const bf16* QPE = (const bf16*)(ar + DA_QPE); const bf16* LATC = (const bf16*)(ar + DA_LATC); const bf16* KPE = (const bf16*)(ar + DA_KPE);
    const unsigned short* SEL = (const unsigned short*)(ar + DA_SEL); const int* CNT = (const int*)(ar + DA_CNT);
    const int lane = F.lane, r = lane & 31, h = lane >> 5, w = F.wave;
    LAS unsigned char* IMG = F.lds; LAS unsigned char* QB = F.lds + LDSCTL_OFF + 256; LAS float* MX = (LAS float*)(F.lds + LDSCTL_OFF + 256 + 19456); LAS float* SX = MX + 256;
    const int i16 = lane & 15, tq_ = i16 >> 2, tp_ = i16 & 3, blk = (lane >> 4) & 1;
    int ml = blockIdx.x;
    if (ml >= MC) return;
    DsaPre P;
    int cnt_c = CNT[ml];
    { const int slot = 32 * w + r; const int selv = slot < cnt_c ? (int)SEL[(size_t)ml * 256 + slot] : 0; dsa_prefetch(P, LATC, KPE, QL, QPE, c48, s48, half, ml, selv, lane, w); }
    int cnt_n = 0, selv_n = 0;
    if (ml + F.G < MC) { cnt_n = CNT[ml + F.G]; const int slot = 32 * w + r; selv_n = slot < cnt_n ? (int)SEL[(size_t)(ml + F.G) * 256 + slot] : 0; }
#pragma unroll 1
    for (; ml < MC; ml += F.G) {
        const int cnt = cnt_c, nch = (cnt + 31) >> 5; const bool act = w < nch;
#pragma unroll
        for (int it = 0; it < 16; ++it) { const int rr = (lane >> 5) + 2 * it; *(LAS u32x4*)(IMG + (32 * w + rr) * 512 + (((lane & 31) ^ dsa_fsw(rr)) * 16)) = P.row[it]; }
#pragma unroll
        for (int j = 0; j < 3; ++j) { const int fi = w + 8 * j; if (fi < 19) *(LAS bf16x8*)(QB + fi * 1024 + lane * 16) = P.q[j]; }
        bf16x8 kpe[3];
#pragma unroll
        for (int s = 0; s < 3; ++s) kpe[s] = P.kpe[s];
        LDS_WAIT(); __builtin_amdgcn_s_barrier(); asm volatile("" ::: "memory");
        if (ml + F.G < MC) {
            dsa_prefetch(P, LATC, KPE, QL, QPE, c48, s48, half, ml + F.G, selv_n, lane, w); cnt_c = cnt_n;
            if (ml + 2 * F.G < MC) { cnt_n = CNT[ml + 2 * F.G]; const int slot = 32 * w + r; selv_n = slot < cnt_n ? (int)SEL[(size_t)(ml + 2 * F.G) * 256 + slot] : 0; }
        }
        f32x16 S; float mx = -INFINITY;
#pragma unroll
        for (int i = 0; i < 16; ++i) S[i] = 0.f;
        if (act) {
#pragma unroll
            for (int s = 0; s < 16; ++s) S = MFMA32(*(const LAS bf16x8*)(IMG + (32 * w + r) * 512 + (((2 * s + h) ^ dsa_fsw(r)) * 16)), *(const LAS bf16x8*)(QB + s * 1024 + lane * 16), S);
#pragma unroll
            for (int s = 0; s < 3; ++s) S = MFMA32(kpe[s], *(const LAS bf16x8*)(QB + (16 + s) * 1024 + lane * 16), S);
#pragma unroll
            for (int i = 0; i < 16; ++i) { S[i] = (32 * w + crow(i, h) < cnt) ? S[i] : -INFINITY; mx = fmaxf(mx, S[i]); }
            mx = fmaxf(mx, __shfl_xor(mx, 32));
        }
        if (h == 0) MX[w * 32 + r] = mx;
        LDS_WAIT(); __builtin_amdgcn_s_barrier(); asm volatile("" ::: "memory");
        float M = MX[r];
#pragma unroll
        for (int k = 1; k < 8; ++k) M = fmaxf(M, MX[k * 32 + r]);
        float lsum = 0.f; bf16x8 pf[2] = {(bf16x8){0, 0, 0, 0, 0, 0, 0, 0}, (bf16x8){0, 0, 0, 0, 0, 0, 0, 0}};
        if (act) {
#pragma unroll
            for (int i = 0; i < 16; ++i) { S[i] = __builtin_amdgcn_exp2f(S[i] - M); lsum += S[i]; }
#pragma unroll
            for (int s = 0; s < 2; ++s) { u32x4 t; t.x = pk2(S[8 * s], S[8 * s + 1]); t.y = pk2(S[8 * s + 2], S[8 * s + 3]); t.z = pk2(S[8 * s + 4], S[8 * s + 5]); t.w = pk2(S[8 * s + 6], S[8 * s + 7]); pf[s] = __builtin_bit_cast(bf16x8, t); }
        }
        lsum += __shfl_xor(lsum, 32);
        if (h == 0) SX[w * 32 + r] = lsum;
        *(LAS bf16x8*)(QB + (2 * w) * 1024 + lane * 16) = pf[0]; *(LAS bf16x8*)(QB + (2 * w + 1) * 1024 + lane * 16) = pf[1];
        LDS_WAIT(); __builtin_amdgcn_s_barrier(); asm volatile("" ::: "memory");
        f32x16 O;
#pragma unroll
        for (int i = 0; i < 16; ++i) O[i] = 0.f;
#pragma unroll 2
        for (int ks = 0; ks < 2 * nch; ++ks) {
            const int r0 = 16 * ks + 4 * h + tq_, r1 = r0 + 8, pc = 4 * w + 2 * blk + (tp_ >> 1);
            const s16x4 lo = __builtin_bit_cast(s16x4, __builtin_amdgcn_ds_read_tr16_b64_v4i16((LAS v4i16_t*)(IMG + r0 * 512 + ((pc ^ dsa_fsw(r0)) * 16) + 8 * (tp_ & 1))));
            const s16x4 hi = __builtin_bit_cast(s16x4, __builtin_amdgcn_ds_read_tr16_b64_v4i16((LAS v4i16_t*)(IMG + r1 * 512 + ((pc ^ dsa_fsw(r1)) * 16) + 8 * (tp_ & 1))));
            O = MFMA32(__builtin_shufflevector(lo, hi, 0, 1, 2, 3, 4, 5, 6, 7), *(const LAS bf16x8*)(QB + ks * 1024 + lane * 16), O);
        }
        float l = SX[r];
#pragma unroll
        for (int k = 1; k < 8; ++k) l += SX[k * 32 + r];
        const float linv = 1.0f / l;
        bf16* o = QL + (size_t)ml * 8192 + r * 256 + 32 * w + 4 * h;
#pragma unroll
        for (int g = 0; g < 4; ++g) { u32x2 t; t.x = pk2(O[4 * g] * linv, O[4 * g + 1] * linv); t.y = pk2(O[4 * g + 2] * linv, O[4 * g + 3] * linv); *(u32x2*)(o + 8 * g) = t; }
        LDS_WAIT(); __builtin_amdgcn_s_barrier(); asm volatile("" ::: "memory");
    }
}
template <int NDB, bool RESC = true> DI void softmax_step(f32x16& S, float& m, float& l, f32x16 (&O)[NDB], bf16x8 (&pf)[2]) {
    float mx = fmaxf(S[0], S[1]);
#pragma unroll
    for (int i = 2; i < 16; i += 2) mx = __builtin_fmaxf(mx, __builtin_fmaxf(S[i], S[i + 1]));
    mx = fmaxf(mx, __shfl_xor(mx, 32));
    const float mn = fmaxf(m, mx), ms = (mn == -INFINITY) ? 0.f : mn;
    const float alpha = __builtin_amdgcn_exp2f(m - ms);
    float sum = 0.f;
#pragma unroll
    for (int i = 0; i < 16; ++i) { S[i] = __builtin_amdgcn_exp2f(S[i] - ms); sum += S[i]; }
    l = l * alpha + sum; m = mn;
    if (RESC && __builtin_amdgcn_ballot_w64(alpha != 1.0f) != 0ull) {
#pragma unroll
        for (int db = 0; db < NDB; ++db)
#pragma unroll
            for (int i = 0; i < 16; ++i) O[db][i] *= alpha;
    }
#pragma unroll
    for (int s = 0; s < 2; ++s) { u32x4 w; w.x = pk2(S[8 * s], S[8 * s + 1]); w.y = pk2(S[8 * s + 2], S[8 * s + 3]); w.z = pk2(S[8 * s + 4], S[8 * s + 5]); w.w = pk2(S[8 * s + 6], S[8 * s + 7]); pf[s] = __builtin_bit_cast(bf16x8, w); }
}
template <bool ACC> DI void store_col(bf16* out, const f32x16 (&O)[4], float scale, int h) {
#pragma unroll
    for (int db = 0; db < 4; ++db)
#pragma unroll
        for (int g = 0; g < 4; ++g) { u32x2* p = (u32x2*)(out + db * 32 + 8 * g + 4 * h);
            float a = O[db][4 * g] * scale, b = O[db][4 * g + 1] * scale, c = O[db][4 * g + 2] * scale, d = O[db][4 * g + 3] * scale;
            if (ACC) { const u32x2 o = *p; a += bflo(o.x); b += bfhi(o.x); c += bflo(o.y); d += bfhi(o.y); }
            u32x2 w; w.x = pk2(a, b); w.y = pk2(c, d); *p = w; }
}
template <int NQ> struct TilePre { u32x4 a, b, c; };
template <int NQ, class SRC> DI void tile_fetch(TilePre<NQ>& p, const SRC& src, int T, int tid) {
    const bf16* k = src.k(T); const bf16* v = src.v(T);
    constexpr int NK = NQ * 64;
    p.a = *(const u32x4*)(k + (size_t)tid * 8);
    const int p1 = tid + 512; p.b = (p1 < NK) ? *(const u32x4*)(k + (size_t)p1 * 8) : *(const u32x4*)(v + (size_t)(p1 - NK) * 8);
    if (NQ * 64 + 512 > 1024) { const int p2 = tid + 1024; if (p2 < NK + 512) p.c = *(const u32x4*)(v + (size_t)(p2 - NK) * 8); }
}
template <int NQ> DI void tile_put(const TilePre<NQ>& p, LAS unsigned char* buf, int tid) {
    *(LAS u32x4*)(buf + tid * 16) = p.a; *(LAS u32x4*)(buf + (tid + 512) * 16) = p.b;
    if (NQ * 64 + 512 > 1024) { if (tid + 1024 < NQ * 64 + 512) *(LAS u32x4*)(buf + (tid + 1024) * 16) = p.c; }
}
template <int NQ, bool PV, class SRC, class MK>
DI void attn_run_sh(LAS unsigned char* tl, int tid, int lane, const bf16x8 (&qf)[NQ], f32x16 (&O)[4], float& m, float& l, int TB, int TE, int tb, int te, const SRC& src, const MK& mk) {
    constexpr int TBYTES = (NQ + 8) * 1024;
    if (TB >= TE) return;
    TilePre<NQ> pre;
    tile_fetch<NQ>(pre, src, TB, tid); tile_put<NQ>(pre, tl, tid);
    LDS_WAIT(); __builtin_amdgcn_s_barrier(); asm volatile("" ::: "memory");
#pragma unroll 1
    for (int T = TB; T < TE; ++T) {
        LAS unsigned char* cur = tl + ((T - TB) & 1) * TBYTES;
        if (T + 1 < TE) tile_fetch<NQ>(pre, src, T + 1, tid);
        if (T >= tb && T < te) {
            f32x16 S;
#pragma unroll
            for (int i = 0; i < 16; ++i) S[i] = 0.f;
#pragma unroll
            for (int s = 0; s < NQ; ++s) S = MFMA32(*(const LAS bf16x8*)(cur + s * 1024 + lane * 16), qf[s], S);
            if (mk.need(T)) mk(T, S);
            bf16x8 pf[2]; softmax_step<4, PV>(S, m, l, O, pf);
            if (PV) {
#pragma unroll
                for (int db = 0; db < 4; ++db)
#pragma unroll
                    for (int s = 0; s < 2; ++s) O[db] = MFMA32(*(const LAS bf16x8*)(cur + (NQ + db * 2 + s) * 1024 + lane * 16), pf[s], O[db]);
            }
        }
        if (T + 1 < TE) tile_put<NQ>(pre, tl + ((T + 1 - TB) & 1) * TBYTES, tid);
        LDS_WAIT(); __builtin_amdgcn_s_barrier(); asm volatile("" ::: "memory");
    }
}
struct FragSrc { const bf16* kb; const bf16* vb; int nq; DI const bf16* k(int T) const { return kb + (size_t)T * nq * 512; } DI const bf16* v(int T) const { return vb + (size_t)T * 8 * 512; } };
constexpr size_t FA_Q = 0, FA_K = 64 * MiB, FA_F = 128 * MiB, FA_V = 136 * MiB, FA_CUM = 200 * MiB, FA_O = 202 * MiB, FA_KF = 266 * MiB, FA_VF = 338 * MiB;
constexpr size_t FW_IN = 0, FW_OUT = (size_t)6400 * 2048;
constexpr float FOX_QSCALE = 0.08838834764831845f * LOG2E;
DI void ph_fox_cvt(const Frame& F, const float* w_in, const float* w_out) {
    bf16* WB = (bf16*)(F.ws + WS_WMIX);
    cvt_job(F, w_in, 6160, DM, 0, 2048, WB + FW_IN, DM, 0, FOX_QSCALE);
    cvt_job(F, w_in, 6160, DM, 2048, 2048, WB + FW_IN, DM, 2048, 1.f);
    cvt_job(F, w_in, 6160, DM, 4096, 2048, WB + FW_IN, DM, 4352, 1.f);
    cvt_job(F, w_in, 6160, DM, 6144, 16, WB + FW_IN, DM, 4096, 1.f);
    zero_bf16(F, WB + FW_IN + (size_t)4112 * DM, (size_t)240 * DM);
    cvt_job(F, w_out, DM, DM, 0, DM, WB + FW_OUT, DM, 0, 1.f);
}
DI void ph_fox_scan(const Frame& F, const float* b_f) {
    unsigned char* ar = F.ws + WS_AR; const bf16* FB = (const bf16*)(ar + FA_F); float* CUM = (float*)(ar + FA_CUM);
    for (int w = F.gw; w < BPH * 16; w += F.NGW) {
        const int bl = w >> 4, hd = w & 15; const float bf_ = b_f[hd];
        float v[64]; float run = 0.f;
#pragma unroll
        for (int i = 0; i < 64; ++i) { const float x = bf2f(FB[(size_t)(bl * SEQ + F.lane * 64 + i) * 256 + hd]) + bf_;
            const float ls = fminf(x, 0.f) - log1pf(expf(-fabsf(x))); run += ls; v[i] = run; }
        float inc = run;
#pragma unroll
        for (int o = 1; o < 64; o <<= 1) { const float y = __shfl_up(inc, o); if (F.lane >= o) inc += y; }
        const float base = inc - run;
        float* dst = CUM + (size_t)w * SEQ + F.lane * 64;
#pragma unroll
        for (int i = 0; i < 64; i += 4) *(f32x4*)(dst + i) = (f32x4){(v[i] + base) * LOG2E, (v[i + 1] + base) * LOG2E, (v[i + 2] + base) * LOG2E, (v[i + 3] + base) * LOG2E};
        bf16* KF9 = (bf16*)(ar + FA_KF) + (size_t)w * 128 * 9 * 512;
#pragma unroll
        for (int i = 0; i < 64; ++i) { const int p = F.lane * 64 + i, tile = p >> 5, r_ = p & 31; const float c = (v[i] + base) * LOG2E;
            const unsigned short hi = f2bf(c); const float c1 = c - bf2f(hi); const unsigned short mid = f2bf(c1); const unsigned short lo = f2bf(c1 - bf2f(mid));
            u32x4 wv; wv.x = 0x3F803F80u; wv.y = 0x3F80u | ((unsigned)(hi ^ 0x8000u) << 16); wv.z = (unsigned)(mid ^ 0x8000u) | ((unsigned)(lo ^ 0x8000u) << 16); wv.w = 0u;
            bf16* d = KF9 + ((size_t)(tile * 9 + 8) * 64 + r_) * 8;
            *(u32x4*)d = wv; *(u32x4*)(d + 32 * 8) = (u32x4){0u, 0u, 0u, 0u}; }
    }
}
struct FoxMK { int tq, h, qt; DI bool need(int t) const { return t == qt; }
    DI void operator()(int t, f32x16& S) const {
#pragma unroll
        for (int i = 0; i < 16; ++i) S[i] = (32 * t + crow(i, h) <= tq) ? S[i] : -INFINITY;
    } };
DI void ph_fox_attn(const Frame& F) {
    unsigned char* ar = F.ws + WS_AR; const bf16* Q = (const bf16*)(ar + FA_Q); const bf16* KF = (const bf16*)(ar + FA_KF); const bf16* VF = (const bf16*)(ar + FA_VF); const float* CUM = (const float*)(ar + FA_CUM); bf16* Ob = (bf16*)(ar + FA_O);
    const int r = F.lane & 31, h = F.lane >> 5;
    for (int wb = blockIdx.x; wb < BPH * 16 * 4; wb += F.G) {
        const int bh = wb >> 2, x = (wb & 3) * 8 + F.wave, bl = bh >> 4, hd = bh & 15;
#pragma unroll 1
        for (int k = 0; k < 4; ++k) {
            const int qt = (k == 0) ? x : (k == 1) ? 63 - x : (k == 2) ? 64 + x : 127 - x;
            const int qhi = (k == 0) ? (wb & 3) * 8 + 7 : (k == 1) ? 63 - (wb & 3) * 8 : (k == 2) ? 64 + (wb & 3) * 8 + 7 : 127 - (wb & 3) * 8;
            const int tq = qt * 32 + r; const size_t mrow = (size_t)bl * SEQ + tq;
            bf16x8 qf[9];
#pragma unroll
            for (int s = 0; s < 8; ++s) qf[s] = *(const bf16x8*)(Q + mrow * DM + hd * 128 + 16 * s + 8 * h);
            { const float ct = CUM[(size_t)bh * SEQ + tq]; const unsigned short hi = f2bf(ct); const float c1 = ct - bf2f(hi); const unsigned short mid = f2bf(c1); const unsigned short lo = f2bf(c1 - bf2f(mid));
              u32x4 wq; wq.x = (unsigned)hi | ((unsigned)mid << 16); wq.y = (unsigned)lo | (0x3F80u << 16); wq.z = 0x3F803F80u; wq.w = 0u;
              if (h) wq = (u32x4){0u, 0u, 0u, 0u};
              qf[8] = __builtin_bit_cast(bf16x8, wq); }
            f32x16 O[4];
#pragma unroll
            for (int db = 0; db < 4; ++db)
#pragma unroll
                for (int i = 0; i < 16; ++i) O[db][i] = 0.f;
            float m = -INFINITY, l = 0.f;
            const FragSrc src{KF + (size_t)bh * 128 * 9 * 512, VF + (size_t)bh * 128 * 8 * 512, 9}; const FoxMK mk{tq, h, qt};
            attn_run_sh<9, true>(F.lds, F.tid, F.lane, qf, O, m, l, 0, qhi + 1, 0, qt + 1, src, mk);
            l += __shfl_xor(l, 32);
            store_col<false>(Ob + mrow * DM + hd * 128, O, l > 0.f ? 1.0f / l : 0.f, h);
        }
    }
}
typedef long fp8x8_t;
DI fp8x8_t pack_fp8x8(float a0, float a1, float a2, float a3, float a4, float a5, float a6, float a7) {
    int lo = 0, hi = 0;
    lo = __builtin_amdgcn_cvt_pk_fp8_f32(a0, a1, lo, false); lo = __builtin_amdgcn_cvt_pk_fp8_f32(a2, a3, lo, true);
    hi = __builtin_amdgcn_cvt_pk_fp8_f32(a4, a5, hi, false); hi = __builtin_amdgcn_cvt_pk_fp8_f32(a6, a7, hi, true);
    return (fp8x8_t)(((unsigned long long)(unsigned)hi << 32) | (unsigned long long)(unsigned)lo);
}
#define MFMA32F8(a, b, c) __builtin_amdgcn_mfma_f32_32x32x16_fp8_fp8((a), (b), (c), 0, 0, 0)
constexpr size_t NA_Q = 0, NA_KC = 288 * MiB, NA_VC = 313 * MiB, NA_KSR = 330 * MiB, NA_KWR = 354 * MiB, NA_GT = 378 * MiB, NA_VSR = 386 * MiB, NA_VWR = 402 * MiB, NA_GK = 418 * MiB, NA_GV = 420 * MiB,
                 NA_KCMP = 422 * MiB, NA_VCT = 424 * MiB, NA_SELB = 426 * MiB, NA_O = 428 * MiB,
                 NA_KSF = 620 * MiB, NA_KWF = 644 * MiB, NA_VSF = 668 * MiB, NA_VWF = 684 * MiB;
constexpr size_t NW_IN = 0, NW_W1K = (size_t)13312 * 2048, NW_W1V = NW_W1K + (size_t)256 * 6144, NW_W2K = NW_W1V + (size_t)256 * 4096, NW_W2V = NW_W2K + 65536, NW_OUT = NW_W2V + 65536;
constexpr float NSA_QSCALE = 0.07216878364870322f * LOG2E;
DI void ph_nsa_cvt(const Frame& F, const float* w_in, const float* k_pe, const float* k_w1, const float* k_b1, const float* k_w2, const float* v_pe, const float* v_w1, const float* v_b1, const float* v_w2, const float* w_out) {
    bf16* WB = (bf16*)(F.ws + WS_WMIX); float* BIAS = (float*)(F.ws + WS_MISC);
    cvt_job(F, w_in, 13200, DM, 0, 9216, WB + NW_IN, DM, 0, NSA_QSCALE);
    cvt_job(F, w_in, 13200, DM, 9216, 768, WB + NW_IN, DM, 9216, 1.f);
    cvt_job(F, w_in, 13200, DM, 9984, 512, WB + NW_IN, DM, 9984, 1.f);
    cvt_job(F, w_in, 13200, DM, 10496, 768, WB + NW_IN, DM, 10496, 1.f);
    cvt_job(F, w_in, 13200, DM, 11776, 768, WB + NW_IN, DM, 11264, 1.f);
    cvt_job(F, w_in, 13200, DM, 13056, 144, WB + NW_IN, DM, 12032, 1.f);
    zero_bf16(F, WB + NW_IN + (size_t)12176 * DM, (size_t)112 * DM);
    cvt_job(F, w_in, 13200, DM, 11264, 512, WB + NW_IN, DM, 12288, 1.f);
    cvt_job(F, w_in, 13200, DM, 12544, 512, WB + NW_IN, DM, 12800, 1.f);
    cvt_job(F, k_w1, 256, 6144, 0, 256, WB + NW_W1K, 6144, 0, 1.f);
    cvt_job(F, v_w1, 256, 4096, 0, 256, WB + NW_W1V, 4096, 0, 1.f);
    cvt_job(F, k_w2, 192, 256, 0, 192, WB + NW_W2K, 256, 0, 1.f); zero_bf16(F, WB + NW_W2K + 192 * 256, 64 * 256);
    cvt_job(F, v_w2, 128, 256, 0, 128, WB + NW_W2V, 256, 0, 1.f); zero_bf16(F, WB + NW_W2V + 128 * 256, 128 * 256);
    cvt_job(F, w_out, DM, 6144, 0, DM, WB + NW_OUT, 6144, 0, 1.f);
    for (int w = F.gw; w < 512; w += F.NGW) { const bool isk = w < 256; const int c = w & 255, n = isk ? 6144 : 4096; const float* pe = isk ? k_pe : v_pe; const float* w1 = isk ? k_w1 : v_w1;
        float s = 0.f; for (int i = F.lane; i < n; i += 64) s += pe[i] * w1[(size_t)i * 256 + c];
        s = wave_sum(s); if (F.lane == 0) BIAS[w] = s + (isk ? k_b1[c] : v_b1[c]); }
}
DI void ph_nsa_rope(const Frame& F, int half) {
    unsigned char* ar = F.ws + WS_AR; bf16* Q = (bf16*)(ar + NA_Q); bf16* KC = (bf16*)(ar + NA_KC);
    const bf16* KSR = (const bf16*)(ar + NA_KSR); const bf16* KWR = (const bf16*)(ar + NA_KWR); bf16* KSF = (bf16*)(ar + NA_KSF); bf16* KWF = (bf16*)(ar + NA_KWF);
    const float* c48 = (const float*)(F.ws + TAB_COS48); const float* s48 = (const float*)(F.ws + TAB_SIN48);
    for (int ml = F.gw; ml < MC; ml += F.NGW) {
        const size_t mg = (size_t)half * MC + ml; const int bl = ml >> 12, sq = ml & 4095;
        for (int p = F.lane; p < 96; p += 64) {
            const int hd = 48 + p / 24, i = p - (p / 24) * 24; bf16* q;
            q = KC + ((size_t)(bl * 4 + hd - 48) * 4096 + sq) * 192 + i;
            const float x1 = bf2f(q[0]), x2 = bf2f(q[24]), c = c48[mg * 24 + i], s = s48[mg * 24 + i]; q[0] = f2bf(x1 * c - x2 * s); q[24] = f2bf(x1 * s + x2 * c);
        }
        const int tile = sq >> 5, rr = sq & 31;
        for (int u = F.lane; u < 168; u += 64) {
            const int tens = u / 84, uu = u - tens * 84, g = uu / 21, v = uu - g * 21;
            const bf16* src = (tens ? KWR : KSR) + (size_t)ml * 768 + g * 192;
            bf16* dst = (tens ? KWF : KSF) + ((size_t)((bl * 4 + g) * 128 + tile) * 12 * 64 + rr) * 8;
            if (v < 3) {
                const u32x4 a = *(const u32x4*)(src + 8 * v), b = *(const u32x4*)(src + 8 * v + 24); u32x4 o1, o2;
#pragma unroll
                for (int e = 0; e < 4; ++e) { const float c0 = c48[mg * 24 + 8 * v + 2 * e], s0 = s48[mg * 24 + 8 * v + 2 * e], c1 = c48[mg * 24 + 8 * v + 2 * e + 1], s1 = s48[mg * 24 + 8 * v + 2 * e + 1];
                    const float x1l = bflo(a[e]), x1h = bfhi(a[e]), x2l = bflo(b[e]), x2h = bfhi(b[e]);
                    o1[e] = pk2(x1l * c0 - x2l * s0, x1h * c1 - x2h * s1); o2[e] = pk2(x1l * s0 + x2l * c0, x1h * s1 + x2h * c1); }
                const int p1 = v, p2 = v + 3;
                if (tens) { *(u32x4*)(dst + ((p1 >> 1) * 64 + (p1 & 1) * 32) * 8) = o1; *(u32x4*)(dst + ((p2 >> 1) * 64 + (p2 & 1) * 32) * 8) = o2; }
                else { unsigned char* d8 = (unsigned char*)KSF + ((size_t)(((bl * 4 + g) * 128 + tile) * 2 + (rr >> 4)) * 6 * 64 + (rr & 15)) * 8;
                    *(fp8x8_t*)(d8 + ((p1 >> 2) * 64 + (p1 & 3) * 16) * 8) = pack_fp8x8(bflo(o1[0]), bfhi(o1[0]), bflo(o1[1]), bfhi(o1[1]), bflo(o1[2]), bfhi(o1[2]), bflo(o1[3]), bfhi(o1[3]));
                    *(fp8x8_t*)(d8 + ((p2 >> 2) * 64 + (p2 & 3) * 16) * 8) = pack_fp8x8(bflo(o2[0]), bfhi(o2[0]), bflo(o2[1]), bfhi(o2[1]), bflo(o2[2]), bfhi(o2[2]), bflo(o2[3]), bfhi(o2[3])); }
            } else { const int pc = v + 3; const u32x4 c = *(const u32x4*)(src + 8 * pc);
                if (tens) *(u32x4*)(dst + ((pc >> 1) * 64 + (pc & 1) * 32) * 8) = c;
                else { unsigned char* d8 = (unsigned char*)KSF + ((size_t)(((bl * 4 + g) * 128 + tile) * 2 + (rr >> 4)) * 6 * 64 + (rr & 15)) * 8;
                    *(fp8x8_t*)(d8 + ((pc >> 2) * 64 + (pc & 3) * 16) * 8) = pack_fp8x8(bflo(c[0]), bfhi(c[0]), bflo(c[1]), bfhi(c[1]), bflo(c[2]), bfhi(c[2]), bflo(c[3]), bfhi(c[3])); } }
        }
    }
}
DI float sigmoidf_(float x) { return __builtin_amdgcn_rcpf(1.0f + __builtin_amdgcn_exp2f(-x * LOG2E)); }
struct CmpMK { int tq, h, q0; DI bool need(int t) const { return 512 * t + 527 > q0; }
    DI void operator()(int t, f32x16& S) const {
#pragma unroll
    for (int i = 0; i < 16; ++i) { const int n = 32 * t + crow(i, h); S[i] = (16 * n + 31 <= tq) ? S[i] : -INFINITY; } } };
struct WinMK { int tq, h, qt; DI bool need(int t) const { return t == qt || t == qt - 16; }
    DI void operator()(int t, f32x16& S) const {
#pragma unroll
    for (int i = 0; i < 16; ++i) { const int k = 32 * t + crow(i, h); S[i] = (k <= tq && k > tq - 512) ? S[i] : -INFINITY; } } };
DI void ph_nsa_cmp(const Frame& F, const int half) {
    const float* c48 = (const float*)(F.ws + TAB_COS48); const float* s48 = (const float*)(F.ws + TAB_SIN48);
    unsigned char* ar = F.ws + WS_AR; const bf16* Q = (const bf16*)(ar + NA_Q); const bf16* KCMP = (const bf16*)(ar + NA_KCMP); const bf16* VCT = (const bf16*)(ar + NA_VCT); const bf16* GT = (const bf16*)(ar + NA_GT);
    unsigned char* SELB = ar + NA_SELB; bf16* Ob = (bf16*)(ar + NA_O);
    LAS float* imp = (LAS float*)F.lds;
    LAS unsigned char* kres = F.lds + 20480;
    LAS unsigned char* vring = F.lds + 20480 + 98304;
    const int lane = F.lane, r = lane & 31, h = lane >> 5, tid = F.tid;
    for (int u = blockIdx.x; u < BPH * 4 * 64; u += F.G) {
        const int bg = u >> 6, qt64 = ((u >> 8) & 1) ? 63 - (u & 63) : (u & 63), bl = bg >> 2, g = bg & 3;
        const int tqmaxb = qt64 * 64 + 63, TE = (tqmaxb >= 31) ? ((tqmaxb - 31) / 16) / 32 + 1 : 0;
        const bf16* ksrc = KCMP + (size_t)bg * 8 * 12 * 512; const bf16* vsrc = VCT + (size_t)bg * 8 * 8 * 512;
        for (int i = F.tid; i < 64 * 65; i += NWAVES * 64) imp[i] = 0.f;
        for (int p = tid; p < TE * 768; p += NWAVES * 64) *(LAS u32x4*)(kres + p * 16) = *(const u32x4*)(ksrc + (size_t)p * 8);
        __syncthreads();
#pragma unroll 1
        for (int k = 0; k < 3; ++k) {
            const int idx = F.wave * 3 + k, j = idx >> 1, sub = idx & 1, ql = sub * 32 + r, tq = qt64 * 64 + ql, hd = g * 12 + j;
            const size_t mrow = (size_t)bl * SEQ + tq;
            bf16x8 qf[12];
#pragma unroll
            for (int s = 3; s < 12; ++s) qf[s] = *(const bf16x8*)(Q + mrow * 9216 + hd * 192 + 16 * s + 8 * h);
            { const float* cs = c48 + ((size_t)half * MC + mrow) * 24; const float* sn = s48 + ((size_t)half * MC + mrow) * 24;
#pragma unroll
              for (int s = 0; s < 3; ++s) qf[s] = rope_frag32(Q + mrow * 9216 + hd * 192, s, h, cs, sn); }
            const int tqmax = qt64 * 64 + sub * 32 + 31, te = (tqmax >= 31) ? ((tqmax - 31) / 16) / 32 + 1 : 0;
            const CmpMK mk{tq, h, qt64 * 64 + sub * 32};
            float m = -INFINITY, l = 0.f;
            {
                f32x16 Od[4];
#pragma unroll 1
                for (int t = 0; t < te; ++t) {
                    const LAS unsigned char* cur = kres + t * 12288;
                    f32x16 S;
#pragma unroll
                    for (int i = 0; i < 16; ++i) S[i] = 0.f;
#pragma unroll
                    for (int s = 0; s < 12; ++s) S = MFMA32(*(const LAS bf16x8*)(cur + s * 1024 + lane * 16), qf[s], S);
                    if (mk.need(t)) mk(t, S);
                    bf16x8 pfd[2]; softmax_step<4, false>(S, m, l, Od, pfd);
                }
            }
            l += __shfl_xor(l, 32);
            const float linv = l > 0.f ? 1.0f / l : 0.f, ms = (m == -INFINITY) ? 0.f : m;
            f32x16 O[4];
#pragma unroll
            for (int db = 0; db < 4; ++db)
#pragma unroll
                for (int i = 0; i < 16; ++i) O[db][i] = 0.f;
            if (TE > 0) {
                u32x4 pv = *(const u32x4*)(vsrc + (size_t)tid * 8);
                *(LAS u32x4*)(vring + tid * 16) = pv;
                LDS_WAIT(); __builtin_amdgcn_s_barrier(); asm volatile("" ::: "memory");
#pragma unroll 1
                for (int t = 0; t < TE; ++t) {
                    const LAS unsigned char* cur = kres + t * 12288; const LAS unsigned char* vcur = vring + (t & 1) * 8192;
                    if (t + 1 < TE) pv = *(const u32x4*)(vsrc + ((size_t)(t + 1) * 512 + tid) * 8);
                    if (t < te) {
                        f32x16 S;
#pragma unroll
                        for (int i = 0; i < 16; ++i) S[i] = 0.f;
#pragma unroll
                        for (int s = 0; s < 12; ++s) S = MFMA32(*(const LAS bf16x8*)(cur + s * 1024 + lane * 16), qf[s], S);
                        if (mk.need(t)) mk(t, S);
#pragma unroll
                        for (int i = 0; i < 16; ++i) S[i] = __builtin_amdgcn_exp2f(S[i] - ms) * linv;
#pragma unroll
                        for (int g4 = 0; g4 < 4; ++g4) { const float gs = (S[4 * g4] + S[4 * g4 + 1]) + (S[4 * g4 + 2] + S[4 * g4 + 3]); const int mb = 8 * t + 2 * g4 + h;
                            __hip_atomic_fetch_add(imp + ql * 65 + mb, gs, __ATOMIC_RELAXED, __HIP_MEMORY_SCOPE_WORKGROUP);
                            if (mb + 1 < 64) __hip_atomic_fetch_add(imp + ql * 65 + mb + 1, S[4 * g4 + 3], __ATOMIC_RELAXED, __HIP_MEMORY_SCOPE_WORKGROUP); }
                        bf16x8 pf[2];
#pragma unroll
                        for (int s = 0; s < 2; ++s) { u32x4 w; w.x = pk2(S[8 * s], S[8 * s + 1]); w.y = pk2(S[8 * s + 2], S[8 * s + 3]); w.z = pk2(S[8 * s + 4], S[8 * s + 5]); w.w = pk2(S[8 * s + 6], S[8 * s + 7]); pf[s] = __builtin_bit_cast(bf16x8, w); }
#pragma unroll
                        for (int db = 0; db < 4; ++db)
#pragma unroll
                            for (int s = 0; s < 2; ++s) O[db] = MFMA32(*(const LAS bf16x8*)(vcur + (db * 2 + s) * 1024 + lane * 16), pf[s], O[db]);
                    }
                    if (t + 1 < TE) *(LAS u32x4*)(vring + ((t + 1) & 1) * 8192 + tid * 16) = pv;
                    LDS_WAIT(); __builtin_amdgcn_s_barrier(); asm volatile("" ::: "memory");
                }
            }
            const float gate = sigmoidf_(bf2f(GT[mrow * 256 + hd]));
            store_col<false>(Ob + mrow * 6144 + hd * 128, O, gate, h);
        }
        __syncthreads();
#pragma unroll 1
        for (int k = 0; k < 8; ++k) {
            const int ql = F.wave * 8 + k, tq = qt64 * 64 + ql, cur = tq >> 6, mb = lane;
            const bool causal = mb <= cur, forced = (mb == 0) || (mb == cur) || (mb == cur - 1);
            const float v = causal ? (forced ? INFINITY : imp[ql * 65 + mb]) : -INFINITY;
            int rank = 0;
            for (int o = 0; o < 64; ++o) { const float vo = __shfl(v, o); rank += (vo > v || (vo == v && o < mb)) ? 1 : 0; }
            if (rank < 16) SELB[((size_t)bg * 4096 + tq) * 16 + rank] = causal ? (unsigned char)mb : (unsigned char)0xFF;
        }
        __syncthreads();
    }
}
DI int sel_tile(const u32x4& sel, int t) { const int b = t >> 1; const unsigned w = (b < 4) ? sel.x : (b < 8) ? sel.y : (b < 12) ? sel.z : sel.w; return (int)((w >> ((b & 3) * 8)) & 0xFFu) * 2 + (t & 1); }
struct SelMK { u32x4 sel; int tq, h; DI void operator()(int t, f32x16& S) const { const int k0 = sel_tile(sel, t) * 32;
#pragma unroll
    for (int i = 0; i < 16; ++i) S[i] = (k0 + crow(i, h) <= tq) ? S[i] : -INFINITY; } };
typedef float f32x4_ __attribute__((ext_vector_type(4)));
#define MFMA16F8(a, b, c) __builtin_amdgcn_mfma_f32_16x16x32_fp8_fp8((a), (b), (c), 0, 0, 0)
DI void ph_nsa_sel(const Frame& F, const int half) {
    const float* c48 = (const float*)(F.ws + TAB_COS48); const float* s48 = (const float*)(F.ws + TAB_SIN48);
    unsigned char* ar = F.ws + WS_AR; const bf16* Q = (const bf16*)(ar + NA_Q); const unsigned char* KS8 = ar + NA_KSF; const unsigned char* VS8 = ar + NA_VSF; const bf16* GT = (const bf16*)(ar + NA_GT);
    const unsigned char* SELB = ar + NA_SELB; bf16* Ob = (bf16*)(ar + NA_O);
    const int c16 = F.lane & 15, kq = F.lane >> 4; const bool act = c16 < 12;
    for (int it = F.gw; it < BPH * 4 * SEQ; it += F.NGW) {
        const int bg = it >> 12, tq = ((it & 4095) + 256 * bg) & 4095, bl = bg >> 2, g = bg & 3; const size_t mrow = (size_t)bl * SEQ + tq; const int hd = g * 12 + (act ? c16 : 0);
        fp8x8_t qf[6];
#pragma unroll
        for (int s = 0; s < 6; ++s) { const float qs = act ? (1.0f / NSA_QSCALE) : 0.f; const int p = 4 * s + kq;
            if (s < 2 && p < 6) { float o[8]; rope_piece(Q + mrow * 9216 + hd * 192, p, c48 + ((size_t)half * MC + mrow) * 24, s48 + ((size_t)half * MC + mrow) * 24, o);
                qf[s] = pack_fp8x8(o[0] * qs, o[1] * qs, o[2] * qs, o[3] * qs, o[4] * qs, o[5] * qs, o[6] * qs, o[7] * qs); }
            else { const u32x4 q = *(const u32x4*)(Q + mrow * 9216 + hd * 192 + 32 * s + 8 * kq);
                qf[s] = pack_fp8x8(bflo(q[0]) * qs, bfhi(q[0]) * qs, bflo(q[1]) * qs, bfhi(q[1]) * qs, bflo(q[2]) * qs, bfhi(q[2]) * qs, bflo(q[3]) * qs, bfhi(q[3]) * qs); } }
        const u32x4 sel = *(const u32x4*)(SELB + ((size_t)bg * 4096 + tq) * 16);
        const int nv = ((tq >> 6) + 1 < 16) ? (tq >> 6) + 1 : 16, te = 2 * nv;
        const unsigned char* kb = KS8 + ((size_t)bg * 128 * 12 * 64 + F.lane) * 8; const unsigned char* vb = VS8 + ((size_t)bg * 128 * 8 * 64 + F.lane) * 8;
        f32x4_ O[8];
#pragma unroll
        for (int db = 0; db < 8; ++db) O[db] = (f32x4_){0.f, 0.f, 0.f, 0.f};
        float m = -INFINITY, l = 0.f;
        fp8x8_t kfA[12], kfB[12], vfA[8], vfB[8];
        { const unsigned char* kp = kb + (size_t)sel_tile(sel, 0) * 12 * 512; const unsigned char* kp1 = kb + (size_t)sel_tile(sel, 1) * 12 * 512; const unsigned char* vp = vb + (size_t)sel_tile(sel, 0) * 8 * 512;
#pragma unroll
          for (int s = 0; s < 12; ++s) { kfA[s] = *(const fp8x8_t*)(kp + s * 512); kfB[s] = *(const fp8x8_t*)(kp1 + s * 512); }
#pragma unroll
          for (int j = 0; j < 8; ++j) vfA[j] = *(const fp8x8_t*)(vp + j * 512); }
#define SEL_STEP(T_, KF_, VF_, VFN_) do { const int t_ = (T_); const int tile = sel_tile(sel, t_); \
            if (t_ + 1 < te) { const unsigned char* vp = vb + (size_t)sel_tile(sel, t_ + 1) * 8 * 512; _Pragma("unroll") for (int j = 0; j < 8; ++j) VFN_[j] = *(const fp8x8_t*)(vp + j * 512); } \
            f32x4_ S0 = {0.f, 0.f, 0.f, 0.f}, S1 = S0; \
            _Pragma("unroll") for (int s = 0; s < 6; ++s) { S0 = MFMA16F8(KF_[s], qf[s], S0); S1 = MFMA16F8(KF_[6 + s], qf[s], S1); } \
            if (t_ + 2 < te) { const unsigned char* kp = kb + (size_t)sel_tile(sel, t_ + 2) * 12 * 512; _Pragma("unroll") for (int s = 0; s < 12; ++s) KF_[s] = *(const fp8x8_t*)(kp + s * 512); } \
            const int k0 = tile * 32 + 4 * kq; float mx = -INFINITY; \
            _Pragma("unroll") for (int i = 0; i < 4; ++i) { S0[i] = (k0 + i <= tq) ? S0[i] * NSA_QSCALE : -INFINITY; S1[i] = (k0 + 16 + i <= tq) ? S1[i] * NSA_QSCALE : -INFINITY; mx = fmaxf(mx, fmaxf(S0[i], S1[i])); } \
            mx = fmaxf(mx, __shfl_xor(mx, 16)); mx = fmaxf(mx, __shfl_xor(mx, 32)); \
            const float mn = fmaxf(m, mx), ms = (mn == -INFINITY) ? 0.f : mn, alpha = __builtin_amdgcn_exp2f(m - ms); \
            float sum = 0.f; \
            _Pragma("unroll") for (int i = 0; i < 4; ++i) { S0[i] = __builtin_amdgcn_exp2f(S0[i] - ms); S1[i] = __builtin_amdgcn_exp2f(S1[i] - ms); sum += S0[i] + S1[i]; } \
            l = l * alpha + sum; m = mn; \
            if (__builtin_amdgcn_ballot_w64(alpha != 1.0f) != 0ull) { _Pragma("unroll") for (int db = 0; db < 8; ++db) O[db] = O[db] * alpha; } \
            const fp8x8_t p8 = pack_fp8x8(S0[0], S0[1], S0[2], S0[3], S1[0], S1[1], S1[2], S1[3]);       \
            _Pragma("unroll") for (int db = 0; db < 8; ++db) O[db] = MFMA16F8(VF_[db], p8, O[db]); } while (0)
#pragma unroll 1
        for (int t = 0; t < te; t += 2) { SEL_STEP(t, kfA, vfA, vfB); SEL_STEP(t + 1, kfB, vfB, vfA); }
#undef SEL_STEP
        l += __shfl_xor(l, 16); l += __shfl_xor(l, 32);
        if (act) { const float gate = sigmoidf_(bf2f(GT[mrow * 256 + 48 + hd])); const float sc = l > 0.f ? gate / l : 0.f;
            bf16* o = Ob + mrow * 6144 + hd * 128 + 4 * kq;
#pragma unroll
            for (int db = 0; db < 8; ++db) { u32x2* p = (u32x2*)(o + db * 16); const u32x2 prev = *p;
                u32x2 w; w.x = pk2(O[db][0] * sc + bflo(prev.x), O[db][1] * sc + bfhi(prev.x)); w.y = pk2(O[db][2] * sc + bflo(prev.y), O[db][3] * sc + bfhi(prev.y)); *p = w; } }
    }
}
DI void ph_nsa_win(const Frame& F, const int half) {
    const float* c48 = (const float*)(F.ws + TAB_COS48); const float* s48 = (const float*)(F.ws + TAB_SIN48);
    unsigned char* ar = F.ws + WS_AR; const bf16* Q = (const bf16*)(ar + NA_Q); const bf16* KWF = (const bf16*)(ar + NA_KWF); const bf16* VWF = (const bf16*)(ar + NA_VWF); const bf16* GT = (const bf16*)(ar + NA_GT); bf16* Ob = (bf16*)(ar + NA_O);
    const int r = F.lane & 31, h = F.lane >> 5;
    for (int idb = blockIdx.x; idb < BPH * 4 * 3 * 64; idb += F.G) {
        const int qt0 = (((idb & 63) + (idb >> 8)) & 63) * 2, qt = qt0 + (F.wave & 1), rest = idb >> 6, hq = rest % 3, bg = rest / 3, bl = bg >> 2, g = bg & 3, hd = g * 12 + hq * 4 + (F.wave >> 1), tq = qt * 32 + r; const size_t mrow = (size_t)bl * SEQ + tq;
        bf16x8 qf[12];
#pragma unroll
        for (int s = 3; s < 12; ++s) qf[s] = *(const bf16x8*)(Q + mrow * 9216 + hd * 192 + 16 * s + 8 * h);
        { const float* cs = c48 + ((size_t)half * MC + mrow) * 24; const float* sn = s48 + ((size_t)half * MC + mrow) * 24;
#pragma unroll
          for (int s = 0; s < 3; ++s) qf[s] = rope_frag32(Q + mrow * 9216 + hd * 192, s, h, cs, sn); }
        const FragSrc src{KWF + (size_t)bg * 128 * 12 * 512, VWF + (size_t)bg * 128 * 8 * 512, 12}; const WinMK mk{tq, h, qt};
        f32x16 O[4];
#pragma unroll
        for (int db = 0; db < 4; ++db)
#pragma unroll
            for (int i = 0; i < 16; ++i) O[db][i] = 0.f;
        float m = -INFINITY, l = 0.f;
        attn_run_sh<12, true>(F.lds, F.tid, F.lane, qf, O, m, l, qt0 >= 16 ? qt0 - 16 : 0, qt0 + 2, qt >= 16 ? qt - 16 : 0, qt + 1, src, mk);
        l += __shfl_xor(l, 32);
        const float gate = sigmoidf_(bf2f(GT[mrow * 256 + 96 + hd]));
        store_col<true>(Ob + mrow * 6144 + hd * 128, O, l > 0.f ? gate / l : 0.f, h);
    }
}
#ifndef MK_ONE_LAUNCH
#define MK_ONE_LAUNCH 1
#endif
constexpr int NPH = 69;
struct Args { const float* in[58]; float* out; unsigned char* ws; int ph_lo, ph_hi; };
#define GEMM_AKOFF 0
#define GEMM_CALL(EpiT, Evar, Aptr, Bptr, Mv, Nv, Kv, ldav, ldbv, cidx) do { const pg8::Gemm g_{(const pg8::bf16_t*)(Aptr), (const pg8::bf16_t*)(Bptr), (Mv), (Nv), (Kv), (ldav), (ldbv), GEMM_AKOFF}; \
    pg8::StaticOrder S_; S_.init((Mv), (Nv), F.G, (cidx)); pg8::gemm_phase<EpiT, pg8::StaticOrder, true, true>((PG8_LAS unsigned char*)F.lds, g_, S_, Evar); } while (0)
DI pg8::EpiBf16R epi1(bf16* base, int ldc) { pg8::EpiBf16R e; for (int s = 0; s < 8; ++s) { e.T.base[s] = base; e.T.ldc[s] = ldc; e.T.t0[s] = 0; e.T.gw[s] = 0; } e.T.nseg = 1; e.T.pad_ = 0; e.ssp = nullptr; e.ss_off = 0; return e; }
#define PH_BEGIN if (ph >= lo && ph < hi) { Frame F; { unsigned long long w_ = (unsigned long long)args.ws; asm volatile("" : "+s"(w_)); F.ws = (unsigned char*)w_; F.ctl = (unsigned*)(F.ws + WS_CTL); } \
    F.lds = lds; F.tid = threadIdx.x; F.lane = F.tid & 63; F.wave = __builtin_amdgcn_readfirstlane(F.tid >> 6); F.G = gridDim.x; F.gw = blockIdx.x * NWAVES + F.wave; F.NGW = F.G * NWAVES; \
    float* out; { unsigned long long o_ = (unsigned long long)args.out; asm volatile("" : "+s"(o_)); out = (float*)o_; } \
    unsigned char* const ar = F.ws + WS_AR; bf16* const XN = (bf16*)(F.ws + WS_XNR); float* const SSB = (float*)(F.ws + WS_SS); bf16* const WB = (bf16*)(F.ws + WS_WMIX); bf16* const WUP = (bf16*)(F.ws + WS_WFFN); bf16* const WDN = WUP + (size_t)2 * DFF * DM; \
    const float* const res_mix = (ib == 2) ? args.in[0] : (const float*)out; (void)ar; (void)XN; (void)SSB; (void)WB; (void)WUP; (void)WDN; (void)res_mix; (void)iff;
#define PH_END   if (ph + 1 < hi) { XcdBarrier b_; b_.bar = (unsigned*)F.ctl + CW_BAR; b_.x = xb_xcc_id(); b_.st = MISC + 8; xcd_barrier(b_); } } ++ph;
template <int LAYER> DI void run_cvt(const Args& args, LAS unsigned char* lds, volatile LAS unsigned* MISC, int& ph, const int lo, const int hi) {
    constexpr int ib = (LAYER == 0) ? 2 : (LAYER == 1) ? 17 : (LAYER == 2) ? 26 : 42;
    constexpr int iff = (LAYER == 0) ? 12 : (LAYER == 1) ? 21 : (LAYER == 2) ? 37 : 52;
    constexpr int kind = (LAYER == 1) ? 1 : (LAYER == 2) ? 2 : 0;
        PH_BEGIN
            if constexpr (LAYER == 0) { ph_tables(F, (const int*)args.in[1]); ph_norm_first(F, args.in[0], args.in[2], XN, SSB); }
            if constexpr (kind == 0) ph_dsa_cvt(F, args.in[ib + 1], args.in[ib + 6], args.in[ib + 7], args.in[ib + 8], args.in[ib + 9]);
            else if constexpr (kind == 1) ph_fox_cvt(F, args.in[ib + 1], args.in[ib + 3]);
            else ph_nsa_cvt(F, args.in[ib + 1], args.in[ib + 2], args.in[ib + 3], args.in[ib + 4], args.in[ib + 5], args.in[ib + 6], args.in[ib + 7], args.in[ib + 8], args.in[ib + 9], args.in[ib + 10]);
            ph_cvt_ffn(F, args.in[iff + 1], args.in[iff + 4]);
        PH_END
}
template <int LAYER, int HALF> DI void run_half(const Args& args, LAS unsigned char* lds, volatile LAS unsigned* MISC, int& ph, const int lo, const int hi) {
    constexpr int ib = (LAYER == 0) ? 2 : (LAYER == 1) ? 17 : (LAYER == 2) ? 26 : 42;
    constexpr int iff = (LAYER == 0) ? 12 : (LAYER == 1) ? 21 : (LAYER == 2) ? 37 : 52;
    constexpr int kind = (LAYER == 1) ? 1 : (LAYER == 2) ? 2 : 0;
    constexpr int half = HALF;
            const int roff = half * MC;
            if constexpr (kind == 0) {
                PH_BEGIN { pg8::EpiF32 E{(float*)(ar + DA_DIN), 1024, SSB + (size_t)(LAYER * 2) * MTOT * 8, roff}; GEMM_CALL(pg8::EpiF32, E, XN + (size_t)roff * DM, WB + DW_W1, MC, 1024, DM, DM, DM, (int)blockIdx.x); } PH_END
                PH_BEGIN ph_dsa_post1(F, half, args.in[ib + 2], args.in[ib + 3], args.in[ib + 4], args.in[ib + 5]); PH_END
                PH_BEGIN { pg8::EpiBf16R E = epi1((bf16*)(ar + DA_QL), 8192); E.T.base[1] = (bf16*)(ar + DA_QPE); E.T.ldc[1] = 1536; E.T.t0[1] = 32; E.T.base[2] = (bf16*)(ar + DA_QIDX); E.T.ldc[2] = 2048; E.T.t0[2] = 38; E.T.nseg = 3;
                    GEMM_CALL(pg8::EpiBf16R, E, ar + DA_CQN, WB + DW_W2, MC, 11776, 512, 512, 512, (int)blockIdx.x); } PH_END
                PH_BEGIN ph_dsa_index(F, half); PH_END
                PH_BEGIN ph_dsa_attn(F, half); PH_END
                PH_BEGIN {
                    pg8::EpiBf16R E = epi1((bf16*)(ar + DA_O2), 4096);
                    { const pg8::Gemm g_{(const pg8::bf16_t*)(ar + DA_QL), (const pg8::bf16_t*)(WB + DW_BD), MC, 4096, 512, 8192, 512, 512}; pg8::StaticOrder S_; S_.init(MC, 4096, F.G, (int)blockIdx.x);
                      pg8::gemm_phase<pg8::EpiBf16R, pg8::StaticOrder, true, true>((PG8_LAS unsigned char*)F.lds, g_, S_, E); } } PH_END
                PH_BEGIN { pg8::EpiResN E{LAYER == 0 ? args.in[0] : nullptr, args.in[ib], nullptr, DM, roff, args.in[iff], (pg8::bf16_t*)XN, SSB + (size_t)(LAYER * 2 + 1) * MTOT * 8, (PG8_LAS float*)(F.lds + LDSCTL_OFF + 256)}; GEMM_CALL(pg8::EpiResN, E, ar + DA_O2, WB + DW_WO, MC, DM, 4096, 4096, 4096, (int)blockIdx.x); } PH_END
            } else if constexpr (kind == 1) {
                PH_BEGIN {
                    { pg8::EpiBf16R E = epi1((bf16*)(ar + FA_Q), DM); E.T.base[1] = (bf16*)(ar + FA_KF); E.T.ldc[1] = 9; E.T.t0[1] = 8; E.T.gw[1] = -3;
                      E.T.base[2] = (bf16*)(ar + FA_F); E.T.ldc[2] = 256; E.T.t0[2] = 16; E.T.nseg = 3; E.ssp = SSB + (size_t)(LAYER * 2) * MTOT * 8; E.ss_off = roff;
                      GEMM_CALL(pg8::EpiBf16R, E, XN + (size_t)roff * DM, WB + FW_IN, MC, 4352, DM, DM, DM, (int)blockIdx.x); }
                    { pg8::EpiBf16R E = epi1((bf16*)(ar + FA_VF), 16); E.T.gw[0] = -4; E.ssp = SSB + (size_t)(LAYER * 2) * MTOT * 8; E.ss_off = roff;
                      GEMM_CALL(pg8::EpiBf16R, E, WB + FW_IN + (size_t)4352 * DM, XN + (size_t)roff * DM, DM, MC, DM, DM, DM, (int)((blockIdx.x + F.G - 64) % F.G)); }
                } PH_END
                PH_BEGIN ph_fox_scan(F, args.in[ib + 2]); PH_END
                PH_BEGIN ph_fox_attn(F); PH_END
                PH_BEGIN { pg8::EpiResN E{LAYER == 0 ? args.in[0] : nullptr, args.in[ib], nullptr, DM, roff, args.in[iff], (pg8::bf16_t*)XN, SSB + (size_t)(LAYER * 2 + 1) * MTOT * 8, (PG8_LAS float*)(F.lds + LDSCTL_OFF + 256)}; GEMM_CALL(pg8::EpiResN, E, ar + FA_O, WB + FW_OUT, MC, DM, DM, DM, DM, (int)blockIdx.x); } PH_END
            } else {
                PH_BEGIN { pg8::EpiBf16R E = epi1((bf16*)(ar + NA_Q), 9216);
                    E.T.base[1] = (bf16*)(ar + NA_KC); E.T.ldc[1] = 192; E.T.t0[1] = 36; E.T.gw[1] = 192;
                    E.T.base[2] = (bf16*)(ar + NA_VC); E.T.ldc[2] = 128; E.T.t0[2] = 39; E.T.gw[2] = 128;
                    E.T.base[3] = (bf16*)(ar + NA_KSR); E.T.ldc[3] = 768; E.T.t0[3] = 41;
                    E.T.base[4] = (bf16*)(ar + NA_KWR); E.T.ldc[4] = 768; E.T.t0[4] = 44;
                    E.T.base[5] = (bf16*)(ar + NA_GT); E.T.ldc[5] = 256; E.T.t0[5] = 47; E.T.nseg = 6; E.ssp = SSB + (size_t)(LAYER * 2) * MTOT * 8; E.ss_off = roff;
                    GEMM_CALL(pg8::EpiBf16R, E, XN + (size_t)roff * DM, WB + NW_IN, MC, 12288, DM, DM, DM, (int)blockIdx.x);
                    { pg8::EpiBf16R E2 = epi1((bf16*)(ar + NA_VSF), 4); E2.T.gw[0] = -5; E2.ssp = E.ssp; E2.ss_off = roff;
                      GEMM_CALL(pg8::EpiBf16R, E2, WB + NW_IN + (size_t)12288 * DM, XN + (size_t)roff * DM, 512, MC, DM, DM, DM, (int)blockIdx.x); }
                    { pg8::EpiBf16R E2 = epi1((bf16*)(ar + NA_VWF), 4); E2.T.gw[0] = -4; E2.ssp = E.ssp; E2.ss_off = roff;
                      GEMM_CALL(pg8::EpiBf16R, E2, WB + NW_IN + (size_t)12800 * DM, XN + (size_t)roff * DM, 512, MC, DM, DM, DM, (int)((blockIdx.x + F.G - 128) % F.G)); } } PH_END
                PH_BEGIN ph_nsa_rope(F, half); PH_END
                PH_BEGIN {
                    const float* BIAS = (const float*)(args.ws + WS_MISC);
                    { pg8::EpiGelu E{(bf16*)(ar + NA_GK), 256, BIAS}; GEMM_CALL(pg8::EpiGelu, E, ar + NA_KC, WB + NW_W1K, 4096, 256, 6144, 3072, 6144, (int)blockIdx.x); }
                    { pg8::EpiGelu E{(bf16*)(ar + NA_GV), 256, BIAS + 256}; GEMM_CALL(pg8::EpiGelu, E, ar + NA_VC, WB + NW_W1V, 4096, 256, 4096, 2048, 4096, (int)((blockIdx.x + F.G - 16) % F.G)); }
                } PH_END
                PH_BEGIN {
                    { pg8::EpiBf16R E = epi1((bf16*)(ar + NA_KCMP), 12); E.T.gw[0] = -1; GEMM_CALL(pg8::EpiBf16R, E, ar + NA_GK, WB + NW_W2K, 4096, 256, 256, 256, 256, (int)blockIdx.x); }
                    { pg8::EpiBf16R E = epi1((bf16*)(ar + NA_VCT), 4); E.T.gw[0] = -2; GEMM_CALL(pg8::EpiBf16R, E, WB + NW_W2V, ar + NA_GV, 256, 4096, 256, 256, 256, (int)((blockIdx.x + F.G - 16) % F.G)); }
                } PH_END
                PH_BEGIN ph_nsa_cmp(F, half); PH_END
                PH_BEGIN ph_nsa_sel(F, half); PH_END
                PH_BEGIN ph_nsa_win(F, half); PH_END
                PH_BEGIN { pg8::EpiResN E{LAYER == 0 ? args.in[0] : nullptr, args.in[ib], nullptr, DM, roff, args.in[iff], (pg8::bf16_t*)XN, SSB + (size_t)(LAYER * 2 + 1) * MTOT * 8, (PG8_LAS float*)(F.lds + LDSCTL_OFF + 256)}; GEMM_CALL(pg8::EpiResN, E, ar + NA_O, WB + NW_OUT, MC, DM, 6144, 6144, 6144, (int)blockIdx.x); } PH_END
            }
}
template <int LAYER> DI void run_ffn(const Args& args, LAS unsigned char* lds, volatile LAS unsigned* MISC, int& ph, const int lo, const int hi) {
    constexpr int ib = (LAYER == 0) ? 2 : (LAYER == 1) ? 17 : (LAYER == 2) ? 26 : 42;
    constexpr int iff = (LAYER == 0) ? 12 : (LAYER == 1) ? 21 : (LAYER == 2) ? 37 : 52;
    PH_BEGIN {
        LAS float* rt = (LAS float*)(F.lds + LDSCTL_OFF + 256 + 8192); const int rbase = 4096 * (int)(blockIdx.x & 7); const float* ssq = SSB + (size_t)(LAYER * 2 + 1) * MTOT * 8;
        for (int i = F.tid; i < 4096; i += NWAVES * 64) rt[i] = pg8::rms_rowscale(ssq, rbase + i);
        __syncthreads();
        pg8::EpiConvGlu E{(pg8::bf16_t*)ar, (float*)(ar + 352 * MiB), args.in[iff + 2], args.in[iff + 3], (PG8_LAS float*)(F.lds + LDSCTL_OFF + 256), DFF, (const PG8_LAS float*)rt, rbase};
        GEMM_CALL(pg8::EpiConvGlu, E, XN, WUP, MTOT, 2 * DFF, DM, DM, DM, (int)blockIdx.x); } PH_END
    PH_BEGIN ph_conv_fix(F, (const float*)(ar + 352 * MiB), (bf16*)ar, args.in[iff + 2], args.in[iff + 3], MTOT); PH_END
    PH_BEGIN {
        if constexpr (LAYER < 3) { constexpr int ibn = (LAYER == 0) ? 17 : (LAYER == 1) ? 26 : 42;
            pg8::EpiResN E{nullptr, args.in[iff], nullptr, DM, 0, args.in[ibn], (pg8::bf16_t*)XN, SSB + (size_t)((LAYER + 1) * 2) * MTOT * 8, (PG8_LAS float*)(F.lds + LDSCTL_OFF + 256)}; GEMM_CALL(pg8::EpiResN, E, ar, WDN, MTOT, DM, DFF, DFF, DFF, (int)blockIdx.x); }
        else { pg8::EpiResN E{nullptr, args.in[iff], nullptr, DM, 0, args.in[57], (pg8::bf16_t*)XN, SSB, (PG8_LAS float*)(F.lds + LDSCTL_OFF + 256)}; GEMM_CALL(pg8::EpiResN, E, ar, WDN, MTOT, DM, DFF, DFF, DFF, (int)blockIdx.x); }
    } PH_END
}
__global__ void __launch_bounds__(NWAVES * 64, 2) mk_fwd(Args args) {
    extern __shared__ __attribute__((aligned(16))) unsigned char lds_[];
    LAS unsigned char* const lds = (LAS unsigned char*)lds_;
    volatile LAS unsigned* MISC = (volatile LAS unsigned*)(lds + LDSCTL_OFF);
    for (int u = threadIdx.x; u < 64; u += NWAVES * 64) ((LAS unsigned*)(lds + LDSCTL_OFF))[u] = 0u;
    __syncthreads();
    const int lo = args.ph_lo, hi = args.ph_hi;
    (void)xcd_barrier_post((unsigned*)(args.ws + WS_CTL) + CW_BAR, MISC + 8);
    int ph = 0;
    run_cvt<0>(args, lds, MISC, ph, lo, hi); run_half<0, 0>(args, lds, MISC, ph, lo, hi); run_half<0, 1>(args, lds, MISC, ph, lo, hi); run_ffn<0>(args, lds, MISC, ph, lo, hi);
    run_cvt<1>(args, lds, MISC, ph, lo, hi); run_half<1, 0>(args, lds, MISC, ph, lo, hi); run_half<1, 1>(args, lds, MISC, ph, lo, hi); run_ffn<1>(args, lds, MISC, ph, lo, hi);
    run_cvt<2>(args, lds, MISC, ph, lo, hi); run_half<2, 0>(args, lds, MISC, ph, lo, hi); run_half<2, 1>(args, lds, MISC, ph, lo, hi); run_ffn<2>(args, lds, MISC, ph, lo, hi);
    run_cvt<3>(args, lds, MISC, ph, lo, hi); run_half<3, 0>(args, lds, MISC, ph, lo, hi); run_half<3, 1>(args, lds, MISC, ph, lo, hi); run_ffn<3>(args, lds, MISC, ph, lo, hi);
    { constexpr int ib = 42, iff = 52; PH_BEGIN ph_final_norm(F, (const bf16*)XN, SSB, out); PH_END }
}
extern "C" void kernel_launch(void* const* d_in, const int* in_sizes, int n_in, void* d_out, int out_size, void* d_ws, size_t ws_size, hipStream_t stream) {
    static int grid = 0;
    if (grid == 0) {
        if (n_in != 58 || out_size != MTOT * DM || ws_size < WS_END) { fprintf(stderr, "kernel_launch: unexpected shapes (n_in %d, out %d, ws %zu)\n", n_in, out_size, ws_size); grid = -1; return; }
        int dev = 0, cus = 0;
        if (hipGetDevice(&dev) != hipSuccess || hipDeviceGetAttribute(&cus, hipDeviceAttributeMultiprocessorCount, dev) != hipSuccess) { grid = -1; return; }
        if (hipFuncSetAttribute((const void*)mk_fwd, hipFuncAttributeMaxDynamicSharedMemorySize, LDS_BYTES) != hipSuccess) { fprintf(stderr, "kernel_launch: hipFuncSetAttribute failed\n"); grid = -1; return; }
        int per_cu = 0;
        (void)hipOccupancyMaxActiveBlocksPerMultiprocessor(&per_cu, (const void*)mk_fwd, NWAVES * 64, LDS_BYTES);
        (void)hipGetLastError();
        grid = cus;
    }
    if (grid < 0) return;
    if (hipMemsetAsync((char*)d_ws + WS_CTL, 0, CTL_ZERO_BYTES, stream) != hipSuccess) return;
    Args a{};
    for (int i = 0; i < 58; ++i) a.in[i] = (const float*)d_in[i];
    a.out = (float*)d_out; a.ws = (unsigned char*)d_ws;
#if MK_ONE_LAUNCH
    a.ph_lo = 0; a.ph_hi = NPH;
    hipLaunchKernelGGL(mk_fwd, dim3(grid), dim3(NWAVES * 64), LDS_BYTES, stream, a);
#else
    for (int p = 0; p < NPH; ++p) { a.ph_lo = p; a.ph_hi = p + 1; hipLaunchKernelGGL(mk_fwd, dim3(grid), dim3(NWAVES * 64), LDS_BYTES, stream, a); }
#endif
}
```

```cpp
#include <hip/hip_runtime.h>
#include <cstdio>
#include <cstdint>
#define DI __device__ __forceinline__
namespace pg8 {
#define PG8_LAS __attribute__((address_space(3)))
typedef unsigned short bf16_t;
typedef short bf16x8 __attribute__((ext_vector_type(8)));
typedef float f32x4 __attribute__((ext_vector_type(4)));
typedef unsigned u32x4 __attribute__((ext_vector_type(4)));
constexpr int BM = 256, BK = 64, HALF = 128, HTB = HALF * BK * 2  , STAGE_BYTES = 8 * HTB, NXCD = 8, WGM = 8;

__host__ __device__ __forceinline__ int lds_byte(int r, int c) { const int st = (r >> 4) * 2 + (c >> 5), rr = r & 15, cc = c & 31, ob = rr * 64 + cc * 2; return st * 1024 + (ob ^ (((ob >> 9) & 1) << 5)); }
__host__ __device__ __forceinline__ void stage_rc(int b, int& R, int& C) { const int st = b / 1024, sb = b % 1024, swz = sb ^ (((sb >> 9) & 1) << 5); R = (st >> 1) * 16 + swz / 64; C = (st & 1) * 32 + (swz % 64) / 2; }
__host__ __device__ __forceinline__ int perm32(int rho) { const int n = rho >> 4, i = rho & 15; return 8 * (i >> 2) + 4 * n + (i & 3); }

struct Unit { int pm, pn; };
struct Gemm { const bf16_t* A; const bf16_t* Bt; int M, N, K, lda, ldb, akoff; };

struct StaticOrder {
    int nM, nN, nwg, G, c;
    __host__ __device__ void init(int M, int N, int G_, int c_) { nM = M / BM; nN = N / BM; nwg = nM * nN; G = G_; c = c_; }
    __host__ __device__ bool next(int i, Unit& u) const {
        const long L = (long)i * G + c; if (L >= nwg) return false;
        int wgid = (int)L; { const int q = nwg / NXCD, r = nwg % NXCD, xcd = wgid % NXCD, off = wgid / NXCD; wgid = (xcd < r ? xcd * (q + 1) : r * (q + 1) + (xcd - r) * q) + off; }
        const int nig = WGM * nN, gid = wgid / nig, fm = gid * WGM, gsz = (nM - fm) < WGM ? (nM - fm) : WGM;
        u.pm = fm + ((wgid % nig) % gsz); u.pn = (wgid % nig) / gsz; return true;
    }
    __device__ __forceinline__ void a_ready(const Unit&) const {}
    __device__ __forceinline__ void done(const Unit&) const {}
};
__device__ __forceinline__ unsigned cvt_pk_bf16(float lo, float hi) { unsigned r; asm volatile("v_cvt_pk_bf16_f32 %0, %1, %2" : "=v"(r) : "v"(lo), "v"(hi)); return r; }
template <class Epi, class Sched, bool ALIGN_EPI = false, bool SP2 = false>
__device__ __forceinline__ void gemm_phase(PG8_LAS unsigned char* lds, const Gemm g, const Sched& S, const Epi& E) {
    const int tid = threadIdx.x, wid = __builtin_amdgcn_readfirstlane(tid >> 6), lane = tid & 63, wr = wid >> 2, wc = wid & 3, fr = lane & 15, fq = lane >> 4;
    const int K = g.K, nt = K / BK;
    unsigned voffA[2], voffB[2];
#pragma unroll
    for (int i = 0; i < 2; ++i) { int R, C; stage_rc(tid * 16 + i * 8192, R, C); const int Rb = Epi::PERM ? ((R & ~31) + perm32(R & 31)) : R;
        const int Ra = Epi::APERM ? ((R & ~63) | ((R & 15) << 2) | ((R >> 4) & 3)) : R;
        voffA[i] = (unsigned)(Ra * g.lda + C) * 2u; voffB[i] = (unsigned)(Rb * g.ldb + C) * 2u; }
    const size_t kstep = (size_t)(BK * 2);
    const size_t hstepA = (size_t)HALF * g.lda * 2, hstepB = (size_t)HALF * g.ldb * 2;
    const size_t tstepA = 2 * hstepA, tstepB = 2 * hstepB;
    const unsigned ldsw = (unsigned)wid * 1024u;
    const int aoff = lds_byte(wr * 64 + fr, fq * 8), boff = lds_byte(wc * 32 + fr, fq * 8);
#define PG8_SA(b, h) (((b) * 2 + (h)) * HTB)
#define PG8_SB(b, h) ((4 + (b) * 2 + (h)) * HTB)
#define PG8_STAGE(bufoff, gbase, voff) do { _Pragma("unroll") for (int _i = 0; _i < 2; ++_i) \
        __builtin_amdgcn_global_load_lds((const unsigned*)((const char*)(gbase) + (voff)[_i]), (PG8_LAS unsigned*)(lds + (bufoff) + ldsw + _i * 8192), 16, 0, 0); } while (0)
#define PG8_LDA(dst, b, h) do { _Pragma("unroll") for (int m = 0; m < 4; ++m) _Pragma("unroll") for (int k = 0; k < 2; ++k) dst[m][k] = *(const PG8_LAS bf16x8*)(lds + PG8_SA(b, h) + aoff + m * 2048 + k * 1024); } while (0)
#define PG8_LDB(dst, b, h) do { _Pragma("unroll") for (int n = 0; n < 2; ++n) _Pragma("unroll") for (int k = 0; k < 2; ++k) dst[n][k] = *(const PG8_LAS bf16x8*)(lds + PG8_SB(b, h) + boff + n * 2048 + k * 1024); } while (0)
#define PG8_MMA(ai, bj, At, Bt) do { __builtin_amdgcn_s_setprio(1); _Pragma("unroll") for (int m = 0; m < 4; ++m) _Pragma("unroll") for (int n = 0; n < 2; ++n) _Pragma("unroll") for (int k = 0; k < 2; ++k) \
        acc[ai][bj][m][n] = __builtin_amdgcn_mfma_f32_16x16x32_bf16(Bt[n][k], At[m][k], acc[ai][bj][m][n], 0, 0, 0); __builtin_amdgcn_s_setprio(0); } while (0)
#define PG8_WAIT_V(n) asm volatile("s_waitcnt vmcnt(" #n ")" ::: "memory")
#define PG8_WAIT_L(n) asm volatile("s_waitcnt lgkmcnt(" #n ")" ::: "memory")
#define PG8_BAR __builtin_amdgcn_s_barrier()
#define PG8_SCHED __builtin_amdgcn_sched_barrier(0)
    Unit cur, nxt; int ui = 0;
    if (!S.next(0, cur)) return;
    f32x4 acc[2][2][4][2];
#pragma unroll
    for (int a = 0; a < 2; ++a)
#pragma unroll
        for (int b = 0; b < 2; ++b)
#pragma unroll
            for (int m = 0; m < 4; ++m)
#pragma unroll
                for (int n = 0; n < 2; ++n) acc[a][b][m][n] = (f32x4){0.f, 0.f, 0.f, 0.f};
    bf16x8 At[4][2], B0[2][2], B1[2][2];
    const char* cA = (const char*)g.A + (size_t)cur.pm * tstepA + (size_t)cur.pn * g.akoff * 2; const char* cB = (const char*)g.Bt + (size_t)cur.pn * tstepB;
    S.a_ready(cur);
    if constexpr (SP2) {
        PG8_STAGE(PG8_SB(0, 0), cB, voffB); PG8_STAGE(PG8_SB(0, 1), cB + hstepB, voffB); PG8_STAGE(PG8_SA(0, 0), cA, voffA); PG8_STAGE(PG8_SA(0, 1), cA + hstepA, voffA);
        if (wr == 1) PG8_BAR;
        PG8_WAIT_V(2); PG8_BAR;
        PG8_STAGE(PG8_SB(1, 0), cB + kstep, voffB); PG8_STAGE(PG8_SA(1, 0), cA + kstep, voffA); PG8_STAGE(PG8_SB(1, 1), cB + hstepB + kstep, voffB);
        PG8_WAIT_V(6); PG8_BAR;
    } else {
        PG8_STAGE(PG8_SB(0, 0), cB, voffB); PG8_STAGE(PG8_SA(0, 0), cA, voffA); PG8_STAGE(PG8_SB(0, 1), cB + hstepB, voffB); PG8_STAGE(PG8_SA(0, 1), cA + hstepA, voffA);
        if (wr == 1) PG8_BAR;
        PG8_WAIT_V(4); PG8_BAR;
        PG8_STAGE(PG8_SB(1, 0), cB + kstep, voffB); PG8_STAGE(PG8_SA(1, 0), cA + kstep, voffA); PG8_STAGE(PG8_SB(1, 1), cB + hstepB + kstep, voffB);
        PG8_WAIT_V(6); PG8_BAR;
    }
    for (;;) {
        const bool has_next = S.next(ui + 1, nxt);
        const char* nA = has_next ? (const char*)g.A + (size_t)nxt.pm * tstepA + (size_t)nxt.pn * g.akoff * 2 : cA; const char* nB = has_next ? (const char*)g.Bt + (size_t)nxt.pn * tstepB : cB;
        for (int t = 0; t < nt; t += 2) {
            const bool last = (t == nt - 2);
            const char* a1 = cA + (size_t)(t + 1) * kstep;
            const char* a2 = last ? nA : cA + (size_t)(t + 2) * kstep; const char* b2 = last ? nB : cB + (size_t)(t + 2) * kstep;
            const char* a3 = a2 + kstep; const char* b3 = b2 + kstep;
            if (last && has_next) S.a_ready(nxt);
            if constexpr (SP2) {
            PG8_LDB(B0, 0, 0); PG8_LDB(B1, 0, 1); PG8_SCHED; PG8_LDA(At, 0, 0); PG8_STAGE(PG8_SA(1, 1), a1 + hstepA, voffA);
            PG8_WAIT_V(8); PG8_WAIT_L(0); PG8_BAR; PG8_MMA(0, 0, At, B0); PG8_MMA(0, 1, At, B1); PG8_BAR; PG8_SCHED;
            PG8_LDA(At, 0, 1); PG8_STAGE(PG8_SB(0, 0), b2, voffB); PG8_STAGE(PG8_SB(0, 1), b2 + hstepB, voffB); PG8_STAGE(PG8_SA(0, 0), a2, voffA);
            PG8_WAIT_V(8); PG8_WAIT_L(0); PG8_BAR; PG8_MMA(1, 0, At, B0); PG8_MMA(1, 1, At, B1); PG8_BAR; PG8_SCHED;
            PG8_LDB(B0, 1, 0); PG8_LDB(B1, 1, 1); PG8_SCHED; PG8_LDA(At, 1, 0); PG8_STAGE(PG8_SA(0, 1), a2 + hstepA, voffA);
            PG8_WAIT_V(8); PG8_WAIT_L(0); PG8_BAR; PG8_MMA(0, 0, At, B0); PG8_MMA(0, 1, At, B1); PG8_BAR; PG8_SCHED;
            PG8_LDA(At, 1, 1); PG8_STAGE(PG8_SB(1, 0), b3, voffB); PG8_STAGE(PG8_SB(1, 1), b3 + hstepB, voffB); PG8_STAGE(PG8_SA(1, 0), a3, voffA);
            PG8_WAIT_V(8); PG8_WAIT_L(0); PG8_BAR; PG8_MMA(1, 0, At, B0); PG8_MMA(1, 1, At, B1); PG8_BAR; PG8_SCHED;
            } else {
            PG8_LDB(B0, 0, 0); PG8_SCHED; PG8_LDA(At, 0, 0); PG8_STAGE(PG8_SA(1, 1), a1 + hstepA, voffA);
            PG8_WAIT_L(8); PG8_BAR; PG8_WAIT_L(0); PG8_MMA(0, 0, At, B0); PG8_BAR; PG8_SCHED;
            PG8_LDB(B1, 0, 1); PG8_STAGE(PG8_SB(0, 0), b2, voffB);
            PG8_BAR; PG8_WAIT_L(0); PG8_MMA(0, 1, At, B1); PG8_BAR;
            PG8_LDA(At, 0, 1); PG8_STAGE(PG8_SA(0, 0), a2, voffA);
            PG8_BAR; PG8_WAIT_L(0); PG8_MMA(1, 0, At, B0); PG8_BAR; PG8_SCHED;
            PG8_STAGE(PG8_SB(0, 1), b2 + hstepB, voffB);
            PG8_WAIT_V(6); PG8_BAR; PG8_MMA(1, 1, At, B1); PG8_BAR;
            PG8_LDB(B0, 1, 0); PG8_SCHED; PG8_LDA(At, 1, 0); PG8_STAGE(PG8_SA(0, 1), a2 + hstepA, voffA);
            PG8_WAIT_L(8); PG8_BAR; PG8_WAIT_L(0); PG8_MMA(0, 0, At, B0); PG8_BAR; PG8_SCHED;
            PG8_LDB(B1, 1, 1); PG8_STAGE(PG8_SB(1, 0), b3, voffB);
            PG8_BAR; PG8_WAIT_L(0); PG8_MMA(0, 1, At, B1); PG8_BAR;
            PG8_LDA(At, 1, 1); PG8_STAGE(PG8_SA(1, 0), a3, voffA);
            PG8_BAR; PG8_WAIT_L(0); PG8_MMA(1, 0, At, B0); PG8_BAR; PG8_SCHED;
            PG8_STAGE(PG8_SB(1, 1), b3 + hstepB, voffB);
            PG8_WAIT_V(6); PG8_BAR; PG8_MMA(1, 1, At, B1); PG8_BAR;
            }
        }
        if constexpr (ALIGN_EPI) { if (wr == 0) PG8_BAR; }
        if constexpr (!Epi::AFTER_DRAIN) { E(acc, cur, wr, wc, fr, fq); S.done(cur); }
        if (!has_next) break;
#pragma unroll
        for (int a = 0; a < 2; ++a)
#pragma unroll
            for (int b = 0; b < 2; ++b)
#pragma unroll
                for (int m = 0; m < 4; ++m)
#pragma unroll
                    for (int n = 0; n < 2; ++n) acc[a][b][m][n] = (f32x4){0.f, 0.f, 0.f, 0.f};
        cur = nxt; cA = nA; cB = nB; ++ui;
        if constexpr (ALIGN_EPI) { if (wr == 1) PG8_BAR; }
    }
    PG8_WAIT_V(0);
    if constexpr (!ALIGN_EPI) { if (wr == 0) PG8_BAR; }
    PG8_BAR;
    if constexpr (Epi::AFTER_DRAIN) { E.fused(acc, cur, wr, wc, fr, fq, lds, wid, lane); S.done(cur); }
#undef PG8_SA
#undef PG8_SB
#undef PG8_STAGE
#undef PG8_LDA
#undef PG8_LDB
#undef PG8_MMA
#undef PG8_WAIT_V
#undef PG8_WAIT_L
#undef PG8_BAR
#undef PG8_SCHED
}
}
namespace pg8 {
typedef float f32x2 __attribute__((ext_vector_type(2)));
__device__ __forceinline__ float rms_rowscale(const float* ssq, int row) { const f32x4 a = *(const f32x4*)(ssq + (size_t)row * 8), b = *(const f32x4*)(ssq + (size_t)row * 8 + 4);
    return __builtin_amdgcn_rsqf((((a[0] + a[1]) + (a[2] + a[3])) + ((b[0] + b[1]) + (b[2] + b[3]))) * (1.0f / 2048.0f) + 1e-6f); }
struct SegTab { bf16_t* base[8]; int ldc[8]; int t0[8]; int gw[8]; int nseg; int pad_; };
struct EpiBf16R {
    static constexpr bool PERM = true, AFTER_DRAIN = false, APERM = false;
    SegTab T; const float* ssp; int ss_off;
    __device__ __forceinline__ void operator()(const f32x4 (&acc)[2][2][4][2], const Unit& u, int wr, int wc, int fr, int fq) const {
        bf16_t* base = T.base[0]; int ldc = T.ldc[0], gw = T.gw[0], t0 = T.t0[0];
#pragma unroll
        for (int s = 1; s < 8; ++s) if (s < T.nseg && u.pn >= T.t0[s]) { base = T.base[s]; ldc = T.ldc[s]; gw = T.gw[s]; t0 = T.t0[s]; }
        const int colt = (u.pn - t0) * BM, row0 = u.pm * BM + wr * 64 + fr;
        if (gw <= -4) {
            typedef unsigned u32x2_ __attribute__((ext_vector_type(2)));
#pragma unroll
            for (int bj = 0; bj < 2; ++bj) { const int col = colt + bj * HALF + wc * 32 + 8 * fq;
                f32x4 c0 = {1.f, 1.f, 1.f, 1.f}, c1 = {1.f, 1.f, 1.f, 1.f};
                if (ssp) {
#pragma unroll
                    for (int j = 0; j < 4; ++j) { c0[j] = rms_rowscale(ssp, ss_off + col + j); c1[j] = rms_rowscale(ssp, ss_off + col + 4 + j); } }
                const int bt = ((col >> 12) * ldc) * 128 + ((col & 4095) >> 5);
#pragma unroll
                for (int ai = 0; ai < 2; ++ai)
#pragma unroll
                    for (int m = 0; m < 4; ++m) { const int row = row0 + ai * HALF + m * 16;
                        const f32x4 v0 = acc[ai][bj][m][0] * c0, v1 = acc[ai][bj][m][1] * c1;
                        if (gw == -4) {
                            bf16_t* d0 = base + ((size_t)(((bt + (row >> 7) * 128) * 8 + ((row >> 5) & 3) * 2 + ((col >> 4) & 1)) * 64) + (row & 31)) * 8 + 4 * ((col >> 3) & 1);
                            *(u32x2_*)d0 = (u32x2_){cvt_pk_bf16(v0[0], v0[1]), cvt_pk_bf16(v0[2], v0[3])}; *(u32x2_*)(d0 + 32 * 8) = (u32x2_){cvt_pk_bf16(v1[0], v1[1]), cvt_pk_bf16(v1[2], v1[3])};
                        } else {
                            const int k0 = col & 31, kq = (k0 & 15) >> 2, j0 = (k0 >> 4) * 4;
                            unsigned char* d8 = (unsigned char*)base + ((size_t)(((bt + (row >> 7) * 128) * 8 + ((row >> 4) & 7)) * 64) + 16 * kq + (row & 15)) * 8 + j0;
                            int lo = 0, hi = 0;
                            lo = __builtin_amdgcn_cvt_pk_fp8_f32(v0[0], v0[1], lo, false); lo = __builtin_amdgcn_cvt_pk_fp8_f32(v0[2], v0[3], lo, true);
                            hi = __builtin_amdgcn_cvt_pk_fp8_f32(v1[0], v1[1], hi, false); hi = __builtin_amdgcn_cvt_pk_fp8_f32(v1[2], v1[3], hi, true);
                            *(int*)d8 = lo; *(int*)(d8 + 16 * 8) = hi; } } }
            return; }
#pragma unroll
        for (int ai = 0; ai < 2; ++ai)
#pragma unroll
            for (int m = 0; m < 4; ++m) { const int row = row0 + ai * HALF + m * 16;
                const float rs = ssp ? rms_rowscale(ssp, ss_off + row) : 1.0f;
#pragma unroll
                for (int bj = 0; bj < 2; ++bj) { const int col = colt + bj * HALF + wc * 32 + 8 * fq;
                    const f32x4 v0 = acc[ai][bj][m][0] * rs, v1 = acc[ai][bj][m][1] * rs;
                    u32x4 w; w.x = cvt_pk_bf16(v0[0], v0[1]); w.y = cvt_pk_bf16(v0[2], v0[3]); w.z = cvt_pk_bf16(v1[0], v1[1]); w.w = cvt_pk_bf16(v1[2], v1[3]);
                    if (gw == -2) {
                        if ((row >> 5) < ldc) { bf16_t* d0 = base + ((size_t)(((col >> 5) * ldc + (row >> 5)) * 2 + ((col >> 4) & 1)) * 64 + (row & 31)) * 8 + 4 * ((col >> 3) & 1);
                            typedef unsigned u32x2_ __attribute__((ext_vector_type(2)));
                            *(u32x2_*)d0 = (u32x2_){w.x, w.y}; *(u32x2_*)(d0 + 32 * 8) = (u32x2_){w.z, w.w}; }
                        continue; }
                    bf16_t* dst;
                    if (gw == 0) dst = base + (size_t)row * ldc + col;
                    else if (gw == -1) { if ((col >> 4) >= ldc) continue; dst = base + ((size_t)((row >> 5) * ldc + (col >> 4)) * 64 + ((col >> 3) & 1) * 32 + (row & 31)) * 8; }
                    else if (gw == -3) dst = base + ((size_t)(((((row >> 12) * 16 + (col >> 7)) * 128 + ((row & 4095) >> 5)) * 9 + ((col >> 4) & 7)) * 64) + ((col >> 3) & 1) * 32 + (row & 31)) * 8;
                    else { const int g = col / gw, d = col - g * gw; dst = base + ((size_t)((row >> 12) * 4 + g) * 4096 + (row & 4095)) * gw + d; }
                    *(u32x4*)dst = w; } }
    }
};
struct EpiGelu {
    static constexpr bool PERM = true, AFTER_DRAIN = false, APERM = false;
    bf16_t* O; int ldc; const float* bias;
    static __device__ __forceinline__ float gelu(float x) { const float u2 = 1.5957691216f * (x + 0.044715f * x * x * x); const float e = __builtin_amdgcn_exp2f(-u2 * 1.4426950409f); return x * __builtin_amdgcn_rcpf(1.0f + e); }
    __device__ __forceinline__ void operator()(const f32x4 (&acc)[2][2][4][2], const Unit& u, int wr, int wc, int fr, int fq) const {
        const int row0 = u.pm * BM + wr * 64 + fr, col0 = u.pn * BM + wc * 32 + 8 * fq;
#pragma unroll
        for (int bj = 0; bj < 2; ++bj) { const f32x4 b0 = *(const f32x4*)(bias + col0 + bj * HALF), b1 = *(const f32x4*)(bias + col0 + bj * HALF + 4);
#pragma unroll
            for (int ai = 0; ai < 2; ++ai)
#pragma unroll
                for (int m = 0; m < 4; ++m) { const f32x4 v0 = acc[ai][bj][m][0] + b0, v1 = acc[ai][bj][m][1] + b1;
                    u32x4 w; w.x = cvt_pk_bf16(gelu(v0[0]), gelu(v0[1])); w.y = cvt_pk_bf16(gelu(v0[2]), gelu(v0[3])); w.z = cvt_pk_bf16(gelu(v1[0]), gelu(v1[1])); w.w = cvt_pk_bf16(gelu(v1[2]), gelu(v1[3]));
                    *(u32x4*)(O + (size_t)(row0 + ai * HALF + m * 16) * ldc + col0 + bj * HALF) = w; } }
    }
};
struct EpiF32 {
    static constexpr bool PERM = false, AFTER_DRAIN = false, APERM = false;
    float* C; int ldc; const float* ssp; int ss_off;
    __device__ __forceinline__ void operator()(const f32x4 (&acc)[2][2][4][2], const Unit& u, int wr, int wc, int fr, int fq) const {
        const int row0 = u.pm * BM + wr * 64 + fr, col0 = u.pn * BM + wc * 32 + 4 * fq;
#pragma unroll
        for (int ai = 0; ai < 2; ++ai)
#pragma unroll
            for (int m = 0; m < 4; ++m) { float* rowp = C + (size_t)(row0 + ai * HALF + m * 16) * ldc + col0;
                const float rs = ssp ? rms_rowscale(ssp, ss_off + row0 + ai * HALF + m * 16) : 1.0f;
#pragma unroll
                for (int bj = 0; bj < 2; ++bj)
#pragma unroll
                    for (int n = 0; n < 2; ++n) *(f32x4*)(rowp + bj * HALF + n * 16) = acc[ai][bj][m][n] * rs; }
    }
};
struct EpiResN {
    static constexpr bool PERM = false, AFTER_DRAIN = false, APERM = false;
    const float* res32; const float* gprev; float* out32; int ldc; int row_off; const float* g; bf16_t* xn; float* ss; PG8_LAS float* xb;
    __device__ __forceinline__ void operator()(const f32x4 (&acc)[2][2][4][2], const Unit& u, int wr, int wc, int fr, int fq) const {
        typedef unsigned u32x2_ __attribute__((ext_vector_type(2)));
        const int row0 = row_off + u.pm * BM + wr * 64 + fr, col0 = u.pn * BM + wc * 32 + 4 * fq;
        f32x4 gv[2][2], gi[2][2];
#pragma unroll
        for (int bj = 0; bj < 2; ++bj)
#pragma unroll
            for (int n = 0; n < 2; ++n) { gv[bj][n] = g ? *(const f32x4*)(g + col0 + bj * HALF + n * 16) : (f32x4){0.f, 0.f, 0.f, 0.f};
                if (!res32) { const f32x4 t = *(const f32x4*)(gprev + col0 + bj * HALF + n * 16); gi[bj][n] = (f32x4){1.0f / t[0], 1.0f / t[1], 1.0f / t[2], 1.0f / t[3]}; } else gi[bj][n] = (f32x4){1.f, 1.f, 1.f, 1.f}; }
#pragma unroll
        for (int ai = 0; ai < 2; ++ai)
#pragma unroll
            for (int m = 0; m < 4; ++m) { const int row = row0 + ai * HALF + m * 16; const size_t off = (size_t)row * ldc + col0;
                f32x4 r[2][2]; float sq = 0.f;
#pragma unroll
                for (int bj = 0; bj < 2; ++bj)
#pragma unroll
                    for (int n = 0; n < 2; ++n) {
                        if (res32) r[bj][n] = *(const f32x4*)(res32 + off + bj * HALF + n * 16);
                        else { const u32x2_ w = *(const u32x2_*)(xn + off + bj * HALF + n * 16);
                            r[bj][n] = (f32x4){__builtin_bit_cast(float, w.x << 16), __builtin_bit_cast(float, w.x & 0xffff0000u), __builtin_bit_cast(float, w.y << 16), __builtin_bit_cast(float, w.y & 0xffff0000u)} * gi[bj][n]; } }
#pragma unroll
                for (int bj = 0; bj < 2; ++bj)
#pragma unroll
                    for (int n = 0; n < 2; ++n) { const f32x4 o = r[bj][n] + acc[ai][bj][m][n];
                        if (out32) *(f32x4*)(out32 + off + bj * HALF + n * 16) = o;
                        if (g) { sq += (o[0] * o[0] + o[1] * o[1]) + (o[2] * o[2] + o[3] * o[3]);
                            const f32x4 y = o * gv[bj][n]; *(u32x2_*)(xn + off + bj * HALF + n * 16) = (u32x2_){cvt_pk_bf16(y[0], y[1]), cvt_pk_bf16(y[2], y[3])}; } }
                if (g) { sq += __shfl_xor(sq, 16); sq += __shfl_xor(sq, 32);
                    if (fq == 0) xb[(ai * HALF + wr * 64 + m * 16 + fr) * 4 + wc] = sq; }
                asm volatile("" ::: "memory"); }
        if (g) {
            asm volatile("s_waitcnt lgkmcnt(0)" ::: "memory"); __builtin_amdgcn_s_barrier(); asm volatile("" ::: "memory");
            const int t = (wr * 4 + wc) * 64 + fq * 16 + fr;
            if (t < BM) { const f32x4 v = *(const PG8_LAS f32x4*)(xb + t * 4); ss[(size_t)(row_off + u.pm * BM + t) * 8 + u.pn] = (v[0] + v[1]) + (v[2] + v[3]); }
        }
    }
};
struct EpiConvGlu {
    static constexpr bool PERM = true, AFTER_DRAIN = false, APERM = true;
    bf16_t* G; float* UB; const float* cw; const float* cb; PG8_LAS float* xb; int dff; const PG8_LAS float* rstd; int rbase;
    static __device__ __forceinline__ float shr1(float old, float src) { const int o = __builtin_bit_cast(int, old), s = __builtin_bit_cast(int, src);
        return __builtin_bit_cast(float, __builtin_amdgcn_update_dpp(o, s, 0x111, 0xf, 0xf, false)); }
    __device__ __forceinline__ void operator()(f32x4 (&acc)[2][2][4][2], const Unit& u, int wr, int wc, int fr, int fq) const {
        typedef unsigned u32x2_ __attribute__((ext_vector_type(2)));
        if (rstd) {
#pragma unroll
            for (int ai = 0; ai < 2; ++ai) { const f32x4 rs = *(const PG8_LAS f32x4*)(rstd + (u.pm * BM + ai * HALF + wr * 64 + fr * 4 - rbase));
#pragma unroll
                for (int m = 0; m < 4; ++m)
#pragma unroll
                    for (int bj = 0; bj < 2; ++bj)
#pragma unroll
                        for (int n = 0; n < 2; ++n) acc[ai][bj][m][n] = acc[ai][bj][m][n] * rs[m]; }
        }
        if (fr == 15) {
#pragma unroll
            for (int ai = 0; ai < 2; ++ai)
#pragma unroll
                for (int k = 0; k < 2; ++k)
#pragma unroll
                    for (int bj = 0; bj < 2; ++bj)
#pragma unroll
                        for (int n = 0; n < 2; ++n) *(PG8_LAS f32x4*)(xb + (((((ai * 2 + wr) * 4 + wc) * 2 + k) * 4 + fq) * 16) + (bj * 2 + n) * 4) = acc[ai][bj][2 + k][n];
        }
        { const int ncol = 4 * dff / 2;
          const bool top = (wr == 0 && fr == 0), bot = (wr == 1 && fr == 15);
          if (top || bot) {
#pragma unroll
            for (int k = 0; k < 2; ++k) { float* ub = UB + ((size_t)(u.pm * 4 + (top ? k : 2 + k)) * ncol) + u.pn * BM + wc * 32 + 8 * fq;
#pragma unroll
              for (int bj = 0; bj < 2; ++bj)
#pragma unroll
                for (int n = 0; n < 2; ++n) *(f32x4*)(ub + bj * HALF + 4 * n) = top ? acc[0][bj][k][n] : acc[1][bj][2 + k][n]; } } }
        asm volatile("s_waitcnt lgkmcnt(0)" ::: "memory"); __builtin_amdgcn_s_barrier(); asm volatile("" ::: "memory");
        u32x2_ res[2][4][2];
        const int ch0 = u.pn * HALF + wc * 32 + 8 * fq;
#pragma unroll
        for (int n = 0; n < 2; ++n) {
            const float* wp = cw + ch0 + 4 * n; const float* bp = cb + ch0 + 4 * n;
            const f32x4 w0g = *(const f32x4*)(wp), w1g = *(const f32x4*)(wp + 2 * dff), w2g = *(const f32x4*)(wp + 4 * dff), bg = *(const f32x4*)(bp);
            const f32x4 w0v = *(const f32x4*)(wp + dff), w1v = *(const f32x4*)(wp + 3 * dff), w2v = *(const f32x4*)(wp + 5 * dff), bv = *(const f32x4*)(bp + dff);
#pragma unroll
            for (int ai = 0; ai < 2; ++ai) {
                const int sai = wr ? ai : ai - 1, swr = wr ? 0 : 1;
                f32x4 x62g = {0.f, 0.f, 0.f, 0.f}, x63g = x62g, x62v = x62g, x63v = x62g;
                if (sai >= 0) { const PG8_LAS float* xp = xb + (((((sai * 2 + swr) * 4 + wc) * 2) * 4 + fq) * 16);
                    x62g = *(const PG8_LAS f32x4*)(xp + n * 4); x62v = *(const PG8_LAS f32x4*)(xp + (2 + n) * 4); x63g = *(const PG8_LAS f32x4*)(xp + 64 + n * 4); x63v = *(const PG8_LAS f32x4*)(xp + 64 + (2 + n) * 4); }
                float o[4][4];
#pragma unroll
                for (int e = 0; e < 4; ++e) {
                    const float g0 = acc[ai][0][0][n][e], g1 = acc[ai][0][1][n][e], g2 = acc[ai][0][2][n][e], g3 = acc[ai][0][3][n][e];
                    const float v0 = acc[ai][1][0][n][e], v1 = acc[ai][1][1][n][e], v2 = acc[ai][1][2][n][e], v3 = acc[ai][1][3][n][e];
                    const float q1g = shr1(x63g[e], g3), q2g = shr1(x62g[e], g2), q1v = shr1(x63v[e], v3), q2v = shr1(x62v[e], v2);
                    const float yg[4] = {bg[e] + w0g[e] * q2g + w1g[e] * q1g + w2g[e] * g0, bg[e] + w0g[e] * q1g + w1g[e] * g0 + w2g[e] * g1, bg[e] + w0g[e] * g0 + w1g[e] * g1 + w2g[e] * g2, bg[e] + w0g[e] * g1 + w1g[e] * g2 + w2g[e] * g3};
                    const float yv[4] = {bv[e] + w0v[e] * q2v + w1v[e] * q1v + w2v[e] * v0, bv[e] + w0v[e] * q1v + w1v[e] * v0 + w2v[e] * v1, bv[e] + w0v[e] * v0 + w1v[e] * v1 + w2v[e] * v2, bv[e] + w0v[e] * v1 + w1v[e] * v2 + w2v[e] * v3};
#pragma unroll
                    for (int m = 0; m < 4; ++m) o[m][e] = yg[m] * __builtin_amdgcn_rcpf(1.0f + __builtin_amdgcn_exp2f(-yg[m] * 1.4426950409f)) * yv[m];
                }
#pragma unroll
                for (int m = 0; m < 4; ++m) res[ai][m][n] = (u32x2_){cvt_pk_bf16(o[m][0], o[m][1]), cvt_pk_bf16(o[m][2], o[m][3])};
            }
        }
        const int row0 = u.pm * BM + wr * 64 + fr * 4;
#pragma unroll
        for (int ai = 0; ai < 2; ++ai)
#pragma unroll
            for (int m = 0; m < 4; ++m) *(u32x4*)(G + (size_t)(row0 + ai * HALF + m) * dff + ch0) = (u32x4){res[ai][m][0].x, res[ai][m][0].y, res[ai][m][1].x, res[ai][m][1].y};
    }
};
}
constexpr int BATCH = 8, SEQ = 4096, DM = 2048, MTOT = BATCH * SEQ, MC = MTOT / 2  , BPH = BATCH / 2;
constexpr int DFF = 5632;
constexpr float NORM_EPS = 1e-6f, LOG2E = 1.4426950408889634f;
constexpr int NWAVES = 8;
constexpr size_t MiB = 1u << 20;
constexpr size_t WS_CTL = 0, CTL_ZERO_BYTES = 1 * MiB;
constexpr size_t WS_TAB = 1 * MiB;
constexpr size_t TAB_COS48 = WS_TAB, TAB_SIN48 = WS_TAB + 3 * MiB, TAB_COS32 = WS_TAB + 6 * MiB, TAB_SIN32 = WS_TAB + 8 * MiB;
constexpr size_t WS_WMIX = 12 * MiB;
constexpr size_t WS_WFFN = 100 * MiB;
constexpr size_t WS_MISC = 168 * MiB;
constexpr size_t WS_SS = 170 * MiB;
constexpr size_t WS_XNR = 1010 * MiB;
constexpr size_t WS_AR = 234 * MiB;
constexpr size_t WS_END = 1138 * MiB;
constexpr int CW_TMO = 0;
constexpr int CW_BAR = 4096;
constexpr int RING_BYTES = 131072;
constexpr int LDSCTL_OFF = 135168;
constexpr int LDS_BYTES = 163840;

#define GAS __attribute__((address_space(1)))
#define LAS __attribute__((address_space(3)))
typedef unsigned short bf16;
typedef unsigned u32x4 __attribute__((ext_vector_type(4)));
typedef unsigned u32x2 __attribute__((ext_vector_type(2)));
typedef float f32x4 __attribute__((ext_vector_type(4)));
typedef float f32x16 __attribute__((ext_vector_type(16)));
typedef short bf16x8 __attribute__((ext_vector_type(8)));
typedef short s16x4 __attribute__((ext_vector_type(4)));
typedef short v4i16_t __attribute__((ext_vector_type(4)));
typedef __bf16 bf16x2_t __attribute__((ext_vector_type(2)));
typedef float f32x2_t __attribute__((ext_vector_type(2)));
#define LDS_WAIT() asm volatile("s_waitcnt lgkmcnt(0)" ::: "memory")
#define VM_WAIT() asm volatile("s_waitcnt vmcnt(0)" ::: "memory")
#define MFMA32(a, b, c) __builtin_amdgcn_mfma_f32_32x32x16_bf16((a), (b), (c), 0, 0, 0)
DI unsigned pk2(float lo, float hi) { f32x2_t v = {lo, hi}; bf16x2_t b = __builtin_convertvector(v, bf16x2_t); return __builtin_bit_cast(unsigned, b); }
DI float bf2f(unsigned short b) { return __builtin_bit_cast(float, (unsigned)b << 16); }
DI float bflo(unsigned w) { return __builtin_bit_cast(float, w << 16); }
DI float bfhi(unsigned w) { return __builtin_bit_cast(float, w & 0xffff0000u); }
DI unsigned short f2bf(float f) { return (unsigned short)(pk2(f, 0.f) & 0xffffu); }
DI float wave_sum(float v) {
#pragma unroll
    for (int o = 1; o < 64; o <<= 1) v += __shfl_xor(v, o);
    return v;
}
DI int crow(int i, int h) { return (i & 3) + 8 * (i >> 2) + 4 * h; }
#define XB_TMO      128
#define XB_XCNT(j)  (256  + 64 * (j))
#define XB_XSUB(j)  (1280 + 64 * (j))
#define XB_XGEN(j)  (2304 + 64 * (j))
#define XB_TOP      3328
#define XB_TOPGEN   3392
#define XCD_BAR_WORDS 3456
#define XB_SPIN_CAP (1u << 18)

__device__ __forceinline__ unsigned xb_ld(unsigned* p)              { return __hip_atomic_load(p, __ATOMIC_RELAXED, __HIP_MEMORY_SCOPE_AGENT); }
__device__ __forceinline__ unsigned xb_add(unsigned* p, unsigned v) { return __hip_atomic_fetch_add(p, v, __ATOMIC_RELAXED, __HIP_MEMORY_SCOPE_AGENT); }
__device__ __forceinline__ unsigned xb_xcc_id() { return (unsigned)__builtin_amdgcn_s_getreg((3 << 11) | 20) & 0xFu; }
#define XB_SPIN(cond, bar) do { unsigned _sp = 0; while (cond) { __builtin_amdgcn_s_sleep(1); \
    if ((++_sp & 255u) == 0u) { if (xb_ld(&(bar)[XB_TMO])) break; if (_sp > XB_SPIN_CAP) { atomicAdd(&(bar)[XB_TMO], 1u); break; } } } } while (0)

struct XcdBarrier {
    unsigned* bar; unsigned x;
    volatile LAS unsigned* st;
};

__device__ __forceinline__ XcdBarrier xcd_barrier_post(unsigned* bar, volatile LAS unsigned* st) {
    XcdBarrier b; b.bar = bar; b.x = xb_xcc_id(); b.st = st;
    if (threadIdx.x == 0) (void)xb_add(&bar[XB_XCNT(b.x)], 1u);
    return b;
}
__device__ __forceinline__ void xcd_barrier_complete(unsigned* bar, unsigned x, unsigned& nloc, unsigned& nx) {
    const unsigned G = gridDim.x * gridDim.y * gridDim.z;
    unsigned sum, cnt, mine, sp = 0u;
    for (;;) {
        sum = 0u; cnt = 0u; mine = 0u;
#pragma unroll
        for (unsigned j = 0; j < 16; ++j) { const unsigned c = xb_ld(&bar[XB_XCNT(j)]); sum += c; cnt += (c > 0u) ? 1u : 0u; mine = (j == x) ? c : mine; }
        if (sum == G) break;
        __builtin_amdgcn_s_sleep(1);
        if ((++sp & 255u) == 0u) { if (xb_ld(&bar[XB_TMO])) break; if (sp > XB_SPIN_CAP) { atomicAdd(&bar[XB_TMO], 1u); break; } }
    }
    nloc = mine > 0u ? mine : 1u; nx = cnt > 0u ? cnt : 1u;
}

__device__ __forceinline__ void xcd_barrier(const XcdBarrier& b) {
    asm volatile("s_waitcnt vmcnt(0)" ::: "memory");
    __syncthreads();
    if (threadIdx.x == 0) {
        unsigned* bar = b.bar;
        __builtin_amdgcn_s_waitcnt(0);
        unsigned nloc = b.st[0], nx = b.st[1];
        if (nloc == 0u) { xcd_barrier_complete(bar, b.x, nloc, nx); b.st[0] = nloc; b.st[1] = nx; }
        const unsigned old = xb_add(&bar[XB_XSUB(b.x)], 1u);
        const unsigned gen = old / nloc;
        if (old + 1u == (gen + 1u) * nloc) {
            __builtin_amdgcn_fence(__ATOMIC_RELEASE, "agent");
            asm volatile("s_waitcnt vmcnt(0)" ::: "memory");
            const unsigned og = xb_add(&bar[XB_TOP], 1u);
            const unsigned tg = og / nx;
            if (og + 1u == (tg + 1u) * nx) xb_add(&bar[XB_TOPGEN], 1u);
            else XB_SPIN(xb_ld(&bar[XB_TOPGEN]) == tg, bar);
            __builtin_amdgcn_fence(__ATOMIC_ACQUIRE, "agent");
            xb_add(&bar[XB_XGEN(b.x)], 1u);
            asm volatile("s_waitcnt vmcnt(0)" ::: "memory");
        } else {
            XB_SPIN(xb_ld(&bar[XB_XGEN(b.x)]) == gen, bar);
            __builtin_amdgcn_fence(__ATOMIC_ACQUIRE, "agent");
            asm volatile("s_waitcnt vmcnt(0)" ::: "memory");
        }
    }
    __syncthreads();
}
struct Frame {
    LAS unsigned char* lds; unsigned* ctl; unsigned char* ws;
    int tid, lane, wave, G, gw, NGW;
};
DI void ph_tables(const Frame& F, const int* pos) {
    float* c48 = (float*)(F.ws + TAB_COS48); float* s48 = (float*)(F.ws + TAB_SIN48); float* c32 = (float*)(F.ws + TAB_COS32); float* s32 = (float*)(F.ws + TAB_SIN32);
    const int gt = blockIdx.x * (NWAVES * 64) + F.tid, NT = F.G * NWAVES * 64;
    for (int i = gt; i < MTOT * 40; i += NT) {
        const int m = i / 40, j = i - m * 40; const float p = (float)pos[m];
        const bool a = j < 24; const int jj = a ? j : j - 24;
        const float inv = (float)exp(-(2.0 * jj / (a ? 48.0 : 32.0)) * 13.122363377404328);
        const float ang = p * inv; float sn, cs; sincosf(ang, &sn, &cs);
        if (a) { c48[m * 24 + jj] = cs; s48[m * 24 + jj] = sn; } else { c32[m * 16 + jj] = cs; s32[m * 16 + jj] = sn; }
    }
}
DI void cvt_load(float (&v)[32], const float* W, int ldw, int col0, int ncols, int item, int nblk, int lane) {
    const int kb = item / nblk, nb = item - kb * nblk, k0 = 64 * kb, n0 = 32 * nb, nn = n0 + (lane & 31); const bool ok = nn < ncols;
    const float* p = W + (size_t)(k0 + (lane >> 5)) * ldw + col0 + (ok ? nn : 0);
#pragma unroll
    for (int i = 0; i < 32; ++i) { const float x = p[(size_t)(2 * i) * ldw]; v[i] = ok ? x : 0.f; }
}
DI void cvt_store(const float (&v)[32], int ncols, bf16* WT, int ldt, int row_off, float scale, LAS float* scr, int item, int nblk, int lane) {
    const int kb = item / nblk, nb = item - kb * nblk, k0 = 64 * kb, n0 = 32 * nb;
#pragma unroll
    for (int i = 0; i < 32; ++i) scr[(2 * i + (lane >> 5)) * 33 + (lane & 31)] = v[i] * scale;
    LDS_WAIT();
    const int c = lane & 7;
#pragma unroll
    for (int j = 0; j < 4; ++j) { const int n = (lane >> 3) + 8 * j; const LAS float* s = scr + (8 * c) * 33 + n;
        u32x4 o; o.x = pk2(s[0 * 33], s[1 * 33]); o.y = pk2(s[2 * 33], s[3 * 33]); o.z = pk2(s[4 * 33], s[5 * 33]); o.w = pk2(s[6 * 33], s[7 * 33]);
        if (n0 + n < ncols) *(u32x4*)(WT + (size_t)(row_off + n0 + n) * ldt + k0 + 8 * c) = o; }
    LDS_WAIT();
}
DI void cvt_item(const float* W, int ldw, int col0, int ncols, bf16* WT, int ldt, int row_off, float scale, LAS float* scr, int item, int nblk, int lane) {
    float v[32]; cvt_load(v, W, ldw, col0, ncols, item, nblk, lane); cvt_store(v, ncols, WT, ldt, row_off, scale, scr, item, nblk, lane);
}
template <class MAP> DI void cvt_loop(const Frame& F, const float* W, int ldw, int ncols, bf16* WT, int ldt, float scale, int nitems, int nblk, const MAP& map) {
    LAS float* scr = (LAS float*)(F.lds + F.wave * 16384);
    int it = F.gw; float cur[32]; int c0 = 0, ro = 0, li = 0;
    if (it < nitems) { map(it, c0, ro, li); cvt_load(cur, W, ldw, c0, ncols, li, nblk, F.lane); }
#pragma unroll 1
    for (; it < nitems; it += F.NGW) {
        float nxt[32]; int c1 = 0, r1 = 0, l1 = 0; const int ni = it + F.NGW;
        if (ni < nitems) { map(ni, c1, r1, l1); cvt_load(nxt, W, ldw, c1, ncols, l1, nblk, F.lane); }
        cvt_store(cur, ncols, WT, ldt, ro, scale, scr, li, nblk, F.lane);
#pragma unroll
        for (int i = 0; i < 32; ++i) cur[i] = nxt[i];
        c0 = c1; ro = r1; li = l1;
    }
}
struct CvtPlain { int col0, row_off; DI void operator()(int it, int& c, int& r, int& l) const { c = col0; r = row_off; l = it; } };
DI void cvt_job(const Frame& F, const float* W, int ldw, int K, int col0, int ncols, bf16* WT, int ldt, int row_off, float scale) {
    const int nblk = (ncols + 31) / 32;
    cvt_loop(F, W, ldw, ncols, WT, ldt, scale, (K / 64) * nblk, nblk, CvtPlain{col0, row_off});
}
DI void zero_bf16(const Frame& F, bf16* p, size_t nelem) {
    const size_t gt = (size_t)blockIdx.x * (NWAVES * 64) + F.tid, NT = (size_t)F.G * NWAVES * 64;
    for (size_t i = gt; i < nelem / 8; i += NT) ((u32x4*)p)[i] = (u32x4){0u, 0u, 0u, 0u};
}
DI void ph_cvt_ffn(const Frame& F, const float* up, const float* down) {
    bf16* WUP = (bf16*)(F.ws + WS_WFFN); bf16* WDN = WUP + (size_t)2 * DFF * DM;
    struct UpMap { DI void operator()(int it, int& c, int& r, int& l) const { const int seg = it >> 7, pn = seg >> 1, isv = seg & 1; c = isv * DFF + pn * 128; r = pn * 256 + isv * 128; l = it & 127; } };
    cvt_loop(F, up, 2 * DFF, 128, WUP, DM, 1.f, 88 * 128, 4, UpMap{});
    cvt_job(F, down, DM, DFF, 0, DM, WDN, DFF, 0, 1.f);
}
DI void ph_conv_fix(const Frame& F, const float* UB, bf16* Gb, const float* cw, const float* cb, const int nrows = MC) {
    const int gt = blockIdx.x * (NWAVES * 64) + F.tid, NT = F.G * NWAVES * 64;
    for (int it = gt; it < (nrows / 256) * (DFF / 4); it += NT) {
        const int pm = it / (DFF / 4), c4 = it - pm * (DFF / 4), ch = c4 * 4, col = (ch >> 7) * 256 + (ch & 127);
        const float* ub = UB + (size_t)pm * 4 * (2 * DFF) + col; const bool has = (pm & 15) != 0;
        const f32x4 z = {0.f, 0.f, 0.f, 0.f};
        const f32x4 g0 = *(const f32x4*)(ub), g1 = *(const f32x4*)(ub + 2 * DFF), v0 = *(const f32x4*)(ub + 128), v1 = *(const f32x4*)(ub + 2 * DFF + 128);
        const f32x4 gm2 = has ? *(const f32x4*)(ub - 2 * (2 * DFF)) : z, gm1 = has ? *(const f32x4*)(ub - (2 * DFF)) : z, vm2 = has ? *(const f32x4*)(ub - 2 * (2 * DFF) + 128) : z, vm1 = has ? *(const f32x4*)(ub - (2 * DFF) + 128) : z;
        const f32x4 w0g = *(const f32x4*)(cw + ch), w1g = *(const f32x4*)(cw + 2 * DFF + ch), w2g = *(const f32x4*)(cw + 4 * DFF + ch), bg = *(const f32x4*)(cb + ch);
        const f32x4 w0v = *(const f32x4*)(cw + DFF + ch), w1v = *(const f32x4*)(cw + 3 * DFF + ch), w2v = *(const f32x4*)(cw + 5 * DFF + ch), bv = *(const f32x4*)(cb + DFF + ch);
        float o0[4], o1[4];
#pragma unroll
        for (int e = 0; e < 4; ++e) {
            const float yg0 = bg[e] + w0g[e] * gm2[e] + w1g[e] * gm1[e] + w2g[e] * g0[e], yv0 = bv[e] + w0v[e] * vm2[e] + w1v[e] * vm1[e] + w2v[e] * v0[e];
            const float yg1 = bg[e] + w0g[e] * gm1[e] + w1g[e] * g0[e] + w2g[e] * g1[e], yv1 = bv[e] + w0v[e] * vm1[e] + w1v[e] * v0[e] + w2v[e] * v1[e];
            o0[e] = yg0 * __builtin_amdgcn_rcpf(1.0f + __builtin_amdgcn_exp2f(-yg0 * LOG2E)) * yv0; o1[e] = yg1 * __builtin_amdgcn_rcpf(1.0f + __builtin_amdgcn_exp2f(-yg1 * LOG2E)) * yv1;
        }
        u32x2 a, b; a.x = pk2(o0[0], o0[1]); a.y = pk2(o0[2], o0[3]); b.x = pk2(o1[0], o1[1]); b.y = pk2(o1[2], o1[3]);
        *(u32x2*)(Gb + (size_t)(pm * 256) * DFF + ch) = a; *(u32x2*)(Gb + (size_t)(pm * 256 + 1) * DFF + ch) = b;
    }
}
DI void ph_norm_first(const Frame& F, const float* src, const float* gain, bf16* XNR, float* ss) {
    f32x4 g[8];
#pragma unroll
    for (int j = 0; j < 8; ++j) g[j] = *(const f32x4*)(gain + 4 * (F.lane + 64 * j));
    for (int m = F.gw; m < MTOT; m += F.NGW) {
        const f32x4* xr = (const f32x4*)(src + (size_t)m * DM) + F.lane;
        f32x4 v[8]; float s2 = 0.f;
#pragma unroll
        for (int j = 0; j < 8; ++j) { v[j] = xr[64 * j]; s2 += (v[j].x * v[j].x + v[j].y * v[j].y) + (v[j].z * v[j].z + v[j].w * v[j].w); }
        s2 = wave_sum(s2);
        if (F.lane < 2) *(f32x4*)(ss + (size_t)m * 8 + 4 * F.lane) = (f32x4){F.lane == 0 ? s2 : 0.f, 0.f, 0.f, 0.f};
        u32x2* o = (u32x2*)(XNR + (size_t)m * DM) + F.lane;
#pragma unroll
        for (int j = 0; j < 8; ++j) { const f32x4 y = v[j] * g[j]; u32x2 w; w.x = pk2(y.x, y.y); w.y = pk2(y.z, y.w); o[64 * j] = w; }
    }
}
DI void ph_final_norm(const Frame& F, const bf16* xn, const float* ss, float* out) {
    for (int m = F.gw; m < MTOT; m += F.NGW) {
        const float rs = pg8::rms_rowscale(ss, m);
        u32x4 v[4];
#pragma unroll
        for (int j = 0; j < 4; ++j) v[j] = *(const u32x4*)(xn + (size_t)m * DM + j * 512 + F.lane * 8);
#pragma unroll
        for (int j = 0; j < 4; ++j) { float* o = out + (size_t)m * DM + j * 512 + F.lane * 8;
            *(f32x4*)o = (f32x4){__builtin_bit_cast(float, v[j].x << 16), __builtin_bit_cast(float, v[j].x & 0xffff0000u), __builtin_bit_cast(float, v[j].y << 16), __builtin_bit_cast(float, v[j].y & 0xffff0000u)} * rs;
            *(f32x4*)(o + 4) = (f32x4){__builtin_bit_cast(float, v[j].z << 16), __builtin_bit_cast(float, v[j].z & 0xffff0000u), __builtin_bit_cast(float, v[j].w << 16), __builtin_bit_cast(float, v[j].w & 0xffff0000u)} * rs; }
    }
}
DI void rope_piece(const bf16* qrow, int p, const float* cs, const float* sn, float (&o)[8]) {
    const bool lo = p < 3; const int pp = lo ? p + 3 : p - 3, i0 = 8 * (lo ? p : p - 3);
    const u32x4 a = *(const u32x4*)(qrow + 8 * p), b = *(const u32x4*)(qrow + 8 * pp);
    const f32x4 c0 = *(const f32x4*)(cs + i0), c1 = *(const f32x4*)(cs + i0 + 4), s0 = *(const f32x4*)(sn + i0), s1 = *(const f32x4*)(sn + i0 + 4);
#pragma unroll
    for (int e = 0; e < 4; ++e) { const float c_l = e < 2 ? c0[2 * e] : c1[2 * e - 4], c_h = e < 2 ? c0[2 * e + 1] : c1[2 * e - 3], s_l = e < 2 ? s0[2 * e] : s1[2 * e - 4], s_h = e < 2 ? s0[2 * e + 1] : s1[2 * e - 3];
        const float al = bflo(a[e]), ah = bfhi(a[e]), bl_ = bflo(b[e]), bh_ = bfhi(b[e]);
        o[2 * e] = lo ? al * c_l - bl_ * s_l : bl_ * s_l + al * c_l; o[2 * e + 1] = lo ? ah * c_h - bh_ * s_h : bh_ * s_h + ah * c_h; }
}
DI bf16x8 rope_frag32(const bf16* qrow, int s, int h, const float* cs, const float* sn) {
    float o[8]; rope_piece(qrow, 2 * s + h, cs, sn, o);
    u32x4 w; w.x = pk2(o[0], o[1]); w.y = pk2(o[2], o[3]); w.z = pk2(o[4], o[5]); w.w = pk2(o[6], o[7]); return __builtin_bit_cast(bf16x8, w);
}
constexpr size_t DA_DIN = 0, DA_CQN = 64 * MiB, DA_LATC = 80 * MiB, DA_KPE = 88 * MiB, DA_KIDX = 90 * MiB, DA_WIDX = 94 * MiB, DA_QL = 96 * MiB, DA_QPE = 352 * MiB, DA_QIDX = 400 * MiB,
                 DA_SEL = 464 * MiB, DA_CNT = 472 * MiB, DA_SC = 474 * MiB, DA_O2 = 474 * MiB;
constexpr size_t DW_W1 = 0, DW_W2 = (size_t)1024 * 2048, DW_WO = DW_W2 + (size_t)11776 * 512, DW_BD = DW_WO + (size_t)2048 * 4096;
constexpr float DSA_QSCALE = 0.07216878364870322f * LOG2E;
constexpr float DSA_WIDX_SCALE = 0.25f * 0.08838834764831845f;

DI void ph_dsa_cvt(const Frame& F, const float* w_in, const float* w_qup, const float* w_uk, const float* w_uv, const float* w_out) {
    bf16* WB = (bf16*)(F.ws + WS_WMIX);
    cvt_job(F, w_in, 960, DM, 0, 960, WB + DW_W1, DM, 0, 1.f);
    zero_bf16(F, WB + DW_W1 + (size_t)960 * DM, (size_t)64 * DM);
    { LAS float* scr = (LAS float*)(F.lds + F.wave * 16384);
      for (int it = F.gw; it < 32 * 16; it += F.NGW) { const int h = it >> 4; cvt_item(w_qup, 8192, h * 192, 48, WB + DW_W2, 512, 8192 + h * 48, DSA_QSCALE, scr, it & 15, 2, F.lane); } }
    cvt_job(F, w_qup, 8192, 512, 6144, 2048, WB + DW_W2, 512, 9728, 1.f);
    __syncthreads();
    {
        LAS float* As = (LAS float*)F.lds; LAS float* Bs = As + 64 * 145;
        for (int u = blockIdx.x; u < 32 * 4 * 8; u += F.G) {
            const int h = u >> 5, r0 = ((u >> 3) & 3) * 64, k0 = (u & 7) * 64;
            for (int i = F.tid; i < 64 * 144; i += NWAVES * 64) { const int row = i / 144, col = i - row * 144;
                As[row * 145 + col] = w_uk[(size_t)(h * 256 + r0) * 144 + i]; Bs[row * 145 + col] = w_qup[(size_t)(k0 + row) * 8192 + h * 192 + 48 + col]; }
            __syncthreads();
            const int r = F.tid & 63, kg = F.tid >> 6; float acc[8];
#pragma unroll
            for (int j = 0; j < 8; ++j) acc[j] = 0.f;
            for (int n = 0; n < 144; ++n) { const float a = As[r * 145 + n];
#pragma unroll
                for (int j = 0; j < 8; ++j) acc[j] += a * Bs[(kg * 8 + j) * 145 + n]; }
            u32x4 o; o.x = pk2(acc[0] * DSA_QSCALE, acc[1] * DSA_QSCALE); o.y = pk2(acc[2] * DSA_QSCALE, acc[3] * DSA_QSCALE); o.z = pk2(acc[4] * DSA_QSCALE, acc[5] * DSA_QSCALE); o.w = pk2(acc[6] * DSA_QSCALE, acc[7] * DSA_QSCALE);
            *(u32x4*)(WB + DW_W2 + (size_t)(h * 256 + r0 + r) * 512 + k0 + kg * 8) = o;
            __syncthreads();
        }
    }
    { LAS float* scr = (LAS float*)(F.lds + F.wave * 16384);
      for (int it = F.gw; it < 32 * 16; it += F.NGW) { const int h = it >> 4; cvt_item(w_uv + (size_t)h * 256 * 128, 128, 0, 128, WB + DW_BD + (h & 1) * 256, 512, h * 128, 1.f, scr, it & 15, 4, F.lane); } }
    { const size_t gt = (size_t)blockIdx.x * (NWAVES * 64) + F.tid, NT = (size_t)F.G * NWAVES * 64;
      for (size_t i = gt; i < (size_t)4096 * 32; i += NT) { const int row = (int)(i >> 5), pc = (int)(i & 31); *(u32x4*)(WB + DW_BD + (size_t)row * 512 + (1 - ((row >> 7) & 1)) * 256 + pc * 8) = (u32x4){0u, 0u, 0u, 0u}; } }
    cvt_job(F, w_out, DM, 4096, 0, DM, WB + DW_WO, 4096, 0, 1.f);
}
DI void ph_dsa_post1(const Frame& F, int half, const float* qn, const float* kvn, const float* lng, const float* lnb) {
    unsigned char* ar = F.ws + WS_AR;
    const float* DIN = (const float*)(ar + DA_DIN); bf16* CQN = (bf16*)(ar + DA_CQN); bf16* LATC = (bf16*)(ar + DA_LATC); bf16* KPE = (bf16*)(ar + DA_KPE); bf16* KIDX = (bf16*)(ar + DA_KIDX); float* WIDX = (float*)(ar + DA_WIDX);
    const float* c48 = (const float*)(F.ws + TAB_COS48); const float* s48 = (const float*)(F.ws + TAB_SIN48); const float* c32 = (const float*)(F.ws + TAB_COS32); const float* s32 = (const float*)(F.ws + TAB_SIN32);
    LAS float* buf = (LAS float*)(F.lds + F.wave * 1024);
    const int lane = F.lane;
    for (int ml = F.gw; ml < MC; ml += F.NGW) {
        const int mg = half * MC + ml;
        const size_t kfb = ((size_t)(ml >> 5) * 8 * 64 + (ml & 31)) * 8;
        const float* row = DIN + (size_t)ml * 1024 + 16 * lane;
        f32x4 v[4]; float ss = 0.f, s1 = 0.f;
#pragma unroll
        for (int j = 0; j < 4; ++j) { v[j] = *(const f32x4*)(row + 4 * j); ss += (v[j].x * v[j].x + v[j].y * v[j].y) + (v[j].z * v[j].z + v[j].w * v[j].w); s1 += (v[j].x + v[j].y) + (v[j].z + v[j].w); }
        const bool isq = lane < 32, iskv = lane >= 32 && lane < 48, ispe = lane >= 48 && lane < 51, isix = lane >= 51 && lane < 59;
        const float ssq = wave_sum(isq ? ss : 0.f), sskv = wave_sum(iskv ? ss : 0.f), mean = wave_sum(isix ? s1 : 0.f) * (1.f / 128.f);
        float d2 = 0.f;
#pragma unroll
        for (int j = 0; j < 4; ++j) { const f32x4 d = v[j] - mean; d2 += (d.x * d.x + d.y * d.y) + (d.z * d.z + d.w * d.w); }
        const float var = wave_sum(isix ? d2 : 0.f) * (1.f / 128.f);
        const float rq = 1.0f / sqrtf(ssq * (1.f / 512.f) + NORM_EPS), rkv = 1.0f / sqrtf(sskv * (1.f / 256.f) + NORM_EPS), rstd = 1.0f / sqrtf(var + NORM_EPS);
        if (isq || iskv) {
            const float* gp = isq ? qn + 16 * lane : kvn + 16 * (lane - 32); const float rs = isq ? rq : rkv;
            bf16* dst = isq ? CQN + (size_t)ml * 512 + 16 * lane : LATC + (size_t)ml * 256 + 16 * (lane - 32);
            u32x4 o[2];
#pragma unroll
            for (int j = 0; j < 4; ++j) { const f32x4 g = *(const f32x4*)(gp + 4 * j); const f32x4 y = v[j] * rs * g; o[j >> 1][(j & 1) * 2] = pk2(y.x, y.y); o[j >> 1][(j & 1) * 2 + 1] = pk2(y.z, y.w); }
            *(u32x4*)dst = o[0]; *(u32x4*)(dst + 8) = o[1];
        } else if (ispe) {
#pragma unroll
            for (int j = 0; j < 4; ++j) *(LAS f32x4*)(buf + (lane - 48) * 16 + 4 * j) = v[j];
        } else if (isix) {
#pragma unroll
            for (int j = 0; j < 4; ++j) { const f32x4 g = *(const f32x4*)(lng + (lane - 51) * 16 + 4 * j), b = *(const f32x4*)(lnb + (lane - 51) * 16 + 4 * j); *(LAS f32x4*)(buf + 48 + (lane - 51) * 16 + 4 * j) = (v[j] - mean) * rstd * g + b; }
        } else if (lane == 59) {
#pragma unroll
            for (int j = 0; j < 4; ++j) *(f32x4*)(WIDX + (size_t)ml * 16 + 4 * j) = v[j] * DSA_WIDX_SCALE;
        }
        LDS_WAIT();
        if (lane < 24) { const float x1 = buf[lane], x2 = buf[24 + lane], c = c48[(size_t)mg * 24 + lane], s = s48[(size_t)mg * 24 + lane];
            KPE[(size_t)ml * 48 + lane] = f2bf(x1 * c - x2 * s); KPE[(size_t)ml * 48 + 24 + lane] = f2bf(x1 * s + x2 * c);
        } else if (lane < 40) { const int i = lane - 24; const float x1 = buf[48 + i], x2 = buf[48 + 16 + i], c = c32[(size_t)mg * 16 + i], s = s32[(size_t)mg * 16 + i];
            KIDX[kfb + (size_t)((i >> 3) * 32) * 8 + (i & 7)] = f2bf(x1 * c - x2 * s); KIDX[kfb + (size_t)(64 + (i >> 3) * 32) * 8 + (i & 7)] = f2bf(x1 * s + x2 * c);
        } else { const int d = 32 + 4 * (lane - 40); const f32x4 y = *(const LAS f32x4*)(buf + 48 + d); u32x2 w; w.x = pk2(y.x, y.y); w.y = pk2(y.z, y.w); *(u32x2*)(KIDX + kfb + (size_t)((d >> 4) * 64 + ((d >> 3) & 1) * 32) * 8 + (d & 7)) = w; }
        LDS_WAIT();
    }
}
DI int wave_iscan_dpp(int v) {
    v += __builtin_amdgcn_update_dpp(0, v, 0x111, 0xf, 0xf, true); v += __builtin_amdgcn_update_dpp(0, v, 0x112, 0xf, 0xf, true);
    v += __builtin_amdgcn_update_dpp(0, v, 0x114, 0xf, 0xf, true); v += __builtin_amdgcn_update_dpp(0, v, 0x118, 0xf, 0xf, true);
    v += __builtin_amdgcn_update_dpp(0, v, 0x142, 0xa, 0xf, false);
    v += __builtin_amdgcn_update_dpp(0, v, 0x143, 0xc, 0xf, false);
    return v;
}
DI int wave_isum_dpp(int v) {
    v += __builtin_amdgcn_update_dpp(0, v, 0x111, 0xf, 0xf, true); v += __builtin_amdgcn_update_dpp(0, v, 0x112, 0xf, 0xf, true);
    v += __builtin_amdgcn_update_dpp(0, v, 0x114, 0xf, 0xf, true); v += __builtin_amdgcn_update_dpp(0, v, 0x118, 0xf, 0xf, true);
    v += __builtin_amdgcn_update_dpp(0, v, 0x142, 0xa, 0xf, false);
    v += __builtin_amdgcn_update_dpp(0, v, 0x143, 0xc, 0xf, false);
    return __builtin_amdgcn_readlane(v, 63);
}
DI unsigned f2sortable(float s) { const unsigned b = __builtin_bit_cast(unsigned, s); return (b & 0x80000000u) ? ~b : (b | 0x80000000u); }
DI void ph_dsa_index(const Frame& F, const int half) {
    const float* c32 = (const float*)(F.ws + TAB_COS32); const float* s32 = (const float*)(F.ws + TAB_SIN32);
    unsigned char* ar = F.ws + WS_AR;
    const bf16* QIDX = (const bf16*)(ar + DA_QIDX); const bf16* KIDX = (const bf16*)(ar + DA_KIDX); const float* WIDX = (const float*)(ar + DA_WIDX);
    unsigned short* SEL = (unsigned short*)(ar + DA_SEL); int* CNT = (int*)(ar + DA_CNT); float* SC = (float*)(ar + DA_SC) + (size_t)F.gw * 16384;
    const int lane = F.lane, r = lane & 31, hf = lane >> 5;
    LAS unsigned char* wl = F.lds + F.wave * 8192 + lane * 16;
    LAS unsigned* hist = (LAS unsigned*)(F.lds + 65536 + F.wave * 1024);
#pragma unroll 1
    for (int tile = blockIdx.x; tile < BPH * 128; tile += F.G) {
        const int j = tile >> 8, c8 = tile & 255, c7 = c8 & 127, bl = (c8 >> 7) * 2 + j, qt = j ? 127 - c7 : c7;
        const int q0 = qt * 32 + 4 * F.wave;
        const int ntile = (q0 + 3) / 32 + 1;
        bf16x8 qa[2][8];
#pragma unroll
        for (int pr = 0; pr < 2; ++pr) {
            const int mrow = bl * SEQ + q0 + 2 * pr + (r >> 4);
#pragma unroll
            for (int s = 0; s < 8; ++s) qa[pr][s] = *(const bf16x8*)(QIDX + (size_t)mrow * 2048 + (r & 15) * 128 + 16 * s + 8 * hf);
            { const float* cs = c32 + ((size_t)half * MC + mrow) * 16 + 8 * hf; const float* sn = s32 + ((size_t)half * MC + mrow) * 16 + 8 * hf;
              const f32x4 c0 = *(const f32x4*)cs, c1 = *(const f32x4*)(cs + 4), s0 = *(const f32x4*)sn, s1 = *(const f32x4*)(sn + 4);
              const u32x4 a = __builtin_bit_cast(u32x4, qa[pr][0]), b = __builtin_bit_cast(u32x4, qa[pr][1]); u32x4 o1, o2;
#pragma unroll
              for (int e = 0; e < 4; ++e) { const float c_l = e < 2 ? c0[2 * e] : c1[2 * e - 4], c_h = e < 2 ? c0[2 * e + 1] : c1[2 * e - 3], s_l = e < 2 ? s0[2 * e] : s1[2 * e - 4], s_h = e < 2 ? s0[2 * e + 1] : s1[2 * e - 3];
                  const float x1l = bflo(a[e]), x1h = bfhi(a[e]), x2l = bflo(b[e]), x2h = bfhi(b[e]);
                  o1[e] = pk2(x1l * c_l - x2l * s_l, x1h * c_h - x2h * s_h); o2[e] = pk2(x1l * s_l + x2l * c_l, x1h * s_h + x2h * c_h); }
              qa[pr][0] = __builtin_bit_cast(bf16x8, o1); qa[pr][1] = __builtin_bit_cast(bf16x8, o2); }
            float wv[2][16];
#pragma unroll
            for (int i = 0; i < 16; ++i) wv[pr][i] = WIDX[(size_t)(bl * SEQ + q0 + 2 * pr + (i >> 3)) * 16 + (i & 3) + 8 * ((i >> 2) & 1) + 4 * hf];
#pragma unroll
            for (int i = 0; i < 16; i += 4) *(LAS f32x4*)(wl + (pr * 4 + (i >> 2)) * 1024) = (f32x4){wv[pr][i], wv[pr][i + 1], wv[pr][i + 2], wv[pr][i + 3]};
        }
        LDS_WAIT();
        {
        bf16x8 kf[8];
        { const bf16* kp = KIDX + ((size_t)(bl * 128) * 8 * 64 + lane) * 8;
#pragma unroll
          for (int s = 0; s < 8; ++s) kf[s] = *(const bf16x8*)(kp + 512 * s); }
#pragma unroll 1
        for (int t = 0; t < ntile; ++t) {
            f32x16 accs[2];
#pragma unroll
            for (int pr = 0; pr < 2; ++pr) {
#pragma unroll
                for (int i = 0; i < 16; ++i) accs[pr][i] = 0.f;
#pragma unroll
                for (int s = 0; s < 8; ++s) accs[pr] = MFMA32(qa[pr][s], kf[s], accs[pr]);
            }
            if (t + 1 < ntile) { const bf16* kp = KIDX + ((size_t)(bl * 128 + t + 1) * 8 * 64 + lane) * 8;
#pragma unroll
                for (int s = 0; s < 8; ++s) kf[s] = *(const bf16x8*)(kp + 512 * s); }
#pragma unroll
            for (int pr = 0; pr < 2; ++pr) {
                const f32x16 acc = accs[pr];
                float wv[2][16];
                { unsigned wa_ = (unsigned)(size_t)wl; asm volatile("" : "+v"(wa_));
#pragma unroll
                  for (int i = 0; i < 16; i += 4) { const f32x4 w4 = *(const LAS f32x4*)((LAS unsigned char*)(size_t)wa_ + (pr * 4 + (i >> 2)) * 1024); wv[pr][i] = w4.x; wv[pr][i + 1] = w4.y; wv[pr][i + 2] = w4.z; wv[pr][i + 3] = w4.w; } }
                float p0 = 0.f, p1 = 0.f;
#pragma unroll
                for (int i = 0; i < 8; ++i) { p0 += wv[pr][i] * fmaxf(acc[i], 0.f); p1 += wv[pr][8 + i] * fmaxf(acc[8 + i], 0.f); }
                const float t0 = p0 + __shfl_xor(p0, 32), t1 = p1 + __shfl_xor(p1, 32);
                SC[(pr * 128 + t) * 64 + lane] = hf ? t1 : t0;
            }
        }
        }
        VM_WAIT();
#pragma unroll 1
        for (int qi = 0; qi < 4; ++qi) {
            const int tq = q0 + qi, pr = qi >> 1, qs = qi & 1;
            unsigned u[64];
            const unsigned* scp = (const unsigned*)(SC + pr * 8192 + hf * 64 + qs * 32 + r);
#pragma unroll
            for (int g8 = 0; g8 < 8; ++g8) {
#pragma unroll
                for (int e = 0; e < 8; ++e) { const int i = 8 * g8 + e; const float s = __builtin_bit_cast(float, __hip_atomic_load(scp + e * 128, __ATOMIC_RELAXED, __HIP_MEMORY_SCOPE_AGENT));
                    u[i] = (2 * i + hf < ntile && 64 * i + lane <= tq) ? f2sortable(s) : 0u; }
                scp += 1024; asm volatile("" : "+v"(scp));
            }
            unsigned prefix = 0u;
            if (tq >= 256) {
#pragma unroll 1
                for (int bit = 31; bit >= 0; --bit) {
                    const unsigned cand = prefix | (1u << bit); int c = 0;
#pragma unroll
                    for (int g8 = 0; g8 < 8; ++g8) { if (g8 * 512 <= tq) {
#pragma unroll
                        for (int e = 0; e < 8; ++e) c += (u[8 * g8 + e] >= cand) ? 1 : 0; } }
                    c = wave_isum_dpp(c);
                    if (c >= 256) prefix = cand;
                    if (c == 256) break;
                }
            }
            const unsigned T = prefix > 1u ? prefix : 1u;
            int nl = 0;
#pragma unroll
            for (int g8 = 0; g8 < 8; ++g8) { if (g8 * 512 <= tq) {
#pragma unroll
                for (int e = 0; e < 8; ++e) nl += (u[8 * g8 + e] >= T) ? 1 : 0; } }
            const int inc = wave_iscan_dpp(nl), base = __builtin_amdgcn_readlane(inc, 63);
            int pos = inc - nl;
            unsigned short* sel = SEL + (size_t)(bl * SEQ + tq) * 256;
#pragma unroll
            for (int g8 = 0; g8 < 8; ++g8) { if (g8 * 512 <= tq) {
#pragma unroll
                for (int e = 0; e < 8; ++e) { const int i = 8 * g8 + e; if (u[i] >= T) { if (pos < 256) sel[pos] = (unsigned short)(64 * i + lane); ++pos; } } } }
            if (lane == 0) CNT[bl * SEQ + tq] = base < 256 ? base : 256;
        }
    }
}
DI int dsa_fsw(int row) { return ((row & 3) << 2) | ((row >> 2) & 3); }
struct DsaPre { u32x4 row[16]; bf16x8 kpe[3]; bf16x8 q[3]; };
DI void dsa_prefetch(DsaPre& P, const bf16* LATC, const bf16* KPE, const bf16* QL, const bf16* QPE, const float* c48, const float* s48, int half, int ml, int selv, int lane, int w) {
    const int bl = ml >> 12, r = lane & 31, h = lane >> 5;
#pragma unroll
    for (int it = 0; it < 16; ++it) { const int ki = __shfl(selv, (lane >> 5) + 2 * it); P.row[it] = *(const u32x4*)(LATC + (size_t)(bl * SEQ + ki) * 256 + (lane & 31) * 8); }
#pragma unroll
    for (int s = 0; s < 3; ++s) P.kpe[s] = *(const bf16x8*)(KPE + (size_t)(bl * SEQ + selv) * 48 + 16 * s + 8 * h);
#pragma unroll
    for (int j = 0; j < 3; ++j) { const int fi = w + 8 * j;
        if (fi < 16) P.q[j] = *(const bf16x8*)(QL + (size_t)ml * 8192 + r * 256 + 16 * fi + 8 * h);
        else if (fi < 19) P.q[j] = rope_frag32(QPE + (size_t)ml * 1536 + r * 48, fi - 16, h, c48 + ((size_t)half * MC + ml) * 24, s48 + ((size_t)half * MC + ml) * 24); }
}
DI void ph_dsa_attn(const Frame& F, const int half) {
    const float* c48 = (const float*)(F.ws + TAB_COS48); const float* s48 = (const float*)(F.ws + TAB_SIN48);
    unsigned char* ar = F.ws + WS_AR;
    bf16* QL = (bf16*)(ar + DA_QL); const bf16* QPE = (const bf16*)(ar + DA_QPE); const bf16* LATC = (const bf16*)(ar + DA_LATC); const bf16* KPE = (const bf16*)(ar + DA_KPE);
    const unsigned short* SEL = (const unsigned short*)(ar + DA_SEL); const int* CNT = (const int*)(ar + DA_CNT);
    const int lane = F.lane, r = lane & 31, h = lane >> 5, w = F.wave;
    LAS unsigned char* IMG = F.lds; LAS unsigned char* QB = F.lds + LDSCTL_OFF + 256; LAS float* MX = (LAS float*)(F.lds + LDSCTL_OFF + 256 + 19456); LAS float* SX = MX + 256;
    const int i16 = lane & 15, tq_ = i16 >> 2, tp_ = i16 & 3, blk = (lane >> 4) & 1;
    int ml = blockIdx.x;
    if (ml >= MC) return;
    DsaPre P;
    int cnt_c = CNT[ml];
    { const int slot = 32 * w + r; const int selv = slot < cnt_c ? (int)SEL[(size_t)ml * 256 + slot] : 0; dsa_prefetch(P, LATC, KPE, QL, QPE, c48, s48, half, ml, selv, lane, w); }
    int cnt_n = 0, selv_n = 0;
    if (ml + F.G < MC) { cnt_n = CNT[ml + F.G]; const int slot = 32 * w + r; selv_n = slot < cnt_n ? (int)SEL[(size_t)(ml + F.G) * 256 + slot] : 0; }
#pragma unroll 1
    for (; ml < MC; ml += F.G) {
        const int cnt = cnt_c, nch = (cnt + 31) >> 5; const bool act = w < nch;
#pragma unroll
        for (int it = 0; it < 16; ++it) { const int rr = (lane >> 5) + 2 * it; *(LAS u32x4*)(IMG + (32 * w + rr) * 512 + (((lane & 31) ^ dsa_fsw(rr)) * 16)) = P.row[it]; }
#pragma unroll
        for (int j = 0; j < 3; ++j) { const int fi = w + 8 * j; if (fi < 19) *(LAS bf16x8*)(QB + fi * 1024 + lane * 16) = P.q[j]; }
        bf16x8 kpe[3];
#pragma unroll
        for (int s = 0; s < 3; ++s) kpe[s] = P.kpe[s];
        LDS_WAIT(); __builtin_amdgcn_s_barrier(); asm volatile("" ::: "memory");
        if (ml + F.G < MC) {
            dsa_prefetch(P, LATC, KPE, QL, QPE, c48, s48, half, ml + F.G, selv_n, lane, w); cnt_c = cnt_n;
            if (ml + 2 * F.G < MC) { cnt_n = CNT[ml + 2 * F.G]; const int slot = 32 * w + r; selv_n = slot < cnt_n ? (int)SEL[(size_t)(ml + 2 * F.G) * 256 + slot] : 0; }
        }
        f32x16 S; float mx = -INFINITY;
#pragma unroll
        for (int i = 0; i < 16; ++i) S[i] = 0.f;
        if (act) {
#pragma unroll
            for (int s = 0; s < 16; ++s) S = MFMA32(*(const LAS bf16x8*)(IMG + (32 * w + r) * 512 + (((2 * s + h) ^ dsa_fsw(r)) * 16)), *(const LAS bf16x8*)(QB + s * 1024 + lane * 16), S);
#pragma unroll
            for (int s = 0; s < 3; ++s) S = MFMA32(kpe[s], *(const LAS bf16x8*)(QB + (16 + s) * 1024 + lane * 16), S);
#pragma unroll
            for (int i = 0; i < 16; ++i) { S[i] = (32 * w + crow(i, h) < cnt) ? S[i] : -INFINITY; mx = fmaxf(mx, S[i]); }
            mx = fmaxf(mx, __shfl_xor(mx, 32));
        }
        if (h == 0) MX[w * 32 + r] = mx;
        LDS_WAIT(); __builtin_amdgcn_s_barrier(); asm volatile("" ::: "memory");
        float M = MX[r];
#pragma unroll
        for (int k = 1; k < 8; ++k) M = fmaxf(M, MX[k * 32 + r]);
        float lsum = 0.f; bf16x8 pf[2] = {(bf16x8){0, 0, 0, 0, 0, 0, 0, 0}, (bf16x8){0, 0, 0, 0, 0, 0, 0, 0}};
        if (act) {
#pragma unroll
            for (int i = 0; i < 16; ++i) { S[i] = __builtin_amdgcn_exp2f(S[i] - M); lsum += S[i]; }
#pragma unroll
            for (int s = 0; s < 2; ++s) { u32x4 t; t.x = pk2(S[8 * s], S[8 * s + 1]); t.y = pk2(S[8 * s + 2], S[8 * s + 3]); t.z = pk2(S[8 * s + 4], S[8 * s + 5]); t.w = pk2(S[8 * s + 6], S[8 * s + 7]); pf[s] = __builtin_bit_cast(bf16x8, t); }
        }
        lsum += __shfl_xor(lsum, 32);
        if (h == 0) SX[w * 32 + r] = lsum;
        *(LAS bf16x8*)(QB + (2 * w) * 1024 + lane * 16) = pf[0]; *(LAS bf16x8*)(QB + (2 * w + 1) * 1024 + lane * 16) = pf[1];
        LDS_WAIT(); __builtin_amdgcn_s_barrier(); asm volatile("" ::: "memory");
        f32x16 O;
#pragma unroll
        for (int i = 0; i < 16; ++i) O[i] = 0.f;
#pragma unroll 2
        for (int ks = 0; ks < 2 * nch; ++ks) {
            const int r0 = 16 * ks + 4 * h + tq_, r1 = r0 + 8, pc = 4 * w + 2 * blk + (tp_ >> 1);
            const s16x4 lo = __builtin_bit_cast(s16x4, __builtin_amdgcn_ds_read_tr16_b64_v4i16((LAS v4i16_t*)(IMG + r0 * 512 + ((pc ^ dsa_fsw(r0)) * 16) + 8 * (tp_ & 1))));
            const s16x4 hi = __builtin_bit_cast(s16x4, __builtin_amdgcn_ds_read_tr16_b64_v4i16((LAS v4i16_t*)(IMG + r1 * 512 + ((pc ^ dsa_fsw(r1)) * 16) + 8 * (tp_ & 1))));
            O = MFMA32(__builtin_shufflevector(lo, hi, 0, 1, 2, 3, 4, 5, 6, 7), *(const LAS bf16x8*)(QB + ks * 1024 + lane * 16), O);
        }
        float l = SX[r];
#pragma unroll
        for (int k = 1; k < 8; ++k) l += SX[k * 32 + r];
        const float linv = 1.0f / l;
        bf16* o = QL + (size_t)ml * 8192 + r * 256 + 32 * w + 4 * h;
#pragma unroll
        for (int g = 0; g < 4; ++g) { u32x2 t; t.x = pk2(O[4 * g] * linv, O[4 * g + 1] * linv); t.y = pk2(O[4 * g + 2] * linv, O[4 * g + 3] * linv); *(u32x2*)(o + 8 * g) = t; }
        LDS_WAIT(); __builtin_amdgcn_s_barrier(); asm volatile("" ::: "memory");
    }
}
template <int NDB, bool RESC = true> DI void softmax_step(f32x16& S, float& m, float& l, f32x16 (&O)[NDB], bf16x8 (&pf)[2]) {
    float mx = fmaxf(S[0], S[1]);
#pragma unroll
    for (int i = 2; i < 16; i += 2) mx = __builtin_fmaxf(mx, __builtin_fmaxf(S[i], S[i + 1]));
    mx = fmaxf(mx, __shfl_xor(mx, 32));
    const float mn = fmaxf(m, mx), ms = (mn == -INFINITY) ? 0.f : mn;
    const float alpha = __builtin_amdgcn_exp2f(m - ms);
    float sum = 0.f;
#pragma unroll
    for (int i = 0; i < 16; ++i) { S[i] = __builtin_amdgcn_exp2f(S[i] - ms); sum += S[i]; }
    l = l * alpha + sum; m = mn;
    if (RESC && __builtin_amdgcn_ballot_w64(alpha != 1.0f) != 0ull) {
#pragma unroll
        for (int db = 0; db < NDB; ++db)
#pragma unroll
            for (int i = 0; i < 16; ++i) O[db][i] *= alpha;
    }
#pragma unroll
    for (int s = 0; s < 2; ++s) { u32x4 w; w.x = pk2(S[8 * s], S[8 * s + 1]); w.y = pk2(S[8 * s + 2], S[8 * s + 3]); w.z = pk2(S[8 * s + 4], S[8 * s + 5]); w.w = pk2(S[8 * s + 6], S[8 * s + 7]); pf[s] = __builtin_bit_cast(bf16x8, w); }
}
template <bool ACC> DI void store_col(bf16* out, const f32x16 (&O)[4], float scale, int h) {
#pragma unroll
    for (int db = 0; db < 4; ++db)
#pragma unroll
        for (int g = 0; g < 4; ++g) { u32x2* p = (u32x2*)(out + db * 32 + 8 * g + 4 * h);
            float a = O[db][4 * g] * scale, b = O[db][4 * g + 1] * scale, c = O[db][4 * g + 2] * scale, d = O[db][4 * g + 3] * scale;
            if (ACC) { const u32x2 o = *p; a += bflo(o.x); b += bfhi(o.x); c += bflo(o.y); d += bfhi(o.y); }
            u32x2 w; w.x = pk2(a, b); w.y = pk2(c, d); *p = w; }
}
template <int NQ> struct TilePre { u32x4 a, b, c; };
template <int NQ, class SRC> DI void tile_fetch(TilePre<NQ>& p, const SRC& src, int T, int tid) {
    const bf16* k = src.k(T); const bf16* v = src.v(T);
    constexpr int NK = NQ * 64;
    p.a = *(const u32x4*)(k + (size_t)tid * 8);
    const int p1 = tid + 512; p.b = (p1 < NK) ? *(const u32x4*)(k + (size_t)p1 * 8) : *(const u32x4*)(v + (size_t)(p1 - NK) * 8);
    if (NQ * 64 + 512 > 1024) { const int p2 = tid + 1024; if (p2 < NK + 512) p.c = *(const u32x4*)(v + (size_t)(p2 - NK) * 8); }
}
template <int NQ> DI void tile_put(const TilePre<NQ>& p, LAS unsigned char* buf, int tid) {
    *(LAS u32x4*)(buf + tid * 16) = p.a; *(LAS u32x4*)(buf + (tid + 512) * 16) = p.b;
    if (NQ * 64 + 512 > 1024) { if (tid + 1024 < NQ * 64 + 512) *(LAS u32x4*)(buf + (tid + 1024) * 16) = p.c; }
}
template <int NQ, bool PV, class SRC, class MK>
DI void attn_run_sh(LAS unsigned char* tl, int tid, int lane, const bf16x8 (&qf)[NQ], f32x16 (&O)[4], float& m, float& l, int TB, int TE, int tb, int te, const SRC& src, const MK& mk) {
    constexpr int TBYTES = (NQ + 8) * 1024;
    if (TB >= TE) return;
    TilePre<NQ> pre;
    tile_fetch<NQ>(pre, src, TB, tid); tile_put<NQ>(pre, tl, tid);
    LDS_WAIT(); __builtin_amdgcn_s_barrier(); asm volatile("" ::: "memory");
#pragma unroll 1
    for (int T = TB; T < TE; ++T) {
        LAS unsigned char* cur = tl + ((T - TB) & 1) * TBYTES;
        if (T + 1 < TE) tile_fetch<NQ>(pre, src, T + 1, tid);
        if (T >= tb && T < te) {
            f32x16 S;
#pragma unroll
            for (int i = 0; i < 16; ++i) S[i] = 0.f;
#pragma unroll
            for (int s = 0; s < NQ; ++s) S = MFMA32(*(const LAS bf16x8*)(cur + s * 1024 + lane * 16), qf[s], S);
            if (mk.need(T)) mk(T, S);
            bf16x8 pf[2]; softmax_step<4, PV>(S, m, l, O, pf);
            if (PV) {
#pragma unroll
                for (int db = 0; db < 4; ++db)
#pragma unroll
                    for (int s = 0; s < 2; ++s) O[db] = MFMA32(*(const LAS bf16x8*)(cur + (NQ + db * 2 + s) * 1024 + lane * 16), pf[s], O[db]);
            }
        }
        if (T + 1 < TE) tile_put<NQ>(pre, tl + ((T + 1 - TB) & 1) * TBYTES, tid);
        LDS_WAIT(); __builtin_amdgcn_s_barrier(); asm volatile("" ::: "memory");
    }
}
struct FragSrc { const bf16* kb; const bf16* vb; int nq; DI const bf16* k(int T) const { return kb + (size_t)T * nq * 512; } DI const bf16* v(int T) const { return vb + (size_t)T * 8 * 512; } };
constexpr size_t FA_Q = 0, FA_K = 64 * MiB, FA_F = 128 * MiB, FA_V = 136 * MiB, FA_CUM = 200 * MiB, FA_O = 202 * MiB, FA_KF = 266 * MiB, FA_VF = 338 * MiB;
constexpr size_t FW_IN = 0, FW_OUT = (size_t)6400 * 2048;
constexpr float FOX_QSCALE = 0.08838834764831845f * LOG2E;
DI void ph_fox_cvt(const Frame& F, const float* w_in, const float* w_out) {
    bf16* WB = (bf16*)(F.ws + WS_WMIX);
    cvt_job(F, w_in, 6160, DM, 0, 2048, WB + FW_IN, DM, 0, FOX_QSCALE);
    cvt_job(F, w_in, 6160, DM, 2048, 2048, WB + FW_IN, DM, 2048, 1.f);
    cvt_job(F, w_in, 6160, DM, 4096, 2048, WB + FW_IN, DM, 4352, 1.f);
    cvt_job(F, w_in, 6160, DM, 6144, 16, WB + FW_IN, DM, 4096, 1.f);
    zero_bf16(F, WB + FW_IN + (size_t)4112 * DM, (size_t)240 * DM);
    cvt_job(F, w_out, DM, DM, 0, DM, WB + FW_OUT, DM, 0, 1.f);
}
DI void ph_fox_scan(const Frame& F, const float* b_f) {
    unsigned char* ar = F.ws + WS_AR; const bf16* FB = (const bf16*)(ar + FA_F); float* CUM = (float*)(ar + FA_CUM);
    for (int w = F.gw; w < BPH * 16; w += F.NGW) {
        const int bl = w >> 4, hd = w & 15; const float bf_ = b_f[hd];
        float v[64]; float run = 0.f;
#pragma unroll
        for (int i = 0; i < 64; ++i) { const float x = bf2f(FB[(size_t)(bl * SEQ + F.lane * 64 + i) * 256 + hd]) + bf_;
            const float ls = fminf(x, 0.f) - log1pf(expf(-fabsf(x))); run += ls; v[i] = run; }
        float inc = run;
#pragma unroll
        for (int o = 1; o < 64; o <<= 1) { const float y = __shfl_up(inc, o); if (F.lane >= o) inc += y; }
        const float base = inc - run;
        float* dst = CUM + (size_t)w * SEQ + F.lane * 64;
#pragma unroll
        for (int i = 0; i < 64; i += 4) *(f32x4*)(dst + i) = (f32x4){(v[i] + base) * LOG2E, (v[i + 1] + base) * LOG2E, (v[i + 2] + base) * LOG2E, (v[i + 3] + base) * LOG2E};
        bf16* KF9 = (bf16*)(ar + FA_KF) + (size_t)w * 128 * 9 * 512;
#pragma unroll
        for (int i = 0; i < 64; ++i) { const int p = F.lane * 64 + i, tile = p >> 5, r_ = p & 31; const float c = (v[i] + base) * LOG2E;
            const unsigned short hi = f2bf(c); const float c1 = c - bf2f(hi); const unsigned short mid = f2bf(c1); const unsigned short lo = f2bf(c1 - bf2f(mid));
            u32x4 wv; wv.x = 0x3F803F80u; wv.y = 0x3F80u | ((unsigned)(hi ^ 0x8000u) << 16); wv.z = (unsigned)(mid ^ 0x8000u) | ((unsigned)(lo ^ 0x8000u) << 16); wv.w = 0u;
            bf16* d = KF9 + ((size_t)(tile * 9 + 8) * 64 + r_) * 8;
            *(u32x4*)d = wv; *(u32x4*)(d + 32 * 8) = (u32x4){0u, 0u, 0u, 0u}; }
    }
}
struct FoxMK { int tq, h, qt; DI bool need(int t) const { return t == qt; }
    DI void operator()(int t, f32x16& S) const {
#pragma unroll
        for (int i = 0; i < 16; ++i) S[i] = (32 * t + crow(i, h) <= tq) ? S[i] : -INFINITY;
    } };
DI void ph_fox_attn(const Frame& F) {
    unsigned char* ar = F.ws + WS_AR; const bf16* Q = (const bf16*)(ar + FA_Q); const bf16* KF = (const bf16*)(ar + FA_KF); const bf16* VF = (const bf16*)(ar + FA_VF); const float* CUM = (const float*)(ar + FA_CUM); bf16* Ob = (bf16*)(ar + FA_O);
    const int r = F.lane & 31, h = F.lane >> 5;
    for (int wb = blockIdx.x; wb < BPH * 16 * 4; wb += F.G) {
        const int bh = wb >> 2, x = (wb & 3) * 8 + F.wave, bl = bh >> 4, hd = bh & 15;
#pragma unroll 1
        for (int k = 0; k < 4; ++k) {
            const int qt = (k == 0) ? x : (k == 1) ? 63 - x : (k == 2) ? 64 + x : 127 - x;
            const int qhi = (k == 0) ? (wb & 3) * 8 + 7 : (k == 1) ? 63 - (wb & 3) * 8 : (k == 2) ? 64 + (wb & 3) * 8 + 7 : 127 - (wb & 3) * 8;
            const int tq = qt * 32 + r; const size_t mrow = (size_t)bl * SEQ + tq;
            bf16x8 qf[9];
#pragma unroll
            for (int s = 0; s < 8; ++s) qf[s] = *(const bf16x8*)(Q + mrow * DM + hd * 128 + 16 * s + 8 * h);
            { const float ct = CUM[(size_t)bh * SEQ + tq]; const unsigned short hi = f2bf(ct); const float c1 = ct - bf2f(hi); const unsigned short mid = f2bf(c1); const unsigned short lo = f2bf(c1 - bf2f(mid));
              u32x4 wq; wq.x = (unsigned)hi | ((unsigned)mid << 16); wq.y = (unsigned)lo | (0x3F80u << 16); wq.z = 0x3F803F80u; wq.w = 0u;
              if (h) wq = (u32x4){0u, 0u, 0u, 0u};
              qf[8] = __builtin_bit_cast(bf16x8, wq); }
            f32x16 O[4];
#pragma unroll
            for (int db = 0; db < 4; ++db)
#pragma unroll
                for (int i = 0; i < 16; ++i) O[db][i] = 0.f;
            float m = -INFINITY, l = 0.f;
            const FragSrc src{KF + (size_t)bh * 128 * 9 * 512, VF + (size_t)bh * 128 * 8 * 512, 9}; const FoxMK mk{tq, h, qt};
            attn_run_sh<9, true>(F.lds, F.tid, F.lane, qf, O, m, l, 0, qhi + 1, 0, qt + 1, src, mk);
            l += __shfl_xor(l, 32);
            store_col<false>(Ob + mrow * DM + hd * 128, O, l > 0.f ? 1.0f / l : 0.f, h);
        }
    }
}
typedef long fp8x8_t;
DI fp8x8_t pack_fp8x8(float a0, float a1, float a2, float a3, float a4, float a5, float a6, float a7) {
    int lo = 0, hi = 0;
    lo = __builtin_amdgcn_cvt_pk_fp8_f32(a0, a1, lo, false); lo = __builtin_amdgcn_cvt_pk_fp8_f32(a2, a3, lo, true);
    hi = __builtin_amdgcn_cvt_pk_fp8_f32(a4, a5, hi, false); hi = __builtin_amdgcn_cvt_pk_fp8_f32(a6, a7, hi, true);
    return (fp8x8_t)(((unsigned long long)(unsigned)hi << 32) | (unsigned long long)(unsigned)lo);
}
#define MFMA32F8(a, b, c) __builtin_amdgcn_mfma_f32_32x32x16_fp8_fp8((a), (b), (c), 0, 0, 0)
constexpr size_t NA_Q = 0, NA_KC = 288 * MiB, NA_VC = 313 * MiB, NA_KSR = 330 * MiB, NA_KWR = 354 * MiB, NA_GT = 378 * MiB, NA_VSR = 386 * MiB, NA_VWR = 402 * MiB, NA_GK = 418 * MiB, NA_GV = 420 * MiB,
                 NA_KCMP = 422 * MiB, NA_VCT = 424 * MiB, NA_SELB = 426 * MiB, NA_O = 428 * MiB,
                 NA_KSF = 620 * MiB, NA_KWF = 644 * MiB, NA_VSF = 668 * MiB, NA_VWF = 684 * MiB;
constexpr size_t NW_IN = 0, NW_W1K = (size_t)13312 * 2048, NW_W1V = NW_W1K + (size_t)256 * 6144, NW_W2K = NW_W1V + (size_t)256 * 4096, NW_W2V = NW_W2K + 65536, NW_OUT = NW_W2V + 65536;
constexpr float NSA_QSCALE = 0.07216878364870322f * LOG2E;
DI void ph_nsa_cvt(const Frame& F, const float* w_in, const float* k_pe, const float* k_w1, const float* k_b1, const float* k_w2, const float* v_pe, const float* v_w1, const float* v_b1, const float* v_w2, const float* w_out) {
    bf16* WB = (bf16*)(F.ws + WS_WMIX); float* BIAS = (float*)(F.ws + WS_MISC);
    cvt_job(F, w_in, 13200, DM, 0, 9216, WB + NW_IN, DM, 0, NSA_QSCALE);
    cvt_job(F, w_in, 13200, DM, 9216, 768, WB + NW_IN, DM, 9216, 1.f);
    cvt_job(F, w_in, 13200, DM, 9984, 512, WB + NW_IN, DM, 9984, 1.f);
    cvt_job(F, w_in, 13200, DM, 10496, 768, WB + NW_IN, DM, 10496, 1.f);
    cvt_job(F, w_in, 13200, DM, 11776, 768, WB + NW_IN, DM, 11264, 1.f);
    cvt_job(F, w_in, 13200, DM, 13056, 144, WB + NW_IN, DM, 12032, 1.f);
    zero_bf16(F, WB + NW_IN + (size_t)12176 * DM, (size_t)112 * DM);
    cvt_job(F, w_in, 13200, DM, 11264, 512, WB + NW_IN, DM, 12288, 1.f);
    cvt_job(F, w_in, 13200, DM, 12544, 512, WB + NW_IN, DM, 12800, 1.f);
    cvt_job(F, k_w1, 256, 6144, 0, 256, WB + NW_W1K, 6144, 0, 1.f);
    cvt_job(F, v_w1, 256, 4096, 0, 256, WB + NW_W1V, 4096, 0, 1.f);
    cvt_job(F, k_w2, 192, 256, 0, 192, WB + NW_W2K, 256, 0, 1.f); zero_bf16(F, WB + NW_W2K + 192 * 256, 64 * 256);
    cvt_job(F, v_w2, 128, 256, 0, 128, WB + NW_W2V, 256, 0, 1.f); zero_bf16(F, WB + NW_W2V + 128 * 256, 128 * 256);
    cvt_job(F, w_out, DM, 6144, 0, DM, WB + NW_OUT, 6144, 0, 1.f);
    for (int w = F.gw; w < 512; w += F.NGW) { const bool isk = w < 256; const int c = w & 255, n = isk ? 6144 : 4096; const float* pe = isk ? k_pe : v_pe; const float* w1 = isk ? k_w1 : v_w1;
        float s = 0.f; for (int i = F.lane; i < n; i += 64) s += pe[i] * w1[(size_t)i * 256 + c];
        s = wave_sum(s); if (F.lane == 0) BIAS[w] = s + (isk ? k_b1[c] : v_b1[c]); }
}
DI void ph_nsa_rope(const Frame& F, int half) {
    unsigned char* ar = F.ws + WS_AR; bf16* Q = (bf16*)(ar + NA_Q); bf16* KC = (bf16*)(ar + NA_KC);
    const bf16* KSR = (const bf16*)(ar + NA_KSR); const bf16* KWR = (const bf16*)(ar + NA_KWR); bf16* KSF = (bf16*)(ar + NA_KSF); bf16* KWF = (bf16*)(ar + NA_KWF);
    const float* c48 = (const float*)(F.ws + TAB_COS48); const float* s48 = (const float*)(F.ws + TAB_SIN48);
    for (int ml = F.gw; ml < MC; ml += F.NGW) {
        const size_t mg = (size_t)half * MC + ml; const int bl = ml >> 12, sq = ml & 4095;
        for (int p = F.lane; p < 96; p += 64) {
            const int hd = 48 + p / 24, i = p - (p / 24) * 24; bf16* q;
            q = KC + ((size_t)(bl * 4 + hd - 48) * 4096 + sq) * 192 + i;
            const float x1 = bf2f(q[0]), x2 = bf2f(q[24]), c = c48[mg * 24 + i], s = s48[mg * 24 + i]; q[0] = f2bf(x1 * c - x2 * s); q[24] = f2bf(x1 * s + x2 * c);
        }
        const int tile = sq >> 5, rr = sq & 31;
        for (int u = F.lane; u < 168; u += 64) {
            const int tens = u / 84, uu = u - tens * 84, g = uu / 21, v = uu - g * 21;
            const bf16* src = (tens ? KWR : KSR) + (size_t)ml * 768 + g * 192;
            bf16* dst = (tens ? KWF : KSF) + ((size_t)((bl * 4 + g) * 128 + tile) * 12 * 64 + rr) * 8;
            if (v < 3) {
                const u32x4 a = *(const u32x4*)(src + 8 * v), b = *(const u32x4*)(src + 8 * v + 24); u32x4 o1, o2;
#pragma unroll
                for (int e = 0; e < 4; ++e) { const float c0 = c48[mg * 24 + 8 * v + 2 * e], s0 = s48[mg * 24 + 8 * v + 2 * e], c1 = c48[mg * 24 + 8 * v + 2 * e + 1], s1 = s48[mg * 24 + 8 * v + 2 * e + 1];
                    const float x1l = bflo(a[e]), x1h = bfhi(a[e]), x2l = bflo(b[e]), x2h = bfhi(b[e]);
                    o1[e] = pk2(x1l * c0 - x2l * s0, x1h * c1 - x2h * s1); o2[e] = pk2(x1l * s0 + x2l * c0, x1h * s1 + x2h * c1); }
                const int p1 = v, p2 = v + 3;
                if (tens) { *(u32x4*)(dst + ((p1 >> 1) * 64 + (p1 & 1) * 32) * 8) = o1; *(u32x4*)(dst + ((p2 >> 1) * 64 + (p2 & 1) * 32) * 8) = o2; }
                else { unsigned char* d8 = (unsigned char*)KSF + ((size_t)(((bl * 4 + g) * 128 + tile) * 2 + (rr >> 4)) * 6 * 64 + (rr & 15)) * 8;
                    *(fp8x8_t*)(d8 + ((p1 >> 2) * 64 + (p1 & 3) * 16) * 8) = pack_fp8x8(bflo(o1[0]), bfhi(o1[0]), bflo(o1[1]), bfhi(o1[1]), bflo(o1[2]), bfhi(o1[2]), bflo(o1[3]), bfhi(o1[3]));
                    *(fp8x8_t*)(d8 + ((p2 >> 2) * 64 + (p2 & 3) * 16) * 8) = pack_fp8x8(bflo(o2[0]), bfhi(o2[0]), bflo(o2[1]), bfhi(o2[1]), bflo(o2[2]), bfhi(o2[2]), bflo(o2[3]), bfhi(o2[3])); }
            } else { const int pc = v + 3; const u32x4 c = *(const u32x4*)(src + 8 * pc);
                if (tens) *(u32x4*)(dst + ((pc >> 1) * 64 + (pc & 1) * 32) * 8) = c;
                else { unsigned char* d8 = (unsigned char*)KSF + ((size_t)(((bl * 4 + g) * 128 + tile) * 2 + (rr >> 4)) * 6 * 64 + (rr & 15)) * 8;
                    *(fp8x8_t*)(d8 + ((pc >> 2) * 64 + (pc & 3) * 16) * 8) = pack_fp8x8(bflo(c[0]), bfhi(c[0]), bflo(c[1]), bfhi(c[1]), bflo(c[2]), bfhi(c[2]), bflo(c[3]), bfhi(c[3])); } }
        }
    }
}
DI float sigmoidf_(float x) { return __builtin_amdgcn_rcpf(1.0f + __builtin_amdgcn_exp2f(-x * LOG2E)); }
struct CmpMK { int tq, h, q0; DI bool need(int t) const { return 512 * t + 527 > q0; }
    DI void operator()(int t, f32x16& S) const {
#pragma unroll
    for (int i = 0; i < 16; ++i) { const int n = 32 * t + crow(i, h); S[i] = (16 * n + 31 <= tq) ? S[i] : -INFINITY; } } };
struct WinMK { int tq, h, qt; DI bool need(int t) const { return t == qt || t == qt - 16; }
    DI void operator()(int t, f32x16& S) const {
#pragma unroll
    for (int i = 0; i < 16; ++i) { const int k = 32 * t + crow(i, h); S[i] = (k <= tq && k > tq - 512) ? S[i] : -INFINITY; } } };
DI void ph_nsa_cmp(const Frame& F, const int half) {
    const float* c48 = (const float*)(F.ws + TAB_COS48); const float* s48 = (const float*)(F.ws + TAB_SIN48);
    unsigned char* ar = F.ws + WS_AR; const bf16* Q = (const bf16*)(ar + NA_Q); const bf16* KCMP = (const bf16*)(ar + NA_KCMP); const bf16* VCT = (const bf16*)(ar + NA_VCT); const bf16* GT = (const bf16*)(ar + NA_GT);
    unsigned char* SELB = ar + NA_SELB; bf16* Ob = (bf16*)(ar + NA_O);
    LAS float* imp = (LAS float*)F.lds;
    LAS unsigned char* kres = F.lds + 20480;
    LAS unsigned char* vring = F.lds + 20480 + 98304;
    const int lane = F.lane, r = lane & 31, h = lane >> 5, tid = F.tid;
    for (int u = blockIdx.x; u < BPH * 4 * 64; u += F.G) {
        const int bg = u >> 6, qt64 = ((u >> 8) & 1) ? 63 - (u & 63) : (u & 63), bl = bg >> 2, g = bg & 3;
        const int tqmaxb = qt64 * 64 + 63, TE = (tqmaxb >= 31) ? ((tqmaxb - 31) / 16) / 32 + 1 : 0;
        const bf16* ksrc = KCMP + (size_t)bg * 8 * 12 * 512; const bf16* vsrc = VCT + (size_t)bg * 8 * 8 * 512;
        for (int i = F.tid; i < 64 * 65; i += NWAVES * 64) imp[i] = 0.f;
        for (int p = tid; p < TE * 768; p += NWAVES * 64) *(LAS u32x4*)(kres + p * 16) = *(const u32x4*)(ksrc + (size_t)p * 8);
        __syncthreads();
#pragma unroll 1
        for (int k = 0; k < 3; ++k) {
            const int idx = F.wave * 3 + k, j = idx >> 1, sub = idx & 1, ql = sub * 32 + r, tq = qt64 * 64 + ql, hd = g * 12 + j;
            const size_t mrow = (size_t)bl * SEQ + tq;
            bf16x8 qf[12];
#pragma unroll
            for (int s = 3; s < 12; ++s) qf[s] = *(const bf16x8*)(Q + mrow * 9216 + hd * 192 + 16 * s + 8 * h);
            { const float* cs = c48 + ((size_t)half * MC + mrow) * 24; const float* sn = s48 + ((size_t)half * MC + mrow) * 24;
#pragma unroll
              for (int s = 0; s < 3; ++s) qf[s] = rope_frag32(Q + mrow * 9216 + hd * 192, s, h, cs, sn); }
            const int tqmax = qt64 * 64 + sub * 32 + 31, te = (tqmax >= 31) ? ((tqmax - 31) / 16) / 32 + 1 : 0;
            const CmpMK mk{tq, h, qt64 * 64 + sub * 32};
            float m = -INFINITY, l = 0.f;
            {
                f32x16 Od[4];
#pragma unroll 1
                for (int t = 0; t < te; ++t) {
                    const LAS unsigned char* cur = kres + t * 12288;
                    f32x16 S;
#pragma unroll
                    for (int i = 0; i < 16; ++i) S[i] = 0.f;
#pragma unroll
                    for (int s = 0; s < 12; ++s) S = MFMA32(*(const LAS bf16x8*)(cur + s * 1024 + lane * 16), qf[s], S);
                    if (mk.need(t)) mk(t, S);
                    bf16x8 pfd[2]; softmax_step<4, false>(S, m, l, Od, pfd);
                }
            }
            l += __shfl_xor(l, 32);
            const float linv = l > 0.f ? 1.0f / l : 0.f, ms = (m == -INFINITY) ? 0.f : m;
            f32x16 O[4];
#pragma unroll
            for (int db = 0; db < 4; ++db)
#pragma unroll
                for (int i = 0; i < 16; ++i) O[db][i] = 0.f;
            if (TE > 0) {
                u32x4 pv = *(const u32x4*)(vsrc + (size_t)tid * 8);
                *(LAS u32x4*)(vring + tid * 16) = pv;
                LDS_WAIT(); __builtin_amdgcn_s_barrier(); asm volatile("" ::: "memory");
#pragma unroll 1
                for (int t = 0; t < TE; ++t) {
                    const LAS unsigned char* cur = kres + t * 12288; const LAS unsigned char* vcur = vring + (t & 1) * 8192;
                    if (t + 1 < TE) pv = *(const u32x4*)(vsrc + ((size_t)(t + 1) * 512 + tid) * 8);
                    if (t < te) {
                        f32x16 S;
#pragma unroll
                        for (int i = 0; i < 16; ++i) S[i] = 0.f;
#pragma unroll
                        for (int s = 0; s < 12; ++s) S = MFMA32(*(const LAS bf16x8*)(cur + s * 1024 + lane * 16), qf[s], S);
                        if (mk.need(t)) mk(t, S);
#pragma unroll
                        for (int i = 0; i < 16; ++i) S[i] = __builtin_amdgcn_exp2f(S[i] - ms) * linv;
#pragma unroll
                        for (int g4 = 0; g4 < 4; ++g4) { const float gs = (S[4 * g4] + S[4 * g4 + 1]) + (S[4 * g4 + 2] + S[4 * g4 + 3]); const int mb = 8 * t + 2 * g4 + h;
                            __hip_atomic_fetch_add(imp + ql * 65 + mb, gs, __ATOMIC_RELAXED, __HIP_MEMORY_SCOPE_WORKGROUP);
                            if (mb + 1 < 64) __hip_atomic_fetch_add(imp + ql * 65 + mb + 1, S[4 * g4 + 3], __ATOMIC_RELAXED, __HIP_MEMORY_SCOPE_WORKGROUP); }
                        bf16x8 pf[2];
#pragma unroll
                        for (int s = 0; s < 2; ++s) { u32x4 w; w.x = pk2(S[8 * s], S[8 * s + 1]); w.y = pk2(S[8 * s + 2], S[8 * s + 3]); w.z = pk2(S[8 * s + 4], S[8 * s + 5]); w.w = pk2(S[8 * s + 6], S[8 * s + 7]); pf[s] = __builtin_bit_cast(bf16x8, w); }
#pragma unroll
                        for (int db = 0; db < 4; ++db)
#pragma unroll
                            for (int s = 0; s < 2; ++s) O[db] = MFMA32(*(const LAS bf16x8*)(vcur + (db * 2 + s) * 1024 + lane * 16), pf[s], O[db]);
                    }
                    if (t + 1 < TE) *(LAS u32x4*)(vring + ((t + 1) & 1) * 8192 + tid * 16) = pv;
                    LDS_WAIT(); __builtin_amdgcn_s_barrier(); asm volatile("" ::: "memory");
                }
            }
            const float gate = sigmoidf_(bf2f(GT[mrow * 256 + hd]));
            store_col<false>(Ob + mrow * 6144 + hd * 128, O, gate, h);
        }
        __syncthreads();
#pragma unroll 1
        for (int k = 0; k < 8; ++k) {
            const int ql = F.wave * 8 + k, tq = qt64 * 64 + ql, cur = tq >> 6, mb = lane;
            const bool causal = mb <= cur, forced = (mb == 0) || (mb == cur) || (mb == cur - 1);
            const float v = causal ? (forced ? INFINITY : imp[ql * 65 + mb]) : -INFINITY;
            int rank = 0;
            for (int o = 0; o < 64; ++o) { const float vo = __shfl(v, o); rank += (vo > v || (vo == v && o < mb)) ? 1 : 0; }
            if (rank < 16) SELB[((size_t)bg * 4096 + tq) * 16 + rank] = causal ? (unsigned char)mb : (unsigned char)0xFF;
        }
        __syncthreads();
    }
}
DI int sel_tile(const u32x4& sel, int t) { const int b = t >> 1; const unsigned w = (b < 4) ? sel.x : (b < 8) ? sel.y : (b < 12) ? sel.z : sel.w; return (int)((w >> ((b & 3) * 8)) & 0xFFu) * 2 + (t & 1); }
struct SelMK { u32x4 sel; int tq, h; DI void operator()(int t, f32x16& S) const { const int k0 = sel_tile(sel, t) * 32;
#pragma unroll
    for (int i = 0; i < 16; ++i) S[i] = (k0 + crow(i, h) <= tq) ? S[i] : -INFINITY; } };
typedef float f32x4_ __attribute__((ext_vector_type(4)));
#define MFMA16F8(a, b, c) __builtin_amdgcn_mfma_f32_16x16x32_fp8_fp8((a), (b), (c), 0, 0, 0)
DI void ph_nsa_sel(const Frame& F, const int half) {
    const float* c48 = (const float*)(F.ws + TAB_COS48); const float* s48 = (const float*)(F.ws + TAB_SIN48);
    unsigned char* ar = F.ws + WS_AR; const bf16* Q = (const bf16*)(ar + NA_Q); const unsigned char* KS8 = ar + NA_KSF; const unsigned char* VS8 = ar + NA_VSF; const bf16* GT = (const bf16*)(ar + NA_GT);
    const unsigned char* SELB = ar + NA_SELB; bf16* Ob = (bf16*)(ar + NA_O);
    const int c16 = F.lane & 15, kq = F.lane >> 4; const bool act = c16 < 12;
    for (int it = F.gw; it < BPH * 4 * SEQ; it += F.NGW) {
        const int bg = it >> 12, tq = ((it & 4095) + 256 * bg) & 4095, bl = bg >> 2, g = bg & 3; const size_t mrow = (size_t)bl * SEQ + tq; const int hd = g * 12 + (act ? c16 : 0);
        fp8x8_t qf[6];
#pragma unroll
        for (int s = 0; s < 6; ++s) { const float qs = act ? (1.0f / NSA_QSCALE) : 0.f; const int p = 4 * s + kq;
            if (s < 2 && p < 6) { float o[8]; rope_piece(Q + mrow * 9216 + hd * 192, p, c48 + ((size_t)half * MC + mrow) * 24, s48 + ((size_t)half * MC + mrow) * 24, o);
                qf[s] = pack_fp8x8(o[0] * qs, o[1] * qs, o[2] * qs, o[3] * qs, o[4] * qs, o[5] * qs, o[6] * qs, o[7] * qs); }
            else { const u32x4 q = *(const u32x4*)(Q + mrow * 9216 + hd * 192 + 32 * s + 8 * kq);
                qf[s] = pack_fp8x8(bflo(q[0]) * qs, bfhi(q[0]) * qs, bflo(q[1]) * qs, bfhi(q[1]) * qs, bflo(q[2]) * qs, bfhi(q[2]) * qs, bflo(q[3]) * qs, bfhi(q[3]) * qs); } }
        const u32x4 sel = *(const u32x4*)(SELB + ((size_t)bg * 4096 + tq) * 16);
        const int nv = ((tq >> 6) + 1 < 16) ? (tq >> 6) + 1 : 16, te = 2 * nv;
        const unsigned char* kb = KS8 + ((size_t)bg * 128 * 12 * 64 + F.lane) * 8; const unsigned char* vb = VS8 + ((size_t)bg * 128 * 8 * 64 + F.lane) * 8;
        f32x4_ O[8];
#pragma unroll
        for (int db = 0; db < 8; ++db) O[db] = (f32x4_){0.f, 0.f, 0.f, 0.f};
        float m = -INFINITY, l = 0.f;
        fp8x8_t kfA[12], kfB[12], vfA[8], vfB[8];
        { const unsigned char* kp = kb + (size_t)sel_tile(sel, 0) * 12 * 512; const unsigned char* kp1 = kb + (size_t)sel_tile(sel, 1) * 12 * 512; const unsigned char* vp = vb + (size_t)sel_tile(sel, 0) * 8 * 512;
#pragma unroll
          for (int s = 0; s < 12; ++s) { kfA[s] = *(const fp8x8_t*)(kp + s * 512); kfB[s] = *(const fp8x8_t*)(kp1 + s * 512); }
#pragma unroll
          for (int j = 0; j < 8; ++j) vfA[j] = *(const fp8x8_t*)(vp + j * 512); }
#define SEL_STEP(T_, KF_, VF_, VFN_) do { const int t_ = (T_); const int tile = sel_tile(sel, t_); \
            if (t_ + 1 < te) { const unsigned char* vp = vb + (size_t)sel_tile(sel, t_ + 1) * 8 * 512; _Pragma("unroll") for (int j = 0; j < 8; ++j) VFN_[j] = *(const fp8x8_t*)(vp + j * 512); } \
            f32x4_ S0 = {0.f, 0.f, 0.f, 0.f}, S1 = S0; \
            _Pragma("unroll") for (int s = 0; s < 6; ++s) { S0 = MFMA16F8(KF_[s], qf[s], S0); S1 = MFMA16F8(KF_[6 + s], qf[s], S1); } \
            if (t_ + 2 < te) { const unsigned char* kp = kb + (size_t)sel_tile(sel, t_ + 2) * 12 * 512; _Pragma("unroll") for (int s = 0; s < 12; ++s) KF_[s] = *(const fp8x8_t*)(kp + s * 512); } \
            const int k0 = tile * 32 + 4 * kq; float mx = -INFINITY; \
            _Pragma("unroll") for (int i = 0; i < 4; ++i) { S0[i] = (k0 + i <= tq) ? S0[i] * NSA_QSCALE : -INFINITY; S1[i] = (k0 + 16 + i <= tq) ? S1[i] * NSA_QSCALE : -INFINITY; mx = fmaxf(mx, fmaxf(S0[i], S1[i])); } \
            mx = fmaxf(mx, __shfl_xor(mx, 16)); mx = fmaxf(mx, __shfl_xor(mx, 32)); \
            const float mn = fmaxf(m, mx), ms = (mn == -INFINITY) ? 0.f : mn, alpha = __builtin_amdgcn_exp2f(m - ms); \
            float sum = 0.f; \
            _Pragma("unroll") for (int i = 0; i < 4; ++i) { S0[i] = __builtin_amdgcn_exp2f(S0[i] - ms); S1[i] = __builtin_amdgcn_exp2f(S1[i] - ms); sum += S0[i] + S1[i]; } \
            l = l * alpha + sum; m = mn; \
            if (__builtin_amdgcn_ballot_w64(alpha != 1.0f) != 0ull) { _Pragma("unroll") for (int db = 0; db < 8; ++db) O[db] = O[db] * alpha; } \
            const fp8x8_t p8 = pack_fp8x8(S0[0], S0[1], S0[2], S0[3], S1[0], S1[1], S1[2], S1[3]);       \
            _Pragma("unroll") for (int db = 0; db < 8; ++db) O[db] = MFMA16F8(VF_[db], p8, O[db]); } while (0)
#pragma unroll 1
        for (int t = 0; t < te; t += 2) { SEL_STEP(t, kfA, vfA, vfB); SEL_STEP(t + 1, kfB, vfB, vfA); }
#undef SEL_STEP
        l += __shfl_xor(l, 16); l += __shfl_xor(l, 32);
        if (act) { const float gate = sigmoidf_(bf2f(GT[mrow * 256 + 48 + hd])); const float sc = l > 0.f ? gate / l : 0.f;
            bf16* o = Ob + mrow * 6144 + hd * 128 + 4 * kq;
#pragma unroll
            for (int db = 0; db < 8; ++db) { u32x2* p = (u32x2*)(o + db * 16); const u32x2 prev = *p;
                u32x2 w; w.x = pk2(O[db][0] * sc + bflo(prev.x), O[db][1] * sc + bfhi(prev.x)); w.y = pk2(O[db][2] * sc + bflo(prev.y), O[db][3] * sc + bfhi(prev.y)); *p = w; } }
    }
}
DI void ph_nsa_win(const Frame& F, const int half) {
    const float* c48 = (const float*)(F.ws + TAB_COS48); const float* s48 = (const float*)(F.ws + TAB_SIN48);
    unsigned char* ar = F.ws + WS_AR; const bf16* Q = (const bf16*)(ar + NA_Q); const bf16* KWF = (const bf16*)(ar + NA_KWF); const bf16* VWF = (const bf16*)(ar + NA_VWF); const bf16* GT = (const bf16*)(ar + NA_GT); bf16* Ob = (bf16*)(ar + NA_O);
    const int r = F.lane & 31, h = F.lane >> 5;
    for (int idb = blockIdx.x; idb < BPH * 4 * 3 * 64; idb += F.G) {
        const int qt0 = (((idb & 63) + (idb >> 8)) & 63) * 2, qt = qt0 + (F.wave & 1), rest = idb >> 6, hq = rest % 3, bg = rest / 3, bl = bg >> 2, g = bg & 3, hd = g * 12 + hq * 4 + (F.wave >> 1), tq = qt * 32 + r; const size_t mrow = (size_t)bl * SEQ + tq;
        bf16x8 qf[12];
#pragma unroll
        for (int s = 3; s < 12; ++s) qf[s] = *(const bf16x8*)(Q + mrow * 9216 + hd * 192 + 16 * s + 8 * h);
        { const float* cs = c48 + ((size_t)half * MC + mrow) * 24; const float* sn = s48 + ((size_t)half * MC + mrow) * 24;
#pragma unroll
          for (int s = 0; s < 3; ++s) qf[s] = rope_frag32(Q + mrow * 9216 + hd * 192, s, h, cs, sn); }
        const FragSrc src{KWF + (size_t)bg * 128 * 12 * 512, VWF + (size_t)bg * 128 * 8 * 512, 12}; const WinMK mk{tq, h, qt};
        f32x16 O[4];
#pragma unroll
        for (int db = 0; db < 4; ++db)
#pragma unroll
            for (int i = 0; i < 16; ++i) O[db][i] = 0.f;
        float m = -INFINITY, l = 0.f;
        attn_run_sh<12, true>(F.lds, F.tid, F.lane, qf, O, m, l, qt0 >= 16 ? qt0 - 16 : 0, qt0 + 2, qt >= 16 ? qt - 16 : 0, qt + 1, src, mk);
        l += __shfl_xor(l, 32);
        const float gate = sigmoidf_(bf2f(GT[mrow * 256 + 96 + hd]));
        store_col<true>(Ob + mrow * 6144 + hd * 128, O, l > 0.f ? gate / l : 0.f, h);
    }
}
#ifndef MK_ONE_LAUNCH
#define MK_ONE_LAUNCH 1
#endif
constexpr int NPH = 69;
struct Args { const float* in[58]; float* out; unsigned char* ws; int ph_lo, ph_hi; };
#define GEMM_AKOFF 0
#define GEMM_CALL(EpiT, Evar, Aptr, Bptr, Mv, Nv, Kv, ldav, ldbv, cidx) do { const pg8::Gemm g_{(const pg8::bf16_t*)(Aptr), (const pg8::bf16_t*)(Bptr), (Mv), (Nv), (Kv), (ldav), (ldbv), GEMM_AKOFF}; \
    pg8::StaticOrder S_; S_.init((Mv), (Nv), F.G, (cidx)); pg8::gemm_phase<EpiT, pg8::StaticOrder, true, true>((PG8_LAS unsigned char*)F.lds, g_, S_, Evar); } while (0)
DI pg8::EpiBf16R epi1(bf16* base, int ldc) { pg8::EpiBf16R e; for (int s = 0; s < 8; ++s) { e.T.base[s] = base; e.T.ldc[s] = ldc; e.T.t0[s] = 0; e.T.gw[s] = 0; } e.T.nseg = 1; e.T.pad_ = 0; e.ssp = nullptr; e.ss_off = 0; return e; }
#define PH_BEGIN if (ph >= lo && ph < hi) { Frame F; { unsigned long long w_ = (unsigned long long)args.ws; asm volatile("" : "+s"(w_)); F.ws = (unsigned char*)w_; F.ctl = (unsigned*)(F.ws + WS_CTL); } \
    F.lds = lds; F.tid = threadIdx.x; F.lane = F.tid & 63; F.wave = __builtin_amdgcn_readfirstlane(F.tid >> 6); F.G = gridDim.x; F.gw = blockIdx.x * NWAVES + F.wave; F.NGW = F.G * NWAVES; \
    float* out; { unsigned long long o_ = (unsigned long long)args.out; asm volatile("" : "+s"(o_)); out = (float*)o_; } \
    unsigned char* const ar = F.ws + WS_AR; bf16* const XN = (bf16*)(F.ws + WS_XNR); float* const SSB = (float*)(F.ws + WS_SS); bf16* const WB = (bf16*)(F.ws + WS_WMIX); bf16* const WUP = (bf16*)(F.ws + WS_WFFN); bf16* const WDN = WUP + (size_t)2 * DFF * DM; \
    const float* const res_mix = (ib == 2) ? args.in[0] : (const float*)out; (void)ar; (void)XN; (void)SSB; (void)WB; (void)WUP; (void)WDN; (void)res_mix; (void)iff;
#define PH_END   if (ph + 1 < hi) { XcdBarrier b_; b_.bar = (unsigned*)F.ctl + CW_BAR; b_.x = xb_xcc_id(); b_.st = MISC + 8; xcd_barrier(b_); } } ++ph;
template <int LAYER> DI void run_cvt(const Args& args, LAS unsigned char* lds, volatile LAS unsigned* MISC, int& ph, const int lo, const int hi) {
    constexpr int ib = (LAYER == 0) ? 2 : (LAYER == 1) ? 17 : (LAYER == 2) ? 26 : 42;
    constexpr int iff = (LAYER == 0) ? 12 : (LAYER == 1) ? 21 : (LAYER == 2) ? 37 : 52;
    constexpr int kind = (LAYER == 1) ? 1 : (LAYER == 2) ? 2 : 0;
        PH_BEGIN
            if constexpr (LAYER == 0) { ph_tables(F, (const int*)args.in[1]); ph_norm_first(F, args.in[0], args.in[2], XN, SSB); }
            if constexpr (kind == 0) ph_dsa_cvt(F, args.in[ib + 1], args.in[ib + 6], args.in[ib + 7], args.in[ib + 8], args.in[ib + 9]);
            else if constexpr (kind == 1) ph_fox_cvt(F, args.in[ib + 1], args.in[ib + 3]);
            else ph_nsa_cvt(F, args.in[ib + 1], args.in[ib + 2], args.in[ib + 3], args.in[ib + 4], args.in[ib + 5], args.in[ib + 6], args.in[ib + 7], args.in[ib + 8], args.in[ib + 9], args.in[ib + 10]);
            ph_cvt_ffn(F, args.in[iff + 1], args.in[iff + 4]);
        PH_END
}
template <int LAYER, int HALF> DI void run_half(const Args& args, LAS unsigned char* lds, volatile LAS unsigned* MISC, int& ph, const int lo, const int hi) {
    constexpr int ib = (LAYER == 0) ? 2 : (LAYER == 1) ? 17 : (LAYER == 2) ? 26 : 42;
    constexpr int iff = (LAYER == 0) ? 12 : (LAYER == 1) ? 21 : (LAYER == 2) ? 37 : 52;
    constexpr int kind = (LAYER == 1) ? 1 : (LAYER == 2) ? 2 : 0;
    constexpr int half = HALF;
            const int roff = half * MC;
            if constexpr (kind == 0) {
                PH_BEGIN { pg8::EpiF32 E{(float*)(ar + DA_DIN), 1024, SSB + (size_t)(LAYER * 2) * MTOT * 8, roff}; GEMM_CALL(pg8::EpiF32, E, XN + (size_t)roff * DM, WB + DW_W1, MC, 1024, DM, DM, DM, (int)blockIdx.x); } PH_END
                PH_BEGIN ph_dsa_post1(F, half, args.in[ib + 2], args.in[ib + 3], args.in[ib + 4], args.in[ib + 5]); PH_END
                PH_BEGIN { pg8::EpiBf16R E = epi1((bf16*)(ar + DA_QL), 8192); E.T.base[1] = (bf16*)(ar + DA_QPE); E.T.ldc[1] = 1536; E.T.t0[1] = 32; E.T.base[2] = (bf16*)(ar + DA_QIDX); E.T.ldc[2] = 2048; E.T.t0[2] = 38; E.T.nseg = 3;
                    GEMM_CALL(pg8::EpiBf16R, E, ar + DA_CQN, WB + DW_W2, MC, 11776, 512, 512, 512, (int)blockIdx.x); } PH_END
                PH_BEGIN ph_dsa_index(F, half); PH_END
                PH_BEGIN ph_dsa_attn(F, half); PH_END
                PH_BEGIN {
                    pg8::EpiBf16R E = epi1((bf16*)(ar + DA_O2), 4096);
                    { const pg8::Gemm g_{(const pg8::bf16_t*)(ar + DA_QL), (const pg8::bf16_t*)(WB + DW_BD), MC, 4096, 512, 8192, 512, 512}; pg8::StaticOrder S_; S_.init(MC, 4096, F.G, (int)blockIdx.x);
                      pg8::gemm_phase<pg8::EpiBf16R, pg8::StaticOrder, true, true>((PG8_LAS unsigned char*)F.lds, g_, S_, E); } } PH_END
                PH_BEGIN { pg8::EpiResN E{LAYER == 0 ? args.in[0] : nullptr, args.in[ib], nullptr, DM, roff, args.in[iff], (pg8::bf16_t*)XN, SSB + (size_t)(LAYER * 2 + 1) * MTOT * 8, (PG8_LAS float*)(F.lds + LDSCTL_OFF + 256)}; GEMM_CALL(pg8::EpiResN, E, ar + DA_O2, WB + DW_WO, MC, DM, 4096, 4096, 4096, (int)blockIdx.x); } PH_END
            } else if constexpr (kind == 1) {
                PH_BEGIN {
                    { pg8::EpiBf16R E = epi1((bf16*)(ar + FA_Q), DM); E.T.base[1] = (bf16*)(ar + FA_KF); E.T.ldc[1] = 9; E.T.t0[1] = 8; E.T.gw[1] = -3;
                      E.T.base[2] = (bf16*)(ar + FA_F); E.T.ldc[2] = 256; E.T.t0[2] = 16; E.T.nseg = 3; E.ssp = SSB + (size_t)(LAYER * 2) * MTOT * 8; E.ss_off = roff;
                      GEMM_CALL(pg8::EpiBf16R, E, XN + (size_t)roff * DM, WB + FW_IN, MC, 4352, DM, DM, DM, (int)blockIdx.x); }
                    { pg8::EpiBf16R E = epi1((bf16*)(ar + FA_VF), 16); E.T.gw[0] = -4; E.ssp = SSB + (size_t)(LAYER * 2) * MTOT * 8; E.ss_off = roff;
                      GEMM_CALL(pg8::EpiBf16R, E, WB + FW_IN + (size_t)4352 * DM, XN + (size_t)roff * DM, DM, MC, DM, DM, DM, (int)((blockIdx.x + F.G - 64) % F.G)); }
                } PH_END
                PH_BEGIN ph_fox_scan(F, args.in[ib + 2]); PH_END
                PH_BEGIN ph_fox_attn(F); PH_END
                PH_BEGIN { pg8::EpiResN E{LAYER == 0 ? args.in[0] : nullptr, args.in[ib], nullptr, DM, roff, args.in[iff], (pg8::bf16_t*)XN, SSB + (size_t)(LAYER * 2 + 1) * MTOT * 8, (PG8_LAS float*)(F.lds + LDSCTL_OFF + 256)}; GEMM_CALL(pg8::EpiResN, E, ar + FA_O, WB + FW_OUT, MC, DM, DM, DM, DM, (int)blockIdx.x); } PH_END
            } else {
                PH_BEGIN { pg8::EpiBf16R E = epi1((bf16*)(ar + NA_Q), 9216);
                    E.T.base[1] = (bf16*)(ar + NA_KC); E.T.ldc[1] = 192; E.T.t0[1] = 36; E.T.gw[1] = 192;
                    E.T.base[2] = (bf16*)(ar + NA_VC); E.T.ldc[2] = 128; E.T.t0[2] = 39; E.T.gw[2] = 128;
                    E.T.base[3] = (bf16*)(ar + NA_KSR); E.T.ldc[3] = 768; E.T.t0[3] = 41;
                    E.T.base[4] = (bf16*)(ar + NA_KWR); E.T.ldc[4] = 768; E.T.t0[4] = 44;
                    E.T.base[5] = (bf16*)(ar + NA_GT); E.T.ldc[5] = 256; E.T.t0[5] = 47; E.T.nseg = 6; E.ssp = SSB + (size_t)(LAYER * 2) * MTOT * 8; E.ss_off = roff;
                    GEMM_CALL(pg8::EpiBf16R, E, XN + (size_t)roff * DM, WB + NW_IN, MC, 12288, DM, DM, DM, (int)blockIdx.x);
                    { pg8::EpiBf16R E2 = epi1((bf16*)(ar + NA_VSF), 4); E2.T.gw[0] = -5; E2.ssp = E.ssp; E2.ss_off = roff;
                      GEMM_CALL(pg8::EpiBf16R, E2, WB + NW_IN + (size_t)12288 * DM, XN + (size_t)roff * DM, 512, MC, DM, DM, DM, (int)blockIdx.x); }
                    { pg8::EpiBf16R E2 = epi1((bf16*)(ar + NA_VWF), 4); E2.T.gw[0] = -4; E2.ssp = E.ssp; E2.ss_off = roff;
                      GEMM_CALL(pg8::EpiBf16R, E2, WB + NW_IN + (size_t)12800 * DM, XN + (size_t)roff * DM, 512, MC, DM, DM, DM, (int)((blockIdx.x + F.G - 128) % F.G)); } } PH_END
                PH_BEGIN ph_nsa_rope(F, half); PH_END
                PH_BEGIN {
                    const float* BIAS = (const float*)(args.ws + WS_MISC);
                    { pg8::EpiGelu E{(bf16*)(ar + NA_GK), 256, BIAS}; GEMM_CALL(pg8::EpiGelu, E, ar + NA_KC, WB + NW_W1K, 4096, 256, 6144, 3072, 6144, (int)blockIdx.x); }
                    { pg8::EpiGelu E{(bf16*)(ar + NA_GV), 256, BIAS + 256}; GEMM_CALL(pg8::EpiGelu, E, ar + NA_VC, WB + NW_W1V, 4096, 256, 4096, 2048, 4096, (int)((blockIdx.x + F.G - 16) % F.G)); }
                } PH_END
                PH_BEGIN {
                    { pg8::EpiBf16R E = epi1((bf16*)(ar + NA_KCMP), 12); E.T.gw[0] = -1; GEMM_CALL(pg8::EpiBf16R, E, ar + NA_GK, WB + NW_W2K, 4096, 256, 256, 256, 256, (int)blockIdx.x); }
                    { pg8::EpiBf16R E = epi1((bf16*)(ar + NA_VCT), 4); E.T.gw[0] = -2; GEMM_CALL(pg8::EpiBf16R, E, WB + NW_W2V, ar + NA_GV, 256, 4096, 256, 256, 256, (int)((blockIdx.x + F.G - 16) % F.G)); }
                } PH_END
                PH_BEGIN ph_nsa_cmp(F, half); PH_END
                PH_BEGIN ph_nsa_sel(F, half); PH_END
                PH_BEGIN ph_nsa_win(F, half); PH_END
                PH_BEGIN { pg8::EpiResN E{LAYER == 0 ? args.in[0] : nullptr, args.in[ib], nullptr, DM, roff, args.in[iff], (pg8::bf16_t*)XN, SSB + (size_t)(LAYER * 2 + 1) * MTOT * 8, (PG8_LAS float*)(F.lds + LDSCTL_OFF + 256)}; GEMM_CALL(pg8::EpiResN, E, ar + NA_O, WB + NW_OUT, MC, DM, 6144, 6144, 6144, (int)blockIdx.x); } PH_END
            }
}
template <int LAYER> DI void run_ffn(const Args& args, LAS unsigned char* lds, volatile LAS unsigned* MISC, int& ph, const int lo, const int hi) {
    constexpr int ib = (LAYER == 0) ? 2 : (LAYER == 1) ? 17 : (LAYER == 2) ? 26 : 42;
    constexpr int iff = (LAYER == 0) ? 12 : (LAYER == 1) ? 21 : (LAYER == 2) ? 37 : 52;
    PH_BEGIN {
        LAS float* rt = (LAS float*)(F.lds + LDSCTL_OFF + 256 + 8192); const int rbase = 4096 * (int)(blockIdx.x & 7); const float* ssq = SSB + (size_t)(LAYER * 2 + 1) * MTOT * 8;
        for (int i = F.tid; i < 4096; i += NWAVES * 64) rt[i] = pg8::rms_rowscale(ssq, rbase + i);
        __syncthreads();
        pg8::EpiConvGlu E{(pg8::bf16_t*)ar, (float*)(ar + 352 * MiB), args.in[iff + 2], args.in[iff + 3], (PG8_LAS float*)(F.lds + LDSCTL_OFF + 256), DFF, (const PG8_LAS float*)rt, rbase};
        GEMM_CALL(pg8::EpiConvGlu, E, XN, WUP, MTOT, 2 * DFF, DM, DM, DM, (int)blockIdx.x); } PH_END
    PH_BEGIN ph_conv_fix(F, (const float*)(ar + 352 * MiB), (bf16*)ar, args.in[iff + 2], args.in[iff + 3], MTOT); PH_END
    PH_BEGIN {
        if constexpr (LAYER < 3) { constexpr int ibn = (LAYER == 0) ? 17 : (LAYER == 1) ? 26 : 42;
            pg8::EpiResN E{nullptr, args.in[iff], nullptr, DM, 0, args.in[ibn], (pg8::bf16_t*)XN, SSB + (size_t)((LAYER + 1) * 2) * MTOT * 8, (PG8_LAS float*)(F.lds + LDSCTL_OFF + 256)}; GEMM_CALL(pg8::EpiResN, E, ar, WDN, MTOT, DM, DFF, DFF, DFF, (int)blockIdx.x); }
        else { pg8::EpiResN E{nullptr, args.in[iff], nullptr, DM, 0, args.in[57], (pg8::bf16_t*)XN, SSB, (PG8_LAS float*)(F.lds + LDSCTL_OFF + 256)}; GEMM_CALL(pg8::EpiResN, E, ar, WDN, MTOT, DM, DFF, DFF, DFF, (int)blockIdx.x); }
    } PH_END
}
__global__ void __launch_bounds__(NWAVES * 64, 2) mk_fwd(Args args) {
    extern __shared__ __attribute__((aligned(16))) unsigned char lds_[];
    LAS unsigned char* const lds = (LAS unsigned char*)lds_;
    volatile LAS unsigned* MISC = (volatile LAS unsigned*)(lds + LDSCTL_OFF);
    for (int u = threadIdx.x; u < 64; u += NWAVES * 64) ((LAS unsigned*)(lds + LDSCTL_OFF))[u] = 0u;
    __syncthreads();
    const int lo = args.ph_lo, hi = args.ph_hi;
    (void)xcd_barrier_post((unsigned*)(args.ws + WS_CTL) + CW_BAR, MISC + 8);
    int ph = 0;
    run_cvt<0>(args, lds, MISC, ph, lo, hi); run_half<0, 0>(args, lds, MISC, ph, lo, hi); run_half<0, 1>(args, lds, MISC, ph, lo, hi); run_ffn<0>(args, lds, MISC, ph, lo, hi);
    run_cvt<1>(args, lds, MISC, ph, lo, hi); run_half<1, 0>(args, lds, MISC, ph, lo, hi); run_half<1, 1>(args, lds, MISC, ph, lo, hi); run_ffn<1>(args, lds, MISC, ph, lo, hi);
    run_cvt<2>(args, lds, MISC, ph, lo, hi); run_half<2, 0>(args, lds, MISC, ph, lo, hi); run_half<2, 1>(args, lds, MISC, ph, lo, hi); run_ffn<2>(args, lds, MISC, ph, lo, hi);
    run_cvt<3>(args, lds, MISC, ph, lo, hi); run_half<3, 0>(args, lds, MISC, ph, lo, hi); run_half<3, 1>(args, lds, MISC, ph, lo, hi); run_ffn<3>(args, lds, MISC, ph, lo, hi);
    { constexpr int ib = 42, iff = 52; PH_BEGIN ph_final_norm(F, (const bf16*)XN, SSB, out); PH_END }
}
extern "C" void kernel_launch(void* const* d_in, const int* in_sizes, int n_in, void* d_out, int out_size, void* d_ws, size_t ws_size, hipStream_t stream) {
    static int grid = 0;
    if (grid == 0) {
        if (n_in != 58 || out_size != MTOT * DM || ws_size < WS_END) { fprintf(stderr, "kernel_launch: unexpected shapes (n_in %d, out %d, ws %zu)\n", n_in, out_size, ws_size); grid = -1; return; }
        int dev = 0, cus = 0;
        if (hipGetDevice(&dev) != hipSuccess || hipDeviceGetAttribute(&cus, hipDeviceAttributeMultiprocessorCount, dev) != hipSuccess) { grid = -1; return; }
        if (hipFuncSetAttribute((const void*)mk_fwd, hipFuncAttributeMaxDynamicSharedMemorySize, LDS_BYTES) != hipSuccess) { fprintf(stderr, "kernel_launch: hipFuncSetAttribute failed\n"); grid = -1; return; }
        int per_cu = 0;
        (void)hipOccupancyMaxActiveBlocksPerMultiprocessor(&per_cu, (const void*)mk_fwd, NWAVES * 64, LDS_BYTES);
        (void)hipGetLastError();
        grid = cus;
    }
    if (grid < 0) return;
    if (hipMemsetAsync((char*)d_ws + WS_CTL, 0, CTL_ZERO_BYTES, stream) != hipSuccess) return;
    Args a{};
    for (int i = 0; i < 58; ++i) a.in[i] = (const float*)d_in[i];
    a.out = (float*)d_out; a.ws = (unsigned char*)d_ws;
#if MK_ONE_LAUNCH
    a.ph_lo = 0; a.ph_hi = NPH;
    hipLaunchKernelGGL(mk_fwd, dim3(grid), dim3(NWAVES * 64), LDS_BYTES, stream, a);
#else
    for (int p = 0; p < NPH; ++p) { a.ph_lo = p; a.ph_hi = p + 1; hipLaunchKernelGGL(mk_fwd, dim3(grid), dim3(NWAVES * 64), LDS_BYTES, stream, a); }
#endif
}
```

```cpp
#include <hip/hip_runtime.h>
#include <cstdio>
#include <cstdint>
#define DI __device__ __forceinline__
namespace pg8 {
#define PG8_LAS __attribute__((address_space(3)))
typedef unsigned short bf16_t;
typedef short bf16x8 __attribute__((ext_vector_type(8)));
typedef float f32x4 __attribute__((ext_vector_type(4)));
typedef unsigned u32x4 __attribute__((ext_vector_type(4)));
constexpr int BM = 256, BK = 64, HALF = 128, HTB = HALF * BK * 2  , STAGE_BYTES = 8 * HTB, NXCD = 8, WGM = 8;

__host__ __device__ __forceinline__ int lds_byte(int r, int c) { const int st = (r >> 4) * 2 + (c >> 5), rr = r & 15, cc = c & 31, ob = rr * 64 + cc * 2; return st * 1024 + (ob ^ (((ob >> 9) & 1) << 5)); }
__host__ __device__ __forceinline__ void stage_rc(int b, int& R, int& C) { const int st = b / 1024, sb = b % 1024, swz = sb ^ (((sb >> 9) & 1) << 5); R = (st >> 1) * 16 + swz / 64; C = (st & 1) * 32 + (swz % 64) / 2; }
__host__ __device__ __forceinline__ int perm32(int rho) { const int n = rho >> 4, i = rho & 15; return 8 * (i >> 2) + 4 * n + (i & 3); }

struct Unit { int pm, pn; };
struct Gemm { const bf16_t* A; const bf16_t* Bt; int M, N, K, lda, ldb, akoff; };

struct StaticOrder {
    int nM, nN, nwg, G, c;
    __host__ __device__ void init(int M, int N, int G_, int c_) { nM = M / BM; nN = N / BM; nwg = nM * nN; G = G_; c = c_; }
    __host__ __device__ bool next(int i, Unit& u) const {
        const long L = (long)i * G + c; if (L >= nwg) return false;
        int wgid = (int)L; { const int q = nwg / NXCD, r = nwg % NXCD, xcd = wgid % NXCD, off = wgid / NXCD; wgid = (xcd < r ? xcd * (q + 1) : r * (q + 1) + (xcd - r) * q) + off; }
        const int nig = WGM * nN, gid = wgid / nig, fm = gid * WGM, gsz = (nM - fm) < WGM ? (nM - fm) : WGM;
        u.pm = fm + ((wgid % nig) % gsz); u.pn = (wgid % nig) / gsz; return true;
    }
    __device__ __forceinline__ void a_ready(const Unit&) const {}
    __device__ __forceinline__ void done(const Unit&) const {}
};
__device__ __forceinline__ unsigned cvt_pk_bf16(float lo, float hi) { unsigned r; asm volatile("v_cvt_pk_bf16_f32 %0, %1, %2" : "=v"(r) : "v"(lo), "v"(hi)); return r; }
template <class Epi, class Sched, bool ALIGN_EPI = false, bool SP2 = false>
__device__ __forceinline__ void gemm_phase(PG8_LAS unsigned char* lds, const Gemm g, const Sched& S, const Epi& E) {
    const int tid = threadIdx.x, wid = __builtin_amdgcn_readfirstlane(tid >> 6), lane = tid & 63, wr = wid >> 2, wc = wid & 3, fr = lane & 15, fq = lane >> 4;
    const int K = g.K, nt = K / BK;
    unsigned voffA[2], voffB[2];
#pragma unroll
    for (int i = 0; i < 2; ++i) { int R, C; stage_rc(tid * 16 + i * 8192, R, C); const int Rb = Epi::PERM ? ((R & ~31) + perm32(R & 31)) : R;
        const int Ra = Epi::APERM ? ((R & ~63) | ((R & 15) << 2) | ((R >> 4) & 3)) : R;
        voffA[i] = (unsigned)(Ra * g.lda + C) * 2u; voffB[i] = (unsigned)(Rb * g.ldb + C) * 2u; }
    const size_t kstep = (size_t)(BK * 2);
    const size_t hstepA = (size_t)HALF * g.lda * 2, hstepB = (size_t)HALF * g.ldb * 2;
    const size_t tstepA = 2 * hstepA, tstepB = 2 * hstepB;
    const unsigned ldsw = (unsigned)wid * 1024u;
    const int aoff = lds_byte(wr * 64 + fr, fq * 8), boff = lds_byte(wc * 32 + fr, fq * 8);
#define PG8_SA(b, h) (((b) * 2 + (h)) * HTB)
#define PG8_SB(b, h) ((4 + (b) * 2 + (h)) * HTB)
#define PG8_STAGE(bufoff, gbase, voff) do { _Pragma("unroll") for (int _i = 0; _i < 2; ++_i) \
        __builtin_amdgcn_global_load_lds((const unsigned*)((const char*)(gbase) + (voff)[_i]), (PG8_LAS unsigned*)(lds + (bufoff) + ldsw + _i * 8192), 16, 0, 0); } while (0)
#define PG8_LDA(dst, b, h) do { _Pragma("unroll") for (int m = 0; m < 4; ++m) _Pragma("unroll") for (int k = 0; k < 2; ++k) dst[m][k] = *(const PG8_LAS bf16x8*)(lds + PG8_SA(b, h) + aoff + m * 2048 + k * 1024); } while (0)
#define PG8_LDB(dst, b, h) do { _Pragma("unroll") for (int n = 0; n < 2; ++n) _Pragma("unroll") for (int k = 0; k < 2; ++k) dst[n][k] = *(const PG8_LAS bf16x8*)(lds + PG8_SB(b, h) + boff + n * 2048 + k * 1024); } while (0)
#define PG8_MMA(ai, bj, At, Bt) do { __builtin_amdgcn_s_setprio(1); _Pragma("unroll") for (int m = 0; m < 4; ++m) _Pragma("unroll") for (int n = 0; n < 2; ++n) _Pragma("unroll") for (int k = 0; k < 2; ++k) \
        acc[ai][bj][m][n] = __builtin_amdgcn_mfma_f32_16x16x32_bf16(Bt[n][k], At[m][k], acc[ai][bj][m][n], 0, 0, 0); __builtin_amdgcn_s_setprio(0); } while (0)
#define PG8_WAIT_V(n) asm volatile("s_waitcnt vmcnt(" #n ")" ::: "memory")
#define PG8_WAIT_L(n) asm volatile("s_waitcnt lgkmcnt(" #n ")" ::: "memory")
#define PG8_BAR __builtin_amdgcn_s_barrier()
#define PG8_SCHED __builtin_amdgcn_sched_barrier(0)
    Unit cur, nxt; int ui = 0;
    if (!S.next(0, cur)) return;
    f32x4 acc[2][2][4][2];
#pragma unroll
    for (int a = 0; a < 2; ++a)
#pragma unroll
        for (int b = 0; b < 2; ++b)
#pragma unroll
            for (int m = 0; m < 4; ++m)
#pragma unroll
                for (int n = 0; n < 2; ++n) acc[a][b][m][n] = (f32x4){0.f, 0.f, 0.f, 0.f};
    bf16x8 At[4][2], B0[2][2], B1[2][2];
    const char* cA = (const char*)g.A + (size_t)cur.pm * tstepA + (size_t)cur.pn * g.akoff * 2; const char* cB = (const char*)g.Bt + (size_t)cur.pn * tstepB;
    S.a_ready(cur);
    if constexpr (SP2) {
        PG8_STAGE(PG8_SB(0, 0), cB, voffB); PG8_STAGE(PG8_SB(0, 1), cB + hstepB, voffB); PG8_STAGE(PG8_SA(0, 0), cA, voffA); PG8_STAGE(PG8_SA(0, 1), cA + hstepA, voffA);
        if (wr == 1) PG8_BAR;
        PG8_WAIT_V(2); PG8_BAR;
        PG8_STAGE(PG8_SB(1, 0), cB + kstep, voffB); PG8_STAGE(PG8_SA(1, 0), cA + kstep, voffA); PG8_STAGE(PG8_SB(1, 1), cB + hstepB + kstep, voffB);
        PG8_WAIT_V(6); PG8_BAR;
    } else {
        PG8_STAGE(PG8_SB(0, 0), cB, voffB); PG8_STAGE(PG8_SA(0, 0), cA, voffA); PG8_STAGE(PG8_SB(0, 1), cB + hstepB, voffB); PG8_STAGE(PG8_SA(0, 1), cA + hstepA, voffA);
        if (wr == 1) PG8_BAR;
        PG8_WAIT_V(4); PG8_BAR;
        PG8_STAGE(PG8_SB(1, 0), cB + kstep, voffB); PG8_STAGE(PG8_SA(1, 0), cA + kstep, voffA); PG8_STAGE(PG8_SB(1, 1), cB + hstepB + kstep, voffB);
        PG8_WAIT_V(6); PG8_BAR;
    }
    for (;;) {
        const bool has_next = S.next(ui + 1, nxt);
        const char* nA = has_next ? (const char*)g.A + (size_t)nxt.pm * tstepA + (size_t)nxt.pn * g.akoff * 2 : cA; const char* nB = has_next ? (const char*)g.Bt + (size_t)nxt.pn * tstepB : cB;
        for (int t = 0; t < nt; t += 2) {
            const bool last = (t == nt - 2);
            const char* a1 = cA + (size_t)(t + 1) * kstep;
            const char* a2 = last ? nA : cA + (size_t)(t + 2) * kstep; const char* b2 = last ? nB : cB + (size_t)(t + 2) * kstep;
            const char* a3 = a2 + kstep; const char* b3 = b2 + kstep;
            if (last && has_next) S.a_ready(nxt);
            if constexpr (SP2) {
            PG8_LDB(B0, 0, 0); PG8_LDB(B1, 0, 1); PG8_SCHED; PG8_LDA(At, 0, 0); PG8_STAGE(PG8_SA(1, 1), a1 + hstepA, voffA);
            PG8_WAIT_V(8); PG8_WAIT_L(0); PG8_BAR; PG8_MMA(0, 0, At, B0); PG8_MMA(0, 1, At, B1); PG8_BAR; PG8_SCHED;
            PG8_LDA(At, 0, 1); PG8_STAGE(PG8_SB(0, 0), b2, voffB); PG8_STAGE(PG8_SB(0, 1), b2 + hstepB, voffB); PG8_STAGE(PG8_SA(0, 0), a2, voffA);
            PG8_WAIT_V(8); PG8_WAIT_L(0); PG8_BAR; PG8_MMA(1, 0, At, B0); PG8_MMA(1, 1, At, B1); PG8_BAR; PG8_SCHED;
            PG8_LDB(B0, 1, 0); PG8_LDB(B1, 1, 1); PG8_SCHED; PG8_LDA(At, 1, 0); PG8_STAGE(PG8_SA(0, 1), a2 + hstepA, voffA);
            PG8_WAIT_V(8); PG8_WAIT_L(0); PG8_BAR; PG8_MMA(0, 0, At, B0); PG8_MMA(0, 1, At, B1); PG8_BAR; PG8_SCHED;
            PG8_LDA(At, 1, 1); PG8_STAGE(PG8_SB(1, 0), b3, voffB); PG8_STAGE(PG8_SB(1, 1), b3 + hstepB, voffB); PG8_STAGE(PG8_SA(1, 0), a3, voffA);
            PG8_WAIT_V(8); PG8_WAIT_L(0); PG8_BAR; PG8_MMA(1, 0, At, B0); PG8_MMA(1, 1, At, B1); PG8_BAR; PG8_SCHED;
            } else {
            PG8_LDB(B0, 0, 0); PG8_SCHED; PG8_LDA(At, 0, 0); PG8_STAGE(PG8_SA(1, 1), a1 + hstepA, voffA);
            PG8_WAIT_L(8); PG8_BAR; PG8_WAIT_L(0); PG8_MMA(0, 0, At, B0); PG8_BAR; PG8_SCHED;
            PG8_LDB(B1, 0, 1); PG8_STAGE(PG8_SB(0, 0), b2, voffB);
            PG8_BAR; PG8_WAIT_L(0); PG8_MMA(0, 1, At, B1); PG8_BAR;
            PG8_LDA(At, 0, 1); PG8_STAGE(PG8_SA(0, 0), a2, voffA);
            PG8_BAR; PG8_WAIT_L(0); PG8_MMA(1, 0, At, B0); PG8_BAR; PG8_SCHED;
            PG8_STAGE(PG8_SB(0, 1), b2 + hstepB, voffB);
            PG8_WAIT_V(6); PG8_BAR; PG8_MMA(1, 1, At, B1); PG8_BAR;
            PG8_LDB(B0, 1, 0); PG8_SCHED; PG8_LDA(At, 1, 0); PG8_STAGE(PG8_SA(0, 1), a2 + hstepA, voffA);
            PG8_WAIT_L(8); PG8_BAR; PG8_WAIT_L(0); PG8_MMA(0, 0, At, B0); PG8_BAR; PG8_SCHED;
            PG8_LDB(B1, 1, 1); PG8_STAGE(PG8_SB(1, 0), b3, voffB);
            PG8_BAR; PG8_WAIT_L(0); PG8_MMA(0, 1, At, B1); PG8_BAR;
            PG8_LDA(At, 1, 1); PG8_STAGE(PG8_SA(1, 0), a3, voffA);
            PG8_BAR; PG8_WAIT_L(0); PG8_MMA(1, 0, At, B0); PG8_BAR; PG8_SCHED;
            PG8_STAGE(PG8_SB(1, 1), b3 + hstepB, voffB);
            PG8_WAIT_V(6); PG8_BAR; PG8_MMA(1, 1, At, B1); PG8_BAR;
            }
        }
        if constexpr (ALIGN_EPI) { if (wr == 0) PG8_BAR; }
        if constexpr (!Epi::AFTER_DRAIN) { E(acc, cur, wr, wc, fr, fq); S.done(cur); }
        if (!has_next) break;
#pragma unroll
        for (int a = 0; a < 2; ++a)
#pragma unroll
            for (int b = 0; b < 2; ++b)
#pragma unroll
                for (int m = 0; m < 4; ++m)
#pragma unroll
                    for (int n = 0; n < 2; ++n) acc[a][b][m][n] = (f32x4){0.f, 0.f, 0.f, 0.f};
        cur = nxt; cA = nA; cB = nB; ++ui;
        if constexpr (ALIGN_EPI) { if (wr == 1) PG8_BAR; }
    }
    PG8_WAIT_V(0);
    if constexpr (!ALIGN_EPI) { if (wr == 0) PG8_BAR; }
    PG8_BAR;
    if constexpr (Epi::AFTER_DRAIN) { E.fused(acc, cur, wr, wc, fr, fq, lds, wid, lane); S.done(cur); }
#undef PG8_SA
#undef PG8_SB
#undef PG8_STAGE
#undef PG8_LDA
#undef PG8_LDB
#undef PG8_MMA
#undef PG8_WAIT_V
#undef PG8_WAIT_L
#undef PG8_BAR
#undef PG8_SCHED
}
}
namespace pg8 {
typedef float f32x2 __attribute__((ext_vector_type(2)));
__device__ __forceinline__ float rms_rowscale(const float* ssq, int row) { const f32x4 a = *(const f32x4*)(ssq + (size_t)row * 8), b = *(const f32x4*)(ssq + (size_t)row * 8 + 4);
    return __builtin_amdgcn_rsqf((((a[0] + a[1]) + (a[2] + a[3])) + ((b[0] + b[1]) + (b[2] + b[3]))) * (1.0f / 2048.0f) + 1e-6f); }
struct SegTab { bf16_t* base[8]; int ldc[8]; int t0[8]; int gw[8]; int nseg; int pad_; };
struct EpiBf16R {
    static constexpr bool PERM = true, AFTER_DRAIN = false, APERM = false;
    SegTab T; const float* ssp; int ss_off;
    __device__ __forceinline__ void operator()(const f32x4 (&acc)[2][2][4][2], const Unit& u, int wr, int wc, int fr, int fq) const {
        bf16_t* base = T.base[0]; int ldc = T.ldc[0], gw = T.gw[0], t0 = T.t0[0];
#pragma unroll
        for (int s = 1; s < 8; ++s) if (s < T.nseg && u.pn >= T.t0[s]) { base = T.base[s]; ldc = T.ldc[s]; gw = T.gw[s]; t0 = T.t0[s]; }
        const int colt = (u.pn - t0) * BM, row0 = u.pm * BM + wr * 64 + fr;
        if (gw <= -4) {
            typedef unsigned u32x2_ __attribute__((ext_vector_type(2)));
#pragma unroll
            for (int bj = 0; bj < 2; ++bj) { const int col = colt + bj * HALF + wc * 32 + 8 * fq;
                f32x4 c0 = {1.f, 1.f, 1.f, 1.f}, c1 = {1.f, 1.f, 1.f, 1.f};
                if (ssp) {
#pragma unroll
                    for (int j = 0; j < 4; ++j) { c0[j] = rms_rowscale(ssp, ss_off + col + j); c1[j] = rms_rowscale(ssp, ss_off + col + 4 + j); } }
                const int bt = ((col >> 12) * ldc) * 128 + ((col & 4095) >> 5);
#pragma unroll
                for (int ai = 0; ai < 2; ++ai)
#pragma unroll
                    for (int m = 0; m < 4; ++m) { const int row = row0 + ai * HALF + m * 16;
                        const f32x4 v0 = acc[ai][bj][m][0] * c0, v1 = acc[ai][bj][m][1] * c1;
                        if (gw == -4) {
                            bf16_t* d0 = base + ((size_t)(((bt + (row >> 7) * 128) * 8 + ((row >> 5) & 3) * 2 + ((col >> 4) & 1)) * 64) + (row & 31)) * 8 + 4 * ((col >> 3) & 1);
                            *(u32x2_*)d0 = (u32x2_){cvt_pk_bf16(v0[0], v0[1]), cvt_pk_bf16(v0[2], v0[3])}; *(u32x2_*)(d0 + 32 * 8) = (u32x2_){cvt_pk_bf16(v1[0], v1[1]), cvt_pk_bf16(v1[2], v1[3])};
                        } else {
                            const int k0 = col & 31, kq = (k0 & 15) >> 2, j0 = (k0 >> 4) * 4;
                            unsigned char* d8 = (unsigned char*)base + ((size_t)(((bt + (row >> 7) * 128) * 8 + ((row >> 4) & 7)) * 64) + 16 * kq + (row & 15)) * 8 + j0;
                            int lo = 0, hi = 0;
                            lo = __builtin_amdgcn_cvt_pk_fp8_f32(v0[0], v0[1], lo, false); lo = __builtin_amdgcn_cvt_pk_fp8_f32(v0[2], v0[3], lo, true);
                            hi = __builtin_amdgcn_cvt_pk_fp8_f32(v1[0], v1[1], hi, false); hi = __builtin_amdgcn_cvt_pk_fp8_f32(v1[2], v1[3], hi, true);
                            *(int*)d8 = lo; *(int*)(d8 + 16 * 8) = hi; } } }
            return; }
#pragma unroll
        for (int ai = 0; ai < 2; ++ai)
#pragma unroll
            for (int m = 0; m < 4; ++m) { const int row = row0 + ai * HALF + m * 16;
                const float rs = ssp ? rms_rowscale(ssp, ss_off + row) : 1.0f;
#pragma unroll
                for (int bj = 0; bj < 2; ++bj) { const int col = colt + bj * HALF + wc * 32 + 8 * fq;
                    const f32x4 v0 = acc[ai][bj][m][0] * rs, v1 = acc[ai][bj][m][1] * rs;
                    u32x4 w; w.x = cvt_pk_bf16(v0[0], v0[1]); w.y = cvt_pk_bf16(v0[2], v0[3]); w.z = cvt_pk_bf16(v1[0], v1[1]); w.w = cvt_pk_bf16(v1[2], v1[3]);
                    if (gw == -2) {
                        if ((row >> 5) < ldc) { bf16_t* d0 = base + ((size_t)(((col >> 5) * ldc + (row >> 5)) * 2 + ((col >> 4) & 1)) * 64 + (row & 31)) * 8 + 4 * ((col >> 3) & 1);
                            typedef unsigned u32x2_ __attribute__((ext_vector_type(2)));
                            *(u32x2_*)d0 = (u32x2_){w.x, w.y}; *(u32x2_*)(d0 + 32 * 8) = (u32x2_){w.z, w.w}; }
                        continue; }
                    bf16_t* dst;
                    if (gw == 0) dst = base + (size_t)row * ldc + col;
                    else if (gw == -1) { if ((col >> 4) >= ldc) continue; dst = base + ((size_t)((row >> 5) * ldc + (col >> 4)) * 64 + ((col >> 3) & 1) * 32 + (row & 31)) * 8; }
                    else if (gw == -3) dst = base + ((size_t)(((((row >> 12) * 16 + (col >> 7)) * 128 + ((row & 4095) >> 5)) * 9 + ((col >> 4) & 7)) * 64) + ((col >> 3) & 1) * 32 + (row & 31)) * 8;
                    else { const int g = col / gw, d = col - g * gw; dst = base + ((size_t)((row >> 12) * 4 + g) * 4096 + (row & 4095)) * gw + d; }
                    *(u32x4*)dst = w; } }
    }
};
struct EpiGelu {
    static constexpr bool PERM = true, AFTER_DRAIN = false, APERM = false;
    bf16_t* O; int ldc; const float* bias;
    static __device__ __forceinline__ float gelu(float x) { const float u2 = 1.5957691216f * (x + 0.044715f * x * x * x); const float e = __builtin_amdgcn_exp2f(-u2 * 1.4426950409f); return x * __builtin_amdgcn_rcpf(1.0f + e); }
    __device__ __forceinline__ void operator()(const f32x4 (&acc)[2][2][4][2], const Unit& u, int wr, int wc, int fr, int fq) const {
        const int row0 = u.pm * BM + wr * 64 + fr, col0 = u.pn * BM + wc * 32 + 8 * fq;
#pragma unroll
        for (int bj = 0; bj < 2; ++bj) { const f32x4 b0 = *(const f32x4*)(bias + col0 + bj * HALF), b1 = *(const f32x4*)(bias + col0 + bj * HALF + 4);
#pragma unroll
            for (int ai = 0; ai < 2; ++ai)
#pragma unroll
                for (int m = 0; m < 4; ++m) { const f32x4 v0 = acc[ai][bj][m][0] + b0, v1 = acc[ai][bj][m][1] + b1;
                    u32x4 w; w.x = cvt_pk_bf16(gelu(v0[0]), gelu(v0[1])); w.y = cvt_pk_bf16(gelu(v0[2]), gelu(v0[3])); w.z = cvt_pk_bf16(gelu(v1[0]), gelu(v1[1])); w.w = cvt_pk_bf16(gelu(v1[2]), gelu(v1[3]));
                    *(u32x4*)(O + (size_t)(row0 + ai * HALF + m * 16) * ldc + col0 + bj * HALF) = w; } }
    }
};
struct EpiF32 {
    static constexpr bool PERM = false, AFTER_DRAIN = false, APERM = false;
    float* C; int ldc; const float* ssp; int ss_off;
    __device__ __forceinline__ void operator()(const f32x4 (&acc)[2][2][4][2], const Unit& u, int wr, int wc, int fr, int fq) const {
        const int row0 = u.pm * BM + wr * 64 + fr, col0 = u.pn * BM + wc * 32 + 4 * fq;
#pragma unroll
        for (int ai = 0; ai < 2; ++ai)
#pragma unroll
            for (int m = 0; m < 4; ++m) { float* rowp = C + (size_t)(row0 + ai * HALF + m * 16) * ldc + col0;
                const float rs = ssp ? rms_rowscale(ssp, ss_off + row0 + ai * HALF + m * 16) : 1.0f;
#pragma unroll
                for (int bj = 0; bj < 2; ++bj)
#pragma unroll
                    for (int n = 0; n < 2; ++n) *(f32x4*)(rowp + bj * HALF + n * 16) = acc[ai][bj][m][n] * rs; }
    }
};
struct EpiResN {
    static constexpr bool PERM = false, AFTER_DRAIN = false, APERM = false;
    const float* res32; const float* gprev; float* out32; int ldc; int row_off; const float* g; bf16_t* xn; float* ss; PG8_LAS float* xb;
    __device__ __forceinline__ void operator()(const f32x4 (&acc)[2][2][4][2], const Unit& u, int wr, int wc, int fr, int fq) const {
        typedef unsigned u32x2_ __attribute__((ext_vector_type(2)));
        const int row0 = row_off + u.pm * BM + wr * 64 + fr, col0 = u.pn * BM + wc * 32 + 4 * fq;
        f32x4 gv[2][2], gi[2][2];
#pragma unroll
        for (int bj = 0; bj < 2; ++bj)
#pragma unroll
            for (int n = 0; n < 2; ++n) { gv[bj][n] = g ? *(const f32x4*)(g + col0 + bj * HALF + n * 16) : (f32x4){0.f, 0.f, 0.f, 0.f};
                if (!res32) { const f32x4 t = *(const f32x4*)(gprev + col0 + bj * HALF + n * 16); gi[bj][n] = (f32x4){1.0f / t[0], 1.0f / t[1], 1.0f / t[2], 1.0f / t[3]}; } else gi[bj][n] = (f32x4){1.f, 1.f, 1.f, 1.f}; }
#pragma unroll
        for (int ai = 0; ai < 2; ++ai)
#pragma unroll
            for (int m = 0; m < 4; ++m) { const int row = row0 + ai * HALF + m * 16; const size_t off = (size_t)row * ldc + col0;
                f32x4 r[2][2]; float sq = 0.f;
#pragma unroll
                for (int bj = 0; bj < 2; ++bj)
#pragma unroll
                    for (int n = 0; n < 2; ++n) {
                        if (res32) r[bj][n] = *(const f32x4*)(res32 + off + bj * HALF + n * 16);
                        else { const u32x2_ w = *(const u32x2_*)(xn + off + bj * HALF + n * 16);
                            r[bj][n] = (f32x4){__builtin_bit_cast(float, w.x << 16), __builtin_bit_cast(float, w.x & 0xffff0000u), __builtin_bit_cast(float, w.y << 16), __builtin_bit_cast(float, w.y & 0xffff0000u)} * gi[bj][n]; } }
#pragma unroll
                for (int bj = 0; bj < 2; ++bj)
#pragma unroll
                    for (int n = 0; n < 2; ++n) { const f32x4 o = r[bj][n] + acc[ai][bj][m][n];
                        if (out32) *(f32x4*)(out32 + off + bj * HALF + n * 16) = o;
                        if (g) { sq += (o[0] * o[0] + o[1] * o[1]) + (o[2] * o[2] + o[3] * o[3]);
                            const f32x4 y = o * gv[bj][n]; *(u32x2_*)(xn + off + bj * HALF + n * 16) = (u32x2_){cvt_pk_bf16(y[0], y[1]), cvt_pk_bf16(y[2], y[3])}; } }
                if (g) { sq += __shfl_xor(sq, 16); sq += __shfl_xor(sq, 32);
                    if (fq == 0) xb[(ai * HALF + wr * 64 + m * 16 + fr) * 4 + wc] = sq; }
                asm volatile("" ::: "memory"); }
        if (g) {
            asm volatile("s_waitcnt lgkmcnt(0)" ::: "memory"); __builtin_amdgcn_s_barrier(); asm volatile("" ::: "memory");
            const int t = (wr * 4 + wc) * 64 + fq * 16 + fr;
            if (t < BM) { const f32x4 v = *(const PG8_LAS f32x4*)(xb + t * 4); ss[(size_t)(row_off + u.pm * BM + t) * 8 + u.pn] = (v[0] + v[1]) + (v[2] + v[3]); }
        }
    }
};
struct EpiConvGlu {
    static constexpr bool PERM = true, AFTER_DRAIN = false, APERM = true;
    bf16_t* G; float* UB; const float* cw; const float* cb; PG8_LAS float* xb; int dff; const PG8_LAS float* rstd; int rbase;
    static __device__ __forceinline__ float shr1(float old, float src) { const int o = __builtin_bit_cast(int, old), s = __builtin_bit_cast(int, src);
        return __builtin_bit_cast(float, __builtin_amdgcn_update_dpp(o, s, 0x111, 0xf, 0xf, false)); }
    __device__ __forceinline__ void operator()(f32x4 (&acc)[2][2][4][2], const Unit& u, int wr, int wc, int fr, int fq) const {
        typedef unsigned u32x2_ __attribute__((ext_vector_type(2)));
        if (rstd) {
#pragma unroll
            for (int ai = 0; ai < 2; ++ai) { const f32x4 rs = *(const PG8_LAS f32x4*)(rstd + (u.pm * BM + ai * HALF + wr * 64 + fr * 4 - rbase));
#pragma unroll
                for (int m = 0; m < 4; ++m)
#pragma unroll
                    for (int bj = 0; bj < 2; ++bj)
#pragma unroll
                        for (int n = 0; n < 2; ++n) acc[ai][bj][m][n] = acc[ai][bj][m][n] * rs[m]; }
        }
        if (fr == 15) {
#pragma unroll
            for (int ai = 0; ai < 2; ++ai)
#pragma unroll
                for (int k = 0; k < 2; ++k)
#pragma unroll
                    for (int bj = 0; bj < 2; ++bj)
#pragma unroll
                        for (int n = 0; n < 2; ++n) *(PG8_LAS f32x4*)(xb + (((((ai * 2 + wr) * 4 + wc) * 2 + k) * 4 + fq) * 16) + (bj * 2 + n) * 4) = acc[ai][bj][2 + k][n];
        }
        { const int ncol = 4 * dff / 2;
          const bool top = (wr == 0 && fr == 0), bot = (wr == 1 && fr == 15);
          if (top || bot) {
#pragma unroll
            for (int k = 0; k < 2; ++k) { float* ub = UB + ((size_t)(u.pm * 4 + (top ? k : 2 + k)) * ncol) + u.pn * BM + wc * 32 + 8 * fq;
#pragma unroll
              for (int bj = 0; bj < 2; ++bj)
#pragma unroll
                for (int n = 0; n < 2; ++n) *(f32x4*)(ub + bj * HALF + 4 * n) = top ? acc[0][bj][k][n] : acc[1][bj][2 + k][n]; } } }
        asm volatile("s_waitcnt lgkmcnt(0)" ::: "memory"); __builtin_amdgcn_s_barrier(); asm volatile("" ::: "memory");
        u32x2_ res[2][4][2];
        const int ch0 = u.pn * HALF + wc * 32 + 8 * fq;
#pragma unroll
        for (int n = 0; n < 2; ++n) {
            const float* wp = cw + ch0 + 4 * n; const float* bp = cb + ch0 + 4 * n;
            const f32x4 w0g = *(const f32x4*)(wp), w1g = *(const f32x4*)(wp + 2 * dff), w2g = *(const f32x4*)(wp + 4 * dff), bg = *(const f32x4*)(bp);
            const f32x4 w0v = *(const f32x4*)(wp + dff), w1v = *(const f32x4*)(wp + 3 * dff), w2v = *(const f32x4*)(wp + 5 * dff), bv = *(const f32x4*)(bp + dff);
#pragma unroll
            for (int ai = 0; ai < 2; ++ai) {
                const int sai = wr ? ai : ai - 1, swr = wr ? 0 : 1;
                f32x4 x62g = {0.f, 0.f, 0.f, 0.f}, x63g = x62g, x62v = x62g, x63v = x62g;
                if (sai >= 0) { const PG8_LAS float* xp = xb + (((((sai * 2 + swr) * 4 + wc) * 2) * 4 + fq) * 16);
                    x62g = *(const PG8_LAS f32x4*)(xp + n * 4); x62v = *(const PG8_LAS f32x4*)(xp + (2 + n) * 4); x63g = *(const PG8_LAS f32x4*)(xp + 64 + n * 4); x63v = *(const PG8_LAS f32x4*)(xp + 64 + (2 + n) * 4); }
                float o[4][4];
#pragma unroll
                for (int e = 0; e < 4; ++e) {
                    const float g0 = acc[ai][0][0][n][e], g1 = acc[ai][0][1][n][e], g2 = acc[ai][0][2][n][e], g3 = acc[ai][0][3][n][e];
                    const float v0 = acc[ai][1][0][n][e], v1 = acc[ai][1][1][n][e], v2 = acc[ai][1][2][n][e], v3 = acc[ai][1][3][n][e];
                    const float q1g = shr1(x63g[e], g3), q2g = shr1(x62g[e], g2), q1v = shr1(x63v[e], v3), q2v = shr1(x62v[e], v2);
                    const float yg[4] = {bg[e] + w0g[e] * q2g + w1g[e] * q1g + w2g[e] * g0, bg[e] + w0g[e] * q1g + w1g[e] * g0 + w2g[e] * g1, bg[e] + w0g[e] * g0 + w1g[e] * g1 + w2g[e] * g2, bg[e] + w0g[e] * g1 + w1g[e] * g2 + w2g[e] * g3};
                    const float yv[4] = {bv[e] + w0v[e] * q2v + w1v[e] * q1v + w2v[e] * v0, bv[e] + w0v[e] * q1v + w1v[e] * v0 + w2v[e] * v1, bv[e] + w0v[e] * v0 + w1v[e] * v1 + w2v[e] * v2, bv[e] + w0v[e] * v1 + w1v[e] * v2 + w2v[e] * v3};
#pragma unroll
                    for (int m = 0; m < 4; ++m) o[m][e] = yg[m] * __builtin_amdgcn_rcpf(1.0f + __builtin_amdgcn_exp2f(-yg[m] * 1.4426950409f)) * yv[m];
                }
#pragma unroll
                for (int m = 0; m < 4; ++m) res[ai][m][n] = (u32x2_){cvt_pk_bf16(o[m][0], o[m][1]), cvt_pk_bf16(o[m][2], o[m][3])};
            }
        }
        const int row0 = u.pm * BM + wr * 64 + fr * 4;
#pragma unroll
        for (int ai = 0; ai < 2; ++ai)
#pragma unroll
            for (int m = 0; m < 4; ++m) *(u32x4*)(G + (size_t)(row0 + ai * HALF + m) * dff + ch0) = (u32x4){res[ai][m][0].x, res[ai][m][0].y, res[ai][m][1].x, res[ai][m][1].y};
    }
};
}
constexpr int BATCH = 8, SEQ = 4096, DM = 2048, MTOT = BATCH * SEQ, MC = MTOT / 2  , BPH = BATCH / 2;
constexpr int DFF = 5632;
constexpr float NORM_EPS = 1e-6f, LOG2E = 1.4426950408889634f;
constexpr int NWAVES = 8;
constexpr size_t MiB = 1u << 20;
constexpr size_t WS_CTL = 0, CTL_ZERO_BYTES = 1 * MiB;
constexpr size_t WS_TAB = 1 * MiB;
constexpr size_t TAB_COS48 = WS_TAB, TAB_SIN48 = WS_TAB + 3 * MiB, TAB_COS32 = WS_TAB + 6 * MiB, TAB_SIN32 = WS_TAB + 8 * MiB;
constexpr size_t WS_WMIX = 12 * MiB;
constexpr size_t WS_WFFN = 100 * MiB;
constexpr size_t WS_MISC = 168 * MiB;
constexpr size_t WS_SS = 170 * MiB;
constexpr size_t WS_XNR = 1010 * MiB;
constexpr size_t WS_AR = 234 * MiB;
constexpr size_t WS_END = 1138 * MiB;
constexpr int CW_TMO = 0;
constexpr int CW_BAR = 4096;
constexpr int RING_BYTES = 131072;
constexpr int LDSCTL_OFF = 135168;
constexpr int LDS_BYTES = 163840;

#define GAS __attribute__((address_space(1)))
#define LAS __attribute__((address_space(3)))
typedef unsigned short bf16;
typedef unsigned u32x4 __attribute__((ext_vector_type(4)));
typedef unsigned u32x2 __attribute__((ext_vector_type(2)));
typedef float f32x4 __attribute__((ext_vector_type(4)));
typedef float f32x16 __attribute__((ext_vector_type(16)));
typedef short bf16x8 __attribute__((ext_vector_type(8)));
typedef short s16x4 __attribute__((ext_vector_type(4)));
typedef short v4i16_t __attribute__((ext_vector_type(4)));
typedef __bf16 bf16x2_t __attribute__((ext_vector_type(2)));
typedef float f32x2_t __attribute__((ext_vector_type(2)));
#define LDS_WAIT() asm volatile("s_waitcnt lgkmcnt(0)" ::: "memory")
#define VM_WAIT() asm volatile("s_waitcnt vmcnt(0)" ::: "memory")
#define MFMA32(a, b, c) __builtin_amdgcn_mfma_f32_32x32x16_bf16((a), (b), (c), 0, 0, 0)
DI unsigned pk2(float lo, float hi) { f32x2_t v = {lo, hi}; bf16x2_t b = __builtin_convertvector(v, bf16x2_t); return __builtin_bit_cast(unsigned, b); }
DI float bf2f(unsigned short b) { return __builtin_bit_cast(float, (unsigned)b << 16); }
DI float bflo(unsigned w) { return __builtin_bit_cast(float, w << 16); }
DI float bfhi(unsigned w) { return __builtin_bit_cast(float, w & 0xffff0000u); }
DI unsigned short f2bf(float f) { return (unsigned short)(pk2(f, 0.f) & 0xffffu); }
DI float wave_sum(float v) {
#pragma unroll
    for (int o = 1; o < 64; o <<= 1) v += __shfl_xor(v, o);
    return v;
}
DI int crow(int i, int h) { return (i & 3) + 8 * (i >> 2) + 4 * h; }
#define XB_TMO      128
#define XB_XCNT(j)  (256  + 64 * (j))
#define XB_XSUB(j)  (1280 + 64 * (j))
#define XB_XGEN(j)  (2304 + 64 * (j))
#define XB_TOP      3328
#define XB_TOPGEN   3392
#define XCD_BAR_WORDS 3456
#define XB_SPIN_CAP (1u << 18)

__device__ __forceinline__ unsigned xb_ld(unsigned* p)              { return __hip_atomic_load(p, __ATOMIC_RELAXED, __HIP_MEMORY_SCOPE_AGENT); }
__device__ __forceinline__ unsigned xb_add(unsigned* p, unsigned v) { return __hip_atomic_fetch_add(p, v, __ATOMIC_RELAXED, __HIP_MEMORY_SCOPE_AGENT); }
__device__ __forceinline__ unsigned xb_xcc_id() { return (unsigned)__builtin_amdgcn_s_getreg((3 << 11) | 20) & 0xFu; }
#define XB_SPIN(cond, bar) do { unsigned _sp = 0; while (cond) { __builtin_amdgcn_s_sleep(1); \
    if ((++_sp & 255u) == 0u) { if (xb_ld(&(bar)[XB_TMO])) break; if (_sp > XB_SPIN_CAP) { atomicAdd(&(bar)[XB_TMO], 1u); break; } } } } while (0)

struct XcdBarrier {
    unsigned* bar; unsigned x;
    volatile LAS unsigned* st;
};

__device__ __forceinline__ XcdBarrier xcd_barrier_post(unsigned* bar, volatile LAS unsigned* st) {
    XcdBarrier b; b.bar = bar; b.x = xb_xcc_id(); b.st = st;
    if (threadIdx.x == 0) (void)xb_add(&bar[XB_XCNT(b.x)], 1u);
    return b;
}
__device__ __forceinline__ void xcd_barrier_complete(unsigned* bar, unsigned x, unsigned& nloc, unsigned& nx) {
    const unsigned G = gridDim.x * gridDim.y * gridDim.z;
    unsigned sum, cnt, mine, sp = 0u;
    for (;;) {
        sum = 0u; cnt = 0u; mine = 0u;
#pragma unroll
        for (unsigned j = 0; j < 16; ++j) { const unsigned c = xb_ld(&bar[XB_XCNT(j)]); sum += c; cnt += (c > 0u) ? 1u : 0u; mine = (j == x) ? c : mine; }
        if (sum == G) break;
        __builtin_amdgcn_s_sleep(1);
        if ((++sp & 255u) == 0u) { if (xb_ld(&bar[XB_TMO])) break; if (sp > XB_SPIN_CAP) { atomicAdd(&bar[XB_TMO], 1u); break; } }
    }
    nloc = mine > 0u ? mine : 1u; nx = cnt > 0u ? cnt : 1u;
}

__device__ __forceinline__ void xcd_barrier(const XcdBarrier& b) {
    asm volatile("s_waitcnt vmcnt(0)" ::: "memory");
    __syncthreads();
    if (threadIdx.x == 0) {
        unsigned* bar = b.bar;
        __builtin_amdgcn_s_waitcnt(0);
        unsigned nloc = b.st[0], nx = b.st[1];
        if (nloc == 0u) { xcd_barrier_complete(bar, b.x, nloc, nx); b.st[0] = nloc; b.st[1] = nx; }
        const unsigned old = xb_add(&bar[XB_XSUB(b.x)], 1u);
        const unsigned gen = old / nloc;
        if (old + 1u == (gen + 1u) * nloc) {
            __builtin_amdgcn_fence(__ATOMIC_RELEASE, "agent");
            asm volatile("s_waitcnt vmcnt(0)" ::: "memory");
            const unsigned og = xb_add(&bar[XB_TOP], 1u);
            const unsigned tg = og / nx;
            if (og + 1u == (tg + 1u) * nx) xb_add(&bar[XB_TOPGEN], 1u);
            else XB_SPIN(xb_ld(&bar[XB_TOPGEN]) == tg, bar);
            __builtin_amdgcn_fence(__ATOMIC_ACQUIRE, "agent");
            xb_add(&bar[XB_XGEN(b.x)], 1u);
            asm volatile("s_waitcnt vmcnt(0)" ::: "memory");
        } else {
            XB_SPIN(xb_ld(&bar[XB_XGEN(b.x)]) == gen, bar);
            __builtin_amdgcn_fence(__ATOMIC_ACQUIRE, "agent");
            asm volatile("s_waitcnt vmcnt(0)" ::: "memory");
        }
    }
    __syncthreads();
}
struct Frame {
    LAS unsigned char* lds; unsigned* ctl; unsigned char* ws;
    int tid, lane, wave, G, gw, NGW;
};
DI void ph_tables(const Frame& F, const int* pos) {
    float* c48 = (float*)(F.ws + TAB_COS48); float* s48 = (float*)(F.ws + TAB_SIN48); float* c32 = (float*)(F.ws + TAB_COS32); float* s32 = (float*)(F.ws + TAB_SIN32);
    const int gt = blockIdx.x * (NWAVES * 64) + F.tid, NT = F.G * NWAVES * 64;
    for (int i = gt; i < MTOT * 40; i += NT) {
        const int m = i / 40, j = i - m * 40; const float p = (float)pos[m];
        const bool a = j < 24; const int jj = a ? j : j - 24;
        const float inv = (float)exp(-(2.0 * jj / (a ? 48.0 : 32.0)) * 13.122363377404328);
        const float ang = p * inv; float sn, cs; sincosf(ang, &sn, &cs);
        if (a) { c48[m * 24 + jj] = cs; s48[m * 24 + jj] = sn; } else { c32[m * 16 + jj] = cs; s32[m * 16 + jj] = sn; }
    }
}
DI void cvt_load(float (&v)[32], const float* W, int ldw, int col0, int ncols, int item, int nblk, int lane) {
    const int kb = item / nblk, nb = item - kb * nblk, k0 = 64 * kb, n0 = 32 * nb, nn = n0 + (lane & 31); const bool ok = nn < ncols;
    const float* p = W + (size_t)(k0 + (lane >> 5)) * ldw + col0 + (ok ? nn : 0);
#pragma unroll
    for (int i = 0; i < 32; ++i) { const float x = p[(size_t)(2 * i) * ldw]; v[i] = ok ? x : 0.f; }
}
DI void cvt_store(const float (&v)[32], int ncols, bf16* WT, int ldt, int row_off, float scale, LAS float* scr, int item, int nblk, int lane) {
    const int kb = item / nblk, nb = item - kb * nblk, k0 = 64 * kb, n0 = 32 * nb;
#pragma unroll
    for (int i = 0; i < 32; ++i) scr[(2 * i + (lane >> 5)) * 33 + (lane & 31)] = v[i] * scale;
    LDS_WAIT();
    const int c = lane & 7;
#pragma unroll
    for (int j = 0; j < 4; ++j) { const int n = (lane >> 3) + 8 * j; const LAS float* s = scr + (8 * c) * 33 + n;
        u32x4 o; o.x = pk2(s[0 * 33], s[1 * 33]); o.y = pk2(s[2 * 33], s[3 * 33]); o.z = pk2(s[4 * 33], s[5 * 33]); o.w = pk2(s[6 * 33], s[7 * 33]);
        if (n0 + n < ncols) *(u32x4*)(WT + (size_t)(row_off + n0 + n) * ldt + k0 + 8 * c) = o; }
    LDS_WAIT();
}
DI void cvt_item(const float* W, int ldw, int col0, int ncols, bf16* WT, int ldt, int row_off, float scale, LAS float* scr, int item, int nblk, int lane) {
    float v[32]; cvt_load(v, W, ldw, col0, ncols, item, nblk, lane); cvt_store(v, ncols, WT, ldt, row_off, scale, scr, item, nblk, lane);
}
template <class MAP> DI void cvt_loop(const Frame& F, const float* W, int ldw, int ncols, bf16* WT, int ldt, float scale, int nitems, int nblk, const MAP& map) {
    LAS float* scr = (LAS float*)(F.lds + F.wave * 16384);
    int it = F.gw; float cur[32]; int c0 = 0, ro = 0, li = 0;
    if (it < nitems) { map(it, c0, ro, li); cvt_load(cur, W, ldw, c0, ncols, li, nblk, F.lane); }
#pragma unroll 1
    for (; it < nitems; it += F.NGW) {
        float nxt[32]; int c1 = 0, r1 = 0, l1 = 0; const int ni = it + F.NGW;
        if (ni < nitems) { map(ni, c1, r1, l1); cvt_load(nxt, W, ldw, c1, ncols, l1, nblk, F.lane); }
        cvt_store(cur, ncols, WT, ldt, ro, scale, scr, li, nblk, F.lane);
#pragma unroll
        for (int i = 0; i < 32; ++i) cur[i] = nxt[i];
        c0 = c1; ro = r1; li = l1;
    }
}
struct CvtPlain { int col0, row_off; DI void operator()(int it, int& c, int& r, int& l) const { c = col0; r = row_off; l = it; } };
DI void cvt_job(const Frame& F, const float* W, int ldw, int K, int col0, int ncols, bf16* WT, int ldt, int row_off, float scale) {
    const int nblk = (ncols + 31) / 32;
    cvt_loop(F, W, ldw, ncols, WT, ldt, scale, (K / 64) * nblk, nblk, CvtPlain{col0, row_off});
}
DI void zero_bf16(const Frame& F, bf16* p, size_t nelem) {
    const size_t gt = (size_t)blockIdx.x * (NWAVES * 64) + F.tid, NT = (size_t)F.G * NWAVES * 64;
    for (size_t i = gt; i < nelem / 8; i += NT) ((u32x4*)p)[i] = (u32x4){0u, 0u, 0u, 0u};
}
DI void ph_cvt_ffn(const Frame& F, const float* up, const float* down) {
    bf16* WUP = (bf16*)(F.ws + WS_WFFN); bf16* WDN = WUP + (size_t)2 * DFF * DM;
    struct UpMap { DI void operator()(int it, int& c, int& r, int& l) const { const int seg = it >> 7, pn = seg >> 1, isv = seg & 1; c = isv * DFF + pn * 128; r = pn * 256 + isv * 128; l = it & 127; } };
    cvt_loop(F, up, 2 * DFF, 128, WUP, DM, 1.f, 88 * 128, 4, UpMap{});
    cvt_job(F, down, DM, DFF, 0, DM, WDN, DFF, 0, 1.f);
}
DI void ph_conv_fix(const Frame& F, const float* UB, bf16* Gb, const float* cw, const float* cb, const int nrows = MC) {
    const int gt = blockIdx.x * (NWAVES * 64) + F.tid, NT = F.G * NWAVES * 64;
    for (int it = gt; it < (nrows / 256) * (DFF / 4); it += NT) {
        const int pm = it / (DFF / 4), c4 = it - pm * (DFF / 4), ch = c4 * 4, col = (ch >> 7) * 256 + (ch & 127);
        const float* ub = UB + (size_t)pm * 4 * (2 * DFF) + col; const bool has = (pm & 15) != 0;
        const f32x4 z = {0.f, 0.f, 0.f, 0.f};
        const f32x4 g0 = *(const f32x4*)(ub), g1 = *(const f32x4*)(ub + 2 * DFF), v0 = *(const f32x4*)(ub + 128), v1 = *(const f32x4*)(ub + 2 * DFF + 128);
        const f32x4 gm2 = has ? *(const f32x4*)(ub - 2 * (2 * DFF)) : z, gm1 = has ? *(const f32x4*)(ub - (2 * DFF)) : z, vm2 = has ? *(const f32x4*)(ub - 2 * (2 * DFF) + 128) : z, vm1 = has ? *(const f32x4*)(ub - (2 * DFF) + 128) : z;
        const f32x4 w0g = *(const f32x4*)(cw + ch), w1g = *(const f32x4*)(cw + 2 * DFF + ch), w2g = *(const f32x4*)(cw + 4 * DFF + ch), bg = *(const f32x4*)(cb + ch);
        const f32x4 w0v = *(const f32x4*)(cw + DFF + ch), w1v = *(const f32x4*)(cw + 3 * DFF + ch), w2v = *(const f32x4*)(cw + 5 * DFF + ch), bv = *(const f32x4*)(cb + DFF + ch);
        float o0[4], o1[4];
#pragma unroll
        for (int e = 0; e < 4; ++e) {
            const float yg0 = bg[e] + w0g[e] * gm2[e] + w1g[e] * gm1[e] + w2g[e] * g0[e], yv0 = bv[e] + w0v[e] * vm2[e] + w1v[e] * vm1[e] + w2v[e] * v0[e];
            const float yg1 = bg[e] + w0g[e] * gm1[e] + w1g[e] * g0[e] + w2g[e] * g1[e], yv1 = bv[e] + w0v[e] * vm1[e] + w1v[e] * v0[e] + w2v[e] * v1[e];
            o0[e] = yg0 * __builtin_amdgcn_rcpf(1.0f + __builtin_amdgcn_exp2f(-yg0 * LOG2E)) * yv0; o1[e] = yg1 * __builtin_amdgcn_rcpf(1.0f + __builtin_amdgcn_exp2f(-yg1 * LOG2E)) * yv1;
        }
        u32x2 a, b; a.x = pk2(o0[0], o0[1]); a.y = pk2(o0[2], o0[3]); b.x = pk2(o1[0], o1[1]); b.y = pk2(o1[2], o1[3]);
        *(u32x2*)(Gb + (size_t)(pm * 256) * DFF + ch) = a; *(u32x2*)(Gb + (size_t)(pm * 256 + 1) * DFF + ch) = b;
    }
}
DI void ph_norm_first(const Frame& F, const float* src, const float* gain, bf16* XNR, float* ss) {
    f32x4 g[8];
#pragma unroll
    for (int j = 0; j < 8; ++j) g[j] = *(const f32x4*)(gain + 4 * (F.lane + 64 * j));
    for (int m = F.gw; m < MTOT; m += F.NGW) {
        const f32x4* xr = (const f32x4*)(src + (size_t)m * DM) + F.lane;
        f32x4 v[8]; float s2 = 0.f;
#pragma unroll
        for (int j = 0; j < 8; ++j) { v[j] = xr[64 * j]; s2 += (v[j].x * v[j].x + v[j].y * v[j].y) + (v[j].z * v[j].z + v[j].w * v[j].w); }
        s2 = wave_sum(s2);
        if (F.lane < 2) *(f32x4*)(ss + (size_t)m * 8 + 4 * F.lane) = (f32x4){F.lane == 0 ? s2 : 0.f, 0.f, 0.f, 0.f};
        u32x2* o = (u32x2*)(XNR + (size_t)m * DM) + F.lane;
#pragma unroll
        for (int j = 0; j < 8; ++j) { const f32x4 y = v[j] * g[j]; u32x2 w; w.x = pk2(y.x, y.y); w.y = pk2(y.z, y.w); o[64 * j] = w; }
    }
}
DI void ph_final_norm(const Frame& F, const bf16* xn, const float* ss, float* out) {
    for (int m = F.gw; m < MTOT; m += F.NGW) {
        const float rs = pg8::rms_rowscale(ss, m);
        u32x4 v[4];
#pragma unroll
        for (int j = 0; j < 4; ++j) v[j] = *(const u32x4*)(xn + (size_t)m * DM + j * 512 + F.lane * 8);
#pragma unroll
        for (int j = 0; j < 4; ++j) { float* o = out + (size_t)m * DM + j * 512 + F.lane * 8;
            *(f32x4*)o = (f32x4){__builtin_bit_cast(float, v[j].x << 16), __builtin_bit_cast(float, v[j].x & 0xffff0000u), __builtin_bit_cast(float, v[j].y << 16), __builtin_bit_cast(float, v[j].y & 0xffff0000u)} * rs;
            *(f32x4*)(o + 4) = (f32x4){__builtin_bit_cast(float, v[j].z << 16), __builtin_bit_cast(float, v[j].z & 0xffff0000u), __builtin_bit_cast(float, v[j].w << 16), __builtin_bit_cast(float, v[j].w & 0xffff0000u)} * rs; }
    }
}
DI void rope_piece(const bf16* qrow, int p, const float* cs, const float* sn, float (&o)[8]) {
    const bool lo = p < 3; const int pp = lo ? p + 3 : p - 3, i0 = 8 * (lo ? p : p - 3);
    const u32x4 a = *(const u32x4*)(qrow + 8 * p), b = *(const u32x4*)(qrow + 8 * pp);
    const f32x4 c0 = *(const f32x4*)(cs + i0), c1 = *(const f32x4*)(cs + i0 + 4), s0 = *(const f32x4*)(sn + i0), s1 = *(const f32x4*)(sn + i0 + 4);
#pragma unroll
    for (int e = 0; e < 4; ++e) { const float c_l = e < 2 ? c0[2 * e] : c1[2 * e - 4], c_h = e < 2 ? c0[2 * e + 1] : c1[2 * e - 3], s_l = e < 2 ? s0[2 * e] : s1[2 * e - 4], s_h = e < 2 ? s0[2 * e + 1] : s1[2 * e - 3];
        const float al = bflo(a[e]), ah = bfhi(a[e]), bl_ = bflo(b[e]), bh_ = bfhi(b[e]);
        o[2 * e] = lo ? al * c_l - bl_ * s_l : bl_ * s_l + al * c_l; o[2 * e + 1] = lo ? ah * c_h - bh_ * s_h : bh_ * s_h + ah * c_h; }
}
DI bf16x8 rope_frag32(const bf16* qrow, int s, int h, const float* cs, const float* sn) {
    float o[8]; rope_piece(qrow, 2 * s + h, cs, sn, o);
    u32x4 w; w.x = pk2(o[0], o[1]); w.y = pk2(o[2], o[3]); w.z = pk2(o[4], o[5]); w.w = pk2(o[6], o[7]); return __builtin_bit_cast(bf16x8, w);
}
constexpr size_t DA_DIN = 0, DA_CQN = 64 * MiB, DA_LATC = 80 * MiB, DA_KPE = 88 * MiB, DA_KIDX = 90 * MiB, DA_WIDX = 94 * MiB, DA_QL = 96 * MiB, DA_QPE = 352 * MiB, DA_QIDX = 400 * MiB,
                 DA_SEL = 464 * MiB, DA_CNT = 472 * MiB, DA_SC = 474 * MiB, DA_O2 = 474 * MiB;
constexpr size_t DW_W1 = 0, DW_W2 = (size_t)1024 * 2048, DW_WO = DW_W2 + (size_t)11776 * 512, DW_BD = DW_WO + (size_t)2048 * 4096;
constexpr float DSA_QSCALE = 0.07216878364870322f * LOG2E;
constexpr float DSA_WIDX_SCALE = 0.25f * 0.08838834764831845f;

DI void ph_dsa_cvt(const Frame& F, const float* w_in, const float* w_qup, const float* w_uk, const float* w_uv, const float* w_out) {
    bf16* WB = (bf16*)(F.ws + WS_WMIX);
    cvt_job(F, w_in, 960, DM, 0, 960, WB + DW_W1, DM, 0, 1.f);
    zero_bf16(F, WB + DW_W1 + (size_t)960 * DM, (size_t)64 * DM);
    { LAS float* scr = (LAS float*)(F.lds + F.wave * 16384);
      for (int it = F.gw; it < 32 * 16; it += F.NGW) { const int h = it >> 4; cvt_item(w_qup, 8192, h * 192, 48, WB + DW_W2, 512, 8192 + h * 48, DSA_QSCALE, scr, it & 15, 2, F.lane); } }
    cvt_job(F, w_qup, 8192, 512, 6144, 2048, WB + DW_W2, 512, 9728, 1.f);
    __syncthreads();
    {
        LAS float* As = (LAS float*)F.lds; LAS float* Bs = As + 64 * 145;
        for (int u = blockIdx.x; u < 32 * 4 * 8; u += F.G) {
            const int h = u >> 5, r0 = ((u >> 3) & 3) * 64, k0 = (u & 7) * 64;
            for (int i = F.tid; i < 64 * 144; i += NWAVES * 64) { const int row = i / 144, col = i - row * 144;
                As[row * 145 + col] = w_uk[(size_t)(h * 256 + r0) * 144 + i]; Bs[row * 145 + col] = w_qup[(size_t)(k0 + row) * 8192 + h * 192 + 48 + col]; }
            __syncthreads();
            const int r = F.tid & 63, kg = F.tid >> 6; float acc[8];
#pragma unroll
            for (int j = 0; j < 8; ++j) acc[j] = 0.f;
            for (int n = 0; n < 144; ++n) { const float a = As[r * 145 + n];
#pragma unroll
                for (int j = 0; j < 8; ++j) acc[j] += a * Bs[(kg * 8 + j) * 145 + n]; }
            u32x4 o; o.x = pk2(acc[0] * DSA_QSCALE, acc[1] * DSA_QSCALE); o.y = pk2(acc[2] * DSA_QSCALE, acc[3] * DSA_QSCALE); o.z = pk2(acc[4] * DSA_QSCALE, acc[5] * DSA_QSCALE); o.w = pk2(acc[6] * DSA_QSCALE, acc[7] * DSA_QSCALE);
            *(u32x4*)(WB + DW_W2 + (size_t)(h * 256 + r0 + r) * 512 + k0 + kg * 8) = o;
            __syncthreads();
        }
    }
    { LAS float* scr = (LAS float*)(F.lds + F.wave * 16384);
      for (int it = F.gw; it < 32 * 16; it += F.NGW) { const int h = it >> 4; cvt_item(w_uv + (size_t)h * 256 * 128, 128, 0, 128, WB + DW_BD + (h & 1) * 256, 512, h * 128, 1.f, scr, it & 15, 4, F.lane); } }
    { const size_t gt = (size_t)blockIdx.x * (NWAVES * 64) + F.tid, NT = (size_t)F.G * NWAVES * 64;
      for (size_t i = gt; i < (size_t)4096 * 32; i += NT) { const int row = (int)(i >> 5), pc = (int)(i & 31); *(u32x4*)(WB + DW_BD + (size_t)row * 512 + (1 - ((row >> 7) & 1)) * 256 + pc * 8) = (u32x4){0u, 0u, 0u, 0u}; } }
    cvt_job(F, w_out, DM, 4096, 0, DM, WB + DW_WO, 4096, 0, 1.f);
}
DI void ph_dsa_post1(const Frame& F, int half, const float* qn, const float* kvn, const float* lng, const float* lnb) {
    unsigned char* ar = F.ws + WS_AR;
    const float* DIN = (const float*)(ar + DA_DIN); bf16* CQN = (bf16*)(ar + DA_CQN); bf16* LATC = (bf16*)(ar + DA_LATC); bf16* KPE = (bf16*)(ar + DA_KPE); bf16* KIDX = (bf16*)(ar + DA_KIDX); float* WIDX = (float*)(ar + DA_WIDX);
    const float* c48 = (const float*)(F.ws + TAB_COS48); const float* s48 = (const float*)(F.ws + TAB_SIN48); const float* c32 = (const float*)(F.ws + TAB_COS32); const float* s32 = (const float*)(F.ws + TAB_SIN32);
    LAS float* buf = (LAS float*)(F.lds + F.wave * 1024);
    const int lane = F.lane;
    for (int ml = F.gw; ml < MC; ml += F.NGW) {
        const int mg = half * MC + ml;
        const size_t kfb = ((size_t)(ml >> 5) * 8 * 64 + (ml & 31)) * 8;
        const float* row = DIN + (size_t)ml * 1024 + 16 * lane;
        f32x4 v[4]; float ss = 0.f, s1 = 0.f;
#pragma unroll
        for (int j = 0; j < 4; ++j) { v[j] = *(const f32x4*)(row + 4 * j); ss += (v[j].x * v[j].x + v[j].y * v[j].y) + (v[j].z * v[j].z + v[j].w * v[j].w); s1 += (v[j].x + v[j].y) + (v[j].z + v[j].w); }
        const bool isq = lane < 32, iskv = lane >= 32 && lane < 48, ispe = lane >= 48 && lane < 51, isix = lane >= 51 && lane < 59;
        const float ssq = wave_sum(isq ? ss : 0.f), sskv = wave_sum(iskv ? ss : 0.f), mean = wave_sum(isix ? s1 : 0.f) * (1.f / 128.f);
        float d2 = 0.f;
#pragma unroll
        for (int j = 0; j < 4; ++j) { const f32x4 d = v[j] - mean; d2 += (d.x * d.x + d.y * d.y) + (d.z * d.z + d.w * d.w); }
        const float var = wave_sum(isix ? d2 : 0.f) * (1.f / 128.f);
        const float rq = 1.0f / sqrtf(ssq * (1.f / 512.f) + NORM_EPS), rkv = 1.0f / sqrtf(sskv * (1.f / 256.f) + NORM_EPS), rstd = 1.0f / sqrtf(var + NORM_EPS);
        if (isq || iskv) {
            const float* gp = isq ? qn + 16 * lane : kvn + 16 * (lane - 32); const float rs = isq ? rq : rkv;
            bf16* dst = isq ? CQN + (size_t)ml * 512 + 16 * lane : LATC + (size_t)ml * 256 + 16 * (lane - 32);
            u32x4 o[2];
#pragma unroll
            for (int j = 0; j < 4; ++j) { const f32x4 g = *(const f32x4*)(gp + 4 * j); const f32x4 y = v[j] * rs * g; o[j >> 1][(j & 1) * 2] = pk2(y.x, y.y); o[j >> 1][(j & 1) * 2 + 1] = pk2(y.z, y.w); }
            *(u32x4*)dst = o[0]; *(u32x4*)(dst + 8) = o[1];
        } else if (ispe) {
#pragma unroll
            for (int j = 0; j < 4; ++j) *(LAS f32x4*)(buf + (lane - 48) * 16 + 4 * j) = v[j];
        } else if (isix) {
#pragma unroll
            for (int j = 0; j < 4; ++j) { const f32x4 g = *(const f32x4*)(lng + (lane - 51) * 16 + 4 * j), b = *(const f32x4*)(lnb + (lane - 51) * 16 + 4 * j); *(LAS f32x4*)(buf + 48 + (lane - 51) * 16 + 4 * j) = (v[j] - mean) * rstd * g + b; }
        } else if (lane == 59) {
#pragma unroll
            for (int j = 0; j < 4; ++j) *(f32x4*)(WIDX + (size_t)ml * 16 + 4 * j) = v[j] * DSA_WIDX_SCALE;
        }
        LDS_WAIT();
        if (lane < 24) { const float x1 = buf[lane], x2 = buf[24 + lane], c = c48[(size_t)mg * 24 + lane], s = s48[(size_t)mg * 24 + lane];
            KPE[(size_t)ml * 48 + lane] = f2bf(x1 * c - x2 * s); KPE[(size_t)ml * 48 + 24 + lane] = f2bf(x1 * s + x2 * c);
        } else if (lane < 40) { const int i = lane - 24; const float x1 = buf[48 + i], x2 = buf[48 + 16 + i], c = c32[(size_t)mg * 16 + i], s = s32[(size_t)mg * 16 + i];
            KIDX[kfb + (size_t)((i >> 3) * 32) * 8 + (i & 7)] = f2bf(x1 * c - x2 * s); KIDX[kfb + (size_t)(64 + (i >> 3) * 32) * 8 + (i & 7)] = f2bf(x1 * s + x2 * c);
        } else { const int d = 32 + 4 * (lane - 40); const f32x4 y = *(const LAS f32x4*)(buf + 48 + d); u32x2 w; w.x = pk2(y.x, y.y); w.y = pk2(y.z, y.w); *(u32x2*)(KIDX + kfb + (size_t)((d >> 4) * 64 + ((d >> 3) & 1) * 32) * 8 + (d & 7)) = w; }
        LDS_WAIT();
    }
}
DI int wave_iscan_dpp(int v) {
    v += __builtin_amdgcn_update_dpp(0, v, 0x111, 0xf, 0xf, true); v += __builtin_amdgcn_update_dpp(0, v, 0x112, 0xf, 0xf, true);
    v += __builtin_amdgcn_update_dpp(0, v, 0x114, 0xf, 0xf, true); v += __builtin_amdgcn_update_dpp(0, v, 0x118, 0xf, 0xf, true);
    v += __builtin_amdgcn_update_dpp(0, v, 0x142, 0xa, 0xf, false);
    v += __builtin_amdgcn_update_dpp(0, v, 0x143, 0xc, 0xf, false);
    return v;
}
DI int wave_isum_dpp(int v) {
    v += __builtin_amdgcn_update_dpp(0, v, 0x111, 0xf, 0xf, true); v += __builtin_amdgcn_update_dpp(0, v, 0x112, 0xf, 0xf, true);
    v += __builtin_amdgcn_update_dpp(0, v, 0x114, 0xf, 0xf, true); v += __builtin_amdgcn_update_dpp(0, v, 0x118, 0xf, 0xf, true);
    v += __builtin_amdgcn_update_dpp(0, v, 0x142, 0xa, 0xf, false);
    v += __builtin_amdgcn_update_dpp(0, v, 0x143, 0xc, 0xf, false);
    return __builtin_amdgcn_readlane(v, 63);
}
DI unsigned f2sortable(float s) { const unsigned b = __builtin_bit_cast(unsigned, s); return (b & 0x80000000u) ? ~b : (b | 0x80000000u); }
DI void ph_dsa_index(const Frame& F, const int half) {
    const float* c32 = (const float*)(F.ws + TAB_COS32); const float* s32 = (const float*)(F.ws + TAB_SIN32);
    unsigned char* ar = F.ws + WS_AR;
    const bf16* QIDX = (const bf16*)(ar + DA_QIDX); const bf16* KIDX = (const bf16*)(ar + DA_KIDX); const float* WIDX = (const float*)(ar + DA_WIDX);
    unsigned short* SEL = (unsigned short*)(ar + DA_SEL); int* CNT = (int*)(ar + DA_CNT); float* SC = (float*)(ar + DA_SC) + (size_t)F.gw * 16384;
    const int lane = F.lane, r = lane & 31, hf = lane >> 5;
    LAS unsigned char* wl = F.lds + F.wave * 8192 + lane * 16;
    LAS unsigned* hist = (LAS unsigned*)(F.lds + 65536 + F.wave * 1024);
#pragma unroll 1
    for (int tile = blockIdx.x; tile < BPH * 128; tile += F.G) {
        const int j = tile >> 8, c8 = tile & 255, c7 = c8 & 127, bl = (c8 >> 7) * 2 + j, qt = j ? 127 - c7 : c7;
        const int q0 = qt * 32 + 4 * F.wave;
        const int ntile = (q0 + 3) / 32 + 1;
        bf16x8 qa[2][8];
#pragma unroll
        for (int pr = 0; pr < 2; ++pr) {
            const int mrow = bl * SEQ + q0 + 2 * pr + (r >> 4);
#pragma unroll
            for (int s = 0; s < 8; ++s) qa[pr][s] = *(const bf16x8*)(QIDX + (size_t)mrow * 2048 + (r & 15) * 128 + 16 * s + 8 * hf);
            { const float* cs = c32 + ((size_t)half * MC + mrow) * 16 + 8 * hf; const float* sn = s32 + ((size_t)half * MC + mrow) * 16 + 8 * hf;
              const f32x4 c0 = *(const f32x4*)cs, c1 = *(const f32x4*)(cs + 4), s0 = *(const f32x4*)sn, s1 = *(const f32x4*)(sn + 4);
              const u32x4 a = __builtin_bit_cast(u32x4, qa[pr][0]), b = __builtin_bit_cast(u32x4, qa[pr][1]); u32x4 o1, o2;
#pragma unroll
              for (int e = 0; e < 4; ++e) { const float c_l = e < 2 ? c0[2 * e] : c1[2 * e - 4], c_h = e < 2 ? c0[2 * e + 1] : c1[2 * e - 3], s_l = e < 2 ? s0[2 * e] : s1[2 * e - 4], s_h = e < 2 ? s0[2 * e + 1] : s1[2 * e - 3];
                  const float x1l = bflo(a[e]), x1h = bfhi(a[e]), x2l = bflo(b[e]), x2h = bfhi(b[e]);
                  o1[e] = pk2(x1l * c_l - x2l * s_l, x1h * c_h - x2h * s_h); o2[e] = pk2(x1l * s_l + x2l * c_l, x1h * s_h + x2h * c_h); }
              qa[pr][0] = __builtin_bit_cast(bf16x8, o1); qa[pr][1] = __builtin_bit_cast(bf16x8, o2); }
            float wv[2][16];
#pragma unroll
            for (int i = 0; i < 16; ++i) wv[pr][i] = WIDX[(size_t)(bl * SEQ + q0 + 2 * pr + (i >> 3)) * 16 + (i & 3) + 8 * ((i >> 2) & 1) + 4 * hf];
#pragma unroll
            for (int i = 0; i < 16; i += 4) *(LAS f32x4*)(wl + (pr * 4 + (i >> 2)) * 1024) = (f32x4){wv[pr][i], wv[pr][i + 1], wv[pr][i + 2], wv[pr][i + 3]};
        }
        LDS_WAIT();
        {
        bf16x8 kf[8];
        { const bf16* kp = KIDX + ((size_t)(bl * 128) * 8 * 64 + lane) * 8;
#pragma unroll
          for (int s = 0; s < 8; ++s) kf[s] = *(const bf16x8*)(kp + 512 * s); }
#pragma unroll 1
        for (int t = 0; t < ntile; ++t) {
            f32x16 accs[2];
#pragma unroll
            for (int pr = 0; pr < 2; ++pr) {
#pragma unroll
                for (int i = 0; i < 16; ++i) accs[pr][i] = 0.f;
#pragma unroll
                for (int s = 0; s < 8; ++s) accs[pr] = MFMA32(qa[pr][s], kf[s], accs[pr]);
            }
            if (t + 1 < ntile) { const bf16* kp = KIDX + ((size_t)(bl * 128 + t + 1) * 8 * 64 + lane) * 8;
#pragma unroll
                for (int s = 0; s < 8; ++s) kf[s] = *(const bf16x8*)(kp + 512 * s); }
#pragma unroll
            for (int pr = 0; pr < 2; ++pr) {
                const f32x16 acc = accs[pr];
                float wv[2][16];
                { unsigned wa_ = (unsigned)(size_t)wl; asm volatile("" : "+v"(wa_));
#pragma unroll
                  for (int i = 0; i < 16; i += 4) { const f32x4 w4 = *(const LAS f32x4*)((LAS unsigned char*)(size_t)wa_ + (pr * 4 + (i >> 2)) * 1024); wv[pr][i] = w4.x; wv[pr][i + 1] = w4.y; wv[pr][i + 2] = w4.z; wv[pr][i + 3] = w4.w; } }
                float p0 = 0.f, p1 = 0.f;
#pragma unroll
                for (int i = 0; i < 8; ++i) { p0 += wv[pr][i] * fmaxf(acc[i], 0.f); p1 += wv[pr][8 + i] * fmaxf(acc[8 + i], 0.f); }
                const float t0 = p0 + __shfl_xor(p0, 32), t1 = p1 + __shfl_xor(p1, 32);
                SC[(pr * 128 + t) * 64 + lane] = hf ? t1 : t0;
            }
        }
        }
        VM_WAIT();
#pragma unroll 1
        for (int qi = 0; qi < 4; ++qi) {
            const int tq = q0 + qi, pr = qi >> 1, qs = qi & 1;
            unsigned u[64];
            const unsigned* scp = (const unsigned*)(SC + pr * 8192 + hf * 64 + qs * 32 + r);
#pragma unroll
            for (int g8 = 0; g8 < 8; ++g8) {
#pragma unroll
                for (int e = 0; e < 8; ++e) { const int i = 8 * g8 + e; const float s = __builtin_bit_cast(float, __hip_atomic_load(scp + e * 128, __ATOMIC_RELAXED, __HIP_MEMORY_SCOPE_AGENT));
                    u[i] = (2 * i + hf < ntile && 64 * i + lane <= tq) ? f2sortable(s) : 0u; }
                scp += 1024; asm volatile("" : "+v"(scp));
            }
            unsigned prefix = 0u;
            if (tq >= 256) {
#pragma unroll 1
                for (int bit = 31; bit >= 0; --bit) {
                    const unsigned cand = prefix | (1u << bit); int c = 0;
#pragma unroll
                    for (int g8 = 0; g8 < 8; ++g8) { if (g8 * 512 <= tq) {
#pragma unroll
                        for (int e = 0; e < 8; ++e) c += (u[8 * g8 + e] >= cand) ? 1 : 0; } }
                    c = wave_isum_dpp(c);
                    if (c >= 256) prefix = cand;
                    if (c == 256) break;
                }
            }
            const unsigned T = prefix > 1u ? prefix : 1u;
            int nl = 0;
#pragma unroll
            for (int g8 = 0; g8 < 8; ++g8) { if (g8 * 512 <= tq) {
#pragma unroll
                for (int e = 0; e < 8; ++e) nl += (u[8 * g8 + e] >= T) ? 1 : 0; } }
            const int inc = wave_iscan_dpp(nl), base = __builtin_amdgcn_readlane(inc, 63);
            int pos = inc - nl;
            unsigned short* sel = SEL + (size_t)(bl * SEQ + tq) * 256;
#pragma unroll
            for (int g8 = 0; g8 < 8; ++g8) { if (g8 * 512 <= tq) {
#pragma unroll
                for (int e = 0; e < 8; ++e) { const int i = 8 * g8 + e; if (u[i] >= T) { if (pos < 256) sel[pos] = (unsigned short)(64 * i + lane); ++pos; } } } }
            if (lane == 0) CNT[bl * SEQ + tq] = base < 256 ? base : 256;
        }
    }
}
DI int dsa_fsw(int row) { return ((row & 3) << 2) | ((row >> 2) & 3); }
struct DsaPre { u32x4 row[16]; bf16x8 kpe[3]; bf16x8 q[3]; };
DI void dsa_prefetch(DsaPre& P, const bf16* LATC, const bf16* KPE, const bf16* QL, const bf16* QPE, const float* c48, const float* s48, int half, int ml, int selv, int lane, int w) {
    const int bl = ml >> 12, r = lane & 31, h = lane >> 5;
#pragma unroll
    for (int it = 0; it < 16; ++it) { const int ki = __shfl(selv, (lane >> 5) + 2 * it); P.row[it] = *(const u32x4*)(LATC + (size_t)(bl * SEQ + ki) * 256 + (lane & 31) * 8); }
#pragma unroll
    for (int s = 0; s < 3; ++s) P.kpe[s] = *(const bf16x8*)(KPE + (size_t)(bl * SEQ + selv) * 48 + 16 * s + 8 * h);
#pragma unroll
    for (int j = 0; j < 3; ++j) { const int fi = w + 8 * j;
        if (fi < 16) P.q[j] = *(const bf16x8*)(QL + (size_t)ml * 8192 + r * 256 + 16 * fi + 8 * h);
        else if (fi < 19) P.q[j] = rope_frag32(QPE + (size_t)ml * 1536 + r * 48, fi - 16, h, c48 + ((size_t)half * MC + ml) * 24, s48 + ((size_t)half * MC + ml) * 24); }
}
DI void ph_dsa_attn(const Frame& F, const int half) {
    const float* c48 = (const float*)(F.ws + TAB_COS48); const float* s48 = (const float*)(F.ws + TAB_SIN48);
    unsigned char* ar = F.ws + WS_AR;
    bf16* QL = (bf16*)(ar + DA_QL); const bf16* QPE = (const bf16*)(ar + DA_QPE); const bf16* LATC = (const bf16*)(ar + DA_LATC); const bf16* KPE = (const bf16*)(ar + DA_KPE);
    const unsigned short* SEL = (const unsigned short*)(ar + DA_SEL); const int* CNT = (const int*)(ar + DA_CNT);
    const int lane = F.lane, r = lane & 31, h = lane >> 5, w = F.wave;
    LAS unsigned char* IMG = F.lds; LAS unsigned char* QB = F.lds + LDSCTL_OFF + 256; LAS float* MX = (LAS float*)(F.lds + LDSCTL_OFF + 256 + 19456); LAS float* SX = MX + 256;
    const int i16 = lane & 15, tq_ = i16 >> 2, tp_ = i16 & 3, blk = (lane >> 4) & 1;
    int ml = blockIdx.x;
    if (ml >= MC) return;
    DsaPre P;
    int cnt_c = CNT[ml];
    { const int slot = 32 * w + r; const int selv = slot < cnt_c ? (int)SEL[(size_t)ml * 256 + slot] : 0; dsa_prefetch(P, LATC, KPE, QL, QPE, c48, s48, half, ml, selv, lane, w); }
    int cnt_n = 0, selv_n = 0;
    if (ml + F.G < MC) { cnt_n = CNT[ml + F.G]; const int slot = 32 * w + r; selv_n = slot < cnt_n ? (int)SEL[(size_t)(ml + F.G) * 256 + slot] : 0; }
#pragma unroll 1
    for (; ml < MC; ml += F.G) {
        const int cnt = cnt_c, nch = (cnt + 31) >> 5; const bool act = w < nch;
#pragma unroll
        for (int it = 0; it < 16; ++it) { const int rr = (lane >> 5) + 2 * it; *(LAS u32x4*)(IMG + (32 * w + rr) * 512 + (((lane & 31) ^ dsa_fsw(rr)) * 16)) = P.row[it]; }
#pragma unroll
        for (int j = 0; j < 3; ++j) { const int fi = w + 8 * j; if (fi < 19) *(LAS bf16x8*)(QB + fi * 1024 + lane * 16) = P.q[j]; }
        bf16x8 kpe[3];
#pragma unroll
        for (int s = 0; s < 3; ++s) kpe[s] = P.kpe[s];
        LDS_WAIT(); __builtin_amdgcn_s_barrier(); asm volatile("" ::: "memory");
        if (ml + F.G < MC) {
            dsa_prefetch(P, LATC, KPE, QL, QPE, c48, s48, half, ml + F.G, selv_n, lane, w); cnt_c = cnt_n;
            if (ml + 2 * F.G < MC) { cnt_n = CNT[ml + 2 * F.G]; const int slot = 32 * w + r; selv_n = slot < cnt_n ? (int)SEL[(size_t)(ml + 2 * F.G) * 256 + slot] : 0; }
        }
        f32x16 S; float mx = -INFINITY;
#pragma unroll
        for (int i = 0; i < 16; ++i) S[i] = 0.f;
        if (act) {
#pragma unroll
            for (int s = 0; s < 16; ++s) S = MFMA32(*(const LAS bf16x8*)(IMG + (32 * w + r) * 512 + (((2 * s + h) ^ dsa_fsw(r)) * 16)), *(const LAS bf16x8*)(QB + s * 1024 + lane * 16), S);
#pragma unroll
            for (int s = 0; s < 3; ++s) S = MFMA32(kpe[s], *(const LAS bf16x8*)(QB + (16 + s) * 1024 + lane * 16), S);
#pragma unroll
            for (int i = 0; i < 16; ++i) { S[i] = (32 * w + crow(i, h) < cnt) ? S[i] : -INFINITY; mx = fmaxf(mx, S[i]); }
            mx = fmaxf(mx, __shfl_xor(mx, 32));
        }
        if (h == 0) MX[w * 32 + r] = mx;
        LDS_WAIT(); __builtin_amdgcn_s_barrier(); asm volatile("" ::: "memory");
        float M = MX[r];
#pragma unroll
        for (int k = 1; k < 8; ++k) M = fmaxf(M, MX[k * 32 + r]);
        float lsum = 0.f; bf16x8 pf[2] = {(bf16x8){0, 0, 0, 0, 0, 0, 0, 0}, (bf16x8){0, 0, 0, 0, 0, 0, 0, 0}};
        if (act) {
#pragma unroll
            for (int i = 0; i < 16; ++i) { S[i] = __builtin_amdgcn_exp2f(S[i] - M); lsum += S[i]; }
#pragma unroll
            for (int s = 0; s < 2; ++s) { u32x4 t; t.x = pk2(S[8 * s], S[8 * s + 1]); t.y = pk2(S[8 * s + 2], S[8 * s + 3]); t.z = pk2(S[8 * s + 4], S[8 * s + 5]); t.w = pk2(S[8 * s + 6], S[8 * s + 7]); pf[s] = __builtin_bit_cast(bf16x8, t); }
        }
        lsum += __shfl_xor(lsum, 32);
        if (h == 0) SX[w * 32 + r] = lsum;
        *(LAS bf16x8*)(QB + (2 * w) * 1024 + lane * 16) = pf[0]; *(LAS bf16x8*)(QB + (2 * w + 1) * 1024 + lane * 16) = pf[1];
        LDS_WAIT(); __builtin_amdgcn_s_barrier(); asm volatile("" ::: "memory");
        f32x16 O;
#pragma unroll
        for (int i = 0; i < 16; ++i) O[i] = 0.f;
#pragma unroll 2
        for (int ks = 0; ks < 2 * nch; ++ks) {
            const int r0 = 16 * ks + 4 * h + tq_, r1 = r0 + 8, pc = 4 * w + 2 * blk + (tp_ >> 1);
            const s16x4 lo = __builtin_bit_cast(s16x4, __builtin_amdgcn_ds_read_tr16_b64_v4i16((LAS v4i16_t*)(IMG + r0 * 512 + ((pc ^ dsa_fsw(r0)) * 16) + 8 * (tp_ & 1))));
            const s16x4 hi = __builtin_bit_cast(s16x4, __builtin_amdgcn_ds_read_tr16_b64_v4i16((LAS v4i16_t*)(IMG + r1 * 512 + ((pc ^ dsa_fsw(r1)) * 16) + 8 * (tp_ & 1))));
            O = MFMA32(__builtin_shufflevector(lo, hi, 0, 1, 2, 3, 4, 5, 6, 7), *(const LAS bf16x8*)(QB + ks * 1024 + lane * 16), O);
        }
        float l = SX[r];
#pragma unroll
        for (int k = 1; k < 8; ++k) l += SX[k * 32 + r];
        const float linv = 1.0f / l;
        bf16* o = QL + (size_t)ml * 8192 + r * 256 + 32 * w + 4 * h;
#pragma unroll
        for (int g = 0; g < 4; ++g) { u32x2 t; t.x = pk2(O[4 * g] * linv, O[4 * g + 1] * linv); t.y = pk2(O[4 * g + 2] * linv, O[4 * g + 3] * linv); *(u32x2*)(o + 8 * g) = t; }
        LDS_WAIT(); __builtin_amdgcn_s_barrier(); asm volatile("" ::: "memory");
    }
}
template <int NDB, bool RESC = true> DI void softmax_step(f32x16& S, float& m, float& l, f32x16 (&O)[NDB], bf16x8 (&pf)[2]) {
    float mx = fmaxf(S[0], S[1]);
#pragma unroll
    for (int i = 2; i < 16; i += 2) mx = __builtin_fmaxf(mx, __builtin_fmaxf(S[i], S[i + 1]));
    mx = fmaxf(mx, __shfl_xor(mx, 32));
    const float mn = fmaxf(m, mx), ms = (mn == -INFINITY) ? 0.f : mn;
    const float alpha = __builtin_amdgcn_exp2f(m - ms);
    float sum = 0.f;
#pragma unroll
    for (int i = 0; i < 16; ++i) { S[i] = __builtin_amdgcn_exp2f(S[i] - ms); sum += S[i]; }
    l = l * alpha + sum; m = mn;
    if (RESC && __builtin_amdgcn_ballot_w64(alpha != 1.0f) != 0ull) {
#pragma unroll
        for (int db = 0; db < NDB; ++db)
#pragma unroll
            for (int i = 0; i < 16; ++i) O[db][i] *= alpha;
    }
#pragma unroll
    for (int s = 0; s < 2; ++s) { u32x4 w; w.x = pk2(S[8 * s], S[8 * s + 1]); w.y = pk2(S[8 * s + 2], S[8 * s + 3]); w.z = pk2(S[8 * s + 4], S[8 * s + 5]); w.w = pk2(S[8 * s + 6], S[8 * s + 7]); pf[s] = __builtin_bit_cast(bf16x8, w); }
}
template <bool ACC> DI void store_col(bf16* out, const f32x16 (&O)[4], float scale, int h) {
#pragma unroll
    for (int db = 0; db < 4; ++db)
#pragma unroll
        for (int g = 0; g < 4; ++g) { u32x2* p = (u32x2*)(out + db * 32 + 8 * g + 4 * h);
            float a = O[db][4 * g] * scale, b = O[db][4 * g + 1] * scale, c = O[db][4 * g + 2] * scale, d = O[db][4 * g + 3] * scale;
            if (ACC) { const u32x2 o = *p; a += bflo(o.x); b += bfhi(o.x); c += bflo(o.y); d += bfhi(o.y); }
            u32x2 w; w.x = pk2(a, b); w.y = pk2(c, d); *p = w; }
}
template <int NQ> struct TilePre { u32x4 a, b, c; };
template <int NQ, class SRC> DI void tile_fetch(TilePre<NQ>& p, const SRC& src, int T, int tid) {
    const bf16* k = src.k(T); const bf16* v = src.v(T);
    constexpr int NK = NQ * 64;
    p.a = *(const u32x4*)(k + (size_t)tid * 8);
    const int p1 = tid + 512; p.b = (p1 < NK) ? *(const u32x4*)(k + (size_t)p1 * 8) : *(const u32x4*)(v + (size_t)(p1 - NK) * 8);
    if (NQ * 64 + 512 > 1024) { const int p2 = tid + 1024; if (p2 < NK + 512) p.c = *(const u32x4*)(v + (size_t)(p2 - NK) * 8); }
}
template <int NQ> DI void tile_put(const TilePre<NQ>& p, LAS unsigned char* buf, int tid) {
    *(LAS u32x4*)(buf + tid * 16) = p.a; *(LAS u32x4*)(buf + (tid + 512) * 16) = p.b;
    if (NQ * 64 + 512 > 1024) { if (tid + 1024 < NQ * 64 + 512) *(LAS u32x4*)(buf + (tid + 1024) * 16) = p.c; }
}
template <int NQ, bool PV, class SRC, class MK>
DI void attn_run_sh(LAS unsigned char* tl, int tid, int lane, const bf16x8 (&qf)[NQ], f32x16 (&O)[4], float& m, float& l, int TB, int TE, int tb, int te, const SRC& src, const MK& mk) {
    constexpr int TBYTES = (NQ + 8) * 1024;
    if (TB >= TE) return;
    TilePre<NQ> pre;
    tile_fetch<NQ>(pre, src, TB, tid); tile_put<NQ>(pre, tl, tid);
    LDS_WAIT(); __builtin_amdgcn_s_barrier(); asm volatile("" ::: "memory");
#pragma unroll 1
    for (int T = TB; T < TE; ++T) {
        LAS unsigned char* cur = tl + ((T - TB) & 1) * TBYTES;
        if (T + 1 < TE) tile_fetch<NQ>(pre, src, T + 1, tid);
        if (T >= tb && T < te) {
            f32x16 S;
#pragma unroll
            for (int i = 0; i < 16; ++i) S[i] = 0.f;
#pragma unroll
            for (int s = 0; s < NQ; ++s) S = MFMA32(*(const LAS bf16x8*)(cur + s * 1024 + lane * 16), qf[s], S);
            if (mk.need(T)) mk(T, S);
            bf16x8 pf[2]; softmax_step<4, PV>(S, m, l, O, pf);
            if (PV) {
#pragma unroll
                for (int db = 0; db < 4; ++db)
#pragma unroll
                    for (int s = 0; s < 2; ++s) O[db] = MFMA32(*(const LAS bf16x8*)(cur + (NQ + db * 2 + s) * 1024 + lane * 16), pf[s], O[db]);
            }
        }
        if (T + 1 < TE) tile_put<NQ>(pre, tl + ((T + 1 - TB) & 1) * TBYTES, tid);
        LDS_WAIT(); __builtin_amdgcn_s_barrier(); asm volatile("" ::: "memory");
    }
}
#define ATTN_QK(dst, kptr) do { _Pragma("unroll") for (int i_ = 0; i_ < 16; ++i_) dst[i_] = 0.f; \
    _Pragma("unroll") for (int s_ = 0; s_ < NQ; ++s_) dst = MFMA32(*(const LAS bf16x8*)((kptr) + s_ * 1024 + lane * 16), qf[s_], dst); } while (0)
#define ATTN_SMPV(T_) do { if (mk.need(T_)) mk(T_, S); bf16x8 pf[2]; softmax_step<4, true>(S, m, l, O, pf); \
    _Pragma("unroll") for (int db_ = 0; db_ < 4; ++db_) _Pragma("unroll") for (int s_ = 0; s_ < 2; ++s_) O[db_] = MFMA32(*(const LAS bf16x8*)(vc + (db_ * 2 + s_) * 1024 + lane * 16), pf[s_], O[db_]); } while (0)
template <int NQ, class SRC, class MK>
DI void attn_run_p(LAS unsigned char* tl, int tid, int lane, const bf16x8 (&qf)[NQ], f32x16 (&O)[4], float& m, float& l, int TB, int TE, int tb, int te, const SRC& src, const MK& mk) {
    constexpr int KB = NQ * 1024, NK = NQ * 64;
    if (TB >= TE) return;
    LAS unsigned char* kbuf = tl; LAS unsigned char* vbuf = tl + 2 * KB;
    const int wid = __builtin_amdgcn_readfirstlane(tid >> 6);
#define ATTN_STAGE_K(T_, kd) do { const bf16* k_ = src.k(T_); __builtin_amdgcn_global_load_lds((const unsigned*)(k_ + (size_t)tid * 8), (LAS unsigned*)((kd) + wid * 1024), 16, 0, 0); \
        if (wid * 64 + 512 < NK) __builtin_amdgcn_global_load_lds((const unsigned*)(k_ + (size_t)(tid + 512) * 8), (LAS unsigned*)((kd) + 8192 + wid * 1024), 16, 0, 0); } while (0)
#define ATTN_STAGE_V(T_, vd) __builtin_amdgcn_global_load_lds((const unsigned*)(src.v(T_) + (size_t)tid * 8), (LAS unsigned*)((vd) + wid * 1024), 16, 0, 0)
#define ATTN_SYNC() do { asm volatile("s_waitcnt vmcnt(0) lgkmcnt(0)" ::: "memory"); __builtin_amdgcn_s_barrier(); asm volatile("" ::: "memory"); } while (0)
    ATTN_STAGE_K(TB, kbuf);
    ATTN_SYNC();
    f32x16 Sn;
    {
        if (TB + 1 < TE) ATTN_STAGE_K(TB + 1, kbuf + KB);
        ATTN_STAGE_V(TB, vbuf);
        if (TB >= tb && TB < te) ATTN_QK(Sn, kbuf);
        ATTN_SYNC();
    }
#pragma unroll 1
    for (int T = TB; T < TE; ++T) {
        const int i = T - TB;
        const LAS unsigned char* kn = kbuf + ((i + 1) & 1) * KB;
        const LAS unsigned char* vc = vbuf + (i & 1) * 8192;
        if (T + 2 < TE) ATTN_STAGE_K(T + 2, kbuf + (i & 1) * KB);
        if (T + 1 < TE) ATTN_STAGE_V(T + 1, vbuf + ((i + 1) & 1) * 8192);
        const bool own = T >= tb && T < te, nxt = T + 1 >= tb && T + 1 < te;
        if (own && nxt) { f32x16 S = Sn; ATTN_QK(Sn, kn); ATTN_SMPV(T); }
        else if (own) { f32x16 S = Sn; ATTN_SMPV(T); }
        else if (nxt) { ATTN_QK(Sn, kn); }
        ATTN_SYNC();
    }
}
struct FragSrc { const bf16* kb; const bf16* vb; int nq; DI const bf16* k(int T) const { return kb + (size_t)T * nq * 512; } DI const bf16* v(int T) const { return vb + (size_t)T * 8 * 512; } };
constexpr size_t FA_Q = 0, FA_K = 64 * MiB, FA_F = 128 * MiB, FA_V = 136 * MiB, FA_CUM = 200 * MiB, FA_O = 202 * MiB, FA_KF = 266 * MiB, FA_VF = 338 * MiB;
constexpr size_t FW_IN = 0, FW_OUT = (size_t)6400 * 2048;
constexpr float FOX_QSCALE = 0.08838834764831845f * LOG2E;
DI void ph_fox_cvt(const Frame& F, const float* w_in, const float* w_out) {
    bf16* WB = (bf16*)(F.ws + WS_WMIX);
    cvt_job(F, w_in, 6160, DM, 0, 2048, WB + FW_IN, DM, 0, FOX_QSCALE);
    cvt_job(F, w_in, 6160, DM, 2048, 2048, WB + FW_IN, DM, 2048, 1.f);
    cvt_job(F, w_in, 6160, DM, 4096, 2048, WB + FW_IN, DM, 4352, 1.f);
    cvt_job(F, w_in, 6160, DM, 6144, 16, WB + FW_IN, DM, 4096, 1.f);
    zero_bf16(F, WB + FW_IN + (size_t)4112 * DM, (size_t)240 * DM);
    cvt_job(F, w_out, DM, DM, 0, DM, WB + FW_OUT, DM, 0, 1.f);
}
DI void ph_fox_scan(const Frame& F, const float* b_f) {
    unsigned char* ar = F.ws + WS_AR; const bf16* FB = (const bf16*)(ar + FA_F); float* CUM = (float*)(ar + FA_CUM);
    for (int w = F.gw; w < BPH * 16; w += F.NGW) {
        const int bl = w >> 4, hd = w & 15; const float bf_ = b_f[hd];
        float v[64]; float run = 0.f;
#pragma unroll
        for (int i = 0; i < 64; ++i) { const float x = bf2f(FB[(size_t)(bl * SEQ + F.lane * 64 + i) * 256 + hd]) + bf_;
            const float ls = fminf(x, 0.f) - log1pf(expf(-fabsf(x))); run += ls; v[i] = run; }
        float inc = run;
#pragma unroll
        for (int o = 1; o < 64; o <<= 1) { const float y = __shfl_up(inc, o); if (F.lane >= o) inc += y; }
        const float base = inc - run;
        float* dst = CUM + (size_t)w * SEQ + F.lane * 64;
#pragma unroll
        for (int i = 0; i < 64; i += 4) *(f32x4*)(dst + i) = (f32x4){(v[i] + base) * LOG2E, (v[i + 1] + base) * LOG2E, (v[i + 2] + base) * LOG2E, (v[i + 3] + base) * LOG2E};
        bf16* KF9 = (bf16*)(ar + FA_KF) + (size_t)w * 128 * 9 * 512;
#pragma unroll
        for (int i = 0; i < 64; ++i) { const int p = F.lane * 64 + i, tile = p >> 5, r_ = p & 31; const float c = (v[i] + base) * LOG2E;
            const unsigned short hi = f2bf(c); const float c1 = c - bf2f(hi); const unsigned short mid = f2bf(c1); const unsigned short lo = f2bf(c1 - bf2f(mid));
            u32x4 wv; wv.x = 0x3F803F80u; wv.y = 0x3F80u | ((unsigned)(hi ^ 0x8000u) << 16); wv.z = (unsigned)(mid ^ 0x8000u) | ((unsigned)(lo ^ 0x8000u) << 16); wv.w = 0u;
            bf16* d = KF9 + ((size_t)(tile * 9 + 8) * 64 + r_) * 8;
            *(u32x4*)d = wv; *(u32x4*)(d + 32 * 8) = (u32x4){0u, 0u, 0u, 0u}; }
    }
}
struct FoxMK { int tq, h, qt; DI bool need(int t) const { return t == qt; }
    DI void operator()(int t, f32x16& S) const {
#pragma unroll
        for (int i = 0; i < 16; ++i) S[i] = (32 * t + crow(i, h) <= tq) ? S[i] : -INFINITY;
    } };
DI void ph_fox_attn(const Frame& F) {
    unsigned char* ar = F.ws + WS_AR; const bf16* Q = (const bf16*)(ar + FA_Q); const bf16* KF = (const bf16*)(ar + FA_KF); const bf16* VF = (const bf16*)(ar + FA_VF); const float* CUM = (const float*)(ar + FA_CUM); bf16* Ob = (bf16*)(ar + FA_O);
    const int r = F.lane & 31, h = F.lane >> 5;
    for (int wb = blockIdx.x; wb < BPH * 16 * 4; wb += F.G) {
        const int bh = wb >> 2, x = (wb & 3) * 8 + F.wave, bl = bh >> 4, hd = bh & 15;
#pragma unroll 1
        for (int k = 0; k < 4; ++k) {
            const int qt = (k == 0) ? x : (k == 1) ? 63 - x : (k == 2) ? 64 + x : 127 - x;
            const int qhi = (k == 0) ? (wb & 3) * 8 + 7 : (k == 1) ? 63 - (wb & 3) * 8 : (k == 2) ? 64 + (wb & 3) * 8 + 7 : 127 - (wb & 3) * 8;
            const int tq = qt * 32 + r; const size_t mrow = (size_t)bl * SEQ + tq;
            bf16x8 qf[9];
#pragma unroll
            for (int s = 0; s < 8; ++s) qf[s] = *(const bf16x8*)(Q + mrow * DM + hd * 128 + 16 * s + 8 * h);
            { const float ct = CUM[(size_t)bh * SEQ + tq]; const unsigned short hi = f2bf(ct); const float c1 = ct - bf2f(hi); const unsigned short mid = f2bf(c1); const unsigned short lo = f2bf(c1 - bf2f(mid));
              u32x4 wq; wq.x = (unsigned)hi | ((unsigned)mid << 16); wq.y = (unsigned)lo | (0x3F80u << 16); wq.z = 0x3F803F80u; wq.w = 0u;
              if (h) wq = (u32x4){0u, 0u, 0u, 0u};
              qf[8] = __builtin_bit_cast(bf16x8, wq); }
            f32x16 O[4];
#pragma unroll
            for (int db = 0; db < 4; ++db)
#pragma unroll
                for (int i = 0; i < 16; ++i) O[db][i] = 0.f;
            float m = -INFINITY, l = 0.f;
            const FragSrc src{KF + (size_t)bh * 128 * 9 * 512, VF + (size_t)bh * 128 * 8 * 512, 9}; const FoxMK mk{tq, h, qt};
            attn_run_p<9>(F.lds, F.tid, F.lane, qf, O, m, l, 0, qhi + 1, 0, qt + 1, src, mk);
            l += __shfl_xor(l, 32);
            store_col<false>(Ob + mrow * DM + hd * 128, O, l > 0.f ? 1.0f / l : 0.f, h);
        }
    }
}
typedef long fp8x8_t;
DI fp8x8_t pack_fp8x8(float a0, float a1, float a2, float a3, float a4, float a5, float a6, float a7) {
    int lo = 0, hi = 0;
    lo = __builtin_amdgcn_cvt_pk_fp8_f32(a0, a1, lo, false); lo = __builtin_amdgcn_cvt_pk_fp8_f32(a2, a3, lo, true);
    hi = __builtin_amdgcn_cvt_pk_fp8_f32(a4, a5, hi, false); hi = __builtin_amdgcn_cvt_pk_fp8_f32(a6, a7, hi, true);
    return (fp8x8_t)(((unsigned long long)(unsigned)hi << 32) | (unsigned long long)(unsigned)lo);
}
#define MFMA32F8(a, b, c) __builtin_amdgcn_mfma_f32_32x32x16_fp8_fp8((a), (b), (c), 0, 0, 0)
constexpr size_t NA_Q = 0, NA_KC = 288 * MiB, NA_VC = 313 * MiB, NA_KSR = 330 * MiB, NA_KWR = 354 * MiB, NA_GT = 378 * MiB, NA_VSR = 386 * MiB, NA_VWR = 402 * MiB, NA_GK = 418 * MiB, NA_GV = 420 * MiB,
                 NA_KCMP = 422 * MiB, NA_VCT = 424 * MiB, NA_SELB = 426 * MiB, NA_O = 428 * MiB,
                 NA_KSF = 620 * MiB, NA_KWF = 644 * MiB, NA_VSF = 668 * MiB, NA_VWF = 684 * MiB;
constexpr size_t NW_IN = 0, NW_W1K = (size_t)13312 * 2048, NW_W1V = NW_W1K + (size_t)256 * 6144, NW_W2K = NW_W1V + (size_t)256 * 4096, NW_W2V = NW_W2K + 65536, NW_OUT = NW_W2V + 65536;
constexpr float NSA_QSCALE = 0.07216878364870322f * LOG2E;
DI void ph_nsa_cvt(const Frame& F, const float* w_in, const float* k_pe, const float* k_w1, const float* k_b1, const float* k_w2, const float* v_pe, const float* v_w1, const float* v_b1, const float* v_w2, const float* w_out) {
    bf16* WB = (bf16*)(F.ws + WS_WMIX); float* BIAS = (float*)(F.ws + WS_MISC);
    cvt_job(F, w_in, 13200, DM, 0, 9216, WB + NW_IN, DM, 0, NSA_QSCALE);
    cvt_job(F, w_in, 13200, DM, 9216, 768, WB + NW_IN, DM, 9216, 1.f);
    cvt_job(F, w_in, 13200, DM, 9984, 512, WB + NW_IN, DM, 9984, 1.f);
    cvt_job(F, w_in, 13200, DM, 10496, 768, WB + NW_IN, DM, 10496, 1.f);
    cvt_job(F, w_in, 13200, DM, 11776, 768, WB + NW_IN, DM, 11264, 1.f);
    cvt_job(F, w_in, 13200, DM, 13056, 144, WB + NW_IN, DM, 12032, 1.f);
    zero_bf16(F, WB + NW_IN + (size_t)12176 * DM, (size_t)112 * DM);
    cvt_job(F, w_in, 13200, DM, 11264, 512, WB + NW_IN, DM, 12288, 1.f);
    cvt_job(F, w_in, 13200, DM, 12544, 512, WB + NW_IN, DM, 12800, 1.f);
    cvt_job(F, k_w1, 256, 6144, 0, 256, WB + NW_W1K, 6144, 0, 1.f);
    cvt_job(F, v_w1, 256, 4096, 0, 256, WB + NW_W1V, 4096, 0, 1.f);
    cvt_job(F, k_w2, 192, 256, 0, 192, WB + NW_W2K, 256, 0, 1.f); zero_bf16(F, WB + NW_W2K + 192 * 256, 64 * 256);
    cvt_job(F, v_w2, 128, 256, 0, 128, WB + NW_W2V, 256, 0, 1.f); zero_bf16(F, WB + NW_W2V + 128 * 256, 128 * 256);
    cvt_job(F, w_out, DM, 6144, 0, DM, WB + NW_OUT, 6144, 0, 1.f);
    for (int w = F.gw; w < 512; w += F.NGW) { const bool isk = w < 256; const int c = w & 255, n = isk ? 6144 : 4096; const float* pe = isk ? k_pe : v_pe; const float* w1 = isk ? k_w1 : v_w1;
        float s = 0.f; for (int i = F.lane; i < n; i += 64) s += pe[i] * w1[(size_t)i * 256 + c];
        s = wave_sum(s); if (F.lane == 0) BIAS[w] = s + (isk ? k_b1[c] : v_b1[c]); }
}
DI void ph_nsa_rope(const Frame& F, int half) {
    unsigned char* ar = F.ws + WS_AR; bf16* Q = (bf16*)(ar + NA_Q); bf16* KC = (bf16*)(ar + NA_KC);
    const bf16* KSR = (const bf16*)(ar + NA_KSR); const bf16* KWR = (const bf16*)(ar + NA_KWR); bf16* KSF = (bf16*)(ar + NA_KSF); bf16* KWF = (bf16*)(ar + NA_KWF);
    const float* c48 = (const float*)(F.ws + TAB_COS48); const float* s48 = (const float*)(F.ws + TAB_SIN48);
    for (int ml = F.gw; ml < MC; ml += F.NGW) {
        const size_t mg = (size_t)half * MC + ml; const int bl = ml >> 12, sq = ml & 4095;
        for (int p = F.lane; p < 96; p += 64) {
            const int hd = 48 + p / 24, i = p - (p / 24) * 24; bf16* q;
            q = KC + ((size_t)(bl * 4 + hd - 48) * 4096 + sq) * 192 + i;
            const float x1 = bf2f(q[0]), x2 = bf2f(q[24]), c = c48[mg * 24 + i], s = s48[mg * 24 + i]; q[0] = f2bf(x1 * c - x2 * s); q[24] = f2bf(x1 * s + x2 * c);
        }
        const int tile = sq >> 5, rr = sq & 31;
        for (int u = F.lane; u < 168; u += 64) {
            const int tens = u / 84, uu = u - tens * 84, g = uu / 21, v = uu - g * 21;
            const bf16* src = (tens ? KWR : KSR) + (size_t)ml * 768 + g * 192;
            bf16* dst = (tens ? KWF : KSF) + ((size_t)((bl * 4 + g) * 128 + tile) * 12 * 64 + rr) * 8;
            if (v < 3) {
                const u32x4 a = *(const u32x4*)(src + 8 * v), b = *(const u32x4*)(src + 8 * v + 24); u32x4 o1, o2;
#pragma unroll
                for (int e = 0; e < 4; ++e) { const float c0 = c48[mg * 24 + 8 * v + 2 * e], s0 = s48[mg * 24 + 8 * v + 2 * e], c1 = c48[mg * 24 + 8 * v + 2 * e + 1], s1 = s48[mg * 24 + 8 * v + 2 * e + 1];
                    const float x1l = bflo(a[e]), x1h = bfhi(a[e]), x2l = bflo(b[e]), x2h = bfhi(b[e]);
                    o1[e] = pk2(x1l * c0 - x2l * s0, x1h * c1 - x2h * s1); o2[e] = pk2(x1l * s0 + x2l * c0, x1h * s1 + x2h * c1); }
                const int p1 = v, p2 = v + 3;
                if (tens) { *(u32x4*)(dst + ((p1 >> 1) * 64 + (p1 & 1) * 32) * 8) = o1; *(u32x4*)(dst + ((p2 >> 1) * 64 + (p2 & 1) * 32) * 8) = o2; }
                else { unsigned char* d8 = (unsigned char*)KSF + ((size_t)(((bl * 4 + g) * 128 + tile) * 2 + (rr >> 4)) * 6 * 64 + (rr & 15)) * 8;
                    *(fp8x8_t*)(d8 + ((p1 >> 2) * 64 + (p1 & 3) * 16) * 8) = pack_fp8x8(bflo(o1[0]), bfhi(o1[0]), bflo(o1[1]), bfhi(o1[1]), bflo(o1[2]), bfhi(o1[2]), bflo(o1[3]), bfhi(o1[3]));
                    *(fp8x8_t*)(d8 + ((p2 >> 2) * 64 + (p2 & 3) * 16) * 8) = pack_fp8x8(bflo(o2[0]), bfhi(o2[0]), bflo(o2[1]), bfhi(o2[1]), bflo(o2[2]), bfhi(o2[2]), bflo(o2[3]), bfhi(o2[3])); }
            } else { const int pc = v + 3; const u32x4 c = *(const u32x4*)(src + 8 * pc);
                if (tens) *(u32x4*)(dst + ((pc >> 1) * 64 + (pc & 1) * 32) * 8) = c;
                else { unsigned char* d8 = (unsigned char*)KSF + ((size_t)(((bl * 4 + g) * 128 + tile) * 2 + (rr >> 4)) * 6 * 64 + (rr & 15)) * 8;
                    *(fp8x8_t*)(d8 + ((pc >> 2) * 64 + (pc & 3) * 16) * 8) = pack_fp8x8(bflo(c[0]), bfhi(c[0]), bflo(c[1]), bfhi(c[1]), bflo(c[2]), bfhi(c[2]), bflo(c[3]), bfhi(c[3])); } }
        }
    }
}
DI float sigmoidf_(float x) { return __builtin_amdgcn_rcpf(1.0f + __builtin_amdgcn_exp2f(-x * LOG2E)); }
struct CmpMK { int tq, h, q0; DI bool need(int t) const { return 512 * t + 527 > q0; }
    DI void operator()(int t, f32x16& S) const {
#pragma unroll
    for (int i = 0; i < 16; ++i) { const int n = 32 * t + crow(i, h); S[i] = (16 * n + 31 <= tq) ? S[i] : -INFINITY; } } };
struct WinMK { int tq, h, qt; DI bool need(int t) const { return t == qt || t == qt - 16; }
    DI void operator()(int t, f32x16& S) const {
#pragma unroll
    for (int i = 0; i < 16; ++i) { const int k = 32 * t + crow(i, h); S[i] = (k <= tq && k > tq - 512) ? S[i] : -INFINITY; } } };
DI void ph_nsa_cmp(const Frame& F, const int half) {
    const float* c48 = (const float*)(F.ws + TAB_COS48); const float* s48 = (const float*)(F.ws + TAB_SIN48);
    unsigned char* ar = F.ws + WS_AR; const bf16* Q = (const bf16*)(ar + NA_Q); const bf16* KCMP = (const bf16*)(ar + NA_KCMP); const bf16* VCT = (const bf16*)(ar + NA_VCT); const bf16* GT = (const bf16*)(ar + NA_GT);
    unsigned char* SELB = ar + NA_SELB; bf16* Ob = (bf16*)(ar + NA_O);
    LAS float* imp = (LAS float*)F.lds;
    LAS unsigned char* kres = F.lds + 20480;
    LAS unsigned char* vring = F.lds + 20480 + 98304;
    const int lane = F.lane, r = lane & 31, h = lane >> 5, tid = F.tid;
    for (int u = blockIdx.x; u < BPH * 4 * 64; u += F.G) {
        const int bg = u >> 6, qt64 = ((u >> 8) & 1) ? 63 - (u & 63) : (u & 63), bl = bg >> 2, g = bg & 3;
        const int tqmaxb = qt64 * 64 + 63, TE = (tqmaxb >= 31) ? ((tqmaxb - 31) / 16) / 32 + 1 : 0;
        const bf16* ksrc = KCMP + (size_t)bg * 8 * 12 * 512; const bf16* vsrc = VCT + (size_t)bg * 8 * 8 * 512;
        for (int i = F.tid; i < 64 * 65; i += NWAVES * 64) imp[i] = 0.f;
        for (int p = tid; p < TE * 768; p += NWAVES * 64) *(LAS u32x4*)(kres + p * 16) = *(const u32x4*)(ksrc + (size_t)p * 8);
        __syncthreads();
#pragma unroll 1
        for (int k = 0; k < 3; ++k) {
            const int idx = F.wave * 3 + k, j = idx >> 1, sub = idx & 1, ql = sub * 32 + r, tq = qt64 * 64 + ql, hd = g * 12 + j;
            const size_t mrow = (size_t)bl * SEQ + tq;
            bf16x8 qf[12];
#pragma unroll
            for (int s = 3; s < 12; ++s) qf[s] = *(const bf16x8*)(Q + mrow * 9216 + hd * 192 + 16 * s + 8 * h);
            { const float* cs = c48 + ((size_t)half * MC + mrow) * 24; const float* sn = s48 + ((size_t)half * MC + mrow) * 24;
#pragma unroll
              for (int s = 0; s < 3; ++s) qf[s] = rope_frag32(Q + mrow * 9216 + hd * 192, s, h, cs, sn); }
            const int tqmax = qt64 * 64 + sub * 32 + 31, te = (tqmax >= 31) ? ((tqmax - 31) / 16) / 32 + 1 : 0;
            const CmpMK mk{tq, h, qt64 * 64 + sub * 32};
            float m = -INFINITY, l = 0.f;
            {
                f32x16 Od[4];
#pragma unroll 1
                for (int t = 0; t < te; ++t) {
                    const LAS unsigned char* cur = kres + t * 12288;
                    f32x16 S;
#pragma unroll
                    for (int i = 0; i < 16; ++i) S[i] = 0.f;
#pragma unroll
                    for (int s = 0; s < 12; ++s) S = MFMA32(*(const LAS bf16x8*)(cur + s * 1024 + lane * 16), qf[s], S);
                    if (mk.need(t)) mk(t, S);
                    bf16x8 pfd[2]; softmax_step<4, false>(S, m, l, Od, pfd);
                }
            }
            l += __shfl_xor(l, 32);
            const float linv = l > 0.f ? 1.0f / l : 0.f, ms = (m == -INFINITY) ? 0.f : m;
            f32x16 O[4];
#pragma unroll
            for (int db = 0; db < 4; ++db)
#pragma unroll
                for (int i = 0; i < 16; ++i) O[db][i] = 0.f;
            if (TE > 0) {
                u32x4 pv = *(const u32x4*)(vsrc + (size_t)tid * 8);
                *(LAS u32x4*)(vring + tid * 16) = pv;
                LDS_WAIT(); __builtin_amdgcn_s_barrier(); asm volatile("" ::: "memory");
#pragma unroll 1
                for (int t = 0; t < TE; ++t) {
                    const LAS unsigned char* cur = kres + t * 12288; const LAS unsigned char* vcur = vring + (t & 1) * 8192;
                    if (t + 1 < TE) pv = *(const u32x4*)(vsrc + ((size_t)(t + 1) * 512 + tid) * 8);
                    if (t < te) {
                        f32x16 S;
#pragma unroll
                        for (int i = 0; i < 16; ++i) S[i] = 0.f;
#pragma unroll
                        for (int s = 0; s < 12; ++s) S = MFMA32(*(const LAS bf16x8*)(cur + s * 1024 + lane * 16), qf[s], S);
                        if (mk.need(t)) mk(t, S);
#pragma unroll
                        for (int i = 0; i < 16; ++i) S[i] = __builtin_amdgcn_exp2f(S[i] - ms) * linv;
#pragma unroll
                        for (int g4 = 0; g4 < 4; ++g4) { const float gs = (S[4 * g4] + S[4 * g4 + 1]) + (S[4 * g4 + 2] + S[4 * g4 + 3]); const int mb = 8 * t + 2 * g4 + h;
                            __hip_atomic_fetch_add(imp + ql * 65 + mb, gs, __ATOMIC_RELAXED, __HIP_MEMORY_SCOPE_WORKGROUP);
                            if (mb + 1 < 64) __hip_atomic_fetch_add(imp + ql * 65 + mb + 1, S[4 * g4 + 3], __ATOMIC_RELAXED, __HIP_MEMORY_SCOPE_WORKGROUP); }
                        bf16x8 pf[2];
#pragma unroll
                        for (int s = 0; s < 2; ++s) { u32x4 w; w.x = pk2(S[8 * s], S[8 * s + 1]); w.y = pk2(S[8 * s + 2], S[8 * s + 3]); w.z = pk2(S[8 * s + 4], S[8 * s + 5]); w.w = pk2(S[8 * s + 6], S[8 * s + 7]); pf[s] = __builtin_bit_cast(bf16x8, w); }
#pragma unroll
                        for (int db = 0; db < 4; ++db)
#pragma unroll
                            for (int s = 0; s < 2; ++s) O[db] = MFMA32(*(const LAS bf16x8*)(vcur + (db * 2 + s) * 1024 + lane * 16), pf[s], O[db]);
                    }
                    if (t + 1 < TE) *(LAS u32x4*)(vring + ((t + 1) & 1) * 8192 + tid * 16) = pv;
                    LDS_WAIT(); __builtin_amdgcn_s_barrier(); asm volatile("" ::: "memory");
                }
            }
            const float gate = sigmoidf_(bf2f(GT[mrow * 256 + hd]));
            store_col<false>(Ob + mrow * 6144 + hd * 128, O, gate, h);
        }
        __syncthreads();
#pragma unroll 1
        for (int k = 0; k < 8; ++k) {
            const int ql = F.wave * 8 + k, tq = qt64 * 64 + ql, cur = tq >> 6, mb = lane;
            const bool causal = mb <= cur, forced = (mb == 0) || (mb == cur) || (mb == cur - 1);
            const float v = causal ? (forced ? INFINITY : imp[ql * 65 + mb]) : -INFINITY;
            int rank = 0;
            for (int o = 0; o < 64; ++o) { const float vo = __shfl(v, o); rank += (vo > v || (vo == v && o < mb)) ? 1 : 0; }
            if (rank < 16) SELB[((size_t)bg * 4096 + tq) * 16 + rank] = causal ? (unsigned char)mb : (unsigned char)0xFF;
        }
        __syncthreads();
    }
}
DI int sel_tile(const u32x4& sel, int t) { const int b = t >> 1; const unsigned w = (b < 4) ? sel.x : (b < 8) ? sel.y : (b < 12) ? sel.z : sel.w; return (int)((w >> ((b & 3) * 8)) & 0xFFu) * 2 + (t & 1); }
struct SelMK { u32x4 sel; int tq, h; DI void operator()(int t, f32x16& S) const { const int k0 = sel_tile(sel, t) * 32;
#pragma unroll
    for (int i = 0; i < 16; ++i) S[i] = (k0 + crow(i, h) <= tq) ? S[i] : -INFINITY; } };
typedef float f32x4_ __attribute__((ext_vector_type(4)));
#define MFMA16F8(a, b, c) __builtin_amdgcn_mfma_f32_16x16x32_fp8_fp8((a), (b), (c), 0, 0, 0)
DI void ph_nsa_sel(const Frame& F, const int half) {
    const float* c48 = (const float*)(F.ws + TAB_COS48); const float* s48 = (const float*)(F.ws + TAB_SIN48);
    unsigned char* ar = F.ws + WS_AR; const bf16* Q = (const bf16*)(ar + NA_Q); const unsigned char* KS8 = ar + NA_KSF; const unsigned char* VS8 = ar + NA_VSF; const bf16* GT = (const bf16*)(ar + NA_GT);
    const unsigned char* SELB = ar + NA_SELB; bf16* Ob = (bf16*)(ar + NA_O);
    const int c16 = F.lane & 15, kq = F.lane >> 4; const bool act = c16 < 12;
    for (int it = F.gw; it < BPH * 4 * SEQ; it += F.NGW) {
        const int bg = it >> 12, tq = ((it & 4095) + 256 * bg) & 4095, bl = bg >> 2, g = bg & 3; const size_t mrow = (size_t)bl * SEQ + tq; const int hd = g * 12 + (act ? c16 : 0);
        fp8x8_t qf[6];
#pragma unroll
        for (int s = 0; s < 6; ++s) { const float qs = act ? (1.0f / NSA_QSCALE) : 0.f; const int p = 4 * s + kq;
            if (s < 2 && p < 6) { float o[8]; rope_piece(Q + mrow * 9216 + hd * 192, p, c48 + ((size_t)half * MC + mrow) * 24, s48 + ((size_t)half * MC + mrow) * 24, o);
                qf[s] = pack_fp8x8(o[0] * qs, o[1] * qs, o[2] * qs, o[3] * qs, o[4] * qs, o[5] * qs, o[6] * qs, o[7] * qs); }
            else { const u32x4 q = *(const u32x4*)(Q + mrow * 9216 + hd * 192 + 32 * s + 8 * kq);
                qf[s] = pack_fp8x8(bflo(q[0]) * qs, bfhi(q[0]) * qs, bflo(q[1]) * qs, bfhi(q[1]) * qs, bflo(q[2]) * qs, bfhi(q[2]) * qs, bflo(q[3]) * qs, bfhi(q[3]) * qs); } }
        const u32x4 sel = *(const u32x4*)(SELB + ((size_t)bg * 4096 + tq) * 16);
        const int nv = ((tq >> 6) + 1 < 16) ? (tq >> 6) + 1 : 16, te = 2 * nv;
        const unsigned char* kb = KS8 + ((size_t)bg * 128 * 12 * 64 + F.lane) * 8; const unsigned char* vb = VS8 + ((size_t)bg * 128 * 8 * 64 + F.lane) * 8;
        f32x4_ O[8];
#pragma unroll
        for (int db = 0; db < 8; ++db) O[db] = (f32x4_){0.f, 0.f, 0.f, 0.f};
        float m = -INFINITY, l = 0.f;
        fp8x8_t kfA[12], kfB[12], vfA[8], vfB[8];
        { const unsigned char* kp = kb + (size_t)sel_tile(sel, 0) * 12 * 512; const unsigned char* kp1 = kb + (size_t)sel_tile(sel, 1) * 12 * 512; const unsigned char* vp = vb + (size_t)sel_tile(sel, 0) * 8 * 512;
#pragma unroll
          for (int s = 0; s < 12; ++s) { kfA[s] = *(const fp8x8_t*)(kp + s * 512); kfB[s] = *(const fp8x8_t*)(kp1 + s * 512); }
#pragma unroll
          for (int j = 0; j < 8; ++j) vfA[j] = *(const fp8x8_t*)(vp + j * 512); }
#define SEL_STEP(T_, KF_, VF_, VFN_) do { const int t_ = (T_); const int tile = sel_tile(sel, t_); \
            if (t_ + 1 < te) { const unsigned char* vp = vb + (size_t)sel_tile(sel, t_ + 1) * 8 * 512; _Pragma("unroll") for (int j = 0; j < 8; ++j) VFN_[j] = *(const fp8x8_t*)(vp + j * 512); } \
            f32x4_ S0 = {0.f, 0.f, 0.f, 0.f}, S1 = S0; \
            _Pragma("unroll") for (int s = 0; s < 6; ++s) { S0 = MFMA16F8(KF_[s], qf[s], S0); S1 = MFMA16F8(KF_[6 + s], qf[s], S1); } \
            if (t_ + 2 < te) { const unsigned char* kp = kb + (size_t)sel_tile(sel, t_ + 2) * 12 * 512; _Pragma("unroll") for (int s = 0; s < 12; ++s) KF_[s] = *(const fp8x8_t*)(kp + s * 512); } \
            const int k0 = tile * 32 + 4 * kq; float mx = -INFINITY; \
            _Pragma("unroll") for (int i = 0; i < 4; ++i) { S0[i] = (k0 + i <= tq) ? S0[i] * NSA_QSCALE : -INFINITY; S1[i] = (k0 + 16 + i <= tq) ? S1[i] * NSA_QSCALE : -INFINITY; mx = fmaxf(mx, fmaxf(S0[i], S1[i])); } \
            mx = fmaxf(mx, __shfl_xor(mx, 16)); mx = fmaxf(mx, __shfl_xor(mx, 32)); \
            const float mn = fmaxf(m, mx), ms = (mn == -INFINITY) ? 0.f : mn, alpha = __builtin_amdgcn_exp2f(m - ms); \
            float sum = 0.f; \
            _Pragma("unroll") for (int i = 0; i < 4; ++i) { S0[i] = __builtin_amdgcn_exp2f(S0[i] - ms); S1[i] = __builtin_amdgcn_exp2f(S1[i] - ms); sum += S0[i] + S1[i]; } \
            l = l * alpha + sum; m = mn; \
            if (__builtin_amdgcn_ballot_w64(alpha != 1.0f) != 0ull) { _Pragma("unroll") for (int db = 0; db < 8; ++db) O[db] = O[db] * alpha; } \
            const fp8x8_t p8 = pack_fp8x8(S0[0], S0[1], S0[2], S0[3], S1[0], S1[1], S1[2], S1[3]);       \
            _Pragma("unroll") for (int db = 0; db < 8; ++db) O[db] = MFMA16F8(VF_[db], p8, O[db]); } while (0)
#pragma unroll 1
        for (int t = 0; t < te; t += 2) { SEL_STEP(t, kfA, vfA, vfB); SEL_STEP(t + 1, kfB, vfB, vfA); }
#undef SEL_STEP
        l += __shfl_xor(l, 16); l += __shfl_xor(l, 32);
        if (act) { const float gate = sigmoidf_(bf2f(GT[mrow * 256 + 48 + hd])); const float sc = l > 0.f ? gate / l : 0.f;
            bf16* o = Ob + mrow * 6144 + hd * 128 + 4 * kq;
#pragma unroll
            for (int db = 0; db < 8; ++db) { u32x2* p = (u32x2*)(o + db * 16); const u32x2 prev = *p;
                u32x2 w; w.x = pk2(O[db][0] * sc + bflo(prev.x), O[db][1] * sc + bfhi(prev.x)); w.y = pk2(O[db][2] * sc + bflo(prev.y), O[db][3] * sc + bfhi(prev.y)); *p = w; } }
    }
}
DI void ph_nsa_win(const Frame& F, const int half) {
    const float* c48 = (const float*)(F.ws + TAB_COS48); const float* s48 = (const float*)(F.ws + TAB_SIN48);
    unsigned char* ar = F.ws + WS_AR; const bf16* Q = (const bf16*)(ar + NA_Q); const bf16* KWF = (const bf16*)(ar + NA_KWF); const bf16* VWF = (const bf16*)(ar + NA_VWF); const bf16* GT = (const bf16*)(ar + NA_GT); bf16* Ob = (bf16*)(ar + NA_O);
    const int r = F.lane & 31, h = F.lane >> 5;
    for (int idb = blockIdx.x; idb < BPH * 4 * 3 * 64; idb += F.G) {
        const int qt0 = (((idb & 63) + (idb >> 8)) & 63) * 2, qt = qt0 + (F.wave & 1), rest = idb >> 6, hq = rest % 3, bg = rest / 3, bl = bg >> 2, g = bg & 3, hd = g * 12 + hq * 4 + (F.wave >> 1), tq = qt * 32 + r; const size_t mrow = (size_t)bl * SEQ + tq;
        bf16x8 qf[12];
#pragma unroll
        for (int s = 3; s < 12; ++s) qf[s] = *(const bf16x8*)(Q + mrow * 9216 + hd * 192 + 16 * s + 8 * h);
        { const float* cs = c48 + ((size_t)half * MC + mrow) * 24; const float* sn = s48 + ((size_t)half * MC + mrow) * 24;
#pragma unroll
          for (int s = 0; s < 3; ++s) qf[s] = rope_frag32(Q + mrow * 9216 + hd * 192, s, h, cs, sn); }
        const FragSrc src{KWF + (size_t)bg * 128 * 12 * 512, VWF + (size_t)bg * 128 * 8 * 512, 12}; const WinMK mk{tq, h, qt};
        f32x16 O[4];
#pragma unroll
        for (int db = 0; db < 4; ++db)
#pragma unroll
            for (int i = 0; i < 16; ++i) O[db][i] = 0.f;
        float m = -INFINITY, l = 0.f;
        attn_run_sh<12, true>(F.lds, F.tid, F.lane, qf, O, m, l, qt0 >= 16 ? qt0 - 16 : 0, qt0 + 2, qt >= 16 ? qt - 16 : 0, qt + 1, src, mk);
        l += __shfl_xor(l, 32);
        const float gate = sigmoidf_(bf2f(GT[mrow * 256 + 96 + hd]));
        store_col<true>(Ob + mrow * 6144 + hd * 128, O, l > 0.f ? gate / l : 0.f, h);
    }
}
#ifndef MK_ONE_LAUNCH
#define MK_ONE_LAUNCH 1
#endif
constexpr int NPH = 69;
struct Args { const float* in[58]; float* out; unsigned char* ws; int ph_lo, ph_hi; };
#define GEMM_AKOFF 0
#define GEMM_CALL(EpiT, Evar, Aptr, Bptr, Mv, Nv, Kv, ldav, ldbv, cidx) do { const pg8::Gemm g_{(const pg8::bf16_t*)(Aptr), (const pg8::bf16_t*)(Bptr), (Mv), (Nv), (Kv), (ldav), (ldbv), GEMM_AKOFF}; \
    pg8::StaticOrder S_; S_.init((Mv), (Nv), F.G, (cidx)); pg8::gemm_phase<EpiT, pg8::StaticOrder, true, true>((PG8_LAS unsigned char*)F.lds, g_, S_, Evar); } while (0)
DI pg8::EpiBf16R epi1(bf16* base, int ldc) { pg8::EpiBf16R e; for (int s = 0; s < 8; ++s) { e.T.base[s] = base; e.T.ldc[s] = ldc; e.T.t0[s] = 0; e.T.gw[s] = 0; } e.T.nseg = 1; e.T.pad_ = 0; e.ssp = nullptr; e.ss_off = 0; return e; }
#define PH_BEGIN if (ph >= lo && ph < hi) { Frame F; { unsigned long long w_ = (unsigned long long)args.ws; asm volatile("" : "+s"(w_)); F.ws = (unsigned char*)w_; F.ctl = (unsigned*)(F.ws + WS_CTL); } \
    F.lds = lds; F.tid = threadIdx.x; F.lane = F.tid & 63; F.wave = __builtin_amdgcn_readfirstlane(F.tid >> 6); F.G = gridDim.x; F.gw = blockIdx.x * NWAVES + F.wave; F.NGW = F.G * NWAVES; \
    float* out; { unsigned long long o_ = (unsigned long long)args.out; asm volatile("" : "+s"(o_)); out = (float*)o_; } \
    unsigned char* const ar = F.ws + WS_AR; bf16* const XN = (bf16*)(F.ws + WS_XNR); float* const SSB = (float*)(F.ws + WS_SS); bf16* const WB = (bf16*)(F.ws + WS_WMIX); bf16* const WUP = (bf16*)(F.ws + WS_WFFN); bf16* const WDN = WUP + (size_t)2 * DFF * DM; \
    const float* const res_mix = (ib == 2) ? args.in[0] : (const float*)out; (void)ar; (void)XN; (void)SSB; (void)WB; (void)WUP; (void)WDN; (void)res_mix; (void)iff;
#define PH_END   if (ph + 1 < hi) { XcdBarrier b_; b_.bar = (unsigned*)F.ctl + CW_BAR; b_.x = xb_xcc_id(); b_.st = MISC + 8; xcd_barrier(b_); } } ++ph;
template <int LAYER> DI void run_cvt(const Args& args, LAS unsigned char* lds, volatile LAS unsigned* MISC, int& ph, const int lo, const int hi) {
    constexpr int ib = (LAYER == 0) ? 2 : (LAYER == 1) ? 17 : (LAYER == 2) ? 26 : 42;
    constexpr int iff = (LAYER == 0) ? 12 : (LAYER == 1) ? 21 : (LAYER == 2) ? 37 : 52;
    constexpr int kind = (LAYER == 1) ? 1 : (LAYER == 2) ? 2 : 0;
        PH_BEGIN
            if constexpr (LAYER == 0) { ph_tables(F, (const int*)args.in[1]); ph_norm_first(F, args.in[0], args.in[2], XN, SSB); }
            if constexpr (kind == 0) ph_dsa_cvt(F, args.in[ib + 1], args.in[ib + 6], args.in[ib + 7], args.in[ib + 8], args.in[ib + 9]);
            else if constexpr (kind == 1) ph_fox_cvt(F, args.in[ib + 1], args.in[ib + 3]);
            else ph_nsa_cvt(F, args.in[ib + 1], args.in[ib + 2], args.in[ib + 3], args.in[ib + 4], args.in[ib + 5], args.in[ib + 6], args.in[ib + 7], args.in[ib + 8], args.in[ib + 9], args.in[ib + 10]);
            ph_cvt_ffn(F, args.in[iff + 1], args.in[iff + 4]);
        PH_END
}
template <int LAYER, int HALF> DI void run_half(const Args& args, LAS unsigned char* lds, volatile LAS unsigned* MISC, int& ph, const int lo, const int hi) {
    constexpr int ib = (LAYER == 0) ? 2 : (LAYER == 1) ? 17 : (LAYER == 2) ? 26 : 42;
    constexpr int iff = (LAYER == 0) ? 12 : (LAYER == 1) ? 21 : (LAYER == 2) ? 37 : 52;
    constexpr int kind = (LAYER == 1) ? 1 : (LAYER == 2) ? 2 : 0;
    constexpr int half = HALF;
            const int roff = half * MC;
            if constexpr (kind == 0) {
                PH_BEGIN { pg8::EpiF32 E{(float*)(ar + DA_DIN), 1024, SSB + (size_t)(LAYER * 2) * MTOT * 8, roff}; GEMM_CALL(pg8::EpiF32, E, XN + (size_t)roff * DM, WB + DW_W1, MC, 1024, DM, DM, DM, (int)blockIdx.x); } PH_END
                PH_BEGIN ph_dsa_post1(F, half, args.in[ib + 2], args.in[ib + 3], args.in[ib + 4], args.in[ib + 5]); PH_END
                PH_BEGIN { pg8::EpiBf16R E = epi1((bf16*)(ar + DA_QL), 8192); E.T.base[1] = (bf16*)(ar + DA_QPE); E.T.ldc[1] = 1536; E.T.t0[1] = 32; E.T.base[2] = (bf16*)(ar + DA_QIDX); E.T.ldc[2] = 2048; E.T.t0[2] = 38; E.T.nseg = 3;
                    GEMM_CALL(pg8::EpiBf16R, E, ar + DA_CQN, WB + DW_W2, MC, 11776, 512, 512, 512, (int)blockIdx.x); } PH_END
                PH_BEGIN ph_dsa_index(F, half); PH_END
                PH_BEGIN ph_dsa_attn(F, half); PH_END
                PH_BEGIN {
                    pg8::EpiBf16R E = epi1((bf16*)(ar + DA_O2), 4096);
                    { const pg8::Gemm g_{(const pg8::bf16_t*)(ar + DA_QL), (const pg8::bf16_t*)(WB + DW_BD), MC, 4096, 512, 8192, 512, 512}; pg8::StaticOrder S_; S_.init(MC, 4096, F.G, (int)blockIdx.x);
                      pg8::gemm_phase<pg8::EpiBf16R, pg8::StaticOrder, true, true>((PG8_LAS unsigned char*)F.lds, g_, S_, E); } } PH_END
                PH_BEGIN { pg8::EpiResN E{LAYER == 0 ? args.in[0] : nullptr, args.in[ib], nullptr, DM, roff, args.in[iff], (pg8::bf16_t*)XN, SSB + (size_t)(LAYER * 2 + 1) * MTOT * 8, (PG8_LAS float*)(F.lds + LDSCTL_OFF + 256)}; GEMM_CALL(pg8::EpiResN, E, ar + DA_O2, WB + DW_WO, MC, DM, 4096, 4096, 4096, (int)blockIdx.x); } PH_END
            } else if constexpr (kind == 1) {
                PH_BEGIN {
                    { pg8::EpiBf16R E = epi1((bf16*)(ar + FA_Q), DM); E.T.base[1] = (bf16*)(ar + FA_KF); E.T.ldc[1] = 9; E.T.t0[1] = 8; E.T.gw[1] = -3;
                      E.T.base[2] = (bf16*)(ar + FA_F); E.T.ldc[2] = 256; E.T.t0[2] = 16; E.T.nseg = 3; E.ssp = SSB + (size_t)(LAYER * 2) * MTOT * 8; E.ss_off = roff;
                      GEMM_CALL(pg8::EpiBf16R, E, XN + (size_t)roff * DM, WB + FW_IN, MC, 4352, DM, DM, DM, (int)blockIdx.x); }
                    { pg8::EpiBf16R E = epi1((bf16*)(ar + FA_VF), 16); E.T.gw[0] = -4; E.ssp = SSB + (size_t)(LAYER * 2) * MTOT * 8; E.ss_off = roff;
                      GEMM_CALL(pg8::EpiBf16R, E, WB + FW_IN + (size_t)4352 * DM, XN + (size_t)roff * DM, DM, MC, DM, DM, DM, (int)((blockIdx.x + F.G - 64) % F.G)); }
                } PH_END
                PH_BEGIN ph_fox_scan(F, args.in[ib + 2]); PH_END
                PH_BEGIN ph_fox_attn(F); PH_END
                PH_BEGIN { pg8::EpiResN E{LAYER == 0 ? args.in[0] : nullptr, args.in[ib], nullptr, DM, roff, args.in[iff], (pg8::bf16_t*)XN, SSB + (size_t)(LAYER * 2 + 1) * MTOT * 8, (PG8_LAS float*)(F.lds + LDSCTL_OFF + 256)}; GEMM_CALL(pg8::EpiResN, E, ar + FA_O, WB + FW_OUT, MC, DM, DM, DM, DM, (int)blockIdx.x); } PH_END
            } else {
                PH_BEGIN { pg8::EpiBf16R E = epi1((bf16*)(ar + NA_Q), 9216);
                    E.T.base[1] = (bf16*)(ar + NA_KC); E.T.ldc[1] = 192; E.T.t0[1] = 36; E.T.gw[1] = 192;
                    E.T.base[2] = (bf16*)(ar + NA_VC); E.T.ldc[2] = 128; E.T.t0[2] = 39; E.T.gw[2] = 128;
                    E.T.base[3] = (bf16*)(ar + NA_KSR); E.T.ldc[3] = 768; E.T.t0[3] = 41;
                    E.T.base[4] = (bf16*)(ar + NA_KWR); E.T.ldc[4] = 768; E.T.t0[4] = 44;
                    E.T.base[5] = (bf16*)(ar + NA_GT); E.T.ldc[5] = 256; E.T.t0[5] = 47; E.T.nseg = 6; E.ssp = SSB + (size_t)(LAYER * 2) * MTOT * 8; E.ss_off = roff;
                    GEMM_CALL(pg8::EpiBf16R, E, XN + (size_t)roff * DM, WB + NW_IN, MC, 12288, DM, DM, DM, (int)blockIdx.x);
                    { pg8::EpiBf16R E2 = epi1((bf16*)(ar + NA_VSF), 4); E2.T.gw[0] = -5; E2.ssp = E.ssp; E2.ss_off = roff;
                      GEMM_CALL(pg8::EpiBf16R, E2, WB + NW_IN + (size_t)12288 * DM, XN + (size_t)roff * DM, 512, MC, DM, DM, DM, (int)blockIdx.x); }
                    { pg8::EpiBf16R E2 = epi1((bf16*)(ar + NA_VWF), 4); E2.T.gw[0] = -4; E2.ssp = E.ssp; E2.ss_off = roff;
                      GEMM_CALL(pg8::EpiBf16R, E2, WB + NW_IN + (size_t)12800 * DM, XN + (size_t)roff * DM, 512, MC, DM, DM, DM, (int)((blockIdx.x + F.G - 128) % F.G)); } } PH_END
                PH_BEGIN ph_nsa_rope(F, half); PH_END
                PH_BEGIN {
                    const float* BIAS = (const float*)(args.ws + WS_MISC);
                    { pg8::EpiGelu E{(bf16*)(ar + NA_GK), 256, BIAS}; GEMM_CALL(pg8::EpiGelu, E, ar + NA_KC, WB + NW_W1K, 4096, 256, 6144, 3072, 6144, (int)blockIdx.x); }
                    { pg8::EpiGelu E{(bf16*)(ar + NA_GV), 256, BIAS + 256}; GEMM_CALL(pg8::EpiGelu, E, ar + NA_VC, WB + NW_W1V, 4096, 256, 4096, 2048, 4096, (int)((blockIdx.x + F.G - 16) % F.G)); }
                } PH_END
                PH_BEGIN {
                    { pg8::EpiBf16R E = epi1((bf16*)(ar + NA_KCMP), 12); E.T.gw[0] = -1; GEMM_CALL(pg8::EpiBf16R, E, ar + NA_GK, WB + NW_W2K, 4096, 256, 256, 256, 256, (int)blockIdx.x); }
                    { pg8::EpiBf16R E = epi1((bf16*)(ar + NA_VCT), 4); E.T.gw[0] = -2; GEMM_CALL(pg8::EpiBf16R, E, WB + NW_W2V, ar + NA_GV, 256, 4096, 256, 256, 256, (int)((blockIdx.x + F.G - 16) % F.G)); }
                } PH_END
                PH_BEGIN ph_nsa_cmp(F, half); PH_END
                PH_BEGIN ph_nsa_sel(F, half); PH_END
                PH_BEGIN ph_nsa_win(F, half); PH_END
                PH_BEGIN { pg8::EpiResN E{LAYER == 0 ? args.in[0] : nullptr, args.in[ib], nullptr, DM, roff, args.in[iff], (pg8::bf16_t*)XN, SSB + (size_t)(LAYER * 2 + 1) * MTOT * 8, (PG8_LAS float*)(F.lds + LDSCTL_OFF + 256)}; GEMM_CALL(pg8::EpiResN, E, ar + NA_O, WB + NW_OUT, MC, DM, 6144, 6144, 6144, (int)blockIdx.x); } PH_END
            }
}
template <int LAYER> DI void run_ffn(const Args& args, LAS unsigned char* lds, volatile LAS unsigned* MISC, int& ph, const int lo, const int hi) {
    constexpr int ib = (LAYER == 0) ? 2 : (LAYER == 1) ? 17 : (LAYER == 2) ? 26 : 42;
    constexpr int iff = (LAYER == 0) ? 12 : (LAYER == 1) ? 21 : (LAYER == 2) ? 37 : 52;
    PH_BEGIN {
        LAS float* rt = (LAS float*)(F.lds + LDSCTL_OFF + 256 + 8192); const int rbase = 4096 * (int)(blockIdx.x & 7); const float* ssq = SSB + (size_t)(LAYER * 2 + 1) * MTOT * 8;
        for (int i = F.tid; i < 4096; i += NWAVES * 64) rt[i] = pg8::rms_rowscale(ssq, rbase + i);
        __syncthreads();
        pg8::EpiConvGlu E{(pg8::bf16_t*)ar, (float*)(ar + 352 * MiB), args.in[iff + 2], args.in[iff + 3], (PG8_LAS float*)(F.lds + LDSCTL_OFF + 256), DFF, (const PG8_LAS float*)rt, rbase};
        GEMM_CALL(pg8::EpiConvGlu, E, XN, WUP, MTOT, 2 * DFF, DM, DM, DM, (int)blockIdx.x); } PH_END
    PH_BEGIN ph_conv_fix(F, (const float*)(ar + 352 * MiB), (bf16*)ar, args.in[iff + 2], args.in[iff + 3], MTOT); PH_END
    PH_BEGIN {
        if constexpr (LAYER < 3) { constexpr int ibn = (LAYER == 0) ? 17 : (LAYER == 1) ? 26 : 42;
            pg8::EpiResN E{nullptr, args.in[iff], nullptr, DM, 0, args.in[ibn], (pg8::bf16_t*)XN, SSB + (size_t)((LAYER + 1) * 2) * MTOT * 8, (PG8_LAS float*)(F.lds + LDSCTL_OFF + 256)}; GEMM_CALL(pg8::EpiResN, E, ar, WDN, MTOT, DM, DFF, DFF, DFF, (int)blockIdx.x); }
        else { pg8::EpiResN E{nullptr, args.in[iff], nullptr, DM, 0, args.in[57], (pg8::bf16_t*)XN, SSB, (PG8_LAS float*)(F.lds + LDSCTL_OFF + 256)}; GEMM_CALL(pg8::EpiResN, E, ar, WDN, MTOT, DM, DFF, DFF, DFF, (int)blockIdx.x); }
    } PH_END
}
__global__ void __launch_bounds__(NWAVES * 64, 2) mk_fwd(Args args) {
    extern __shared__ __attribute__((aligned(16))) unsigned char lds_[];
    LAS unsigned char* const lds = (LAS unsigned char*)lds_;
    volatile LAS unsigned* MISC = (volatile LAS unsigned*)(lds + LDSCTL_OFF);
    for (int u = threadIdx.x; u < 64; u += NWAVES * 64) ((LAS unsigned*)(lds + LDSCTL_OFF))[u] = 0u;
    __syncthreads();
    const int lo = args.ph_lo, hi = args.ph_hi;
    (void)xcd_barrier_post((unsigned*)(args.ws + WS_CTL) + CW_BAR, MISC + 8);
    int ph = 0;
    run_cvt<0>(args, lds, MISC, ph, lo, hi); run_half<0, 0>(args, lds, MISC, ph, lo, hi); run_half<0, 1>(args, lds, MISC, ph, lo, hi); run_ffn<0>(args, lds, MISC, ph, lo, hi);
    run_cvt<1>(args, lds, MISC, ph, lo, hi); run_half<1, 0>(args, lds, MISC, ph, lo, hi); run_half<1, 1>(args, lds, MISC, ph, lo, hi); run_ffn<1>(args, lds, MISC, ph, lo, hi);
    run_cvt<2>(args, lds, MISC, ph, lo, hi); run_half<2, 0>(args, lds, MISC, ph, lo, hi); run_half<2, 1>(args, lds, MISC, ph, lo, hi); run_ffn<2>(args, lds, MISC, ph, lo, hi);
    run_cvt<3>(args, lds, MISC, ph, lo, hi); run_half<3, 0>(args, lds, MISC, ph, lo, hi); run_half<3, 1>(args, lds, MISC, ph, lo, hi); run_ffn<3>(args, lds, MISC, ph, lo, hi);
    { constexpr int ib = 42, iff = 52; PH_BEGIN ph_final_norm(F, (const bf16*)XN, SSB, out); PH_END }
}
extern "C" void kernel_launch(void* const* d_in, const int* in_sizes, int n_in, void* d_out, int out_size, void* d_ws, size_t ws_size, hipStream_t stream) {
    static int grid = 0;
    if (grid == 0) {
        if (n_in != 58 || out_size != MTOT * DM || ws_size < WS_END) { fprintf(stderr, "kernel_launch: unexpected shapes (n_in %d, out %d, ws %zu)\n", n_in, out_size, ws_size); grid = -1; return; }
        int dev = 0, cus = 0;
        if (hipGetDevice(&dev) != hipSuccess || hipDeviceGetAttribute(&cus, hipDeviceAttributeMultiprocessorCount, dev) != hipSuccess) { grid = -1; return; }
        if (hipFuncSetAttribute((const void*)mk_fwd, hipFuncAttributeMaxDynamicSharedMemorySize, LDS_BYTES) != hipSuccess) { fprintf(stderr, "kernel_launch: hipFuncSetAttribute failed\n"); grid = -1; return; }
        int per_cu = 0;
        (void)hipOccupancyMaxActiveBlocksPerMultiprocessor(&per_cu, (const void*)mk_fwd, NWAVES * 64, LDS_BYTES);
        (void)hipGetLastError();
        grid = cus;
    }
    if (grid < 0) return;
    if (hipMemsetAsync((char*)d_ws + WS_CTL, 0, CTL_ZERO_BYTES, stream) != hipSuccess) return;
    Args a{};
    for (int i = 0; i < 58; ++i) a.in[i] = (const float*)d_in[i];
    a.out = (float*)d_out; a.ws = (unsigned char*)d_ws;
#if MK_ONE_LAUNCH
    a.ph_lo = 0; a.ph_hi = NPH;
    hipLaunchKernelGGL(mk_fwd, dim3(grid), dim3(NWAVES * 64), LDS_BYTES, stream, a);
#else
    for (int p = 0; p < NPH; ++p) { a.ph_lo = p; a.ph_hi = p + 1; hipLaunchKernelGGL(mk_fwd, dim3(grid), dim3(NWAVES * 64), LDS_BYTES, stream, a); }
#endif
}
```

```cpp
#include <hip/hip_runtime.h>
#include <cstdio>
#include <cstdint>
#define DI __device__ __forceinline__
namespace pg8 {
#define PG8_LAS __attribute__((address_space(3)))
typedef unsigned short bf16_t;
typedef short bf16x8 __attribute__((ext_vector_type(8)));
typedef float f32x4 __attribute__((ext_vector_type(4)));
typedef unsigned u32x4 __attribute__((ext_vector_type(4)));
constexpr int BM = 256, BK = 64, HALF = 128, HTB = HALF * BK * 2  , STAGE_BYTES = 8 * HTB, NXCD = 8, WGM = 8;

__host__ __device__ __forceinline__ int lds_byte(int r, int c) { const int st = (r >> 4) * 2 + (c >> 5), rr = r & 15, cc = c & 31, ob = rr * 64 + cc * 2; return st * 1024 + (ob ^ (((ob >> 9) & 1) << 5)); }
__host__ __device__ __forceinline__ void stage_rc(int b, int& R, int& C) { const int st = b / 1024, sb = b % 1024, swz = sb ^ (((sb >> 9) & 1) << 5); R = (st >> 1) * 16 + swz / 64; C = (st & 1) * 32 + (swz % 64) / 2; }
__host__ __device__ __forceinline__ int perm32(int rho) { const int n = rho >> 4, i = rho & 15; return 8 * (i >> 2) + 4 * n + (i & 3); }

struct Unit { int pm, pn; };
struct Gemm { const bf16_t* A; const bf16_t* Bt; int M, N, K, lda, ldb, akoff; };

struct StaticOrder {
    int nM, nN, nwg, G, c;
    __host__ __device__ void init(int M, int N, int G_, int c_) { nM = M / BM; nN = N / BM; nwg = nM * nN; G = G_; c = c_; }
    __host__ __device__ bool next(int i, Unit& u) const {
        const long L = (long)i * G + c; if (L >= nwg) return false;
        int wgid = (int)L; { const int q = nwg / NXCD, r = nwg % NXCD, xcd = wgid % NXCD, off = wgid / NXCD; wgid = (xcd < r ? xcd * (q + 1) : r * (q + 1) + (xcd - r) * q) + off; }
        const int nig = WGM * nN, gid = wgid / nig, fm = gid * WGM, gsz = (nM - fm) < WGM ? (nM - fm) : WGM;
        u.pm = fm + ((wgid % nig) % gsz); u.pn = (wgid % nig) / gsz; return true;
    }
    __device__ __forceinline__ void a_ready(const Unit&) const {}
    __device__ __forceinline__ void done(const Unit&) const {}
};
__device__ __forceinline__ unsigned cvt_pk_bf16(float lo, float hi) { unsigned r; asm volatile("v_cvt_pk_bf16_f32 %0, %1, %2" : "=v"(r) : "v"(lo), "v"(hi)); return r; }
template <class Epi, class Sched, bool ALIGN_EPI = false, bool SP2 = false>
__device__ __forceinline__ void gemm_phase(PG8_LAS unsigned char* lds, const Gemm g, const Sched& S, const Epi& E) {
    const int tid = threadIdx.x, wid = __builtin_amdgcn_readfirstlane(tid >> 6), lane = tid & 63, wr = wid >> 2, wc = wid & 3, fr = lane & 15, fq = lane >> 4;
    const int K = g.K, nt = K / BK;
    unsigned voffA[2], voffB[2];
#pragma unroll
    for (int i = 0; i < 2; ++i) { int R, C; stage_rc(tid * 16 + i * 8192, R, C); const int Rb = Epi::PERM ? ((R & ~31) + perm32(R & 31)) : R;
        const int Ra = Epi::APERM ? ((R & ~63) | ((R & 15) << 2) | ((R >> 4) & 3)) : R;
        voffA[i] = (unsigned)(Ra * g.lda + C) * 2u; voffB[i] = (unsigned)(Rb * g.ldb + C) * 2u; }
    const size_t kstep = (size_t)(BK * 2);
    const size_t hstepA = (size_t)HALF * g.lda * 2, hstepB = (size_t)HALF * g.ldb * 2;
    const size_t tstepA = 2 * hstepA, tstepB = 2 * hstepB;
    const unsigned ldsw = (unsigned)wid * 1024u;
    const int aoff = lds_byte(wr * 64 + fr, fq * 8), boff = lds_byte(wc * 32 + fr, fq * 8);
#define PG8_SA(b, h) (((b) * 2 + (h)) * HTB)
#define PG8_SB(b, h) ((4 + (b) * 2 + (h)) * HTB)
#define PG8_STAGE(bufoff, gbase, voff) do { _Pragma("unroll") for (int _i = 0; _i < 2; ++_i) \
        __builtin_amdgcn_global_load_lds((const unsigned*)((const char*)(gbase) + (voff)[_i]), (PG8_LAS unsigned*)(lds + (bufoff) + ldsw + _i * 8192), 16, 0, 0); } while (0)
#define PG8_LDA(dst, b, h) do { _Pragma("unroll") for (int m = 0; m < 4; ++m) _Pragma("unroll") for (int k = 0; k < 2; ++k) dst[m][k] = *(const PG8_LAS bf16x8*)(lds + PG8_SA(b, h) + aoff + m * 2048 + k * 1024); } while (0)
#define PG8_LDB(dst, b, h) do { _Pragma("unroll") for (int n = 0; n < 2; ++n) _Pragma("unroll") for (int k = 0; k < 2; ++k) dst[n][k] = *(const PG8_LAS bf16x8*)(lds + PG8_SB(b, h) + boff + n * 2048 + k * 1024); } while (0)
#define PG8_MMA(ai, bj, At, Bt) do { __builtin_amdgcn_s_setprio(1); _Pragma("unroll") for (int m = 0; m < 4; ++m) _Pragma("unroll") for (int n = 0; n < 2; ++n) _Pragma("unroll") for (int k = 0; k < 2; ++k) \
        acc[ai][bj][m][n] = __builtin_amdgcn_mfma_f32_16x16x32_bf16(Bt[n][k], At[m][k], acc[ai][bj][m][n], 0, 0, 0); __builtin_amdgcn_s_setprio(0); } while (0)
#define PG8_WAIT_V(n) asm volatile("s_waitcnt vmcnt(" #n ")" ::: "memory")
#define PG8_WAIT_L(n) asm volatile("s_waitcnt lgkmcnt(" #n ")" ::: "memory")
#define PG8_BAR __builtin_amdgcn_s_barrier()
#define PG8_SCHED __builtin_amdgcn_sched_barrier(0)
    Unit cur, nxt; int ui = 0;
    if (!S.next(0, cur)) return;
    f32x4 acc[2][2][4][2];
#pragma unroll
    for (int a = 0; a < 2; ++a)
#pragma unroll
        for (int b = 0; b < 2; ++b)
#pragma unroll
            for (int m = 0; m < 4; ++m)
#pragma unroll
                for (int n = 0; n < 2; ++n) acc[a][b][m][n] = (f32x4){0.f, 0.f, 0.f, 0.f};
    bf16x8 At[4][2], B0[2][2], B1[2][2];
    const char* cA = (const char*)g.A + (size_t)cur.pm * tstepA + (size_t)cur.pn * g.akoff * 2; const char* cB = (const char*)g.Bt + (size_t)cur.pn * tstepB;
    S.a_ready(cur);
    if constexpr (SP2) {
        PG8_STAGE(PG8_SB(0, 0), cB, voffB); PG8_STAGE(PG8_SB(0, 1), cB + hstepB, voffB); PG8_STAGE(PG8_SA(0, 0), cA, voffA); PG8_STAGE(PG8_SA(0, 1), cA + hstepA, voffA);
        if (wr == 1) PG8_BAR;
        PG8_WAIT_V(2); PG8_BAR;
        PG8_STAGE(PG8_SB(1, 0), cB + kstep, voffB); PG8_STAGE(PG8_SA(1, 0), cA + kstep, voffA); PG8_STAGE(PG8_SB(1, 1), cB + hstepB + kstep, voffB);
        PG8_WAIT_V(6); PG8_BAR;
    } else {
        PG8_STAGE(PG8_SB(0, 0), cB, voffB); PG8_STAGE(PG8_SA(0, 0), cA, voffA); PG8_STAGE(PG8_SB(0, 1), cB + hstepB, voffB); PG8_STAGE(PG8_SA(0, 1), cA + hstepA, voffA);
        if (wr == 1) PG8_BAR;
        PG8_WAIT_V(4); PG8_BAR;
        PG8_STAGE(PG8_SB(1, 0), cB + kstep, voffB); PG8_STAGE(PG8_SA(1, 0), cA + kstep, voffA); PG8_STAGE(PG8_SB(1, 1), cB + hstepB + kstep, voffB);
        PG8_WAIT_V(6); PG8_BAR;
    }
    for (;;) {
        const bool has_next = S.next(ui + 1, nxt);
        const char* nA = has_next ? (const char*)g.A + (size_t)nxt.pm * tstepA + (size_t)nxt.pn * g.akoff * 2 : cA; const char* nB = has_next ? (const char*)g.Bt + (size_t)nxt.pn * tstepB : cB;
        for (int t = 0; t < nt; t += 2) {
            const bool last = (t == nt - 2);
            const char* a1 = cA + (size_t)(t + 1) * kstep;
            const char* a2 = last ? nA : cA + (size_t)(t + 2) * kstep; const char* b2 = last ? nB : cB + (size_t)(t + 2) * kstep;
            const char* a3 = a2 + kstep; const char* b3 = b2 + kstep;
            if (last && has_next) S.a_ready(nxt);
            if constexpr (SP2) {
            PG8_LDB(B0, 0, 0); PG8_LDB(B1, 0, 1); PG8_SCHED; PG8_LDA(At, 0, 0); PG8_STAGE(PG8_SA(1, 1), a1 + hstepA, voffA);
            PG8_WAIT_V(8); PG8_WAIT_L(0); PG8_BAR; PG8_MMA(0, 0, At, B0); PG8_MMA(0, 1, At, B1); PG8_BAR; PG8_SCHED;
            PG8_LDA(At, 0, 1); PG8_STAGE(PG8_SB(0, 0), b2, voffB); PG8_STAGE(PG8_SB(0, 1), b2 + hstepB, voffB); PG8_STAGE(PG8_SA(0, 0), a2, voffA);
            PG8_WAIT_V(8); PG8_WAIT_L(0); PG8_BAR; PG8_MMA(1, 0, At, B0); PG8_MMA(1, 1, At, B1); PG8_BAR; PG8_SCHED;
            PG8_LDB(B0, 1, 0); PG8_LDB(B1, 1, 1); PG8_SCHED; PG8_LDA(At, 1, 0); PG8_STAGE(PG8_SA(0, 1), a2 + hstepA, voffA);
            PG8_WAIT_V(8); PG8_WAIT_L(0); PG8_BAR; PG8_MMA(0, 0, At, B0); PG8_MMA(0, 1, At, B1); PG8_BAR; PG8_SCHED;
            PG8_LDA(At, 1, 1); PG8_STAGE(PG8_SB(1, 0), b3, voffB); PG8_STAGE(PG8_SB(1, 1), b3 + hstepB, voffB); PG8_STAGE(PG8_SA(1, 0), a3, voffA);
            PG8_WAIT_V(8); PG8_WAIT_L(0); PG8_BAR; PG8_MMA(1, 0, At, B0); PG8_MMA(1, 1, At, B1); PG8_BAR; PG8_SCHED;
            } else {
            PG8_LDB(B0, 0, 0); PG8_SCHED; PG8_LDA(At, 0, 0); PG8_STAGE(PG8_SA(1, 1), a1 + hstepA, voffA);
            PG8_WAIT_L(8); PG8_BAR; PG8_WAIT_L(0); PG8_MMA(0, 0, At, B0); PG8_BAR; PG8_SCHED;
            PG8_LDB(B1, 0, 1); PG8_STAGE(PG8_SB(0, 0), b2, voffB);
            PG8_BAR; PG8_WAIT_L(0); PG8_MMA(0, 1, At, B1); PG8_BAR;
            PG8_LDA(At, 0, 1); PG8_STAGE(PG8_SA(0, 0), a2, voffA);
            PG8_BAR; PG8_WAIT_L(0); PG8_MMA(1, 0, At, B0); PG8_BAR; PG8_SCHED;
            PG8_STAGE(PG8_SB(0, 1), b2 + hstepB, voffB);
            PG8_WAIT_V(6); PG8_BAR; PG8_MMA(1, 1, At, B1); PG8_BAR;
            PG8_LDB(B0, 1, 0); PG8_SCHED; PG8_LDA(At, 1, 0); PG8_STAGE(PG8_SA(0, 1), a2 + hstepA, voffA);
            PG8_WAIT_L(8); PG8_BAR; PG8_WAIT_L(0); PG8_MMA(0, 0, At, B0); PG8_BAR; PG8_SCHED;
            PG8_LDB(B1, 1, 1); PG8_STAGE(PG8_SB(1, 0), b3, voffB);
            PG8_BAR; PG8_WAIT_L(0); PG8_MMA(0, 1, At, B1); PG8_BAR;
            PG8_LDA(At, 1, 1); PG8_STAGE(PG8_SA(1, 0), a3, voffA);
            PG8_BAR; PG8_WAIT_L(0); PG8_MMA(1, 0, At, B0); PG8_BAR; PG8_SCHED;
            PG8_STAGE(PG8_SB(1, 1), b3 + hstepB, voffB);
            PG8_WAIT_V(6); PG8_BAR; PG8_MMA(1, 1, At, B1); PG8_BAR;
            }
        }
        if constexpr (ALIGN_EPI) { if (wr == 0) PG8_BAR; }
        if constexpr (!Epi::AFTER_DRAIN) { E(acc, cur, wr, wc, fr, fq); S.done(cur); }
        if (!has_next) break;
#pragma unroll
        for (int a = 0; a < 2; ++a)
#pragma unroll
            for (int b = 0; b < 2; ++b)
#pragma unroll
                for (int m = 0; m < 4; ++m)
#pragma unroll
                    for (int n = 0; n < 2; ++n) acc[a][b][m][n] = (f32x4){0.f, 0.f, 0.f, 0.f};
        cur = nxt; cA = nA; cB = nB; ++ui;
        if constexpr (ALIGN_EPI) { if (wr == 1) PG8_BAR; }
    }
    PG8_WAIT_V(0);
    if constexpr (!ALIGN_EPI) { if (wr == 0) PG8_BAR; }
    PG8_BAR;
    if constexpr (Epi::AFTER_DRAIN) { E.fused(acc, cur, wr, wc, fr, fq, lds, wid, lane); S.done(cur); }
#undef PG8_SA
#undef PG8_SB
#undef PG8_STAGE
#undef PG8_LDA
#undef PG8_LDB
#undef PG8_MMA
#undef PG8_WAIT_V
#undef PG8_WAIT_L
#undef PG8_BAR
#undef PG8_SCHED
}
}
namespace pg8 {
typedef float f32x2 __attribute__((ext_vector_type(2)));
__device__ __forceinline__ float rms_rowscale(const float* ssq, int row) { const f32x4 a = *(const f32x4*)(ssq + (size_t)row * 8), b = *(const f32x4*)(ssq + (size_t)row * 8 + 4);
    return __builtin_amdgcn_rsqf((((a[0] + a[1]) + (a[2] + a[3])) + ((b[0] + b[1]) + (b[2] + b[3]))) * (1.0f / 2048.0f) + 1e-6f); }
struct SegTab { bf16_t* base[8]; int ldc[8]; int t0[8]; int gw[8]; int nseg; int pad_; };
struct EpiBf16R {
    static constexpr bool PERM = true, AFTER_DRAIN = false, APERM = false;
    SegTab T; const float* ssp; int ss_off;
    __device__ __forceinline__ void operator()(const f32x4 (&acc)[2][2][4][2], const Unit& u, int wr, int wc, int fr, int fq) const {
        bf16_t* base = T.base[0]; int ldc = T.ldc[0], gw = T.gw[0], t0 = T.t0[0];
#pragma unroll
        for (int s = 1; s < 8; ++s) if (s < T.nseg && u.pn >= T.t0[s]) { base = T.base[s]; ldc = T.ldc[s]; gw = T.gw[s]; t0 = T.t0[s]; }
        const int colt = (u.pn - t0) * BM, row0 = u.pm * BM + wr * 64 + fr;
        if (gw <= -4) {
            typedef unsigned u32x2_ __attribute__((ext_vector_type(2)));
#pragma unroll
            for (int bj = 0; bj < 2; ++bj) { const int col = colt + bj * HALF + wc * 32 + 8 * fq;
                f32x4 c0 = {1.f, 1.f, 1.f, 1.f}, c1 = {1.f, 1.f, 1.f, 1.f};
                if (ssp) {
#pragma unroll
                    for (int j = 0; j < 4; ++j) { c0[j] = rms_rowscale(ssp, ss_off + col + j); c1[j] = rms_rowscale(ssp, ss_off + col + 4 + j); } }
                const int bt = ((col >> 12) * ldc) * 128 + ((col & 4095) >> 5);
#pragma unroll
                for (int ai = 0; ai < 2; ++ai)
#pragma unroll
                    for (int m = 0; m < 4; ++m) { const int row = row0 + ai * HALF + m * 16;
                        const f32x4 v0 = acc[ai][bj][m][0] * c0, v1 = acc[ai][bj][m][1] * c1;
                        if (gw == -4) {
                            bf16_t* d0 = base + ((size_t)(((bt + (row >> 7) * 128) * 8 + ((row >> 5) & 3) * 2 + ((col >> 4) & 1)) * 64) + (row & 31)) * 8 + 4 * ((col >> 3) & 1);
                            *(u32x2_*)d0 = (u32x2_){cvt_pk_bf16(v0[0], v0[1]), cvt_pk_bf16(v0[2], v0[3])}; *(u32x2_*)(d0 + 32 * 8) = (u32x2_){cvt_pk_bf16(v1[0], v1[1]), cvt_pk_bf16(v1[2], v1[3])};
                        } else {
                            const int k0 = col & 31, kq = (k0 & 15) >> 2, j0 = (k0 >> 4) * 4;
                            unsigned char* d8 = (unsigned char*)base + ((size_t)(((bt + (row >> 7) * 128) * 8 + ((row >> 4) & 7)) * 64) + 16 * kq + (row & 15)) * 8 + j0;
                            int lo = 0, hi = 0;
                            lo = __builtin_amdgcn_cvt_pk_fp8_f32(v0[0], v0[1], lo, false); lo = __builtin_amdgcn_cvt_pk_fp8_f32(v0[2], v0[3], lo, true);
                            hi = __builtin_amdgcn_cvt_pk_fp8_f32(v1[0], v1[1], hi, false); hi = __builtin_amdgcn_cvt_pk_fp8_f32(v1[2], v1[3], hi, true);
                            *(int*)d8 = lo; *(int*)(d8 + 16 * 8) = hi; } } }
            return; }
#pragma unroll
        for (int ai = 0; ai < 2; ++ai)
#pragma unroll
            for (int m = 0; m < 4; ++m) { const int row = row0 + ai * HALF + m * 16;
                const float rs = ssp ? rms_rowscale(ssp, ss_off + row) : 1.0f;
#pragma unroll
                for (int bj = 0; bj < 2; ++bj) { const int col = colt + bj * HALF + wc * 32 + 8 * fq;
                    const f32x4 v0 = acc[ai][bj][m][0] * rs, v1 = acc[ai][bj][m][1] * rs;
                    u32x4 w; w.x = cvt_pk_bf16(v0[0], v0[1]); w.y = cvt_pk_bf16(v0[2], v0[3]); w.z = cvt_pk_bf16(v1[0], v1[1]); w.w = cvt_pk_bf16(v1[2], v1[3]);
                    if (gw == -2) {
                        if ((row >> 5) < ldc) { bf16_t* d0 = base + ((size_t)(((col >> 5) * ldc + (row >> 5)) * 2 + ((col >> 4) & 1)) * 64 + (row & 31)) * 8 + 4 * ((col >> 3) & 1);
                            typedef unsigned u32x2_ __attribute__((ext_vector_type(2)));
                            *(u32x2_*)d0 = (u32x2_){w.x, w.y}; *(u32x2_*)(d0 + 32 * 8) = (u32x2_){w.z, w.w}; }
                        continue; }
                    bf16_t* dst;
                    if (gw == 0) dst = base + (size_t)row * ldc + col;
                    else if (gw == -1) { if ((col >> 4) >= ldc) continue; dst = base + ((size_t)((row >> 5) * ldc + (col >> 4)) * 64 + ((col >> 3) & 1) * 32 + (row & 31)) * 8; }
                    else if (gw == -3) dst = base + ((size_t)(((((row >> 12) * 16 + (col >> 7)) * 128 + ((row & 4095) >> 5)) * 9 + ((col >> 4) & 7)) * 64) + ((col >> 3) & 1) * 32 + (row & 31)) * 8;
                    else { const int g = col / gw, d = col - g * gw; dst = base + ((size_t)((row >> 12) * 4 + g) * 4096 + (row & 4095)) * gw + d; }
                    *(u32x4*)dst = w; } }
    }
};
struct EpiGelu {
    static constexpr bool PERM = true, AFTER_DRAIN = false, APERM = false;
    bf16_t* O; int ldc; const float* bias;
    static __device__ __forceinline__ float gelu(float x) { const float u2 = 1.5957691216f * (x + 0.044715f * x * x * x); const float e = __builtin_amdgcn_exp2f(-u2 * 1.4426950409f); return x * __builtin_amdgcn_rcpf(1.0f + e); }
    __device__ __forceinline__ void operator()(const f32x4 (&acc)[2][2][4][2], const Unit& u, int wr, int wc, int fr, int fq) const {
        const int row0 = u.pm * BM + wr * 64 + fr, col0 = u.pn * BM + wc * 32 + 8 * fq;
#pragma unroll
        for (int bj = 0; bj < 2; ++bj) { const f32x4 b0 = *(const f32x4*)(bias + col0 + bj * HALF), b1 = *(const f32x4*)(bias + col0 + bj * HALF + 4);
#pragma unroll
            for (int ai = 0; ai < 2; ++ai)
#pragma unroll
                for (int m = 0; m < 4; ++m) { const f32x4 v0 = acc[ai][bj][m][0] + b0, v1 = acc[ai][bj][m][1] + b1;
                    u32x4 w; w.x = cvt_pk_bf16(gelu(v0[0]), gelu(v0[1])); w.y = cvt_pk_bf16(gelu(v0[2]), gelu(v0[3])); w.z = cvt_pk_bf16(gelu(v1[0]), gelu(v1[1])); w.w = cvt_pk_bf16(gelu(v1[2]), gelu(v1[3]));
                    *(u32x4*)(O + (size_t)(row0 + ai * HALF + m * 16) * ldc + col0 + bj * HALF) = w; } }
    }
};
struct EpiF32 {
    static constexpr bool PERM = false, AFTER_DRAIN = false, APERM = false;
    float* C; int ldc; const float* ssp; int ss_off;
    __device__ __forceinline__ void operator()(const f32x4 (&acc)[2][2][4][2], const Unit& u, int wr, int wc, int fr, int fq) const {
        const int row0 = u.pm * BM + wr * 64 + fr, col0 = u.pn * BM + wc * 32 + 4 * fq;
#pragma unroll
        for (int ai = 0; ai < 2; ++ai)
#pragma unroll
            for (int m = 0; m < 4; ++m) { float* rowp = C + (size_t)(row0 + ai * HALF + m * 16) * ldc + col0;
                const float rs = ssp ? rms_rowscale(ssp, ss_off + row0 + ai * HALF + m * 16) : 1.0f;
#pragma unroll
                for (int bj = 0; bj < 2; ++bj)
#pragma unroll
                    for (int n = 0; n < 2; ++n) *(f32x4*)(rowp + bj * HALF + n * 16) = acc[ai][bj][m][n] * rs; }
    }
};
struct EpiResN {
    static constexpr bool PERM = false, AFTER_DRAIN = false, APERM = false;
    const float* res32; const float* gprev; float* out32; int ldc; int row_off; const float* g; bf16_t* xn; float* ss; PG8_LAS float* xb;
    __device__ __forceinline__ void operator()(const f32x4 (&acc)[2][2][4][2], const Unit& u, int wr, int wc, int fr, int fq) const {
        typedef unsigned u32x2_ __attribute__((ext_vector_type(2)));
        const int row0 = row_off + u.pm * BM + wr * 64 + fr, col0 = u.pn * BM + wc * 32 + 4 * fq;
        f32x4 gv[2][2], gi[2][2];
#pragma unroll
        for (int bj = 0; bj < 2; ++bj)
#pragma unroll
            for (int n = 0; n < 2; ++n) { gv[bj][n] = g ? *(const f32x4*)(g + col0 + bj * HALF + n * 16) : (f32x4){0.f, 0.f, 0.f, 0.f};
                if (!res32) { const f32x4 t = *(const f32x4*)(gprev + col0 + bj * HALF + n * 16); gi[bj][n] = (f32x4){1.0f / t[0], 1.0f / t[1], 1.0f / t[2], 1.0f / t[3]}; } else gi[bj][n] = (f32x4){1.f, 1.f, 1.f, 1.f}; }
#pragma unroll
        for (int ai = 0; ai < 2; ++ai)
#pragma unroll
            for (int m = 0; m < 4; ++m) { const int row = row0 + ai * HALF + m * 16; const size_t off = (size_t)row * ldc + col0;
                f32x4 r[2][2]; float sq = 0.f;
#pragma unroll
                for (int bj = 0; bj < 2; ++bj)
#pragma unroll
                    for (int n = 0; n < 2; ++n) {
                        if (res32) r[bj][n] = *(const f32x4*)(res32 + off + bj * HALF + n * 16);
                        else { const u32x2_ w = *(const u32x2_*)(xn + off + bj * HALF + n * 16);
                            r[bj][n] = (f32x4){__builtin_bit_cast(float, w.x << 16), __builtin_bit_cast(float, w.x & 0xffff0000u), __builtin_bit_cast(float, w.y << 16), __builtin_bit_cast(float, w.y & 0xffff0000u)} * gi[bj][n]; } }
#pragma unroll
                for (int bj = 0; bj < 2; ++bj)
#pragma unroll
                    for (int n = 0; n < 2; ++n) { const f32x4 o = r[bj][n] + acc[ai][bj][m][n];
                        if (out32) *(f32x4*)(out32 + off + bj * HALF + n * 16) = o;
                        if (g) { sq += (o[0] * o[0] + o[1] * o[1]) + (o[2] * o[2] + o[3] * o[3]);
                            const f32x4 y = o * gv[bj][n]; *(u32x2_*)(xn + off + bj * HALF + n * 16) = (u32x2_){cvt_pk_bf16(y[0], y[1]), cvt_pk_bf16(y[2], y[3])}; } }
                if (g) { sq += __shfl_xor(sq, 16); sq += __shfl_xor(sq, 32);
                    if (fq == 0) xb[(ai * HALF + wr * 64 + m * 16 + fr) * 4 + wc] = sq; }
                asm volatile("" ::: "memory"); }
        if (g) {
            asm volatile("s_waitcnt lgkmcnt(0)" ::: "memory"); __builtin_amdgcn_s_barrier(); asm volatile("" ::: "memory");
            const int t = (wr * 4 + wc) * 64 + fq * 16 + fr;
            if (t < BM) { const f32x4 v = *(const PG8_LAS f32x4*)(xb + t * 4); ss[(size_t)(row_off + u.pm * BM + t) * 8 + u.pn] = (v[0] + v[1]) + (v[2] + v[3]); }
        }
    }
};
struct EpiConvGlu {
    static constexpr bool PERM = true, AFTER_DRAIN = false, APERM = true;
    bf16_t* G; float* UB; const float* cw; const float* cb; PG8_LAS float* xb; int dff; const PG8_LAS float* rstd; int rbase;
    static __device__ __forceinline__ float shr1(float old, float src) { const int o = __builtin_bit_cast(int, old), s = __builtin_bit_cast(int, src);
        return __builtin_bit_cast(float, __builtin_amdgcn_update_dpp(o, s, 0x111, 0xf, 0xf, false)); }
    __device__ __forceinline__ void operator()(f32x4 (&acc)[2][2][4][2], const Unit& u, int wr, int wc, int fr, int fq) const {
        typedef unsigned u32x2_ __attribute__((ext_vector_type(2)));
        if (rstd) {
#pragma unroll
            for (int ai = 0; ai < 2; ++ai) { const f32x4 rs = *(const PG8_LAS f32x4*)(rstd + (u.pm * BM + ai * HALF + wr * 64 + fr * 4 - rbase));
#pragma unroll
                for (int m = 0; m < 4; ++m)
#pragma unroll
                    for (int bj = 0; bj < 2; ++bj)
#pragma unroll
                        for (int n = 0; n < 2; ++n) acc[ai][bj][m][n] = acc[ai][bj][m][n] * rs[m]; }
        }
        if (fr == 15) {
#pragma unroll
            for (int ai = 0; ai < 2; ++ai)
#pragma unroll
                for (int k = 0; k < 2; ++k)
#pragma unroll
                    for (int bj = 0; bj < 2; ++bj)
#pragma unroll
                        for (int n = 0; n < 2; ++n) *(PG8_LAS f32x4*)(xb + (((((ai * 2 + wr) * 4 + wc) * 2 + k) * 4 + fq) * 16) + (bj * 2 + n) * 4) = acc[ai][bj][2 + k][n];
        }
        { const int ncol = 4 * dff / 2;
          const bool top = (wr == 0 && fr == 0), bot = (wr == 1 && fr == 15);
          if (top || bot) {
#pragma unroll
            for (int k = 0; k < 2; ++k) { float* ub = UB + ((size_t)(u.pm * 4 + (top ? k : 2 + k)) * ncol) + u.pn * BM + wc * 32 + 8 * fq;
#pragma unroll
              for (int bj = 0; bj < 2; ++bj)
#pragma unroll
                for (int n = 0; n < 2; ++n) *(f32x4*)(ub + bj * HALF + 4 * n) = top ? acc[0][bj][k][n] : acc[1][bj][2 + k][n]; } } }
        asm volatile("s_waitcnt lgkmcnt(0)" ::: "memory"); __builtin_amdgcn_s_barrier(); asm volatile("" ::: "memory");
        u32x2_ res[2][4][2];
        const int ch0 = u.pn * HALF + wc * 32 + 8 * fq;
#pragma unroll
        for (int n = 0; n < 2; ++n) {
            const float* wp = cw + ch0 + 4 * n; const float* bp = cb + ch0 + 4 * n;
            const f32x4 w0g = *(const f32x4*)(wp), w1g = *(const f32x4*)(wp + 2 * dff), w2g = *(const f32x4*)(wp + 4 * dff), bg = *(const f32x4*)(bp);
            const f32x4 w0v = *(const f32x4*)(wp + dff), w1v = *(const f32x4*)(wp + 3 * dff), w2v = *(const f32x4*)(wp + 5 * dff), bv = *(const f32x4*)(bp + dff);
#pragma unroll
            for (int ai = 0; ai < 2; ++ai) {
                const int sai = wr ? ai : ai - 1, swr = wr ? 0 : 1;
                f32x4 x62g = {0.f, 0.f, 0.f, 0.f}, x63g = x62g, x62v = x62g, x63v = x62g;
                if (sai >= 0) { const PG8_LAS float* xp = xb + (((((sai * 2 + swr) * 4 + wc) * 2) * 4 + fq) * 16);
                    x62g = *(const PG8_LAS f32x4*)(xp + n * 4); x62v = *(const PG8_LAS f32x4*)(xp + (2 + n) * 4); x63g = *(const PG8_LAS f32x4*)(xp + 64 + n * 4); x63v = *(const PG8_LAS f32x4*)(xp + 64 + (2 + n) * 4); }
                float o[4][4];
#pragma unroll
                for (int e = 0; e < 4; ++e) {
                    const float g0 = acc[ai][0][0][n][e], g1 = acc[ai][0][1][n][e], g2 = acc[ai][0][2][n][e], g3 = acc[ai][0][3][n][e];
                    const float v0 = acc[ai][1][0][n][e], v1 = acc[ai][1][1][n][e], v2 = acc[ai][1][2][n][e], v3 = acc[ai][1][3][n][e];
                    const float q1g = shr1(x63g[e], g3), q2g = shr1(x62g[e], g2), q1v = shr1(x63v[e], v3), q2v = shr1(x62v[e], v2);
                    const float yg[4] = {bg[e] + w0g[e] * q2g + w1g[e] * q1g + w2g[e] * g0, bg[e] + w0g[e] * q1g + w1g[e] * g0 + w2g[e] * g1, bg[e] + w0g[e] * g0 + w1g[e] * g1 + w2g[e] * g2, bg[e] + w0g[e] * g1 + w1g[e] * g2 + w2g[e] * g3};
                    const float yv[4] = {bv[e] + w0v[e] * q2v + w1v[e] * q1v + w2v[e] * v0, bv[e] + w0v[e] * q1v + w1v[e] * v0 + w2v[e] * v1, bv[e] + w0v[e] * v0 + w1v[e] * v1 + w2v[e] * v2, bv[e] + w0v[e] * v1 + w1v[e] * v2 + w2v[e] * v3};
#pragma unroll
                    for (int m = 0; m < 4; ++m) o[m][e] = yg[m] * __builtin_amdgcn_rcpf(1.0f + __builtin_amdgcn_exp2f(-yg[m] * 1.4426950409f)) * yv[m];
                }
#pragma unroll
                for (int m = 0; m < 4; ++m) res[ai][m][n] = (u32x2_){cvt_pk_bf16(o[m][0], o[m][1]), cvt_pk_bf16(o[m][2], o[m][3])};
            }
        }
        const int row0 = u.pm * BM + wr * 64 + fr * 4;
#pragma unroll
        for (int ai = 0; ai < 2; ++ai)
#pragma unroll
            for (int m = 0; m < 4; ++m) *(u32x4*)(G + (size_t)(row0 + ai * HALF + m) * dff + ch0) = (u32x4){res[ai][m][0].x, res[ai][m][0].y, res[ai][m][1].x, res[ai][m][1].y};
    }
};
}
constexpr int BATCH = 8, SEQ = 4096, DM = 2048, MTOT = BATCH * SEQ, MC = MTOT / 2  , BPH = BATCH / 2;
constexpr int DFF = 5632;
constexpr float NORM_EPS = 1e-6f, LOG2E = 1.4426950408889634f;
constexpr int NWAVES = 8;
constexpr size_t MiB = 1u << 20;
constexpr size_t WS_CTL = 0, CTL_ZERO_BYTES = 1 * MiB;
constexpr size_t WS_TAB = 1 * MiB;
constexpr size_t TAB_COS48 = WS_TAB, TAB_SIN48 = WS_TAB + 3 * MiB, TAB_COS32 = WS_TAB + 6 * MiB, TAB_SIN32 = WS_TAB + 8 * MiB;
constexpr size_t WS_WMIX = 12 * MiB;
constexpr size_t WS_WFFN = 100 * MiB;
constexpr size_t WS_MISC = 168 * MiB;
constexpr size_t WS_SS = 170 * MiB;
constexpr size_t WS_XNR = 1010 * MiB;
constexpr size_t WS_AR = 234 * MiB;
constexpr size_t WS_END = 1138 * MiB;
constexpr int CW_TMO = 0;
constexpr int CW_BAR = 4096;
constexpr int RING_BYTES = 131072;
constexpr int LDSCTL_OFF = 135168;
constexpr int LDS_BYTES = 163840;

#define GAS __attribute__((address_space(1)))
#define LAS __attribute__((address_space(3)))
typedef unsigned short bf16;
typedef unsigned u32x4 __attribute__((ext_vector_type(4)));
typedef unsigned u32x2 __attribute__((ext_vector_type(2)));
typedef float f32x4 __attribute__((ext_vector_type(4)));
typedef float f32x16 __attribute__((ext_vector_type(16)));
typedef short bf16x8 __attribute__((ext_vector_type(8)));
typedef short s16x4 __attribute__((ext_vector_type(4)));
typedef short v4i16_t __attribute__((ext_vector_type(4)));
typedef __bf16 bf16x2_t __attribute__((ext_vector_type(2)));
typedef float f32x2_t __attribute__((ext_vector_type(2)));
#define LDS_WAIT() asm volatile("s_waitcnt lgkmcnt(0)" ::: "memory")
#define VM_WAIT() asm volatile("s_waitcnt vmcnt(0)" ::: "memory")
#define MFMA32(a, b, c) __builtin_amdgcn_mfma_f32_32x32x16_bf16((a), (b), (c), 0, 0, 0)
DI unsigned pk2(float lo, float hi) { f32x2_t v = {lo, hi}; bf16x2_t b = __builtin_convertvector(v, bf16x2_t); return __builtin_bit_cast(unsigned, b); }
DI float bf2f(unsigned short b) { return __builtin_bit_cast(float, (unsigned)b << 16); }
DI float bflo(unsigned w) { return __builtin_bit_cast(float, w << 16); }
DI float bfhi(unsigned w) { return __builtin_bit_cast(float, w & 0xffff0000u); }
DI unsigned short f2bf(float f) { return (unsigned short)(pk2(f, 0.f) & 0xffffu); }
DI float wave_sum(float v) {
#pragma unroll
    for (int o = 1; o < 64; o <<= 1) v += __shfl_xor(v, o);
    return v;
}
DI int crow(int i, int h) { return (i & 3) + 8 * (i >> 2) + 4 * h; }
#define XB_TMO      128
#define XB_XCNT(j)  (256  + 64 * (j))
#define XB_XSUB(j)  (1280 + 64 * (j))
#define XB_XGEN(j)  (2304 + 64 * (j))
#define XB_TOP      3328
#define XB_TOPGEN   3392
#define XCD_BAR_WORDS 3456
#define XB_SPIN_CAP (1u << 18)

__device__ __forceinline__ unsigned xb_ld(unsigned* p)              { return __hip_atomic_load(p, __ATOMIC_RELAXED, __HIP_MEMORY_SCOPE_AGENT); }
__device__ __forceinline__ unsigned xb_add(unsigned* p, unsigned v) { return __hip_atomic_fetch_add(p, v, __ATOMIC_RELAXED, __HIP_MEMORY_SCOPE_AGENT); }
__device__ __forceinline__ unsigned xb_xcc_id() { return (unsigned)__builtin_amdgcn_s_getreg((3 << 11) | 20) & 0xFu; }
#define XB_SPIN(cond, bar) do { unsigned _sp = 0; while (cond) { __builtin_amdgcn_s_sleep(1); \
    if ((++_sp & 255u) == 0u) { if (xb_ld(&(bar)[XB_TMO])) break; if (_sp > XB_SPIN_CAP) { atomicAdd(&(bar)[XB_TMO], 1u); break; } } } } while (0)

struct XcdBarrier {
    unsigned* bar; unsigned x;
    volatile LAS unsigned* st;
};

__device__ __forceinline__ XcdBarrier xcd_barrier_post(unsigned* bar, volatile LAS unsigned* st) {
    XcdBarrier b; b.bar = bar; b.x = xb_xcc_id(); b.st = st;
    if (threadIdx.x == 0) (void)xb_add(&bar[XB_XCNT(b.x)], 1u);
    return b;
}
__device__ __forceinline__ void xcd_barrier_complete(unsigned* bar, unsigned x, unsigned& nloc, unsigned& nx) {
    const unsigned G = gridDim.x * gridDim.y * gridDim.z;
    unsigned sum, cnt, mine, sp = 0u;
    for (;;) {
        sum = 0u; cnt = 0u; mine = 0u;
#pragma unroll
        for (unsigned j = 0; j < 16; ++j) { const unsigned c = xb_ld(&bar[XB_XCNT(j)]); sum += c; cnt += (c > 0u) ? 1u : 0u; mine = (j == x) ? c : mine; }
        if (sum == G) break;
        __builtin_amdgcn_s_sleep(1);
        if ((++sp & 255u) == 0u) { if (xb_ld(&bar[XB_TMO])) break; if (sp > XB_SPIN_CAP) { atomicAdd(&bar[XB_TMO], 1u); break; } }
    }
    nloc = mine > 0u ? mine : 1u; nx = cnt > 0u ? cnt : 1u;
}

__device__ __forceinline__ void xcd_barrier(const XcdBarrier& b) {
    asm volatile("s_waitcnt vmcnt(0)" ::: "memory");
    __syncthreads();
    if (threadIdx.x == 0) {
        unsigned* bar = b.bar;
        __builtin_amdgcn_s_waitcnt(0);
        unsigned nloc = b.st[0], nx = b.st[1];
        if (nloc == 0u) { xcd_barrier_complete(bar, b.x, nloc, nx); b.st[0] = nloc; b.st[1] = nx; }
        const unsigned old = xb_add(&bar[XB_XSUB(b.x)], 1u);
        const unsigned gen = old / nloc;
        if (old + 1u == (gen + 1u) * nloc) {
            __builtin_amdgcn_fence(__ATOMIC_RELEASE, "agent");
            asm volatile("s_waitcnt vmcnt(0)" ::: "memory");
            const unsigned og = xb_add(&bar[XB_TOP], 1u);
            const unsigned tg = og / nx;
            if (og + 1u == (tg + 1u) * nx) xb_add(&bar[XB_TOPGEN], 1u);
            else XB_SPIN(xb_ld(&bar[XB_TOPGEN]) == tg, bar);
            __builtin_amdgcn_fence(__ATOMIC_ACQUIRE, "agent");
            xb_add(&bar[XB_XGEN(b.x)], 1u);
            asm volatile("s_waitcnt vmcnt(0)" ::: "memory");
        } else {
            XB_SPIN(xb_ld(&bar[XB_XGEN(b.x)]) == gen, bar);
            __builtin_amdgcn_fence(__ATOMIC_ACQUIRE, "agent");
            asm volatile("s_waitcnt vmcnt(0)" ::: "memory");
        }
    }
    __syncthreads();
}
struct Frame {
    LAS unsigned char* lds; unsigned* ctl; unsigned char* ws;
    int tid, lane, wave, G, gw, NGW;
};
DI void ph_tables(const Frame& F, const int* pos) {
    float* c48 = (float*)(F.ws + TAB_COS48); float* s48 = (float*)(F.ws + TAB_SIN48); float* c32 = (float*)(F.ws + TAB_COS32); float* s32 = (float*)(F.ws + TAB_SIN32);
    const int gt = blockIdx.x * (NWAVES * 64) + F.tid, NT = F.G * NWAVES * 64;
    for (int i = gt; i < MTOT * 40; i += NT) {
        const int m = i / 40, j = i - m * 40; const float p = (float)pos[m];
        const bool a = j < 24; const int jj = a ? j : j - 24;
        const float inv = (float)exp(-(2.0 * jj / (a ? 48.0 : 32.0)) * 13.122363377404328);
        const float ang = p * inv; float sn, cs; sincosf(ang, &sn, &cs);
        if (a) { c48[m * 24 + jj] = cs; s48[m * 24 + jj] = sn; } else { c32[m * 16 + jj] = cs; s32[m * 16 + jj] = sn; }
    }
}
DI void cvt_load(float (&v)[32], const float* W, int ldw, int col0, int ncols, int item, int nblk, int lane) {
    const int kb = item / nblk, nb = item - kb * nblk, k0 = 64 * kb, n0 = 32 * nb, nn = n0 + (lane & 31); const bool ok = nn < ncols;
    const float* p = W + (size_t)(k0 + (lane >> 5)) * ldw + col0 + (ok ? nn : 0);
#pragma unroll
    for (int i = 0; i < 32; ++i) { const float x = p[(size_t)(2 * i) * ldw]; v[i] = ok ? x : 0.f; }
}
DI void cvt_store(const float (&v)[32], int ncols, bf16* WT, int ldt, int row_off, float scale, LAS float* scr, int item, int nblk, int lane) {
    const int kb = item / nblk, nb = item - kb * nblk, k0 = 64 * kb, n0 = 32 * nb;
#pragma unroll
    for (int i = 0; i < 32; ++i) scr[(2 * i + (lane >> 5)) * 33 + (lane & 31)] = v[i] * scale;
    LDS_WAIT();
    const int c = lane & 7;
#pragma unroll
    for (int j = 0; j < 4; ++j) { const int n = (lane >> 3) + 8 * j; const LAS float* s = scr + (8 * c) * 33 + n;
        u32x4 o; o.x = pk2(s[0 * 33], s[1 * 33]); o.y = pk2(s[2 * 33], s[3 * 33]); o.z = pk2(s[4 * 33], s[5 * 33]); o.w = pk2(s[6 * 33], s[7 * 33]);
        if (n0 + n < ncols) *(u32x4*)(WT + (size_t)(row_off + n0 + n) * ldt + k0 + 8 * c) = o; }
    LDS_WAIT();
}
DI void cvt_item(const float* W, int ldw, int col0, int ncols, bf16* WT, int ldt, int row_off, float scale, LAS float* scr, int item, int nblk, int lane) {
    float v[32]; cvt_load(v, W, ldw, col0, ncols, item, nblk, lane); cvt_store(v, ncols, WT, ldt, row_off, scale, scr, item, nblk, lane);
}
template <class MAP> DI void cvt_loop(const Frame& F, const float* W, int ldw, int ncols, bf16* WT, int ldt, float scale, int nitems, int nblk, const MAP& map) {
    LAS float* scr = (LAS float*)(F.lds + F.wave * 16384);
    int it = F.gw; float cur[32]; int c0 = 0, ro = 0, li = 0;
    if (it < nitems) { map(it, c0, ro, li); cvt_load(cur, W, ldw, c0, ncols, li, nblk, F.lane); }
#pragma unroll 1
    for (; it < nitems; it += F.NGW) {
        float nxt[32]; int c1 = 0, r1 = 0, l1 = 0; const int ni = it + F.NGW;
        if (ni < nitems) { map(ni, c1, r1, l1); cvt_load(nxt, W, ldw, c1, ncols, l1, nblk, F.lane); }
        cvt_store(cur, ncols, WT, ldt, ro, scale, scr, li, nblk, F.lane);
#pragma unroll
        for (int i = 0; i < 32; ++i) cur[i] = nxt[i];
        c0 = c1; ro = r1; li = l1;
    }
}
struct CvtPlain { int col0, row_off; DI void operator()(int it, int& c, int& r, int& l) const { c = col0; r = row_off; l = it; } };
DI void cvt_job(const Frame& F, const float* W, int ldw, int K, int col0, int ncols, bf16* WT, int ldt, int row_off, float scale) {
    const int nblk = (ncols + 31) / 32;
    cvt_loop(F, W, ldw, ncols, WT, ldt, scale, (K / 64) * nblk, nblk, CvtPlain{col0, row_off});
}
DI void zero_bf16(const Frame& F, bf16* p, size_t nelem) {
    const size_t gt = (size_t)blockIdx.x * (NWAVES * 64) + F.tid, NT = (size_t)F.G * NWAVES * 64;
    for (size_t i = gt; i < nelem / 8; i += NT) ((u32x4*)p)[i] = (u32x4){0u, 0u, 0u, 0u};
}
DI void ph_cvt_ffn(const Frame& F, const float* up, const float* down) {
    bf16* WUP = (bf16*)(F.ws + WS_WFFN); bf16* WDN = WUP + (size_t)2 * DFF * DM;
    struct UpMap { DI void operator()(int it, int& c, int& r, int& l) const { const int seg = it >> 7, pn = seg >> 1, isv = seg & 1; c = isv * DFF + pn * 128; r = pn * 256 + isv * 128; l = it & 127; } };
    cvt_loop(F, up, 2 * DFF, 128, WUP, DM, 1.f, 88 * 128, 4, UpMap{});
    cvt_job(F, down, DM, DFF, 0, DM, WDN, DFF, 0, 1.f);
}
DI void ph_conv_fix(const Frame& F, const float* UB, bf16* Gb, const float* cw, const float* cb, const int nrows = MC) {
    const int gt = blockIdx.x * (NWAVES * 64) + F.tid, NT = F.G * NWAVES * 64;
    for (int it = gt; it < (nrows / 256) * (DFF / 4); it += NT) {
        const int pm = it / (DFF / 4), c4 = it - pm * (DFF / 4), ch = c4 * 4, col = (ch >> 7) * 256 + (ch & 127);
        const float* ub = UB + (size_t)pm * 4 * (2 * DFF) + col; const bool has = (pm & 15) != 0;
        const f32x4 z = {0.f, 0.f, 0.f, 0.f};
        const f32x4 g0 = *(const f32x4*)(ub), g1 = *(const f32x4*)(ub + 2 * DFF), v0 = *(const f32x4*)(ub + 128), v1 = *(const f32x4*)(ub + 2 * DFF + 128);
        const f32x4 gm2 = has ? *(const f32x4*)(ub - 2 * (2 * DFF)) : z, gm1 = has ? *(const f32x4*)(ub - (2 * DFF)) : z, vm2 = has ? *(const f32x4*)(ub - 2 * (2 * DFF) + 128) : z, vm1 = has ? *(const f32x4*)(ub - (2 * DFF) + 128) : z;
        const f32x4 w0g = *(const f32x4*)(cw + ch), w1g = *(const f32x4*)(cw + 2 * DFF + ch), w2g = *(const f32x4*)(cw + 4 * DFF + ch), bg = *(const f32x4*)(cb + ch);
        const f32x4 w0v = *(const f32x4*)(cw + DFF + ch), w1v = *(const f32x4*)(cw + 3 * DFF + ch), w2v = *(const f32x4*)(cw + 5 * DFF + ch), bv = *(const f32x4*)(cb + DFF + ch);
        float o0[4], o1[4];
#pragma unroll
        for (int e = 0; e < 4; ++e) {
            const float yg0 = bg[e] + w0g[e] * gm2[e] + w1g[e] * gm1[e] + w2g[e] * g0[e], yv0 = bv[e] + w0v[e] * vm2[e] + w1v[e] * vm1[e] + w2v[e] * v0[e];
            const float yg1 = bg[e] + w0g[e] * gm1[e] + w1g[e] * g0[e] + w2g[e] * g1[e], yv1 = bv[e] + w0v[e] * vm1[e] + w1v[e] * v0[e] + w2v[e] * v1[e];
            o0[e] = yg0 * __builtin_amdgcn_rcpf(1.0f + __builtin_amdgcn_exp2f(-yg0 * LOG2E)) * yv0; o1[e] = yg1 * __builtin_amdgcn_rcpf(1.0f + __builtin_amdgcn_exp2f(-yg1 * LOG2E)) * yv1;
        }
        u32x2 a, b; a.x = pk2(o0[0], o0[1]); a.y = pk2(o0[2], o0[3]); b.x = pk2(o1[0], o1[1]); b.y = pk2(o1[2], o1[3]);
        *(u32x2*)(Gb + (size_t)(pm * 256) * DFF + ch) = a; *(u32x2*)(Gb + (size_t)(pm * 256 + 1) * DFF + ch) = b;
    }
}
DI void ph_norm_first(const Frame& F, const float* src, const float* gain, bf16* XNR, float* ss) {
    f32x4 g[8];
#pragma unroll
    for (int j = 0; j < 8; ++j) g[j] = *(const f32x4*)(gain + 4 * (F.lane + 64 * j));
    for (int m = F.gw; m < MTOT; m += F.NGW) {
        const f32x4* xr = (const f32x4*)(src + (size_t)m * DM) + F.lane;
        f32x4 v[8]; float s2 = 0.f;
#pragma unroll
        for (int j = 0; j < 8; ++j) { v[j] = xr[64 * j]; s2 += (v[j].x * v[j].x + v[j].y * v[j].y) + (v[j].z * v[j].z + v[j].w * v[j].w); }
        s2 = wave_sum(s2);
        if (F.lane < 2) *(f32x4*)(ss + (size_t)m * 8 + 4 * F.lane) = (f32x4){F.lane == 0 ? s2 : 0.f, 0.f, 0.f, 0.f};
        u32x2* o = (u32x2*)(XNR + (size_t)m * DM) + F.lane;
#pragma unroll
        for (int j = 0; j < 8; ++j) { const f32x4 y = v[j] * g[j]; u32x2 w; w.x = pk2(y.x, y.y); w.y = pk2(y.z, y.w); o[64 * j] = w; }
    }
}
DI void ph_final_norm(const Frame& F, const bf16* xn, const float* ss, float* out) {
    for (int m = F.gw; m < MTOT; m += F.NGW) {
        const float rs = pg8::rms_rowscale(ss, m);
        u32x4 v[4];
#pragma unroll
        for (int j = 0; j < 4; ++j) v[j] = *(const u32x4*)(xn + (size_t)m * DM + j * 512 + F.lane * 8);
#pragma unroll
        for (int j = 0; j < 4; ++j) { float* o = out + (size_t)m * DM + j * 512 + F.lane * 8;
            *(f32x4*)o = (f32x4){__builtin_bit_cast(float, v[j].x << 16), __builtin_bit_cast(float, v[j].x & 0xffff0000u), __builtin_bit_cast(float, v[j].y << 16), __builtin_bit_cast(float, v[j].y & 0xffff0000u)} * rs;
            *(f32x4*)(o + 4) = (f32x4){__builtin_bit_cast(float, v[j].z << 16), __builtin_bit_cast(float, v[j].z & 0xffff0000u), __builtin_bit_cast(float, v[j].w << 16), __builtin_bit_cast(float, v[j].w & 0xffff0000u)} * rs; }
    }
}
DI void rope_piece(const bf16* qrow, int p, const float* cs, const float* sn, float (&o)[8]) {
    const bool lo = p < 3; const int pp = lo ? p + 3 : p - 3, i0 = 8 * (lo ? p : p - 3);
    const u32x4 a = *(const u32x4*)(qrow + 8 * p), b = *(const u32x4*)(qrow + 8 * pp);
    const f32x4 c0 = *(const f32x4*)(cs + i0), c1 = *(const f32x4*)(cs + i0 + 4), s0 = *(const f32x4*)(sn + i0), s1 = *(const f32x4*)(sn + i0 + 4);
#pragma unroll
    for (int e = 0; e < 4; ++e) { const float c_l = e < 2 ? c0[2 * e] : c1[2 * e - 4], c_h = e < 2 ? c0[2 * e + 1] : c1[2 * e - 3], s_l = e < 2 ? s0[2 * e] : s1[2 * e - 4], s_h = e < 2 ? s0[2 * e + 1] : s1[2 * e - 3];
        const float al = bflo(a[e]), ah = bfhi(a[e]), bl_ = bflo(b[e]), bh_ = bfhi(b[e]);
        o[2 * e] = lo ? al * c_l - bl_ * s_l : bl_ * s_l + al * c_l; o[2 * e + 1] = lo ? ah * c_h - bh_ * s_h : bh_ * s_h + ah * c_h; }
}
DI bf16x8 rope_frag32(const bf16* qrow, int s, int h, const float* cs, const float* sn) {
    float o[8]; rope_piece(qrow, 2 * s + h, cs, sn, o);
    u32x4 w; w.x = pk2(o[0], o[1]); w.y = pk2(o[2], o[3]); w.z = pk2(o[4], o[5]); w.w = pk2(o[6], o[7]); return __builtin_bit_cast(bf16x8, w);
}
constexpr size_t DA_DIN = 0, DA_CQN = 64 * MiB, DA_LATC = 80 * MiB, DA_KPE = 88 * MiB, DA_KIDX = 90 * MiB, DA_WIDX = 94 * MiB, DA_QL = 96 * MiB, DA_QPE = 352 * MiB, DA_QIDX = 400 * MiB,
                 DA_SEL = 464 * MiB, DA_CNT = 472 * MiB, DA_SC = 474 * MiB, DA_O2 = 474 * MiB;
constexpr size_t DW_W1 = 0, DW_W2 = (size_t)1024 * 2048, DW_WO = DW_W2 + (size_t)11776 * 512, DW_BD = DW_WO + (size_t)2048 * 4096;
constexpr float DSA_QSCALE = 0.07216878364870322f * LOG2E;
constexpr float DSA_WIDX_SCALE = 0.25f * 0.08838834764831845f;

DI void ph_dsa_cvt(const Frame& F, const float* w_in, const float* w_qup, const float* w_uk, const float* w_uv, const float* w_out) {
    bf16* WB = (bf16*)(F.ws + WS_WMIX);
    cvt_job(F, w_in, 960, DM, 0, 960, WB + DW_W1, DM, 0, 1.f);
    zero_bf16(F, WB + DW_W1 + (size_t)960 * DM, (size_t)64 * DM);
    { LAS float* scr = (LAS float*)(F.lds + F.wave * 16384);
      for (int it = F.gw; it < 32 * 16; it += F.NGW) { const int h = it >> 4; cvt_item(w_qup, 8192, h * 192, 48, WB + DW_W2, 512, 8192 + h * 48, DSA_QSCALE, scr, it & 15, 2, F.lane); } }
    cvt_job(F, w_qup, 8192, 512, 6144, 2048, WB + DW_W2, 512, 9728, 1.f);
    __syncthreads();
    {
        LAS float* As = (LAS float*)F.lds; LAS float* Bs = As + 64 * 145;
        for (int u = blockIdx.x; u < 32 * 4 * 8; u += F.G) {
            const int h = u >> 5, r0 = ((u >> 3) & 3) * 64, k0 = (u & 7) * 64;
            for (int i = F.tid; i < 64 * 144; i += NWAVES * 64) { const int row = i / 144, col = i - row * 144;
                As[row * 145 + col] = w_uk[(size_t)(h * 256 + r0) * 144 + i]; Bs[row * 145 + col] = w_qup[(size_t)(k0 + row) * 8192 + h * 192 + 48 + col]; }
            __syncthreads();
            const int r = F.tid & 63, kg = F.tid >> 6; float acc[8];
#pragma unroll
            for (int j = 0; j < 8; ++j) acc[j] = 0.f;
            for (int n = 0; n < 144; ++n) { const float a = As[r * 145 + n];
#pragma unroll
                for (int j = 0; j < 8; ++j) acc[j] += a * Bs[(kg * 8 + j) * 145 + n]; }
            u32x4 o; o.x = pk2(acc[0] * DSA_QSCALE, acc[1] * DSA_QSCALE); o.y = pk2(acc[2] * DSA_QSCALE, acc[3] * DSA_QSCALE); o.z = pk2(acc[4] * DSA_QSCALE, acc[5] * DSA_QSCALE); o.w = pk2(acc[6] * DSA_QSCALE, acc[7] * DSA_QSCALE);
            *(u32x4*)(WB + DW_W2 + (size_t)(h * 256 + r0 + r) * 512 + k0 + kg * 8) = o;
            __syncthreads();
        }
    }
    { LAS float* scr = (LAS float*)(F.lds + F.wave * 16384);
      for (int it = F.gw; it < 32 * 16; it += F.NGW) { const int h = it >> 4; cvt_item(w_uv + (size_t)h * 256 * 128, 128, 0, 128, WB + DW_BD + (h & 1) * 256, 512, h * 128, 1.f, scr, it & 15, 4, F.lane); } }
    { const size_t gt = (size_t)blockIdx.x * (NWAVES * 64) + F.tid, NT = (size_t)F.G * NWAVES * 64;
      for (size_t i = gt; i < (size_t)4096 * 32; i += NT) { const int row = (int)(i >> 5), pc = (int)(i & 31); *(u32x4*)(WB + DW_BD + (size_t)row * 512 + (1 - ((row >> 7) & 1)) * 256 + pc * 8) = (u32x4){0u, 0u, 0u, 0u}; } }
    cvt_job(F, w_out, DM, 4096, 0, DM, WB + DW_WO, 4096, 0, 1.f);
}
DI void ph_dsa_post1(const Frame& F, int half, const float* qn, const float* kvn, const float* lng, const float* lnb) {
    unsigned char* ar = F.ws + WS_AR;
    const float* DIN = (const float*)(ar + DA_DIN); bf16* CQN = (bf16*)(ar + DA_CQN); bf16* LATC = (bf16*)(ar + DA_LATC); bf16* KPE = (bf16*)(ar + DA_KPE); bf16* KIDX = (bf16*)(ar + DA_KIDX); float* WIDX = (float*)(ar + DA_WIDX);
    const float* c48 = (const float*)(F.ws + TAB_COS48); const float* s48 = (const float*)(F.ws + TAB_SIN48); const float* c32 = (const float*)(F.ws + TAB_COS32); const float* s32 = (const float*)(F.ws + TAB_SIN32);
    LAS float* buf = (LAS float*)(F.lds + F.wave * 1024);
    const int lane = F.lane;
    for (int ml = F.gw; ml < MC; ml += F.NGW) {
        const int mg = half * MC + ml;
        const size_t kfb = ((size_t)(ml >> 5) * 8 * 64 + (ml & 31)) * 8;
        const float* row = DIN + (size_t)ml * 1024 + 16 * lane;
        f32x4 v[4]; float ss = 0.f, s1 = 0.f;
#pragma unroll
        for (int j = 0; j < 4; ++j) { v[j] = *(const f32x4*)(row + 4 * j); ss += (v[j].x * v[j].x + v[j].y * v[j].y) + (v[j].z * v[j].z + v[j].w * v[j].w); s1 += (v[j].x + v[j].y) + (v[j].z + v[j].w); }
        const bool isq = lane < 32, iskv = lane >= 32 && lane < 48, ispe = lane >= 48 && lane < 51, isix = lane >= 51 && lane < 59;
        const float ssq = wave_sum(isq ? ss : 0.f), sskv = wave_sum(iskv ? ss : 0.f), mean = wave_sum(isix ? s1 : 0.f) * (1.f / 128.f);
        float d2 = 0.f;
#pragma unroll
        for (int j = 0; j < 4; ++j) { const f32x4 d = v[j] - mean; d2 += (d.x * d.x + d.y * d.y) + (d.z * d.z + d.w * d.w); }
        const float var = wave_sum(isix ? d2 : 0.f) * (1.f / 128.f);
        const float rq = 1.0f / sqrtf(ssq * (1.f / 512.f) + NORM_EPS), rkv = 1.0f / sqrtf(sskv * (1.f / 256.f) + NORM_EPS), rstd = 1.0f / sqrtf(var + NORM_EPS);
        if (isq || iskv) {
            const float* gp = isq ? qn + 16 * lane : kvn + 16 * (lane - 32); const float rs = isq ? rq : rkv;
            bf16* dst = isq ? CQN + (size_t)ml * 512 + 16 * lane : LATC + (size_t)ml * 256 + 16 * (lane - 32);
            u32x4 o[2];
#pragma unroll
            for (int j = 0; j < 4; ++j) { const f32x4 g = *(const f32x4*)(gp + 4 * j); const f32x4 y = v[j] * rs * g; o[j >> 1][(j & 1) * 2] = pk2(y.x, y.y); o[j >> 1][(j & 1) * 2 + 1] = pk2(y.z, y.w); }
            *(u32x4*)dst = o[0]; *(u32x4*)(dst + 8) = o[1];
        } else if (ispe) {
#pragma unroll
            for (int j = 0; j < 4; ++j) *(LAS f32x4*)(buf + (lane - 48) * 16 + 4 * j) = v[j];
        } else if (isix) {
#pragma unroll
            for (int j = 0; j < 4; ++j) { const f32x4 g = *(const f32x4*)(lng + (lane - 51) * 16 + 4 * j), b = *(const f32x4*)(lnb + (lane - 51) * 16 + 4 * j); *(LAS f32x4*)(buf + 48 + (lane - 51) * 16 + 4 * j) = (v[j] - mean) * rstd * g + b; }
        } else if (lane == 59) {
#pragma unroll
            for (int j = 0; j < 4; ++j) *(f32x4*)(WIDX + (size_t)ml * 16 + 4 * j) = v[j] * DSA_WIDX_SCALE;
        }
        LDS_WAIT();
        if (lane < 24) { const float x1 = buf[lane], x2 = buf[24 + lane], c = c48[(size_t)mg * 24 + lane], s = s48[(size_t)mg * 24 + lane];
            KPE[(size_t)ml * 48 + lane] = f2bf(x1 * c - x2 * s); KPE[(size_t)ml * 48 + 24 + lane] = f2bf(x1 * s + x2 * c);
        } else if (lane < 40) { const int i = lane - 24; const float x1 = buf[48 + i], x2 = buf[48 + 16 + i], c = c32[(size_t)mg * 16 + i], s = s32[(size_t)mg * 16 + i];
            KIDX[kfb + (size_t)((i >> 3) * 32) * 8 + (i & 7)] = f2bf(x1 * c - x2 * s); KIDX[kfb + (size_t)(64 + (i >> 3) * 32) * 8 + (i & 7)] = f2bf(x1 * s + x2 * c);
        } else { const int d = 32 + 4 * (lane - 40); const f32x4 y = *(const LAS f32x4*)(buf + 48 + d); u32x2 w; w.x = pk2(y.x, y.y); w.y = pk2(y.z, y.w); *(u32x2*)(KIDX + kfb + (size_t)((d >> 4) * 64 + ((d >> 3) & 1) * 32) * 8 + (d & 7)) = w; }
        LDS_WAIT();
    }
}
DI int wave_iscan_dpp(int v) {
    v += __builtin_amdgcn_update_dpp(0, v, 0x111, 0xf, 0xf, true); v += __builtin_amdgcn_update_dpp(0, v, 0x112, 0xf, 0xf, true);
    v += __builtin_amdgcn_update_dpp(0, v, 0x114, 0xf, 0xf, true); v += __builtin_amdgcn_update_dpp(0, v, 0x118, 0xf, 0xf, true);
    v += __builtin_amdgcn_update_dpp(0, v, 0x142, 0xa, 0xf, false);
    v += __builtin_amdgcn_update_dpp(0, v, 0x143, 0xc, 0xf, false);
    return v;
}
DI int wave_isum_dpp(int v) {
    v += __builtin_amdgcn_update_dpp(0, v, 0x111, 0xf, 0xf, true); v += __builtin_amdgcn_update_dpp(0, v, 0x112, 0xf, 0xf, true);
    v += __builtin_amdgcn_update_dpp(0, v, 0x114, 0xf, 0xf, true); v += __builtin_amdgcn_update_dpp(0, v, 0x118, 0xf, 0xf, true);
    v += __builtin_amdgcn_update_dpp(0, v, 0x142, 0xa, 0xf, false);
    v += __builtin_amdgcn_update_dpp(0, v, 0x143, 0xc, 0xf, false);
    return __builtin_amdgcn_readlane(v, 63);
}
DI unsigned f2sortable(float s) { const unsigned b = __builtin_bit_cast(unsigned, s); return (b & 0x80000000u) ? ~b : (b | 0x80000000u); }
DI void ph_dsa_index(const Frame& F, const int half) {
    const float* c32 = (const float*)(F.ws + TAB_COS32); const float* s32 = (const float*)(F.ws + TAB_SIN32);
    unsigned char* ar = F.ws + WS_AR;
    const bf16* QIDX = (const bf16*)(ar + DA_QIDX); const bf16* KIDX = (const bf16*)(ar + DA_KIDX); const float* WIDX = (const float*)(ar + DA_WIDX);
    unsigned short* SEL = (unsigned short*)(ar + DA_SEL); int* CNT = (int*)(ar + DA_CNT); float* SC = (float*)(ar + DA_SC) + (size_t)F.gw * 16384;
    const int lane = F.lane, r = lane & 31, hf = lane >> 5;
    LAS unsigned char* wl = F.lds + F.wave * 8192 + lane * 16;
    LAS unsigned* hist = (LAS unsigned*)(F.lds + 65536 + F.wave * 1024);
#pragma unroll 1
    for (int tile = blockIdx.x; tile < BPH * 128; tile += F.G) {
        const int j = tile >> 8, c8 = tile & 255, c7 = c8 & 127, bl = (c8 >> 7) * 2 + j, qt = j ? 127 - c7 : c7;
        const int q0 = qt * 32 + 4 * F.wave;
        const int ntile = (q0 + 3) / 32 + 1;
        bf16x8 qa[2][8];
#pragma unroll
        for (int pr = 0; pr < 2; ++pr) {
            const int mrow = bl * SEQ + q0 + 2 * pr + (r >> 4);
#pragma unroll
            for (int s = 0; s < 8; ++s) qa[pr][s] = *(const bf16x8*)(QIDX + (size_t)mrow * 2048 + (r & 15) * 128 + 16 * s + 8 * hf);
            { const float* cs = c32 + ((size_t)half * MC + mrow) * 16 + 8 * hf; const float* sn = s32 + ((size_t)half * MC + mrow) * 16 + 8 * hf;
              const f32x4 c0 = *(const f32x4*)cs, c1 = *(const f32x4*)(cs + 4), s0 = *(const f32x4*)sn, s1 = *(const f32x4*)(sn + 4);
              const u32x4 a = __builtin_bit_cast(u32x4, qa[pr][0]), b = __builtin_bit_cast(u32x4, qa[pr][1]); u32x4 o1, o2;
#pragma unroll
              for (int e = 0; e < 4; ++e) { const float c_l = e < 2 ? c0[2 * e] : c1[2 * e - 4], c_h = e < 2 ? c0[2 * e + 1] : c1[2 * e - 3], s_l = e < 2 ? s0[2 * e] : s1[2 * e - 4], s_h = e < 2 ? s0[2 * e + 1] : s1[2 * e - 3];
                  const float x1l = bflo(a[e]), x1h = bfhi(a[e]), x2l = bflo(b[e]), x2h = bfhi(b[e]);
                  o1[e] = pk2(x1l * c_l - x2l * s_l, x1h * c_h - x2h * s_h); o2[e] = pk2(x1l * s_l + x2l * c_l, x1h * s_h + x2h * c_h); }
              qa[pr][0] = __builtin_bit_cast(bf16x8, o1); qa[pr][1] = __builtin_bit_cast(bf16x8, o2); }
            float wv[2][16];
#pragma unroll
            for (int i = 0; i < 16; ++i) wv[pr][i] = WIDX[(size_t)(bl * SEQ + q0 + 2 * pr + (i >> 3)) * 16 + (i & 3) + 8 * ((i >> 2) & 1) + 4 * hf];
#pragma unroll
            for (int i = 0; i < 16; i += 4) *(LAS f32x4*)(wl + (pr * 4 + (i >> 2)) * 1024) = (f32x4){wv[pr][i], wv[pr][i + 1], wv[pr][i + 2], wv[pr][i + 3]};
        }
        LDS_WAIT();
        {
        bf16x8 kf[8];
        { const bf16* kp = KIDX + ((size_t)(bl * 128) * 8 * 64 + lane) * 8;
#pragma unroll
          for (int s = 0; s < 8; ++s) kf[s] = *(const bf16x8*)(kp + 512 * s); }
#pragma unroll 1
        for (int t = 0; t < ntile; ++t) {
            f32x16 accs[2];
#pragma unroll
            for (int pr = 0; pr < 2; ++pr) {
#pragma unroll
                for (int i = 0; i < 16; ++i) accs[pr][i] = 0.f;
#pragma unroll
                for (int s = 0; s < 8; ++s) accs[pr] = MFMA32(qa[pr][s], kf[s], accs[pr]);
            }
            if (t + 1 < ntile) { const bf16* kp = KIDX + ((size_t)(bl * 128 + t + 1) * 8 * 64 + lane) * 8;
#pragma unroll
                for (int s = 0; s < 8; ++s) kf[s] = *(const bf16x8*)(kp + 512 * s); }
#pragma unroll
            for (int pr = 0; pr < 2; ++pr) {
                const f32x16 acc = accs[pr];
                float wv[2][16];
                { unsigned wa_ = (unsigned)(size_t)wl; asm volatile("" : "+v"(wa_));
#pragma unroll
                  for (int i = 0; i < 16; i += 4) { const f32x4 w4 = *(const LAS f32x4*)((LAS unsigned char*)(size_t)wa_ + (pr * 4 + (i >> 2)) * 1024); wv[pr][i] = w4.x; wv[pr][i + 1] = w4.y; wv[pr][i + 2] = w4.z; wv[pr][i + 3] = w4.w; } }
                float p0 = 0.f, p1 = 0.f;
#pragma unroll
                for (int i = 0; i < 8; ++i) { p0 += wv[pr][i] * fmaxf(acc[i], 0.f); p1 += wv[pr][8 + i] * fmaxf(acc[8 + i], 0.f); }
                const float t0 = p0 + __shfl_xor(p0, 32), t1 = p1 + __shfl_xor(p1, 32);
                SC[(pr * 128 + t) * 64 + lane] = hf ? t1 : t0;
            }
        }
        }
        VM_WAIT();
#pragma unroll 1
        for (int qi = 0; qi < 4; ++qi) {
            const int tq = q0 + qi, pr = qi >> 1, qs = qi & 1;
            unsigned u[64];
            const unsigned* scp = (const unsigned*)(SC + pr * 8192 + hf * 64 + qs * 32 + r);
#pragma unroll
            for (int g8 = 0; g8 < 8; ++g8) {
#pragma unroll
                for (int e = 0; e < 8; ++e) { const int i = 8 * g8 + e; const float s = __builtin_bit_cast(float, __hip_atomic_load(scp + e * 128, __ATOMIC_RELAXED, __HIP_MEMORY_SCOPE_AGENT));
                    u[i] = (2 * i + hf < ntile && 64 * i + lane <= tq) ? f2sortable(s) : 0u; }
                scp += 1024; asm volatile("" : "+v"(scp));
            }
            unsigned prefix = 0u;
            if (tq >= 256) {
#pragma unroll 1
                for (int bit = 31; bit >= 0; --bit) {
                    const unsigned cand = prefix | (1u << bit); int c = 0;
#pragma unroll
                    for (int g8 = 0; g8 < 8; ++g8) { if (g8 * 512 <= tq) {
#pragma unroll
                        for (int e = 0; e < 8; ++e) c += (u[8 * g8 + e] >= cand) ? 1 : 0; } }
                    c = wave_isum_dpp(c);
                    if (c >= 256) prefix = cand;
                    if (c == 256) break;
                }
            }
            const unsigned T = prefix > 1u ? prefix : 1u;
            int nl = 0;
#pragma unroll
            for (int g8 = 0; g8 < 8; ++g8) { if (g8 * 512 <= tq) {
#pragma unroll
                for (int e = 0; e < 8; ++e) nl += (u[8 * g8 + e] >= T) ? 1 : 0; } }
            const int inc = wave_iscan_dpp(nl), base = __builtin_amdgcn_readlane(inc, 63);
            int pos = inc - nl;
            unsigned short* sel = SEL + (size_t)(bl * SEQ + tq) * 256;
#pragma unroll
            for (int g8 = 0; g8 < 8; ++g8) { if (g8 * 512 <= tq) {
#pragma unroll
                for (int e = 0; e < 8; ++e) { const int i = 8 * g8 + e; if (u[i] >= T) { if (pos < 256) sel[pos] = (unsigned short)(64 * i + lane); ++pos; } } } }
            if (lane == 0) CNT[bl * SEQ + tq] = base < 256 ? base : 256;
        }
    }
}
DI int dsa_fsw(int row) { return ((row & 3) << 2) | ((row >> 2) & 3); }
struct DsaPre { u32x4 row[16]; bf16x8 kpe[3]; bf16x8 q[3]; };
DI void dsa_prefetch(DsaPre& P, const bf16* LATC, const bf16* KPE, const bf16* QL, const bf16* QPE, const float* c48, const float* s48, int half, int ml, int selv, int lane, int w) {
    const int bl = ml >> 12, r = lane & 31, h = lane >> 5;
#pragma unroll
    for (int it = 0; it < 16; ++it) { const int ki = __shfl(selv, (lane >> 5) + 2 * it); P.row[it] = *(const u32x4*)(LATC + (size_t)(bl * SEQ + ki) * 256 + (lane & 31) * 8); }
#pragma unroll
    for (int s = 0; s < 3; ++s) P.kpe[s] = *(const bf16x8*)(KPE + (size_t)(bl * SEQ + selv) * 48 + 16 * s + 8 * h);
#pragma unroll
    for (int j = 0; j < 3; ++j) { const int fi = w + 8 * j;
        if (fi < 16) P.q[j] = *(const bf16x8*)(QL + (size_t)ml * 8192 + r * 256 + 16 * fi + 8 * h);
        else if (fi < 19) P.q[j] = rope_frag32(QPE + (size_t)ml * 1536 + r * 48, fi - 16, h, c48 + ((size_t)half * MC + ml) * 24, s48 + ((size_t)half * MC + ml) * 24); }
}
DI void ph_dsa_attn(const Frame& F, const int half) {
    const float* c48 = (const float*)(F.ws + TAB_COS48); const float* s48 = (const float*)(F.ws + TAB_SIN48);
    unsigned char* ar = F.ws + WS_AR;
    bf16* QL = (bf16*)(ar + DA_QL); const bf16* QPE = (const bf16*)(ar + DA_QPE); const bf16* LATC = (const bf16*)(ar + DA_LATC); const bf16* KPE = (const bf16*)(ar + DA_KPE);
    const unsigned short* SEL = (const unsigned short*)(ar + DA_SEL); const int* CNT = (const int*)(ar + DA_CNT);
    const int lane = F.lane, r = lane & 31, h = lane >> 5, w = F.wave;
    LAS unsigned char* IMG = F.lds; LAS unsigned char* QB = F.lds + LDSCTL_OFF + 256; LAS float* MX = (LAS float*)(F.lds + LDSCTL_OFF + 256 + 19456); LAS float* SX = MX + 256;
    const int i16 = lane & 15, tq_ = i16 >> 2, tp_ = i16 & 3, blk = (lane >> 4) & 1;
    int ml = blockIdx.x;
    if (ml >= MC) return;
    DsaPre P;
    int cnt_c = CNT[ml];
    { const int slot = 32 * w + r; const int selv = slot < cnt_c ? (int)SEL[(size_t)ml * 256 + slot] : 0; dsa_prefetch(P, LATC, KPE, QL, QPE, c48, s48, half, ml, selv, lane, w); }
    int cnt_n = 0, selv_n = 0;
    if (ml + F.G < MC) { cnt_n = CNT[ml + F.G]; const int slot = 32 * w + r; selv_n = slot < cnt_n ? (int)SEL[(size_t)(ml + F.G) * 256 + slot] : 0; }
#pragma unroll 1
    for (; ml < MC; ml += F.G) {
        const int cnt = cnt_c, nch = (cnt + 31) >> 5; const bool act = w < nch;
#pragma unroll
        for (int it = 0; it < 16; ++it) { const int rr = (lane >> 5) + 2 * it; *(LAS u32x4*)(IMG + (32 * w + rr) * 512 + (((lane & 31) ^ dsa_fsw(rr)) * 16)) = P.row[it]; }
#pragma unroll
        for (int j = 0; j < 3; ++j) { const int fi = w + 8 * j; if (fi < 19) *(LAS bf16x8*)(QB + fi * 1024 + lane * 16) = P.q[j]; }
        bf16x8 kpe[3];
#pragma unroll
        for (int s = 0; s < 3; ++s) kpe[s] = P.kpe[s];
        LDS_WAIT(); __builtin_amdgcn_s_barrier(); asm volatile("" ::: "memory");
        if (ml + F.G < MC) {
            dsa_prefetch(P, LATC, KPE, QL, QPE, c48, s48, half, ml + F.G, selv_n, lane, w); cnt_c = cnt_n;
            if (ml + 2 * F.G < MC) { cnt_n = CNT[ml + 2 * F.G]; const int slot = 32 * w + r; selv_n = slot < cnt_n ? (int)SEL[(size_t)(ml + 2 * F.G) * 256 + slot] : 0; }
        }
        f32x16 S; float mx = -INFINITY;
#pragma unroll
        for (int i = 0; i < 16; ++i) S[i] = 0.f;
        if (act) {
#pragma unroll
            for (int s = 0; s < 16; ++s) S = MFMA32(*(const LAS bf16x8*)(IMG + (32 * w + r) * 512 + (((2 * s + h) ^ dsa_fsw(r)) * 16)), *(const LAS bf16x8*)(QB + s * 1024 + lane * 16), S);
#pragma unroll
            for (int s = 0; s < 3; ++s) S = MFMA32(kpe[s], *(const LAS bf16x8*)(QB + (16 + s) * 1024 + lane * 16), S);
#pragma unroll
            for (int i = 0; i < 16; ++i) { S[i] = (32 * w + crow(i, h) < cnt) ? S[i] : -INFINITY; mx = fmaxf(mx, S[i]); }
            mx = fmaxf(mx, __shfl_xor(mx, 32));
        }
        if (h == 0) MX[w * 32 + r] = mx;
        LDS_WAIT(); __builtin_amdgcn_s_barrier(); asm volatile("" ::: "memory");
        float M = MX[r];
#pragma unroll
        for (int k = 1; k < 8; ++k) M = fmaxf(M, MX[k * 32 + r]);
        float lsum = 0.f; bf16x8 pf[2] = {(bf16x8){0, 0, 0, 0, 0, 0, 0, 0}, (bf16x8){0, 0, 0, 0, 0, 0, 0, 0}};
        if (act) {
#pragma unroll
            for (int i = 0; i < 16; ++i) { S[i] = __builtin_amdgcn_exp2f(S[i] - M); lsum += S[i]; }
#pragma unroll
            for (int s = 0; s < 2; ++s) { u32x4 t; t.x = pk2(S[8 * s], S[8 * s + 1]); t.y = pk2(S[8 * s + 2], S[8 * s + 3]); t.z = pk2(S[8 * s + 4], S[8 * s + 5]); t.w = pk2(S[8 * s + 6], S[8 * s + 7]); pf[s] = __builtin_bit_cast(bf16x8, t); }
        }
        lsum += __shfl_xor(lsum, 32);
        if (h == 0) SX[w * 32 + r] = lsum;
        *(LAS bf16x8*)(QB + (2 * w) * 1024 + lane * 16) = pf[0]; *(LAS bf16x8*)(QB + (2 * w + 1) * 1024 + lane * 16) = pf[1];
        LDS_WAIT(); __builtin_amdgcn_s_barrier(); asm volatile("" ::: "memory");
        f32x16 O;
#pragma unroll
        for (int i = 0; i < 16; ++i) O[i] = 0.f;
#pragma unroll 2
        for (int ks = 0; ks < 2 * nch; ++ks) {
            const int r0 = 16 * ks + 4 * h + tq_, r1 = r0 + 8, pc = 4 * w + 2 * blk + (tp_ >> 1);
            const s16x4 lo = __builtin_bit_cast(s16x4, __builtin_amdgcn_ds_read_tr16_b64_v4i16((LAS v4i16_t*)(IMG + r0 * 512 + ((pc ^ dsa_fsw(r0)) * 16) + 8 * (tp_ & 1))));
            const s16x4 hi = __builtin_bit_cast(s16x4, __builtin_amdgcn_ds_read_tr16_b64_v4i16((LAS v4i16_t*)(IMG + r1 * 512 + ((pc ^ dsa_fsw(r1)) * 16) + 8 * (tp_ & 1))));
            O = MFMA32(__builtin_shufflevector(lo, hi, 0, 1, 2, 3, 4, 5, 6, 7), *(const LAS bf16x8*)(QB + ks * 1024 + lane * 16), O);
        }
        float l = SX[r];
#pragma unroll
        for (int k = 1; k < 8; ++k) l += SX[k * 32 + r];
        const float linv = 1.0f / l;
        bf16* o = QL + (size_t)ml * 8192 + r * 256 + 32 * w + 4 * h;
#pragma unroll
        for (int g = 0; g < 4; ++g) { u32x2 t; t.x = pk2(O[4 * g] * linv, O[4 * g + 1] * linv); t.y = pk2(O[4 * g + 2] * linv, O[4 * g + 3] * linv); *(u32x2*)(o + 8 * g) = t; }
        LDS_WAIT(); __builtin_amdgcn_s_barrier(); asm volatile("" ::: "memory");
    }
}
#define LDS_RD(dst, addr, OFF) asm volatile("ds_read_b128 %0, %1 offset:" #OFF : "=v"(dst) : "v"(addr) : "memory")
DI void frag_wait(bf16x8& a, bf16x8& b) { asm volatile("s_waitcnt lgkmcnt(0)" : "+v"(a), "+v"(b)); }
DI void frag_wait(bf16x8& a, bf16x8& b, bf16x8& c) { asm volatile("s_waitcnt lgkmcnt(0)" : "+v"(a), "+v"(b), "+v"(c)); }
template <int NQ> DI void qk_frags(f32x16& S, const LAS unsigned char* kt, int lane, const bf16x8 (&qf)[NQ]) {
    static_assert(NQ == 9 || NQ == 12, "qk_frags: NQ");
    const unsigned ad = (unsigned)(size_t)kt + (unsigned)lane * 16u;
#pragma unroll
    for (int i = 0; i < 16; ++i) S[i] = 0.f;
    bf16x8 f0, f1, f2, f3, f4, f5, f6, f7, f8;
    LDS_RD(f0, ad, 0); LDS_RD(f1, ad, 1024); LDS_RD(f2, ad, 2048);
    frag_wait(f0, f1, f2);
    LDS_RD(f3, ad, 3072); LDS_RD(f4, ad, 4096); LDS_RD(f5, ad, 5120);
    S = MFMA32(f0, qf[0], S); S = MFMA32(f1, qf[1], S); S = MFMA32(f2, qf[2], S);
    frag_wait(f3, f4, f5);
    LDS_RD(f6, ad, 6144); LDS_RD(f7, ad, 7168); LDS_RD(f8, ad, 8192);
    S = MFMA32(f3, qf[3], S); S = MFMA32(f4, qf[4], S); S = MFMA32(f5, qf[5], S);
    frag_wait(f6, f7, f8);
    if constexpr (NQ == 12) {
        bf16x8 f9, f10, f11;
        LDS_RD(f9, ad, 9216); LDS_RD(f10, ad, 10240); LDS_RD(f11, ad, 11264);
        S = MFMA32(f6, qf[6], S); S = MFMA32(f7, qf[7], S); S = MFMA32(f8, qf[8], S);
        frag_wait(f9, f10, f11);
        S = MFMA32(f9, qf[9 % NQ], S); S = MFMA32(f10, qf[10 % NQ], S); S = MFMA32(f11, qf[11 % NQ], S);
    } else {
        S = MFMA32(f6, qf[6], S); S = MFMA32(f7, qf[7], S); S = MFMA32(f8, qf[8], S);
    }
}
DI void pv_frags(f32x16 (&O)[4], const LAS unsigned char* vt, int lane, const bf16x8 (&pf)[2]) {
    const unsigned ad = (unsigned)(size_t)vt + (unsigned)lane * 16u;
    bf16x8 f0, f1, f2, f3, f4, f5, f6, f7;
    LDS_RD(f0, ad, 0); LDS_RD(f1, ad, 1024);
    frag_wait(f0, f1);
    LDS_RD(f2, ad, 2048); LDS_RD(f3, ad, 3072);
    O[0] = MFMA32(f0, pf[0], O[0]); O[0] = MFMA32(f1, pf[1], O[0]);
    frag_wait(f2, f3);
    LDS_RD(f4, ad, 4096); LDS_RD(f5, ad, 5120);
    O[1] = MFMA32(f2, pf[0], O[1]); O[1] = MFMA32(f3, pf[1], O[1]);
    frag_wait(f4, f5);
    LDS_RD(f6, ad, 6144); LDS_RD(f7, ad, 7168);
    O[2] = MFMA32(f4, pf[0], O[2]); O[2] = MFMA32(f5, pf[1], O[2]);
    frag_wait(f6, f7);
    O[3] = MFMA32(f6, pf[0], O[3]); O[3] = MFMA32(f7, pf[1], O[3]);
}
template <int NDB, bool RESC = true> DI void softmax_step(f32x16& S, float& m, float& l, f32x16 (&O)[NDB], bf16x8 (&pf)[2]) {
    float mx = fmaxf(S[0], S[1]);
#pragma unroll
    for (int i = 2; i < 16; i += 2) mx = __builtin_fmaxf(mx, __builtin_fmaxf(S[i], S[i + 1]));
    mx = fmaxf(mx, __shfl_xor(mx, 32));
    const float mn = fmaxf(m, mx), ms = (mn == -INFINITY) ? 0.f : mn;
    const float alpha = __builtin_amdgcn_exp2f(m - ms);
    float sum = 0.f;
#pragma unroll
    for (int i = 0; i < 16; ++i) { S[i] = __builtin_amdgcn_exp2f(S[i] - ms); sum += S[i]; }
    l = l * alpha + sum; m = mn;
    if (RESC && __builtin_amdgcn_ballot_w64(alpha != 1.0f) != 0ull) {
#pragma unroll
        for (int db = 0; db < NDB; ++db)
#pragma unroll
            for (int i = 0; i < 16; ++i) O[db][i] *= alpha;
    }
#pragma unroll
    for (int s = 0; s < 2; ++s) { u32x4 w; w.x = pk2(S[8 * s], S[8 * s + 1]); w.y = pk2(S[8 * s + 2], S[8 * s + 3]); w.z = pk2(S[8 * s + 4], S[8 * s + 5]); w.w = pk2(S[8 * s + 6], S[8 * s + 7]); pf[s] = __builtin_bit_cast(bf16x8, w); }
}
template <bool ACC> DI void store_col(bf16* out, const f32x16 (&O)[4], float scale, int h) {
#pragma unroll
    for (int db = 0; db < 4; ++db)
#pragma unroll
        for (int g = 0; g < 4; ++g) { u32x2* p = (u32x2*)(out + db * 32 + 8 * g + 4 * h);
            float a = O[db][4 * g] * scale, b = O[db][4 * g + 1] * scale, c = O[db][4 * g + 2] * scale, d = O[db][4 * g + 3] * scale;
            if (ACC) { const u32x2 o = *p; a += bflo(o.x); b += bfhi(o.x); c += bflo(o.y); d += bfhi(o.y); }
            u32x2 w; w.x = pk2(a, b); w.y = pk2(c, d); *p = w; }
}
template <int NQ> struct TilePre { u32x4 a, b, c; };
template <int NQ, class SRC> DI void tile_fetch(TilePre<NQ>& p, const SRC& src, int T, int tid) {
    const bf16* k = src.k(T); const bf16* v = src.v(T);
    constexpr int NK = NQ * 64;
    p.a = *(const u32x4*)(k + (size_t)tid * 8);
    const int p1 = tid + 512; p.b = (p1 < NK) ? *(const u32x4*)(k + (size_t)p1 * 8) : *(const u32x4*)(v + (size_t)(p1 - NK) * 8);
    if (NQ * 64 + 512 > 1024) { const int p2 = tid + 1024; if (p2 < NK + 512) p.c = *(const u32x4*)(v + (size_t)(p2 - NK) * 8); }
}
template <int NQ> DI void tile_put(const TilePre<NQ>& p, LAS unsigned char* buf, int tid) {
    *(LAS u32x4*)(buf + tid * 16) = p.a; *(LAS u32x4*)(buf + (tid + 512) * 16) = p.b;
    if (NQ * 64 + 512 > 1024) { if (tid + 1024 < NQ * 64 + 512) *(LAS u32x4*)(buf + (tid + 1024) * 16) = p.c; }
}
template <int NQ, bool PV, class SRC, class MK>
DI void attn_run_sh(LAS unsigned char* tl, int tid, int lane, const bf16x8 (&qf)[NQ], f32x16 (&O)[4], float& m, float& l, int TB, int TE, int tb, int te, const SRC& src, const MK& mk) {
    constexpr int TBYTES = (NQ + 8) * 1024;
    if (TB >= TE) return;
    TilePre<NQ> pre;
    tile_fetch<NQ>(pre, src, TB, tid); tile_put<NQ>(pre, tl, tid);
    LDS_WAIT(); __builtin_amdgcn_s_barrier(); asm volatile("" ::: "memory");
#pragma unroll 1
    for (int T = TB; T < TE; ++T) {
        LAS unsigned char* cur = tl + ((T - TB) & 1) * TBYTES;
        if (T + 1 < TE) tile_fetch<NQ>(pre, src, T + 1, tid);
        if (T >= tb && T < te) {
            f32x16 S; qk_frags<NQ>(S, cur, lane, qf);
            if (mk.need(T)) mk(T, S);
            bf16x8 pf[2]; softmax_step<4, PV>(S, m, l, O, pf);
            if (PV) pv_frags(O, cur + NQ * 1024, lane, pf);
        }
        if (T + 1 < TE) tile_put<NQ>(pre, tl + ((T + 1 - TB) & 1) * TBYTES, tid);
        LDS_WAIT(); __builtin_amdgcn_s_barrier(); asm volatile("" ::: "memory");
    }
}
#define ATTN_QK(dst, kptr) qk_frags<NQ>(dst, (kptr), lane, qf)
#define ATTN_SMPV_NM() do { bf16x8 pf[2]; softmax_step<4, true>(S, m, l, O, pf); pv_frags(O, vc, lane, pf); } while (0)
#define ATTN_SMPV(T_) do { if (mk.need(T_)) mk(T_, S); ATTN_SMPV_NM(); } while (0)
template <int NQ, class SRC, class MK>
DI void attn_run_p(LAS unsigned char* tl, int tid, int lane, const bf16x8 (&qf)[NQ], f32x16 (&O)[4], float& m, float& l, int TB, int TE, int tb, int te, const SRC& src, const MK& mk) {
    constexpr int KB = NQ * 1024, NK = NQ * 64;
    if (TB >= TE) return;
    LAS unsigned char* kbuf = tl; LAS unsigned char* vbuf = tl + 2 * KB;
    const int wid = __builtin_amdgcn_readfirstlane(tid >> 6);
#define ATTN_STAGE_K(T_, kd) do { const bf16* k_ = src.k(T_); __builtin_amdgcn_global_load_lds((const unsigned*)(k_ + (size_t)tid * 8), (LAS unsigned*)((kd) + wid * 1024), 16, 0, 0); \
        if (wid * 64 + 512 < NK) __builtin_amdgcn_global_load_lds((const unsigned*)(k_ + (size_t)(tid + 512) * 8), (LAS unsigned*)((kd) + 8192 + wid * 1024), 16, 0, 0); } while (0)
#define ATTN_STAGE_V(T_, vd) __builtin_amdgcn_global_load_lds((const unsigned*)(src.v(T_) + (size_t)tid * 8), (LAS unsigned*)((vd) + wid * 1024), 16, 0, 0)
#define ATTN_SYNC() do { asm volatile("s_waitcnt vmcnt(0) lgkmcnt(0)" ::: "memory"); __builtin_amdgcn_s_barrier(); asm volatile("" ::: "memory"); } while (0)
    ATTN_STAGE_K(TB, kbuf);
    ATTN_SYNC();
    f32x16 Sn;
    {
        if (TB + 1 < TE) ATTN_STAGE_K(TB + 1, kbuf + KB);
        ATTN_STAGE_V(TB, vbuf);
        if (TB >= tb && TB < te) ATTN_QK(Sn, kbuf);
        ATTN_SYNC();
    }
#pragma unroll 1
    for (int T = TB; T < TE; ++T) {
        const int i = T - TB;
        const LAS unsigned char* kn = kbuf + ((i + 1) & 1) * KB;
        const LAS unsigned char* vc = vbuf + (i & 1) * 8192;
        if (T + 2 < TE) ATTN_STAGE_K(T + 2, kbuf + (i & 1) * KB);
        if (T + 1 < TE) ATTN_STAGE_V(T + 1, vbuf + ((i + 1) & 1) * 8192);
        const bool own = T >= tb && T < te, nxt = T + 1 >= tb && T + 1 < te;
        if (own && nxt) { f32x16 S = Sn; if (mk.need(T)) mk(T, S); ATTN_QK(Sn, kn); ATTN_SMPV_NM(); }
        else if (own) { f32x16 S = Sn; ATTN_SMPV(T); }
        else if (nxt) { ATTN_QK(Sn, kn); }
        ATTN_SYNC();
    }
}
struct FragSrc { const bf16* kb; const bf16* vb; int nq; DI const bf16* k(int T) const { return kb + (size_t)T * nq * 512; } DI const bf16* v(int T) const { return vb + (size_t)T * 8 * 512; } };
constexpr size_t FA_Q = 0, FA_K = 64 * MiB, FA_F = 128 * MiB, FA_V = 136 * MiB, FA_CUM = 200 * MiB, FA_O = 202 * MiB, FA_KF = 266 * MiB, FA_VF = 338 * MiB;
constexpr size_t FW_IN = 0, FW_OUT = (size_t)6400 * 2048;
constexpr float FOX_QSCALE = 0.08838834764831845f * LOG2E;
DI void ph_fox_cvt(const Frame& F, const float* w_in, const float* w_out) {
    bf16* WB = (bf16*)(F.ws + WS_WMIX);
    cvt_job(F, w_in, 6160, DM, 0, 2048, WB + FW_IN, DM, 0, FOX_QSCALE);
    cvt_job(F, w_in, 6160, DM, 2048, 2048, WB + FW_IN, DM, 2048, 1.f);
    cvt_job(F, w_in, 6160, DM, 4096, 2048, WB + FW_IN, DM, 4352, 1.f);
    cvt_job(F, w_in, 6160, DM, 6144, 16, WB + FW_IN, DM, 4096, 1.f);
    zero_bf16(F, WB + FW_IN + (size_t)4112 * DM, (size_t)240 * DM);
    cvt_job(F, w_out, DM, DM, 0, DM, WB + FW_OUT, DM, 0, 1.f);
}
DI void ph_fox_scan(const Frame& F, const float* b_f) {
    unsigned char* ar = F.ws + WS_AR; const bf16* FB = (const bf16*)(ar + FA_F); float* CUM = (float*)(ar + FA_CUM);
    for (int w = F.gw; w < BPH * 16; w += F.NGW) {
        const int bl = w >> 4, hd = w & 15; const float bf_ = b_f[hd];
        float v[64]; float run = 0.f;
#pragma unroll
        for (int i = 0; i < 64; ++i) { const float x = bf2f(FB[(size_t)(bl * SEQ + F.lane * 64 + i) * 256 + hd]) + bf_;
            const float ls = fminf(x, 0.f) - log1pf(expf(-fabsf(x))); run += ls; v[i] = run; }
        float inc = run;
#pragma unroll
        for (int o = 1; o < 64; o <<= 1) { const float y = __shfl_up(inc, o); if (F.lane >= o) inc += y; }
        const float base = inc - run;
        float* dst = CUM + (size_t)w * SEQ + F.lane * 64;
#pragma unroll
        for (int i = 0; i < 64; i += 4) *(f32x4*)(dst + i) = (f32x4){(v[i] + base) * LOG2E, (v[i + 1] + base) * LOG2E, (v[i + 2] + base) * LOG2E, (v[i + 3] + base) * LOG2E};
        bf16* KF9 = (bf16*)(ar + FA_KF) + (size_t)w * 128 * 9 * 512;
#pragma unroll
        for (int i = 0; i < 64; ++i) { const int p = F.lane * 64 + i, tile = p >> 5, r_ = p & 31; const float c = (v[i] + base) * LOG2E;
            const unsigned short hi = f2bf(c); const float c1 = c - bf2f(hi); const unsigned short mid = f2bf(c1); const unsigned short lo = f2bf(c1 - bf2f(mid));
            u32x4 wv; wv.x = 0x3F803F80u; wv.y = 0x3F80u | ((unsigned)(hi ^ 0x8000u) << 16); wv.z = (unsigned)(mid ^ 0x8000u) | ((unsigned)(lo ^ 0x8000u) << 16); wv.w = 0u;
            bf16* d = KF9 + ((size_t)(tile * 9 + 8) * 64 + r_) * 8;
            *(u32x4*)d = wv; *(u32x4*)(d + 32 * 8) = (u32x4){0u, 0u, 0u, 0u}; }
    }
}
struct FoxMK { int tq, h, qt; DI bool need(int t) const { return t == qt; }
    DI void operator()(int t, f32x16& S) const {
#pragma unroll
        for (int i = 0; i < 16; ++i) S[i] = (32 * t + crow(i, h) <= tq) ? S[i] : -INFINITY;
    } };
DI void ph_fox_attn(const Frame& F) {
    unsigned char* ar = F.ws + WS_AR; const bf16* Q = (const bf16*)(ar + FA_Q); const bf16* KF = (const bf16*)(ar + FA_KF); const bf16* VF = (const bf16*)(ar + FA_VF); const float* CUM = (const float*)(ar + FA_CUM); bf16* Ob = (bf16*)(ar + FA_O);
    const int r = F.lane & 31, h = F.lane >> 5;
    for (int wb = blockIdx.x; wb < BPH * 16 * 4; wb += F.G) {
        const int bh = wb >> 2, x = (wb & 3) * 8 + F.wave, bl = bh >> 4, hd = bh & 15;
#pragma unroll 1
        for (int k = 0; k < 4; ++k) {
            const int qt = (k == 0) ? x : (k == 1) ? 63 - x : (k == 2) ? 64 + x : 127 - x;
            const int qhi = (k == 0) ? (wb & 3) * 8 + 7 : (k == 1) ? 63 - (wb & 3) * 8 : (k == 2) ? 64 + (wb & 3) * 8 + 7 : 127 - (wb & 3) * 8;
            const int tq = qt * 32 + r; const size_t mrow = (size_t)bl * SEQ + tq;
            bf16x8 qf[9];
#pragma unroll
            for (int s = 0; s < 8; ++s) qf[s] = *(const bf16x8*)(Q + mrow * DM + hd * 128 + 16 * s + 8 * h);
            { const float ct = CUM[(size_t)bh * SEQ + tq]; const unsigned short hi = f2bf(ct); const float c1 = ct - bf2f(hi); const unsigned short mid = f2bf(c1); const unsigned short lo = f2bf(c1 - bf2f(mid));
              u32x4 wq; wq.x = (unsigned)hi | ((unsigned)mid << 16); wq.y = (unsigned)lo | (0x3F80u << 16); wq.z = 0x3F803F80u; wq.w = 0u;
              if (h) wq = (u32x4){0u, 0u, 0u, 0u};
              qf[8] = __builtin_bit_cast(bf16x8, wq); }
            f32x16 O[4];
#pragma unroll
            for (int db = 0; db < 4; ++db)
#pragma unroll
                for (int i = 0; i < 16; ++i) O[db][i] = 0.f;
            float m = -INFINITY, l = 0.f;
            const FragSrc src{KF + (size_t)bh * 128 * 9 * 512, VF + (size_t)bh * 128 * 8 * 512, 9}; const FoxMK mk{tq, h, qt};
            attn_run_sh<9, true>(F.lds, F.tid, F.lane, qf, O, m, l, 0, qhi + 1, 0, qt + 1, src, mk);
            l += __shfl_xor(l, 32);
            store_col<false>(Ob + mrow * DM + hd * 128, O, l > 0.f ? 1.0f / l : 0.f, h);
        }
    }
}
typedef long fp8x8_t;
DI fp8x8_t pack_fp8x8(float a0, float a1, float a2, float a3, float a4, float a5, float a6, float a7) {
    int lo = 0, hi = 0;
    lo = __builtin_amdgcn_cvt_pk_fp8_f32(a0, a1, lo, false); lo = __builtin_amdgcn_cvt_pk_fp8_f32(a2, a3, lo, true);
    hi = __builtin_amdgcn_cvt_pk_fp8_f32(a4, a5, hi, false); hi = __builtin_amdgcn_cvt_pk_fp8_f32(a6, a7, hi, true);
    return (fp8x8_t)(((unsigned long long)(unsigned)hi << 32) | (unsigned long long)(unsigned)lo);
}
#define MFMA32F8(a, b, c) __builtin_amdgcn_mfma_f32_32x32x16_fp8_fp8((a), (b), (c), 0, 0, 0)
constexpr size_t NA_Q = 0, NA_KC = 288 * MiB, NA_VC = 313 * MiB, NA_KSR = 330 * MiB, NA_KWR = 354 * MiB, NA_GT = 378 * MiB, NA_VSR = 386 * MiB, NA_VWR = 402 * MiB, NA_GK = 418 * MiB, NA_GV = 420 * MiB,
                 NA_KCMP = 422 * MiB, NA_VCT = 424 * MiB, NA_SELB = 426 * MiB, NA_O = 428 * MiB,
                 NA_KSF = 620 * MiB, NA_KWF = 644 * MiB, NA_VSF = 668 * MiB, NA_VWF = 684 * MiB;
constexpr size_t NW_IN = 0, NW_W1K = (size_t)13312 * 2048, NW_W1V = NW_W1K + (size_t)256 * 6144, NW_W2K = NW_W1V + (size_t)256 * 4096, NW_W2V = NW_W2K + 65536, NW_OUT = NW_W2V + 65536;
constexpr float NSA_QSCALE = 0.07216878364870322f * LOG2E;
DI void ph_nsa_cvt(const Frame& F, const float* w_in, const float* k_pe, const float* k_w1, const float* k_b1, const float* k_w2, const float* v_pe, const float* v_w1, const float* v_b1, const float* v_w2, const float* w_out) {
    bf16* WB = (bf16*)(F.ws + WS_WMIX); float* BIAS = (float*)(F.ws + WS_MISC);
    cvt_job(F, w_in, 13200, DM, 0, 9216, WB + NW_IN, DM, 0, NSA_QSCALE);
    cvt_job(F, w_in, 13200, DM, 9216, 768, WB + NW_IN, DM, 9216, 1.f);
    cvt_job(F, w_in, 13200, DM, 9984, 512, WB + NW_IN, DM, 9984, 1.f);
    cvt_job(F, w_in, 13200, DM, 10496, 768, WB + NW_IN, DM, 10496, 1.f);
    cvt_job(F, w_in, 13200, DM, 11776, 768, WB + NW_IN, DM, 11264, 1.f);
    cvt_job(F, w_in, 13200, DM, 13056, 144, WB + NW_IN, DM, 12032, 1.f);
    zero_bf16(F, WB + NW_IN + (size_t)12176 * DM, (size_t)112 * DM);
    cvt_job(F, w_in, 13200, DM, 11264, 512, WB + NW_IN, DM, 12288, 1.f);
    cvt_job(F, w_in, 13200, DM, 12544, 512, WB + NW_IN, DM, 12800, 1.f);
    cvt_job(F, k_w1, 256, 6144, 0, 256, WB + NW_W1K, 6144, 0, 1.f);
    cvt_job(F, v_w1, 256, 4096, 0, 256, WB + NW_W1V, 4096, 0, 1.f);
    cvt_job(F, k_w2, 192, 256, 0, 192, WB + NW_W2K, 256, 0, 1.f); zero_bf16(F, WB + NW_W2K + 192 * 256, 64 * 256);
    cvt_job(F, v_w2, 128, 256, 0, 128, WB + NW_W2V, 256, 0, 1.f); zero_bf16(F, WB + NW_W2V + 128 * 256, 128 * 256);
    cvt_job(F, w_out, DM, 6144, 0, DM, WB + NW_OUT, 6144, 0, 1.f);
    for (int w = F.gw; w < 512; w += F.NGW) { const bool isk = w < 256; const int c = w & 255, n = isk ? 6144 : 4096; const float* pe = isk ? k_pe : v_pe; const float* w1 = isk ? k_w1 : v_w1;
        float s = 0.f; for (int i = F.lane; i < n; i += 64) s += pe[i] * w1[(size_t)i * 256 + c];
        s = wave_sum(s); if (F.lane == 0) BIAS[w] = s + (isk ? k_b1[c] : v_b1[c]); }
}
DI void ph_nsa_rope(const Frame& F, int half) {
    unsigned char* ar = F.ws + WS_AR; bf16* Q = (bf16*)(ar + NA_Q); bf16* KC = (bf16*)(ar + NA_KC);
    const bf16* KSR = (const bf16*)(ar + NA_KSR); const bf16* KWR = (const bf16*)(ar + NA_KWR); bf16* KSF = (bf16*)(ar + NA_KSF); bf16* KWF = (bf16*)(ar + NA_KWF);
    const float* c48 = (const float*)(F.ws + TAB_COS48); const float* s48 = (const float*)(F.ws + TAB_SIN48);
    for (int ml = F.gw; ml < MC; ml += F.NGW) {
        const size_t mg = (size_t)half * MC + ml; const int bl = ml >> 12, sq = ml & 4095;
        for (int p = F.lane; p < 96; p += 64) {
            const int hd = 48 + p / 24, i = p - (p / 24) * 24; bf16* q;
            q = KC + ((size_t)(bl * 4 + hd - 48) * 4096 + sq) * 192 + i;
            const float x1 = bf2f(q[0]), x2 = bf2f(q[24]), c = c48[mg * 24 + i], s = s48[mg * 24 + i]; q[0] = f2bf(x1 * c - x2 * s); q[24] = f2bf(x1 * s + x2 * c);
        }
        const int tile = sq >> 5, rr = sq & 31;
        for (int u = F.lane; u < 168; u += 64) {
            const int tens = u / 84, uu = u - tens * 84, g = uu / 21, v = uu - g * 21;
            const bf16* src = (tens ? KWR : KSR) + (size_t)ml * 768 + g * 192;
            bf16* dst = (tens ? KWF : KSF) + ((size_t)((bl * 4 + g) * 128 + tile) * 12 * 64 + rr) * 8;
            if (v < 3) {
                const u32x4 a = *(const u32x4*)(src + 8 * v), b = *(const u32x4*)(src + 8 * v + 24); u32x4 o1, o2;
#pragma unroll
                for (int e = 0; e < 4; ++e) { const float c0 = c48[mg * 24 + 8 * v + 2 * e], s0 = s48[mg * 24 + 8 * v + 2 * e], c1 = c48[mg * 24 + 8 * v + 2 * e + 1], s1 = s48[mg * 24 + 8 * v + 2 * e + 1];
                    const float x1l = bflo(a[e]), x1h = bfhi(a[e]), x2l = bflo(b[e]), x2h = bfhi(b[e]);
                    o1[e] = pk2(x1l * c0 - x2l * s0, x1h * c1 - x2h * s1); o2[e] = pk2(x1l * s0 + x2l * c0, x1h * s1 + x2h * c1); }
                const int p1 = v, p2 = v + 3;
                if (tens) { *(u32x4*)(dst + ((p1 >> 1) * 64 + (p1 & 1) * 32) * 8) = o1; *(u32x4*)(dst + ((p2 >> 1) * 64 + (p2 & 1) * 32) * 8) = o2; }
                else { unsigned char* d8 = (unsigned char*)KSF + ((size_t)(((bl * 4 + g) * 128 + tile) * 2 + (rr >> 4)) * 6 * 64 + (rr & 15)) * 8;
                    *(fp8x8_t*)(d8 + ((p1 >> 2) * 64 + (p1 & 3) * 16) * 8) = pack_fp8x8(bflo(o1[0]), bfhi(o1[0]), bflo(o1[1]), bfhi(o1[1]), bflo(o1[2]), bfhi(o1[2]), bflo(o1[3]), bfhi(o1[3]));
                    *(fp8x8_t*)(d8 + ((p2 >> 2) * 64 + (p2 & 3) * 16) * 8) = pack_fp8x8(bflo(o2[0]), bfhi(o2[0]), bflo(o2[1]), bfhi(o2[1]), bflo(o2[2]), bfhi(o2[2]), bflo(o2[3]), bfhi(o2[3])); }
            } else { const int pc = v + 3; const u32x4 c = *(const u32x4*)(src + 8 * pc);
                if (tens) *(u32x4*)(dst + ((pc >> 1) * 64 + (pc & 1) * 32) * 8) = c;
                else { unsigned char* d8 = (unsigned char*)KSF + ((size_t)(((bl * 4 + g) * 128 + tile) * 2 + (rr >> 4)) * 6 * 64 + (rr & 15)) * 8;
                    *(fp8x8_t*)(d8 + ((pc >> 2) * 64 + (pc & 3) * 16) * 8) = pack_fp8x8(bflo(c[0]), bfhi(c[0]), bflo(c[1]), bfhi(c[1]), bflo(c[2]), bfhi(c[2]), bflo(c[3]), bfhi(c[3])); } }
        }
    }
}
DI float sigmoidf_(float x) { return __builtin_amdgcn_rcpf(1.0f + __builtin_amdgcn_exp2f(-x * LOG2E)); }
struct CmpMK { int tq, h, q0; DI bool need(int t) const { return 512 * t + 527 > q0; }
    DI void operator()(int t, f32x16& S) const {
#pragma unroll
    for (int i = 0; i < 16; ++i) { const int n = 32 * t + crow(i, h); S[i] = (16 * n + 31 <= tq) ? S[i] : -INFINITY; } } };
struct WinMK { int tq, h, qt; DI bool need(int t) const { return t == qt || t == qt - 16; }
    DI void operator()(int t, f32x16& S) const {
#pragma unroll
    for (int i = 0; i < 16; ++i) { const int k = 32 * t + crow(i, h); S[i] = (k <= tq && k > tq - 512) ? S[i] : -INFINITY; } } };
DI void ph_nsa_cmp(const Frame& F, const int half) {
    const float* c48 = (const float*)(F.ws + TAB_COS48); const float* s48 = (const float*)(F.ws + TAB_SIN48);
    unsigned char* ar = F.ws + WS_AR; const bf16* Q = (const bf16*)(ar + NA_Q); const bf16* KCMP = (const bf16*)(ar + NA_KCMP); const bf16* VCT = (const bf16*)(ar + NA_VCT); const bf16* GT = (const bf16*)(ar + NA_GT);
    unsigned char* SELB = ar + NA_SELB; bf16* Ob = (bf16*)(ar + NA_O);
    LAS float* imp = (LAS float*)F.lds;
    LAS unsigned char* kres = F.lds + 20480;
    LAS unsigned char* vring = F.lds + 20480 + 98304;
    const int lane = F.lane, r = lane & 31, h = lane >> 5, tid = F.tid;
    for (int u = blockIdx.x; u < BPH * 4 * 64; u += F.G) {
        const int bg = u >> 6, qt64 = ((u >> 8) & 1) ? 63 - (u & 63) : (u & 63), bl = bg >> 2, g = bg & 3;
        const int tqmaxb = qt64 * 64 + 63, TE = (tqmaxb >= 31) ? ((tqmaxb - 31) / 16) / 32 + 1 : 0;
        const bf16* ksrc = KCMP + (size_t)bg * 8 * 12 * 512; const bf16* vsrc = VCT + (size_t)bg * 8 * 8 * 512;
        for (int i = F.tid; i < 64 * 65; i += NWAVES * 64) imp[i] = 0.f;
        for (int p = tid; p < TE * 768; p += NWAVES * 64) *(LAS u32x4*)(kres + p * 16) = *(const u32x4*)(ksrc + (size_t)p * 8);
        __syncthreads();
#pragma unroll 1
        for (int k = 0; k < 3; ++k) {
            const int idx = F.wave * 3 + k, j = idx >> 1, sub = idx & 1, ql = sub * 32 + r, tq = qt64 * 64 + ql, hd = g * 12 + j;
            const size_t mrow = (size_t)bl * SEQ + tq;
            bf16x8 qf[12];
#pragma unroll
            for (int s = 3; s < 12; ++s) qf[s] = *(const bf16x8*)(Q + mrow * 9216 + hd * 192 + 16 * s + 8 * h);
            { const float* cs = c48 + ((size_t)half * MC + mrow) * 24; const float* sn = s48 + ((size_t)half * MC + mrow) * 24;
#pragma unroll
              for (int s = 0; s < 3; ++s) qf[s] = rope_frag32(Q + mrow * 9216 + hd * 192, s, h, cs, sn); }
            const int tqmax = qt64 * 64 + sub * 32 + 31, te = (tqmax >= 31) ? ((tqmax - 31) / 16) / 32 + 1 : 0;
            const CmpMK mk{tq, h, qt64 * 64 + sub * 32};
            float m = -INFINITY, l = 0.f;
            {
                f32x16 Od[4];
#pragma unroll 1
                for (int t = 0; t < te; ++t) {
                    const LAS unsigned char* cur = kres + t * 12288;
                    f32x16 S;
#pragma unroll
                    for (int i = 0; i < 16; ++i) S[i] = 0.f;
#pragma unroll
                    for (int s = 0; s < 12; ++s) S = MFMA32(*(const LAS bf16x8*)(cur + s * 1024 + lane * 16), qf[s], S);
                    if (mk.need(t)) mk(t, S);
                    bf16x8 pfd[2]; softmax_step<4, false>(S, m, l, Od, pfd);
                }
            }
            l += __shfl_xor(l, 32);
            const float linv = l > 0.f ? 1.0f / l : 0.f, ms = (m == -INFINITY) ? 0.f : m;
            f32x16 O[4];
#pragma unroll
            for (int db = 0; db < 4; ++db)
#pragma unroll
                for (int i = 0; i < 16; ++i) O[db][i] = 0.f;
            if (TE > 0) {
                u32x4 pv = *(const u32x4*)(vsrc + (size_t)tid * 8);
                *(LAS u32x4*)(vring + tid * 16) = pv;
                LDS_WAIT(); __builtin_amdgcn_s_barrier(); asm volatile("" ::: "memory");
#pragma unroll 1
                for (int t = 0; t < TE; ++t) {
                    const LAS unsigned char* cur = kres + t * 12288; const LAS unsigned char* vcur = vring + (t & 1) * 8192;
                    if (t + 1 < TE) pv = *(const u32x4*)(vsrc + ((size_t)(t + 1) * 512 + tid) * 8);
                    if (t < te) {
                        f32x16 S;
#pragma unroll
                        for (int i = 0; i < 16; ++i) S[i] = 0.f;
#pragma unroll
                        for (int s = 0; s < 12; ++s) S = MFMA32(*(const LAS bf16x8*)(cur + s * 1024 + lane * 16), qf[s], S);
                        if (mk.need(t)) mk(t, S);
#pragma unroll
                        for (int i = 0; i < 16; ++i) S[i] = __builtin_amdgcn_exp2f(S[i] - ms) * linv;
#pragma unroll
                        for (int g4 = 0; g4 < 4; ++g4) { const float gs = (S[4 * g4] + S[4 * g4 + 1]) + (S[4 * g4 + 2] + S[4 * g4 + 3]); const int mb = 8 * t + 2 * g4 + h;
                            __hip_atomic_fetch_add(imp + ql * 65 + mb, gs, __ATOMIC_RELAXED, __HIP_MEMORY_SCOPE_WORKGROUP);
                            if (mb + 1 < 64) __hip_atomic_fetch_add(imp + ql * 65 + mb + 1, S[4 * g4 + 3], __ATOMIC_RELAXED, __HIP_MEMORY_SCOPE_WORKGROUP); }
                        bf16x8 pf[2];
#pragma unroll
                        for (int s = 0; s < 2; ++s) { u32x4 w; w.x = pk2(S[8 * s], S[8 * s + 1]); w.y = pk2(S[8 * s + 2], S[8 * s + 3]); w.z = pk2(S[8 * s + 4], S[8 * s + 5]); w.w = pk2(S[8 * s + 6], S[8 * s + 7]); pf[s] = __builtin_bit_cast(bf16x8, w); }
#pragma unroll
                        for (int db = 0; db < 4; ++db)
#pragma unroll
                            for (int s = 0; s < 2; ++s) O[db] = MFMA32(*(const LAS bf16x8*)(vcur + (db * 2 + s) * 1024 + lane * 16), pf[s], O[db]);
                    }
                    if (t + 1 < TE) *(LAS u32x4*)(vring + ((t + 1) & 1) * 8192 + tid * 16) = pv;
                    LDS_WAIT(); __builtin_amdgcn_s_barrier(); asm volatile("" ::: "memory");
                }
            }
            const float gate = sigmoidf_(bf2f(GT[mrow * 256 + hd]));
            store_col<false>(Ob + mrow * 6144 + hd * 128, O, gate, h);
        }
        __syncthreads();
#pragma unroll 1
        for (int k = 0; k < 8; ++k) {
            const int ql = F.wave * 8 + k, tq = qt64 * 64 + ql, cur = tq >> 6, mb = lane;
            const bool causal = mb <= cur, forced = (mb == 0) || (mb == cur) || (mb == cur - 1);
            const float v = causal ? (forced ? INFINITY : imp[ql * 65 + mb]) : -INFINITY;
            int rank = 0;
            for (int o = 0; o < 64; ++o) { const float vo = __shfl(v, o); rank += (vo > v || (vo == v && o < mb)) ? 1 : 0; }
            if (rank < 16) SELB[((size_t)bg * 4096 + tq) * 16 + rank] = causal ? (unsigned char)mb : (unsigned char)0xFF;
        }
        __syncthreads();
    }
}
DI int sel_tile(const u32x4& sel, int t) { const int b = t >> 1; const unsigned w = (b < 4) ? sel.x : (b < 8) ? sel.y : (b < 12) ? sel.z : sel.w; return (int)((w >> ((b & 3) * 8)) & 0xFFu) * 2 + (t & 1); }
struct SelMK { u32x4 sel; int tq, h; DI void operator()(int t, f32x16& S) const { const int k0 = sel_tile(sel, t) * 32;
#pragma unroll
    for (int i = 0; i < 16; ++i) S[i] = (k0 + crow(i, h) <= tq) ? S[i] : -INFINITY; } };
typedef float f32x4_ __attribute__((ext_vector_type(4)));
#define MFMA16F8(a, b, c) __builtin_amdgcn_mfma_f32_16x16x32_fp8_fp8((a), (b), (c), 0, 0, 0)
DI void ph_nsa_sel(const Frame& F, const int half) {
    const float* c48 = (const float*)(F.ws + TAB_COS48); const float* s48 = (const float*)(F.ws + TAB_SIN48);
    unsigned char* ar = F.ws + WS_AR; const bf16* Q = (const bf16*)(ar + NA_Q); const unsigned char* KS8 = ar + NA_KSF; const unsigned char* VS8 = ar + NA_VSF; const bf16* GT = (const bf16*)(ar + NA_GT);
    const unsigned char* SELB = ar + NA_SELB; bf16* Ob = (bf16*)(ar + NA_O);
    const int c16 = F.lane & 15, kq = F.lane >> 4; const bool act = c16 < 12;
    for (int it = F.gw; it < BPH * 4 * SEQ; it += F.NGW) {
        const int bg = it >> 12, tq = ((it & 4095) + 256 * bg) & 4095, bl = bg >> 2, g = bg & 3; const size_t mrow = (size_t)bl * SEQ + tq; const int hd = g * 12 + (act ? c16 : 0);
        fp8x8_t qf[6];
#pragma unroll
        for (int s = 0; s < 6; ++s) { const float qs = act ? (1.0f / NSA_QSCALE) : 0.f; const int p = 4 * s + kq;
            if (s < 2 && p < 6) { float o[8]; rope_piece(Q + mrow * 9216 + hd * 192, p, c48 + ((size_t)half * MC + mrow) * 24, s48 + ((size_t)half * MC + mrow) * 24, o);
                qf[s] = pack_fp8x8(o[0] * qs, o[1] * qs, o[2] * qs, o[3] * qs, o[4] * qs, o[5] * qs, o[6] * qs, o[7] * qs); }
            else { const u32x4 q = *(const u32x4*)(Q + mrow * 9216 + hd * 192 + 32 * s + 8 * kq);
                qf[s] = pack_fp8x8(bflo(q[0]) * qs, bfhi(q[0]) * qs, bflo(q[1]) * qs, bfhi(q[1]) * qs, bflo(q[2]) * qs, bfhi(q[2]) * qs, bflo(q[3]) * qs, bfhi(q[3]) * qs); } }
        const u32x4 sel = *(const u32x4*)(SELB + ((size_t)bg * 4096 + tq) * 16);
        const int nv = ((tq >> 6) + 1 < 16) ? (tq >> 6) + 1 : 16, te = 2 * nv;
        const unsigned char* kb = KS8 + ((size_t)bg * 128 * 12 * 64 + F.lane) * 8; const unsigned char* vb = VS8 + ((size_t)bg * 128 * 8 * 64 + F.lane) * 8;
        f32x4_ O[8];
#pragma unroll
        for (int db = 0; db < 8; ++db) O[db] = (f32x4_){0.f, 0.f, 0.f, 0.f};
        float m = -INFINITY, l = 0.f;
        fp8x8_t kfA[12], kfB[12], vfA[8], vfB[8];
        { const unsigned char* kp = kb + (size_t)sel_tile(sel, 0) * 12 * 512; const unsigned char* kp1 = kb + (size_t)sel_tile(sel, 1) * 12 * 512; const unsigned char* vp = vb + (size_t)sel_tile(sel, 0) * 8 * 512;
#pragma unroll
          for (int s = 0; s < 12; ++s) { kfA[s] = *(const fp8x8_t*)(kp + s * 512); kfB[s] = *(const fp8x8_t*)(kp1 + s * 512); }
#pragma unroll
          for (int j = 0; j < 8; ++j) vfA[j] = *(const fp8x8_t*)(vp + j * 512); }
#define SEL_STEP(T_, KF_, VF_, VFN_) do { const int t_ = (T_); const int tile = sel_tile(sel, t_); \
            if (t_ + 1 < te) { const unsigned char* vp = vb + (size_t)sel_tile(sel, t_ + 1) * 8 * 512; _Pragma("unroll") for (int j = 0; j < 8; ++j) VFN_[j] = *(const fp8x8_t*)(vp + j * 512); } \
            f32x4_ S0 = {0.f, 0.f, 0.f, 0.f}, S1 = S0; \
            _Pragma("unroll") for (int s = 0; s < 6; ++s) { S0 = MFMA16F8(KF_[s], qf[s], S0); S1 = MFMA16F8(KF_[6 + s], qf[s], S1); } \
            if (t_ + 2 < te) { const unsigned char* kp = kb + (size_t)sel_tile(sel, t_ + 2) * 12 * 512; _Pragma("unroll") for (int s = 0; s < 12; ++s) KF_[s] = *(const fp8x8_t*)(kp + s * 512); } \
            const int k0 = tile * 32 + 4 * kq; float mx = -INFINITY; \
            _Pragma("unroll") for (int i = 0; i < 4; ++i) { S0[i] = (k0 + i <= tq) ? S0[i] * NSA_QSCALE : -INFINITY; S1[i] = (k0 + 16 + i <= tq) ? S1[i] * NSA_QSCALE : -INFINITY; mx = fmaxf(mx, fmaxf(S0[i], S1[i])); } \
            mx = fmaxf(mx, __shfl_xor(mx, 16)); mx = fmaxf(mx, __shfl_xor(mx, 32)); \
            const float mn = fmaxf(m, mx), ms = (mn == -INFINITY) ? 0.f : mn, alpha = __builtin_amdgcn_exp2f(m - ms); \
            float sum = 0.f; \
            _Pragma("unroll") for (int i = 0; i < 4; ++i) { S0[i] = __builtin_amdgcn_exp2f(S0[i] - ms); S1[i] = __builtin_amdgcn_exp2f(S1[i] - ms); sum += S0[i] + S1[i]; } \
            l = l * alpha + sum; m = mn; \
            if (__builtin_amdgcn_ballot_w64(alpha != 1.0f) != 0ull) { _Pragma("unroll") for (int db = 0; db < 8; ++db) O[db] = O[db] * alpha; } \
            const fp8x8_t p8 = pack_fp8x8(S0[0], S0[1], S0[2], S0[3], S1[0], S1[1], S1[2], S1[3]);       \
            _Pragma("unroll") for (int db = 0; db < 8; ++db) O[db] = MFMA16F8(VF_[db], p8, O[db]); } while (0)
#pragma unroll 1
        for (int t = 0; t < te; t += 2) { SEL_STEP(t, kfA, vfA, vfB); SEL_STEP(t + 1, kfB, vfB, vfA); }
#undef SEL_STEP
        l += __shfl_xor(l, 16); l += __shfl_xor(l, 32);
        if (act) { const float gate = sigmoidf_(bf2f(GT[mrow * 256 + 48 + hd])); const float sc = l > 0.f ? gate / l : 0.f;
            bf16* o = Ob + mrow * 6144 + hd * 128 + 4 * kq;
#pragma unroll
            for (int db = 0; db < 8; ++db) { u32x2* p = (u32x2*)(o + db * 16); const u32x2 prev = *p;
                u32x2 w; w.x = pk2(O[db][0] * sc + bflo(prev.x), O[db][1] * sc + bfhi(prev.x)); w.y = pk2(O[db][2] * sc + bflo(prev.y), O[db][3] * sc + bfhi(prev.y)); *p = w; } }
    }
}
DI void ph_nsa_win(const Frame& F, const int half) {
    const float* c48 = (const float*)(F.ws + TAB_COS48); const float* s48 = (const float*)(F.ws + TAB_SIN48);
    unsigned char* ar = F.ws + WS_AR; const bf16* Q = (const bf16*)(ar + NA_Q); const bf16* KWF = (const bf16*)(ar + NA_KWF); const bf16* VWF = (const bf16*)(ar + NA_VWF); const bf16* GT = (const bf16*)(ar + NA_GT); bf16* Ob = (bf16*)(ar + NA_O);
    const int r = F.lane & 31, h = F.lane >> 5;
    for (int idb = blockIdx.x; idb < BPH * 4 * 3 * 64; idb += F.G) {
        const int qt0 = (((idb & 63) + (idb >> 8)) & 63) * 2, qt = qt0 + (F.wave & 1), rest = idb >> 6, hq = rest % 3, bg = rest / 3, bl = bg >> 2, g = bg & 3, hd = g * 12 + hq * 4 + (F.wave >> 1), tq = qt * 32 + r; const size_t mrow = (size_t)bl * SEQ + tq;
        bf16x8 qf[12];
#pragma unroll
        for (int s = 3; s < 12; ++s) qf[s] = *(const bf16x8*)(Q + mrow * 9216 + hd * 192 + 16 * s + 8 * h);
        { const float* cs = c48 + ((size_t)half * MC + mrow) * 24; const float* sn = s48 + ((size_t)half * MC + mrow) * 24;
#pragma unroll
          for (int s = 0; s < 3; ++s) qf[s] = rope_frag32(Q + mrow * 9216 + hd * 192, s, h, cs, sn); }
        const FragSrc src{KWF + (size_t)bg * 128 * 12 * 512, VWF + (size_t)bg * 128 * 8 * 512, 12}; const WinMK mk{tq, h, qt};
        f32x16 O[4];
#pragma unroll
        for (int db = 0; db < 4; ++db)
#pragma unroll
            for (int i = 0; i < 16; ++i) O[db][i] = 0.f;
        float m = -INFINITY, l = 0.f;
        attn_run_sh<12, true>(F.lds, F.tid, F.lane, qf, O, m, l, qt0 >= 16 ? qt0 - 16 : 0, qt0 + 2, qt >= 16 ? qt - 16 : 0, qt + 1, src, mk);
        l += __shfl_xor(l, 32);
        const float gate = sigmoidf_(bf2f(GT[mrow * 256 + 96 + hd]));
        store_col<true>(Ob + mrow * 6144 + hd * 128, O, l > 0.f ? gate / l : 0.f, h);
    }
}
#ifndef MK_ONE_LAUNCH
#define MK_ONE_LAUNCH 1
#endif
constexpr int NPH = 69;
struct Args { const float* in[58]; float* out; unsigned char* ws; int ph_lo, ph_hi; };
#define GEMM_AKOFF 0
#define GEMM_CALL(EpiT, Evar, Aptr, Bptr, Mv, Nv, Kv, ldav, ldbv, cidx) do { const pg8::Gemm g_{(const pg8::bf16_t*)(Aptr), (const pg8::bf16_t*)(Bptr), (Mv), (Nv), (Kv), (ldav), (ldbv), GEMM_AKOFF}; \
    pg8::StaticOrder S_; S_.init((Mv), (Nv), F.G, (cidx)); pg8::gemm_phase<EpiT, pg8::StaticOrder, true, true>((PG8_LAS unsigned char*)F.lds, g_, S_, Evar); } while (0)
DI pg8::EpiBf16R epi1(bf16* base, int ldc) { pg8::EpiBf16R e; for (int s = 0; s < 8; ++s) { e.T.base[s] = base; e.T.ldc[s] = ldc; e.T.t0[s] = 0; e.T.gw[s] = 0; } e.T.nseg = 1; e.T.pad_ = 0; e.ssp = nullptr; e.ss_off = 0; return e; }
#define PH_BEGIN if (ph >= lo && ph < hi) { Frame F; { unsigned long long w_ = (unsigned long long)args.ws; asm volatile("" : "+s"(w_)); F.ws = (unsigned char*)w_; F.ctl = (unsigned*)(F.ws + WS_CTL); } \
    F.lds = lds; F.tid = threadIdx.x; F.lane = F.tid & 63; F.wave = __builtin_amdgcn_readfirstlane(F.tid >> 6); F.G = gridDim.x; F.gw = blockIdx.x * NWAVES + F.wave; F.NGW = F.G * NWAVES; \
    float* out; { unsigned long long o_ = (unsigned long long)args.out; asm volatile("" : "+s"(o_)); out = (float*)o_; } \
    unsigned char* const ar = F.ws + WS_AR; bf16* const XN = (bf16*)(F.ws + WS_XNR); float* const SSB = (float*)(F.ws + WS_SS); bf16* const WB = (bf16*)(F.ws + WS_WMIX); bf16* const WUP = (bf16*)(F.ws + WS_WFFN); bf16* const WDN = WUP + (size_t)2 * DFF * DM; \
    const float* const res_mix = (ib == 2) ? args.in[0] : (const float*)out; (void)ar; (void)XN; (void)SSB; (void)WB; (void)WUP; (void)WDN; (void)res_mix; (void)iff;
#define PH_END   if (ph + 1 < hi) { XcdBarrier b_; b_.bar = (unsigned*)F.ctl + CW_BAR; b_.x = xb_xcc_id(); b_.st = MISC + 8; xcd_barrier(b_); } } ++ph;
template <int LAYER> DI void run_cvt(const Args& args, LAS unsigned char* lds, volatile LAS unsigned* MISC, int& ph, const int lo, const int hi) {
    constexpr int ib = (LAYER == 0) ? 2 : (LAYER == 1) ? 17 : (LAYER == 2) ? 26 : 42;
    constexpr int iff = (LAYER == 0) ? 12 : (LAYER == 1) ? 21 : (LAYER == 2) ? 37 : 52;
    constexpr int kind = (LAYER == 1) ? 1 : (LAYER == 2) ? 2 : 0;
        PH_BEGIN
            if constexpr (LAYER == 0) { ph_tables(F, (const int*)args.in[1]); ph_norm_first(F, args.in[0], args.in[2], XN, SSB); }
            if constexpr (kind == 0) ph_dsa_cvt(F, args.in[ib + 1], args.in[ib + 6], args.in[ib + 7], args.in[ib + 8], args.in[ib + 9]);
            else if constexpr (kind == 1) ph_fox_cvt(F, args.in[ib + 1], args.in[ib + 3]);
            else ph_nsa_cvt(F, args.in[ib + 1], args.in[ib + 2], args.in[ib + 3], args.in[ib + 4], args.in[ib + 5], args.in[ib + 6], args.in[ib + 7], args.in[ib + 8], args.in[ib + 9], args.in[ib + 10]);
            ph_cvt_ffn(F, args.in[iff + 1], args.in[iff + 4]);
        PH_END
}
template <int LAYER, int HALF> DI void run_half(const Args& args, LAS unsigned char* lds, volatile LAS unsigned* MISC, int& ph, const int lo, const int hi) {
    constexpr int ib = (LAYER == 0) ? 2 : (LAYER == 1) ? 17 : (LAYER == 2) ? 26 : 42;
    constexpr int iff = (LAYER == 0) ? 12 : (LAYER == 1) ? 21 : (LAYER == 2) ? 37 : 52;
    constexpr int kind = (LAYER == 1) ? 1 : (LAYER == 2) ? 2 : 0;
    constexpr int half = HALF;
            const int roff = half * MC;
            if constexpr (kind == 0) {
                PH_BEGIN { pg8::EpiF32 E{(float*)(ar + DA_DIN), 1024, SSB + (size_t)(LAYER * 2) * MTOT * 8, roff}; GEMM_CALL(pg8::EpiF32, E, XN + (size_t)roff * DM, WB + DW_W1, MC, 1024, DM, DM, DM, (int)blockIdx.x); } PH_END
                PH_BEGIN ph_dsa_post1(F, half, args.in[ib + 2], args.in[ib + 3], args.in[ib + 4], args.in[ib + 5]); PH_END
                PH_BEGIN { pg8::EpiBf16R E = epi1((bf16*)(ar + DA_QL), 8192); E.T.base[1] = (bf16*)(ar + DA_QPE); E.T.ldc[1] = 1536; E.T.t0[1] = 32; E.T.base[2] = (bf16*)(ar + DA_QIDX); E.T.ldc[2] = 2048; E.T.t0[2] = 38; E.T.nseg = 3;
                    GEMM_CALL(pg8::EpiBf16R, E, ar + DA_CQN, WB + DW_W2, MC, 11776, 512, 512, 512, (int)blockIdx.x); } PH_END
                PH_BEGIN ph_dsa_index(F, half); PH_END
                PH_BEGIN ph_dsa_attn(F, half); PH_END
                PH_BEGIN {
                    pg8::EpiBf16R E = epi1((bf16*)(ar + DA_O2), 4096);
                    { const pg8::Gemm g_{(const pg8::bf16_t*)(ar + DA_QL), (const pg8::bf16_t*)(WB + DW_BD), MC, 4096, 512, 8192, 512, 512}; pg8::StaticOrder S_; S_.init(MC, 4096, F.G, (int)blockIdx.x);
                      pg8::gemm_phase<pg8::EpiBf16R, pg8::StaticOrder, true, true>((PG8_LAS unsigned char*)F.lds, g_, S_, E); } } PH_END
                PH_BEGIN { pg8::EpiResN E{LAYER == 0 ? args.in[0] : nullptr, args.in[ib], nullptr, DM, roff, args.in[iff], (pg8::bf16_t*)XN, SSB + (size_t)(LAYER * 2 + 1) * MTOT * 8, (PG8_LAS float*)(F.lds + LDSCTL_OFF + 256)}; GEMM_CALL(pg8::EpiResN, E, ar + DA_O2, WB + DW_WO, MC, DM, 4096, 4096, 4096, (int)blockIdx.x); } PH_END
            } else if constexpr (kind == 1) {
                PH_BEGIN {
                    { pg8::EpiBf16R E = epi1((bf16*)(ar + FA_Q), DM); E.T.base[1] = (bf16*)(ar + FA_KF); E.T.ldc[1] = 9; E.T.t0[1] = 8; E.T.gw[1] = -3;
                      E.T.base[2] = (bf16*)(ar + FA_F); E.T.ldc[2] = 256; E.T.t0[2] = 16; E.T.nseg = 3; E.ssp = SSB + (size_t)(LAYER * 2) * MTOT * 8; E.ss_off = roff;
                      GEMM_CALL(pg8::EpiBf16R, E, XN + (size_t)roff * DM, WB + FW_IN, MC, 4352, DM, DM, DM, (int)blockIdx.x); }
                    { pg8::EpiBf16R E = epi1((bf16*)(ar + FA_VF), 16); E.T.gw[0] = -4; E.ssp = SSB + (size_t)(LAYER * 2) * MTOT * 8; E.ss_off = roff;
                      GEMM_CALL(pg8::EpiBf16R, E, WB + FW_IN + (size_t)4352 * DM, XN + (size_t)roff * DM, DM, MC, DM, DM, DM, (int)((blockIdx.x + F.G - 64) % F.G)); }
                } PH_END
                PH_BEGIN ph_fox_scan(F, args.in[ib + 2]); PH_END
                PH_BEGIN ph_fox_attn(F); PH_END
                PH_BEGIN { pg8::EpiResN E{LAYER == 0 ? args.in[0] : nullptr, args.in[ib], nullptr, DM, roff, args.in[iff], (pg8::bf16_t*)XN, SSB + (size_t)(LAYER * 2 + 1) * MTOT * 8, (PG8_LAS float*)(F.lds + LDSCTL_OFF + 256)}; GEMM_CALL(pg8::EpiResN, E, ar + FA_O, WB + FW_OUT, MC, DM, DM, DM, DM, (int)blockIdx.x); } PH_END
            } else {
                PH_BEGIN { pg8::EpiBf16R E = epi1((bf16*)(ar + NA_Q), 9216);
                    E.T.base[1] = (bf16*)(ar + NA_KC); E.T.ldc[1] = 192; E.T.t0[1] = 36; E.T.gw[1] = 192;
                    E.T.base[2] = (bf16*)(ar + NA_VC); E.T.ldc[2] = 128; E.T.t0[2] = 39; E.T.gw[2] = 128;
                    E.T.base[3] = (bf16*)(ar + NA_KSR); E.T.ldc[3] = 768; E.T.t0[3] = 41;
                    E.T.base[4] = (bf16*)(ar + NA_KWR); E.T.ldc[4] = 768; E.T.t0[4] = 44;
                    E.T.base[5] = (bf16*)(ar + NA_GT); E.T.ldc[5] = 256; E.T.t0[5] = 47; E.T.nseg = 6; E.ssp = SSB + (size_t)(LAYER * 2) * MTOT * 8; E.ss_off = roff;
                    GEMM_CALL(pg8::EpiBf16R, E, XN + (size_t)roff * DM, WB + NW_IN, MC, 12288, DM, DM, DM, (int)blockIdx.x);
                    { pg8::EpiBf16R E2 = epi1((bf16*)(ar + NA_VSF), 4); E2.T.gw[0] = -5; E2.ssp = E.ssp; E2.ss_off = roff;
                      GEMM_CALL(pg8::EpiBf16R, E2, WB + NW_IN + (size_t)12288 * DM, XN + (size_t)roff * DM, 512, MC, DM, DM, DM, (int)blockIdx.x); }
                    { pg8::EpiBf16R E2 = epi1((bf16*)(ar + NA_VWF), 4); E2.T.gw[0] = -4; E2.ssp = E.ssp; E2.ss_off = roff;
                      GEMM_CALL(pg8::EpiBf16R, E2, WB + NW_IN + (size_t)12800 * DM, XN + (size_t)roff * DM, 512, MC, DM, DM, DM, (int)((blockIdx.x + F.G - 128) % F.G)); } } PH_END
                PH_BEGIN ph_nsa_rope(F, half); PH_END
                PH_BEGIN {
                    const float* BIAS = (const float*)(args.ws + WS_MISC);
                    { pg8::EpiGelu E{(bf16*)(ar + NA_GK), 256, BIAS}; GEMM_CALL(pg8::EpiGelu, E, ar + NA_KC, WB + NW_W1K, 4096, 256, 6144, 3072, 6144, (int)blockIdx.x); }
                    { pg8::EpiGelu E{(bf16*)(ar + NA_GV), 256, BIAS + 256}; GEMM_CALL(pg8::EpiGelu, E, ar + NA_VC, WB + NW_W1V, 4096, 256, 4096, 2048, 4096, (int)((blockIdx.x + F.G - 16) % F.G)); }
                } PH_END
                PH_BEGIN {
                    { pg8::EpiBf16R E = epi1((bf16*)(ar + NA_KCMP), 12); E.T.gw[0] = -1; GEMM_CALL(pg8::EpiBf16R, E, ar + NA_GK, WB + NW_W2K, 4096, 256, 256, 256, 256, (int)blockIdx.x); }
                    { pg8::EpiBf16R E = epi1((bf16*)(ar + NA_VCT), 4); E.T.gw[0] = -2; GEMM_CALL(pg8::EpiBf16R, E, WB + NW_W2V, ar + NA_GV, 256, 4096, 256, 256, 256, (int)((blockIdx.x + F.G - 16) % F.G)); }
                } PH_END
                PH_BEGIN ph_nsa_cmp(F, half); PH_END
                PH_BEGIN ph_nsa_sel(F, half); PH_END
                PH_BEGIN ph_nsa_win(F, half); PH_END
                PH_BEGIN { pg8::EpiResN E{LAYER == 0 ? args.in[0] : nullptr, args.in[ib], nullptr, DM, roff, args.in[iff], (pg8::bf16_t*)XN, SSB + (size_t)(LAYER * 2 + 1) * MTOT * 8, (PG8_LAS float*)(F.lds + LDSCTL_OFF + 256)}; GEMM_CALL(pg8::EpiResN, E, ar + NA_O, WB + NW_OUT, MC, DM, 6144, 6144, 6144, (int)blockIdx.x); } PH_END
            }
}
template <int LAYER> DI void run_ffn(const Args& args, LAS unsigned char* lds, volatile LAS unsigned* MISC, int& ph, const int lo, const int hi) {
    constexpr int ib = (LAYER == 0) ? 2 : (LAYER == 1) ? 17 : (LAYER == 2) ? 26 : 42;
    constexpr int iff = (LAYER == 0) ? 12 : (LAYER == 1) ? 21 : (LAYER == 2) ? 37 : 52;
    PH_BEGIN {
        LAS float* rt = (LAS float*)(F.lds + LDSCTL_OFF + 256 + 8192); const int rbase = 4096 * (int)(blockIdx.x & 7); const float* ssq = SSB + (size_t)(LAYER * 2 + 1) * MTOT * 8;
        for (int i = F.tid; i < 4096; i += NWAVES * 64) rt[i] = pg8::rms_rowscale(ssq, rbase + i);
        __syncthreads();
        pg8::EpiConvGlu E{(pg8::bf16_t*)ar, (float*)(ar + 352 * MiB), args.in[iff + 2], args.in[iff + 3], (PG8_LAS float*)(F.lds + LDSCTL_OFF + 256), DFF, (const PG8_LAS float*)rt, rbase};
        GEMM_CALL(pg8::EpiConvGlu, E, XN, WUP, MTOT, 2 * DFF, DM, DM, DM, (int)blockIdx.x); } PH_END
    PH_BEGIN ph_conv_fix(F, (const float*)(ar + 352 * MiB), (bf16*)ar, args.in[iff + 2], args.in[iff + 3], MTOT); PH_END
    PH_BEGIN {
        if constexpr (LAYER < 3) { constexpr int ibn = (LAYER == 0) ? 17 : (LAYER == 1) ? 26 : 42;
            pg8::EpiResN E{nullptr, args.in[iff], nullptr, DM, 0, args.in[ibn], (pg8::bf16_t*)XN, SSB + (size_t)((LAYER + 1) * 2) * MTOT * 8, (PG8_LAS float*)(F.lds + LDSCTL_OFF + 256)}; GEMM_CALL(pg8::EpiResN, E, ar, WDN, MTOT, DM, DFF, DFF, DFF, (int)blockIdx.x); }
        else { pg8::EpiResN E{nullptr, args.in[iff], nullptr, DM, 0, args.in[57], (pg8::bf16_t*)XN, SSB, (PG8_LAS float*)(F.lds + LDSCTL_OFF + 256)}; GEMM_CALL(pg8::EpiResN, E, ar, WDN, MTOT, DM, DFF, DFF, DFF, (int)blockIdx.x); }
    } PH_END
}
__global__ void __launch_bounds__(NWAVES * 64, 2) mk_fwd(Args args) {
    extern __shared__ __attribute__((aligned(16))) unsigned char lds_[];
    LAS unsigned char* const lds = (LAS unsigned char*)lds_;
    volatile LAS unsigned* MISC = (volatile LAS unsigned*)(lds + LDSCTL_OFF);
    for (int u = threadIdx.x; u < 64; u += NWAVES * 64) ((LAS unsigned*)(lds + LDSCTL_OFF))[u] = 0u;
    __syncthreads();
    const int lo = args.ph_lo, hi = args.ph_hi;
    (void)xcd_barrier_post((unsigned*)(args.ws + WS_CTL) + CW_BAR, MISC + 8);
    int ph = 0;
    run_cvt<0>(args, lds, MISC, ph, lo, hi); run_half<0, 0>(args, lds, MISC, ph, lo, hi); run_half<0, 1>(args, lds, MISC, ph, lo, hi); run_ffn<0>(args, lds, MISC, ph, lo, hi);
    run_cvt<1>(args, lds, MISC, ph, lo, hi); run_half<1, 0>(args, lds, MISC, ph, lo, hi); run_half<1, 1>(args, lds, MISC, ph, lo, hi); run_ffn<1>(args, lds, MISC, ph, lo, hi);
    run_cvt<2>(args, lds, MISC, ph, lo, hi); run_half<2, 0>(args, lds, MISC, ph, lo, hi); run_half<2, 1>(args, lds, MISC, ph, lo, hi); run_ffn<2>(args, lds, MISC, ph, lo, hi);
    run_cvt<3>(args, lds, MISC, ph, lo, hi); run_half<3, 0>(args, lds, MISC, ph, lo, hi); run_half<3, 1>(args, lds, MISC, ph, lo, hi); run_ffn<3>(args, lds, MISC, ph, lo, hi);
    { constexpr int ib = 42, iff = 52; PH_BEGIN ph_final_norm(F, (const bf16*)XN, SSB, out); PH_END }
}
extern "C" void kernel_launch(void* const* d_in, const int* in_sizes, int n_in, void* d_out, int out_size, void* d_ws, size_t ws_size, hipStream_t stream) {
    static int grid = 0;
    if (grid == 0) {
        if (n_in != 58 || out_size != MTOT * DM || ws_size < WS_END) { fprintf(stderr, "kernel_launch: unexpected shapes (n_in %d, out %d, ws %zu)\n", n_in, out_size, ws_size); grid = -1; return; }
        int dev = 0, cus = 0;
        if (hipGetDevice(&dev) != hipSuccess || hipDeviceGetAttribute(&cus, hipDeviceAttributeMultiprocessorCount, dev) != hipSuccess) { grid = -1; return; }
        if (hipFuncSetAttribute((const void*)mk_fwd, hipFuncAttributeMaxDynamicSharedMemorySize, LDS_BYTES) != hipSuccess) { fprintf(stderr, "kernel_launch: hipFuncSetAttribute failed\n"); grid = -1; return; }
        int per_cu = 0;
        (void)hipOccupancyMaxActiveBlocksPerMultiprocessor(&per_cu, (const void*)mk_fwd, NWAVES * 64, LDS_BYTES);
        (void)hipGetLastError();
        grid = cus;
    }
    if (grid < 0) return;
    if (hipMemsetAsync((char*)d_ws + WS_CTL, 0, CTL_ZERO_BYTES, stream) != hipSuccess) return;
    Args a{};
    for (int i = 0; i < 58; ++i) a.in[i] = (const float*)d_in[i];
    a.out = (float*)d_out; a.ws = (unsigned char*)d_ws;
#if MK_ONE_LAUNCH
    a.ph_lo = 0; a.ph_hi = NPH;
    hipLaunchKernelGGL(mk_fwd, dim3(grid), dim3(NWAVES * 64), LDS_BYTES, stream, a);
#else
    for (int p = 0; p < NPH; ++p) { a.ph_lo = p; a.ph_hi = p + 1; hipLaunchKernelGGL(mk_fwd, dim3(grid), dim3(NWAVES * 64), LDS_BYTES, stream, a); }
#endif
}
```

```cpp
#include <hip/hip_runtime.h>
#include <cstdio>
#include <cstdint>
#define DI __device__ __forceinline__
namespace pg8 {
#define PG8_LAS __attribute__((address_space(3)))
typedef unsigned short bf16_t;
typedef short bf16x8 __attribute__((ext_vector_type(8)));
typedef float f32x4 __attribute__((ext_vector_type(4)));
typedef unsigned u32x4 __attribute__((ext_vector_type(4)));
constexpr int BM = 256, BK = 64, HALF = 128, HTB = HALF * BK * 2  , STAGE_BYTES = 8 * HTB, NXCD = 8, WGM = 8;

__host__ __device__ __forceinline__ int lds_byte(int r, int c) { const int st = (r >> 4) * 2 + (c >> 5), rr = r & 15, cc = c & 31, ob = rr * 64 + cc * 2; return st * 1024 + (ob ^ (((ob >> 9) & 1) << 5)); }
__host__ __device__ __forceinline__ void stage_rc(int b, int& R, int& C) { const int st = b / 1024, sb = b % 1024, swz = sb ^ (((sb >> 9) & 1) << 5); R = (st >> 1) * 16 + swz / 64; C = (st & 1) * 32 + (swz % 64) / 2; }
__host__ __device__ __forceinline__ int perm32(int rho) { const int n = rho >> 4, i = rho & 15; return 8 * (i >> 2) + 4 * n + (i & 3); }

struct Unit { int pm, pn; };
struct Gemm { const bf16_t* A; const bf16_t* Bt; int M, N, K, lda, ldb, akoff; };

struct StaticOrder {
    int nM, nN, nwg, G, c;
    __host__ __device__ void init(int M, int N, int G_, int c_) { nM = M / BM; nN = N / BM; nwg = nM * nN; G = G_; c = c_; }
    __host__ __device__ bool next(int i, Unit& u) const {
        const long L = (long)i * G + c; if (L >= nwg) return false;
        int wgid = (int)L; { const int q = nwg / NXCD, r = nwg % NXCD, xcd = wgid % NXCD, off = wgid / NXCD; wgid = (xcd < r ? xcd * (q + 1) : r * (q + 1) + (xcd - r) * q) + off; }
        const int nig = WGM * nN, gid = wgid / nig, fm = gid * WGM, gsz = (nM - fm) < WGM ? (nM - fm) : WGM;
        u.pm = fm + ((wgid % nig) % gsz); u.pn = (wgid % nig) / gsz; return true;
    }
    __device__ __forceinline__ void a_ready(const Unit&) const {}
    __device__ __forceinline__ void done(const Unit&) const {}
};
__device__ __forceinline__ unsigned cvt_pk_bf16(float lo, float hi) { unsigned r; asm volatile("v_cvt_pk_bf16_f32 %0, %1, %2" : "=v"(r) : "v"(lo), "v"(hi)); return r; }
template <class Epi, class Sched, bool ALIGN_EPI = false, bool SP2 = false>
__device__ __forceinline__ void gemm_phase(PG8_LAS unsigned char* lds, const Gemm g, const Sched& S, const Epi& E) {
    const int tid = threadIdx.x, wid = __builtin_amdgcn_readfirstlane(tid >> 6), lane = tid & 63, wr = wid >> 2, wc = wid & 3, fr = lane & 15, fq = lane >> 4;
    const int K = g.K, nt = K / BK;
    unsigned voffA[2], voffB[2];
#pragma unroll
    for (int i = 0; i < 2; ++i) { int R, C; stage_rc(tid * 16 + i * 8192, R, C); const int Rb = Epi::PERM ? ((R & ~31) + perm32(R & 31)) : R;
        const int Ra = Epi::APERM ? ((R & ~63) | ((R & 15) << 2) | ((R >> 4) & 3)) : R;
        voffA[i] = (unsigned)(Ra * g.lda + C) * 2u; voffB[i] = (unsigned)(Rb * g.ldb + C) * 2u; }
    const size_t kstep = (size_t)(BK * 2);
    const size_t hstepA = (size_t)HALF * g.lda * 2, hstepB = (size_t)HALF * g.ldb * 2;
    const size_t tstepA = 2 * hstepA, tstepB = 2 * hstepB;
    const unsigned ldsw = (unsigned)wid * 1024u;
    const int aoff = lds_byte(wr * 64 + fr, fq * 8), boff = lds_byte(wc * 32 + fr, fq * 8);
#define PG8_SA(b, h) (((b) * 2 + (h)) * HTB)
#define PG8_SB(b, h) ((4 + (b) * 2 + (h)) * HTB)
#define PG8_STAGE(bufoff, gbase, voff) do { _Pragma("unroll") for (int _i = 0; _i < 2; ++_i) \
        __builtin_amdgcn_global_load_lds((const unsigned*)((const char*)(gbase) + (voff)[_i]), (PG8_LAS unsigned*)(lds + (bufoff) + ldsw + _i * 8192), 16, 0, 0); } while (0)
#define PG8_LDA(dst, b, h) do { _Pragma("unroll") for (int m = 0; m < 4; ++m) _Pragma("unroll") for (int k = 0; k < 2; ++k) dst[m][k] = *(const PG8_LAS bf16x8*)(lds + PG8_SA(b, h) + aoff + m * 2048 + k * 1024); } while (0)
#define PG8_LDB(dst, b, h) do { _Pragma("unroll") for (int n = 0; n < 2; ++n) _Pragma("unroll") for (int k = 0; k < 2; ++k) dst[n][k] = *(const PG8_LAS bf16x8*)(lds + PG8_SB(b, h) + boff + n * 2048 + k * 1024); } while (0)
#define PG8_MMA(ai, bj, At, Bt) do { __builtin_amdgcn_s_setprio(1); _Pragma("unroll") for (int m = 0; m < 4; ++m) _Pragma("unroll") for (int n = 0; n < 2; ++n) _Pragma("unroll") for (int k = 0; k < 2; ++k) \
        acc[ai][bj][m][n] = __builtin_amdgcn_mfma_f32_16x16x32_bf16(Bt[n][k], At[m][k], acc[ai][bj][m][n], 0, 0, 0); __builtin_amdgcn_s_setprio(0); } while (0)
#define PG8_WAIT_V(n) asm volatile("s_waitcnt vmcnt(" #n ")" ::: "memory")
#define PG8_WAIT_L(n) asm volatile("s_waitcnt lgkmcnt(" #n ")" ::: "memory")
#define PG8_BAR __builtin_amdgcn_s_barrier()
#define PG8_SCHED __builtin_amdgcn_sched_barrier(0)
    Unit cur, nxt; int ui = 0;
    if (!S.next(0, cur)) return;
    f32x4 acc[2][2][4][2];
#pragma unroll
    for (int a = 0; a < 2; ++a)
#pragma unroll
        for (int b = 0; b < 2; ++b)
#pragma unroll
            for (int m = 0; m < 4; ++m)
#pragma unroll
                for (int n = 0; n < 2; ++n) acc[a][b][m][n] = (f32x4){0.f, 0.f, 0.f, 0.f};
    bf16x8 At[4][2], B0[2][2], B1[2][2];
    const char* cA = (const char*)g.A + (size_t)cur.pm * tstepA + (size_t)cur.pn * g.akoff * 2; const char* cB = (const char*)g.Bt + (size_t)cur.pn * tstepB;
    S.a_ready(cur);
    if constexpr (SP2) {
        PG8_STAGE(PG8_SB(0, 0), cB, voffB); PG8_STAGE(PG8_SB(0, 1), cB + hstepB, voffB); PG8_STAGE(PG8_SA(0, 0), cA, voffA); PG8_STAGE(PG8_SA(0, 1), cA + hstepA, voffA);
        if (wr == 1) PG8_BAR;
        PG8_WAIT_V(2); PG8_BAR;
        PG8_STAGE(PG8_SB(1, 0), cB + kstep, voffB); PG8_STAGE(PG8_SA(1, 0), cA + kstep, voffA); PG8_STAGE(PG8_SB(1, 1), cB + hstepB + kstep, voffB);
        PG8_WAIT_V(6); PG8_BAR;
    } else {
        PG8_STAGE(PG8_SB(0, 0), cB, voffB); PG8_STAGE(PG8_SA(0, 0), cA, voffA); PG8_STAGE(PG8_SB(0, 1), cB + hstepB, voffB); PG8_STAGE(PG8_SA(0, 1), cA + hstepA, voffA);
        if (wr == 1) PG8_BAR;
        PG8_WAIT_V(4); PG8_BAR;
        PG8_STAGE(PG8_SB(1, 0), cB + kstep, voffB); PG8_STAGE(PG8_SA(1, 0), cA + kstep, voffA); PG8_STAGE(PG8_SB(1, 1), cB + hstepB + kstep, voffB);
        PG8_WAIT_V(6); PG8_BAR;
    }
    for (;;) {
        const bool has_next = S.next(ui + 1, nxt);
        const char* nA = has_next ? (const char*)g.A + (size_t)nxt.pm * tstepA + (size_t)nxt.pn * g.akoff * 2 : cA; const char* nB = has_next ? (const char*)g.Bt + (size_t)nxt.pn * tstepB : cB;
        for (int t = 0; t < nt; t += 2) {
            const bool last = (t == nt - 2);
            const char* a1 = cA + (size_t)(t + 1) * kstep;
            const char* a2 = last ? nA : cA + (size_t)(t + 2) * kstep; const char* b2 = last ? nB : cB + (size_t)(t + 2) * kstep;
            const char* a3 = a2 + kstep; const char* b3 = b2 + kstep;
            if (last && has_next) S.a_ready(nxt);
            if constexpr (SP2) {
            PG8_LDB(B0, 0, 0); PG8_LDB(B1, 0, 1); PG8_SCHED; PG8_LDA(At, 0, 0); PG8_STAGE(PG8_SA(1, 1), a1 + hstepA, voffA);
            PG8_WAIT_V(8); PG8_WAIT_L(0); PG8_BAR; PG8_MMA(0, 0, At, B0); PG8_MMA(0, 1, At, B1); PG8_BAR; PG8_SCHED;
            PG8_LDA(At, 0, 1); PG8_STAGE(PG8_SB(0, 0), b2, voffB); PG8_STAGE(PG8_SB(0, 1), b2 + hstepB, voffB); PG8_STAGE(PG8_SA(0, 0), a2, voffA);
            PG8_WAIT_V(8); PG8_WAIT_L(0); PG8_BAR; PG8_MMA(1, 0, At, B0); PG8_MMA(1, 1, At, B1); PG8_BAR; PG8_SCHED;
            PG8_LDB(B0, 1, 0); PG8_LDB(B1, 1, 1); PG8_SCHED; PG8_LDA(At, 1, 0); PG8_STAGE(PG8_SA(0, 1), a2 + hstepA, voffA);
            PG8_WAIT_V(8); PG8_WAIT_L(0); PG8_BAR; PG8_MMA(0, 0, At, B0); PG8_MMA(0, 1, At, B1); PG8_BAR; PG8_SCHED;
            PG8_LDA(At, 1, 1); PG8_STAGE(PG8_SB(1, 0), b3, voffB); PG8_STAGE(PG8_SB(1, 1), b3 + hstepB, voffB); PG8_STAGE(PG8_SA(1, 0), a3, voffA);
            PG8_WAIT_V(8); PG8_WAIT_L(0); PG8_BAR; PG8_MMA(1, 0, At, B0); PG8_MMA(1, 1, At, B1); PG8_BAR; PG8_SCHED;
            } else {
            PG8_LDB(B0, 0, 0); PG8_SCHED; PG8_LDA(At, 0, 0); PG8_STAGE(PG8_SA(1, 1), a1 + hstepA, voffA);
            PG8_WAIT_L(8); PG8_BAR; PG8_WAIT_L(0); PG8_MMA(0, 0, At, B0); PG8_BAR; PG8_SCHED;
            PG8_LDB(B1, 0, 1); PG8_STAGE(PG8_SB(0, 0), b2, voffB);
            PG8_BAR; PG8_WAIT_L(0); PG8_MMA(0, 1, At, B1); PG8_BAR;
            PG8_LDA(At, 0, 1); PG8_STAGE(PG8_SA(0, 0), a2, voffA);
            PG8_BAR; PG8_WAIT_L(0); PG8_MMA(1, 0, At, B0); PG8_BAR; PG8_SCHED;
            PG8_STAGE(PG8_SB(0, 1), b2 + hstepB, voffB);
            PG8_WAIT_V(6); PG8_BAR; PG8_MMA(1, 1, At, B1); PG8_BAR;
            PG8_LDB(B0, 1, 0); PG8_SCHED; PG8_LDA(At, 1, 0); PG8_STAGE(PG8_SA(0, 1), a2 + hstepA, voffA);
            PG8_WAIT_L(8); PG8_BAR; PG8_WAIT_L(0); PG8_MMA(0, 0, At, B0); PG8_BAR; PG8_SCHED;
            PG8_LDB(B1, 1, 1); PG8_STAGE(PG8_SB(1, 0), b3, voffB);
            PG8_BAR; PG8_WAIT_L(0); PG8_MMA(0, 1, At, B1); PG8_BAR;
            PG8_LDA(At, 1, 1); PG8_STAGE(PG8_SA(1, 0), a3, voffA);
            PG8_BAR; PG8_WAIT_L(0); PG8_MMA(1, 0, At, B0); PG8_BAR; PG8_SCHED;
            PG8_STAGE(PG8_SB(1, 1), b3 + hstepB, voffB);
            PG8_WAIT_V(6); PG8_BAR; PG8_MMA(1, 1, At, B1); PG8_BAR;
            }
        }
        if constexpr (ALIGN_EPI) { if (wr == 0) PG8_BAR; }
        if constexpr (!Epi::AFTER_DRAIN) { E(acc, cur, wr, wc, fr, fq); S.done(cur); }
        if (!has_next) break;
#pragma unroll
        for (int a = 0; a < 2; ++a)
#pragma unroll
            for (int b = 0; b < 2; ++b)
#pragma unroll
                for (int m = 0; m < 4; ++m)
#pragma unroll
                    for (int n = 0; n < 2; ++n) acc[a][b][m][n] = (f32x4){0.f, 0.f, 0.f, 0.f};
        cur = nxt; cA = nA; cB = nB; ++ui;
        if constexpr (ALIGN_EPI) { if (wr == 1) PG8_BAR; }
    }
    PG8_WAIT_V(0);
    if constexpr (!ALIGN_EPI) { if (wr == 0) PG8_BAR; }
    PG8_BAR;
    if constexpr (Epi::AFTER_DRAIN) { E.fused(acc, cur, wr, wc, fr, fq, lds, wid, lane); S.done(cur); }
#undef PG8_SA
#undef PG8_SB
#undef PG8_STAGE
#undef PG8_LDA
#undef PG8_LDB
#undef PG8_MMA
#undef PG8_WAIT_V
#undef PG8_WAIT_L
#undef PG8_BAR
#undef PG8_SCHED
}
}
namespace pg8 {
typedef float f32x2 __attribute__((ext_vector_type(2)));
__device__ __forceinline__ float rms_rowscale(const float* ssq, int row) { const f32x4 a = *(const f32x4*)(ssq + (size_t)row * 8), b = *(const f32x4*)(ssq + (size_t)row * 8 + 4);
    return __builtin_amdgcn_rsqf((((a[0] + a[1]) + (a[2] + a[3])) + ((b[0] + b[1]) + (b[2] + b[3]))) * (1.0f / 2048.0f) + 1e-6f); }
struct SegTab { bf16_t* base[8]; int ldc[8]; int t0[8]; int gw[8]; int nseg; int pad_; };
struct EpiBf16R {
    static constexpr bool PERM = true, AFTER_DRAIN = false, APERM = false;
    SegTab T; const float* ssp; int ss_off;
    __device__ __forceinline__ void operator()(const f32x4 (&acc)[2][2][4][2], const Unit& u, int wr, int wc, int fr, int fq) const {
        bf16_t* base = T.base[0]; int ldc = T.ldc[0], gw = T.gw[0], t0 = T.t0[0];
#pragma unroll
        for (int s = 1; s < 8; ++s) if (s < T.nseg && u.pn >= T.t0[s]) { base = T.base[s]; ldc = T.ldc[s]; gw = T.gw[s]; t0 = T.t0[s]; }
        const int colt = (u.pn - t0) * BM, row0 = u.pm * BM + wr * 64 + fr;
        if (gw <= -4) {
            typedef unsigned u32x2_ __attribute__((ext_vector_type(2)));
#pragma unroll
            for (int bj = 0; bj < 2; ++bj) { const int col = colt + bj * HALF + wc * 32 + 8 * fq;
                f32x4 c0 = {1.f, 1.f, 1.f, 1.f}, c1 = {1.f, 1.f, 1.f, 1.f};
                if (ssp) {
#pragma unroll
                    for (int j = 0; j < 4; ++j) { c0[j] = rms_rowscale(ssp, ss_off + col + j); c1[j] = rms_rowscale(ssp, ss_off + col + 4 + j); } }
                const int bt = ((col >> 12) * ldc) * 128 + ((col & 4095) >> 5);
#pragma unroll
                for (int ai = 0; ai < 2; ++ai)
#pragma unroll
                    for (int m = 0; m < 4; ++m) { const int row = row0 + ai * HALF + m * 16;
                        const f32x4 v0 = acc[ai][bj][m][0] * c0, v1 = acc[ai][bj][m][1] * c1;
                        if (gw == -4) {
                            bf16_t* d0 = base + ((size_t)(((bt + (row >> 7) * 128) * 8 + ((row >> 5) & 3) * 2 + ((col >> 4) & 1)) * 64) + (row & 31)) * 8 + 4 * ((col >> 3) & 1);
                            *(u32x2_*)d0 = (u32x2_){cvt_pk_bf16(v0[0], v0[1]), cvt_pk_bf16(v0[2], v0[3])}; *(u32x2_*)(d0 + 32 * 8) = (u32x2_){cvt_pk_bf16(v1[0], v1[1]), cvt_pk_bf16(v1[2], v1[3])};
                        } else {
                            const int k0 = col & 31, kq = (k0 & 15) >> 2, j0 = (k0 >> 4) * 4;
                            unsigned char* d8 = (unsigned char*)base + ((size_t)(((bt + (row >> 7) * 128) * 8 + ((row >> 4) & 7)) * 64) + 16 * kq + (row & 15)) * 8 + j0;
                            int lo = 0, hi = 0;
                            lo = __builtin_amdgcn_cvt_pk_fp8_f32(v0[0], v0[1], lo, false); lo = __builtin_amdgcn_cvt_pk_fp8_f32(v0[2], v0[3], lo, true);
                            hi = __builtin_amdgcn_cvt_pk_fp8_f32(v1[0], v1[1], hi, false); hi = __builtin_amdgcn_cvt_pk_fp8_f32(v1[2], v1[3], hi, true);
                            *(int*)d8 = lo; *(int*)(d8 + 16 * 8) = hi; } } }
            return; }
#pragma unroll
        for (int ai = 0; ai < 2; ++ai)
#pragma unroll
            for (int m = 0; m < 4; ++m) { const int row = row0 + ai * HALF + m * 16;
                const float rs = ssp ? rms_rowscale(ssp, ss_off + row) : 1.0f;
#pragma unroll
                for (int bj = 0; bj < 2; ++bj) { const int col = colt + bj * HALF + wc * 32 + 8 * fq;
                    const f32x4 v0 = acc[ai][bj][m][0] * rs, v1 = acc[ai][bj][m][1] * rs;
                    u32x4 w; w.x = cvt_pk_bf16(v0[0], v0[1]); w.y = cvt_pk_bf16(v0[2], v0[3]); w.z = cvt_pk_bf16(v1[0], v1[1]); w.w = cvt_pk_bf16(v1[2], v1[3]);
                    if (gw == -2) {
                        if ((row >> 5) < ldc) { bf16_t* d0 = base + ((size_t)(((col >> 5) * ldc + (row >> 5)) * 2 + ((col >> 4) & 1)) * 64 + (row & 31)) * 8 + 4 * ((col >> 3) & 1);
                            typedef unsigned u32x2_ __attribute__((ext_vector_type(2)));
                            *(u32x2_*)d0 = (u32x2_){w.x, w.y}; *(u32x2_*)(d0 + 32 * 8) = (u32x2_){w.z, w.w}; }
                        continue; }
                    bf16_t* dst;
                    if (gw == 0) dst = base + (size_t)row * ldc + col;
                    else if (gw == -1) { if ((col >> 4) >= ldc) continue; dst = base + ((size_t)((row >> 5) * ldc + (col >> 4)) * 64 + ((col >> 3) & 1) * 32 + (row & 31)) * 8; }
                    else if (gw == -3) dst = base + ((size_t)(((((row >> 12) * 16 + (col >> 7)) * 128 + ((row & 4095) >> 5)) * 9 + ((col >> 4) & 7)) * 64) + ((col >> 3) & 1) * 32 + (row & 31)) * 8;
                    else { const int g = col / gw, d = col - g * gw; dst = base + ((size_t)((row >> 12) * 4 + g) * 4096 + (row & 4095)) * gw + d; }
                    *(u32x4*)dst = w; } }
    }
};
struct EpiGelu {
    static constexpr bool PERM = true, AFTER_DRAIN = false, APERM = false;
    bf16_t* O; int ldc; const float* bias;
    static __device__ __forceinline__ float gelu(float x) { const float u2 = 1.5957691216f * (x + 0.044715f * x * x * x); const float e = __builtin_amdgcn_exp2f(-u2 * 1.4426950409f); return x * __builtin_amdgcn_rcpf(1.0f + e); }
    __device__ __forceinline__ void operator()(const f32x4 (&acc)[2][2][4][2], const Unit& u, int wr, int wc, int fr, int fq) const {
        const int row0 = u.pm * BM + wr * 64 + fr, col0 = u.pn * BM + wc * 32 + 8 * fq;
#pragma unroll
        for (int bj = 0; bj < 2; ++bj) { const f32x4 b0 = *(const f32x4*)(bias + col0 + bj * HALF), b1 = *(const f32x4*)(bias + col0 + bj * HALF + 4);
#pragma unroll
            for (int ai = 0; ai < 2; ++ai)
#pragma unroll
                for (int m = 0; m < 4; ++m) { const f32x4 v0 = acc[ai][bj][m][0] + b0, v1 = acc[ai][bj][m][1] + b1;
                    u32x4 w; w.x = cvt_pk_bf16(gelu(v0[0]), gelu(v0[1])); w.y = cvt_pk_bf16(gelu(v0[2]), gelu(v0[3])); w.z = cvt_pk_bf16(gelu(v1[0]), gelu(v1[1])); w.w = cvt_pk_bf16(gelu(v1[2]), gelu(v1[3]));
                    *(u32x4*)(O + (size_t)(row0 + ai * HALF + m * 16) * ldc + col0 + bj * HALF) = w; } }
    }
};
struct EpiF32 {
    static constexpr bool PERM = false, AFTER_DRAIN = false, APERM = false;
    float* C; int ldc; const float* ssp; int ss_off;
    __device__ __forceinline__ void operator()(const f32x4 (&acc)[2][2][4][2], const Unit& u, int wr, int wc, int fr, int fq) const {
        const int row0 = u.pm * BM + wr * 64 + fr, col0 = u.pn * BM + wc * 32 + 4 * fq;
#pragma unroll
        for (int ai = 0; ai < 2; ++ai)
#pragma unroll
            for (int m = 0; m < 4; ++m) { float* rowp = C + (size_t)(row0 + ai * HALF + m * 16) * ldc + col0;
                const float rs = ssp ? rms_rowscale(ssp, ss_off + row0 + ai * HALF + m * 16) : 1.0f;
#pragma unroll
                for (int bj = 0; bj < 2; ++bj)
#pragma unroll
                    for (int n = 0; n < 2; ++n) *(f32x4*)(rowp + bj * HALF + n * 16) = acc[ai][bj][m][n] * rs; }
    }
};
struct EpiResN {
    static constexpr bool PERM = false, AFTER_DRAIN = false, APERM = false;
    const float* res32; const float* gprev; float* out32; int ldc; int row_off; const float* g; bf16_t* xn; float* ss; PG8_LAS float* xb;
    __device__ __forceinline__ void operator()(const f32x4 (&acc)[2][2][4][2], const Unit& u, int wr, int wc, int fr, int fq) const {
        typedef unsigned u32x2_ __attribute__((ext_vector_type(2)));
        const int row0 = row_off + u.pm * BM + wr * 64 + fr, col0 = u.pn * BM + wc * 32 + 4 * fq;
        f32x4 gv[2][2], gi[2][2];
#pragma unroll
        for (int bj = 0; bj < 2; ++bj)
#pragma unroll
            for (int n = 0; n < 2; ++n) { gv[bj][n] = g ? *(const f32x4*)(g + col0 + bj * HALF + n * 16) : (f32x4){0.f, 0.f, 0.f, 0.f};
                if (!res32) { const f32x4 t = *(const f32x4*)(gprev + col0 + bj * HALF + n * 16); gi[bj][n] = (f32x4){1.0f / t[0], 1.0f / t[1], 1.0f / t[2], 1.0f / t[3]}; } else gi[bj][n] = (f32x4){1.f, 1.f, 1.f, 1.f}; }
#pragma unroll
        for (int ai = 0; ai < 2; ++ai)
#pragma unroll
            for (int m = 0; m < 4; ++m) { const int row = row0 + ai * HALF + m * 16; const size_t off = (size_t)row * ldc + col0;
                f32x4 r[2][2]; float sq = 0.f;
#pragma unroll
                for (int bj = 0; bj < 2; ++bj)
#pragma unroll
                    for (int n = 0; n < 2; ++n) {
                        if (res32) r[bj][n] = *(const f32x4*)(res32 + off + bj * HALF + n * 16);
                        else { const u32x2_ w = *(const u32x2_*)(xn + off + bj * HALF + n * 16);
                            r[bj][n] = (f32x4){__builtin_bit_cast(float, w.x << 16), __builtin_bit_cast(float, w.x & 0xffff0000u), __builtin_bit_cast(float, w.y << 16), __builtin_bit_cast(float, w.y & 0xffff0000u)} * gi[bj][n]; } }
#pragma unroll
                for (int bj = 0; bj < 2; ++bj)
#pragma unroll
                    for (int n = 0; n < 2; ++n) { const f32x4 o = r[bj][n] + acc[ai][bj][m][n];
                        if (out32) *(f32x4*)(out32 + off + bj * HALF + n * 16) = o;
                        if (g) { sq += (o[0] * o[0] + o[1] * o[1]) + (o[2] * o[2] + o[3] * o[3]);
                            const f32x4 y = o * gv[bj][n]; *(u32x2_*)(xn + off + bj * HALF + n * 16) = (u32x2_){cvt_pk_bf16(y[0], y[1]), cvt_pk_bf16(y[2], y[3])}; } }
                if (g) { sq += __shfl_xor(sq, 16); sq += __shfl_xor(sq, 32);
                    if (fq == 0) xb[(ai * HALF + wr * 64 + m * 16 + fr) * 4 + wc] = sq; }
                asm volatile("" ::: "memory"); }
        if (g) {
            asm volatile("s_waitcnt lgkmcnt(0)" ::: "memory"); __builtin_amdgcn_s_barrier(); asm volatile("" ::: "memory");
            const int t = (wr * 4 + wc) * 64 + fq * 16 + fr;
            if (t < BM) { const f32x4 v = *(const PG8_LAS f32x4*)(xb + t * 4); ss[(size_t)(row_off + u.pm * BM + t) * 8 + u.pn] = (v[0] + v[1]) + (v[2] + v[3]); }
        }
    }
};
struct EpiConvGlu {
    static constexpr bool PERM = true, AFTER_DRAIN = false, APERM = true;
    bf16_t* G; float* UB; const float* cw; const float* cb; PG8_LAS float* xb; int dff; const PG8_LAS float* rstd; int rbase;
    static __device__ __forceinline__ float shr1(float old, float src) { const int o = __builtin_bit_cast(int, old), s = __builtin_bit_cast(int, src);
        return __builtin_bit_cast(float, __builtin_amdgcn_update_dpp(o, s, 0x111, 0xf, 0xf, false)); }
    __device__ __forceinline__ void operator()(f32x4 (&acc)[2][2][4][2], const Unit& u, int wr, int wc, int fr, int fq) const {
        typedef unsigned u32x2_ __attribute__((ext_vector_type(2)));
        if (rstd) {
#pragma unroll
            for (int ai = 0; ai < 2; ++ai) { const f32x4 rs = *(const PG8_LAS f32x4*)(rstd + (u.pm * BM + ai * HALF + wr * 64 + fr * 4 - rbase));
#pragma unroll
                for (int m = 0; m < 4; ++m)
#pragma unroll
                    for (int bj = 0; bj < 2; ++bj)
#pragma unroll
                        for (int n = 0; n < 2; ++n) acc[ai][bj][m][n] = acc[ai][bj][m][n] * rs[m]; }
        }
        if (fr == 15) {
#pragma unroll
            for (int ai = 0; ai < 2; ++ai)
#pragma unroll
                for (int k = 0; k < 2; ++k)
#pragma unroll
                    for (int bj = 0; bj < 2; ++bj)
#pragma unroll
                        for (int n = 0; n < 2; ++n) *(PG8_LAS f32x4*)(xb + (((((ai * 2 + wr) * 4 + wc) * 2 + k) * 4 + fq) * 16) + (bj * 2 + n) * 4) = acc[ai][bj][2 + k][n];
        }
        { const int ncol = 4 * dff / 2;
          const bool top = (wr == 0 && fr == 0), bot = (wr == 1 && fr == 15);
          if (top || bot) {
#pragma unroll
            for (int k = 0; k < 2; ++k) { float* ub = UB + ((size_t)(u.pm * 4 + (top ? k : 2 + k)) * ncol) + u.pn * BM + wc * 32 + 8 * fq;
#pragma unroll
              for (int bj = 0; bj < 2; ++bj)
#pragma unroll
                for (int n = 0; n < 2; ++n) *(f32x4*)(ub + bj * HALF + 4 * n) = top ? acc[0][bj][k][n] : acc[1][bj][2 + k][n]; } } }
        asm volatile("s_waitcnt lgkmcnt(0)" ::: "memory"); __builtin_amdgcn_s_barrier(); asm volatile("" ::: "memory");
        u32x2_ res[2][4][2];
        const int ch0 = u.pn * HALF + wc * 32 + 8 * fq;
#pragma unroll
        for (int n = 0; n < 2; ++n) {
            const float* wp = cw + ch0 + 4 * n; const float* bp = cb + ch0 + 4 * n;
            const f32x4 w0g = *(const f32x4*)(wp), w1g = *(const f32x4*)(wp + 2 * dff), w2g = *(const f32x4*)(wp + 4 * dff), bg = *(const f32x4*)(bp);
            const f32x4 w0v = *(const f32x4*)(wp + dff), w1v = *(const f32x4*)(wp + 3 * dff), w2v = *(const f32x4*)(wp + 5 * dff), bv = *(const f32x4*)(bp + dff);
#pragma unroll
            for (int ai = 0; ai < 2; ++ai) {
                const int sai = wr ? ai : ai - 1, swr = wr ? 0 : 1;
                f32x4 x62g = {0.f, 0.f, 0.f, 0.f}, x63g = x62g, x62v = x62g, x63v = x62g;
                if (sai >= 0) { const PG8_LAS float* xp = xb + (((((sai * 2 + swr) * 4 + wc) * 2) * 4 + fq) * 16);
                    x62g = *(const PG8_LAS f32x4*)(xp + n * 4); x62v = *(const PG8_LAS f32x4*)(xp + (2 + n) * 4); x63g = *(const PG8_LAS f32x4*)(xp + 64 + n * 4); x63v = *(const PG8_LAS f32x4*)(xp + 64 + (2 + n) * 4); }
                float o[4][4];
#pragma unroll
                for (int e = 0; e < 4; ++e) {
                    const float g0 = acc[ai][0][0][n][e], g1 = acc[ai][0][1][n][e], g2 = acc[ai][0][2][n][e], g3 = acc[ai][0][3][n][e];
                    const float v0 = acc[ai][1][0][n][e], v1 = acc[ai][1][1][n][e], v2 = acc[ai][1][2][n][e], v3 = acc[ai][1][3][n][e];
                    const float q1g = shr1(x63g[e], g3), q2g = shr1(x62g[e], g2), q1v = shr1(x63v[e], v3), q2v = shr1(x62v[e], v2);
                    const float yg[4] = {bg[e] + w0g[e] * q2g + w1g[e] * q1g + w2g[e] * g0, bg[e] + w0g[e] * q1g + w1g[e] * g0 + w2g[e] * g1, bg[e] + w0g[e] * g0 + w1g[e] * g1 + w2g[e] * g2, bg[e] + w0g[e] * g1 + w1g[e] * g2 + w2g[e] * g3};
                    const float yv[4] = {bv[e] + w0v[e] * q2v + w1v[e] * q1v + w2v[e] * v0, bv[e] + w0v[e] * q1v + w1v[e] * v0 + w2v[e] * v1, bv[e] + w0v[e] * v0 + w1v[e] * v1 + w2v[e] * v2, bv[e] + w0v[e] * v1 + w1v[e] * v2 + w2v[e] * v3};
#pragma unroll
                    for (int m = 0; m < 4; ++m) o[m][e] = yg[m] * __builtin_amdgcn_rcpf(1.0f + __builtin_amdgcn_exp2f(-yg[m] * 1.4426950409f)) * yv[m];
                }
#pragma unroll
                for (int m = 0; m < 4; ++m) res[ai][m][n] = (u32x2_){cvt_pk_bf16(o[m][0], o[m][1]), cvt_pk_bf16(o[m][2], o[m][3])};
            }
        }
        const int row0 = u.pm * BM + wr * 64 + fr * 4;
#pragma unroll
        for (int ai = 0; ai < 2; ++ai)
#pragma unroll
            for (int m = 0; m < 4; ++m) *(u32x4*)(G + (size_t)(row0 + ai * HALF + m) * dff + ch0) = (u32x4){res[ai][m][0].x, res[ai][m][0].y, res[ai][m][1].x, res[ai][m][1].y};
    }
};
}
constexpr int BATCH = 8, SEQ = 4096, DM = 2048, MTOT = BATCH * SEQ, MC = MTOT / 2  , BPH = BATCH / 2;
constexpr int DFF = 5632;
constexpr float NORM_EPS = 1e-6f, LOG2E = 1.4426950408889634f;
constexpr int NWAVES = 8;
constexpr size_t MiB = 1u << 20;
constexpr size_t WS_CTL = 0, CTL_ZERO_BYTES = 1 * MiB;
constexpr size_t WS_TAB = 1 * MiB;
constexpr size_t TAB_COS48 = WS_TAB, TAB_SIN48 = WS_TAB + 3 * MiB, TAB_COS32 = WS_TAB + 6 * MiB, TAB_SIN32 = WS_TAB + 8 * MiB;
constexpr size_t WS_WMIX = 12 * MiB;
constexpr size_t WS_WFFN = 100 * MiB;
constexpr size_t WS_MISC = 168 * MiB;
constexpr size_t WS_SS = 170 * MiB;
constexpr size_t WS_XNR = 1010 * MiB;
constexpr size_t WS_AR = 234 * MiB;
constexpr size_t WS_END = 1138 * MiB;
constexpr int CW_TMO = 0;
constexpr int CW_BAR = 4096;
constexpr int RING_BYTES = 131072;
constexpr int LDSCTL_OFF = 135168;
constexpr int LDS_BYTES = 163840;

#define GAS __attribute__((address_space(1)))
#define LAS __attribute__((address_space(3)))
typedef unsigned short bf16;
typedef unsigned u32x4 __attribute__((ext_vector_type(4)));
typedef unsigned u32x2 __attribute__((ext_vector_type(2)));
typedef float f32x4 __attribute__((ext_vector_type(4)));
typedef float f32x16 __attribute__((ext_vector_type(16)));
typedef short bf16x8 __attribute__((ext_vector_type(8)));
typedef short s16x4 __attribute__((ext_vector_type(4)));
typedef short v4i16_t __attribute__((ext_vector_type(4)));
typedef __bf16 bf16x2_t __attribute__((ext_vector_type(2)));
typedef float f32x2_t __attribute__((ext_vector_type(2)));
#define LDS_WAIT() asm volatile("s_waitcnt lgkmcnt(0)" ::: "memory")
#define VM_WAIT() asm volatile("s_waitcnt vmcnt(0)" ::: "memory")
#define MFMA32(a, b, c) __builtin_amdgcn_mfma_f32_32x32x16_bf16((a), (b), (c), 0, 0, 0)
DI unsigned pk2(float lo, float hi) { f32x2_t v = {lo, hi}; bf16x2_t b = __builtin_convertvector(v, bf16x2_t); return __builtin_bit_cast(unsigned, b); }
DI float bf2f(unsigned short b) { return __builtin_bit_cast(float, (unsigned)b << 16); }
DI float bflo(unsigned w) { return __builtin_bit_cast(float, w << 16); }
DI float bfhi(unsigned w) { return __builtin_bit_cast(float, w & 0xffff0000u); }
DI unsigned short f2bf(float f) { return (unsigned short)(pk2(f, 0.f) & 0xffffu); }
DI float wave_sum(float v) {
#pragma unroll
    for (int o = 1; o < 64; o <<= 1) v += __shfl_xor(v, o);
    return v;
}
DI int crow(int i, int h) { return (i & 3) + 8 * (i >> 2) + 4 * h; }
#define XB_TMO      128
#define XB_XCNT(j)  (256  + 64 * (j))
#define XB_XSUB(j)  (1280 + 64 * (j))
#define XB_XGEN(j)  (2304 + 64 * (j))
#define XB_TOP      3328
#define XB_TOPGEN   3392
#define XCD_BAR_WORDS 3456
#define XB_SPIN_CAP (1u << 18)

__device__ __forceinline__ unsigned xb_ld(unsigned* p)              { return __hip_atomic_load(p, __ATOMIC_RELAXED, __HIP_MEMORY_SCOPE_AGENT); }
__device__ __forceinline__ unsigned xb_add(unsigned* p, unsigned v) { return __hip_atomic_fetch_add(p, v, __ATOMIC_RELAXED, __HIP_MEMORY_SCOPE_AGENT); }
__device__ __forceinline__ unsigned xb_xcc_id() { return (unsigned)__builtin_amdgcn_s_getreg((3 << 11) | 20) & 0xFu; }
#define XB_SPIN(cond, bar) do { unsigned _sp = 0; while (cond) { __builtin_amdgcn_s_sleep(1); \
    if ((++_sp & 255u) == 0u) { if (xb_ld(&(bar)[XB_TMO])) break; if (_sp > XB_SPIN_CAP) { atomicAdd(&(bar)[XB_TMO], 1u); break; } } } } while (0)

struct XcdBarrier {
    unsigned* bar; unsigned x;
    volatile LAS unsigned* st;
};

__device__ __forceinline__ XcdBarrier xcd_barrier_post(unsigned* bar, volatile LAS unsigned* st) {
    XcdBarrier b; b.bar = bar; b.x = xb_xcc_id(); b.st = st;
    if (threadIdx.x == 0) (void)xb_add(&bar[XB_XCNT(b.x)], 1u);
    return b;
}
__device__ __forceinline__ void xcd_barrier_complete(unsigned* bar, unsigned x, unsigned& nloc, unsigned& nx) {
    const unsigned G = gridDim.x * gridDim.y * gridDim.z;
    unsigned sum, cnt, mine, sp = 0u;
    for (;;) {
        sum = 0u; cnt = 0u; mine = 0u;
#pragma unroll
        for (unsigned j = 0; j < 16; ++j) { const unsigned c = xb_ld(&bar[XB_XCNT(j)]); sum += c; cnt += (c > 0u) ? 1u : 0u; mine = (j == x) ? c : mine; }
        if (sum == G) break;
        __builtin_amdgcn_s_sleep(1);
        if ((++sp & 255u) == 0u) { if (xb_ld(&bar[XB_TMO])) break; if (sp > XB_SPIN_CAP) { atomicAdd(&bar[XB_TMO], 1u); break; } }
    }
    nloc = mine > 0u ? mine : 1u; nx = cnt > 0u ? cnt : 1u;
}

__device__ __forceinline__ void xcd_barrier(const XcdBarrier& b) {
    asm volatile("s_waitcnt vmcnt(0)" ::: "memory");
    __syncthreads();
    if (threadIdx.x == 0) {
        unsigned* bar = b.bar;
        __builtin_amdgcn_s_waitcnt(0);
        unsigned nloc = b.st[0], nx = b.st[1];
        if (nloc == 0u) { xcd_barrier_complete(bar, b.x, nloc, nx); b.st[0] = nloc; b.st[1] = nx; }
        const unsigned old = xb_add(&bar[XB_XSUB(b.x)], 1u);
        const unsigned gen = old / nloc;
        if (old + 1u == (gen + 1u) * nloc) {
            __builtin_amdgcn_fence(__ATOMIC_RELEASE, "agent");
            asm volatile("s_waitcnt vmcnt(0)" ::: "memory");
            const unsigned og = xb_add(&bar[XB_TOP], 1u);
            const unsigned tg = og / nx;
            if (og + 1u == (tg + 1u) * nx) xb_add(&bar[XB_TOPGEN], 1u);
            else XB_SPIN(xb_ld(&bar[XB_TOPGEN]) == tg, bar);
            __builtin_amdgcn_fence(__ATOMIC_ACQUIRE, "agent");
            xb_add(&bar[XB_XGEN(b.x)], 1u);
            asm volatile("s_waitcnt vmcnt(0)" ::: "memory");
        } else {
            XB_SPIN(xb_ld(&bar[XB_XGEN(b.x)]) == gen, bar);
            __builtin_amdgcn_fence(__ATOMIC_ACQUIRE, "agent");
            asm volatile("s_waitcnt vmcnt(0)" ::: "memory");
        }
    }
    __syncthreads();
}
struct Frame {
    LAS unsigned char* lds; unsigned* ctl; unsigned char* ws;
    int tid, lane, wave, G, gw, NGW;
};
DI void ph_tables(const Frame& F, const int* pos) {
    float* c48 = (float*)(F.ws + TAB_COS48); float* s48 = (float*)(F.ws + TAB_SIN48); float* c32 = (float*)(F.ws + TAB_COS32); float* s32 = (float*)(F.ws + TAB_SIN32);
    const int gt = blockIdx.x * (NWAVES * 64) + F.tid, NT = F.G * NWAVES * 64;
    for (int i = gt; i < MTOT * 40; i += NT) {
        const int m = i / 40, j = i - m * 40; const float p = (float)pos[m];
        const bool a = j < 24; const int jj = a ? j : j - 24;
        const float inv = (float)exp(-(2.0 * jj / (a ? 48.0 : 32.0)) * 13.122363377404328);
        const float ang = p * inv; float sn, cs; sincosf(ang, &sn, &cs);
        if (a) { c48[m * 24 + jj] = cs; s48[m * 24 + jj] = sn; } else { c32[m * 16 + jj] = cs; s32[m * 16 + jj] = sn; }
    }
}
DI void cvt_load(float (&v)[32], const float* W, int ldw, int col0, int ncols, int item, int nblk, int lane) {
    const int kb = item / nblk, nb = item - kb * nblk, k0 = 64 * kb, n0 = 32 * nb, nn = n0 + (lane & 31); const bool ok = nn < ncols;
    const float* p = W + (size_t)(k0 + (lane >> 5)) * ldw + col0 + (ok ? nn : 0);
#pragma unroll
    for (int i = 0; i < 32; ++i) { const float x = p[(size_t)(2 * i) * ldw]; v[i] = ok ? x : 0.f; }
}
DI void cvt_store(const float (&v)[32], int ncols, bf16* WT, int ldt, int row_off, float scale, LAS float* scr, int item, int nblk, int lane) {
    const int kb = item / nblk, nb = item - kb * nblk, k0 = 64 * kb, n0 = 32 * nb;
#pragma unroll
    for (int i = 0; i < 32; ++i) scr[(2 * i + (lane >> 5)) * 33 + (lane & 31)] = v[i] * scale;
    LDS_WAIT();
    const int c = lane & 7;
#pragma unroll
    for (int j = 0; j < 4; ++j) { const int n = (lane >> 3) + 8 * j; const LAS float* s = scr + (8 * c) * 33 + n;
        u32x4 o; o.x = pk2(s[0 * 33], s[1 * 33]); o.y = pk2(s[2 * 33], s[3 * 33]); o.z = pk2(s[4 * 33], s[5 * 33]); o.w = pk2(s[6 * 33], s[7 * 33]);
        if (n0 + n < ncols) *(u32x4*)(WT + (size_t)(row_off + n0 + n) * ldt + k0 + 8 * c) = o; }
    LDS_WAIT();
}
DI void cvt_item(const float* W, int ldw, int col0, int ncols, bf16* WT, int ldt, int row_off, float scale, LAS float* scr, int item, int nblk, int lane) {
    float v[32]; cvt_load(v, W, ldw, col0, ncols, item, nblk, lane); cvt_store(v, ncols, WT, ldt, row_off, scale, scr, item, nblk, lane);
}
template <class MAP> DI void cvt_loop(const Frame& F, const float* W, int ldw, int ncols, bf16* WT, int ldt, float scale, int nitems, int nblk, const MAP& map) {
    LAS float* scr = (LAS float*)(F.lds + F.wave * 16384);
    int it = F.gw; float cur[32]; int c0 = 0, ro = 0, li = 0;
    if (it < nitems) { map(it, c0, ro, li); cvt_load(cur, W, ldw, c0, ncols, li, nblk, F.lane); }
#pragma unroll 1
    for (; it < nitems; it += F.NGW) {
        float nxt[32]; int c1 = 0, r1 = 0, l1 = 0; const int ni = it + F.NGW;
        if (ni < nitems) { map(ni, c1, r1, l1); cvt_load(nxt, W, ldw, c1, ncols, l1, nblk, F.lane); }
        cvt_store(cur, ncols, WT, ldt, ro, scale, scr, li, nblk, F.lane);
#pragma unroll
        for (int i = 0; i < 32; ++i) cur[i] = nxt[i];
        c0 = c1; ro = r1; li = l1;
    }
}
struct CvtPlain { int col0, row_off; DI void operator()(int it, int& c, int& r, int& l) const { c = col0; r = row_off; l = it; } };
DI void cvt_job(const Frame& F, const float* W, int ldw, int K, int col0, int ncols, bf16* WT, int ldt, int row_off, float scale) {
    const int nblk = (ncols + 31) / 32;
    cvt_loop(F, W, ldw, ncols, WT, ldt, scale, (K / 64) * nblk, nblk, CvtPlain{col0, row_off});
}
DI void zero_bf16(const Frame& F, bf16* p, size_t nelem) {
    const size_t gt = (size_t)blockIdx.x * (NWAVES * 64) + F.tid, NT = (size_t)F.G * NWAVES * 64;
    for (size_t i = gt; i < nelem / 8; i += NT) ((u32x4*)p)[i] = (u32x4){0u, 0u, 0u, 0u};
}
DI void ph_cvt_ffn(const Frame& F, const float* up, const float* down) {
    bf16* WUP = (bf16*)(F.ws + WS_WFFN); bf16* WDN = WUP + (size_t)2 * DFF * DM;
    struct UpMap { DI void operator()(int it, int& c, int& r, int& l) const { const int seg = it >> 7, pn = seg >> 1, isv = seg & 1; c = isv * DFF + pn * 128; r = pn * 256 + isv * 128; l = it & 127; } };
    cvt_loop(F, up, 2 * DFF, 128, WUP, DM, 1.f, 88 * 128, 4, UpMap{});
    cvt_job(F, down, DM, DFF, 0, DM, WDN, DFF, 0, 1.f);
}
DI void ph_conv_fix(const Frame& F, const float* UB, bf16* Gb, const float* cw, const float* cb, const int nrows = MC) {
    const int gt = blockIdx.x * (NWAVES * 64) + F.tid, NT = F.G * NWAVES * 64;
    for (int it = gt; it < (nrows / 256) * (DFF / 4); it += NT) {
        const int pm = it / (DFF / 4), c4 = it - pm * (DFF / 4), ch = c4 * 4, col = (ch >> 7) * 256 + (ch & 127);
        const float* ub = UB + (size_t)pm * 4 * (2 * DFF) + col; const bool has = (pm & 15) != 0;
        const f32x4 z = {0.f, 0.f, 0.f, 0.f};
        const f32x4 g0 = *(const f32x4*)(ub), g1 = *(const f32x4*)(ub + 2 * DFF), v0 = *(const f32x4*)(ub + 128), v1 = *(const f32x4*)(ub + 2 * DFF + 128);
        const f32x4 gm2 = has ? *(const f32x4*)(ub - 2 * (2 * DFF)) : z, gm1 = has ? *(const f32x4*)(ub - (2 * DFF)) : z, vm2 = has ? *(const f32x4*)(ub - 2 * (2 * DFF) + 128) : z, vm1 = has ? *(const f32x4*)(ub - (2 * DFF) + 128) : z;
        const f32x4 w0g = *(const f32x4*)(cw + ch), w1g = *(const f32x4*)(cw + 2 * DFF + ch), w2g = *(const f32x4*)(cw + 4 * DFF + ch), bg = *(const f32x4*)(cb + ch);
        const f32x4 w0v = *(const f32x4*)(cw + DFF + ch), w1v = *(const f32x4*)(cw + 3 * DFF + ch), w2v = *(const f32x4*)(cw + 5 * DFF + ch), bv = *(const f32x4*)(cb + DFF + ch);
        float o0[4], o1[4];
#pragma unroll
        for (int e = 0; e < 4; ++e) {
            const float yg0 = bg[e] + w0g[e] * gm2[e] + w1g[e] * gm1[e] + w2g[e] * g0[e], yv0 = bv[e] + w0v[e] * vm2[e] + w1v[e] * vm1[e] + w2v[e] * v0[e];
            const float yg1 = bg[e] + w0g[e] * gm1[e] + w1g[e] * g0[e] + w2g[e] * g1[e], yv1 = bv[e] + w0v[e] * vm1[e] + w1v[e] * v0[e] + w2v[e] * v1[e];
            o0[e] = yg0 * __builtin_amdgcn_rcpf(1.0f + __builtin_amdgcn_exp2f(-yg0 * LOG2E)) * yv0; o1[e] = yg1 * __builtin_amdgcn_rcpf(1.0f + __builtin_amdgcn_exp2f(-yg1 * LOG2E)) * yv1;
        }
        u32x2 a, b; a.x = pk2(o0[0], o0[1]); a.y = pk2(o0[2], o0[3]); b.x = pk2(o1[0], o1[1]); b.y = pk2(o1[2], o1[3]);
        *(u32x2*)(Gb + (size_t)(pm * 256) * DFF + ch) = a; *(u32x2*)(Gb + (size_t)(pm * 256 + 1) * DFF + ch) = b;
    }
}
DI void ph_norm_first(const Frame& F, const float* src, const float* gain, bf16* XNR, float* ss) {
    f32x4 g[8];
#pragma unroll
    for (int j = 0; j < 8; ++j) g[j] = *(const f32x4*)(gain + 4 * (F.lane + 64 * j));
    for (int m = F.gw; m < MTOT; m += F.NGW) {
        const f32x4* xr = (const f32x4*)(src + (size_t)m * DM) + F.lane;
        f32x4 v[8]; float s2 = 0.f;
#pragma unroll
        for (int j = 0; j < 8; ++j) { v[j] = xr[64 * j]; s2 += (v[j].x * v[j].x + v[j].y * v[j].y) + (v[j].z * v[j].z + v[j].w * v[j].w); }
        s2 = wave_sum(s2);
        if (F.lane < 2) *(f32x4*)(ss + (size_t)m * 8 + 4 * F.lane) = (f32x4){F.lane == 0 ? s2 : 0.f, 0.f, 0.f, 0.f};
        u32x2* o = (u32x2*)(XNR + (size_t)m * DM) + F.lane;
#pragma unroll
        for (int j = 0; j < 8; ++j) { const f32x4 y = v[j] * g[j]; u32x2 w; w.x = pk2(y.x, y.y); w.y = pk2(y.z, y.w); o[64 * j] = w; }
    }
}
DI void ph_final_norm(const Frame& F, const bf16* xn, const float* ss, float* out) {
    for (int m = F.gw; m < MTOT; m += F.NGW) {
        const float rs = pg8::rms_rowscale(ss, m);
        u32x4 v[4];
#pragma unroll
        for (int j = 0; j < 4; ++j) v[j] = *(const u32x4*)(xn + (size_t)m * DM + j * 512 + F.lane * 8);
#pragma unroll
        for (int j = 0; j < 4; ++j) { float* o = out + (size_t)m * DM + j * 512 + F.lane * 8;
            *(f32x4*)o = (f32x4){__builtin_bit_cast(float, v[j].x << 16), __builtin_bit_cast(float, v[j].x & 0xffff0000u), __builtin_bit_cast(float, v[j].y << 16), __builtin_bit_cast(float, v[j].y & 0xffff0000u)} * rs;
            *(f32x4*)(o + 4) = (f32x4){__builtin_bit_cast(float, v[j].z << 16), __builtin_bit_cast(float, v[j].z & 0xffff0000u), __builtin_bit_cast(float, v[j].w << 16), __builtin_bit_cast(float, v[j].w & 0xffff0000u)} * rs; }
    }
}
DI void rope_piece(const bf16* qrow, int p, const float* cs, const float* sn, float (&o)[8]) {
    const bool lo = p < 3; const int pp = lo ? p + 3 : p - 3, i0 = 8 * (lo ? p : p - 3);
    const u32x4 a = *(const u32x4*)(qrow + 8 * p), b = *(const u32x4*)(qrow + 8 * pp);
    const f32x4 c0 = *(const f32x4*)(cs + i0), c1 = *(const f32x4*)(cs + i0 + 4), s0 = *(const f32x4*)(sn + i0), s1 = *(const f32x4*)(sn + i0 + 4);
#pragma unroll
    for (int e = 0; e < 4; ++e) { const float c_l = e < 2 ? c0[2 * e] : c1[2 * e - 4], c_h = e < 2 ? c0[2 * e + 1] : c1[2 * e - 3], s_l = e < 2 ? s0[2 * e] : s1[2 * e - 4], s_h = e < 2 ? s0[2 * e + 1] : s1[2 * e - 3];
        const float al = bflo(a[e]), ah = bfhi(a[e]), bl_ = bflo(b[e]), bh_ = bfhi(b[e]);
        o[2 * e] = lo ? al * c_l - bl_ * s_l : bl_ * s_l + al * c_l; o[2 * e + 1] = lo ? ah * c_h - bh_ * s_h : bh_ * s_h + ah * c_h; }
}
DI bf16x8 rope_frag32(const bf16* qrow, int s, int h, const float* cs, const float* sn) {
    float o[8]; rope_piece(qrow, 2 * s + h, cs, sn, o);
    u32x4 w; w.x = pk2(o[0], o[1]); w.y = pk2(o[2], o[3]); w.z = pk2(o[4], o[5]); w.w = pk2(o[6], o[7]); return __builtin_bit_cast(bf16x8, w);
}
constexpr size_t DA_DIN = 0, DA_CQN = 64 * MiB, DA_LATC = 80 * MiB, DA_KPE = 88 * MiB, DA_KIDX = 90 * MiB, DA_WIDX = 94 * MiB, DA_QL = 96 * MiB, DA_QPE = 352 * MiB, DA_QIDX = 400 * MiB,
                 DA_SEL = 464 * MiB, DA_CNT = 472 * MiB, DA_SC = 474 * MiB, DA_O2 = 474 * MiB;
constexpr size_t DW_W1 = 0, DW_W2 = (size_t)1024 * 2048, DW_WO = DW_W2 + (size_t)11776 * 512, DW_BD = DW_WO + (size_t)2048 * 4096;
constexpr float DSA_QSCALE = 0.07216878364870322f * LOG2E;
constexpr float DSA_WIDX_SCALE = 0.25f * 0.08838834764831845f;

DI void ph_dsa_cvt(const Frame& F, const float* w_in, const float* w_qup, const float* w_uk, const float* w_uv, const float* w_out) {
    bf16* WB = (bf16*)(F.ws + WS_WMIX);
    cvt_job(F, w_in, 960, DM, 0, 960, WB + DW_W1, DM, 0, 1.f);
    zero_bf16(F, WB + DW_W1 + (size_t)960 * DM, (size_t)64 * DM);
    { LAS float* scr = (LAS float*)(F.lds + F.wave * 16384);
      for (int it = F.gw; it < 32 * 16; it += F.NGW) { const int h = it >> 4; cvt_item(w_qup, 8192, h * 192, 48, WB + DW_W2, 512, 8192 + h * 48, DSA_QSCALE, scr, it & 15, 2, F.lane); } }
    cvt_job(F, w_qup, 8192, 512, 6144, 2048, WB + DW_W2, 512, 9728, 1.f);
    __syncthreads();
    {
        LAS float* As = (LAS float*)F.lds; LAS float* Bs = As + 64 * 145;
        for (int u = blockIdx.x; u < 32 * 4 * 8; u += F.G) {
            const int h = u >> 5, r0 = ((u >> 3) & 3) * 64, k0 = (u & 7) * 64;
            for (int i = F.tid; i < 64 * 144; i += NWAVES * 64) { const int row = i / 144, col = i - row * 144;
                As[row * 145 + col] = w_uk[(size_t)(h * 256 + r0) * 144 + i]; Bs[row * 145 + col] = w_qup[(size_t)(k0 + row) * 8192 + h * 192 + 48 + col]; }
            __syncthreads();
            const int r = F.tid & 63, kg = F.tid >> 6; float acc[8];
#pragma unroll
            for (int j = 0; j < 8; ++j) acc[j] = 0.f;
            for (int n = 0; n < 144; ++n) { const float a = As[r * 145 + n];
#pragma unroll
                for (int j = 0; j < 8; ++j) acc[j] += a * Bs[(kg * 8 + j) * 145 + n]; }
            u32x4 o; o.x = pk2(acc[0] * DSA_QSCALE, acc[1] * DSA_QSCALE); o.y = pk2(acc[2] * DSA_QSCALE, acc[3] * DSA_QSCALE); o.z = pk2(acc[4] * DSA_QSCALE, acc[5] * DSA_QSCALE); o.w = pk2(acc[6] * DSA_QSCALE, acc[7] * DSA_QSCALE);
            *(u32x4*)(WB + DW_W2 + (size_t)(h * 256 + r0 + r) * 512 + k0 + kg * 8) = o;
            __syncthreads();
        }
    }
    { LAS float* scr = (LAS float*)(F.lds + F.wave * 16384);
      for (int it = F.gw; it < 32 * 16; it += F.NGW) { const int h = it >> 4; cvt_item(w_uv + (size_t)h * 256 * 128, 128, 0, 128, WB + DW_BD + (h & 1) * 256, 512, h * 128, 1.f, scr, it & 15, 4, F.lane); } }
    { const size_t gt = (size_t)blockIdx.x * (NWAVES * 64) + F.tid, NT = (size_t)F.G * NWAVES * 64;
      for (size_t i = gt; i < (size_t)4096 * 32; i += NT) { const int row = (int)(i >> 5), pc = (int)(i & 31); *(u32x4*)(WB + DW_BD + (size_t)row * 512 + (1 - ((row >> 7) & 1)) * 256 + pc * 8) = (u32x4){0u, 0u, 0u, 0u}; } }
    cvt_job(F, w_out, DM, 4096, 0, DM, WB + DW_WO, 4096, 0, 1.f);
}
DI void ph_dsa_post1(const Frame& F, int half, const float* qn, const float* kvn, const float* lng, const float* lnb) {
    unsigned char* ar = F.ws + WS_AR;
    const float* DIN = (const float*)(ar + DA_DIN); bf16* CQN = (bf16*)(ar + DA_CQN); bf16* LATC = (bf16*)(ar + DA_LATC); bf16* KPE = (bf16*)(ar + DA_KPE); bf16* KIDX = (bf16*)(ar + DA_KIDX); float* WIDX = (float*)(ar + DA_WIDX);
    const float* c48 = (const float*)(F.ws + TAB_COS48); const float* s48 = (const float*)(F.ws + TAB_SIN48); const float* c32 = (const float*)(F.ws + TAB_COS32); const float* s32 = (const float*)(F.ws + TAB_SIN32);
    LAS float* buf = (LAS float*)(F.lds + F.wave * 1024);
    const int lane = F.lane;
    for (int ml = F.gw; ml < MC; ml += F.NGW) {
        const int mg = half * MC + ml;
        const size_t kfb = ((size_t)(ml >> 5) * 8 * 64 + (ml & 31)) * 8;
        const float* row = DIN + (size_t)ml * 1024 + 16 * lane;
        f32x4 v[4]; float ss = 0.f, s1 = 0.f;
#pragma unroll
        for (int j = 0; j < 4; ++j) { v[j] = *(const f32x4*)(row + 4 * j); ss += (v[j].x * v[j].x + v[j].y * v[j].y) + (v[j].z * v[j].z + v[j].w * v[j].w); s1 += (v[j].x + v[j].y) + (v[j].z + v[j].w); }
        const bool isq = lane < 32, iskv = lane >= 32 && lane < 48, ispe = lane >= 48 && lane < 51, isix = lane >= 51 && lane < 59;
        const float ssq = wave_sum(isq ? ss : 0.f), sskv = wave_sum(iskv ? ss : 0.f), mean = wave_sum(isix ? s1 : 0.f) * (1.f / 128.f);
        float d2 = 0.f;
#pragma unroll
        for (int j = 0; j < 4; ++j) { const f32x4 d = v[j] - mean; d2 += (d.x * d.x + d.y * d.y) + (d.z * d.z + d.w * d.w); }
        const float var = wave_sum(isix ? d2 : 0.f) * (1.f / 128.f);
        const float rq = 1.0f / sqrtf(ssq * (1.f / 512.f) + NORM_EPS), rkv = 1.0f / sqrtf(sskv * (1.f / 256.f) + NORM_EPS), rstd = 1.0f / sqrtf(var + NORM_EPS);
        if (isq || iskv) {
            const float* gp = isq ? qn + 16 * lane : kvn + 16 * (lane - 32); const float rs = isq ? rq : rkv;
            bf16* dst = isq ? CQN + (size_t)ml * 512 + 16 * lane : LATC + (size_t)ml * 256 + 16 * (lane - 32);
            u32x4 o[2];
#pragma unroll
            for (int j = 0; j < 4; ++j) { const f32x4 g = *(const f32x4*)(gp + 4 * j); const f32x4 y = v[j] * rs * g; o[j >> 1][(j & 1) * 2] = pk2(y.x, y.y); o[j >> 1][(j & 1) * 2 + 1] = pk2(y.z, y.w); }
            *(u32x4*)dst = o[0]; *(u32x4*)(dst + 8) = o[1];
        } else if (ispe) {
#pragma unroll
            for (int j = 0; j < 4; ++j) *(LAS f32x4*)(buf + (lane - 48) * 16 + 4 * j) = v[j];
        } else if (isix) {
#pragma unroll
            for (int j = 0; j < 4; ++j) { const f32x4 g = *(const f32x4*)(lng + (lane - 51) * 16 + 4 * j), b = *(const f32x4*)(lnb + (lane - 51) * 16 + 4 * j); *(LAS f32x4*)(buf + 48 + (lane - 51) * 16 + 4 * j) = (v[j] - mean) * rstd * g + b; }
        } else if (lane == 59) {
#pragma unroll
            for (int j = 0; j < 4; ++j) *(f32x4*)(WIDX + (size_t)ml * 16 + 4 * j) = v[j] * DSA_WIDX_SCALE;
        }
        LDS_WAIT();
        if (lane < 24) { const float x1 = buf[lane], x2 = buf[24 + lane], c = c48[(size_t)mg * 24 + lane], s = s48[(size_t)mg * 24 + lane];
            KPE[(size_t)ml * 48 + lane] = f2bf(x1 * c - x2 * s); KPE[(size_t)ml * 48 + 24 + lane] = f2bf(x1 * s + x2 * c);
        } else if (lane < 40) { const int i = lane - 24; const float x1 = buf[48 + i], x2 = buf[48 + 16 + i], c = c32[(size_t)mg * 16 + i], s = s32[(size_t)mg * 16 + i];
            KIDX[kfb + (size_t)((i >> 3) * 32) * 8 + (i & 7)] = f2bf(x1 * c - x2 * s); KIDX[kfb + (size_t)(64 + (i >> 3) * 32) * 8 + (i & 7)] = f2bf(x1 * s + x2 * c);
        } else { const int d = 32 + 4 * (lane - 40); const f32x4 y = *(const LAS f32x4*)(buf + 48 + d); u32x2 w; w.x = pk2(y.x, y.y); w.y = pk2(y.z, y.w); *(u32x2*)(KIDX + kfb + (size_t)((d >> 4) * 64 + ((d >> 3) & 1) * 32) * 8 + (d & 7)) = w; }
        LDS_WAIT();
    }
}
DI int wave_iscan_dpp(int v) {
    v += __builtin_amdgcn_update_dpp(0, v, 0x111, 0xf, 0xf, true); v += __builtin_amdgcn_update_dpp(0, v, 0x112, 0xf, 0xf, true);
    v += __builtin_amdgcn_update_dpp(0, v, 0x114, 0xf, 0xf, true); v += __builtin_amdgcn_update_dpp(0, v, 0x118, 0xf, 0xf, true);
    v += __builtin_amdgcn_update_dpp(0, v, 0x142, 0xa, 0xf, false);
    v += __builtin_amdgcn_update_dpp(0, v, 0x143, 0xc, 0xf, false);
    return v;
}
DI int wave_isum_dpp(int v) {
    v += __builtin_amdgcn_update_dpp(0, v, 0x111, 0xf, 0xf, true); v += __builtin_amdgcn_update_dpp(0, v, 0x112, 0xf, 0xf, true);
    v += __builtin_amdgcn_update_dpp(0, v, 0x114, 0xf, 0xf, true); v += __builtin_amdgcn_update_dpp(0, v, 0x118, 0xf, 0xf, true);
    v += __builtin_amdgcn_update_dpp(0, v, 0x142, 0xa, 0xf, false);
    v += __builtin_amdgcn_update_dpp(0, v, 0x143, 0xc, 0xf, false);
    return __builtin_amdgcn_readlane(v, 63);
}
DI unsigned f2sortable(float s) { const unsigned b = __builtin_bit_cast(unsigned, s); return (b & 0x80000000u) ? ~b : (b | 0x80000000u); }
DI void ph_dsa_index(const Frame& F, const int half) {
    const float* c32 = (const float*)(F.ws + TAB_COS32); const float* s32 = (const float*)(F.ws + TAB_SIN32);
    unsigned char* ar = F.ws + WS_AR;
    const bf16* QIDX = (const bf16*)(ar + DA_QIDX); const bf16* KIDX = (const bf16*)(ar + DA_KIDX); const float* WIDX = (const float*)(ar + DA_WIDX);
    unsigned short* SEL = (unsigned short*)(ar + DA_SEL); int* CNT = (int*)(ar + DA_CNT); float* SC = (float*)(ar + DA_SC) + (size_t)F.gw * 16384;
    const int lane = F.lane, r = lane & 31, hf = lane >> 5;
    LAS unsigned char* wl = F.lds + F.wave * 8192 + lane * 16;
    LAS unsigned* hist = (LAS unsigned*)(F.lds + 65536 + F.wave * 1024);
#pragma unroll 1
    for (int tile = blockIdx.x; tile < BPH * 128; tile += F.G) {
        const int j = tile >> 8, c8 = tile & 255, c7 = c8 & 127, bl = (c8 >> 7) * 2 + j, qt = j ? 127 - c7 : c7;
        const int q0 = qt * 32 + 4 * F.wave;
        const int ntile = (q0 + 3) / 32 + 1;
        bf16x8 qa[2][8];
#pragma unroll
        for (int pr = 0; pr < 2; ++pr) {
            const int mrow = bl * SEQ + q0 + 2 * pr + (r >> 4);
#pragma unroll
            for (int s = 0; s < 8; ++s) qa[pr][s] = *(const bf16x8*)(QIDX + (size_t)mrow * 2048 + (r & 15) * 128 + 16 * s + 8 * hf);
            { const float* cs = c32 + ((size_t)half * MC + mrow) * 16 + 8 * hf; const float* sn = s32 + ((size_t)half * MC + mrow) * 16 + 8 * hf;
              const f32x4 c0 = *(const f32x4*)cs, c1 = *(const f32x4*)(cs + 4), s0 = *(const f32x4*)sn, s1 = *(const f32x4*)(sn + 4);
              const u32x4 a = __builtin_bit_cast(u32x4, qa[pr][0]), b = __builtin_bit_cast(u32x4, qa[pr][1]); u32x4 o1, o2;
#pragma unroll
              for (int e = 0; e < 4; ++e) { const float c_l = e < 2 ? c0[2 * e] : c1[2 * e - 4], c_h = e < 2 ? c0[2 * e + 1] : c1[2 * e - 3], s_l = e < 2 ? s0[2 * e] : s1[2 * e - 4], s_h = e < 2 ? s0[2 * e + 1] : s1[2 * e - 3];
                  const float x1l = bflo(a[e]), x1h = bfhi(a[e]), x2l = bflo(b[e]), x2h = bfhi(b[e]);
                  o1[e] = pk2(x1l * c_l - x2l * s_l, x1h * c_h - x2h * s_h); o2[e] = pk2(x1l * s_l + x2l * c_l, x1h * s_h + x2h * c_h); }
              qa[pr][0] = __builtin_bit_cast(bf16x8, o1); qa[pr][1] = __builtin_bit_cast(bf16x8, o2); }
            float wv[2][16];
#pragma unroll
            for (int i = 0; i < 16; ++i) wv[pr][i] = WIDX[(size_t)(bl * SEQ + q0 + 2 * pr + (i >> 3)) * 16 + (i & 3) + 8 * ((i >> 2) & 1) + 4 * hf];
#pragma unroll
            for (int i = 0; i < 16; i += 4) *(LAS f32x4*)(wl + (pr * 4 + (i >> 2)) * 1024) = (f32x4){wv[pr][i], wv[pr][i + 1], wv[pr][i + 2], wv[pr][i + 3]};
        }
        LDS_WAIT();
        {
        bf16x8 kf[8];
        { const bf16* kp = KIDX + ((size_t)(bl * 128) * 8 * 64 + lane) * 8;
#pragma unroll
          for (int s = 0; s < 8; ++s) kf[s] = *(const bf16x8*)(kp + 512 * s); }
#pragma unroll 1
        for (int t = 0; t < ntile; ++t) {
            f32x16 accs[2];
#pragma unroll
            for (int pr = 0; pr < 2; ++pr) {
#pragma unroll
                for (int i = 0; i < 16; ++i) accs[pr][i] = 0.f;
#pragma unroll
                for (int s = 0; s < 8; ++s) accs[pr] = MFMA32(qa[pr][s], kf[s], accs[pr]);
            }
            if (t + 1 < ntile) { const bf16* kp = KIDX + ((size_t)(bl * 128 + t + 1) * 8 * 64 + lane) * 8;
#pragma unroll
                for (int s = 0; s < 8; ++s) kf[s] = *(const bf16x8*)(kp + 512 * s); }
#pragma unroll
            for (int pr = 0; pr < 2; ++pr) {
                const f32x16 acc = accs[pr];
                float wv[2][16];
                { unsigned wa_ = (unsigned)(size_t)wl; asm volatile("" : "+v"(wa_));
#pragma unroll
                  for (int i = 0; i < 16; i += 4) { const f32x4 w4 = *(const LAS f32x4*)((LAS unsigned char*)(size_t)wa_ + (pr * 4 + (i >> 2)) * 1024); wv[pr][i] = w4.x; wv[pr][i + 1] = w4.y; wv[pr][i + 2] = w4.z; wv[pr][i + 3] = w4.w; } }
                float p0 = 0.f, p1 = 0.f;
#pragma unroll
                for (int i = 0; i < 8; ++i) { p0 += wv[pr][i] * fmaxf(acc[i], 0.f); p1 += wv[pr][8 + i] * fmaxf(acc[8 + i], 0.f); }
                const float t0 = p0 + __shfl_xor(p0, 32), t1 = p1 + __shfl_xor(p1, 32);
                SC[(pr * 128 + t) * 64 + lane] = hf ? t1 : t0;
            }
        }
        }
        VM_WAIT();
#pragma unroll 1
        for (int qi = 0; qi < 4; ++qi) {
            const int tq = q0 + qi, pr = qi >> 1, qs = qi & 1;
            unsigned u[64];
            const unsigned* scp = (const unsigned*)(SC + pr * 8192 + hf * 64 + qs * 32 + r);
#pragma unroll
            for (int g8 = 0; g8 < 8; ++g8) {
#pragma unroll
                for (int e = 0; e < 8; ++e) { const int i = 8 * g8 + e; const float s = __builtin_bit_cast(float, __hip_atomic_load(scp + e * 128, __ATOMIC_RELAXED, __HIP_MEMORY_SCOPE_AGENT));
                    u[i] = (2 * i + hf < ntile && 64 * i + lane <= tq) ? f2sortable(s) : 0u; }
                scp += 1024; asm volatile("" : "+v"(scp));
            }
            unsigned prefix = 0u;
            if (tq >= 256) {
#pragma unroll 1
                for (int bit = 31; bit >= 0; --bit) {
                    const unsigned cand = prefix | (1u << bit); int c = 0;
#pragma unroll
                    for (int g8 = 0; g8 < 8; ++g8) { if (g8 * 512 <= tq) {
#pragma unroll
                        for (int e = 0; e < 8; ++e) c += (u[8 * g8 + e] >= cand) ? 1 : 0; } }
                    c = wave_isum_dpp(c);
                    if (c >= 256) prefix = cand;
                    if (c == 256) break;
                }
            }
            const unsigned T = prefix > 1u ? prefix : 1u;
            int nl = 0;
#pragma unroll
            for (int g8 = 0; g8 < 8; ++g8) { if (g8 * 512 <= tq) {
#pragma unroll
                for (int e = 0; e < 8; ++e) nl += (u[8 * g8 + e] >= T) ? 1 : 0; } }
            const int inc = wave_iscan_dpp(nl), base = __builtin_amdgcn_readlane(inc, 63);
            int pos = inc - nl;
            unsigned short* sel = SEL + (size_t)(bl * SEQ + tq) * 256;
#pragma unroll
            for (int g8 = 0; g8 < 8; ++g8) { if (g8 * 512 <= tq) {
#pragma unroll
                for (int e = 0; e < 8; ++e) { const int i = 8 * g8 + e; if (u[i] >= T) { if (pos < 256) sel[pos] = (unsigned short)(64 * i + lane); ++pos; } } } }
            if (lane == 0) CNT[bl * SEQ + tq] = base < 256 ? base : 256;
        }
    }
}
DI int dsa_fsw(int row) { return ((row & 3) << 2) | ((row >> 2) & 3); }
struct DsaPre { u32x4 row[16]; bf16x8 kpe[3]; bf16x8 q[3]; };
DI void dsa_prefetch(DsaPre& P, const bf16* LATC, const bf16* KPE, const bf16* QL, const bf16* QPE, const float* c48, const float* s48, int half, int ml, int selv, int lane, int w) {
    const int bl = ml >> 12, r = lane & 31, h = lane >> 5;
#pragma unroll
    for (int it = 0; it < 16; ++it) { const int ki = __shfl(selv, (lane >> 5) + 2 * it); P.row[it] = *(const u32x4*)(LATC + (size_t)(bl * SEQ + ki) * 256 + (lane & 31) * 8); }
#pragma unroll
    for (int s = 0; s < 3; ++s) P.kpe[s] = *(const bf16x8*)(KPE + (size_t)(bl * SEQ + selv) * 48 + 16 * s + 8 * h);
#pragma unroll
    for (int j = 0; j < 3; ++j) { const int fi = w + 8 * j;
        if (fi < 16) P.q[j] = *(const bf16x8*)(QL + (size_t)ml * 8192 + r * 256 + 16 * fi + 8 * h);
        else if (fi < 19) P.q[j] = rope_frag32(QPE + (size_t)ml * 1536 + r * 48, fi - 16, h, c48 + ((size_t)half * MC + ml) * 24, s48 + ((size_t)half * MC + ml) * 24); }
}
DI void ph_dsa_attn(const Frame& F, const int half) {
    const float* c48 = (const float*)(F.ws + TAB_COS48); const float* s48 = (const float*)(F.ws + TAB_SIN48);
    unsigned char* ar = F.ws + WS_AR;
    bf16* QL = (bf16*)(ar + DA_QL); const bf16* QPE = (const bf16*)(ar + DA_QPE); const bf16* LATC = (const bf16*)(ar + DA_LATC); const bf16* KPE = (const bf16*)(ar + DA_KPE);
    const unsigned short* SEL = (const unsigned short*)(ar + DA_SEL); const int* CNT = (const int*)(ar + DA_CNT);
    const int lane = F.lane, r = lane & 31, h = lane >> 5, w = F.wave;
    LAS unsigned char* IMG = F.lds; LAS unsigned char* QB = F.lds + LDSCTL_OFF + 256; LAS float* MX = (LAS float*)(F.lds + LDSCTL_OFF + 256 + 19456); LAS float* SX = MX + 256;
    const int i16 = lane & 15, tq_ = i16 >> 2, tp_ = i16 & 3, blk = (lane >> 4) & 1;
    int ml = blockIdx.x;
    if (ml >= MC) return;
    DsaPre P;
    int cnt_c = CNT[ml];
    { const int slot = 32 * w + r; const int selv = slot < cnt_c ? (int)SEL[(size_t)ml * 256 + slot] : 0; dsa_prefetch(P, LATC, KPE, QL, QPE, c48, s48, half, ml, selv, lane, w); }
    int cnt_n = 0, selv_n = 0;
    if (ml + F.G < MC) { cnt_n = CNT[ml + F.G]; const int slot = 32 * w + r; selv_n = slot < cnt_n ? (int)SEL[(size_t)(ml + F.G) * 256 + slot] : 0; }
#pragma unroll 1
    for (; ml < MC; ml += F.G) {
        const int cnt = cnt_c, nch = (cnt + 31) >> 5; const bool act = w < nch;
#pragma unroll
        for (int it = 0; it < 16; ++it) { const int rr = (lane >> 5) + 2 * it; *(LAS u32x4*)(IMG + (32 * w + rr) * 512 + (((lane & 31) ^ dsa_fsw(rr)) * 16)) = P.row[it]; }
#pragma unroll
        for (int j = 0; j < 3; ++j) { const int fi = w + 8 * j; if (fi < 19) *(LAS bf16x8*)(QB + fi * 1024 + lane * 16) = P.q[j]; }
        bf16x8 kpe[3];
#pragma unroll
        for (int s = 0; s < 3; ++s) kpe[s] = P.kpe[s];
        LDS_WAIT(); __builtin_amdgcn_s_barrier(); asm volatile("" ::: "memory");
        if (ml + F.G < MC) {
            dsa_prefetch(P, LATC, KPE, QL, QPE, c48, s48, half, ml + F.G, selv_n, lane, w); cnt_c = cnt_n;
            if (ml + 2 * F.G < MC) { cnt_n = CNT[ml + 2 * F.G]; const int slot = 32 * w + r; selv_n = slot < cnt_n ? (int)SEL[(size_t)(ml + 2 * F.G) * 256 + slot] : 0; }
        }
        f32x16 S; float mx = -INFINITY;
#pragma unroll
        for (int i = 0; i < 16; ++i) S[i] = 0.f;
        if (act) {
#pragma unroll
            for (int s = 0; s < 16; ++s) S = MFMA32(*(const LAS bf16x8*)(IMG + (32 * w + r) * 512 + (((2 * s + h) ^ dsa_fsw(r)) * 16)), *(const LAS bf16x8*)(QB + s * 1024 + lane * 16), S);
#pragma unroll
            for (int s = 0; s < 3; ++s) S = MFMA32(kpe[s], *(const LAS bf16x8*)(QB + (16 + s) * 1024 + lane * 16), S);
#pragma unroll
            for (int i = 0; i < 16; ++i) { S[i] = (32 * w + crow(i, h) < cnt) ? S[i] : -INFINITY; mx = fmaxf(mx, S[i]); }
            mx = fmaxf(mx, __shfl_xor(mx, 32));
        }
        if (h == 0) MX[w * 32 + r] = mx;
        LDS_WAIT(); __builtin_amdgcn_s_barrier(); asm volatile("" ::: "memory");
        float M = MX[r];
#pragma unroll
        for (int k = 1; k < 8; ++k) M = fmaxf(M, MX[k * 32 + r]);
        float lsum = 0.f; bf16x8 pf[2] = {(bf16x8){0, 0, 0, 0, 0, 0, 0, 0}, (bf16x8){0, 0, 0, 0, 0, 0, 0, 0}};
        if (act) {
#pragma unroll
            for (int i = 0; i < 16; ++i) { S[i] = __builtin_amdgcn_exp2f(S[i] - M); lsum += S[i]; }
#pragma unroll
            for (int s = 0; s < 2; ++s) { u32x4 t; t.x = pk2(S[8 * s], S[8 * s + 1]); t.y = pk2(S[8 * s + 2], S[8 * s + 3]); t.z = pk2(S[8 * s + 4], S[8 * s + 5]); t.w = pk2(S[8 * s + 6], S[8 * s + 7]); pf[s] = __builtin_bit_cast(bf16x8, t); }
        }
        lsum += __shfl_xor(lsum, 32);
        if (h == 0) SX[w * 32 + r] = lsum;
        *(LAS bf16x8*)(QB + (2 * w) * 1024 + lane * 16) = pf[0]; *(LAS bf16x8*)(QB + (2 * w + 1) * 1024 + lane * 16) = pf[1];
        LDS_WAIT(); __builtin_amdgcn_s_barrier(); asm volatile("" ::: "memory");
        f32x16 O;
#pragma unroll
        for (int i = 0; i < 16; ++i) O[i] = 0.f;
#pragma unroll 2
        for (int ks = 0; ks < 2 * nch; ++ks) {
            const int r0 = 16 * ks + 4 * h + tq_, r1 = r0 + 8, pc = 4 * w + 2 * blk + (tp_ >> 1);
            const s16x4 lo = __builtin_bit_cast(s16x4, __builtin_amdgcn_ds_read_tr16_b64_v4i16((LAS v4i16_t*)(IMG + r0 * 512 + ((pc ^ dsa_fsw(r0)) * 16) + 8 * (tp_ & 1))));
            const s16x4 hi = __builtin_bit_cast(s16x4, __builtin_amdgcn_ds_read_tr16_b64_v4i16((LAS v4i16_t*)(IMG + r1 * 512 + ((pc ^ dsa_fsw(r1)) * 16) + 8 * (tp_ & 1))));
            O = MFMA32(__builtin_shufflevector(lo, hi, 0, 1, 2, 3, 4, 5, 6, 7), *(const LAS bf16x8*)(QB + ks * 1024 + lane * 16), O);
        }
        float l = SX[r];
#pragma unroll
        for (int k = 1; k < 8; ++k) l += SX[k * 32 + r];
        const float linv = 1.0f / l;
        bf16* o = QL + (size_t)ml * 8192 + r * 256 + 32 * w + 4 * h;
#pragma unroll
        for (int g = 0; g < 4; ++g) { u32x2 t; t.x = pk2(O[4 * g] * linv, O[4 * g + 1] * linv); t.y = pk2(O[4 * g + 2] * linv, O[4 * g + 3] * linv); *(u32x2*)(o + 8 * g) = t; }
        LDS_WAIT(); __builtin_amdgcn_s_barrier(); asm volatile("" ::: "memory");
    }
}
#define LDS_RD(dst, addr, OFF) asm volatile("ds_read_b128 %0, %1 offset:" #OFF : "=v"(dst) : "v"(addr) : "memory")
DI void frag_wait(bf16x8& a, bf16x8& b) { asm volatile("s_waitcnt lgkmcnt(0)" : "+v"(a), "+v"(b)); }
DI void frag_wait(bf16x8& a, bf16x8& b, bf16x8& c) { asm volatile("s_waitcnt lgkmcnt(0)" : "+v"(a), "+v"(b), "+v"(c)); }
template <int NQ> DI void qk_frags(f32x16& S, const LAS unsigned char* kt, int lane, const bf16x8 (&qf)[NQ]) {
    static_assert(NQ == 9 || NQ == 12, "qk_frags: NQ");
    const unsigned ad = (unsigned)(size_t)kt + (unsigned)lane * 16u;
#pragma unroll
    for (int i = 0; i < 16; ++i) S[i] = 0.f;
    bf16x8 f0, f1, f2, f3, f4, f5, f6, f7, f8;
    LDS_RD(f0, ad, 0); LDS_RD(f1, ad, 1024); LDS_RD(f2, ad, 2048);
    frag_wait(f0, f1, f2);
    LDS_RD(f3, ad, 3072); LDS_RD(f4, ad, 4096); LDS_RD(f5, ad, 5120);
    S = MFMA32(f0, qf[0], S); S = MFMA32(f1, qf[1], S); S = MFMA32(f2, qf[2], S);
    frag_wait(f3, f4, f5);
    LDS_RD(f6, ad, 6144); LDS_RD(f7, ad, 7168); LDS_RD(f8, ad, 8192);
    S = MFMA32(f3, qf[3], S); S = MFMA32(f4, qf[4], S); S = MFMA32(f5, qf[5], S);
    frag_wait(f6, f7, f8);
    if constexpr (NQ == 12) {
        bf16x8 f9, f10, f11;
        LDS_RD(f9, ad, 9216); LDS_RD(f10, ad, 10240); LDS_RD(f11, ad, 11264);
        S = MFMA32(f6, qf[6], S); S = MFMA32(f7, qf[7], S); S = MFMA32(f8, qf[8], S);
        frag_wait(f9, f10, f11);
        S = MFMA32(f9, qf[9 % NQ], S); S = MFMA32(f10, qf[10 % NQ], S); S = MFMA32(f11, qf[11 % NQ], S);
    } else {
        S = MFMA32(f6, qf[6], S); S = MFMA32(f7, qf[7], S); S = MFMA32(f8, qf[8], S);
    }
}
DI void pv_frags(f32x16 (&O)[4], const LAS unsigned char* vt, int lane, const bf16x8 (&pf)[2]) {
    const unsigned ad = (unsigned)(size_t)vt + (unsigned)lane * 16u;
    bf16x8 f0, f1, f2, f3, f4, f5, f6, f7;
    LDS_RD(f0, ad, 0); LDS_RD(f1, ad, 1024);
    frag_wait(f0, f1);
    LDS_RD(f2, ad, 2048); LDS_RD(f3, ad, 3072);
    O[0] = MFMA32(f0, pf[0], O[0]); O[0] = MFMA32(f1, pf[1], O[0]);
    frag_wait(f2, f3);
    LDS_RD(f4, ad, 4096); LDS_RD(f5, ad, 5120);
    O[1] = MFMA32(f2, pf[0], O[1]); O[1] = MFMA32(f3, pf[1], O[1]);
    frag_wait(f4, f5);
    LDS_RD(f6, ad, 6144); LDS_RD(f7, ad, 7168);
    O[2] = MFMA32(f4, pf[0], O[2]); O[2] = MFMA32(f5, pf[1], O[2]);
    frag_wait(f6, f7);
    O[3] = MFMA32(f6, pf[0], O[3]); O[3] = MFMA32(f7, pf[1], O[3]);
}
template <int NDB, bool RESC = true> DI void softmax_step(f32x16& S, float& m, float& l, f32x16 (&O)[NDB], bf16x8 (&pf)[2]) {
    float mx = fmaxf(S[0], S[1]);
#pragma unroll
    for (int i = 2; i < 16; i += 2) mx = __builtin_fmaxf(mx, __builtin_fmaxf(S[i], S[i + 1]));
    mx = fmaxf(mx, __shfl_xor(mx, 32));
    const float mn = fmaxf(m, mx), ms = (mn == -INFINITY) ? 0.f : mn;
    const float alpha = __builtin_amdgcn_exp2f(m - ms);
    float sum = 0.f;
#pragma unroll
    for (int i = 0; i < 16; ++i) { S[i] = __builtin_amdgcn_exp2f(S[i] - ms); sum += S[i]; }
    l = l * alpha + sum; m = mn;
    if (RESC && __builtin_amdgcn_ballot_w64(alpha != 1.0f) != 0ull) {
#pragma unroll
        for (int db = 0; db < NDB; ++db)
#pragma unroll
            for (int i = 0; i < 16; ++i) O[db][i] *= alpha;
    }
#pragma unroll
    for (int s = 0; s < 2; ++s) { u32x4 w; w.x = pk2(S[8 * s], S[8 * s + 1]); w.y = pk2(S[8 * s + 2], S[8 * s + 3]); w.z = pk2(S[8 * s + 4], S[8 * s + 5]); w.w = pk2(S[8 * s + 6], S[8 * s + 7]); pf[s] = __builtin_bit_cast(bf16x8, w); }
}
template <bool ACC> DI void store_col(bf16* out, const f32x16 (&O)[4], float scale, int h) {
#pragma unroll
    for (int db = 0; db < 4; ++db)
#pragma unroll
        for (int g = 0; g < 4; ++g) { u32x2* p = (u32x2*)(out + db * 32 + 8 * g + 4 * h);
            float a = O[db][4 * g] * scale, b = O[db][4 * g + 1] * scale, c = O[db][4 * g + 2] * scale, d = O[db][4 * g + 3] * scale;
            if (ACC) { const u32x2 o = *p; a += bflo(o.x); b += bfhi(o.x); c += bflo(o.y); d += bfhi(o.y); }
            u32x2 w; w.x = pk2(a, b); w.y = pk2(c, d); *p = w; }
}
template <int NQ> struct TilePre { u32x4 a, b, c; };
template <int NQ, class SRC> DI void tile_fetch(TilePre<NQ>& p, const SRC& src, int T, int tid) {
    const bf16* k = src.k(T); const bf16* v = src.v(T);
    constexpr int NK = NQ * 64;
    p.a = *(const u32x4*)(k + (size_t)tid * 8);
    const int p1 = tid + 512; p.b = (p1 < NK) ? *(const u32x4*)(k + (size_t)p1 * 8) : *(const u32x4*)(v + (size_t)(p1 - NK) * 8);
    if (NQ * 64 + 512 > 1024) { const int p2 = tid + 1024; if (p2 < NK + 512) p.c = *(const u32x4*)(v + (size_t)(p2 - NK) * 8); }
}
template <int NQ> DI void tile_put(const TilePre<NQ>& p, LAS unsigned char* buf, int tid) {
    *(LAS u32x4*)(buf + tid * 16) = p.a; *(LAS u32x4*)(buf + (tid + 512) * 16) = p.b;
    if (NQ * 64 + 512 > 1024) { if (tid + 1024 < NQ * 64 + 512) *(LAS u32x4*)(buf + (tid + 1024) * 16) = p.c; }
}
template <int NQ, bool PV, class SRC, class MK>
DI void attn_run_sh(LAS unsigned char* tl, int tid, int lane, const bf16x8 (&qf)[NQ], f32x16 (&O)[4], float& m, float& l, int TB, int TE, int tb, int te, const SRC& src, const MK& mk) {
    constexpr int TBYTES = (NQ + 8) * 1024;
    if (TB >= TE) return;
    TilePre<NQ> pre;
    tile_fetch<NQ>(pre, src, TB, tid); tile_put<NQ>(pre, tl, tid);
    LDS_WAIT(); __builtin_amdgcn_s_barrier(); asm volatile("" ::: "memory");
#pragma unroll 1
    for (int T = TB; T < TE; ++T) {
        LAS unsigned char* cur = tl + ((T - TB) & 1) * TBYTES;
        if (T + 1 < TE) tile_fetch<NQ>(pre, src, T + 1, tid);
        if (T >= tb && T < te) {
            f32x16 S; qk_frags<NQ>(S, cur, lane, qf);
            if (mk.need(T)) mk(T, S);
            bf16x8 pf[2]; softmax_step<4, PV>(S, m, l, O, pf);
            if (PV) pv_frags(O, cur + NQ * 1024, lane, pf);
        }
        if (T + 1 < TE) tile_put<NQ>(pre, tl + ((T + 1 - TB) & 1) * TBYTES, tid);
        LDS_WAIT(); __builtin_amdgcn_s_barrier(); asm volatile("" ::: "memory");
    }
}
#define ATTN_QK(dst, kptr) qk_frags<NQ>(dst, (kptr), lane, qf)
#define ATTN_SMPV_NM() do { bf16x8 pf[2]; softmax_step<4, true>(S, m, l, O, pf); pv_frags(O, vc, lane, pf); } while (0)
#define ATTN_SMPV(T_) do { if (mk.need(T_)) mk(T_, S); ATTN_SMPV_NM(); } while (0)
template <int NQ, class SRC, class MK>
DI void attn_run_p(LAS unsigned char* tl, int tid, int lane, const bf16x8 (&qf)[NQ], f32x16 (&O)[4], float& m, float& l, int TB, int TE, int tb, int te, const SRC& src, const MK& mk) {
    constexpr int KB = NQ * 1024, NK = NQ * 64;
    if (TB >= TE) return;
    LAS unsigned char* kbuf = tl; LAS unsigned char* vbuf = tl + 2 * KB;
    const int wid = __builtin_amdgcn_readfirstlane(tid >> 6);
#define ATTN_STAGE_K(T_, kd) do { const bf16* k_ = src.k(T_); __builtin_amdgcn_global_load_lds((const unsigned*)(k_ + (size_t)tid * 8), (LAS unsigned*)((kd) + wid * 1024), 16, 0, 0); \
        if (wid * 64 + 512 < NK) __builtin_amdgcn_global_load_lds((const unsigned*)(k_ + (size_t)(tid + 512) * 8), (LAS unsigned*)((kd) + 8192 + wid * 1024), 16, 0, 0); } while (0)
#define ATTN_STAGE_V(T_, vd) __builtin_amdgcn_global_load_lds((const unsigned*)(src.v(T_) + (size_t)tid * 8), (LAS unsigned*)((vd) + wid * 1024), 16, 0, 0)
#define ATTN_SYNC() do { asm volatile("s_waitcnt vmcnt(0) lgkmcnt(0)" ::: "memory"); __builtin_amdgcn_s_barrier(); asm volatile("" ::: "memory"); } while (0)
    ATTN_STAGE_K(TB, kbuf);
    ATTN_SYNC();
    f32x16 Sn;
    {
        if (TB + 1 < TE) ATTN_STAGE_K(TB + 1, kbuf + KB);
        ATTN_STAGE_V(TB, vbuf);
        if (TB >= tb && TB < te) ATTN_QK(Sn, kbuf);
        ATTN_SYNC();
    }
#pragma unroll 1
    for (int T = TB; T < TE; ++T) {
        const int i = T - TB;
        const LAS unsigned char* kn = kbuf + ((i + 1) & 1) * KB;
        const LAS unsigned char* vc = vbuf + (i & 1) * 8192;
        if (T + 2 < TE) ATTN_STAGE_K(T + 2, kbuf + (i & 1) * KB);
        if (T + 1 < TE) ATTN_STAGE_V(T + 1, vbuf + ((i + 1) & 1) * 8192);
        const bool own = T >= tb && T < te, nxt = T + 1 >= tb && T + 1 < te;
        if (own && nxt) { f32x16 S = Sn; if (mk.need(T)) mk(T, S); ATTN_QK(Sn, kn); ATTN_SMPV_NM(); }
        else if (own) { f32x16 S = Sn; ATTN_SMPV(T); }
        else if (nxt) { ATTN_QK(Sn, kn); }
        ATTN_SYNC();
    }
}
template <int NQ, class SRC, class MK>
DI void attn_run_d(LAS unsigned char* tl, int tid, int lane, const bf16x8 (&qf)[NQ], f32x16 (&O)[4], float& m, float& l, int TB, int TE, int tb, int te, const SRC& src, const MK& mk) {
    constexpr int TBYTES = (NQ + 8) * 1024, NK = NQ * 64;
    if (TB >= TE) return;
    const int wid = __builtin_amdgcn_readfirstlane(tid >> 6);
    const bool two = wid * 64 + 512 < NK;
#define ATTN_DMA(T_, buf) do { const bf16* k_ = src.k(T_); LAS unsigned char* b_ = (buf); \
        __builtin_amdgcn_global_load_lds((const unsigned*)(k_ + (size_t)tid * 8), (LAS unsigned*)(b_ + wid * 1024), 16, 0, 0); \
        if (two) __builtin_amdgcn_global_load_lds((const unsigned*)(k_ + (size_t)(tid + 512) * 8), (LAS unsigned*)(b_ + 8192 + wid * 1024), 16, 0, 0); \
        __builtin_amdgcn_global_load_lds((const unsigned*)(src.v(T_) + (size_t)tid * 8), (LAS unsigned*)(b_ + NQ * 1024 + wid * 1024), 16, 0, 0); } while (0)
#define ATTN_DWAIT(pending) do { if (!(pending)) asm volatile("s_waitcnt vmcnt(0)" ::: "memory"); else if (two) asm volatile("s_waitcnt vmcnt(3)" ::: "memory"); else asm volatile("s_waitcnt vmcnt(2)" ::: "memory"); \
        __builtin_amdgcn_s_barrier(); asm volatile("" ::: "memory"); } while (0)
    asm volatile("s_waitcnt vmcnt(0)" ::: "memory");
    ATTN_DMA(TB, tl);
    if (TB + 1 < TE) ATTN_DMA(TB + 1, tl + TBYTES);
    ATTN_DWAIT(TB + 1 < TE);
    int slot = 0;
#pragma unroll 1
    for (int T = TB; T < TE; ++T) {
        const LAS unsigned char* cur = tl + slot * TBYTES;
        const int s2 = slot == 0 ? 2 : slot - 1;
        if (T + 2 < TE) ATTN_DMA(T + 2, tl + s2 * TBYTES);
        if (T >= tb && T < te) {
            f32x16 S; qk_frags<NQ>(S, cur, lane, qf);
            if (mk.need(T)) mk(T, S);
            bf16x8 pf[2]; softmax_step<4, true>(S, m, l, O, pf);
            pv_frags(O, cur + NQ * 1024, lane, pf);
        }
        asm volatile("s_waitcnt lgkmcnt(0)" ::: "memory");
        ATTN_DWAIT(T + 2 < TE);
        slot = slot == 2 ? 0 : slot + 1;
    }
}
struct FragSrc { const bf16* kb; const bf16* vb; int nq; DI const bf16* k(int T) const { return kb + (size_t)T * nq * 512; } DI const bf16* v(int T) const { return vb + (size_t)T * 8 * 512; } };
constexpr size_t FA_Q = 0, FA_K = 64 * MiB, FA_F = 128 * MiB, FA_V = 136 * MiB, FA_CUM = 200 * MiB, FA_O = 202 * MiB, FA_KF = 266 * MiB, FA_VF = 338 * MiB;
constexpr size_t FW_IN = 0, FW_OUT = (size_t)6400 * 2048;
constexpr float FOX_QSCALE = 0.08838834764831845f * LOG2E;
DI void ph_fox_cvt(const Frame& F, const float* w_in, const float* w_out) {
    bf16* WB = (bf16*)(F.ws + WS_WMIX);
    cvt_job(F, w_in, 6160, DM, 0, 2048, WB + FW_IN, DM, 0, FOX_QSCALE);
    cvt_job(F, w_in, 6160, DM, 2048, 2048, WB + FW_IN, DM, 2048, 1.f);
    cvt_job(F, w_in, 6160, DM, 4096, 2048, WB + FW_IN, DM, 4352, 1.f);
    cvt_job(F, w_in, 6160, DM, 6144, 16, WB + FW_IN, DM, 4096, 1.f);
    zero_bf16(F, WB + FW_IN + (size_t)4112 * DM, (size_t)240 * DM);
    cvt_job(F, w_out, DM, DM, 0, DM, WB + FW_OUT, DM, 0, 1.f);
}
DI void ph_fox_scan(const Frame& F, const float* b_f) {
    unsigned char* ar = F.ws + WS_AR; const bf16* FB = (const bf16*)(ar + FA_F); float* CUM = (float*)(ar + FA_CUM);
    for (int w = F.gw; w < BPH * 16; w += F.NGW) {
        const int bl = w >> 4, hd = w & 15; const float bf_ = b_f[hd];
        float v[64]; float run = 0.f;
#pragma unroll
        for (int i = 0; i < 64; ++i) { const float x = bf2f(FB[(size_t)(bl * SEQ + F.lane * 64 + i) * 256 + hd]) + bf_;
            const float ls = fminf(x, 0.f) - log1pf(expf(-fabsf(x))); run += ls; v[i] = run; }
        float inc = run;
#pragma unroll
        for (int o = 1; o < 64; o <<= 1) { const float y = __shfl_up(inc, o); if (F.lane >= o) inc += y; }
        const float base = inc - run;
        float* dst = CUM + (size_t)w * SEQ + F.lane * 64;
#pragma unroll
        for (int i = 0; i < 64; i += 4) *(f32x4*)(dst + i) = (f32x4){(v[i] + base) * LOG2E, (v[i + 1] + base) * LOG2E, (v[i + 2] + base) * LOG2E, (v[i + 3] + base) * LOG2E};
        bf16* KF9 = (bf16*)(ar + FA_KF) + (size_t)w * 128 * 9 * 512;
#pragma unroll
        for (int i = 0; i < 64; ++i) { const int p = F.lane * 64 + i, tile = p >> 5, r_ = p & 31; const float c = (v[i] + base) * LOG2E;
            const unsigned short hi = f2bf(c); const float c1 = c - bf2f(hi); const unsigned short mid = f2bf(c1); const unsigned short lo = f2bf(c1 - bf2f(mid));
            u32x4 wv; wv.x = 0x3F803F80u; wv.y = 0x3F80u | ((unsigned)(hi ^ 0x8000u) << 16); wv.z = (unsigned)(mid ^ 0x8000u) | ((unsigned)(lo ^ 0x8000u) << 16); wv.w = 0u;
            bf16* d = KF9 + ((size_t)(tile * 9 + 8) * 64 + r_) * 8;
            *(u32x4*)d = wv; *(u32x4*)(d + 32 * 8) = (u32x4){0u, 0u, 0u, 0u}; }
    }
}
struct FoxMK { int tq, h, qt; DI bool need(int t) const { return t == qt; }
    DI void operator()(int t, f32x16& S) const {
#pragma unroll
        for (int i = 0; i < 16; ++i) S[i] = (32 * t + crow(i, h) <= tq) ? S[i] : -INFINITY;
    } };
DI void ph_fox_attn(const Frame& F) {
    unsigned char* ar = F.ws + WS_AR; const bf16* Q = (const bf16*)(ar + FA_Q); const bf16* KF = (const bf16*)(ar + FA_KF); const bf16* VF = (const bf16*)(ar + FA_VF); const float* CUM = (const float*)(ar + FA_CUM); bf16* Ob = (bf16*)(ar + FA_O);
    const int r = F.lane & 31, h = F.lane >> 5;
    for (int wb = blockIdx.x; wb < BPH * 16 * 4; wb += F.G) {
        const int bh = wb >> 2, x = (wb & 3) * 8 + F.wave, bl = bh >> 4, hd = bh & 15;
#pragma unroll 1
        for (int k = 0; k < 4; ++k) {
            const int qt = (k == 0) ? x : (k == 1) ? 63 - x : (k == 2) ? 64 + x : 127 - x;
            const int qhi = (k == 0) ? (wb & 3) * 8 + 7 : (k == 1) ? 63 - (wb & 3) * 8 : (k == 2) ? 64 + (wb & 3) * 8 + 7 : 127 - (wb & 3) * 8;
            const int tq = qt * 32 + r; const size_t mrow = (size_t)bl * SEQ + tq;
            bf16x8 qf[9];
#pragma unroll
            for (int s = 0; s < 8; ++s) qf[s] = *(const bf16x8*)(Q + mrow * DM + hd * 128 + 16 * s + 8 * h);
            { const float ct = CUM[(size_t)bh * SEQ + tq]; const unsigned short hi = f2bf(ct); const float c1 = ct - bf2f(hi); const unsigned short mid = f2bf(c1); const unsigned short lo = f2bf(c1 - bf2f(mid));
              u32x4 wq; wq.x = (unsigned)hi | ((unsigned)mid << 16); wq.y = (unsigned)lo | (0x3F80u << 16); wq.z = 0x3F803F80u; wq.w = 0u;
              if (h) wq = (u32x4){0u, 0u, 0u, 0u};
              qf[8] = __builtin_bit_cast(bf16x8, wq); }
            f32x16 O[4];
#pragma unroll
            for (int db = 0; db < 4; ++db)
#pragma unroll
                for (int i = 0; i < 16; ++i) O[db][i] = 0.f;
            float m = -INFINITY, l = 0.f;
            const FragSrc src{KF + (size_t)bh * 128 * 9 * 512, VF + (size_t)bh * 128 * 8 * 512, 9}; const FoxMK mk{tq, h, qt};
            attn_run_d<9>(F.lds, F.tid, F.lane, qf, O, m, l, 0, qhi + 1, 0, qt + 1, src, mk);
            l += __shfl_xor(l, 32);
            store_col<false>(Ob + mrow * DM + hd * 128, O, l > 0.f ? 1.0f / l : 0.f, h);
        }
    }
}
typedef long fp8x8_t;
DI fp8x8_t pack_fp8x8(float a0, float a1, float a2, float a3, float a4, float a5, float a6, float a7) {
    int lo = 0, hi = 0;
    lo = __builtin_amdgcn_cvt_pk_fp8_f32(a0, a1, lo, false); lo = __builtin_amdgcn_cvt_pk_fp8_f32(a2, a3, lo, true);
    hi = __builtin_amdgcn_cvt_pk_fp8_f32(a4, a5, hi, false); hi = __builtin_amdgcn_cvt_pk_fp8_f32(a6, a7, hi, true);
    return (fp8x8_t)(((unsigned long long)(unsigned)hi << 32) | (unsigned long long)(unsigned)lo);
}
#define MFMA32F8(a, b, c) __builtin_amdgcn_mfma_f32_32x32x16_fp8_fp8((a), (b), (c), 0, 0, 0)
constexpr size_t NA_Q = 0, NA_KC = 288 * MiB, NA_VC = 313 * MiB, NA_KSR = 330 * MiB, NA_KWR = 354 * MiB, NA_GT = 378 * MiB, NA_VSR = 386 * MiB, NA_VWR = 402 * MiB, NA_GK = 418 * MiB, NA_GV = 420 * MiB,
                 NA_KCMP = 422 * MiB, NA_VCT = 424 * MiB, NA_SELB = 426 * MiB, NA_O = 428 * MiB,
                 NA_KSF = 620 * MiB, NA_KWF = 644 * MiB, NA_VSF = 668 * MiB, NA_VWF = 684 * MiB;
constexpr size_t NW_IN = 0, NW_W1K = (size_t)13312 * 2048, NW_W1V = NW_W1K + (size_t)256 * 6144, NW_W2K = NW_W1V + (size_t)256 * 4096, NW_W2V = NW_W2K + 65536, NW_OUT = NW_W2V + 65536;
constexpr float NSA_QSCALE = 0.07216878364870322f * LOG2E;
DI void ph_nsa_cvt(const Frame& F, const float* w_in, const float* k_pe, const float* k_w1, const float* k_b1, const float* k_w2, const float* v_pe, const float* v_w1, const float* v_b1, const float* v_w2, const float* w_out) {
    bf16* WB = (bf16*)(F.ws + WS_WMIX); float* BIAS = (float*)(F.ws + WS_MISC);
    cvt_job(F, w_in, 13200, DM, 0, 9216, WB + NW_IN, DM, 0, NSA_QSCALE);
    cvt_job(F, w_in, 13200, DM, 9216, 768, WB + NW_IN, DM, 9216, 1.f);
    cvt_job(F, w_in, 13200, DM, 9984, 512, WB + NW_IN, DM, 9984, 1.f);
    cvt_job(F, w_in, 13200, DM, 10496, 768, WB + NW_IN, DM, 10496, 1.f);
    cvt_job(F, w_in, 13200, DM, 11776, 768, WB + NW_IN, DM, 11264, 1.f);
    cvt_job(F, w_in, 13200, DM, 13056, 144, WB + NW_IN, DM, 12032, 1.f);
    zero_bf16(F, WB + NW_IN + (size_t)12176 * DM, (size_t)112 * DM);
    cvt_job(F, w_in, 13200, DM, 11264, 512, WB + NW_IN, DM, 12288, 1.f);
    cvt_job(F, w_in, 13200, DM, 12544, 512, WB + NW_IN, DM, 12800, 1.f);
    cvt_job(F, k_w1, 256, 6144, 0, 256, WB + NW_W1K, 6144, 0, 1.f);
    cvt_job(F, v_w1, 256, 4096, 0, 256, WB + NW_W1V, 4096, 0, 1.f);
    cvt_job(F, k_w2, 192, 256, 0, 192, WB + NW_W2K, 256, 0, 1.f); zero_bf16(F, WB + NW_W2K + 192 * 256, 64 * 256);
    cvt_job(F, v_w2, 128, 256, 0, 128, WB + NW_W2V, 256, 0, 1.f); zero_bf16(F, WB + NW_W2V + 128 * 256, 128 * 256);
    cvt_job(F, w_out, DM, 6144, 0, DM, WB + NW_OUT, 6144, 0, 1.f);
    for (int w = F.gw; w < 512; w += F.NGW) { const bool isk = w < 256; const int c = w & 255, n = isk ? 6144 : 4096; const float* pe = isk ? k_pe : v_pe; const float* w1 = isk ? k_w1 : v_w1;
        float s = 0.f; for (int i = F.lane; i < n; i += 64) s += pe[i] * w1[(size_t)i * 256 + c];
        s = wave_sum(s); if (F.lane == 0) BIAS[w] = s + (isk ? k_b1[c] : v_b1[c]); }
}
DI void ph_nsa_rope(const Frame& F, int half) {
    unsigned char* ar = F.ws + WS_AR; bf16* Q = (bf16*)(ar + NA_Q); bf16* KC = (bf16*)(ar + NA_KC);
    const bf16* KSR = (const bf16*)(ar + NA_KSR); const bf16* KWR = (const bf16*)(ar + NA_KWR); bf16* KSF = (bf16*)(ar + NA_KSF); bf16* KWF = (bf16*)(ar + NA_KWF);
    const float* c48 = (const float*)(F.ws + TAB_COS48); const float* s48 = (const float*)(F.ws + TAB_SIN48);
    for (int ml = F.gw; ml < MC; ml += F.NGW) {
        const size_t mg = (size_t)half * MC + ml; const int bl = ml >> 12, sq = ml & 4095;
        for (int p = F.lane; p < 96; p += 64) {
            const int hd = 48 + p / 24, i = p - (p / 24) * 24; bf16* q;
            q = KC + ((size_t)(bl * 4 + hd - 48) * 4096 + sq) * 192 + i;
            const float x1 = bf2f(q[0]), x2 = bf2f(q[24]), c = c48[mg * 24 + i], s = s48[mg * 24 + i]; q[0] = f2bf(x1 * c - x2 * s); q[24] = f2bf(x1 * s + x2 * c);
        }
        const int tile = sq >> 5, rr = sq & 31;
        for (int u = F.lane; u < 168; u += 64) {
            const int tens = u / 84, uu = u - tens * 84, g = uu / 21, v = uu - g * 21;
            const bf16* src = (tens ? KWR : KSR) + (size_t)ml * 768 + g * 192;
            bf16* dst = (tens ? KWF : KSF) + ((size_t)((bl * 4 + g) * 128 + tile) * 12 * 64 + rr) * 8;
            if (v < 3) {
                const u32x4 a = *(const u32x4*)(src + 8 * v), b = *(const u32x4*)(src + 8 * v + 24); u32x4 o1, o2;
#pragma unroll
                for (int e = 0; e < 4; ++e) { const float c0 = c48[mg * 24 + 8 * v + 2 * e], s0 = s48[mg * 24 + 8 * v + 2 * e], c1 = c48[mg * 24 + 8 * v + 2 * e + 1], s1 = s48[mg * 24 + 8 * v + 2 * e + 1];
                    const float x1l = bflo(a[e]), x1h = bfhi(a[e]), x2l = bflo(b[e]), x2h = bfhi(b[e]);
                    o1[e] = pk2(x1l * c0 - x2l * s0, x1h * c1 - x2h * s1); o2[e] = pk2(x1l * s0 + x2l * c0, x1h * s1 + x2h * c1); }
                const int p1 = v, p2 = v + 3;
                if (tens) { *(u32x4*)(dst + ((p1 >> 1) * 64 + (p1 & 1) * 32) * 8) = o1; *(u32x4*)(dst + ((p2 >> 1) * 64 + (p2 & 1) * 32) * 8) = o2; }
                else { unsigned char* d8 = (unsigned char*)KSF + ((size_t)(((bl * 4 + g) * 128 + tile) * 2 + (rr >> 4)) * 6 * 64 + (rr & 15)) * 8;
                    *(fp8x8_t*)(d8 + ((p1 >> 2) * 64 + (p1 & 3) * 16) * 8) = pack_fp8x8(bflo(o1[0]), bfhi(o1[0]), bflo(o1[1]), bfhi(o1[1]), bflo(o1[2]), bfhi(o1[2]), bflo(o1[3]), bfhi(o1[3]));
                    *(fp8x8_t*)(d8 + ((p2 >> 2) * 64 + (p2 & 3) * 16) * 8) = pack_fp8x8(bflo(o2[0]), bfhi(o2[0]), bflo(o2[1]), bfhi(o2[1]), bflo(o2[2]), bfhi(o2[2]), bflo(o2[3]), bfhi(o2[3])); }
            } else { const int pc = v + 3; const u32x4 c = *(const u32x4*)(src + 8 * pc);
                if (tens) *(u32x4*)(dst + ((pc >> 1) * 64 + (pc & 1) * 32) * 8) = c;
                else { unsigned char* d8 = (unsigned char*)KSF + ((size_t)(((bl * 4 + g) * 128 + tile) * 2 + (rr >> 4)) * 6 * 64 + (rr & 15)) * 8;
                    *(fp8x8_t*)(d8 + ((pc >> 2) * 64 + (pc & 3) * 16) * 8) = pack_fp8x8(bflo(c[0]), bfhi(c[0]), bflo(c[1]), bfhi(c[1]), bflo(c[2]), bfhi(c[2]), bflo(c[3]), bfhi(c[3])); } }
        }
    }
}
DI float sigmoidf_(float x) { return __builtin_amdgcn_rcpf(1.0f + __builtin_amdgcn_exp2f(-x * LOG2E)); }
struct CmpMK { int tq, h, q0; DI bool need(int t) const { return 512 * t + 527 > q0; }
    DI void operator()(int t, f32x16& S) const {
#pragma unroll
    for (int i = 0; i < 16; ++i) { const int n = 32 * t + crow(i, h); S[i] = (16 * n + 31 <= tq) ? S[i] : -INFINITY; } } };
struct WinMK { int tq, h, qt; DI bool need(int t) const { return t == qt || t == qt - 16; }
    DI void operator()(int t, f32x16& S) const {
#pragma unroll
    for (int i = 0; i < 16; ++i) { const int k = 32 * t + crow(i, h); S[i] = (k <= tq && k > tq - 512) ? S[i] : -INFINITY; } } };
DI void ph_nsa_cmp(const Frame& F, const int half) {
    const float* c48 = (const float*)(F.ws + TAB_COS48); const float* s48 = (const float*)(F.ws + TAB_SIN48);
    unsigned char* ar = F.ws + WS_AR; const bf16* Q = (const bf16*)(ar + NA_Q); const bf16* KCMP = (const bf16*)(ar + NA_KCMP); const bf16* VCT = (const bf16*)(ar + NA_VCT); const bf16* GT = (const bf16*)(ar + NA_GT);
    unsigned char* SELB = ar + NA_SELB; bf16* Ob = (bf16*)(ar + NA_O);
    LAS float* imp = (LAS float*)F.lds;
    LAS unsigned char* kres = F.lds + 20480;
    LAS unsigned char* vring = F.lds + 20480 + 98304;
    const int lane = F.lane, r = lane & 31, h = lane >> 5, tid = F.tid;
    for (int u = blockIdx.x; u < BPH * 4 * 64; u += F.G) {
        const int bg = u >> 6, qt64 = ((u >> 8) & 1) ? 63 - (u & 63) : (u & 63), bl = bg >> 2, g = bg & 3;
        const int tqmaxb = qt64 * 64 + 63, TE = (tqmaxb >= 31) ? ((tqmaxb - 31) / 16) / 32 + 1 : 0;
        const bf16* ksrc = KCMP + (size_t)bg * 8 * 12 * 512; const bf16* vsrc = VCT + (size_t)bg * 8 * 8 * 512;
        for (int i = F.tid; i < 64 * 65; i += NWAVES * 64) imp[i] = 0.f;
        for (int p = tid; p < TE * 768; p += NWAVES * 64) *(LAS u32x4*)(kres + p * 16) = *(const u32x4*)(ksrc + (size_t)p * 8);
        __syncthreads();
#pragma unroll 1
        for (int k = 0; k < 3; ++k) {
            const int idx = F.wave * 3 + k, j = idx >> 1, sub = idx & 1, ql = sub * 32 + r, tq = qt64 * 64 + ql, hd = g * 12 + j;
            const size_t mrow = (size_t)bl * SEQ + tq;
            bf16x8 qf[12];
#pragma unroll
            for (int s = 3; s < 12; ++s) qf[s] = *(const bf16x8*)(Q + mrow * 9216 + hd * 192 + 16 * s + 8 * h);
            { const float* cs = c48 + ((size_t)half * MC + mrow) * 24; const float* sn = s48 + ((size_t)half * MC + mrow) * 24;
#pragma unroll
              for (int s = 0; s < 3; ++s) qf[s] = rope_frag32(Q + mrow * 9216 + hd * 192, s, h, cs, sn); }
            const int tqmax = qt64 * 64 + sub * 32 + 31, te = (tqmax >= 31) ? ((tqmax - 31) / 16) / 32 + 1 : 0;
            const CmpMK mk{tq, h, qt64 * 64 + sub * 32};
            float m = -INFINITY, l = 0.f;
            {
                f32x16 Od[4];
#pragma unroll 1
                for (int t = 0; t < te; ++t) {
                    const LAS unsigned char* cur = kres + t * 12288;
                    f32x16 S;
#pragma unroll
                    for (int i = 0; i < 16; ++i) S[i] = 0.f;
#pragma unroll
                    for (int s = 0; s < 12; ++s) S = MFMA32(*(const LAS bf16x8*)(cur + s * 1024 + lane * 16), qf[s], S);
                    if (mk.need(t)) mk(t, S);
                    bf16x8 pfd[2]; softmax_step<4, false>(S, m, l, Od, pfd);
                }
            }
            l += __shfl_xor(l, 32);
            const float linv = l > 0.f ? 1.0f / l : 0.f, ms = (m == -INFINITY) ? 0.f : m;
            f32x16 O[4];
#pragma unroll
            for (int db = 0; db < 4; ++db)
#pragma unroll
                for (int i = 0; i < 16; ++i) O[db][i] = 0.f;
            if (TE > 0) {
                u32x4 pv = *(const u32x4*)(vsrc + (size_t)tid * 8);
                *(LAS u32x4*)(vring + tid * 16) = pv;
                LDS_WAIT(); __builtin_amdgcn_s_barrier(); asm volatile("" ::: "memory");
#pragma unroll 1
                for (int t = 0; t < TE; ++t) {
                    const LAS unsigned char* cur = kres + t * 12288; const LAS unsigned char* vcur = vring + (t & 1) * 8192;
                    if (t + 1 < TE) pv = *(const u32x4*)(vsrc + ((size_t)(t + 1) * 512 + tid) * 8);
                    if (t < te) {
                        f32x16 S;
#pragma unroll
                        for (int i = 0; i < 16; ++i) S[i] = 0.f;
#pragma unroll
                        for (int s = 0; s < 12; ++s) S = MFMA32(*(const LAS bf16x8*)(cur + s * 1024 + lane * 16), qf[s], S);
                        if (mk.need(t)) mk(t, S);
#pragma unroll
                        for (int i = 0; i < 16; ++i) S[i] = __builtin_amdgcn_exp2f(S[i] - ms) * linv;
#pragma unroll
                        for (int g4 = 0; g4 < 4; ++g4) { const float gs = (S[4 * g4] + S[4 * g4 + 1]) + (S[4 * g4 + 2] + S[4 * g4 + 3]); const int mb = 8 * t + 2 * g4 + h;
                            __hip_atomic_fetch_add(imp + ql * 65 + mb, gs, __ATOMIC_RELAXED, __HIP_MEMORY_SCOPE_WORKGROUP);
                            if (mb + 1 < 64) __hip_atomic_fetch_add(imp + ql * 65 + mb + 1, S[4 * g4 + 3], __ATOMIC_RELAXED, __HIP_MEMORY_SCOPE_WORKGROUP); }
                        bf16x8 pf[2];
#pragma unroll
                        for (int s = 0; s < 2; ++s) { u32x4 w; w.x = pk2(S[8 * s], S[8 * s + 1]); w.y = pk2(S[8 * s + 2], S[8 * s + 3]); w.z = pk2(S[8 * s + 4], S[8 * s + 5]); w.w = pk2(S[8 * s + 6], S[8 * s + 7]); pf[s] = __builtin_bit_cast(bf16x8, w); }
#pragma unroll
                        for (int db = 0; db < 4; ++db)
#pragma unroll
                            for (int s = 0; s < 2; ++s) O[db] = MFMA32(*(const LAS bf16x8*)(vcur + (db * 2 + s) * 1024 + lane * 16), pf[s], O[db]);
                    }
                    if (t + 1 < TE) *(LAS u32x4*)(vring + ((t + 1) & 1) * 8192 + tid * 16) = pv;
                    LDS_WAIT(); __builtin_amdgcn_s_barrier(); asm volatile("" ::: "memory");
                }
            }
            const float gate = sigmoidf_(bf2f(GT[mrow * 256 + hd]));
            store_col<false>(Ob + mrow * 6144 + hd * 128, O, gate, h);
        }
        __syncthreads();
#pragma unroll 1
        for (int k = 0; k < 8; ++k) {
            const int ql = F.wave * 8 + k, tq = qt64 * 64 + ql, cur = tq >> 6, mb = lane;
            const bool causal = mb <= cur, forced = (mb == 0) || (mb == cur) || (mb == cur - 1);
            const float v = causal ? (forced ? INFINITY : imp[ql * 65 + mb]) : -INFINITY;
            int rank = 0;
            for (int o = 0; o < 64; ++o) { const float vo = __shfl(v, o); rank += (vo > v || (vo == v && o < mb)) ? 1 : 0; }
            if (rank < 16) SELB[((size_t)bg * 4096 + tq) * 16 + rank] = causal ? (unsigned char)mb : (unsigned char)0xFF;
        }
        __syncthreads();
    }
}
DI int sel_tile(const u32x4& sel, int t) { const int b = t >> 1; const unsigned w = (b < 4) ? sel.x : (b < 8) ? sel.y : (b < 12) ? sel.z : sel.w; return (int)((w >> ((b & 3) * 8)) & 0xFFu) * 2 + (t & 1); }
struct SelMK { u32x4 sel; int tq, h; DI void operator()(int t, f32x16& S) const { const int k0 = sel_tile(sel, t) * 32;
#pragma unroll
    for (int i = 0; i < 16; ++i) S[i] = (k0 + crow(i, h) <= tq) ? S[i] : -INFINITY; } };
typedef float f32x4_ __attribute__((ext_vector_type(4)));
#define MFMA16F8(a, b, c) __builtin_amdgcn_mfma_f32_16x16x32_fp8_fp8((a), (b), (c), 0, 0, 0)
DI void ph_nsa_sel(const Frame& F, const int half) {
    const float* c48 = (const float*)(F.ws + TAB_COS48); const float* s48 = (const float*)(F.ws + TAB_SIN48);
    unsigned char* ar = F.ws + WS_AR; const bf16* Q = (const bf16*)(ar + NA_Q); const unsigned char* KS8 = ar + NA_KSF; const unsigned char* VS8 = ar + NA_VSF; const bf16* GT = (const bf16*)(ar + NA_GT);
    const unsigned char* SELB = ar + NA_SELB; bf16* Ob = (bf16*)(ar + NA_O);
    const int c16 = F.lane & 15, kq = F.lane >> 4; const bool act = c16 < 12;
    for (int it = F.gw; it < BPH * 4 * SEQ; it += F.NGW) {
        const int bg = it >> 12, tq = ((it & 4095) + 256 * bg) & 4095, bl = bg >> 2, g = bg & 3; const size_t mrow = (size_t)bl * SEQ + tq; const int hd = g * 12 + (act ? c16 : 0);
        fp8x8_t qf[6];
#pragma unroll
        for (int s = 0; s < 6; ++s) { const float qs = act ? (1.0f / NSA_QSCALE) : 0.f; const int p = 4 * s + kq;
            if (s < 2 && p < 6) { float o[8]; rope_piece(Q + mrow * 9216 + hd * 192, p, c48 + ((size_t)half * MC + mrow) * 24, s48 + ((size_t)half * MC + mrow) * 24, o);
                qf[s] = pack_fp8x8(o[0] * qs, o[1] * qs, o[2] * qs, o[3] * qs, o[4] * qs, o[5] * qs, o[6] * qs, o[7] * qs); }
            else { const u32x4 q = *(const u32x4*)(Q + mrow * 9216 + hd * 192 + 32 * s + 8 * kq);
                qf[s] = pack_fp8x8(bflo(q[0]) * qs, bfhi(q[0]) * qs, bflo(q[1]) * qs, bfhi(q[1]) * qs, bflo(q[2]) * qs, bfhi(q[2]) * qs, bflo(q[3]) * qs, bfhi(q[3]) * qs); } }
        const u32x4 sel = *(const u32x4*)(SELB + ((size_t)bg * 4096 + tq) * 16);
        const int nv = ((tq >> 6) + 1 < 16) ? (tq >> 6) + 1 : 16, te = 2 * nv;
        const unsigned char* kb = KS8 + ((size_t)bg * 128 * 12 * 64 + F.lane) * 8; const unsigned char* vb = VS8 + ((size_t)bg * 128 * 8 * 64 + F.lane) * 8;
        f32x4_ O[8];
#pragma unroll
        for (int db = 0; db < 8; ++db) O[db] = (f32x4_){0.f, 0.f, 0.f, 0.f};
        float m = -INFINITY, l = 0.f;
        fp8x8_t kfA[12], kfB[12], vfA[8], vfB[8];
        { const unsigned char* kp = kb + (size_t)sel_tile(sel, 0) * 12 * 512; const unsigned char* kp1 = kb + (size_t)sel_tile(sel, 1) * 12 * 512; const unsigned char* vp = vb + (size_t)sel_tile(sel, 0) * 8 * 512;
#pragma unroll
          for (int s = 0; s < 12; ++s) { kfA[s] = *(const fp8x8_t*)(kp + s * 512); kfB[s] = *(const fp8x8_t*)(kp1 + s * 512); }
#pragma unroll
          for (int j = 0; j < 8; ++j) vfA[j] = *(const fp8x8_t*)(vp + j * 512); }
#define SEL_STEP(T_, KF_, VF_, VFN_) do { const int t_ = (T_); const int tile = sel_tile(sel, t_); \
            if (t_ + 1 < te) { const unsigned char* vp = vb + (size_t)sel_tile(sel, t_ + 1) * 8 * 512; _Pragma("unroll") for (int j = 0; j < 8; ++j) VFN_[j] = *(const fp8x8_t*)(vp + j * 512); } \
            f32x4_ S0 = {0.f, 0.f, 0.f, 0.f}, S1 = S0; \
            _Pragma("unroll") for (int s = 0; s < 6; ++s) { S0 = MFMA16F8(KF_[s], qf[s], S0); S1 = MFMA16F8(KF_[6 + s], qf[s], S1); } \
            if (t_ + 2 < te) { const unsigned char* kp = kb + (size_t)sel_tile(sel, t_ + 2) * 12 * 512; _Pragma("unroll") for (int s = 0; s < 12; ++s) KF_[s] = *(const fp8x8_t*)(kp + s * 512); } \
            const int k0 = tile * 32 + 4 * kq; float mx = -INFINITY; \
            _Pragma("unroll") for (int i = 0; i < 4; ++i) { S0[i] = (k0 + i <= tq) ? S0[i] * NSA_QSCALE : -INFINITY; S1[i] = (k0 + 16 + i <= tq) ? S1[i] * NSA_QSCALE : -INFINITY; mx = fmaxf(mx, fmaxf(S0[i], S1[i])); } \
            mx = fmaxf(mx, __shfl_xor(mx, 16)); mx = fmaxf(mx, __shfl_xor(mx, 32)); \
            const float mn = fmaxf(m, mx), ms = (mn == -INFINITY) ? 0.f : mn, alpha = __builtin_amdgcn_exp2f(m - ms); \
            float sum = 0.f; \
            _Pragma("unroll") for (int i = 0; i < 4; ++i) { S0[i] = __builtin_amdgcn_exp2f(S0[i] - ms); S1[i] = __builtin_amdgcn_exp2f(S1[i] - ms); sum += S0[i] + S1[i]; } \
            l = l * alpha + sum; m = mn; \
            if (__builtin_amdgcn_ballot_w64(alpha != 1.0f) != 0ull) { _Pragma("unroll") for (int db = 0; db < 8; ++db) O[db] = O[db] * alpha; } \
            const fp8x8_t p8 = pack_fp8x8(S0[0], S0[1], S0[2], S0[3], S1[0], S1[1], S1[2], S1[3]);       \
            _Pragma("unroll") for (int db = 0; db < 8; ++db) O[db] = MFMA16F8(VF_[db], p8, O[db]); } while (0)
#pragma unroll 1
        for (int t = 0; t < te; t += 2) { SEL_STEP(t, kfA, vfA, vfB); SEL_STEP(t + 1, kfB, vfB, vfA); }
#undef SEL_STEP
        l += __shfl_xor(l, 16); l += __shfl_xor(l, 32);
        if (act) { const float gate = sigmoidf_(bf2f(GT[mrow * 256 + 48 + hd])); const float sc = l > 0.f ? gate / l : 0.f;
            bf16* o = Ob + mrow * 6144 + hd * 128 + 4 * kq;
#pragma unroll
            for (int db = 0; db < 8; ++db) { u32x2* p = (u32x2*)(o + db * 16); const u32x2 prev = *p;
                u32x2 w; w.x = pk2(O[db][0] * sc + bflo(prev.x), O[db][1] * sc + bfhi(prev.x)); w.y = pk2(O[db][2] * sc + bflo(prev.y), O[db][3] * sc + bfhi(prev.y)); *p = w; } }
    }
}
DI void ph_nsa_win(const Frame& F, const int half) {
    const float* c48 = (const float*)(F.ws + TAB_COS48); const float* s48 = (const float*)(F.ws + TAB_SIN48);
    unsigned char* ar = F.ws + WS_AR; const bf16* Q = (const bf16*)(ar + NA_Q); const bf16* KWF = (const bf16*)(ar + NA_KWF); const bf16* VWF = (const bf16*)(ar + NA_VWF); const bf16* GT = (const bf16*)(ar + NA_GT); bf16* Ob = (bf16*)(ar + NA_O);
    const int r = F.lane & 31, h = F.lane >> 5;
    for (int idb = blockIdx.x; idb < BPH * 4 * 3 * 64; idb += F.G) {
        const int qt0 = (((idb & 63) + (idb >> 8)) & 63) * 2, qt = qt0 + (F.wave & 1), rest = idb >> 6, hq = rest % 3, bg = rest / 3, bl = bg >> 2, g = bg & 3, hd = g * 12 + hq * 4 + (F.wave >> 1), tq = qt * 32 + r; const size_t mrow = (size_t)bl * SEQ + tq;
        bf16x8 qf[12];
#pragma unroll
        for (int s = 3; s < 12; ++s) qf[s] = *(const bf16x8*)(Q + mrow * 9216 + hd * 192 + 16 * s + 8 * h);
        { const float* cs = c48 + ((size_t)half * MC + mrow) * 24; const float* sn = s48 + ((size_t)half * MC + mrow) * 24;
#pragma unroll
          for (int s = 0; s < 3; ++s) qf[s] = rope_frag32(Q + mrow * 9216 + hd * 192, s, h, cs, sn); }
        const FragSrc src{KWF + (size_t)bg * 128 * 12 * 512, VWF + (size_t)bg * 128 * 8 * 512, 12}; const WinMK mk{tq, h, qt};
        f32x16 O[4];
#pragma unroll
        for (int db = 0; db < 4; ++db)
#pragma unroll
            for (int i = 0; i < 16; ++i) O[db][i] = 0.f;
        float m = -INFINITY, l = 0.f;
        attn_run_d<12>(F.lds, F.tid, F.lane, qf, O, m, l, qt0 >= 16 ? qt0 - 16 : 0, qt0 + 2, qt >= 16 ? qt - 16 : 0, qt + 1, src, mk);
        l += __shfl_xor(l, 32);
        const float gate = sigmoidf_(bf2f(GT[mrow * 256 + 96 + hd]));
        store_col<true>(Ob + mrow * 6144 + hd * 128, O, l > 0.f ? gate / l : 0.f, h);
    }
}
#ifndef MK_ONE_LAUNCH
#define MK_ONE_LAUNCH 1
#endif
constexpr int NPH = 69;
struct Args { const float* in[58]; float* out; unsigned char* ws; int ph_lo, ph_hi; };
#define GEMM_AKOFF 0
#define GEMM_CALL(EpiT, Evar, Aptr, Bptr, Mv, Nv, Kv, ldav, ldbv, cidx) do { const pg8::Gemm g_{(const pg8::bf16_t*)(Aptr), (const pg8::bf16_t*)(Bptr), (Mv), (Nv), (Kv), (ldav), (ldbv), GEMM_AKOFF}; \
    pg8::StaticOrder S_; S_.init((Mv), (Nv), F.G, (cidx)); pg8::gemm_phase<EpiT, pg8::StaticOrder, true, true>((PG8_LAS unsigned char*)F.lds, g_, S_, Evar); } while (0)
DI pg8::EpiBf16R epi1(bf16* base, int ldc) { pg8::EpiBf16R e; for (int s = 0; s < 8; ++s) { e.T.base[s] = base; e.T.ldc[s] = ldc; e.T.t0[s] = 0; e.T.gw[s] = 0; } e.T.nseg = 1; e.T.pad_ = 0; e.ssp = nullptr; e.ss_off = 0; return e; }
#define PH_BEGIN if (ph >= lo && ph < hi) { Frame F; { unsigned long long w_ = (unsigned long long)args.ws; asm volatile("" : "+s"(w_)); F.ws = (unsigned char*)w_; F.ctl = (unsigned*)(F.ws + WS_CTL); } \
    F.lds = lds; F.tid = threadIdx.x; F.lane = F.tid & 63; F.wave = __builtin_amdgcn_readfirstlane(F.tid >> 6); F.G = gridDim.x; F.gw = blockIdx.x * NWAVES + F.wave; F.NGW = F.G * NWAVES; \
    float* out; { unsigned long long o_ = (unsigned long long)args.out; asm volatile("" : "+s"(o_)); out = (float*)o_; } \
    unsigned char* const ar = F.ws + WS_AR; bf16* const XN = (bf16*)(F.ws + WS_XNR); float* const SSB = (float*)(F.ws + WS_SS); bf16* const WB = (bf16*)(F.ws + WS_WMIX); bf16* const WUP = (bf16*)(F.ws + WS_WFFN); bf16* const WDN = WUP + (size_t)2 * DFF * DM; \
    const float* const res_mix = (ib == 2) ? args.in[0] : (const float*)out; (void)ar; (void)XN; (void)SSB; (void)WB; (void)WUP; (void)WDN; (void)res_mix; (void)iff;
#define PH_END   if (ph + 1 < hi) { XcdBarrier b_; b_.bar = (unsigned*)F.ctl + CW_BAR; b_.x = xb_xcc_id(); b_.st = MISC + 8; xcd_barrier(b_); } } ++ph;
template <int LAYER> DI void run_cvt(const Args& args, LAS unsigned char* lds, volatile LAS unsigned* MISC, int& ph, const int lo, const int hi) {
    constexpr int ib = (LAYER == 0) ? 2 : (LAYER == 1) ? 17 : (LAYER == 2) ? 26 : 42;
    constexpr int iff = (LAYER == 0) ? 12 : (LAYER == 1) ? 21 : (LAYER == 2) ? 37 : 52;
    constexpr int kind = (LAYER == 1) ? 1 : (LAYER == 2) ? 2 : 0;
        PH_BEGIN
            if constexpr (LAYER == 0) { ph_tables(F, (const int*)args.in[1]); ph_norm_first(F, args.in[0], args.in[2], XN, SSB); }
            if constexpr (kind == 0) ph_dsa_cvt(F, args.in[ib + 1], args.in[ib + 6], args.in[ib + 7], args.in[ib + 8], args.in[ib + 9]);
            else if constexpr (kind == 1) ph_fox_cvt(F, args.in[ib + 1], args.in[ib + 3]);
            else ph_nsa_cvt(F, args.in[ib + 1], args.in[ib + 2], args.in[ib + 3], args.in[ib + 4], args.in[ib + 5], args.in[ib + 6], args.in[ib + 7], args.in[ib + 8], args.in[ib + 9], args.in[ib + 10]);
            ph_cvt_ffn(F, args.in[iff + 1], args.in[iff + 4]);
        PH_END
}
template <int LAYER, int HALF> DI void run_half(const Args& args, LAS unsigned char* lds, volatile LAS unsigned* MISC, int& ph, const int lo, const int hi) {
    constexpr int ib = (LAYER == 0) ? 2 : (LAYER == 1) ? 17 : (LAYER == 2) ? 26 : 42;
    constexpr int iff = (LAYER == 0) ? 12 : (LAYER == 1) ? 21 : (LAYER == 2) ? 37 : 52;
    constexpr int kind = (LAYER == 1) ? 1 : (LAYER == 2) ? 2 : 0;
    constexpr int half = HALF;
            const int roff = half * MC;
            if constexpr (kind == 0) {
                PH_BEGIN { pg8::EpiF32 E{(float*)(ar + DA_DIN), 1024, SSB + (size_t)(LAYER * 2) * MTOT * 8, roff}; GEMM_CALL(pg8::EpiF32, E, XN + (size_t)roff * DM, WB + DW_W1, MC, 1024, DM, DM, DM, (int)blockIdx.x); } PH_END
                PH_BEGIN ph_dsa_post1(F, half, args.in[ib + 2], args.in[ib + 3], args.in[ib + 4], args.in[ib + 5]); PH_END
                PH_BEGIN { pg8::EpiBf16R E = epi1((bf16*)(ar + DA_QL), 8192); E.T.base[1] = (bf16*)(ar + DA_QPE); E.T.ldc[1] = 1536; E.T.t0[1] = 32; E.T.base[2] = (bf16*)(ar + DA_QIDX); E.T.ldc[2] = 2048; E.T.t0[2] = 38; E.T.nseg = 3;
                    GEMM_CALL(pg8::EpiBf16R, E, ar + DA_CQN, WB + DW_W2, MC, 11776, 512, 512, 512, (int)blockIdx.x); } PH_END
                PH_BEGIN ph_dsa_index(F, half); PH_END
                PH_BEGIN ph_dsa_attn(F, half); PH_END
                PH_BEGIN {
                    pg8::EpiBf16R E = epi1((bf16*)(ar + DA_O2), 4096);
                    { const pg8::Gemm g_{(const pg8::bf16_t*)(ar + DA_QL), (const pg8::bf16_t*)(WB + DW_BD), MC, 4096, 512, 8192, 512, 512}; pg8::StaticOrder S_; S_.init(MC, 4096, F.G, (int)blockIdx.x);
                      pg8::gemm_phase<pg8::EpiBf16R, pg8::StaticOrder, true, true>((PG8_LAS unsigned char*)F.lds, g_, S_, E); } } PH_END
                PH_BEGIN { pg8::EpiResN E{LAYER == 0 ? args.in[0] : nullptr, args.in[ib], nullptr, DM, roff, args.in[iff], (pg8::bf16_t*)XN, SSB + (size_t)(LAYER * 2 + 1) * MTOT * 8, (PG8_LAS float*)(F.lds + LDSCTL_OFF + 256)}; GEMM_CALL(pg8::EpiResN, E, ar + DA_O2, WB + DW_WO, MC, DM, 4096, 4096, 4096, (int)blockIdx.x); } PH_END
            } else if constexpr (kind == 1) {
                PH_BEGIN {
                    { pg8::EpiBf16R E = epi1((bf16*)(ar + FA_Q), DM); E.T.base[1] = (bf16*)(ar + FA_KF); E.T.ldc[1] = 9; E.T.t0[1] = 8; E.T.gw[1] = -3;
                      E.T.base[2] = (bf16*)(ar + FA_F); E.T.ldc[2] = 256; E.T.t0[2] = 16; E.T.nseg = 3; E.ssp = SSB + (size_t)(LAYER * 2) * MTOT * 8; E.ss_off = roff;
                      GEMM_CALL(pg8::EpiBf16R, E, XN + (size_t)roff * DM, WB + FW_IN, MC, 4352, DM, DM, DM, (int)blockIdx.x); }
                    { pg8::EpiBf16R E = epi1((bf16*)(ar + FA_VF), 16); E.T.gw[0] = -4; E.ssp = SSB + (size_t)(LAYER * 2) * MTOT * 8; E.ss_off = roff;
                      GEMM_CALL(pg8::EpiBf16R, E, WB + FW_IN + (size_t)4352 * DM, XN + (size_t)roff * DM, DM, MC, DM, DM, DM, (int)((blockIdx.x + F.G - 64) % F.G)); }
                } PH_END
                PH_BEGIN ph_fox_scan(F, args.in[ib + 2]); PH_END
                PH_BEGIN ph_fox_attn(F); PH_END
                PH_BEGIN { pg8::EpiResN E{LAYER == 0 ? args.in[0] : nullptr, args.in[ib], nullptr, DM, roff, args.in[iff], (pg8::bf16_t*)XN, SSB + (size_t)(LAYER * 2 + 1) * MTOT * 8, (PG8_LAS float*)(F.lds + LDSCTL_OFF + 256)}; GEMM_CALL(pg8::EpiResN, E, ar + FA_O, WB + FW_OUT, MC, DM, DM, DM, DM, (int)blockIdx.x); } PH_END
            } else {
                PH_BEGIN { pg8::EpiBf16R E = epi1((bf16*)(ar + NA_Q), 9216);
                    E.T.base[1] = (bf16*)(ar + NA_KC); E.T.ldc[1] = 192; E.T.t0[1] = 36; E.T.gw[1] = 192;
                    E.T.base[2] = (bf16*)(ar + NA_VC); E.T.ldc[2] = 128; E.T.t0[2] = 39; E.T.gw[2] = 128;
                    E.T.base[3] = (bf16*)(ar + NA_KSR); E.T.ldc[3] = 768; E.T.t0[3] = 41;
                    E.T.base[4] = (bf16*)(ar + NA_KWR); E.T.ldc[4] = 768; E.T.t0[4] = 44;
                    E.T.base[5] = (bf16*)(ar + NA_GT); E.T.ldc[5] = 256; E.T.t0[5] = 47; E.T.nseg = 6; E.ssp = SSB + (size_t)(LAYER * 2) * MTOT * 8; E.ss_off = roff;
                    GEMM_CALL(pg8::EpiBf16R, E, XN + (size_t)roff * DM, WB + NW_IN, MC, 12288, DM, DM, DM, (int)blockIdx.x);
                    { pg8::EpiBf16R E2 = epi1((bf16*)(ar + NA_VSF), 4); E2.T.gw[0] = -5; E2.ssp = E.ssp; E2.ss_off = roff;
                      GEMM_CALL(pg8::EpiBf16R, E2, WB + NW_IN + (size_t)12288 * DM, XN + (size_t)roff * DM, 512, MC, DM, DM, DM, (int)blockIdx.x); }
                    { pg8::EpiBf16R E2 = epi1((bf16*)(ar + NA_VWF), 4); E2.T.gw[0] = -4; E2.ssp = E.ssp; E2.ss_off = roff;
                      GEMM_CALL(pg8::EpiBf16R, E2, WB + NW_IN + (size_t)12800 * DM, XN + (size_t)roff * DM, 512, MC, DM, DM, DM, (int)((blockIdx.x + F.G - 128) % F.G)); } } PH_END
                PH_BEGIN ph_nsa_rope(F, half); PH_END
                PH_BEGIN {
                    const float* BIAS = (const float*)(args.ws + WS_MISC);
                    { pg8::EpiGelu E{(bf16*)(ar + NA_GK), 256, BIAS}; GEMM_CALL(pg8::EpiGelu, E, ar + NA_KC, WB + NW_W1K, 4096, 256, 6144, 3072, 6144, (int)blockIdx.x); }
                    { pg8::EpiGelu E{(bf16*)(ar + NA_GV), 256, BIAS + 256}; GEMM_CALL(pg8::EpiGelu, E, ar + NA_VC, WB + NW_W1V, 4096, 256, 4096, 2048, 4096, (int)((blockIdx.x + F.G - 16) % F.G)); }
                } PH_END
                PH_BEGIN {
                    { pg8::EpiBf16R E = epi1((bf16*)(ar + NA_KCMP), 12); E.T.gw[0] = -1; GEMM_CALL(pg8::EpiBf16R, E, ar + NA_GK, WB + NW_W2K, 4096, 256, 256, 256, 256, (int)blockIdx.x); }
                    { pg8::EpiBf16R E = epi1((bf16*)(ar + NA_VCT), 4); E.T.gw[0] = -2; GEMM_CALL(pg8::EpiBf16R, E, WB + NW_W2V, ar + NA_GV, 256, 4096, 256, 256, 256, (int)((blockIdx.x + F.G - 16) % F.G)); }
                } PH_END
                PH_BEGIN ph_nsa_cmp(F, half); PH_END
                PH_BEGIN ph_nsa_sel(F, half); PH_END
                PH_BEGIN ph_nsa_win(F, half); PH_END
                PH_BEGIN { pg8::EpiResN E{LAYER == 0 ? args.in[0] : nullptr, args.in[ib], nullptr, DM, roff, args.in[iff], (pg8::bf16_t*)XN, SSB + (size_t)(LAYER * 2 + 1) * MTOT * 8, (PG8_LAS float*)(F.lds + LDSCTL_OFF + 256)}; GEMM_CALL(pg8::EpiResN, E, ar + NA_O, WB + NW_OUT, MC, DM, 6144, 6144, 6144, (int)blockIdx.x); } PH_END
            }
}
template <int LAYER> DI void run_ffn(const Args& args, LAS unsigned char* lds, volatile LAS unsigned* MISC, int& ph, const int lo, const int hi) {
    constexpr int ib = (LAYER == 0) ? 2 : (LAYER == 1) ? 17 : (LAYER == 2) ? 26 : 42;
    constexpr int iff = (LAYER == 0) ? 12 : (LAYER == 1) ? 21 : (LAYER == 2) ? 37 : 52;
    PH_BEGIN {
        LAS float* rt = (LAS float*)(F.lds + LDSCTL_OFF + 256 + 8192); const int rbase = 4096 * (int)(blockIdx.x & 7); const float* ssq = SSB + (size_t)(LAYER * 2 + 1) * MTOT * 8;
        for (int i = F.tid; i < 4096; i += NWAVES * 64) rt[i] = pg8::rms_rowscale(ssq, rbase + i);
        __syncthreads();
        pg8::EpiConvGlu E{(pg8::bf16_t*)ar, (float*)(ar + 352 * MiB), args.in[iff + 2], args.in[iff + 3], (PG8_LAS float*)(F.lds + LDSCTL_OFF + 256), DFF, (const PG8_LAS float*)rt, rbase};
        GEMM_CALL(pg8::EpiConvGlu, E, XN, WUP, MTOT, 2 * DFF, DM, DM, DM, (int)blockIdx.x); } PH_END
    PH_BEGIN ph_conv_fix(F, (const float*)(ar + 352 * MiB), (bf16*)ar, args.in[iff + 2], args.in[iff + 3], MTOT); PH_END
    PH_BEGIN {
        if constexpr (LAYER < 3) { constexpr int ibn = (LAYER == 0) ? 17 : (LAYER == 1) ? 26 : 42;
            pg8::EpiResN E{nullptr, args.in[iff], nullptr, DM, 0, args.in[ibn], (pg8::bf16_t*)XN, SSB + (size_t)((LAYER + 1) * 2) * MTOT * 8, (PG8_LAS float*)(F.lds + LDSCTL_OFF + 256)}; GEMM_CALL(pg8::EpiResN, E, ar, WDN, MTOT, DM, DFF, DFF, DFF, (int)blockIdx.x); }
        else { pg8::EpiResN E{nullptr, args.in[iff], nullptr, DM, 0, args.in[57], (pg8::bf16_t*)XN, SSB, (PG8_LAS float*)(F.lds + LDSCTL_OFF + 256)}; GEMM_CALL(pg8::EpiResN, E, ar, WDN, MTOT, DM, DFF, DFF, DFF, (int)blockIdx.x); }
    } PH_END
}
__global__ void __launch_bounds__(NWAVES * 64, 2) mk_fwd(Args args) {
    extern __shared__ __attribute__((aligned(16))) unsigned char lds_[];
    LAS unsigned char* const lds = (LAS unsigned char*)lds_;
    volatile LAS unsigned* MISC = (volatile LAS unsigned*)(lds + LDSCTL_OFF);
    for (int u = threadIdx.x; u < 64; u += NWAVES * 64) ((LAS unsigned*)(lds + LDSCTL_OFF))[u] = 0u;
    __syncthreads();
    const int lo = args.ph_lo, hi = args.ph_hi;
    (void)xcd_barrier_post((unsigned*)(args.ws + WS_CTL) + CW_BAR, MISC + 8);
    int ph = 0;
    run_cvt<0>(args, lds, MISC, ph, lo, hi); run_half<0, 0>(args, lds, MISC, ph, lo, hi); run_half<0, 1>(args, lds, MISC, ph, lo, hi); run_ffn<0>(args, lds, MISC, ph, lo, hi);
    run_cvt<1>(args, lds, MISC, ph, lo, hi); run_half<1, 0>(args, lds, MISC, ph, lo, hi); run_half<1, 1>(args, lds, MISC, ph, lo, hi); run_ffn<1>(args, lds, MISC, ph, lo, hi);
    run_cvt<2>(args, lds, MISC, ph, lo, hi); run_half<2, 0>(args, lds, MISC, ph, lo, hi); run_half<2, 1>(args, lds, MISC, ph, lo, hi); run_ffn<2>(args, lds, MISC, ph, lo, hi);
    run_cvt<3>(args, lds, MISC, ph, lo, hi); run_half<3, 0>(args, lds, MISC, ph, lo, hi); run_half<3, 1>(args, lds, MISC, ph, lo, hi); run_ffn<3>(args, lds, MISC, ph, lo, hi);
    { constexpr int ib = 42, iff = 52; PH_BEGIN ph_final_norm(F, (const bf16*)XN, SSB, out); PH_END }
}
extern "C" void kernel_launch(void* const* d_in, const int* in_sizes, int n_in, void* d_out, int out_size, void* d_ws, size_t ws_size, hipStream_t stream) {
    static int grid = 0;
    if (grid == 0) {
        if (n_in != 58 || out_size != MTOT * DM || ws_size < WS_END) { fprintf(stderr, "kernel_launch: unexpected shapes (n_in %d, out %d, ws %zu)\n", n_in, out_size, ws_size); grid = -1; return; }
        int dev = 0, cus = 0;
        if (hipGetDevice(&dev) != hipSuccess || hipDeviceGetAttribute(&cus, hipDeviceAttributeMultiprocessorCount, dev) != hipSuccess) { grid = -1; return; }
        if (hipFuncSetAttribute((const void*)mk_fwd, hipFuncAttributeMaxDynamicSharedMemorySize, LDS_BYTES) != hipSuccess) { fprintf(stderr, "kernel_launch: hipFuncSetAttribute failed\n"); grid = -1; return; }
        int per_cu = 0;
        (void)hipOccupancyMaxActiveBlocksPerMultiprocessor(&per_cu, (const void*)mk_fwd, NWAVES * 64, LDS_BYTES);
        (void)hipGetLastError();
        grid = cus;
    }
    if (grid < 0) return;
    if (hipMemsetAsync((char*)d_ws + WS_CTL, 0, CTL_ZERO_BYTES, stream) != hipSuccess) return;
    Args a{};
    for (int i = 0; i < 58; ++i) a.in[i] = (const float*)d_in[i];
    a.out = (float*)d_out; a.ws = (unsigned char*)d_ws;
#if MK_ONE_LAUNCH
    a.ph_lo = 0; a.ph_hi = NPH;
    hipLaunchKernelGGL(mk_fwd, dim3(grid), dim3(NWAVES * 64), LDS_BYTES, stream, a);
#else
    for (int p = 0; p < NPH; ++p) { a.ph_lo = p; a.ph_hi = p + 1; hipLaunchKernelGGL(mk_fwd, dim3(grid), dim3(NWAVES * 64), LDS_BYTES, stream, a); }
#endif
}
```
